# Optimizing an MI355X kernel written in HIP

```python
import math
import jax, jax.numpy as jnp
from jax import lax
import numpy as np

D_MODEL = 1024
BATCH = 2
SEQ = 8192
DEPTH = 4

CHUNK = 64
Q_BLOCK = 128
ROPE_THETA = 10000.0
EPS = 1e-6
D_FF = 2816
N_BRANCH = 4
MIX_WIDTH = 512

DA_HEADS = 4
DA_QK_DIM = 64
DA_V_DIM = 128
GLA_HEADS = 4
GLA_DK = 64
GLA_DV = 128
GLA_GATE_RANK = 16
GLA_GATE_TAU = 16.0
SSD_HEADS = 8
SSD_HEAD_DIM = 64
SSD_GROUPS = 2
SSD_STATE = 128
SSD_CONV = 4
SSD_INNER = SSD_HEADS * SSD_HEAD_DIM
SSD_CONV_DIM = SSD_INNER + 2 * SSD_GROUPS * SSD_STATE
RW_HEADS = 8
RW_HEAD = 64
RW_DIM = RW_HEADS * RW_HEAD
RW_DECAY_RANK = 64
RW_A_RANK = 64
RW_GATE_RANK = 128
RW_DECAY_SCALE = 0.606531
RW_GN_EPS = 64e-5

DA_SIZES = (DA_HEADS * 2 * DA_QK_DIM, DA_HEADS * 2 * DA_QK_DIM, DA_HEADS * DA_V_DIM)
GLA_SIZES = (GLA_HEADS * GLA_DK, GLA_HEADS * GLA_DK, GLA_HEADS * GLA_DV, GLA_HEADS * GLA_DV, GLA_GATE_RANK)
SSD_SIZES = (SSD_INNER, SSD_CONV_DIM, SSD_HEADS)
RW_SIZES = (RW_DIM, RW_DIM, RW_DIM, RW_DECAY_RANK, RW_A_RANK, RW_GATE_RANK)
GATE_COLS = N_BRANCH * D_MODEL
MIXER_COLS = (sum(DA_SIZES), sum(GLA_SIZES), sum(SSD_SIZES), sum(RW_SIZES), GATE_COLS)
N_IN = sum(MIXER_COLS)

kernel_name = "hybrid_gated_diffattn_gla_ssd_rwkv7_macaron"


def rmsnorm(x, g, eps=EPS):
    xf = x.astype(jnp.float32)
    y = xf * lax.rsqrt(jnp.mean(jnp.square(xf), axis=-1, keepdims=True) + eps)
    return (y * g.astype(jnp.float32)).astype(x.dtype)


def swiglu_ffn(x, wg, wu, wd):
    return (jax.nn.silu(x @ wg) * (x @ wu)) @ wd


def split_cols(t, sizes):
    return jnp.split(t, np.cumsum(sizes)[:-1].tolist(), axis=-1)


def token_shift(t):
    return jnp.pad(t, ((0, 0), (1, 0), (0, 0)))[:, :-1]


def to_chunks(t):
    B, S, H = t.shape[:3]
    t = t.reshape((B, S // CHUNK, CHUNK, H) + t.shape[3:])
    return jnp.moveaxis(t, (1, 3), (0, 2))


def from_chunks(t):
    n, B, H, C, d = t.shape
    return jnp.moveaxis(t, (0, 2), (1, 3)).reshape(B, n * C, H, d)


def rope(t):
    S, d = t.shape[1], t.shape[-1]
    half = d // 2
    inv_freq = ROPE_THETA ** (-jnp.arange(half, dtype=jnp.float32) / half)
    ang = jnp.arange(S, dtype=jnp.float32)[:, None] * inv_freq[None, :]
    cos = jnp.cos(ang)[None, :, None, :]
    sin = jnp.sin(ang)[None, :, None, :]
    tf = t.astype(jnp.float32)
    t1, t2 = tf[..., :half], tf[..., half:]
    return jnp.concatenate([t1 * cos - t2 * sin, t2 * cos + t1 * sin], axis=-1).astype(t.dtype)


def causal_depthwise_conv(x, w, b):
    K, C = w.shape
    xp = jnp.pad(x, ((0, 0), (K - 1, 0), (0, 0)))
    y = lax.conv_general_dilated(xp, w[:, None, :].astype(x.dtype), window_strides=(1,), padding='VALID',
                                 dimension_numbers=('NWC', 'WIO', 'NWC'), feature_group_count=C)
    return y + b


def differential_attention(q, k, v, lam, lam_init, norm_g):
    B, S, H, _, dq = q.shape
    q = rope(q.reshape(B, S, H * 2, dq)).reshape(B, S, H, 2, dq) * (dq ** -0.5)
    k = rope(k.reshape(B, S, H * 2, dq)).reshape(B, S, H, 2, dq)
    n_blk = S // Q_BLOCK
    q_blocks = jnp.moveaxis(q.reshape(B, n_blk, Q_BLOCK, H, 2, dq), 1, 0)
    key_chunk = jnp.arange(S) // CHUNK

    def attend(args):
        q_blk, blk = args
        query_chunk = (blk * Q_BLOCK + jnp.arange(Q_BLOCK)) // CHUNK
        allowed = key_chunk[None, :] <= query_chunk[:, None]
        s = jnp.einsum('bqhcd,bkhcd->bhcqk', q_blk, k).astype(jnp.float32)
        p = jax.nn.softmax(jnp.where(allowed, s, -jnp.inf), axis=-1)
        a = p[:, :, 0] - lam * p[:, :, 1]
        return jnp.einsum('bhqk,bkhd->bqhd', a.astype(v.dtype), v)

    o = lax.map(attend, (q_blocks, jnp.arange(n_blk)))
    o = jnp.moveaxis(o, 0, 1).reshape(B, S, H, -1)
    o = rmsnorm(o, norm_g) * (1.0 - lam_init)
    return o.reshape(B, S, -1)


def gla_chunked(q, k, v, log_g):
    B, S, H, dk = q.shape
    dv = v.shape[-1]
    f32 = jnp.float32
    qc, kc, vc, gc = (to_chunks(t.astype(f32)) for t in (q, k, v, log_g))
    G = jnp.cumsum(gc, axis=3)
    G_ref = G[:, :, :, CHUNK // 2:CHUNK // 2 + 1]
    causal = jnp.tril(jnp.ones((CHUNK, CHUNK), bool))
    att = jnp.einsum('cbhik,cbhjk->cbhij', qc * jnp.exp(G - G_ref), kc * jnp.exp(G_ref - G))
    att = jnp.where(causal, att, 0.0)
    y_intra = jnp.einsum('cbhij,cbhjv->cbhiv', att, vc)
    G_last = G[:, :, :, -1]
    chunk_kv = jnp.einsum('cbhjk,cbhjv->cbhkv', kc * jnp.exp(G_last[:, :, :, None] - G), vc)
    q_in = qc * jnp.exp(G)

    def step(state, inp):
        dec, kv, qi = inp
        y = jnp.einsum('bhik,bhkv->bhiv', qi, state)
        return jnp.exp(dec)[..., None] * state + kv, y

    _, y_inter = lax.scan(step, jnp.zeros((B, H, dk, dv), f32), (G_last, chunk_kv, q_in))
    return from_chunks(y_intra + y_inter)


def ssd_chunked(x, dt, A, bm, cm):
    B, S, H, P = x.shape
    N = bm.shape[-1]
    f32 = jnp.float32
    xc = to_chunks(x.astype(f32) * dt[..., None])
    bc = to_chunks(bm.astype(f32))
    cc = to_chunks(cm.astype(f32))
    acum = jnp.cumsum(to_chunks(dt * A), axis=-1)
    causal = jnp.tril(jnp.ones((CHUNK, CHUNK), bool))
    L = jnp.exp(jnp.where(causal, acum[..., :, None] - acum[..., None, :], -jnp.inf))
    scores = jnp.einsum('cbhin,cbhjn->cbhij', cc, bc) * L
    y_intra = jnp.einsum('cbhij,cbhjp->cbhip', scores, xc)
    decay_to_end = jnp.exp(acum[..., -1:] - acum)
    chunk_states = jnp.einsum('cbhjn,cbhj,cbhjp->cbhpn', bc, decay_to_end, xc)
    c_in = cc * jnp.exp(acum)[..., None]
    chunk_decay = jnp.exp(acum[..., -1])

    def step(h, inp):
        dec, st, ci = inp
        y = jnp.einsum('bhin,bhpn->bhip', ci, h)
        return dec[..., None, None] * h + st, y

    _, y_inter = lax.scan(step, jnp.zeros((B, H, P, N), f32), (chunk_decay, chunk_states, c_in))
    return from_chunks(y_intra + y_inter)


def rwkv7_recurrence(r, w, k, v, kk, a):
    B, S, H, N = r.shape

    def step(state, inp):
        r_t, w_t, k_t, v_t, kk_t, a_t = inp
        sa = jnp.einsum('bhvk,bhk->bhv', state, -kk_t)
        state = (state * w_t[:, :, None, :] + sa[..., None] * (kk_t * a_t)[:, :, None, :]
                 + v_t[..., None] * k_t[:, :, None, :])
        return state, jnp.einsum('bhvk,bhk->bhv', state, r_t)

    xs = tuple(jnp.moveaxis(t.astype(jnp.float32), 1, 0) for t in (r, w, k, v, kk, a))
    _, y = lax.scan(step, jnp.zeros((B, H, N, N), jnp.float32), xs)
    return jnp.moveaxis(y, 0, 1)


def hybrid_token_mixer(u, lidx, w_in, da_lambda_q1, da_lambda_k1, da_lambda_q2, da_lambda_k2, da_norm,
                       gla_gate_w2, gla_gate_b, gla_norm,
                       ssd_conv_w, ssd_conv_b, ssd_dt_bias, ssd_a_log, ssd_d, ssd_norm,
                       rw_mu, rw_w0, rw_w2, rw_a0, rw_a2, rw_g2, rw_k_k, rw_k_a, rw_r_k, rw_norm_w, rw_norm_b,
                       w_branch, gate_b, w_out):
    B, S, _ = u.shape
    f32 = jnp.float32
    p = u @ w_in
    p_da, p_gla, p_ssd, p_rw, p_gate = split_cols(p, MIXER_COLS)

    q, k, v = split_cols(p_da, DA_SIZES)
    lam_init = 0.8 - 0.6 * math.exp(-0.3 * lidx)
    lam = (jnp.exp(jnp.sum(da_lambda_q1.astype(f32) * da_lambda_k1.astype(f32)))
           - jnp.exp(jnp.sum(da_lambda_q2.astype(f32) * da_lambda_k2.astype(f32))) + lam_init)
    y_a = differential_attention(q.reshape(B, S, DA_HEADS, 2, DA_QK_DIM), k.reshape(B, S, DA_HEADS, 2, DA_QK_DIM),
                                 v.reshape(B, S, DA_HEADS, DA_V_DIM), lam, lam_init, da_norm)

    q, k, v, og, glr = split_cols(p_gla, GLA_SIZES)
    log_g = jax.nn.log_sigmoid((glr @ gla_gate_w2 + gla_gate_b).astype(f32)) / GLA_GATE_TAU
    o = gla_chunked(q.reshape(B, S, GLA_HEADS, GLA_DK) * (GLA_DK ** -0.5), k.reshape(B, S, GLA_HEADS, GLA_DK),
                    v.reshape(B, S, GLA_HEADS, GLA_DV), log_g.reshape(B, S, GLA_HEADS, GLA_DK))
    y_b = rmsnorm(o, gla_norm).reshape(B, S, -1).astype(u.dtype) * jax.nn.silu(og)

    z, xbc, dt = split_cols(p_ssd, SSD_SIZES)
    xbc = jax.nn.silu(causal_depthwise_conv(xbc, ssd_conv_w, ssd_conv_b))
    xs, bm, cm = split_cols(xbc, (SSD_INNER, SSD_GROUPS * SSD_STATE, SSD_GROUPS * SSD_STATE))
    dt = jax.nn.softplus((dt + ssd_dt_bias).astype(f32))
    A = -jnp.exp(ssd_a_log.astype(f32))
    rep = SSD_HEADS // SSD_GROUPS
    bm = jnp.repeat(bm.reshape(B, S, SSD_GROUPS, SSD_STATE), rep, axis=2)
    cm = jnp.repeat(cm.reshape(B, S, SSD_GROUPS, SSD_STATE), rep, axis=2)
    xh = xs.reshape(B, S, SSD_HEADS, SSD_HEAD_DIM)
    y = ssd_chunked(xh, dt, A, bm, cm) + ssd_d.astype(f32)[:, None] * xh.astype(f32)
    y = y.reshape(B, S, SSD_INNER) * jax.nn.silu(z.astype(f32))
    y_c = rmsnorm(y.reshape(B, S, SSD_GROUPS, -1), ssd_norm.reshape(SSD_GROUPS, -1)).reshape(B, S, SSD_INNER)
    y_c = y_c.astype(u.dtype)

    p_rw = p_rw + (token_shift(p_rw) - p_rw) * rw_mu
    r, k, v, wlr, alr, glr = split_cols(p_rw, RW_SIZES)
    log_w = -RW_DECAY_SCALE * jax.nn.sigmoid((rw_w0 + jnp.tanh(wlr) @ rw_w2).astype(f32))
    a = jax.nn.sigmoid((rw_a0 + alr @ rw_a2).astype(f32))
    g = jax.nn.sigmoid(glr) @ rw_g2
    hs = (B, S, RW_HEADS, RW_HEAD)
    kk = (k.astype(f32) * rw_k_k.astype(f32)).reshape(hs)
    kk = kk / jnp.maximum(jnp.sqrt(jnp.sum(kk * kk, axis=-1, keepdims=True)), 1e-12)
    k = k.astype(f32) * (1.0 + (a - 1.0) * rw_k_a.astype(f32))
    r4, k4, v4, a4 = r.astype(f32).reshape(hs), k.reshape(hs), v.astype(f32).reshape(hs), a.reshape(hs)
    y = rwkv7_recurrence(r4, jnp.exp(log_w).reshape(hs), k4, v4, kk, a4)
    mu = jnp.mean(y, axis=-1, keepdims=True)
    var = jnp.mean(jnp.square(y - mu), axis=-1, keepdims=True)
    y = ((y - mu) * lax.rsqrt(var + RW_GN_EPS)).reshape(B, S, RW_DIM) * rw_norm_w.astype(f32) + rw_norm_b.astype(f32)
    bonus = jnp.sum(r4 * k4 * rw_r_k.astype(f32).reshape(RW_HEADS, RW_HEAD), axis=-1, keepdims=True) * v4
    y_d = ((y + bonus.reshape(B, S, RW_DIM)) * g.astype(f32)).astype(u.dtype)

    ys = jnp.stack([y_a.astype(u.dtype), y_b.astype(u.dtype), y_c, y_d], axis=2)
    proj = jnp.einsum('bsnc,ncd->bsnd', ys, w_branch)
    gates = jax.nn.sigmoid(p_gate.reshape(B, S, N_BRANCH, D_MODEL) + gate_b)
    merged = jnp.sum(gates * proj, axis=2)
    return merged @ w_out


def setup_inputs(seed: int = 0) -> dict:
    key = jax.random.key(seed)
    ks = iter(jax.random.split(key, 64))
    L, D, F = DEPTH, D_MODEL, D_FF

    def nrm(shape, scale):
        return jax.random.normal(next(ks), shape, jnp.float32) * scale

    def gain(shape):
        return 1.0 + nrm(shape, 0.01)

    x = nrm((BATCH, SEQ, D), 1.0)
    ffn1_norm = gain((L, D))
    ffn1_wg = nrm((L, D, F), D ** -0.5)
    ffn1_wu = nrm((L, D, F), D ** -0.5)
    ffn1_wd = nrm((L, F, D), F ** -0.5)
    mix_norm = gain((L, D))
    w_in = nrm((L, D, N_IN), D ** -0.5)
    da_lambda_q1 = nrm((L, DA_QK_DIM), 0.1)
    da_lambda_k1 = nrm((L, DA_QK_DIM), 0.1)
    da_lambda_q2 = nrm((L, DA_QK_DIM), 0.1)
    da_lambda_k2 = nrm((L, DA_QK_DIM), 0.1)
    da_norm = gain((L, DA_V_DIM))
    gla_gate_w2 = nrm((L, GLA_GATE_RANK, GLA_HEADS * GLA_DK), GLA_GATE_RANK ** -0.5)
    gla_gate_b = nrm((L, GLA_HEADS * GLA_DK), 0.1)
    gla_norm = gain((L, GLA_DV))
    ssd_conv_w = nrm((L, SSD_CONV, SSD_CONV_DIM), SSD_CONV ** -0.5)
    ssd_conv_b = nrm((L, SSD_CONV_DIM), 0.01)
    dt0 = jnp.exp(jax.random.uniform(next(ks), (L, SSD_HEADS), jnp.float32, math.log(1e-3), math.log(1e-1)))
    ssd_dt_bias = dt0 + jnp.log(-jnp.expm1(-dt0))
    ssd_a_log = jnp.log(jax.random.uniform(next(ks), (L, SSD_HEADS), jnp.float32, 1.0, 16.0))
    ssd_d = gain((L, SSD_HEADS))
    ssd_norm = gain((L, SSD_INNER))
    rw_mu = jax.random.uniform(next(ks), (L, sum(RW_SIZES)), jnp.float32)
    rw_w0 = nrm((L, RW_DIM), 0.5)
    rw_w2 = nrm((L, RW_DECAY_RANK, RW_DIM), RW_DECAY_RANK ** -0.5)
    rw_a0 = nrm((L, RW_DIM), 0.1)
    rw_a2 = nrm((L, RW_A_RANK, RW_DIM), RW_A_RANK ** -0.5)
    rw_g2 = nrm((L, RW_GATE_RANK, RW_DIM), RW_GATE_RANK ** -0.5)
    rw_k_k = 0.85 + nrm((L, RW_DIM), 0.01)
    rw_k_a = gain((L, RW_DIM))
    rw_r_k = nrm((L, RW_DIM), 0.1)
    rw_norm_w = gain((L, RW_DIM))
    rw_norm_b = nrm((L, RW_DIM), 0.01)
    w_branch = nrm((L, N_BRANCH, MIX_WIDTH, D), MIX_WIDTH ** -0.5)
    gate_b = nrm((L, N_BRANCH, D), 0.1)
    w_out = nrm((L, D, D), D ** -0.5)
    ffn2_norm = gain((L, D))
    ffn2_wg = nrm((L, D, F), D ** -0.5)
    ffn2_wu = nrm((L, D, F), D ** -0.5)
    ffn2_wd = nrm((L, F, D), F ** -0.5)
    final_norm = gain((D,))
    return {
        "x": x, "ffn1_norm": ffn1_norm, "ffn1_wg": ffn1_wg, "ffn1_wu": ffn1_wu, "ffn1_wd": ffn1_wd,
        "mix_norm": mix_norm, "w_in": w_in,
        "da_lambda_q1": da_lambda_q1, "da_lambda_k1": da_lambda_k1, "da_lambda_q2": da_lambda_q2,
        "da_lambda_k2": da_lambda_k2, "da_norm": da_norm,
        "gla_gate_w2": gla_gate_w2, "gla_gate_b": gla_gate_b, "gla_norm": gla_norm,
        "ssd_conv_w": ssd_conv_w, "ssd_conv_b": ssd_conv_b, "ssd_dt_bias": ssd_dt_bias, "ssd_a_log": ssd_a_log,
        "ssd_d": ssd_d, "ssd_norm": ssd_norm,
        "rw_mu": rw_mu, "rw_w0": rw_w0, "rw_w2": rw_w2, "rw_a0": rw_a0, "rw_a2": rw_a2, "rw_g2": rw_g2,
        "rw_k_k": rw_k_k, "rw_k_a": rw_k_a, "rw_r_k": rw_r_k, "rw_norm_w": rw_norm_w, "rw_norm_b": rw_norm_b,
        "w_branch": w_branch, "gate_b": gate_b, "w_out": w_out,
        "ffn2_norm": ffn2_norm, "ffn2_wg": ffn2_wg, "ffn2_wu": ffn2_wu, "ffn2_wd": ffn2_wd,
        "final_norm": final_norm,
    }


def reference(x, ffn1_norm, ffn1_wg, ffn1_wu, ffn1_wd, mix_norm, w_in,
              da_lambda_q1, da_lambda_k1, da_lambda_q2, da_lambda_k2, da_norm,
              gla_gate_w2, gla_gate_b, gla_norm,
              ssd_conv_w, ssd_conv_b, ssd_dt_bias, ssd_a_log, ssd_d, ssd_norm,
              rw_mu, rw_w0, rw_w2, rw_a0, rw_a2, rw_g2, rw_k_k, rw_k_a, rw_r_k, rw_norm_w, rw_norm_b,
              w_branch, gate_b, w_out, ffn2_norm, ffn2_wg, ffn2_wu, ffn2_wd, final_norm):
    h = x
    for l in range(DEPTH):
        h = h + 0.5 * swiglu_ffn(rmsnorm(h, ffn1_norm[l]), ffn1_wg[l], ffn1_wu[l], ffn1_wd[l])
        h = h + hybrid_token_mixer(
            rmsnorm(h, mix_norm[l]), l, w_in[l],
            da_lambda_q1[l], da_lambda_k1[l], da_lambda_q2[l], da_lambda_k2[l], da_norm[l],
            gla_gate_w2[l], gla_gate_b[l], gla_norm[l],
            ssd_conv_w[l], ssd_conv_b[l], ssd_dt_bias[l], ssd_a_log[l], ssd_d[l], ssd_norm[l],
            rw_mu[l], rw_w0[l], rw_w2[l], rw_a0[l], rw_a2[l], rw_g2[l], rw_k_k[l], rw_k_a[l], rw_r_k[l],
            rw_norm_w[l], rw_norm_b[l], w_branch[l], gate_b[l], w_out[l])
        h = h + 0.5 * swiglu_ffn(rmsnorm(h, ffn2_norm[l]), ffn2_wg[l], ffn2_wu[l], ffn2_wd[l])
    return rmsnorm(h, final_norm)
```

```cpp
#include <hip/hip_runtime.h>
#include <cstdio>
#include <cstdint>
#include <cmath>

namespace pg8 {
#define PG8_LAS __attribute__((address_space(3)))
typedef unsigned short bf16_t;
typedef short bf16x8 __attribute__((ext_vector_type(8)));
typedef float f32x4 __attribute__((ext_vector_type(4)));
typedef unsigned u32x4 __attribute__((ext_vector_type(4)));
constexpr int BM = 256, BK = 64, HALF = 128, HTB = HALF * BK * 2  , STAGE_BYTES = 8 * HTB, NXCD = 8, WGM = 8;

__host__ __device__ __forceinline__ int lds_byte(int r, int c) { const int st = (r >> 4) * 2 + (c >> 5), rr = r & 15, cc = c & 31, ob = rr * 64 + cc * 2; return st * 1024 + (ob ^ (((ob >> 9) & 1) << 5)); }
__host__ __device__ __forceinline__ void stage_rc(int b, int& R, int& C) { const int st = b / 1024, sb = b % 1024, swz = sb ^ (((sb >> 9) & 1) << 5); R = (st >> 1) * 16 + swz / 64; C = (st & 1) * 32 + (swz % 64) / 2; }
__host__ __device__ __forceinline__ int perm32(int rho) { const int n = rho >> 4, i = rho & 15; return 8 * (i >> 2) + 4 * n + (i & 3); }

struct Unit { int pm, pn, z; };
struct Gemm { const bf16_t* A; const bf16_t* Bt; int M, N, K, lda; };

struct StaticOrder {
    int nM, nN, nwg, G, c;
    __host__ __device__ void init(int M, int N, int G_, int c_) { nM = M / BM; nN = N / BM; nwg = nM * nN; G = G_; c = c_; }
    __host__ __device__ bool next(int i, Unit& u) const {
        const long L = (long)i * G + c; if (L >= nwg) return false;
        int wgid = (int)L; { const int q = nwg / NXCD, r = nwg % NXCD, xcd = wgid % NXCD, off = wgid / NXCD; wgid = (xcd < r ? xcd * (q + 1) : r * (q + 1) + (xcd - r) * q) + off; }
        const int nig = WGM * nN, gid = wgid / nig, fm = gid * WGM, gsz = (nM - fm) < WGM ? (nM - fm) : WGM;
        u.pm = fm + ((wgid % nig) % gsz); u.pn = (wgid % nig) / gsz; u.z = 0; return true;
    }
    __device__ __forceinline__ void a_ready(const Unit&) const {}
    __device__ __forceinline__ void done(const Unit&) const {}
    __device__ __forceinline__ size_t a_off(const Unit&) const { return 0; }
    __device__ __forceinline__ int b_tile(const Unit& u) const { return u.pn; }
};
struct GroupedOrder {
    StaticOrder base; int NZ, Kbytes, tiles_per_group;
    __device__ void init(int M, int N, int NZ_, int K, int G_, int c_) { base.init(M, N, G_, c_); NZ = NZ_; Kbytes = K * 2; tiles_per_group = N / BM; }
    __device__ bool next(int i, Unit& u) const { const int r = i / NZ, z = i - r * NZ; if (!base.next(r, u)) return false; u.z = z; return true; }
    __device__ __forceinline__ void a_ready(const Unit&) const {}
    __device__ __forceinline__ void done(const Unit&) const {}
    __device__ __forceinline__ size_t a_off(const Unit& u) const { return (size_t)u.z * Kbytes; }
    __device__ __forceinline__ int b_tile(const Unit& u) const { return u.z * tiles_per_group + u.pn; }
};

__device__ __forceinline__ unsigned cvt_pk_bf16(float lo, float hi) { unsigned r; asm volatile("v_cvt_pk_bf16_f32 %0, %1, %2" : "=v"(r) : "v"(lo), "v"(hi)); return r; }
__device__ __forceinline__ float bf_lo(unsigned w) { return __uint_as_float(w << 16); }
__device__ __forceinline__ float bf_hi(unsigned w) { return __uint_as_float(w & 0xffff0000u); }
__device__ __forceinline__ float fast_sigmoid(float x) { return __builtin_amdgcn_rcpf(1.0f + __builtin_amdgcn_exp2f(-1.4426950408889634f * x)); }

__device__ __forceinline__ float row_rstd(const float* ssq, int row, int M_) {
    const float s = (ssq[row] + ssq[M_ + row]) + (ssq[2 * M_ + row] + ssq[3 * M_ + row]);
    return 1.0f / sqrtf(s * (1.0f / 1024.0f) + 1e-6f);
}
struct EpiScaleBf16 {
    static constexpr bool PERM = true, AFTER_DRAIN = false;
    bf16_t* O; int ldc; const float* ssq; int M_;
    __device__ __forceinline__ void operator()(const f32x4 (&acc)[2][2][4][2], const Unit& u, int wr, int wc, int fr, int fq) const {
        const int row0 = u.pm * BM + wr * 64 + fr; const int col0 = u.pn * BM + wc * 32 + 8 * fq;
#pragma unroll
        for (int ai = 0; ai < 2; ++ai)
#pragma unroll
            for (int m = 0; m < 4; ++m) { const int row = row0 + ai * HALF + m * 16; const float rs = row_rstd(ssq, row, M_); bf16_t* rowp = O + (size_t)row * ldc + col0;
#pragma unroll
                for (int bj = 0; bj < 2; ++bj) { const f32x4 v0 = acc[ai][bj][m][0] * rs, v1 = acc[ai][bj][m][1] * rs;
                    u32x4 w; w.x = cvt_pk_bf16(v0[0], v0[1]); w.y = cvt_pk_bf16(v0[2], v0[3]); w.z = cvt_pk_bf16(v1[0], v1[1]); w.w = cvt_pk_bf16(v1[2], v1[3]);
                    *(u32x4*)(rowp + bj * HALF) = w; } }
    }
};
struct EpiSwiglu {
    static constexpr bool PERM = true, AFTER_DRAIN = false;
    bf16_t* O; int ldc; const float* ssq; int M_;
    __device__ __forceinline__ void operator()(const f32x4 (&acc)[2][2][4][2], const Unit& u, int wr, int wc, int fr, int fq) const {
        const int row0 = u.pm * BM + wr * 64 + fr; const int col0 = u.pn * HALF + wc * 32 + 8 * fq;
#pragma unroll
        for (int ai = 0; ai < 2; ++ai)
#pragma unroll
            for (int m = 0; m < 4; ++m) { const int row = row0 + ai * HALF + m * 16; const float rs = row_rstd(ssq, row, M_); bf16_t* rowp = O + (size_t)row * ldc + col0;
                float o[8];
#pragma unroll
                for (int n = 0; n < 2; ++n)
#pragma unroll
                    for (int i = 0; i < 4; ++i) { const float g = acc[ai][0][m][n][i] * rs, up = acc[ai][1][m][n][i] * rs; o[n * 4 + i] = g * fast_sigmoid(g) * up; }
                u32x4 w; w.x = cvt_pk_bf16(o[0], o[1]); w.y = cvt_pk_bf16(o[2], o[3]); w.z = cvt_pk_bf16(o[4], o[5]); w.w = cvt_pk_bf16(o[6], o[7]);
                *(u32x4*)rowp = w; }
    }
};
struct EpiGateAcc {
    static constexpr bool PERM = true, AFTER_DRAIN = false;
    bf16_t* O; const bf16_t* PG; const float* gb;
    __device__ __forceinline__ void operator()(const f32x4 (&acc)[2][2][4][2], const Unit& u, int wr, int wc, int fr, int fq) const {
        const int row0 = u.pm * BM + wr * 64 + fr; const int col0 = u.pn * BM + wc * 32 + 8 * fq; const int z = u.z;
        f32x4 gbv[2][2];
#pragma unroll
        for (int bj = 0; bj < 2; ++bj)
#pragma unroll
            for (int n = 0; n < 2; ++n) gbv[bj][n] = *(const f32x4*)(gb + z * 1024 + col0 + bj * HALF + 4 * n);
#pragma unroll
        for (int ai = 0; ai < 2; ++ai)
#pragma unroll
            for (int m = 0; m < 4; ++m) { const int row = row0 + ai * HALF + m * 16;
#pragma unroll
                for (int bj = 0; bj < 2; ++bj) {
                    const u32x4 pg = *(const u32x4*)(PG + (size_t)row * 4096 + z * 1024 + col0 + bj * HALF);
                    bf16_t* op = O + (size_t)row * 1024 + col0 + bj * HALF;
                    float o[8];
                    o[0] = fast_sigmoid(bf_lo(pg.x) + gbv[bj][0][0]) * acc[ai][bj][m][0][0]; o[1] = fast_sigmoid(bf_hi(pg.x) + gbv[bj][0][1]) * acc[ai][bj][m][0][1];
                    o[2] = fast_sigmoid(bf_lo(pg.y) + gbv[bj][0][2]) * acc[ai][bj][m][0][2]; o[3] = fast_sigmoid(bf_hi(pg.y) + gbv[bj][0][3]) * acc[ai][bj][m][0][3];
                    o[4] = fast_sigmoid(bf_lo(pg.z) + gbv[bj][1][0]) * acc[ai][bj][m][1][0]; o[5] = fast_sigmoid(bf_hi(pg.z) + gbv[bj][1][1]) * acc[ai][bj][m][1][1];
                    o[6] = fast_sigmoid(bf_lo(pg.w) + gbv[bj][1][2]) * acc[ai][bj][m][1][2]; o[7] = fast_sigmoid(bf_hi(pg.w) + gbv[bj][1][3]) * acc[ai][bj][m][1][3];
                    if (z > 0) { const u32x4 pv = *(const u32x4*)op;
                        o[0] += bf_lo(pv.x); o[1] += bf_hi(pv.x); o[2] += bf_lo(pv.y); o[3] += bf_hi(pv.y); o[4] += bf_lo(pv.z); o[5] += bf_hi(pv.z); o[6] += bf_lo(pv.w); o[7] += bf_hi(pv.w); }
                    u32x4 w; w.x = cvt_pk_bf16(o[0], o[1]); w.y = cvt_pk_bf16(o[2], o[3]); w.z = cvt_pk_bf16(o[4], o[5]); w.w = cvt_pk_bf16(o[6], o[7]);
                    *(u32x4*)op = w; } }
    }
};
struct EpiResid {
    static constexpr bool PERM = true, AFTER_DRAIN = true;
    float* H; bf16_t* HB; float* ssq; int M_; float s;
    __device__ __forceinline__ void fused(f32x4 (&acc)[2][2][4][2], const Unit& u, int wr, int wc, int fr, int fq, PG8_LAS unsigned char* lds, int wid, int lane) const {
        PG8_LAS float* P = (PG8_LAS float*)lds;
        const int row0 = u.pm * BM + wr * 64 + fr; const int col0 = u.pn * BM + wc * 32 + 8 * fq;
#pragma unroll
        for (int ai = 0; ai < 2; ++ai)
#pragma unroll
            for (int m = 0; m < 4; ++m) { const int row = row0 + ai * HALF + m * 16; float q = 0.f;
#pragma unroll
                for (int bj = 0; bj < 2; ++bj) { float* hp = H + (size_t)row * 1024 + col0 + bj * HALF;
                    const f32x4 h0 = *(const f32x4*)hp + acc[ai][bj][m][0] * s, h1 = *(const f32x4*)(hp + 4) + acc[ai][bj][m][1] * s;
                    *(f32x4*)hp = h0; *(f32x4*)(hp + 4) = h1;
                    q += (h0[0] * h0[0] + h0[1] * h0[1]) + (h0[2] * h0[2] + h0[3] * h0[3]) + (h1[0] * h1[0] + h1[1] * h1[1]) + (h1[2] * h1[2] + h1[3] * h1[3]);
                    u32x4 w; w.x = cvt_pk_bf16(h0[0], h0[1]); w.y = cvt_pk_bf16(h0[2], h0[3]); w.z = cvt_pk_bf16(h1[0], h1[1]); w.w = cvt_pk_bf16(h1[2], h1[3]);
                    *(u32x4*)(HB + (size_t)row * 1024 + col0 + bj * HALF) = w; }
                q += __shfl_xor(q, 16); q += __shfl_xor(q, 32);
                if (fq == 0) P[(ai * HALF + wr * 64 + m * 16 + fr) * 4 + wc] = q; }
        asm volatile("s_waitcnt lgkmcnt(0)" ::: "memory"); __builtin_amdgcn_s_barrier(); asm volatile("" ::: "memory");
        const int t = wid * 64 + lane;
        if (t < 256) { const float q = (P[t * 4 + 0] + P[t * 4 + 1]) + (P[t * 4 + 2] + P[t * 4 + 3]); ssq[(size_t)u.pn * M_ + u.pm * BM + t] = q; }
        asm volatile("s_waitcnt lgkmcnt(0)" ::: "memory"); __builtin_amdgcn_s_barrier(); asm volatile("" ::: "memory");
    }
};
template <class Epi, class Sched, bool ALIGN_EPI = false, bool SP2 = false>
__device__ __forceinline__ void gemm_phase(PG8_LAS unsigned char* lds, const Gemm g, const Sched& S, const Epi& E) {
    int tid_ = threadIdx.x; asm volatile("" : "+v"(tid_)); const int tid = tid_, wid = __builtin_amdgcn_readfirstlane(tid >> 6), lane = tid & 63, wr = wid >> 2, wc = wid & 3, fr = lane & 15, fq = lane >> 4;
    const int K = g.K, nt = K / BK;
    unsigned voffA[2], voffB[2];
#pragma unroll
    for (int i = 0; i < 2; ++i) { int R, C; stage_rc(tid * 16 + i * 8192, R, C); const int Rb = Epi::PERM ? ((R & ~31) + perm32(R & 31)) : R;
        voffA[i] = (unsigned)(R * g.lda + C) * 2u; voffB[i] = (unsigned)(Rb * K + C) * 2u; }
    const size_t kstep = (size_t)(BK * 2);
    const size_t hstep = (size_t)HALF * K * 2;
    const size_t tstep = 2 * hstep; const size_t hstepA = (size_t)HALF * g.lda * 2, tstepA = 2 * hstepA;
    const unsigned ldsw = (unsigned)wid * 1024u;
    const int aoff = lds_byte(wr * 64 + fr, fq * 8), boff = lds_byte(wc * 32 + fr, fq * 8);
#define PG8_SA(b, h) (((b) * 2 + (h)) * HTB)
#define PG8_SB(b, h) ((4 + (b) * 2 + (h)) * HTB)
#define PG8_STAGE(bufoff, gbase, voff) do { _Pragma("unroll") for (int _i = 0; _i < 2; ++_i) \
        __builtin_amdgcn_global_load_lds((const unsigned*)((const char*)(gbase) + (voff)[_i]), (PG8_LAS unsigned*)(lds + (bufoff) + ldsw + _i * 8192), 16, 0, 0); } while (0)
#define PG8_LDA(dst, b, h) do { _Pragma("unroll") for (int m = 0; m < 4; ++m) _Pragma("unroll") for (int k = 0; k < 2; ++k) dst[m][k] = *(const PG8_LAS bf16x8*)(lds + PG8_SA(b, h) + aoff + m * 2048 + k * 1024); } while (0)
#define PG8_LDB(dst, b, h) do { _Pragma("unroll") for (int n = 0; n < 2; ++n) _Pragma("unroll") for (int k = 0; k < 2; ++k) dst[n][k] = *(const PG8_LAS bf16x8*)(lds + PG8_SB(b, h) + boff + n * 2048 + k * 1024); } while (0)
#define PG8_MMA(ai, bj, At, Bt) do { __builtin_amdgcn_s_setprio(1); _Pragma("unroll") for (int m = 0; m < 4; ++m) _Pragma("unroll") for (int n = 0; n < 2; ++n) _Pragma("unroll") for (int k = 0; k < 2; ++k) \
        acc[ai][bj][m][n] = __builtin_amdgcn_mfma_f32_16x16x32_bf16(Bt[n][k], At[m][k], acc[ai][bj][m][n], 0, 0, 0); __builtin_amdgcn_s_setprio(0); } while (0)
#define PG8_WAIT_V(n) asm volatile("s_waitcnt vmcnt(" #n ")" ::: "memory")
#define PG8_WAIT_L(n) asm volatile("s_waitcnt lgkmcnt(" #n ")" ::: "memory")
#define PG8_BAR __builtin_amdgcn_s_barrier()
#define PG8_SCHED __builtin_amdgcn_sched_barrier(0)
    Unit cur, nxt; int ui = 0;
    if (!S.next(0, cur)) return;
    f32x4 acc[2][2][4][2];
#pragma unroll
    for (int a = 0; a < 2; ++a)
#pragma unroll
        for (int b = 0; b < 2; ++b)
#pragma unroll
            for (int m = 0; m < 4; ++m)
#pragma unroll
                for (int n = 0; n < 2; ++n) acc[a][b][m][n] = (f32x4){0.f, 0.f, 0.f, 0.f};
    bf16x8 At[4][2], B0[2][2], B1[2][2];
    const char* cA = (const char*)g.A + (size_t)cur.pm * tstepA + S.a_off(cur); const char* cB = (const char*)g.Bt + (size_t)S.b_tile(cur) * tstep;
    S.a_ready(cur);
    if constexpr (SP2) {
        PG8_STAGE(PG8_SB(0, 0), cB, voffB); PG8_STAGE(PG8_SB(0, 1), cB + hstep, voffB); PG8_STAGE(PG8_SA(0, 0), cA, voffA); PG8_STAGE(PG8_SA(0, 1), cA + hstepA, voffA);
        if (wr == 1) PG8_BAR;
        PG8_WAIT_V(2); PG8_BAR;
        PG8_STAGE(PG8_SB(1, 0), cB + kstep, voffB); PG8_STAGE(PG8_SA(1, 0), cA + kstep, voffA); PG8_STAGE(PG8_SB(1, 1), cB + hstep + kstep, voffB);
        PG8_WAIT_V(6); PG8_BAR;
    } else {
        PG8_STAGE(PG8_SB(0, 0), cB, voffB); PG8_STAGE(PG8_SA(0, 0), cA, voffA); PG8_STAGE(PG8_SB(0, 1), cB + hstep, voffB); PG8_STAGE(PG8_SA(0, 1), cA + hstepA, voffA);
        if (wr == 1) PG8_BAR;
        PG8_WAIT_V(4); PG8_BAR;
        PG8_STAGE(PG8_SB(1, 0), cB + kstep, voffB); PG8_STAGE(PG8_SA(1, 0), cA + kstep, voffA); PG8_STAGE(PG8_SB(1, 1), cB + hstep + kstep, voffB);
        PG8_WAIT_V(6); PG8_BAR;
    }
    for (;;) {
        const bool has_next = S.next(ui + 1, nxt);
        const char* nA = has_next ? (const char*)g.A + (size_t)nxt.pm * tstepA + S.a_off(nxt) : cA; const char* nB = has_next ? (const char*)g.Bt + (size_t)S.b_tile(nxt) * tstep : cB;
        for (int t = 0; t < nt; t += 2) {
            const bool last = (t == nt - 2);
            const char* a1 = cA + (size_t)(t + 1) * kstep;
            const char* a2 = last ? nA : cA + (size_t)(t + 2) * kstep; const char* b2 = last ? nB : cB + (size_t)(t + 2) * kstep;
            const char* a3 = a2 + kstep; const char* b3 = b2 + kstep;
            if (last && has_next) S.a_ready(nxt);
            if constexpr (SP2) {
            PG8_LDB(B0, 0, 0); PG8_LDB(B1, 0, 1); PG8_SCHED; PG8_LDA(At, 0, 0); PG8_STAGE(PG8_SA(1, 1), a1 + hstepA, voffA);
            PG8_WAIT_V(8); PG8_WAIT_L(0); PG8_BAR; PG8_MMA(0, 0, At, B0); PG8_MMA(0, 1, At, B1); PG8_BAR; PG8_SCHED;
            PG8_LDA(At, 0, 1); PG8_STAGE(PG8_SB(0, 0), b2, voffB); PG8_STAGE(PG8_SB(0, 1), b2 + hstep, voffB); PG8_STAGE(PG8_SA(0, 0), a2, voffA);
            PG8_WAIT_V(8); PG8_WAIT_L(0); PG8_BAR; PG8_MMA(1, 0, At, B0); PG8_MMA(1, 1, At, B1); PG8_BAR; PG8_SCHED;
            PG8_LDB(B0, 1, 0); PG8_LDB(B1, 1, 1); PG8_SCHED; PG8_LDA(At, 1, 0); PG8_STAGE(PG8_SA(0, 1), a2 + hstepA, voffA);
            PG8_WAIT_V(8); PG8_WAIT_L(0); PG8_BAR; PG8_MMA(0, 0, At, B0); PG8_MMA(0, 1, At, B1); PG8_BAR; PG8_SCHED;
            PG8_LDA(At, 1, 1); PG8_STAGE(PG8_SB(1, 0), b3, voffB); PG8_STAGE(PG8_SB(1, 1), b3 + hstep, voffB); PG8_STAGE(PG8_SA(1, 0), a3, voffA);
            PG8_WAIT_V(8); PG8_WAIT_L(0); PG8_BAR; PG8_MMA(1, 0, At, B0); PG8_MMA(1, 1, At, B1); PG8_BAR; PG8_SCHED;
            } else {
            PG8_LDB(B0, 0, 0); PG8_SCHED; PG8_LDA(At, 0, 0); PG8_STAGE(PG8_SA(1, 1), a1 + hstepA, voffA);
            PG8_WAIT_L(8); PG8_BAR; PG8_WAIT_L(0); PG8_MMA(0, 0, At, B0); PG8_BAR; PG8_SCHED;
            PG8_LDB(B1, 0, 1); PG8_STAGE(PG8_SB(0, 0), b2, voffB);
            PG8_BAR; PG8_WAIT_L(0); PG8_MMA(0, 1, At, B1); PG8_BAR;
            PG8_LDA(At, 0, 1); PG8_STAGE(PG8_SA(0, 0), a2, voffA);
            PG8_BAR; PG8_WAIT_L(0); PG8_MMA(1, 0, At, B0); PG8_BAR; PG8_SCHED;
            PG8_STAGE(PG8_SB(0, 1), b2 + hstep, voffB);
            PG8_WAIT_V(6); PG8_BAR; PG8_MMA(1, 1, At, B1); PG8_BAR;
            PG8_LDB(B0, 1, 0); PG8_SCHED; PG8_LDA(At, 1, 0); PG8_STAGE(PG8_SA(0, 1), a2 + hstepA, voffA);
            PG8_WAIT_L(8); PG8_BAR; PG8_WAIT_L(0); PG8_MMA(0, 0, At, B0); PG8_BAR; PG8_SCHED;
            PG8_LDB(B1, 1, 1); PG8_STAGE(PG8_SB(1, 0), b3, voffB);
            PG8_BAR; PG8_WAIT_L(0); PG8_MMA(0, 1, At, B1); PG8_BAR;
            PG8_LDA(At, 1, 1); PG8_STAGE(PG8_SA(1, 0), a3, voffA);
            PG8_BAR; PG8_WAIT_L(0); PG8_MMA(1, 0, At, B0); PG8_BAR; PG8_SCHED;
            PG8_STAGE(PG8_SB(1, 1), b3 + hstep, voffB);
            PG8_WAIT_V(6); PG8_BAR; PG8_MMA(1, 1, At, B1); PG8_BAR;
            }
        }
        if constexpr (ALIGN_EPI) { if (wr == 0) PG8_BAR; }
        if constexpr (!Epi::AFTER_DRAIN) { E(acc, cur, wr, wc, fr, fq); S.done(cur); }
        if (!has_next) break;
#pragma unroll
        for (int a = 0; a < 2; ++a)
#pragma unroll
            for (int b = 0; b < 2; ++b)
#pragma unroll
                for (int m = 0; m < 4; ++m)
#pragma unroll
                    for (int n = 0; n < 2; ++n) acc[a][b][m][n] = (f32x4){0.f, 0.f, 0.f, 0.f};
        cur = nxt; cA = nA; cB = nB; ++ui;
        if constexpr (ALIGN_EPI) { if (wr == 1) PG8_BAR; }
    }
    PG8_WAIT_V(0);
    if constexpr (!ALIGN_EPI) { if (wr == 0) PG8_BAR; }
    PG8_BAR;
    if constexpr (Epi::AFTER_DRAIN) { E.fused(acc, cur, wr, wc, fr, fq, lds, wid, lane); S.done(cur); }
#undef PG8_SA
#undef PG8_SB
#undef PG8_STAGE
#undef PG8_LDA
#undef PG8_LDB
#undef PG8_MMA
#undef PG8_WAIT_V
#undef PG8_WAIT_L
#undef PG8_BAR
#undef PG8_SCHED
}
}

constexpr int NWAVES = 8, NTHR = 512;
constexpr int M = 16384, SEQ = 8192, D = 1024, FF = 2816, NL = 4, NCH = 128  , NBC = 256  ;
constexpr int NPM = 6656;
constexpr int NWIN = 10752;
constexpr int C_DAQ = 0, C_DAK = 512, C_DAV = 1024, C_GQ = 1536, C_GK = 1792, C_GV = 2048, C_GOG = 2560, C_SZ = 3072, C_SX = 3584, C_SB = 4096, C_SC = 4352,
              C_RR = 4608, C_RK = 5120, C_RV = 5632, C_RWL = 6144, C_RAL = 6208, C_RGL = 6272, C_GLR = 6400, C_SDT = 6416;
constexpr float EPS = 1e-6f, LOG2E = 1.4426950408889634f;

constexpr size_t MiB = 1u << 20;
constexpr size_t WS_CTL = 0, CTL_ZERO_BYTES = 1 * MiB;
constexpr size_t WS_COS = 1 * MiB, WS_SIN = 2 * MiB, WS_SSQ = 3 * MiB, WS_GLAST = 3 * MiB + 512 * 1024, WS_SDT = 4 * MiB, WS_SACUM = 4 * MiB + 512 * 1024, WS_SCDEC = 5 * MiB;
constexpr size_t WS_WGU1 = 8 * MiB, WS_WD1 = 19 * MiB, WS_WIN = 24 * MiB + 512 * 1024, WS_WB = 45 * MiB + 512 * 1024, WS_WO = 49 * MiB + 512 * 1024, WS_WGU2 = 51 * MiB + 512 * 1024, WS_WD2 = 62 * MiB + 512 * 1024;
constexpr size_t WS_HB = 68 * MiB, WS_P = 100 * MiB, WS_PG = 100 * MiB, WS_YS = 308 * MiB, WS_R1 = 372 * MiB, WS_R2 = 500 * MiB, WS_END = 644 * MiB;
constexpr size_t WS_ACT = WS_R1, WS_MERGED = WS_R1;
constexpr size_t WS_RWW = WS_R1, WS_RWR = WS_R1 + 32 * MiB, WS_RWK = WS_R1 + 48 * MiB, WS_RWV = WS_R1 + 64 * MiB, WS_RWKK = WS_R1 + 80 * MiB, WS_RWB = WS_R1 + 96 * MiB, WS_RWG = WS_R1 + 112 * MiB;
constexpr size_t WS_VT = WS_R2, WS_GKV = WS_R2 + 16 * MiB, WS_SST = WS_R2 + 48 * MiB, WS_RWY = WS_R2 + 112 * MiB;
static_assert(WS_WD2 + (size_t)D * FF * 2 <= WS_HB && WS_P + (size_t)M * NPM * 2 <= WS_YS && WS_RWY + (size_t)M * 512 * 2 <= WS_END, "d_ws map");
constexpr int CW_BAR = 4096;

constexpr int RING_BYTES = 131072, LDSCTL_OFF = RING_BYTES, MISC_OFF = LDSCTL_OFF + 320, LDS_BYTES = 147456;

#define GAS __attribute__((address_space(1)))
#define LAS __attribute__((address_space(3)))
typedef unsigned short bf16;
typedef unsigned v4u __attribute__((ext_vector_type(4)));
typedef float f32x4 __attribute__((ext_vector_type(4)));
typedef short bf16x8 __attribute__((ext_vector_type(8)));
typedef GAS unsigned gu32;
typedef GAS unsigned long long gu64;
#define RLX_AGENT __ATOMIC_RELAXED, __HIP_MEMORY_SCOPE_AGENT
#define LDS_WAIT() asm volatile("s_waitcnt lgkmcnt(0)" ::: "memory")
#define VM_WAIT() asm volatile("s_waitcnt vmcnt(0)" ::: "memory")
__device__ __forceinline__ unsigned long long rt() { return __builtin_amdgcn_s_memrealtime(); }
__device__ __forceinline__ unsigned f2bf(float f) { unsigned u = __builtin_bit_cast(unsigned, f); return (u + 0x7fffu + ((u >> 16) & 1u)) >> 16; }
__device__ __forceinline__ unsigned pk2(float lo, float hi) { return f2bf(lo) | (f2bf(hi) << 16); }

#define XB_TMO      128
#define XB_XCNT(j)  (256  + 64 * (j))
#define XB_XSUB(j)  (1280 + 64 * (j))
#define XB_XGEN(j)  (2304 + 64 * (j))
#define XB_TOP      3328
#define XB_TOPGEN   3392
#define XCD_BAR_WORDS 3456
#define XB_SPIN_CAP (1u << 18)

__device__ __forceinline__ unsigned xb_ld(unsigned* p)              { return __hip_atomic_load(p, __ATOMIC_RELAXED, __HIP_MEMORY_SCOPE_AGENT); }
__device__ __forceinline__ unsigned xb_add(unsigned* p, unsigned v) { return __hip_atomic_fetch_add(p, v, __ATOMIC_RELAXED, __HIP_MEMORY_SCOPE_AGENT); }
__device__ __forceinline__ unsigned xb_xcc_id() { return (unsigned)__builtin_amdgcn_s_getreg((3 << 11) | 20) & 0xFu; }
#define XB_SPIN(cond, bar) do { unsigned _sp = 0; while (cond) { __builtin_amdgcn_s_sleep(1); \
    if ((++_sp & 255u) == 0u) { if (xb_ld(&(bar)[XB_TMO])) break; if (_sp > XB_SPIN_CAP) { atomicAdd(&(bar)[XB_TMO], 1u); break; } } } } while (0)

struct XcdBarrier {
    unsigned* bar; unsigned x;
    volatile LAS unsigned* st;
};

__device__ __forceinline__ XcdBarrier xcd_barrier_post(unsigned* bar, volatile LAS unsigned* st) {
    XcdBarrier b; b.bar = bar; b.x = xb_xcc_id(); b.st = st;
    if (threadIdx.x == 0) (void)xb_add(&bar[XB_XCNT(b.x)], 1u);
    return b;
}
__device__ __forceinline__ void xcd_barrier_complete(unsigned* bar, unsigned x, unsigned& nloc, unsigned& nx) {
    const unsigned G = gridDim.x * gridDim.y * gridDim.z;
    unsigned sum, cnt, mine, sp = 0u;
    for (;;) {
        sum = 0u; cnt = 0u; mine = 0u;
#pragma unroll
        for (unsigned j = 0; j < 16; ++j) { const unsigned c = xb_ld(&bar[XB_XCNT(j)]); sum += c; cnt += (c > 0u) ? 1u : 0u; mine = (j == x) ? c : mine; }
        if (sum == G) break;
        __builtin_amdgcn_s_sleep(1);
        if ((++sp & 255u) == 0u) { if (xb_ld(&bar[XB_TMO])) break; if (sp > XB_SPIN_CAP) { atomicAdd(&bar[XB_TMO], 1u); break; } }
    }
    nloc = mine > 0u ? mine : 1u; nx = cnt > 0u ? cnt : 1u;
}

__device__ __forceinline__ void xcd_barrier(const XcdBarrier& b) {
    asm volatile("s_waitcnt vmcnt(0)" ::: "memory");
    __syncthreads();
    if (threadIdx.x == 0) {
        unsigned* bar = b.bar;
        __builtin_amdgcn_s_waitcnt(0);
        unsigned nloc = b.st[0], nx = b.st[1];
        if (nloc == 0u) { xcd_barrier_complete(bar, b.x, nloc, nx); b.st[0] = nloc; b.st[1] = nx; }
        const unsigned old = xb_add(&bar[XB_XSUB(b.x)], 1u);
        const unsigned gen = old / nloc;
        if (old + 1u == (gen + 1u) * nloc) {
            __builtin_amdgcn_fence(__ATOMIC_RELEASE, "agent");
            asm volatile("s_waitcnt vmcnt(0)" ::: "memory");
            const unsigned og = xb_add(&bar[XB_TOP], 1u);
            const unsigned tg = og / nx;
            if (og + 1u == (tg + 1u) * nx) xb_add(&bar[XB_TOPGEN], 1u);
            else XB_SPIN(xb_ld(&bar[XB_TOPGEN]) == tg, bar);
            __builtin_amdgcn_fence(__ATOMIC_ACQUIRE, "agent");
            xb_add(&bar[XB_XGEN(b.x)], 1u);
            asm volatile("s_waitcnt vmcnt(0)" ::: "memory");
        } else {
            XB_SPIN(xb_ld(&bar[XB_XGEN(b.x)]) == gen, bar);
            __builtin_amdgcn_fence(__ATOMIC_ACQUIRE, "agent");
            asm volatile("s_waitcnt vmcnt(0)" ::: "memory");
        }
    }
    __syncthreads();
}

struct Args { const float* in[40]; float* out; unsigned char* ws; float inv_freq[32]; int g_lo, g_hi; };
typedef const __attribute__((address_space(4))) Args* ArgsP;
typedef LAS float* LF; typedef const LAS float* CLF;
#ifndef PH_FN
#define PH_FN __device__ __noinline__
#endif
#ifndef PH_HEAVY
#define PH_HEAVY __device__ __forceinline__
#endif
struct Ctx {
    LAS unsigned char* lds;
    unsigned char* ws; float* h;
    int tid, lane, wave, bid, G;
};
typedef unsigned u32x4 __attribute__((ext_vector_type(4)));
typedef unsigned u32x2 __attribute__((ext_vector_type(2)));
typedef float f32x2 __attribute__((ext_vector_type(2)));
typedef float f32x16 __attribute__((ext_vector_type(16)));
__device__ __forceinline__ float bf2f(bf16 x) { return __uint_as_float((unsigned)x << 16); }
__device__ __forceinline__ float bflo(unsigned w) { return __uint_as_float(w << 16); }
__device__ __forceinline__ float bfhi(unsigned w) { return __uint_as_float(w & 0xffff0000u); }
__device__ __forceinline__ void unpack8(const u32x4 w, float* o) { o[0] = bflo(w.x); o[1] = bfhi(w.x); o[2] = bflo(w.y); o[3] = bfhi(w.y); o[4] = bflo(w.z); o[5] = bfhi(w.z); o[6] = bflo(w.w); o[7] = bfhi(w.w); }
__device__ __forceinline__ u32x4 pack8(const float* o) { u32x4 w; w.x = pk2(o[0], o[1]); w.y = pk2(o[2], o[3]); w.z = pk2(o[4], o[5]); w.w = pk2(o[6], o[7]); return w; }
__device__ __forceinline__ float sigmoidf_(float x) { return 1.0f / (1.0f + __expf(-x)); }
__device__ __forceinline__ float siluf_(float x) { return x * sigmoidf_(x); }
__device__ __forceinline__ float softplusf_(float x) { return fmaxf(x, 0.f) + log1pf(__expf(-fabsf(x))); }
__device__ __forceinline__ float logsigmoidf_(float x) { return fminf(x, 0.f) - log1pf(__expf(-fabsf(x))); }
__device__ __forceinline__ float wave_sum(float v) {
#pragma unroll
    for (int o = 1; o < 64; o <<= 1) v += __shfl_xor(v, o);
    return v;
}
#define WG_SYNC() __syncthreads()
__device__ __forceinline__ Ctx fresh(const Ctx& C0) { Ctx C = C0; int t = threadIdx.x; asm volatile("" : "+v"(t)); C.tid = t; C.lane = t & 63; C.wave = __builtin_amdgcn_readfirstlane(t >> 6); return C; }

PH_FN void ph_prologue(const Ctx C, ArgsP a) {
    float* cosT = (float*)(C.ws + WS_COS); float* sinT = (float*)(C.ws + WS_SIN);
    for (int idx = C.bid * NTHR + C.tid; idx < SEQ * 32; idx += C.G * NTHR) {
        const int t = idx >> 5, j = idx & 31;
        const float ang = (float)t * a->inv_freq[j];
        const double rev = (double)ang * 0.15915494309189535;
        const float fr = (float)(rev - floor(rev));
        cosT[idx] = __builtin_amdgcn_cosf(fr); sinT[idx] = __builtin_amdgcn_sinf(fr);
    }
    const float* x = a->in[0]; bf16* hb = (bf16*)(C.ws + WS_HB); float* ssq = (float*)(C.ws + WS_SSQ);
    const int gw = C.bid * NWAVES + C.wave, NGW = C.G * NWAVES;
    for (int m = gw; m < M; m += NGW) {
        const f32x4* xr = (const f32x4*)(x + (size_t)m * D) + C.lane; f32x4* hr = (f32x4*)(C.h + (size_t)m * D) + C.lane;
        unsigned long long* o8 = (unsigned long long*)(hb + (size_t)m * D) + C.lane;
        float s = 0.f;
#pragma unroll
        for (int j = 0; j < 4; ++j) { const f32x4 v = xr[64 * j]; hr[64 * j] = v; s += (v.x * v.x + v.y * v.y) + (v.z * v.z + v.w * v.w);
            o8[64 * j] = (unsigned long long)pk2(v.x, v.y) | ((unsigned long long)pk2(v.z, v.w) << 32); }
        s = wave_sum(s);
        if (C.lane == 0) { ssq[m] = s; ssq[M + m] = 0.f; ssq[2 * M + m] = 0.f; ssq[3 * M + m] = 0.f; }
    }
}

template <class SrcF>
__device__ __forceinline__ void tr_item(const SrcF src, const float* gk, bf16* WT, int K, int kb, int nb, LF scr, int lane) {
    const int k0 = 64 * kb, n0 = 32 * nb;
    const int ld = src.ld(); const long co = src.col(n0 + (lane & 31)); const bool ok = co >= 0; const float* colp = src.base(n0 + (lane & 31)) + (ok ? co : 0);
#pragma unroll 8
    for (int i = 0; i < 32; ++i) { const int kk = 2 * i + (lane >> 5); float v = 0.f; if (ok) { v = colp[(size_t)(k0 + kk) * ld]; if (gk) v *= gk[k0 + kk]; } scr[kk * 33 + (lane & 31)] = v; }
    LDS_WAIT(); asm volatile("" ::: "memory");
    const int c = lane & 7;
#pragma unroll
    for (int j = 0; j < 4; ++j) { const int n = (lane >> 3) + 8 * j; CLF s = scr + (8 * c) * 33 + n;
        v4u o; o.x = pk2(s[0 * 33], s[1 * 33]); o.y = pk2(s[2 * 33], s[3 * 33]); o.z = pk2(s[4 * 33], s[5 * 33]); o.w = pk2(s[6 * 33], s[7 * 33]);
        *(v4u*)(WT + (size_t)(n0 + n) * K + k0 + 8 * c) = o; }
    LDS_WAIT(); asm volatile("" ::: "memory");
}
struct SrcGU { const float* wg; const float* wu;
    __device__ __forceinline__ int ld() const { return FF; }
    __device__ __forceinline__ const float* base(int n) const { const uintptr_t sel = (uintptr_t)((n >> 7) & 1); return (const float*)((uintptr_t)wg + sel * ((uintptr_t)wu - (uintptr_t)wg)); }
    __device__ __forceinline__ long col(int n) const { return 128 * (n >> 8) + (n & 127); } };
struct SrcPlain { const float* w; int ldw;
    __device__ __forceinline__ int ld() const { return ldw; }
    __device__ __forceinline__ const float* base(int) const { return w; }
    __device__ __forceinline__ long col(int n) const { return n; } };
struct SrcWin { const float* w;
    __device__ __forceinline__ int ld() const { return 10520; }
    __device__ __forceinline__ const float* base(int) const { return w; }
    __device__ __forceinline__ long col(int n) const {
        int c;
        if (n < 3072) c = n; else if (n < 4608) c = n - 3072 + 3088; else if (n < 6400) c = n - 4608 + 4632; else if (n < 6416) c = n - 6400 + 3072; else if (n < 6424) c = n - 6416 + 4624; else if (n < 6656) c = -1; else c = n - 6656 + 6424;
        return c; } };
PH_FN void ph_weights(const Ctx C, ArgsP a, int l) {
    LF scr = (LF)(C.lds + C.wave * 16384);
    const int gw = C.bid * NWAVES + C.wave, NGW = C.G * NWAVES;
#pragma unroll 1
    for (int f = 0; f < 2; ++f) {
        const float* nrm = a->in[f ? 35 : 1] + (size_t)l * D; const float* wg = a->in[f ? 36 : 2] + (size_t)l * D * FF; const float* wu = a->in[f ? 37 : 3] + (size_t)l * D * FF; const float* wd = a->in[f ? 38 : 4] + (size_t)l * FF * D;
        bf16* Wgu = (bf16*)(C.ws + (f ? WS_WGU2 : WS_WGU1)); bf16* Wd = (bf16*)(C.ws + (f ? WS_WD2 : WS_WD1));
        const SrcGU sgu{wg, wu};
        for (int it = gw; it < (D / 64) * (2 * FF / 32); it += NGW) tr_item(sgu, nrm, Wgu, D, it / (2 * FF / 32), it % (2 * FF / 32), scr, C.lane);
        const SrcPlain sd{wd, D};
        for (int it = gw; it < (FF / 64) * (D / 32); it += NGW) tr_item(sd, nullptr, Wd, FF, it / (D / 32), it % (D / 32), scr, C.lane);
    }
    { const SrcWin sw{a->in[6] + (size_t)l * D * 10520}; const float* nrm = a->in[5] + (size_t)l * D; bf16* Win = (bf16*)(C.ws + WS_WIN);
      for (int it = gw; it < (D / 64) * (NWIN / 32); it += NGW) tr_item(sw, nrm, Win, D, it / (NWIN / 32), it % (NWIN / 32), scr, C.lane); }
    { bf16* Wb = (bf16*)(C.ws + WS_WB);
      for (int it = gw; it < 4 * (512 / 64) * (D / 32); it += NGW) { const int z = it / ((512 / 64) * (D / 32)), r = it % ((512 / 64) * (D / 32));
          const SrcPlain sb{a->in[32] + ((size_t)l * 4 + z) * 512 * D, D}; tr_item(sb, nullptr, Wb + (size_t)z * D * 512, 512, r / (D / 32), r % (D / 32), scr, C.lane); } }
    { const SrcPlain so{a->in[34] + (size_t)l * D * D, D}; bf16* Wo = (bf16*)(C.ws + WS_WO);
      for (int it = gw; it < (D / 64) * (D / 32); it += NGW) tr_item(so, nullptr, Wo, D, it / (D / 32), it % (D / 32), scr, C.lane); }
}

PH_FN void ph_da_prep(const Ctx C) {
    bf16* P = (bf16*)(C.ws + WS_P); const float* cosT = (const float*)(C.ws + WS_COS); const float* sinT = (const float*)(C.ws + WS_SIN);
    const int gw = C.bid * NWAVES + C.wave, NGW = C.G * NWAVES;
    const int hc = C.lane >> 2, ch = C.lane & 3;
    const float sc = (hc < 8) ? 0.125f * LOG2E : 1.0f;
    for (int m = gw; m < M; m += NGW) {
        const int t = m & (SEQ - 1);
        bf16* p1 = P + (size_t)m * NPM + hc * 64 + ch * 8; bf16* p2 = p1 + 32;
        float x1[8], x2[8], o1[8], o2[8];
        unpack8(*(const u32x4*)p1, x1); unpack8(*(const u32x4*)p2, x2);
        const float* cp = cosT + t * 32 + ch * 8; const float* sp = sinT + t * 32 + ch * 8;
#pragma unroll
        for (int i = 0; i < 8; ++i) { const float c = cp[i], s = sp[i]; o1[i] = (x1[i] * c - x2[i] * s) * sc; o2[i] = (x2[i] * c + x1[i] * s) * sc; }
        *(u32x4*)p1 = pack8(o1); *(u32x4*)p2 = pack8(o2);
    }
    bf16* VT = (bf16*)(C.ws + WS_VT); LAS bf16* tile = (LAS bf16*)C.lds;
    for (int it = C.bid; it < 2 * NCH * 4; it += C.G) {
        const int h = it & 3, bc = it >> 2, b = bc >> 7, tb = bc & 127; const size_t row0 = (size_t)bc * 64;
        WG_SYNC();
#pragma unroll
        for (int i = 0; i < 2; ++i) { const int q = C.tid + NTHR * i, t = q >> 4, c16 = q & 15;
            *(LAS u32x4*)(tile + t * 136 + c16 * 8) = *(const u32x4*)(P + (row0 + t) * NPM + C_DAV + h * 128 + c16 * 8); }
        WG_SYNC();
#pragma unroll
        for (int i = 0; i < 2; ++i) { const int q = C.tid + NTHR * i, d = q >> 3, tc = q & 7; unsigned w[4];
#pragma unroll
            for (int e = 0; e < 4; ++e) w[e] = (unsigned)tile[(8 * tc + 2 * e) * 136 + d] | ((unsigned)tile[(8 * tc + 2 * e + 1) * 136 + d] << 16);
            u32x4 o; o.x = w[0]; o.y = w[1]; o.z = w[2]; o.w = w[3];
            *(u32x4*)(VT + ((size_t)(b * 4 + h) * 128 + d) * SEQ + tb * 64 + 8 * tc) = o; }
    }
    WG_SYNC();
}

__device__ __forceinline__ void gla_compute_G(const Ctx& C, ArgsP a, int l, int bc, int h, LF Gs) {
    const bf16* P = (const bf16*)(C.ws + WS_P); const float* W2 = a->in[12] + (size_t)l * 16 * 256; const float* gb = a->in[13] + (size_t)l * 256;
    const int t = C.tid >> 3, kg = C.tid & 7; const size_t row = (size_t)bc * 64 + t;
    float glr[16]; unpack8(*(const u32x4*)(P + row * NPM + C_GLR), glr); unpack8(*(const u32x4*)(P + row * NPM + C_GLR + 8), glr + 8);
#pragma unroll
    for (int i = 0; i < 8; ++i) { const int k = h * 64 + kg * 8 + i; float x = gb[k];
#pragma unroll
        for (int r = 0; r < 16; ++r) x += glr[r] * W2[r * 256 + k];
        Gs[t * 68 + kg * 8 + i] = logsigmoidf_(x) * (1.0f / 16.0f); }
    WG_SYNC();
    if (C.tid < 64) { float run = 0.f; for (int tt = 0; tt < 64; ++tt) { run += Gs[tt * 68 + C.tid]; Gs[tt * 68 + C.tid] = run; } }
    WG_SYNC();
}
PH_FN void ph_gla_a(const Ctx C, ArgsP a, int l) {
    const bf16* P = (const bf16*)(C.ws + WS_P); float* GKV = (float*)(C.ws + WS_GKV); float* GL = (float*)(C.ws + WS_GLAST);
    LF Gs = (LF)C.lds; LF KD = Gs + 64 * 68; LF Vs = KD + 64 * 68;
    for (int it = C.bid; it < NBC * 4; it += C.G) {
        const int bc = it >> 2, h = it & 3;
        WG_SYNC();
        gla_compute_G(C, a, l, bc, h, Gs);
        { const int t = C.tid >> 3, g8 = C.tid & 7; const size_t row = (size_t)bc * 64 + t;
          float kf[8]; unpack8(*(const u32x4*)(P + row * NPM + C_GK + h * 64 + g8 * 8), kf);
#pragma unroll
          for (int i = 0; i < 8; ++i) { const int k = g8 * 8 + i; KD[t * 68 + k] = kf[i] * __expf(Gs[63 * 68 + k] - Gs[t * 68 + k]); }
          float vf[16]; unpack8(*(const u32x4*)(P + row * NPM + C_GV + h * 128 + g8 * 16), vf); unpack8(*(const u32x4*)(P + row * NPM + C_GV + h * 128 + g8 * 16 + 8), vf + 8);
#pragma unroll
          for (int i = 0; i < 16; ++i) Vs[t * 132 + g8 * 16 + i] = vf[i];
          if (C.tid < 64) GL[(size_t)it * 64 + C.tid] = Gs[63 * 68 + C.tid]; }
        WG_SYNC();
        { const int kb = C.tid >> 5, vb = C.tid & 31; float acc[4][4];
#pragma unroll
          for (int x = 0; x < 4; ++x)
#pragma unroll
              for (int y = 0; y < 4; ++y) acc[x][y] = 0.f;
#pragma unroll 2
          for (int j = 0; j < 64; ++j) { const f32x4 av = *(const LAS f32x4*)(KD + j * 68 + 4 * kb), bv = *(const LAS f32x4*)(Vs + j * 132 + 4 * vb);
#pragma unroll
              for (int x = 0; x < 4; ++x)
#pragma unroll
                  for (int y = 0; y < 4; ++y) acc[x][y] += av[x] * bv[y]; }
#pragma unroll
          for (int x = 0; x < 4; ++x) *(f32x4*)(GKV + ((size_t)it * 64 + 4 * kb + x) * 128 + 4 * vb) = (f32x4){acc[x][0], acc[x][1], acc[x][2], acc[x][3]}; }
    }
    WG_SYNC();
}
PH_FN void gla_scan_part(const Ctx C, int part) {
    float* GKV = (float*)(C.ws + WS_GKV); const float* GL = (const float*)(C.ws + WS_GLAST);
    const int e = part * NTHR + C.tid, chain = e >> 13, idx = e & 8191, b = chain >> 2, h = chain & 3, k = idx >> 7;
    float st = 0.f;
#pragma unroll 4
    for (int c = 0; c < NCH; ++c) { const size_t item = (size_t)(b * NCH + c) * 4 + h; float* p = GKV + item * 8192 + idx; const float tmp = *p; const float dec = __expf(GL[item * 64 + k]); *p = st; st = dec * st + tmp; }
}
PH_HEAVY void ph_gla_c(const Ctx C, ArgsP a, int l) {
    const bf16* P = (const bf16*)(C.ws + WS_P); const float* GKV = (const float*)(C.ws + WS_GKV); bf16* YS = (bf16*)(C.ws + WS_YS);
    const float* gnorm = a->in[14] + (size_t)l * 128;
    LF Gs = (LF)C.lds; LF X = Gs + 64 * 68; LF Y = X + 64 * 68; LF Z = Y + 64 * 68;
    for (int it = C.bid; it < NBC * 4; it += C.G) {
        const int bc = it >> 2, h = it & 3;
        WG_SYNC();
        gla_compute_G(C, a, l, bc, h, Gs);
        const int t = C.tid >> 3, g8 = C.tid & 7; const size_t row = (size_t)bc * 64 + t;
        float qf[8]; unpack8(*(const u32x4*)(P + row * NPM + C_GQ + h * 64 + g8 * 8), qf);
#pragma unroll
        for (int i = 0; i < 8; ++i) { const int k = g8 * 8 + i; X[t * 68 + k] = qf[i] * 0.125f * __expf(Gs[t * 68 + k]); }
#pragma unroll
        for (int i = 0; i < 4; ++i) { const int q = C.tid + NTHR * i, k = q >> 5, v4 = q & 31; *(LAS f32x4*)(Z + k * 132 + 4 * v4) = *(const f32x4*)(GKV + ((size_t)it * 64 + k) * 128 + 4 * v4); }
        WG_SYNC();
        const int ib = C.tid >> 5, vb = C.tid & 31; float acc[4][4];
#pragma unroll
        for (int x = 0; x < 4; ++x)
#pragma unroll
            for (int y = 0; y < 4; ++y) acc[x][y] = 0.f;
#pragma unroll 2
        for (int k = 0; k < 64; ++k) { const f32x4 bv = *(const LAS f32x4*)(Z + k * 132 + 4 * vb);
#pragma unroll
            for (int x = 0; x < 4; ++x) { const float av = X[(4 * ib + x) * 68 + k];
#pragma unroll
                for (int y = 0; y < 4; ++y) acc[x][y] += av * bv[y]; } }
        WG_SYNC();
        { float kf[8]; unpack8(*(const u32x4*)(P + row * NPM + C_GK + h * 64 + g8 * 8), kf);
#pragma unroll
          for (int i = 0; i < 8; ++i) { const int k = g8 * 8 + i; const float d = Gs[t * 68 + k] - Gs[32 * 68 + k]; X[t * 68 + k] = qf[i] * 0.125f * __expf(d); Y[t * 68 + k] = kf[i] * __expf(-d); }
          float vf[16]; unpack8(*(const u32x4*)(P + row * NPM + C_GV + h * 128 + g8 * 16), vf); unpack8(*(const u32x4*)(P + row * NPM + C_GV + h * 128 + g8 * 16 + 8), vf + 8);
#pragma unroll
          for (int i = 0; i < 16; ++i) Z[t * 132 + g8 * 16 + i] = vf[i]; }
        WG_SYNC();
        { float at[8];
#pragma unroll
          for (int jj = 0; jj < 8; ++jj) at[jj] = 0.f;
#pragma unroll 2
          for (int k = 0; k < 64; k += 4) { const f32x4 av = *(const LAS f32x4*)(X + t * 68 + k);
#pragma unroll
              for (int jj = 0; jj < 8; ++jj) { const f32x4 bv = *(const LAS f32x4*)(Y + (8 * g8 + jj) * 68 + k); at[jj] += (av[0] * bv[0] + av[1] * bv[1]) + (av[2] * bv[2] + av[3] * bv[3]); } }
          WG_SYNC();
#pragma unroll
          for (int jj = 0; jj < 8; ++jj) Gs[t * 68 + 8 * g8 + jj] = (8 * g8 + jj <= t) ? at[jj] : 0.f; }
        WG_SYNC();
#pragma unroll 2
        for (int j = 0; j < 64; ++j) { const f32x4 bv = *(const LAS f32x4*)(Z + j * 132 + 4 * vb);
#pragma unroll
            for (int x = 0; x < 4; ++x) { const float av = Gs[(4 * ib + x) * 68 + j];
#pragma unroll
                for (int y = 0; y < 4; ++y) acc[x][y] += av * bv[y]; } }
#pragma unroll
        for (int x = 0; x < 4; ++x) { float s = (acc[x][0] * acc[x][0] + acc[x][1] * acc[x][1]) + (acc[x][2] * acc[x][2] + acc[x][3] * acc[x][3]);
#pragma unroll
            for (int o = 1; o < 32; o <<= 1) s += __shfl_xor(s, o);
            const float rs = 1.0f / sqrtf(s * (1.0f / 128.0f) + EPS); const size_t r2 = (size_t)bc * 64 + 4 * ib + x;
            const u32x2 ogw = *(const u32x2*)(P + r2 * NPM + C_GOG + h * 128 + 4 * vb); const f32x4 gn = *(const f32x4*)(gnorm + 4 * vb);
            const float og[4] = {bflo(ogw.x), bfhi(ogw.x), bflo(ogw.y), bfhi(ogw.y)}; float o4[4];
#pragma unroll
            for (int y = 0; y < 4; ++y) o4[y] = acc[x][y] * rs * gn[y] * siluf_(og[y]);
            u32x2 w; w.x = pk2(o4[0], o4[1]); w.y = pk2(o4[2], o4[3]); *(u32x2*)(YS + r2 * 2048 + 512 + h * 128 + 4 * vb) = w; }
    }
    WG_SYNC();
}

__device__ __forceinline__ void ssd_conv8(const bf16* P, const float* cw, const float* cb, int bc, int t, int ch0, float* o) {
    const int pos = (bc & 127) * 64 + t; const size_t row = (size_t)bc * 64 + t;
#pragma unroll
    for (int i = 0; i < 8; ++i) o[i] = cb[ch0 + i];
#pragma unroll
    for (int tap = 0; tap < 4; ++tap) { if (pos - 3 + tap >= 0) { float x[8]; unpack8(*(const u32x4*)(P + (row - 3 + tap) * NPM + C_SX + ch0), x);
#pragma unroll
        for (int i = 0; i < 8; ++i) o[i] += cw[tap * 1024 + ch0 + i] * x[i]; } }
#pragma unroll
    for (int i = 0; i < 8; ++i) o[i] = siluf_(o[i]);
}
PH_FN void ph_ssd_a(const Ctx C, ArgsP a, int l) {
    const bf16* P = (const bf16*)(C.ws + WS_P); float* SST = (float*)(C.ws + WS_SST); float* SDT = (float*)(C.ws + WS_SDT); float* SAC = (float*)(C.ws + WS_SACUM); float* SCD = (float*)(C.ws + WS_SCDEC);
    const float* cw = a->in[15] + (size_t)l * 4 * 1024; const float* cb = a->in[16] + (size_t)l * 1024; const float* dtb = a->in[17] + (size_t)l * 8; const float* alog = a->in[18] + (size_t)l * 8;
    LF XD = (LF)C.lds; LF Bm = XD + 64 * 68; LF dtv = Bm + 64 * 132; LF av = dtv + 64; LF acu = av + 64;
    for (int it = C.bid; it < NBC * 8; it += C.G) {
        const int bc = it >> 3, hd = it & 7, g = hd >> 2;
        WG_SYNC();
        if (C.tid < 64) { const size_t row = (size_t)bc * 64 + C.tid; const float dt = softplusf_(bf2f(P[row * NPM + C_SDT + hd]) + dtb[hd]); dtv[C.tid] = dt; av[C.tid] = -__expf(alog[hd]) * dt; }
        WG_SYNC();
        if (C.tid < 64) { float s = 0.f; for (int j = 0; j <= C.tid; ++j) s += av[j]; acu[C.tid] = s; const size_t row = (size_t)bc * 64 + C.tid; SDT[row * 8 + hd] = dtv[C.tid]; SAC[row * 8 + hd] = s; if (C.tid == 63) SCD[it] = __expf(s); }
        WG_SYNC();
        { const int t = C.tid >> 3, cg = C.tid & 7; float o[8];
          ssd_conv8(P, cw, cb, bc, t, hd * 64 + cg * 8, o); const float sc = dtv[t] * __expf(acu[63] - acu[t]);
#pragma unroll
          for (int i = 0; i < 8; ++i) XD[t * 68 + cg * 8 + i] = o[i] * sc;
          ssd_conv8(P, cw, cb, bc, t, 512 + g * 128 + cg * 16, o);
#pragma unroll
          for (int i = 0; i < 8; ++i) Bm[t * 132 + cg * 16 + i] = o[i];
          ssd_conv8(P, cw, cb, bc, t, 512 + g * 128 + cg * 16 + 8, o);
#pragma unroll
          for (int i = 0; i < 8; ++i) Bm[t * 132 + cg * 16 + 8 + i] = o[i]; }
        WG_SYNC();
        { const int pb = C.tid >> 5, nb = C.tid & 31; float acc[4][4];
#pragma unroll
          for (int x = 0; x < 4; ++x)
#pragma unroll
              for (int y = 0; y < 4; ++y) acc[x][y] = 0.f;
#pragma unroll 2
          for (int j = 0; j < 64; ++j) { const f32x4 xv = *(const LAS f32x4*)(XD + j * 68 + 4 * pb), bv = *(const LAS f32x4*)(Bm + j * 132 + 4 * nb);
#pragma unroll
              for (int x = 0; x < 4; ++x)
#pragma unroll
                  for (int y = 0; y < 4; ++y) acc[x][y] += xv[x] * bv[y]; }
#pragma unroll
          for (int x = 0; x < 4; ++x) *(f32x4*)(SST + ((size_t)it * 64 + 4 * pb + x) * 128 + 4 * nb) = (f32x4){acc[x][0], acc[x][1], acc[x][2], acc[x][3]}; }
    }
    WG_SYNC();
}
PH_FN void ssd_scan_part(const Ctx C, int part) {
    float* SST = (float*)(C.ws + WS_SST); const float* SCD = (const float*)(C.ws + WS_SCDEC);
    const int e = part * NTHR + C.tid, chain = e >> 13, idx = e & 8191, b = chain >> 3, hd = chain & 7;
    float st = 0.f;
#pragma unroll 4
    for (int c = 0; c < NCH; ++c) { const size_t item = (size_t)(b * NCH + c) * 8 + hd; float* p = SST + item * 8192 + idx; const float tmp = *p; const float dec = SCD[item]; *p = st; st = dec * st + tmp; }
}
PH_HEAVY void ph_ssd_c(const Ctx C, ArgsP a, int l) {
    const bf16* P = (const bf16*)(C.ws + WS_P); const float* SST = (const float*)(C.ws + WS_SST); const float* SDT = (const float*)(C.ws + WS_SDT); const float* SAC = (const float*)(C.ws + WS_SACUM); bf16* YS = (bf16*)(C.ws + WS_YS);
    const float* cw = a->in[15] + (size_t)l * 4 * 1024; const float* cb = a->in[16] + (size_t)l * 1024; const float* dpar = a->in[19] + (size_t)l * 8; const float* snorm = a->in[20] + (size_t)l * 512;
    LF Cm = (LF)C.lds; LF BH = Cm + 64 * 132; LF CB = BH + 64 * 132; LF XS = CB + 64 * 68; LF dtv = XS + 64 * 68; LF acu = dtv + 64;
    for (int it = C.bid; it < NBC * 2; it += C.G) {
        const int bc = it >> 1, g = it & 1;
        const int t = C.tid >> 3, cg = C.tid & 7;
        WG_SYNC();
        { float o[8];
#pragma unroll
          for (int half = 0; half < 2; ++half) {
              ssd_conv8(P, cw, cb, bc, t, 512 + g * 128 + cg * 16 + half * 8, o);
#pragma unroll
              for (int i = 0; i < 8; ++i) BH[t * 132 + cg * 16 + half * 8 + i] = o[i];
              ssd_conv8(P, cw, cb, bc, t, 768 + g * 128 + cg * 16 + half * 8, o);
#pragma unroll
              for (int i = 0; i < 8; ++i) Cm[t * 132 + cg * 16 + half * 8 + i] = o[i]; } }
        WG_SYNC();
        { float cbv[8];
#pragma unroll
          for (int jj = 0; jj < 8; ++jj) cbv[jj] = 0.f;
#pragma unroll 2
          for (int n = 0; n < 128; n += 4) { const f32x4 cv = *(const LAS f32x4*)(Cm + t * 132 + n);
#pragma unroll
              for (int jj = 0; jj < 8; ++jj) { const f32x4 bv = *(const LAS f32x4*)(BH + (8 * cg + jj) * 132 + n); cbv[jj] += (cv[0] * bv[0] + cv[1] * bv[1]) + (cv[2] * bv[2] + cv[3] * bv[3]); } }
#pragma unroll
          for (int jj = 0; jj < 8; ++jj) CB[t * 68 + 8 * cg + jj] = cbv[jj]; }
        float yk[4][8]; float ssq = 0.f;
#pragma unroll
        for (int hh = 0; hh < 4; ++hh) {
            const int hd = 4 * g + hh; const size_t item = (size_t)bc * 8 + hd;
            WG_SYNC();
            if (C.tid < 64) { const size_t row = (size_t)bc * 64 + C.tid; dtv[C.tid] = SDT[row * 8 + hd]; acu[C.tid] = SAC[row * 8 + hd]; }
            { float o[8]; ssd_conv8(P, cw, cb, bc, t, hd * 64 + cg * 8, o);
#pragma unroll
              for (int i = 0; i < 8; ++i) XS[t * 68 + cg * 8 + i] = o[i]; }
#pragma unroll
            for (int i = 0; i < 4; ++i) { const int q = C.tid + NTHR * i, p = q >> 5, n4 = q & 31; *(LAS f32x4*)(BH + p * 132 + 4 * n4) = *(const f32x4*)(SST + (item * 64 + p) * 128 + 4 * n4); }
            WG_SYNC();
            float y[8]; const float ai = acu[t];
#pragma unroll
            for (int pp = 0; pp < 8; ++pp) y[pp] = 0.f;
#pragma unroll 2
            for (int j = 0; j <= t; ++j) { const float s = CB[t * 68 + j] * __expf(ai - acu[j]) * dtv[j]; const f32x4 x0 = *(const LAS f32x4*)(XS + j * 68 + 8 * cg), x1 = *(const LAS f32x4*)(XS + j * 68 + 8 * cg + 4);
#pragma unroll
                for (int pp = 0; pp < 4; ++pp) { y[pp] += s * x0[pp]; y[4 + pp] += s * x1[pp]; } }
            { float yi[8];
#pragma unroll
              for (int pp = 0; pp < 8; ++pp) yi[pp] = 0.f;
#pragma unroll 2
              for (int n = 0; n < 128; n += 4) { const f32x4 cv = *(const LAS f32x4*)(Cm + t * 132 + n);
#pragma unroll
                  for (int pp = 0; pp < 8; ++pp) { const f32x4 hv = *(const LAS f32x4*)(BH + (8 * cg + pp) * 132 + n); yi[pp] += (cv[0] * hv[0] + cv[1] * hv[1]) + (cv[2] * hv[2] + cv[3] * hv[3]); } }
              const float ea = __expf(ai); const float dh = dpar[hd]; const size_t row = (size_t)bc * 64 + t;
              float zf[8]; unpack8(*(const u32x4*)(P + row * NPM + C_SZ + hd * 64 + cg * 8), zf);
#pragma unroll
              for (int pp = 0; pp < 8; ++pp) { const float v = (y[pp] + ea * yi[pp] + dh * XS[t * 68 + 8 * cg + pp]) * siluf_(zf[pp]); yk[hh][pp] = v; ssq += v * v; } }
        }
        ssq += __shfl_xor(ssq, 1); ssq += __shfl_xor(ssq, 2); ssq += __shfl_xor(ssq, 4);
        const float rs = 1.0f / sqrtf(ssq * (1.0f / 256.0f) + EPS); const size_t row = (size_t)bc * 64 + t;
#pragma unroll
        for (int hh = 0; hh < 4; ++hh) { float o[8];
#pragma unroll
            for (int pp = 0; pp < 8; ++pp) o[pp] = yk[hh][pp] * rs * snorm[g * 256 + hh * 64 + cg * 8 + pp];
            *(u32x4*)(YS + row * 2048 + 1024 + g * 256 + hh * 64 + cg * 8) = pack8(o); }
    }
    WG_SYNC();
}

__device__ __forceinline__ void rw_lerp8(const bf16* P, const float* mu, int bc, int t, int c0, float* o) {
    const size_t row = (size_t)bc * 64 + t; const bool first = ((bc & 127) == 0) && (t == 0);
    float x[8], xp[8]; unpack8(*(const u32x4*)(P + row * NPM + C_RR + c0), x);
    if (!first) unpack8(*(const u32x4*)(P + (row - 1) * NPM + C_RR + c0), xp); else {
#pragma unroll
        for (int i = 0; i < 8; ++i) xp[i] = 0.f; }
#pragma unroll
    for (int i = 0; i < 8; ++i) o[i] = x[i] + (xp[i] - x[i]) * mu[c0 + i];
}
PH_HEAVY void ph_rw_prep(const Ctx C, ArgsP a, int l) {
    const bf16* P = (const bf16*)(C.ws + WS_P);
    float* RWW = (float*)(C.ws + WS_RWW); bf16* RWR = (bf16*)(C.ws + WS_RWR); bf16* RWK = (bf16*)(C.ws + WS_RWK); bf16* RWV = (bf16*)(C.ws + WS_RWV); bf16* RWKK = (bf16*)(C.ws + WS_RWKK); bf16* RWB = (bf16*)(C.ws + WS_RWB); bf16* RWG = (bf16*)(C.ws + WS_RWG);
    const float* mu = a->in[21] + (size_t)l * 1792; const float* w0 = a->in[22] + (size_t)l * 512; const float* w2 = a->in[23] + (size_t)l * 64 * 512; const float* a0 = a->in[24] + (size_t)l * 512; const float* a2 = a->in[25] + (size_t)l * 64 * 512;
    const float* g2 = a->in[26] + (size_t)l * 128 * 512; const float* k_k = a->in[27] + (size_t)l * 512; const float* k_a = a->in[28] + (size_t)l * 512;
    LF WL = (LF)C.lds; LF AL = WL + 64 * 68; LF GLs = AL + 64 * 68;
    for (int bc = C.bid; bc < NBC; bc += C.G) {
        WG_SYNC();
        { const int t = C.tid >> 3, cg = C.tid & 7; float o[8];
          rw_lerp8(P, mu, bc, t, 1536 + cg * 8, o);
#pragma unroll
          for (int i = 0; i < 8; ++i) WL[t * 68 + cg * 8 + i] = tanhf(o[i]);
          rw_lerp8(P, mu, bc, t, 1600 + cg * 8, o);
#pragma unroll
          for (int i = 0; i < 8; ++i) AL[t * 68 + cg * 8 + i] = o[i];
          rw_lerp8(P, mu, bc, t, 1664 + cg * 16, o);
#pragma unroll
          for (int i = 0; i < 8; ++i) GLs[t * 132 + cg * 16 + i] = sigmoidf_(o[i]);
          rw_lerp8(P, mu, bc, t, 1664 + cg * 16 + 8, o);
#pragma unroll
          for (int i = 0; i < 8; ++i) GLs[t * 132 + cg * 16 + 8 + i] = sigmoidf_(o[i]); }
        WG_SYNC();
        const int tb = C.tid >> 6, cb = C.tid & 63, ch0 = cb * 8;
#pragma unroll 1
        for (int half = 0; half < 2; ++half) {
        const int rb = 8 * tb + 4 * half;
        float acc[4][8], av[4][8];
#pragma unroll
        for (int i = 0; i < 4; ++i)
#pragma unroll
            for (int j = 0; j < 8; ++j) acc[i][j] = 0.f;
#pragma unroll 2
        for (int r = 0; r < 64; ++r) { const f32x4 b0 = *(const f32x4*)(w2 + r * 512 + ch0), b1 = *(const f32x4*)(w2 + r * 512 + ch0 + 4);
#pragma unroll
            for (int i = 0; i < 4; ++i) { const float x = WL[(rb + i) * 68 + r];
#pragma unroll
                for (int j = 0; j < 4; ++j) { acc[i][j] += x * b0[j]; acc[i][4 + j] += x * b1[j]; } } }
#pragma unroll
        for (int i = 0; i < 4; ++i) { const size_t row = (size_t)bc * 64 + rb + i; float o[8];
#pragma unroll
            for (int j = 0; j < 8; ++j) o[j] = __expf(-0.606531f * sigmoidf_(w0[ch0 + j] + acc[i][j]));
            *(f32x4*)(RWW + row * 512 + ch0) = (f32x4){o[0], o[1], o[2], o[3]}; *(f32x4*)(RWW + row * 512 + ch0 + 4) = (f32x4){o[4], o[5], o[6], o[7]}; }
#pragma unroll
        for (int i = 0; i < 4; ++i)
#pragma unroll
            for (int j = 0; j < 8; ++j) acc[i][j] = 0.f;
#pragma unroll 2
        for (int r = 0; r < 64; ++r) { const f32x4 b0 = *(const f32x4*)(a2 + r * 512 + ch0), b1 = *(const f32x4*)(a2 + r * 512 + ch0 + 4);
#pragma unroll
            for (int i = 0; i < 4; ++i) { const float x = AL[(rb + i) * 68 + r];
#pragma unroll
                for (int j = 0; j < 4; ++j) { acc[i][j] += x * b0[j]; acc[i][4 + j] += x * b1[j]; } } }
#pragma unroll
        for (int i = 0; i < 4; ++i)
#pragma unroll
            for (int j = 0; j < 8; ++j) av[i][j] = sigmoidf_(a0[ch0 + j] + acc[i][j]);
#pragma unroll
        for (int i = 0; i < 4; ++i)
#pragma unroll
            for (int j = 0; j < 8; ++j) acc[i][j] = 0.f;
#pragma unroll 2
        for (int r = 0; r < 128; ++r) { const f32x4 b0 = *(const f32x4*)(g2 + r * 512 + ch0), b1 = *(const f32x4*)(g2 + r * 512 + ch0 + 4);
#pragma unroll
            for (int i = 0; i < 4; ++i) { const float x = GLs[(rb + i) * 132 + r];
#pragma unroll
                for (int j = 0; j < 4; ++j) { acc[i][j] += x * b0[j]; acc[i][4 + j] += x * b1[j]; } } }
#pragma unroll
        for (int i = 0; i < 4; ++i) { const size_t row = (size_t)bc * 64 + rb + i; *(u32x4*)(RWG + row * 512 + ch0) = pack8(acc[i]); }
#pragma unroll
        for (int i = 0; i < 4; ++i) { const int t = rb + i; const size_t row = (size_t)bc * 64 + t; float o[8], kx[8], kk[8];
            rw_lerp8(P, mu, bc, t, ch0, o); *(u32x4*)(RWR + row * 512 + ch0) = pack8(o);
            rw_lerp8(P, mu, bc, t, 1024 + ch0, o); *(u32x4*)(RWV + row * 512 + ch0) = pack8(o);
            rw_lerp8(P, mu, bc, t, 512 + ch0, kx);
            float ss = 0.f;
#pragma unroll
            for (int j = 0; j < 8; ++j) { kk[j] = kx[j] * k_k[ch0 + j]; ss += kk[j] * kk[j]; }
            ss += __shfl_xor(ss, 1); ss += __shfl_xor(ss, 2); ss += __shfl_xor(ss, 4);
            const float inv = 1.0f / fmaxf(sqrtf(ss), 1e-12f);
#pragma unroll
            for (int j = 0; j < 8; ++j) { kk[j] *= inv; o[j] = kk[j] * av[i][j]; kx[j] = kx[j] * (1.0f + (av[i][j] - 1.0f) * k_a[ch0 + j]); }
            *(u32x4*)(RWKK + row * 512 + ch0) = pack8(kk); *(u32x4*)(RWB + row * 512 + ch0) = pack8(o); *(u32x4*)(RWK + row * 512 + ch0) = pack8(kx); }
        }
    }
    WG_SYNC();
}
PH_FN void rw_chain(const Ctx C, int chain) {
    const float* RWW = (const float*)(C.ws + WS_RWW); const bf16* RWR = (const bf16*)(C.ws + WS_RWR); const bf16* RWK = (const bf16*)(C.ws + WS_RWK); const bf16* RWV = (const bf16*)(C.ws + WS_RWV);
    const bf16* RWKK = (const bf16*)(C.ws + WS_RWKK); const bf16* RWB = (const bf16*)(C.ws + WS_RWB); bf16* RWY = (bf16*)(C.ws + WS_RWY);
    const int b = chain >> 3, h = chain & 7;
    LF Rs = (LF)C.lds; LF Ws = Rs + 4096; LF Ks = Ws + 4096; LF Vs = Ks + 4096; LF KKs = Vs + 4096; LF Bs = KKs + 4096; LF Ys = Bs + 4096;
    const int rowl = 8 * C.wave + (C.lane >> 3), ks = C.lane & 7;
    float S[8];
#pragma unroll
    for (int j = 0; j < 8; ++j) S[j] = 0.f;
    const int lt = C.tid >> 3, lc = (C.tid & 7) * 8;
    for (int blk = 0; blk < NCH; ++blk) {
        const size_t row0 = (size_t)b * SEQ + blk * 64;
        WG_SYNC();
        { const size_t g = (row0 + lt) * 512 + h * 64 + lc; float o[8];
          *(LAS f32x4*)(Ws + lt * 64 + lc) = *(const f32x4*)(RWW + g); *(LAS f32x4*)(Ws + lt * 64 + lc + 4) = *(const f32x4*)(RWW + g + 4);
          unpack8(*(const u32x4*)(RWR + g), o); *(LAS f32x4*)(Rs + lt * 64 + lc) = (f32x4){o[0], o[1], o[2], o[3]}; *(LAS f32x4*)(Rs + lt * 64 + lc + 4) = (f32x4){o[4], o[5], o[6], o[7]};
          unpack8(*(const u32x4*)(RWK + g), o); *(LAS f32x4*)(Ks + lt * 64 + lc) = (f32x4){o[0], o[1], o[2], o[3]}; *(LAS f32x4*)(Ks + lt * 64 + lc + 4) = (f32x4){o[4], o[5], o[6], o[7]};
          unpack8(*(const u32x4*)(RWV + g), o); *(LAS f32x4*)(Vs + lt * 64 + lc) = (f32x4){o[0], o[1], o[2], o[3]}; *(LAS f32x4*)(Vs + lt * 64 + lc + 4) = (f32x4){o[4], o[5], o[6], o[7]};
          unpack8(*(const u32x4*)(RWKK + g), o); *(LAS f32x4*)(KKs + lt * 64 + lc) = (f32x4){o[0], o[1], o[2], o[3]}; *(LAS f32x4*)(KKs + lt * 64 + lc + 4) = (f32x4){o[4], o[5], o[6], o[7]};
          unpack8(*(const u32x4*)(RWB + g), o); *(LAS f32x4*)(Bs + lt * 64 + lc) = (f32x4){o[0], o[1], o[2], o[3]}; *(LAS f32x4*)(Bs + lt * 64 + lc + 4) = (f32x4){o[4], o[5], o[6], o[7]}; }
        WG_SYNC();
        for (int t = 0; t < 64; ++t) {
            const f32x4 kk0 = *(const LAS f32x4*)(KKs + t * 64 + 8 * ks), kk1 = *(const LAS f32x4*)(KKs + t * 64 + 8 * ks + 4);
            const f32x4 w0 = *(const LAS f32x4*)(Ws + t * 64 + 8 * ks), w1 = *(const LAS f32x4*)(Ws + t * 64 + 8 * ks + 4);
            const f32x4 b0 = *(const LAS f32x4*)(Bs + t * 64 + 8 * ks), b1 = *(const LAS f32x4*)(Bs + t * 64 + 8 * ks + 4);
            const f32x4 k0 = *(const LAS f32x4*)(Ks + t * 64 + 8 * ks), k1 = *(const LAS f32x4*)(Ks + t * 64 + 8 * ks + 4);
            const f32x4 r0 = *(const LAS f32x4*)(Rs + t * 64 + 8 * ks), r1 = *(const LAS f32x4*)(Rs + t * 64 + 8 * ks + 4);
            const float vv = Vs[t * 64 + rowl];
            float sa = (S[0] * kk0[0] + S[1] * kk0[1]) + (S[2] * kk0[2] + S[3] * kk0[3]) + (S[4] * kk1[0] + S[5] * kk1[1]) + (S[6] * kk1[2] + S[7] * kk1[3]);
            sa += __shfl_xor(sa, 1); sa += __shfl_xor(sa, 2); sa += __shfl_xor(sa, 4);
            sa = -sa;
#pragma unroll
            for (int j = 0; j < 4; ++j) { S[j] = S[j] * w0[j] + sa * b0[j] + vv * k0[j]; S[4 + j] = S[4 + j] * w1[j] + sa * b1[j] + vv * k1[j]; }
            float y = (S[0] * r0[0] + S[1] * r0[1]) + (S[2] * r0[2] + S[3] * r0[3]) + (S[4] * r1[0] + S[5] * r1[1]) + (S[6] * r1[2] + S[7] * r1[3]);
            y += __shfl_xor(y, 1); y += __shfl_xor(y, 2); y += __shfl_xor(y, 4);
            if (ks == 0) Ys[t * 64 + rowl] = y;
        }
        WG_SYNC();
        { float o[8];
#pragma unroll
          for (int i = 0; i < 8; ++i) o[i] = Ys[lt * 64 + lc + i];
          *(u32x4*)(RWY + (row0 + lt) * 512 + h * 64 + lc) = pack8(o); }
    }
    WG_SYNC();
}
PH_FN void ph_rw_out(const Ctx C, ArgsP a, int l) {
    const bf16* RWR = (const bf16*)(C.ws + WS_RWR); const bf16* RWK = (const bf16*)(C.ws + WS_RWK); const bf16* RWV = (const bf16*)(C.ws + WS_RWV); const bf16* RWG = (const bf16*)(C.ws + WS_RWG); const bf16* RWY = (const bf16*)(C.ws + WS_RWY);
    bf16* YS = (bf16*)(C.ws + WS_YS);
    const float* r_k = a->in[29] + (size_t)l * 512; const float* nw = a->in[30] + (size_t)l * 512; const float* nb = a->in[31] + (size_t)l * 512;
    const int gw = C.bid * NWAVES + C.wave, NGW = C.G * NWAVES;
    for (int it = gw; it < M * 8; it += NGW) {
        const size_t row = (size_t)(it >> 3); const int h = it & 7, c = h * 64 + C.lane; const size_t g = row * 512 + c;
        const float y = bf2f(RWY[g]), r = bf2f(RWR[g]), k = bf2f(RWK[g]), v = bf2f(RWV[g]), gg = bf2f(RWG[g]);
        const float mu = wave_sum(y) * (1.0f / 64.0f); const float d = y - mu; const float var = wave_sum(d * d) * (1.0f / 64.0f);
        const float yn = d * (1.0f / sqrtf(var + 64e-5f)) * nw[c] + nb[c];
        const float bonus = wave_sum(r * k * r_k[c]) * v;
        YS[row * 2048 + 1536 + c] = (bf16)f2bf((yn + bonus) * gg);
    }
}

__device__ __forceinline__ int pi_swap23(int i) { return (i & ~12) | ((i & 4) << 1) | ((i & 8) >> 1); }
__device__ __forceinline__ void da_unit(const Ctx& C, const Args& a, int l, int b, int h, int jq, float lam, float oml) {
    const bf16* P = (const bf16*)(C.ws + WS_P); const bf16* VT = (const bf16*)(C.ws + WS_VT); bf16* YS = (bf16*)(C.ws + WS_YS);
    const float* dnorm = a.in[11] + (size_t)l * 128;
    const int comp = C.wave >> 2, wq = C.wave & 3, q = C.lane & 31, hi = C.lane >> 5;
    const size_t qrow = (size_t)b * SEQ + jq * 128 + wq * 32 + q;
    pg8::bf16x8 qf[4];
#pragma unroll
    for (int d0 = 0; d0 < 4; ++d0) qf[d0] = *(const pg8::bf16x8*)(P + qrow * NPM + C_DAQ + h * 128 + comp * 64 + 16 * d0 + 8 * hi);
    const int ntile = 2 * jq + 2, my_last = 2 * jq + (wq >= 2 ? 1 : 0);
    f32x16 O[4];
#pragma unroll
    for (int db = 0; db < 4; ++db)
#pragma unroll
        for (int r = 0; r < 16; ++r) O[db][r] = 0.f;
    float mrun = -1e30f, lrun = 0.f;
    const bf16* kg = P + ((size_t)b * SEQ + (C.tid & 63)) * NPM + C_DAK + h * 128;
    const bf16* vg = VT + ((size_t)(b * 4 + h) * 128 + (C.tid & 127)) * SEQ;
    const int kc16 = C.tid >> 6, vc8 = C.tid >> 7;
    u32x4 kr[2], vr[2];
#pragma unroll
    for (int i = 0; i < 2; ++i) { kr[i] = *(const u32x4*)(kg + (kc16 + 8 * i) * 8); vr[i] = *(const u32x4*)(vg + (vc8 + 4 * i) * 8); }
    const int pq = pi_swap23(q);
    for (int tile = 0; tile < ntile; ++tile) {
        LAS unsigned char* buf = C.lds + (tile & 1) * 32768;
#pragma unroll
        for (int i = 0; i < 2; ++i) { const int c16 = kc16 + 8 * i; *(LAS u32x4*)(buf + (c16 >> 3) * 8192 + (c16 & 7) * 1024 + (C.tid & 63) * 16) = kr[i];
            *(LAS u32x4*)(buf + 16384 + (vc8 + 4 * i) * 2048 + (C.tid & 127) * 16) = vr[i]; }
        WG_SYNC();
        if (tile + 1 < ntile) {
#pragma unroll
            for (int i = 0; i < 2; ++i) { kr[i] = *(const u32x4*)(kg + (size_t)(tile + 1) * 64 * NPM + (kc16 + 8 * i) * 8); vr[i] = *(const u32x4*)(vg + (tile + 1) * 64 + (vc8 + 4 * i) * 8); } }
        if (tile <= my_last) {
            const LAS unsigned char* kb = buf + comp * 8192; const LAS unsigned char* vb = buf + 16384;
            f32x16 p0, p1;
#pragma unroll
            for (int r = 0; r < 16; ++r) { p0[r] = 0.f; p1[r] = 0.f; }
#pragma unroll
            for (int d0 = 0; d0 < 4; ++d0) {
                const pg8::bf16x8 a0 = *(const LAS pg8::bf16x8*)(kb + (2 * d0 + hi) * 1024 + pq * 16);
                const pg8::bf16x8 a1 = *(const LAS pg8::bf16x8*)(kb + (2 * d0 + hi) * 1024 + (32 + pq) * 16);
                p0 = __builtin_amdgcn_mfma_f32_32x32x16_bf16(a0, qf[d0], p0, 0, 0, 0);
                p1 = __builtin_amdgcn_mfma_f32_32x32x16_bf16(a1, qf[d0], p1, 0, 0, 0);
            }
            float mx = fmaxf(p0[0], p1[0]);
#pragma unroll
            for (int r = 1; r < 16; ++r) mx = fmaxf(mx, fmaxf(p0[r], p1[r]));
            mx = fmaxf(mx, __shfl_xor(mx, 32));
            const float mnew = fmaxf(mrun, mx); const float alpha = __builtin_amdgcn_exp2f(mrun - mnew); mrun = mnew;
            float rs = 0.f;
#pragma unroll
            for (int r = 0; r < 16; ++r) { p0[r] = __builtin_amdgcn_exp2f(p0[r] - mnew); p1[r] = __builtin_amdgcn_exp2f(p1[r] - mnew); rs += p0[r] + p1[r]; }
            lrun = lrun * alpha + rs;
#pragma unroll
            for (int db = 0; db < 4; ++db)
#pragma unroll
                for (int r = 0; r < 16; ++r) O[db][r] *= alpha;
            pg8::bf16x8 pb[4];
            { u32x4 w;
              w.x = pk2(p0[0], p0[1]); w.y = pk2(p0[2], p0[3]); w.z = pk2(p0[4], p0[5]); w.w = pk2(p0[6], p0[7]); pb[0] = __builtin_bit_cast(pg8::bf16x8, w);
              w.x = pk2(p0[8], p0[9]); w.y = pk2(p0[10], p0[11]); w.z = pk2(p0[12], p0[13]); w.w = pk2(p0[14], p0[15]); pb[1] = __builtin_bit_cast(pg8::bf16x8, w);
              w.x = pk2(p1[0], p1[1]); w.y = pk2(p1[2], p1[3]); w.z = pk2(p1[4], p1[5]); w.w = pk2(p1[6], p1[7]); pb[2] = __builtin_bit_cast(pg8::bf16x8, w);
              w.x = pk2(p1[8], p1[9]); w.y = pk2(p1[10], p1[11]); w.z = pk2(p1[12], p1[13]); w.w = pk2(p1[14], p1[15]); pb[3] = __builtin_bit_cast(pg8::bf16x8, w); }
#pragma unroll
            for (int db = 0; db < 4; ++db)
#pragma unroll
                for (int s = 0; s < 4; ++s) {
                    const pg8::bf16x8 vf = *(const LAS pg8::bf16x8*)(vb + (2 * s + hi) * 2048 + (32 * db + q) * 16);
                    O[db] = __builtin_amdgcn_mfma_f32_32x32x16_bf16(vf, pb[s], O[db], 0, 0, 0);
                }
        }
    }
    const float ltot = lrun + __shfl_xor(lrun, 32); const float inv = 1.0f / ltot;
    WG_SYNC();
    LF X = (LF)C.lds + (wq * 32 + q) * 132;
    if (comp == 1) {
        const float sc = inv * lam;
#pragma unroll
        for (int db = 0; db < 4; ++db)
#pragma unroll
            for (int g4 = 0; g4 < 4; ++g4) *(LAS f32x4*)(X + 32 * db + 8 * g4 + 4 * hi) = (f32x4){O[db][4 * g4] * sc, O[db][4 * g4 + 1] * sc, O[db][4 * g4 + 2] * sc, O[db][4 * g4 + 3] * sc};
    }
    WG_SYNC();
    if (comp == 0) {
        float ss = 0.f;
#pragma unroll
        for (int db = 0; db < 4; ++db)
#pragma unroll
            for (int g4 = 0; g4 < 4; ++g4) { const f32x4 x = *(const LAS f32x4*)(X + 32 * db + 8 * g4 + 4 * hi);
#pragma unroll
                for (int e = 0; e < 4; ++e) { const float v = O[db][4 * g4 + e] * inv - x[e]; O[db][4 * g4 + e] = v; ss += v * v; } }
        ss += __shfl_xor(ss, 32);
        const float rs = oml / sqrtf(ss * (1.0f / 128.0f) + EPS);
#pragma unroll
        for (int db = 0; db < 4; ++db)
#pragma unroll
            for (int g4 = 0; g4 < 4; ++g4) { const int d = 32 * db + 8 * g4 + 4 * hi; const f32x4 gn = *(const f32x4*)(dnorm + d);
                u32x2 w; w.x = pk2(O[db][4 * g4] * rs * gn[0], O[db][4 * g4 + 1] * rs * gn[1]); w.y = pk2(O[db][4 * g4 + 2] * rs * gn[2], O[db][4 * g4 + 3] * rs * gn[3]);
                *(u32x2*)(YS + qrow * 2048 + h * 128 + d) = w; }
    }
    WG_SYNC();
}
__device__ __forceinline__ void ph_da_attn(const Ctx& C, const Args& a, int l) {
    const float* q1 = a.in[7] + (size_t)l * 64; const float* k1 = a.in[8] + (size_t)l * 64; const float* q2 = a.in[9] + (size_t)l * 64; const float* k2 = a.in[10] + (size_t)l * 64;
    float s1 = 0.f, s2 = 0.f;
    for (int i = 0; i < 64; ++i) { s1 += q1[i] * k1[i]; s2 += q2[i] * k2[i]; }
    const float lam_init = 0.8f - 0.6f * expf(-0.3f * (float)l); const float lam = expf(s1) - expf(s2) + lam_init;
    for (int pair = C.bid; pair < 256; pair += C.G) {
        const int bh = pair >> 5, jj = pair & 31;
        da_unit(C, a, l, bh >> 2, bh & 3, 63 - jj, lam, 1.0f - lam_init);
        da_unit(C, a, l, bh >> 2, bh & 3, jj, lam, 1.0f - lam_init);
    }
}

PH_FN void ph_final(const Ctx C, ArgsP a) {
    const float* ssq = (const float*)(C.ws + WS_SSQ); const float* fn = a->in[39];
    const int gw = C.bid * NWAVES + C.wave, NGW = C.G * NWAVES;
    for (int m = gw; m < M; m += NGW) { const float rs = pg8::row_rstd(ssq, m, M); f32x4* hr = (f32x4*)(C.h + (size_t)m * D) + C.lane; const f32x4* gr = (const f32x4*)fn + C.lane;
#pragma unroll
        for (int j = 0; j < 4; ++j) { const f32x4 v = hr[64 * j], g = gr[64 * j]; hr[64 * j] = v * rs * g; } }
}
constexpr int NPH = 12, G_FINAL = 1 + NL * NPH, G_END = G_FINAL + 1;
template <int GRP>
__global__ void __launch_bounds__(NTHR, 2) hybrid_fwd(Args args) {
    constexpr bool ALL = (GRP < 0);
    constexpr bool EN_G1 = ALL || GRP == 0, EN_G2 = EN_G1, EN_G3 = EN_G1, EN_G7 = EN_G1, EN_G8 = EN_G1, EN_G9 = EN_G1;
    constexpr bool EN_PRO = ALL || GRP == 1, EN_W = EN_PRO, EN_FIN = EN_PRO, EN_MA1 = EN_PRO, EN_MA2 = EN_PRO, EN_MA3 = EN_PRO, EN_MA4 = EN_PRO;
    constexpr bool EN_MB1 = ALL || GRP == 2, EN_MB2 = EN_MB1;
    constexpr bool EN_MC1 = ALL || GRP == 3, EN_MC2 = EN_MC1, EN_MC3 = EN_MC1;
    extern __shared__ __attribute__((aligned(16))) unsigned char lds[];
    Ctx C; C.lds = (LAS unsigned char*)lds; C.ws = args.ws; C.h = args.out; C.tid = threadIdx.x; C.lane = C.tid & 63; C.wave = __builtin_amdgcn_readfirstlane(C.tid >> 6); C.bid = blockIdx.x; C.G = gridDim.x;
    LAS unsigned char* ldsl = (LAS unsigned char*)lds;
    const ArgsP ap = (ArgsP)__builtin_amdgcn_kernarg_segment_ptr();
    for (int u = C.tid; u < (LDS_BYTES - LDSCTL_OFF) / 4; u += NTHR) ((LAS unsigned*)(ldsl + LDSCTL_OFF))[u] = 0u;
    __syncthreads();
    volatile LAS unsigned* MISC = (volatile LAS unsigned*)(ldsl + MISC_OFF);
    gu32* ctl = (gu32*)(args.ws + WS_CTL);
    const int g_lo = args.g_lo, g_hi = args.g_hi;
    XcdBarrier bar; bar.bar = (unsigned*)(ctl + CW_BAR); bar.x = 0; bar.st = nullptr;
    if (g_hi - g_lo > 1) bar = xcd_barrier_post((unsigned*)(ctl + CW_BAR), MISC + 8);
#define IN(g) (g_lo <= (g) && (g) < g_hi)
#define SEAM(g) do { if (IN(g) && IN((g) + 1)) xcd_barrier(bar); } while (0)
    bf16* HB = (bf16*)(args.ws + WS_HB); float* SSQ = (float*)(args.ws + WS_SSQ);

    if (EN_PRO && IN(0)) ph_prologue(fresh(C), ap);
    SEAM(0);
#pragma unroll 1
    for (int l = 0; l < NL; ++l) {
        const int gb = 1 + NPH * l;
        if (EN_W && IN(gb + 0)) ph_weights(fresh(C), ap, l);
        SEAM(gb + 0);
#pragma unroll 1
        for (int f = 0; f < 2; ++f) {
            const int gu = gb + (f ? 10 : 1);
            if (EN_G1 && IN(gu)) {
                pg8::Gemm g{HB, (const bf16*)(args.ws + (f ? WS_WGU2 : WS_WGU1)), M, 2 * FF, D, D}; pg8::StaticOrder S; S.init(M, 2 * FF, C.G, C.bid);
                pg8::EpiSwiglu E{(bf16*)(args.ws + WS_ACT), FF, SSQ, M};
                pg8::gemm_phase<pg8::EpiSwiglu, pg8::StaticOrder, true, true>(ldsl, g, S, E);
            }
            SEAM(gu);
            if (EN_G2 && IN(gu + 1)) {
                pg8::Gemm g{(const bf16*)(args.ws + WS_ACT), (const bf16*)(args.ws + (f ? WS_WD2 : WS_WD1)), M, D, FF, FF}; pg8::StaticOrder S; S.init(M, D, C.G, C.bid);
                pg8::EpiResid E{C.h, HB, SSQ, M, 0.5f};
                pg8::gemm_phase<pg8::EpiResid, pg8::StaticOrder, false, true>(ldsl, g, S, E);
            }
            SEAM(gu + 1);
            if (f == 0) {
                if (EN_G3 && IN(gb + 3)) {
                    pg8::Gemm g{HB, (const bf16*)(args.ws + WS_WIN), M, NPM, D, D}; pg8::StaticOrder S; S.init(M, NPM, C.G, C.bid);
                    pg8::EpiScaleBf16 E{(bf16*)(args.ws + WS_P), NPM, SSQ, M};
                    pg8::gemm_phase<pg8::EpiScaleBf16, pg8::StaticOrder, true, true>(ldsl, g, S, E);
                }
                SEAM(gb + 3);
                if (IN(gb + 4)) { if (EN_MA1) ph_da_prep(fresh(C)); if (EN_MA2) ph_gla_a(fresh(C), ap, l); if (EN_MA3) ph_ssd_a(fresh(C), ap, l); if (EN_MA4) ph_rw_prep(fresh(C), ap, l); }
                SEAM(gb + 4);
                if (IN(gb + 5)) {
                    if (EN_MB1) ph_da_attn(fresh(C), args, l);
                    if (!EN_MB2) {} else if (C.bid < 16) rw_chain(fresh(C), C.bid);
                    else if (C.bid < 144) gla_scan_part(fresh(C), C.bid - 16);
                    else { for (int part = C.bid - 144; part < 256; part += C.G - 144) ssd_scan_part(fresh(C), part); }
                }
                SEAM(gb + 5);
                if (IN(gb + 6)) { if (EN_MC1) ph_gla_c(fresh(C), ap, l); if (EN_MC2) ph_ssd_c(fresh(C), ap, l); if (EN_MC3) ph_rw_out(fresh(C), ap, l); }
                SEAM(gb + 6);
                if (EN_G7 && IN(gb + 7)) {
                    pg8::Gemm g{HB, (const bf16*)(args.ws + WS_WIN) + (size_t)NPM * D, M, 4096, D, D}; pg8::StaticOrder S; S.init(M, 4096, C.G, C.bid);
                    pg8::EpiScaleBf16 E{(bf16*)(args.ws + WS_PG), 4096, SSQ, M};
                    pg8::gemm_phase<pg8::EpiScaleBf16, pg8::StaticOrder, true, true>(ldsl, g, S, E);
                }
                SEAM(gb + 7);
                if (EN_G8 && IN(gb + 8)) {
                    pg8::Gemm g{(const bf16*)(args.ws + WS_YS), (const bf16*)(args.ws + WS_WB), M, D, 512, 2048}; pg8::GroupedOrder S; S.init(M, D, 4, 512, C.G, C.bid);
                    pg8::EpiGateAcc E{(bf16*)(args.ws + WS_MERGED), (const bf16*)(args.ws + WS_PG), args.in[33] + (size_t)l * 4096};
                    pg8::gemm_phase<pg8::EpiGateAcc, pg8::GroupedOrder, true, true>(ldsl, g, S, E);
                }
                SEAM(gb + 8);
                if (EN_G9 && IN(gb + 9)) {
                    pg8::Gemm g{(const bf16*)(args.ws + WS_MERGED), (const bf16*)(args.ws + WS_WO), M, D, D, D}; pg8::StaticOrder S; S.init(M, D, C.G, C.bid);
                    pg8::EpiResid E{C.h, HB, SSQ, M, 1.0f};
                    pg8::gemm_phase<pg8::EpiResid, pg8::StaticOrder, false, true>(ldsl, g, S, E);
                }
                SEAM(gb + 9);
            }
        }
    }
    if (EN_FIN && IN(G_FINAL)) ph_final(fresh(C), ap);
#undef IN
#undef SEAM
}

#ifndef ONE_LAUNCH
#define ONE_LAUNCH 1
#endif
extern "C" void kernel_launch(void* const* d_in, const int* in_sizes, int n_in, void* d_out, int out_size, void* d_ws, size_t ws_size, hipStream_t stream) {
    static int grid = 0;
    if (grid == 0) {
        if (n_in != 40 || in_sizes[0] != M * D || out_size != M * D || ws_size < WS_END) { fprintf(stderr, "kernel_launch: unexpected shapes (n_in %d, in0 %d, out %d, ws %zu < %zu); nothing launched\n", n_in, n_in > 0 ? in_sizes[0] : -1, out_size, ws_size, (size_t)WS_END); grid = -1; return; }
        int dev = 0, cus = 0, per_cu = 0;
        if (hipGetDevice(&dev) != hipSuccess || hipDeviceGetAttribute(&cus, hipDeviceAttributeMultiprocessorCount, dev) != hipSuccess) { grid = -1; return; }
#if ONE_LAUNCH
        if (hipFuncSetAttribute((const void*)hybrid_fwd<-1>, hipFuncAttributeMaxDynamicSharedMemorySize, LDS_BYTES) != hipSuccess) { fprintf(stderr, "kernel_launch: hipFuncSetAttribute failed\n"); grid = -1; return; }
#else
        if (hipFuncSetAttribute((const void*)hybrid_fwd<0>, hipFuncAttributeMaxDynamicSharedMemorySize, LDS_BYTES) != hipSuccess || hipFuncSetAttribute((const void*)hybrid_fwd<1>, hipFuncAttributeMaxDynamicSharedMemorySize, LDS_BYTES) != hipSuccess ||
            hipFuncSetAttribute((const void*)hybrid_fwd<2>, hipFuncAttributeMaxDynamicSharedMemorySize, LDS_BYTES) != hipSuccess || hipFuncSetAttribute((const void*)hybrid_fwd<3>, hipFuncAttributeMaxDynamicSharedMemorySize, LDS_BYTES) != hipSuccess) { fprintf(stderr, "kernel_launch: hipFuncSetAttribute failed\n"); grid = -1; return; }
#endif
        if (hipOccupancyMaxActiveBlocksPerMultiprocessor(&per_cu, (const void*)hybrid_fwd<(ONE_LAUNCH ? -1 : 0)>, NTHR, LDS_BYTES) != hipSuccess || per_cu < 1) fprintf(stderr, "kernel_launch: occupancy query reports %d workgroups per CU\n", per_cu);
        (void)hipGetLastError();
        grid = cus;
        if (grid != 256) fprintf(stderr, "kernel_launch: %d CUs; the residual GEMM phases assume 256 workgroups\n", grid);
    }
    if (grid < 0) return;
    if (hipMemsetAsync((char*)d_ws + WS_CTL, 0, CTL_ZERO_BYTES, stream) != hipSuccess) return;
    Args a{};
    for (int i = 0; i < 40; ++i) a.in[i] = (const float*)d_in[i];
    a.out = (float*)d_out; a.ws = (unsigned char*)d_ws;
    for (int j = 0; j < 32; ++j) a.inv_freq[j] = (float)pow(10000.0, -(double)j / 32.0);
#if ONE_LAUNCH
    a.g_lo = 0; a.g_hi = G_END;
    hipLaunchKernelGGL(hybrid_fwd<-1>, dim3(grid), dim3(NTHR), LDS_BYTES, stream, a);
#else
    for (int g = 0; g < G_END; ++g) {
        a.g_lo = g; a.g_hi = g + 1;
        int grp = 1;
        if (g >= 1 && g < G_FINAL) { const int k = (g - 1) % NPH; grp = (k == 0 || k == 4) ? 1 : (k == 5) ? 2 : (k == 6) ? 3 : 0; }
        if (grp == 0) hipLaunchKernelGGL(hybrid_fwd<0>, dim3(grid), dim3(NTHR), LDS_BYTES, stream, a);
        else if (grp == 1) hipLaunchKernelGGL(hybrid_fwd<1>, dim3(grid), dim3(NTHR), LDS_BYTES, stream, a);
        else if (grp == 2) hipLaunchKernelGGL(hybrid_fwd<2>, dim3(grid), dim3(NTHR), LDS_BYTES, stream, a);
        else hipLaunchKernelGGL(hybrid_fwd<3>, dim3(grid), dim3(NTHR), LDS_BYTES, stream, a);
    }
#endif
}
```

```cpp
#include <hip/hip_runtime.h>
#include <cstdio>
#include <cstdint>
#include <cmath>

namespace pg8 {
#define PG8_LAS __attribute__((address_space(3)))
typedef unsigned short bf16_t;
typedef short bf16x8 __attribute__((ext_vector_type(8)));
typedef float f32x4 __attribute__((ext_vector_type(4)));
typedef unsigned u32x4 __attribute__((ext_vector_type(4)));
constexpr int BM = 256, BK = 64, HALF = 128, HTB = HALF * BK * 2  , STAGE_BYTES = 8 * HTB, NXCD = 8, WGM = 8;

__host__ __device__ __forceinline__ int lds_byte(int r, int c) { const int st = (r >> 4) * 2 + (c >> 5), rr = r & 15, cc = c & 31, ob = rr * 64 + cc * 2; return st * 1024 + (ob ^ (((ob >> 9) & 1) << 5)); }
__host__ __device__ __forceinline__ void stage_rc(int b, int& R, int& C) { const int st = b / 1024, sb = b % 1024, swz = sb ^ (((sb >> 9) & 1) << 5); R = (st >> 1) * 16 + swz / 64; C = (st & 1) * 32 + (swz % 64) / 2; }
__host__ __device__ __forceinline__ int perm32(int rho) { const int n = rho >> 4, i = rho & 15; return 8 * (i >> 2) + 4 * n + (i & 3); }

struct Unit { int pm, pn, z; };
struct Gemm { const bf16_t* A; const bf16_t* Bt; int M, N, K, lda; };

struct StaticOrder {
    int nM, nN, nwg, G, c;
    __host__ __device__ void init(int M, int N, int G_, int c_) { nM = M / BM; nN = N / BM; nwg = nM * nN; G = G_; c = c_; }
    __host__ __device__ bool next(int i, Unit& u) const {
        const long L = (long)i * G + c; if (L >= nwg) return false;
        int wgid = (int)L; { const int q = nwg / NXCD, r = nwg % NXCD, xcd = wgid % NXCD, off = wgid / NXCD; wgid = (xcd < r ? xcd * (q + 1) : r * (q + 1) + (xcd - r) * q) + off; }
        const int nig = WGM * nN, gid = wgid / nig, fm = gid * WGM, gsz = (nM - fm) < WGM ? (nM - fm) : WGM;
        u.pm = fm + ((wgid % nig) % gsz); u.pn = (wgid % nig) / gsz; u.z = 0; return true;
    }
    __device__ __forceinline__ void a_ready(const Unit&) const {}
    __device__ __forceinline__ void done(const Unit&) const {}
    __device__ __forceinline__ size_t a_off(const Unit&) const { return 0; }
    __device__ __forceinline__ int b_tile(const Unit& u) const { return u.pn; }
};
struct GroupedOrder {
    StaticOrder base; int NZ, Kbytes, tiles_per_group;
    __device__ void init(int M, int N, int NZ_, int K, int G_, int c_) { base.init(M, N, G_, c_); NZ = NZ_; Kbytes = K * 2; tiles_per_group = N / BM; }
    __device__ bool next(int i, Unit& u) const { const int r = i / NZ, z = i - r * NZ; if (!base.next(r, u)) return false; u.z = z; return true; }
    __device__ __forceinline__ void a_ready(const Unit&) const {}
    __device__ __forceinline__ void done(const Unit&) const {}
    __device__ __forceinline__ size_t a_off(const Unit& u) const { return (size_t)u.z * Kbytes; }
    __device__ __forceinline__ int b_tile(const Unit& u) const { return u.z * tiles_per_group + u.pn; }
};

__device__ __forceinline__ unsigned cvt_pk_bf16(float lo, float hi) { unsigned r; asm volatile("v_cvt_pk_bf16_f32 %0, %1, %2" : "=v"(r) : "v"(lo), "v"(hi)); return r; }
__device__ __forceinline__ float bf_lo(unsigned w) { return __uint_as_float(w << 16); }
__device__ __forceinline__ float bf_hi(unsigned w) { return __uint_as_float(w & 0xffff0000u); }
__device__ __forceinline__ float fast_sigmoid(float x) { return __builtin_amdgcn_rcpf(1.0f + __builtin_amdgcn_exp2f(-1.4426950408889634f * x)); }

__device__ __forceinline__ float row_rstd(const float* ssq, int row, int M_) {
    const float s = (ssq[row] + ssq[M_ + row]) + (ssq[2 * M_ + row] + ssq[3 * M_ + row]);
    return 1.0f / sqrtf(s * (1.0f / 1024.0f) + 1e-6f);
}
struct EpiScaleBf16 {
    static constexpr bool PERM = true, AFTER_DRAIN = false;
    bf16_t* O; int ldc; const float* ssq; int M_;
    __device__ __forceinline__ void operator()(const f32x4 (&acc)[2][2][4][2], const Unit& u, int wr, int wc, int fr, int fq) const {
        const int row0 = u.pm * BM + wr * 64 + fr; const int col0 = u.pn * BM + wc * 32 + 8 * fq;
#pragma unroll
        for (int ai = 0; ai < 2; ++ai)
#pragma unroll
            for (int m = 0; m < 4; ++m) { const int row = row0 + ai * HALF + m * 16; const float rs = row_rstd(ssq, row, M_); bf16_t* rowp = O + (size_t)row * ldc + col0;
#pragma unroll
                for (int bj = 0; bj < 2; ++bj) { const f32x4 v0 = acc[ai][bj][m][0] * rs, v1 = acc[ai][bj][m][1] * rs;
                    u32x4 w; w.x = cvt_pk_bf16(v0[0], v0[1]); w.y = cvt_pk_bf16(v0[2], v0[3]); w.z = cvt_pk_bf16(v1[0], v1[1]); w.w = cvt_pk_bf16(v1[2], v1[3]);
                    *(u32x4*)(rowp + bj * HALF) = w; } }
    }
};
struct EpiSwiglu {
    static constexpr bool PERM = true, AFTER_DRAIN = false;
    bf16_t* O; int ldc; const float* ssq; int M_;
    __device__ __forceinline__ void operator()(const f32x4 (&acc)[2][2][4][2], const Unit& u, int wr, int wc, int fr, int fq) const {
        const int row0 = u.pm * BM + wr * 64 + fr; const int col0 = u.pn * HALF + wc * 32 + 8 * fq;
#pragma unroll
        for (int ai = 0; ai < 2; ++ai)
#pragma unroll
            for (int m = 0; m < 4; ++m) { const int row = row0 + ai * HALF + m * 16; const float rs = row_rstd(ssq, row, M_); bf16_t* rowp = O + (size_t)row * ldc + col0;
                float o[8];
#pragma unroll
                for (int n = 0; n < 2; ++n)
#pragma unroll
                    for (int i = 0; i < 4; ++i) { const float g = acc[ai][0][m][n][i] * rs, up = acc[ai][1][m][n][i] * rs; o[n * 4 + i] = g * fast_sigmoid(g) * up; }
                u32x4 w; w.x = cvt_pk_bf16(o[0], o[1]); w.y = cvt_pk_bf16(o[2], o[3]); w.z = cvt_pk_bf16(o[4], o[5]); w.w = cvt_pk_bf16(o[6], o[7]);
                *(u32x4*)rowp = w; }
    }
};
struct EpiGateAcc {
    static constexpr bool PERM = true, AFTER_DRAIN = false;
    bf16_t* O; const bf16_t* PG; const float* gb;
    __device__ __forceinline__ void operator()(const f32x4 (&acc)[2][2][4][2], const Unit& u, int wr, int wc, int fr, int fq) const {
        const int row0 = u.pm * BM + wr * 64 + fr; const int col0 = u.pn * BM + wc * 32 + 8 * fq; const int z = u.z;
        f32x4 gbv[2][2];
#pragma unroll
        for (int bj = 0; bj < 2; ++bj)
#pragma unroll
            for (int n = 0; n < 2; ++n) gbv[bj][n] = *(const f32x4*)(gb + z * 1024 + col0 + bj * HALF + 4 * n);
#pragma unroll
        for (int ai = 0; ai < 2; ++ai)
#pragma unroll
            for (int m = 0; m < 4; ++m) { const int row = row0 + ai * HALF + m * 16;
#pragma unroll
                for (int bj = 0; bj < 2; ++bj) {
                    const u32x4 pg = *(const u32x4*)(PG + (size_t)row * 4096 + z * 1024 + col0 + bj * HALF);
                    bf16_t* op = O + (size_t)row * 1024 + col0 + bj * HALF;
                    float o[8];
                    o[0] = fast_sigmoid(bf_lo(pg.x) + gbv[bj][0][0]) * acc[ai][bj][m][0][0]; o[1] = fast_sigmoid(bf_hi(pg.x) + gbv[bj][0][1]) * acc[ai][bj][m][0][1];
                    o[2] = fast_sigmoid(bf_lo(pg.y) + gbv[bj][0][2]) * acc[ai][bj][m][0][2]; o[3] = fast_sigmoid(bf_hi(pg.y) + gbv[bj][0][3]) * acc[ai][bj][m][0][3];
                    o[4] = fast_sigmoid(bf_lo(pg.z) + gbv[bj][1][0]) * acc[ai][bj][m][1][0]; o[5] = fast_sigmoid(bf_hi(pg.z) + gbv[bj][1][1]) * acc[ai][bj][m][1][1];
                    o[6] = fast_sigmoid(bf_lo(pg.w) + gbv[bj][1][2]) * acc[ai][bj][m][1][2]; o[7] = fast_sigmoid(bf_hi(pg.w) + gbv[bj][1][3]) * acc[ai][bj][m][1][3];
                    if (z > 0) { const u32x4 pv = *(const u32x4*)op;
                        o[0] += bf_lo(pv.x); o[1] += bf_hi(pv.x); o[2] += bf_lo(pv.y); o[3] += bf_hi(pv.y); o[4] += bf_lo(pv.z); o[5] += bf_hi(pv.z); o[6] += bf_lo(pv.w); o[7] += bf_hi(pv.w); }
                    u32x4 w; w.x = cvt_pk_bf16(o[0], o[1]); w.y = cvt_pk_bf16(o[2], o[3]); w.z = cvt_pk_bf16(o[4], o[5]); w.w = cvt_pk_bf16(o[6], o[7]);
                    *(u32x4*)op = w; } }
    }
};
struct EpiResid {
    static constexpr bool PERM = true, AFTER_DRAIN = true;
    float* H; bf16_t* HB; float* ssq; int M_; float s;
    __device__ __forceinline__ void fused(f32x4 (&acc)[2][2][4][2], const Unit& u, int wr, int wc, int fr, int fq, PG8_LAS unsigned char* lds, int wid, int lane) const {
        PG8_LAS float* P = (PG8_LAS float*)lds;
        const int row0 = u.pm * BM + wr * 64 + fr; const int col0 = u.pn * BM + wc * 32 + 8 * fq;
#pragma unroll
        for (int ai = 0; ai < 2; ++ai)
#pragma unroll
            for (int m = 0; m < 4; ++m) { const int row = row0 + ai * HALF + m * 16; float q = 0.f;
#pragma unroll
                for (int bj = 0; bj < 2; ++bj) { float* hp = H + (size_t)row * 1024 + col0 + bj * HALF;
                    const f32x4 h0 = *(const f32x4*)hp + acc[ai][bj][m][0] * s, h1 = *(const f32x4*)(hp + 4) + acc[ai][bj][m][1] * s;
                    *(f32x4*)hp = h0; *(f32x4*)(hp + 4) = h1;
                    q += (h0[0] * h0[0] + h0[1] * h0[1]) + (h0[2] * h0[2] + h0[3] * h0[3]) + (h1[0] * h1[0] + h1[1] * h1[1]) + (h1[2] * h1[2] + h1[3] * h1[3]);
                    u32x4 w; w.x = cvt_pk_bf16(h0[0], h0[1]); w.y = cvt_pk_bf16(h0[2], h0[3]); w.z = cvt_pk_bf16(h1[0], h1[1]); w.w = cvt_pk_bf16(h1[2], h1[3]);
                    *(u32x4*)(HB + (size_t)row * 1024 + col0 + bj * HALF) = w; }
                q += __shfl_xor(q, 16); q += __shfl_xor(q, 32);
                if (fq == 0) P[(ai * HALF + wr * 64 + m * 16 + fr) * 4 + wc] = q; }
        asm volatile("s_waitcnt lgkmcnt(0)" ::: "memory"); __builtin_amdgcn_s_barrier(); asm volatile("" ::: "memory");
        const int t = wid * 64 + lane;
        if (t < 256) { const float q = (P[t * 4 + 0] + P[t * 4 + 1]) + (P[t * 4 + 2] + P[t * 4 + 3]); ssq[(size_t)u.pn * M_ + u.pm * BM + t] = q; }
        asm volatile("s_waitcnt lgkmcnt(0)" ::: "memory"); __builtin_amdgcn_s_barrier(); asm volatile("" ::: "memory");
    }
};
template <class Epi, class Sched, bool ALIGN_EPI = false, bool SP2 = false>
__device__ __forceinline__ void gemm_phase(PG8_LAS unsigned char* lds, const Gemm g, const Sched& S, const Epi& E) {
    int tid_ = threadIdx.x; asm volatile("" : "+v"(tid_)); const int tid = tid_, wid = __builtin_amdgcn_readfirstlane(tid >> 6), lane = tid & 63, wr = wid >> 2, wc = wid & 3, fr = lane & 15, fq = lane >> 4;
    const int K = g.K, nt = K / BK;
    unsigned voffA[2], voffB[2];
#pragma unroll
    for (int i = 0; i < 2; ++i) { int R, C; stage_rc(tid * 16 + i * 8192, R, C); const int Rb = Epi::PERM ? ((R & ~31) + perm32(R & 31)) : R;
        voffA[i] = (unsigned)(R * g.lda + C) * 2u; voffB[i] = (unsigned)(Rb * K + C) * 2u; }
    const size_t kstep = (size_t)(BK * 2);
    const size_t hstep = (size_t)HALF * K * 2;
    const size_t tstep = 2 * hstep; const size_t hstepA = (size_t)HALF * g.lda * 2, tstepA = 2 * hstepA;
    const unsigned ldsw = (unsigned)wid * 1024u;
    const int aoff = lds_byte(wr * 64 + fr, fq * 8), boff = lds_byte(wc * 32 + fr, fq * 8);
#define PG8_SA(b, h) (((b) * 2 + (h)) * HTB)
#define PG8_SB(b, h) ((4 + (b) * 2 + (h)) * HTB)
#define PG8_STAGE(bufoff, gbase, voff) do { _Pragma("unroll") for (int _i = 0; _i < 2; ++_i) \
        __builtin_amdgcn_global_load_lds((const unsigned*)((const char*)(gbase) + (voff)[_i]), (PG8_LAS unsigned*)(lds + (bufoff) + ldsw + _i * 8192), 16, 0, 0); } while (0)
#define PG8_LDA(dst, b, h) do { _Pragma("unroll") for (int m = 0; m < 4; ++m) _Pragma("unroll") for (int k = 0; k < 2; ++k) dst[m][k] = *(const PG8_LAS bf16x8*)(lds + PG8_SA(b, h) + aoff + m * 2048 + k * 1024); } while (0)
#define PG8_LDB(dst, b, h) do { _Pragma("unroll") for (int n = 0; n < 2; ++n) _Pragma("unroll") for (int k = 0; k < 2; ++k) dst[n][k] = *(const PG8_LAS bf16x8*)(lds + PG8_SB(b, h) + boff + n * 2048 + k * 1024); } while (0)
#define PG8_MMA(ai, bj, At, Bt) do { __builtin_amdgcn_s_setprio(1); _Pragma("unroll") for (int m = 0; m < 4; ++m) _Pragma("unroll") for (int n = 0; n < 2; ++n) _Pragma("unroll") for (int k = 0; k < 2; ++k) \
        acc[ai][bj][m][n] = __builtin_amdgcn_mfma_f32_16x16x32_bf16(Bt[n][k], At[m][k], acc[ai][bj][m][n], 0, 0, 0); __builtin_amdgcn_s_setprio(0); } while (0)
#define PG8_WAIT_V(n) asm volatile("s_waitcnt vmcnt(" #n ")" ::: "memory")
#define PG8_WAIT_L(n) asm volatile("s_waitcnt lgkmcnt(" #n ")" ::: "memory")
#define PG8_BAR __builtin_amdgcn_s_barrier()
#define PG8_SCHED __builtin_amdgcn_sched_barrier(0)
    Unit cur, nxt; int ui = 0;
    if (!S.next(0, cur)) return;
    f32x4 acc[2][2][4][2];
#pragma unroll
    for (int a = 0; a < 2; ++a)
#pragma unroll
        for (int b = 0; b < 2; ++b)
#pragma unroll
            for (int m = 0; m < 4; ++m)
#pragma unroll
                for (int n = 0; n < 2; ++n) acc[a][b][m][n] = (f32x4){0.f, 0.f, 0.f, 0.f};
    bf16x8 At[4][2], B0[2][2], B1[2][2];
    const char* cA = (const char*)g.A + (size_t)cur.pm * tstepA + S.a_off(cur); const char* cB = (const char*)g.Bt + (size_t)S.b_tile(cur) * tstep;
    S.a_ready(cur);
    if constexpr (SP2) {
        PG8_STAGE(PG8_SB(0, 0), cB, voffB); PG8_STAGE(PG8_SB(0, 1), cB + hstep, voffB); PG8_STAGE(PG8_SA(0, 0), cA, voffA); PG8_STAGE(PG8_SA(0, 1), cA + hstepA, voffA);
        if (wr == 1) PG8_BAR;
        PG8_WAIT_V(2); PG8_BAR;
        PG8_STAGE(PG8_SB(1, 0), cB + kstep, voffB); PG8_STAGE(PG8_SA(1, 0), cA + kstep, voffA); PG8_STAGE(PG8_SB(1, 1), cB + hstep + kstep, voffB);
        PG8_WAIT_V(6); PG8_BAR;
    } else {
        PG8_STAGE(PG8_SB(0, 0), cB, voffB); PG8_STAGE(PG8_SA(0, 0), cA, voffA); PG8_STAGE(PG8_SB(0, 1), cB + hstep, voffB); PG8_STAGE(PG8_SA(0, 1), cA + hstepA, voffA);
        if (wr == 1) PG8_BAR;
        PG8_WAIT_V(4); PG8_BAR;
        PG8_STAGE(PG8_SB(1, 0), cB + kstep, voffB); PG8_STAGE(PG8_SA(1, 0), cA + kstep, voffA); PG8_STAGE(PG8_SB(1, 1), cB + hstep + kstep, voffB);
        PG8_WAIT_V(6); PG8_BAR;
    }
    for (;;) {
        const bool has_next = S.next(ui + 1, nxt);
        const char* nA = has_next ? (const char*)g.A + (size_t)nxt.pm * tstepA + S.a_off(nxt) : cA; const char* nB = has_next ? (const char*)g.Bt + (size_t)S.b_tile(nxt) * tstep : cB;
        for (int t = 0; t < nt; t += 2) {
            const bool last = (t == nt - 2);
            const char* a1 = cA + (size_t)(t + 1) * kstep;
            const char* a2 = last ? nA : cA + (size_t)(t + 2) * kstep; const char* b2 = last ? nB : cB + (size_t)(t + 2) * kstep;
            const char* a3 = a2 + kstep; const char* b3 = b2 + kstep;
            if (last && has_next) S.a_ready(nxt);
            if constexpr (SP2) {
            PG8_LDB(B0, 0, 0); PG8_LDB(B1, 0, 1); PG8_SCHED; PG8_LDA(At, 0, 0); PG8_STAGE(PG8_SA(1, 1), a1 + hstepA, voffA);
            PG8_WAIT_V(8); PG8_WAIT_L(0); PG8_BAR; PG8_MMA(0, 0, At, B0); PG8_MMA(0, 1, At, B1); PG8_BAR; PG8_SCHED;
            PG8_LDA(At, 0, 1); PG8_STAGE(PG8_SB(0, 0), b2, voffB); PG8_STAGE(PG8_SB(0, 1), b2 + hstep, voffB); PG8_STAGE(PG8_SA(0, 0), a2, voffA);
            PG8_WAIT_V(8); PG8_WAIT_L(0); PG8_BAR; PG8_MMA(1, 0, At, B0); PG8_MMA(1, 1, At, B1); PG8_BAR; PG8_SCHED;
            PG8_LDB(B0, 1, 0); PG8_LDB(B1, 1, 1); PG8_SCHED; PG8_LDA(At, 1, 0); PG8_STAGE(PG8_SA(0, 1), a2 + hstepA, voffA);
            PG8_WAIT_V(8); PG8_WAIT_L(0); PG8_BAR; PG8_MMA(0, 0, At, B0); PG8_MMA(0, 1, At, B1); PG8_BAR; PG8_SCHED;
            PG8_LDA(At, 1, 1); PG8_STAGE(PG8_SB(1, 0), b3, voffB); PG8_STAGE(PG8_SB(1, 1), b3 + hstep, voffB); PG8_STAGE(PG8_SA(1, 0), a3, voffA);
            PG8_WAIT_V(8); PG8_WAIT_L(0); PG8_BAR; PG8_MMA(1, 0, At, B0); PG8_MMA(1, 1, At, B1); PG8_BAR; PG8_SCHED;
            } else {
            PG8_LDB(B0, 0, 0); PG8_SCHED; PG8_LDA(At, 0, 0); PG8_STAGE(PG8_SA(1, 1), a1 + hstepA, voffA);
            PG8_WAIT_L(8); PG8_BAR; PG8_WAIT_L(0); PG8_MMA(0, 0, At, B0); PG8_BAR; PG8_SCHED;
            PG8_LDB(B1, 0, 1); PG8_STAGE(PG8_SB(0, 0), b2, voffB);
            PG8_BAR; PG8_WAIT_L(0); PG8_MMA(0, 1, At, B1); PG8_BAR;
            PG8_LDA(At, 0, 1); PG8_STAGE(PG8_SA(0, 0), a2, voffA);
            PG8_BAR; PG8_WAIT_L(0); PG8_MMA(1, 0, At, B0); PG8_BAR; PG8_SCHED;
            PG8_STAGE(PG8_SB(0, 1), b2 + hstep, voffB);
            PG8_WAIT_V(6); PG8_BAR; PG8_MMA(1, 1, At, B1); PG8_BAR;
            PG8_LDB(B0, 1, 0); PG8_SCHED; PG8_LDA(At, 1, 0); PG8_STAGE(PG8_SA(0, 1), a2 + hstepA, voffA);
            PG8_WAIT_L(8); PG8_BAR; PG8_WAIT_L(0); PG8_MMA(0, 0, At, B0); PG8_BAR; PG8_SCHED;
            PG8_LDB(B1, 1, 1); PG8_STAGE(PG8_SB(1, 0), b3, voffB);
            PG8_BAR; PG8_WAIT_L(0); PG8_MMA(0, 1, At, B1); PG8_BAR;
            PG8_LDA(At, 1, 1); PG8_STAGE(PG8_SA(1, 0), a3, voffA);
            PG8_BAR; PG8_WAIT_L(0); PG8_MMA(1, 0, At, B0); PG8_BAR; PG8_SCHED;
            PG8_STAGE(PG8_SB(1, 1), b3 + hstep, voffB);
            PG8_WAIT_V(6); PG8_BAR; PG8_MMA(1, 1, At, B1); PG8_BAR;
            }
        }
        if constexpr (ALIGN_EPI) { if (wr == 0) PG8_BAR; }
        if constexpr (!Epi::AFTER_DRAIN) { E(acc, cur, wr, wc, fr, fq); S.done(cur); }
        if (!has_next) break;
#pragma unroll
        for (int a = 0; a < 2; ++a)
#pragma unroll
            for (int b = 0; b < 2; ++b)
#pragma unroll
                for (int m = 0; m < 4; ++m)
#pragma unroll
                    for (int n = 0; n < 2; ++n) acc[a][b][m][n] = (f32x4){0.f, 0.f, 0.f, 0.f};
        cur = nxt; cA = nA; cB = nB; ++ui;
        if constexpr (ALIGN_EPI) { if (wr == 1) PG8_BAR; }
    }
    PG8_WAIT_V(0);
    if constexpr (!ALIGN_EPI) { if (wr == 0) PG8_BAR; }
    PG8_BAR;
    if constexpr (Epi::AFTER_DRAIN) { E.fused(acc, cur, wr, wc, fr, fq, lds, wid, lane); S.done(cur); }
#undef PG8_SA
#undef PG8_SB
#undef PG8_STAGE
#undef PG8_LDA
#undef PG8_LDB
#undef PG8_MMA
#undef PG8_WAIT_V
#undef PG8_WAIT_L
#undef PG8_BAR
#undef PG8_SCHED
}
}

constexpr int NWAVES = 8, NTHR = 512;
constexpr int M = 16384, SEQ = 8192, D = 1024, FF = 2816, NL = 4, NCH = 128  , NBC = 256  ;
constexpr int NPM = 6656;
constexpr int NWIN = 10752;
constexpr int C_DAQ = 0, C_DAK = 512, C_DAV = 1024, C_GQ = 1536, C_GK = 1792, C_GV = 2048, C_GOG = 2560, C_SZ = 3072, C_SX = 3584, C_SB = 4096, C_SC = 4352,
              C_RR = 4608, C_RK = 5120, C_RV = 5632, C_RWL = 6144, C_RAL = 6208, C_RGL = 6272, C_GLR = 6400, C_SDT = 6416;
constexpr float EPS = 1e-6f, LOG2E = 1.4426950408889634f;

constexpr size_t MiB = 1u << 20;
constexpr size_t WS_CTL = 0, CTL_ZERO_BYTES = 1 * MiB;
constexpr size_t WS_COS = 1 * MiB, WS_SIN = 2 * MiB, WS_SSQ = 3 * MiB, WS_GLAST = 3 * MiB + 512 * 1024, WS_SDT = 4 * MiB, WS_SACUM = 4 * MiB + 512 * 1024, WS_SCDEC = 5 * MiB;
constexpr size_t WS_WGU1 = 8 * MiB, WS_WD1 = 19 * MiB, WS_WIN = 24 * MiB + 512 * 1024, WS_WB = 45 * MiB + 512 * 1024, WS_WO = 49 * MiB + 512 * 1024, WS_WGU2 = 51 * MiB + 512 * 1024, WS_WD2 = 62 * MiB + 512 * 1024;
constexpr size_t WS_HB = 68 * MiB, WS_P = 100 * MiB, WS_PG = 100 * MiB, WS_YS = 308 * MiB, WS_R1 = 372 * MiB, WS_R2 = 500 * MiB, WS_END = 644 * MiB;
constexpr size_t WS_ACT = WS_R1, WS_MERGED = WS_R1;
constexpr size_t WS_RWW = WS_R1, WS_RWR = WS_R1 + 32 * MiB, WS_RWK = WS_R1 + 48 * MiB, WS_RWV = WS_R1 + 64 * MiB, WS_RWKK = WS_R1 + 80 * MiB, WS_RWB = WS_R1 + 96 * MiB, WS_RWG = WS_R1 + 112 * MiB;
constexpr size_t WS_VT = WS_R2, WS_GKV = WS_R2 + 16 * MiB, WS_SST = WS_R2 + 48 * MiB, WS_RWY = WS_R2 + 112 * MiB;
static_assert(WS_WD2 + (size_t)D * FF * 2 <= WS_HB && WS_P + (size_t)M * NPM * 2 <= WS_YS && WS_RWY + (size_t)M * 512 * 2 <= WS_END, "d_ws map");
constexpr int CW_BAR = 4096;

constexpr int RING_BYTES = 131072, LDSCTL_OFF = RING_BYTES, MISC_OFF = LDSCTL_OFF + 320, LDS_BYTES = 147456;

#define GAS __attribute__((address_space(1)))
#define LAS __attribute__((address_space(3)))
typedef unsigned short bf16;
typedef unsigned v4u __attribute__((ext_vector_type(4)));
typedef float f32x4 __attribute__((ext_vector_type(4)));
typedef short bf16x8 __attribute__((ext_vector_type(8)));
typedef GAS unsigned gu32;
typedef GAS unsigned long long gu64;
#define RLX_AGENT __ATOMIC_RELAXED, __HIP_MEMORY_SCOPE_AGENT
#define LDS_WAIT() asm volatile("s_waitcnt lgkmcnt(0)" ::: "memory")
#define VM_WAIT() asm volatile("s_waitcnt vmcnt(0)" ::: "memory")
__device__ __forceinline__ unsigned long long rt() { return __builtin_amdgcn_s_memrealtime(); }
__device__ __forceinline__ unsigned f2bf(float f) { unsigned u = __builtin_bit_cast(unsigned, f); return (u + 0x7fffu + ((u >> 16) & 1u)) >> 16; }
__device__ __forceinline__ unsigned pk2(float lo, float hi) { return f2bf(lo) | (f2bf(hi) << 16); }

#define XB_TMO      128
#define XB_XCNT(j)  (256  + 64 * (j))
#define XB_XSUB(j)  (1280 + 64 * (j))
#define XB_XGEN(j)  (2304 + 64 * (j))
#define XB_TOP      3328
#define XB_TOPGEN   3392
#define XCD_BAR_WORDS 3456
#define XB_SPIN_CAP (1u << 18)

__device__ __forceinline__ unsigned xb_ld(unsigned* p)              { return __hip_atomic_load(p, __ATOMIC_RELAXED, __HIP_MEMORY_SCOPE_AGENT); }
__device__ __forceinline__ unsigned xb_add(unsigned* p, unsigned v) { return __hip_atomic_fetch_add(p, v, __ATOMIC_RELAXED, __HIP_MEMORY_SCOPE_AGENT); }
__device__ __forceinline__ unsigned xb_xcc_id() { return (unsigned)__builtin_amdgcn_s_getreg((3 << 11) | 20) & 0xFu; }
#define XB_SPIN(cond, bar) do { unsigned _sp = 0; while (cond) { __builtin_amdgcn_s_sleep(1); \
    if ((++_sp & 255u) == 0u) { if (xb_ld(&(bar)[XB_TMO])) break; if (_sp > XB_SPIN_CAP) { atomicAdd(&(bar)[XB_TMO], 1u); break; } } } } while (0)

struct XcdBarrier {
    unsigned* bar; unsigned x;
    volatile LAS unsigned* st;
};

__device__ __forceinline__ XcdBarrier xcd_barrier_post(unsigned* bar, volatile LAS unsigned* st) {
    XcdBarrier b; b.bar = bar; b.x = xb_xcc_id(); b.st = st;
    if (threadIdx.x == 0) (void)xb_add(&bar[XB_XCNT(b.x)], 1u);
    return b;
}
__device__ __forceinline__ void xcd_barrier_complete(unsigned* bar, unsigned x, unsigned& nloc, unsigned& nx) {
    const unsigned G = gridDim.x * gridDim.y * gridDim.z;
    unsigned sum, cnt, mine, sp = 0u;
    for (;;) {
        sum = 0u; cnt = 0u; mine = 0u;
#pragma unroll
        for (unsigned j = 0; j < 16; ++j) { const unsigned c = xb_ld(&bar[XB_XCNT(j)]); sum += c; cnt += (c > 0u) ? 1u : 0u; mine = (j == x) ? c : mine; }
        if (sum == G) break;
        __builtin_amdgcn_s_sleep(1);
        if ((++sp & 255u) == 0u) { if (xb_ld(&bar[XB_TMO])) break; if (sp > XB_SPIN_CAP) { atomicAdd(&bar[XB_TMO], 1u); break; } }
    }
    nloc = mine > 0u ? mine : 1u; nx = cnt > 0u ? cnt : 1u;
}

__device__ __forceinline__ void xcd_barrier(const XcdBarrier& b) {
    asm volatile("s_waitcnt vmcnt(0)" ::: "memory");
    __syncthreads();
    if (threadIdx.x == 0) {
        unsigned* bar = b.bar;
        __builtin_amdgcn_s_waitcnt(0);
        unsigned nloc = b.st[0], nx = b.st[1];
        if (nloc == 0u) { xcd_barrier_complete(bar, b.x, nloc, nx); b.st[0] = nloc; b.st[1] = nx; }
        const unsigned old = xb_add(&bar[XB_XSUB(b.x)], 1u);
        const unsigned gen = old / nloc;
        if (old + 1u == (gen + 1u) * nloc) {
            __builtin_amdgcn_fence(__ATOMIC_RELEASE, "agent");
            asm volatile("s_waitcnt vmcnt(0)" ::: "memory");
            const unsigned og = xb_add(&bar[XB_TOP], 1u);
            const unsigned tg = og / nx;
            if (og + 1u == (tg + 1u) * nx) xb_add(&bar[XB_TOPGEN], 1u);
            else XB_SPIN(xb_ld(&bar[XB_TOPGEN]) == tg, bar);
            __builtin_amdgcn_fence(__ATOMIC_ACQUIRE, "agent");
            xb_add(&bar[XB_XGEN(b.x)], 1u);
            asm volatile("s_waitcnt vmcnt(0)" ::: "memory");
        } else {
            XB_SPIN(xb_ld(&bar[XB_XGEN(b.x)]) == gen, bar);
            __builtin_amdgcn_fence(__ATOMIC_ACQUIRE, "agent");
            asm volatile("s_waitcnt vmcnt(0)" ::: "memory");
        }
    }
    __syncthreads();
}

struct Args { const float* in[40]; float* out; unsigned char* ws; float inv_freq[32]; int g_lo, g_hi; };
typedef const __attribute__((address_space(4))) Args* ArgsP;
typedef LAS float* LF; typedef const LAS float* CLF;
#ifndef PH_FN
#define PH_FN __device__ __noinline__
#endif
#ifndef PH_HEAVY
#define PH_HEAVY __device__ __forceinline__
#endif
struct Ctx {
    LAS unsigned char* lds;
    unsigned char* ws; float* h;
    int tid, lane, wave, bid, G;
};
typedef unsigned u32x4 __attribute__((ext_vector_type(4)));
typedef unsigned u32x2 __attribute__((ext_vector_type(2)));
typedef float f32x2 __attribute__((ext_vector_type(2)));
typedef float f32x16 __attribute__((ext_vector_type(16)));
__device__ __forceinline__ float bf2f(bf16 x) { return __uint_as_float((unsigned)x << 16); }
__device__ __forceinline__ float bflo(unsigned w) { return __uint_as_float(w << 16); }
__device__ __forceinline__ float bfhi(unsigned w) { return __uint_as_float(w & 0xffff0000u); }
__device__ __forceinline__ void unpack8(const u32x4 w, float* o) { o[0] = bflo(w.x); o[1] = bfhi(w.x); o[2] = bflo(w.y); o[3] = bfhi(w.y); o[4] = bflo(w.z); o[5] = bfhi(w.z); o[6] = bflo(w.w); o[7] = bfhi(w.w); }
__device__ __forceinline__ u32x4 pack8(const float* o) { u32x4 w; w.x = pk2(o[0], o[1]); w.y = pk2(o[2], o[3]); w.z = pk2(o[4], o[5]); w.w = pk2(o[6], o[7]); return w; }
__device__ __forceinline__ float sigmoidf_(float x) { return 1.0f / (1.0f + __expf(-x)); }
__device__ __forceinline__ float siluf_(float x) { return x * sigmoidf_(x); }
__device__ __forceinline__ float softplusf_(float x) { return fmaxf(x, 0.f) + log1pf(__expf(-fabsf(x))); }
__device__ __forceinline__ float logsigmoidf_(float x) { return fminf(x, 0.f) - log1pf(__expf(-fabsf(x))); }
__device__ __forceinline__ float wave_sum(float v) {
#pragma unroll
    for (int o = 1; o < 64; o <<= 1) v += __shfl_xor(v, o);
    return v;
}
#define WG_SYNC() __syncthreads()
__device__ __forceinline__ Ctx fresh(const Ctx& C0) { Ctx C = C0; int t = threadIdx.x; asm volatile("" : "+v"(t)); C.tid = t; C.lane = t & 63; C.wave = __builtin_amdgcn_readfirstlane(t >> 6); return C; }

PH_FN void ph_prologue(const Ctx C, ArgsP a) {
    float* cosT = (float*)(C.ws + WS_COS); float* sinT = (float*)(C.ws + WS_SIN);
    for (int idx = C.bid * NTHR + C.tid; idx < SEQ * 32; idx += C.G * NTHR) {
        const int t = idx >> 5, j = idx & 31;
        const float ang = (float)t * a->inv_freq[j];
        const double rev = (double)ang * 0.15915494309189535;
        const float fr = (float)(rev - floor(rev));
        cosT[idx] = __builtin_amdgcn_cosf(fr); sinT[idx] = __builtin_amdgcn_sinf(fr);
    }
    const float* x = a->in[0]; bf16* hb = (bf16*)(C.ws + WS_HB); float* ssq = (float*)(C.ws + WS_SSQ);
    const int gw = C.bid * NWAVES + C.wave, NGW = C.G * NWAVES;
    for (int m = gw; m < M; m += NGW) {
        const f32x4* xr = (const f32x4*)(x + (size_t)m * D) + C.lane; f32x4* hr = (f32x4*)(C.h + (size_t)m * D) + C.lane;
        unsigned long long* o8 = (unsigned long long*)(hb + (size_t)m * D) + C.lane;
        float s = 0.f;
#pragma unroll
        for (int j = 0; j < 4; ++j) { const f32x4 v = xr[64 * j]; hr[64 * j] = v; s += (v.x * v.x + v.y * v.y) + (v.z * v.z + v.w * v.w);
            o8[64 * j] = (unsigned long long)pk2(v.x, v.y) | ((unsigned long long)pk2(v.z, v.w) << 32); }
        s = wave_sum(s);
        if (C.lane == 0) { ssq[m] = s; ssq[M + m] = 0.f; ssq[2 * M + m] = 0.f; ssq[3 * M + m] = 0.f; }
    }
}

template <class SrcF>
__device__ __forceinline__ void tr_item(const SrcF src, const float* gk, bf16* WT, int K, int kb, int nb, LF scr, int lane) {
    const int k0 = 64 * kb, n0 = 32 * nb;
    const int ld = src.ld(); const long co = src.col(n0 + (lane & 31)); const bool ok = co >= 0; const float* colp = src.base(n0 + (lane & 31)) + (ok ? co : 0);
#pragma unroll 8
    for (int i = 0; i < 32; ++i) { const int kk = 2 * i + (lane >> 5); float v = 0.f; if (ok) { v = colp[(size_t)(k0 + kk) * ld]; if (gk) v *= gk[k0 + kk]; } scr[kk * 33 + (lane & 31)] = v; }
    LDS_WAIT(); asm volatile("" ::: "memory");
    const int c = lane & 7;
#pragma unroll
    for (int j = 0; j < 4; ++j) { const int n = (lane >> 3) + 8 * j; CLF s = scr + (8 * c) * 33 + n;
        v4u o; o.x = pk2(s[0 * 33], s[1 * 33]); o.y = pk2(s[2 * 33], s[3 * 33]); o.z = pk2(s[4 * 33], s[5 * 33]); o.w = pk2(s[6 * 33], s[7 * 33]);
        *(v4u*)(WT + (size_t)(n0 + n) * K + k0 + 8 * c) = o; }
    LDS_WAIT(); asm volatile("" ::: "memory");
}
struct SrcGU { const float* wg; const float* wu;
    __device__ __forceinline__ int ld() const { return FF; }
    __device__ __forceinline__ const float* base(int n) const { const uintptr_t sel = (uintptr_t)((n >> 7) & 1); return (const float*)((uintptr_t)wg + sel * ((uintptr_t)wu - (uintptr_t)wg)); }
    __device__ __forceinline__ long col(int n) const { return 128 * (n >> 8) + (n & 127); } };
struct SrcPlain { const float* w; int ldw;
    __device__ __forceinline__ int ld() const { return ldw; }
    __device__ __forceinline__ const float* base(int) const { return w; }
    __device__ __forceinline__ long col(int n) const { return n; } };
struct SrcWin { const float* w;
    __device__ __forceinline__ int ld() const { return 10520; }
    __device__ __forceinline__ const float* base(int) const { return w; }
    __device__ __forceinline__ long col(int n) const {
        int c;
        if (n < 3072) c = n; else if (n < 4608) c = n - 3072 + 3088; else if (n < 6400) c = n - 4608 + 4632; else if (n < 6416) c = n - 6400 + 3072; else if (n < 6424) c = n - 6416 + 4624; else if (n < 6656) c = -1; else c = n - 6656 + 6424;
        return c; } };
PH_FN void ph_weights(const Ctx C, ArgsP a, int l) {
    LF scr = (LF)(C.lds + C.wave * 16384);
    const int gw = C.bid * NWAVES + C.wave, NGW = C.G * NWAVES;
#pragma unroll 1
    for (int f = 0; f < 2; ++f) {
        const float* nrm = a->in[f ? 35 : 1] + (size_t)l * D; const float* wg = a->in[f ? 36 : 2] + (size_t)l * D * FF; const float* wu = a->in[f ? 37 : 3] + (size_t)l * D * FF; const float* wd = a->in[f ? 38 : 4] + (size_t)l * FF * D;
        bf16* Wgu = (bf16*)(C.ws + (f ? WS_WGU2 : WS_WGU1)); bf16* Wd = (bf16*)(C.ws + (f ? WS_WD2 : WS_WD1));
        const SrcGU sgu{wg, wu};
        for (int it = gw; it < (D / 64) * (2 * FF / 32); it += NGW) tr_item(sgu, nrm, Wgu, D, it / (2 * FF / 32), it % (2 * FF / 32), scr, C.lane);
        const SrcPlain sd{wd, D};
        for (int it = gw; it < (FF / 64) * (D / 32); it += NGW) tr_item(sd, nullptr, Wd, FF, it / (D / 32), it % (D / 32), scr, C.lane);
    }
    { const SrcWin sw{a->in[6] + (size_t)l * D * 10520}; const float* nrm = a->in[5] + (size_t)l * D; bf16* Win = (bf16*)(C.ws + WS_WIN);
      for (int it = gw; it < (D / 64) * (NWIN / 32); it += NGW) tr_item(sw, nrm, Win, D, it / (NWIN / 32), it % (NWIN / 32), scr, C.lane); }
    { bf16* Wb = (bf16*)(C.ws + WS_WB);
      for (int it = gw; it < 4 * (512 / 64) * (D / 32); it += NGW) { const int z = it / ((512 / 64) * (D / 32)), r = it % ((512 / 64) * (D / 32));
          const SrcPlain sb{a->in[32] + ((size_t)l * 4 + z) * 512 * D, D}; tr_item(sb, nullptr, Wb + (size_t)z * D * 512, 512, r / (D / 32), r % (D / 32), scr, C.lane); } }
    { const SrcPlain so{a->in[34] + (size_t)l * D * D, D}; bf16* Wo = (bf16*)(C.ws + WS_WO);
      for (int it = gw; it < (D / 64) * (D / 32); it += NGW) tr_item(so, nullptr, Wo, D, it / (D / 32), it % (D / 32), scr, C.lane); }
}

PH_FN void ph_da_prep(const Ctx C) {
    bf16* P = (bf16*)(C.ws + WS_P); const float* cosT = (const float*)(C.ws + WS_COS); const float* sinT = (const float*)(C.ws + WS_SIN);
    const int gw = C.bid * NWAVES + C.wave, NGW = C.G * NWAVES;
    const int hc = C.lane >> 2, ch = C.lane & 3;
    const float sc = (hc < 8) ? 0.125f * LOG2E : 1.0f;
    for (int m = gw; m < M; m += NGW) {
        const int t = m & (SEQ - 1);
        bf16* p1 = P + (size_t)m * NPM + hc * 64 + ch * 8; bf16* p2 = p1 + 32;
        float x1[8], x2[8], o1[8], o2[8];
        unpack8(*(const u32x4*)p1, x1); unpack8(*(const u32x4*)p2, x2);
        const float* cp = cosT + t * 32 + ch * 8; const float* sp = sinT + t * 32 + ch * 8;
#pragma unroll
        for (int i = 0; i < 8; ++i) { const float c = cp[i], s = sp[i]; o1[i] = (x1[i] * c - x2[i] * s) * sc; o2[i] = (x2[i] * c + x1[i] * s) * sc; }
        *(u32x4*)p1 = pack8(o1); *(u32x4*)p2 = pack8(o2);
    }
    bf16* VT = (bf16*)(C.ws + WS_VT); LAS bf16* tile = (LAS bf16*)C.lds;
    for (int it = C.bid; it < 2 * NCH * 4; it += C.G) {
        const int h = it & 3, bc = it >> 2, b = bc >> 7, tb = bc & 127; const size_t row0 = (size_t)bc * 64;
        WG_SYNC();
#pragma unroll
        for (int i = 0; i < 2; ++i) { const int q = C.tid + NTHR * i, t = q >> 4, c16 = q & 15;
            *(LAS u32x4*)(tile + t * 136 + c16 * 8) = *(const u32x4*)(P + (row0 + t) * NPM + C_DAV + h * 128 + c16 * 8); }
        WG_SYNC();
#pragma unroll
        for (int i = 0; i < 2; ++i) { const int q = C.tid + NTHR * i, d = q >> 3, tc = q & 7; unsigned w[4];
#pragma unroll
            for (int e = 0; e < 4; ++e) w[e] = (unsigned)tile[(8 * tc + 2 * e) * 136 + d] | ((unsigned)tile[(8 * tc + 2 * e + 1) * 136 + d] << 16);
            u32x4 o; o.x = w[0]; o.y = w[1]; o.z = w[2]; o.w = w[3];
            *(u32x4*)(VT + ((size_t)(b * 4 + h) * 128 + d) * SEQ + tb * 64 + 8 * tc) = o; }
    }
    WG_SYNC();
}

__device__ __forceinline__ void gla_compute_G(const Ctx& C, ArgsP a, int l, int bc, int h, LF Gs) {
    const bf16* P = (const bf16*)(C.ws + WS_P); const float* W2 = a->in[12] + (size_t)l * 16 * 256; const float* gb = a->in[13] + (size_t)l * 256;
    const int t = C.tid >> 3, kg = C.tid & 7; const size_t row = (size_t)bc * 64 + t;
    float glr[16]; unpack8(*(const u32x4*)(P + row * NPM + C_GLR), glr); unpack8(*(const u32x4*)(P + row * NPM + C_GLR + 8), glr + 8);
#pragma unroll
    for (int i = 0; i < 8; ++i) { const int k = h * 64 + kg * 8 + i; float x = gb[k];
#pragma unroll
        for (int r = 0; r < 16; ++r) x += glr[r] * W2[r * 256 + k];
        Gs[t * 68 + kg * 8 + i] = logsigmoidf_(x) * (1.0f / 16.0f); }
    WG_SYNC();
    if (C.tid < 64) { float run = 0.f; for (int tt = 0; tt < 64; ++tt) { run += Gs[tt * 68 + C.tid]; Gs[tt * 68 + C.tid] = run; } }
    WG_SYNC();
}
PH_FN void ph_gla_a(const Ctx C, ArgsP a, int l) {
    const bf16* P = (const bf16*)(C.ws + WS_P); float* GKV = (float*)(C.ws + WS_GKV); float* GL = (float*)(C.ws + WS_GLAST);
    LF Gs = (LF)C.lds; LF KD = Gs + 64 * 68; LF Vs = KD + 64 * 68;
    for (int it = C.bid; it < NBC * 4; it += C.G) {
        const int bc = it >> 2, h = it & 3;
        WG_SYNC();
        gla_compute_G(C, a, l, bc, h, Gs);
        { const int t = C.tid >> 3, g8 = C.tid & 7; const size_t row = (size_t)bc * 64 + t;
          float kf[8]; unpack8(*(const u32x4*)(P + row * NPM + C_GK + h * 64 + g8 * 8), kf);
#pragma unroll
          for (int i = 0; i < 8; ++i) { const int k = g8 * 8 + i; KD[t * 68 + k] = kf[i] * __expf(Gs[63 * 68 + k] - Gs[t * 68 + k]); }
          float vf[16]; unpack8(*(const u32x4*)(P + row * NPM + C_GV + h * 128 + g8 * 16), vf); unpack8(*(const u32x4*)(P + row * NPM + C_GV + h * 128 + g8 * 16 + 8), vf + 8);
#pragma unroll
          for (int i = 0; i < 16; ++i) Vs[t * 132 + g8 * 16 + i] = vf[i];
          if (C.tid < 64) GL[(size_t)it * 64 + C.tid] = Gs[63 * 68 + C.tid]; }
        WG_SYNC();
        { const int kb = C.tid >> 5, vb = C.tid & 31; float acc[4][4];
#pragma unroll
          for (int x = 0; x < 4; ++x)
#pragma unroll
              for (int y = 0; y < 4; ++y) acc[x][y] = 0.f;
#pragma unroll 2
          for (int j = 0; j < 64; ++j) { const f32x4 av = *(const LAS f32x4*)(KD + j * 68 + 4 * kb), bv = *(const LAS f32x4*)(Vs + j * 132 + 4 * vb);
#pragma unroll
              for (int x = 0; x < 4; ++x)
#pragma unroll
                  for (int y = 0; y < 4; ++y) acc[x][y] += av[x] * bv[y]; }
#pragma unroll
          for (int x = 0; x < 4; ++x) *(f32x4*)(GKV + ((size_t)it * 64 + 4 * kb + x) * 128 + 4 * vb) = (f32x4){acc[x][0], acc[x][1], acc[x][2], acc[x][3]}; }
    }
    WG_SYNC();
}
PH_FN void gla_scan_part(const Ctx C, int part) {
    float* GKV = (float*)(C.ws + WS_GKV); const float* GL = (const float*)(C.ws + WS_GLAST);
    const int e = part * NTHR + C.tid, chain = e >> 13, idx = e & 8191, b = chain >> 2, h = chain & 3, k = idx >> 7;
    float st = 0.f;
#pragma unroll 4
    for (int c = 0; c < NCH; ++c) { const size_t item = (size_t)(b * NCH + c) * 4 + h; float* p = GKV + item * 8192 + idx; const float tmp = *p; const float dec = __expf(GL[item * 64 + k]); *p = st; st = dec * st + tmp; }
}
PH_HEAVY void ph_gla_c(const Ctx C, ArgsP a, int l) {
    const bf16* P = (const bf16*)(C.ws + WS_P); const float* GKV = (const float*)(C.ws + WS_GKV); bf16* YS = (bf16*)(C.ws + WS_YS);
    const float* gnorm = a->in[14] + (size_t)l * 128;
    LF Gs = (LF)C.lds; LF X = Gs + 64 * 68; LF Y = X + 64 * 68; LF Z = Y + 64 * 68;
    for (int it = C.bid; it < NBC * 4; it += C.G) {
        const int bc = it >> 2, h = it & 3;
        WG_SYNC();
        gla_compute_G(C, a, l, bc, h, Gs);
        const int t = C.tid >> 3, g8 = C.tid & 7; const size_t row = (size_t)bc * 64 + t;
        float qf[8]; unpack8(*(const u32x4*)(P + row * NPM + C_GQ + h * 64 + g8 * 8), qf);
#pragma unroll
        for (int i = 0; i < 8; ++i) { const int k = g8 * 8 + i; X[t * 68 + k] = qf[i] * 0.125f * __expf(Gs[t * 68 + k]); }
#pragma unroll
        for (int i = 0; i < 4; ++i) { const int q = C.tid + NTHR * i, k = q >> 5, v4 = q & 31; *(LAS f32x4*)(Z + k * 132 + 4 * v4) = *(const f32x4*)(GKV + ((size_t)it * 64 + k) * 128 + 4 * v4); }
        WG_SYNC();
        const int ib = C.tid >> 5, vb = C.tid & 31; float acc[4][4];
#pragma unroll
        for (int x = 0; x < 4; ++x)
#pragma unroll
            for (int y = 0; y < 4; ++y) acc[x][y] = 0.f;
#pragma unroll 2
        for (int k = 0; k < 64; ++k) { const f32x4 bv = *(const LAS f32x4*)(Z + k * 132 + 4 * vb);
#pragma unroll
            for (int x = 0; x < 4; ++x) { const float av = X[(4 * ib + x) * 68 + k];
#pragma unroll
                for (int y = 0; y < 4; ++y) acc[x][y] += av * bv[y]; } }
        WG_SYNC();
        { float kf[8]; unpack8(*(const u32x4*)(P + row * NPM + C_GK + h * 64 + g8 * 8), kf);
#pragma unroll
          for (int i = 0; i < 8; ++i) { const int k = g8 * 8 + i; const float d = Gs[t * 68 + k] - Gs[32 * 68 + k]; X[t * 68 + k] = qf[i] * 0.125f * __expf(d); Y[t * 68 + k] = kf[i] * __expf(-d); }
          float vf[16]; unpack8(*(const u32x4*)(P + row * NPM + C_GV + h * 128 + g8 * 16), vf); unpack8(*(const u32x4*)(P + row * NPM + C_GV + h * 128 + g8 * 16 + 8), vf + 8);
#pragma unroll
          for (int i = 0; i < 16; ++i) Z[t * 132 + g8 * 16 + i] = vf[i]; }
        WG_SYNC();
        { float at[8];
#pragma unroll
          for (int jj = 0; jj < 8; ++jj) at[jj] = 0.f;
#pragma unroll 2
          for (int k = 0; k < 64; k += 4) { const f32x4 av = *(const LAS f32x4*)(X + t * 68 + k);
#pragma unroll
              for (int jj = 0; jj < 8; ++jj) { const f32x4 bv = *(const LAS f32x4*)(Y + (8 * g8 + jj) * 68 + k); at[jj] += (av[0] * bv[0] + av[1] * bv[1]) + (av[2] * bv[2] + av[3] * bv[3]); } }
          WG_SYNC();
#pragma unroll
          for (int jj = 0; jj < 8; ++jj) Gs[t * 68 + 8 * g8 + jj] = (8 * g8 + jj <= t) ? at[jj] : 0.f; }
        WG_SYNC();
#pragma unroll 2
        for (int j = 0; j < 64; ++j) { const f32x4 bv = *(const LAS f32x4*)(Z + j * 132 + 4 * vb);
#pragma unroll
            for (int x = 0; x < 4; ++x) { const float av = Gs[(4 * ib + x) * 68 + j];
#pragma unroll
                for (int y = 0; y < 4; ++y) acc[x][y] += av * bv[y]; } }
#pragma unroll
        for (int x = 0; x < 4; ++x) { float s = (acc[x][0] * acc[x][0] + acc[x][1] * acc[x][1]) + (acc[x][2] * acc[x][2] + acc[x][3] * acc[x][3]);
#pragma unroll
            for (int o = 1; o < 32; o <<= 1) s += __shfl_xor(s, o);
            const float rs = 1.0f / sqrtf(s * (1.0f / 128.0f) + EPS); const size_t r2 = (size_t)bc * 64 + 4 * ib + x;
            const u32x2 ogw = *(const u32x2*)(P + r2 * NPM + C_GOG + h * 128 + 4 * vb); const f32x4 gn = *(const f32x4*)(gnorm + 4 * vb);
            const float og[4] = {bflo(ogw.x), bfhi(ogw.x), bflo(ogw.y), bfhi(ogw.y)}; float o4[4];
#pragma unroll
            for (int y = 0; y < 4; ++y) o4[y] = acc[x][y] * rs * gn[y] * siluf_(og[y]);
            u32x2 w; w.x = pk2(o4[0], o4[1]); w.y = pk2(o4[2], o4[3]); *(u32x2*)(YS + r2 * 2048 + 512 + h * 128 + 4 * vb) = w; }
    }
    WG_SYNC();
}

__device__ __forceinline__ void ssd_conv8(const bf16* P, const float* cw, const float* cb, int bc, int t, int ch0, float* o) {
    const int pos = (bc & 127) * 64 + t; const size_t row = (size_t)bc * 64 + t;
#pragma unroll
    for (int i = 0; i < 8; ++i) o[i] = cb[ch0 + i];
#pragma unroll
    for (int tap = 0; tap < 4; ++tap) { if (pos - 3 + tap >= 0) { float x[8]; unpack8(*(const u32x4*)(P + (row - 3 + tap) * NPM + C_SX + ch0), x);
#pragma unroll
        for (int i = 0; i < 8; ++i) o[i] += cw[tap * 1024 + ch0 + i] * x[i]; } }
#pragma unroll
    for (int i = 0; i < 8; ++i) o[i] = siluf_(o[i]);
}
PH_FN void ph_ssd_a(const Ctx C, ArgsP a, int l) {
    const bf16* P = (const bf16*)(C.ws + WS_P); float* SST = (float*)(C.ws + WS_SST); float* SDT = (float*)(C.ws + WS_SDT); float* SAC = (float*)(C.ws + WS_SACUM); float* SCD = (float*)(C.ws + WS_SCDEC);
    const float* cw = a->in[15] + (size_t)l * 4 * 1024; const float* cb = a->in[16] + (size_t)l * 1024; const float* dtb = a->in[17] + (size_t)l * 8; const float* alog = a->in[18] + (size_t)l * 8;
    LF XD = (LF)C.lds; LF Bm = XD + 64 * 68; LF dtv = Bm + 64 * 132; LF av = dtv + 64; LF acu = av + 64;
    for (int it = C.bid; it < NBC * 8; it += C.G) {
        const int bc = it >> 3, hd = it & 7, g = hd >> 2;
        WG_SYNC();
        if (C.tid < 64) { const size_t row = (size_t)bc * 64 + C.tid; const float dt = softplusf_(bf2f(P[row * NPM + C_SDT + hd]) + dtb[hd]); dtv[C.tid] = dt; av[C.tid] = -__expf(alog[hd]) * dt; }
        WG_SYNC();
        if (C.tid < 64) { float s = 0.f; for (int j = 0; j <= C.tid; ++j) s += av[j]; acu[C.tid] = s; const size_t row = (size_t)bc * 64 + C.tid; SDT[row * 8 + hd] = dtv[C.tid]; SAC[row * 8 + hd] = s; if (C.tid == 63) SCD[it] = __expf(s); }
        WG_SYNC();
        { const int t = C.tid >> 3, cg = C.tid & 7; float o[8];
          ssd_conv8(P, cw, cb, bc, t, hd * 64 + cg * 8, o); const float sc = dtv[t] * __expf(acu[63] - acu[t]);
#pragma unroll
          for (int i = 0; i < 8; ++i) XD[t * 68 + cg * 8 + i] = o[i] * sc;
          ssd_conv8(P, cw, cb, bc, t, 512 + g * 128 + cg * 16, o);
#pragma unroll
          for (int i = 0; i < 8; ++i) Bm[t * 132 + cg * 16 + i] = o[i];
          ssd_conv8(P, cw, cb, bc, t, 512 + g * 128 + cg * 16 + 8, o);
#pragma unroll
          for (int i = 0; i < 8; ++i) Bm[t * 132 + cg * 16 + 8 + i] = o[i]; }
        WG_SYNC();
        { const int pb = C.tid >> 5, nb = C.tid & 31; float acc[4][4];
#pragma unroll
          for (int x = 0; x < 4; ++x)
#pragma unroll
              for (int y = 0; y < 4; ++y) acc[x][y] = 0.f;
#pragma unroll 2
          for (int j = 0; j < 64; ++j) { const f32x4 xv = *(const LAS f32x4*)(XD + j * 68 + 4 * pb), bv = *(const LAS f32x4*)(Bm + j * 132 + 4 * nb);
#pragma unroll
              for (int x = 0; x < 4; ++x)
#pragma unroll
                  for (int y = 0; y < 4; ++y) acc[x][y] += xv[x] * bv[y]; }
#pragma unroll
          for (int x = 0; x < 4; ++x) *(f32x4*)(SST + ((size_t)it * 64 + 4 * pb + x) * 128 + 4 * nb) = (f32x4){acc[x][0], acc[x][1], acc[x][2], acc[x][3]}; }
    }
    WG_SYNC();
}
PH_FN void ssd_scan_part(const Ctx C, int part) {
    float* SST = (float*)(C.ws + WS_SST); const float* SCD = (const float*)(C.ws + WS_SCDEC);
    const int e = part * NTHR + C.tid, chain = e >> 13, idx = e & 8191, b = chain >> 3, hd = chain & 7;
    float st = 0.f;
#pragma unroll 4
    for (int c = 0; c < NCH; ++c) { const size_t item = (size_t)(b * NCH + c) * 8 + hd; float* p = SST + item * 8192 + idx; const float tmp = *p; const float dec = SCD[item]; *p = st; st = dec * st + tmp; }
}
PH_HEAVY void ph_ssd_c(const Ctx C, ArgsP a, int l) {
    const bf16* P = (const bf16*)(C.ws + WS_P); const float* SST = (const float*)(C.ws + WS_SST); const float* SDT = (const float*)(C.ws + WS_SDT); const float* SAC = (const float*)(C.ws + WS_SACUM); bf16* YS = (bf16*)(C.ws + WS_YS);
    const float* cw = a->in[15] + (size_t)l * 4 * 1024; const float* cb = a->in[16] + (size_t)l * 1024; const float* dpar = a->in[19] + (size_t)l * 8; const float* snorm = a->in[20] + (size_t)l * 512;
    LF Cm = (LF)C.lds; LF BH = Cm + 64 * 132; LF CB = BH + 64 * 132; LF XS = CB + 64 * 68; LF dtv = XS + 64 * 68; LF acu = dtv + 64;
    for (int it = C.bid; it < NBC * 2; it += C.G) {
        const int bc = it >> 1, g = it & 1;
        const int t = C.tid >> 3, cg = C.tid & 7;
        WG_SYNC();
        { float o[8];
#pragma unroll
          for (int half = 0; half < 2; ++half) {
              ssd_conv8(P, cw, cb, bc, t, 512 + g * 128 + cg * 16 + half * 8, o);
#pragma unroll
              for (int i = 0; i < 8; ++i) BH[t * 132 + cg * 16 + half * 8 + i] = o[i];
              ssd_conv8(P, cw, cb, bc, t, 768 + g * 128 + cg * 16 + half * 8, o);
#pragma unroll
              for (int i = 0; i < 8; ++i) Cm[t * 132 + cg * 16 + half * 8 + i] = o[i]; } }
        WG_SYNC();
        { float cbv[8];
#pragma unroll
          for (int jj = 0; jj < 8; ++jj) cbv[jj] = 0.f;
#pragma unroll 2
          for (int n = 0; n < 128; n += 4) { const f32x4 cv = *(const LAS f32x4*)(Cm + t * 132 + n);
#pragma unroll
              for (int jj = 0; jj < 8; ++jj) { const f32x4 bv = *(const LAS f32x4*)(BH + (8 * cg + jj) * 132 + n); cbv[jj] += (cv[0] * bv[0] + cv[1] * bv[1]) + (cv[2] * bv[2] + cv[3] * bv[3]); } }
#pragma unroll
          for (int jj = 0; jj < 8; ++jj) CB[t * 68 + 8 * cg + jj] = cbv[jj]; }
        float yk[4][8]; float ssq = 0.f;
#pragma unroll
        for (int hh = 0; hh < 4; ++hh) {
            const int hd = 4 * g + hh; const size_t item = (size_t)bc * 8 + hd;
            WG_SYNC();
            if (C.tid < 64) { const size_t row = (size_t)bc * 64 + C.tid; dtv[C.tid] = SDT[row * 8 + hd]; acu[C.tid] = SAC[row * 8 + hd]; }
            { float o[8]; ssd_conv8(P, cw, cb, bc, t, hd * 64 + cg * 8, o);
#pragma unroll
              for (int i = 0; i < 8; ++i) XS[t * 68 + cg * 8 + i] = o[i]; }
#pragma unroll
            for (int i = 0; i < 4; ++i) { const int q = C.tid + NTHR * i, p = q >> 5, n4 = q & 31; *(LAS f32x4*)(BH + p * 132 + 4 * n4) = *(const f32x4*)(SST + (item * 64 + p) * 128 + 4 * n4); }
            WG_SYNC();
            float y[8]; const float ai = acu[t];
#pragma unroll
            for (int pp = 0; pp < 8; ++pp) y[pp] = 0.f;
#pragma unroll 2
            for (int j = 0; j <= t; ++j) { const float s = CB[t * 68 + j] * __expf(ai - acu[j]) * dtv[j]; const f32x4 x0 = *(const LAS f32x4*)(XS + j * 68 + 8 * cg), x1 = *(const LAS f32x4*)(XS + j * 68 + 8 * cg + 4);
#pragma unroll
                for (int pp = 0; pp < 4; ++pp) { y[pp] += s * x0[pp]; y[4 + pp] += s * x1[pp]; } }
            { float yi[8];
#pragma unroll
              for (int pp = 0; pp < 8; ++pp) yi[pp] = 0.f;
#pragma unroll 2
              for (int n = 0; n < 128; n += 4) { const f32x4 cv = *(const LAS f32x4*)(Cm + t * 132 + n);
#pragma unroll
                  for (int pp = 0; pp < 8; ++pp) { const f32x4 hv = *(const LAS f32x4*)(BH + (8 * cg + pp) * 132 + n); yi[pp] += (cv[0] * hv[0] + cv[1] * hv[1]) + (cv[2] * hv[2] + cv[3] * hv[3]); } }
              const float ea = __expf(ai); const float dh = dpar[hd]; const size_t row = (size_t)bc * 64 + t;
              float zf[8]; unpack8(*(const u32x4*)(P + row * NPM + C_SZ + hd * 64 + cg * 8), zf);
#pragma unroll
              for (int pp = 0; pp < 8; ++pp) { const float v = (y[pp] + ea * yi[pp] + dh * XS[t * 68 + 8 * cg + pp]) * siluf_(zf[pp]); yk[hh][pp] = v; ssq += v * v; } }
        }
        ssq += __shfl_xor(ssq, 1); ssq += __shfl_xor(ssq, 2); ssq += __shfl_xor(ssq, 4);
        const float rs = 1.0f / sqrtf(ssq * (1.0f / 256.0f) + EPS); const size_t row = (size_t)bc * 64 + t;
#pragma unroll
        for (int hh = 0; hh < 4; ++hh) { float o[8];
#pragma unroll
            for (int pp = 0; pp < 8; ++pp) o[pp] = yk[hh][pp] * rs * snorm[g * 256 + hh * 64 + cg * 8 + pp];
            *(u32x4*)(YS + row * 2048 + 1024 + g * 256 + hh * 64 + cg * 8) = pack8(o); }
    }
    WG_SYNC();
}

__device__ __forceinline__ void rw_lerp8(const bf16* P, const float* mu, int bc, int t, int c0, float* o) {
    const size_t row = (size_t)bc * 64 + t; const bool first = ((bc & 127) == 0) && (t == 0);
    float x[8], xp[8]; unpack8(*(const u32x4*)(P + row * NPM + C_RR + c0), x);
    if (!first) unpack8(*(const u32x4*)(P + (row - 1) * NPM + C_RR + c0), xp); else {
#pragma unroll
        for (int i = 0; i < 8; ++i) xp[i] = 0.f; }
#pragma unroll
    for (int i = 0; i < 8; ++i) o[i] = x[i] + (xp[i] - x[i]) * mu[c0 + i];
}
PH_HEAVY void ph_rw_prep(const Ctx C, ArgsP a, int l) {
    const bf16* P = (const bf16*)(C.ws + WS_P);
    float* RWW = (float*)(C.ws + WS_RWW); bf16* RWR = (bf16*)(C.ws + WS_RWR); bf16* RWK = (bf16*)(C.ws + WS_RWK); bf16* RWV = (bf16*)(C.ws + WS_RWV); bf16* RWKK = (bf16*)(C.ws + WS_RWKK); bf16* RWB = (bf16*)(C.ws + WS_RWB); bf16* RWG = (bf16*)(C.ws + WS_RWG);
    const float* mu = a->in[21] + (size_t)l * 1792; const float* w0 = a->in[22] + (size_t)l * 512; const float* w2 = a->in[23] + (size_t)l * 64 * 512; const float* a0 = a->in[24] + (size_t)l * 512; const float* a2 = a->in[25] + (size_t)l * 64 * 512;
    const float* g2 = a->in[26] + (size_t)l * 128 * 512; const float* k_k = a->in[27] + (size_t)l * 512; const float* k_a = a->in[28] + (size_t)l * 512;
    LF WL = (LF)C.lds; LF AL = WL + 64 * 68; LF GLs = AL + 64 * 68;
    for (int bc = C.bid; bc < NBC; bc += C.G) {
        WG_SYNC();
        { const int t = C.tid >> 3, cg = C.tid & 7; float o[8];
          rw_lerp8(P, mu, bc, t, 1536 + cg * 8, o);
#pragma unroll
          for (int i = 0; i < 8; ++i) WL[t * 68 + cg * 8 + i] = tanhf(o[i]);
          rw_lerp8(P, mu, bc, t, 1600 + cg * 8, o);
#pragma unroll
          for (int i = 0; i < 8; ++i) AL[t * 68 + cg * 8 + i] = o[i];
          rw_lerp8(P, mu, bc, t, 1664 + cg * 16, o);
#pragma unroll
          for (int i = 0; i < 8; ++i) GLs[t * 132 + cg * 16 + i] = sigmoidf_(o[i]);
          rw_lerp8(P, mu, bc, t, 1664 + cg * 16 + 8, o);
#pragma unroll
          for (int i = 0; i < 8; ++i) GLs[t * 132 + cg * 16 + 8 + i] = sigmoidf_(o[i]); }
        WG_SYNC();
        const int tb = C.tid >> 6, cb = C.tid & 63, ch0 = cb * 8;
#pragma unroll 1
        for (int half = 0; half < 2; ++half) {
        const int rb = 8 * tb + 4 * half;
        float acc[4][8], av[4][8];
#pragma unroll
        for (int i = 0; i < 4; ++i)
#pragma unroll
            for (int j = 0; j < 8; ++j) acc[i][j] = 0.f;
#pragma unroll 2
        for (int r = 0; r < 64; ++r) { const f32x4 b0 = *(const f32x4*)(w2 + r * 512 + ch0), b1 = *(const f32x4*)(w2 + r * 512 + ch0 + 4);
#pragma unroll
            for (int i = 0; i < 4; ++i) { const float x = WL[(rb + i) * 68 + r];
#pragma unroll
                for (int j = 0; j < 4; ++j) { acc[i][j] += x * b0[j]; acc[i][4 + j] += x * b1[j]; } } }
#pragma unroll
        for (int i = 0; i < 4; ++i) { const size_t row = (size_t)bc * 64 + rb + i; float o[8];
#pragma unroll
            for (int j = 0; j < 8; ++j) o[j] = __expf(-0.606531f * sigmoidf_(w0[ch0 + j] + acc[i][j]));
            *(f32x4*)(RWW + row * 512 + ch0) = (f32x4){o[0], o[1], o[2], o[3]}; *(f32x4*)(RWW + row * 512 + ch0 + 4) = (f32x4){o[4], o[5], o[6], o[7]}; }
#pragma unroll
        for (int i = 0; i < 4; ++i)
#pragma unroll
            for (int j = 0; j < 8; ++j) acc[i][j] = 0.f;
#pragma unroll 2
        for (int r = 0; r < 64; ++r) { const f32x4 b0 = *(const f32x4*)(a2 + r * 512 + ch0), b1 = *(const f32x4*)(a2 + r * 512 + ch0 + 4);
#pragma unroll
            for (int i = 0; i < 4; ++i) { const float x = AL[(rb + i) * 68 + r];
#pragma unroll
                for (int j = 0; j < 4; ++j) { acc[i][j] += x * b0[j]; acc[i][4 + j] += x * b1[j]; } } }
#pragma unroll
        for (int i = 0; i < 4; ++i)
#pragma unroll
            for (int j = 0; j < 8; ++j) av[i][j] = sigmoidf_(a0[ch0 + j] + acc[i][j]);
#pragma unroll
        for (int i = 0; i < 4; ++i)
#pragma unroll
            for (int j = 0; j < 8; ++j) acc[i][j] = 0.f;
#pragma unroll 2
        for (int r = 0; r < 128; ++r) { const f32x4 b0 = *(const f32x4*)(g2 + r * 512 + ch0), b1 = *(const f32x4*)(g2 + r * 512 + ch0 + 4);
#pragma unroll
            for (int i = 0; i < 4; ++i) { const float x = GLs[(rb + i) * 132 + r];
#pragma unroll
                for (int j = 0; j < 4; ++j) { acc[i][j] += x * b0[j]; acc[i][4 + j] += x * b1[j]; } } }
#pragma unroll
        for (int i = 0; i < 4; ++i) { const size_t row = (size_t)bc * 64 + rb + i; *(u32x4*)(RWG + row * 512 + ch0) = pack8(acc[i]); }
#pragma unroll
        for (int i = 0; i < 4; ++i) { const int t = rb + i; const size_t row = (size_t)bc * 64 + t; float o[8], kx[8], kk[8];
            rw_lerp8(P, mu, bc, t, ch0, o); *(u32x4*)(RWR + row * 512 + ch0) = pack8(o);
            rw_lerp8(P, mu, bc, t, 1024 + ch0, o); *(u32x4*)(RWV + row * 512 + ch0) = pack8(o);
            rw_lerp8(P, mu, bc, t, 512 + ch0, kx);
            float ss = 0.f;
#pragma unroll
            for (int j = 0; j < 8; ++j) { kk[j] = kx[j] * k_k[ch0 + j]; ss += kk[j] * kk[j]; }
            ss += __shfl_xor(ss, 1); ss += __shfl_xor(ss, 2); ss += __shfl_xor(ss, 4);
            const float inv = 1.0f / fmaxf(sqrtf(ss), 1e-12f);
#pragma unroll
            for (int j = 0; j < 8; ++j) { kk[j] *= inv; o[j] = kk[j] * av[i][j]; kx[j] = kx[j] * (1.0f + (av[i][j] - 1.0f) * k_a[ch0 + j]); }
            *(u32x4*)(RWKK + row * 512 + ch0) = pack8(kk); *(u32x4*)(RWB + row * 512 + ch0) = pack8(o); *(u32x4*)(RWK + row * 512 + ch0) = pack8(kx); }
        }
    }
    WG_SYNC();
}
template <int CTRL> __device__ __forceinline__ float dpp_get(float x) { return __builtin_bit_cast(float, __builtin_amdgcn_update_dpp(0, __builtin_bit_cast(int, x), CTRL, 0xf, 0xf, true)); }
__device__ __forceinline__ float reduce16(float x) { x += dpp_get<0xB1>(x); x += dpp_get<0x4E>(x); x += dpp_get<0x141>(x); x += dpp_get<0x140>(x); return x; }
#define RW_BAR() do { asm volatile("s_waitcnt lgkmcnt(0)" ::: "memory"); __builtin_amdgcn_s_barrier(); asm volatile("" ::: "memory"); } while (0)
PH_FN void rw_unit(const Ctx C, int chain, int rq) {
    const float* RWW = (const float*)(C.ws + WS_RWW); const bf16* RWR = (const bf16*)(C.ws + WS_RWR); const bf16* RWK = (const bf16*)(C.ws + WS_RWK); const bf16* RWV = (const bf16*)(C.ws + WS_RWV);
    const bf16* RWKK = (const bf16*)(C.ws + WS_RWKK); const bf16* RWB = (const bf16*)(C.ws + WS_RWB); bf16* RWY = (bf16*)(C.ws + WS_RWY);
    const int b = chain >> 3, h = chain & 7; const size_t rowb = (size_t)b * SEQ;
    constexpr int BUFB = 43008, O_KK = 0, O_W = 8192, O_B = 16384, O_K = 24576, O_R = 32768, O_V = 40960, NBLK = SEQ / 32;
    LAS unsigned char* L = C.lds;
    if (C.wave >= 4) {
        const int p = C.tid - 256, t = p >> 3, c8 = (p & 7) * 8;
        u32x4 rr, rk, rkk, rb; f32x4 w0, w1; unsigned rv;
#define RW_LOAD(blk) do { const size_t g_ = (rowb + (size_t)(blk) * 32 + t) * 512 + h * 64; \
            w0 = *(const f32x4*)(RWW + g_ + c8); w1 = *(const f32x4*)(RWW + g_ + c8 + 4); rr = *(const u32x4*)(RWR + g_ + c8); rk = *(const u32x4*)(RWK + g_ + c8); \
            rkk = *(const u32x4*)(RWKK + g_ + c8); rb = *(const u32x4*)(RWB + g_ + c8); rv = *(const unsigned*)(RWV + g_ + 16 * rq + (p & 7) * 2); } while (0)
#define RW_ST8(off, w_) do { float o_[8]; unpack8(w_, o_); LF d_ = (LF)(Lb + (off)) + t * 64 + c8; *(LAS f32x4*)d_ = (f32x4){o_[0], o_[1], o_[2], o_[3]}; *(LAS f32x4*)(d_ + 4) = (f32x4){o_[4], o_[5], o_[6], o_[7]}; } while (0)
        RW_LOAD(0);
        for (int blk = 0; blk < NBLK; ++blk) {
            LAS unsigned char* Lb = L + (blk & 1) * BUFB;
            { LF d = (LF)(Lb + O_W) + t * 64 + c8; *(LAS f32x4*)d = w0; *(LAS f32x4*)(d + 4) = w1; }
            RW_ST8(O_R, rr); RW_ST8(O_K, rk); RW_ST8(O_KK, rkk); RW_ST8(O_B, rb);
            { LF d = (LF)(Lb + O_V) + t * 16 + (p & 7) * 2; d[0] = bflo(rv); d[1] = bfhi(rv); }
            if (blk + 1 < NBLK) RW_LOAD(blk + 1);
            RW_BAR();
        }
        RW_BAR();
#undef RW_LOAD
#undef RW_ST8
    } else {
        const int rowl = C.lane >> 4, ks = C.lane & 15, row = 4 * C.wave + rowl;
        float S0 = 0.f, S1 = 0.f, S2 = 0.f, S3 = 0.f, ykeep = 0.f;
        bf16* yout = RWY + rowb * 512 + h * 64 + 16 * rq + row;
        for (int blk = 0; blk < NBLK; ++blk) {
            RW_BAR();
            const LAS unsigned char* Lb = L + (blk & 1) * BUFB;
            CLF pKK = (CLF)(Lb + O_KK) + 4 * ks; CLF pW = (CLF)(Lb + O_W) + 4 * ks; CLF pB = (CLF)(Lb + O_B) + 4 * ks; CLF pK = (CLF)(Lb + O_K) + 4 * ks; CLF pR = (CLF)(Lb + O_R) + 4 * ks; CLF pV = (CLF)(Lb + O_V) + row;
            f32x4 kk = *(const LAS f32x4*)pKK, w = *(const LAS f32x4*)pW, bb = *(const LAS f32x4*)pB, k = *(const LAS f32x4*)pK, r = *(const LAS f32x4*)pR; float vv = *pV;
#pragma unroll 4
            for (int t = 0; t < 32; ++t) {
                f32x4 nkk, nw, nb, nk, nr; float nv;
                const int tn = (t < 31) ? t + 1 : t;
                nkk = *(const LAS f32x4*)(pKK + tn * 64); nw = *(const LAS f32x4*)(pW + tn * 64); nb = *(const LAS f32x4*)(pB + tn * 64); nk = *(const LAS f32x4*)(pK + tn * 64); nr = *(const LAS f32x4*)(pR + tn * 64); nv = pV[tn * 16];
                float sa = (S0 * kk[0] + S1 * kk[1]) + (S2 * kk[2] + S3 * kk[3]);
                sa = -reduce16(sa);
                const float vk0 = vv * k[0], vk1 = vv * k[1], vk2 = vv * k[2], vk3 = vv * k[3];
                S0 = S0 * w[0] + (sa * bb[0] + vk0); S1 = S1 * w[1] + (sa * bb[1] + vk1); S2 = S2 * w[2] + (sa * bb[2] + vk2); S3 = S3 * w[3] + (sa * bb[3] + vk3);
                float y = (S0 * r[0] + S1 * r[1]) + (S2 * r[2] + S3 * r[3]);
                y = reduce16(y);
                if ((t & 15) == ks) ykeep = y;
                if ((t & 15) == 15) yout[(size_t)(blk * 32 + (t & 16) + ks) * 512] = (bf16)f2bf(ykeep);
                kk = nkk; w = nw; bb = nb; k = nk; r = nr; vv = nv;
            }
        }
        RW_BAR();
    }
}
PH_FN void ph_rw_out(const Ctx C, ArgsP a, int l) {
    const bf16* RWR = (const bf16*)(C.ws + WS_RWR); const bf16* RWK = (const bf16*)(C.ws + WS_RWK); const bf16* RWV = (const bf16*)(C.ws + WS_RWV); const bf16* RWG = (const bf16*)(C.ws + WS_RWG); const bf16* RWY = (const bf16*)(C.ws + WS_RWY);
    bf16* YS = (bf16*)(C.ws + WS_YS);
    const float* r_k = a->in[29] + (size_t)l * 512; const float* nw = a->in[30] + (size_t)l * 512; const float* nb = a->in[31] + (size_t)l * 512;
    const int gw = C.bid * NWAVES + C.wave, NGW = C.G * NWAVES;
    for (int it = gw; it < M * 8; it += NGW) {
        const size_t row = (size_t)(it >> 3); const int h = it & 7, c = h * 64 + C.lane; const size_t g = row * 512 + c;
        const float y = bf2f(RWY[g]), r = bf2f(RWR[g]), k = bf2f(RWK[g]), v = bf2f(RWV[g]), gg = bf2f(RWG[g]);
        const float mu = wave_sum(y) * (1.0f / 64.0f); const float d = y - mu; const float var = wave_sum(d * d) * (1.0f / 64.0f);
        const float yn = d * (1.0f / sqrtf(var + 64e-5f)) * nw[c] + nb[c];
        const float bonus = wave_sum(r * k * r_k[c]) * v;
        YS[row * 2048 + 1536 + c] = (bf16)f2bf((yn + bonus) * gg);
    }
}

__device__ __forceinline__ int pi_swap23(int i) { return (i & ~12) | ((i & 4) << 1) | ((i & 8) >> 1); }
__device__ __forceinline__ void da_unit(const Ctx& C, const Args& a, int l, int b, int h, int jq, float lam, float oml) {
    const bf16* P = (const bf16*)(C.ws + WS_P); const bf16* VT = (const bf16*)(C.ws + WS_VT); bf16* YS = (bf16*)(C.ws + WS_YS);
    const float* dnorm = a.in[11] + (size_t)l * 128;
    const int comp = C.wave >> 2, wq = C.wave & 3, q = C.lane & 31, hi = C.lane >> 5;
    const size_t qrow = (size_t)b * SEQ + jq * 128 + wq * 32 + q;
    pg8::bf16x8 qf[4];
#pragma unroll
    for (int d0 = 0; d0 < 4; ++d0) qf[d0] = *(const pg8::bf16x8*)(P + qrow * NPM + C_DAQ + h * 128 + comp * 64 + 16 * d0 + 8 * hi);
    const int ntile = 2 * jq + 2, my_last = 2 * jq + (wq >= 2 ? 1 : 0);
    f32x16 O[4];
#pragma unroll
    for (int db = 0; db < 4; ++db)
#pragma unroll
        for (int r = 0; r < 16; ++r) O[db][r] = 0.f;
    float mrun = -1e30f, lrun = 0.f;
    const bf16* kg = P + ((size_t)b * SEQ + (C.tid & 63)) * NPM + C_DAK + h * 128;
    const bf16* vg = VT + ((size_t)(b * 4 + h) * 128 + (C.tid & 127)) * SEQ;
    const int kc16 = C.tid >> 6, vc8 = C.tid >> 7;
    u32x4 kr[2], vr[2];
#pragma unroll
    for (int i = 0; i < 2; ++i) { kr[i] = *(const u32x4*)(kg + (kc16 + 8 * i) * 8); vr[i] = *(const u32x4*)(vg + (vc8 + 4 * i) * 8); }
    const int pq = pi_swap23(q);
    for (int tile = 0; tile < ntile; ++tile) {
        LAS unsigned char* buf = C.lds + (tile & 1) * 32768;
#pragma unroll
        for (int i = 0; i < 2; ++i) { const int c16 = kc16 + 8 * i; *(LAS u32x4*)(buf + (c16 >> 3) * 8192 + (c16 & 7) * 1024 + (C.tid & 63) * 16) = kr[i];
            *(LAS u32x4*)(buf + 16384 + (vc8 + 4 * i) * 2048 + (C.tid & 127) * 16) = vr[i]; }
        WG_SYNC();
        if (tile + 1 < ntile) {
#pragma unroll
            for (int i = 0; i < 2; ++i) { kr[i] = *(const u32x4*)(kg + (size_t)(tile + 1) * 64 * NPM + (kc16 + 8 * i) * 8); vr[i] = *(const u32x4*)(vg + (tile + 1) * 64 + (vc8 + 4 * i) * 8); } }
        if (tile <= my_last) {
            const LAS unsigned char* kb = buf + comp * 8192; const LAS unsigned char* vb = buf + 16384;
            f32x16 p0, p1;
#pragma unroll
            for (int r = 0; r < 16; ++r) { p0[r] = 0.f; p1[r] = 0.f; }
#pragma unroll
            for (int d0 = 0; d0 < 4; ++d0) {
                const pg8::bf16x8 a0 = *(const LAS pg8::bf16x8*)(kb + (2 * d0 + hi) * 1024 + pq * 16);
                const pg8::bf16x8 a1 = *(const LAS pg8::bf16x8*)(kb + (2 * d0 + hi) * 1024 + (32 + pq) * 16);
                p0 = __builtin_amdgcn_mfma_f32_32x32x16_bf16(a0, qf[d0], p0, 0, 0, 0);
                p1 = __builtin_amdgcn_mfma_f32_32x32x16_bf16(a1, qf[d0], p1, 0, 0, 0);
            }
            float mx = fmaxf(p0[0], p1[0]);
#pragma unroll
            for (int r = 1; r < 16; ++r) mx = fmaxf(mx, fmaxf(p0[r], p1[r]));
            mx = fmaxf(mx, __shfl_xor(mx, 32));
            const float mnew = fmaxf(mrun, mx); const float alpha = __builtin_amdgcn_exp2f(mrun - mnew); mrun = mnew;
            float rs = 0.f;
#pragma unroll
            for (int r = 0; r < 16; ++r) { p0[r] = __builtin_amdgcn_exp2f(p0[r] - mnew); p1[r] = __builtin_amdgcn_exp2f(p1[r] - mnew); rs += p0[r] + p1[r]; }
            lrun = lrun * alpha + rs;
#pragma unroll
            for (int db = 0; db < 4; ++db)
#pragma unroll
                for (int r = 0; r < 16; ++r) O[db][r] *= alpha;
            pg8::bf16x8 pb[4];
            { u32x4 w;
              w.x = pk2(p0[0], p0[1]); w.y = pk2(p0[2], p0[3]); w.z = pk2(p0[4], p0[5]); w.w = pk2(p0[6], p0[7]); pb[0] = __builtin_bit_cast(pg8::bf16x8, w);
              w.x = pk2(p0[8], p0[9]); w.y = pk2(p0[10], p0[11]); w.z = pk2(p0[12], p0[13]); w.w = pk2(p0[14], p0[15]); pb[1] = __builtin_bit_cast(pg8::bf16x8, w);
              w.x = pk2(p1[0], p1[1]); w.y = pk2(p1[2], p1[3]); w.z = pk2(p1[4], p1[5]); w.w = pk2(p1[6], p1[7]); pb[2] = __builtin_bit_cast(pg8::bf16x8, w);
              w.x = pk2(p1[8], p1[9]); w.y = pk2(p1[10], p1[11]); w.z = pk2(p1[12], p1[13]); w.w = pk2(p1[14], p1[15]); pb[3] = __builtin_bit_cast(pg8::bf16x8, w); }
#pragma unroll
            for (int db = 0; db < 4; ++db)
#pragma unroll
                for (int s = 0; s < 4; ++s) {
                    const pg8::bf16x8 vf = *(const LAS pg8::bf16x8*)(vb + (2 * s + hi) * 2048 + (32 * db + q) * 16);
                    O[db] = __builtin_amdgcn_mfma_f32_32x32x16_bf16(vf, pb[s], O[db], 0, 0, 0);
                }
        }
    }
    const float ltot = lrun + __shfl_xor(lrun, 32); const float inv = 1.0f / ltot;
    WG_SYNC();
    LF X = (LF)C.lds + (wq * 32 + q) * 132;
    if (comp == 1) {
        const float sc = inv * lam;
#pragma unroll
        for (int db = 0; db < 4; ++db)
#pragma unroll
            for (int g4 = 0; g4 < 4; ++g4) *(LAS f32x4*)(X + 32 * db + 8 * g4 + 4 * hi) = (f32x4){O[db][4 * g4] * sc, O[db][4 * g4 + 1] * sc, O[db][4 * g4 + 2] * sc, O[db][4 * g4 + 3] * sc};
    }
    WG_SYNC();
    if (comp == 0) {
        float ss = 0.f;
#pragma unroll
        for (int db = 0; db < 4; ++db)
#pragma unroll
            for (int g4 = 0; g4 < 4; ++g4) { const f32x4 x = *(const LAS f32x4*)(X + 32 * db + 8 * g4 + 4 * hi);
#pragma unroll
                for (int e = 0; e < 4; ++e) { const float v = O[db][4 * g4 + e] * inv - x[e]; O[db][4 * g4 + e] = v; ss += v * v; } }
        ss += __shfl_xor(ss, 32);
        const float rs = oml / sqrtf(ss * (1.0f / 128.0f) + EPS);
#pragma unroll
        for (int db = 0; db < 4; ++db)
#pragma unroll
            for (int g4 = 0; g4 < 4; ++g4) { const int d = 32 * db + 8 * g4 + 4 * hi; const f32x4 gn = *(const f32x4*)(dnorm + d);
                u32x2 w; w.x = pk2(O[db][4 * g4] * rs * gn[0], O[db][4 * g4 + 1] * rs * gn[1]); w.y = pk2(O[db][4 * g4 + 2] * rs * gn[2], O[db][4 * g4 + 3] * rs * gn[3]);
                *(u32x2*)(YS + qrow * 2048 + h * 128 + d) = w; }
    }
    WG_SYNC();
}
__device__ const signed char ATT_BINS[24][12] = {{63,21,-1,-1,-1,-1,-1,-1,-1,-1,-1,-1}, {62,22,-1,-1,-1,-1,-1,-1,-1,-1,-1,-1}, {61,23,-1,-1,-1,-1,-1,-1,-1,-1,-1,-1}, {60,24,-1,-1,-1,-1,-1,-1,-1,-1,-1,-1}, {59,25,-1,-1,-1,-1,-1,-1,-1,-1,-1,-1}, {58,26,-1,-1,-1,-1,-1,-1,-1,-1,-1,-1}, {57,27,-1,-1,-1,-1,-1,-1,-1,-1,-1,-1}, {56,28,-1,-1,-1,-1,-1,-1,-1,-1,-1,-1}, {55,29,-1,-1,-1,-1,-1,-1,-1,-1,-1,-1}, {54,30,-1,-1,-1,-1,-1,-1,-1,-1,-1,-1}, {53,31,-1,-1,-1,-1,-1,-1,-1,-1,-1,-1}, {52,32,-1,-1,-1,-1,-1,-1,-1,-1,-1,-1}, {51,33,-1,-1,-1,-1,-1,-1,-1,-1,-1,-1}, {50,34,-1,-1,-1,-1,-1,-1,-1,-1,-1,-1}, {49,35,-1,-1,-1,-1,-1,-1,-1,-1,-1,-1}, {48,36,-1,-1,-1,-1,-1,-1,-1,-1,-1,-1}, {47,37,-1,-1,-1,-1,-1,-1,-1,-1,-1,-1}, {46,38,-1,-1,-1,-1,-1,-1,-1,-1,-1,-1}, {45,39,-1,-1,-1,-1,-1,-1,-1,-1,-1,-1}, {44,40,-1,-1,-1,-1,-1,-1,-1,-1,-1,-1}, {43,41,-1,-1,-1,-1,-1,-1,-1,-1,-1,-1}, {42,20,19,6,-1,-1,-1,-1,-1,-1,-1,-1}, {18,17,16,15,14,5,-1,-1,-1,-1,-1,-1}, {13,12,11,10,9,8,7,4,3,2,1,0}};
__device__ __forceinline__ void ph_da_attn(const Ctx& C, const Args& a, int l, int bh, int bin) {
    const float* q1 = a.in[7] + (size_t)l * 64; const float* k1 = a.in[8] + (size_t)l * 64; const float* q2 = a.in[9] + (size_t)l * 64; const float* k2 = a.in[10] + (size_t)l * 64;
    float s1 = 0.f, s2 = 0.f;
    for (int i = 0; i < 64; ++i) { s1 += q1[i] * k1[i]; s2 += q2[i] * k2[i]; }
    const float lam_init = 0.8f - 0.6f * expf(-0.3f * (float)l); const float lam = expf(s1) - expf(s2) + lam_init;
    for (int i = 0; i < 12; ++i) { const int jq = ATT_BINS[bin][i]; if (jq < 0) break; da_unit(C, a, l, bh >> 2, bh & 3, jq, lam, 1.0f - lam_init); }
}

PH_FN void ph_final(const Ctx C, ArgsP a) {
    const float* ssq = (const float*)(C.ws + WS_SSQ); const float* fn = a->in[39];
    const int gw = C.bid * NWAVES + C.wave, NGW = C.G * NWAVES;
    for (int m = gw; m < M; m += NGW) { const float rs = pg8::row_rstd(ssq, m, M); f32x4* hr = (f32x4*)(C.h + (size_t)m * D) + C.lane; const f32x4* gr = (const f32x4*)fn + C.lane;
#pragma unroll
        for (int j = 0; j < 4; ++j) { const f32x4 v = hr[64 * j], g = gr[64 * j]; hr[64 * j] = v * rs * g; } }
}
#ifndef REP_ATTN
#define REP_ATTN 1
#endif
#ifndef REP_RWC
#define REP_RWC 1
#endif
#ifndef REP_MAC
#define REP_MAC 1
#endif
constexpr int NPH = 12, G_FINAL = 1 + NL * NPH, G_END = G_FINAL + 1;
template <int GRP>
__global__ void __launch_bounds__(NTHR, 2) hybrid_fwd(Args args) {
    constexpr bool ALL = (GRP < 0);
    constexpr bool EN_G1 = ALL || GRP == 0, EN_G2 = EN_G1, EN_G3 = EN_G1, EN_G7 = EN_G1, EN_G8 = EN_G1, EN_G9 = EN_G1;
    constexpr bool EN_PRO = ALL || GRP == 1, EN_W = EN_PRO, EN_FIN = EN_PRO, EN_MA1 = EN_PRO, EN_MA2 = EN_PRO, EN_MA3 = EN_PRO, EN_MA4 = EN_PRO;
    constexpr bool EN_MB1 = ALL || GRP == 2, EN_MB2 = EN_MB1;
    constexpr bool EN_MC1 = ALL || GRP == 3, EN_MC2 = EN_MC1, EN_MC3 = EN_MC1;
    extern __shared__ __attribute__((aligned(16))) unsigned char lds[];
    Ctx C; C.lds = (LAS unsigned char*)lds; C.ws = args.ws; C.h = args.out; C.tid = threadIdx.x; C.lane = C.tid & 63; C.wave = __builtin_amdgcn_readfirstlane(C.tid >> 6); C.bid = blockIdx.x; C.G = gridDim.x;
    LAS unsigned char* ldsl = (LAS unsigned char*)lds;
    const ArgsP ap = (ArgsP)__builtin_amdgcn_kernarg_segment_ptr();
    for (int u = C.tid; u < (LDS_BYTES - LDSCTL_OFF) / 4; u += NTHR) ((LAS unsigned*)(ldsl + LDSCTL_OFF))[u] = 0u;
    __syncthreads();
    volatile LAS unsigned* MISC = (volatile LAS unsigned*)(ldsl + MISC_OFF);
    gu32* ctl = (gu32*)(args.ws + WS_CTL);
    const int g_lo = args.g_lo, g_hi = args.g_hi;
    XcdBarrier bar; bar.bar = (unsigned*)(ctl + CW_BAR); bar.x = 0; bar.st = nullptr;
    if (g_hi - g_lo > 1) bar = xcd_barrier_post((unsigned*)(ctl + CW_BAR), MISC + 8);
#define IN(g) (g_lo <= (g) && (g) < g_hi)
#define SEAM(g) do { if (IN(g) && IN((g) + 1)) xcd_barrier(bar); } while (0)
    bf16* HB = (bf16*)(args.ws + WS_HB); float* SSQ = (float*)(args.ws + WS_SSQ);

    if (EN_PRO && IN(0)) ph_prologue(fresh(C), ap);
    SEAM(0);
#pragma unroll 1
    for (int l = 0; l < NL; ++l) {
        const int gb = 1 + NPH * l;
        if (EN_W && IN(gb + 0)) ph_weights(fresh(C), ap, l);
        SEAM(gb + 0);
#pragma unroll 1
        for (int f = 0; f < 2; ++f) {
            const int gu = gb + (f ? 10 : 1);
            if (EN_G1 && IN(gu)) {
                pg8::Gemm g{HB, (const bf16*)(args.ws + (f ? WS_WGU2 : WS_WGU1)), M, 2 * FF, D, D}; pg8::StaticOrder S; S.init(M, 2 * FF, C.G, C.bid);
                pg8::EpiSwiglu E{(bf16*)(args.ws + WS_ACT), FF, SSQ, M};
                pg8::gemm_phase<pg8::EpiSwiglu, pg8::StaticOrder, true, true>(ldsl, g, S, E);
            }
            SEAM(gu);
            if (EN_G2 && IN(gu + 1)) {
                pg8::Gemm g{(const bf16*)(args.ws + WS_ACT), (const bf16*)(args.ws + (f ? WS_WD2 : WS_WD1)), M, D, FF, FF}; pg8::StaticOrder S; S.init(M, D, C.G, C.bid);
                pg8::EpiResid E{C.h, HB, SSQ, M, 0.5f};
                pg8::gemm_phase<pg8::EpiResid, pg8::StaticOrder, false, true>(ldsl, g, S, E);
            }
            SEAM(gu + 1);
            if (f == 0) {
                if (EN_G3 && IN(gb + 3)) {
                    pg8::Gemm g{HB, (const bf16*)(args.ws + WS_WIN), M, NPM, D, D}; pg8::StaticOrder S; S.init(M, NPM, C.G, C.bid);
                    pg8::EpiScaleBf16 E{(bf16*)(args.ws + WS_P), NPM, SSQ, M};
                    pg8::gemm_phase<pg8::EpiScaleBf16, pg8::StaticOrder, true, true>(ldsl, g, S, E);
                }
                SEAM(gb + 3);
                if (IN(gb + 4)) { if (EN_MA1) ph_da_prep(fresh(C)); for (int rep = 0; rep < REP_MAC; ++rep) { if (EN_MA2) ph_gla_a(fresh(C), ap, l); if (EN_MA3) ph_ssd_a(fresh(C), ap, l); if (EN_MA4) ph_rw_prep(fresh(C), ap, l); } }
                SEAM(gb + 4);
                if (IN(gb + 5)) {
                    if (C.bid < 64) { if (EN_MB2) { const int xcd = C.bid & 7, slot = C.bid >> 3; for (int rep = 0; rep < REP_RWC; ++rep) rw_unit(fresh(C), xcd * 2 + (slot >> 2), slot & 3); } }
                    else { const int a = C.bid - 64;
                        if (EN_MB2) { for (int p = a; p < 384; p += 192) { if (p < 128) gla_scan_part(fresh(C), p); else ssd_scan_part(fresh(C), p - 128); } }
                        for (int rep = 0; rep < REP_ATTN; ++rep) if (EN_MB1) ph_da_attn(fresh(C), args, l, a & 7, a >> 3); }
                }
                SEAM(gb + 5);
                if (IN(gb + 6)) { for (int rep = 0; rep < REP_MAC; ++rep) { if (EN_MC1) ph_gla_c(fresh(C), ap, l); if (EN_MC2) ph_ssd_c(fresh(C), ap, l); if (EN_MC3) ph_rw_out(fresh(C), ap, l); } }
                SEAM(gb + 6);
                if (EN_G7 && IN(gb + 7)) {
                    pg8::Gemm g{HB, (const bf16*)(args.ws + WS_WIN) + (size_t)NPM * D, M, 4096, D, D}; pg8::StaticOrder S; S.init(M, 4096, C.G, C.bid);
                    pg8::EpiScaleBf16 E{(bf16*)(args.ws + WS_PG), 4096, SSQ, M};
                    pg8::gemm_phase<pg8::EpiScaleBf16, pg8::StaticOrder, true, true>(ldsl, g, S, E);
                }
                SEAM(gb + 7);
                if (EN_G8 && IN(gb + 8)) {
                    pg8::Gemm g{(const bf16*)(args.ws + WS_YS), (const bf16*)(args.ws + WS_WB), M, D, 512, 2048}; pg8::GroupedOrder S; S.init(M, D, 4, 512, C.G, C.bid);
                    pg8::EpiGateAcc E{(bf16*)(args.ws + WS_MERGED), (const bf16*)(args.ws + WS_PG), args.in[33] + (size_t)l * 4096};
                    pg8::gemm_phase<pg8::EpiGateAcc, pg8::GroupedOrder, true, true>(ldsl, g, S, E);
                }
                SEAM(gb + 8);
                if (EN_G9 && IN(gb + 9)) {
                    pg8::Gemm g{(const bf16*)(args.ws + WS_MERGED), (const bf16*)(args.ws + WS_WO), M, D, D, D}; pg8::StaticOrder S; S.init(M, D, C.G, C.bid);
                    pg8::EpiResid E{C.h, HB, SSQ, M, 1.0f};
                    pg8::gemm_phase<pg8::EpiResid, pg8::StaticOrder, false, true>(ldsl, g, S, E);
                }
                SEAM(gb + 9);
            }
        }
    }
    if (EN_FIN && IN(G_FINAL)) ph_final(fresh(C), ap);
#undef IN
#undef SEAM
}

#ifndef ONE_LAUNCH
#define ONE_LAUNCH 1
#endif
extern "C" void kernel_launch(void* const* d_in, const int* in_sizes, int n_in, void* d_out, int out_size, void* d_ws, size_t ws_size, hipStream_t stream) {
    static int grid = 0;
    if (grid == 0) {
        if (n_in != 40 || in_sizes[0] != M * D || out_size != M * D || ws_size < WS_END) { fprintf(stderr, "kernel_launch: unexpected shapes (n_in %d, in0 %d, out %d, ws %zu < %zu); nothing launched\n", n_in, n_in > 0 ? in_sizes[0] : -1, out_size, ws_size, (size_t)WS_END); grid = -1; return; }
        int dev = 0, cus = 0, per_cu = 0;
        if (hipGetDevice(&dev) != hipSuccess || hipDeviceGetAttribute(&cus, hipDeviceAttributeMultiprocessorCount, dev) != hipSuccess) { grid = -1; return; }
#if ONE_LAUNCH
        if (hipFuncSetAttribute((const void*)hybrid_fwd<-1>, hipFuncAttributeMaxDynamicSharedMemorySize, LDS_BYTES) != hipSuccess) { fprintf(stderr, "kernel_launch: hipFuncSetAttribute failed\n"); grid = -1; return; }
#else
        if (hipFuncSetAttribute((const void*)hybrid_fwd<0>, hipFuncAttributeMaxDynamicSharedMemorySize, LDS_BYTES) != hipSuccess || hipFuncSetAttribute((const void*)hybrid_fwd<1>, hipFuncAttributeMaxDynamicSharedMemorySize, LDS_BYTES) != hipSuccess ||
            hipFuncSetAttribute((const void*)hybrid_fwd<2>, hipFuncAttributeMaxDynamicSharedMemorySize, LDS_BYTES) != hipSuccess || hipFuncSetAttribute((const void*)hybrid_fwd<3>, hipFuncAttributeMaxDynamicSharedMemorySize, LDS_BYTES) != hipSuccess) { fprintf(stderr, "kernel_launch: hipFuncSetAttribute failed\n"); grid = -1; return; }
#endif
        if (hipOccupancyMaxActiveBlocksPerMultiprocessor(&per_cu, (const void*)hybrid_fwd<(ONE_LAUNCH ? -1 : 0)>, NTHR, LDS_BYTES) != hipSuccess || per_cu < 1) fprintf(stderr, "kernel_launch: occupancy query reports %d workgroups per CU\n", per_cu);
        (void)hipGetLastError();
        grid = cus;
        if (grid != 256) { fprintf(stderr, "kernel_launch: %d CUs; this kernel is laid out for 256 workgroups; nothing launched\n", grid); grid = -1; return; }
    }
    if (grid < 0) return;
    if (hipMemsetAsync((char*)d_ws + WS_CTL, 0, CTL_ZERO_BYTES, stream) != hipSuccess) return;
    Args a{};
    for (int i = 0; i < 40; ++i) a.in[i] = (const float*)d_in[i];
    a.out = (float*)d_out; a.ws = (unsigned char*)d_ws;
    for (int j = 0; j < 32; ++j) a.inv_freq[j] = (float)pow(10000.0, -(double)j / 32.0);
#if ONE_LAUNCH
    a.g_lo = 0; a.g_hi = G_END;
    hipLaunchKernelGGL(hybrid_fwd<-1>, dim3(grid), dim3(NTHR), LDS_BYTES, stream, a);
#else
    for (int g = 0; g < G_END; ++g) {
        a.g_lo = g; a.g_hi = g + 1;
        int grp = 1;
        if (g >= 1 && g < G_FINAL) { const int k = (g - 1) % NPH; grp = (k == 0 || k == 4) ? 1 : (k == 5) ? 2 : (k == 6) ? 3 : 0; }
        if (grp == 0) hipLaunchKernelGGL(hybrid_fwd<0>, dim3(grid), dim3(NTHR), LDS_BYTES, stream, a);
        else if (grp == 1) hipLaunchKernelGGL(hybrid_fwd<1>, dim3(grid), dim3(NTHR), LDS_BYTES, stream, a);
        else if (grp == 2) hipLaunchKernelGGL(hybrid_fwd<2>, dim3(grid), dim3(NTHR), LDS_BYTES, stream, a);
        else hipLaunchKernelGGL(hybrid_fwd<3>, dim3(grid), dim3(NTHR), LDS_BYTES, stream, a);
    }
#endif
}
```

```cpp
#include <hip/hip_runtime.h>
#include <cstdio>
#include <cstdint>
#include <cmath>

namespace pg8 {
#define PG8_LAS __attribute__((address_space(3)))
typedef unsigned short bf16_t;
typedef short bf16x8 __attribute__((ext_vector_type(8)));
typedef float f32x4 __attribute__((ext_vector_type(4)));
typedef unsigned u32x4 __attribute__((ext_vector_type(4)));
constexpr int BM = 256, BK = 64, HALF = 128, HTB = HALF * BK * 2  , STAGE_BYTES = 8 * HTB, NXCD = 8, WGM = 8;

__host__ __device__ __forceinline__ int lds_byte(int r, int c) { const int st = (r >> 4) * 2 + (c >> 5), rr = r & 15, cc = c & 31, ob = rr * 64 + cc * 2; return st * 1024 + (ob ^ (((ob >> 9) & 1) << 5)); }
__host__ __device__ __forceinline__ void stage_rc(int b, int& R, int& C) { const int st = b / 1024, sb = b % 1024, swz = sb ^ (((sb >> 9) & 1) << 5); R = (st >> 1) * 16 + swz / 64; C = (st & 1) * 32 + (swz % 64) / 2; }
__host__ __device__ __forceinline__ int perm32(int rho) { const int n = rho >> 4, i = rho & 15; return 8 * (i >> 2) + 4 * n + (i & 3); }

struct Unit { int pm, pn, z; };
struct Gemm { const bf16_t* A; const bf16_t* Bt; int M, N, K, lda; };

struct StaticOrder {
    int nM, nN, nwg, G, c;
    __host__ __device__ void init(int M, int N, int G_, int c_) { nM = M / BM; nN = N / BM; nwg = nM * nN; G = G_; c = c_; }
    __host__ __device__ bool next(int i, Unit& u) const {
        const long L = (long)i * G + c; if (L >= nwg) return false;
        int wgid = (int)L; { const int q = nwg / NXCD, r = nwg % NXCD, xcd = wgid % NXCD, off = wgid / NXCD; wgid = (xcd < r ? xcd * (q + 1) : r * (q + 1) + (xcd - r) * q) + off; }
        const int nig = WGM * nN, gid = wgid / nig, fm = gid * WGM, gsz = (nM - fm) < WGM ? (nM - fm) : WGM;
        u.pm = fm + ((wgid % nig) % gsz); u.pn = (wgid % nig) / gsz; u.z = 0; return true;
    }
    __device__ __forceinline__ void a_ready(const Unit&) const {}
    __device__ __forceinline__ void done(const Unit&) const {}
    __device__ __forceinline__ size_t a_off(const Unit&) const { return 0; }
    __device__ __forceinline__ int b_tile(const Unit& u) const { return u.pn; }
};
struct GroupedOrder {
    StaticOrder base; int NZ, Kbytes, tiles_per_group;
    __device__ void init(int M, int N, int NZ_, int K, int G_, int c_) { base.init(M, N, G_, c_); NZ = NZ_; Kbytes = K * 2; tiles_per_group = N / BM; }
    __device__ bool next(int i, Unit& u) const { const int r = i / NZ, z = i - r * NZ; if (!base.next(r, u)) return false; u.z = z; return true; }
    __device__ __forceinline__ void a_ready(const Unit&) const {}
    __device__ __forceinline__ void done(const Unit&) const {}
    __device__ __forceinline__ size_t a_off(const Unit& u) const { return (size_t)u.z * Kbytes; }
    __device__ __forceinline__ int b_tile(const Unit& u) const { return u.z * tiles_per_group + u.pn; }
};

__device__ __forceinline__ unsigned cvt_pk_bf16(float lo, float hi) { unsigned r; asm volatile("v_cvt_pk_bf16_f32 %0, %1, %2" : "=v"(r) : "v"(lo), "v"(hi)); return r; }
__device__ __forceinline__ float bf_lo(unsigned w) { return __uint_as_float(w << 16); }
__device__ __forceinline__ float bf_hi(unsigned w) { return __uint_as_float(w & 0xffff0000u); }
__device__ __forceinline__ float fast_sigmoid(float x) { return __builtin_amdgcn_rcpf(1.0f + __builtin_amdgcn_exp2f(-1.4426950408889634f * x)); }

__device__ __forceinline__ float row_rstd(const float* ssq, int row, int M_) {
    const float s = (ssq[row] + ssq[M_ + row]) + (ssq[2 * M_ + row] + ssq[3 * M_ + row]);
    return 1.0f / sqrtf(s * (1.0f / 1024.0f) + 1e-6f);
}
struct EpiScaleBf16 {
    static constexpr bool PERM = true, AFTER_DRAIN = false;
    bf16_t* O; int ldc; const float* ssq; int M_;
    __device__ __forceinline__ void operator()(const f32x4 (&acc)[2][2][4][2], const Unit& u, int wr, int wc, int fr, int fq) const {
        const int row0 = u.pm * BM + wr * 64 + fr; const int col0 = u.pn * BM + wc * 32 + 8 * fq;
#pragma unroll
        for (int ai = 0; ai < 2; ++ai)
#pragma unroll
            for (int m = 0; m < 4; ++m) { const int row = row0 + ai * HALF + m * 16; const float rs = row_rstd(ssq, row, M_); bf16_t* rowp = O + (size_t)row * ldc + col0;
#pragma unroll
                for (int bj = 0; bj < 2; ++bj) { const f32x4 v0 = acc[ai][bj][m][0] * rs, v1 = acc[ai][bj][m][1] * rs;
                    u32x4 w; w.x = cvt_pk_bf16(v0[0], v0[1]); w.y = cvt_pk_bf16(v0[2], v0[3]); w.z = cvt_pk_bf16(v1[0], v1[1]); w.w = cvt_pk_bf16(v1[2], v1[3]);
                    *(u32x4*)(rowp + bj * HALF) = w; } }
    }
};
struct EpiSwiglu {
    static constexpr bool PERM = true, AFTER_DRAIN = false;
    bf16_t* O; int ldc; const float* ssq; int M_;
    __device__ __forceinline__ void operator()(const f32x4 (&acc)[2][2][4][2], const Unit& u, int wr, int wc, int fr, int fq) const {
        const int row0 = u.pm * BM + wr * 64 + fr; const int col0 = u.pn * HALF + wc * 32 + 8 * fq;
#pragma unroll
        for (int ai = 0; ai < 2; ++ai)
#pragma unroll
            for (int m = 0; m < 4; ++m) { const int row = row0 + ai * HALF + m * 16; const float rs = row_rstd(ssq, row, M_); bf16_t* rowp = O + (size_t)row * ldc + col0;
                float o[8];
#pragma unroll
                for (int n = 0; n < 2; ++n)
#pragma unroll
                    for (int i = 0; i < 4; ++i) { const float g = acc[ai][0][m][n][i] * rs, up = acc[ai][1][m][n][i] * rs; o[n * 4 + i] = g * fast_sigmoid(g) * up; }
                u32x4 w; w.x = cvt_pk_bf16(o[0], o[1]); w.y = cvt_pk_bf16(o[2], o[3]); w.z = cvt_pk_bf16(o[4], o[5]); w.w = cvt_pk_bf16(o[6], o[7]);
                *(u32x4*)rowp = w; }
    }
};
struct EpiGateAcc {
    static constexpr bool PERM = true, AFTER_DRAIN = false;
    bf16_t* O; const bf16_t* PG; const float* gb;
    __device__ __forceinline__ void operator()(const f32x4 (&acc)[2][2][4][2], const Unit& u, int wr, int wc, int fr, int fq) const {
        const int row0 = u.pm * BM + wr * 64 + fr; const int col0 = u.pn * BM + wc * 32 + 8 * fq; const int z = u.z;
        f32x4 gbv[2][2];
#pragma unroll
        for (int bj = 0; bj < 2; ++bj)
#pragma unroll
            for (int n = 0; n < 2; ++n) gbv[bj][n] = *(const f32x4*)(gb + z * 1024 + col0 + bj * HALF + 4 * n);
#pragma unroll
        for (int ai = 0; ai < 2; ++ai)
#pragma unroll
            for (int m = 0; m < 4; ++m) { const int row = row0 + ai * HALF + m * 16;
#pragma unroll
                for (int bj = 0; bj < 2; ++bj) {
                    const u32x4 pg = *(const u32x4*)(PG + (size_t)row * 4096 + z * 1024 + col0 + bj * HALF);
                    bf16_t* op = O + (size_t)row * 1024 + col0 + bj * HALF;
                    float o[8];
                    o[0] = fast_sigmoid(bf_lo(pg.x) + gbv[bj][0][0]) * acc[ai][bj][m][0][0]; o[1] = fast_sigmoid(bf_hi(pg.x) + gbv[bj][0][1]) * acc[ai][bj][m][0][1];
                    o[2] = fast_sigmoid(bf_lo(pg.y) + gbv[bj][0][2]) * acc[ai][bj][m][0][2]; o[3] = fast_sigmoid(bf_hi(pg.y) + gbv[bj][0][3]) * acc[ai][bj][m][0][3];
                    o[4] = fast_sigmoid(bf_lo(pg.z) + gbv[bj][1][0]) * acc[ai][bj][m][1][0]; o[5] = fast_sigmoid(bf_hi(pg.z) + gbv[bj][1][1]) * acc[ai][bj][m][1][1];
                    o[6] = fast_sigmoid(bf_lo(pg.w) + gbv[bj][1][2]) * acc[ai][bj][m][1][2]; o[7] = fast_sigmoid(bf_hi(pg.w) + gbv[bj][1][3]) * acc[ai][bj][m][1][3];
                    if (z > 0) { const u32x4 pv = *(const u32x4*)op;
                        o[0] += bf_lo(pv.x); o[1] += bf_hi(pv.x); o[2] += bf_lo(pv.y); o[3] += bf_hi(pv.y); o[4] += bf_lo(pv.z); o[5] += bf_hi(pv.z); o[6] += bf_lo(pv.w); o[7] += bf_hi(pv.w); }
                    u32x4 w; w.x = cvt_pk_bf16(o[0], o[1]); w.y = cvt_pk_bf16(o[2], o[3]); w.z = cvt_pk_bf16(o[4], o[5]); w.w = cvt_pk_bf16(o[6], o[7]);
                    *(u32x4*)op = w; } }
    }
};
struct EpiResid {
    static constexpr bool PERM = true, AFTER_DRAIN = true;
    float* H; bf16_t* HB; float* ssq; int M_; float s;
    __device__ __forceinline__ void fused(f32x4 (&acc)[2][2][4][2], const Unit& u, int wr, int wc, int fr, int fq, PG8_LAS unsigned char* lds, int wid, int lane) const {
        PG8_LAS float* P = (PG8_LAS float*)lds;
        const int row0 = u.pm * BM + wr * 64 + fr; const int col0 = u.pn * BM + wc * 32 + 8 * fq;
#pragma unroll
        for (int ai = 0; ai < 2; ++ai)
#pragma unroll
            for (int m = 0; m < 4; ++m) { const int row = row0 + ai * HALF + m * 16; float q = 0.f;
#pragma unroll
                for (int bj = 0; bj < 2; ++bj) { float* hp = H + (size_t)row * 1024 + col0 + bj * HALF;
                    const f32x4 h0 = *(const f32x4*)hp + acc[ai][bj][m][0] * s, h1 = *(const f32x4*)(hp + 4) + acc[ai][bj][m][1] * s;
                    *(f32x4*)hp = h0; *(f32x4*)(hp + 4) = h1;
                    q += (h0[0] * h0[0] + h0[1] * h0[1]) + (h0[2] * h0[2] + h0[3] * h0[3]) + (h1[0] * h1[0] + h1[1] * h1[1]) + (h1[2] * h1[2] + h1[3] * h1[3]);
                    u32x4 w; w.x = cvt_pk_bf16(h0[0], h0[1]); w.y = cvt_pk_bf16(h0[2], h0[3]); w.z = cvt_pk_bf16(h1[0], h1[1]); w.w = cvt_pk_bf16(h1[2], h1[3]);
                    *(u32x4*)(HB + (size_t)row * 1024 + col0 + bj * HALF) = w; }
                q += __shfl_xor(q, 16); q += __shfl_xor(q, 32);
                if (fq == 0) P[(ai * HALF + wr * 64 + m * 16 + fr) * 4 + wc] = q; }
        asm volatile("s_waitcnt lgkmcnt(0)" ::: "memory"); __builtin_amdgcn_s_barrier(); asm volatile("" ::: "memory");
        const int t = wid * 64 + lane;
        if (t < 256) { const float q = (P[t * 4 + 0] + P[t * 4 + 1]) + (P[t * 4 + 2] + P[t * 4 + 3]); ssq[(size_t)u.pn * M_ + u.pm * BM + t] = q; }
        asm volatile("s_waitcnt lgkmcnt(0)" ::: "memory"); __builtin_amdgcn_s_barrier(); asm volatile("" ::: "memory");
    }
};
template <class Epi, class Sched, bool ALIGN_EPI = false, bool SP2 = false>
__device__ __forceinline__ void gemm_phase(PG8_LAS unsigned char* lds, const Gemm g, const Sched& S, const Epi& E) {
    int tid_ = threadIdx.x; asm volatile("" : "+v"(tid_)); const int tid = tid_, wid = __builtin_amdgcn_readfirstlane(tid >> 6), lane = tid & 63, wr = wid >> 2, wc = wid & 3, fr = lane & 15, fq = lane >> 4;
    const int K = g.K, nt = K / BK;
    unsigned voffA[2], voffB[2];
#pragma unroll
    for (int i = 0; i < 2; ++i) { int R, C; stage_rc(tid * 16 + i * 8192, R, C); const int Rb = Epi::PERM ? ((R & ~31) + perm32(R & 31)) : R;
        voffA[i] = (unsigned)(R * g.lda + C) * 2u; voffB[i] = (unsigned)(Rb * K + C) * 2u; }
    const size_t kstep = (size_t)(BK * 2);
    const size_t hstep = (size_t)HALF * K * 2;
    const size_t tstep = 2 * hstep; const size_t hstepA = (size_t)HALF * g.lda * 2, tstepA = 2 * hstepA;
    const unsigned ldsw = (unsigned)wid * 1024u;
    const int aoff = lds_byte(wr * 64 + fr, fq * 8), boff = lds_byte(wc * 32 + fr, fq * 8);
#define PG8_SA(b, h) (((b) * 2 + (h)) * HTB)
#define PG8_SB(b, h) ((4 + (b) * 2 + (h)) * HTB)
#define PG8_STAGE(bufoff, gbase, voff) do { _Pragma("unroll") for (int _i = 0; _i < 2; ++_i) \
        __builtin_amdgcn_global_load_lds((const unsigned*)((const char*)(gbase) + (voff)[_i]), (PG8_LAS unsigned*)(lds + (bufoff) + ldsw + _i * 8192), 16, 0, 0); } while (0)
#define PG8_LDA(dst, b, h) do { _Pragma("unroll") for (int m = 0; m < 4; ++m) _Pragma("unroll") for (int k = 0; k < 2; ++k) dst[m][k] = *(const PG8_LAS bf16x8*)(lds + PG8_SA(b, h) + aoff + m * 2048 + k * 1024); } while (0)
#define PG8_LDB(dst, b, h) do { _Pragma("unroll") for (int n = 0; n < 2; ++n) _Pragma("unroll") for (int k = 0; k < 2; ++k) dst[n][k] = *(const PG8_LAS bf16x8*)(lds + PG8_SB(b, h) + boff + n * 2048 + k * 1024); } while (0)
#define PG8_MMA(ai, bj, At, Bt) do { __builtin_amdgcn_s_setprio(1); _Pragma("unroll") for (int m = 0; m < 4; ++m) _Pragma("unroll") for (int n = 0; n < 2; ++n) _Pragma("unroll") for (int k = 0; k < 2; ++k) \
        acc[ai][bj][m][n] = __builtin_amdgcn_mfma_f32_16x16x32_bf16(Bt[n][k], At[m][k], acc[ai][bj][m][n], 0, 0, 0); __builtin_amdgcn_s_setprio(0); } while (0)
#define PG8_WAIT_V(n) asm volatile("s_waitcnt vmcnt(" #n ")" ::: "memory")
#define PG8_WAIT_L(n) asm volatile("s_waitcnt lgkmcnt(" #n ")" ::: "memory")
#define PG8_BAR __builtin_amdgcn_s_barrier()
#define PG8_SCHED __builtin_amdgcn_sched_barrier(0)
    Unit cur, nxt; int ui = 0;
    if (!S.next(0, cur)) return;
    f32x4 acc[2][2][4][2];
#pragma unroll
    for (int a = 0; a < 2; ++a)
#pragma unroll
        for (int b = 0; b < 2; ++b)
#pragma unroll
            for (int m = 0; m < 4; ++m)
#pragma unroll
                for (int n = 0; n < 2; ++n) acc[a][b][m][n] = (f32x4){0.f, 0.f, 0.f, 0.f};
    bf16x8 At[4][2], B0[2][2], B1[2][2];
    const char* cA = (const char*)g.A + (size_t)cur.pm * tstepA + S.a_off(cur); const char* cB = (const char*)g.Bt + (size_t)S.b_tile(cur) * tstep;
    S.a_ready(cur);
    if constexpr (SP2) {
        PG8_STAGE(PG8_SB(0, 0), cB, voffB); PG8_STAGE(PG8_SB(0, 1), cB + hstep, voffB); PG8_STAGE(PG8_SA(0, 0), cA, voffA); PG8_STAGE(PG8_SA(0, 1), cA + hstepA, voffA);
        if (wr == 1) PG8_BAR;
        PG8_WAIT_V(2); PG8_BAR;
        PG8_STAGE(PG8_SB(1, 0), cB + kstep, voffB); PG8_STAGE(PG8_SA(1, 0), cA + kstep, voffA); PG8_STAGE(PG8_SB(1, 1), cB + hstep + kstep, voffB);
        PG8_WAIT_V(6); PG8_BAR;
    } else {
        PG8_STAGE(PG8_SB(0, 0), cB, voffB); PG8_STAGE(PG8_SA(0, 0), cA, voffA); PG8_STAGE(PG8_SB(0, 1), cB + hstep, voffB); PG8_STAGE(PG8_SA(0, 1), cA + hstepA, voffA);
        if (wr == 1) PG8_BAR;
        PG8_WAIT_V(4); PG8_BAR;
        PG8_STAGE(PG8_SB(1, 0), cB + kstep, voffB); PG8_STAGE(PG8_SA(1, 0), cA + kstep, voffA); PG8_STAGE(PG8_SB(1, 1), cB + hstep + kstep, voffB);
        PG8_WAIT_V(6); PG8_BAR;
    }
    for (;;) {
        const bool has_next = S.next(ui + 1, nxt);
        const char* nA = has_next ? (const char*)g.A + (size_t)nxt.pm * tstepA + S.a_off(nxt) : cA; const char* nB = has_next ? (const char*)g.Bt + (size_t)S.b_tile(nxt) * tstep : cB;
        for (int t = 0; t < nt; t += 2) {
            const bool last = (t == nt - 2);
            const char* a1 = cA + (size_t)(t + 1) * kstep;
            const char* a2 = last ? nA : cA + (size_t)(t + 2) * kstep; const char* b2 = last ? nB : cB + (size_t)(t + 2) * kstep;
            const char* a3 = a2 + kstep; const char* b3 = b2 + kstep;
            if (last && has_next) S.a_ready(nxt);
            if constexpr (SP2) {
            PG8_LDB(B0, 0, 0); PG8_LDB(B1, 0, 1); PG8_SCHED; PG8_LDA(At, 0, 0); PG8_STAGE(PG8_SA(1, 1), a1 + hstepA, voffA);
            PG8_WAIT_V(8); PG8_WAIT_L(0); PG8_BAR; PG8_MMA(0, 0, At, B0); PG8_MMA(0, 1, At, B1); PG8_BAR; PG8_SCHED;
            PG8_LDA(At, 0, 1); PG8_STAGE(PG8_SB(0, 0), b2, voffB); PG8_STAGE(PG8_SB(0, 1), b2 + hstep, voffB); PG8_STAGE(PG8_SA(0, 0), a2, voffA);
            PG8_WAIT_V(8); PG8_WAIT_L(0); PG8_BAR; PG8_MMA(1, 0, At, B0); PG8_MMA(1, 1, At, B1); PG8_BAR; PG8_SCHED;
            PG8_LDB(B0, 1, 0); PG8_LDB(B1, 1, 1); PG8_SCHED; PG8_LDA(At, 1, 0); PG8_STAGE(PG8_SA(0, 1), a2 + hstepA, voffA);
            PG8_WAIT_V(8); PG8_WAIT_L(0); PG8_BAR; PG8_MMA(0, 0, At, B0); PG8_MMA(0, 1, At, B1); PG8_BAR; PG8_SCHED;
            PG8_LDA(At, 1, 1); PG8_STAGE(PG8_SB(1, 0), b3, voffB); PG8_STAGE(PG8_SB(1, 1), b3 + hstep, voffB); PG8_STAGE(PG8_SA(1, 0), a3, voffA);
            PG8_WAIT_V(8); PG8_WAIT_L(0); PG8_BAR; PG8_MMA(1, 0, At, B0); PG8_MMA(1, 1, At, B1); PG8_BAR; PG8_SCHED;
            } else {
            PG8_LDB(B0, 0, 0); PG8_SCHED; PG8_LDA(At, 0, 0); PG8_STAGE(PG8_SA(1, 1), a1 + hstepA, voffA);
            PG8_WAIT_L(8); PG8_BAR; PG8_WAIT_L(0); PG8_MMA(0, 0, At, B0); PG8_BAR; PG8_SCHED;
            PG8_LDB(B1, 0, 1); PG8_STAGE(PG8_SB(0, 0), b2, voffB);
            PG8_BAR; PG8_WAIT_L(0); PG8_MMA(0, 1, At, B1); PG8_BAR;
            PG8_LDA(At, 0, 1); PG8_STAGE(PG8_SA(0, 0), a2, voffA);
            PG8_BAR; PG8_WAIT_L(0); PG8_MMA(1, 0, At, B0); PG8_BAR; PG8_SCHED;
            PG8_STAGE(PG8_SB(0, 1), b2 + hstep, voffB);
            PG8_WAIT_V(6); PG8_BAR; PG8_MMA(1, 1, At, B1); PG8_BAR;
            PG8_LDB(B0, 1, 0); PG8_SCHED; PG8_LDA(At, 1, 0); PG8_STAGE(PG8_SA(0, 1), a2 + hstepA, voffA);
            PG8_WAIT_L(8); PG8_BAR; PG8_WAIT_L(0); PG8_MMA(0, 0, At, B0); PG8_BAR; PG8_SCHED;
            PG8_LDB(B1, 1, 1); PG8_STAGE(PG8_SB(1, 0), b3, voffB);
            PG8_BAR; PG8_WAIT_L(0); PG8_MMA(0, 1, At, B1); PG8_BAR;
            PG8_LDA(At, 1, 1); PG8_STAGE(PG8_SA(1, 0), a3, voffA);
            PG8_BAR; PG8_WAIT_L(0); PG8_MMA(1, 0, At, B0); PG8_BAR; PG8_SCHED;
            PG8_STAGE(PG8_SB(1, 1), b3 + hstep, voffB);
            PG8_WAIT_V(6); PG8_BAR; PG8_MMA(1, 1, At, B1); PG8_BAR;
            }
        }
        if constexpr (ALIGN_EPI) { if (wr == 0) PG8_BAR; }
        if constexpr (!Epi::AFTER_DRAIN) { E(acc, cur, wr, wc, fr, fq); S.done(cur); }
        if (!has_next) break;
#pragma unroll
        for (int a = 0; a < 2; ++a)
#pragma unroll
            for (int b = 0; b < 2; ++b)
#pragma unroll
                for (int m = 0; m < 4; ++m)
#pragma unroll
                    for (int n = 0; n < 2; ++n) acc[a][b][m][n] = (f32x4){0.f, 0.f, 0.f, 0.f};
        cur = nxt; cA = nA; cB = nB; ++ui;
        if constexpr (ALIGN_EPI) { if (wr == 1) PG8_BAR; }
    }
    PG8_WAIT_V(0);
    if constexpr (!ALIGN_EPI) { if (wr == 0) PG8_BAR; }
    PG8_BAR;
    if constexpr (Epi::AFTER_DRAIN) { E.fused(acc, cur, wr, wc, fr, fq, lds, wid, lane); S.done(cur); }
#undef PG8_SA
#undef PG8_SB
#undef PG8_STAGE
#undef PG8_LDA
#undef PG8_LDB
#undef PG8_MMA
#undef PG8_WAIT_V
#undef PG8_WAIT_L
#undef PG8_BAR
#undef PG8_SCHED
}
}

constexpr int NWAVES = 8, NTHR = 512;
constexpr int M = 16384, SEQ = 8192, D = 1024, FF = 2816, NL = 4, NCH = 128  , NBC = 256  ;
constexpr int NPM = 6656;
constexpr int NWIN = 10752;
constexpr int C_DAQ = 0, C_DAK = 512, C_DAV = 1024, C_GQ = 1536, C_GK = 1792, C_GV = 2048, C_GOG = 2560, C_SZ = 3072, C_SX = 3584, C_SB = 4096, C_SC = 4352,
              C_RR = 4608, C_RK = 5120, C_RV = 5632, C_RWL = 6144, C_RAL = 6208, C_RGL = 6272, C_GLR = 6400, C_SDT = 6416;
constexpr float EPS = 1e-6f, LOG2E = 1.4426950408889634f;

constexpr size_t MiB = 1u << 20;
constexpr size_t WS_CTL = 0, CTL_ZERO_BYTES = 1 * MiB;
constexpr size_t WS_COS = 1 * MiB, WS_SIN = 2 * MiB, WS_SSQ = 3 * MiB, WS_GLAST = 3 * MiB + 512 * 1024, WS_SDT = 4 * MiB, WS_SACUM = 4 * MiB + 512 * 1024, WS_SCDEC = 5 * MiB;
constexpr size_t WS_WGU1 = 8 * MiB, WS_WD1 = 19 * MiB, WS_WIN = 24 * MiB + 512 * 1024, WS_WB = 45 * MiB + 512 * 1024, WS_WO = 49 * MiB + 512 * 1024, WS_WGU2 = 51 * MiB + 512 * 1024, WS_WD2 = 62 * MiB + 512 * 1024;
constexpr size_t WS_HB = 68 * MiB, WS_P = 100 * MiB, WS_PG = 100 * MiB, WS_YS = 308 * MiB, WS_R1 = 372 * MiB, WS_R2 = 500 * MiB, WS_END = 644 * MiB;
constexpr size_t WS_ACT = WS_R1, WS_MERGED = WS_R1;
constexpr size_t WS_RWW = WS_R1, WS_RWR = WS_R1 + 32 * MiB, WS_RWK = WS_R1 + 48 * MiB, WS_RWV = WS_R1 + 64 * MiB, WS_RWKK = WS_R1 + 80 * MiB, WS_RWB = WS_R1 + 96 * MiB, WS_RWG = WS_R1 + 112 * MiB;
constexpr size_t WS_VT = WS_R2, WS_GKV = WS_R2 + 16 * MiB, WS_SST = WS_R2 + 48 * MiB, WS_RWY = WS_R2 + 112 * MiB;
static_assert(WS_WD2 + (size_t)D * FF * 2 <= WS_HB && WS_P + (size_t)M * NPM * 2 <= WS_YS && WS_RWY + (size_t)M * 512 * 2 <= WS_END, "d_ws map");
constexpr int CW_BAR = 4096;

constexpr int RING_BYTES = 131072, LDSCTL_OFF = RING_BYTES, MISC_OFF = LDSCTL_OFF + 320, LDS_BYTES = 147456;

#define GAS __attribute__((address_space(1)))
#define LAS __attribute__((address_space(3)))
typedef unsigned short bf16;
typedef unsigned v4u __attribute__((ext_vector_type(4)));
typedef float f32x4 __attribute__((ext_vector_type(4)));
typedef short bf16x8 __attribute__((ext_vector_type(8)));
typedef GAS unsigned gu32;
typedef GAS unsigned long long gu64;
#define RLX_AGENT __ATOMIC_RELAXED, __HIP_MEMORY_SCOPE_AGENT
#define LDS_WAIT() asm volatile("s_waitcnt lgkmcnt(0)" ::: "memory")
#define VM_WAIT() asm volatile("s_waitcnt vmcnt(0)" ::: "memory")
__device__ __forceinline__ unsigned long long rt() { return __builtin_amdgcn_s_memrealtime(); }
__device__ __forceinline__ unsigned f2bf(float f) { unsigned u = __builtin_bit_cast(unsigned, f); return (u + 0x7fffu + ((u >> 16) & 1u)) >> 16; }
__device__ __forceinline__ unsigned pk2(float lo, float hi) { return f2bf(lo) | (f2bf(hi) << 16); }

#define XB_TMO      128
#define XB_XCNT(j)  (256  + 64 * (j))
#define XB_XSUB(j)  (1280 + 64 * (j))
#define XB_XGEN(j)  (2304 + 64 * (j))
#define XB_TOP      3328
#define XB_TOPGEN   3392
#define XCD_BAR_WORDS 3456
#define XB_SPIN_CAP (1u << 18)

__device__ __forceinline__ unsigned xb_ld(unsigned* p)              { return __hip_atomic_load(p, __ATOMIC_RELAXED, __HIP_MEMORY_SCOPE_AGENT); }
__device__ __forceinline__ unsigned xb_add(unsigned* p, unsigned v) { return __hip_atomic_fetch_add(p, v, __ATOMIC_RELAXED, __HIP_MEMORY_SCOPE_AGENT); }
__device__ __forceinline__ unsigned xb_xcc_id() { return (unsigned)__builtin_amdgcn_s_getreg((3 << 11) | 20) & 0xFu; }
#define XB_SPIN(cond, bar) do { unsigned _sp = 0; while (cond) { __builtin_amdgcn_s_sleep(1); \
    if ((++_sp & 255u) == 0u) { if (xb_ld(&(bar)[XB_TMO])) break; if (_sp > XB_SPIN_CAP) { atomicAdd(&(bar)[XB_TMO], 1u); break; } } } } while (0)

struct XcdBarrier {
    unsigned* bar; unsigned x;
    volatile LAS unsigned* st;
};

__device__ __forceinline__ XcdBarrier xcd_barrier_post(unsigned* bar, volatile LAS unsigned* st) {
    XcdBarrier b; b.bar = bar; b.x = xb_xcc_id(); b.st = st;
    if (threadIdx.x == 0) (void)xb_add(&bar[XB_XCNT(b.x)], 1u);
    return b;
}
__device__ __forceinline__ void xcd_barrier_complete(unsigned* bar, unsigned x, unsigned& nloc, unsigned& nx) {
    const unsigned G = gridDim.x * gridDim.y * gridDim.z;
    unsigned sum, cnt, mine, sp = 0u;
    for (;;) {
        sum = 0u; cnt = 0u; mine = 0u;
#pragma unroll
        for (unsigned j = 0; j < 16; ++j) { const unsigned c = xb_ld(&bar[XB_XCNT(j)]); sum += c; cnt += (c > 0u) ? 1u : 0u; mine = (j == x) ? c : mine; }
        if (sum == G) break;
        __builtin_amdgcn_s_sleep(1);
        if ((++sp & 255u) == 0u) { if (xb_ld(&bar[XB_TMO])) break; if (sp > XB_SPIN_CAP) { atomicAdd(&bar[XB_TMO], 1u); break; } }
    }
    nloc = mine > 0u ? mine : 1u; nx = cnt > 0u ? cnt : 1u;
}

__device__ __forceinline__ void xcd_barrier(const XcdBarrier& b) {
    asm volatile("s_waitcnt vmcnt(0)" ::: "memory");
    __syncthreads();
    if (threadIdx.x == 0) {
        unsigned* bar = b.bar;
        __builtin_amdgcn_s_waitcnt(0);
        unsigned nloc = b.st[0], nx = b.st[1];
        if (nloc == 0u) { xcd_barrier_complete(bar, b.x, nloc, nx); b.st[0] = nloc; b.st[1] = nx; }
        const unsigned old = xb_add(&bar[XB_XSUB(b.x)], 1u);
        const unsigned gen = old / nloc;
        if (old + 1u == (gen + 1u) * nloc) {
            __builtin_amdgcn_fence(__ATOMIC_RELEASE, "agent");
            asm volatile("s_waitcnt vmcnt(0)" ::: "memory");
            const unsigned og = xb_add(&bar[XB_TOP], 1u);
            const unsigned tg = og / nx;
            if (og + 1u == (tg + 1u) * nx) xb_add(&bar[XB_TOPGEN], 1u);
            else XB_SPIN(xb_ld(&bar[XB_TOPGEN]) == tg, bar);
            __builtin_amdgcn_fence(__ATOMIC_ACQUIRE, "agent");
            xb_add(&bar[XB_XGEN(b.x)], 1u);
            asm volatile("s_waitcnt vmcnt(0)" ::: "memory");
        } else {
            XB_SPIN(xb_ld(&bar[XB_XGEN(b.x)]) == gen, bar);
            __builtin_amdgcn_fence(__ATOMIC_ACQUIRE, "agent");
            asm volatile("s_waitcnt vmcnt(0)" ::: "memory");
        }
    }
    __syncthreads();
}

struct Args { const float* in[40]; float* out; unsigned char* ws; float inv_freq[32]; int g_lo, g_hi; };
typedef const __attribute__((address_space(4))) Args* ArgsP;
typedef LAS float* LF; typedef const LAS float* CLF;
#ifndef PH_FN
#define PH_FN __device__ __noinline__
#endif
#ifndef PH_HEAVY
#define PH_HEAVY __device__ __forceinline__
#endif
struct Ctx {
    LAS unsigned char* lds;
    unsigned char* ws; float* h;
    int tid, lane, wave, bid, G;
};
typedef unsigned u32x4 __attribute__((ext_vector_type(4)));
typedef unsigned u32x2 __attribute__((ext_vector_type(2)));
typedef float f32x2 __attribute__((ext_vector_type(2)));
typedef float f32x16 __attribute__((ext_vector_type(16)));
__device__ __forceinline__ float bf2f(bf16 x) { return __uint_as_float((unsigned)x << 16); }
__device__ __forceinline__ float bflo(unsigned w) { return __uint_as_float(w << 16); }
__device__ __forceinline__ float bfhi(unsigned w) { return __uint_as_float(w & 0xffff0000u); }
__device__ __forceinline__ void unpack8(const u32x4 w, float* o) { o[0] = bflo(w.x); o[1] = bfhi(w.x); o[2] = bflo(w.y); o[3] = bfhi(w.y); o[4] = bflo(w.z); o[5] = bfhi(w.z); o[6] = bflo(w.w); o[7] = bfhi(w.w); }
__device__ __forceinline__ u32x4 pack8(const float* o) { u32x4 w; w.x = pk2(o[0], o[1]); w.y = pk2(o[2], o[3]); w.z = pk2(o[4], o[5]); w.w = pk2(o[6], o[7]); return w; }
__device__ __forceinline__ float sigmoidf_(float x) { return 1.0f / (1.0f + __expf(-x)); }
__device__ __forceinline__ float siluf_(float x) { return x * sigmoidf_(x); }
__device__ __forceinline__ float softplusf_(float x) { return fmaxf(x, 0.f) + log1pf(__expf(-fabsf(x))); }
__device__ __forceinline__ float logsigmoidf_(float x) { return fminf(x, 0.f) - log1pf(__expf(-fabsf(x))); }
__device__ __forceinline__ float wave_sum(float v) {
#pragma unroll
    for (int o = 1; o < 64; o <<= 1) v += __shfl_xor(v, o);
    return v;
}
#define WG_SYNC() __syncthreads()
__device__ __forceinline__ Ctx fresh(const Ctx& C0) { Ctx C = C0; int t = threadIdx.x; asm volatile("" : "+v"(t)); C.tid = t; C.lane = t & 63; C.wave = __builtin_amdgcn_readfirstlane(t >> 6); return C; }

PH_FN void ph_prologue(const Ctx C, ArgsP a) {
    float* cosT = (float*)(C.ws + WS_COS); float* sinT = (float*)(C.ws + WS_SIN);
    for (int idx = C.bid * NTHR + C.tid; idx < SEQ * 32; idx += C.G * NTHR) {
        const int t = idx >> 5, j = idx & 31;
        const float ang = (float)t * a->inv_freq[j];
        const double rev = (double)ang * 0.15915494309189535;
        const float fr = (float)(rev - floor(rev));
        cosT[idx] = __builtin_amdgcn_cosf(fr); sinT[idx] = __builtin_amdgcn_sinf(fr);
    }
    const float* x = a->in[0]; bf16* hb = (bf16*)(C.ws + WS_HB); float* ssq = (float*)(C.ws + WS_SSQ);
    const int gw = C.bid * NWAVES + C.wave, NGW = C.G * NWAVES;
    for (int m = gw; m < M; m += NGW) {
        const f32x4* xr = (const f32x4*)(x + (size_t)m * D) + C.lane; f32x4* hr = (f32x4*)(C.h + (size_t)m * D) + C.lane;
        unsigned long long* o8 = (unsigned long long*)(hb + (size_t)m * D) + C.lane;
        float s = 0.f;
#pragma unroll
        for (int j = 0; j < 4; ++j) { const f32x4 v = xr[64 * j]; hr[64 * j] = v; s += (v.x * v.x + v.y * v.y) + (v.z * v.z + v.w * v.w);
            o8[64 * j] = (unsigned long long)pk2(v.x, v.y) | ((unsigned long long)pk2(v.z, v.w) << 32); }
        s = wave_sum(s);
        if (C.lane == 0) { ssq[m] = s; ssq[M + m] = 0.f; ssq[2 * M + m] = 0.f; ssq[3 * M + m] = 0.f; }
    }
}

template <class SrcF>
__device__ __forceinline__ void tr_item(const SrcF src, const float* gk, bf16* WT, int K, int kb, int nb, LF scr, int lane) {
    const int k0 = 64 * kb, n0 = 32 * nb;
    const int ld = src.ld(); const long co = src.col(n0 + (lane & 31)); const bool ok = co >= 0; const float* colp = src.base(n0 + (lane & 31)) + (ok ? co : 0);
#pragma unroll 8
    for (int i = 0; i < 32; ++i) { const int kk = 2 * i + (lane >> 5); float v = 0.f; if (ok) { v = colp[(size_t)(k0 + kk) * ld]; if (gk) v *= gk[k0 + kk]; } scr[kk * 33 + (lane & 31)] = v; }
    LDS_WAIT(); asm volatile("" ::: "memory");
    const int c = lane & 7;
#pragma unroll
    for (int j = 0; j < 4; ++j) { const int n = (lane >> 3) + 8 * j; CLF s = scr + (8 * c) * 33 + n;
        v4u o; o.x = pk2(s[0 * 33], s[1 * 33]); o.y = pk2(s[2 * 33], s[3 * 33]); o.z = pk2(s[4 * 33], s[5 * 33]); o.w = pk2(s[6 * 33], s[7 * 33]);
        *(v4u*)(WT + (size_t)(n0 + n) * K + k0 + 8 * c) = o; }
    LDS_WAIT(); asm volatile("" ::: "memory");
}
struct SrcGU { const float* wg; const float* wu;
    __device__ __forceinline__ int ld() const { return FF; }
    __device__ __forceinline__ const float* base(int n) const { const uintptr_t sel = (uintptr_t)((n >> 7) & 1); return (const float*)((uintptr_t)wg + sel * ((uintptr_t)wu - (uintptr_t)wg)); }
    __device__ __forceinline__ long col(int n) const { return 128 * (n >> 8) + (n & 127); } };
struct SrcPlain { const float* w; int ldw;
    __device__ __forceinline__ int ld() const { return ldw; }
    __device__ __forceinline__ const float* base(int) const { return w; }
    __device__ __forceinline__ long col(int n) const { return n; } };
struct SrcWin { const float* w;
    __device__ __forceinline__ int ld() const { return 10520; }
    __device__ __forceinline__ const float* base(int) const { return w; }
    __device__ __forceinline__ long col(int n) const {
        int c;
        if (n < 3072) c = n; else if (n < 4608) c = n - 3072 + 3088; else if (n < 6400) c = n - 4608 + 4632; else if (n < 6416) c = n - 6400 + 3072; else if (n < 6424) c = n - 6416 + 4624; else if (n < 6656) c = -1; else c = n - 6656 + 6424;
        return c; } };
PH_FN void ph_weights(const Ctx C, ArgsP a, int l) {
    LF scr = (LF)(C.lds + C.wave * 16384);
    const int gw = C.bid * NWAVES + C.wave, NGW = C.G * NWAVES;
#pragma unroll 1
    for (int f = 0; f < 2; ++f) {
        const float* nrm = a->in[f ? 35 : 1] + (size_t)l * D; const float* wg = a->in[f ? 36 : 2] + (size_t)l * D * FF; const float* wu = a->in[f ? 37 : 3] + (size_t)l * D * FF; const float* wd = a->in[f ? 38 : 4] + (size_t)l * FF * D;
        bf16* Wgu = (bf16*)(C.ws + (f ? WS_WGU2 : WS_WGU1)); bf16* Wd = (bf16*)(C.ws + (f ? WS_WD2 : WS_WD1));
        const SrcGU sgu{wg, wu};
        for (int it = gw; it < (D / 64) * (2 * FF / 32); it += NGW) tr_item(sgu, nrm, Wgu, D, it / (2 * FF / 32), it % (2 * FF / 32), scr, C.lane);
        const SrcPlain sd{wd, D};
        for (int it = gw; it < (FF / 64) * (D / 32); it += NGW) tr_item(sd, nullptr, Wd, FF, it / (D / 32), it % (D / 32), scr, C.lane);
    }
    { const SrcWin sw{a->in[6] + (size_t)l * D * 10520}; const float* nrm = a->in[5] + (size_t)l * D; bf16* Win = (bf16*)(C.ws + WS_WIN);
      for (int it = gw; it < (D / 64) * (NWIN / 32); it += NGW) tr_item(sw, nrm, Win, D, it / (NWIN / 32), it % (NWIN / 32), scr, C.lane); }
    { bf16* Wb = (bf16*)(C.ws + WS_WB);
      for (int it = gw; it < 4 * (512 / 64) * (D / 32); it += NGW) { const int z = it / ((512 / 64) * (D / 32)), r = it % ((512 / 64) * (D / 32));
          const SrcPlain sb{a->in[32] + ((size_t)l * 4 + z) * 512 * D, D}; tr_item(sb, nullptr, Wb + (size_t)z * D * 512, 512, r / (D / 32), r % (D / 32), scr, C.lane); } }
    { const SrcPlain so{a->in[34] + (size_t)l * D * D, D}; bf16* Wo = (bf16*)(C.ws + WS_WO);
      for (int it = gw; it < (D / 64) * (D / 32); it += NGW) tr_item(so, nullptr, Wo, D, it / (D / 32), it % (D / 32), scr, C.lane); }
}

PH_FN void ph_da_prep(const Ctx C) {
    bf16* P = (bf16*)(C.ws + WS_P); const float* cosT = (const float*)(C.ws + WS_COS); const float* sinT = (const float*)(C.ws + WS_SIN);
    const int gw = C.bid * NWAVES + C.wave, NGW = C.G * NWAVES;
    const int hc = C.lane >> 2, ch = C.lane & 3;
    const float sc = (hc < 8) ? 0.125f * LOG2E : 1.0f;
    for (int m = gw; m < M; m += NGW) {
        const int t = m & (SEQ - 1);
        bf16* p1 = P + (size_t)m * NPM + hc * 64 + ch * 8; bf16* p2 = p1 + 32;
        float x1[8], x2[8], o1[8], o2[8];
        unpack8(*(const u32x4*)p1, x1); unpack8(*(const u32x4*)p2, x2);
        const float* cp = cosT + t * 32 + ch * 8; const float* sp = sinT + t * 32 + ch * 8;
#pragma unroll
        for (int i = 0; i < 8; ++i) { const float c = cp[i], s = sp[i]; o1[i] = (x1[i] * c - x2[i] * s) * sc; o2[i] = (x2[i] * c + x1[i] * s) * sc; }
        *(u32x4*)p1 = pack8(o1); *(u32x4*)p2 = pack8(o2);
    }
    bf16* VT = (bf16*)(C.ws + WS_VT); LAS bf16* tile = (LAS bf16*)C.lds;
    for (int it = C.bid; it < 2 * NCH * 4; it += C.G) {
        const int h = it & 3, bc = it >> 2, b = bc >> 7, tb = bc & 127; const size_t row0 = (size_t)bc * 64;
        WG_SYNC();
#pragma unroll
        for (int i = 0; i < 2; ++i) { const int q = C.tid + NTHR * i, t = q >> 4, c16 = q & 15;
            *(LAS u32x4*)(tile + t * 136 + c16 * 8) = *(const u32x4*)(P + (row0 + t) * NPM + C_DAV + h * 128 + c16 * 8); }
        WG_SYNC();
#pragma unroll
        for (int i = 0; i < 2; ++i) { const int q = C.tid + NTHR * i, d = q >> 3, tc = q & 7; unsigned w[4];
#pragma unroll
            for (int e = 0; e < 4; ++e) w[e] = (unsigned)tile[(8 * tc + 2 * e) * 136 + d] | ((unsigned)tile[(8 * tc + 2 * e + 1) * 136 + d] << 16);
            u32x4 o; o.x = w[0]; o.y = w[1]; o.z = w[2]; o.w = w[3];
            *(u32x4*)(VT + ((size_t)(b * 4 + h) * 128 + d) * SEQ + tb * 64 + 8 * tc) = o; }
    }
    WG_SYNC();
}

typedef LAS bf16* LB; typedef const LAS bf16* CLB;
__device__ __forceinline__ pg8::bf16x8 frag32(CLB X, int ld, int row0, int k0, int lane) { return *(const LAS pg8::bf16x8*)(X + (row0 + (lane & 31)) * ld + k0 + 8 * (lane >> 5)); }
template <int K> __device__ __forceinline__ void mma_nt(f32x16& acc, CLB A, int lda, int m0, CLB Bt, int ldb, int n0, int lane) {
#pragma unroll
    for (int k = 0; k < K; k += 16) acc = __builtin_amdgcn_mfma_f32_32x32x16_bf16(frag32(A, lda, m0, k, lane), frag32(Bt, ldb, n0, k, lane), acc, 0, 0, 0);
}
__device__ __forceinline__ int crow(int r, int hi) { return (r & 3) + 8 * (r >> 2) + 4 * hi; }
__device__ __forceinline__ f32x16 zero16() { f32x16 z;
#pragma unroll
    for (int r = 0; r < 16; ++r) z[r] = 0.f;
    return z; }

__device__ __forceinline__ void gla_compute_G(const Ctx& C, ArgsP a, int l, int bc, int h, LF Gs) {
    const bf16* P = (const bf16*)(C.ws + WS_P); const float* W2 = a->in[12] + (size_t)l * 16 * 256; const float* gb = a->in[13] + (size_t)l * 256;
    const int t = C.tid >> 3, kg = C.tid & 7; const size_t row = (size_t)bc * 64 + t;
    float glr[16]; unpack8(*(const u32x4*)(P + row * NPM + C_GLR), glr); unpack8(*(const u32x4*)(P + row * NPM + C_GLR + 8), glr + 8);
#pragma unroll
    for (int i = 0; i < 8; ++i) { const int k = h * 64 + kg * 8 + i; float x = gb[k];
#pragma unroll
        for (int r = 0; r < 16; ++r) x += glr[r] * W2[r * 256 + k];
        Gs[t * 68 + kg * 8 + i] = logsigmoidf_(x) * (1.0f / 16.0f); }
    WG_SYNC();
    if (C.tid < 64) { float run = 0.f; for (int tt = 0; tt < 64; ++tt) { run += Gs[tt * 68 + C.tid]; Gs[tt * 68 + C.tid] = run; } }
    WG_SYNC();
}
PH_HEAVY void ph_gla_a(const Ctx C, ArgsP a, int l) {
    const bf16* P = (const bf16*)(C.ws + WS_P); float* GKV = (float*)(C.ws + WS_GKV); float* GL = (float*)(C.ws + WS_GLAST);
    LF Gs = (LF)C.lds; LB KDT = (LB)(C.lds + 17408); LB VT = (LB)(C.lds + 26624);
    for (int it = C.bid; it < NBC * 4; it += C.G) {
        const int bc = it >> 2, h = it & 3;
        WG_SYNC();
        gla_compute_G(C, a, l, bc, h, Gs);
        { const int t = C.tid >> 3, g8 = C.tid & 7; const size_t row = (size_t)bc * 64 + t;
          float kf[8]; unpack8(*(const u32x4*)(P + row * NPM + C_GK + h * 64 + g8 * 8), kf);
#pragma unroll
          for (int i = 0; i < 8; ++i) { const int k = g8 * 8 + i; KDT[k * 72 + t] = (bf16)f2bf(kf[i] * __expf(Gs[63 * 68 + k] - Gs[t * 68 + k])); }
          const u32x4 v0 = *(const u32x4*)(P + row * NPM + C_GV + h * 128 + g8 * 16), v1 = *(const u32x4*)(P + row * NPM + C_GV + h * 128 + g8 * 16 + 8);
          const unsigned vw[8] = {v0.x, v0.y, v0.z, v0.w, v1.x, v1.y, v1.z, v1.w};
#pragma unroll
          for (int i = 0; i < 8; ++i) { VT[(g8 * 16 + 2 * i) * 72 + t] = (bf16)(vw[i] & 0xffffu); VT[(g8 * 16 + 2 * i + 1) * 72 + t] = (bf16)(vw[i] >> 16); }
          if (C.tid < 64) GL[(size_t)it * 64 + C.tid] = Gs[63 * 68 + C.tid]; }
        WG_SYNC();
        { const int kt = C.wave >> 2, vt = C.wave & 3, n = C.lane & 31, hi = C.lane >> 5;
          f32x16 acc = zero16(); mma_nt<64>(acc, KDT, 72, 32 * kt, VT, 72, 32 * vt, C.lane);
          float* dst = GKV + ((size_t)it * 128 + 32 * vt + n) * 64 + 32 * kt + 4 * hi;
#pragma unroll
          for (int g = 0; g < 4; ++g) *(f32x4*)(dst + 8 * g) = (f32x4){acc[4 * g], acc[4 * g + 1], acc[4 * g + 2], acc[4 * g + 3]}; }
    }
    WG_SYNC();
}
PH_FN void gla_scan_part(const Ctx C, int part) {
    float* GKV = (float*)(C.ws + WS_GKV); const float* GL = (const float*)(C.ws + WS_GLAST);
    const int e = part * NTHR + C.tid, chain = e >> 13, idx = e & 8191, b = chain >> 2, h = chain & 3, k = idx & 63;
    float st = 0.f;
#pragma unroll 4
    for (int c = 0; c < NCH; ++c) { const size_t item = (size_t)(b * NCH + c) * 4 + h; float* p = GKV + item * 8192 + idx; const float tmp = *p; const float dec = __expf(GL[item * 64 + k]); *p = st; st = dec * st + tmp; }
}
PH_HEAVY void ph_gla_c(const Ctx C, ArgsP a, int l) {
    const bf16* P = (const bf16*)(C.ws + WS_P); const float* GKV = (const float*)(C.ws + WS_GKV); bf16* YS = (bf16*)(C.ws + WS_YS);
    const float* gnorm = a->in[14] + (size_t)l * 128;
    LF Gs = (LF)C.lds; LB QD = (LB)(C.lds + 17408); LB KDR = (LB)(C.lds + 26624); LB QI = (LB)(C.lds + 35840); LB ATT = (LB)(C.lds + 45056); LB VT = (LB)(C.lds + 54272); LB ST = (LB)(C.lds + 72704); LF PS = (LF)(C.lds + 91136);
    for (int it = C.bid; it < NBC * 4; it += C.G) {
        const int bc = it >> 2, h = it & 3;
        WG_SYNC();
        gla_compute_G(C, a, l, bc, h, Gs);
        { const int t = C.tid >> 3, g8 = C.tid & 7; const size_t row = (size_t)bc * 64 + t;
          float qf[8], kf[8], o1[8], o2[8], o3[8];
          unpack8(*(const u32x4*)(P + row * NPM + C_GQ + h * 64 + g8 * 8), qf); unpack8(*(const u32x4*)(P + row * NPM + C_GK + h * 64 + g8 * 8), kf);
#pragma unroll
          for (int i = 0; i < 8; ++i) { const int k = g8 * 8 + i; const float g = Gs[t * 68 + k], d = g - Gs[32 * 68 + k]; o1[i] = qf[i] * 0.125f * __expf(d); o2[i] = kf[i] * __expf(-d); o3[i] = qf[i] * 0.125f * __expf(g); }
          *(LAS u32x4*)(QD + t * 72 + g8 * 8) = pack8(o1); *(LAS u32x4*)(KDR + t * 72 + g8 * 8) = pack8(o2); *(LAS u32x4*)(QI + t * 72 + g8 * 8) = pack8(o3);
          const u32x4 v0 = *(const u32x4*)(P + row * NPM + C_GV + h * 128 + g8 * 16), v1 = *(const u32x4*)(P + row * NPM + C_GV + h * 128 + g8 * 16 + 8);
          const unsigned vw[8] = {v0.x, v0.y, v0.z, v0.w, v1.x, v1.y, v1.z, v1.w};
#pragma unroll
          for (int i = 0; i < 8; ++i) { VT[(g8 * 16 + 2 * i) * 72 + t] = (bf16)(vw[i] & 0xffffu); VT[(g8 * 16 + 2 * i + 1) * 72 + t] = (bf16)(vw[i] >> 16); }
          const int v = C.tid >> 2, kq = (C.tid & 3) * 16; const float* sp = GKV + ((size_t)it * 128 + v) * 64 + kq;
          float s[16];
#pragma unroll
          for (int i = 0; i < 4; ++i) { const f32x4 x = *(const f32x4*)(sp + 4 * i); s[4 * i] = x[0]; s[4 * i + 1] = x[1]; s[4 * i + 2] = x[2]; s[4 * i + 3] = x[3]; }
          *(LAS u32x4*)(ST + v * 72 + kq) = pack8(s); *(LAS u32x4*)(ST + v * 72 + kq + 8) = pack8(s + 8); }
        WG_SYNC();
        const int n = C.lane & 31, hi = C.lane >> 5;
        if (C.wave < 4) {
            const int it_ = C.wave >> 1, jt = C.wave & 1;
            f32x16 acc = zero16();
            if (jt <= it_) mma_nt<64>(acc, QD, 72, 32 * it_, KDR, 72, 32 * jt, C.lane);
#pragma unroll
            for (int r = 0; r < 16; ++r) { const int i = 32 * it_ + crow(r, hi), j = 32 * jt + n; ATT[i * 72 + j] = (bf16)f2bf(j <= i ? acc[r] : 0.f); }
        }
        WG_SYNC();
        {
            const int it_ = C.wave & 1, vt = C.wave >> 1;
            f32x16 acc = zero16();
            mma_nt<64>(acc, VT, 72, 32 * vt, ATT, 72, 32 * it_, C.lane);
            mma_nt<64>(acc, ST, 72, 32 * vt, QI, 72, 32 * it_, C.lane);
            float ss = 0.f;
#pragma unroll
            for (int r = 0; r < 16; ++r) ss += acc[r] * acc[r];
            ss += __shfl_xor(ss, 32);
            if (hi == 0) PS[(32 * it_ + n) * 4 + vt] = ss;
            WG_SYNC();
            const int i = 32 * it_ + n; const float tot = (PS[i * 4] + PS[i * 4 + 1]) + (PS[i * 4 + 2] + PS[i * 4 + 3]);
            const float rs = 1.0f / sqrtf(tot * (1.0f / 128.0f) + EPS); const size_t row = (size_t)bc * 64 + i;
#pragma unroll
            for (int g = 0; g < 4; ++g) { const int v0 = 32 * vt + 8 * g + 4 * hi;
                const u32x2 ogw = *(const u32x2*)(P + row * NPM + C_GOG + h * 128 + v0); const f32x4 gn = *(const f32x4*)(gnorm + v0);
                const float og[4] = {bflo(ogw.x), bfhi(ogw.x), bflo(ogw.y), bfhi(ogw.y)}; float o4[4];
#pragma unroll
                for (int y = 0; y < 4; ++y) o4[y] = acc[4 * g + y] * rs * gn[y] * siluf_(og[y]);
                u32x2 w; w.x = pk2(o4[0], o4[1]); w.y = pk2(o4[2], o4[3]); *(u32x2*)(YS + row * 2048 + 512 + h * 128 + v0) = w; }
        }
    }
    WG_SYNC();
}

__device__ __forceinline__ void ssd_conv8(const bf16* P, const float* cw, const float* cb, int bc, int t, int ch0, float* o) {
    const int pos = (bc & 127) * 64 + t; const size_t row = (size_t)bc * 64 + t;
#pragma unroll
    for (int i = 0; i < 8; ++i) o[i] = cb[ch0 + i];
#pragma unroll
    for (int tap = 0; tap < 4; ++tap) { if (pos - 3 + tap >= 0) { float x[8]; unpack8(*(const u32x4*)(P + (row - 3 + tap) * NPM + C_SX + ch0), x);
#pragma unroll
        for (int i = 0; i < 8; ++i) o[i] += cw[tap * 1024 + ch0 + i] * x[i]; } }
#pragma unroll
    for (int i = 0; i < 8; ++i) o[i] = siluf_(o[i]);
}
PH_HEAVY void ph_ssd_a(const Ctx C, ArgsP a, int l) {
    const bf16* P = (const bf16*)(C.ws + WS_P); float* SST = (float*)(C.ws + WS_SST); float* SDT = (float*)(C.ws + WS_SDT); float* SAC = (float*)(C.ws + WS_SACUM); float* SCD = (float*)(C.ws + WS_SCDEC);
    const float* cw = a->in[15] + (size_t)l * 4 * 1024; const float* cb = a->in[16] + (size_t)l * 1024; const float* dtb = a->in[17] + (size_t)l * 8; const float* alog = a->in[18] + (size_t)l * 8;
    LB BT = (LB)C.lds; LB XDT = (LB)(C.lds + 18432); LF dtv = (LF)(C.lds + 27648); LF acu = (LF)(C.lds + 27904); LF av = (LF)(C.lds + 28160);
    for (int it = C.bid; it < NBC * 2; it += C.G) {
        const int bc = it >> 1, g = it & 1; const int t = C.tid >> 3, cg = C.tid & 7;
        WG_SYNC();
        { float o[8];
#pragma unroll
          for (int half = 0; half < 2; ++half) { ssd_conv8(P, cw, cb, bc, t, 512 + g * 128 + cg * 16 + half * 8, o);
#pragma unroll
              for (int i = 0; i < 8; ++i) BT[(cg * 16 + half * 8 + i) * 72 + t] = (bf16)f2bf(o[i]); } }
#pragma unroll 1
        for (int hh = 0; hh < 4; ++hh) {
            const int hd = 4 * g + hh; const size_t item8 = (size_t)bc * 8 + hd;
            WG_SYNC();
            if (C.tid < 64) { const size_t row = (size_t)bc * 64 + C.tid; const float dt = softplusf_(bf2f(P[row * NPM + C_SDT + hd]) + dtb[hd]); dtv[C.tid] = dt; av[C.tid] = -__expf(alog[hd]) * dt; }
            WG_SYNC();
            if (C.tid < 64) { float s = 0.f; for (int j = 0; j <= C.tid; ++j) s += av[j]; acu[C.tid] = s; const size_t row = (size_t)bc * 64 + C.tid; SDT[row * 8 + hd] = dtv[C.tid]; SAC[row * 8 + hd] = s; if (C.tid == 63) SCD[item8] = __expf(s); }
            WG_SYNC();
            { float o[8]; ssd_conv8(P, cw, cb, bc, t, hd * 64 + cg * 8, o); const float sc = dtv[t] * __expf(acu[63] - acu[t]);
#pragma unroll
              for (int i = 0; i < 8; ++i) XDT[(cg * 8 + i) * 72 + t] = (bf16)f2bf(o[i] * sc); }
            WG_SYNC();
            { const int pt = C.wave >> 2, nt = C.wave & 3, n = C.lane & 31, hi = C.lane >> 5;
              f32x16 acc = zero16(); mma_nt<64>(acc, XDT, 72, 32 * pt, BT, 72, 32 * nt, C.lane);
#pragma unroll
              for (int r = 0; r < 16; ++r) SST[(item8 * 64 + 32 * pt + crow(r, hi)) * 128 + 32 * nt + n] = acc[r]; }
        }
    }
    WG_SYNC();
}
PH_FN void ssd_scan_part(const Ctx C, int part) {
    float* SST = (float*)(C.ws + WS_SST); const float* SCD = (const float*)(C.ws + WS_SCDEC);
    const int e = part * NTHR + C.tid, chain = e >> 13, idx = e & 8191, b = chain >> 3, hd = chain & 7;
    float st = 0.f;
#pragma unroll 4
    for (int c = 0; c < NCH; ++c) { const size_t item = (size_t)(b * NCH + c) * 8 + hd; float* p = SST + item * 8192 + idx; const float tmp = *p; const float dec = SCD[item]; *p = st; st = dec * st + tmp; }
}
PH_HEAVY void ph_ssd_c(const Ctx C, ArgsP a, int l) {
    const bf16* P = (const bf16*)(C.ws + WS_P); const float* SST = (const float*)(C.ws + WS_SST); const float* SDT = (const float*)(C.ws + WS_SDT); const float* SAC = (const float*)(C.ws + WS_SACUM); bf16* YS = (bf16*)(C.ws + WS_YS);
    const float* cw = a->in[15] + (size_t)l * 4 * 1024; const float* cb = a->in[16] + (size_t)l * 1024; const float* dpar = a->in[19] + (size_t)l * 8; const float* snorm = a->in[20] + (size_t)l * 512;
    LB BN = (LB)C.lds; LB CN = (LB)(C.lds + 17408); LF CB = (LF)(C.lds + 34816); LB SC = (LB)(C.lds + 52224); LB XST = (LB)(C.lds + 61440); LB HP = (LB)(C.lds + 70656); LB CE = (LB)(C.lds + 88064);
    LF dtv = (LF)(C.lds + 105472); LF acu = (LF)(C.lds + 105728); LF PSQ = (LF)(C.lds + 105984);
    for (int it = C.bid; it < NBC * 2; it += C.G) {
        const int bc = it >> 1, g = it & 1;
        const int t = C.tid >> 3, cg = C.tid & 7, n = C.lane & 31, hi = C.lane >> 5;
        WG_SYNC();
        { float o[8];
#pragma unroll
          for (int half = 0; half < 2; ++half) {
              ssd_conv8(P, cw, cb, bc, t, 512 + g * 128 + cg * 16 + half * 8, o); *(LAS u32x4*)(BN + t * 136 + cg * 16 + half * 8) = pack8(o);
              ssd_conv8(P, cw, cb, bc, t, 768 + g * 128 + cg * 16 + half * 8, o); *(LAS u32x4*)(CN + t * 136 + cg * 16 + half * 8) = pack8(o); } }
        WG_SYNC();
        if (C.wave < 4) {
            const int it_ = C.wave >> 1, jt = C.wave & 1;
            f32x16 acc = zero16(); mma_nt<128>(acc, CN, 136, 32 * it_, BN, 136, 32 * jt, C.lane);
#pragma unroll
            for (int r = 0; r < 16; ++r) CB[(32 * it_ + crow(r, hi)) * 68 + 32 * jt + n] = acc[r];
        }
        float yk[4][16]; float ssq = 0.f;
        const int pt = (C.wave >> 1) & 1, it2 = C.wave & 1;
#pragma unroll
        for (int hh = 0; hh < 4; ++hh) {
            const int hd = 4 * g + hh; const size_t item8 = (size_t)bc * 8 + hd;
            WG_SYNC();
            if (C.tid < 64) { const size_t row = (size_t)bc * 64 + C.tid; dtv[C.tid] = SDT[row * 8 + hd]; acu[C.tid] = SAC[row * 8 + hd]; }
            { float o[8]; ssd_conv8(P, cw, cb, bc, t, hd * 64 + cg * 8, o);
#pragma unroll
              for (int i = 0; i < 8; ++i) XST[(cg * 8 + i) * 72 + t] = (bf16)f2bf(o[i]);
              const int p = C.tid >> 3, n0 = (C.tid & 7) * 16; const float* sp = SST + (item8 * 64 + p) * 128 + n0; float s[16];
#pragma unroll
              for (int i = 0; i < 4; ++i) { const f32x4 x = *(const f32x4*)(sp + 4 * i); s[4 * i] = x[0]; s[4 * i + 1] = x[1]; s[4 * i + 2] = x[2]; s[4 * i + 3] = x[3]; }
              *(LAS u32x4*)(HP + p * 136 + n0) = pack8(s); *(LAS u32x4*)(HP + p * 136 + n0 + 8) = pack8(s + 8); }
            WG_SYNC();
            { const float ai = acu[t]; float o[8];
#pragma unroll
              for (int jj = 0; jj < 8; ++jj) { const int j = 8 * cg + jj; o[jj] = (j <= t) ? CB[t * 68 + j] * __expf(ai - acu[j]) * dtv[j] : 0.f; }
              *(LAS u32x4*)(SC + t * 72 + 8 * cg) = pack8(o);
              const float ea = __expf(ai); float c8[8];
#pragma unroll
              for (int half = 0; half < 2; ++half) { unpack8(*(const LAS u32x4*)(CN + t * 136 + cg * 16 + half * 8), c8);
#pragma unroll
                  for (int i = 0; i < 8; ++i) c8[i] *= ea;
                  *(LAS u32x4*)(CE + t * 136 + cg * 16 + half * 8) = pack8(c8); } }
            WG_SYNC();
            if (C.wave < 4) {
                f32x16 acc = zero16();
                mma_nt<64>(acc, XST, 72, 32 * pt, SC, 72, 32 * it2, C.lane);
                mma_nt<128>(acc, HP, 136, 32 * pt, CE, 136, 32 * it2, C.lane);
                const int i = 32 * it2 + n; const size_t row = (size_t)bc * 64 + i; const float dh = dpar[hd];
#pragma unroll
                for (int q4 = 0; q4 < 4; ++q4) { const int p0 = 32 * pt + 8 * q4 + 4 * hi;
                    const u32x2 zw = *(const u32x2*)(P + row * NPM + C_SZ + hd * 64 + p0); const float zf[4] = {bflo(zw.x), bfhi(zw.x), bflo(zw.y), bfhi(zw.y)};
#pragma unroll
                    for (int e = 0; e < 4; ++e) { const float xs = bf2f(XST[(p0 + e) * 72 + i]); const float v = (acc[4 * q4 + e] + dh * xs) * siluf_(zf[e]); yk[hh][4 * q4 + e] = v; ssq += v * v; } }
            }
        }
        if (C.wave < 4) { ssq += __shfl_xor(ssq, 32); if (hi == 0) PSQ[(32 * it2 + n) * 2 + pt] = ssq; }
        WG_SYNC();
        if (C.wave < 4) {
            const int i = 32 * it2 + n; const float rs = 1.0f / sqrtf((PSQ[i * 2] + PSQ[i * 2 + 1]) * (1.0f / 256.0f) + EPS); const size_t row = (size_t)bc * 64 + i;
#pragma unroll
            for (int hh = 0; hh < 4; ++hh)
#pragma unroll
                for (int q4 = 0; q4 < 4; ++q4) { const int ch = g * 256 + hh * 64 + 32 * pt + 8 * q4 + 4 * hi; const f32x4 sn = *(const f32x4*)(snorm + ch);
                    u32x2 w; w.x = pk2(yk[hh][4 * q4] * rs * sn[0], yk[hh][4 * q4 + 1] * rs * sn[1]); w.y = pk2(yk[hh][4 * q4 + 2] * rs * sn[2], yk[hh][4 * q4 + 3] * rs * sn[3]);
                    *(u32x2*)(YS + row * 2048 + 1024 + ch) = w; }
        }
    }
    WG_SYNC();
}

__device__ __forceinline__ void rw_lerp8(const bf16* P, const float* mu, int bc, int t, int c0, float* o) {
    const size_t row = (size_t)bc * 64 + t; const bool first = ((bc & 127) == 0) && (t == 0);
    float x[8], xp[8]; unpack8(*(const u32x4*)(P + row * NPM + C_RR + c0), x);
    if (!first) unpack8(*(const u32x4*)(P + (row - 1) * NPM + C_RR + c0), xp); else {
#pragma unroll
        for (int i = 0; i < 8; ++i) xp[i] = 0.f; }
#pragma unroll
    for (int i = 0; i < 8; ++i) o[i] = x[i] + (xp[i] - x[i]) * mu[c0 + i];
}
PH_HEAVY void ph_rw_prep(const Ctx C, ArgsP a, int l) {
    const bf16* P = (const bf16*)(C.ws + WS_P);
    float* RWW = (float*)(C.ws + WS_RWW); bf16* RWR = (bf16*)(C.ws + WS_RWR); bf16* RWK = (bf16*)(C.ws + WS_RWK); bf16* RWV = (bf16*)(C.ws + WS_RWV); bf16* RWKK = (bf16*)(C.ws + WS_RWKK); bf16* RWB = (bf16*)(C.ws + WS_RWB); bf16* RWG = (bf16*)(C.ws + WS_RWG);
    const float* mu = a->in[21] + (size_t)l * 1792; const float* w0 = a->in[22] + (size_t)l * 512; const float* w2 = a->in[23] + (size_t)l * 64 * 512; const float* a0 = a->in[24] + (size_t)l * 512; const float* a2 = a->in[25] + (size_t)l * 64 * 512;
    const float* g2 = a->in[26] + (size_t)l * 128 * 512; const float* k_k = a->in[27] + (size_t)l * 512; const float* k_a = a->in[28] + (size_t)l * 512;
    LF WL = (LF)C.lds; LF AL = WL + 64 * 68; LF GLs = AL + 64 * 68;
    for (int bc = C.bid; bc < NBC; bc += C.G) {
        WG_SYNC();
        { const int t = C.tid >> 3, cg = C.tid & 7; float o[8];
          rw_lerp8(P, mu, bc, t, 1536 + cg * 8, o);
#pragma unroll
          for (int i = 0; i < 8; ++i) WL[t * 68 + cg * 8 + i] = tanhf(o[i]);
          rw_lerp8(P, mu, bc, t, 1600 + cg * 8, o);
#pragma unroll
          for (int i = 0; i < 8; ++i) AL[t * 68 + cg * 8 + i] = o[i];
          rw_lerp8(P, mu, bc, t, 1664 + cg * 16, o);
#pragma unroll
          for (int i = 0; i < 8; ++i) GLs[t * 132 + cg * 16 + i] = sigmoidf_(o[i]);
          rw_lerp8(P, mu, bc, t, 1664 + cg * 16 + 8, o);
#pragma unroll
          for (int i = 0; i < 8; ++i) GLs[t * 132 + cg * 16 + 8 + i] = sigmoidf_(o[i]); }
        WG_SYNC();
        const int tb = C.tid >> 6, cb = C.tid & 63, ch0 = cb * 8;
#pragma unroll 1
        for (int half = 0; half < 2; ++half) {
        const int rb = 8 * tb + 4 * half;
        float acc[4][8], av[4][8];
#pragma unroll
        for (int i = 0; i < 4; ++i)
#pragma unroll
            for (int j = 0; j < 8; ++j) acc[i][j] = 0.f;
#pragma unroll 2
        for (int r = 0; r < 64; ++r) { const f32x4 b0 = *(const f32x4*)(w2 + r * 512 + ch0), b1 = *(const f32x4*)(w2 + r * 512 + ch0 + 4);
#pragma unroll
            for (int i = 0; i < 4; ++i) { const float x = WL[(rb + i) * 68 + r];
#pragma unroll
                for (int j = 0; j < 4; ++j) { acc[i][j] += x * b0[j]; acc[i][4 + j] += x * b1[j]; } } }
#pragma unroll
        for (int i = 0; i < 4; ++i) { const size_t row = (size_t)bc * 64 + rb + i; float o[8];
#pragma unroll
            for (int j = 0; j < 8; ++j) o[j] = __expf(-0.606531f * sigmoidf_(w0[ch0 + j] + acc[i][j]));
            *(f32x4*)(RWW + row * 512 + ch0) = (f32x4){o[0], o[1], o[2], o[3]}; *(f32x4*)(RWW + row * 512 + ch0 + 4) = (f32x4){o[4], o[5], o[6], o[7]}; }
#pragma unroll
        for (int i = 0; i < 4; ++i)
#pragma unroll
            for (int j = 0; j < 8; ++j) acc[i][j] = 0.f;
#pragma unroll 2
        for (int r = 0; r < 64; ++r) { const f32x4 b0 = *(const f32x4*)(a2 + r * 512 + ch0), b1 = *(const f32x4*)(a2 + r * 512 + ch0 + 4);
#pragma unroll
            for (int i = 0; i < 4; ++i) { const float x = AL[(rb + i) * 68 + r];
#pragma unroll
                for (int j = 0; j < 4; ++j) { acc[i][j] += x * b0[j]; acc[i][4 + j] += x * b1[j]; } } }
#pragma unroll
        for (int i = 0; i < 4; ++i)
#pragma unroll
            for (int j = 0; j < 8; ++j) av[i][j] = sigmoidf_(a0[ch0 + j] + acc[i][j]);
#pragma unroll
        for (int i = 0; i < 4; ++i)
#pragma unroll
            for (int j = 0; j < 8; ++j) acc[i][j] = 0.f;
#pragma unroll 2
        for (int r = 0; r < 128; ++r) { const f32x4 b0 = *(const f32x4*)(g2 + r * 512 + ch0), b1 = *(const f32x4*)(g2 + r * 512 + ch0 + 4);
#pragma unroll
            for (int i = 0; i < 4; ++i) { const float x = GLs[(rb + i) * 132 + r];
#pragma unroll
                for (int j = 0; j < 4; ++j) { acc[i][j] += x * b0[j]; acc[i][4 + j] += x * b1[j]; } } }
#pragma unroll
        for (int i = 0; i < 4; ++i) { const size_t row = (size_t)bc * 64 + rb + i; *(u32x4*)(RWG + row * 512 + ch0) = pack8(acc[i]); }
#pragma unroll
        for (int i = 0; i < 4; ++i) { const int t = rb + i; const size_t row = (size_t)bc * 64 + t; float o[8], kx[8], kk[8];
            rw_lerp8(P, mu, bc, t, ch0, o); *(u32x4*)(RWR + row * 512 + ch0) = pack8(o);
            rw_lerp8(P, mu, bc, t, 1024 + ch0, o); *(u32x4*)(RWV + row * 512 + ch0) = pack8(o);
            rw_lerp8(P, mu, bc, t, 512 + ch0, kx);
            float ss = 0.f;
#pragma unroll
            for (int j = 0; j < 8; ++j) { kk[j] = kx[j] * k_k[ch0 + j]; ss += kk[j] * kk[j]; }
            ss += __shfl_xor(ss, 1); ss += __shfl_xor(ss, 2); ss += __shfl_xor(ss, 4);
            const float inv = 1.0f / fmaxf(sqrtf(ss), 1e-12f);
#pragma unroll
            for (int j = 0; j < 8; ++j) { kk[j] *= inv; o[j] = kk[j] * av[i][j]; kx[j] = kx[j] * (1.0f + (av[i][j] - 1.0f) * k_a[ch0 + j]); }
            *(u32x4*)(RWKK + row * 512 + ch0) = pack8(kk); *(u32x4*)(RWB + row * 512 + ch0) = pack8(o); *(u32x4*)(RWK + row * 512 + ch0) = pack8(kx); }
        }
    }
    WG_SYNC();
}
template <int CTRL> __device__ __forceinline__ float dpp_get(float x) { return __builtin_bit_cast(float, __builtin_amdgcn_update_dpp(0, __builtin_bit_cast(int, x), CTRL, 0xf, 0xf, true)); }
__device__ __forceinline__ float reduce16(float x) { x += dpp_get<0xB1>(x); x += dpp_get<0x4E>(x); x += dpp_get<0x141>(x); x += dpp_get<0x140>(x); return x; }
#define RW_BAR() do { asm volatile("s_waitcnt lgkmcnt(0)" ::: "memory"); __builtin_amdgcn_s_barrier(); asm volatile("" ::: "memory"); } while (0)
PH_FN void rw_unit(const Ctx C, int chain, int rq) {
    const float* RWW = (const float*)(C.ws + WS_RWW); const bf16* RWR = (const bf16*)(C.ws + WS_RWR); const bf16* RWK = (const bf16*)(C.ws + WS_RWK); const bf16* RWV = (const bf16*)(C.ws + WS_RWV);
    const bf16* RWKK = (const bf16*)(C.ws + WS_RWKK); const bf16* RWB = (const bf16*)(C.ws + WS_RWB); bf16* RWY = (bf16*)(C.ws + WS_RWY);
    const int b = chain >> 3, h = chain & 7; const size_t rowb = (size_t)b * SEQ;
    constexpr int BUFB = 43008, O_KK = 0, O_W = 8192, O_B = 16384, O_K = 24576, O_R = 32768, O_V = 40960, NBLK = SEQ / 32;
    LAS unsigned char* L = C.lds;
    if (C.wave >= 4) {
        const int p = C.tid - 256, t = p >> 3, c8 = (p & 7) * 8;
        u32x4 rr, rk, rkk, rb; f32x4 w0, w1; unsigned rv;
#define RW_LOAD(blk) do { const size_t g_ = (rowb + (size_t)(blk) * 32 + t) * 512 + h * 64; \
            w0 = *(const f32x4*)(RWW + g_ + c8); w1 = *(const f32x4*)(RWW + g_ + c8 + 4); rr = *(const u32x4*)(RWR + g_ + c8); rk = *(const u32x4*)(RWK + g_ + c8); \
            rkk = *(const u32x4*)(RWKK + g_ + c8); rb = *(const u32x4*)(RWB + g_ + c8); rv = *(const unsigned*)(RWV + g_ + 16 * rq + (p & 7) * 2); } while (0)
#define RW_ST8(off, w_) do { float o_[8]; unpack8(w_, o_); LF d_ = (LF)(Lb + (off)) + t * 64 + c8; *(LAS f32x4*)d_ = (f32x4){o_[0], o_[1], o_[2], o_[3]}; *(LAS f32x4*)(d_ + 4) = (f32x4){o_[4], o_[5], o_[6], o_[7]}; } while (0)
        RW_LOAD(0);
        for (int blk = 0; blk < NBLK; ++blk) {
            LAS unsigned char* Lb = L + (blk & 1) * BUFB;
            { LF d = (LF)(Lb + O_W) + t * 64 + c8; *(LAS f32x4*)d = w0; *(LAS f32x4*)(d + 4) = w1; }
            RW_ST8(O_R, rr); RW_ST8(O_K, rk); RW_ST8(O_KK, rkk); RW_ST8(O_B, rb);
            { LF d = (LF)(Lb + O_V) + t * 16 + (p & 7) * 2; d[0] = bflo(rv); d[1] = bfhi(rv); }
            if (blk + 1 < NBLK) RW_LOAD(blk + 1);
            RW_BAR();
        }
        RW_BAR();
#undef RW_LOAD
#undef RW_ST8
    } else {
        const int rowl = C.lane >> 4, ks = C.lane & 15, row = 4 * C.wave + rowl;
        float S0 = 0.f, S1 = 0.f, S2 = 0.f, S3 = 0.f, ykeep = 0.f;
        bf16* yout = RWY + rowb * 512 + h * 64 + 16 * rq + row;
        for (int blk = 0; blk < NBLK; ++blk) {
            RW_BAR();
            const LAS unsigned char* Lb = L + (blk & 1) * BUFB;
            CLF pKK = (CLF)(Lb + O_KK) + 4 * ks; CLF pW = (CLF)(Lb + O_W) + 4 * ks; CLF pB = (CLF)(Lb + O_B) + 4 * ks; CLF pK = (CLF)(Lb + O_K) + 4 * ks; CLF pR = (CLF)(Lb + O_R) + 4 * ks; CLF pV = (CLF)(Lb + O_V) + row;
            f32x4 kk = *(const LAS f32x4*)pKK, w = *(const LAS f32x4*)pW, bb = *(const LAS f32x4*)pB, k = *(const LAS f32x4*)pK, r = *(const LAS f32x4*)pR; float vv = *pV;
#pragma unroll 4
            for (int t = 0; t < 32; ++t) {
                f32x4 nkk, nw, nb, nk, nr; float nv;
                const int tn = (t < 31) ? t + 1 : t;
                nkk = *(const LAS f32x4*)(pKK + tn * 64); nw = *(const LAS f32x4*)(pW + tn * 64); nb = *(const LAS f32x4*)(pB + tn * 64); nk = *(const LAS f32x4*)(pK + tn * 64); nr = *(const LAS f32x4*)(pR + tn * 64); nv = pV[tn * 16];
                float sa = (S0 * kk[0] + S1 * kk[1]) + (S2 * kk[2] + S3 * kk[3]);
                sa = -reduce16(sa);
                const float vk0 = vv * k[0], vk1 = vv * k[1], vk2 = vv * k[2], vk3 = vv * k[3];
                S0 = S0 * w[0] + (sa * bb[0] + vk0); S1 = S1 * w[1] + (sa * bb[1] + vk1); S2 = S2 * w[2] + (sa * bb[2] + vk2); S3 = S3 * w[3] + (sa * bb[3] + vk3);
                float y = (S0 * r[0] + S1 * r[1]) + (S2 * r[2] + S3 * r[3]);
                y = reduce16(y);
                if ((t & 15) == ks) ykeep = y;
                if ((t & 15) == 15) yout[(size_t)(blk * 32 + (t & 16) + ks) * 512] = (bf16)f2bf(ykeep);
                kk = nkk; w = nw; bb = nb; k = nk; r = nr; vv = nv;
            }
        }
        RW_BAR();
    }
}
PH_FN void ph_rw_out(const Ctx C, ArgsP a, int l) {
    const bf16* RWR = (const bf16*)(C.ws + WS_RWR); const bf16* RWK = (const bf16*)(C.ws + WS_RWK); const bf16* RWV = (const bf16*)(C.ws + WS_RWV); const bf16* RWG = (const bf16*)(C.ws + WS_RWG); const bf16* RWY = (const bf16*)(C.ws + WS_RWY);
    bf16* YS = (bf16*)(C.ws + WS_YS);
    const float* r_k = a->in[29] + (size_t)l * 512; const float* nw = a->in[30] + (size_t)l * 512; const float* nb = a->in[31] + (size_t)l * 512;
    const int gw = C.bid * NWAVES + C.wave, NGW = C.G * NWAVES;
    for (int it = gw; it < M * 8; it += NGW) {
        const size_t row = (size_t)(it >> 3); const int h = it & 7, c = h * 64 + C.lane; const size_t g = row * 512 + c;
        const float y = bf2f(RWY[g]), r = bf2f(RWR[g]), k = bf2f(RWK[g]), v = bf2f(RWV[g]), gg = bf2f(RWG[g]);
        const float mu = wave_sum(y) * (1.0f / 64.0f); const float d = y - mu; const float var = wave_sum(d * d) * (1.0f / 64.0f);
        const float yn = d * (1.0f / sqrtf(var + 64e-5f)) * nw[c] + nb[c];
        const float bonus = wave_sum(r * k * r_k[c]) * v;
        YS[row * 2048 + 1536 + c] = (bf16)f2bf((yn + bonus) * gg);
    }
}

__device__ __forceinline__ int pi_swap23(int i) { return (i & ~12) | ((i & 4) << 1) | ((i & 8) >> 1); }
__device__ __forceinline__ void da_unit(const Ctx& C, const Args& a, int l, int b, int h, int jq, float lam, float oml) {
    const bf16* P = (const bf16*)(C.ws + WS_P); const bf16* VT = (const bf16*)(C.ws + WS_VT); bf16* YS = (bf16*)(C.ws + WS_YS);
    const float* dnorm = a.in[11] + (size_t)l * 128;
    const int comp = C.wave >> 2, wq = C.wave & 3, q = C.lane & 31, hi = C.lane >> 5;
    const size_t qrow = (size_t)b * SEQ + jq * 128 + wq * 32 + q;
    pg8::bf16x8 qf[4];
#pragma unroll
    for (int d0 = 0; d0 < 4; ++d0) qf[d0] = *(const pg8::bf16x8*)(P + qrow * NPM + C_DAQ + h * 128 + comp * 64 + 16 * d0 + 8 * hi);
    const int ntile = 2 * jq + 2, my_last = 2 * jq + (wq >= 2 ? 1 : 0);
    f32x16 O[4];
#pragma unroll
    for (int db = 0; db < 4; ++db)
#pragma unroll
        for (int r = 0; r < 16; ++r) O[db][r] = 0.f;
    float mrun = -1e30f, lrun = 0.f;
    const bf16* kg = P + ((size_t)b * SEQ + (C.tid & 63)) * NPM + C_DAK + h * 128;
    const bf16* vg = VT + ((size_t)(b * 4 + h) * 128 + (C.tid & 127)) * SEQ;
    const int kc16 = C.tid >> 6, vc8 = C.tid >> 7;
    u32x4 kr[2], vr[2];
#pragma unroll
    for (int i = 0; i < 2; ++i) { kr[i] = *(const u32x4*)(kg + (kc16 + 8 * i) * 8); vr[i] = *(const u32x4*)(vg + (vc8 + 4 * i) * 8); }
    const int pq = pi_swap23(q);
    for (int tile = 0; tile < ntile; ++tile) {
        LAS unsigned char* buf = C.lds + (tile & 1) * 32768;
#pragma unroll
        for (int i = 0; i < 2; ++i) { const int c16 = kc16 + 8 * i; *(LAS u32x4*)(buf + (c16 >> 3) * 8192 + (c16 & 7) * 1024 + (C.tid & 63) * 16) = kr[i];
            *(LAS u32x4*)(buf + 16384 + (vc8 + 4 * i) * 2048 + (C.tid & 127) * 16) = vr[i]; }
        WG_SYNC();
        if (tile + 1 < ntile) {
#pragma unroll
            for (int i = 0; i < 2; ++i) { kr[i] = *(const u32x4*)(kg + (size_t)(tile + 1) * 64 * NPM + (kc16 + 8 * i) * 8); vr[i] = *(const u32x4*)(vg + (tile + 1) * 64 + (vc8 + 4 * i) * 8); } }
        if (tile <= my_last) {
            const LAS unsigned char* kb = buf + comp * 8192; const LAS unsigned char* vb = buf + 16384;
            f32x16 p0, p1;
#pragma unroll
            for (int r = 0; r < 16; ++r) { p0[r] = 0.f; p1[r] = 0.f; }
#pragma unroll
            for (int d0 = 0; d0 < 4; ++d0) {
                const pg8::bf16x8 a0 = *(const LAS pg8::bf16x8*)(kb + (2 * d0 + hi) * 1024 + pq * 16);
                const pg8::bf16x8 a1 = *(const LAS pg8::bf16x8*)(kb + (2 * d0 + hi) * 1024 + (32 + pq) * 16);
                p0 = __builtin_amdgcn_mfma_f32_32x32x16_bf16(a0, qf[d0], p0, 0, 0, 0);
                p1 = __builtin_amdgcn_mfma_f32_32x32x16_bf16(a1, qf[d0], p1, 0, 0, 0);
            }
            float mx = fmaxf(p0[0], p1[0]);
#pragma unroll
            for (int r = 1; r < 16; ++r) mx = fmaxf(mx, fmaxf(p0[r], p1[r]));
            mx = fmaxf(mx, __shfl_xor(mx, 32));
            const float mnew = fmaxf(mrun, mx); const float alpha = __builtin_amdgcn_exp2f(mrun - mnew); mrun = mnew;
            float rs = 0.f;
#pragma unroll
            for (int r = 0; r < 16; ++r) { p0[r] = __builtin_amdgcn_exp2f(p0[r] - mnew); p1[r] = __builtin_amdgcn_exp2f(p1[r] - mnew); rs += p0[r] + p1[r]; }
            lrun = lrun * alpha + rs;
#pragma unroll
            for (int db = 0; db < 4; ++db)
#pragma unroll
                for (int r = 0; r < 16; ++r) O[db][r] *= alpha;
            pg8::bf16x8 pb[4];
            { u32x4 w;
              w.x = pk2(p0[0], p0[1]); w.y = pk2(p0[2], p0[3]); w.z = pk2(p0[4], p0[5]); w.w = pk2(p0[6], p0[7]); pb[0] = __builtin_bit_cast(pg8::bf16x8, w);
              w.x = pk2(p0[8], p0[9]); w.y = pk2(p0[10], p0[11]); w.z = pk2(p0[12], p0[13]); w.w = pk2(p0[14], p0[15]); pb[1] = __builtin_bit_cast(pg8::bf16x8, w);
              w.x = pk2(p1[0], p1[1]); w.y = pk2(p1[2], p1[3]); w.z = pk2(p1[4], p1[5]); w.w = pk2(p1[6], p1[7]); pb[2] = __builtin_bit_cast(pg8::bf16x8, w);
              w.x = pk2(p1[8], p1[9]); w.y = pk2(p1[10], p1[11]); w.z = pk2(p1[12], p1[13]); w.w = pk2(p1[14], p1[15]); pb[3] = __builtin_bit_cast(pg8::bf16x8, w); }
#pragma unroll
            for (int db = 0; db < 4; ++db)
#pragma unroll
                for (int s = 0; s < 4; ++s) {
                    const pg8::bf16x8 vf = *(const LAS pg8::bf16x8*)(vb + (2 * s + hi) * 2048 + (32 * db + q) * 16);
                    O[db] = __builtin_amdgcn_mfma_f32_32x32x16_bf16(vf, pb[s], O[db], 0, 0, 0);
                }
        }
    }
    const float ltot = lrun + __shfl_xor(lrun, 32); const float inv = 1.0f / ltot;
    WG_SYNC();
    LF X = (LF)C.lds + (wq * 32 + q) * 132;
    if (comp == 1) {
        const float sc = inv * lam;
#pragma unroll
        for (int db = 0; db < 4; ++db)
#pragma unroll
            for (int g4 = 0; g4 < 4; ++g4) *(LAS f32x4*)(X + 32 * db + 8 * g4 + 4 * hi) = (f32x4){O[db][4 * g4] * sc, O[db][4 * g4 + 1] * sc, O[db][4 * g4 + 2] * sc, O[db][4 * g4 + 3] * sc};
    }
    WG_SYNC();
    if (comp == 0) {
        float ss = 0.f;
#pragma unroll
        for (int db = 0; db < 4; ++db)
#pragma unroll
            for (int g4 = 0; g4 < 4; ++g4) { const f32x4 x = *(const LAS f32x4*)(X + 32 * db + 8 * g4 + 4 * hi);
#pragma unroll
                for (int e = 0; e < 4; ++e) { const float v = O[db][4 * g4 + e] * inv - x[e]; O[db][4 * g4 + e] = v; ss += v * v; } }
        ss += __shfl_xor(ss, 32);
        const float rs = oml / sqrtf(ss * (1.0f / 128.0f) + EPS);
#pragma unroll
        for (int db = 0; db < 4; ++db)
#pragma unroll
            for (int g4 = 0; g4 < 4; ++g4) { const int d = 32 * db + 8 * g4 + 4 * hi; const f32x4 gn = *(const f32x4*)(dnorm + d);
                u32x2 w; w.x = pk2(O[db][4 * g4] * rs * gn[0], O[db][4 * g4 + 1] * rs * gn[1]); w.y = pk2(O[db][4 * g4 + 2] * rs * gn[2], O[db][4 * g4 + 3] * rs * gn[3]);
                *(u32x2*)(YS + qrow * 2048 + h * 128 + d) = w; }
    }
    WG_SYNC();
}
__device__ const signed char ATT_BINS[24][12] = {{63,21,-1,-1,-1,-1,-1,-1,-1,-1,-1,-1}, {62,22,-1,-1,-1,-1,-1,-1,-1,-1,-1,-1}, {61,23,-1,-1,-1,-1,-1,-1,-1,-1,-1,-1}, {60,24,-1,-1,-1,-1,-1,-1,-1,-1,-1,-1}, {59,25,-1,-1,-1,-1,-1,-1,-1,-1,-1,-1}, {58,26,-1,-1,-1,-1,-1,-1,-1,-1,-1,-1}, {57,27,-1,-1,-1,-1,-1,-1,-1,-1,-1,-1}, {56,28,-1,-1,-1,-1,-1,-1,-1,-1,-1,-1}, {55,29,-1,-1,-1,-1,-1,-1,-1,-1,-1,-1}, {54,30,-1,-1,-1,-1,-1,-1,-1,-1,-1,-1}, {53,31,-1,-1,-1,-1,-1,-1,-1,-1,-1,-1}, {52,32,-1,-1,-1,-1,-1,-1,-1,-1,-1,-1}, {51,33,-1,-1,-1,-1,-1,-1,-1,-1,-1,-1}, {50,34,-1,-1,-1,-1,-1,-1,-1,-1,-1,-1}, {49,35,-1,-1,-1,-1,-1,-1,-1,-1,-1,-1}, {48,36,-1,-1,-1,-1,-1,-1,-1,-1,-1,-1}, {47,37,-1,-1,-1,-1,-1,-1,-1,-1,-1,-1}, {46,38,-1,-1,-1,-1,-1,-1,-1,-1,-1,-1}, {45,39,-1,-1,-1,-1,-1,-1,-1,-1,-1,-1}, {44,40,-1,-1,-1,-1,-1,-1,-1,-1,-1,-1}, {43,41,-1,-1,-1,-1,-1,-1,-1,-1,-1,-1}, {42,20,19,6,-1,-1,-1,-1,-1,-1,-1,-1}, {18,17,16,15,14,5,-1,-1,-1,-1,-1,-1}, {13,12,11,10,9,8,7,4,3,2,1,0}};
__device__ __forceinline__ void ph_da_attn(const Ctx& C, const Args& a, int l, int bh, int bin) {
    const float* q1 = a.in[7] + (size_t)l * 64; const float* k1 = a.in[8] + (size_t)l * 64; const float* q2 = a.in[9] + (size_t)l * 64; const float* k2 = a.in[10] + (size_t)l * 64;
    float s1 = 0.f, s2 = 0.f;
    for (int i = 0; i < 64; ++i) { s1 += q1[i] * k1[i]; s2 += q2[i] * k2[i]; }
    const float lam_init = 0.8f - 0.6f * expf(-0.3f * (float)l); const float lam = expf(s1) - expf(s2) + lam_init;
    for (int i = 0; i < 12; ++i) { const int jq = ATT_BINS[bin][i]; if (jq < 0) break; da_unit(C, a, l, bh >> 2, bh & 3, jq, lam, 1.0f - lam_init); }
}

PH_FN void ph_final(const Ctx C, ArgsP a) {
    const float* ssq = (const float*)(C.ws + WS_SSQ); const float* fn = a->in[39];
    const int gw = C.bid * NWAVES + C.wave, NGW = C.G * NWAVES;
    for (int m = gw; m < M; m += NGW) { const float rs = pg8::row_rstd(ssq, m, M); f32x4* hr = (f32x4*)(C.h + (size_t)m * D) + C.lane; const f32x4* gr = (const f32x4*)fn + C.lane;
#pragma unroll
        for (int j = 0; j < 4; ++j) { const f32x4 v = hr[64 * j], g = gr[64 * j]; hr[64 * j] = v * rs * g; } }
}
#ifndef REP_ATTN
#define REP_ATTN 1
#endif
#ifndef REP_W
#define REP_W 1
#endif
#ifndef REP_RWC
#define REP_RWC 1
#endif
#ifndef REP_MAC
#define REP_MAC 1
#endif
constexpr int NPH = 12, G_FINAL = 1 + NL * NPH, G_END = G_FINAL + 1;
template <int GRP>
__global__ void __launch_bounds__(NTHR, 2) hybrid_fwd(Args args) {
    constexpr bool ALL = (GRP < 0);
    constexpr bool EN_G1 = ALL || GRP == 0, EN_G2 = EN_G1, EN_G3 = EN_G1, EN_G7 = EN_G1, EN_G8 = EN_G1, EN_G9 = EN_G1;
    constexpr bool EN_PRO = ALL || GRP == 1, EN_W = EN_PRO, EN_FIN = EN_PRO, EN_MA1 = EN_PRO, EN_MA2 = EN_PRO, EN_MA3 = EN_PRO, EN_MA4 = EN_PRO;
    constexpr bool EN_MB1 = ALL || GRP == 2, EN_MB2 = EN_MB1;
    constexpr bool EN_MC1 = ALL || GRP == 3, EN_MC2 = EN_MC1, EN_MC3 = EN_MC1;
    extern __shared__ __attribute__((aligned(16))) unsigned char lds[];
    Ctx C; C.lds = (LAS unsigned char*)lds; C.ws = args.ws; C.h = args.out; C.tid = threadIdx.x; C.lane = C.tid & 63; C.wave = __builtin_amdgcn_readfirstlane(C.tid >> 6); C.bid = blockIdx.x; C.G = gridDim.x;
    LAS unsigned char* ldsl = (LAS unsigned char*)lds;
    const ArgsP ap = (ArgsP)__builtin_amdgcn_kernarg_segment_ptr();
    for (int u = C.tid; u < (LDS_BYTES - LDSCTL_OFF) / 4; u += NTHR) ((LAS unsigned*)(ldsl + LDSCTL_OFF))[u] = 0u;
    __syncthreads();
    volatile LAS unsigned* MISC = (volatile LAS unsigned*)(ldsl + MISC_OFF);
    gu32* ctl = (gu32*)(args.ws + WS_CTL);
    const int g_lo = args.g_lo, g_hi = args.g_hi;
    XcdBarrier bar; bar.bar = (unsigned*)(ctl + CW_BAR); bar.x = 0; bar.st = nullptr;
    if (g_hi - g_lo > 1) bar = xcd_barrier_post((unsigned*)(ctl + CW_BAR), MISC + 8);
#define IN(g) (g_lo <= (g) && (g) < g_hi)
#define SEAM(g) do { if (IN(g) && IN((g) + 1)) xcd_barrier(bar); } while (0)
    bf16* HB = (bf16*)(args.ws + WS_HB); float* SSQ = (float*)(args.ws + WS_SSQ);

    if (EN_PRO && IN(0)) ph_prologue(fresh(C), ap);
    SEAM(0);
#pragma unroll 1
    for (int l = 0; l < NL; ++l) {
        const int gb = 1 + NPH * l;
        if (EN_W && IN(gb + 0)) { for (int rep = 0; rep < REP_W; ++rep) ph_weights(fresh(C), ap, l); }
        SEAM(gb + 0);
#pragma unroll 1
        for (int f = 0; f < 2; ++f) {
            const int gu = gb + (f ? 10 : 1);
            if (EN_G1 && IN(gu)) {
                pg8::Gemm g{HB, (const bf16*)(args.ws + (f ? WS_WGU2 : WS_WGU1)), M, 2 * FF, D, D}; pg8::StaticOrder S; S.init(M, 2 * FF, C.G, C.bid);
                pg8::EpiSwiglu E{(bf16*)(args.ws + WS_ACT), FF, SSQ, M};
                pg8::gemm_phase<pg8::EpiSwiglu, pg8::StaticOrder, true, true>(ldsl, g, S, E);
            }
            SEAM(gu);
            if (EN_G2 && IN(gu + 1)) {
                pg8::Gemm g{(const bf16*)(args.ws + WS_ACT), (const bf16*)(args.ws + (f ? WS_WD2 : WS_WD1)), M, D, FF, FF}; pg8::StaticOrder S; S.init(M, D, C.G, C.bid);
                pg8::EpiResid E{C.h, HB, SSQ, M, 0.5f};
                pg8::gemm_phase<pg8::EpiResid, pg8::StaticOrder, false, true>(ldsl, g, S, E);
            }
            SEAM(gu + 1);
            if (f == 0) {
                if (EN_G3 && IN(gb + 3)) {
                    pg8::Gemm g{HB, (const bf16*)(args.ws + WS_WIN), M, NPM, D, D}; pg8::StaticOrder S; S.init(M, NPM, C.G, C.bid);
                    pg8::EpiScaleBf16 E{(bf16*)(args.ws + WS_P), NPM, SSQ, M};
                    pg8::gemm_phase<pg8::EpiScaleBf16, pg8::StaticOrder, true, true>(ldsl, g, S, E);
                }
                SEAM(gb + 3);
                if (IN(gb + 4)) { if (EN_MA1) ph_da_prep(fresh(C)); for (int rep = 0; rep < REP_MAC; ++rep) { if (EN_MA2) ph_gla_a(fresh(C), ap, l); if (EN_MA3) ph_ssd_a(fresh(C), ap, l); if (EN_MA4) ph_rw_prep(fresh(C), ap, l); } }
                SEAM(gb + 4);
                if (IN(gb + 5)) {
                    if (C.bid < 64) { if (EN_MB2) { const int xcd = C.bid & 7, slot = C.bid >> 3; for (int rep = 0; rep < REP_RWC; ++rep) rw_unit(fresh(C), xcd * 2 + (slot >> 2), slot & 3); } }
                    else { const int a = C.bid - 64;
                        if (EN_MB2) { for (int p = a; p < 384; p += 192) { if (p < 128) gla_scan_part(fresh(C), p); else ssd_scan_part(fresh(C), p - 128); } }
                        for (int rep = 0; rep < REP_ATTN; ++rep) if (EN_MB1) ph_da_attn(fresh(C), args, l, a & 7, a >> 3); }
                }
                SEAM(gb + 5);
                if (IN(gb + 6)) { for (int rep = 0; rep < REP_MAC; ++rep) { if (EN_MC1) ph_gla_c(fresh(C), ap, l); if (EN_MC2) ph_ssd_c(fresh(C), ap, l); if (EN_MC3) ph_rw_out(fresh(C), ap, l); } }
                SEAM(gb + 6);
                if (EN_G7 && IN(gb + 7)) {
                    pg8::Gemm g{HB, (const bf16*)(args.ws + WS_WIN) + (size_t)NPM * D, M, 4096, D, D}; pg8::StaticOrder S; S.init(M, 4096, C.G, C.bid);
                    pg8::EpiScaleBf16 E{(bf16*)(args.ws + WS_PG), 4096, SSQ, M};
                    pg8::gemm_phase<pg8::EpiScaleBf16, pg8::StaticOrder, true, true>(ldsl, g, S, E);
                }
                SEAM(gb + 7);
                if (EN_G8 && IN(gb + 8)) {
                    pg8::Gemm g{(const bf16*)(args.ws + WS_YS), (const bf16*)(args.ws + WS_WB), M, D, 512, 2048}; pg8::GroupedOrder S; S.init(M, D, 4, 512, C.G, C.bid);
                    pg8::EpiGateAcc E{(bf16*)(args.ws + WS_MERGED), (const bf16*)(args.ws + WS_PG), args.in[33] + (size_t)l * 4096};
                    pg8::gemm_phase<pg8::EpiGateAcc, pg8::GroupedOrder, true, true>(ldsl, g, S, E);
                }
                SEAM(gb + 8);
                if (EN_G9 && IN(gb + 9)) {
                    pg8::Gemm g{(const bf16*)(args.ws + WS_MERGED), (const bf16*)(args.ws + WS_WO), M, D, D, D}; pg8::StaticOrder S; S.init(M, D, C.G, C.bid);
                    pg8::EpiResid E{C.h, HB, SSQ, M, 1.0f};
                    pg8::gemm_phase<pg8::EpiResid, pg8::StaticOrder, false, true>(ldsl, g, S, E);
                }
                SEAM(gb + 9);
            }
        }
    }
    if (EN_FIN && IN(G_FINAL)) ph_final(fresh(C), ap);
#undef IN
#undef SEAM
}

#ifndef ONE_LAUNCH
#define ONE_LAUNCH 1
#endif
extern "C" void kernel_launch(void* const* d_in, const int* in_sizes, int n_in, void* d_out, int out_size, void* d_ws, size_t ws_size, hipStream_t stream) {
    static int grid = 0;
    if (grid == 0) {
        if (n_in != 40 || in_sizes[0] != M * D || out_size != M * D || ws_size < WS_END) { fprintf(stderr, "kernel_launch: unexpected shapes (n_in %d, in0 %d, out %d, ws %zu < %zu); nothing launched\n", n_in, n_in > 0 ? in_sizes[0] : -1, out_size, ws_size, (size_t)WS_END); grid = -1; return; }
        int dev = 0, cus = 0, per_cu = 0;
        if (hipGetDevice(&dev) != hipSuccess || hipDeviceGetAttribute(&cus, hipDeviceAttributeMultiprocessorCount, dev) != hipSuccess) { grid = -1; return; }
#if ONE_LAUNCH
        if (hipFuncSetAttribute((const void*)hybrid_fwd<-1>, hipFuncAttributeMaxDynamicSharedMemorySize, LDS_BYTES) != hipSuccess) { fprintf(stderr, "kernel_launch: hipFuncSetAttribute failed\n"); grid = -1; return; }
#else
        if (hipFuncSetAttribute((const void*)hybrid_fwd<0>, hipFuncAttributeMaxDynamicSharedMemorySize, LDS_BYTES) != hipSuccess || hipFuncSetAttribute((const void*)hybrid_fwd<1>, hipFuncAttributeMaxDynamicSharedMemorySize, LDS_BYTES) != hipSuccess ||
            hipFuncSetAttribute((const void*)hybrid_fwd<2>, hipFuncAttributeMaxDynamicSharedMemorySize, LDS_BYTES) != hipSuccess || hipFuncSetAttribute((const void*)hybrid_fwd<3>, hipFuncAttributeMaxDynamicSharedMemorySize, LDS_BYTES) != hipSuccess) { fprintf(stderr, "kernel_launch: hipFuncSetAttribute failed\n"); grid = -1; return; }
#endif
        if (hipOccupancyMaxActiveBlocksPerMultiprocessor(&per_cu, (const void*)hybrid_fwd<(ONE_LAUNCH ? -1 : 0)>, NTHR, LDS_BYTES) != hipSuccess || per_cu < 1) fprintf(stderr, "kernel_launch: occupancy query reports %d workgroups per CU\n", per_cu);
        (void)hipGetLastError();
        grid = cus;
        if (grid != 256) { fprintf(stderr, "kernel_launch: %d CUs; this kernel is laid out for 256 workgroups; nothing launched\n", grid); grid = -1; return; }
    }
    if (grid < 0) return;
    if (hipMemsetAsync((char*)d_ws + WS_CTL, 0, CTL_ZERO_BYTES, stream) != hipSuccess) return;
    Args a{};
    for (int i = 0; i < 40; ++i) a.in[i] = (const float*)d_in[i];
    a.out = (float*)d_out; a.ws = (unsigned char*)d_ws;
    for (int j = 0; j < 32; ++j) a.inv_freq[j] = (float)pow(10000.0, -(double)j / 32.0);
#if ONE_LAUNCH
    a.g_lo = 0; a.g_hi = G_END;
    hipLaunchKernelGGL(hybrid_fwd<-1>, dim3(grid), dim3(NTHR), LDS_BYTES, stream, a);
#else
    for (int g = 0; g < G_END; ++g) {
        a.g_lo = g; a.g_hi = g + 1;
        int grp = 1;
        if (g >= 1 && g < G_FINAL) { const int k = (g - 1) % NPH; grp = (k == 0 || k == 4) ? 1 : (k == 5) ? 2 : (k == 6) ? 3 : 0; }
        if (grp == 0) hipLaunchKernelGGL(hybrid_fwd<0>, dim3(grid), dim3(NTHR), LDS_BYTES, stream, a);
        else if (grp == 1) hipLaunchKernelGGL(hybrid_fwd<1>, dim3(grid), dim3(NTHR), LDS_BYTES, stream, a);
        else if (grp == 2) hipLaunchKernelGGL(hybrid_fwd<2>, dim3(grid), dim3(NTHR), LDS_BYTES, stream, a);
        else hipLaunchKernelGGL(hybrid_fwd<3>, dim3(grid), dim3(NTHR), LDS_BYTES, stream, a);
    }
#endif
}
```

```cpp
#include <hip/hip_runtime.h>
#include <cstdio>
#include <cstdint>
#include <cmath>

namespace pg8 {
#define PG8_LAS __attribute__((address_space(3)))
typedef unsigned short bf16_t;
typedef short bf16x8 __attribute__((ext_vector_type(8)));
typedef float f32x4 __attribute__((ext_vector_type(4)));
typedef unsigned u32x4 __attribute__((ext_vector_type(4)));
constexpr int BM = 256, BK = 64, HALF = 128, HTB = HALF * BK * 2  , STAGE_BYTES = 8 * HTB, NXCD = 8, WGM = 8;

__host__ __device__ __forceinline__ int lds_byte(int r, int c) { const int st = (r >> 4) * 2 + (c >> 5), rr = r & 15, cc = c & 31, ob = rr * 64 + cc * 2; return st * 1024 + (ob ^ (((ob >> 9) & 1) << 5)); }
__host__ __device__ __forceinline__ void stage_rc(int b, int& R, int& C) { const int st = b / 1024, sb = b % 1024, swz = sb ^ (((sb >> 9) & 1) << 5); R = (st >> 1) * 16 + swz / 64; C = (st & 1) * 32 + (swz % 64) / 2; }
__host__ __device__ __forceinline__ int perm32(int rho) { const int n = rho >> 4, i = rho & 15; return 8 * (i >> 2) + 4 * n + (i & 3); }

struct Unit { int pm, pn, z; };
struct Gemm { const bf16_t* A; const bf16_t* Bt; int M, N, K, lda; };

struct StaticOrder {
    int nM, nN, nwg, G, c;
    __host__ __device__ void init(int M, int N, int G_, int c_) { nM = M / BM; nN = N / BM; nwg = nM * nN; G = G_; c = c_; }
    __host__ __device__ bool next(int i, Unit& u) const {
        const long L = (long)i * G + c; if (L >= nwg) return false;
        int wgid = (int)L; { const int q = nwg / NXCD, r = nwg % NXCD, xcd = wgid % NXCD, off = wgid / NXCD; wgid = (xcd < r ? xcd * (q + 1) : r * (q + 1) + (xcd - r) * q) + off; }
        const int nig = WGM * nN, gid = wgid / nig, fm = gid * WGM, gsz = (nM - fm) < WGM ? (nM - fm) : WGM;
        u.pm = fm + ((wgid % nig) % gsz); u.pn = (wgid % nig) / gsz; u.z = 0; return true;
    }
    __device__ __forceinline__ void a_ready(const Unit&) const {}
    __device__ __forceinline__ void done(const Unit&) const {}
    __device__ __forceinline__ size_t a_off(const Unit&) const { return 0; }
    __device__ __forceinline__ int b_tile(const Unit& u) const { return u.pn; }
};
struct GroupedOrder {
    StaticOrder base; int NZ, Kbytes, tiles_per_group;
    __device__ void init(int M, int N, int NZ_, int K, int G_, int c_) { base.init(M, N, G_, c_); NZ = NZ_; Kbytes = K * 2; tiles_per_group = N / BM; }
    __device__ bool next(int i, Unit& u) const { const int r = i / NZ, z = i - r * NZ; if (!base.next(r, u)) return false; u.z = z; return true; }
    __device__ __forceinline__ void a_ready(const Unit&) const {}
    __device__ __forceinline__ void done(const Unit&) const {}
    __device__ __forceinline__ size_t a_off(const Unit& u) const { return (size_t)u.z * Kbytes; }
    __device__ __forceinline__ int b_tile(const Unit& u) const { return u.z * tiles_per_group + u.pn; }
};

__device__ __forceinline__ unsigned cvt_pk_bf16(float lo, float hi) { unsigned r; asm volatile("v_cvt_pk_bf16_f32 %0, %1, %2" : "=v"(r) : "v"(lo), "v"(hi)); return r; }
__device__ __forceinline__ float bf_lo(unsigned w) { return __uint_as_float(w << 16); }
__device__ __forceinline__ float bf_hi(unsigned w) { return __uint_as_float(w & 0xffff0000u); }
__device__ __forceinline__ float fast_sigmoid(float x) { return __builtin_amdgcn_rcpf(1.0f + __builtin_amdgcn_exp2f(-1.4426950408889634f * x)); }

__device__ __forceinline__ float row_rstd(const float* ssq, int row, int M_) {
    const float s = (ssq[row] + ssq[M_ + row]) + (ssq[2 * M_ + row] + ssq[3 * M_ + row]);
    return 1.0f / sqrtf(s * (1.0f / 1024.0f) + 1e-6f);
}
struct EpiScaleBf16 {
    static constexpr bool PERM = true, AFTER_DRAIN = false;
    bf16_t* O; int ldc; const float* ssq; int M_;
    __device__ __forceinline__ void operator()(const f32x4 (&acc)[2][2][4][2], const Unit& u, int wr, int wc, int fr, int fq) const {
        const int row0 = u.pm * BM + wr * 64 + fr; const int col0 = u.pn * BM + wc * 32 + 8 * fq;
#pragma unroll
        for (int ai = 0; ai < 2; ++ai)
#pragma unroll
            for (int m = 0; m < 4; ++m) { const int row = row0 + ai * HALF + m * 16; const float rs = row_rstd(ssq, row, M_); bf16_t* rowp = O + (size_t)row * ldc + col0;
#pragma unroll
                for (int bj = 0; bj < 2; ++bj) { const f32x4 v0 = acc[ai][bj][m][0] * rs, v1 = acc[ai][bj][m][1] * rs;
                    u32x4 w; w.x = cvt_pk_bf16(v0[0], v0[1]); w.y = cvt_pk_bf16(v0[2], v0[3]); w.z = cvt_pk_bf16(v1[0], v1[1]); w.w = cvt_pk_bf16(v1[2], v1[3]);
                    *(u32x4*)(rowp + bj * HALF) = w; } }
    }
};
struct EpiSwiglu {
    static constexpr bool PERM = true, AFTER_DRAIN = false;
    bf16_t* O; int ldc; const float* ssq; int M_;
    __device__ __forceinline__ void operator()(const f32x4 (&acc)[2][2][4][2], const Unit& u, int wr, int wc, int fr, int fq) const {
        const int row0 = u.pm * BM + wr * 64 + fr; const int col0 = u.pn * HALF + wc * 32 + 8 * fq;
#pragma unroll
        for (int ai = 0; ai < 2; ++ai)
#pragma unroll
            for (int m = 0; m < 4; ++m) { const int row = row0 + ai * HALF + m * 16; const float rs = row_rstd(ssq, row, M_); bf16_t* rowp = O + (size_t)row * ldc + col0;
                float o[8];
#pragma unroll
                for (int n = 0; n < 2; ++n)
#pragma unroll
                    for (int i = 0; i < 4; ++i) { const float g = acc[ai][0][m][n][i] * rs, up = acc[ai][1][m][n][i] * rs; o[n * 4 + i] = g * fast_sigmoid(g) * up; }
                u32x4 w; w.x = cvt_pk_bf16(o[0], o[1]); w.y = cvt_pk_bf16(o[2], o[3]); w.z = cvt_pk_bf16(o[4], o[5]); w.w = cvt_pk_bf16(o[6], o[7]);
                *(u32x4*)rowp = w; }
    }
};
struct EpiGateAcc {
    static constexpr bool PERM = true, AFTER_DRAIN = false;
    bf16_t* O; const bf16_t* PG; const float* gb;
    __device__ __forceinline__ void operator()(const f32x4 (&acc)[2][2][4][2], const Unit& u, int wr, int wc, int fr, int fq) const {
        const int row0 = u.pm * BM + wr * 64 + fr; const int col0 = u.pn * BM + wc * 32 + 8 * fq; const int z = u.z;
        f32x4 gbv[2][2];
#pragma unroll
        for (int bj = 0; bj < 2; ++bj)
#pragma unroll
            for (int n = 0; n < 2; ++n) gbv[bj][n] = *(const f32x4*)(gb + z * 1024 + col0 + bj * HALF + 4 * n);
#pragma unroll
        for (int ai = 0; ai < 2; ++ai)
#pragma unroll
            for (int m = 0; m < 4; ++m) { const int row = row0 + ai * HALF + m * 16;
#pragma unroll
                for (int bj = 0; bj < 2; ++bj) {
                    const u32x4 pg = *(const u32x4*)(PG + (size_t)row * 4096 + z * 1024 + col0 + bj * HALF);
                    bf16_t* op = O + (size_t)row * 1024 + col0 + bj * HALF;
                    float o[8];
                    o[0] = fast_sigmoid(bf_lo(pg.x) + gbv[bj][0][0]) * acc[ai][bj][m][0][0]; o[1] = fast_sigmoid(bf_hi(pg.x) + gbv[bj][0][1]) * acc[ai][bj][m][0][1];
                    o[2] = fast_sigmoid(bf_lo(pg.y) + gbv[bj][0][2]) * acc[ai][bj][m][0][2]; o[3] = fast_sigmoid(bf_hi(pg.y) + gbv[bj][0][3]) * acc[ai][bj][m][0][3];
                    o[4] = fast_sigmoid(bf_lo(pg.z) + gbv[bj][1][0]) * acc[ai][bj][m][1][0]; o[5] = fast_sigmoid(bf_hi(pg.z) + gbv[bj][1][1]) * acc[ai][bj][m][1][1];
                    o[6] = fast_sigmoid(bf_lo(pg.w) + gbv[bj][1][2]) * acc[ai][bj][m][1][2]; o[7] = fast_sigmoid(bf_hi(pg.w) + gbv[bj][1][3]) * acc[ai][bj][m][1][3];
                    if (z > 0) { const u32x4 pv = *(const u32x4*)op;
                        o[0] += bf_lo(pv.x); o[1] += bf_hi(pv.x); o[2] += bf_lo(pv.y); o[3] += bf_hi(pv.y); o[4] += bf_lo(pv.z); o[5] += bf_hi(pv.z); o[6] += bf_lo(pv.w); o[7] += bf_hi(pv.w); }
                    u32x4 w; w.x = cvt_pk_bf16(o[0], o[1]); w.y = cvt_pk_bf16(o[2], o[3]); w.z = cvt_pk_bf16(o[4], o[5]); w.w = cvt_pk_bf16(o[6], o[7]);
                    *(u32x4*)op = w; } }
    }
};
struct EpiResid {
    static constexpr bool PERM = true, AFTER_DRAIN = true;
    float* H; bf16_t* HB; float* ssq; int M_; float s;
    __device__ __forceinline__ void fused(f32x4 (&acc)[2][2][4][2], const Unit& u, int wr, int wc, int fr, int fq, PG8_LAS unsigned char* lds, int wid, int lane) const {
        PG8_LAS float* P = (PG8_LAS float*)lds;
        const int row0 = u.pm * BM + wr * 64 + fr; const int col0 = u.pn * BM + wc * 32 + 8 * fq;
#pragma unroll
        for (int ai = 0; ai < 2; ++ai)
#pragma unroll
            for (int m = 0; m < 4; ++m) { const int row = row0 + ai * HALF + m * 16; float q = 0.f;
#pragma unroll
                for (int bj = 0; bj < 2; ++bj) { float* hp = H + (size_t)row * 1024 + col0 + bj * HALF;
                    const f32x4 h0 = *(const f32x4*)hp + acc[ai][bj][m][0] * s, h1 = *(const f32x4*)(hp + 4) + acc[ai][bj][m][1] * s;
                    *(f32x4*)hp = h0; *(f32x4*)(hp + 4) = h1;
                    q += (h0[0] * h0[0] + h0[1] * h0[1]) + (h0[2] * h0[2] + h0[3] * h0[3]) + (h1[0] * h1[0] + h1[1] * h1[1]) + (h1[2] * h1[2] + h1[3] * h1[3]);
                    u32x4 w; w.x = cvt_pk_bf16(h0[0], h0[1]); w.y = cvt_pk_bf16(h0[2], h0[3]); w.z = cvt_pk_bf16(h1[0], h1[1]); w.w = cvt_pk_bf16(h1[2], h1[3]);
                    *(u32x4*)(HB + (size_t)row * 1024 + col0 + bj * HALF) = w; }
                q += __shfl_xor(q, 16); q += __shfl_xor(q, 32);
                if (fq == 0) P[(ai * HALF + wr * 64 + m * 16 + fr) * 4 + wc] = q; }
        asm volatile("s_waitcnt lgkmcnt(0)" ::: "memory"); __builtin_amdgcn_s_barrier(); asm volatile("" ::: "memory");
        const int t = wid * 64 + lane;
        if (t < 256) { const float q = (P[t * 4 + 0] + P[t * 4 + 1]) + (P[t * 4 + 2] + P[t * 4 + 3]); ssq[(size_t)u.pn * M_ + u.pm * BM + t] = q; }
        asm volatile("s_waitcnt lgkmcnt(0)" ::: "memory"); __builtin_amdgcn_s_barrier(); asm volatile("" ::: "memory");
    }
};
template <class Epi, class Sched, bool ALIGN_EPI = false, bool SP2 = false>
__device__ __forceinline__ void gemm_phase(PG8_LAS unsigned char* lds, const Gemm g, const Sched& S, const Epi& E) {
    int tid_ = threadIdx.x; asm volatile("" : "+v"(tid_)); const int tid = tid_, wid = __builtin_amdgcn_readfirstlane(tid >> 6), lane = tid & 63, wr = wid >> 2, wc = wid & 3, fr = lane & 15, fq = lane >> 4;
    const int K = g.K, nt = K / BK;
    unsigned voffA[2], voffB[2];
#pragma unroll
    for (int i = 0; i < 2; ++i) { int R, C; stage_rc(tid * 16 + i * 8192, R, C); const int Rb = Epi::PERM ? ((R & ~31) + perm32(R & 31)) : R;
        voffA[i] = (unsigned)(R * g.lda + C) * 2u; voffB[i] = (unsigned)(Rb * K + C) * 2u; }
    const size_t kstep = (size_t)(BK * 2);
    const size_t hstep = (size_t)HALF * K * 2;
    const size_t tstep = 2 * hstep; const size_t hstepA = (size_t)HALF * g.lda * 2, tstepA = 2 * hstepA;
    const unsigned ldsw = (unsigned)wid * 1024u;
    const int aoff = lds_byte(wr * 64 + fr, fq * 8), boff = lds_byte(wc * 32 + fr, fq * 8);
#define PG8_SA(b, h) (((b) * 2 + (h)) * HTB)
#define PG8_SB(b, h) ((4 + (b) * 2 + (h)) * HTB)
#define PG8_STAGE(bufoff, gbase, voff) do { _Pragma("unroll") for (int _i = 0; _i < 2; ++_i) \
        __builtin_amdgcn_global_load_lds((const unsigned*)((const char*)(gbase) + (voff)[_i]), (PG8_LAS unsigned*)(lds + (bufoff) + ldsw + _i * 8192), 16, 0, 0); } while (0)
#define PG8_LDA(dst, b, h) do { _Pragma("unroll") for (int m = 0; m < 4; ++m) _Pragma("unroll") for (int k = 0; k < 2; ++k) dst[m][k] = *(const PG8_LAS bf16x8*)(lds + PG8_SA(b, h) + aoff + m * 2048 + k * 1024); } while (0)
#define PG8_LDB(dst, b, h) do { _Pragma("unroll") for (int n = 0; n < 2; ++n) _Pragma("unroll") for (int k = 0; k < 2; ++k) dst[n][k] = *(const PG8_LAS bf16x8*)(lds + PG8_SB(b, h) + boff + n * 2048 + k * 1024); } while (0)
#define PG8_MMA(ai, bj, At, Bt) do { __builtin_amdgcn_s_setprio(1); _Pragma("unroll") for (int m = 0; m < 4; ++m) _Pragma("unroll") for (int n = 0; n < 2; ++n) _Pragma("unroll") for (int k = 0; k < 2; ++k) \
        acc[ai][bj][m][n] = __builtin_amdgcn_mfma_f32_16x16x32_bf16(Bt[n][k], At[m][k], acc[ai][bj][m][n], 0, 0, 0); __builtin_amdgcn_s_setprio(0); } while (0)
#define PG8_WAIT_V(n) asm volatile("s_waitcnt vmcnt(" #n ")" ::: "memory")
#define PG8_WAIT_L(n) asm volatile("s_waitcnt lgkmcnt(" #n ")" ::: "memory")
#define PG8_BAR __builtin_amdgcn_s_barrier()
#define PG8_SCHED __builtin_amdgcn_sched_barrier(0)
    Unit cur, nxt; int ui = 0;
    if (!S.next(0, cur)) return;
    f32x4 acc[2][2][4][2];
#pragma unroll
    for (int a = 0; a < 2; ++a)
#pragma unroll
        for (int b = 0; b < 2; ++b)
#pragma unroll
            for (int m = 0; m < 4; ++m)
#pragma unroll
                for (int n = 0; n < 2; ++n) acc[a][b][m][n] = (f32x4){0.f, 0.f, 0.f, 0.f};
    bf16x8 At[4][2], B0[2][2], B1[2][2];
    const char* cA = (const char*)g.A + (size_t)cur.pm * tstepA + S.a_off(cur); const char* cB = (const char*)g.Bt + (size_t)S.b_tile(cur) * tstep;
    S.a_ready(cur);
    if constexpr (SP2) {
        PG8_STAGE(PG8_SB(0, 0), cB, voffB); PG8_STAGE(PG8_SB(0, 1), cB + hstep, voffB); PG8_STAGE(PG8_SA(0, 0), cA, voffA); PG8_STAGE(PG8_SA(0, 1), cA + hstepA, voffA);
        if (wr == 1) PG8_BAR;
        PG8_WAIT_V(2); PG8_BAR;
        PG8_STAGE(PG8_SB(1, 0), cB + kstep, voffB); PG8_STAGE(PG8_SA(1, 0), cA + kstep, voffA); PG8_STAGE(PG8_SB(1, 1), cB + hstep + kstep, voffB);
        PG8_WAIT_V(6); PG8_BAR;
    } else {
        PG8_STAGE(PG8_SB(0, 0), cB, voffB); PG8_STAGE(PG8_SA(0, 0), cA, voffA); PG8_STAGE(PG8_SB(0, 1), cB + hstep, voffB); PG8_STAGE(PG8_SA(0, 1), cA + hstepA, voffA);
        if (wr == 1) PG8_BAR;
        PG8_WAIT_V(4); PG8_BAR;
        PG8_STAGE(PG8_SB(1, 0), cB + kstep, voffB); PG8_STAGE(PG8_SA(1, 0), cA + kstep, voffA); PG8_STAGE(PG8_SB(1, 1), cB + hstep + kstep, voffB);
        PG8_WAIT_V(6); PG8_BAR;
    }
    for (;;) {
        const bool has_next = S.next(ui + 1, nxt);
        const char* nA = has_next ? (const char*)g.A + (size_t)nxt.pm * tstepA + S.a_off(nxt) : cA; const char* nB = has_next ? (const char*)g.Bt + (size_t)S.b_tile(nxt) * tstep : cB;
        for (int t = 0; t < nt; t += 2) {
            const bool last = (t == nt - 2);
            const char* a1 = cA + (size_t)(t + 1) * kstep;
            const char* a2 = last ? nA : cA + (size_t)(t + 2) * kstep; const char* b2 = last ? nB : cB + (size_t)(t + 2) * kstep;
            const char* a3 = a2 + kstep; const char* b3 = b2 + kstep;
            if (last && has_next) S.a_ready(nxt);
            if constexpr (SP2) {
            PG8_LDB(B0, 0, 0); PG8_LDB(B1, 0, 1); PG8_SCHED; PG8_LDA(At, 0, 0); PG8_STAGE(PG8_SA(1, 1), a1 + hstepA, voffA);
            PG8_WAIT_V(8); PG8_WAIT_L(0); PG8_BAR; PG8_MMA(0, 0, At, B0); PG8_MMA(0, 1, At, B1); PG8_BAR; PG8_SCHED;
            PG8_LDA(At, 0, 1); PG8_STAGE(PG8_SB(0, 0), b2, voffB); PG8_STAGE(PG8_SB(0, 1), b2 + hstep, voffB); PG8_STAGE(PG8_SA(0, 0), a2, voffA);
            PG8_WAIT_V(8); PG8_WAIT_L(0); PG8_BAR; PG8_MMA(1, 0, At, B0); PG8_MMA(1, 1, At, B1); PG8_BAR; PG8_SCHED;
            PG8_LDB(B0, 1, 0); PG8_LDB(B1, 1, 1); PG8_SCHED; PG8_LDA(At, 1, 0); PG8_STAGE(PG8_SA(0, 1), a2 + hstepA, voffA);
            PG8_WAIT_V(8); PG8_WAIT_L(0); PG8_BAR; PG8_MMA(0, 0, At, B0); PG8_MMA(0, 1, At, B1); PG8_BAR; PG8_SCHED;
            PG8_LDA(At, 1, 1); PG8_STAGE(PG8_SB(1, 0), b3, voffB); PG8_STAGE(PG8_SB(1, 1), b3 + hstep, voffB); PG8_STAGE(PG8_SA(1, 0), a3, voffA);
            PG8_WAIT_V(8); PG8_WAIT_L(0); PG8_BAR; PG8_MMA(1, 0, At, B0); PG8_MMA(1, 1, At, B1); PG8_BAR; PG8_SCHED;
            } else {
            PG8_LDB(B0, 0, 0); PG8_SCHED; PG8_LDA(At, 0, 0); PG8_STAGE(PG8_SA(1, 1), a1 + hstepA, voffA);
            PG8_WAIT_L(8); PG8_BAR; PG8_WAIT_L(0); PG8_MMA(0, 0, At, B0); PG8_BAR; PG8_SCHED;
            PG8_LDB(B1, 0, 1); PG8_STAGE(PG8_SB(0, 0), b2, voffB);
            PG8_BAR; PG8_WAIT_L(0); PG8_MMA(0, 1, At, B1); PG8_BAR;
            PG8_LDA(At, 0, 1); PG8_STAGE(PG8_SA(0, 0), a2, voffA);
            PG8_BAR; PG8_WAIT_L(0); PG8_MMA(1, 0, At, B0); PG8_BAR; PG8_SCHED;
            PG8_STAGE(PG8_SB(0, 1), b2 + hstep, voffB);
            PG8_WAIT_V(6); PG8_BAR; PG8_MMA(1, 1, At, B1); PG8_BAR;
            PG8_LDB(B0, 1, 0); PG8_SCHED; PG8_LDA(At, 1, 0); PG8_STAGE(PG8_SA(0, 1), a2 + hstepA, voffA);
            PG8_WAIT_L(8); PG8_BAR; PG8_WAIT_L(0); PG8_MMA(0, 0, At, B0); PG8_BAR; PG8_SCHED;
            PG8_LDB(B1, 1, 1); PG8_STAGE(PG8_SB(1, 0), b3, voffB);
            PG8_BAR; PG8_WAIT_L(0); PG8_MMA(0, 1, At, B1); PG8_BAR;
            PG8_LDA(At, 1, 1); PG8_STAGE(PG8_SA(1, 0), a3, voffA);
            PG8_BAR; PG8_WAIT_L(0); PG8_MMA(1, 0, At, B0); PG8_BAR; PG8_SCHED;
            PG8_STAGE(PG8_SB(1, 1), b3 + hstep, voffB);
            PG8_WAIT_V(6); PG8_BAR; PG8_MMA(1, 1, At, B1); PG8_BAR;
            }
        }
        if constexpr (ALIGN_EPI) { if (wr == 0) PG8_BAR; }
        if constexpr (!Epi::AFTER_DRAIN) { E(acc, cur, wr, wc, fr, fq); S.done(cur); }
        if (!has_next) break;
#pragma unroll
        for (int a = 0; a < 2; ++a)
#pragma unroll
            for (int b = 0; b < 2; ++b)
#pragma unroll
                for (int m = 0; m < 4; ++m)
#pragma unroll
                    for (int n = 0; n < 2; ++n) acc[a][b][m][n] = (f32x4){0.f, 0.f, 0.f, 0.f};
        cur = nxt; cA = nA; cB = nB; ++ui;
        if constexpr (ALIGN_EPI) { if (wr == 1) PG8_BAR; }
    }
    PG8_WAIT_V(0);
    if constexpr (!ALIGN_EPI) { if (wr == 0) PG8_BAR; }
    PG8_BAR;
    if constexpr (Epi::AFTER_DRAIN) { E.fused(acc, cur, wr, wc, fr, fq, lds, wid, lane); S.done(cur); }
#undef PG8_SA
#undef PG8_SB
#undef PG8_STAGE
#undef PG8_LDA
#undef PG8_LDB
#undef PG8_MMA
#undef PG8_WAIT_V
#undef PG8_WAIT_L
#undef PG8_BAR
#undef PG8_SCHED
}
}

constexpr int NWAVES = 8, NTHR = 512;
constexpr int M = 16384, SEQ = 8192, D = 1024, FF = 2816, NL = 4, NCH = 128  , NBC = 256  ;
constexpr int NPM = 6656;
constexpr int NWIN = 10752;
constexpr int C_DAQ = 0, C_DAK = 512, C_DAV = 1024, C_GQ = 1536, C_GK = 1792, C_GV = 2048, C_GOG = 2560, C_SZ = 3072, C_SX = 3584, C_SB = 4096, C_SC = 4352,
              C_RR = 4608, C_RK = 5120, C_RV = 5632, C_RWL = 6144, C_RAL = 6208, C_RGL = 6272, C_GLR = 6400, C_SDT = 6416;
constexpr float EPS = 1e-6f, LOG2E = 1.4426950408889634f;

constexpr size_t MiB = 1u << 20;
constexpr size_t WS_CTL = 0, CTL_ZERO_BYTES = 1 * MiB;
constexpr size_t WS_COS = 1 * MiB, WS_SIN = 2 * MiB, WS_SSQ = 3 * MiB, WS_GLAST = 3 * MiB + 512 * 1024, WS_SDT = 4 * MiB, WS_SACUM = 4 * MiB + 512 * 1024, WS_SCDEC = 5 * MiB;
constexpr size_t WS_WGU1 = 8 * MiB, WS_WD1 = 19 * MiB, WS_WIN = 24 * MiB + 512 * 1024, WS_WB = 45 * MiB + 512 * 1024, WS_WO = 49 * MiB + 512 * 1024, WS_WGU2 = 51 * MiB + 512 * 1024, WS_WD2 = 62 * MiB + 512 * 1024;
constexpr size_t WS_HB = 68 * MiB, WS_P = 100 * MiB, WS_PG = 100 * MiB, WS_YS = 308 * MiB, WS_R1 = 372 * MiB, WS_R2 = 500 * MiB, WS_END = 644 * MiB;
constexpr size_t WS_ACT = WS_R1, WS_MERGED = WS_R1;
constexpr size_t WS_RWW = WS_R1, WS_RWR = WS_R1 + 32 * MiB, WS_RWK = WS_R1 + 48 * MiB, WS_RWV = WS_R1 + 64 * MiB, WS_RWKK = WS_R1 + 80 * MiB, WS_RWB = WS_R1 + 96 * MiB, WS_RWG = WS_R1 + 112 * MiB;
constexpr size_t WS_VT = WS_R2, WS_GKV = WS_R2 + 16 * MiB, WS_SST = WS_R2 + 48 * MiB, WS_RWY = WS_R2 + 112 * MiB;
static_assert(WS_WD2 + (size_t)D * FF * 2 <= WS_HB && WS_P + (size_t)M * NPM * 2 <= WS_YS && WS_RWY + (size_t)M * 512 * 2 <= WS_END, "d_ws map");
constexpr int CW_BAR = 4096;

constexpr int RING_BYTES = 131072, LDSCTL_OFF = RING_BYTES, MISC_OFF = LDSCTL_OFF + 320, LDS_BYTES = 147456;

#define GAS __attribute__((address_space(1)))
#define LAS __attribute__((address_space(3)))
typedef unsigned short bf16;
typedef unsigned v4u __attribute__((ext_vector_type(4)));
typedef float f32x4 __attribute__((ext_vector_type(4)));
typedef short bf16x8 __attribute__((ext_vector_type(8)));
typedef GAS unsigned gu32;
typedef GAS unsigned long long gu64;
#define RLX_AGENT __ATOMIC_RELAXED, __HIP_MEMORY_SCOPE_AGENT
#define LDS_WAIT() asm volatile("s_waitcnt lgkmcnt(0)" ::: "memory")
#define VM_WAIT() asm volatile("s_waitcnt vmcnt(0)" ::: "memory")
__device__ __forceinline__ unsigned long long rt() { return __builtin_amdgcn_s_memrealtime(); }
__device__ __forceinline__ unsigned f2bf(float f) { unsigned u = __builtin_bit_cast(unsigned, f); return (u + 0x7fffu + ((u >> 16) & 1u)) >> 16; }
__device__ __forceinline__ unsigned pk2(float lo, float hi) { return f2bf(lo) | (f2bf(hi) << 16); }

#define XB_TMO      128
#define XB_XCNT(j)  (256  + 64 * (j))
#define XB_XSUB(j)  (1280 + 64 * (j))
#define XB_XGEN(j)  (2304 + 64 * (j))
#define XB_TOP      3328
#define XB_TOPGEN   3392
#define XCD_BAR_WORDS 3456
#define XB_SPIN_CAP (1u << 18)

__device__ __forceinline__ unsigned xb_ld(unsigned* p)              { return __hip_atomic_load(p, __ATOMIC_RELAXED, __HIP_MEMORY_SCOPE_AGENT); }
__device__ __forceinline__ unsigned xb_add(unsigned* p, unsigned v) { return __hip_atomic_fetch_add(p, v, __ATOMIC_RELAXED, __HIP_MEMORY_SCOPE_AGENT); }
__device__ __forceinline__ unsigned xb_xcc_id() { return (unsigned)__builtin_amdgcn_s_getreg((3 << 11) | 20) & 0xFu; }
#define XB_SPIN(cond, bar) do { unsigned _sp = 0; while (cond) { __builtin_amdgcn_s_sleep(1); \
    if ((++_sp & 255u) == 0u) { if (xb_ld(&(bar)[XB_TMO])) break; if (_sp > XB_SPIN_CAP) { atomicAdd(&(bar)[XB_TMO], 1u); break; } } } } while (0)

struct XcdBarrier {
    unsigned* bar; unsigned x;
    volatile LAS unsigned* st;
};

__device__ __forceinline__ XcdBarrier xcd_barrier_post(unsigned* bar, volatile LAS unsigned* st) {
    XcdBarrier b; b.bar = bar; b.x = xb_xcc_id(); b.st = st;
    if (threadIdx.x == 0) (void)xb_add(&bar[XB_XCNT(b.x)], 1u);
    return b;
}
__device__ __forceinline__ void xcd_barrier_complete(unsigned* bar, unsigned x, unsigned& nloc, unsigned& nx) {
    const unsigned G = gridDim.x * gridDim.y * gridDim.z;
    unsigned sum, cnt, mine, sp = 0u;
    for (;;) {
        sum = 0u; cnt = 0u; mine = 0u;
#pragma unroll
        for (unsigned j = 0; j < 16; ++j) { const unsigned c = xb_ld(&bar[XB_XCNT(j)]); sum += c; cnt += (c > 0u) ? 1u : 0u; mine = (j == x) ? c : mine; }
        if (sum == G) break;
        __builtin_amdgcn_s_sleep(1);
        if ((++sp & 255u) == 0u) { if (xb_ld(&bar[XB_TMO])) break; if (sp > XB_SPIN_CAP) { atomicAdd(&bar[XB_TMO], 1u); break; } }
    }
    nloc = mine > 0u ? mine : 1u; nx = cnt > 0u ? cnt : 1u;
}

__device__ __forceinline__ void xcd_barrier(const XcdBarrier& b) {
    asm volatile("s_waitcnt vmcnt(0)" ::: "memory");
    __syncthreads();
    if (threadIdx.x == 0) {
        unsigned* bar = b.bar;
        __builtin_amdgcn_s_waitcnt(0);
        unsigned nloc = b.st[0], nx = b.st[1];
        if (nloc == 0u) { xcd_barrier_complete(bar, b.x, nloc, nx); b.st[0] = nloc; b.st[1] = nx; }
        const unsigned old = xb_add(&bar[XB_XSUB(b.x)], 1u);
        const unsigned gen = old / nloc;
        if (old + 1u == (gen + 1u) * nloc) {
            __builtin_amdgcn_fence(__ATOMIC_RELEASE, "agent");
            asm volatile("s_waitcnt vmcnt(0)" ::: "memory");
            const unsigned og = xb_add(&bar[XB_TOP], 1u);
            const unsigned tg = og / nx;
            if (og + 1u == (tg + 1u) * nx) xb_add(&bar[XB_TOPGEN], 1u);
            else XB_SPIN(xb_ld(&bar[XB_TOPGEN]) == tg, bar);
            __builtin_amdgcn_fence(__ATOMIC_ACQUIRE, "agent");
            xb_add(&bar[XB_XGEN(b.x)], 1u);
            asm volatile("s_waitcnt vmcnt(0)" ::: "memory");
        } else {
            XB_SPIN(xb_ld(&bar[XB_XGEN(b.x)]) == gen, bar);
            __builtin_amdgcn_fence(__ATOMIC_ACQUIRE, "agent");
            asm volatile("s_waitcnt vmcnt(0)" ::: "memory");
        }
    }
    __syncthreads();
}

struct Args { const float* in[40]; float* out; unsigned char* ws; float inv_freq[32]; int g_lo, g_hi; };
typedef const __attribute__((address_space(4))) Args* ArgsP;
typedef LAS float* LF; typedef const LAS float* CLF;
#ifndef PH_FN
#define PH_FN __device__ __noinline__
#endif
#ifndef PH_HEAVY
#define PH_HEAVY __device__ __forceinline__
#endif
struct Ctx {
    LAS unsigned char* lds;
    unsigned char* ws; float* h;
    int tid, lane, wave, bid, G;
};
typedef unsigned u32x4 __attribute__((ext_vector_type(4)));
typedef unsigned u32x2 __attribute__((ext_vector_type(2)));
typedef float f32x2 __attribute__((ext_vector_type(2)));
typedef float f32x16 __attribute__((ext_vector_type(16)));
__device__ __forceinline__ float bf2f(bf16 x) { return __uint_as_float((unsigned)x << 16); }
__device__ __forceinline__ float bflo(unsigned w) { return __uint_as_float(w << 16); }
__device__ __forceinline__ float bfhi(unsigned w) { return __uint_as_float(w & 0xffff0000u); }
__device__ __forceinline__ void unpack8(const u32x4 w, float* o) { o[0] = bflo(w.x); o[1] = bfhi(w.x); o[2] = bflo(w.y); o[3] = bfhi(w.y); o[4] = bflo(w.z); o[5] = bfhi(w.z); o[6] = bflo(w.w); o[7] = bfhi(w.w); }
__device__ __forceinline__ u32x4 pack8(const float* o) { u32x4 w; w.x = pk2(o[0], o[1]); w.y = pk2(o[2], o[3]); w.z = pk2(o[4], o[5]); w.w = pk2(o[6], o[7]); return w; }
__device__ __forceinline__ float sigmoidf_(float x) { return 1.0f / (1.0f + __expf(-x)); }
__device__ __forceinline__ float siluf_(float x) { return x * sigmoidf_(x); }
__device__ __forceinline__ float softplusf_(float x) { return fmaxf(x, 0.f) + log1pf(__expf(-fabsf(x))); }
__device__ __forceinline__ float logsigmoidf_(float x) { return fminf(x, 0.f) - log1pf(__expf(-fabsf(x))); }
__device__ __forceinline__ float wave_sum(float v) {
#pragma unroll
    for (int o = 1; o < 64; o <<= 1) v += __shfl_xor(v, o);
    return v;
}
#define WG_SYNC() __syncthreads()
__device__ __forceinline__ Ctx fresh(const Ctx& C0) { Ctx C = C0; int t = threadIdx.x; asm volatile("" : "+v"(t)); C.tid = t; C.lane = t & 63; C.wave = __builtin_amdgcn_readfirstlane(t >> 6); return C; }

PH_FN void ph_prologue(const Ctx C, ArgsP a) {
    float* cosT = (float*)(C.ws + WS_COS); float* sinT = (float*)(C.ws + WS_SIN);
    for (int idx = C.bid * NTHR + C.tid; idx < SEQ * 32; idx += C.G * NTHR) {
        const int t = idx >> 5, j = idx & 31;
        const float ang = (float)t * a->inv_freq[j];
        const double rev = (double)ang * 0.15915494309189535;
        const float fr = (float)(rev - floor(rev));
        cosT[idx] = __builtin_amdgcn_cosf(fr); sinT[idx] = __builtin_amdgcn_sinf(fr);
    }
    const float* x = a->in[0]; bf16* hb = (bf16*)(C.ws + WS_HB); float* ssq = (float*)(C.ws + WS_SSQ);
    const int gw = C.bid * NWAVES + C.wave, NGW = C.G * NWAVES;
    for (int m = gw; m < M; m += NGW) {
        const f32x4* xr = (const f32x4*)(x + (size_t)m * D) + C.lane; f32x4* hr = (f32x4*)(C.h + (size_t)m * D) + C.lane;
        unsigned long long* o8 = (unsigned long long*)(hb + (size_t)m * D) + C.lane;
        float s = 0.f;
#pragma unroll
        for (int j = 0; j < 4; ++j) { const f32x4 v = xr[64 * j]; hr[64 * j] = v; s += (v.x * v.x + v.y * v.y) + (v.z * v.z + v.w * v.w);
            o8[64 * j] = (unsigned long long)pk2(v.x, v.y) | ((unsigned long long)pk2(v.z, v.w) << 32); }
        s = wave_sum(s);
        if (C.lane == 0) { ssq[m] = s; ssq[M + m] = 0.f; ssq[2 * M + m] = 0.f; ssq[3 * M + m] = 0.f; }
    }
}

template <class SrcF>
__device__ __forceinline__ void tr_item(const SrcF src, const float* gk, bf16* WT, int K, int kb, int nb, LF scr, int lane) {
    const int k0 = 64 * kb, n0 = 32 * nb;
    const int ld = src.ld(); const long co = src.col(n0 + (lane & 31)); const bool ok = co >= 0; const float* colp = src.base(n0 + (lane & 31)) + (ok ? co : 0);
#pragma unroll 8
    for (int i = 0; i < 32; ++i) { const int kk = 2 * i + (lane >> 5); float v = 0.f; if (ok) { v = colp[(size_t)(k0 + kk) * ld]; if (gk) v *= gk[k0 + kk]; } scr[kk * 33 + (lane & 31)] = v; }
    LDS_WAIT(); asm volatile("" ::: "memory");
    const int c = lane & 7;
#pragma unroll
    for (int j = 0; j < 4; ++j) { const int n = (lane >> 3) + 8 * j; CLF s = scr + (8 * c) * 33 + n;
        v4u o; o.x = pk2(s[0 * 33], s[1 * 33]); o.y = pk2(s[2 * 33], s[3 * 33]); o.z = pk2(s[4 * 33], s[5 * 33]); o.w = pk2(s[6 * 33], s[7 * 33]);
        *(v4u*)(WT + (size_t)(n0 + n) * K + k0 + 8 * c) = o; }
    LDS_WAIT(); asm volatile("" ::: "memory");
}
struct SrcGU { const float* wg; const float* wu;
    __device__ __forceinline__ int ld() const { return FF; }
    __device__ __forceinline__ const float* base(int n) const { const uintptr_t sel = (uintptr_t)((n >> 7) & 1); return (const float*)((uintptr_t)wg + sel * ((uintptr_t)wu - (uintptr_t)wg)); }
    __device__ __forceinline__ long col(int n) const { return 128 * (n >> 8) + (n & 127); } };
struct SrcPlain { const float* w; int ldw;
    __device__ __forceinline__ int ld() const { return ldw; }
    __device__ __forceinline__ const float* base(int) const { return w; }
    __device__ __forceinline__ long col(int n) const { return n; } };
struct SrcWin { const float* w;
    __device__ __forceinline__ int ld() const { return 10520; }
    __device__ __forceinline__ const float* base(int) const { return w; }
    __device__ __forceinline__ long col(int n) const {
        int c;
        if (n < 3072) c = n; else if (n < 4608) c = n - 3072 + 3088; else if (n < 6400) c = n - 4608 + 4632; else if (n < 6416) c = n - 6400 + 3072; else if (n < 6424) c = n - 6416 + 4624; else if (n < 6656) c = -1; else c = n - 6656 + 6424;
        return c; } };
PH_FN void ph_weights(const Ctx C, ArgsP a, int l) {
    LF scr = (LF)(C.lds + C.wave * 16384);
    const int gw = C.bid * NWAVES + C.wave, NGW = C.G * NWAVES;
#pragma unroll 1
    for (int f = 0; f < 2; ++f) {
        const float* nrm = a->in[f ? 35 : 1] + (size_t)l * D; const float* wg = a->in[f ? 36 : 2] + (size_t)l * D * FF; const float* wu = a->in[f ? 37 : 3] + (size_t)l * D * FF; const float* wd = a->in[f ? 38 : 4] + (size_t)l * FF * D;
        bf16* Wgu = (bf16*)(C.ws + (f ? WS_WGU2 : WS_WGU1)); bf16* Wd = (bf16*)(C.ws + (f ? WS_WD2 : WS_WD1));
        const SrcGU sgu{wg, wu};
        for (int it = gw; it < (D / 64) * (2 * FF / 32); it += NGW) tr_item(sgu, nrm, Wgu, D, it / (2 * FF / 32), it % (2 * FF / 32), scr, C.lane);
        const SrcPlain sd{wd, D};
        for (int it = gw; it < (FF / 64) * (D / 32); it += NGW) tr_item(sd, nullptr, Wd, FF, it / (D / 32), it % (D / 32), scr, C.lane);
    }
    { const SrcWin sw{a->in[6] + (size_t)l * D * 10520}; const float* nrm = a->in[5] + (size_t)l * D; bf16* Win = (bf16*)(C.ws + WS_WIN);
      for (int it = gw; it < (D / 64) * (NWIN / 32); it += NGW) tr_item(sw, nrm, Win, D, it / (NWIN / 32), it % (NWIN / 32), scr, C.lane); }
    { bf16* Wb = (bf16*)(C.ws + WS_WB);
      for (int it = gw; it < 4 * (512 / 64) * (D / 32); it += NGW) { const int z = it / ((512 / 64) * (D / 32)), r = it % ((512 / 64) * (D / 32));
          const SrcPlain sb{a->in[32] + ((size_t)l * 4 + z) * 512 * D, D}; tr_item(sb, nullptr, Wb + (size_t)z * D * 512, 512, r / (D / 32), r % (D / 32), scr, C.lane); } }
    { const SrcPlain so{a->in[34] + (size_t)l * D * D, D}; bf16* Wo = (bf16*)(C.ws + WS_WO);
      for (int it = gw; it < (D / 64) * (D / 32); it += NGW) tr_item(so, nullptr, Wo, D, it / (D / 32), it % (D / 32), scr, C.lane); }
}

PH_FN void ph_da_prep(const Ctx C) {
    bf16* P = (bf16*)(C.ws + WS_P); const float* cosT = (const float*)(C.ws + WS_COS); const float* sinT = (const float*)(C.ws + WS_SIN);
    const int gw = C.bid * NWAVES + C.wave, NGW = C.G * NWAVES;
    const int hc = C.lane >> 2, ch = C.lane & 3;
    const float sc = (hc < 8) ? 0.125f * LOG2E : 1.0f;
    for (int m = gw; m < M; m += NGW) {
        const int t = m & (SEQ - 1);
        bf16* p1 = P + (size_t)m * NPM + hc * 64 + ch * 8; bf16* p2 = p1 + 32;
        float x1[8], x2[8], o1[8], o2[8];
        unpack8(*(const u32x4*)p1, x1); unpack8(*(const u32x4*)p2, x2);
        const float* cp = cosT + t * 32 + ch * 8; const float* sp = sinT + t * 32 + ch * 8;
#pragma unroll
        for (int i = 0; i < 8; ++i) { const float c = cp[i], s = sp[i]; o1[i] = (x1[i] * c - x2[i] * s) * sc; o2[i] = (x2[i] * c + x1[i] * s) * sc; }
        *(u32x4*)p1 = pack8(o1); *(u32x4*)p2 = pack8(o2);
    }
    bf16* VT = (bf16*)(C.ws + WS_VT); LAS bf16* tile = (LAS bf16*)C.lds;
    for (int it = C.bid; it < 2 * NCH * 4; it += C.G) {
        const int h = it & 3, bc = it >> 2, b = bc >> 7, tb = bc & 127; const size_t row0 = (size_t)bc * 64;
        WG_SYNC();
#pragma unroll
        for (int i = 0; i < 2; ++i) { const int q = C.tid + NTHR * i, t = q >> 4, c16 = q & 15;
            *(LAS u32x4*)(tile + t * 136 + c16 * 8) = *(const u32x4*)(P + (row0 + t) * NPM + C_DAV + h * 128 + c16 * 8); }
        WG_SYNC();
#pragma unroll
        for (int i = 0; i < 2; ++i) { const int q = C.tid + NTHR * i, d = q >> 3, tc = q & 7; unsigned w[4];
#pragma unroll
            for (int e = 0; e < 4; ++e) w[e] = (unsigned)tile[(8 * tc + 2 * e) * 136 + d] | ((unsigned)tile[(8 * tc + 2 * e + 1) * 136 + d] << 16);
            u32x4 o; o.x = w[0]; o.y = w[1]; o.z = w[2]; o.w = w[3];
            *(u32x4*)(VT + ((size_t)(b * 4 + h) * 128 + d) * SEQ + tb * 64 + 8 * tc) = o; }
    }
    WG_SYNC();
}

typedef LAS bf16* LB; typedef const LAS bf16* CLB;
__device__ __forceinline__ pg8::bf16x8 frag32(CLB X, int ld, int row0, int k0, int lane) { return *(const LAS pg8::bf16x8*)(X + (row0 + (lane & 31)) * ld + k0 + 8 * (lane >> 5)); }
template <int K> __device__ __forceinline__ void mma_nt(f32x16& acc, CLB A, int lda, int m0, CLB Bt, int ldb, int n0, int lane) {
#pragma unroll
    for (int k = 0; k < K; k += 16) acc = __builtin_amdgcn_mfma_f32_32x32x16_bf16(frag32(A, lda, m0, k, lane), frag32(Bt, ldb, n0, k, lane), acc, 0, 0, 0);
}
__device__ __forceinline__ int crow(int r, int hi) { return (r & 3) + 8 * (r >> 2) + 4 * hi; }
__device__ __forceinline__ f32x16 zero16() { f32x16 z;
#pragma unroll
    for (int r = 0; r < 16; ++r) z[r] = 0.f;
    return z; }

__device__ __forceinline__ void gla_compute_G(const Ctx& C, ArgsP a, int l, int bc, int h, LF Gs) {
    const bf16* P = (const bf16*)(C.ws + WS_P); const float* W2 = a->in[12] + (size_t)l * 16 * 256; const float* gb = a->in[13] + (size_t)l * 256;
    const int t = C.tid >> 3, kg = C.tid & 7; const size_t row = (size_t)bc * 64 + t;
    float glr[16]; unpack8(*(const u32x4*)(P + row * NPM + C_GLR), glr); unpack8(*(const u32x4*)(P + row * NPM + C_GLR + 8), glr + 8);
#pragma unroll
    for (int i = 0; i < 8; ++i) { const int k = h * 64 + kg * 8 + i; float x = gb[k];
#pragma unroll
        for (int r = 0; r < 16; ++r) x += glr[r] * W2[r * 256 + k];
        Gs[t * 68 + kg * 8 + i] = logsigmoidf_(x) * (1.0f / 16.0f); }
    WG_SYNC();
    if (C.tid < 64) { float run = 0.f; for (int tt = 0; tt < 64; ++tt) { run += Gs[tt * 68 + C.tid]; Gs[tt * 68 + C.tid] = run; } }
    WG_SYNC();
}
PH_HEAVY void ph_gla_a(const Ctx C, ArgsP a, int l) {
    const bf16* P = (const bf16*)(C.ws + WS_P); float* GKV = (float*)(C.ws + WS_GKV); float* GL = (float*)(C.ws + WS_GLAST);
    LF Gs = (LF)C.lds; LB KDT = (LB)(C.lds + 17408); LB VT = (LB)(C.lds + 26624);
    for (int it = C.bid; it < NBC * 4; it += C.G) {
        const int bc = it >> 2, h = it & 3;
        WG_SYNC();
        gla_compute_G(C, a, l, bc, h, Gs);
        { const int t = C.tid >> 3, g8 = C.tid & 7; const size_t row = (size_t)bc * 64 + t;
          float kf[8]; unpack8(*(const u32x4*)(P + row * NPM + C_GK + h * 64 + g8 * 8), kf);
#pragma unroll
          for (int i = 0; i < 8; ++i) { const int k = g8 * 8 + i; KDT[k * 72 + t] = (bf16)f2bf(kf[i] * __expf(Gs[63 * 68 + k] - Gs[t * 68 + k])); }
          const u32x4 v0 = *(const u32x4*)(P + row * NPM + C_GV + h * 128 + g8 * 16), v1 = *(const u32x4*)(P + row * NPM + C_GV + h * 128 + g8 * 16 + 8);
          const unsigned vw[8] = {v0.x, v0.y, v0.z, v0.w, v1.x, v1.y, v1.z, v1.w};
#pragma unroll
          for (int i = 0; i < 8; ++i) { VT[(g8 * 16 + 2 * i) * 72 + t] = (bf16)(vw[i] & 0xffffu); VT[(g8 * 16 + 2 * i + 1) * 72 + t] = (bf16)(vw[i] >> 16); }
          if (C.tid < 64) GL[(size_t)it * 64 + C.tid] = Gs[63 * 68 + C.tid]; }
        WG_SYNC();
        { const int kt = C.wave >> 2, vt = C.wave & 3, n = C.lane & 31, hi = C.lane >> 5;
          f32x16 acc = zero16(); mma_nt<64>(acc, KDT, 72, 32 * kt, VT, 72, 32 * vt, C.lane);
          float* dst = GKV + ((size_t)it * 128 + 32 * vt + n) * 64 + 32 * kt + 4 * hi;
#pragma unroll
          for (int g = 0; g < 4; ++g) *(f32x4*)(dst + 8 * g) = (f32x4){acc[4 * g], acc[4 * g + 1], acc[4 * g + 2], acc[4 * g + 3]}; }
    }
    WG_SYNC();
}
PH_FN void gla_scan_part(const Ctx C, int part) {
    float* GKV = (float*)(C.ws + WS_GKV); const float* GL = (const float*)(C.ws + WS_GLAST);
    const int e = part * NTHR + C.tid, chain = e >> 13, idx = e & 8191, b = chain >> 2, h = chain & 3, k = idx & 63;
    float st = 0.f;
#pragma unroll 4
    for (int c = 0; c < NCH; ++c) { const size_t item = (size_t)(b * NCH + c) * 4 + h; float* p = GKV + item * 8192 + idx; const float tmp = *p; const float dec = __expf(GL[item * 64 + k]); *p = st; st = dec * st + tmp; }
}
PH_HEAVY void ph_gla_c(const Ctx C, ArgsP a, int l) {
    const bf16* P = (const bf16*)(C.ws + WS_P); const float* GKV = (const float*)(C.ws + WS_GKV); bf16* YS = (bf16*)(C.ws + WS_YS);
    const float* gnorm = a->in[14] + (size_t)l * 128;
    LF Gs = (LF)C.lds; LB QD = (LB)(C.lds + 17408); LB KDR = (LB)(C.lds + 26624); LB QI = (LB)(C.lds + 35840); LB ATT = (LB)(C.lds + 45056); LB VT = (LB)(C.lds + 54272); LB ST = (LB)(C.lds + 72704); LF PS = (LF)(C.lds + 91136);
    for (int it = C.bid; it < NBC * 4; it += C.G) {
        const int bc = it >> 2, h = it & 3;
        WG_SYNC();
        gla_compute_G(C, a, l, bc, h, Gs);
        { const int t = C.tid >> 3, g8 = C.tid & 7; const size_t row = (size_t)bc * 64 + t;
          float qf[8], kf[8], o1[8], o2[8], o3[8];
          unpack8(*(const u32x4*)(P + row * NPM + C_GQ + h * 64 + g8 * 8), qf); unpack8(*(const u32x4*)(P + row * NPM + C_GK + h * 64 + g8 * 8), kf);
#pragma unroll
          for (int i = 0; i < 8; ++i) { const int k = g8 * 8 + i; const float g = Gs[t * 68 + k], d = g - Gs[32 * 68 + k]; o1[i] = qf[i] * 0.125f * __expf(d); o2[i] = kf[i] * __expf(-d); o3[i] = qf[i] * 0.125f * __expf(g); }
          *(LAS u32x4*)(QD + t * 72 + g8 * 8) = pack8(o1); *(LAS u32x4*)(KDR + t * 72 + g8 * 8) = pack8(o2); *(LAS u32x4*)(QI + t * 72 + g8 * 8) = pack8(o3);
          const u32x4 v0 = *(const u32x4*)(P + row * NPM + C_GV + h * 128 + g8 * 16), v1 = *(const u32x4*)(P + row * NPM + C_GV + h * 128 + g8 * 16 + 8);
          const unsigned vw[8] = {v0.x, v0.y, v0.z, v0.w, v1.x, v1.y, v1.z, v1.w};
#pragma unroll
          for (int i = 0; i < 8; ++i) { VT[(g8 * 16 + 2 * i) * 72 + t] = (bf16)(vw[i] & 0xffffu); VT[(g8 * 16 + 2 * i + 1) * 72 + t] = (bf16)(vw[i] >> 16); }
          const int v = C.tid >> 2, kq = (C.tid & 3) * 16; const float* sp = GKV + ((size_t)it * 128 + v) * 64 + kq;
          float s[16];
#pragma unroll
          for (int i = 0; i < 4; ++i) { const f32x4 x = *(const f32x4*)(sp + 4 * i); s[4 * i] = x[0]; s[4 * i + 1] = x[1]; s[4 * i + 2] = x[2]; s[4 * i + 3] = x[3]; }
          *(LAS u32x4*)(ST + v * 72 + kq) = pack8(s); *(LAS u32x4*)(ST + v * 72 + kq + 8) = pack8(s + 8); }
        WG_SYNC();
        const int n = C.lane & 31, hi = C.lane >> 5;
        if (C.wave < 4) {
            const int it_ = C.wave >> 1, jt = C.wave & 1;
            f32x16 acc = zero16();
            if (jt <= it_) mma_nt<64>(acc, QD, 72, 32 * it_, KDR, 72, 32 * jt, C.lane);
#pragma unroll
            for (int r = 0; r < 16; ++r) { const int i = 32 * it_ + crow(r, hi), j = 32 * jt + n; ATT[i * 72 + j] = (bf16)f2bf(j <= i ? acc[r] : 0.f); }
        }
        WG_SYNC();
        {
            const int it_ = C.wave & 1, vt = C.wave >> 1;
            f32x16 acc = zero16();
            mma_nt<64>(acc, VT, 72, 32 * vt, ATT, 72, 32 * it_, C.lane);
            mma_nt<64>(acc, ST, 72, 32 * vt, QI, 72, 32 * it_, C.lane);
            float ss = 0.f;
#pragma unroll
            for (int r = 0; r < 16; ++r) ss += acc[r] * acc[r];
            ss += __shfl_xor(ss, 32);
            if (hi == 0) PS[(32 * it_ + n) * 4 + vt] = ss;
            WG_SYNC();
            const int i = 32 * it_ + n; const float tot = (PS[i * 4] + PS[i * 4 + 1]) + (PS[i * 4 + 2] + PS[i * 4 + 3]);
            const float rs = 1.0f / sqrtf(tot * (1.0f / 128.0f) + EPS); const size_t row = (size_t)bc * 64 + i;
#pragma unroll
            for (int g = 0; g < 4; ++g) { const int v0 = 32 * vt + 8 * g + 4 * hi;
                const u32x2 ogw = *(const u32x2*)(P + row * NPM + C_GOG + h * 128 + v0); const f32x4 gn = *(const f32x4*)(gnorm + v0);
                const float og[4] = {bflo(ogw.x), bfhi(ogw.x), bflo(ogw.y), bfhi(ogw.y)}; float o4[4];
#pragma unroll
                for (int y = 0; y < 4; ++y) o4[y] = acc[4 * g + y] * rs * gn[y] * siluf_(og[y]);
                u32x2 w; w.x = pk2(o4[0], o4[1]); w.y = pk2(o4[2], o4[3]); *(u32x2*)(YS + row * 2048 + 512 + h * 128 + v0) = w; }
        }
    }
    WG_SYNC();
}

__device__ __forceinline__ void ssd_conv8(const bf16* P, const float* cw, const float* cb, int bc, int t, int ch0, float* o) {
    const int pos = (bc & 127) * 64 + t; const size_t row = (size_t)bc * 64 + t;
#pragma unroll
    for (int i = 0; i < 8; ++i) o[i] = cb[ch0 + i];
#pragma unroll
    for (int tap = 0; tap < 4; ++tap) { if (pos - 3 + tap >= 0) { float x[8]; unpack8(*(const u32x4*)(P + (row - 3 + tap) * NPM + C_SX + ch0), x);
#pragma unroll
        for (int i = 0; i < 8; ++i) o[i] += cw[tap * 1024 + ch0 + i] * x[i]; } }
#pragma unroll
    for (int i = 0; i < 8; ++i) o[i] = siluf_(o[i]);
}
PH_HEAVY void ph_ssd_a(const Ctx C, ArgsP a, int l) {
    const bf16* P = (const bf16*)(C.ws + WS_P); float* SST = (float*)(C.ws + WS_SST); float* SDT = (float*)(C.ws + WS_SDT); float* SAC = (float*)(C.ws + WS_SACUM); float* SCD = (float*)(C.ws + WS_SCDEC);
    const float* cw = a->in[15] + (size_t)l * 4 * 1024; const float* cb = a->in[16] + (size_t)l * 1024; const float* dtb = a->in[17] + (size_t)l * 8; const float* alog = a->in[18] + (size_t)l * 8;
    LB BT = (LB)C.lds; LB XDT = (LB)(C.lds + 18432); LF dtv = (LF)(C.lds + 27648); LF acu = (LF)(C.lds + 27904); LF av = (LF)(C.lds + 28160);
    for (int it = C.bid; it < NBC * 2; it += C.G) {
        const int bc = it >> 1, g = it & 1; const int t = C.tid >> 3, cg = C.tid & 7;
        WG_SYNC();
        { float o[8];
#pragma unroll
          for (int half = 0; half < 2; ++half) { ssd_conv8(P, cw, cb, bc, t, 512 + g * 128 + cg * 16 + half * 8, o);
#pragma unroll
              for (int i = 0; i < 8; ++i) BT[(cg * 16 + half * 8 + i) * 72 + t] = (bf16)f2bf(o[i]); } }
#pragma unroll 1
        for (int hh = 0; hh < 4; ++hh) {
            const int hd = 4 * g + hh; const size_t item8 = (size_t)bc * 8 + hd;
            WG_SYNC();
            if (C.tid < 64) { const size_t row = (size_t)bc * 64 + C.tid; const float dt = softplusf_(bf2f(P[row * NPM + C_SDT + hd]) + dtb[hd]); dtv[C.tid] = dt; av[C.tid] = -__expf(alog[hd]) * dt; }
            WG_SYNC();
            if (C.tid < 64) { float s = 0.f; for (int j = 0; j <= C.tid; ++j) s += av[j]; acu[C.tid] = s; const size_t row = (size_t)bc * 64 + C.tid; SDT[row * 8 + hd] = dtv[C.tid]; SAC[row * 8 + hd] = s; if (C.tid == 63) SCD[item8] = __expf(s); }
            WG_SYNC();
            { float o[8]; ssd_conv8(P, cw, cb, bc, t, hd * 64 + cg * 8, o); const float sc = dtv[t] * __expf(acu[63] - acu[t]);
#pragma unroll
              for (int i = 0; i < 8; ++i) XDT[(cg * 8 + i) * 72 + t] = (bf16)f2bf(o[i] * sc); }
            WG_SYNC();
            { const int pt = C.wave >> 2, nt = C.wave & 3, n = C.lane & 31, hi = C.lane >> 5;
              f32x16 acc = zero16(); mma_nt<64>(acc, XDT, 72, 32 * pt, BT, 72, 32 * nt, C.lane);
#pragma unroll
              for (int r = 0; r < 16; ++r) SST[(item8 * 64 + 32 * pt + crow(r, hi)) * 128 + 32 * nt + n] = acc[r]; }
        }
    }
    WG_SYNC();
}
PH_FN void ssd_scan_part(const Ctx C, int part) {
    float* SST = (float*)(C.ws + WS_SST); const float* SCD = (const float*)(C.ws + WS_SCDEC);
    const int e = part * NTHR + C.tid, chain = e >> 13, idx = e & 8191, b = chain >> 3, hd = chain & 7;
    float st = 0.f;
#pragma unroll 4
    for (int c = 0; c < NCH; ++c) { const size_t item = (size_t)(b * NCH + c) * 8 + hd; float* p = SST + item * 8192 + idx; const float tmp = *p; const float dec = SCD[item]; *p = st; st = dec * st + tmp; }
}
PH_HEAVY void ph_ssd_c(const Ctx C, ArgsP a, int l) {
    const bf16* P = (const bf16*)(C.ws + WS_P); const float* SST = (const float*)(C.ws + WS_SST); const float* SDT = (const float*)(C.ws + WS_SDT); const float* SAC = (const float*)(C.ws + WS_SACUM); bf16* YS = (bf16*)(C.ws + WS_YS);
    const float* cw = a->in[15] + (size_t)l * 4 * 1024; const float* cb = a->in[16] + (size_t)l * 1024; const float* dpar = a->in[19] + (size_t)l * 8; const float* snorm = a->in[20] + (size_t)l * 512;
    LB BN = (LB)C.lds; LB CN = (LB)(C.lds + 17408); LF CB = (LF)(C.lds + 34816); LB SC = (LB)(C.lds + 52224); LB XST = (LB)(C.lds + 61440); LB HP = (LB)(C.lds + 70656); LB CE = (LB)(C.lds + 88064);
    LF dtv = (LF)(C.lds + 105472); LF acu = (LF)(C.lds + 105728); LF PSQ = (LF)(C.lds + 105984);
    for (int it = C.bid; it < NBC * 2; it += C.G) {
        const int bc = it >> 1, g = it & 1;
        const int t = C.tid >> 3, cg = C.tid & 7, n = C.lane & 31, hi = C.lane >> 5;
        WG_SYNC();
        { float o[8];
#pragma unroll
          for (int half = 0; half < 2; ++half) {
              ssd_conv8(P, cw, cb, bc, t, 512 + g * 128 + cg * 16 + half * 8, o); *(LAS u32x4*)(BN + t * 136 + cg * 16 + half * 8) = pack8(o);
              ssd_conv8(P, cw, cb, bc, t, 768 + g * 128 + cg * 16 + half * 8, o); *(LAS u32x4*)(CN + t * 136 + cg * 16 + half * 8) = pack8(o); } }
        WG_SYNC();
        if (C.wave < 4) {
            const int it_ = C.wave >> 1, jt = C.wave & 1;
            f32x16 acc = zero16(); mma_nt<128>(acc, CN, 136, 32 * it_, BN, 136, 32 * jt, C.lane);
#pragma unroll
            for (int r = 0; r < 16; ++r) CB[(32 * it_ + crow(r, hi)) * 68 + 32 * jt + n] = acc[r];
        }
        float yk[4][16]; float ssq = 0.f;
        const int pt = (C.wave >> 1) & 1, it2 = C.wave & 1;
#pragma unroll
        for (int hh = 0; hh < 4; ++hh) {
            const int hd = 4 * g + hh; const size_t item8 = (size_t)bc * 8 + hd;
            WG_SYNC();
            if (C.tid < 64) { const size_t row = (size_t)bc * 64 + C.tid; dtv[C.tid] = SDT[row * 8 + hd]; acu[C.tid] = SAC[row * 8 + hd]; }
            { float o[8]; ssd_conv8(P, cw, cb, bc, t, hd * 64 + cg * 8, o);
#pragma unroll
              for (int i = 0; i < 8; ++i) XST[(cg * 8 + i) * 72 + t] = (bf16)f2bf(o[i]);
              const int p = C.tid >> 3, n0 = (C.tid & 7) * 16; const float* sp = SST + (item8 * 64 + p) * 128 + n0; float s[16];
#pragma unroll
              for (int i = 0; i < 4; ++i) { const f32x4 x = *(const f32x4*)(sp + 4 * i); s[4 * i] = x[0]; s[4 * i + 1] = x[1]; s[4 * i + 2] = x[2]; s[4 * i + 3] = x[3]; }
              *(LAS u32x4*)(HP + p * 136 + n0) = pack8(s); *(LAS u32x4*)(HP + p * 136 + n0 + 8) = pack8(s + 8); }
            WG_SYNC();
            { const float ai = acu[t]; float o[8];
#pragma unroll
              for (int jj = 0; jj < 8; ++jj) { const int j = 8 * cg + jj; o[jj] = (j <= t) ? CB[t * 68 + j] * __expf(ai - acu[j]) * dtv[j] : 0.f; }
              *(LAS u32x4*)(SC + t * 72 + 8 * cg) = pack8(o);
              const float ea = __expf(ai); float c8[8];
#pragma unroll
              for (int half = 0; half < 2; ++half) { unpack8(*(const LAS u32x4*)(CN + t * 136 + cg * 16 + half * 8), c8);
#pragma unroll
                  for (int i = 0; i < 8; ++i) c8[i] *= ea;
                  *(LAS u32x4*)(CE + t * 136 + cg * 16 + half * 8) = pack8(c8); } }
            WG_SYNC();
            if (C.wave < 4) {
                f32x16 acc = zero16();
                mma_nt<64>(acc, XST, 72, 32 * pt, SC, 72, 32 * it2, C.lane);
                mma_nt<128>(acc, HP, 136, 32 * pt, CE, 136, 32 * it2, C.lane);
                const int i = 32 * it2 + n; const size_t row = (size_t)bc * 64 + i; const float dh = dpar[hd];
#pragma unroll
                for (int q4 = 0; q4 < 4; ++q4) { const int p0 = 32 * pt + 8 * q4 + 4 * hi;
                    const u32x2 zw = *(const u32x2*)(P + row * NPM + C_SZ + hd * 64 + p0); const float zf[4] = {bflo(zw.x), bfhi(zw.x), bflo(zw.y), bfhi(zw.y)};
#pragma unroll
                    for (int e = 0; e < 4; ++e) { const float xs = bf2f(XST[(p0 + e) * 72 + i]); const float v = (acc[4 * q4 + e] + dh * xs) * siluf_(zf[e]); yk[hh][4 * q4 + e] = v; ssq += v * v; } }
            }
        }
        if (C.wave < 4) { ssq += __shfl_xor(ssq, 32); if (hi == 0) PSQ[(32 * it2 + n) * 2 + pt] = ssq; }
        WG_SYNC();
        if (C.wave < 4) {
            const int i = 32 * it2 + n; const float rs = 1.0f / sqrtf((PSQ[i * 2] + PSQ[i * 2 + 1]) * (1.0f / 256.0f) + EPS); const size_t row = (size_t)bc * 64 + i;
#pragma unroll
            for (int hh = 0; hh < 4; ++hh)
#pragma unroll
                for (int q4 = 0; q4 < 4; ++q4) { const int ch = g * 256 + hh * 64 + 32 * pt + 8 * q4 + 4 * hi; const f32x4 sn = *(const f32x4*)(snorm + ch);
                    u32x2 w; w.x = pk2(yk[hh][4 * q4] * rs * sn[0], yk[hh][4 * q4 + 1] * rs * sn[1]); w.y = pk2(yk[hh][4 * q4 + 2] * rs * sn[2], yk[hh][4 * q4 + 3] * rs * sn[3]);
                    *(u32x2*)(YS + row * 2048 + 1024 + ch) = w; }
        }
    }
    WG_SYNC();
}

#ifndef RW_CHUNKED
#define RW_CHUNKED 1
#endif
__device__ __forceinline__ void rw_lerp8(const bf16* P, const float* mu, int bc, int t, int c0, float* o) {
    const size_t row = (size_t)bc * 64 + t; const bool first = ((bc & 127) == 0) && (t == 0);
    float x[8], xp[8]; unpack8(*(const u32x4*)(P + row * NPM + C_RR + c0), x);
    if (!first) unpack8(*(const u32x4*)(P + (row - 1) * NPM + C_RR + c0), xp); else {
#pragma unroll
        for (int i = 0; i < 8; ++i) xp[i] = 0.f; }
#pragma unroll
    for (int i = 0; i < 8; ++i) o[i] = x[i] + (xp[i] - x[i]) * mu[c0 + i];
}
PH_HEAVY void ph_rw_prep(const Ctx C, ArgsP a, int l) {
    const bf16* P = (const bf16*)(C.ws + WS_P);
    float* RWW = (float*)(C.ws + WS_RWW); bf16* RWR = (bf16*)(C.ws + WS_RWR); bf16* RWK = (bf16*)(C.ws + WS_RWK); bf16* RWV = (bf16*)(C.ws + WS_RWV); bf16* RWKK = (bf16*)(C.ws + WS_RWKK); bf16* RWB = (bf16*)(C.ws + WS_RWB); bf16* RWG = (bf16*)(C.ws + WS_RWG);
    const float* mu = a->in[21] + (size_t)l * 1792; const float* w0 = a->in[22] + (size_t)l * 512; const float* w2 = a->in[23] + (size_t)l * 64 * 512; const float* a0 = a->in[24] + (size_t)l * 512; const float* a2 = a->in[25] + (size_t)l * 64 * 512;
    const float* g2 = a->in[26] + (size_t)l * 128 * 512; const float* k_k = a->in[27] + (size_t)l * 512; const float* k_a = a->in[28] + (size_t)l * 512;
    LF WL = (LF)C.lds; LF AL = WL + 64 * 68; LF GLs = AL + 64 * 68;
    for (int bc = C.bid; bc < NBC; bc += C.G) {
        WG_SYNC();
        { const int t = C.tid >> 3, cg = C.tid & 7; float o[8];
          rw_lerp8(P, mu, bc, t, 1536 + cg * 8, o);
#pragma unroll
          for (int i = 0; i < 8; ++i) WL[t * 68 + cg * 8 + i] = tanhf(o[i]);
          rw_lerp8(P, mu, bc, t, 1600 + cg * 8, o);
#pragma unroll
          for (int i = 0; i < 8; ++i) AL[t * 68 + cg * 8 + i] = o[i];
          rw_lerp8(P, mu, bc, t, 1664 + cg * 16, o);
#pragma unroll
          for (int i = 0; i < 8; ++i) GLs[t * 132 + cg * 16 + i] = sigmoidf_(o[i]);
          rw_lerp8(P, mu, bc, t, 1664 + cg * 16 + 8, o);
#pragma unroll
          for (int i = 0; i < 8; ++i) GLs[t * 132 + cg * 16 + 8 + i] = sigmoidf_(o[i]); }
        WG_SYNC();
        const int tb = C.tid >> 6, cb = C.tid & 63, ch0 = cb * 8;
#pragma unroll 1
        for (int half = 0; half < 2; ++half) {
        const int rb = 8 * tb + 4 * half;
        float acc[4][8], av[4][8];
#pragma unroll
        for (int i = 0; i < 4; ++i)
#pragma unroll
            for (int j = 0; j < 8; ++j) acc[i][j] = 0.f;
#pragma unroll 2
        for (int r = 0; r < 64; ++r) { const f32x4 b0 = *(const f32x4*)(w2 + r * 512 + ch0), b1 = *(const f32x4*)(w2 + r * 512 + ch0 + 4);
#pragma unroll
            for (int i = 0; i < 4; ++i) { const float x = WL[(rb + i) * 68 + r];
#pragma unroll
                for (int j = 0; j < 4; ++j) { acc[i][j] += x * b0[j]; acc[i][4 + j] += x * b1[j]; } } }
#pragma unroll
        for (int i = 0; i < 4; ++i) { const size_t row = (size_t)bc * 64 + rb + i; float o[8];
#pragma unroll
            for (int j = 0; j < 8; ++j) { const float lw_ = -0.606531f * sigmoidf_(w0[ch0 + j] + acc[i][j]); o[j] = RW_CHUNKED ? lw_ : __expf(lw_); }
            *(f32x4*)(RWW + row * 512 + ch0) = (f32x4){o[0], o[1], o[2], o[3]}; *(f32x4*)(RWW + row * 512 + ch0 + 4) = (f32x4){o[4], o[5], o[6], o[7]}; }
#pragma unroll
        for (int i = 0; i < 4; ++i)
#pragma unroll
            for (int j = 0; j < 8; ++j) acc[i][j] = 0.f;
#pragma unroll 2
        for (int r = 0; r < 64; ++r) { const f32x4 b0 = *(const f32x4*)(a2 + r * 512 + ch0), b1 = *(const f32x4*)(a2 + r * 512 + ch0 + 4);
#pragma unroll
            for (int i = 0; i < 4; ++i) { const float x = AL[(rb + i) * 68 + r];
#pragma unroll
                for (int j = 0; j < 4; ++j) { acc[i][j] += x * b0[j]; acc[i][4 + j] += x * b1[j]; } } }
#pragma unroll
        for (int i = 0; i < 4; ++i)
#pragma unroll
            for (int j = 0; j < 8; ++j) av[i][j] = sigmoidf_(a0[ch0 + j] + acc[i][j]);
#pragma unroll
        for (int i = 0; i < 4; ++i)
#pragma unroll
            for (int j = 0; j < 8; ++j) acc[i][j] = 0.f;
#pragma unroll 2
        for (int r = 0; r < 128; ++r) { const f32x4 b0 = *(const f32x4*)(g2 + r * 512 + ch0), b1 = *(const f32x4*)(g2 + r * 512 + ch0 + 4);
#pragma unroll
            for (int i = 0; i < 4; ++i) { const float x = GLs[(rb + i) * 132 + r];
#pragma unroll
                for (int j = 0; j < 4; ++j) { acc[i][j] += x * b0[j]; acc[i][4 + j] += x * b1[j]; } } }
#pragma unroll
        for (int i = 0; i < 4; ++i) { const size_t row = (size_t)bc * 64 + rb + i; *(u32x4*)(RWG + row * 512 + ch0) = pack8(acc[i]); }
#pragma unroll
        for (int i = 0; i < 4; ++i) { const int t = rb + i; const size_t row = (size_t)bc * 64 + t; float o[8], kx[8], kk[8];
            rw_lerp8(P, mu, bc, t, ch0, o); *(u32x4*)(RWR + row * 512 + ch0) = pack8(o);
            rw_lerp8(P, mu, bc, t, 1024 + ch0, o); *(u32x4*)(RWV + row * 512 + ch0) = pack8(o);
            rw_lerp8(P, mu, bc, t, 512 + ch0, kx);
            float ss = 0.f;
#pragma unroll
            for (int j = 0; j < 8; ++j) { kk[j] = kx[j] * k_k[ch0 + j]; ss += kk[j] * kk[j]; }
            ss += __shfl_xor(ss, 1); ss += __shfl_xor(ss, 2); ss += __shfl_xor(ss, 4);
            const float inv = 1.0f / fmaxf(sqrtf(ss), 1e-12f);
#pragma unroll
            for (int j = 0; j < 8; ++j) { kk[j] *= inv; o[j] = kk[j] * av[i][j]; kx[j] = kx[j] * (1.0f + (av[i][j] - 1.0f) * k_a[ch0 + j]); }
            *(u32x4*)(RWKK + row * 512 + ch0) = pack8(kk); *(u32x4*)(RWB + row * 512 + ch0) = pack8(o); *(u32x4*)(RWK + row * 512 + ch0) = pack8(kx); }
        }
    }
    WG_SYNC();
}
template <int CTRL> __device__ __forceinline__ float dpp_get(float x) { return __builtin_bit_cast(float, __builtin_amdgcn_update_dpp(0, __builtin_bit_cast(int, x), CTRL, 0xf, 0xf, true)); }
__device__ __forceinline__ float reduce16(float x) { x += dpp_get<0xB1>(x); x += dpp_get<0x4E>(x); x += dpp_get<0x141>(x); x += dpp_get<0x140>(x); return x; }
#define RW_BAR() do { asm volatile("s_waitcnt lgkmcnt(0)" ::: "memory"); __builtin_amdgcn_s_barrier(); asm volatile("" ::: "memory"); } while (0)
PH_FN void rw_unit(const Ctx C, int chain, int rq) {
    const float* RWW = (const float*)(C.ws + WS_RWW); const bf16* RWR = (const bf16*)(C.ws + WS_RWR); const bf16* RWK = (const bf16*)(C.ws + WS_RWK); const bf16* RWV = (const bf16*)(C.ws + WS_RWV);
    const bf16* RWKK = (const bf16*)(C.ws + WS_RWKK); const bf16* RWB = (const bf16*)(C.ws + WS_RWB); bf16* RWY = (bf16*)(C.ws + WS_RWY);
    const int b = chain >> 3, h = chain & 7; const size_t rowb = (size_t)b * SEQ;
    constexpr int BUFB = 43008, O_KK = 0, O_W = 8192, O_B = 16384, O_K = 24576, O_R = 32768, O_V = 40960, NBLK = SEQ / 32;
    LAS unsigned char* L = C.lds;
    if (C.wave >= 4) {
        const int p = C.tid - 256, t = p >> 3, c8 = (p & 7) * 8;
        u32x4 rr, rk, rkk, rb; f32x4 w0, w1; unsigned rv;
#define RW_LOAD(blk) do { const size_t g_ = (rowb + (size_t)(blk) * 32 + t) * 512 + h * 64; \
            w0 = *(const f32x4*)(RWW + g_ + c8); w1 = *(const f32x4*)(RWW + g_ + c8 + 4); rr = *(const u32x4*)(RWR + g_ + c8); rk = *(const u32x4*)(RWK + g_ + c8); \
            rkk = *(const u32x4*)(RWKK + g_ + c8); rb = *(const u32x4*)(RWB + g_ + c8); rv = *(const unsigned*)(RWV + g_ + 16 * rq + (p & 7) * 2); } while (0)
#define RW_ST8(off, w_) do { float o_[8]; unpack8(w_, o_); LF d_ = (LF)(Lb + (off)) + t * 64 + c8; *(LAS f32x4*)d_ = (f32x4){o_[0], o_[1], o_[2], o_[3]}; *(LAS f32x4*)(d_ + 4) = (f32x4){o_[4], o_[5], o_[6], o_[7]}; } while (0)
        RW_LOAD(0);
        for (int blk = 0; blk < NBLK; ++blk) {
            LAS unsigned char* Lb = L + (blk & 1) * BUFB;
            { LF d = (LF)(Lb + O_W) + t * 64 + c8; *(LAS f32x4*)d = w0; *(LAS f32x4*)(d + 4) = w1; }
            RW_ST8(O_R, rr); RW_ST8(O_K, rk); RW_ST8(O_KK, rkk); RW_ST8(O_B, rb);
            { LF d = (LF)(Lb + O_V) + t * 16 + (p & 7) * 2; d[0] = bflo(rv); d[1] = bfhi(rv); }
            if (blk + 1 < NBLK) RW_LOAD(blk + 1);
            RW_BAR();
        }
        RW_BAR();
#undef RW_LOAD
#undef RW_ST8
    } else {
        const int rowl = C.lane >> 4, ks = C.lane & 15, row = 4 * C.wave + rowl;
        float S0 = 0.f, S1 = 0.f, S2 = 0.f, S3 = 0.f, ykeep = 0.f;
        bf16* yout = RWY + rowb * 512 + h * 64 + 16 * rq + row;
        for (int blk = 0; blk < NBLK; ++blk) {
            RW_BAR();
            const LAS unsigned char* Lb = L + (blk & 1) * BUFB;
            CLF pKK = (CLF)(Lb + O_KK) + 4 * ks; CLF pW = (CLF)(Lb + O_W) + 4 * ks; CLF pB = (CLF)(Lb + O_B) + 4 * ks; CLF pK = (CLF)(Lb + O_K) + 4 * ks; CLF pR = (CLF)(Lb + O_R) + 4 * ks; CLF pV = (CLF)(Lb + O_V) + row;
            f32x4 kk = *(const LAS f32x4*)pKK, w = *(const LAS f32x4*)pW, bb = *(const LAS f32x4*)pB, k = *(const LAS f32x4*)pK, r = *(const LAS f32x4*)pR; float vv = *pV;
#pragma unroll 4
            for (int t = 0; t < 32; ++t) {
                f32x4 nkk, nw, nb, nk, nr; float nv;
                const int tn = (t < 31) ? t + 1 : t;
                nkk = *(const LAS f32x4*)(pKK + tn * 64); nw = *(const LAS f32x4*)(pW + tn * 64); nb = *(const LAS f32x4*)(pB + tn * 64); nk = *(const LAS f32x4*)(pK + tn * 64); nr = *(const LAS f32x4*)(pR + tn * 64); nv = pV[tn * 16];
                float sa = (S0 * kk[0] + S1 * kk[1]) + (S2 * kk[2] + S3 * kk[3]);
                sa = -reduce16(sa);
                const float vk0 = vv * k[0], vk1 = vv * k[1], vk2 = vv * k[2], vk3 = vv * k[3];
                S0 = S0 * w[0] + (sa * bb[0] + vk0); S1 = S1 * w[1] + (sa * bb[1] + vk1); S2 = S2 * w[2] + (sa * bb[2] + vk2); S3 = S3 * w[3] + (sa * bb[3] + vk3);
                float y = (S0 * r[0] + S1 * r[1]) + (S2 * r[2] + S3 * r[3]);
                y = reduce16(y);
                if ((t & 15) == ks) ykeep = y;
                if ((t & 15) == 15) yout[(size_t)(blk * 32 + (t & 16) + ks) * 512] = (bf16)f2bf(ykeep);
                kk = nkk; w = nw; bb = nb; k = nk; r = nr; vv = nv;
            }
        }
        RW_BAR();
    }
}
PH_FN void ph_rw_out(const Ctx C, ArgsP a, int l) {
    const bf16* RWR = (const bf16*)(C.ws + WS_RWR); const bf16* RWK = (const bf16*)(C.ws + WS_RWK); const bf16* RWV = (const bf16*)(C.ws + WS_RWV); const bf16* RWG = (const bf16*)(C.ws + WS_RWG); const bf16* RWY = (const bf16*)(C.ws + WS_RWY);
    bf16* YS = (bf16*)(C.ws + WS_YS);
    const float* r_k = a->in[29] + (size_t)l * 512; const float* nw = a->in[30] + (size_t)l * 512; const float* nb = a->in[31] + (size_t)l * 512;
    const int gw = C.bid * NWAVES + C.wave, NGW = C.G * NWAVES;
    for (int it = gw; it < M * 8; it += NGW) {
        const size_t row = (size_t)(it >> 3); const int h = it & 7, c = h * 64 + C.lane; const size_t g = row * 512 + c;
        const float y = bf2f(RWY[g]), r = bf2f(RWR[g]), k = bf2f(RWK[g]), v = bf2f(RWV[g]), gg = bf2f(RWG[g]);
        const float mu = wave_sum(y) * (1.0f / 64.0f); const float d = y - mu; const float var = wave_sum(d * d) * (1.0f / 64.0f);
        const float yn = d * (1.0f / sqrtf(var + 64e-5f)) * nw[c] + nb[c];
        const float bonus = wave_sum(r * k * r_k[c]) * v;
        YS[row * 2048 + 1536 + c] = (bf16)f2bf((yn + bonus) * gg);
    }
}

__device__ __forceinline__ int pi_swap23(int i) { return (i & ~12) | ((i & 4) << 1) | ((i & 8) >> 1); }
__device__ __forceinline__ void da_unit(const Ctx& C, const Args& a, int l, int b, int h, int jq, float lam, float oml) {
    const bf16* P = (const bf16*)(C.ws + WS_P); const bf16* VT = (const bf16*)(C.ws + WS_VT); bf16* YS = (bf16*)(C.ws + WS_YS);
    const float* dnorm = a.in[11] + (size_t)l * 128;
    const int comp = C.wave >> 2, wq = C.wave & 3, q = C.lane & 31, hi = C.lane >> 5;
    const size_t qrow = (size_t)b * SEQ + jq * 128 + wq * 32 + q;
    pg8::bf16x8 qf[4];
#pragma unroll
    for (int d0 = 0; d0 < 4; ++d0) qf[d0] = *(const pg8::bf16x8*)(P + qrow * NPM + C_DAQ + h * 128 + comp * 64 + 16 * d0 + 8 * hi);
    const int ntile = 2 * jq + 2, my_last = 2 * jq + (wq >= 2 ? 1 : 0);
    f32x16 O[4];
#pragma unroll
    for (int db = 0; db < 4; ++db)
#pragma unroll
        for (int r = 0; r < 16; ++r) O[db][r] = 0.f;
    float mrun = -1e30f, lrun = 0.f;
    const bf16* kg = P + ((size_t)b * SEQ + (C.tid & 63)) * NPM + C_DAK + h * 128;
    const bf16* vg = VT + ((size_t)(b * 4 + h) * 128 + (C.tid & 127)) * SEQ;
    const int kc16 = C.tid >> 6, vc8 = C.tid >> 7;
    u32x4 kr[2], vr[2];
#pragma unroll
    for (int i = 0; i < 2; ++i) { kr[i] = *(const u32x4*)(kg + (kc16 + 8 * i) * 8); vr[i] = *(const u32x4*)(vg + (vc8 + 4 * i) * 8); }
    const int pq = pi_swap23(q);
    for (int tile = 0; tile < ntile; ++tile) {
        LAS unsigned char* buf = C.lds + (tile & 1) * 32768;
#pragma unroll
        for (int i = 0; i < 2; ++i) { const int c16 = kc16 + 8 * i; *(LAS u32x4*)(buf + (c16 >> 3) * 8192 + (c16 & 7) * 1024 + (C.tid & 63) * 16) = kr[i];
            *(LAS u32x4*)(buf + 16384 + (vc8 + 4 * i) * 2048 + (C.tid & 127) * 16) = vr[i]; }
        WG_SYNC();
        if (tile + 1 < ntile) {
#pragma unroll
            for (int i = 0; i < 2; ++i) { kr[i] = *(const u32x4*)(kg + (size_t)(tile + 1) * 64 * NPM + (kc16 + 8 * i) * 8); vr[i] = *(const u32x4*)(vg + (tile + 1) * 64 + (vc8 + 4 * i) * 8); } }
        if (tile <= my_last) {
            const LAS unsigned char* kb = buf + comp * 8192; const LAS unsigned char* vb = buf + 16384;
            f32x16 p0, p1;
#pragma unroll
            for (int r = 0; r < 16; ++r) { p0[r] = 0.f; p1[r] = 0.f; }
#pragma unroll
            for (int d0 = 0; d0 < 4; ++d0) {
                const pg8::bf16x8 a0 = *(const LAS pg8::bf16x8*)(kb + (2 * d0 + hi) * 1024 + pq * 16);
                const pg8::bf16x8 a1 = *(const LAS pg8::bf16x8*)(kb + (2 * d0 + hi) * 1024 + (32 + pq) * 16);
                p0 = __builtin_amdgcn_mfma_f32_32x32x16_bf16(a0, qf[d0], p0, 0, 0, 0);
                p1 = __builtin_amdgcn_mfma_f32_32x32x16_bf16(a1, qf[d0], p1, 0, 0, 0);
            }
            float mx = fmaxf(p0[0], p1[0]);
#pragma unroll
            for (int r = 1; r < 16; ++r) mx = fmaxf(mx, fmaxf(p0[r], p1[r]));
            mx = fmaxf(mx, __shfl_xor(mx, 32));
            const float mnew = fmaxf(mrun, mx); const float alpha = __builtin_amdgcn_exp2f(mrun - mnew); mrun = mnew;
            float rs = 0.f;
#pragma unroll
            for (int r = 0; r < 16; ++r) { p0[r] = __builtin_amdgcn_exp2f(p0[r] - mnew); p1[r] = __builtin_amdgcn_exp2f(p1[r] - mnew); rs += p0[r] + p1[r]; }
            lrun = lrun * alpha + rs;
#pragma unroll
            for (int db = 0; db < 4; ++db)
#pragma unroll
                for (int r = 0; r < 16; ++r) O[db][r] *= alpha;
            pg8::bf16x8 pb[4];
            { u32x4 w;
              w.x = pk2(p0[0], p0[1]); w.y = pk2(p0[2], p0[3]); w.z = pk2(p0[4], p0[5]); w.w = pk2(p0[6], p0[7]); pb[0] = __builtin_bit_cast(pg8::bf16x8, w);
              w.x = pk2(p0[8], p0[9]); w.y = pk2(p0[10], p0[11]); w.z = pk2(p0[12], p0[13]); w.w = pk2(p0[14], p0[15]); pb[1] = __builtin_bit_cast(pg8::bf16x8, w);
              w.x = pk2(p1[0], p1[1]); w.y = pk2(p1[2], p1[3]); w.z = pk2(p1[4], p1[5]); w.w = pk2(p1[6], p1[7]); pb[2] = __builtin_bit_cast(pg8::bf16x8, w);
              w.x = pk2(p1[8], p1[9]); w.y = pk2(p1[10], p1[11]); w.z = pk2(p1[12], p1[13]); w.w = pk2(p1[14], p1[15]); pb[3] = __builtin_bit_cast(pg8::bf16x8, w); }
#pragma unroll
            for (int db = 0; db < 4; ++db)
#pragma unroll
                for (int s = 0; s < 4; ++s) {
                    const pg8::bf16x8 vf = *(const LAS pg8::bf16x8*)(vb + (2 * s + hi) * 2048 + (32 * db + q) * 16);
                    O[db] = __builtin_amdgcn_mfma_f32_32x32x16_bf16(vf, pb[s], O[db], 0, 0, 0);
                }
        }
    }
    const float ltot = lrun + __shfl_xor(lrun, 32); const float inv = 1.0f / ltot;
    WG_SYNC();
    LF X = (LF)C.lds + (wq * 32 + q) * 132;
    if (comp == 1) {
        const float sc = inv * lam;
#pragma unroll
        for (int db = 0; db < 4; ++db)
#pragma unroll
            for (int g4 = 0; g4 < 4; ++g4) *(LAS f32x4*)(X + 32 * db + 8 * g4 + 4 * hi) = (f32x4){O[db][4 * g4] * sc, O[db][4 * g4 + 1] * sc, O[db][4 * g4 + 2] * sc, O[db][4 * g4 + 3] * sc};
    }
    WG_SYNC();
    if (comp == 0) {
        float ss = 0.f;
#pragma unroll
        for (int db = 0; db < 4; ++db)
#pragma unroll
            for (int g4 = 0; g4 < 4; ++g4) { const f32x4 x = *(const LAS f32x4*)(X + 32 * db + 8 * g4 + 4 * hi);
#pragma unroll
                for (int e = 0; e < 4; ++e) { const float v = O[db][4 * g4 + e] * inv - x[e]; O[db][4 * g4 + e] = v; ss += v * v; } }
        ss += __shfl_xor(ss, 32);
        const float rs = oml / sqrtf(ss * (1.0f / 128.0f) + EPS);
#pragma unroll
        for (int db = 0; db < 4; ++db)
#pragma unroll
            for (int g4 = 0; g4 < 4; ++g4) { const int d = 32 * db + 8 * g4 + 4 * hi; const f32x4 gn = *(const f32x4*)(dnorm + d);
                u32x2 w; w.x = pk2(O[db][4 * g4] * rs * gn[0], O[db][4 * g4 + 1] * rs * gn[1]); w.y = pk2(O[db][4 * g4 + 2] * rs * gn[2], O[db][4 * g4 + 3] * rs * gn[3]);
                *(u32x2*)(YS + qrow * 2048 + h * 128 + d) = w; }
    }
    WG_SYNC();
}
#if RW_CHUNKED
__device__ __forceinline__ int att_bin_unit(int bin, int i) { return i == 0 ? 63 - bin : (i == 1 ? bin : -1); }
#else
__device__ const signed char ATT_BINS[24][12] = {{63,21,-1,-1,-1,-1,-1,-1,-1,-1,-1,-1}, {62,22,-1,-1,-1,-1,-1,-1,-1,-1,-1,-1}, {61,23,-1,-1,-1,-1,-1,-1,-1,-1,-1,-1}, {60,24,-1,-1,-1,-1,-1,-1,-1,-1,-1,-1}, {59,25,-1,-1,-1,-1,-1,-1,-1,-1,-1,-1}, {58,26,-1,-1,-1,-1,-1,-1,-1,-1,-1,-1}, {57,27,-1,-1,-1,-1,-1,-1,-1,-1,-1,-1}, {56,28,-1,-1,-1,-1,-1,-1,-1,-1,-1,-1}, {55,29,-1,-1,-1,-1,-1,-1,-1,-1,-1,-1}, {54,30,-1,-1,-1,-1,-1,-1,-1,-1,-1,-1}, {53,31,-1,-1,-1,-1,-1,-1,-1,-1,-1,-1}, {52,32,-1,-1,-1,-1,-1,-1,-1,-1,-1,-1}, {51,33,-1,-1,-1,-1,-1,-1,-1,-1,-1,-1}, {50,34,-1,-1,-1,-1,-1,-1,-1,-1,-1,-1}, {49,35,-1,-1,-1,-1,-1,-1,-1,-1,-1,-1}, {48,36,-1,-1,-1,-1,-1,-1,-1,-1,-1,-1}, {47,37,-1,-1,-1,-1,-1,-1,-1,-1,-1,-1}, {46,38,-1,-1,-1,-1,-1,-1,-1,-1,-1,-1}, {45,39,-1,-1,-1,-1,-1,-1,-1,-1,-1,-1}, {44,40,-1,-1,-1,-1,-1,-1,-1,-1,-1,-1}, {43,41,-1,-1,-1,-1,-1,-1,-1,-1,-1,-1}, {42,20,19,6,-1,-1,-1,-1,-1,-1,-1,-1}, {18,17,16,15,14,5,-1,-1,-1,-1,-1,-1}, {13,12,11,10,9,8,7,4,3,2,1,0}};
__device__ __forceinline__ int att_bin_unit(int bin, int i) { return i < 12 ? (int)ATT_BINS[bin][i] : -1; }
#endif
__device__ __forceinline__ void ph_da_attn(const Ctx& C, const Args& a, int l, int bh, int bin) {
    const float* q1 = a.in[7] + (size_t)l * 64; const float* k1 = a.in[8] + (size_t)l * 64; const float* q2 = a.in[9] + (size_t)l * 64; const float* k2 = a.in[10] + (size_t)l * 64;
    float s1 = 0.f, s2 = 0.f;
    for (int i = 0; i < 64; ++i) { s1 += q1[i] * k1[i]; s2 += q2[i] * k2[i]; }
    const float lam_init = 0.8f - 0.6f * expf(-0.3f * (float)l); const float lam = expf(s1) - expf(s2) + lam_init;
    for (int i = 0; i < 12; ++i) { const int jq = att_bin_unit(bin, i); if (jq < 0) break; da_unit(C, a, l, bh >> 2, bh & 3, jq, lam, 1.0f - lam_init); }
}

PH_FN void ph_final(const Ctx C, ArgsP a) {
    const float* ssq = (const float*)(C.ws + WS_SSQ); const float* fn = a->in[39];
    const int gw = C.bid * NWAVES + C.wave, NGW = C.G * NWAVES;
    for (int m = gw; m < M; m += NGW) { const float rs = pg8::row_rstd(ssq, m, M); f32x4* hr = (f32x4*)(C.h + (size_t)m * D) + C.lane; const f32x4* gr = (const f32x4*)fn + C.lane;
#pragma unroll
        for (int j = 0; j < 4; ++j) { const f32x4 v = hr[64 * j], g = gr[64 * j]; hr[64 * j] = v * rs * g; } }
}
PH_FN void rwc_stage0(const Ctx C, int bc, int h) {
    float* RWW = (float*)(C.ws + WS_RWW); const bf16* RWR = (const bf16*)(C.ws + WS_RWR); const bf16* RWK = (const bf16*)(C.ws + WS_RWK); const bf16* RWV = (const bf16*)(C.ws + WS_RWV);
    bf16* RWKK = (bf16*)(C.ws + WS_RWKK); bf16* RWB = (bf16*)(C.ws + WS_RWB); bf16* RWY = (bf16*)(C.ws + WS_RWY);
    LF LGs = (LF)C.lds; LF X1T = LGs; LB AT = (LB)(C.lds + 17408); LB LAK = AT; LB A2T = (LB)(C.lds + 99328); LB RT = (LB)(C.lds + 26624); LB BTl = (LB)(C.lds + 35840); LB MRB = BTl; LB KTl = (LB)(C.lds + 45056); LB MRK = KTl;
    LB VT = (LB)(C.lds + 54272); LB BHT = (LB)(C.lds + 63488); LB KHT = (LB)(C.lds + 72704); LF LAB = (LF)(C.lds + 81920); LB WT = (LB)C.lds; LF A0T = (LF)(C.lds + 99328); LF rho = (LF)(C.lds + 116736); LF lgl = rho + 64;
    const int t = C.tid >> 3, g8 = C.tid & 7, n = C.lane & 31, hi = C.lane >> 5; const size_t row0 = (size_t)bc * 64; (void)t; (void)g8; (void)n; (void)hi; (void)row0;
    (void)RWW; (void)RWR; (void)RWK; (void)RWV; (void)RWKK; (void)RWB; (void)RWY; (void)LGs; (void)X1T; (void)AT; (void)LAK; (void)A2T; (void)RT; (void)BTl; (void)MRB; (void)KTl; (void)MRK; (void)VT; (void)BHT; (void)KHT; (void)LAB; (void)WT; (void)A0T; (void)rho; (void)lgl;
        const size_t g = (row0 + t) * 512 + h * 64 + g8 * 8;
        WG_SYNC();
        float lw[8]; { const f32x4 x0 = *(const f32x4*)(RWW + g), x1 = *(const f32x4*)(RWW + g + 4); lw[0] = x0[0]; lw[1] = x0[1]; lw[2] = x0[2]; lw[3] = x0[3]; lw[4] = x1[0]; lw[5] = x1[1]; lw[6] = x1[2]; lw[7] = x1[3]; }
#pragma unroll
        for (int i = 0; i < 8; ++i) LGs[t * 68 + g8 * 8 + i] = lw[i];
        WG_SYNC();
        if (C.tid < 64) { float run = 0.f; for (int tt = 0; tt < 64; ++tt) { run += LGs[tt * 68 + C.tid]; LGs[tt * 68 + C.tid] = run; } }
        WG_SYNC();
        {   float rf[8], kf[8], kkf[8], bf[8], lg[8], rh[8], ll[8], o1[8], o2[8], o3[8], o4[8];
            unpack8(*(const u32x4*)(RWR + g), rf); unpack8(*(const u32x4*)(RWK + g), kf); unpack8(*(const u32x4*)(RWKK + g), kkf); unpack8(*(const u32x4*)(RWB + g), bf);
#pragma unroll
            for (int i = 0; i < 8; ++i) { const int k = g8 * 8 + i; lg[i] = LGs[t * 68 + k]; rh[i] = LGs[31 * 68 + k]; ll[i] = LGs[63 * 68 + k]; }
#pragma unroll
            for (int i = 0; i < 8; ++i) { const int k = g8 * 8 + i; const float lm1 = lg[i] - lw[i];
                const float ed = __expf(lg[i] - rh[i]), edi = __expf(rh[i] - lg[i]), el = __expf(ll[i] - lg[i]);
                o1[i] = -kkf[i] * __expf(lm1 - rh[i]); o2[i] = rf[i] * ed; o3[i] = bf[i] * edi; o4[i] = kf[i] * edi;
                A0T[k * 68 + t] = -kkf[i] * __expf(lm1);
                BHT[k * 72 + t] = (bf16)f2bf(bf[i] * el); KHT[k * 72 + t] = (bf16)f2bf(kf[i] * el); }
            *(LAS u32x4*)(AT + t * 72 + g8 * 8) = pack8(o1); *(LAS u32x4*)(RT + t * 72 + g8 * 8) = pack8(o2); *(LAS u32x4*)(BTl + t * 72 + g8 * 8) = pack8(o3); *(LAS u32x4*)(KTl + t * 72 + g8 * 8) = pack8(o4);
            const u32x4 vv = *(const u32x4*)(RWV + g); const unsigned vw[4] = {vv.x, vv.y, vv.z, vv.w};
#pragma unroll
            for (int i = 0; i < 4; ++i) { VT[(g8 * 8 + 2 * i) * 72 + t] = (bf16)(vw[i] & 0xffffu); VT[(g8 * 8 + 2 * i + 1) * 72 + t] = (bf16)(vw[i] >> 16); }
            if (t == 0) {
#pragma unroll
                for (int i = 0; i < 8; ++i) { rho[g8 * 8 + i] = rh[i]; lgl[g8 * 8 + i] = ll[i]; } }
        }
        WG_SYNC();
}
PH_FN void rwc_stage12(const Ctx C) {
    const int bc = 0;
    float* RWW = (float*)(C.ws + WS_RWW); const bf16* RWR = (const bf16*)(C.ws + WS_RWR); const bf16* RWK = (const bf16*)(C.ws + WS_RWK); const bf16* RWV = (const bf16*)(C.ws + WS_RWV);
    bf16* RWKK = (bf16*)(C.ws + WS_RWKK); bf16* RWB = (bf16*)(C.ws + WS_RWB); bf16* RWY = (bf16*)(C.ws + WS_RWY);
    LF LGs = (LF)C.lds; LF X1T = LGs; LB AT = (LB)(C.lds + 17408); LB LAK = AT; LB A2T = (LB)(C.lds + 99328); LB RT = (LB)(C.lds + 26624); LB BTl = (LB)(C.lds + 35840); LB MRB = BTl; LB KTl = (LB)(C.lds + 45056); LB MRK = KTl;
    LB VT = (LB)(C.lds + 54272); LB BHT = (LB)(C.lds + 63488); LB KHT = (LB)(C.lds + 72704); LF LAB = (LF)(C.lds + 81920); LB WT = (LB)C.lds; LF A0T = (LF)(C.lds + 99328); LF rho = (LF)(C.lds + 116736); LF lgl = rho + 64;
    const int t = C.tid >> 3, g8 = C.tid & 7, n = C.lane & 31, hi = C.lane >> 5; const size_t row0 = (size_t)bc * 64; (void)t; (void)g8; (void)n; (void)hi; (void)row0;
    (void)RWW; (void)RWR; (void)RWK; (void)RWV; (void)RWKK; (void)RWB; (void)RWY; (void)LGs; (void)X1T; (void)AT; (void)LAK; (void)A2T; (void)RT; (void)BTl; (void)MRB; (void)KTl; (void)MRK; (void)VT; (void)BHT; (void)KHT; (void)LAB; (void)WT; (void)A0T; (void)rho; (void)lgl;
        {   const int mt = C.wave >> 1, nt0 = 2 * (C.wave & 1);
            CLB Am = (mt < 2) ? (CLB)AT : (CLB)RT; const int m0 = 32 * (mt & 1);
            CLB Bm = (nt0 < 2) ? (CLB)BTl : (CLB)KTl;
            f32x16 c0 = zero16(), c1 = zero16();
            mma_nt<64>(c0, Am, 72, m0, Bm, 72, 0, C.lane); mma_nt<64>(c1, Am, 72, m0, Bm, 72, 32, C.lane);
            WG_SYNC();
#pragma unroll
            for (int r = 0; r < 16; ++r) { const int tt = m0 + crow(r, hi); const int j0 = n, j1 = 32 + n;
                if (mt < 2) { const float x0 = (j0 < tt) ? c0[r] : 0.f, x1 = (j1 < tt) ? c1[r] : 0.f;
                    if (nt0 < 2) { LAB[tt * 68 + j0] = x0; LAB[tt * 68 + j1] = x1; } else { LAK[tt * 72 + j0] = (bf16)f2bf(x0); LAK[tt * 72 + j1] = (bf16)f2bf(x1); } }
                else { const float x0 = (j0 <= tt) ? c0[r] : 0.f, x1 = (j1 <= tt) ? c1[r] : 0.f;
                    if (nt0 < 2) { MRB[tt * 72 + j0] = (bf16)f2bf(x0); MRB[tt * 72 + j1] = (bf16)f2bf(x1); } else { MRK[tt * 72 + j0] = (bf16)f2bf(x0); MRK[tt * 72 + j1] = (bf16)f2bf(x1); } } }
        }
        WG_SYNC();
        if (C.wave < 4) { const int vt = C.wave >> 1, tt0 = C.wave & 1; f32x16 c = zero16(); mma_nt<64>(c, VT, 72, 32 * vt, LAK, 72, 32 * tt0, C.lane);
#pragma unroll
            for (int r = 0; r < 16; ++r) X1T[(32 * vt + crow(r, hi)) * 68 + 32 * tt0 + n] = c[r]; }
        WG_SYNC();
}
PH_FN void rwc_solve(const Ctx C) {
    const int bc = 0;
    float* RWW = (float*)(C.ws + WS_RWW); const bf16* RWR = (const bf16*)(C.ws + WS_RWR); const bf16* RWK = (const bf16*)(C.ws + WS_RWK); const bf16* RWV = (const bf16*)(C.ws + WS_RWV);
    bf16* RWKK = (bf16*)(C.ws + WS_RWKK); bf16* RWB = (bf16*)(C.ws + WS_RWB); bf16* RWY = (bf16*)(C.ws + WS_RWY);
    LF LGs = (LF)C.lds; LF X1T = LGs; LB AT = (LB)(C.lds + 17408); LB LAK = AT; LB A2T = (LB)(C.lds + 99328); LB RT = (LB)(C.lds + 26624); LB BTl = (LB)(C.lds + 35840); LB MRB = BTl; LB KTl = (LB)(C.lds + 45056); LB MRK = KTl;
    LB VT = (LB)(C.lds + 54272); LB BHT = (LB)(C.lds + 63488); LB KHT = (LB)(C.lds + 72704); LF LAB = (LF)(C.lds + 81920); LB WT = (LB)C.lds; LF A0T = (LF)(C.lds + 99328); LF rho = (LF)(C.lds + 116736); LF lgl = rho + 64;
    const int t = C.tid >> 3, g8 = C.tid & 7, n = C.lane & 31, hi = C.lane >> 5; const size_t row0 = (size_t)bc * 64; (void)t; (void)g8; (void)n; (void)hi; (void)row0;
    (void)RWW; (void)RWR; (void)RWK; (void)RWV; (void)RWKK; (void)RWB; (void)RWY; (void)LGs; (void)X1T; (void)AT; (void)LAK; (void)A2T; (void)RT; (void)BTl; (void)MRB; (void)KTl; (void)MRK; (void)VT; (void)BHT; (void)KHT; (void)LAB; (void)WT; (void)A0T; (void)rho; (void)lgl;
        if (C.tid < 128) {
            LF row = (C.tid < 64) ? (A0T + C.tid * 68) : (X1T + (C.tid - 64) * 68);
#pragma unroll 1
            for (int tt = 1; tt < 64; ++tt) {
                CLF lr = (CLF)LAB + tt * 68; float s0 = row[tt], s1 = 0.f, s2 = 0.f, s3 = 0.f;
#pragma unroll 2
                for (int j = 0; j < tt; j += 4) {
                    const f32x4 l = *(const LAS f32x4*)(lr + j), xv = *(const LAS f32x4*)(row + j);
                    s0 += l[0] * xv[0]; s1 += l[1] * xv[1]; s2 += l[2] * xv[2]; s3 += l[3] * xv[3]; }
                row[tt] = (s0 + s1) + (s2 + s3);
            }
            float x[64];
#pragma unroll
            for (int q = 0; q < 16; ++q) { const f32x4 v4 = *(const LAS f32x4*)(row + 4 * q); x[4 * q] = v4[0]; x[4 * q + 1] = v4[1]; x[4 * q + 2] = v4[2]; x[4 * q + 3] = v4[3]; }
            LB dst = (LB)row;
#pragma unroll
            for (int q = 0; q < 8; ++q) { u32x4 w; w.x = pk2(x[8 * q], x[8 * q + 1]); w.y = pk2(x[8 * q + 2], x[8 * q + 3]); w.z = pk2(x[8 * q + 4], x[8 * q + 5]); w.w = pk2(x[8 * q + 6], x[8 * q + 7]); *(LAS u32x4*)(dst + 8 * q) = w; }
        }
        WG_SYNC();
}
PH_FN void rwc_stage4(const Ctx C, int bc, int h) {
    float* RWW = (float*)(C.ws + WS_RWW); const bf16* RWR = (const bf16*)(C.ws + WS_RWR); const bf16* RWK = (const bf16*)(C.ws + WS_RWK); const bf16* RWV = (const bf16*)(C.ws + WS_RWV);
    bf16* RWKK = (bf16*)(C.ws + WS_RWKK); bf16* RWB = (bf16*)(C.ws + WS_RWB); bf16* RWY = (bf16*)(C.ws + WS_RWY);
    LF LGs = (LF)C.lds; LF X1T = LGs; LB AT = (LB)(C.lds + 17408); LB LAK = AT; LB A2T = (LB)(C.lds + 99328); LB RT = (LB)(C.lds + 26624); LB BTl = (LB)(C.lds + 35840); LB MRB = BTl; LB KTl = (LB)(C.lds + 45056); LB MRK = KTl;
    LB VT = (LB)(C.lds + 54272); LB BHT = (LB)(C.lds + 63488); LB KHT = (LB)(C.lds + 72704); LF LAB = (LF)(C.lds + 81920); LB WT = (LB)C.lds; LF A0T = (LF)(C.lds + 99328); LF rho = (LF)(C.lds + 116736); LF lgl = rho + 64;
    const int t = C.tid >> 3, g8 = C.tid & 7, n = C.lane & 31, hi = C.lane >> 5; const size_t row0 = (size_t)bc * 64; (void)t; (void)g8; (void)n; (void)hi; (void)row0;
    (void)RWW; (void)RWR; (void)RWK; (void)RWV; (void)RWKK; (void)RWB; (void)RWY; (void)LGs; (void)X1T; (void)AT; (void)LAK; (void)A2T; (void)RT; (void)BTl; (void)MRB; (void)KTl; (void)MRK; (void)VT; (void)BHT; (void)KHT; (void)LAB; (void)WT; (void)A0T; (void)rho; (void)lgl;
        {   const int kind = C.wave >> 1, mt = C.wave & 1;
            f32x16 c0 = zero16(), c1 = zero16();
            if (kind == 0) { mma_nt<64>(c0, BHT, 72, 32 * mt, A2T, 136, 0, C.lane); mma_nt<64>(c1, BHT, 72, 32 * mt, A2T, 136, 32, C.lane); }
            else if (kind == 1) { mma_nt<64>(c0, BHT, 72, 32 * mt, WT, 136, 0, C.lane); mma_nt<64>(c1, BHT, 72, 32 * mt, WT, 136, 32, C.lane); mma_nt<64>(c0, KHT, 72, 32 * mt, VT, 72, 0, C.lane); mma_nt<64>(c1, KHT, 72, 32 * mt, VT, 72, 32, C.lane); }
            else if (kind == 2) { mma_nt<64>(c0, MRB, 72, 32 * mt, A2T, 136, 0, C.lane); mma_nt<64>(c1, MRB, 72, 32 * mt, A2T, 136, 32, C.lane); }
            else { mma_nt<64>(c0, MRB, 72, 32 * mt, WT, 136, 0, C.lane); mma_nt<64>(c1, MRB, 72, 32 * mt, WT, 136, 32, C.lane); mma_nt<64>(c0, MRK, 72, 32 * mt, VT, 72, 0, C.lane); mma_nt<64>(c1, MRK, 72, 32 * mt, VT, 72, 32, C.lane); }
#pragma unroll
            for (int r = 0; r < 16; ++r) { const int m = 32 * mt + crow(r, hi); const size_t go = (row0 + m) * 512 + h * 64;
                if (kind == 0) { const float d = __expf(lgl[m]); RWB[go + n] = (bf16)f2bf(c0[r] + ((n == m) ? d : 0.f)); RWB[go + 32 + n] = (bf16)f2bf(c1[r] + ((32 + n == m) ? d : 0.f)); }
                else if (kind == 1) { RWW[go + n] = c0[r]; RWW[go + 32 + n] = c1[r]; }
                else if (kind == 2) { RWKK[go + n] = (bf16)f2bf(c0[r] + bf2f(RT[m * 72 + n]) * __expf(rho[n])); RWKK[go + 32 + n] = (bf16)f2bf(c1[r] + bf2f(RT[m * 72 + 32 + n]) * __expf(rho[32 + n])); }
                else { RWY[go + n] = (bf16)f2bf(c0[r]); RWY[go + 32 + n] = (bf16)f2bf(c1[r]); } }
        }
}
__device__ __forceinline__ void ph_rw_chunk(const Ctx& C, int bc) {
#pragma unroll 1
    for (int h = 0; h < 8; ++h) { rwc_stage0(C, bc, h); rwc_stage12(C); rwc_solve(C); rwc_stage4(C, bc, h); }
    WG_SYNC();
}
PH_FN void rw_scan_unit(const Ctx C, int chain) {
    const float* RWW = (const float*)(C.ws + WS_RWW); const bf16* RWKK = (const bf16*)(C.ws + WS_RWKK); const bf16* RWB = (const bf16*)(C.ws + WS_RWB); bf16* RWY = (bf16*)(C.ws + WS_RWY);
    const int b = chain >> 3, h = chain & 7; const size_t rowb = (size_t)b * SEQ;
    constexpr int BUFB = 45056, O_RQ = 0, O_PT = 9216, O_QT = 18432, O_Y0 = 35840;
    LAS unsigned char* L = C.lds;
    if (C.wave >= 4) {
        const int p = C.tid - 256, t = p >> 2, q4 = (p & 3) * 16;
        u32x4 rq0, rq1, pt0, pt1, y00, y01; f32x4 q0, q1, q2, q3;
#define SC_LOAD(c_) do { const size_t g_ = (rowb + (size_t)(c_) * 64 + t) * 512 + h * 64 + q4; \
            rq0 = *(const u32x4*)(RWKK + g_); rq1 = *(const u32x4*)(RWKK + g_ + 8); pt0 = *(const u32x4*)(RWB + g_); pt1 = *(const u32x4*)(RWB + g_ + 8); y00 = *(const u32x4*)(RWY + g_); y01 = *(const u32x4*)(RWY + g_ + 8); \
            q0 = *(const f32x4*)(RWW + g_); q1 = *(const f32x4*)(RWW + g_ + 4); q2 = *(const f32x4*)(RWW + g_ + 8); q3 = *(const f32x4*)(RWW + g_ + 12); } while (0)
        SC_LOAD(0);
        for (int c = 0; c < NCH; ++c) {
            LAS unsigned char* Lb = L + (c & 1) * BUFB;
            *(LAS u32x4*)((LB)(Lb + O_RQ) + t * 72 + q4) = rq0; *(LAS u32x4*)((LB)(Lb + O_RQ) + t * 72 + q4 + 8) = rq1;
            *(LAS u32x4*)((LB)(Lb + O_PT) + t * 72 + q4) = pt0; *(LAS u32x4*)((LB)(Lb + O_PT) + t * 72 + q4 + 8) = pt1;
            *(LAS u32x4*)((LB)(Lb + O_Y0) + t * 72 + q4) = y00; *(LAS u32x4*)((LB)(Lb + O_Y0) + t * 72 + q4 + 8) = y01;
            { LF d = (LF)(Lb + O_QT) + t * 68 + q4; *(LAS f32x4*)d = q0; *(LAS f32x4*)(d + 4) = q1; *(LAS f32x4*)(d + 8) = q2; *(LAS f32x4*)(d + 12) = q3; }
            if (c + 1 < NCH) SC_LOAD(c + 1);
            RW_BAR();
        }
        RW_BAR();
#undef SC_LOAD
    } else {
        const int n = C.lane & 31, hi = C.lane >> 5, vh = C.wave & 1;
        f32x16 st0 = zero16(), st1 = zero16();
        for (int c = 0; c < NCH; ++c) {
            RW_BAR();
            if (C.wave < 2) {
                const LAS unsigned char* Lb = L + (c & 1) * BUFB;
                CLB RQ = (CLB)(Lb + O_RQ); CLB PT = (CLB)(Lb + O_PT); CLF QT = (CLF)(Lb + O_QT); CLB Y0 = (CLB)(Lb + O_Y0);
                pg8::bf16x8 sb[4];
                { u32x4 w;
                  w.x = pk2(st0[0], st0[1]); w.y = pk2(st0[2], st0[3]); w.z = pk2(st0[4], st0[5]); w.w = pk2(st0[6], st0[7]); sb[0] = __builtin_bit_cast(pg8::bf16x8, w);
                  w.x = pk2(st0[8], st0[9]); w.y = pk2(st0[10], st0[11]); w.z = pk2(st0[12], st0[13]); w.w = pk2(st0[14], st0[15]); sb[1] = __builtin_bit_cast(pg8::bf16x8, w);
                  w.x = pk2(st1[0], st1[1]); w.y = pk2(st1[2], st1[3]); w.z = pk2(st1[4], st1[5]); w.w = pk2(st1[6], st1[7]); sb[2] = __builtin_bit_cast(pg8::bf16x8, w);
                  w.x = pk2(st1[8], st1[9]); w.y = pk2(st1[10], st1[11]); w.z = pk2(st1[12], st1[13]); w.w = pk2(st1[14], st1[15]); sb[3] = __builtin_bit_cast(pg8::bf16x8, w); }
#define SC_AFRAG(X_, row_, s_) ({ const u32x2 lo_ = *(const LAS u32x2*)((X_) + (row_) * 72 + 16 * (s_) + 4 * hi), hi_ = *(const LAS u32x2*)((X_) + (row_) * 72 + 16 * (s_) + 8 + 4 * hi); \
                    u32x4 w_; w_.x = lo_.x; w_.y = lo_.y; w_.z = hi_.x; w_.w = hi_.y; __builtin_bit_cast(pg8::bf16x8, w_); })
#pragma unroll
                for (int tt = 0; tt < 2; ++tt) { f32x16 y;
#pragma unroll
                    for (int r = 0; r < 16; ++r) y[r] = bf2f(Y0[(32 * tt + crow(r, hi)) * 72 + 32 * vh + n]);
#pragma unroll
                    for (int s = 0; s < 4; ++s) y = __builtin_amdgcn_mfma_f32_32x32x16_bf16(SC_AFRAG(RQ, 32 * tt + n, s), sb[s], y, 0, 0, 0);
                    bf16* yo = RWY + (rowb + (size_t)c * 64 + 32 * tt) * 512 + h * 64 + 32 * vh + n;
#pragma unroll
                    for (int r = 0; r < 16; ++r) yo[(size_t)crow(r, hi) * 512] = (bf16)f2bf(y[r]); }
                f32x16 n0, n1;
#pragma unroll
                for (int r = 0; r < 16; ++r) { n0[r] = QT[crow(r, hi) * 68 + 32 * vh + n]; n1[r] = QT[(32 + crow(r, hi)) * 68 + 32 * vh + n]; }
#pragma unroll
                for (int s = 0; s < 4; ++s) { n0 = __builtin_amdgcn_mfma_f32_32x32x16_bf16(SC_AFRAG(PT, n, s), sb[s], n0, 0, 0, 0); n1 = __builtin_amdgcn_mfma_f32_32x32x16_bf16(SC_AFRAG(PT, 32 + n, s), sb[s], n1, 0, 0, 0); }
                st0 = n0; st1 = n1;
#undef SC_AFRAG
            }
        }
        RW_BAR();
    }
}
#ifndef REP_ATTN
#define REP_ATTN 1
#endif
#ifndef REP_W
#define REP_W 1
#endif
#ifndef REP_RWC
#define REP_RWC 1
#endif
#ifndef REP_MAC
#define REP_MAC 1
#endif
constexpr int NPH = 12, G_FINAL = 1 + NL * NPH, G_END = G_FINAL + 1;
template <int GRP>
__global__ void __launch_bounds__(NTHR, 2) hybrid_fwd(Args args) {
    constexpr bool ALL = (GRP < 0);
    constexpr bool EN_G1 = ALL || GRP == 0, EN_G2 = EN_G1, EN_G3 = EN_G1, EN_G7 = EN_G1, EN_G8 = EN_G1, EN_G9 = EN_G1;
    constexpr bool EN_PRO = ALL || GRP == 1, EN_W = EN_PRO, EN_FIN = EN_PRO, EN_MA1 = EN_PRO, EN_MA2 = EN_PRO, EN_MA3 = EN_PRO, EN_MA4 = EN_PRO;
    constexpr bool EN_MB1 = ALL || GRP == 2, EN_MB2 = EN_MB1;
    constexpr bool EN_MC1 = ALL || GRP == 3, EN_MC2 = EN_MC1, EN_MC3 = EN_MC1;
    extern __shared__ __attribute__((aligned(16))) unsigned char lds[];
    Ctx C; C.lds = (LAS unsigned char*)lds; C.ws = args.ws; C.h = args.out; C.tid = threadIdx.x; C.lane = C.tid & 63; C.wave = __builtin_amdgcn_readfirstlane(C.tid >> 6); C.bid = blockIdx.x; C.G = gridDim.x;
    LAS unsigned char* ldsl = (LAS unsigned char*)lds;
    const ArgsP ap = (ArgsP)__builtin_amdgcn_kernarg_segment_ptr();
    for (int u = C.tid; u < (LDS_BYTES - LDSCTL_OFF) / 4; u += NTHR) ((LAS unsigned*)(ldsl + LDSCTL_OFF))[u] = 0u;
    __syncthreads();
    volatile LAS unsigned* MISC = (volatile LAS unsigned*)(ldsl + MISC_OFF);
    gu32* ctl = (gu32*)(args.ws + WS_CTL);
    const int g_lo = args.g_lo, g_hi = args.g_hi;
    XcdBarrier bar; bar.bar = (unsigned*)(ctl + CW_BAR); bar.x = 0; bar.st = nullptr;
    if (g_hi - g_lo > 1) bar = xcd_barrier_post((unsigned*)(ctl + CW_BAR), MISC + 8);
#define IN(g) (g_lo <= (g) && (g) < g_hi)
#define SEAM(g) do { if (IN(g) && IN((g) + 1)) xcd_barrier(bar); } while (0)
    bf16* HB = (bf16*)(args.ws + WS_HB); float* SSQ = (float*)(args.ws + WS_SSQ);

    if (EN_PRO && IN(0)) ph_prologue(fresh(C), ap);
    SEAM(0);
#pragma unroll 1
    for (int l = 0; l < NL; ++l) {
        const int gb = 1 + NPH * l;
        if (EN_W && IN(gb + 0)) { for (int rep = 0; rep < REP_W; ++rep) ph_weights(fresh(C), ap, l); }
        SEAM(gb + 0);
#pragma unroll 1
        for (int f = 0; f < 2; ++f) {
            const int gu = gb + (f ? 10 : 1);
            if (EN_G1 && IN(gu)) {
                pg8::Gemm g{HB, (const bf16*)(args.ws + (f ? WS_WGU2 : WS_WGU1)), M, 2 * FF, D, D}; pg8::StaticOrder S; S.init(M, 2 * FF, C.G, C.bid);
                pg8::EpiSwiglu E{(bf16*)(args.ws + WS_ACT), FF, SSQ, M};
                pg8::gemm_phase<pg8::EpiSwiglu, pg8::StaticOrder, true, true>(ldsl, g, S, E);
            }
            SEAM(gu);
            if (EN_G2 && IN(gu + 1)) {
                pg8::Gemm g{(const bf16*)(args.ws + WS_ACT), (const bf16*)(args.ws + (f ? WS_WD2 : WS_WD1)), M, D, FF, FF}; pg8::StaticOrder S; S.init(M, D, C.G, C.bid);
                pg8::EpiResid E{C.h, HB, SSQ, M, 0.5f};
                pg8::gemm_phase<pg8::EpiResid, pg8::StaticOrder, false, true>(ldsl, g, S, E);
            }
            SEAM(gu + 1);
            if (f == 0) {
                if (EN_G3 && IN(gb + 3)) {
                    pg8::Gemm g{HB, (const bf16*)(args.ws + WS_WIN), M, NPM, D, D}; pg8::StaticOrder S; S.init(M, NPM, C.G, C.bid);
                    pg8::EpiScaleBf16 E{(bf16*)(args.ws + WS_P), NPM, SSQ, M};
                    pg8::gemm_phase<pg8::EpiScaleBf16, pg8::StaticOrder, true, true>(ldsl, g, S, E);
                }
                SEAM(gb + 3);
                if (IN(gb + 4)) { if (EN_MA1) ph_da_prep(fresh(C)); for (int rep = 0; rep < REP_MAC; ++rep) { if (EN_MA2) ph_gla_a(fresh(C), ap, l); if (EN_MA3) ph_ssd_a(fresh(C), ap, l); if (EN_MA4) { ph_rw_prep(fresh(C), ap, l); if (RW_CHUNKED) ph_rw_chunk(fresh(C), C.bid); } } }
                SEAM(gb + 4);
                if (IN(gb + 5)) {
#if RW_CHUNKED
                    if (EN_MB2) { if (C.bid < 16) rw_scan_unit(fresh(C), C.bid); else { for (int p = C.bid - 16; p < 384; p += C.G - 16) { if (p < 128) gla_scan_part(fresh(C), p); else ssd_scan_part(fresh(C), p - 128); } } }
                    for (int rep = 0; rep < REP_ATTN; ++rep) if (EN_MB1) ph_da_attn(fresh(C), args, l, C.bid & 7, C.bid >> 3);
#else
                    if (C.bid < 64) { if (EN_MB2) { const int xcd = C.bid & 7, slot = C.bid >> 3; for (int rep = 0; rep < REP_RWC; ++rep) rw_unit(fresh(C), xcd * 2 + (slot >> 2), slot & 3); } }
                    else { const int a = C.bid - 64;
                        if (EN_MB2) { for (int p = a; p < 384; p += 192) { if (p < 128) gla_scan_part(fresh(C), p); else ssd_scan_part(fresh(C), p - 128); } }
                        for (int rep = 0; rep < REP_ATTN; ++rep) if (EN_MB1) ph_da_attn(fresh(C), args, l, a & 7, a >> 3); }
#endif
                }
                SEAM(gb + 5);
                if (IN(gb + 6)) { for (int rep = 0; rep < REP_MAC; ++rep) { if (EN_MC1) ph_gla_c(fresh(C), ap, l); if (EN_MC2) ph_ssd_c(fresh(C), ap, l); if (EN_MC3) ph_rw_out(fresh(C), ap, l); } }
                SEAM(gb + 6);
                if (EN_G7 && IN(gb + 7)) {
                    pg8::Gemm g{HB, (const bf16*)(args.ws + WS_WIN) + (size_t)NPM * D, M, 4096, D, D}; pg8::StaticOrder S; S.init(M, 4096, C.G, C.bid);
                    pg8::EpiScaleBf16 E{(bf16*)(args.ws + WS_PG), 4096, SSQ, M};
                    pg8::gemm_phase<pg8::EpiScaleBf16, pg8::StaticOrder, true, true>(ldsl, g, S, E);
                }
                SEAM(gb + 7);
                if (EN_G8 && IN(gb + 8)) {
                    pg8::Gemm g{(const bf16*)(args.ws + WS_YS), (const bf16*)(args.ws + WS_WB), M, D, 512, 2048}; pg8::GroupedOrder S; S.init(M, D, 4, 512, C.G, C.bid);
                    pg8::EpiGateAcc E{(bf16*)(args.ws + WS_MERGED), (const bf16*)(args.ws + WS_PG), args.in[33] + (size_t)l * 4096};
                    pg8::gemm_phase<pg8::EpiGateAcc, pg8::GroupedOrder, true, true>(ldsl, g, S, E);
                }
                SEAM(gb + 8);
                if (EN_G9 && IN(gb + 9)) {
                    pg8::Gemm g{(const bf16*)(args.ws + WS_MERGED), (const bf16*)(args.ws + WS_WO), M, D, D, D}; pg8::StaticOrder S; S.init(M, D, C.G, C.bid);
                    pg8::EpiResid E{C.h, HB, SSQ, M, 1.0f};
                    pg8::gemm_phase<pg8::EpiResid, pg8::StaticOrder, false, true>(ldsl, g, S, E);
                }
                SEAM(gb + 9);
            }
        }
    }
    if (EN_FIN && IN(G_FINAL)) ph_final(fresh(C), ap);
#undef IN
#undef SEAM
}

#ifndef ONE_LAUNCH
#define ONE_LAUNCH 1
#endif
extern "C" void kernel_launch(void* const* d_in, const int* in_sizes, int n_in, void* d_out, int out_size, void* d_ws, size_t ws_size, hipStream_t stream) {
    static int grid = 0;
    if (grid == 0) {
        if (n_in != 40 || in_sizes[0] != M * D || out_size != M * D || ws_size < WS_END) { fprintf(stderr, "kernel_launch: unexpected shapes (n_in %d, in0 %d, out %d, ws %zu < %zu); nothing launched\n", n_in, n_in > 0 ? in_sizes[0] : -1, out_size, ws_size, (size_t)WS_END); grid = -1; return; }
        int dev = 0, cus = 0, per_cu = 0;
        if (hipGetDevice(&dev) != hipSuccess || hipDeviceGetAttribute(&cus, hipDeviceAttributeMultiprocessorCount, dev) != hipSuccess) { grid = -1; return; }
#if ONE_LAUNCH
        if (hipFuncSetAttribute((const void*)hybrid_fwd<-1>, hipFuncAttributeMaxDynamicSharedMemorySize, LDS_BYTES) != hipSuccess) { fprintf(stderr, "kernel_launch: hipFuncSetAttribute failed\n"); grid = -1; return; }
#else
        if (hipFuncSetAttribute((const void*)hybrid_fwd<0>, hipFuncAttributeMaxDynamicSharedMemorySize, LDS_BYTES) != hipSuccess || hipFuncSetAttribute((const void*)hybrid_fwd<1>, hipFuncAttributeMaxDynamicSharedMemorySize, LDS_BYTES) != hipSuccess ||
            hipFuncSetAttribute((const void*)hybrid_fwd<2>, hipFuncAttributeMaxDynamicSharedMemorySize, LDS_BYTES) != hipSuccess || hipFuncSetAttribute((const void*)hybrid_fwd<3>, hipFuncAttributeMaxDynamicSharedMemorySize, LDS_BYTES) != hipSuccess) { fprintf(stderr, "kernel_launch: hipFuncSetAttribute failed\n"); grid = -1; return; }
#endif
        if (hipOccupancyMaxActiveBlocksPerMultiprocessor(&per_cu, (const void*)hybrid_fwd<(ONE_LAUNCH ? -1 : 0)>, NTHR, LDS_BYTES) != hipSuccess || per_cu < 1) fprintf(stderr, "kernel_launch: occupancy query reports %d workgroups per CU\n", per_cu);
        (void)hipGetLastError();
        grid = cus;
        if (grid != 256) { fprintf(stderr, "kernel_launch: %d CUs; this kernel is laid out for 256 workgroups; nothing launched\n", grid); grid = -1; return; }
    }
    if (grid < 0) return;
    if (hipMemsetAsync((char*)d_ws + WS_CTL, 0, CTL_ZERO_BYTES, stream) != hipSuccess) return;
    Args a{};
    for (int i = 0; i < 40; ++i) a.in[i] = (const float*)d_in[i];
    a.out = (float*)d_out; a.ws = (unsigned char*)d_ws;
    for (int j = 0; j < 32; ++j) a.inv_freq[j] = (float)pow(10000.0, -(double)j / 32.0);
#if ONE_LAUNCH
    a.g_lo = 0; a.g_hi = G_END;
    hipLaunchKernelGGL(hybrid_fwd<-1>, dim3(grid), dim3(NTHR), LDS_BYTES, stream, a);
#else
    for (int g = 0; g < G_END; ++g) {
        a.g_lo = g; a.g_hi = g + 1;
        int grp = 1;
        if (g >= 1 && g < G_FINAL) { const int k = (g - 1) % NPH; grp = (k == 0 || k == 4) ? 1 : (k == 5) ? 2 : (k == 6) ? 3 : 0; }
        if (grp == 0) hipLaunchKernelGGL(hybrid_fwd<0>, dim3(grid), dim3(NTHR), LDS_BYTES, stream, a);
        else if (grp == 1) hipLaunchKernelGGL(hybrid_fwd<1>, dim3(grid), dim3(NTHR), LDS_BYTES, stream, a);
        else if (grp == 2) hipLaunchKernelGGL(hybrid_fwd<2>, dim3(grid), dim3(NTHR), LDS_BYTES, stream, a);
        else hipLaunchKernelGGL(hybrid_fwd<3>, dim3(grid), dim3(NTHR), LDS_BYTES, stream, a);
    }
#endif
}
```

```cpp
#include <hip/hip_runtime.h>
#include <cstdio>
#include <cstdint>
#include <cmath>

namespace pg8 {
#define PG8_LAS __attribute__((address_space(3)))
typedef unsigned short bf16_t;
typedef short bf16x8 __attribute__((ext_vector_type(8)));
typedef float f32x4 __attribute__((ext_vector_type(4)));
typedef unsigned u32x4 __attribute__((ext_vector_type(4)));
constexpr int BM = 256, BK = 64, HALF = 128, HTB = HALF * BK * 2  , STAGE_BYTES = 8 * HTB, NXCD = 8, WGM = 8;

__host__ __device__ __forceinline__ int lds_byte(int r, int c) { const int st = (r >> 4) * 2 + (c >> 5), rr = r & 15, cc = c & 31, ob = rr * 64 + cc * 2; return st * 1024 + (ob ^ (((ob >> 9) & 1) << 5)); }
__host__ __device__ __forceinline__ void stage_rc(int b, int& R, int& C) { const int st = b / 1024, sb = b % 1024, swz = sb ^ (((sb >> 9) & 1) << 5); R = (st >> 1) * 16 + swz / 64; C = (st & 1) * 32 + (swz % 64) / 2; }
__host__ __device__ __forceinline__ int perm32(int rho) { const int n = rho >> 4, i = rho & 15; return 8 * (i >> 2) + 4 * n + (i & 3); }

struct Unit { int pm, pn, z; };
struct Gemm { const bf16_t* A; const bf16_t* Bt; int M, N, K, lda; };

struct StaticOrder {
    int nM, nN, nwg, G, c;
    __host__ __device__ void init(int M, int N, int G_, int c_) { nM = M / BM; nN = N / BM; nwg = nM * nN; G = G_; c = c_; }
    __host__ __device__ bool next(int i, Unit& u) const {
        const long L = (long)i * G + c; if (L >= nwg) return false;
        int wgid = (int)L; { const int q = nwg / NXCD, r = nwg % NXCD, xcd = wgid % NXCD, off = wgid / NXCD; wgid = (xcd < r ? xcd * (q + 1) : r * (q + 1) + (xcd - r) * q) + off; }
        const int nig = WGM * nN, gid = wgid / nig, fm = gid * WGM, gsz = (nM - fm) < WGM ? (nM - fm) : WGM;
        u.pm = fm + ((wgid % nig) % gsz); u.pn = (wgid % nig) / gsz; u.z = 0; return true;
    }
    __device__ __forceinline__ void a_ready(const Unit&) const {}
    __device__ __forceinline__ void done(const Unit&) const {}
    __device__ __forceinline__ size_t a_off(const Unit&) const { return 0; }
    __device__ __forceinline__ int b_tile(const Unit& u) const { return u.pn; }
};
struct GroupedOrder {
    StaticOrder base; int NZ, Kbytes, tiles_per_group;
    __device__ void init(int M, int N, int NZ_, int K, int G_, int c_) { base.init(M, N, G_, c_); NZ = NZ_; Kbytes = K * 2; tiles_per_group = N / BM; }
    __device__ bool next(int i, Unit& u) const { const int r = i / NZ, z = i - r * NZ; if (!base.next(r, u)) return false; u.z = z; return true; }
    __device__ __forceinline__ void a_ready(const Unit&) const {}
    __device__ __forceinline__ void done(const Unit&) const {}
    __device__ __forceinline__ size_t a_off(const Unit& u) const { return (size_t)u.z * Kbytes; }
    __device__ __forceinline__ int b_tile(const Unit& u) const { return u.z * tiles_per_group + u.pn; }
};

__device__ __forceinline__ unsigned cvt_pk_bf16(float lo, float hi) { unsigned r; asm volatile("v_cvt_pk_bf16_f32 %0, %1, %2" : "=v"(r) : "v"(lo), "v"(hi)); return r; }
__device__ __forceinline__ float bf_lo(unsigned w) { return __uint_as_float(w << 16); }
__device__ __forceinline__ float bf_hi(unsigned w) { return __uint_as_float(w & 0xffff0000u); }
__device__ __forceinline__ float fast_sigmoid(float x) { return __builtin_amdgcn_rcpf(1.0f + __builtin_amdgcn_exp2f(-1.4426950408889634f * x)); }

__device__ __forceinline__ float row_rstd(const float* ssq, int row, int M_) {
    const float s = (ssq[row] + ssq[M_ + row]) + (ssq[2 * M_ + row] + ssq[3 * M_ + row]);
    return 1.0f / sqrtf(s * (1.0f / 1024.0f) + 1e-6f);
}
struct EpiScaleBf16 {
    static constexpr bool PERM = true, AFTER_DRAIN = false;
    bf16_t* O; int ldc; const float* ssq; int M_;
    __device__ __forceinline__ void operator()(const f32x4 (&acc)[2][2][4][2], const Unit& u, int wr, int wc, int fr, int fq) const {
        const int row0 = u.pm * BM + wr * 64 + fr; const int col0 = u.pn * BM + wc * 32 + 8 * fq;
#pragma unroll
        for (int ai = 0; ai < 2; ++ai)
#pragma unroll
            for (int m = 0; m < 4; ++m) { const int row = row0 + ai * HALF + m * 16; const float rs = row_rstd(ssq, row, M_); bf16_t* rowp = O + (size_t)row * ldc + col0;
#pragma unroll
                for (int bj = 0; bj < 2; ++bj) { const f32x4 v0 = acc[ai][bj][m][0] * rs, v1 = acc[ai][bj][m][1] * rs;
                    u32x4 w; w.x = cvt_pk_bf16(v0[0], v0[1]); w.y = cvt_pk_bf16(v0[2], v0[3]); w.z = cvt_pk_bf16(v1[0], v1[1]); w.w = cvt_pk_bf16(v1[2], v1[3]);
                    *(u32x4*)(rowp + bj * HALF) = w; } }
    }
};
struct EpiSwiglu {
    static constexpr bool PERM = true, AFTER_DRAIN = false;
    bf16_t* O; int ldc; const float* ssq; int M_;
    __device__ __forceinline__ void operator()(const f32x4 (&acc)[2][2][4][2], const Unit& u, int wr, int wc, int fr, int fq) const {
        const int row0 = u.pm * BM + wr * 64 + fr; const int col0 = u.pn * HALF + wc * 32 + 8 * fq;
#pragma unroll
        for (int ai = 0; ai < 2; ++ai)
#pragma unroll
            for (int m = 0; m < 4; ++m) { const int row = row0 + ai * HALF + m * 16; const float rs = row_rstd(ssq, row, M_); bf16_t* rowp = O + (size_t)row * ldc + col0;
                float o[8];
#pragma unroll
                for (int n = 0; n < 2; ++n)
#pragma unroll
                    for (int i = 0; i < 4; ++i) { const float g = acc[ai][0][m][n][i] * rs, up = acc[ai][1][m][n][i] * rs; o[n * 4 + i] = g * fast_sigmoid(g) * up; }
                u32x4 w; w.x = cvt_pk_bf16(o[0], o[1]); w.y = cvt_pk_bf16(o[2], o[3]); w.z = cvt_pk_bf16(o[4], o[5]); w.w = cvt_pk_bf16(o[6], o[7]);
                *(u32x4*)rowp = w; }
    }
};
struct EpiGateAcc {
    static constexpr bool PERM = true, AFTER_DRAIN = false;
    bf16_t* O; const bf16_t* PG; const float* gb;
    __device__ __forceinline__ void operator()(const f32x4 (&acc)[2][2][4][2], const Unit& u, int wr, int wc, int fr, int fq) const {
        const int row0 = u.pm * BM + wr * 64 + fr; const int col0 = u.pn * BM + wc * 32 + 8 * fq; const int z = u.z;
        f32x4 gbv[2][2];
#pragma unroll
        for (int bj = 0; bj < 2; ++bj)
#pragma unroll
            for (int n = 0; n < 2; ++n) gbv[bj][n] = *(const f32x4*)(gb + z * 1024 + col0 + bj * HALF + 4 * n);
#pragma unroll
        for (int ai = 0; ai < 2; ++ai)
#pragma unroll
            for (int m = 0; m < 4; ++m) { const int row = row0 + ai * HALF + m * 16;
#pragma unroll
                for (int bj = 0; bj < 2; ++bj) {
                    const u32x4 pg = *(const u32x4*)(PG + (size_t)row * 4096 + z * 1024 + col0 + bj * HALF);
                    bf16_t* op = O + (size_t)row * 1024 + col0 + bj * HALF;
                    float o[8];
                    o[0] = fast_sigmoid(bf_lo(pg.x) + gbv[bj][0][0]) * acc[ai][bj][m][0][0]; o[1] = fast_sigmoid(bf_hi(pg.x) + gbv[bj][0][1]) * acc[ai][bj][m][0][1];
                    o[2] = fast_sigmoid(bf_lo(pg.y) + gbv[bj][0][2]) * acc[ai][bj][m][0][2]; o[3] = fast_sigmoid(bf_hi(pg.y) + gbv[bj][0][3]) * acc[ai][bj][m][0][3];
                    o[4] = fast_sigmoid(bf_lo(pg.z) + gbv[bj][1][0]) * acc[ai][bj][m][1][0]; o[5] = fast_sigmoid(bf_hi(pg.z) + gbv[bj][1][1]) * acc[ai][bj][m][1][1];
                    o[6] = fast_sigmoid(bf_lo(pg.w) + gbv[bj][1][2]) * acc[ai][bj][m][1][2]; o[7] = fast_sigmoid(bf_hi(pg.w) + gbv[bj][1][3]) * acc[ai][bj][m][1][3];
                    if (z > 0) { const u32x4 pv = *(const u32x4*)op;
                        o[0] += bf_lo(pv.x); o[1] += bf_hi(pv.x); o[2] += bf_lo(pv.y); o[3] += bf_hi(pv.y); o[4] += bf_lo(pv.z); o[5] += bf_hi(pv.z); o[6] += bf_lo(pv.w); o[7] += bf_hi(pv.w); }
                    u32x4 w; w.x = cvt_pk_bf16(o[0], o[1]); w.y = cvt_pk_bf16(o[2], o[3]); w.z = cvt_pk_bf16(o[4], o[5]); w.w = cvt_pk_bf16(o[6], o[7]);
                    *(u32x4*)op = w; } }
    }
};
struct EpiResid {
    static constexpr bool PERM = true, AFTER_DRAIN = true;
    float* H; bf16_t* HB; float* ssq; int M_; float s;
    __device__ __forceinline__ void fused(f32x4 (&acc)[2][2][4][2], const Unit& u, int wr, int wc, int fr, int fq, PG8_LAS unsigned char* lds, int wid, int lane) const {
        PG8_LAS float* P = (PG8_LAS float*)lds;
        const int row0 = u.pm * BM + wr * 64 + fr; const int col0 = u.pn * BM + wc * 32 + 8 * fq;
#pragma unroll
        for (int ai = 0; ai < 2; ++ai)
#pragma unroll
            for (int m = 0; m < 4; ++m) { const int row = row0 + ai * HALF + m * 16; float q = 0.f;
#pragma unroll
                for (int bj = 0; bj < 2; ++bj) { float* hp = H + (size_t)row * 1024 + col0 + bj * HALF;
                    const f32x4 h0 = *(const f32x4*)hp + acc[ai][bj][m][0] * s, h1 = *(const f32x4*)(hp + 4) + acc[ai][bj][m][1] * s;
                    *(f32x4*)hp = h0; *(f32x4*)(hp + 4) = h1;
                    q += (h0[0] * h0[0] + h0[1] * h0[1]) + (h0[2] * h0[2] + h0[3] * h0[3]) + (h1[0] * h1[0] + h1[1] * h1[1]) + (h1[2] * h1[2] + h1[3] * h1[3]);
                    u32x4 w; w.x = cvt_pk_bf16(h0[0], h0[1]); w.y = cvt_pk_bf16(h0[2], h0[3]); w.z = cvt_pk_bf16(h1[0], h1[1]); w.w = cvt_pk_bf16(h1[2], h1[3]);
                    *(u32x4*)(HB + (size_t)row * 1024 + col0 + bj * HALF) = w; }
                q += __shfl_xor(q, 16); q += __shfl_xor(q, 32);
                if (fq == 0) P[(ai * HALF + wr * 64 + m * 16 + fr) * 4 + wc] = q; }
        asm volatile("s_waitcnt lgkmcnt(0)" ::: "memory"); __builtin_amdgcn_s_barrier(); asm volatile("" ::: "memory");
        const int t = wid * 64 + lane;
        if (t < 256) { const float q = (P[t * 4 + 0] + P[t * 4 + 1]) + (P[t * 4 + 2] + P[t * 4 + 3]); ssq[(size_t)u.pn * M_ + u.pm * BM + t] = q; }
        asm volatile("s_waitcnt lgkmcnt(0)" ::: "memory"); __builtin_amdgcn_s_barrier(); asm volatile("" ::: "memory");
    }
};
template <class Epi, class Sched, bool ALIGN_EPI = false, bool SP2 = false>
__device__ __forceinline__ void gemm_phase(PG8_LAS unsigned char* lds, const Gemm g, const Sched& S, const Epi& E) {
    int tid_ = threadIdx.x; asm volatile("" : "+v"(tid_)); const int tid = tid_, wid = __builtin_amdgcn_readfirstlane(tid >> 6), lane = tid & 63, wr = wid >> 2, wc = wid & 3, fr = lane & 15, fq = lane >> 4;
    const int K = g.K, nt = K / BK;
    unsigned voffA[2], voffB[2];
#pragma unroll
    for (int i = 0; i < 2; ++i) { int R, C; stage_rc(tid * 16 + i * 8192, R, C); const int Rb = Epi::PERM ? ((R & ~31) + perm32(R & 31)) : R;
        voffA[i] = (unsigned)(R * g.lda + C) * 2u; voffB[i] = (unsigned)(Rb * K + C) * 2u; }
    const size_t kstep = (size_t)(BK * 2);
    const size_t hstep = (size_t)HALF * K * 2;
    const size_t tstep = 2 * hstep; const size_t hstepA = (size_t)HALF * g.lda * 2, tstepA = 2 * hstepA;
    const unsigned ldsw = (unsigned)wid * 1024u;
    const int aoff = lds_byte(wr * 64 + fr, fq * 8), boff = lds_byte(wc * 32 + fr, fq * 8);
#define PG8_SA(b, h) (((b) * 2 + (h)) * HTB)
#define PG8_SB(b, h) ((4 + (b) * 2 + (h)) * HTB)
#define PG8_STAGE(bufoff, gbase, voff) do { _Pragma("unroll") for (int _i = 0; _i < 2; ++_i) \
        __builtin_amdgcn_global_load_lds((const unsigned*)((const char*)(gbase) + (voff)[_i]), (PG8_LAS unsigned*)(lds + (bufoff) + ldsw + _i * 8192), 16, 0, 0); } while (0)
#define PG8_LDA(dst, b, h) do { _Pragma("unroll") for (int m = 0; m < 4; ++m) _Pragma("unroll") for (int k = 0; k < 2; ++k) dst[m][k] = *(const PG8_LAS bf16x8*)(lds + PG8_SA(b, h) + aoff + m * 2048 + k * 1024); } while (0)
#define PG8_LDB(dst, b, h) do { _Pragma("unroll") for (int n = 0; n < 2; ++n) _Pragma("unroll") for (int k = 0; k < 2; ++k) dst[n][k] = *(const PG8_LAS bf16x8*)(lds + PG8_SB(b, h) + boff + n * 2048 + k * 1024); } while (0)
#define PG8_MMA(ai, bj, At, Bt) do { __builtin_amdgcn_s_setprio(1); _Pragma("unroll") for (int m = 0; m < 4; ++m) _Pragma("unroll") for (int n = 0; n < 2; ++n) _Pragma("unroll") for (int k = 0; k < 2; ++k) \
        acc[ai][bj][m][n] = __builtin_amdgcn_mfma_f32_16x16x32_bf16(Bt[n][k], At[m][k], acc[ai][bj][m][n], 0, 0, 0); __builtin_amdgcn_s_setprio(0); } while (0)
#define PG8_WAIT_V(n) asm volatile("s_waitcnt vmcnt(" #n ")" ::: "memory")
#define PG8_WAIT_L(n) asm volatile("s_waitcnt lgkmcnt(" #n ")" ::: "memory")
#define PG8_BAR __builtin_amdgcn_s_barrier()
#define PG8_SCHED __builtin_amdgcn_sched_barrier(0)
    Unit cur, nxt; int ui = 0;
    if (!S.next(0, cur)) return;
    f32x4 acc[2][2][4][2];
#pragma unroll
    for (int a = 0; a < 2; ++a)
#pragma unroll
        for (int b = 0; b < 2; ++b)
#pragma unroll
            for (int m = 0; m < 4; ++m)
#pragma unroll
                for (int n = 0; n < 2; ++n) acc[a][b][m][n] = (f32x4){0.f, 0.f, 0.f, 0.f};
    bf16x8 At[4][2], B0[2][2], B1[2][2];
    const char* cA = (const char*)g.A + (size_t)cur.pm * tstepA + S.a_off(cur); const char* cB = (const char*)g.Bt + (size_t)S.b_tile(cur) * tstep;
    S.a_ready(cur);
    if constexpr (SP2) {
        PG8_STAGE(PG8_SB(0, 0), cB, voffB); PG8_STAGE(PG8_SB(0, 1), cB + hstep, voffB); PG8_STAGE(PG8_SA(0, 0), cA, voffA); PG8_STAGE(PG8_SA(0, 1), cA + hstepA, voffA);
        if (wr == 1) PG8_BAR;
        PG8_WAIT_V(2); PG8_BAR;
        PG8_STAGE(PG8_SB(1, 0), cB + kstep, voffB); PG8_STAGE(PG8_SA(1, 0), cA + kstep, voffA); PG8_STAGE(PG8_SB(1, 1), cB + hstep + kstep, voffB);
        PG8_WAIT_V(6); PG8_BAR;
    } else {
        PG8_STAGE(PG8_SB(0, 0), cB, voffB); PG8_STAGE(PG8_SA(0, 0), cA, voffA); PG8_STAGE(PG8_SB(0, 1), cB + hstep, voffB); PG8_STAGE(PG8_SA(0, 1), cA + hstepA, voffA);
        if (wr == 1) PG8_BAR;
        PG8_WAIT_V(4); PG8_BAR;
        PG8_STAGE(PG8_SB(1, 0), cB + kstep, voffB); PG8_STAGE(PG8_SA(1, 0), cA + kstep, voffA); PG8_STAGE(PG8_SB(1, 1), cB + hstep + kstep, voffB);
        PG8_WAIT_V(6); PG8_BAR;
    }
    for (;;) {
        const bool has_next = S.next(ui + 1, nxt);
        const char* nA = has_next ? (const char*)g.A + (size_t)nxt.pm * tstepA + S.a_off(nxt) : cA; const char* nB = has_next ? (const char*)g.Bt + (size_t)S.b_tile(nxt) * tstep : cB;
        for (int t = 0; t < nt; t += 2) {
            const bool last = (t == nt - 2);
            const char* a1 = cA + (size_t)(t + 1) * kstep;
            const char* a2 = last ? nA : cA + (size_t)(t + 2) * kstep; const char* b2 = last ? nB : cB + (size_t)(t + 2) * kstep;
            const char* a3 = a2 + kstep; const char* b3 = b2 + kstep;
            if (last && has_next) S.a_ready(nxt);
            if constexpr (SP2) {
            PG8_LDB(B0, 0, 0); PG8_LDB(B1, 0, 1); PG8_SCHED; PG8_LDA(At, 0, 0); PG8_STAGE(PG8_SA(1, 1), a1 + hstepA, voffA);
            PG8_WAIT_V(8); PG8_WAIT_L(0); PG8_BAR; PG8_MMA(0, 0, At, B0); PG8_MMA(0, 1, At, B1); PG8_BAR; PG8_SCHED;
            PG8_LDA(At, 0, 1); PG8_STAGE(PG8_SB(0, 0), b2, voffB); PG8_STAGE(PG8_SB(0, 1), b2 + hstep, voffB); PG8_STAGE(PG8_SA(0, 0), a2, voffA);
            PG8_WAIT_V(8); PG8_WAIT_L(0); PG8_BAR; PG8_MMA(1, 0, At, B0); PG8_MMA(1, 1, At, B1); PG8_BAR; PG8_SCHED;
            PG8_LDB(B0, 1, 0); PG8_LDB(B1, 1, 1); PG8_SCHED; PG8_LDA(At, 1, 0); PG8_STAGE(PG8_SA(0, 1), a2 + hstepA, voffA);
            PG8_WAIT_V(8); PG8_WAIT_L(0); PG8_BAR; PG8_MMA(0, 0, At, B0); PG8_MMA(0, 1, At, B1); PG8_BAR; PG8_SCHED;
            PG8_LDA(At, 1, 1); PG8_STAGE(PG8_SB(1, 0), b3, voffB); PG8_STAGE(PG8_SB(1, 1), b3 + hstep, voffB); PG8_STAGE(PG8_SA(1, 0), a3, voffA);
            PG8_WAIT_V(8); PG8_WAIT_L(0); PG8_BAR; PG8_MMA(1, 0, At, B0); PG8_MMA(1, 1, At, B1); PG8_BAR; PG8_SCHED;
            } else {
            PG8_LDB(B0, 0, 0); PG8_SCHED; PG8_LDA(At, 0, 0); PG8_STAGE(PG8_SA(1, 1), a1 + hstepA, voffA);
            PG8_WAIT_L(8); PG8_BAR; PG8_WAIT_L(0); PG8_MMA(0, 0, At, B0); PG8_BAR; PG8_SCHED;
            PG8_LDB(B1, 0, 1); PG8_STAGE(PG8_SB(0, 0), b2, voffB);
            PG8_BAR; PG8_WAIT_L(0); PG8_MMA(0, 1, At, B1); PG8_BAR;
            PG8_LDA(At, 0, 1); PG8_STAGE(PG8_SA(0, 0), a2, voffA);
            PG8_BAR; PG8_WAIT_L(0); PG8_MMA(1, 0, At, B0); PG8_BAR; PG8_SCHED;
            PG8_STAGE(PG8_SB(0, 1), b2 + hstep, voffB);
            PG8_WAIT_V(6); PG8_BAR; PG8_MMA(1, 1, At, B1); PG8_BAR;
            PG8_LDB(B0, 1, 0); PG8_SCHED; PG8_LDA(At, 1, 0); PG8_STAGE(PG8_SA(0, 1), a2 + hstepA, voffA);
            PG8_WAIT_L(8); PG8_BAR; PG8_WAIT_L(0); PG8_MMA(0, 0, At, B0); PG8_BAR; PG8_SCHED;
            PG8_LDB(B1, 1, 1); PG8_STAGE(PG8_SB(1, 0), b3, voffB);
            PG8_BAR; PG8_WAIT_L(0); PG8_MMA(0, 1, At, B1); PG8_BAR;
            PG8_LDA(At, 1, 1); PG8_STAGE(PG8_SA(1, 0), a3, voffA);
            PG8_BAR; PG8_WAIT_L(0); PG8_MMA(1, 0, At, B0); PG8_BAR; PG8_SCHED;
            PG8_STAGE(PG8_SB(1, 1), b3 + hstep, voffB);
            PG8_WAIT_V(6); PG8_BAR; PG8_MMA(1, 1, At, B1); PG8_BAR;
            }
        }
        if constexpr (ALIGN_EPI) { if (wr == 0) PG8_BAR; }
        if constexpr (!Epi::AFTER_DRAIN) { E(acc, cur, wr, wc, fr, fq); S.done(cur); }
        if (!has_next) break;
#pragma unroll
        for (int a = 0; a < 2; ++a)
#pragma unroll
            for (int b = 0; b < 2; ++b)
#pragma unroll
                for (int m = 0; m < 4; ++m)
#pragma unroll
                    for (int n = 0; n < 2; ++n) acc[a][b][m][n] = (f32x4){0.f, 0.f, 0.f, 0.f};
        cur = nxt; cA = nA; cB = nB; ++ui;
        if constexpr (ALIGN_EPI) { if (wr == 1) PG8_BAR; }
    }
    PG8_WAIT_V(0);
    if constexpr (!ALIGN_EPI) { if (wr == 0) PG8_BAR; }
    PG8_BAR;
    if constexpr (Epi::AFTER_DRAIN) { E.fused(acc, cur, wr, wc, fr, fq, lds, wid, lane); S.done(cur); }
#undef PG8_SA
#undef PG8_SB
#undef PG8_STAGE
#undef PG8_LDA
#undef PG8_LDB
#undef PG8_MMA
#undef PG8_WAIT_V
#undef PG8_WAIT_L
#undef PG8_BAR
#undef PG8_SCHED
}
}

constexpr int NWAVES = 8, NTHR = 512;
constexpr int M = 16384, SEQ = 8192, D = 1024, FF = 2816, NL = 4, NCH = 128  , NBC = 256  ;
constexpr int NPM = 6656;
constexpr int NWIN = 10752;
constexpr int C_DAQ = 0, C_DAK = 512, C_DAV = 1024, C_GQ = 1536, C_GK = 1792, C_GV = 2048, C_GOG = 2560, C_SZ = 3072, C_SX = 3584, C_SB = 4096, C_SC = 4352,
              C_RR = 4608, C_RK = 5120, C_RV = 5632, C_RWL = 6144, C_RAL = 6208, C_RGL = 6272, C_GLR = 6400, C_SDT = 6416;
constexpr float EPS = 1e-6f, LOG2E = 1.4426950408889634f;

constexpr size_t MiB = 1u << 20;
constexpr size_t WS_CTL = 0, CTL_ZERO_BYTES = 1 * MiB;
constexpr size_t WS_COS = 1 * MiB, WS_SIN = 2 * MiB, WS_SSQ = 3 * MiB, WS_GLAST = 3 * MiB + 512 * 1024, WS_SDT = 4 * MiB, WS_SACUM = 4 * MiB + 512 * 1024, WS_SCDEC = 5 * MiB;
constexpr size_t WS_WGU1 = 8 * MiB, WS_WD1 = 19 * MiB, WS_WIN = 24 * MiB + 512 * 1024, WS_WB = 45 * MiB + 512 * 1024, WS_WO = 49 * MiB + 512 * 1024, WS_WGU2 = 51 * MiB + 512 * 1024, WS_WD2 = 62 * MiB + 512 * 1024;
constexpr size_t WS_HB = 68 * MiB, WS_P = 100 * MiB, WS_PG = 100 * MiB, WS_YS = 308 * MiB, WS_R1 = 372 * MiB, WS_R2 = 500 * MiB, WS_END = 644 * MiB;
constexpr size_t WS_ACT = WS_R1, WS_MERGED = WS_R1;
constexpr size_t WS_RWW = WS_R1, WS_RWR = WS_R1 + 32 * MiB, WS_RWK = WS_R1 + 48 * MiB, WS_RWV = WS_R1 + 64 * MiB, WS_RWKK = WS_R1 + 80 * MiB, WS_RWB = WS_R1 + 96 * MiB, WS_RWG = WS_R1 + 112 * MiB;
constexpr size_t WS_VT = WS_R2, WS_GKV = WS_R2 + 16 * MiB, WS_SST = WS_R2 + 48 * MiB, WS_RWY = WS_R2 + 112 * MiB;
static_assert(WS_WD2 + (size_t)D * FF * 2 <= WS_HB && WS_P + (size_t)M * NPM * 2 <= WS_YS && WS_RWY + (size_t)M * 512 * 2 <= WS_END, "d_ws map");
constexpr int CW_BAR = 4096;

constexpr int RING_BYTES = 131072, LDSCTL_OFF = RING_BYTES, MISC_OFF = LDSCTL_OFF + 320, LDS_BYTES = 147456;

#define GAS __attribute__((address_space(1)))
#define LAS __attribute__((address_space(3)))
typedef unsigned short bf16;
typedef unsigned v4u __attribute__((ext_vector_type(4)));
typedef float f32x4 __attribute__((ext_vector_type(4)));
typedef short bf16x8 __attribute__((ext_vector_type(8)));
typedef GAS unsigned gu32;
typedef GAS unsigned long long gu64;
#define RLX_AGENT __ATOMIC_RELAXED, __HIP_MEMORY_SCOPE_AGENT
#define LDS_WAIT() asm volatile("s_waitcnt lgkmcnt(0)" ::: "memory")
#define VM_WAIT() asm volatile("s_waitcnt vmcnt(0)" ::: "memory")
__device__ __forceinline__ unsigned long long rt() { return __builtin_amdgcn_s_memrealtime(); }
__device__ __forceinline__ unsigned f2bf(float f) { unsigned u = __builtin_bit_cast(unsigned, f); return (u + 0x7fffu + ((u >> 16) & 1u)) >> 16; }
__device__ __forceinline__ unsigned pk2(float lo, float hi) { return f2bf(lo) | (f2bf(hi) << 16); }

#define XB_TMO      128
#define XB_XCNT(j)  (256  + 64 * (j))
#define XB_XSUB(j)  (1280 + 64 * (j))
#define XB_XGEN(j)  (2304 + 64 * (j))
#define XB_TOP      3328
#define XB_TOPGEN   3392
#define XCD_BAR_WORDS 3456
#define XB_SPIN_CAP (1u << 18)

__device__ __forceinline__ unsigned xb_ld(unsigned* p)              { return __hip_atomic_load(p, __ATOMIC_RELAXED, __HIP_MEMORY_SCOPE_AGENT); }
__device__ __forceinline__ unsigned xb_add(unsigned* p, unsigned v) { return __hip_atomic_fetch_add(p, v, __ATOMIC_RELAXED, __HIP_MEMORY_SCOPE_AGENT); }
__device__ __forceinline__ unsigned xb_xcc_id() { return (unsigned)__builtin_amdgcn_s_getreg((3 << 11) | 20) & 0xFu; }
#define XB_SPIN(cond, bar) do { unsigned _sp = 0; while (cond) { __builtin_amdgcn_s_sleep(1); \
    if ((++_sp & 255u) == 0u) { if (xb_ld(&(bar)[XB_TMO])) break; if (_sp > XB_SPIN_CAP) { atomicAdd(&(bar)[XB_TMO], 1u); break; } } } } while (0)

struct XcdBarrier {
    unsigned* bar; unsigned x;
    volatile LAS unsigned* st;
};

__device__ __forceinline__ XcdBarrier xcd_barrier_post(unsigned* bar, volatile LAS unsigned* st) {
    XcdBarrier b; b.bar = bar; b.x = xb_xcc_id(); b.st = st;
    if (threadIdx.x == 0) (void)xb_add(&bar[XB_XCNT(b.x)], 1u);
    return b;
}
__device__ __forceinline__ void xcd_barrier_complete(unsigned* bar, unsigned x, unsigned& nloc, unsigned& nx) {
    const unsigned G = gridDim.x * gridDim.y * gridDim.z;
    unsigned sum, cnt, mine, sp = 0u;
    for (;;) {
        sum = 0u; cnt = 0u; mine = 0u;
#pragma unroll
        for (unsigned j = 0; j < 16; ++j) { const unsigned c = xb_ld(&bar[XB_XCNT(j)]); sum += c; cnt += (c > 0u) ? 1u : 0u; mine = (j == x) ? c : mine; }
        if (sum == G) break;
        __builtin_amdgcn_s_sleep(1);
        if ((++sp & 255u) == 0u) { if (xb_ld(&bar[XB_TMO])) break; if (sp > XB_SPIN_CAP) { atomicAdd(&bar[XB_TMO], 1u); break; } }
    }
    nloc = mine > 0u ? mine : 1u; nx = cnt > 0u ? cnt : 1u;
}

__device__ __forceinline__ void xcd_barrier(const XcdBarrier& b) {
    asm volatile("s_waitcnt vmcnt(0)" ::: "memory");
    __syncthreads();
    if (threadIdx.x == 0) {
        unsigned* bar = b.bar;
        __builtin_amdgcn_s_waitcnt(0);
        unsigned nloc = b.st[0], nx = b.st[1];
        if (nloc == 0u) { xcd_barrier_complete(bar, b.x, nloc, nx); b.st[0] = nloc; b.st[1] = nx; }
        const unsigned old = xb_add(&bar[XB_XSUB(b.x)], 1u);
        const unsigned gen = old / nloc;
        if (old + 1u == (gen + 1u) * nloc) {
            __builtin_amdgcn_fence(__ATOMIC_RELEASE, "agent");
            asm volatile("s_waitcnt vmcnt(0)" ::: "memory");
            const unsigned og = xb_add(&bar[XB_TOP], 1u);
            const unsigned tg = og / nx;
            if (og + 1u == (tg + 1u) * nx) xb_add(&bar[XB_TOPGEN], 1u);
            else XB_SPIN(xb_ld(&bar[XB_TOPGEN]) == tg, bar);
            __builtin_amdgcn_fence(__ATOMIC_ACQUIRE, "agent");
            xb_add(&bar[XB_XGEN(b.x)], 1u);
            asm volatile("s_waitcnt vmcnt(0)" ::: "memory");
        } else {
            XB_SPIN(xb_ld(&bar[XB_XGEN(b.x)]) == gen, bar);
            __builtin_amdgcn_fence(__ATOMIC_ACQUIRE, "agent");
            asm volatile("s_waitcnt vmcnt(0)" ::: "memory");
        }
    }
    __syncthreads();
}

struct Args { const float* in[40]; float* out; unsigned char* ws; float inv_freq[32]; int g_lo, g_hi; };
typedef const __attribute__((address_space(4))) Args* ArgsP;
typedef LAS float* LF; typedef const LAS float* CLF;
#ifndef PH_FN
#define PH_FN __device__ __noinline__
#endif
#ifndef PH_HEAVY
#define PH_HEAVY __device__ __forceinline__
#endif
struct Ctx {
    LAS unsigned char* lds;
    unsigned char* ws; float* h;
    int tid, lane, wave, bid, G;
};
typedef unsigned u32x4 __attribute__((ext_vector_type(4)));
typedef unsigned u32x2 __attribute__((ext_vector_type(2)));
typedef float f32x2 __attribute__((ext_vector_type(2)));
typedef float f32x16 __attribute__((ext_vector_type(16)));
__device__ __forceinline__ float bf2f(bf16 x) { return __uint_as_float((unsigned)x << 16); }
__device__ __forceinline__ float bflo(unsigned w) { return __uint_as_float(w << 16); }
__device__ __forceinline__ float bfhi(unsigned w) { return __uint_as_float(w & 0xffff0000u); }
__device__ __forceinline__ void unpack8(const u32x4 w, float* o) { o[0] = bflo(w.x); o[1] = bfhi(w.x); o[2] = bflo(w.y); o[3] = bfhi(w.y); o[4] = bflo(w.z); o[5] = bfhi(w.z); o[6] = bflo(w.w); o[7] = bfhi(w.w); }
__device__ __forceinline__ u32x4 pack8(const float* o) { u32x4 w; w.x = pk2(o[0], o[1]); w.y = pk2(o[2], o[3]); w.z = pk2(o[4], o[5]); w.w = pk2(o[6], o[7]); return w; }
__device__ __forceinline__ float sigmoidf_(float x) { return 1.0f / (1.0f + __expf(-x)); }
__device__ __forceinline__ float siluf_(float x) { return x * sigmoidf_(x); }
__device__ __forceinline__ float softplusf_(float x) { return fmaxf(x, 0.f) + log1pf(__expf(-fabsf(x))); }
__device__ __forceinline__ float logsigmoidf_(float x) { return fminf(x, 0.f) - log1pf(__expf(-fabsf(x))); }
__device__ __forceinline__ float wave_sum(float v) {
#pragma unroll
    for (int o = 1; o < 64; o <<= 1) v += __shfl_xor(v, o);
    return v;
}
#define WG_SYNC() __syncthreads()
__device__ __forceinline__ Ctx fresh(const Ctx& C0) { Ctx C = C0; int t = threadIdx.x; asm volatile("" : "+v"(t)); C.tid = t; C.lane = t & 63; C.wave = __builtin_amdgcn_readfirstlane(t >> 6); return C; }

PH_FN void ph_prologue(const Ctx C, ArgsP a) {
    float* cosT = (float*)(C.ws + WS_COS); float* sinT = (float*)(C.ws + WS_SIN);
    for (int idx = C.bid * NTHR + C.tid; idx < SEQ * 32; idx += C.G * NTHR) {
        const int t = idx >> 5, j = idx & 31;
        const float ang = (float)t * a->inv_freq[j];
        const double rev = (double)ang * 0.15915494309189535;
        const float fr = (float)(rev - floor(rev));
        cosT[idx] = __builtin_amdgcn_cosf(fr); sinT[idx] = __builtin_amdgcn_sinf(fr);
    }
    const float* x = a->in[0]; bf16* hb = (bf16*)(C.ws + WS_HB); float* ssq = (float*)(C.ws + WS_SSQ);
    const int gw = C.bid * NWAVES + C.wave, NGW = C.G * NWAVES;
    for (int m = gw; m < M; m += NGW) {
        const f32x4* xr = (const f32x4*)(x + (size_t)m * D) + C.lane; f32x4* hr = (f32x4*)(C.h + (size_t)m * D) + C.lane;
        unsigned long long* o8 = (unsigned long long*)(hb + (size_t)m * D) + C.lane;
        float s = 0.f;
#pragma unroll
        for (int j = 0; j < 4; ++j) { const f32x4 v = xr[64 * j]; hr[64 * j] = v; s += (v.x * v.x + v.y * v.y) + (v.z * v.z + v.w * v.w);
            o8[64 * j] = (unsigned long long)pk2(v.x, v.y) | ((unsigned long long)pk2(v.z, v.w) << 32); }
        s = wave_sum(s);
        if (C.lane == 0) { ssq[m] = s; ssq[M + m] = 0.f; ssq[2 * M + m] = 0.f; ssq[3 * M + m] = 0.f; }
    }
}

template <class SrcF>
__device__ __forceinline__ void tr_item(const SrcF src, const float* gk, bf16* WT, int K, int kb, int nb, LF scr, int lane) {
    const int k0 = 64 * kb, n0 = 32 * nb;
    const int ld = src.ld(); const long co = src.col(n0 + (lane & 31)); const bool ok = co >= 0; const float* colp = src.base(n0 + (lane & 31)) + (ok ? co : 0);
#pragma unroll 8
    for (int i = 0; i < 32; ++i) { const int kk = 2 * i + (lane >> 5); float v = 0.f; if (ok) { v = colp[(size_t)(k0 + kk) * ld]; if (gk) v *= gk[k0 + kk]; } scr[kk * 33 + (lane & 31)] = v; }
    LDS_WAIT(); asm volatile("" ::: "memory");
    const int c = lane & 7;
#pragma unroll
    for (int j = 0; j < 4; ++j) { const int n = (lane >> 3) + 8 * j; CLF s = scr + (8 * c) * 33 + n;
        v4u o; o.x = pk2(s[0 * 33], s[1 * 33]); o.y = pk2(s[2 * 33], s[3 * 33]); o.z = pk2(s[4 * 33], s[5 * 33]); o.w = pk2(s[6 * 33], s[7 * 33]);
        *(v4u*)(WT + (size_t)(n0 + n) * K + k0 + 8 * c) = o; }
    LDS_WAIT(); asm volatile("" ::: "memory");
}
struct SrcGU { const float* wg; const float* wu;
    __device__ __forceinline__ int ld() const { return FF; }
    __device__ __forceinline__ const float* base(int n) const { const uintptr_t sel = (uintptr_t)((n >> 7) & 1); return (const float*)((uintptr_t)wg + sel * ((uintptr_t)wu - (uintptr_t)wg)); }
    __device__ __forceinline__ long col(int n) const { return 128 * (n >> 8) + (n & 127); } };
struct SrcPlain { const float* w; int ldw;
    __device__ __forceinline__ int ld() const { return ldw; }
    __device__ __forceinline__ const float* base(int) const { return w; }
    __device__ __forceinline__ long col(int n) const { return n; } };
struct SrcWin { const float* w;
    __device__ __forceinline__ int ld() const { return 10520; }
    __device__ __forceinline__ const float* base(int) const { return w; }
    __device__ __forceinline__ long col(int n) const {
        int c;
        if (n < 3072) c = n; else if (n < 4608) c = n - 3072 + 3088; else if (n < 6400) c = n - 4608 + 4632; else if (n < 6416) c = n - 6400 + 3072; else if (n < 6424) c = n - 6416 + 4624; else if (n < 6656) c = -1; else c = n - 6656 + 6424;
        return c; } };
PH_FN void ph_weights(const Ctx C, ArgsP a, int l) {
    LF scr = (LF)(C.lds + C.wave * 16384);
    const int gw = C.bid * NWAVES + C.wave, NGW = C.G * NWAVES;
#pragma unroll 1
    for (int f = 0; f < 2; ++f) {
        const float* nrm = a->in[f ? 35 : 1] + (size_t)l * D; const float* wg = a->in[f ? 36 : 2] + (size_t)l * D * FF; const float* wu = a->in[f ? 37 : 3] + (size_t)l * D * FF; const float* wd = a->in[f ? 38 : 4] + (size_t)l * FF * D;
        bf16* Wgu = (bf16*)(C.ws + (f ? WS_WGU2 : WS_WGU1)); bf16* Wd = (bf16*)(C.ws + (f ? WS_WD2 : WS_WD1));
        const SrcGU sgu{wg, wu};
        for (int it = gw; it < (D / 64) * (2 * FF / 32); it += NGW) tr_item(sgu, nrm, Wgu, D, it / (2 * FF / 32), it % (2 * FF / 32), scr, C.lane);
        const SrcPlain sd{wd, D};
        for (int it = gw; it < (FF / 64) * (D / 32); it += NGW) tr_item(sd, nullptr, Wd, FF, it / (D / 32), it % (D / 32), scr, C.lane);
    }
    { const SrcWin sw{a->in[6] + (size_t)l * D * 10520}; const float* nrm = a->in[5] + (size_t)l * D; bf16* Win = (bf16*)(C.ws + WS_WIN);
      for (int it = gw; it < (D / 64) * (NWIN / 32); it += NGW) tr_item(sw, nrm, Win, D, it / (NWIN / 32), it % (NWIN / 32), scr, C.lane); }
    { bf16* Wb = (bf16*)(C.ws + WS_WB);
      for (int it = gw; it < 4 * (512 / 64) * (D / 32); it += NGW) { const int z = it / ((512 / 64) * (D / 32)), r = it % ((512 / 64) * (D / 32));
          const SrcPlain sb{a->in[32] + ((size_t)l * 4 + z) * 512 * D, D}; tr_item(sb, nullptr, Wb + (size_t)z * D * 512, 512, r / (D / 32), r % (D / 32), scr, C.lane); } }
    { const SrcPlain so{a->in[34] + (size_t)l * D * D, D}; bf16* Wo = (bf16*)(C.ws + WS_WO);
      for (int it = gw; it < (D / 64) * (D / 32); it += NGW) tr_item(so, nullptr, Wo, D, it / (D / 32), it % (D / 32), scr, C.lane); }
}

PH_FN void ph_da_prep(const Ctx C) {
    bf16* P = (bf16*)(C.ws + WS_P); const float* cosT = (const float*)(C.ws + WS_COS); const float* sinT = (const float*)(C.ws + WS_SIN);
    const int gw = C.bid * NWAVES + C.wave, NGW = C.G * NWAVES;
    const int hc = C.lane >> 2, ch = C.lane & 3;
    const float sc = (hc < 8) ? 0.125f * LOG2E : 1.0f;
    for (int m = gw; m < M; m += NGW) {
        const int t = m & (SEQ - 1);
        bf16* p1 = P + (size_t)m * NPM + hc * 64 + ch * 8; bf16* p2 = p1 + 32;
        float x1[8], x2[8], o1[8], o2[8];
        unpack8(*(const u32x4*)p1, x1); unpack8(*(const u32x4*)p2, x2);
        const float* cp = cosT + t * 32 + ch * 8; const float* sp = sinT + t * 32 + ch * 8;
#pragma unroll
        for (int i = 0; i < 8; ++i) { const float c = cp[i], s = sp[i]; o1[i] = (x1[i] * c - x2[i] * s) * sc; o2[i] = (x2[i] * c + x1[i] * s) * sc; }
        *(u32x4*)p1 = pack8(o1); *(u32x4*)p2 = pack8(o2);
    }
    bf16* VT = (bf16*)(C.ws + WS_VT); LAS bf16* tile = (LAS bf16*)C.lds;
    for (int it = C.bid; it < 2 * NCH * 4; it += C.G) {
        const int h = it & 3, bc = it >> 2, b = bc >> 7, tb = bc & 127; const size_t row0 = (size_t)bc * 64;
        WG_SYNC();
#pragma unroll
        for (int i = 0; i < 2; ++i) { const int q = C.tid + NTHR * i, t = q >> 4, c16 = q & 15;
            *(LAS u32x4*)(tile + t * 136 + c16 * 8) = *(const u32x4*)(P + (row0 + t) * NPM + C_DAV + h * 128 + c16 * 8); }
        WG_SYNC();
#pragma unroll
        for (int i = 0; i < 2; ++i) { const int q = C.tid + NTHR * i, d = q >> 3, tc = q & 7; unsigned w[4];
#pragma unroll
            for (int e = 0; e < 4; ++e) w[e] = (unsigned)tile[(8 * tc + 2 * e) * 136 + d] | ((unsigned)tile[(8 * tc + 2 * e + 1) * 136 + d] << 16);
            u32x4 o; o.x = w[0]; o.y = w[1]; o.z = w[2]; o.w = w[3];
            *(u32x4*)(VT + ((size_t)(b * 4 + h) * 128 + d) * SEQ + tb * 64 + 8 * tc) = o; }
    }
    WG_SYNC();
}

typedef LAS bf16* LB; typedef const LAS bf16* CLB;
__device__ __forceinline__ pg8::bf16x8 frag32(CLB X, int ld, int row0, int k0, int lane) { return *(const LAS pg8::bf16x8*)(X + (row0 + (lane & 31)) * ld + k0 + 8 * (lane >> 5)); }
template <int K> __device__ __forceinline__ void mma_nt(f32x16& acc, CLB A, int lda, int m0, CLB Bt, int ldb, int n0, int lane) {
#pragma unroll
    for (int k = 0; k < K; k += 16) acc = __builtin_amdgcn_mfma_f32_32x32x16_bf16(frag32(A, lda, m0, k, lane), frag32(Bt, ldb, n0, k, lane), acc, 0, 0, 0);
}
__device__ __forceinline__ int crow(int r, int hi) { return (r & 3) + 8 * (r >> 2) + 4 * hi; }
__device__ __forceinline__ f32x16 zero16() { f32x16 z;
#pragma unroll
    for (int r = 0; r < 16; ++r) z[r] = 0.f;
    return z; }

__device__ __forceinline__ void gla_compute_G(const Ctx& C, ArgsP a, int l, int bc, int h, LF Gs) {
    const bf16* P = (const bf16*)(C.ws + WS_P); const float* W2 = a->in[12] + (size_t)l * 16 * 256; const float* gb = a->in[13] + (size_t)l * 256;
    const int t = C.tid >> 3, kg = C.tid & 7; const size_t row = (size_t)bc * 64 + t;
    float glr[16]; unpack8(*(const u32x4*)(P + row * NPM + C_GLR), glr); unpack8(*(const u32x4*)(P + row * NPM + C_GLR + 8), glr + 8);
#pragma unroll
    for (int i = 0; i < 8; ++i) { const int k = h * 64 + kg * 8 + i; float x = gb[k];
#pragma unroll
        for (int r = 0; r < 16; ++r) x += glr[r] * W2[r * 256 + k];
        Gs[t * 68 + kg * 8 + i] = logsigmoidf_(x) * (1.0f / 16.0f); }
    WG_SYNC();
    if (C.tid < 64) { float run = 0.f; for (int tt = 0; tt < 64; ++tt) { run += Gs[tt * 68 + C.tid]; Gs[tt * 68 + C.tid] = run; } }
    WG_SYNC();
}
PH_HEAVY void ph_gla_a(const Ctx C, ArgsP a, int l) {
    const bf16* P = (const bf16*)(C.ws + WS_P); float* GKV = (float*)(C.ws + WS_GKV); float* GL = (float*)(C.ws + WS_GLAST);
    LF Gs = (LF)C.lds; LB KDT = (LB)(C.lds + 17408); LB VT = (LB)(C.lds + 26624);
    for (int it = C.bid; it < NBC * 4; it += C.G) {
        const int bc = it >> 2, h = it & 3;
        WG_SYNC();
        gla_compute_G(C, a, l, bc, h, Gs);
        { const int t = C.tid >> 3, g8 = C.tid & 7; const size_t row = (size_t)bc * 64 + t;
          float kf[8]; unpack8(*(const u32x4*)(P + row * NPM + C_GK + h * 64 + g8 * 8), kf);
#pragma unroll
          for (int i = 0; i < 8; ++i) { const int k = g8 * 8 + i; KDT[k * 72 + t] = (bf16)f2bf(kf[i] * __expf(Gs[63 * 68 + k] - Gs[t * 68 + k])); }
          const u32x4 v0 = *(const u32x4*)(P + row * NPM + C_GV + h * 128 + g8 * 16), v1 = *(const u32x4*)(P + row * NPM + C_GV + h * 128 + g8 * 16 + 8);
          const unsigned vw[8] = {v0.x, v0.y, v0.z, v0.w, v1.x, v1.y, v1.z, v1.w};
#pragma unroll
          for (int i = 0; i < 8; ++i) { VT[(g8 * 16 + 2 * i) * 72 + t] = (bf16)(vw[i] & 0xffffu); VT[(g8 * 16 + 2 * i + 1) * 72 + t] = (bf16)(vw[i] >> 16); }
          if (C.tid < 64) GL[(size_t)it * 64 + C.tid] = Gs[63 * 68 + C.tid]; }
        WG_SYNC();
        { const int kt = C.wave >> 2, vt = C.wave & 3, n = C.lane & 31, hi = C.lane >> 5;
          f32x16 acc = zero16(); mma_nt<64>(acc, KDT, 72, 32 * kt, VT, 72, 32 * vt, C.lane);
          float* dst = GKV + ((size_t)it * 128 + 32 * vt + n) * 64 + 32 * kt + 4 * hi;
#pragma unroll
          for (int g = 0; g < 4; ++g) *(f32x4*)(dst + 8 * g) = (f32x4){acc[4 * g], acc[4 * g + 1], acc[4 * g + 2], acc[4 * g + 3]}; }
    }
    WG_SYNC();
}
PH_FN void gla_scan_part(const Ctx C, int part) {
    float* GKV = (float*)(C.ws + WS_GKV); const float* GL = (const float*)(C.ws + WS_GLAST);
    const int e = part * NTHR + C.tid, chain = e >> 13, idx = e & 8191, b = chain >> 2, h = chain & 3, k = idx & 63;
    float st = 0.f;
#pragma unroll 1
    for (int c0 = 0; c0 < NCH; c0 += 16) {
        float tmp[16], dec[16];
#pragma unroll
        for (int i = 0; i < 16; ++i) { const size_t item = (size_t)(b * NCH + c0 + i) * 4 + h; tmp[i] = GKV[item * 8192 + idx]; dec[i] = GL[item * 64 + k]; }
#pragma unroll
        for (int i = 0; i < 16; ++i) { const size_t item = (size_t)(b * NCH + c0 + i) * 4 + h; GKV[item * 8192 + idx] = st; st = __expf(dec[i]) * st + tmp[i]; }
    }
}
PH_HEAVY void ph_gla_c(const Ctx C, ArgsP a, int l) {
    const bf16* P = (const bf16*)(C.ws + WS_P); const float* GKV = (const float*)(C.ws + WS_GKV); bf16* YS = (bf16*)(C.ws + WS_YS);
    const float* gnorm = a->in[14] + (size_t)l * 128;
    LF Gs = (LF)C.lds; LB QD = (LB)(C.lds + 17408); LB KDR = (LB)(C.lds + 26624); LB QI = (LB)(C.lds + 35840); LB ATT = (LB)(C.lds + 45056); LB VT = (LB)(C.lds + 54272); LB ST = (LB)(C.lds + 72704); LF PS = (LF)(C.lds + 91136);
    for (int it = C.bid; it < NBC * 4; it += C.G) {
        const int bc = it >> 2, h = it & 3;
        WG_SYNC();
        gla_compute_G(C, a, l, bc, h, Gs);
        { const int t = C.tid >> 3, g8 = C.tid & 7; const size_t row = (size_t)bc * 64 + t;
          float qf[8], kf[8], o1[8], o2[8], o3[8];
          unpack8(*(const u32x4*)(P + row * NPM + C_GQ + h * 64 + g8 * 8), qf); unpack8(*(const u32x4*)(P + row * NPM + C_GK + h * 64 + g8 * 8), kf);
#pragma unroll
          for (int i = 0; i < 8; ++i) { const int k = g8 * 8 + i; const float g = Gs[t * 68 + k], d = g - Gs[32 * 68 + k]; o1[i] = qf[i] * 0.125f * __expf(d); o2[i] = kf[i] * __expf(-d); o3[i] = qf[i] * 0.125f * __expf(g); }
          *(LAS u32x4*)(QD + t * 72 + g8 * 8) = pack8(o1); *(LAS u32x4*)(KDR + t * 72 + g8 * 8) = pack8(o2); *(LAS u32x4*)(QI + t * 72 + g8 * 8) = pack8(o3);
          const u32x4 v0 = *(const u32x4*)(P + row * NPM + C_GV + h * 128 + g8 * 16), v1 = *(const u32x4*)(P + row * NPM + C_GV + h * 128 + g8 * 16 + 8);
          const unsigned vw[8] = {v0.x, v0.y, v0.z, v0.w, v1.x, v1.y, v1.z, v1.w};
#pragma unroll
          for (int i = 0; i < 8; ++i) { VT[(g8 * 16 + 2 * i) * 72 + t] = (bf16)(vw[i] & 0xffffu); VT[(g8 * 16 + 2 * i + 1) * 72 + t] = (bf16)(vw[i] >> 16); }
          const int v = C.tid >> 2, kq = (C.tid & 3) * 16; const float* sp = GKV + ((size_t)it * 128 + v) * 64 + kq;
          float s[16];
#pragma unroll
          for (int i = 0; i < 4; ++i) { const f32x4 x = *(const f32x4*)(sp + 4 * i); s[4 * i] = x[0]; s[4 * i + 1] = x[1]; s[4 * i + 2] = x[2]; s[4 * i + 3] = x[3]; }
          *(LAS u32x4*)(ST + v * 72 + kq) = pack8(s); *(LAS u32x4*)(ST + v * 72 + kq + 8) = pack8(s + 8); }
        WG_SYNC();
        const int n = C.lane & 31, hi = C.lane >> 5;
        if (C.wave < 4) {
            const int it_ = C.wave >> 1, jt = C.wave & 1;
            f32x16 acc = zero16();
            if (jt <= it_) mma_nt<64>(acc, QD, 72, 32 * it_, KDR, 72, 32 * jt, C.lane);
#pragma unroll
            for (int r = 0; r < 16; ++r) { const int i = 32 * it_ + crow(r, hi), j = 32 * jt + n; ATT[i * 72 + j] = (bf16)f2bf(j <= i ? acc[r] : 0.f); }
        }
        WG_SYNC();
        {
            const int it_ = C.wave & 1, vt = C.wave >> 1;
            f32x16 acc = zero16();
            mma_nt<64>(acc, VT, 72, 32 * vt, ATT, 72, 32 * it_, C.lane);
            mma_nt<64>(acc, ST, 72, 32 * vt, QI, 72, 32 * it_, C.lane);
            float ss = 0.f;
#pragma unroll
            for (int r = 0; r < 16; ++r) ss += acc[r] * acc[r];
            ss += __shfl_xor(ss, 32);
            if (hi == 0) PS[(32 * it_ + n) * 4 + vt] = ss;
            WG_SYNC();
            const int i = 32 * it_ + n; const float tot = (PS[i * 4] + PS[i * 4 + 1]) + (PS[i * 4 + 2] + PS[i * 4 + 3]);
            const float rs = 1.0f / sqrtf(tot * (1.0f / 128.0f) + EPS); const size_t row = (size_t)bc * 64 + i;
#pragma unroll
            for (int g = 0; g < 4; ++g) { const int v0 = 32 * vt + 8 * g + 4 * hi;
                const u32x2 ogw = *(const u32x2*)(P + row * NPM + C_GOG + h * 128 + v0); const f32x4 gn = *(const f32x4*)(gnorm + v0);
                const float og[4] = {bflo(ogw.x), bfhi(ogw.x), bflo(ogw.y), bfhi(ogw.y)}; float o4[4];
#pragma unroll
                for (int y = 0; y < 4; ++y) o4[y] = acc[4 * g + y] * rs * gn[y] * siluf_(og[y]);
                u32x2 w; w.x = pk2(o4[0], o4[1]); w.y = pk2(o4[2], o4[3]); *(u32x2*)(YS + row * 2048 + 512 + h * 128 + v0) = w; }
        }
    }
    WG_SYNC();
}

__device__ __forceinline__ void ssd_conv8(const bf16* P, const float* cw, const float* cb, int bc, int t, int ch0, float* o) {
    const int pos = (bc & 127) * 64 + t; const size_t row = (size_t)bc * 64 + t;
#pragma unroll
    for (int i = 0; i < 8; ++i) o[i] = cb[ch0 + i];
#pragma unroll
    for (int tap = 0; tap < 4; ++tap) { if (pos - 3 + tap >= 0) { float x[8]; unpack8(*(const u32x4*)(P + (row - 3 + tap) * NPM + C_SX + ch0), x);
#pragma unroll
        for (int i = 0; i < 8; ++i) o[i] += cw[tap * 1024 + ch0 + i] * x[i]; } }
#pragma unroll
    for (int i = 0; i < 8; ++i) o[i] = siluf_(o[i]);
}
PH_HEAVY void ph_ssd_a(const Ctx C, ArgsP a, int l) {
    const bf16* P = (const bf16*)(C.ws + WS_P); float* SST = (float*)(C.ws + WS_SST); float* SDT = (float*)(C.ws + WS_SDT); float* SAC = (float*)(C.ws + WS_SACUM); float* SCD = (float*)(C.ws + WS_SCDEC);
    const float* cw = a->in[15] + (size_t)l * 4 * 1024; const float* cb = a->in[16] + (size_t)l * 1024; const float* dtb = a->in[17] + (size_t)l * 8; const float* alog = a->in[18] + (size_t)l * 8;
    LB BT = (LB)C.lds; LB XDT = (LB)(C.lds + 18432); LF dtv = (LF)(C.lds + 27648); LF acu = (LF)(C.lds + 27904); LF av = (LF)(C.lds + 28160);
    for (int it = C.bid; it < NBC * 2; it += C.G) {
        const int bc = it >> 1, g = it & 1; const int t = C.tid >> 3, cg = C.tid & 7;
        WG_SYNC();
        { float o[8];
#pragma unroll
          for (int half = 0; half < 2; ++half) { ssd_conv8(P, cw, cb, bc, t, 512 + g * 128 + cg * 16 + half * 8, o);
#pragma unroll
              for (int i = 0; i < 8; ++i) BT[(cg * 16 + half * 8 + i) * 72 + t] = (bf16)f2bf(o[i]); } }
#pragma unroll 1
        for (int hh = 0; hh < 4; ++hh) {
            const int hd = 4 * g + hh; const size_t item8 = (size_t)bc * 8 + hd;
            WG_SYNC();
            if (C.tid < 64) { const size_t row = (size_t)bc * 64 + C.tid; const float dt = softplusf_(bf2f(P[row * NPM + C_SDT + hd]) + dtb[hd]); dtv[C.tid] = dt; av[C.tid] = -__expf(alog[hd]) * dt; }
            WG_SYNC();
            if (C.tid < 64) { float s = 0.f; for (int j = 0; j <= C.tid; ++j) s += av[j]; acu[C.tid] = s; const size_t row = (size_t)bc * 64 + C.tid; SDT[row * 8 + hd] = dtv[C.tid]; SAC[row * 8 + hd] = s; if (C.tid == 63) SCD[item8] = __expf(s); }
            WG_SYNC();
            { float o[8]; ssd_conv8(P, cw, cb, bc, t, hd * 64 + cg * 8, o); const float sc = dtv[t] * __expf(acu[63] - acu[t]);
#pragma unroll
              for (int i = 0; i < 8; ++i) XDT[(cg * 8 + i) * 72 + t] = (bf16)f2bf(o[i] * sc); }
            WG_SYNC();
            { const int pt = C.wave >> 2, nt = C.wave & 3, n = C.lane & 31, hi = C.lane >> 5;
              f32x16 acc = zero16(); mma_nt<64>(acc, XDT, 72, 32 * pt, BT, 72, 32 * nt, C.lane);
#pragma unroll
              for (int r = 0; r < 16; ++r) SST[(item8 * 64 + 32 * pt + crow(r, hi)) * 128 + 32 * nt + n] = acc[r]; }
        }
    }
    WG_SYNC();
}
PH_FN void ssd_scan_part(const Ctx C, int part) {
    float* SST = (float*)(C.ws + WS_SST); const float* SCD = (const float*)(C.ws + WS_SCDEC);
    const int e = part * NTHR + C.tid, chain = e >> 13, idx = e & 8191, b = chain >> 3, hd = chain & 7;
    float st = 0.f;
#pragma unroll 1
    for (int c0 = 0; c0 < NCH; c0 += 16) {
        float tmp[16], dec[16];
#pragma unroll
        for (int i = 0; i < 16; ++i) { const size_t item = (size_t)(b * NCH + c0 + i) * 8 + hd; tmp[i] = SST[item * 8192 + idx]; dec[i] = SCD[item]; }
#pragma unroll
        for (int i = 0; i < 16; ++i) { const size_t item = (size_t)(b * NCH + c0 + i) * 8 + hd; SST[item * 8192 + idx] = st; st = dec[i] * st + tmp[i]; }
    }
}
PH_HEAVY void ph_ssd_c(const Ctx C, ArgsP a, int l) {
    const bf16* P = (const bf16*)(C.ws + WS_P); const float* SST = (const float*)(C.ws + WS_SST); const float* SDT = (const float*)(C.ws + WS_SDT); const float* SAC = (const float*)(C.ws + WS_SACUM); bf16* YS = (bf16*)(C.ws + WS_YS);
    const float* cw = a->in[15] + (size_t)l * 4 * 1024; const float* cb = a->in[16] + (size_t)l * 1024; const float* dpar = a->in[19] + (size_t)l * 8; const float* snorm = a->in[20] + (size_t)l * 512;
    LB BN = (LB)C.lds; LB CN = (LB)(C.lds + 17408); LF CB = (LF)(C.lds + 34816); LB SC = (LB)(C.lds + 52224); LB XST = (LB)(C.lds + 61440); LB HP = (LB)(C.lds + 70656); LB CE = (LB)(C.lds + 88064);
    LF dtv = (LF)(C.lds + 105472); LF acu = (LF)(C.lds + 105728); LF PSQ = (LF)(C.lds + 105984);
    for (int it = C.bid; it < NBC * 2; it += C.G) {
        const int bc = it >> 1, g = it & 1;
        const int t = C.tid >> 3, cg = C.tid & 7, n = C.lane & 31, hi = C.lane >> 5;
        WG_SYNC();
        { float o[8];
#pragma unroll
          for (int half = 0; half < 2; ++half) {
              ssd_conv8(P, cw, cb, bc, t, 512 + g * 128 + cg * 16 + half * 8, o); *(LAS u32x4*)(BN + t * 136 + cg * 16 + half * 8) = pack8(o);
              ssd_conv8(P, cw, cb, bc, t, 768 + g * 128 + cg * 16 + half * 8, o); *(LAS u32x4*)(CN + t * 136 + cg * 16 + half * 8) = pack8(o); } }
        WG_SYNC();
        if (C.wave < 4) {
            const int it_ = C.wave >> 1, jt = C.wave & 1;
            f32x16 acc = zero16(); mma_nt<128>(acc, CN, 136, 32 * it_, BN, 136, 32 * jt, C.lane);
#pragma unroll
            for (int r = 0; r < 16; ++r) CB[(32 * it_ + crow(r, hi)) * 68 + 32 * jt + n] = acc[r];
        }
        float yk[4][16]; float ssq = 0.f;
        const int pt = (C.wave >> 1) & 1, it2 = C.wave & 1;
#pragma unroll
        for (int hh = 0; hh < 4; ++hh) {
            const int hd = 4 * g + hh; const size_t item8 = (size_t)bc * 8 + hd;
            WG_SYNC();
            if (C.tid < 64) { const size_t row = (size_t)bc * 64 + C.tid; dtv[C.tid] = SDT[row * 8 + hd]; acu[C.tid] = SAC[row * 8 + hd]; }
            { float o[8]; ssd_conv8(P, cw, cb, bc, t, hd * 64 + cg * 8, o);
#pragma unroll
              for (int i = 0; i < 8; ++i) XST[(cg * 8 + i) * 72 + t] = (bf16)f2bf(o[i]);
              const int p = C.tid >> 3, n0 = (C.tid & 7) * 16; const float* sp = SST + (item8 * 64 + p) * 128 + n0; float s[16];
#pragma unroll
              for (int i = 0; i < 4; ++i) { const f32x4 x = *(const f32x4*)(sp + 4 * i); s[4 * i] = x[0]; s[4 * i + 1] = x[1]; s[4 * i + 2] = x[2]; s[4 * i + 3] = x[3]; }
              *(LAS u32x4*)(HP + p * 136 + n0) = pack8(s); *(LAS u32x4*)(HP + p * 136 + n0 + 8) = pack8(s + 8); }
            WG_SYNC();
            { const float ai = acu[t]; float o[8];
#pragma unroll
              for (int jj = 0; jj < 8; ++jj) { const int j = 8 * cg + jj; o[jj] = (j <= t) ? CB[t * 68 + j] * __expf(ai - acu[j]) * dtv[j] : 0.f; }
              *(LAS u32x4*)(SC + t * 72 + 8 * cg) = pack8(o);
              const float ea = __expf(ai); float c8[8];
#pragma unroll
              for (int half = 0; half < 2; ++half) { unpack8(*(const LAS u32x4*)(CN + t * 136 + cg * 16 + half * 8), c8);
#pragma unroll
                  for (int i = 0; i < 8; ++i) c8[i] *= ea;
                  *(LAS u32x4*)(CE + t * 136 + cg * 16 + half * 8) = pack8(c8); } }
            WG_SYNC();
            if (C.wave < 4) {
                f32x16 acc = zero16();
                mma_nt<64>(acc, XST, 72, 32 * pt, SC, 72, 32 * it2, C.lane);
                mma_nt<128>(acc, HP, 136, 32 * pt, CE, 136, 32 * it2, C.lane);
                const int i = 32 * it2 + n; const size_t row = (size_t)bc * 64 + i; const float dh = dpar[hd];
#pragma unroll
                for (int q4 = 0; q4 < 4; ++q4) { const int p0 = 32 * pt + 8 * q4 + 4 * hi;
                    const u32x2 zw = *(const u32x2*)(P + row * NPM + C_SZ + hd * 64 + p0); const float zf[4] = {bflo(zw.x), bfhi(zw.x), bflo(zw.y), bfhi(zw.y)};
#pragma unroll
                    for (int e = 0; e < 4; ++e) { const float xs = bf2f(XST[(p0 + e) * 72 + i]); const float v = (acc[4 * q4 + e] + dh * xs) * siluf_(zf[e]); yk[hh][4 * q4 + e] = v; ssq += v * v; } }
            }
        }
        if (C.wave < 4) { ssq += __shfl_xor(ssq, 32); if (hi == 0) PSQ[(32 * it2 + n) * 2 + pt] = ssq; }
        WG_SYNC();
        if (C.wave < 4) {
            const int i = 32 * it2 + n; const float rs = 1.0f / sqrtf((PSQ[i * 2] + PSQ[i * 2 + 1]) * (1.0f / 256.0f) + EPS); const size_t row = (size_t)bc * 64 + i;
#pragma unroll
            for (int hh = 0; hh < 4; ++hh)
#pragma unroll
                for (int q4 = 0; q4 < 4; ++q4) { const int ch = g * 256 + hh * 64 + 32 * pt + 8 * q4 + 4 * hi; const f32x4 sn = *(const f32x4*)(snorm + ch);
                    u32x2 w; w.x = pk2(yk[hh][4 * q4] * rs * sn[0], yk[hh][4 * q4 + 1] * rs * sn[1]); w.y = pk2(yk[hh][4 * q4 + 2] * rs * sn[2], yk[hh][4 * q4 + 3] * rs * sn[3]);
                    *(u32x2*)(YS + row * 2048 + 1024 + ch) = w; }
        }
    }
    WG_SYNC();
}

#ifndef RW_CHUNKED
#define RW_CHUNKED 1
#endif
__device__ __forceinline__ void rw_lerp8(const bf16* P, const float* mu, int bc, int t, int c0, float* o) {
    const size_t row = (size_t)bc * 64 + t; const bool first = ((bc & 127) == 0) && (t == 0);
    float x[8], xp[8]; unpack8(*(const u32x4*)(P + row * NPM + C_RR + c0), x);
    if (!first) unpack8(*(const u32x4*)(P + (row - 1) * NPM + C_RR + c0), xp); else {
#pragma unroll
        for (int i = 0; i < 8; ++i) xp[i] = 0.f; }
#pragma unroll
    for (int i = 0; i < 8; ++i) o[i] = x[i] + (xp[i] - x[i]) * mu[c0 + i];
}
PH_HEAVY void ph_rw_prep(const Ctx C, ArgsP a, int l) {
    const bf16* P = (const bf16*)(C.ws + WS_P);
    float* RWW = (float*)(C.ws + WS_RWW); bf16* RWR = (bf16*)(C.ws + WS_RWR); bf16* RWK = (bf16*)(C.ws + WS_RWK); bf16* RWV = (bf16*)(C.ws + WS_RWV); bf16* RWKK = (bf16*)(C.ws + WS_RWKK); bf16* RWB = (bf16*)(C.ws + WS_RWB); bf16* RWG = (bf16*)(C.ws + WS_RWG);
    const float* mu = a->in[21] + (size_t)l * 1792; const float* w0 = a->in[22] + (size_t)l * 512; const float* w2 = a->in[23] + (size_t)l * 64 * 512; const float* a0 = a->in[24] + (size_t)l * 512; const float* a2 = a->in[25] + (size_t)l * 64 * 512;
    const float* g2 = a->in[26] + (size_t)l * 128 * 512; const float* k_k = a->in[27] + (size_t)l * 512; const float* k_a = a->in[28] + (size_t)l * 512;
    LF WL = (LF)C.lds; LF AL = WL + 64 * 68; LF GLs = AL + 64 * 68;
    for (int bc = C.bid; bc < NBC; bc += C.G) {
        WG_SYNC();
        { const int t = C.tid >> 3, cg = C.tid & 7; float o[8];
          rw_lerp8(P, mu, bc, t, 1536 + cg * 8, o);
#pragma unroll
          for (int i = 0; i < 8; ++i) WL[t * 68 + cg * 8 + i] = tanhf(o[i]);
          rw_lerp8(P, mu, bc, t, 1600 + cg * 8, o);
#pragma unroll
          for (int i = 0; i < 8; ++i) AL[t * 68 + cg * 8 + i] = o[i];
          rw_lerp8(P, mu, bc, t, 1664 + cg * 16, o);
#pragma unroll
          for (int i = 0; i < 8; ++i) GLs[t * 132 + cg * 16 + i] = sigmoidf_(o[i]);
          rw_lerp8(P, mu, bc, t, 1664 + cg * 16 + 8, o);
#pragma unroll
          for (int i = 0; i < 8; ++i) GLs[t * 132 + cg * 16 + 8 + i] = sigmoidf_(o[i]); }
        WG_SYNC();
        const int tb = C.tid >> 6, cb = C.tid & 63, ch0 = cb * 8;
#pragma unroll 1
        for (int half = 0; half < 2; ++half) {
        const int rb = 8 * tb + 4 * half;
        float acc[4][8], av[4][8];
#pragma unroll
        for (int i = 0; i < 4; ++i)
#pragma unroll
            for (int j = 0; j < 8; ++j) acc[i][j] = 0.f;
#pragma unroll 2
        for (int r = 0; r < 64; ++r) { const f32x4 b0 = *(const f32x4*)(w2 + r * 512 + ch0), b1 = *(const f32x4*)(w2 + r * 512 + ch0 + 4);
#pragma unroll
            for (int i = 0; i < 4; ++i) { const float x = WL[(rb + i) * 68 + r];
#pragma unroll
                for (int j = 0; j < 4; ++j) { acc[i][j] += x * b0[j]; acc[i][4 + j] += x * b1[j]; } } }
#pragma unroll
        for (int i = 0; i < 4; ++i) { const size_t row = (size_t)bc * 64 + rb + i; float o[8];
#pragma unroll
            for (int j = 0; j < 8; ++j) { const float lw_ = -0.606531f * sigmoidf_(w0[ch0 + j] + acc[i][j]); o[j] = RW_CHUNKED ? lw_ : __expf(lw_); }
            *(f32x4*)(RWW + row * 512 + ch0) = (f32x4){o[0], o[1], o[2], o[3]}; *(f32x4*)(RWW + row * 512 + ch0 + 4) = (f32x4){o[4], o[5], o[6], o[7]}; }
#pragma unroll
        for (int i = 0; i < 4; ++i)
#pragma unroll
            for (int j = 0; j < 8; ++j) acc[i][j] = 0.f;
#pragma unroll 2
        for (int r = 0; r < 64; ++r) { const f32x4 b0 = *(const f32x4*)(a2 + r * 512 + ch0), b1 = *(const f32x4*)(a2 + r * 512 + ch0 + 4);
#pragma unroll
            for (int i = 0; i < 4; ++i) { const float x = AL[(rb + i) * 68 + r];
#pragma unroll
                for (int j = 0; j < 4; ++j) { acc[i][j] += x * b0[j]; acc[i][4 + j] += x * b1[j]; } } }
#pragma unroll
        for (int i = 0; i < 4; ++i)
#pragma unroll
            for (int j = 0; j < 8; ++j) av[i][j] = sigmoidf_(a0[ch0 + j] + acc[i][j]);
#pragma unroll
        for (int i = 0; i < 4; ++i)
#pragma unroll
            for (int j = 0; j < 8; ++j) acc[i][j] = 0.f;
#pragma unroll 2
        for (int r = 0; r < 128; ++r) { const f32x4 b0 = *(const f32x4*)(g2 + r * 512 + ch0), b1 = *(const f32x4*)(g2 + r * 512 + ch0 + 4);
#pragma unroll
            for (int i = 0; i < 4; ++i) { const float x = GLs[(rb + i) * 132 + r];
#pragma unroll
                for (int j = 0; j < 4; ++j) { acc[i][j] += x * b0[j]; acc[i][4 + j] += x * b1[j]; } } }
#pragma unroll
        for (int i = 0; i < 4; ++i) { const size_t row = (size_t)bc * 64 + rb + i; *(u32x4*)(RWG + row * 512 + ch0) = pack8(acc[i]); }
#pragma unroll
        for (int i = 0; i < 4; ++i) { const int t = rb + i; const size_t row = (size_t)bc * 64 + t; float o[8], kx[8], kk[8];
            rw_lerp8(P, mu, bc, t, ch0, o); *(u32x4*)(RWR + row * 512 + ch0) = pack8(o);
            rw_lerp8(P, mu, bc, t, 1024 + ch0, o); *(u32x4*)(RWV + row * 512 + ch0) = pack8(o);
            rw_lerp8(P, mu, bc, t, 512 + ch0, kx);
            float ss = 0.f;
#pragma unroll
            for (int j = 0; j < 8; ++j) { kk[j] = kx[j] * k_k[ch0 + j]; ss += kk[j] * kk[j]; }
            ss += __shfl_xor(ss, 1); ss += __shfl_xor(ss, 2); ss += __shfl_xor(ss, 4);
            const float inv = 1.0f / fmaxf(sqrtf(ss), 1e-12f);
#pragma unroll
            for (int j = 0; j < 8; ++j) { kk[j] *= inv; o[j] = kk[j] * av[i][j]; kx[j] = kx[j] * (1.0f + (av[i][j] - 1.0f) * k_a[ch0 + j]); }
            *(u32x4*)(RWKK + row * 512 + ch0) = pack8(kk); *(u32x4*)(RWB + row * 512 + ch0) = pack8(o); *(u32x4*)(RWK + row * 512 + ch0) = pack8(kx); }
        }
    }
    WG_SYNC();
}
template <int CTRL> __device__ __forceinline__ float dpp_get(float x) { return __builtin_bit_cast(float, __builtin_amdgcn_update_dpp(0, __builtin_bit_cast(int, x), CTRL, 0xf, 0xf, true)); }
__device__ __forceinline__ float reduce16(float x) { x += dpp_get<0xB1>(x); x += dpp_get<0x4E>(x); x += dpp_get<0x141>(x); x += dpp_get<0x140>(x); return x; }
#define RW_BAR() do { asm volatile("s_waitcnt lgkmcnt(0)" ::: "memory"); __builtin_amdgcn_s_barrier(); asm volatile("" ::: "memory"); } while (0)
PH_FN void rw_unit(const Ctx C, int chain, int rq) {
    const float* RWW = (const float*)(C.ws + WS_RWW); const bf16* RWR = (const bf16*)(C.ws + WS_RWR); const bf16* RWK = (const bf16*)(C.ws + WS_RWK); const bf16* RWV = (const bf16*)(C.ws + WS_RWV);
    const bf16* RWKK = (const bf16*)(C.ws + WS_RWKK); const bf16* RWB = (const bf16*)(C.ws + WS_RWB); bf16* RWY = (bf16*)(C.ws + WS_RWY);
    const int b = chain >> 3, h = chain & 7; const size_t rowb = (size_t)b * SEQ;
    constexpr int BUFB = 43008, O_KK = 0, O_W = 8192, O_B = 16384, O_K = 24576, O_R = 32768, O_V = 40960, NBLK = SEQ / 32;
    LAS unsigned char* L = C.lds;
    if (C.wave >= 4) {
        const int p = C.tid - 256, t = p >> 3, c8 = (p & 7) * 8;
        u32x4 rr, rk, rkk, rb; f32x4 w0, w1; unsigned rv;
#define RW_LOAD(blk) do { const size_t g_ = (rowb + (size_t)(blk) * 32 + t) * 512 + h * 64; \
            w0 = *(const f32x4*)(RWW + g_ + c8); w1 = *(const f32x4*)(RWW + g_ + c8 + 4); rr = *(const u32x4*)(RWR + g_ + c8); rk = *(const u32x4*)(RWK + g_ + c8); \
            rkk = *(const u32x4*)(RWKK + g_ + c8); rb = *(const u32x4*)(RWB + g_ + c8); rv = *(const unsigned*)(RWV + g_ + 16 * rq + (p & 7) * 2); } while (0)
#define RW_ST8(off, w_) do { float o_[8]; unpack8(w_, o_); LF d_ = (LF)(Lb + (off)) + t * 64 + c8; *(LAS f32x4*)d_ = (f32x4){o_[0], o_[1], o_[2], o_[3]}; *(LAS f32x4*)(d_ + 4) = (f32x4){o_[4], o_[5], o_[6], o_[7]}; } while (0)
        RW_LOAD(0);
        for (int blk = 0; blk < NBLK; ++blk) {
            LAS unsigned char* Lb = L + (blk & 1) * BUFB;
            { LF d = (LF)(Lb + O_W) + t * 64 + c8; *(LAS f32x4*)d = w0; *(LAS f32x4*)(d + 4) = w1; }
            RW_ST8(O_R, rr); RW_ST8(O_K, rk); RW_ST8(O_KK, rkk); RW_ST8(O_B, rb);
            { LF d = (LF)(Lb + O_V) + t * 16 + (p & 7) * 2; d[0] = bflo(rv); d[1] = bfhi(rv); }
            if (blk + 1 < NBLK) RW_LOAD(blk + 1);
            RW_BAR();
        }
        RW_BAR();
#undef RW_LOAD
#undef RW_ST8
    } else {
        const int rowl = C.lane >> 4, ks = C.lane & 15, row = 4 * C.wave + rowl;
        float S0 = 0.f, S1 = 0.f, S2 = 0.f, S3 = 0.f, ykeep = 0.f;
        bf16* yout = RWY + rowb * 512 + h * 64 + 16 * rq + row;
        for (int blk = 0; blk < NBLK; ++blk) {
            RW_BAR();
            const LAS unsigned char* Lb = L + (blk & 1) * BUFB;
            CLF pKK = (CLF)(Lb + O_KK) + 4 * ks; CLF pW = (CLF)(Lb + O_W) + 4 * ks; CLF pB = (CLF)(Lb + O_B) + 4 * ks; CLF pK = (CLF)(Lb + O_K) + 4 * ks; CLF pR = (CLF)(Lb + O_R) + 4 * ks; CLF pV = (CLF)(Lb + O_V) + row;
            f32x4 kk = *(const LAS f32x4*)pKK, w = *(const LAS f32x4*)pW, bb = *(const LAS f32x4*)pB, k = *(const LAS f32x4*)pK, r = *(const LAS f32x4*)pR; float vv = *pV;
#pragma unroll 4
            for (int t = 0; t < 32; ++t) {
                f32x4 nkk, nw, nb, nk, nr; float nv;
                const int tn = (t < 31) ? t + 1 : t;
                nkk = *(const LAS f32x4*)(pKK + tn * 64); nw = *(const LAS f32x4*)(pW + tn * 64); nb = *(const LAS f32x4*)(pB + tn * 64); nk = *(const LAS f32x4*)(pK + tn * 64); nr = *(const LAS f32x4*)(pR + tn * 64); nv = pV[tn * 16];
                float sa = (S0 * kk[0] + S1 * kk[1]) + (S2 * kk[2] + S3 * kk[3]);
                sa = -reduce16(sa);
                const float vk0 = vv * k[0], vk1 = vv * k[1], vk2 = vv * k[2], vk3 = vv * k[3];
                S0 = S0 * w[0] + (sa * bb[0] + vk0); S1 = S1 * w[1] + (sa * bb[1] + vk1); S2 = S2 * w[2] + (sa * bb[2] + vk2); S3 = S3 * w[3] + (sa * bb[3] + vk3);
                float y = (S0 * r[0] + S1 * r[1]) + (S2 * r[2] + S3 * r[3]);
                y = reduce16(y);
                if ((t & 15) == ks) ykeep = y;
                if ((t & 15) == 15) yout[(size_t)(blk * 32 + (t & 16) + ks) * 512] = (bf16)f2bf(ykeep);
                kk = nkk; w = nw; bb = nb; k = nk; r = nr; vv = nv;
            }
        }
        RW_BAR();
    }
}
PH_FN void ph_rw_out(const Ctx C, ArgsP a, int l) {
    const bf16* RWR = (const bf16*)(C.ws + WS_RWR); const bf16* RWK = (const bf16*)(C.ws + WS_RWK); const bf16* RWV = (const bf16*)(C.ws + WS_RWV); const bf16* RWG = (const bf16*)(C.ws + WS_RWG); const bf16* RWY = (const bf16*)(C.ws + WS_RWY);
    bf16* YS = (bf16*)(C.ws + WS_YS);
    const float* r_k = a->in[29] + (size_t)l * 512; const float* nw = a->in[30] + (size_t)l * 512; const float* nb = a->in[31] + (size_t)l * 512;
    const int gw = C.bid * NWAVES + C.wave, NGW = C.G * NWAVES;
    for (int it = gw; it < M * 8; it += NGW) {
        const size_t row = (size_t)(it >> 3); const int h = it & 7, c = h * 64 + C.lane; const size_t g = row * 512 + c;
        const float y = bf2f(RWY[g]), r = bf2f(RWR[g]), k = bf2f(RWK[g]), v = bf2f(RWV[g]), gg = bf2f(RWG[g]);
        const float mu = wave_sum(y) * (1.0f / 64.0f); const float d = y - mu; const float var = wave_sum(d * d) * (1.0f / 64.0f);
        const float yn = d * (1.0f / sqrtf(var + 64e-5f)) * nw[c] + nb[c];
        const float bonus = wave_sum(r * k * r_k[c]) * v;
        YS[row * 2048 + 1536 + c] = (bf16)f2bf((yn + bonus) * gg);
    }
}

__device__ __forceinline__ int pi_swap23(int i) { return (i & ~12) | ((i & 4) << 1) | ((i & 8) >> 1); }
__device__ __forceinline__ void da_unit(const Ctx& C, const Args& a, int l, int b, int h, int jq, float lam, float oml) {
    const bf16* P = (const bf16*)(C.ws + WS_P); const bf16* VT = (const bf16*)(C.ws + WS_VT); bf16* YS = (bf16*)(C.ws + WS_YS);
    const float* dnorm = a.in[11] + (size_t)l * 128;
    const int comp = C.wave >> 2, wq = C.wave & 3, q = C.lane & 31, hi = C.lane >> 5;
    const size_t qrow = (size_t)b * SEQ + jq * 128 + wq * 32 + q;
    pg8::bf16x8 qf[4];
#pragma unroll
    for (int d0 = 0; d0 < 4; ++d0) qf[d0] = *(const pg8::bf16x8*)(P + qrow * NPM + C_DAQ + h * 128 + comp * 64 + 16 * d0 + 8 * hi);
    const int ntile = 2 * jq + 2, my_last = 2 * jq + (wq >= 2 ? 1 : 0);
    f32x16 O[4];
#pragma unroll
    for (int db = 0; db < 4; ++db)
#pragma unroll
        for (int r = 0; r < 16; ++r) O[db][r] = 0.f;
    float mrun = -1e30f, lrun = 0.f;
    const bf16* kg = P + ((size_t)b * SEQ + (C.tid & 63)) * NPM + C_DAK + h * 128;
    const bf16* vg = VT + ((size_t)(b * 4 + h) * 128 + (C.tid & 127)) * SEQ;
    const int kc16 = C.tid >> 6, vc8 = C.tid >> 7;
    u32x4 kr[2], vr[2];
#pragma unroll
    for (int i = 0; i < 2; ++i) { kr[i] = *(const u32x4*)(kg + (kc16 + 8 * i) * 8); vr[i] = *(const u32x4*)(vg + (vc8 + 4 * i) * 8); }
    const int pq = pi_swap23(q);
    for (int tile = 0; tile < ntile; ++tile) {
        LAS unsigned char* buf = C.lds + (tile & 1) * 32768;
#pragma unroll
        for (int i = 0; i < 2; ++i) { const int c16 = kc16 + 8 * i; *(LAS u32x4*)(buf + (c16 >> 3) * 8192 + (c16 & 7) * 1024 + (C.tid & 63) * 16) = kr[i];
            *(LAS u32x4*)(buf + 16384 + (vc8 + 4 * i) * 2048 + (C.tid & 127) * 16) = vr[i]; }
        WG_SYNC();
        if (tile + 1 < ntile) {
#pragma unroll
            for (int i = 0; i < 2; ++i) { kr[i] = *(const u32x4*)(kg + (size_t)(tile + 1) * 64 * NPM + (kc16 + 8 * i) * 8); vr[i] = *(const u32x4*)(vg + (tile + 1) * 64 + (vc8 + 4 * i) * 8); } }
        if (tile <= my_last) {
            const LAS unsigned char* kb = buf + comp * 8192; const LAS unsigned char* vb = buf + 16384;
            f32x16 p0, p1;
#pragma unroll
            for (int r = 0; r < 16; ++r) { p0[r] = 0.f; p1[r] = 0.f; }
#pragma unroll
            for (int d0 = 0; d0 < 4; ++d0) {
                const pg8::bf16x8 a0 = *(const LAS pg8::bf16x8*)(kb + (2 * d0 + hi) * 1024 + pq * 16);
                const pg8::bf16x8 a1 = *(const LAS pg8::bf16x8*)(kb + (2 * d0 + hi) * 1024 + (32 + pq) * 16);
                p0 = __builtin_amdgcn_mfma_f32_32x32x16_bf16(a0, qf[d0], p0, 0, 0, 0);
                p1 = __builtin_amdgcn_mfma_f32_32x32x16_bf16(a1, qf[d0], p1, 0, 0, 0);
            }
            float mx = fmaxf(p0[0], p1[0]);
#pragma unroll
            for (int r = 1; r < 16; ++r) mx = fmaxf(mx, fmaxf(p0[r], p1[r]));
            mx = fmaxf(mx, __shfl_xor(mx, 32));
            const float mnew = fmaxf(mrun, mx); const float alpha = __builtin_amdgcn_exp2f(mrun - mnew); mrun = mnew;
            float rs = 0.f;
#pragma unroll
            for (int r = 0; r < 16; ++r) { p0[r] = __builtin_amdgcn_exp2f(p0[r] - mnew); p1[r] = __builtin_amdgcn_exp2f(p1[r] - mnew); rs += p0[r] + p1[r]; }
            lrun = lrun * alpha + rs;
#pragma unroll
            for (int db = 0; db < 4; ++db)
#pragma unroll
                for (int r = 0; r < 16; ++r) O[db][r] *= alpha;
            pg8::bf16x8 pb[4];
            { u32x4 w;
              w.x = pk2(p0[0], p0[1]); w.y = pk2(p0[2], p0[3]); w.z = pk2(p0[4], p0[5]); w.w = pk2(p0[6], p0[7]); pb[0] = __builtin_bit_cast(pg8::bf16x8, w);
              w.x = pk2(p0[8], p0[9]); w.y = pk2(p0[10], p0[11]); w.z = pk2(p0[12], p0[13]); w.w = pk2(p0[14], p0[15]); pb[1] = __builtin_bit_cast(pg8::bf16x8, w);
              w.x = pk2(p1[0], p1[1]); w.y = pk2(p1[2], p1[3]); w.z = pk2(p1[4], p1[5]); w.w = pk2(p1[6], p1[7]); pb[2] = __builtin_bit_cast(pg8::bf16x8, w);
              w.x = pk2(p1[8], p1[9]); w.y = pk2(p1[10], p1[11]); w.z = pk2(p1[12], p1[13]); w.w = pk2(p1[14], p1[15]); pb[3] = __builtin_bit_cast(pg8::bf16x8, w); }
#pragma unroll
            for (int db = 0; db < 4; ++db)
#pragma unroll
                for (int s = 0; s < 4; ++s) {
                    const pg8::bf16x8 vf = *(const LAS pg8::bf16x8*)(vb + (2 * s + hi) * 2048 + (32 * db + q) * 16);
                    O[db] = __builtin_amdgcn_mfma_f32_32x32x16_bf16(vf, pb[s], O[db], 0, 0, 0);
                }
        }
    }
    const float ltot = lrun + __shfl_xor(lrun, 32); const float inv = 1.0f / ltot;
    WG_SYNC();
    LF X = (LF)C.lds + (wq * 32 + q) * 132;
    if (comp == 1) {
        const float sc = inv * lam;
#pragma unroll
        for (int db = 0; db < 4; ++db)
#pragma unroll
            for (int g4 = 0; g4 < 4; ++g4) *(LAS f32x4*)(X + 32 * db + 8 * g4 + 4 * hi) = (f32x4){O[db][4 * g4] * sc, O[db][4 * g4 + 1] * sc, O[db][4 * g4 + 2] * sc, O[db][4 * g4 + 3] * sc};
    }
    WG_SYNC();
    if (comp == 0) {
        float ss = 0.f;
#pragma unroll
        for (int db = 0; db < 4; ++db)
#pragma unroll
            for (int g4 = 0; g4 < 4; ++g4) { const f32x4 x = *(const LAS f32x4*)(X + 32 * db + 8 * g4 + 4 * hi);
#pragma unroll
                for (int e = 0; e < 4; ++e) { const float v = O[db][4 * g4 + e] * inv - x[e]; O[db][4 * g4 + e] = v; ss += v * v; } }
        ss += __shfl_xor(ss, 32);
        const float rs = oml / sqrtf(ss * (1.0f / 128.0f) + EPS);
#pragma unroll
        for (int db = 0; db < 4; ++db)
#pragma unroll
            for (int g4 = 0; g4 < 4; ++g4) { const int d = 32 * db + 8 * g4 + 4 * hi; const f32x4 gn = *(const f32x4*)(dnorm + d);
                u32x2 w; w.x = pk2(O[db][4 * g4] * rs * gn[0], O[db][4 * g4 + 1] * rs * gn[1]); w.y = pk2(O[db][4 * g4 + 2] * rs * gn[2], O[db][4 * g4 + 3] * rs * gn[3]);
                *(u32x2*)(YS + qrow * 2048 + h * 128 + d) = w; }
    }
    WG_SYNC();
}
#if RW_CHUNKED
__device__ const signed char ATT_BINS30[30][3] = {{63,4,3}, {62,5,2}, {61,6,1}, {60,7,0}, {59,8,-1}, {58,9,-1}, {57,10,-1}, {56,11,-1}, {55,12,-1}, {54,13,-1}, {53,14,-1}, {52,15,-1}, {51,16,-1}, {50,17,-1}, {49,18,-1}, {48,19,-1}, {47,20,-1}, {46,21,-1}, {45,22,-1}, {44,23,-1}, {43,24,-1}, {42,25,-1}, {41,26,-1}, {40,27,-1}, {39,28,-1}, {38,29,-1}, {37,30,-1}, {36,31,-1}, {35,32,-1}, {34,33,-1}};
__device__ __forceinline__ int att_bin_unit(int bin, int i) { return i < 3 ? (int)ATT_BINS30[bin][i] : -1; }
#else
__device__ const signed char ATT_BINS[24][12] = {{63,21,-1,-1,-1,-1,-1,-1,-1,-1,-1,-1}, {62,22,-1,-1,-1,-1,-1,-1,-1,-1,-1,-1}, {61,23,-1,-1,-1,-1,-1,-1,-1,-1,-1,-1}, {60,24,-1,-1,-1,-1,-1,-1,-1,-1,-1,-1}, {59,25,-1,-1,-1,-1,-1,-1,-1,-1,-1,-1}, {58,26,-1,-1,-1,-1,-1,-1,-1,-1,-1,-1}, {57,27,-1,-1,-1,-1,-1,-1,-1,-1,-1,-1}, {56,28,-1,-1,-1,-1,-1,-1,-1,-1,-1,-1}, {55,29,-1,-1,-1,-1,-1,-1,-1,-1,-1,-1}, {54,30,-1,-1,-1,-1,-1,-1,-1,-1,-1,-1}, {53,31,-1,-1,-1,-1,-1,-1,-1,-1,-1,-1}, {52,32,-1,-1,-1,-1,-1,-1,-1,-1,-1,-1}, {51,33,-1,-1,-1,-1,-1,-1,-1,-1,-1,-1}, {50,34,-1,-1,-1,-1,-1,-1,-1,-1,-1,-1}, {49,35,-1,-1,-1,-1,-1,-1,-1,-1,-1,-1}, {48,36,-1,-1,-1,-1,-1,-1,-1,-1,-1,-1}, {47,37,-1,-1,-1,-1,-1,-1,-1,-1,-1,-1}, {46,38,-1,-1,-1,-1,-1,-1,-1,-1,-1,-1}, {45,39,-1,-1,-1,-1,-1,-1,-1,-1,-1,-1}, {44,40,-1,-1,-1,-1,-1,-1,-1,-1,-1,-1}, {43,41,-1,-1,-1,-1,-1,-1,-1,-1,-1,-1}, {42,20,19,6,-1,-1,-1,-1,-1,-1,-1,-1}, {18,17,16,15,14,5,-1,-1,-1,-1,-1,-1}, {13,12,11,10,9,8,7,4,3,2,1,0}};
__device__ __forceinline__ int att_bin_unit(int bin, int i) { return i < 12 ? (int)ATT_BINS[bin][i] : -1; }
#endif
__device__ __forceinline__ void ph_da_attn(const Ctx& C, const Args& a, int l, int bh, int bin) {
    const float* q1 = a.in[7] + (size_t)l * 64; const float* k1 = a.in[8] + (size_t)l * 64; const float* q2 = a.in[9] + (size_t)l * 64; const float* k2 = a.in[10] + (size_t)l * 64;
    float s1 = 0.f, s2 = 0.f;
    for (int i = 0; i < 64; ++i) { s1 += q1[i] * k1[i]; s2 += q2[i] * k2[i]; }
    const float lam_init = 0.8f - 0.6f * expf(-0.3f * (float)l); const float lam = expf(s1) - expf(s2) + lam_init;
    for (int i = 0; i < 12; ++i) { const int jq = att_bin_unit(bin, i); if (jq < 0) break; da_unit(C, a, l, bh >> 2, bh & 3, jq, lam, 1.0f - lam_init); }
}

PH_FN void ph_final(const Ctx C, ArgsP a) {
    const float* ssq = (const float*)(C.ws + WS_SSQ); const float* fn = a->in[39];
    const int gw = C.bid * NWAVES + C.wave, NGW = C.G * NWAVES;
    for (int m = gw; m < M; m += NGW) { const float rs = pg8::row_rstd(ssq, m, M); f32x4* hr = (f32x4*)(C.h + (size_t)m * D) + C.lane; const f32x4* gr = (const f32x4*)fn + C.lane;
#pragma unroll
        for (int j = 0; j < 4; ++j) { const f32x4 v = hr[64 * j], g = gr[64 * j]; hr[64 * j] = v * rs * g; } }
}
PH_FN void rwc_stage0(const Ctx C, int bc, int h) {
    float* RWW = (float*)(C.ws + WS_RWW); const bf16* RWR = (const bf16*)(C.ws + WS_RWR); const bf16* RWK = (const bf16*)(C.ws + WS_RWK); const bf16* RWV = (const bf16*)(C.ws + WS_RWV);
    bf16* RWKK = (bf16*)(C.ws + WS_RWKK); bf16* RWB = (bf16*)(C.ws + WS_RWB); bf16* RWY = (bf16*)(C.ws + WS_RWY);
    LF LGs = (LF)C.lds; LF X1T = LGs; LB AT = (LB)(C.lds + 17408); LB LAK = AT; LB A2T = (LB)(C.lds + 99328); LB RT = (LB)(C.lds + 26624); LB BTl = (LB)(C.lds + 35840); LB MRB = BTl; LB KTl = (LB)(C.lds + 45056); LB MRK = KTl;
    LB VT = (LB)(C.lds + 54272); LB BHT = (LB)(C.lds + 63488); LB KHT = (LB)(C.lds + 72704); LF LAB = (LF)(C.lds + 81920); LB WT = (LB)C.lds; LF A0T = (LF)(C.lds + 99328); LF rho = (LF)(C.lds + 116736); LF lgl = rho + 64;
    const int t = C.tid >> 3, g8 = C.tid & 7, n = C.lane & 31, hi = C.lane >> 5; const size_t row0 = (size_t)bc * 64; (void)t; (void)g8; (void)n; (void)hi; (void)row0;
    (void)RWW; (void)RWR; (void)RWK; (void)RWV; (void)RWKK; (void)RWB; (void)RWY; (void)LGs; (void)X1T; (void)AT; (void)LAK; (void)A2T; (void)RT; (void)BTl; (void)MRB; (void)KTl; (void)MRK; (void)VT; (void)BHT; (void)KHT; (void)LAB; (void)WT; (void)A0T; (void)rho; (void)lgl;
        const size_t g = (row0 + t) * 512 + h * 64 + g8 * 8;
        WG_SYNC();
        float lw[8]; { const f32x4 x0 = *(const f32x4*)(RWW + g), x1 = *(const f32x4*)(RWW + g + 4); lw[0] = x0[0]; lw[1] = x0[1]; lw[2] = x0[2]; lw[3] = x0[3]; lw[4] = x1[0]; lw[5] = x1[1]; lw[6] = x1[2]; lw[7] = x1[3]; }
#pragma unroll
        for (int i = 0; i < 8; ++i) LGs[t * 68 + g8 * 8 + i] = lw[i];
        WG_SYNC();
        if (C.tid < 64) { float run = 0.f; for (int tt = 0; tt < 64; ++tt) { run += LGs[tt * 68 + C.tid]; LGs[tt * 68 + C.tid] = run; } }
        WG_SYNC();
        {   float rf[8], kf[8], kkf[8], bf[8], lg[8], rh[8], ll[8], o1[8], o2[8], o3[8], o4[8];
            unpack8(*(const u32x4*)(RWR + g), rf); unpack8(*(const u32x4*)(RWK + g), kf); unpack8(*(const u32x4*)(RWKK + g), kkf); unpack8(*(const u32x4*)(RWB + g), bf);
#pragma unroll
            for (int i = 0; i < 8; ++i) { const int k = g8 * 8 + i; lg[i] = LGs[t * 68 + k]; rh[i] = LGs[31 * 68 + k]; ll[i] = LGs[63 * 68 + k]; }
#pragma unroll
            for (int i = 0; i < 8; ++i) { const int k = g8 * 8 + i; const float lm1 = lg[i] - lw[i];
                const float ed = __expf(lg[i] - rh[i]), edi = __expf(rh[i] - lg[i]), el = __expf(ll[i] - lg[i]);
                o1[i] = -kkf[i] * __expf(lm1 - rh[i]); o2[i] = rf[i] * ed; o3[i] = bf[i] * edi; o4[i] = kf[i] * edi;
                A0T[k * 68 + t] = -kkf[i] * __expf(lm1);
                BHT[k * 72 + t] = (bf16)f2bf(bf[i] * el); KHT[k * 72 + t] = (bf16)f2bf(kf[i] * el); }
            *(LAS u32x4*)(AT + t * 72 + g8 * 8) = pack8(o1); *(LAS u32x4*)(RT + t * 72 + g8 * 8) = pack8(o2); *(LAS u32x4*)(BTl + t * 72 + g8 * 8) = pack8(o3); *(LAS u32x4*)(KTl + t * 72 + g8 * 8) = pack8(o4);
            const u32x4 vv = *(const u32x4*)(RWV + g); const unsigned vw[4] = {vv.x, vv.y, vv.z, vv.w};
#pragma unroll
            for (int i = 0; i < 4; ++i) { VT[(g8 * 8 + 2 * i) * 72 + t] = (bf16)(vw[i] & 0xffffu); VT[(g8 * 8 + 2 * i + 1) * 72 + t] = (bf16)(vw[i] >> 16); }
            if (t == 0) {
#pragma unroll
                for (int i = 0; i < 8; ++i) { rho[g8 * 8 + i] = rh[i]; lgl[g8 * 8 + i] = ll[i]; } }
        }
        WG_SYNC();
}
PH_FN void rwc_stage12(const Ctx C) {
    const int bc = 0;
    float* RWW = (float*)(C.ws + WS_RWW); const bf16* RWR = (const bf16*)(C.ws + WS_RWR); const bf16* RWK = (const bf16*)(C.ws + WS_RWK); const bf16* RWV = (const bf16*)(C.ws + WS_RWV);
    bf16* RWKK = (bf16*)(C.ws + WS_RWKK); bf16* RWB = (bf16*)(C.ws + WS_RWB); bf16* RWY = (bf16*)(C.ws + WS_RWY);
    LF LGs = (LF)C.lds; LF X1T = LGs; LB AT = (LB)(C.lds + 17408); LB LAK = AT; LB A2T = (LB)(C.lds + 99328); LB RT = (LB)(C.lds + 26624); LB BTl = (LB)(C.lds + 35840); LB MRB = BTl; LB KTl = (LB)(C.lds + 45056); LB MRK = KTl;
    LB VT = (LB)(C.lds + 54272); LB BHT = (LB)(C.lds + 63488); LB KHT = (LB)(C.lds + 72704); LF LAB = (LF)(C.lds + 81920); LB WT = (LB)C.lds; LF A0T = (LF)(C.lds + 99328); LF rho = (LF)(C.lds + 116736); LF lgl = rho + 64;
    const int t = C.tid >> 3, g8 = C.tid & 7, n = C.lane & 31, hi = C.lane >> 5; const size_t row0 = (size_t)bc * 64; (void)t; (void)g8; (void)n; (void)hi; (void)row0;
    (void)RWW; (void)RWR; (void)RWK; (void)RWV; (void)RWKK; (void)RWB; (void)RWY; (void)LGs; (void)X1T; (void)AT; (void)LAK; (void)A2T; (void)RT; (void)BTl; (void)MRB; (void)KTl; (void)MRK; (void)VT; (void)BHT; (void)KHT; (void)LAB; (void)WT; (void)A0T; (void)rho; (void)lgl;
        {   const int mt = C.wave >> 1, nt0 = 2 * (C.wave & 1);
            CLB Am = (mt < 2) ? (CLB)AT : (CLB)RT; const int m0 = 32 * (mt & 1);
            CLB Bm = (nt0 < 2) ? (CLB)BTl : (CLB)KTl;
            f32x16 c0 = zero16(), c1 = zero16();
            mma_nt<64>(c0, Am, 72, m0, Bm, 72, 0, C.lane); mma_nt<64>(c1, Am, 72, m0, Bm, 72, 32, C.lane);
            WG_SYNC();
#pragma unroll
            for (int r = 0; r < 16; ++r) { const int tt = m0 + crow(r, hi); const int j0 = n, j1 = 32 + n;
                if (mt < 2) { const float x0 = (j0 < tt) ? c0[r] : 0.f, x1 = (j1 < tt) ? c1[r] : 0.f;
                    if (nt0 < 2) { LAB[tt * 68 + j0] = x0; LAB[tt * 68 + j1] = x1; } else { LAK[tt * 72 + j0] = (bf16)f2bf(x0); LAK[tt * 72 + j1] = (bf16)f2bf(x1); } }
                else { const float x0 = (j0 <= tt) ? c0[r] : 0.f, x1 = (j1 <= tt) ? c1[r] : 0.f;
                    if (nt0 < 2) { MRB[tt * 72 + j0] = (bf16)f2bf(x0); MRB[tt * 72 + j1] = (bf16)f2bf(x1); } else { MRK[tt * 72 + j0] = (bf16)f2bf(x0); MRK[tt * 72 + j1] = (bf16)f2bf(x1); } } }
        }
        WG_SYNC();
        if (C.wave < 4) { const int vt = C.wave >> 1, tt0 = C.wave & 1; f32x16 c = zero16(); mma_nt<64>(c, VT, 72, 32 * vt, LAK, 72, 32 * tt0, C.lane);
#pragma unroll
            for (int r = 0; r < 16; ++r) X1T[(32 * vt + crow(r, hi)) * 68 + 32 * tt0 + n] = c[r]; }
        WG_SYNC();
}
PH_FN void rwc_solve(const Ctx C) {
    const int bc = 0;
    float* RWW = (float*)(C.ws + WS_RWW); const bf16* RWR = (const bf16*)(C.ws + WS_RWR); const bf16* RWK = (const bf16*)(C.ws + WS_RWK); const bf16* RWV = (const bf16*)(C.ws + WS_RWV);
    bf16* RWKK = (bf16*)(C.ws + WS_RWKK); bf16* RWB = (bf16*)(C.ws + WS_RWB); bf16* RWY = (bf16*)(C.ws + WS_RWY);
    LF LGs = (LF)C.lds; LF X1T = LGs; LB AT = (LB)(C.lds + 17408); LB LAK = AT; LB A2T = (LB)(C.lds + 99328); LB RT = (LB)(C.lds + 26624); LB BTl = (LB)(C.lds + 35840); LB MRB = BTl; LB KTl = (LB)(C.lds + 45056); LB MRK = KTl;
    LB VT = (LB)(C.lds + 54272); LB BHT = (LB)(C.lds + 63488); LB KHT = (LB)(C.lds + 72704); LF LAB = (LF)(C.lds + 81920); LB WT = (LB)C.lds; LF A0T = (LF)(C.lds + 99328); LF rho = (LF)(C.lds + 116736); LF lgl = rho + 64;
    const int t = C.tid >> 3, g8 = C.tid & 7, n = C.lane & 31, hi = C.lane >> 5; const size_t row0 = (size_t)bc * 64; (void)t; (void)g8; (void)n; (void)hi; (void)row0;
    (void)RWW; (void)RWR; (void)RWK; (void)RWV; (void)RWKK; (void)RWB; (void)RWY; (void)LGs; (void)X1T; (void)AT; (void)LAK; (void)A2T; (void)RT; (void)BTl; (void)MRB; (void)KTl; (void)MRK; (void)VT; (void)BHT; (void)KHT; (void)LAB; (void)WT; (void)A0T; (void)rho; (void)lgl;
        if (C.tid < 128) {
            LF row = (C.tid < 64) ? (A0T + C.tid * 68) : (X1T + (C.tid - 64) * 68);
#pragma unroll 1
            for (int tt = 1; tt < 64; ++tt) {
                CLF lr = (CLF)LAB + tt * 68; float s0 = row[tt], s1 = 0.f, s2 = 0.f, s3 = 0.f;
#pragma unroll 2
                for (int j = 0; j < tt; j += 4) {
                    const f32x4 l = *(const LAS f32x4*)(lr + j), xv = *(const LAS f32x4*)(row + j);
                    s0 += l[0] * xv[0]; s1 += l[1] * xv[1]; s2 += l[2] * xv[2]; s3 += l[3] * xv[3]; }
                row[tt] = (s0 + s1) + (s2 + s3);
            }
            float x[64];
#pragma unroll
            for (int q = 0; q < 16; ++q) { const f32x4 v4 = *(const LAS f32x4*)(row + 4 * q); x[4 * q] = v4[0]; x[4 * q + 1] = v4[1]; x[4 * q + 2] = v4[2]; x[4 * q + 3] = v4[3]; }
            LB dst = (LB)row;
#pragma unroll
            for (int q = 0; q < 8; ++q) { u32x4 w; w.x = pk2(x[8 * q], x[8 * q + 1]); w.y = pk2(x[8 * q + 2], x[8 * q + 3]); w.z = pk2(x[8 * q + 4], x[8 * q + 5]); w.w = pk2(x[8 * q + 6], x[8 * q + 7]); *(LAS u32x4*)(dst + 8 * q) = w; }
        }
        WG_SYNC();
}
PH_FN void rwc_stage4(const Ctx C, int bc, int h) {
    float* RWW = (float*)(C.ws + WS_RWW); const bf16* RWR = (const bf16*)(C.ws + WS_RWR); const bf16* RWK = (const bf16*)(C.ws + WS_RWK); const bf16* RWV = (const bf16*)(C.ws + WS_RWV);
    bf16* RWKK = (bf16*)(C.ws + WS_RWKK); bf16* RWB = (bf16*)(C.ws + WS_RWB); bf16* RWY = (bf16*)(C.ws + WS_RWY);
    LF LGs = (LF)C.lds; LF X1T = LGs; LB AT = (LB)(C.lds + 17408); LB LAK = AT; LB A2T = (LB)(C.lds + 99328); LB RT = (LB)(C.lds + 26624); LB BTl = (LB)(C.lds + 35840); LB MRB = BTl; LB KTl = (LB)(C.lds + 45056); LB MRK = KTl;
    LB VT = (LB)(C.lds + 54272); LB BHT = (LB)(C.lds + 63488); LB KHT = (LB)(C.lds + 72704); LF LAB = (LF)(C.lds + 81920); LB WT = (LB)C.lds; LF A0T = (LF)(C.lds + 99328); LF rho = (LF)(C.lds + 116736); LF lgl = rho + 64;
    const int t = C.tid >> 3, g8 = C.tid & 7, n = C.lane & 31, hi = C.lane >> 5; const size_t row0 = (size_t)bc * 64; (void)t; (void)g8; (void)n; (void)hi; (void)row0;
    (void)RWW; (void)RWR; (void)RWK; (void)RWV; (void)RWKK; (void)RWB; (void)RWY; (void)LGs; (void)X1T; (void)AT; (void)LAK; (void)A2T; (void)RT; (void)BTl; (void)MRB; (void)KTl; (void)MRK; (void)VT; (void)BHT; (void)KHT; (void)LAB; (void)WT; (void)A0T; (void)rho; (void)lgl;
        {   const int kind = C.wave >> 1, mt = C.wave & 1;
            f32x16 c0 = zero16(), c1 = zero16();
            if (kind == 0) { mma_nt<64>(c0, BHT, 72, 32 * mt, A2T, 136, 0, C.lane); mma_nt<64>(c1, BHT, 72, 32 * mt, A2T, 136, 32, C.lane); }
            else if (kind == 1) { mma_nt<64>(c0, BHT, 72, 32 * mt, WT, 136, 0, C.lane); mma_nt<64>(c1, BHT, 72, 32 * mt, WT, 136, 32, C.lane); mma_nt<64>(c0, KHT, 72, 32 * mt, VT, 72, 0, C.lane); mma_nt<64>(c1, KHT, 72, 32 * mt, VT, 72, 32, C.lane); }
            else if (kind == 2) { mma_nt<64>(c0, MRB, 72, 32 * mt, A2T, 136, 0, C.lane); mma_nt<64>(c1, MRB, 72, 32 * mt, A2T, 136, 32, C.lane); }
            else { mma_nt<64>(c0, MRB, 72, 32 * mt, WT, 136, 0, C.lane); mma_nt<64>(c1, MRB, 72, 32 * mt, WT, 136, 32, C.lane); mma_nt<64>(c0, MRK, 72, 32 * mt, VT, 72, 0, C.lane); mma_nt<64>(c1, MRK, 72, 32 * mt, VT, 72, 32, C.lane); }
#pragma unroll
            for (int r = 0; r < 16; ++r) { const int m = 32 * mt + crow(r, hi); const size_t go = (row0 + m) * 512 + h * 64;
                if (kind == 0) { const float d = __expf(lgl[m]); RWB[go + n] = (bf16)f2bf(c0[r] + ((n == m) ? d : 0.f)); RWB[go + 32 + n] = (bf16)f2bf(c1[r] + ((32 + n == m) ? d : 0.f)); }
                else if (kind == 1) { RWW[go + n] = c0[r]; RWW[go + 32 + n] = c1[r]; }
                else if (kind == 2) { RWKK[go + n] = (bf16)f2bf(c0[r] + bf2f(RT[m * 72 + n]) * __expf(rho[n])); RWKK[go + 32 + n] = (bf16)f2bf(c1[r] + bf2f(RT[m * 72 + 32 + n]) * __expf(rho[32 + n])); }
                else { RWY[go + n] = (bf16)f2bf(c0[r]); RWY[go + 32 + n] = (bf16)f2bf(c1[r]); } }
        }
}
__device__ __forceinline__ void ph_rw_chunk(const Ctx& C, int bc) {
#pragma unroll 1
    for (int h = 0; h < 8; ++h) { rwc_stage0(C, bc, h); rwc_stage12(C); rwc_solve(C); rwc_stage4(C, bc, h); }
    WG_SYNC();
}
PH_FN void rw_scan_unit(const Ctx C, int chain) {
    const float* RWW = (const float*)(C.ws + WS_RWW); const bf16* RWKK = (const bf16*)(C.ws + WS_RWKK); const bf16* RWB = (const bf16*)(C.ws + WS_RWB); bf16* RWY = (bf16*)(C.ws + WS_RWY);
    const int b = chain >> 3, h = chain & 7; const size_t rowb = (size_t)b * SEQ;
    constexpr int BUFB = 45056, O_RQ = 0, O_PT = 9216, O_QT = 18432, O_Y0 = 35840;
    LAS unsigned char* L = C.lds;
    if (C.wave >= 4) {
        const int p = C.tid - 256, t = p >> 2, q4 = (p & 3) * 16;
        u32x4 Arq0, Arq1, Apt0, Apt1, Ay00, Ay01, Brq0, Brq1, Bpt0, Bpt1, By00, By01; f32x4 Aq0, Aq1, Aq2, Aq3, Bq0, Bq1, Bq2, Bq3;
#define SC_LOAD(S, c_) do { const size_t g_ = (rowb + (size_t)(c_) * 64 + t) * 512 + h * 64 + q4; \
            S##rq0 = *(const u32x4*)(RWKK + g_); S##rq1 = *(const u32x4*)(RWKK + g_ + 8); S##pt0 = *(const u32x4*)(RWB + g_); S##pt1 = *(const u32x4*)(RWB + g_ + 8); S##y00 = *(const u32x4*)(RWY + g_); S##y01 = *(const u32x4*)(RWY + g_ + 8); \
            S##q0 = *(const f32x4*)(RWW + g_); S##q1 = *(const f32x4*)(RWW + g_ + 4); S##q2 = *(const f32x4*)(RWW + g_ + 8); S##q3 = *(const f32x4*)(RWW + g_ + 12); } while (0)
#define SC_WRITE(S, Lb) do { \
            *(LAS u32x4*)((LB)((Lb) + O_RQ) + t * 72 + q4) = S##rq0; *(LAS u32x4*)((LB)((Lb) + O_RQ) + t * 72 + q4 + 8) = S##rq1; \
            *(LAS u32x4*)((LB)((Lb) + O_PT) + t * 72 + q4) = S##pt0; *(LAS u32x4*)((LB)((Lb) + O_PT) + t * 72 + q4 + 8) = S##pt1; \
            *(LAS u32x4*)((LB)((Lb) + O_Y0) + t * 72 + q4) = S##y00; *(LAS u32x4*)((LB)((Lb) + O_Y0) + t * 72 + q4 + 8) = S##y01; \
            { LF d_ = (LF)((Lb) + O_QT) + t * 68 + q4; *(LAS f32x4*)d_ = S##q0; *(LAS f32x4*)(d_ + 4) = S##q1; *(LAS f32x4*)(d_ + 8) = S##q2; *(LAS f32x4*)(d_ + 12) = S##q3; } } while (0)
        SC_LOAD(A, 0); SC_LOAD(B, 1);
        for (int c = 0; c < NCH; c += 2) {
            SC_WRITE(A, L); if (c + 2 < NCH) SC_LOAD(A, c + 2); RW_BAR();
            SC_WRITE(B, L + BUFB); if (c + 3 < NCH) SC_LOAD(B, c + 3); RW_BAR();
        }
        RW_BAR();
#undef SC_LOAD
#undef SC_WRITE
    } else {
        const int n = C.lane & 31, hi = C.lane >> 5, vh = C.wave & 1;
        f32x16 st0 = zero16(), st1 = zero16();
        for (int c = 0; c < NCH; ++c) {
            RW_BAR();
            if (C.wave < 2) {
                const LAS unsigned char* Lb = L + (c & 1) * BUFB;
                CLB RQ = (CLB)(Lb + O_RQ); CLB PT = (CLB)(Lb + O_PT); CLF QT = (CLF)(Lb + O_QT); CLB Y0 = (CLB)(Lb + O_Y0);
                pg8::bf16x8 sb[4];
                { u32x4 w;
                  w.x = pk2(st0[0], st0[1]); w.y = pk2(st0[2], st0[3]); w.z = pk2(st0[4], st0[5]); w.w = pk2(st0[6], st0[7]); sb[0] = __builtin_bit_cast(pg8::bf16x8, w);
                  w.x = pk2(st0[8], st0[9]); w.y = pk2(st0[10], st0[11]); w.z = pk2(st0[12], st0[13]); w.w = pk2(st0[14], st0[15]); sb[1] = __builtin_bit_cast(pg8::bf16x8, w);
                  w.x = pk2(st1[0], st1[1]); w.y = pk2(st1[2], st1[3]); w.z = pk2(st1[4], st1[5]); w.w = pk2(st1[6], st1[7]); sb[2] = __builtin_bit_cast(pg8::bf16x8, w);
                  w.x = pk2(st1[8], st1[9]); w.y = pk2(st1[10], st1[11]); w.z = pk2(st1[12], st1[13]); w.w = pk2(st1[14], st1[15]); sb[3] = __builtin_bit_cast(pg8::bf16x8, w); }
#define SC_AFRAG(X_, row_, s_) ({ const u32x2 lo_ = *(const LAS u32x2*)((X_) + (row_) * 72 + 16 * (s_) + 4 * hi), hi_ = *(const LAS u32x2*)((X_) + (row_) * 72 + 16 * (s_) + 8 + 4 * hi); \
                    u32x4 w_; w_.x = lo_.x; w_.y = lo_.y; w_.z = hi_.x; w_.w = hi_.y; __builtin_bit_cast(pg8::bf16x8, w_); })
#pragma unroll
                for (int tt = 0; tt < 2; ++tt) { f32x16 y;
#pragma unroll
                    for (int r = 0; r < 16; ++r) y[r] = bf2f(Y0[(32 * tt + crow(r, hi)) * 72 + 32 * vh + n]);
#pragma unroll
                    for (int s = 0; s < 4; ++s) y = __builtin_amdgcn_mfma_f32_32x32x16_bf16(SC_AFRAG(RQ, 32 * tt + n, s), sb[s], y, 0, 0, 0);
                    bf16* yo = RWY + (rowb + (size_t)c * 64 + 32 * tt) * 512 + h * 64 + 32 * vh + n;
#pragma unroll
                    for (int r = 0; r < 16; ++r) yo[(size_t)crow(r, hi) * 512] = (bf16)f2bf(y[r]); }
                f32x16 n0, n1;
#pragma unroll
                for (int r = 0; r < 16; ++r) { n0[r] = QT[crow(r, hi) * 68 + 32 * vh + n]; n1[r] = QT[(32 + crow(r, hi)) * 68 + 32 * vh + n]; }
#pragma unroll
                for (int s = 0; s < 4; ++s) { n0 = __builtin_amdgcn_mfma_f32_32x32x16_bf16(SC_AFRAG(PT, n, s), sb[s], n0, 0, 0, 0); n1 = __builtin_amdgcn_mfma_f32_32x32x16_bf16(SC_AFRAG(PT, 32 + n, s), sb[s], n1, 0, 0, 0); }
                st0 = n0; st1 = n1;
#undef SC_AFRAG
            }
        }
        RW_BAR();
    }
}
#ifndef REP_ATTN
#define REP_ATTN 1
#endif
#ifndef REP_W
#define REP_W 1
#endif
#ifndef REP_RWC
#define REP_RWC 1
#endif
#ifndef REP_MA
#define REP_MA 1
#endif
#ifndef REP_MAFULL
#define REP_MAFULL 1
#endif
#ifndef REP_SCANS
#define REP_SCANS 1
#endif
#ifndef REP_MC
#define REP_MC 1
#endif
#ifndef REP_GEMM
#define REP_GEMM 1
#endif
constexpr int NPH = 12, G_FINAL = 1 + NL * NPH, G_END = G_FINAL + 1;
template <int GRP>
__global__ void __launch_bounds__(NTHR, 2) hybrid_fwd(Args args) {
    constexpr bool ALL = (GRP < 0);
    constexpr bool EN_G1 = ALL || GRP == 0, EN_G2 = EN_G1, EN_G3 = EN_G1, EN_G7 = EN_G1, EN_G8 = EN_G1, EN_G9 = EN_G1;
    constexpr bool EN_PRO = ALL || GRP == 1, EN_W = EN_PRO, EN_FIN = EN_PRO, EN_MA1 = EN_PRO, EN_MA2 = EN_PRO, EN_MA3 = EN_PRO, EN_MA4 = EN_PRO;
    constexpr bool EN_MB1 = ALL || GRP == 2, EN_MB2 = EN_MB1;
    constexpr bool EN_MC1 = ALL || GRP == 3, EN_MC2 = EN_MC1, EN_MC3 = EN_MC1;
    extern __shared__ __attribute__((aligned(16))) unsigned char lds[];
    Ctx C; C.lds = (LAS unsigned char*)lds; C.ws = args.ws; C.h = args.out; C.tid = threadIdx.x; C.lane = C.tid & 63; C.wave = __builtin_amdgcn_readfirstlane(C.tid >> 6); C.bid = blockIdx.x; C.G = gridDim.x;
    LAS unsigned char* ldsl = (LAS unsigned char*)lds;
    const ArgsP ap = (ArgsP)__builtin_amdgcn_kernarg_segment_ptr();
    for (int u = C.tid; u < (LDS_BYTES - LDSCTL_OFF) / 4; u += NTHR) ((LAS unsigned*)(ldsl + LDSCTL_OFF))[u] = 0u;
    __syncthreads();
    volatile LAS unsigned* MISC = (volatile LAS unsigned*)(ldsl + MISC_OFF);
    gu32* ctl = (gu32*)(args.ws + WS_CTL);
    const int g_lo = args.g_lo, g_hi = args.g_hi;
    XcdBarrier bar; bar.bar = (unsigned*)(ctl + CW_BAR); bar.x = 0; bar.st = nullptr;
    if (g_hi - g_lo > 1) bar = xcd_barrier_post((unsigned*)(ctl + CW_BAR), MISC + 8);
#define IN(g) (g_lo <= (g) && (g) < g_hi)
#define SEAM(g) do { if (IN(g) && IN((g) + 1)) xcd_barrier(bar); } while (0)
    bf16* HB = (bf16*)(args.ws + WS_HB); float* SSQ = (float*)(args.ws + WS_SSQ);

    if (EN_PRO && IN(0)) ph_prologue(fresh(C), ap);
    SEAM(0);
#pragma unroll 1
    for (int l = 0; l < NL; ++l) {
        const int gb = 1 + NPH * l;
        if (EN_W && IN(gb + 0)) { for (int rep = 0; rep < REP_W; ++rep) ph_weights(fresh(C), ap, l); }
        SEAM(gb + 0);
#pragma unroll 1
        for (int f = 0; f < 2; ++f) {
            const int gu = gb + (f ? 10 : 1);
            if (EN_G1 && IN(gu)) {
                pg8::Gemm g{HB, (const bf16*)(args.ws + (f ? WS_WGU2 : WS_WGU1)), M, 2 * FF, D, D}; pg8::StaticOrder S; S.init(M, 2 * FF, C.G, C.bid);
                pg8::EpiSwiglu E{(bf16*)(args.ws + WS_ACT), FF, SSQ, M};
                pg8::gemm_phase<pg8::EpiSwiglu, pg8::StaticOrder, true, true>(ldsl, g, S, E);
            }
            SEAM(gu);
            if (EN_G2 && IN(gu + 1)) {
                pg8::Gemm g{(const bf16*)(args.ws + WS_ACT), (const bf16*)(args.ws + (f ? WS_WD2 : WS_WD1)), M, D, FF, FF}; pg8::StaticOrder S; S.init(M, D, C.G, C.bid);
                pg8::EpiResid E{C.h, HB, SSQ, M, 0.5f};
                pg8::gemm_phase<pg8::EpiResid, pg8::StaticOrder, false, true>(ldsl, g, S, E);
            }
            SEAM(gu + 1);
            if (f == 0) {
                if (EN_G3 && IN(gb + 3)) {
                    pg8::Gemm g{HB, (const bf16*)(args.ws + WS_WIN), M, NPM, D, D}; pg8::StaticOrder S; S.init(M, NPM, C.G, C.bid);
                    pg8::EpiScaleBf16 E{(bf16*)(args.ws + WS_P), NPM, SSQ, M};
                    pg8::gemm_phase<pg8::EpiScaleBf16, pg8::StaticOrder, true, true>(ldsl, g, S, E);
                }
                SEAM(gb + 3);
                if (IN(gb + 4)) { if (EN_MA1) ph_da_prep(fresh(C)); for (int rf = 0; rf < REP_MAFULL; ++rf) { for (int rep = 0; rep < REP_MA; ++rep) { if (EN_MA2) ph_gla_a(fresh(C), ap, l); if (EN_MA3) ph_ssd_a(fresh(C), ap, l); if (EN_MA4) ph_rw_prep(fresh(C), ap, l); } if (EN_MA4 && RW_CHUNKED) ph_rw_chunk(fresh(C), C.bid); } }
                SEAM(gb + 4);
                if (IN(gb + 5)) {
#if RW_CHUNKED
#define MB_SCANS() do { if (EN_MB2) { if (C.bid < 16) rw_scan_unit(fresh(C), C.bid); else { for (int p = C.bid - 16; p < 384; p += C.G - 16) { if (p < 128) gla_scan_part(fresh(C), p); else ssd_scan_part(fresh(C), p - 128); } } } } while (0)
                    MB_SCANS();
                    for (int rs = 1; rs < REP_SCANS; ++rs) {
                        xcd_barrier(bar); if (EN_MA2) ph_gla_a(fresh(C), ap, l); if (EN_MA3) ph_ssd_a(fresh(C), ap, l); if (EN_MA4) { ph_rw_prep(fresh(C), ap, l); ph_rw_chunk(fresh(C), C.bid); } xcd_barrier(bar); MB_SCANS(); }
                    if (C.bid >= 16) { const int a = C.bid - 16; for (int rep = 0; rep < REP_ATTN; ++rep) if (EN_MB1) ph_da_attn(fresh(C), args, l, a & 7, a >> 3); }
#else
                    if (C.bid < 64) { if (EN_MB2) { const int xcd = C.bid & 7, slot = C.bid >> 3; for (int rep = 0; rep < REP_RWC; ++rep) rw_unit(fresh(C), xcd * 2 + (slot >> 2), slot & 3); } }
                    else { const int a = C.bid - 64;
                        if (EN_MB2) { for (int p = a; p < 384; p += 192) { if (p < 128) gla_scan_part(fresh(C), p); else ssd_scan_part(fresh(C), p - 128); } }
                        for (int rep = 0; rep < REP_ATTN; ++rep) if (EN_MB1) ph_da_attn(fresh(C), args, l, a & 7, a >> 3); }
#endif
                }
                SEAM(gb + 5);
                if (IN(gb + 6)) { for (int rep = 0; rep < REP_MC; ++rep) { if (EN_MC1) ph_gla_c(fresh(C), ap, l); if (EN_MC2) ph_ssd_c(fresh(C), ap, l); if (EN_MC3) ph_rw_out(fresh(C), ap, l); } }
                SEAM(gb + 6);
                if (EN_G7 && IN(gb + 7)) {
                    pg8::Gemm g{HB, (const bf16*)(args.ws + WS_WIN) + (size_t)NPM * D, M, 4096, D, D}; pg8::StaticOrder S; S.init(M, 4096, C.G, C.bid);
                    pg8::EpiScaleBf16 E{(bf16*)(args.ws + WS_PG), 4096, SSQ, M};
                    pg8::gemm_phase<pg8::EpiScaleBf16, pg8::StaticOrder, true, true>(ldsl, g, S, E);
                }
                SEAM(gb + 7);
                if (EN_G8 && IN(gb + 8)) {
                    pg8::Gemm g{(const bf16*)(args.ws + WS_YS), (const bf16*)(args.ws + WS_WB), M, D, 512, 2048}; pg8::GroupedOrder S; S.init(M, D, 4, 512, C.G, C.bid);
                    pg8::EpiGateAcc E{(bf16*)(args.ws + WS_MERGED), (const bf16*)(args.ws + WS_PG), args.in[33] + (size_t)l * 4096};
                    pg8::gemm_phase<pg8::EpiGateAcc, pg8::GroupedOrder, true, true>(ldsl, g, S, E);
                }
                SEAM(gb + 8);
                if (EN_G9 && IN(gb + 9)) {
                    pg8::Gemm g{(const bf16*)(args.ws + WS_MERGED), (const bf16*)(args.ws + WS_WO), M, D, D, D}; pg8::StaticOrder S; S.init(M, D, C.G, C.bid);
                    pg8::EpiResid E{C.h, HB, SSQ, M, 1.0f};
                    pg8::gemm_phase<pg8::EpiResid, pg8::StaticOrder, false, true>(ldsl, g, S, E);
                }
                SEAM(gb + 9);
            }
        }
    }
    if (EN_FIN && IN(G_FINAL)) ph_final(fresh(C), ap);
#undef IN
#undef SEAM
}

#ifndef ONE_LAUNCH
#define ONE_LAUNCH 1
#endif
extern "C" void kernel_launch(void* const* d_in, const int* in_sizes, int n_in, void* d_out, int out_size, void* d_ws, size_t ws_size, hipStream_t stream) {
    static int grid = 0;
    if (grid == 0) {
        if (n_in != 40 || in_sizes[0] != M * D || out_size != M * D || ws_size < WS_END) { fprintf(stderr, "kernel_launch: unexpected shapes (n_in %d, in0 %d, out %d, ws %zu < %zu); nothing launched\n", n_in, n_in > 0 ? in_sizes[0] : -1, out_size, ws_size, (size_t)WS_END); grid = -1; return; }
        int dev = 0, cus = 0, per_cu = 0;
        if (hipGetDevice(&dev) != hipSuccess || hipDeviceGetAttribute(&cus, hipDeviceAttributeMultiprocessorCount, dev) != hipSuccess) { grid = -1; return; }
#if ONE_LAUNCH
        if (hipFuncSetAttribute((const void*)hybrid_fwd<-1>, hipFuncAttributeMaxDynamicSharedMemorySize, LDS_BYTES) != hipSuccess) { fprintf(stderr, "kernel_launch: hipFuncSetAttribute failed\n"); grid = -1; return; }
#else
        if (hipFuncSetAttribute((const void*)hybrid_fwd<0>, hipFuncAttributeMaxDynamicSharedMemorySize, LDS_BYTES) != hipSuccess || hipFuncSetAttribute((const void*)hybrid_fwd<1>, hipFuncAttributeMaxDynamicSharedMemorySize, LDS_BYTES) != hipSuccess ||
            hipFuncSetAttribute((const void*)hybrid_fwd<2>, hipFuncAttributeMaxDynamicSharedMemorySize, LDS_BYTES) != hipSuccess || hipFuncSetAttribute((const void*)hybrid_fwd<3>, hipFuncAttributeMaxDynamicSharedMemorySize, LDS_BYTES) != hipSuccess) { fprintf(stderr, "kernel_launch: hipFuncSetAttribute failed\n"); grid = -1; return; }
#endif
        if (hipOccupancyMaxActiveBlocksPerMultiprocessor(&per_cu, (const void*)hybrid_fwd<(ONE_LAUNCH ? -1 : 0)>, NTHR, LDS_BYTES) != hipSuccess || per_cu < 1) fprintf(stderr, "kernel_launch: occupancy query reports %d workgroups per CU\n", per_cu);
        (void)hipGetLastError();
        grid = cus;
        if (grid != 256) { fprintf(stderr, "kernel_launch: %d CUs; this kernel is laid out for 256 workgroups; nothing launched\n", grid); grid = -1; return; }
    }
    if (grid < 0) return;
    if (hipMemsetAsync((char*)d_ws + WS_CTL, 0, CTL_ZERO_BYTES, stream) != hipSuccess) return;
    Args a{};
    for (int i = 0; i < 40; ++i) a.in[i] = (const float*)d_in[i];
    a.out = (float*)d_out; a.ws = (unsigned char*)d_ws;
    for (int j = 0; j < 32; ++j) a.inv_freq[j] = (float)pow(10000.0, -(double)j / 32.0);
#if ONE_LAUNCH
    a.g_lo = 0; a.g_hi = G_END;
    hipLaunchKernelGGL(hybrid_fwd<-1>, dim3(grid), dim3(NTHR), LDS_BYTES, stream, a);
#else
    for (int g = 0; g < G_END; ++g) {
        a.g_lo = g; a.g_hi = g + 1;
        int grp = 1;
        if (g >= 1 && g < G_FINAL) { const int k = (g - 1) % NPH; grp = (k == 0 || k == 4) ? 1 : (k == 5) ? 2 : (k == 6) ? 3 : 0; }
        if (grp == 0) hipLaunchKernelGGL(hybrid_fwd<0>, dim3(grid), dim3(NTHR), LDS_BYTES, stream, a);
        else if (grp == 1) hipLaunchKernelGGL(hybrid_fwd<1>, dim3(grid), dim3(NTHR), LDS_BYTES, stream, a);
        else if (grp == 2) hipLaunchKernelGGL(hybrid_fwd<2>, dim3(grid), dim3(NTHR), LDS_BYTES, stream, a);
        else hipLaunchKernelGGL(hybrid_fwd<3>, dim3(grid), dim3(NTHR), LDS_BYTES, stream, a);
    }
#endif
}
```

```cpp
#include <hip/hip_runtime.h>
#include <cstdio>
#include <cstdint>
#include <cmath>

namespace pg8 {
#define PG8_LAS __attribute__((address_space(3)))
typedef unsigned short bf16_t;
typedef short bf16x8 __attribute__((ext_vector_type(8)));
typedef float f32x4 __attribute__((ext_vector_type(4)));
typedef unsigned u32x4 __attribute__((ext_vector_type(4)));
constexpr int BM = 256, BK = 64, HALF = 128, HTB = HALF * BK * 2  , STAGE_BYTES = 8 * HTB, NXCD = 8, WGM = 8;

__host__ __device__ __forceinline__ int lds_byte(int r, int c) { const int st = (r >> 4) * 2 + (c >> 5), rr = r & 15, cc = c & 31, ob = rr * 64 + cc * 2; return st * 1024 + (ob ^ (((ob >> 9) & 1) << 5)); }
__host__ __device__ __forceinline__ void stage_rc(int b, int& R, int& C) { const int st = b / 1024, sb = b % 1024, swz = sb ^ (((sb >> 9) & 1) << 5); R = (st >> 1) * 16 + swz / 64; C = (st & 1) * 32 + (swz % 64) / 2; }
__host__ __device__ __forceinline__ int perm32(int rho) { const int n = rho >> 4, i = rho & 15; return 8 * (i >> 2) + 4 * n + (i & 3); }

struct Unit { int pm, pn, z; };
struct Gemm { const bf16_t* A; const bf16_t* Bt; int M, N, K, lda; };

struct StaticOrder {
    int nM, nN, nwg, G, c;
    __host__ __device__ void init(int M, int N, int G_, int c_) { nM = M / BM; nN = N / BM; nwg = nM * nN; G = G_; c = c_; }
    __host__ __device__ bool next(int i, Unit& u) const {
        const long L = (long)i * G + c; if (L >= nwg) return false;
        int wgid = (int)L; { const int q = nwg / NXCD, r = nwg % NXCD, xcd = wgid % NXCD, off = wgid / NXCD; wgid = (xcd < r ? xcd * (q + 1) : r * (q + 1) + (xcd - r) * q) + off; }
        const int nig = WGM * nN, gid = wgid / nig, fm = gid * WGM, gsz = (nM - fm) < WGM ? (nM - fm) : WGM;
        u.pm = fm + ((wgid % nig) % gsz); u.pn = (wgid % nig) / gsz; u.z = 0; return true;
    }
    __device__ __forceinline__ void a_ready(const Unit&) const {}
    __device__ __forceinline__ void done(const Unit&) const {}
    __device__ __forceinline__ size_t a_off(const Unit&) const { return 0; }
    __device__ __forceinline__ int b_tile(const Unit& u) const { return u.pn; }
};
struct GroupedOrder {
    StaticOrder base; int NZ, Kbytes, tiles_per_group;
    __device__ void init(int M, int N, int NZ_, int K, int G_, int c_) { base.init(M, N, G_, c_); NZ = NZ_; Kbytes = K * 2; tiles_per_group = N / BM; }
    __device__ bool next(int i, Unit& u) const { const int r = i / NZ, z = i - r * NZ; if (!base.next(r, u)) return false; u.z = z; return true; }
    __device__ __forceinline__ void a_ready(const Unit&) const {}
    __device__ __forceinline__ void done(const Unit&) const {}
    __device__ __forceinline__ size_t a_off(const Unit& u) const { return (size_t)u.z * Kbytes; }
    __device__ __forceinline__ int b_tile(const Unit& u) const { return u.z * tiles_per_group + u.pn; }
};

__device__ __forceinline__ unsigned cvt_pk_bf16(float lo, float hi) { unsigned r; asm volatile("v_cvt_pk_bf16_f32 %0, %1, %2" : "=v"(r) : "v"(lo), "v"(hi)); return r; }
__device__ __forceinline__ float bf_lo(unsigned w) { return __uint_as_float(w << 16); }
__device__ __forceinline__ float bf_hi(unsigned w) { return __uint_as_float(w & 0xffff0000u); }
__device__ __forceinline__ float fast_sigmoid(float x) { return __builtin_amdgcn_rcpf(1.0f + __builtin_amdgcn_exp2f(-1.4426950408889634f * x)); }

__device__ __forceinline__ float row_rstd(const float* ssq, int row, int M_) {
    const float s = (ssq[row] + ssq[M_ + row]) + (ssq[2 * M_ + row] + ssq[3 * M_ + row]);
    return 1.0f / sqrtf(s * (1.0f / 1024.0f) + 1e-6f);
}
struct EpiScaleBf16 {
    static constexpr bool PERM = true, AFTER_DRAIN = false;
    bf16_t* O; int ldc; const float* ssq; int M_;
    __device__ __forceinline__ void operator()(const f32x4 (&acc)[2][2][4][2], const Unit& u, int wr, int wc, int fr, int fq) const {
        const int row0 = u.pm * BM + wr * 64 + fr; const int col0 = u.pn * BM + wc * 32 + 8 * fq;
#pragma unroll
        for (int ai = 0; ai < 2; ++ai)
#pragma unroll
            for (int m = 0; m < 4; ++m) { const int row = row0 + ai * HALF + m * 16; const float rs = row_rstd(ssq, row, M_); bf16_t* rowp = O + (size_t)row * ldc + col0;
#pragma unroll
                for (int bj = 0; bj < 2; ++bj) { const f32x4 v0 = acc[ai][bj][m][0] * rs, v1 = acc[ai][bj][m][1] * rs;
                    u32x4 w; w.x = cvt_pk_bf16(v0[0], v0[1]); w.y = cvt_pk_bf16(v0[2], v0[3]); w.z = cvt_pk_bf16(v1[0], v1[1]); w.w = cvt_pk_bf16(v1[2], v1[3]);
                    *(u32x4*)(rowp + bj * HALF) = w; } }
    }
};
struct EpiSwiglu {
    static constexpr bool PERM = true, AFTER_DRAIN = false;
    bf16_t* O; int ldc; const float* ssq; int M_;
    __device__ __forceinline__ void operator()(const f32x4 (&acc)[2][2][4][2], const Unit& u, int wr, int wc, int fr, int fq) const {
        const int row0 = u.pm * BM + wr * 64 + fr; const int col0 = u.pn * HALF + wc * 32 + 8 * fq;
#pragma unroll
        for (int ai = 0; ai < 2; ++ai)
#pragma unroll
            for (int m = 0; m < 4; ++m) { const int row = row0 + ai * HALF + m * 16; const float rs = row_rstd(ssq, row, M_); bf16_t* rowp = O + (size_t)row * ldc + col0;
                float o[8];
#pragma unroll
                for (int n = 0; n < 2; ++n)
#pragma unroll
                    for (int i = 0; i < 4; ++i) { const float g = acc[ai][0][m][n][i] * rs, up = acc[ai][1][m][n][i] * rs; o[n * 4 + i] = g * fast_sigmoid(g) * up; }
                u32x4 w; w.x = cvt_pk_bf16(o[0], o[1]); w.y = cvt_pk_bf16(o[2], o[3]); w.z = cvt_pk_bf16(o[4], o[5]); w.w = cvt_pk_bf16(o[6], o[7]);
                *(u32x4*)rowp = w; }
    }
};
struct EpiGateAcc {
    static constexpr bool PERM = true, AFTER_DRAIN = false;
    bf16_t* O; const bf16_t* PG; const float* gb;
    __device__ __forceinline__ void operator()(const f32x4 (&acc)[2][2][4][2], const Unit& u, int wr, int wc, int fr, int fq) const {
        const int row0 = u.pm * BM + wr * 64 + fr; const int col0 = u.pn * BM + wc * 32 + 8 * fq; const int z = u.z;
        f32x4 gbv[2][2];
#pragma unroll
        for (int bj = 0; bj < 2; ++bj)
#pragma unroll
            for (int n = 0; n < 2; ++n) gbv[bj][n] = *(const f32x4*)(gb + z * 1024 + col0 + bj * HALF + 4 * n);
#pragma unroll
        for (int ai = 0; ai < 2; ++ai)
#pragma unroll
            for (int m = 0; m < 4; ++m) { const int row = row0 + ai * HALF + m * 16;
#pragma unroll
                for (int bj = 0; bj < 2; ++bj) {
                    const u32x4 pg = *(const u32x4*)(PG + (size_t)row * 4096 + z * 1024 + col0 + bj * HALF);
                    bf16_t* op = O + (size_t)row * 1024 + col0 + bj * HALF;
                    float o[8];
                    o[0] = fast_sigmoid(bf_lo(pg.x) + gbv[bj][0][0]) * acc[ai][bj][m][0][0]; o[1] = fast_sigmoid(bf_hi(pg.x) + gbv[bj][0][1]) * acc[ai][bj][m][0][1];
                    o[2] = fast_sigmoid(bf_lo(pg.y) + gbv[bj][0][2]) * acc[ai][bj][m][0][2]; o[3] = fast_sigmoid(bf_hi(pg.y) + gbv[bj][0][3]) * acc[ai][bj][m][0][3];
                    o[4] = fast_sigmoid(bf_lo(pg.z) + gbv[bj][1][0]) * acc[ai][bj][m][1][0]; o[5] = fast_sigmoid(bf_hi(pg.z) + gbv[bj][1][1]) * acc[ai][bj][m][1][1];
                    o[6] = fast_sigmoid(bf_lo(pg.w) + gbv[bj][1][2]) * acc[ai][bj][m][1][2]; o[7] = fast_sigmoid(bf_hi(pg.w) + gbv[bj][1][3]) * acc[ai][bj][m][1][3];
                    if (z > 0) { const u32x4 pv = *(const u32x4*)op;
                        o[0] += bf_lo(pv.x); o[1] += bf_hi(pv.x); o[2] += bf_lo(pv.y); o[3] += bf_hi(pv.y); o[4] += bf_lo(pv.z); o[5] += bf_hi(pv.z); o[6] += bf_lo(pv.w); o[7] += bf_hi(pv.w); }
                    u32x4 w; w.x = cvt_pk_bf16(o[0], o[1]); w.y = cvt_pk_bf16(o[2], o[3]); w.z = cvt_pk_bf16(o[4], o[5]); w.w = cvt_pk_bf16(o[6], o[7]);
                    *(u32x4*)op = w; } }
    }
};
struct EpiResid {
    static constexpr bool PERM = true, AFTER_DRAIN = true;
    float* H; bf16_t* HB; float* ssq; int M_; float s;
    __device__ __forceinline__ void fused(f32x4 (&acc)[2][2][4][2], const Unit& u, int wr, int wc, int fr, int fq, PG8_LAS unsigned char* lds, int wid, int lane) const {
        PG8_LAS float* P = (PG8_LAS float*)lds;
        const int row0 = u.pm * BM + wr * 64 + fr; const int col0 = u.pn * BM + wc * 32 + 8 * fq;
#pragma unroll
        for (int ai = 0; ai < 2; ++ai)
#pragma unroll
            for (int m = 0; m < 4; ++m) { const int row = row0 + ai * HALF + m * 16; float q = 0.f;
#pragma unroll
                for (int bj = 0; bj < 2; ++bj) { float* hp = H + (size_t)row * 1024 + col0 + bj * HALF;
                    const f32x4 h0 = *(const f32x4*)hp + acc[ai][bj][m][0] * s, h1 = *(const f32x4*)(hp + 4) + acc[ai][bj][m][1] * s;
                    *(f32x4*)hp = h0; *(f32x4*)(hp + 4) = h1;
                    q += (h0[0] * h0[0] + h0[1] * h0[1]) + (h0[2] * h0[2] + h0[3] * h0[3]) + (h1[0] * h1[0] + h1[1] * h1[1]) + (h1[2] * h1[2] + h1[3] * h1[3]);
                    u32x4 w; w.x = cvt_pk_bf16(h0[0], h0[1]); w.y = cvt_pk_bf16(h0[2], h0[3]); w.z = cvt_pk_bf16(h1[0], h1[1]); w.w = cvt_pk_bf16(h1[2], h1[3]);
                    *(u32x4*)(HB + (size_t)row * 1024 + col0 + bj * HALF) = w; }
                q += __shfl_xor(q, 16); q += __shfl_xor(q, 32);
                if (fq == 0) P[(ai * HALF + wr * 64 + m * 16 + fr) * 4 + wc] = q; }
        asm volatile("s_waitcnt lgkmcnt(0)" ::: "memory"); __builtin_amdgcn_s_barrier(); asm volatile("" ::: "memory");
        const int t = wid * 64 + lane;
        if (t < 256) { const float q = (P[t * 4 + 0] + P[t * 4 + 1]) + (P[t * 4 + 2] + P[t * 4 + 3]); ssq[(size_t)u.pn * M_ + u.pm * BM + t] = q; }
        asm volatile("s_waitcnt lgkmcnt(0)" ::: "memory"); __builtin_amdgcn_s_barrier(); asm volatile("" ::: "memory");
    }
};
template <class Epi, class Sched, bool ALIGN_EPI = false, bool SP2 = false>
__device__ __forceinline__ void gemm_phase(PG8_LAS unsigned char* lds, const Gemm g, const Sched& S, const Epi& E) {
    int tid_ = threadIdx.x; asm volatile("" : "+v"(tid_)); const int tid = tid_, wid = __builtin_amdgcn_readfirstlane(tid >> 6), lane = tid & 63, wr = wid >> 2, wc = wid & 3, fr = lane & 15, fq = lane >> 4;
    const int K = g.K, nt = K / BK;
    unsigned voffA[2], voffB[2];
#pragma unroll
    for (int i = 0; i < 2; ++i) { int R, C; stage_rc(tid * 16 + i * 8192, R, C); const int Rb = Epi::PERM ? ((R & ~31) + perm32(R & 31)) : R;
        voffA[i] = (unsigned)(R * g.lda + C) * 2u; voffB[i] = (unsigned)(Rb * K + C) * 2u; }
    const size_t kstep = (size_t)(BK * 2);
    const size_t hstep = (size_t)HALF * K * 2;
    const size_t tstep = 2 * hstep; const size_t hstepA = (size_t)HALF * g.lda * 2, tstepA = 2 * hstepA;
    const unsigned ldsw = (unsigned)wid * 1024u;
    const int aoff = lds_byte(wr * 64 + fr, fq * 8), boff = lds_byte(wc * 32 + fr, fq * 8);
#define PG8_SA(b, h) (((b) * 2 + (h)) * HTB)
#define PG8_SB(b, h) ((4 + (b) * 2 + (h)) * HTB)
#define PG8_STAGE(bufoff, gbase, voff) do { _Pragma("unroll") for (int _i = 0; _i < 2; ++_i) \
        __builtin_amdgcn_global_load_lds((const unsigned*)((const char*)(gbase) + (voff)[_i]), (PG8_LAS unsigned*)(lds + (bufoff) + ldsw + _i * 8192), 16, 0, 0); } while (0)
#define PG8_LDA(dst, b, h) do { _Pragma("unroll") for (int m = 0; m < 4; ++m) _Pragma("unroll") for (int k = 0; k < 2; ++k) dst[m][k] = *(const PG8_LAS bf16x8*)(lds + PG8_SA(b, h) + aoff + m * 2048 + k * 1024); } while (0)
#define PG8_LDB(dst, b, h) do { _Pragma("unroll") for (int n = 0; n < 2; ++n) _Pragma("unroll") for (int k = 0; k < 2; ++k) dst[n][k] = *(const PG8_LAS bf16x8*)(lds + PG8_SB(b, h) + boff + n * 2048 + k * 1024); } while (0)
#define PG8_MMA(ai, bj, At, Bt) do { __builtin_amdgcn_s_setprio(1); _Pragma("unroll") for (int m = 0; m < 4; ++m) _Pragma("unroll") for (int n = 0; n < 2; ++n) _Pragma("unroll") for (int k = 0; k < 2; ++k) \
        acc[ai][bj][m][n] = __builtin_amdgcn_mfma_f32_16x16x32_bf16(Bt[n][k], At[m][k], acc[ai][bj][m][n], 0, 0, 0); __builtin_amdgcn_s_setprio(0); } while (0)
#define PG8_WAIT_V(n) asm volatile("s_waitcnt vmcnt(" #n ")" ::: "memory")
#define PG8_WAIT_L(n) asm volatile("s_waitcnt lgkmcnt(" #n ")" ::: "memory")
#define PG8_BAR __builtin_amdgcn_s_barrier()
#define PG8_SCHED __builtin_amdgcn_sched_barrier(0)
    Unit cur, nxt; int ui = 0;
    if (!S.next(0, cur)) return;
    f32x4 acc[2][2][4][2];
#pragma unroll
    for (int a = 0; a < 2; ++a)
#pragma unroll
        for (int b = 0; b < 2; ++b)
#pragma unroll
            for (int m = 0; m < 4; ++m)
#pragma unroll
                for (int n = 0; n < 2; ++n) acc[a][b][m][n] = (f32x4){0.f, 0.f, 0.f, 0.f};
    bf16x8 At[4][2], B0[2][2], B1[2][2];
    const char* cA = (const char*)g.A + (size_t)cur.pm * tstepA + S.a_off(cur); const char* cB = (const char*)g.Bt + (size_t)S.b_tile(cur) * tstep;
    S.a_ready(cur);
    if constexpr (SP2) {
        PG8_STAGE(PG8_SB(0, 0), cB, voffB); PG8_STAGE(PG8_SB(0, 1), cB + hstep, voffB); PG8_STAGE(PG8_SA(0, 0), cA, voffA); PG8_STAGE(PG8_SA(0, 1), cA + hstepA, voffA);
        if (wr == 1) PG8_BAR;
        PG8_WAIT_V(2); PG8_BAR;
        PG8_STAGE(PG8_SB(1, 0), cB + kstep, voffB); PG8_STAGE(PG8_SA(1, 0), cA + kstep, voffA); PG8_STAGE(PG8_SB(1, 1), cB + hstep + kstep, voffB);
        PG8_WAIT_V(6); PG8_BAR;
    } else {
        PG8_STAGE(PG8_SB(0, 0), cB, voffB); PG8_STAGE(PG8_SA(0, 0), cA, voffA); PG8_STAGE(PG8_SB(0, 1), cB + hstep, voffB); PG8_STAGE(PG8_SA(0, 1), cA + hstepA, voffA);
        if (wr == 1) PG8_BAR;
        PG8_WAIT_V(4); PG8_BAR;
        PG8_STAGE(PG8_SB(1, 0), cB + kstep, voffB); PG8_STAGE(PG8_SA(1, 0), cA + kstep, voffA); PG8_STAGE(PG8_SB(1, 1), cB + hstep + kstep, voffB);
        PG8_WAIT_V(6); PG8_BAR;
    }
    for (;;) {
        const bool has_next = S.next(ui + 1, nxt);
        const char* nA = has_next ? (const char*)g.A + (size_t)nxt.pm * tstepA + S.a_off(nxt) : cA; const char* nB = has_next ? (const char*)g.Bt + (size_t)S.b_tile(nxt) * tstep : cB;
        for (int t = 0; t < nt; t += 2) {
            const bool last = (t == nt - 2);
            const char* a1 = cA + (size_t)(t + 1) * kstep;
            const char* a2 = last ? nA : cA + (size_t)(t + 2) * kstep; const char* b2 = last ? nB : cB + (size_t)(t + 2) * kstep;
            const char* a3 = a2 + kstep; const char* b3 = b2 + kstep;
            if (last && has_next) S.a_ready(nxt);
            if constexpr (SP2) {
            PG8_LDB(B0, 0, 0); PG8_LDB(B1, 0, 1); PG8_SCHED; PG8_LDA(At, 0, 0); PG8_STAGE(PG8_SA(1, 1), a1 + hstepA, voffA);
            PG8_WAIT_V(8); PG8_WAIT_L(0); PG8_BAR; PG8_MMA(0, 0, At, B0); PG8_MMA(0, 1, At, B1); PG8_BAR; PG8_SCHED;
            PG8_LDA(At, 0, 1); PG8_STAGE(PG8_SB(0, 0), b2, voffB); PG8_STAGE(PG8_SB(0, 1), b2 + hstep, voffB); PG8_STAGE(PG8_SA(0, 0), a2, voffA);
            PG8_WAIT_V(8); PG8_WAIT_L(0); PG8_BAR; PG8_MMA(1, 0, At, B0); PG8_MMA(1, 1, At, B1); PG8_BAR; PG8_SCHED;
            PG8_LDB(B0, 1, 0); PG8_LDB(B1, 1, 1); PG8_SCHED; PG8_LDA(At, 1, 0); PG8_STAGE(PG8_SA(0, 1), a2 + hstepA, voffA);
            PG8_WAIT_V(8); PG8_WAIT_L(0); PG8_BAR; PG8_MMA(0, 0, At, B0); PG8_MMA(0, 1, At, B1); PG8_BAR; PG8_SCHED;
            PG8_LDA(At, 1, 1); PG8_STAGE(PG8_SB(1, 0), b3, voffB); PG8_STAGE(PG8_SB(1, 1), b3 + hstep, voffB); PG8_STAGE(PG8_SA(1, 0), a3, voffA);
            PG8_WAIT_V(8); PG8_WAIT_L(0); PG8_BAR; PG8_MMA(1, 0, At, B0); PG8_MMA(1, 1, At, B1); PG8_BAR; PG8_SCHED;
            } else {
            PG8_LDB(B0, 0, 0); PG8_SCHED; PG8_LDA(At, 0, 0); PG8_STAGE(PG8_SA(1, 1), a1 + hstepA, voffA);
            PG8_WAIT_L(8); PG8_BAR; PG8_WAIT_L(0); PG8_MMA(0, 0, At, B0); PG8_BAR; PG8_SCHED;
            PG8_LDB(B1, 0, 1); PG8_STAGE(PG8_SB(0, 0), b2, voffB);
            PG8_BAR; PG8_WAIT_L(0); PG8_MMA(0, 1, At, B1); PG8_BAR;
            PG8_LDA(At, 0, 1); PG8_STAGE(PG8_SA(0, 0), a2, voffA);
            PG8_BAR; PG8_WAIT_L(0); PG8_MMA(1, 0, At, B0); PG8_BAR; PG8_SCHED;
            PG8_STAGE(PG8_SB(0, 1), b2 + hstep, voffB);
            PG8_WAIT_V(6); PG8_BAR; PG8_MMA(1, 1, At, B1); PG8_BAR;
            PG8_LDB(B0, 1, 0); PG8_SCHED; PG8_LDA(At, 1, 0); PG8_STAGE(PG8_SA(0, 1), a2 + hstepA, voffA);
            PG8_WAIT_L(8); PG8_BAR; PG8_WAIT_L(0); PG8_MMA(0, 0, At, B0); PG8_BAR; PG8_SCHED;
            PG8_LDB(B1, 1, 1); PG8_STAGE(PG8_SB(1, 0), b3, voffB);
            PG8_BAR; PG8_WAIT_L(0); PG8_MMA(0, 1, At, B1); PG8_BAR;
            PG8_LDA(At, 1, 1); PG8_STAGE(PG8_SA(1, 0), a3, voffA);
            PG8_BAR; PG8_WAIT_L(0); PG8_MMA(1, 0, At, B0); PG8_BAR; PG8_SCHED;
            PG8_STAGE(PG8_SB(1, 1), b3 + hstep, voffB);
            PG8_WAIT_V(6); PG8_BAR; PG8_MMA(1, 1, At, B1); PG8_BAR;
            }
        }
        if constexpr (ALIGN_EPI) { if (wr == 0) PG8_BAR; }
        if constexpr (!Epi::AFTER_DRAIN) { E(acc, cur, wr, wc, fr, fq); S.done(cur); }
        if (!has_next) break;
#pragma unroll
        for (int a = 0; a < 2; ++a)
#pragma unroll
            for (int b = 0; b < 2; ++b)
#pragma unroll
                for (int m = 0; m < 4; ++m)
#pragma unroll
                    for (int n = 0; n < 2; ++n) acc[a][b][m][n] = (f32x4){0.f, 0.f, 0.f, 0.f};
        cur = nxt; cA = nA; cB = nB; ++ui;
        if constexpr (ALIGN_EPI) { if (wr == 1) PG8_BAR; }
    }
    PG8_WAIT_V(0);
    if constexpr (!ALIGN_EPI) { if (wr == 0) PG8_BAR; }
    PG8_BAR;
    if constexpr (Epi::AFTER_DRAIN) { E.fused(acc, cur, wr, wc, fr, fq, lds, wid, lane); S.done(cur); }
#undef PG8_SA
#undef PG8_SB
#undef PG8_STAGE
#undef PG8_LDA
#undef PG8_LDB
#undef PG8_MMA
#undef PG8_WAIT_V
#undef PG8_WAIT_L
#undef PG8_BAR
#undef PG8_SCHED
}
}

constexpr int NWAVES = 8, NTHR = 512;
constexpr int M = 16384, SEQ = 8192, D = 1024, FF = 2816, NL = 4, NCH = 128  , NBC = 256  ;
constexpr int NPM = 6656;
constexpr int NWIN = 10752;
constexpr int C_DAQ = 0, C_DAK = 512, C_DAV = 1024, C_GQ = 1536, C_GK = 1792, C_GV = 2048, C_GOG = 2560, C_SZ = 3072, C_SX = 3584, C_SB = 4096, C_SC = 4352,
              C_RR = 4608, C_RK = 5120, C_RV = 5632, C_RWL = 6144, C_RAL = 6208, C_RGL = 6272, C_GLR = 6400, C_SDT = 6416;
constexpr float EPS = 1e-6f, LOG2E = 1.4426950408889634f;

constexpr size_t MiB = 1u << 20;
constexpr size_t WS_CTL = 0, CTL_ZERO_BYTES = 1 * MiB;
constexpr size_t WS_COS = 1 * MiB, WS_SIN = 2 * MiB, WS_SSQ = 3 * MiB, WS_GLAST = 3 * MiB + 512 * 1024, WS_SDT = 4 * MiB, WS_SACUM = 4 * MiB + 512 * 1024, WS_SCDEC = 5 * MiB, WS_RW2T = 5 * MiB + 64 * 1024;
constexpr size_t WS_WGU1 = 8 * MiB, WS_WD1 = 19 * MiB, WS_WIN = 24 * MiB + 512 * 1024, WS_WB = 45 * MiB + 512 * 1024, WS_WO = 49 * MiB + 512 * 1024, WS_WGU2 = 51 * MiB + 512 * 1024, WS_WD2 = 62 * MiB + 512 * 1024;
constexpr size_t WS_HB = 68 * MiB, WS_P = 100 * MiB, WS_PG = 100 * MiB, WS_YS = 308 * MiB, WS_R1 = 372 * MiB, WS_R2 = 500 * MiB, WS_END = 644 * MiB;
constexpr size_t WS_ACT = WS_R1, WS_MERGED = WS_R1;
constexpr size_t WS_RWW = WS_R1, WS_RWR = WS_R1 + 32 * MiB, WS_RWK = WS_R1 + 48 * MiB, WS_RWV = WS_R1 + 64 * MiB, WS_RWKK = WS_R1 + 80 * MiB, WS_RWB = WS_R1 + 96 * MiB, WS_RWG = WS_R1 + 112 * MiB;
constexpr size_t WS_VT = WS_R2, WS_GKV = WS_R2 + 16 * MiB, WS_SST = WS_R2 + 48 * MiB, WS_RWY = WS_R2 + 112 * MiB;
static_assert(WS_WD2 + (size_t)D * FF * 2 <= WS_HB && WS_P + (size_t)M * NPM * 2 <= WS_YS && WS_RWY + (size_t)M * 512 * 2 <= WS_END, "d_ws map");
constexpr int CW_BAR = 4096;

constexpr int RING_BYTES = 131072, LDSCTL_OFF = RING_BYTES, MISC_OFF = LDSCTL_OFF + 320, LDS_BYTES = 147456;

#define GAS __attribute__((address_space(1)))
#define LAS __attribute__((address_space(3)))
typedef unsigned short bf16;
typedef unsigned v4u __attribute__((ext_vector_type(4)));
typedef float f32x4 __attribute__((ext_vector_type(4)));
typedef short bf16x8 __attribute__((ext_vector_type(8)));
typedef GAS unsigned gu32;
typedef GAS unsigned long long gu64;
#define RLX_AGENT __ATOMIC_RELAXED, __HIP_MEMORY_SCOPE_AGENT
#define LDS_WAIT() asm volatile("s_waitcnt lgkmcnt(0)" ::: "memory")
#define VM_WAIT() asm volatile("s_waitcnt vmcnt(0)" ::: "memory")
__device__ __forceinline__ unsigned long long rt() { return __builtin_amdgcn_s_memrealtime(); }
__device__ __forceinline__ unsigned f2bf(float f) { unsigned u = __builtin_bit_cast(unsigned, f); return (u + 0x7fffu + ((u >> 16) & 1u)) >> 16; }
__device__ __forceinline__ unsigned pk2(float lo, float hi) { return f2bf(lo) | (f2bf(hi) << 16); }

#define XB_TMO      128
#define XB_XCNT(j)  (256  + 64 * (j))
#define XB_XSUB(j)  (1280 + 64 * (j))
#define XB_XGEN(j)  (2304 + 64 * (j))
#define XB_TOP      3328
#define XB_TOPGEN   3392
#define XCD_BAR_WORDS 3456
#define XB_SPIN_CAP (1u << 18)

__device__ __forceinline__ unsigned xb_ld(unsigned* p)              { return __hip_atomic_load(p, __ATOMIC_RELAXED, __HIP_MEMORY_SCOPE_AGENT); }
__device__ __forceinline__ unsigned xb_add(unsigned* p, unsigned v) { return __hip_atomic_fetch_add(p, v, __ATOMIC_RELAXED, __HIP_MEMORY_SCOPE_AGENT); }
__device__ __forceinline__ unsigned xb_xcc_id() { return (unsigned)__builtin_amdgcn_s_getreg((3 << 11) | 20) & 0xFu; }
#define XB_SPIN(cond, bar) do { unsigned _sp = 0; while (cond) { __builtin_amdgcn_s_sleep(1); \
    if ((++_sp & 255u) == 0u) { if (xb_ld(&(bar)[XB_TMO])) break; if (_sp > XB_SPIN_CAP) { atomicAdd(&(bar)[XB_TMO], 1u); break; } } } } while (0)

struct XcdBarrier {
    unsigned* bar; unsigned x;
    volatile LAS unsigned* st;
};

__device__ __forceinline__ XcdBarrier xcd_barrier_post(unsigned* bar, volatile LAS unsigned* st) {
    XcdBarrier b; b.bar = bar; b.x = xb_xcc_id(); b.st = st;
    if (threadIdx.x == 0) (void)xb_add(&bar[XB_XCNT(b.x)], 1u);
    return b;
}
__device__ __forceinline__ void xcd_barrier_complete(unsigned* bar, unsigned x, unsigned& nloc, unsigned& nx) {
    const unsigned G = gridDim.x * gridDim.y * gridDim.z;
    unsigned sum, cnt, mine, sp = 0u;
    for (;;) {
        sum = 0u; cnt = 0u; mine = 0u;
#pragma unroll
        for (unsigned j = 0; j < 16; ++j) { const unsigned c = xb_ld(&bar[XB_XCNT(j)]); sum += c; cnt += (c > 0u) ? 1u : 0u; mine = (j == x) ? c : mine; }
        if (sum == G) break;
        __builtin_amdgcn_s_sleep(1);
        if ((++sp & 255u) == 0u) { if (xb_ld(&bar[XB_TMO])) break; if (sp > XB_SPIN_CAP) { atomicAdd(&bar[XB_TMO], 1u); break; } }
    }
    nloc = mine > 0u ? mine : 1u; nx = cnt > 0u ? cnt : 1u;
}

__device__ __forceinline__ void xcd_barrier(const XcdBarrier& b) {
    asm volatile("s_waitcnt vmcnt(0)" ::: "memory");
    __syncthreads();
    if (threadIdx.x == 0) {
        unsigned* bar = b.bar;
        __builtin_amdgcn_s_waitcnt(0);
        unsigned nloc = b.st[0], nx = b.st[1];
        if (nloc == 0u) { xcd_barrier_complete(bar, b.x, nloc, nx); b.st[0] = nloc; b.st[1] = nx; }
        const unsigned old = xb_add(&bar[XB_XSUB(b.x)], 1u);
        const unsigned gen = old / nloc;
        if (old + 1u == (gen + 1u) * nloc) {
            __builtin_amdgcn_fence(__ATOMIC_RELEASE, "agent");
            asm volatile("s_waitcnt vmcnt(0)" ::: "memory");
            const unsigned og = xb_add(&bar[XB_TOP], 1u);
            const unsigned tg = og / nx;
            if (og + 1u == (tg + 1u) * nx) xb_add(&bar[XB_TOPGEN], 1u);
            else XB_SPIN(xb_ld(&bar[XB_TOPGEN]) == tg, bar);
            __builtin_amdgcn_fence(__ATOMIC_ACQUIRE, "agent");
            xb_add(&bar[XB_XGEN(b.x)], 1u);
            asm volatile("s_waitcnt vmcnt(0)" ::: "memory");
        } else {
            XB_SPIN(xb_ld(&bar[XB_XGEN(b.x)]) == gen, bar);
            __builtin_amdgcn_fence(__ATOMIC_ACQUIRE, "agent");
            asm volatile("s_waitcnt vmcnt(0)" ::: "memory");
        }
    }
    __syncthreads();
}

struct Args { const float* in[40]; float* out; unsigned char* ws; float inv_freq[32]; int g_lo, g_hi; };
typedef const __attribute__((address_space(4))) Args* ArgsP;
typedef LAS float* LF; typedef const LAS float* CLF;
#ifndef PH_FN
#define PH_FN __device__ __noinline__
#endif
#ifndef PH_HEAVY
#define PH_HEAVY __device__ __forceinline__
#endif
struct Ctx {
    LAS unsigned char* lds;
    unsigned char* ws; float* h;
    int tid, lane, wave, bid, G;
};
typedef unsigned u32x4 __attribute__((ext_vector_type(4)));
typedef unsigned u32x2 __attribute__((ext_vector_type(2)));
typedef float f32x2 __attribute__((ext_vector_type(2)));
typedef float f32x16 __attribute__((ext_vector_type(16)));
__device__ __forceinline__ float bf2f(bf16 x) { return __uint_as_float((unsigned)x << 16); }
__device__ __forceinline__ float bflo(unsigned w) { return __uint_as_float(w << 16); }
__device__ __forceinline__ float bfhi(unsigned w) { return __uint_as_float(w & 0xffff0000u); }
__device__ __forceinline__ void unpack8(const u32x4 w, float* o) { o[0] = bflo(w.x); o[1] = bfhi(w.x); o[2] = bflo(w.y); o[3] = bfhi(w.y); o[4] = bflo(w.z); o[5] = bfhi(w.z); o[6] = bflo(w.w); o[7] = bfhi(w.w); }
__device__ __forceinline__ u32x4 pack8(const float* o) { u32x4 w; w.x = pk2(o[0], o[1]); w.y = pk2(o[2], o[3]); w.z = pk2(o[4], o[5]); w.w = pk2(o[6], o[7]); return w; }
__device__ __forceinline__ float sigmoidf_(float x) { return 1.0f / (1.0f + __expf(-x)); }
__device__ __forceinline__ float siluf_(float x) { return x * sigmoidf_(x); }
__device__ __forceinline__ float softplusf_(float x) { return fmaxf(x, 0.f) + log1pf(__expf(-fabsf(x))); }
__device__ __forceinline__ float logsigmoidf_(float x) { return fminf(x, 0.f) - log1pf(__expf(-fabsf(x))); }
__device__ __forceinline__ float wave_sum(float v) {
#pragma unroll
    for (int o = 1; o < 64; o <<= 1) v += __shfl_xor(v, o);
    return v;
}
#define WG_SYNC() __syncthreads()
__device__ __forceinline__ Ctx fresh(const Ctx& C0) { Ctx C = C0; int t = threadIdx.x; asm volatile("" : "+v"(t)); C.tid = t; C.lane = t & 63; C.wave = __builtin_amdgcn_readfirstlane(t >> 6); return C; }

PH_FN void ph_prologue(const Ctx C, ArgsP a) {
    float* cosT = (float*)(C.ws + WS_COS); float* sinT = (float*)(C.ws + WS_SIN);
    for (int idx = C.bid * NTHR + C.tid; idx < SEQ * 32; idx += C.G * NTHR) {
        const int t = idx >> 5, j = idx & 31;
        const float ang = (float)t * a->inv_freq[j];
        const double rev = (double)ang * 0.15915494309189535;
        const float fr = (float)(rev - floor(rev));
        cosT[idx] = __builtin_amdgcn_cosf(fr); sinT[idx] = __builtin_amdgcn_sinf(fr);
    }
    const float* x = a->in[0]; bf16* hb = (bf16*)(C.ws + WS_HB); float* ssq = (float*)(C.ws + WS_SSQ);
    const int gw = C.bid * NWAVES + C.wave, NGW = C.G * NWAVES;
    for (int m = gw; m < M; m += NGW) {
        const f32x4* xr = (const f32x4*)(x + (size_t)m * D) + C.lane; f32x4* hr = (f32x4*)(C.h + (size_t)m * D) + C.lane;
        unsigned long long* o8 = (unsigned long long*)(hb + (size_t)m * D) + C.lane;
        float s = 0.f;
#pragma unroll
        for (int j = 0; j < 4; ++j) { const f32x4 v = xr[64 * j]; hr[64 * j] = v; s += (v.x * v.x + v.y * v.y) + (v.z * v.z + v.w * v.w);
            o8[64 * j] = (unsigned long long)pk2(v.x, v.y) | ((unsigned long long)pk2(v.z, v.w) << 32); }
        s = wave_sum(s);
        if (C.lane == 0) { ssq[m] = s; ssq[M + m] = 0.f; ssq[2 * M + m] = 0.f; ssq[3 * M + m] = 0.f; }
    }
}

template <class SrcF>
__device__ __forceinline__ void tr_item(const SrcF src, const float* gk, bf16* WT, int K, int kb, int nb, LF scr, int lane) {
    const int k0 = 64 * kb, n0 = 32 * nb;
    const int ld = src.ld(); const long co = src.col(n0 + (lane & 31)); const bool ok = co >= 0; const float* colp = src.base(n0 + (lane & 31)) + (ok ? co : 0);
#pragma unroll 8
    for (int i = 0; i < 32; ++i) { const int kk = 2 * i + (lane >> 5); float v = 0.f; if (ok) { v = colp[(size_t)(k0 + kk) * ld]; if (gk) v *= gk[k0 + kk]; } scr[kk * 33 + (lane & 31)] = v; }
    LDS_WAIT(); asm volatile("" ::: "memory");
    const int c = lane & 7;
#pragma unroll
    for (int j = 0; j < 4; ++j) { const int n = (lane >> 3) + 8 * j; CLF s = scr + (8 * c) * 33 + n;
        v4u o; o.x = pk2(s[0 * 33], s[1 * 33]); o.y = pk2(s[2 * 33], s[3 * 33]); o.z = pk2(s[4 * 33], s[5 * 33]); o.w = pk2(s[6 * 33], s[7 * 33]);
        *(v4u*)(WT + (size_t)(n0 + n) * K + k0 + 8 * c) = o; }
    LDS_WAIT(); asm volatile("" ::: "memory");
}
struct SrcGU { const float* wg; const float* wu;
    __device__ __forceinline__ int ld() const { return FF; }
    __device__ __forceinline__ const float* base(int n) const { const uintptr_t sel = (uintptr_t)((n >> 7) & 1); return (const float*)((uintptr_t)wg + sel * ((uintptr_t)wu - (uintptr_t)wg)); }
    __device__ __forceinline__ long col(int n) const { return 128 * (n >> 8) + (n & 127); } };
struct SrcPlain { const float* w; int ldw;
    __device__ __forceinline__ int ld() const { return ldw; }
    __device__ __forceinline__ const float* base(int) const { return w; }
    __device__ __forceinline__ long col(int n) const { return n; } };
struct SrcWin { const float* w;
    __device__ __forceinline__ int ld() const { return 10520; }
    __device__ __forceinline__ const float* base(int) const { return w; }
    __device__ __forceinline__ long col(int n) const {
        int c;
        if (n < 3072) c = n; else if (n < 4608) c = n - 3072 + 3088; else if (n < 6400) c = n - 4608 + 4632; else if (n < 6416) c = n - 6400 + 3072; else if (n < 6424) c = n - 6416 + 4624; else if (n < 6656) c = -1; else c = n - 6656 + 6424;
        return c; } };
PH_FN void ph_weights(const Ctx C, ArgsP a, int l) {
    LF scr = (LF)(C.lds + C.wave * 16384);
    const int gw = C.bid * NWAVES + C.wave, NGW = C.G * NWAVES;
#pragma unroll 1
    for (int f = 0; f < 2; ++f) {
        const float* nrm = a->in[f ? 35 : 1] + (size_t)l * D; const float* wg = a->in[f ? 36 : 2] + (size_t)l * D * FF; const float* wu = a->in[f ? 37 : 3] + (size_t)l * D * FF; const float* wd = a->in[f ? 38 : 4] + (size_t)l * FF * D;
        bf16* Wgu = (bf16*)(C.ws + (f ? WS_WGU2 : WS_WGU1)); bf16* Wd = (bf16*)(C.ws + (f ? WS_WD2 : WS_WD1));
        const SrcGU sgu{wg, wu};
        for (int it = gw; it < (D / 64) * (2 * FF / 32); it += NGW) tr_item(sgu, nrm, Wgu, D, it / (2 * FF / 32), it % (2 * FF / 32), scr, C.lane);
        const SrcPlain sd{wd, D};
        for (int it = gw; it < (FF / 64) * (D / 32); it += NGW) tr_item(sd, nullptr, Wd, FF, it / (D / 32), it % (D / 32), scr, C.lane);
    }
    { const SrcWin sw{a->in[6] + (size_t)l * D * 10520}; const float* nrm = a->in[5] + (size_t)l * D; bf16* Win = (bf16*)(C.ws + WS_WIN);
      for (int it = gw; it < (D / 64) * (NWIN / 32); it += NGW) tr_item(sw, nrm, Win, D, it / (NWIN / 32), it % (NWIN / 32), scr, C.lane); }
    { bf16* Wb = (bf16*)(C.ws + WS_WB);
      for (int it = gw; it < 4 * (512 / 64) * (D / 32); it += NGW) { const int z = it / ((512 / 64) * (D / 32)), r = it % ((512 / 64) * (D / 32));
          const SrcPlain sb{a->in[32] + ((size_t)l * 4 + z) * 512 * D, D}; tr_item(sb, nullptr, Wb + (size_t)z * D * 512, 512, r / (D / 32), r % (D / 32), scr, C.lane); } }
    { bf16* W2T = (bf16*)(C.ws + WS_RW2T); bf16* A2T = W2T + 512 * 64; bf16* G2T = A2T + 512 * 64;
      const SrcPlain s1{a->in[23] + (size_t)l * 64 * 512, 512}, s2{a->in[25] + (size_t)l * 64 * 512, 512}, s3{a->in[26] + (size_t)l * 128 * 512, 512};
      for (int it = gw; it < 16; it += NGW) tr_item(s1, nullptr, W2T, 64, 0, it, scr, C.lane);
      for (int it = gw; it < 16; it += NGW) tr_item(s2, nullptr, A2T, 64, 0, it, scr, C.lane);
      for (int it = gw; it < 32; it += NGW) tr_item(s3, nullptr, G2T, 128, it >> 4, it & 15, scr, C.lane); }
    { const SrcPlain so{a->in[34] + (size_t)l * D * D, D}; bf16* Wo = (bf16*)(C.ws + WS_WO);
      for (int it = gw; it < (D / 64) * (D / 32); it += NGW) tr_item(so, nullptr, Wo, D, it / (D / 32), it % (D / 32), scr, C.lane); }
}

PH_FN void ph_da_prep(const Ctx C) {
    bf16* P = (bf16*)(C.ws + WS_P); const float* cosT = (const float*)(C.ws + WS_COS); const float* sinT = (const float*)(C.ws + WS_SIN);
    const int gw = C.bid * NWAVES + C.wave, NGW = C.G * NWAVES;
    const int hc = C.lane >> 2, ch = C.lane & 3;
    const float sc = (hc < 8) ? 0.125f * LOG2E : 1.0f;
    for (int m = gw; m < M; m += NGW) {
        const int t = m & (SEQ - 1);
        bf16* p1 = P + (size_t)m * NPM + hc * 64 + ch * 8; bf16* p2 = p1 + 32;
        float x1[8], x2[8], o1[8], o2[8];
        unpack8(*(const u32x4*)p1, x1); unpack8(*(const u32x4*)p2, x2);
        const float* cp = cosT + t * 32 + ch * 8; const float* sp = sinT + t * 32 + ch * 8;
#pragma unroll
        for (int i = 0; i < 8; ++i) { const float c = cp[i], s = sp[i]; o1[i] = (x1[i] * c - x2[i] * s) * sc; o2[i] = (x2[i] * c + x1[i] * s) * sc; }
        *(u32x4*)p1 = pack8(o1); *(u32x4*)p2 = pack8(o2);
    }
    bf16* VT = (bf16*)(C.ws + WS_VT); LAS bf16* tile = (LAS bf16*)C.lds;
    for (int it = C.bid; it < 2 * NCH * 4; it += C.G) {
        const int h = it & 3, bc = it >> 2, b = bc >> 7, tb = bc & 127; const size_t row0 = (size_t)bc * 64;
        WG_SYNC();
#pragma unroll
        for (int i = 0; i < 2; ++i) { const int q = C.tid + NTHR * i, t = q >> 4, c16 = q & 15;
            *(LAS u32x4*)(tile + t * 136 + c16 * 8) = *(const u32x4*)(P + (row0 + t) * NPM + C_DAV + h * 128 + c16 * 8); }
        WG_SYNC();
#pragma unroll
        for (int i = 0; i < 2; ++i) { const int q = C.tid + NTHR * i, d = q >> 3, tc = q & 7; unsigned w[4];
#pragma unroll
            for (int e = 0; e < 4; ++e) w[e] = (unsigned)tile[(8 * tc + 2 * e) * 136 + d] | ((unsigned)tile[(8 * tc + 2 * e + 1) * 136 + d] << 16);
            u32x4 o; o.x = w[0]; o.y = w[1]; o.z = w[2]; o.w = w[3];
            *(u32x4*)(VT + ((size_t)(b * 4 + h) * 128 + d) * SEQ + tb * 64 + 8 * tc) = o; }
    }
    WG_SYNC();
}

typedef LAS bf16* LB; typedef const LAS bf16* CLB;
__device__ __forceinline__ pg8::bf16x8 frag32(CLB X, int ld, int row0, int k0, int lane) { return *(const LAS pg8::bf16x8*)(X + (row0 + (lane & 31)) * ld + k0 + 8 * (lane >> 5)); }
template <int K> __device__ __forceinline__ void mma_nt(f32x16& acc, CLB A, int lda, int m0, CLB Bt, int ldb, int n0, int lane) {
#pragma unroll
    for (int k = 0; k < K; k += 16) acc = __builtin_amdgcn_mfma_f32_32x32x16_bf16(frag32(A, lda, m0, k, lane), frag32(Bt, ldb, n0, k, lane), acc, 0, 0, 0);
}
__device__ __forceinline__ int crow(int r, int hi) { return (r & 3) + 8 * (r >> 2) + 4 * hi; }
__device__ __forceinline__ f32x16 zero16() { f32x16 z;
#pragma unroll
    for (int r = 0; r < 16; ++r) z[r] = 0.f;
    return z; }

__device__ __forceinline__ void gla_compute_G(const Ctx& C, ArgsP a, int l, int bc, int h, LF Gs) {
    const bf16* P = (const bf16*)(C.ws + WS_P); const float* W2 = a->in[12] + (size_t)l * 16 * 256; const float* gb = a->in[13] + (size_t)l * 256;
    const int t = C.tid >> 3, kg = C.tid & 7; const size_t row = (size_t)bc * 64 + t;
    float glr[16]; unpack8(*(const u32x4*)(P + row * NPM + C_GLR), glr); unpack8(*(const u32x4*)(P + row * NPM + C_GLR + 8), glr + 8);
#pragma unroll
    for (int i = 0; i < 8; ++i) { const int k = h * 64 + kg * 8 + i; float x = gb[k];
#pragma unroll
        for (int r = 0; r < 16; ++r) x += glr[r] * W2[r * 256 + k];
        Gs[t * 68 + kg * 8 + i] = logsigmoidf_(x) * (1.0f / 16.0f); }
    WG_SYNC();
    if (C.tid < 64) { float run = 0.f; for (int tt = 0; tt < 64; ++tt) { run += Gs[tt * 68 + C.tid]; Gs[tt * 68 + C.tid] = run; } }
    WG_SYNC();
}
PH_HEAVY void ph_gla_a(const Ctx C, ArgsP a, int l) {
    const bf16* P = (const bf16*)(C.ws + WS_P); float* GKV = (float*)(C.ws + WS_GKV); float* GL = (float*)(C.ws + WS_GLAST);
    LF Gs = (LF)C.lds; LB KDT = (LB)(C.lds + 17408); LB VT = (LB)(C.lds + 26624);
    for (int it = C.bid; it < NBC * 4; it += C.G) {
        const int bc = it >> 2, h = it & 3;
        WG_SYNC();
        gla_compute_G(C, a, l, bc, h, Gs);
        { const int t = C.tid >> 3, g8 = C.tid & 7; const size_t row = (size_t)bc * 64 + t;
          float kf[8]; unpack8(*(const u32x4*)(P + row * NPM + C_GK + h * 64 + g8 * 8), kf);
#pragma unroll
          for (int i = 0; i < 8; ++i) { const int k = g8 * 8 + i; KDT[k * 72 + t] = (bf16)f2bf(kf[i] * __expf(Gs[63 * 68 + k] - Gs[t * 68 + k])); }
          const u32x4 v0 = *(const u32x4*)(P + row * NPM + C_GV + h * 128 + g8 * 16), v1 = *(const u32x4*)(P + row * NPM + C_GV + h * 128 + g8 * 16 + 8);
          const unsigned vw[8] = {v0.x, v0.y, v0.z, v0.w, v1.x, v1.y, v1.z, v1.w};
#pragma unroll
          for (int i = 0; i < 8; ++i) { VT[(g8 * 16 + 2 * i) * 72 + t] = (bf16)(vw[i] & 0xffffu); VT[(g8 * 16 + 2 * i + 1) * 72 + t] = (bf16)(vw[i] >> 16); }
          if (C.tid < 64) GL[(size_t)it * 64 + C.tid] = Gs[63 * 68 + C.tid]; }
        WG_SYNC();
        { const int kt = C.wave >> 2, vt = C.wave & 3, n = C.lane & 31, hi = C.lane >> 5;
          f32x16 acc = zero16(); mma_nt<64>(acc, KDT, 72, 32 * kt, VT, 72, 32 * vt, C.lane);
          float* dst = GKV + ((size_t)it * 128 + 32 * vt + n) * 64 + 32 * kt + 4 * hi;
#pragma unroll
          for (int g = 0; g < 4; ++g) *(f32x4*)(dst + 8 * g) = (f32x4){acc[4 * g], acc[4 * g + 1], acc[4 * g + 2], acc[4 * g + 3]}; }
    }
    WG_SYNC();
}
PH_FN void gla_scan_part(const Ctx C, int part) {
    float* GKV = (float*)(C.ws + WS_GKV); const float* GL = (const float*)(C.ws + WS_GLAST);
    const int e = part * NTHR + C.tid, chain = e >> 13, idx = e & 8191, b = chain >> 2, h = chain & 3, k = idx & 63;
    float st = 0.f;
#pragma unroll 1
    for (int c0 = 0; c0 < NCH; c0 += 16) {
        float tmp[16], dec[16];
#pragma unroll
        for (int i = 0; i < 16; ++i) { const size_t item = (size_t)(b * NCH + c0 + i) * 4 + h; tmp[i] = GKV[item * 8192 + idx]; dec[i] = GL[item * 64 + k]; }
#pragma unroll
        for (int i = 0; i < 16; ++i) { const size_t item = (size_t)(b * NCH + c0 + i) * 4 + h; GKV[item * 8192 + idx] = st; st = __expf(dec[i]) * st + tmp[i]; }
    }
}
PH_HEAVY void ph_gla_c(const Ctx C, ArgsP a, int l) {
    const bf16* P = (const bf16*)(C.ws + WS_P); const float* GKV = (const float*)(C.ws + WS_GKV); bf16* YS = (bf16*)(C.ws + WS_YS);
    const float* gnorm = a->in[14] + (size_t)l * 128;
    LF Gs = (LF)C.lds; LB QD = (LB)(C.lds + 17408); LB KDR = (LB)(C.lds + 26624); LB QI = (LB)(C.lds + 35840); LB ATT = (LB)(C.lds + 45056); LB VT = (LB)(C.lds + 54272); LB ST = (LB)(C.lds + 72704); LF PS = (LF)(C.lds + 91136);
    for (int it = C.bid; it < NBC * 4; it += C.G) {
        const int bc = it >> 2, h = it & 3;
        WG_SYNC();
        gla_compute_G(C, a, l, bc, h, Gs);
        { const int t = C.tid >> 3, g8 = C.tid & 7; const size_t row = (size_t)bc * 64 + t;
          float qf[8], kf[8], o1[8], o2[8], o3[8];
          unpack8(*(const u32x4*)(P + row * NPM + C_GQ + h * 64 + g8 * 8), qf); unpack8(*(const u32x4*)(P + row * NPM + C_GK + h * 64 + g8 * 8), kf);
#pragma unroll
          for (int i = 0; i < 8; ++i) { const int k = g8 * 8 + i; const float g = Gs[t * 68 + k], d = g - Gs[32 * 68 + k]; o1[i] = qf[i] * 0.125f * __expf(d); o2[i] = kf[i] * __expf(-d); o3[i] = qf[i] * 0.125f * __expf(g); }
          *(LAS u32x4*)(QD + t * 72 + g8 * 8) = pack8(o1); *(LAS u32x4*)(KDR + t * 72 + g8 * 8) = pack8(o2); *(LAS u32x4*)(QI + t * 72 + g8 * 8) = pack8(o3);
          const u32x4 v0 = *(const u32x4*)(P + row * NPM + C_GV + h * 128 + g8 * 16), v1 = *(const u32x4*)(P + row * NPM + C_GV + h * 128 + g8 * 16 + 8);
          const unsigned vw[8] = {v0.x, v0.y, v0.z, v0.w, v1.x, v1.y, v1.z, v1.w};
#pragma unroll
          for (int i = 0; i < 8; ++i) { VT[(g8 * 16 + 2 * i) * 72 + t] = (bf16)(vw[i] & 0xffffu); VT[(g8 * 16 + 2 * i + 1) * 72 + t] = (bf16)(vw[i] >> 16); }
          const int v = C.tid >> 2, kq = (C.tid & 3) * 16; const float* sp = GKV + ((size_t)it * 128 + v) * 64 + kq;
          float s[16];
#pragma unroll
          for (int i = 0; i < 4; ++i) { const f32x4 x = *(const f32x4*)(sp + 4 * i); s[4 * i] = x[0]; s[4 * i + 1] = x[1]; s[4 * i + 2] = x[2]; s[4 * i + 3] = x[3]; }
          *(LAS u32x4*)(ST + v * 72 + kq) = pack8(s); *(LAS u32x4*)(ST + v * 72 + kq + 8) = pack8(s + 8); }
        WG_SYNC();
        const int n = C.lane & 31, hi = C.lane >> 5;
        if (C.wave < 4) {
            const int it_ = C.wave >> 1, jt = C.wave & 1;
            f32x16 acc = zero16();
            if (jt <= it_) mma_nt<64>(acc, QD, 72, 32 * it_, KDR, 72, 32 * jt, C.lane);
#pragma unroll
            for (int r = 0; r < 16; ++r) { const int i = 32 * it_ + crow(r, hi), j = 32 * jt + n; ATT[i * 72 + j] = (bf16)f2bf(j <= i ? acc[r] : 0.f); }
        }
        WG_SYNC();
        {
            const int it_ = C.wave & 1, vt = C.wave >> 1;
            f32x16 acc = zero16();
            mma_nt<64>(acc, VT, 72, 32 * vt, ATT, 72, 32 * it_, C.lane);
            mma_nt<64>(acc, ST, 72, 32 * vt, QI, 72, 32 * it_, C.lane);
            float ss = 0.f;
#pragma unroll
            for (int r = 0; r < 16; ++r) ss += acc[r] * acc[r];
            ss += __shfl_xor(ss, 32);
            if (hi == 0) PS[(32 * it_ + n) * 4 + vt] = ss;
            WG_SYNC();
            const int i = 32 * it_ + n; const float tot = (PS[i * 4] + PS[i * 4 + 1]) + (PS[i * 4 + 2] + PS[i * 4 + 3]);
            const float rs = 1.0f / sqrtf(tot * (1.0f / 128.0f) + EPS); const size_t row = (size_t)bc * 64 + i;
#pragma unroll
            for (int g = 0; g < 4; ++g) { const int v0 = 32 * vt + 8 * g + 4 * hi;
                const u32x2 ogw = *(const u32x2*)(P + row * NPM + C_GOG + h * 128 + v0); const f32x4 gn = *(const f32x4*)(gnorm + v0);
                const float og[4] = {bflo(ogw.x), bfhi(ogw.x), bflo(ogw.y), bfhi(ogw.y)}; float o4[4];
#pragma unroll
                for (int y = 0; y < 4; ++y) o4[y] = acc[4 * g + y] * rs * gn[y] * siluf_(og[y]);
                u32x2 w; w.x = pk2(o4[0], o4[1]); w.y = pk2(o4[2], o4[3]); *(u32x2*)(YS + row * 2048 + 512 + h * 128 + v0) = w; }
        }
    }
    WG_SYNC();
}

__device__ __forceinline__ void ssd_conv8(const bf16* P, const float* cw, const float* cb, int bc, int t, int ch0, float* o) {
    const int pos = (bc & 127) * 64 + t; const size_t row = (size_t)bc * 64 + t;
#pragma unroll
    for (int i = 0; i < 8; ++i) o[i] = cb[ch0 + i];
#pragma unroll
    for (int tap = 0; tap < 4; ++tap) { if (pos - 3 + tap >= 0) { float x[8]; unpack8(*(const u32x4*)(P + (row - 3 + tap) * NPM + C_SX + ch0), x);
#pragma unroll
        for (int i = 0; i < 8; ++i) o[i] += cw[tap * 1024 + ch0 + i] * x[i]; } }
#pragma unroll
    for (int i = 0; i < 8; ++i) o[i] = siluf_(o[i]);
}
PH_HEAVY void ph_ssd_a(const Ctx C, ArgsP a, int l) {
    const bf16* P = (const bf16*)(C.ws + WS_P); float* SST = (float*)(C.ws + WS_SST); float* SDT = (float*)(C.ws + WS_SDT); float* SAC = (float*)(C.ws + WS_SACUM); float* SCD = (float*)(C.ws + WS_SCDEC);
    const float* cw = a->in[15] + (size_t)l * 4 * 1024; const float* cb = a->in[16] + (size_t)l * 1024; const float* dtb = a->in[17] + (size_t)l * 8; const float* alog = a->in[18] + (size_t)l * 8;
    LB BT = (LB)C.lds; LB XDT = (LB)(C.lds + 18432); LF dtv = (LF)(C.lds + 27648); LF acu = (LF)(C.lds + 27904); LF av = (LF)(C.lds + 28160);
    for (int it = C.bid; it < NBC * 2; it += C.G) {
        const int bc = it >> 1, g = it & 1; const int t = C.tid >> 3, cg = C.tid & 7;
        WG_SYNC();
        { float o[8];
#pragma unroll
          for (int half = 0; half < 2; ++half) { ssd_conv8(P, cw, cb, bc, t, 512 + g * 128 + cg * 16 + half * 8, o);
#pragma unroll
              for (int i = 0; i < 8; ++i) BT[(cg * 16 + half * 8 + i) * 72 + t] = (bf16)f2bf(o[i]); } }
#pragma unroll 1
        for (int hh = 0; hh < 4; ++hh) {
            const int hd = 4 * g + hh; const size_t item8 = (size_t)bc * 8 + hd;
            WG_SYNC();
            if (C.tid < 64) { const size_t row = (size_t)bc * 64 + C.tid; const float dt = softplusf_(bf2f(P[row * NPM + C_SDT + hd]) + dtb[hd]); dtv[C.tid] = dt; av[C.tid] = -__expf(alog[hd]) * dt; }
            WG_SYNC();
            if (C.tid < 64) { float s = 0.f; for (int j = 0; j <= C.tid; ++j) s += av[j]; acu[C.tid] = s; const size_t row = (size_t)bc * 64 + C.tid; SDT[row * 8 + hd] = dtv[C.tid]; SAC[row * 8 + hd] = s; if (C.tid == 63) SCD[item8] = __expf(s); }
            WG_SYNC();
            { float o[8]; ssd_conv8(P, cw, cb, bc, t, hd * 64 + cg * 8, o); const float sc = dtv[t] * __expf(acu[63] - acu[t]);
#pragma unroll
              for (int i = 0; i < 8; ++i) XDT[(cg * 8 + i) * 72 + t] = (bf16)f2bf(o[i] * sc); }
            WG_SYNC();
            { const int pt = C.wave >> 2, nt = C.wave & 3, n = C.lane & 31, hi = C.lane >> 5;
              f32x16 acc = zero16(); mma_nt<64>(acc, XDT, 72, 32 * pt, BT, 72, 32 * nt, C.lane);
#pragma unroll
              for (int r = 0; r < 16; ++r) SST[(item8 * 64 + 32 * pt + crow(r, hi)) * 128 + 32 * nt + n] = acc[r]; }
        }
    }
    WG_SYNC();
}
PH_FN void ssd_scan_part(const Ctx C, int part) {
    float* SST = (float*)(C.ws + WS_SST); const float* SCD = (const float*)(C.ws + WS_SCDEC);
    const int e = part * NTHR + C.tid, chain = e >> 13, idx = e & 8191, b = chain >> 3, hd = chain & 7;
    float st = 0.f;
#pragma unroll 1
    for (int c0 = 0; c0 < NCH; c0 += 16) {
        float tmp[16], dec[16];
#pragma unroll
        for (int i = 0; i < 16; ++i) { const size_t item = (size_t)(b * NCH + c0 + i) * 8 + hd; tmp[i] = SST[item * 8192 + idx]; dec[i] = SCD[item]; }
#pragma unroll
        for (int i = 0; i < 16; ++i) { const size_t item = (size_t)(b * NCH + c0 + i) * 8 + hd; SST[item * 8192 + idx] = st; st = dec[i] * st + tmp[i]; }
    }
}
PH_HEAVY void ph_ssd_c(const Ctx C, ArgsP a, int l) {
    const bf16* P = (const bf16*)(C.ws + WS_P); const float* SST = (const float*)(C.ws + WS_SST); const float* SDT = (const float*)(C.ws + WS_SDT); const float* SAC = (const float*)(C.ws + WS_SACUM); bf16* YS = (bf16*)(C.ws + WS_YS);
    const float* cw = a->in[15] + (size_t)l * 4 * 1024; const float* cb = a->in[16] + (size_t)l * 1024; const float* dpar = a->in[19] + (size_t)l * 8; const float* snorm = a->in[20] + (size_t)l * 512;
    LB BN = (LB)C.lds; LB CN = (LB)(C.lds + 17408); LF CB = (LF)(C.lds + 34816); LB SC = (LB)(C.lds + 52224); LB XST = (LB)(C.lds + 61440); LB HP = (LB)(C.lds + 70656); LB CE = (LB)(C.lds + 88064);
    LF dtv = (LF)(C.lds + 105472); LF acu = (LF)(C.lds + 105728); LF PSQ = (LF)(C.lds + 105984);
    for (int it = C.bid; it < NBC * 2; it += C.G) {
        const int bc = it >> 1, g = it & 1;
        const int t = C.tid >> 3, cg = C.tid & 7, n = C.lane & 31, hi = C.lane >> 5;
        WG_SYNC();
        { float o[8];
#pragma unroll
          for (int half = 0; half < 2; ++half) {
              ssd_conv8(P, cw, cb, bc, t, 512 + g * 128 + cg * 16 + half * 8, o); *(LAS u32x4*)(BN + t * 136 + cg * 16 + half * 8) = pack8(o);
              ssd_conv8(P, cw, cb, bc, t, 768 + g * 128 + cg * 16 + half * 8, o); *(LAS u32x4*)(CN + t * 136 + cg * 16 + half * 8) = pack8(o); } }
        WG_SYNC();
        if (C.wave < 4) {
            const int it_ = C.wave >> 1, jt = C.wave & 1;
            f32x16 acc = zero16(); mma_nt<128>(acc, CN, 136, 32 * it_, BN, 136, 32 * jt, C.lane);
#pragma unroll
            for (int r = 0; r < 16; ++r) CB[(32 * it_ + crow(r, hi)) * 68 + 32 * jt + n] = acc[r];
        }
        float yk[4][16]; float ssq = 0.f;
        const int pt = (C.wave >> 1) & 1, it2 = C.wave & 1;
#pragma unroll
        for (int hh = 0; hh < 4; ++hh) {
            const int hd = 4 * g + hh; const size_t item8 = (size_t)bc * 8 + hd;
            WG_SYNC();
            if (C.tid < 64) { const size_t row = (size_t)bc * 64 + C.tid; dtv[C.tid] = SDT[row * 8 + hd]; acu[C.tid] = SAC[row * 8 + hd]; }
            { float o[8]; ssd_conv8(P, cw, cb, bc, t, hd * 64 + cg * 8, o);
#pragma unroll
              for (int i = 0; i < 8; ++i) XST[(cg * 8 + i) * 72 + t] = (bf16)f2bf(o[i]);
              const int p = C.tid >> 3, n0 = (C.tid & 7) * 16; const float* sp = SST + (item8 * 64 + p) * 128 + n0; float s[16];
#pragma unroll
              for (int i = 0; i < 4; ++i) { const f32x4 x = *(const f32x4*)(sp + 4 * i); s[4 * i] = x[0]; s[4 * i + 1] = x[1]; s[4 * i + 2] = x[2]; s[4 * i + 3] = x[3]; }
              *(LAS u32x4*)(HP + p * 136 + n0) = pack8(s); *(LAS u32x4*)(HP + p * 136 + n0 + 8) = pack8(s + 8); }
            WG_SYNC();
            { const float ai = acu[t]; float o[8];
#pragma unroll
              for (int jj = 0; jj < 8; ++jj) { const int j = 8 * cg + jj; o[jj] = (j <= t) ? CB[t * 68 + j] * __expf(ai - acu[j]) * dtv[j] : 0.f; }
              *(LAS u32x4*)(SC + t * 72 + 8 * cg) = pack8(o);
              const float ea = __expf(ai); float c8[8];
#pragma unroll
              for (int half = 0; half < 2; ++half) { unpack8(*(const LAS u32x4*)(CN + t * 136 + cg * 16 + half * 8), c8);
#pragma unroll
                  for (int i = 0; i < 8; ++i) c8[i] *= ea;
                  *(LAS u32x4*)(CE + t * 136 + cg * 16 + half * 8) = pack8(c8); } }
            WG_SYNC();
            if (C.wave < 4) {
                f32x16 acc = zero16();
                mma_nt<64>(acc, XST, 72, 32 * pt, SC, 72, 32 * it2, C.lane);
                mma_nt<128>(acc, HP, 136, 32 * pt, CE, 136, 32 * it2, C.lane);
                const int i = 32 * it2 + n; const size_t row = (size_t)bc * 64 + i; const float dh = dpar[hd];
#pragma unroll
                for (int q4 = 0; q4 < 4; ++q4) { const int p0 = 32 * pt + 8 * q4 + 4 * hi;
                    const u32x2 zw = *(const u32x2*)(P + row * NPM + C_SZ + hd * 64 + p0); const float zf[4] = {bflo(zw.x), bfhi(zw.x), bflo(zw.y), bfhi(zw.y)};
#pragma unroll
                    for (int e = 0; e < 4; ++e) { const float xs = bf2f(XST[(p0 + e) * 72 + i]); const float v = (acc[4 * q4 + e] + dh * xs) * siluf_(zf[e]); yk[hh][4 * q4 + e] = v; ssq += v * v; } }
            }
        }
        if (C.wave < 4) { ssq += __shfl_xor(ssq, 32); if (hi == 0) PSQ[(32 * it2 + n) * 2 + pt] = ssq; }
        WG_SYNC();
        if (C.wave < 4) {
            const int i = 32 * it2 + n; const float rs = 1.0f / sqrtf((PSQ[i * 2] + PSQ[i * 2 + 1]) * (1.0f / 256.0f) + EPS); const size_t row = (size_t)bc * 64 + i;
#pragma unroll
            for (int hh = 0; hh < 4; ++hh)
#pragma unroll
                for (int q4 = 0; q4 < 4; ++q4) { const int ch = g * 256 + hh * 64 + 32 * pt + 8 * q4 + 4 * hi; const f32x4 sn = *(const f32x4*)(snorm + ch);
                    u32x2 w; w.x = pk2(yk[hh][4 * q4] * rs * sn[0], yk[hh][4 * q4 + 1] * rs * sn[1]); w.y = pk2(yk[hh][4 * q4 + 2] * rs * sn[2], yk[hh][4 * q4 + 3] * rs * sn[3]);
                    *(u32x2*)(YS + row * 2048 + 1024 + ch) = w; }
        }
    }
    WG_SYNC();
}

#ifndef RW_CHUNKED
#define RW_CHUNKED 1
#endif
__device__ __forceinline__ void rw_lerp8(const bf16* P, const float* mu, int bc, int t, int c0, float* o) {
    const size_t row = (size_t)bc * 64 + t; const bool first = ((bc & 127) == 0) && (t == 0);
    float x[8], xp[8]; unpack8(*(const u32x4*)(P + row * NPM + C_RR + c0), x);
    if (!first) unpack8(*(const u32x4*)(P + (row - 1) * NPM + C_RR + c0), xp); else {
#pragma unroll
        for (int i = 0; i < 8; ++i) xp[i] = 0.f; }
#pragma unroll
    for (int i = 0; i < 8; ++i) o[i] = x[i] + (xp[i] - x[i]) * mu[c0 + i];
}
__device__ __forceinline__ void rw_lerp4(const bf16* P, const float* mu, size_t row, bool first, int c0, float* o) {
    const u32x2 xw = *(const u32x2*)(P + row * NPM + C_RR + c0); const float x[4] = {bflo(xw.x), bfhi(xw.x), bflo(xw.y), bfhi(xw.y)};
    float xp[4] = {0.f, 0.f, 0.f, 0.f};
    if (!first) { const u32x2 pw = *(const u32x2*)(P + (row - 1) * NPM + C_RR + c0); xp[0] = bflo(pw.x); xp[1] = bfhi(pw.x); xp[2] = bflo(pw.y); xp[3] = bfhi(pw.y); }
    const f32x4 m = *(const f32x4*)(mu + c0);
#pragma unroll
    for (int i = 0; i < 4; ++i) o[i] = x[i] + (xp[i] - x[i]) * m[i];
}
#define RW_WFRAG(WT_, K_, nt_, s_) (*(const pg8::bf16x8*)((WT_) + (size_t)(head * 64 + 32 * (nt_) + n) * (K_) + 16 * (s_) + 8 * hi))
PH_FN void rwp_stage(const Ctx C, ArgsP a, int l, int bc) {
    const bf16* P = (const bf16*)(C.ws + WS_P);
    float* RWW = (float*)(C.ws + WS_RWW); bf16* RWR = (bf16*)(C.ws + WS_RWR); bf16* RWK = (bf16*)(C.ws + WS_RWK); bf16* RWV = (bf16*)(C.ws + WS_RWV); bf16* RWKK = (bf16*)(C.ws + WS_RWKK); bf16* RWB = (bf16*)(C.ws + WS_RWB); bf16* RWG = (bf16*)(C.ws + WS_RWG);
    const bf16* W2T = (const bf16*)(C.ws + WS_RW2T); const bf16* A2T = W2T + 512 * 64; const bf16* G2T = A2T + 512 * 64;
    const float* mu = a->in[21] + (size_t)l * 1792; const float* w0 = a->in[22] + (size_t)l * 512; const float* a0 = a->in[24] + (size_t)l * 512;
    const float* k_k = a->in[27] + (size_t)l * 512; const float* k_a = a->in[28] + (size_t)l * 512;
    LB WLb = (LB)C.lds; LB ALb = (LB)(C.lds + 9216); LB GLb = (LB)(C.lds + 18432);
    (void)P; (void)RWW; (void)RWR; (void)RWK; (void)RWV; (void)RWKK; (void)RWB; (void)RWG; (void)W2T; (void)A2T; (void)G2T; (void)mu; (void)w0; (void)a0; (void)k_k; (void)k_a; (void)WLb; (void)ALb; (void)GLb;
        WG_SYNC();
        { const int t = C.tid >> 3, cg = C.tid & 7; float o[8];
          rw_lerp8(P, mu, bc, t, 1536 + cg * 8, o);
#pragma unroll
          for (int i = 0; i < 8; ++i) o[i] = tanhf(o[i]);
          *(LAS u32x4*)(WLb + t * 72 + cg * 8) = pack8(o);
          rw_lerp8(P, mu, bc, t, 1600 + cg * 8, o); *(LAS u32x4*)(ALb + t * 72 + cg * 8) = pack8(o);
#pragma unroll
          for (int half = 0; half < 2; ++half) { rw_lerp8(P, mu, bc, t, 1664 + cg * 16 + half * 8, o);
#pragma unroll
              for (int i = 0; i < 8; ++i) o[i] = sigmoidf_(o[i]);
              *(LAS u32x4*)(GLb + t * 136 + cg * 16 + half * 8) = pack8(o); } }
        WG_SYNC();
}
PH_FN void rwp_w(const Ctx C, ArgsP a, int l, int bc, int tt) {
    const bf16* P = (const bf16*)(C.ws + WS_P);
    float* RWW = (float*)(C.ws + WS_RWW); bf16* RWR = (bf16*)(C.ws + WS_RWR); bf16* RWK = (bf16*)(C.ws + WS_RWK); bf16* RWV = (bf16*)(C.ws + WS_RWV); bf16* RWKK = (bf16*)(C.ws + WS_RWKK); bf16* RWB = (bf16*)(C.ws + WS_RWB); bf16* RWG = (bf16*)(C.ws + WS_RWG);
    const bf16* W2T = (const bf16*)(C.ws + WS_RW2T); const bf16* A2T = W2T + 512 * 64; const bf16* G2T = A2T + 512 * 64;
    const float* mu = a->in[21] + (size_t)l * 1792; const float* w0 = a->in[22] + (size_t)l * 512; const float* a0 = a->in[24] + (size_t)l * 512;
    const float* k_k = a->in[27] + (size_t)l * 512; const float* k_a = a->in[28] + (size_t)l * 512;
    LB WLb = (LB)C.lds; LB ALb = (LB)(C.lds + 9216); LB GLb = (LB)(C.lds + 18432);
    (void)P; (void)RWW; (void)RWR; (void)RWK; (void)RWV; (void)RWKK; (void)RWB; (void)RWG; (void)W2T; (void)A2T; (void)G2T; (void)mu; (void)w0; (void)a0; (void)k_k; (void)k_a; (void)WLb; (void)ALb; (void)GLb;
            const int head = C.wave, n = C.lane & 31, hi = C.lane >> 5; const int t = 32 * tt + n; const size_t row = (size_t)bc * 64 + t; const bool first = ((bc & 127) == 0) && (t == 0); (void)first; (void)row;
            { f32x16 c[2] = {zero16(), zero16()};
#pragma unroll
              for (int s4 = 0; s4 < 4; ++s4) { const pg8::bf16x8 fb = frag32(WLb, 72, 32 * tt, 16 * s4, C.lane);
#pragma unroll
                  for (int nt = 0; nt < 2; ++nt) c[nt] = __builtin_amdgcn_mfma_f32_32x32x16_bf16(RW_WFRAG(W2T, 64, nt, s4), fb, c[nt], 0, 0, 0); }
#pragma unroll
              for (int nt = 0; nt < 2; ++nt)
#pragma unroll
                  for (int g = 0; g < 4; ++g) { const int ch = head * 64 + 32 * nt + 8 * g + 4 * hi; const f32x4 w0v = *(const f32x4*)(w0 + ch); f32x4 o;
#pragma unroll
                      for (int e = 0; e < 4; ++e) o[e] = -0.606531f * sigmoidf_(w0v[e] + c[nt][4 * g + e]);
                      *(f32x4*)(RWW + row * 512 + ch) = o; } }
}
PH_FN void rwp_g(const Ctx C, ArgsP a, int l, int bc, int tt) {
    const bf16* P = (const bf16*)(C.ws + WS_P);
    float* RWW = (float*)(C.ws + WS_RWW); bf16* RWR = (bf16*)(C.ws + WS_RWR); bf16* RWK = (bf16*)(C.ws + WS_RWK); bf16* RWV = (bf16*)(C.ws + WS_RWV); bf16* RWKK = (bf16*)(C.ws + WS_RWKK); bf16* RWB = (bf16*)(C.ws + WS_RWB); bf16* RWG = (bf16*)(C.ws + WS_RWG);
    const bf16* W2T = (const bf16*)(C.ws + WS_RW2T); const bf16* A2T = W2T + 512 * 64; const bf16* G2T = A2T + 512 * 64;
    const float* mu = a->in[21] + (size_t)l * 1792; const float* w0 = a->in[22] + (size_t)l * 512; const float* a0 = a->in[24] + (size_t)l * 512;
    const float* k_k = a->in[27] + (size_t)l * 512; const float* k_a = a->in[28] + (size_t)l * 512;
    LB WLb = (LB)C.lds; LB ALb = (LB)(C.lds + 9216); LB GLb = (LB)(C.lds + 18432);
    (void)P; (void)RWW; (void)RWR; (void)RWK; (void)RWV; (void)RWKK; (void)RWB; (void)RWG; (void)W2T; (void)A2T; (void)G2T; (void)mu; (void)w0; (void)a0; (void)k_k; (void)k_a; (void)WLb; (void)ALb; (void)GLb;
            const int head = C.wave, n = C.lane & 31, hi = C.lane >> 5; const int t = 32 * tt + n; const size_t row = (size_t)bc * 64 + t; const bool first = ((bc & 127) == 0) && (t == 0); (void)first; (void)row;
            { f32x16 c[2] = {zero16(), zero16()};
#pragma unroll
              for (int s8 = 0; s8 < 8; ++s8) { const pg8::bf16x8 fb = frag32(GLb, 136, 32 * tt, 16 * s8, C.lane);
#pragma unroll
                  for (int nt = 0; nt < 2; ++nt) c[nt] = __builtin_amdgcn_mfma_f32_32x32x16_bf16(RW_WFRAG(G2T, 128, nt, s8), fb, c[nt], 0, 0, 0); }
#pragma unroll
              for (int nt = 0; nt < 2; ++nt)
#pragma unroll
                  for (int g = 0; g < 4; ++g) { const int ch = head * 64 + 32 * nt + 8 * g + 4 * hi;
                      u32x2 w; w.x = pk2(c[nt][4 * g], c[nt][4 * g + 1]); w.y = pk2(c[nt][4 * g + 2], c[nt][4 * g + 3]); *(u32x2*)(RWG + row * 512 + ch) = w; } }
}
PH_FN void rwp_ak(const Ctx C, ArgsP a, int l, int bc, int tt) {
    const bf16* P = (const bf16*)(C.ws + WS_P);
    float* RWW = (float*)(C.ws + WS_RWW); bf16* RWR = (bf16*)(C.ws + WS_RWR); bf16* RWK = (bf16*)(C.ws + WS_RWK); bf16* RWV = (bf16*)(C.ws + WS_RWV); bf16* RWKK = (bf16*)(C.ws + WS_RWKK); bf16* RWB = (bf16*)(C.ws + WS_RWB); bf16* RWG = (bf16*)(C.ws + WS_RWG);
    const bf16* W2T = (const bf16*)(C.ws + WS_RW2T); const bf16* A2T = W2T + 512 * 64; const bf16* G2T = A2T + 512 * 64;
    const float* mu = a->in[21] + (size_t)l * 1792; const float* w0 = a->in[22] + (size_t)l * 512; const float* a0 = a->in[24] + (size_t)l * 512;
    const float* k_k = a->in[27] + (size_t)l * 512; const float* k_a = a->in[28] + (size_t)l * 512;
    LB WLb = (LB)C.lds; LB ALb = (LB)(C.lds + 9216); LB GLb = (LB)(C.lds + 18432);
    (void)P; (void)RWW; (void)RWR; (void)RWK; (void)RWV; (void)RWKK; (void)RWB; (void)RWG; (void)W2T; (void)A2T; (void)G2T; (void)mu; (void)w0; (void)a0; (void)k_k; (void)k_a; (void)WLb; (void)ALb; (void)GLb;
            const int head = C.wave, n = C.lane & 31, hi = C.lane >> 5; const int t = 32 * tt + n; const size_t row = (size_t)bc * 64 + t; const bool first = ((bc & 127) == 0) && (t == 0); (void)first; (void)row;
            { float ss = 0.f;
#pragma unroll
              for (int nt = 0; nt < 2; ++nt)
#pragma unroll
                  for (int g = 0; g < 4; ++g) { const int ch = head * 64 + 32 * nt + 8 * g + 4 * hi; const f32x4 kkv = *(const f32x4*)(k_k + ch); float o[4]; rw_lerp4(P, mu, row, first, 512 + ch, o);
#pragma unroll
                      for (int e = 0; e < 4; ++e) { const float q = o[e] * kkv[e]; ss += q * q; } }
              ss += __shfl_xor(ss, 32);
              const float inv = 1.0f / fmaxf(sqrtf(ss), 1e-12f);
#pragma unroll 1
              for (int nt = 0; nt < 2; ++nt) {
                  f32x16 c = zero16();
#pragma unroll
                  for (int s4 = 0; s4 < 4; ++s4) c = __builtin_amdgcn_mfma_f32_32x32x16_bf16(RW_WFRAG(A2T, 64, nt, s4), frag32(ALb, 72, 32 * tt, 16 * s4, C.lane), c, 0, 0, 0);
#pragma unroll
                  for (int g = 0; g < 4; ++g) { const int ch = head * 64 + 32 * nt + 8 * g + 4 * hi; const f32x4 a0v = *(const f32x4*)(a0 + ch), kkv = *(const f32x4*)(k_k + ch), kav = *(const f32x4*)(k_a + ch);
                      float kkn[4], bb[4], kp[4], o[4]; rw_lerp4(P, mu, row, first, 512 + ch, o);
#pragma unroll
                      for (int e = 0; e < 4; ++e) { const float al = sigmoidf_(a0v[e] + c[4 * g + e]), x = o[e]; kkn[e] = x * kkv[e] * inv; bb[e] = kkn[e] * al; kp[e] = x * (1.0f + (al - 1.0f) * kav[e]); }
                      u32x2 w; w.x = pk2(kkn[0], kkn[1]); w.y = pk2(kkn[2], kkn[3]); *(u32x2*)(RWKK + row * 512 + ch) = w;
                      w.x = pk2(bb[0], bb[1]); w.y = pk2(bb[2], bb[3]); *(u32x2*)(RWB + row * 512 + ch) = w;
                      w.x = pk2(kp[0], kp[1]); w.y = pk2(kp[2], kp[3]); *(u32x2*)(RWK + row * 512 + ch) = w;
                      rw_lerp4(P, mu, row, first, ch, o); w.x = pk2(o[0], o[1]); w.y = pk2(o[2], o[3]); *(u32x2*)(RWR + row * 512 + ch) = w;
                      rw_lerp4(P, mu, row, first, 1024 + ch, o); w.x = pk2(o[0], o[1]); w.y = pk2(o[2], o[3]); *(u32x2*)(RWV + row * 512 + ch) = w; } } }
}
#undef RW_WFRAG
__device__ __forceinline__ void ph_rw_prep(const Ctx& C, ArgsP a, int l) {
    for (int bc = C.bid; bc < NBC; bc += C.G) { rwp_stage(C, a, l, bc);
#pragma unroll 1
        for (int tt = 0; tt < 2; ++tt) { rwp_w(C, a, l, bc, tt); rwp_g(C, a, l, bc, tt); rwp_ak(C, a, l, bc, tt); } }
    WG_SYNC();
}
template <int CTRL> __device__ __forceinline__ float dpp_get(float x) { return __builtin_bit_cast(float, __builtin_amdgcn_update_dpp(0, __builtin_bit_cast(int, x), CTRL, 0xf, 0xf, true)); }
__device__ __forceinline__ float reduce16(float x) { x += dpp_get<0xB1>(x); x += dpp_get<0x4E>(x); x += dpp_get<0x141>(x); x += dpp_get<0x140>(x); return x; }
#define RW_BAR() do { asm volatile("s_waitcnt lgkmcnt(0)" ::: "memory"); __builtin_amdgcn_s_barrier(); asm volatile("" ::: "memory"); } while (0)
PH_FN void rw_unit(const Ctx C, int chain, int rq) {
    const float* RWW = (const float*)(C.ws + WS_RWW); const bf16* RWR = (const bf16*)(C.ws + WS_RWR); const bf16* RWK = (const bf16*)(C.ws + WS_RWK); const bf16* RWV = (const bf16*)(C.ws + WS_RWV);
    const bf16* RWKK = (const bf16*)(C.ws + WS_RWKK); const bf16* RWB = (const bf16*)(C.ws + WS_RWB); bf16* RWY = (bf16*)(C.ws + WS_RWY);
    const int b = chain >> 3, h = chain & 7; const size_t rowb = (size_t)b * SEQ;
    constexpr int BUFB = 43008, O_KK = 0, O_W = 8192, O_B = 16384, O_K = 24576, O_R = 32768, O_V = 40960, NBLK = SEQ / 32;
    LAS unsigned char* L = C.lds;
    if (C.wave >= 4) {
        const int p = C.tid - 256, t = p >> 3, c8 = (p & 7) * 8;
        u32x4 rr, rk, rkk, rb; f32x4 w0, w1; unsigned rv;
#define RW_LOAD(blk) do { const size_t g_ = (rowb + (size_t)(blk) * 32 + t) * 512 + h * 64; \
            w0 = *(const f32x4*)(RWW + g_ + c8); w1 = *(const f32x4*)(RWW + g_ + c8 + 4); rr = *(const u32x4*)(RWR + g_ + c8); rk = *(const u32x4*)(RWK + g_ + c8); \
            rkk = *(const u32x4*)(RWKK + g_ + c8); rb = *(const u32x4*)(RWB + g_ + c8); rv = *(const unsigned*)(RWV + g_ + 16 * rq + (p & 7) * 2); } while (0)
#define RW_ST8(off, w_) do { float o_[8]; unpack8(w_, o_); LF d_ = (LF)(Lb + (off)) + t * 64 + c8; *(LAS f32x4*)d_ = (f32x4){o_[0], o_[1], o_[2], o_[3]}; *(LAS f32x4*)(d_ + 4) = (f32x4){o_[4], o_[5], o_[6], o_[7]}; } while (0)
        RW_LOAD(0);
        for (int blk = 0; blk < NBLK; ++blk) {
            LAS unsigned char* Lb = L + (blk & 1) * BUFB;
            { LF d = (LF)(Lb + O_W) + t * 64 + c8; *(LAS f32x4*)d = w0; *(LAS f32x4*)(d + 4) = w1; }
            RW_ST8(O_R, rr); RW_ST8(O_K, rk); RW_ST8(O_KK, rkk); RW_ST8(O_B, rb);
            { LF d = (LF)(Lb + O_V) + t * 16 + (p & 7) * 2; d[0] = bflo(rv); d[1] = bfhi(rv); }
            if (blk + 1 < NBLK) RW_LOAD(blk + 1);
            RW_BAR();
        }
        RW_BAR();
#undef RW_LOAD
#undef RW_ST8
    } else {
        const int rowl = C.lane >> 4, ks = C.lane & 15, row = 4 * C.wave + rowl;
        float S0 = 0.f, S1 = 0.f, S2 = 0.f, S3 = 0.f, ykeep = 0.f;
        bf16* yout = RWY + rowb * 512 + h * 64 + 16 * rq + row;
        for (int blk = 0; blk < NBLK; ++blk) {
            RW_BAR();
            const LAS unsigned char* Lb = L + (blk & 1) * BUFB;
            CLF pKK = (CLF)(Lb + O_KK) + 4 * ks; CLF pW = (CLF)(Lb + O_W) + 4 * ks; CLF pB = (CLF)(Lb + O_B) + 4 * ks; CLF pK = (CLF)(Lb + O_K) + 4 * ks; CLF pR = (CLF)(Lb + O_R) + 4 * ks; CLF pV = (CLF)(Lb + O_V) + row;
            f32x4 kk = *(const LAS f32x4*)pKK, w = *(const LAS f32x4*)pW, bb = *(const LAS f32x4*)pB, k = *(const LAS f32x4*)pK, r = *(const LAS f32x4*)pR; float vv = *pV;
#pragma unroll 4
            for (int t = 0; t < 32; ++t) {
                f32x4 nkk, nw, nb, nk, nr; float nv;
                const int tn = (t < 31) ? t + 1 : t;
                nkk = *(const LAS f32x4*)(pKK + tn * 64); nw = *(const LAS f32x4*)(pW + tn * 64); nb = *(const LAS f32x4*)(pB + tn * 64); nk = *(const LAS f32x4*)(pK + tn * 64); nr = *(const LAS f32x4*)(pR + tn * 64); nv = pV[tn * 16];
                float sa = (S0 * kk[0] + S1 * kk[1]) + (S2 * kk[2] + S3 * kk[3]);
                sa = -reduce16(sa);
                const float vk0 = vv * k[0], vk1 = vv * k[1], vk2 = vv * k[2], vk3 = vv * k[3];
                S0 = S0 * w[0] + (sa * bb[0] + vk0); S1 = S1 * w[1] + (sa * bb[1] + vk1); S2 = S2 * w[2] + (sa * bb[2] + vk2); S3 = S3 * w[3] + (sa * bb[3] + vk3);
                float y = (S0 * r[0] + S1 * r[1]) + (S2 * r[2] + S3 * r[3]);
                y = reduce16(y);
                if ((t & 15) == ks) ykeep = y;
                if ((t & 15) == 15) yout[(size_t)(blk * 32 + (t & 16) + ks) * 512] = (bf16)f2bf(ykeep);
                kk = nkk; w = nw; bb = nb; k = nk; r = nr; vv = nv;
            }
        }
        RW_BAR();
    }
}
PH_FN void ph_rw_out(const Ctx C, ArgsP a, int l) {
    const bf16* RWR = (const bf16*)(C.ws + WS_RWR); const bf16* RWK = (const bf16*)(C.ws + WS_RWK); const bf16* RWV = (const bf16*)(C.ws + WS_RWV); const bf16* RWG = (const bf16*)(C.ws + WS_RWG); const bf16* RWY = (const bf16*)(C.ws + WS_RWY);
    bf16* YS = (bf16*)(C.ws + WS_YS);
    const float* r_k = a->in[29] + (size_t)l * 512; const float* nw = a->in[30] + (size_t)l * 512; const float* nb = a->in[31] + (size_t)l * 512;
    const int gw = C.bid * NWAVES + C.wave, NGW = C.G * NWAVES;
    for (int it = gw; it < M * 8; it += NGW) {
        const size_t row = (size_t)(it >> 3); const int h = it & 7, c = h * 64 + C.lane; const size_t g = row * 512 + c;
        const float y = bf2f(RWY[g]), r = bf2f(RWR[g]), k = bf2f(RWK[g]), v = bf2f(RWV[g]), gg = bf2f(RWG[g]);
        const float mu = wave_sum(y) * (1.0f / 64.0f); const float d = y - mu; const float var = wave_sum(d * d) * (1.0f / 64.0f);
        const float yn = d * (1.0f / sqrtf(var + 64e-5f)) * nw[c] + nb[c];
        const float bonus = wave_sum(r * k * r_k[c]) * v;
        YS[row * 2048 + 1536 + c] = (bf16)f2bf((yn + bonus) * gg);
    }
}

__device__ __forceinline__ int pi_swap23(int i) { return (i & ~12) | ((i & 4) << 1) | ((i & 8) >> 1); }
__device__ __forceinline__ void da_unit(const Ctx& C, const Args& a, int l, int b, int h, int jq, float lam, float oml) {
    const bf16* P = (const bf16*)(C.ws + WS_P); const bf16* VT = (const bf16*)(C.ws + WS_VT); bf16* YS = (bf16*)(C.ws + WS_YS);
    const float* dnorm = a.in[11] + (size_t)l * 128;
    const int comp = C.wave >> 2, wq = C.wave & 3, q = C.lane & 31, hi = C.lane >> 5;
    const size_t qrow = (size_t)b * SEQ + jq * 128 + wq * 32 + q;
    pg8::bf16x8 qf[4];
#pragma unroll
    for (int d0 = 0; d0 < 4; ++d0) qf[d0] = *(const pg8::bf16x8*)(P + qrow * NPM + C_DAQ + h * 128 + comp * 64 + 16 * d0 + 8 * hi);
    const int ntile = 2 * jq + 2, my_last = 2 * jq + (wq >= 2 ? 1 : 0);
    f32x16 O[4];
#pragma unroll
    for (int db = 0; db < 4; ++db)
#pragma unroll
        for (int r = 0; r < 16; ++r) O[db][r] = 0.f;
    float mrun = -1e30f, lrun = 0.f;
    const bf16* kg = P + ((size_t)b * SEQ + (C.tid & 63)) * NPM + C_DAK + h * 128;
    const bf16* vg = VT + ((size_t)(b * 4 + h) * 128 + (C.tid & 127)) * SEQ;
    const int kc16 = C.tid >> 6, vc8 = C.tid >> 7;
    u32x4 kr[2], vr[2];
#pragma unroll
    for (int i = 0; i < 2; ++i) { kr[i] = *(const u32x4*)(kg + (kc16 + 8 * i) * 8); vr[i] = *(const u32x4*)(vg + (vc8 + 4 * i) * 8); }
    const int pq = pi_swap23(q);
    for (int tile = 0; tile < ntile; ++tile) {
        LAS unsigned char* buf = C.lds + (tile & 1) * 32768;
#pragma unroll
        for (int i = 0; i < 2; ++i) { const int c16 = kc16 + 8 * i; *(LAS u32x4*)(buf + (c16 >> 3) * 8192 + (c16 & 7) * 1024 + (C.tid & 63) * 16) = kr[i];
            *(LAS u32x4*)(buf + 16384 + (vc8 + 4 * i) * 2048 + (C.tid & 127) * 16) = vr[i]; }
        WG_SYNC();
        if (tile + 1 < ntile) {
#pragma unroll
            for (int i = 0; i < 2; ++i) { kr[i] = *(const u32x4*)(kg + (size_t)(tile + 1) * 64 * NPM + (kc16 + 8 * i) * 8); vr[i] = *(const u32x4*)(vg + (tile + 1) * 64 + (vc8 + 4 * i) * 8); } }
        if (tile <= my_last) {
            const LAS unsigned char* kb = buf + comp * 8192; const LAS unsigned char* vb = buf + 16384;
            f32x16 p0, p1;
#pragma unroll
            for (int r = 0; r < 16; ++r) { p0[r] = 0.f; p1[r] = 0.f; }
#pragma unroll
            for (int d0 = 0; d0 < 4; ++d0) {
                const pg8::bf16x8 a0 = *(const LAS pg8::bf16x8*)(kb + (2 * d0 + hi) * 1024 + pq * 16);
                const pg8::bf16x8 a1 = *(const LAS pg8::bf16x8*)(kb + (2 * d0 + hi) * 1024 + (32 + pq) * 16);
                p0 = __builtin_amdgcn_mfma_f32_32x32x16_bf16(a0, qf[d0], p0, 0, 0, 0);
                p1 = __builtin_amdgcn_mfma_f32_32x32x16_bf16(a1, qf[d0], p1, 0, 0, 0);
            }
            float mx = fmaxf(p0[0], p1[0]);
#pragma unroll
            for (int r = 1; r < 16; ++r) mx = fmaxf(mx, fmaxf(p0[r], p1[r]));
            mx = fmaxf(mx, __shfl_xor(mx, 32));
            const float mnew = fmaxf(mrun, mx); const float alpha = __builtin_amdgcn_exp2f(mrun - mnew); mrun = mnew;
            float rs = 0.f;
#pragma unroll
            for (int r = 0; r < 16; ++r) { p0[r] = __builtin_amdgcn_exp2f(p0[r] - mnew); p1[r] = __builtin_amdgcn_exp2f(p1[r] - mnew); rs += p0[r] + p1[r]; }
            lrun = lrun * alpha + rs;
#pragma unroll
            for (int db = 0; db < 4; ++db)
#pragma unroll
                for (int r = 0; r < 16; ++r) O[db][r] *= alpha;
            pg8::bf16x8 pb[4];
            { u32x4 w;
              w.x = pk2(p0[0], p0[1]); w.y = pk2(p0[2], p0[3]); w.z = pk2(p0[4], p0[5]); w.w = pk2(p0[6], p0[7]); pb[0] = __builtin_bit_cast(pg8::bf16x8, w);
              w.x = pk2(p0[8], p0[9]); w.y = pk2(p0[10], p0[11]); w.z = pk2(p0[12], p0[13]); w.w = pk2(p0[14], p0[15]); pb[1] = __builtin_bit_cast(pg8::bf16x8, w);
              w.x = pk2(p1[0], p1[1]); w.y = pk2(p1[2], p1[3]); w.z = pk2(p1[4], p1[5]); w.w = pk2(p1[6], p1[7]); pb[2] = __builtin_bit_cast(pg8::bf16x8, w);
              w.x = pk2(p1[8], p1[9]); w.y = pk2(p1[10], p1[11]); w.z = pk2(p1[12], p1[13]); w.w = pk2(p1[14], p1[15]); pb[3] = __builtin_bit_cast(pg8::bf16x8, w); }
#pragma unroll
            for (int db = 0; db < 4; ++db)
#pragma unroll
                for (int s = 0; s < 4; ++s) {
                    const pg8::bf16x8 vf = *(const LAS pg8::bf16x8*)(vb + (2 * s + hi) * 2048 + (32 * db + q) * 16);
                    O[db] = __builtin_amdgcn_mfma_f32_32x32x16_bf16(vf, pb[s], O[db], 0, 0, 0);
                }
        }
    }
    const float ltot = lrun + __shfl_xor(lrun, 32); const float inv = 1.0f / ltot;
    WG_SYNC();
    LF X = (LF)C.lds + (wq * 32 + q) * 132;
    if (comp == 1) {
        const float sc = inv * lam;
#pragma unroll
        for (int db = 0; db < 4; ++db)
#pragma unroll
            for (int g4 = 0; g4 < 4; ++g4) *(LAS f32x4*)(X + 32 * db + 8 * g4 + 4 * hi) = (f32x4){O[db][4 * g4] * sc, O[db][4 * g4 + 1] * sc, O[db][4 * g4 + 2] * sc, O[db][4 * g4 + 3] * sc};
    }
    WG_SYNC();
    if (comp == 0) {
        float ss = 0.f;
#pragma unroll
        for (int db = 0; db < 4; ++db)
#pragma unroll
            for (int g4 = 0; g4 < 4; ++g4) { const f32x4 x = *(const LAS f32x4*)(X + 32 * db + 8 * g4 + 4 * hi);
#pragma unroll
                for (int e = 0; e < 4; ++e) { const float v = O[db][4 * g4 + e] * inv - x[e]; O[db][4 * g4 + e] = v; ss += v * v; } }
        ss += __shfl_xor(ss, 32);
        const float rs = oml / sqrtf(ss * (1.0f / 128.0f) + EPS);
#pragma unroll
        for (int db = 0; db < 4; ++db)
#pragma unroll
            for (int g4 = 0; g4 < 4; ++g4) { const int d = 32 * db + 8 * g4 + 4 * hi; const f32x4 gn = *(const f32x4*)(dnorm + d);
                u32x2 w; w.x = pk2(O[db][4 * g4] * rs * gn[0], O[db][4 * g4 + 1] * rs * gn[1]); w.y = pk2(O[db][4 * g4 + 2] * rs * gn[2], O[db][4 * g4 + 3] * rs * gn[3]);
                *(u32x2*)(YS + qrow * 2048 + h * 128 + d) = w; }
    }
    WG_SYNC();
}
#if RW_CHUNKED
__device__ const signed char ATT_BINS30[30][3] = {{63,4,3}, {62,5,2}, {61,6,1}, {60,7,0}, {59,8,-1}, {58,9,-1}, {57,10,-1}, {56,11,-1}, {55,12,-1}, {54,13,-1}, {53,14,-1}, {52,15,-1}, {51,16,-1}, {50,17,-1}, {49,18,-1}, {48,19,-1}, {47,20,-1}, {46,21,-1}, {45,22,-1}, {44,23,-1}, {43,24,-1}, {42,25,-1}, {41,26,-1}, {40,27,-1}, {39,28,-1}, {38,29,-1}, {37,30,-1}, {36,31,-1}, {35,32,-1}, {34,33,-1}};
__device__ __forceinline__ int att_bin_unit(int bin, int i) { return i < 3 ? (int)ATT_BINS30[bin][i] : -1; }
#else
__device__ const signed char ATT_BINS[24][12] = {{63,21,-1,-1,-1,-1,-1,-1,-1,-1,-1,-1}, {62,22,-1,-1,-1,-1,-1,-1,-1,-1,-1,-1}, {61,23,-1,-1,-1,-1,-1,-1,-1,-1,-1,-1}, {60,24,-1,-1,-1,-1,-1,-1,-1,-1,-1,-1}, {59,25,-1,-1,-1,-1,-1,-1,-1,-1,-1,-1}, {58,26,-1,-1,-1,-1,-1,-1,-1,-1,-1,-1}, {57,27,-1,-1,-1,-1,-1,-1,-1,-1,-1,-1}, {56,28,-1,-1,-1,-1,-1,-1,-1,-1,-1,-1}, {55,29,-1,-1,-1,-1,-1,-1,-1,-1,-1,-1}, {54,30,-1,-1,-1,-1,-1,-1,-1,-1,-1,-1}, {53,31,-1,-1,-1,-1,-1,-1,-1,-1,-1,-1}, {52,32,-1,-1,-1,-1,-1,-1,-1,-1,-1,-1}, {51,33,-1,-1,-1,-1,-1,-1,-1,-1,-1,-1}, {50,34,-1,-1,-1,-1,-1,-1,-1,-1,-1,-1}, {49,35,-1,-1,-1,-1,-1,-1,-1,-1,-1,-1}, {48,36,-1,-1,-1,-1,-1,-1,-1,-1,-1,-1}, {47,37,-1,-1,-1,-1,-1,-1,-1,-1,-1,-1}, {46,38,-1,-1,-1,-1,-1,-1,-1,-1,-1,-1}, {45,39,-1,-1,-1,-1,-1,-1,-1,-1,-1,-1}, {44,40,-1,-1,-1,-1,-1,-1,-1,-1,-1,-1}, {43,41,-1,-1,-1,-1,-1,-1,-1,-1,-1,-1}, {42,20,19,6,-1,-1,-1,-1,-1,-1,-1,-1}, {18,17,16,15,14,5,-1,-1,-1,-1,-1,-1}, {13,12,11,10,9,8,7,4,3,2,1,0}};
__device__ __forceinline__ int att_bin_unit(int bin, int i) { return i < 12 ? (int)ATT_BINS[bin][i] : -1; }
#endif
__device__ __forceinline__ void ph_da_attn(const Ctx& C, const Args& a, int l, int bh, int bin) {
    const float* q1 = a.in[7] + (size_t)l * 64; const float* k1 = a.in[8] + (size_t)l * 64; const float* q2 = a.in[9] + (size_t)l * 64; const float* k2 = a.in[10] + (size_t)l * 64;
    float s1 = 0.f, s2 = 0.f;
    for (int i = 0; i < 64; ++i) { s1 += q1[i] * k1[i]; s2 += q2[i] * k2[i]; }
    const float lam_init = 0.8f - 0.6f * expf(-0.3f * (float)l); const float lam = expf(s1) - expf(s2) + lam_init;
    for (int i = 0; i < 12; ++i) { const int jq = att_bin_unit(bin, i); if (jq < 0) break; da_unit(C, a, l, bh >> 2, bh & 3, jq, lam, 1.0f - lam_init); }
}

PH_FN void ph_final(const Ctx C, ArgsP a) {
    const float* ssq = (const float*)(C.ws + WS_SSQ); const float* fn = a->in[39];
    const int gw = C.bid * NWAVES + C.wave, NGW = C.G * NWAVES;
    for (int m = gw; m < M; m += NGW) { const float rs = pg8::row_rstd(ssq, m, M); f32x4* hr = (f32x4*)(C.h + (size_t)m * D) + C.lane; const f32x4* gr = (const f32x4*)fn + C.lane;
#pragma unroll
        for (int j = 0; j < 4; ++j) { const f32x4 v = hr[64 * j], g = gr[64 * j]; hr[64 * j] = v * rs * g; } }
}
#define RWC_PTRS \
    float* RWW = (float*)(C.ws + WS_RWW); const bf16* RWR = (const bf16*)(C.ws + WS_RWR); const bf16* RWK = (const bf16*)(C.ws + WS_RWK); const bf16* RWV = (const bf16*)(C.ws + WS_RWV); \
    bf16* RWKK = (bf16*)(C.ws + WS_RWKK); bf16* RWB = (bf16*)(C.ws + WS_RWB); bf16* RWY = (bf16*)(C.ws + WS_RWY); \
    LF LGs = (LF)C.lds; LB LP = (LB)C.lds; LB LPT = (LB)(C.lds + 9216); LB AT = (LB)(C.lds + 18432); LB LAK = AT; LB LP2 = AT; LB RT = (LB)(C.lds + 27648); LB BTl = (LB)(C.lds + 36864); LB MRB = BTl; LB KTl = (LB)(C.lds + 46080); LB MRK = KTl; \
    LB VT = (LB)(C.lds + 55296); LB BHT = (LB)(C.lds + 64512); LB KHT = (LB)(C.lds + 73728); LB XB0 = (LB)(C.lds + 82944); LB XB1 = (LB)(C.lds + 101376); LB LPT2 = (LB)(C.lds + 119808); LF rho = (LF)(C.lds + 129024); LF lgl = rho + 64; \
    const int t = C.tid >> 3, g8 = C.tid & 7, n = C.lane & 31, hi = C.lane >> 5; \
    (void)RWW; (void)RWR; (void)RWK; (void)RWV; (void)RWKK; (void)RWB; (void)RWY; (void)LGs; (void)LP; (void)LPT; (void)AT; (void)LAK; (void)LP2; (void)RT; (void)BTl; (void)MRB; (void)KTl; (void)MRK; (void)VT; (void)BHT; (void)KHT; (void)XB0; (void)XB1; (void)LPT2; (void)rho; (void)lgl; (void)t; (void)g8; (void)n; (void)hi;
PH_FN void rwc_stage0(const Ctx C, int bc, int h) {
    RWC_PTRS
    const size_t row0 = (size_t)bc * 64; const size_t g = (row0 + t) * 512 + h * 64 + g8 * 8;
    WG_SYNC();
    float lw[8]; { const f32x4 x0 = *(const f32x4*)(RWW + g), x1 = *(const f32x4*)(RWW + g + 4); lw[0] = x0[0]; lw[1] = x0[1]; lw[2] = x0[2]; lw[3] = x0[3]; lw[4] = x1[0]; lw[5] = x1[1]; lw[6] = x1[2]; lw[7] = x1[3]; }
#pragma unroll
    for (int i = 0; i < 8; ++i) LGs[t * 68 + g8 * 8 + i] = lw[i];
    WG_SYNC();
    { const int seg = C.tid >> 6, k = C.tid & 63; float run = 0.f;
#pragma unroll
      for (int i = 0; i < 8; ++i) { run += LGs[(8 * seg + i) * 68 + k]; LGs[(8 * seg + i) * 68 + k] = run; }
      WG_SYNC();
      float off = 0.f;
#pragma unroll
      for (int sg = 0; sg < 7; ++sg) { const float tot = LGs[(8 * sg + 7) * 68 + k]; off += (sg < seg) ? tot : 0.f; }
      WG_SYNC();
#pragma unroll
      for (int i = 0; i < 8; ++i) LGs[(8 * seg + i) * 68 + k] += off; }
    WG_SYNC();
    {   float rf[8], kf[8], kkf[8], bf[8], lg[8], rh[8], ll[8], o1[8], o2[8], o3[8], o4[8];
        unpack8(*(const u32x4*)(RWR + g), rf); unpack8(*(const u32x4*)(RWK + g), kf); unpack8(*(const u32x4*)(RWKK + g), kkf); unpack8(*(const u32x4*)(RWB + g), bf);
#pragma unroll
        for (int i = 0; i < 8; ++i) { const int k = g8 * 8 + i; lg[i] = LGs[t * 68 + k]; rh[i] = LGs[31 * 68 + k]; ll[i] = LGs[63 * 68 + k]; }
#pragma unroll
        for (int i = 0; i < 8; ++i) { const int k = g8 * 8 + i; const float lm1 = lg[i] - lw[i];
            const float ed = __expf(lg[i] - rh[i]), edi = __expf(rh[i] - lg[i]), el = __expf(ll[i] - lg[i]);
            o1[i] = -kkf[i] * __expf(lm1 - rh[i]); o2[i] = rf[i] * ed; o3[i] = bf[i] * edi; o4[i] = kf[i] * edi;
            XB0[k * 72 + t] = (bf16)f2bf(-kkf[i] * __expf(lm1));
            BHT[k * 72 + t] = (bf16)f2bf(bf[i] * el); KHT[k * 72 + t] = (bf16)f2bf(kf[i] * el); }
        *(LAS u32x4*)(AT + t * 72 + g8 * 8) = pack8(o1); *(LAS u32x4*)(RT + t * 72 + g8 * 8) = pack8(o2); *(LAS u32x4*)(BTl + t * 72 + g8 * 8) = pack8(o3); *(LAS u32x4*)(KTl + t * 72 + g8 * 8) = pack8(o4);
        const u32x4 vv = *(const u32x4*)(RWV + g); const unsigned vw[4] = {vv.x, vv.y, vv.z, vv.w};
#pragma unroll
        for (int i = 0; i < 4; ++i) { VT[(g8 * 8 + 2 * i) * 72 + t] = (bf16)(vw[i] & 0xffffu); VT[(g8 * 8 + 2 * i + 1) * 72 + t] = (bf16)(vw[i] >> 16); }
        if (t == 0) {
#pragma unroll
            for (int i = 0; i < 8; ++i) { rho[g8 * 8 + i] = rh[i]; lgl[g8 * 8 + i] = ll[i]; } }
    }
    WG_SYNC();
}
PH_FN void rwc_stage12(const Ctx C) {
    RWC_PTRS
    {   const int mt = C.wave >> 1, nt0 = 2 * (C.wave & 1);
        CLB Am = (mt < 2) ? (CLB)AT : (CLB)RT; const int m0 = 32 * (mt & 1);
        CLB Bm = (nt0 < 2) ? (CLB)BTl : (CLB)KTl;
        f32x16 c0 = zero16(), c1 = zero16();
        mma_nt<64>(c0, Am, 72, m0, Bm, 72, 0, C.lane); mma_nt<64>(c1, Am, 72, m0, Bm, 72, 32, C.lane);
        WG_SYNC();
#pragma unroll
        for (int r = 0; r < 16; ++r) { const int tt = m0 + crow(r, hi); const int j0 = n, j1 = 32 + n;
            if (mt < 2) { const bf16 x0 = (bf16)f2bf((j0 < tt) ? c0[r] : 0.f), x1 = (bf16)f2bf((j1 < tt) ? c1[r] : 0.f);
                if (nt0 < 2) { LP[tt * 72 + j0] = x0; LP[tt * 72 + j1] = x1; LPT[j0 * 72 + tt] = x0; LPT[j1 * 72 + tt] = x1; } else { LAK[tt * 72 + j0] = x0; LAK[tt * 72 + j1] = x1; } }
            else { const bf16 x0 = (bf16)f2bf((j0 <= tt) ? c0[r] : 0.f), x1 = (bf16)f2bf((j1 <= tt) ? c1[r] : 0.f);
                if (nt0 < 2) { MRB[tt * 72 + j0] = x0; MRB[tt * 72 + j1] = x1; } else { MRK[tt * 72 + j0] = x0; MRK[tt * 72 + j1] = x1; } } }
    }
    WG_SYNC();
    if (C.wave < 4) { const int vt = C.wave >> 1, tt0 = C.wave & 1; f32x16 c = zero16(); mma_nt<64>(c, VT, 72, 32 * vt, LAK, 72, 32 * tt0, C.lane);
#pragma unroll
        for (int r = 0; r < 16; ++r) XB0[(64 + 32 * vt + crow(r, hi)) * 72 + 32 * tt0 + n] = (bf16)f2bf(c[r]); }
    WG_SYNC();
}
PH_FN void rwc_solve(const Ctx C) {
    RWC_PTRS
    const int ct = C.wave >> 1, tt = C.wave & 1;
    const int sk = C.wave >> 2, st = (C.wave >> 1) & 1, sj = C.wave & 1;
#pragma unroll 1
    for (int i = 0; i < 6; ++i) {
        CLB Pc = (i & 1) ? (CLB)LP2 : (CLB)LP; CLB PTc = (i & 1) ? (CLB)LPT2 : (CLB)LPT; LB Pn = (i & 1) ? LP : LP2; LB PTn = (i & 1) ? LPT : LPT2;
        CLB Xc = (i & 1) ? (CLB)XB1 : (CLB)XB0; LB Xn = (i & 1) ? XB0 : XB1;
        { f32x16 acc;
#pragma unroll
          for (int r = 0; r < 16; ++r) acc[r] = bf2f(Xc[(32 * ct + crow(r, hi)) * 72 + 32 * tt + n]);
          mma_nt<64>(acc, Xc, 72, 32 * ct, Pc, 72, 32 * tt, C.lane);
#pragma unroll
          for (int r = 0; r < 16; ++r) Xn[(32 * ct + crow(r, hi)) * 72 + 32 * tt + n] = (bf16)f2bf(acc[r]); }
        if (i < 5) { f32x16 acc = zero16();
          if (sk == 0) mma_nt<64>(acc, Pc, 72, 32 * st, PTc, 72, 32 * sj, C.lane); else mma_nt<64>(acc, PTc, 72, 32 * st, Pc, 72, 32 * sj, C.lane);
          LB dst = (sk == 0) ? Pn : PTn;
#pragma unroll
          for (int r = 0; r < 16; ++r) dst[(32 * st + crow(r, hi)) * 72 + 32 * sj + n] = (bf16)f2bf(acc[r]); }
        WG_SYNC();
    }
}
PH_FN void rwc_stage4(const Ctx C, int bc, int h) {
    RWC_PTRS
    const size_t row0 = (size_t)bc * 64; CLB A2T = (CLB)XB0; CLB WT = (CLB)(XB0 + 64 * 72);
    {   const int kind = C.wave >> 1, mt = C.wave & 1;
        f32x16 c0 = zero16(), c1 = zero16();
        if (kind == 0) { mma_nt<64>(c0, BHT, 72, 32 * mt, A2T, 72, 0, C.lane); mma_nt<64>(c1, BHT, 72, 32 * mt, A2T, 72, 32, C.lane); }
        else if (kind == 1) { mma_nt<64>(c0, BHT, 72, 32 * mt, WT, 72, 0, C.lane); mma_nt<64>(c1, BHT, 72, 32 * mt, WT, 72, 32, C.lane); mma_nt<64>(c0, KHT, 72, 32 * mt, VT, 72, 0, C.lane); mma_nt<64>(c1, KHT, 72, 32 * mt, VT, 72, 32, C.lane); }
        else if (kind == 2) { mma_nt<64>(c0, MRB, 72, 32 * mt, A2T, 72, 0, C.lane); mma_nt<64>(c1, MRB, 72, 32 * mt, A2T, 72, 32, C.lane); }
        else { mma_nt<64>(c0, MRB, 72, 32 * mt, WT, 72, 0, C.lane); mma_nt<64>(c1, MRB, 72, 32 * mt, WT, 72, 32, C.lane); mma_nt<64>(c0, MRK, 72, 32 * mt, VT, 72, 0, C.lane); mma_nt<64>(c1, MRK, 72, 32 * mt, VT, 72, 32, C.lane); }
#pragma unroll
        for (int r = 0; r < 16; ++r) { const int m = 32 * mt + crow(r, hi); const size_t go = (row0 + m) * 512 + h * 64;
            if (kind == 0) { const float d = __expf(lgl[m]); RWB[go + n] = (bf16)f2bf(c0[r] + ((n == m) ? d : 0.f)); RWB[go + 32 + n] = (bf16)f2bf(c1[r] + ((32 + n == m) ? d : 0.f)); }
            else if (kind == 1) { RWW[go + n] = c0[r]; RWW[go + 32 + n] = c1[r]; }
            else if (kind == 2) { RWKK[go + n] = (bf16)f2bf(c0[r] + bf2f(RT[m * 72 + n]) * __expf(rho[n])); RWKK[go + 32 + n] = (bf16)f2bf(c1[r] + bf2f(RT[m * 72 + 32 + n]) * __expf(rho[32 + n])); }
            else { RWY[go + n] = (bf16)f2bf(c0[r]); RWY[go + 32 + n] = (bf16)f2bf(c1[r]); } }
    }
}
__device__ __forceinline__ void ph_rw_chunk(const Ctx& C, int bc) {
#pragma unroll 1
    for (int h = 0; h < 8; ++h) { rwc_stage0(C, bc, h); rwc_stage12(C); rwc_solve(C); rwc_stage4(C, bc, h); }
    WG_SYNC();
}
PH_FN void rw_scan_unit(const Ctx C, int chain) {
    const float* RWW = (const float*)(C.ws + WS_RWW); const bf16* RWKK = (const bf16*)(C.ws + WS_RWKK); const bf16* RWB = (const bf16*)(C.ws + WS_RWB); bf16* RWY = (bf16*)(C.ws + WS_RWY);
    const int b = chain >> 3, h = chain & 7; const size_t rowb = (size_t)b * SEQ;
    constexpr int BUFB = 45056, O_RQ = 0, O_PT = 9216, O_QT = 18432, O_Y0 = 35840;
    LAS unsigned char* L = C.lds;
    if (C.wave >= 4) {
        const int p = C.tid - 256, t = p >> 2, q4 = (p & 3) * 16;
        u32x4 Arq0, Arq1, Apt0, Apt1, Ay00, Ay01, Brq0, Brq1, Bpt0, Bpt1, By00, By01; f32x4 Aq0, Aq1, Aq2, Aq3, Bq0, Bq1, Bq2, Bq3;
#define SC_LOAD(S, c_) do { const size_t g_ = (rowb + (size_t)(c_) * 64 + t) * 512 + h * 64 + q4; \
            S##rq0 = *(const u32x4*)(RWKK + g_); S##rq1 = *(const u32x4*)(RWKK + g_ + 8); S##pt0 = *(const u32x4*)(RWB + g_); S##pt1 = *(const u32x4*)(RWB + g_ + 8); S##y00 = *(const u32x4*)(RWY + g_); S##y01 = *(const u32x4*)(RWY + g_ + 8); \
            S##q0 = *(const f32x4*)(RWW + g_); S##q1 = *(const f32x4*)(RWW + g_ + 4); S##q2 = *(const f32x4*)(RWW + g_ + 8); S##q3 = *(const f32x4*)(RWW + g_ + 12); } while (0)
#define SC_WRITE(S, Lb) do { \
            *(LAS u32x4*)((LB)((Lb) + O_RQ) + t * 72 + q4) = S##rq0; *(LAS u32x4*)((LB)((Lb) + O_RQ) + t * 72 + q4 + 8) = S##rq1; \
            *(LAS u32x4*)((LB)((Lb) + O_PT) + t * 72 + q4) = S##pt0; *(LAS u32x4*)((LB)((Lb) + O_PT) + t * 72 + q4 + 8) = S##pt1; \
            *(LAS u32x4*)((LB)((Lb) + O_Y0) + t * 72 + q4) = S##y00; *(LAS u32x4*)((LB)((Lb) + O_Y0) + t * 72 + q4 + 8) = S##y01; \
            { LF d_ = (LF)((Lb) + O_QT) + t * 68 + q4; *(LAS f32x4*)d_ = S##q0; *(LAS f32x4*)(d_ + 4) = S##q1; *(LAS f32x4*)(d_ + 8) = S##q2; *(LAS f32x4*)(d_ + 12) = S##q3; } } while (0)
        SC_LOAD(A, 0); SC_LOAD(B, 1);
        for (int c = 0; c < NCH; c += 2) {
            SC_WRITE(A, L); if (c + 2 < NCH) SC_LOAD(A, c + 2); RW_BAR();
            SC_WRITE(B, L + BUFB); if (c + 3 < NCH) SC_LOAD(B, c + 3); RW_BAR();
        }
        RW_BAR();
#undef SC_LOAD
#undef SC_WRITE
    } else {
        const int n = C.lane & 31, hi = C.lane >> 5, vh = C.wave & 1;
        f32x16 st0 = zero16(), st1 = zero16();
        for (int c = 0; c < NCH; ++c) {
            RW_BAR();
            if (C.wave < 2) {
                const LAS unsigned char* Lb = L + (c & 1) * BUFB;
                CLB RQ = (CLB)(Lb + O_RQ); CLB PT = (CLB)(Lb + O_PT); CLF QT = (CLF)(Lb + O_QT); CLB Y0 = (CLB)(Lb + O_Y0);
                pg8::bf16x8 sb[4];
                { u32x4 w;
                  w.x = pk2(st0[0], st0[1]); w.y = pk2(st0[2], st0[3]); w.z = pk2(st0[4], st0[5]); w.w = pk2(st0[6], st0[7]); sb[0] = __builtin_bit_cast(pg8::bf16x8, w);
                  w.x = pk2(st0[8], st0[9]); w.y = pk2(st0[10], st0[11]); w.z = pk2(st0[12], st0[13]); w.w = pk2(st0[14], st0[15]); sb[1] = __builtin_bit_cast(pg8::bf16x8, w);
                  w.x = pk2(st1[0], st1[1]); w.y = pk2(st1[2], st1[3]); w.z = pk2(st1[4], st1[5]); w.w = pk2(st1[6], st1[7]); sb[2] = __builtin_bit_cast(pg8::bf16x8, w);
                  w.x = pk2(st1[8], st1[9]); w.y = pk2(st1[10], st1[11]); w.z = pk2(st1[12], st1[13]); w.w = pk2(st1[14], st1[15]); sb[3] = __builtin_bit_cast(pg8::bf16x8, w); }
#define SC_AFRAG(X_, row_, s_) ({ const u32x2 lo_ = *(const LAS u32x2*)((X_) + (row_) * 72 + 16 * (s_) + 4 * hi), hi_ = *(const LAS u32x2*)((X_) + (row_) * 72 + 16 * (s_) + 8 + 4 * hi); \
                    u32x4 w_; w_.x = lo_.x; w_.y = lo_.y; w_.z = hi_.x; w_.w = hi_.y; __builtin_bit_cast(pg8::bf16x8, w_); })
#pragma unroll
                for (int tt = 0; tt < 2; ++tt) { f32x16 y;
#pragma unroll
                    for (int r = 0; r < 16; ++r) y[r] = bf2f(Y0[(32 * tt + crow(r, hi)) * 72 + 32 * vh + n]);
#pragma unroll
                    for (int s = 0; s < 4; ++s) y = __builtin_amdgcn_mfma_f32_32x32x16_bf16(SC_AFRAG(RQ, 32 * tt + n, s), sb[s], y, 0, 0, 0);
                    bf16* yo = RWY + (rowb + (size_t)c * 64 + 32 * tt) * 512 + h * 64 + 32 * vh + n;
#pragma unroll
                    for (int r = 0; r < 16; ++r) yo[(size_t)crow(r, hi) * 512] = (bf16)f2bf(y[r]); }
                f32x16 n0, n1;
#pragma unroll
                for (int r = 0; r < 16; ++r) { n0[r] = QT[crow(r, hi) * 68 + 32 * vh + n]; n1[r] = QT[(32 + crow(r, hi)) * 68 + 32 * vh + n]; }
#pragma unroll
                for (int s = 0; s < 4; ++s) { n0 = __builtin_amdgcn_mfma_f32_32x32x16_bf16(SC_AFRAG(PT, n, s), sb[s], n0, 0, 0, 0); n1 = __builtin_amdgcn_mfma_f32_32x32x16_bf16(SC_AFRAG(PT, 32 + n, s), sb[s], n1, 0, 0, 0); }
                st0 = n0; st1 = n1;
#undef SC_AFRAG
            }
        }
        RW_BAR();
    }
}
#ifndef REP_ATTN
#define REP_ATTN 1
#endif
#ifndef REP_W
#define REP_W 1
#endif
#ifndef REP_RWC
#define REP_RWC 1
#endif
#ifndef REP_MA
#define REP_MA 1
#endif
#ifndef REP_MAFULL
#define REP_MAFULL 1
#endif
#ifndef REP_SCANS
#define REP_SCANS 1
#endif
#ifndef REP_MC
#define REP_MC 1
#endif
#ifndef REP_GEMM
#define REP_GEMM 1
#endif
constexpr int NPH = 12, G_FINAL = 1 + NL * NPH, G_END = G_FINAL + 1;
template <int GRP>
__global__ void __launch_bounds__(NTHR, 2) hybrid_fwd(Args args) {
    constexpr bool ALL = (GRP < 0);
    constexpr bool EN_G1 = ALL || GRP == 0, EN_G2 = EN_G1, EN_G3 = EN_G1, EN_G7 = EN_G1, EN_G8 = EN_G1, EN_G9 = EN_G1;
    constexpr bool EN_PRO = ALL || GRP == 1, EN_W = EN_PRO, EN_FIN = EN_PRO, EN_MA1 = EN_PRO, EN_MA2 = EN_PRO, EN_MA3 = EN_PRO, EN_MA4 = EN_PRO;
    constexpr bool EN_MB1 = ALL || GRP == 2, EN_MB2 = EN_MB1;
    constexpr bool EN_MC1 = ALL || GRP == 3, EN_MC2 = EN_MC1, EN_MC3 = EN_MC1;
    extern __shared__ __attribute__((aligned(16))) unsigned char lds[];
    Ctx C; C.lds = (LAS unsigned char*)lds; C.ws = args.ws; C.h = args.out; C.tid = threadIdx.x; C.lane = C.tid & 63; C.wave = __builtin_amdgcn_readfirstlane(C.tid >> 6); C.bid = blockIdx.x; C.G = gridDim.x;
    LAS unsigned char* ldsl = (LAS unsigned char*)lds;
    const ArgsP ap = (ArgsP)__builtin_amdgcn_kernarg_segment_ptr();
    for (int u = C.tid; u < (LDS_BYTES - LDSCTL_OFF) / 4; u += NTHR) ((LAS unsigned*)(ldsl + LDSCTL_OFF))[u] = 0u;
    __syncthreads();
    volatile LAS unsigned* MISC = (volatile LAS unsigned*)(ldsl + MISC_OFF);
    gu32* ctl = (gu32*)(args.ws + WS_CTL);
    const int g_lo = args.g_lo, g_hi = args.g_hi;
    XcdBarrier bar; bar.bar = (unsigned*)(ctl + CW_BAR); bar.x = 0; bar.st = nullptr;
    if (g_hi - g_lo > 1) bar = xcd_barrier_post((unsigned*)(ctl + CW_BAR), MISC + 8);
#define IN(g) (g_lo <= (g) && (g) < g_hi)
#define SEAM(g) do { if (IN(g) && IN((g) + 1)) xcd_barrier(bar); } while (0)
    bf16* HB = (bf16*)(args.ws + WS_HB); float* SSQ = (float*)(args.ws + WS_SSQ);

    if (EN_PRO && IN(0)) ph_prologue(fresh(C), ap);
    SEAM(0);
#pragma unroll 1
    for (int l = 0; l < NL; ++l) {
        const int gb = 1 + NPH * l;
        if (EN_W && IN(gb + 0)) { for (int rep = 0; rep < REP_W; ++rep) ph_weights(fresh(C), ap, l); }
        SEAM(gb + 0);
#pragma unroll 1
        for (int f = 0; f < 2; ++f) {
            const int gu = gb + (f ? 10 : 1);
            if (EN_G1 && IN(gu)) {
                pg8::Gemm g{HB, (const bf16*)(args.ws + (f ? WS_WGU2 : WS_WGU1)), M, 2 * FF, D, D}; pg8::StaticOrder S; S.init(M, 2 * FF, C.G, C.bid);
                pg8::EpiSwiglu E{(bf16*)(args.ws + WS_ACT), FF, SSQ, M};
                pg8::gemm_phase<pg8::EpiSwiglu, pg8::StaticOrder, true, true>(ldsl, g, S, E);
            }
            SEAM(gu);
            if (EN_G2 && IN(gu + 1)) {
                pg8::Gemm g{(const bf16*)(args.ws + WS_ACT), (const bf16*)(args.ws + (f ? WS_WD2 : WS_WD1)), M, D, FF, FF}; pg8::StaticOrder S; S.init(M, D, C.G, C.bid);
                pg8::EpiResid E{C.h, HB, SSQ, M, 0.5f};
                pg8::gemm_phase<pg8::EpiResid, pg8::StaticOrder, false, true>(ldsl, g, S, E);
            }
            SEAM(gu + 1);
            if (f == 0) {
                if (EN_G3 && IN(gb + 3)) {
                    pg8::Gemm g{HB, (const bf16*)(args.ws + WS_WIN), M, NPM, D, D}; pg8::StaticOrder S; S.init(M, NPM, C.G, C.bid);
                    pg8::EpiScaleBf16 E{(bf16*)(args.ws + WS_P), NPM, SSQ, M};
                    pg8::gemm_phase<pg8::EpiScaleBf16, pg8::StaticOrder, true, true>(ldsl, g, S, E);
                }
                SEAM(gb + 3);
                if (IN(gb + 4)) { if (EN_MA1) ph_da_prep(fresh(C)); for (int rf = 0; rf < REP_MAFULL; ++rf) { for (int rep = 0; rep < REP_MA; ++rep) { if (EN_MA2) ph_gla_a(fresh(C), ap, l); if (EN_MA3) ph_ssd_a(fresh(C), ap, l); if (EN_MA4) ph_rw_prep(fresh(C), ap, l); } if (EN_MA4 && RW_CHUNKED) ph_rw_chunk(fresh(C), C.bid); } }
                SEAM(gb + 4);
                if (IN(gb + 5)) {
#if RW_CHUNKED
#define MB_SCANS() do { if (EN_MB2) { if (C.bid < 16) rw_scan_unit(fresh(C), C.bid); else { for (int p = C.bid - 16; p < 384; p += C.G - 16) { if (p < 128) gla_scan_part(fresh(C), p); else ssd_scan_part(fresh(C), p - 128); } } } } while (0)
                    MB_SCANS();
                    for (int rs = 1; rs < REP_SCANS; ++rs) {
                        xcd_barrier(bar); if (EN_MA2) ph_gla_a(fresh(C), ap, l); if (EN_MA3) ph_ssd_a(fresh(C), ap, l); if (EN_MA4) { ph_rw_prep(fresh(C), ap, l); ph_rw_chunk(fresh(C), C.bid); } xcd_barrier(bar); MB_SCANS(); }
                    if (C.bid >= 16) { const int a = C.bid - 16; for (int rep = 0; rep < REP_ATTN; ++rep) if (EN_MB1) ph_da_attn(fresh(C), args, l, a & 7, a >> 3); }
#else
                    if (C.bid < 64) { if (EN_MB2) { const int xcd = C.bid & 7, slot = C.bid >> 3; for (int rep = 0; rep < REP_RWC; ++rep) rw_unit(fresh(C), xcd * 2 + (slot >> 2), slot & 3); } }
                    else { const int a = C.bid - 64;
                        if (EN_MB2) { for (int p = a; p < 384; p += 192) { if (p < 128) gla_scan_part(fresh(C), p); else ssd_scan_part(fresh(C), p - 128); } }
                        for (int rep = 0; rep < REP_ATTN; ++rep) if (EN_MB1) ph_da_attn(fresh(C), args, l, a & 7, a >> 3); }
#endif
                }
                SEAM(gb + 5);
                if (IN(gb + 6)) { for (int rep = 0; rep < REP_MC; ++rep) { if (EN_MC1) ph_gla_c(fresh(C), ap, l); if (EN_MC2) ph_ssd_c(fresh(C), ap, l); if (EN_MC3) ph_rw_out(fresh(C), ap, l); } }
                SEAM(gb + 6);
                if (EN_G7 && IN(gb + 7)) {
                    pg8::Gemm g{HB, (const bf16*)(args.ws + WS_WIN) + (size_t)NPM * D, M, 4096, D, D}; pg8::StaticOrder S; S.init(M, 4096, C.G, C.bid);
                    pg8::EpiScaleBf16 E{(bf16*)(args.ws + WS_PG), 4096, SSQ, M};
                    pg8::gemm_phase<pg8::EpiScaleBf16, pg8::StaticOrder, true, true>(ldsl, g, S, E);
                }
                SEAM(gb + 7);
                if (EN_G8 && IN(gb + 8)) {
                    pg8::Gemm g{(const bf16*)(args.ws + WS_YS), (const bf16*)(args.ws + WS_WB), M, D, 512, 2048}; pg8::GroupedOrder S; S.init(M, D, 4, 512, C.G, C.bid);
                    pg8::EpiGateAcc E{(bf16*)(args.ws + WS_MERGED), (const bf16*)(args.ws + WS_PG), args.in[33] + (size_t)l * 4096};
                    pg8::gemm_phase<pg8::EpiGateAcc, pg8::GroupedOrder, true, true>(ldsl, g, S, E);
                }
                SEAM(gb + 8);
                if (EN_G9 && IN(gb + 9)) {
                    pg8::Gemm g{(const bf16*)(args.ws + WS_MERGED), (const bf16*)(args.ws + WS_WO), M, D, D, D}; pg8::StaticOrder S; S.init(M, D, C.G, C.bid);
                    pg8::EpiResid E{C.h, HB, SSQ, M, 1.0f};
                    pg8::gemm_phase<pg8::EpiResid, pg8::StaticOrder, false, true>(ldsl, g, S, E);
                }
                SEAM(gb + 9);
            }
        }
    }
    if (EN_FIN && IN(G_FINAL)) ph_final(fresh(C), ap);
#undef IN
#undef SEAM
}

#ifndef ONE_LAUNCH
#define ONE_LAUNCH 1
#endif
extern "C" void kernel_launch(void* const* d_in, const int* in_sizes, int n_in, void* d_out, int out_size, void* d_ws, size_t ws_size, hipStream_t stream) {
    static int grid = 0;
    if (grid == 0) {
        if (n_in != 40 || in_sizes[0] != M * D || out_size != M * D || ws_size < WS_END) { fprintf(stderr, "kernel_launch: unexpected shapes (n_in %d, in0 %d, out %d, ws %zu < %zu); nothing launched\n", n_in, n_in > 0 ? in_sizes[0] : -1, out_size, ws_size, (size_t)WS_END); grid = -1; return; }
        int dev = 0, cus = 0, per_cu = 0;
        if (hipGetDevice(&dev) != hipSuccess || hipDeviceGetAttribute(&cus, hipDeviceAttributeMultiprocessorCount, dev) != hipSuccess) { grid = -1; return; }
#if ONE_LAUNCH
        if (hipFuncSetAttribute((const void*)hybrid_fwd<-1>, hipFuncAttributeMaxDynamicSharedMemorySize, LDS_BYTES) != hipSuccess) { fprintf(stderr, "kernel_launch: hipFuncSetAttribute failed\n"); grid = -1; return; }
#else
        if (hipFuncSetAttribute((const void*)hybrid_fwd<0>, hipFuncAttributeMaxDynamicSharedMemorySize, LDS_BYTES) != hipSuccess || hipFuncSetAttribute((const void*)hybrid_fwd<1>, hipFuncAttributeMaxDynamicSharedMemorySize, LDS_BYTES) != hipSuccess ||
            hipFuncSetAttribute((const void*)hybrid_fwd<2>, hipFuncAttributeMaxDynamicSharedMemorySize, LDS_BYTES) != hipSuccess || hipFuncSetAttribute((const void*)hybrid_fwd<3>, hipFuncAttributeMaxDynamicSharedMemorySize, LDS_BYTES) != hipSuccess) { fprintf(stderr, "kernel_launch: hipFuncSetAttribute failed\n"); grid = -1; return; }
#endif
        if (hipOccupancyMaxActiveBlocksPerMultiprocessor(&per_cu, (const void*)hybrid_fwd<(ONE_LAUNCH ? -1 : 0)>, NTHR, LDS_BYTES) != hipSuccess || per_cu < 1) fprintf(stderr, "kernel_launch: occupancy query reports %d workgroups per CU\n", per_cu);
        (void)hipGetLastError();
        grid = cus;
        if (grid != 256) { fprintf(stderr, "kernel_launch: %d CUs; this kernel is laid out for 256 workgroups; nothing launched\n", grid); grid = -1; return; }
    }
    if (grid < 0) return;
    if (hipMemsetAsync((char*)d_ws + WS_CTL, 0, CTL_ZERO_BYTES, stream) != hipSuccess) return;
    Args a{};
    for (int i = 0; i < 40; ++i) a.in[i] = (const float*)d_in[i];
    a.out = (float*)d_out; a.ws = (unsigned char*)d_ws;
    for (int j = 0; j < 32; ++j) a.inv_freq[j] = (float)pow(10000.0, -(double)j / 32.0);
#if ONE_LAUNCH
    a.g_lo = 0; a.g_hi = G_END;
    hipLaunchKernelGGL(hybrid_fwd<-1>, dim3(grid), dim3(NTHR), LDS_BYTES, stream, a);
#else
    for (int g = 0; g < G_END; ++g) {
        a.g_lo = g; a.g_hi = g + 1;
        int grp = 1;
        if (g >= 1 && g < G_FINAL) { const int k = (g - 1) % NPH; grp = (k == 0 || k == 4) ? 1 : (k == 5) ? 2 : (k == 6) ? 3 : 0; }
        if (grp == 0) hipLaunchKernelGGL(hybrid_fwd<0>, dim3(grid), dim3(NTHR), LDS_BYTES, stream, a);
        else if (grp == 1) hipLaunchKernelGGL(hybrid_fwd<1>, dim3(grid), dim3(NTHR), LDS_BYTES, stream, a);
        else if (grp == 2) hipLaunchKernelGGL(hybrid_fwd<2>, dim3(grid), dim3(NTHR), LDS_BYTES, stream, a);
        else hipLaunchKernelGGL(hybrid_fwd<3>, dim3(grid), dim3(NTHR), LDS_BYTES, stream, a);
    }
#endif
}
```

```cpp
#include <hip/hip_runtime.h>
#include <cstdio>
#include <cstdint>
#include <cmath>

namespace pg8 {
#define PG8_LAS __attribute__((address_space(3)))
typedef unsigned short bf16_t;
typedef short bf16x8 __attribute__((ext_vector_type(8)));
typedef float f32x4 __attribute__((ext_vector_type(4)));
typedef unsigned u32x4 __attribute__((ext_vector_type(4)));
constexpr int BM = 256, BK = 64, HALF = 128, HTB = HALF * BK * 2  , STAGE_BYTES = 8 * HTB, NXCD = 8, WGM = 8;

__host__ __device__ __forceinline__ int lds_byte(int r, int c) { const int st = (r >> 4) * 2 + (c >> 5), rr = r & 15, cc = c & 31, ob = rr * 64 + cc * 2; return st * 1024 + (ob ^ (((ob >> 9) & 1) << 5)); }
__host__ __device__ __forceinline__ void stage_rc(int b, int& R, int& C) { const int st = b / 1024, sb = b % 1024, swz = sb ^ (((sb >> 9) & 1) << 5); R = (st >> 1) * 16 + swz / 64; C = (st & 1) * 32 + (swz % 64) / 2; }
__host__ __device__ __forceinline__ int perm32(int rho) { const int n = rho >> 4, i = rho & 15; return 8 * (i >> 2) + 4 * n + (i & 3); }

struct Unit { int pm, pn, z; };
struct Gemm { const bf16_t* A; const bf16_t* Bt; int M, N, K, lda; };

struct StaticOrder {
    int nM, nN, nwg, G, c;
    __host__ __device__ void init(int M, int N, int G_, int c_) { nM = M / BM; nN = N / BM; nwg = nM * nN; G = G_; c = c_; }
    __host__ __device__ bool next(int i, Unit& u) const {
        const long L = (long)i * G + c; if (L >= nwg) return false;
        int wgid = (int)L; { const int q = nwg / NXCD, r = nwg % NXCD, xcd = wgid % NXCD, off = wgid / NXCD; wgid = (xcd < r ? xcd * (q + 1) : r * (q + 1) + (xcd - r) * q) + off; }
        const int nig = WGM * nN, gid = wgid / nig, fm = gid * WGM, gsz = (nM - fm) < WGM ? (nM - fm) : WGM;
        u.pm = fm + ((wgid % nig) % gsz); u.pn = (wgid % nig) / gsz; u.z = 0; return true;
    }
    __device__ __forceinline__ void a_ready(const Unit&) const {}
    __device__ __forceinline__ void done(const Unit&) const {}
    __device__ __forceinline__ size_t a_off(const Unit&) const { return 0; }
    __device__ __forceinline__ int b_tile(const Unit& u) const { return u.pn; }
};
struct GroupedOrder {
    StaticOrder base; int NZ, Kbytes, tiles_per_group;
    __device__ void init(int M, int N, int NZ_, int K, int G_, int c_) { base.init(M, N, G_, c_); NZ = NZ_; Kbytes = K * 2; tiles_per_group = N / BM; }
    __device__ bool next(int i, Unit& u) const { const int r = i / NZ, z = i - r * NZ; if (!base.next(r, u)) return false; u.z = z; return true; }
    __device__ __forceinline__ void a_ready(const Unit&) const {}
    __device__ __forceinline__ void done(const Unit&) const {}
    __device__ __forceinline__ size_t a_off(const Unit& u) const { return (size_t)u.z * Kbytes; }
    __device__ __forceinline__ int b_tile(const Unit& u) const { return u.z * tiles_per_group + u.pn; }
};

__device__ __forceinline__ unsigned cvt_pk_bf16(float lo, float hi) { unsigned r; asm volatile("v_cvt_pk_bf16_f32 %0, %1, %2" : "=v"(r) : "v"(lo), "v"(hi)); return r; }
__device__ __forceinline__ float bf_lo(unsigned w) { return __uint_as_float(w << 16); }
__device__ __forceinline__ float bf_hi(unsigned w) { return __uint_as_float(w & 0xffff0000u); }
__device__ __forceinline__ float fast_sigmoid(float x) { return __builtin_amdgcn_rcpf(1.0f + __builtin_amdgcn_exp2f(-1.4426950408889634f * x)); }

__device__ __forceinline__ float row_rstd(const float* ssq, int row, int M_) {
    const float s = (ssq[row] + ssq[M_ + row]) + (ssq[2 * M_ + row] + ssq[3 * M_ + row]);
    return 1.0f / sqrtf(s * (1.0f / 1024.0f) + 1e-6f);
}
struct EpiScaleBf16 {
    static constexpr bool PERM = true, AFTER_DRAIN = false;
    bf16_t* O; int ldc; const float* ssq; int M_;
    __device__ __forceinline__ void operator()(const f32x4 (&acc)[2][2][4][2], const Unit& u, int wr, int wc, int fr, int fq) const {
        const int row0 = u.pm * BM + wr * 64 + fr; const int col0 = u.pn * BM + wc * 32 + 8 * fq;
#pragma unroll
        for (int ai = 0; ai < 2; ++ai)
#pragma unroll
            for (int m = 0; m < 4; ++m) { const int row = row0 + ai * HALF + m * 16; const float rs = row_rstd(ssq, row, M_); bf16_t* rowp = O + (size_t)row * ldc + col0;
#pragma unroll
                for (int bj = 0; bj < 2; ++bj) { const f32x4 v0 = acc[ai][bj][m][0] * rs, v1 = acc[ai][bj][m][1] * rs;
                    u32x4 w; w.x = cvt_pk_bf16(v0[0], v0[1]); w.y = cvt_pk_bf16(v0[2], v0[3]); w.z = cvt_pk_bf16(v1[0], v1[1]); w.w = cvt_pk_bf16(v1[2], v1[3]);
                    *(u32x4*)(rowp + bj * HALF) = w; } }
    }
};
struct EpiSwiglu {
    static constexpr bool PERM = true, AFTER_DRAIN = false;
    bf16_t* O; int ldc; const float* ssq; int M_;
    __device__ __forceinline__ void operator()(const f32x4 (&acc)[2][2][4][2], const Unit& u, int wr, int wc, int fr, int fq) const {
        const int row0 = u.pm * BM + wr * 64 + fr; const int col0 = u.pn * HALF + wc * 32 + 8 * fq;
#pragma unroll
        for (int ai = 0; ai < 2; ++ai)
#pragma unroll
            for (int m = 0; m < 4; ++m) { const int row = row0 + ai * HALF + m * 16; const float rs = row_rstd(ssq, row, M_); bf16_t* rowp = O + (size_t)row * ldc + col0;
                float o[8];
#pragma unroll
                for (int n = 0; n < 2; ++n)
#pragma unroll
                    for (int i = 0; i < 4; ++i) { const float g = acc[ai][0][m][n][i] * rs, up = acc[ai][1][m][n][i] * rs; o[n * 4 + i] = g * fast_sigmoid(g) * up; }
                u32x4 w; w.x = cvt_pk_bf16(o[0], o[1]); w.y = cvt_pk_bf16(o[2], o[3]); w.z = cvt_pk_bf16(o[4], o[5]); w.w = cvt_pk_bf16(o[6], o[7]);
                *(u32x4*)rowp = w; }
    }
};
struct EpiGateAcc {
    static constexpr bool PERM = true, AFTER_DRAIN = false;
    bf16_t* O; const bf16_t* PG; const float* gb;
    __device__ __forceinline__ void operator()(const f32x4 (&acc)[2][2][4][2], const Unit& u, int wr, int wc, int fr, int fq) const {
        const int row0 = u.pm * BM + wr * 64 + fr; const int col0 = u.pn * BM + wc * 32 + 8 * fq; const int z = u.z;
        f32x4 gbv[2][2];
#pragma unroll
        for (int bj = 0; bj < 2; ++bj)
#pragma unroll
            for (int n = 0; n < 2; ++n) gbv[bj][n] = *(const f32x4*)(gb + z * 1024 + col0 + bj * HALF + 4 * n);
#pragma unroll
        for (int ai = 0; ai < 2; ++ai)
#pragma unroll
            for (int m = 0; m < 4; ++m) { const int row = row0 + ai * HALF + m * 16;
#pragma unroll
                for (int bj = 0; bj < 2; ++bj) {
                    const u32x4 pg = *(const u32x4*)(PG + (size_t)row * 4096 + z * 1024 + col0 + bj * HALF);
                    bf16_t* op = O + (size_t)row * 1024 + col0 + bj * HALF;
                    float o[8];
                    o[0] = fast_sigmoid(bf_lo(pg.x) + gbv[bj][0][0]) * acc[ai][bj][m][0][0]; o[1] = fast_sigmoid(bf_hi(pg.x) + gbv[bj][0][1]) * acc[ai][bj][m][0][1];
                    o[2] = fast_sigmoid(bf_lo(pg.y) + gbv[bj][0][2]) * acc[ai][bj][m][0][2]; o[3] = fast_sigmoid(bf_hi(pg.y) + gbv[bj][0][3]) * acc[ai][bj][m][0][3];
                    o[4] = fast_sigmoid(bf_lo(pg.z) + gbv[bj][1][0]) * acc[ai][bj][m][1][0]; o[5] = fast_sigmoid(bf_hi(pg.z) + gbv[bj][1][1]) * acc[ai][bj][m][1][1];
                    o[6] = fast_sigmoid(bf_lo(pg.w) + gbv[bj][1][2]) * acc[ai][bj][m][1][2]; o[7] = fast_sigmoid(bf_hi(pg.w) + gbv[bj][1][3]) * acc[ai][bj][m][1][3];
                    if (z > 0) { const u32x4 pv = *(const u32x4*)op;
                        o[0] += bf_lo(pv.x); o[1] += bf_hi(pv.x); o[2] += bf_lo(pv.y); o[3] += bf_hi(pv.y); o[4] += bf_lo(pv.z); o[5] += bf_hi(pv.z); o[6] += bf_lo(pv.w); o[7] += bf_hi(pv.w); }
                    u32x4 w; w.x = cvt_pk_bf16(o[0], o[1]); w.y = cvt_pk_bf16(o[2], o[3]); w.z = cvt_pk_bf16(o[4], o[5]); w.w = cvt_pk_bf16(o[6], o[7]);
                    *(u32x4*)op = w; } }
    }
};
struct EpiResid {
    static constexpr bool PERM = true, AFTER_DRAIN = true;
    float* H; bf16_t* HB; float* ssq; int M_; float s;
    __device__ __forceinline__ void fused(f32x4 (&acc)[2][2][4][2], const Unit& u, int wr, int wc, int fr, int fq, PG8_LAS unsigned char* lds, int wid, int lane) const {
        PG8_LAS float* P = (PG8_LAS float*)lds;
        const int row0 = u.pm * BM + wr * 64 + fr; const int col0 = u.pn * BM + wc * 32 + 8 * fq;
#pragma unroll
        for (int ai = 0; ai < 2; ++ai)
#pragma unroll
            for (int m = 0; m < 4; ++m) { const int row = row0 + ai * HALF + m * 16; float q = 0.f;
#pragma unroll
                for (int bj = 0; bj < 2; ++bj) { float* hp = H + (size_t)row * 1024 + col0 + bj * HALF;
                    const f32x4 h0 = *(const f32x4*)hp + acc[ai][bj][m][0] * s, h1 = *(const f32x4*)(hp + 4) + acc[ai][bj][m][1] * s;
                    *(f32x4*)hp = h0; *(f32x4*)(hp + 4) = h1;
                    q += (h0[0] * h0[0] + h0[1] * h0[1]) + (h0[2] * h0[2] + h0[3] * h0[3]) + (h1[0] * h1[0] + h1[1] * h1[1]) + (h1[2] * h1[2] + h1[3] * h1[3]);
                    u32x4 w; w.x = cvt_pk_bf16(h0[0], h0[1]); w.y = cvt_pk_bf16(h0[2], h0[3]); w.z = cvt_pk_bf16(h1[0], h1[1]); w.w = cvt_pk_bf16(h1[2], h1[3]);
                    *(u32x4*)(HB + (size_t)row * 1024 + col0 + bj * HALF) = w; }
                q += __shfl_xor(q, 16); q += __shfl_xor(q, 32);
                if (fq == 0) P[(ai * HALF + wr * 64 + m * 16 + fr) * 4 + wc] = q; }
        asm volatile("s_waitcnt lgkmcnt(0)" ::: "memory"); __builtin_amdgcn_s_barrier(); asm volatile("" ::: "memory");
        const int t = wid * 64 + lane;
        if (t < 256) { const float q = (P[t * 4 + 0] + P[t * 4 + 1]) + (P[t * 4 + 2] + P[t * 4 + 3]); ssq[(size_t)u.pn * M_ + u.pm * BM + t] = q; }
        asm volatile("s_waitcnt lgkmcnt(0)" ::: "memory"); __builtin_amdgcn_s_barrier(); asm volatile("" ::: "memory");
    }
};
template <class Epi, class Sched, bool ALIGN_EPI = false, bool SP2 = false>
__device__ __forceinline__ void gemm_phase(PG8_LAS unsigned char* lds, const Gemm g, const Sched& S, const Epi& E) {
    int tid_ = threadIdx.x; asm volatile("" : "+v"(tid_)); const int tid = tid_, wid = __builtin_amdgcn_readfirstlane(tid >> 6), lane = tid & 63, wr = wid >> 2, wc = wid & 3, fr = lane & 15, fq = lane >> 4;
    const int K = g.K, nt = K / BK;
    unsigned voffA[2], voffB[2];
#pragma unroll
    for (int i = 0; i < 2; ++i) { int R, C; stage_rc(tid * 16 + i * 8192, R, C); const int Rb = Epi::PERM ? ((R & ~31) + perm32(R & 31)) : R;
        voffA[i] = (unsigned)(R * g.lda + C) * 2u; voffB[i] = (unsigned)(Rb * K + C) * 2u; }
    const size_t kstep = (size_t)(BK * 2);
    const size_t hstep = (size_t)HALF * K * 2;
    const size_t tstep = 2 * hstep; const size_t hstepA = (size_t)HALF * g.lda * 2, tstepA = 2 * hstepA;
    const unsigned ldsw = (unsigned)wid * 1024u;
    const int aoff = lds_byte(wr * 64 + fr, fq * 8), boff = lds_byte(wc * 32 + fr, fq * 8);
#define PG8_SA(b, h) (((b) * 2 + (h)) * HTB)
#define PG8_SB(b, h) ((4 + (b) * 2 + (h)) * HTB)
#define PG8_STAGE(bufoff, gbase, voff) do { _Pragma("unroll") for (int _i = 0; _i < 2; ++_i) \
        __builtin_amdgcn_global_load_lds((const unsigned*)((const char*)(gbase) + (voff)[_i]), (PG8_LAS unsigned*)(lds + (bufoff) + ldsw + _i * 8192), 16, 0, 0); } while (0)
#define PG8_LDA(dst, b, h) do { _Pragma("unroll") for (int m = 0; m < 4; ++m) _Pragma("unroll") for (int k = 0; k < 2; ++k) dst[m][k] = *(const PG8_LAS bf16x8*)(lds + PG8_SA(b, h) + aoff + m * 2048 + k * 1024); } while (0)
#define PG8_LDB(dst, b, h) do { _Pragma("unroll") for (int n = 0; n < 2; ++n) _Pragma("unroll") for (int k = 0; k < 2; ++k) dst[n][k] = *(const PG8_LAS bf16x8*)(lds + PG8_SB(b, h) + boff + n * 2048 + k * 1024); } while (0)
#define PG8_MMA(ai, bj, At, Bt) do { __builtin_amdgcn_s_setprio(1); _Pragma("unroll") for (int m = 0; m < 4; ++m) _Pragma("unroll") for (int n = 0; n < 2; ++n) _Pragma("unroll") for (int k = 0; k < 2; ++k) \
        acc[ai][bj][m][n] = __builtin_amdgcn_mfma_f32_16x16x32_bf16(Bt[n][k], At[m][k], acc[ai][bj][m][n], 0, 0, 0); __builtin_amdgcn_s_setprio(0); } while (0)
#define PG8_WAIT_V(n) asm volatile("s_waitcnt vmcnt(" #n ")" ::: "memory")
#define PG8_WAIT_L(n) asm volatile("s_waitcnt lgkmcnt(" #n ")" ::: "memory")
#define PG8_BAR __builtin_amdgcn_s_barrier()
#define PG8_SCHED __builtin_amdgcn_sched_barrier(0)
    Unit cur, nxt; int ui = 0;
    if (!S.next(0, cur)) return;
    f32x4 acc[2][2][4][2];
#pragma unroll
    for (int a = 0; a < 2; ++a)
#pragma unroll
        for (int b = 0; b < 2; ++b)
#pragma unroll
            for (int m = 0; m < 4; ++m)
#pragma unroll
                for (int n = 0; n < 2; ++n) acc[a][b][m][n] = (f32x4){0.f, 0.f, 0.f, 0.f};
    bf16x8 At[4][2], B0[2][2], B1[2][2];
    const char* cA = (const char*)g.A + (size_t)cur.pm * tstepA + S.a_off(cur); const char* cB = (const char*)g.Bt + (size_t)S.b_tile(cur) * tstep;
    S.a_ready(cur);
    if constexpr (SP2) {
        PG8_STAGE(PG8_SB(0, 0), cB, voffB); PG8_STAGE(PG8_SB(0, 1), cB + hstep, voffB); PG8_STAGE(PG8_SA(0, 0), cA, voffA); PG8_STAGE(PG8_SA(0, 1), cA + hstepA, voffA);
        if (wr == 1) PG8_BAR;
        PG8_WAIT_V(2); PG8_BAR;
        PG8_STAGE(PG8_SB(1, 0), cB + kstep, voffB); PG8_STAGE(PG8_SA(1, 0), cA + kstep, voffA); PG8_STAGE(PG8_SB(1, 1), cB + hstep + kstep, voffB);
        PG8_WAIT_V(6); PG8_BAR;
    } else {
        PG8_STAGE(PG8_SB(0, 0), cB, voffB); PG8_STAGE(PG8_SA(0, 0), cA, voffA); PG8_STAGE(PG8_SB(0, 1), cB + hstep, voffB); PG8_STAGE(PG8_SA(0, 1), cA + hstepA, voffA);
        if (wr == 1) PG8_BAR;
        PG8_WAIT_V(4); PG8_BAR;
        PG8_STAGE(PG8_SB(1, 0), cB + kstep, voffB); PG8_STAGE(PG8_SA(1, 0), cA + kstep, voffA); PG8_STAGE(PG8_SB(1, 1), cB + hstep + kstep, voffB);
        PG8_WAIT_V(6); PG8_BAR;
    }
    for (;;) {
        const bool has_next = S.next(ui + 1, nxt);
        const char* nA = has_next ? (const char*)g.A + (size_t)nxt.pm * tstepA + S.a_off(nxt) : cA; const char* nB = has_next ? (const char*)g.Bt + (size_t)S.b_tile(nxt) * tstep : cB;
        for (int t = 0; t < nt; t += 2) {
            const bool last = (t == nt - 2);
            const char* a1 = cA + (size_t)(t + 1) * kstep;
            const char* a2 = last ? nA : cA + (size_t)(t + 2) * kstep; const char* b2 = last ? nB : cB + (size_t)(t + 2) * kstep;
            const char* a3 = a2 + kstep; const char* b3 = b2 + kstep;
            if (last && has_next) S.a_ready(nxt);
            if constexpr (SP2) {
            PG8_LDB(B0, 0, 0); PG8_LDB(B1, 0, 1); PG8_SCHED; PG8_LDA(At, 0, 0); PG8_STAGE(PG8_SA(1, 1), a1 + hstepA, voffA);
            PG8_WAIT_V(8); PG8_WAIT_L(0); PG8_BAR; PG8_MMA(0, 0, At, B0); PG8_MMA(0, 1, At, B1); PG8_BAR; PG8_SCHED;
            PG8_LDA(At, 0, 1); PG8_STAGE(PG8_SB(0, 0), b2, voffB); PG8_STAGE(PG8_SB(0, 1), b2 + hstep, voffB); PG8_STAGE(PG8_SA(0, 0), a2, voffA);
            PG8_WAIT_V(8); PG8_WAIT_L(0); PG8_BAR; PG8_MMA(1, 0, At, B0); PG8_MMA(1, 1, At, B1); PG8_BAR; PG8_SCHED;
            PG8_LDB(B0, 1, 0); PG8_LDB(B1, 1, 1); PG8_SCHED; PG8_LDA(At, 1, 0); PG8_STAGE(PG8_SA(0, 1), a2 + hstepA, voffA);
            PG8_WAIT_V(8); PG8_WAIT_L(0); PG8_BAR; PG8_MMA(0, 0, At, B0); PG8_MMA(0, 1, At, B1); PG8_BAR; PG8_SCHED;
            PG8_LDA(At, 1, 1); PG8_STAGE(PG8_SB(1, 0), b3, voffB); PG8_STAGE(PG8_SB(1, 1), b3 + hstep, voffB); PG8_STAGE(PG8_SA(1, 0), a3, voffA);
            PG8_WAIT_V(8); PG8_WAIT_L(0); PG8_BAR; PG8_MMA(1, 0, At, B0); PG8_MMA(1, 1, At, B1); PG8_BAR; PG8_SCHED;
            } else {
            PG8_LDB(B0, 0, 0); PG8_SCHED; PG8_LDA(At, 0, 0); PG8_STAGE(PG8_SA(1, 1), a1 + hstepA, voffA);
            PG8_WAIT_L(8); PG8_BAR; PG8_WAIT_L(0); PG8_MMA(0, 0, At, B0); PG8_BAR; PG8_SCHED;
            PG8_LDB(B1, 0, 1); PG8_STAGE(PG8_SB(0, 0), b2, voffB);
            PG8_BAR; PG8_WAIT_L(0); PG8_MMA(0, 1, At, B1); PG8_BAR;
            PG8_LDA(At, 0, 1); PG8_STAGE(PG8_SA(0, 0), a2, voffA);
            PG8_BAR; PG8_WAIT_L(0); PG8_MMA(1, 0, At, B0); PG8_BAR; PG8_SCHED;
            PG8_STAGE(PG8_SB(0, 1), b2 + hstep, voffB);
            PG8_WAIT_V(6); PG8_BAR; PG8_MMA(1, 1, At, B1); PG8_BAR;
            PG8_LDB(B0, 1, 0); PG8_SCHED; PG8_LDA(At, 1, 0); PG8_STAGE(PG8_SA(0, 1), a2 + hstepA, voffA);
            PG8_WAIT_L(8); PG8_BAR; PG8_WAIT_L(0); PG8_MMA(0, 0, At, B0); PG8_BAR; PG8_SCHED;
            PG8_LDB(B1, 1, 1); PG8_STAGE(PG8_SB(1, 0), b3, voffB);
            PG8_BAR; PG8_WAIT_L(0); PG8_MMA(0, 1, At, B1); PG8_BAR;
            PG8_LDA(At, 1, 1); PG8_STAGE(PG8_SA(1, 0), a3, voffA);
            PG8_BAR; PG8_WAIT_L(0); PG8_MMA(1, 0, At, B0); PG8_BAR; PG8_SCHED;
            PG8_STAGE(PG8_SB(1, 1), b3 + hstep, voffB);
            PG8_WAIT_V(6); PG8_BAR; PG8_MMA(1, 1, At, B1); PG8_BAR;
            }
        }
        if constexpr (ALIGN_EPI) { if (wr == 0) PG8_BAR; }
        if constexpr (!Epi::AFTER_DRAIN) { E(acc, cur, wr, wc, fr, fq); S.done(cur); }
        if (!has_next) break;
#pragma unroll
        for (int a = 0; a < 2; ++a)
#pragma unroll
            for (int b = 0; b < 2; ++b)
#pragma unroll
                for (int m = 0; m < 4; ++m)
#pragma unroll
                    for (int n = 0; n < 2; ++n) acc[a][b][m][n] = (f32x4){0.f, 0.f, 0.f, 0.f};
        cur = nxt; cA = nA; cB = nB; ++ui;
        if constexpr (ALIGN_EPI) { if (wr == 1) PG8_BAR; }
    }
    PG8_WAIT_V(0);
    if constexpr (!ALIGN_EPI) { if (wr == 0) PG8_BAR; }
    PG8_BAR;
    if constexpr (Epi::AFTER_DRAIN) { E.fused(acc, cur, wr, wc, fr, fq, lds, wid, lane); S.done(cur); }
#undef PG8_SA
#undef PG8_SB
#undef PG8_STAGE
#undef PG8_LDA
#undef PG8_LDB
#undef PG8_MMA
#undef PG8_WAIT_V
#undef PG8_WAIT_L
#undef PG8_BAR
#undef PG8_SCHED
}
}

constexpr int NWAVES = 8, NTHR = 512;
constexpr int M = 16384, SEQ = 8192, D = 1024, FF = 2816, NL = 4, NCH = 128  , NBC = 256  ;
constexpr int NPM = 6656;
constexpr int NWIN = 10752;
constexpr int C_DAQ = 0, C_DAK = 512, C_DAV = 1024, C_GQ = 1536, C_GK = 1792, C_GV = 2048, C_GOG = 2560, C_SZ = 3072, C_SX = 3584, C_SB = 4096, C_SC = 4352,
              C_RR = 4608, C_RK = 5120, C_RV = 5632, C_RWL = 6144, C_RAL = 6208, C_RGL = 6272, C_GLR = 6400, C_SDT = 6416;
constexpr float EPS = 1e-6f, LOG2E = 1.4426950408889634f;

constexpr size_t MiB = 1u << 20;
constexpr size_t WS_CTL = 0, CTL_ZERO_BYTES = 1 * MiB;
constexpr size_t WS_COS = 1 * MiB, WS_SIN = 2 * MiB, WS_SSQ = 3 * MiB, WS_GLAST = 3 * MiB + 512 * 1024, WS_SDT = 4 * MiB, WS_SACUM = 4 * MiB + 512 * 1024, WS_SCDEC = 5 * MiB, WS_RW2T = 5 * MiB + 64 * 1024;
constexpr size_t WS_WGU1 = 8 * MiB, WS_WD1 = 19 * MiB, WS_WIN = 24 * MiB + 512 * 1024, WS_WB = 45 * MiB + 512 * 1024, WS_WO = 49 * MiB + 512 * 1024, WS_WGU2 = 51 * MiB + 512 * 1024, WS_WD2 = 62 * MiB + 512 * 1024;
constexpr size_t WS_HB = 68 * MiB, WS_P = 100 * MiB, WS_PG = 100 * MiB, WS_YS = 308 * MiB, WS_R1 = 372 * MiB, WS_R2 = 500 * MiB, WS_END = 644 * MiB;
constexpr size_t WS_ACT = WS_R1, WS_MERGED = WS_R1;
constexpr size_t WS_RWW = WS_R1, WS_RWR = WS_R1 + 32 * MiB, WS_RWK = WS_R1 + 48 * MiB, WS_RWV = WS_R1 + 64 * MiB, WS_RWKK = WS_R1 + 80 * MiB, WS_RWB = WS_R1 + 96 * MiB, WS_RWG = WS_R1 + 112 * MiB;
constexpr size_t WS_VT = WS_R2, WS_GKV = WS_R2 + 16 * MiB, WS_SST = WS_R2 + 48 * MiB, WS_RWY = WS_R2 + 112 * MiB;
static_assert(WS_WD2 + (size_t)D * FF * 2 <= WS_HB && WS_P + (size_t)M * NPM * 2 <= WS_YS && WS_RWY + (size_t)M * 512 * 2 <= WS_END, "d_ws map");
constexpr int CW_BAR = 4096;

constexpr int RING_BYTES = 131072, LDSCTL_OFF = RING_BYTES, MISC_OFF = LDSCTL_OFF + 320, LDS_BYTES = 147456;

#define GAS __attribute__((address_space(1)))
#define LAS __attribute__((address_space(3)))
typedef unsigned short bf16;
typedef unsigned v4u __attribute__((ext_vector_type(4)));
typedef float f32x4 __attribute__((ext_vector_type(4)));
typedef short bf16x8 __attribute__((ext_vector_type(8)));
typedef GAS unsigned gu32;
typedef GAS unsigned long long gu64;
#define RLX_AGENT __ATOMIC_RELAXED, __HIP_MEMORY_SCOPE_AGENT
#define LDS_WAIT() asm volatile("s_waitcnt lgkmcnt(0)" ::: "memory")
#define VM_WAIT() asm volatile("s_waitcnt vmcnt(0)" ::: "memory")
__device__ __forceinline__ unsigned long long rt() { return __builtin_amdgcn_s_memrealtime(); }
__device__ __forceinline__ unsigned f2bf(float f) { unsigned u = __builtin_bit_cast(unsigned, f); return (u + 0x7fffu + ((u >> 16) & 1u)) >> 16; }
__device__ __forceinline__ unsigned pk2(float lo, float hi) { return f2bf(lo) | (f2bf(hi) << 16); }

#define XB_TMO      128
#define XB_XCNT(j)  (256  + 64 * (j))
#define XB_XSUB(j)  (1280 + 64 * (j))
#define XB_XGEN(j)  (2304 + 64 * (j))
#define XB_TOP      3328
#define XB_TOPGEN   3392
#define XCD_BAR_WORDS 3456
#define XB_SPIN_CAP (1u << 18)

__device__ __forceinline__ unsigned xb_ld(unsigned* p)              { return __hip_atomic_load(p, __ATOMIC_RELAXED, __HIP_MEMORY_SCOPE_AGENT); }
__device__ __forceinline__ unsigned xb_add(unsigned* p, unsigned v) { return __hip_atomic_fetch_add(p, v, __ATOMIC_RELAXED, __HIP_MEMORY_SCOPE_AGENT); }
__device__ __forceinline__ unsigned xb_xcc_id() { return (unsigned)__builtin_amdgcn_s_getreg((3 << 11) | 20) & 0xFu; }
#define XB_SPIN(cond, bar) do { unsigned _sp = 0; while (cond) { __builtin_amdgcn_s_sleep(1); \
    if ((++_sp & 255u) == 0u) { if (xb_ld(&(bar)[XB_TMO])) break; if (_sp > XB_SPIN_CAP) { atomicAdd(&(bar)[XB_TMO], 1u); break; } } } } while (0)

struct XcdBarrier {
    unsigned* bar; unsigned x;
    volatile LAS unsigned* st;
};

__device__ __forceinline__ XcdBarrier xcd_barrier_post(unsigned* bar, volatile LAS unsigned* st) {
    XcdBarrier b; b.bar = bar; b.x = xb_xcc_id(); b.st = st;
    if (threadIdx.x == 0) (void)xb_add(&bar[XB_XCNT(b.x)], 1u);
    return b;
}
__device__ __forceinline__ void xcd_barrier_complete(unsigned* bar, unsigned x, unsigned& nloc, unsigned& nx) {
    const unsigned G = gridDim.x * gridDim.y * gridDim.z;
    unsigned sum, cnt, mine, sp = 0u;
    for (;;) {
        sum = 0u; cnt = 0u; mine = 0u;
#pragma unroll
        for (unsigned j = 0; j < 16; ++j) { const unsigned c = xb_ld(&bar[XB_XCNT(j)]); sum += c; cnt += (c > 0u) ? 1u : 0u; mine = (j == x) ? c : mine; }
        if (sum == G) break;
        __builtin_amdgcn_s_sleep(1);
        if ((++sp & 255u) == 0u) { if (xb_ld(&bar[XB_TMO])) break; if (sp > XB_SPIN_CAP) { atomicAdd(&bar[XB_TMO], 1u); break; } }
    }
    nloc = mine > 0u ? mine : 1u; nx = cnt > 0u ? cnt : 1u;
}

__device__ __forceinline__ void xcd_barrier(const XcdBarrier& b) {
    asm volatile("s_waitcnt vmcnt(0)" ::: "memory");
    __syncthreads();
    if (threadIdx.x == 0) {
        unsigned* bar = b.bar;
        __builtin_amdgcn_s_waitcnt(0);
        unsigned nloc = b.st[0], nx = b.st[1];
        if (nloc == 0u) { xcd_barrier_complete(bar, b.x, nloc, nx); b.st[0] = nloc; b.st[1] = nx; }
        const unsigned old = xb_add(&bar[XB_XSUB(b.x)], 1u);
        const unsigned gen = old / nloc;
        if (old + 1u == (gen + 1u) * nloc) {
            __builtin_amdgcn_fence(__ATOMIC_RELEASE, "agent");
            asm volatile("s_waitcnt vmcnt(0)" ::: "memory");
            const unsigned og = xb_add(&bar[XB_TOP], 1u);
            const unsigned tg = og / nx;
            if (og + 1u == (tg + 1u) * nx) xb_add(&bar[XB_TOPGEN], 1u);
            else XB_SPIN(xb_ld(&bar[XB_TOPGEN]) == tg, bar);
            __builtin_amdgcn_fence(__ATOMIC_ACQUIRE, "agent");
            xb_add(&bar[XB_XGEN(b.x)], 1u);
            asm volatile("s_waitcnt vmcnt(0)" ::: "memory");
        } else {
            XB_SPIN(xb_ld(&bar[XB_XGEN(b.x)]) == gen, bar);
            __builtin_amdgcn_fence(__ATOMIC_ACQUIRE, "agent");
            asm volatile("s_waitcnt vmcnt(0)" ::: "memory");
        }
    }
    __syncthreads();
}

struct Args { const float* in[40]; float* out; unsigned char* ws; float inv_freq[32]; int g_lo, g_hi; };
typedef const __attribute__((address_space(4))) Args* ArgsP;
typedef LAS float* LF; typedef const LAS float* CLF;
#ifndef PH_FN
#define PH_FN __device__ __noinline__
#endif
#ifndef PH_HEAVY
#define PH_HEAVY __device__ __forceinline__
#endif
struct Ctx {
    LAS unsigned char* lds;
    unsigned char* ws; float* h;
    int tid, lane, wave, bid, G;
};
typedef unsigned u32x4 __attribute__((ext_vector_type(4)));
typedef unsigned u32x2 __attribute__((ext_vector_type(2)));
typedef float f32x2 __attribute__((ext_vector_type(2)));
typedef float f32x16 __attribute__((ext_vector_type(16)));
__device__ __forceinline__ float bf2f(bf16 x) { return __uint_as_float((unsigned)x << 16); }
__device__ __forceinline__ float bflo(unsigned w) { return __uint_as_float(w << 16); }
__device__ __forceinline__ float bfhi(unsigned w) { return __uint_as_float(w & 0xffff0000u); }
__device__ __forceinline__ void unpack8(const u32x4 w, float* o) { o[0] = bflo(w.x); o[1] = bfhi(w.x); o[2] = bflo(w.y); o[3] = bfhi(w.y); o[4] = bflo(w.z); o[5] = bfhi(w.z); o[6] = bflo(w.w); o[7] = bfhi(w.w); }
__device__ __forceinline__ u32x4 pack8(const float* o) { u32x4 w; w.x = pk2(o[0], o[1]); w.y = pk2(o[2], o[3]); w.z = pk2(o[4], o[5]); w.w = pk2(o[6], o[7]); return w; }
__device__ __forceinline__ float sigmoidf_(float x) { return 1.0f / (1.0f + __expf(-x)); }
__device__ __forceinline__ float siluf_(float x) { return x * sigmoidf_(x); }
__device__ __forceinline__ float softplusf_(float x) { return fmaxf(x, 0.f) + log1pf(__expf(-fabsf(x))); }
__device__ __forceinline__ float logsigmoidf_(float x) { return fminf(x, 0.f) - log1pf(__expf(-fabsf(x))); }
__device__ __forceinline__ float wave_sum(float v) {
#pragma unroll
    for (int o = 1; o < 64; o <<= 1) v += __shfl_xor(v, o);
    return v;
}
#define WG_SYNC() __syncthreads()
__device__ __forceinline__ Ctx fresh(const Ctx& C0) { Ctx C = C0; int t = threadIdx.x; asm volatile("" : "+v"(t)); C.tid = t; C.lane = t & 63; C.wave = __builtin_amdgcn_readfirstlane(t >> 6); return C; }

PH_FN void ph_prologue(const Ctx C, ArgsP a) {
    float* cosT = (float*)(C.ws + WS_COS); float* sinT = (float*)(C.ws + WS_SIN);
    for (int idx = C.bid * NTHR + C.tid; idx < SEQ * 32; idx += C.G * NTHR) {
        const int t = idx >> 5, j = idx & 31;
        const float ang = (float)t * a->inv_freq[j];
        const double rev = (double)ang * 0.15915494309189535;
        const float fr = (float)(rev - floor(rev));
        cosT[idx] = __builtin_amdgcn_cosf(fr); sinT[idx] = __builtin_amdgcn_sinf(fr);
    }
    const float* x = a->in[0]; bf16* hb = (bf16*)(C.ws + WS_HB); float* ssq = (float*)(C.ws + WS_SSQ);
    const int gw = C.bid * NWAVES + C.wave, NGW = C.G * NWAVES;
    for (int m = gw; m < M; m += NGW) {
        const f32x4* xr = (const f32x4*)(x + (size_t)m * D) + C.lane; f32x4* hr = (f32x4*)(C.h + (size_t)m * D) + C.lane;
        unsigned long long* o8 = (unsigned long long*)(hb + (size_t)m * D) + C.lane;
        float s = 0.f;
#pragma unroll
        for (int j = 0; j < 4; ++j) { const f32x4 v = xr[64 * j]; hr[64 * j] = v; s += (v.x * v.x + v.y * v.y) + (v.z * v.z + v.w * v.w);
            o8[64 * j] = (unsigned long long)pk2(v.x, v.y) | ((unsigned long long)pk2(v.z, v.w) << 32); }
        s = wave_sum(s);
        if (C.lane == 0) { ssq[m] = s; ssq[M + m] = 0.f; ssq[2 * M + m] = 0.f; ssq[3 * M + m] = 0.f; }
    }
}

template <class SrcF>
__device__ __forceinline__ void tr_item(const SrcF src, const float* gk, bf16* WT, int K, int kb, int nb, LAS bf16* scr, int lane) {
    const int k0 = 64 * kb, n0 = 64 * nb, kr = lane >> 4, n4 = 4 * (lane & 15);
    const int ld = src.ld(); const long co = src.col(n0 + n4); const bool ok = co >= 0; const float* colp = src.base(n0 + n4) + (ok ? co : 0);
    f32x4 v[16];
#pragma unroll
    for (int i = 0; i < 16; ++i) v[i] = ok ? *(const f32x4*)(colp + (size_t)(k0 + 4 * i + kr) * ld) : (f32x4){0.f, 0.f, 0.f, 0.f};
#pragma unroll
    for (int i = 0; i < 16; ++i) { const int kk = 4 * i + kr; const float g = gk ? gk[k0 + kk] : 1.0f;
#pragma unroll
        for (int e = 0; e < 4; ++e) scr[(n4 + e) * 72 + kk] = (bf16)f2bf(v[i][e] * g); }
    LDS_WAIT(); asm volatile("" ::: "memory");
    const int c = lane & 7;
#pragma unroll
    for (int j = 0; j < 8; ++j) { const int n = (lane >> 3) + 8 * j; *(v4u*)(WT + (size_t)(n0 + n) * K + k0 + 8 * c) = *(const LAS v4u*)(scr + n * 72 + 8 * c); }
    LDS_WAIT(); asm volatile("" ::: "memory");
}
struct SrcGU { const float* wg; const float* wu;
    __device__ __forceinline__ int ld() const { return FF; }
    __device__ __forceinline__ const float* base(int n) const { const uintptr_t sel = (uintptr_t)((n >> 7) & 1); return (const float*)((uintptr_t)wg + sel * ((uintptr_t)wu - (uintptr_t)wg)); }
    __device__ __forceinline__ long col(int n) const { return 128 * (n >> 8) + (n & 127); } };
struct SrcPlain { const float* w; int ldw;
    __device__ __forceinline__ int ld() const { return ldw; }
    __device__ __forceinline__ const float* base(int) const { return w; }
    __device__ __forceinline__ long col(int n) const { return n; } };
struct SrcWin { const float* w;
    __device__ __forceinline__ int ld() const { return 10520; }
    __device__ __forceinline__ const float* base(int) const { return w; }
    __device__ __forceinline__ long col(int n) const {
        int c;
        if (n < 3072) c = n; else if (n < 4608) c = n - 3072 + 3088; else if (n < 6400) c = n - 4608 + 4632; else if (n < 6416) c = n - 6400 + 3072; else if (n < 6424) c = n - 6416 + 4624; else if (n < 6656) c = -1; else c = n - 6656 + 6424;
        return c; } };
PH_FN void ph_weights(const Ctx C, ArgsP a, int l) {
    LAS bf16* scr = (LAS bf16*)(C.lds + C.wave * 16384);
    const int gw = C.bid * NWAVES + C.wave, NGW = C.G * NWAVES; int rot = 0;
#define W_FIRST(cnt) ({ const int f_ = (gw + NGW - rot % NGW) % NGW; rot += (cnt); f_; })
#pragma unroll 1
    for (int f = 0; f < 2; ++f) {
        const float* nrm = a->in[f ? 35 : 1] + (size_t)l * D; const float* wg = a->in[f ? 36 : 2] + (size_t)l * D * FF; const float* wu = a->in[f ? 37 : 3] + (size_t)l * D * FF; const float* wd = a->in[f ? 38 : 4] + (size_t)l * FF * D;
        bf16* Wgu = (bf16*)(C.ws + (f ? WS_WGU2 : WS_WGU1)); bf16* Wd = (bf16*)(C.ws + (f ? WS_WD2 : WS_WD1));
        const SrcGU sgu{wg, wu};
        for (int it = W_FIRST((D / 64) * (2 * FF / 64)); it < (D / 64) * (2 * FF / 64); it += NGW) tr_item(sgu, nrm, Wgu, D, it / (2 * FF / 64), it % (2 * FF / 64), scr, C.lane);
        const SrcPlain sd{wd, D};
        for (int it = W_FIRST((FF / 64) * (D / 64)); it < (FF / 64) * (D / 64); it += NGW) tr_item(sd, nullptr, Wd, FF, it / (D / 64), it % (D / 64), scr, C.lane);
    }
    { const SrcWin sw{a->in[6] + (size_t)l * D * 10520}; const float* nrm = a->in[5] + (size_t)l * D; bf16* Win = (bf16*)(C.ws + WS_WIN);
      for (int it = W_FIRST((D / 64) * (NWIN / 64)); it < (D / 64) * (NWIN / 64); it += NGW) tr_item(sw, nrm, Win, D, it / (NWIN / 64), it % (NWIN / 64), scr, C.lane); }
    { bf16* Wb = (bf16*)(C.ws + WS_WB);
      for (int it = W_FIRST(4 * (512 / 64) * (D / 64)); it < 4 * (512 / 64) * (D / 64); it += NGW) { const int z = it / ((512 / 64) * (D / 64)), r = it % ((512 / 64) * (D / 64));
          const SrcPlain sb{a->in[32] + ((size_t)l * 4 + z) * 512 * D, D}; tr_item(sb, nullptr, Wb + (size_t)z * D * 512, 512, r / (D / 64), r % (D / 64), scr, C.lane); } }
    { bf16* W2T = (bf16*)(C.ws + WS_RW2T); bf16* A2T = W2T + 512 * 64; bf16* G2T = A2T + 512 * 64;
      const SrcPlain s1{a->in[23] + (size_t)l * 64 * 512, 512}, s2{a->in[25] + (size_t)l * 64 * 512, 512}, s3{a->in[26] + (size_t)l * 128 * 512, 512};
      for (int it = W_FIRST(8); it < 8; it += NGW) tr_item(s1, nullptr, W2T, 64, 0, it, scr, C.lane);
      for (int it = W_FIRST(8); it < 8; it += NGW) tr_item(s2, nullptr, A2T, 64, 0, it, scr, C.lane);
      for (int it = W_FIRST(16); it < 16; it += NGW) tr_item(s3, nullptr, G2T, 128, it >> 3, it & 7, scr, C.lane); }
    { const SrcPlain so{a->in[34] + (size_t)l * D * D, D}; bf16* Wo = (bf16*)(C.ws + WS_WO);
      for (int it = W_FIRST((D / 64) * (D / 64)); it < (D / 64) * (D / 64); it += NGW) tr_item(so, nullptr, Wo, D, it / (D / 64), it % (D / 64), scr, C.lane); }
}

#undef W_FIRST
PH_FN void ph_da_prep(const Ctx C) {
    bf16* P = (bf16*)(C.ws + WS_P); const float* cosT = (const float*)(C.ws + WS_COS); const float* sinT = (const float*)(C.ws + WS_SIN);
    const int gw = C.bid * NWAVES + C.wave, NGW = C.G * NWAVES;
    const int hc = C.lane >> 2, ch = C.lane & 3;
    const float sc = (hc < 8) ? 0.125f * LOG2E : 1.0f;
    for (int m = gw; m < M; m += NGW) {
        const int t = m & (SEQ - 1);
        bf16* p1 = P + (size_t)m * NPM + hc * 64 + ch * 8; bf16* p2 = p1 + 32;
        float x1[8], x2[8], o1[8], o2[8];
        unpack8(*(const u32x4*)p1, x1); unpack8(*(const u32x4*)p2, x2);
        const float* cp = cosT + t * 32 + ch * 8; const float* sp = sinT + t * 32 + ch * 8;
#pragma unroll
        for (int i = 0; i < 8; ++i) { const float c = cp[i], s = sp[i]; o1[i] = (x1[i] * c - x2[i] * s) * sc; o2[i] = (x2[i] * c + x1[i] * s) * sc; }
        *(u32x4*)p1 = pack8(o1); *(u32x4*)p2 = pack8(o2);
    }
    bf16* VT = (bf16*)(C.ws + WS_VT); LAS bf16* tile = (LAS bf16*)C.lds;
    for (int it = C.bid; it < 2 * NCH * 4; it += C.G) {
        const int h = it & 3, bc = it >> 2, b = bc >> 7, tb = bc & 127; const size_t row0 = (size_t)bc * 64;
        WG_SYNC();
#pragma unroll
        for (int i = 0; i < 2; ++i) { const int q = C.tid + NTHR * i, t = q >> 4, c16 = q & 15;
            *(LAS u32x4*)(tile + t * 136 + c16 * 8) = *(const u32x4*)(P + (row0 + t) * NPM + C_DAV + h * 128 + c16 * 8); }
        WG_SYNC();
#pragma unroll
        for (int i = 0; i < 2; ++i) { const int q = C.tid + NTHR * i, d = q >> 3, tc = q & 7; unsigned w[4];
#pragma unroll
            for (int e = 0; e < 4; ++e) w[e] = (unsigned)tile[(8 * tc + 2 * e) * 136 + d] | ((unsigned)tile[(8 * tc + 2 * e + 1) * 136 + d] << 16);
            u32x4 o; o.x = w[0]; o.y = w[1]; o.z = w[2]; o.w = w[3];
            *(u32x4*)(VT + ((size_t)(b * 4 + h) * 128 + d) * SEQ + tb * 64 + 8 * tc) = o; }
    }
    WG_SYNC();
}

typedef LAS bf16* LB; typedef const LAS bf16* CLB;
__device__ __forceinline__ pg8::bf16x8 frag32(CLB X, int ld, int row0, int k0, int lane) { return *(const LAS pg8::bf16x8*)(X + (row0 + (lane & 31)) * ld + k0 + 8 * (lane >> 5)); }
template <int K> __device__ __forceinline__ void mma_nt(f32x16& acc, CLB A, int lda, int m0, CLB Bt, int ldb, int n0, int lane) {
#pragma unroll
    for (int k = 0; k < K; k += 16) acc = __builtin_amdgcn_mfma_f32_32x32x16_bf16(frag32(A, lda, m0, k, lane), frag32(Bt, ldb, n0, k, lane), acc, 0, 0, 0);
}
__device__ __forceinline__ int crow(int r, int hi) { return (r & 3) + 8 * (r >> 2) + 4 * hi; }
__device__ __forceinline__ f32x16 zero16() { f32x16 z;
#pragma unroll
    for (int r = 0; r < 16; ++r) z[r] = 0.f;
    return z; }

__device__ __forceinline__ void gla_compute_G(const Ctx& C, ArgsP a, int l, int bc, int h, LF Gs) {
    const bf16* P = (const bf16*)(C.ws + WS_P); const float* W2 = a->in[12] + (size_t)l * 16 * 256; const float* gb = a->in[13] + (size_t)l * 256;
    const int t = C.tid >> 3, kg = C.tid & 7; const size_t row = (size_t)bc * 64 + t;
    float glr[16]; unpack8(*(const u32x4*)(P + row * NPM + C_GLR), glr); unpack8(*(const u32x4*)(P + row * NPM + C_GLR + 8), glr + 8);
#pragma unroll
    for (int i = 0; i < 8; ++i) { const int k = h * 64 + kg * 8 + i; float x = gb[k];
#pragma unroll
        for (int r = 0; r < 16; ++r) x += glr[r] * W2[r * 256 + k];
        Gs[t * 68 + kg * 8 + i] = logsigmoidf_(x) * (1.0f / 16.0f); }
    WG_SYNC();
    { const int seg = C.tid >> 6, k = C.tid & 63; float run = 0.f;
#pragma unroll
      for (int i = 0; i < 8; ++i) { run += Gs[(8 * seg + i) * 68 + k]; Gs[(8 * seg + i) * 68 + k] = run; }
      WG_SYNC();
      float off = 0.f;
#pragma unroll
      for (int sg = 0; sg < 7; ++sg) { const float tot = Gs[(8 * sg + 7) * 68 + k]; off += (sg < seg) ? tot : 0.f; }
      WG_SYNC();
#pragma unroll
      for (int i = 0; i < 8; ++i) Gs[(8 * seg + i) * 68 + k] += off; }
    WG_SYNC();
}
PH_HEAVY void ph_gla_a(const Ctx C, ArgsP a, int l) {
    const bf16* P = (const bf16*)(C.ws + WS_P); float* GKV = (float*)(C.ws + WS_GKV); float* GL = (float*)(C.ws + WS_GLAST);
    LF Gs = (LF)C.lds; LB KDT = (LB)(C.lds + 17408); LB VT = (LB)(C.lds + 26624);
    for (int it = C.bid; it < NBC * 4; it += C.G) {
        const int bc = it >> 2, h = it & 3;
        WG_SYNC();
        gla_compute_G(C, a, l, bc, h, Gs);
        { const int t = C.tid >> 3, g8 = C.tid & 7; const size_t row = (size_t)bc * 64 + t;
          float kf[8]; unpack8(*(const u32x4*)(P + row * NPM + C_GK + h * 64 + g8 * 8), kf);
#pragma unroll
          for (int i = 0; i < 8; ++i) { const int k = g8 * 8 + i; KDT[k * 72 + t] = (bf16)f2bf(kf[i] * __expf(Gs[63 * 68 + k] - Gs[t * 68 + k])); }
          const u32x4 v0 = *(const u32x4*)(P + row * NPM + C_GV + h * 128 + g8 * 16), v1 = *(const u32x4*)(P + row * NPM + C_GV + h * 128 + g8 * 16 + 8);
          const unsigned vw[8] = {v0.x, v0.y, v0.z, v0.w, v1.x, v1.y, v1.z, v1.w};
#pragma unroll
          for (int i = 0; i < 8; ++i) { VT[(g8 * 16 + 2 * i) * 72 + t] = (bf16)(vw[i] & 0xffffu); VT[(g8 * 16 + 2 * i + 1) * 72 + t] = (bf16)(vw[i] >> 16); }
          if (C.tid < 64) GL[(size_t)it * 64 + C.tid] = Gs[63 * 68 + C.tid]; }
        WG_SYNC();
        { const int kt = C.wave >> 2, vt = C.wave & 3, n = C.lane & 31, hi = C.lane >> 5;
          f32x16 acc = zero16(); mma_nt<64>(acc, KDT, 72, 32 * kt, VT, 72, 32 * vt, C.lane);
          float* dst = GKV + ((size_t)it * 128 + 32 * vt + n) * 64 + 32 * kt + 4 * hi;
#pragma unroll
          for (int g = 0; g < 4; ++g) *(f32x4*)(dst + 8 * g) = (f32x4){acc[4 * g], acc[4 * g + 1], acc[4 * g + 2], acc[4 * g + 3]}; }
    }
    WG_SYNC();
}
PH_FN void gla_scan_part(const Ctx C, int part) {
    float* GKV = (float*)(C.ws + WS_GKV); const float* GL = (const float*)(C.ws + WS_GLAST);
    const int e = part * NTHR + C.tid, chain = e >> 13, idx = e & 8191, b = chain >> 2, h = chain & 3, k = idx & 63;
    float st = 0.f;
#pragma unroll 1
    for (int c0 = 0; c0 < NCH; c0 += 16) {
        float tmp[16], dec[16];
#pragma unroll
        for (int i = 0; i < 16; ++i) { const size_t item = (size_t)(b * NCH + c0 + i) * 4 + h; tmp[i] = GKV[item * 8192 + idx]; dec[i] = GL[item * 64 + k]; }
#pragma unroll
        for (int i = 0; i < 16; ++i) { const size_t item = (size_t)(b * NCH + c0 + i) * 4 + h; GKV[item * 8192 + idx] = st; st = __expf(dec[i]) * st + tmp[i]; }
    }
}
PH_HEAVY void ph_gla_c(const Ctx C, ArgsP a, int l) {
    const bf16* P = (const bf16*)(C.ws + WS_P); const float* GKV = (const float*)(C.ws + WS_GKV); bf16* YS = (bf16*)(C.ws + WS_YS);
    const float* gnorm = a->in[14] + (size_t)l * 128;
    LF Gs = (LF)C.lds; LB QD = (LB)(C.lds + 17408); LB KDR = (LB)(C.lds + 26624); LB QI = (LB)(C.lds + 35840); LB ATT = (LB)(C.lds + 45056); LB VT = (LB)(C.lds + 54272); LB ST = (LB)(C.lds + 72704); LF PS = (LF)(C.lds + 91136);
    for (int it = C.bid; it < NBC * 4; it += C.G) {
        const int bc = it >> 2, h = it & 3;
        WG_SYNC();
        gla_compute_G(C, a, l, bc, h, Gs);
        { const int t = C.tid >> 3, g8 = C.tid & 7; const size_t row = (size_t)bc * 64 + t;
          float qf[8], kf[8], o1[8], o2[8], o3[8];
          unpack8(*(const u32x4*)(P + row * NPM + C_GQ + h * 64 + g8 * 8), qf); unpack8(*(const u32x4*)(P + row * NPM + C_GK + h * 64 + g8 * 8), kf);
#pragma unroll
          for (int i = 0; i < 8; ++i) { const int k = g8 * 8 + i; const float g = Gs[t * 68 + k], d = g - Gs[32 * 68 + k]; o1[i] = qf[i] * 0.125f * __expf(d); o2[i] = kf[i] * __expf(-d); o3[i] = qf[i] * 0.125f * __expf(g); }
          *(LAS u32x4*)(QD + t * 72 + g8 * 8) = pack8(o1); *(LAS u32x4*)(KDR + t * 72 + g8 * 8) = pack8(o2); *(LAS u32x4*)(QI + t * 72 + g8 * 8) = pack8(o3);
          const u32x4 v0 = *(const u32x4*)(P + row * NPM + C_GV + h * 128 + g8 * 16), v1 = *(const u32x4*)(P + row * NPM + C_GV + h * 128 + g8 * 16 + 8);
          const unsigned vw[8] = {v0.x, v0.y, v0.z, v0.w, v1.x, v1.y, v1.z, v1.w};
#pragma unroll
          for (int i = 0; i < 8; ++i) { VT[(g8 * 16 + 2 * i) * 72 + t] = (bf16)(vw[i] & 0xffffu); VT[(g8 * 16 + 2 * i + 1) * 72 + t] = (bf16)(vw[i] >> 16); }
          const int v = C.tid >> 2, kq = (C.tid & 3) * 16; const float* sp = GKV + ((size_t)it * 128 + v) * 64 + kq;
          float s[16];
#pragma unroll
          for (int i = 0; i < 4; ++i) { const f32x4 x = *(const f32x4*)(sp + 4 * i); s[4 * i] = x[0]; s[4 * i + 1] = x[1]; s[4 * i + 2] = x[2]; s[4 * i + 3] = x[3]; }
          *(LAS u32x4*)(ST + v * 72 + kq) = pack8(s); *(LAS u32x4*)(ST + v * 72 + kq + 8) = pack8(s + 8); }
        WG_SYNC();
        const int n = C.lane & 31, hi = C.lane >> 5;
        if (C.wave < 4) {
            const int it_ = C.wave >> 1, jt = C.wave & 1;
            f32x16 acc = zero16();
            if (jt <= it_) mma_nt<64>(acc, QD, 72, 32 * it_, KDR, 72, 32 * jt, C.lane);
#pragma unroll
            for (int r = 0; r < 16; ++r) { const int i = 32 * it_ + crow(r, hi), j = 32 * jt + n; ATT[i * 72 + j] = (bf16)f2bf(j <= i ? acc[r] : 0.f); }
        }
        WG_SYNC();
        {
            const int it_ = C.wave & 1, vt = C.wave >> 1;
            f32x16 acc = zero16();
            mma_nt<64>(acc, VT, 72, 32 * vt, ATT, 72, 32 * it_, C.lane);
            mma_nt<64>(acc, ST, 72, 32 * vt, QI, 72, 32 * it_, C.lane);
            float ss = 0.f;
#pragma unroll
            for (int r = 0; r < 16; ++r) ss += acc[r] * acc[r];
            ss += __shfl_xor(ss, 32);
            if (hi == 0) PS[(32 * it_ + n) * 4 + vt] = ss;
            WG_SYNC();
            const int i = 32 * it_ + n; const float tot = (PS[i * 4] + PS[i * 4 + 1]) + (PS[i * 4 + 2] + PS[i * 4 + 3]);
            const float rs = 1.0f / sqrtf(tot * (1.0f / 128.0f) + EPS); const size_t row = (size_t)bc * 64 + i;
#pragma unroll
            for (int g = 0; g < 4; ++g) { const int v0 = 32 * vt + 8 * g + 4 * hi;
                const u32x2 ogw = *(const u32x2*)(P + row * NPM + C_GOG + h * 128 + v0); const f32x4 gn = *(const f32x4*)(gnorm + v0);
                const float og[4] = {bflo(ogw.x), bfhi(ogw.x), bflo(ogw.y), bfhi(ogw.y)}; float o4[4];
#pragma unroll
                for (int y = 0; y < 4; ++y) o4[y] = acc[4 * g + y] * rs * gn[y] * siluf_(og[y]);
                u32x2 w; w.x = pk2(o4[0], o4[1]); w.y = pk2(o4[2], o4[3]); *(u32x2*)(YS + row * 2048 + 512 + h * 128 + v0) = w; }
        }
    }
    WG_SYNC();
}

__device__ __forceinline__ void ssd_conv8(const bf16* P, const float* cw, const float* cb, int bc, int t, int ch0, float* o) {
    const int pos = (bc & 127) * 64 + t; const size_t row = (size_t)bc * 64 + t;
#pragma unroll
    for (int i = 0; i < 8; ++i) o[i] = cb[ch0 + i];
#pragma unroll
    for (int tap = 0; tap < 4; ++tap) { if (pos - 3 + tap >= 0) { float x[8]; unpack8(*(const u32x4*)(P + (row - 3 + tap) * NPM + C_SX + ch0), x);
#pragma unroll
        for (int i = 0; i < 8; ++i) o[i] += cw[tap * 1024 + ch0 + i] * x[i]; } }
#pragma unroll
    for (int i = 0; i < 8; ++i) o[i] = siluf_(o[i]);
}
PH_HEAVY void ph_ssd_a(const Ctx C, ArgsP a, int l) {
    const bf16* P = (const bf16*)(C.ws + WS_P); float* SST = (float*)(C.ws + WS_SST); float* SDT = (float*)(C.ws + WS_SDT); float* SAC = (float*)(C.ws + WS_SACUM); float* SCD = (float*)(C.ws + WS_SCDEC);
    const float* cw = a->in[15] + (size_t)l * 4 * 1024; const float* cb = a->in[16] + (size_t)l * 1024; const float* dtb = a->in[17] + (size_t)l * 8; const float* alog = a->in[18] + (size_t)l * 8;
    LB BT = (LB)C.lds; LB XDT = (LB)(C.lds + 18432); LF dtv = (LF)(C.lds + 27648); LF acu = (LF)(C.lds + 27904); LF av = (LF)(C.lds + 28160);
    for (int it = C.bid; it < NBC * 2; it += C.G) {
        const int bc = it >> 1, g = it & 1; const int t = C.tid >> 3, cg = C.tid & 7;
        WG_SYNC();
        { float o[8];
#pragma unroll
          for (int half = 0; half < 2; ++half) { ssd_conv8(P, cw, cb, bc, t, 512 + g * 128 + cg * 16 + half * 8, o);
#pragma unroll
              for (int i = 0; i < 8; ++i) BT[(cg * 16 + half * 8 + i) * 72 + t] = (bf16)f2bf(o[i]); } }
#pragma unroll 1
        for (int hh = 0; hh < 4; ++hh) {
            const int hd = 4 * g + hh; const size_t item8 = (size_t)bc * 8 + hd;
            WG_SYNC();
            if (C.tid < 64) { const size_t row = (size_t)bc * 64 + C.tid; const float dt = softplusf_(bf2f(P[row * NPM + C_SDT + hd]) + dtb[hd]); dtv[C.tid] = dt; av[C.tid] = -__expf(alog[hd]) * dt; }
            WG_SYNC();
            if (C.tid < 64) { float s = av[C.tid];
#pragma unroll
                for (int o = 1; o < 64; o <<= 1) { const float nb_ = __shfl_up(s, o); if (C.lane >= o) s += nb_; }
                acu[C.tid] = s; const size_t row = (size_t)bc * 64 + C.tid; SDT[row * 8 + hd] = dtv[C.tid]; SAC[row * 8 + hd] = s; if (C.tid == 63) SCD[item8] = __expf(s); }
            WG_SYNC();
            { float o[8]; ssd_conv8(P, cw, cb, bc, t, hd * 64 + cg * 8, o); const float sc = dtv[t] * __expf(acu[63] - acu[t]);
#pragma unroll
              for (int i = 0; i < 8; ++i) XDT[(cg * 8 + i) * 72 + t] = (bf16)f2bf(o[i] * sc); }
            WG_SYNC();
            { const int pt = C.wave >> 2, nt = C.wave & 3, n = C.lane & 31, hi = C.lane >> 5;
              f32x16 acc = zero16(); mma_nt<64>(acc, XDT, 72, 32 * pt, BT, 72, 32 * nt, C.lane);
#pragma unroll
              for (int r = 0; r < 16; ++r) SST[(item8 * 64 + 32 * pt + crow(r, hi)) * 128 + 32 * nt + n] = acc[r]; }
        }
    }
    WG_SYNC();
}
PH_FN void ssd_scan_part(const Ctx C, int part) {
    float* SST = (float*)(C.ws + WS_SST); const float* SCD = (const float*)(C.ws + WS_SCDEC);
    const int e = part * NTHR + C.tid, chain = e >> 13, idx = e & 8191, b = chain >> 3, hd = chain & 7;
    float st = 0.f;
#pragma unroll 1
    for (int c0 = 0; c0 < NCH; c0 += 16) {
        float tmp[16], dec[16];
#pragma unroll
        for (int i = 0; i < 16; ++i) { const size_t item = (size_t)(b * NCH + c0 + i) * 8 + hd; tmp[i] = SST[item * 8192 + idx]; dec[i] = SCD[item]; }
#pragma unroll
        for (int i = 0; i < 16; ++i) { const size_t item = (size_t)(b * NCH + c0 + i) * 8 + hd; SST[item * 8192 + idx] = st; st = dec[i] * st + tmp[i]; }
    }
}
PH_HEAVY void ph_ssd_c(const Ctx C, ArgsP a, int l) {
    const bf16* P = (const bf16*)(C.ws + WS_P); const float* SST = (const float*)(C.ws + WS_SST); const float* SDT = (const float*)(C.ws + WS_SDT); const float* SAC = (const float*)(C.ws + WS_SACUM); bf16* YS = (bf16*)(C.ws + WS_YS);
    const float* cw = a->in[15] + (size_t)l * 4 * 1024; const float* cb = a->in[16] + (size_t)l * 1024; const float* dpar = a->in[19] + (size_t)l * 8; const float* snorm = a->in[20] + (size_t)l * 512;
    LB BN = (LB)C.lds; LB CN = (LB)(C.lds + 17408); LF CB = (LF)(C.lds + 34816); LB SC = (LB)(C.lds + 52224); LB XST = (LB)(C.lds + 61440); LB HP = (LB)(C.lds + 70656); LB CE = (LB)(C.lds + 88064);
    LF dtv = (LF)(C.lds + 105472); LF acu = (LF)(C.lds + 105728); LF PSQ = (LF)(C.lds + 105984);
    for (int it = C.bid; it < NBC * 2; it += C.G) {
        const int bc = it >> 1, g = it & 1;
        const int t = C.tid >> 3, cg = C.tid & 7, n = C.lane & 31, hi = C.lane >> 5;
        WG_SYNC();
        { float o[8];
#pragma unroll
          for (int half = 0; half < 2; ++half) {
              ssd_conv8(P, cw, cb, bc, t, 512 + g * 128 + cg * 16 + half * 8, o); *(LAS u32x4*)(BN + t * 136 + cg * 16 + half * 8) = pack8(o);
              ssd_conv8(P, cw, cb, bc, t, 768 + g * 128 + cg * 16 + half * 8, o); *(LAS u32x4*)(CN + t * 136 + cg * 16 + half * 8) = pack8(o); } }
        WG_SYNC();
        if (C.wave < 4) {
            const int it_ = C.wave >> 1, jt = C.wave & 1;
            f32x16 acc = zero16(); mma_nt<128>(acc, CN, 136, 32 * it_, BN, 136, 32 * jt, C.lane);
#pragma unroll
            for (int r = 0; r < 16; ++r) CB[(32 * it_ + crow(r, hi)) * 68 + 32 * jt + n] = acc[r];
        }
        float yk[4][16]; float ssq = 0.f;
        const int pt = (C.wave >> 1) & 1, it2 = C.wave & 1;
#pragma unroll
        for (int hh = 0; hh < 4; ++hh) {
            const int hd = 4 * g + hh; const size_t item8 = (size_t)bc * 8 + hd;
            WG_SYNC();
            if (C.tid < 64) { const size_t row = (size_t)bc * 64 + C.tid; dtv[C.tid] = SDT[row * 8 + hd]; acu[C.tid] = SAC[row * 8 + hd]; }
            { float o[8]; ssd_conv8(P, cw, cb, bc, t, hd * 64 + cg * 8, o);
#pragma unroll
              for (int i = 0; i < 8; ++i) XST[(cg * 8 + i) * 72 + t] = (bf16)f2bf(o[i]);
              const int p = C.tid >> 3, n0 = (C.tid & 7) * 16; const float* sp = SST + (item8 * 64 + p) * 128 + n0; float s[16];
#pragma unroll
              for (int i = 0; i < 4; ++i) { const f32x4 x = *(const f32x4*)(sp + 4 * i); s[4 * i] = x[0]; s[4 * i + 1] = x[1]; s[4 * i + 2] = x[2]; s[4 * i + 3] = x[3]; }
              *(LAS u32x4*)(HP + p * 136 + n0) = pack8(s); *(LAS u32x4*)(HP + p * 136 + n0 + 8) = pack8(s + 8); }
            WG_SYNC();
            { const float ai = acu[t]; float o[8];
#pragma unroll
              for (int jj = 0; jj < 8; ++jj) { const int j = 8 * cg + jj; o[jj] = (j <= t) ? CB[t * 68 + j] * __expf(ai - acu[j]) * dtv[j] : 0.f; }
              *(LAS u32x4*)(SC + t * 72 + 8 * cg) = pack8(o);
              const float ea = __expf(ai); float c8[8];
#pragma unroll
              for (int half = 0; half < 2; ++half) { unpack8(*(const LAS u32x4*)(CN + t * 136 + cg * 16 + half * 8), c8);
#pragma unroll
                  for (int i = 0; i < 8; ++i) c8[i] *= ea;
                  *(LAS u32x4*)(CE + t * 136 + cg * 16 + half * 8) = pack8(c8); } }
            WG_SYNC();
            if (C.wave < 4) {
                f32x16 acc = zero16();
                mma_nt<64>(acc, XST, 72, 32 * pt, SC, 72, 32 * it2, C.lane);
                mma_nt<128>(acc, HP, 136, 32 * pt, CE, 136, 32 * it2, C.lane);
                const int i = 32 * it2 + n; const size_t row = (size_t)bc * 64 + i; const float dh = dpar[hd];
#pragma unroll
                for (int q4 = 0; q4 < 4; ++q4) { const int p0 = 32 * pt + 8 * q4 + 4 * hi;
                    const u32x2 zw = *(const u32x2*)(P + row * NPM + C_SZ + hd * 64 + p0); const float zf[4] = {bflo(zw.x), bfhi(zw.x), bflo(zw.y), bfhi(zw.y)};
#pragma unroll
                    for (int e = 0; e < 4; ++e) { const float xs = bf2f(XST[(p0 + e) * 72 + i]); const float v = (acc[4 * q4 + e] + dh * xs) * siluf_(zf[e]); yk[hh][4 * q4 + e] = v; ssq += v * v; } }
            }
        }
        if (C.wave < 4) { ssq += __shfl_xor(ssq, 32); if (hi == 0) PSQ[(32 * it2 + n) * 2 + pt] = ssq; }
        WG_SYNC();
        if (C.wave < 4) {
            const int i = 32 * it2 + n; const float rs = 1.0f / sqrtf((PSQ[i * 2] + PSQ[i * 2 + 1]) * (1.0f / 256.0f) + EPS); const size_t row = (size_t)bc * 64 + i;
#pragma unroll
            for (int hh = 0; hh < 4; ++hh)
#pragma unroll
                for (int q4 = 0; q4 < 4; ++q4) { const int ch = g * 256 + hh * 64 + 32 * pt + 8 * q4 + 4 * hi; const f32x4 sn = *(const f32x4*)(snorm + ch);
                    u32x2 w; w.x = pk2(yk[hh][4 * q4] * rs * sn[0], yk[hh][4 * q4 + 1] * rs * sn[1]); w.y = pk2(yk[hh][4 * q4 + 2] * rs * sn[2], yk[hh][4 * q4 + 3] * rs * sn[3]);
                    *(u32x2*)(YS + row * 2048 + 1024 + ch) = w; }
        }
    }
    WG_SYNC();
}

#ifndef RW_CHUNKED
#define RW_CHUNKED 1
#endif
__device__ __forceinline__ void rw_lerp8(const bf16* P, const float* mu, int bc, int t, int c0, float* o) {
    const size_t row = (size_t)bc * 64 + t; const bool first = ((bc & 127) == 0) && (t == 0);
    float x[8], xp[8]; unpack8(*(const u32x4*)(P + row * NPM + C_RR + c0), x);
    if (!first) unpack8(*(const u32x4*)(P + (row - 1) * NPM + C_RR + c0), xp); else {
#pragma unroll
        for (int i = 0; i < 8; ++i) xp[i] = 0.f; }
#pragma unroll
    for (int i = 0; i < 8; ++i) o[i] = x[i] + (xp[i] - x[i]) * mu[c0 + i];
}
__device__ __forceinline__ void rw_lerp4(const bf16* P, const float* mu, size_t row, bool first, int c0, float* o) {
    const u32x2 xw = *(const u32x2*)(P + row * NPM + C_RR + c0); const float x[4] = {bflo(xw.x), bfhi(xw.x), bflo(xw.y), bfhi(xw.y)};
    float xp[4] = {0.f, 0.f, 0.f, 0.f};
    if (!first) { const u32x2 pw = *(const u32x2*)(P + (row - 1) * NPM + C_RR + c0); xp[0] = bflo(pw.x); xp[1] = bfhi(pw.x); xp[2] = bflo(pw.y); xp[3] = bfhi(pw.y); }
    const f32x4 m = *(const f32x4*)(mu + c0);
#pragma unroll
    for (int i = 0; i < 4; ++i) o[i] = x[i] + (xp[i] - x[i]) * m[i];
}
#define RW_WFRAG(WT_, K_, nt_, s_) (*(const pg8::bf16x8*)((WT_) + (size_t)(head * 64 + 32 * (nt_) + n) * (K_) + 16 * (s_) + 8 * hi))
PH_FN void rwp_stage(const Ctx C, ArgsP a, int l, int bc) {
    const bf16* P = (const bf16*)(C.ws + WS_P);
    float* RWW = (float*)(C.ws + WS_RWW); bf16* RWR = (bf16*)(C.ws + WS_RWR); bf16* RWK = (bf16*)(C.ws + WS_RWK); bf16* RWV = (bf16*)(C.ws + WS_RWV); bf16* RWKK = (bf16*)(C.ws + WS_RWKK); bf16* RWB = (bf16*)(C.ws + WS_RWB); bf16* RWG = (bf16*)(C.ws + WS_RWG);
    const bf16* W2T = (const bf16*)(C.ws + WS_RW2T); const bf16* A2T = W2T + 512 * 64; const bf16* G2T = A2T + 512 * 64;
    const float* mu = a->in[21] + (size_t)l * 1792; const float* w0 = a->in[22] + (size_t)l * 512; const float* a0 = a->in[24] + (size_t)l * 512;
    const float* k_k = a->in[27] + (size_t)l * 512; const float* k_a = a->in[28] + (size_t)l * 512;
    LB WLb = (LB)C.lds; LB ALb = (LB)(C.lds + 9216); LB GLb = (LB)(C.lds + 18432);
    (void)P; (void)RWW; (void)RWR; (void)RWK; (void)RWV; (void)RWKK; (void)RWB; (void)RWG; (void)W2T; (void)A2T; (void)G2T; (void)mu; (void)w0; (void)a0; (void)k_k; (void)k_a; (void)WLb; (void)ALb; (void)GLb;
        WG_SYNC();
        { const int t = C.tid >> 3, cg = C.tid & 7; float o[8];
          rw_lerp8(P, mu, bc, t, 1536 + cg * 8, o);
#pragma unroll
          for (int i = 0; i < 8; ++i) o[i] = tanhf(o[i]);
          *(LAS u32x4*)(WLb + t * 72 + cg * 8) = pack8(o);
          rw_lerp8(P, mu, bc, t, 1600 + cg * 8, o); *(LAS u32x4*)(ALb + t * 72 + cg * 8) = pack8(o);
#pragma unroll
          for (int half = 0; half < 2; ++half) { rw_lerp8(P, mu, bc, t, 1664 + cg * 16 + half * 8, o);
#pragma unroll
              for (int i = 0; i < 8; ++i) o[i] = sigmoidf_(o[i]);
              *(LAS u32x4*)(GLb + t * 136 + cg * 16 + half * 8) = pack8(o); } }
        WG_SYNC();
}
PH_FN void rwp_w(const Ctx C, ArgsP a, int l, int bc, int tt) {
    const bf16* P = (const bf16*)(C.ws + WS_P);
    float* RWW = (float*)(C.ws + WS_RWW); bf16* RWR = (bf16*)(C.ws + WS_RWR); bf16* RWK = (bf16*)(C.ws + WS_RWK); bf16* RWV = (bf16*)(C.ws + WS_RWV); bf16* RWKK = (bf16*)(C.ws + WS_RWKK); bf16* RWB = (bf16*)(C.ws + WS_RWB); bf16* RWG = (bf16*)(C.ws + WS_RWG);
    const bf16* W2T = (const bf16*)(C.ws + WS_RW2T); const bf16* A2T = W2T + 512 * 64; const bf16* G2T = A2T + 512 * 64;
    const float* mu = a->in[21] + (size_t)l * 1792; const float* w0 = a->in[22] + (size_t)l * 512; const float* a0 = a->in[24] + (size_t)l * 512;
    const float* k_k = a->in[27] + (size_t)l * 512; const float* k_a = a->in[28] + (size_t)l * 512;
    LB WLb = (LB)C.lds; LB ALb = (LB)(C.lds + 9216); LB GLb = (LB)(C.lds + 18432);
    (void)P; (void)RWW; (void)RWR; (void)RWK; (void)RWV; (void)RWKK; (void)RWB; (void)RWG; (void)W2T; (void)A2T; (void)G2T; (void)mu; (void)w0; (void)a0; (void)k_k; (void)k_a; (void)WLb; (void)ALb; (void)GLb;
            const int head = C.wave, n = C.lane & 31, hi = C.lane >> 5; const int t = 32 * tt + n; const size_t row = (size_t)bc * 64 + t; const bool first = ((bc & 127) == 0) && (t == 0); (void)first; (void)row;
            { f32x16 c[2] = {zero16(), zero16()};
#pragma unroll
              for (int s4 = 0; s4 < 4; ++s4) { const pg8::bf16x8 fb = frag32(WLb, 72, 32 * tt, 16 * s4, C.lane);
#pragma unroll
                  for (int nt = 0; nt < 2; ++nt) c[nt] = __builtin_amdgcn_mfma_f32_32x32x16_bf16(RW_WFRAG(W2T, 64, nt, s4), fb, c[nt], 0, 0, 0); }
#pragma unroll
              for (int nt = 0; nt < 2; ++nt)
#pragma unroll
                  for (int g = 0; g < 4; ++g) { const int ch = head * 64 + 32 * nt + 8 * g + 4 * hi; const f32x4 w0v = *(const f32x4*)(w0 + ch); f32x4 o;
#pragma unroll
                      for (int e = 0; e < 4; ++e) o[e] = -0.606531f * sigmoidf_(w0v[e] + c[nt][4 * g + e]);
                      *(f32x4*)(RWW + row * 512 + ch) = o; } }
}
PH_FN void rwp_g(const Ctx C, ArgsP a, int l, int bc, int tt) {
    const bf16* P = (const bf16*)(C.ws + WS_P);
    float* RWW = (float*)(C.ws + WS_RWW); bf16* RWR = (bf16*)(C.ws + WS_RWR); bf16* RWK = (bf16*)(C.ws + WS_RWK); bf16* RWV = (bf16*)(C.ws + WS_RWV); bf16* RWKK = (bf16*)(C.ws + WS_RWKK); bf16* RWB = (bf16*)(C.ws + WS_RWB); bf16* RWG = (bf16*)(C.ws + WS_RWG);
    const bf16* W2T = (const bf16*)(C.ws + WS_RW2T); const bf16* A2T = W2T + 512 * 64; const bf16* G2T = A2T + 512 * 64;
    const float* mu = a->in[21] + (size_t)l * 1792; const float* w0 = a->in[22] + (size_t)l * 512; const float* a0 = a->in[24] + (size_t)l * 512;
    const float* k_k = a->in[27] + (size_t)l * 512; const float* k_a = a->in[28] + (size_t)l * 512;
    LB WLb = (LB)C.lds; LB ALb = (LB)(C.lds + 9216); LB GLb = (LB)(C.lds + 18432);
    (void)P; (void)RWW; (void)RWR; (void)RWK; (void)RWV; (void)RWKK; (void)RWB; (void)RWG; (void)W2T; (void)A2T; (void)G2T; (void)mu; (void)w0; (void)a0; (void)k_k; (void)k_a; (void)WLb; (void)ALb; (void)GLb;
            const int head = C.wave, n = C.lane & 31, hi = C.lane >> 5; const int t = 32 * tt + n; const size_t row = (size_t)bc * 64 + t; const bool first = ((bc & 127) == 0) && (t == 0); (void)first; (void)row;
            { f32x16 c[2] = {zero16(), zero16()};
#pragma unroll
              for (int s8 = 0; s8 < 8; ++s8) { const pg8::bf16x8 fb = frag32(GLb, 136, 32 * tt, 16 * s8, C.lane);
#pragma unroll
                  for (int nt = 0; nt < 2; ++nt) c[nt] = __builtin_amdgcn_mfma_f32_32x32x16_bf16(RW_WFRAG(G2T, 128, nt, s8), fb, c[nt], 0, 0, 0); }
#pragma unroll
              for (int nt = 0; nt < 2; ++nt)
#pragma unroll
                  for (int g = 0; g < 4; ++g) { const int ch = head * 64 + 32 * nt + 8 * g + 4 * hi;
                      u32x2 w; w.x = pk2(c[nt][4 * g], c[nt][4 * g + 1]); w.y = pk2(c[nt][4 * g + 2], c[nt][4 * g + 3]); *(u32x2*)(RWG + row * 512 + ch) = w; } }
}
PH_FN void rwp_ak(const Ctx C, ArgsP a, int l, int bc, int tt) {
    const bf16* P = (const bf16*)(C.ws + WS_P);
    float* RWW = (float*)(C.ws + WS_RWW); bf16* RWR = (bf16*)(C.ws + WS_RWR); bf16* RWK = (bf16*)(C.ws + WS_RWK); bf16* RWV = (bf16*)(C.ws + WS_RWV); bf16* RWKK = (bf16*)(C.ws + WS_RWKK); bf16* RWB = (bf16*)(C.ws + WS_RWB); bf16* RWG = (bf16*)(C.ws + WS_RWG);
    const bf16* W2T = (const bf16*)(C.ws + WS_RW2T); const bf16* A2T = W2T + 512 * 64; const bf16* G2T = A2T + 512 * 64;
    const float* mu = a->in[21] + (size_t)l * 1792; const float* w0 = a->in[22] + (size_t)l * 512; const float* a0 = a->in[24] + (size_t)l * 512;
    const float* k_k = a->in[27] + (size_t)l * 512; const float* k_a = a->in[28] + (size_t)l * 512;
    LB WLb = (LB)C.lds; LB ALb = (LB)(C.lds + 9216); LB GLb = (LB)(C.lds + 18432);
    (void)P; (void)RWW; (void)RWR; (void)RWK; (void)RWV; (void)RWKK; (void)RWB; (void)RWG; (void)W2T; (void)A2T; (void)G2T; (void)mu; (void)w0; (void)a0; (void)k_k; (void)k_a; (void)WLb; (void)ALb; (void)GLb;
            const int head = C.wave, n = C.lane & 31, hi = C.lane >> 5; const int t = 32 * tt + n; const size_t row = (size_t)bc * 64 + t; const bool first = ((bc & 127) == 0) && (t == 0); (void)first; (void)row;
            { float ss = 0.f;
#pragma unroll
              for (int nt = 0; nt < 2; ++nt)
#pragma unroll
                  for (int g = 0; g < 4; ++g) { const int ch = head * 64 + 32 * nt + 8 * g + 4 * hi; const f32x4 kkv = *(const f32x4*)(k_k + ch); float o[4]; rw_lerp4(P, mu, row, first, 512 + ch, o);
#pragma unroll
                      for (int e = 0; e < 4; ++e) { const float q = o[e] * kkv[e]; ss += q * q; } }
              ss += __shfl_xor(ss, 32);
              const float inv = 1.0f / fmaxf(sqrtf(ss), 1e-12f);
#pragma unroll 1
              for (int nt = 0; nt < 2; ++nt) {
                  f32x16 c = zero16();
#pragma unroll
                  for (int s4 = 0; s4 < 4; ++s4) c = __builtin_amdgcn_mfma_f32_32x32x16_bf16(RW_WFRAG(A2T, 64, nt, s4), frag32(ALb, 72, 32 * tt, 16 * s4, C.lane), c, 0, 0, 0);
#pragma unroll
                  for (int g = 0; g < 4; ++g) { const int ch = head * 64 + 32 * nt + 8 * g + 4 * hi; const f32x4 a0v = *(const f32x4*)(a0 + ch), kkv = *(const f32x4*)(k_k + ch), kav = *(const f32x4*)(k_a + ch);
                      float kkn[4], bb[4], kp[4], o[4]; rw_lerp4(P, mu, row, first, 512 + ch, o);
#pragma unroll
                      for (int e = 0; e < 4; ++e) { const float al = sigmoidf_(a0v[e] + c[4 * g + e]), x = o[e]; kkn[e] = x * kkv[e] * inv; bb[e] = kkn[e] * al; kp[e] = x * (1.0f + (al - 1.0f) * kav[e]); }
                      u32x2 w; w.x = pk2(kkn[0], kkn[1]); w.y = pk2(kkn[2], kkn[3]); *(u32x2*)(RWKK + row * 512 + ch) = w;
                      w.x = pk2(bb[0], bb[1]); w.y = pk2(bb[2], bb[3]); *(u32x2*)(RWB + row * 512 + ch) = w;
                      w.x = pk2(kp[0], kp[1]); w.y = pk2(kp[2], kp[3]); *(u32x2*)(RWK + row * 512 + ch) = w;
                      rw_lerp4(P, mu, row, first, ch, o); w.x = pk2(o[0], o[1]); w.y = pk2(o[2], o[3]); *(u32x2*)(RWR + row * 512 + ch) = w;
                      rw_lerp4(P, mu, row, first, 1024 + ch, o); w.x = pk2(o[0], o[1]); w.y = pk2(o[2], o[3]); *(u32x2*)(RWV + row * 512 + ch) = w; } } }
}
#undef RW_WFRAG
__device__ __forceinline__ void ph_rw_prep(const Ctx& C, ArgsP a, int l) {
    for (int bc = C.bid; bc < NBC; bc += C.G) { rwp_stage(C, a, l, bc);
#pragma unroll 1
        for (int tt = 0; tt < 2; ++tt) { rwp_w(C, a, l, bc, tt); rwp_g(C, a, l, bc, tt); rwp_ak(C, a, l, bc, tt); } }
    WG_SYNC();
}
template <int CTRL> __device__ __forceinline__ float dpp_get(float x) { return __builtin_bit_cast(float, __builtin_amdgcn_update_dpp(0, __builtin_bit_cast(int, x), CTRL, 0xf, 0xf, true)); }
__device__ __forceinline__ float reduce16(float x) { x += dpp_get<0xB1>(x); x += dpp_get<0x4E>(x); x += dpp_get<0x141>(x); x += dpp_get<0x140>(x); return x; }
#define RW_BAR() do { asm volatile("s_waitcnt lgkmcnt(0)" ::: "memory"); __builtin_amdgcn_s_barrier(); asm volatile("" ::: "memory"); } while (0)
PH_FN void rw_unit(const Ctx C, int chain, int rq) {
    const float* RWW = (const float*)(C.ws + WS_RWW); const bf16* RWR = (const bf16*)(C.ws + WS_RWR); const bf16* RWK = (const bf16*)(C.ws + WS_RWK); const bf16* RWV = (const bf16*)(C.ws + WS_RWV);
    const bf16* RWKK = (const bf16*)(C.ws + WS_RWKK); const bf16* RWB = (const bf16*)(C.ws + WS_RWB); bf16* RWY = (bf16*)(C.ws + WS_RWY);
    const int b = chain >> 3, h = chain & 7; const size_t rowb = (size_t)b * SEQ;
    constexpr int BUFB = 43008, O_KK = 0, O_W = 8192, O_B = 16384, O_K = 24576, O_R = 32768, O_V = 40960, NBLK = SEQ / 32;
    LAS unsigned char* L = C.lds;
    if (C.wave >= 4) {
        const int p = C.tid - 256, t = p >> 3, c8 = (p & 7) * 8;
        u32x4 rr, rk, rkk, rb; f32x4 w0, w1; unsigned rv;
#define RW_LOAD(blk) do { const size_t g_ = (rowb + (size_t)(blk) * 32 + t) * 512 + h * 64; \
            w0 = *(const f32x4*)(RWW + g_ + c8); w1 = *(const f32x4*)(RWW + g_ + c8 + 4); rr = *(const u32x4*)(RWR + g_ + c8); rk = *(const u32x4*)(RWK + g_ + c8); \
            rkk = *(const u32x4*)(RWKK + g_ + c8); rb = *(const u32x4*)(RWB + g_ + c8); rv = *(const unsigned*)(RWV + g_ + 16 * rq + (p & 7) * 2); } while (0)
#define RW_ST8(off, w_) do { float o_[8]; unpack8(w_, o_); LF d_ = (LF)(Lb + (off)) + t * 64 + c8; *(LAS f32x4*)d_ = (f32x4){o_[0], o_[1], o_[2], o_[3]}; *(LAS f32x4*)(d_ + 4) = (f32x4){o_[4], o_[5], o_[6], o_[7]}; } while (0)
        RW_LOAD(0);
        for (int blk = 0; blk < NBLK; ++blk) {
            LAS unsigned char* Lb = L + (blk & 1) * BUFB;
            { LF d = (LF)(Lb + O_W) + t * 64 + c8; *(LAS f32x4*)d = w0; *(LAS f32x4*)(d + 4) = w1; }
            RW_ST8(O_R, rr); RW_ST8(O_K, rk); RW_ST8(O_KK, rkk); RW_ST8(O_B, rb);
            { LF d = (LF)(Lb + O_V) + t * 16 + (p & 7) * 2; d[0] = bflo(rv); d[1] = bfhi(rv); }
            if (blk + 1 < NBLK) RW_LOAD(blk + 1);
            RW_BAR();
        }
        RW_BAR();
#undef RW_LOAD
#undef RW_ST8
    } else {
        const int rowl = C.lane >> 4, ks = C.lane & 15, row = 4 * C.wave + rowl;
        float S0 = 0.f, S1 = 0.f, S2 = 0.f, S3 = 0.f, ykeep = 0.f;
        bf16* yout = RWY + rowb * 512 + h * 64 + 16 * rq + row;
        for (int blk = 0; blk < NBLK; ++blk) {
            RW_BAR();
            const LAS unsigned char* Lb = L + (blk & 1) * BUFB;
            CLF pKK = (CLF)(Lb + O_KK) + 4 * ks; CLF pW = (CLF)(Lb + O_W) + 4 * ks; CLF pB = (CLF)(Lb + O_B) + 4 * ks; CLF pK = (CLF)(Lb + O_K) + 4 * ks; CLF pR = (CLF)(Lb + O_R) + 4 * ks; CLF pV = (CLF)(Lb + O_V) + row;
            f32x4 kk = *(const LAS f32x4*)pKK, w = *(const LAS f32x4*)pW, bb = *(const LAS f32x4*)pB, k = *(const LAS f32x4*)pK, r = *(const LAS f32x4*)pR; float vv = *pV;
#pragma unroll 4
            for (int t = 0; t < 32; ++t) {
                f32x4 nkk, nw, nb, nk, nr; float nv;
                const int tn = (t < 31) ? t + 1 : t;
                nkk = *(const LAS f32x4*)(pKK + tn * 64); nw = *(const LAS f32x4*)(pW + tn * 64); nb = *(const LAS f32x4*)(pB + tn * 64); nk = *(const LAS f32x4*)(pK + tn * 64); nr = *(const LAS f32x4*)(pR + tn * 64); nv = pV[tn * 16];
                float sa = (S0 * kk[0] + S1 * kk[1]) + (S2 * kk[2] + S3 * kk[3]);
                sa = -reduce16(sa);
                const float vk0 = vv * k[0], vk1 = vv * k[1], vk2 = vv * k[2], vk3 = vv * k[3];
                S0 = S0 * w[0] + (sa * bb[0] + vk0); S1 = S1 * w[1] + (sa * bb[1] + vk1); S2 = S2 * w[2] + (sa * bb[2] + vk2); S3 = S3 * w[3] + (sa * bb[3] + vk3);
                float y = (S0 * r[0] + S1 * r[1]) + (S2 * r[2] + S3 * r[3]);
                y = reduce16(y);
                if ((t & 15) == ks) ykeep = y;
                if ((t & 15) == 15) yout[(size_t)(blk * 32 + (t & 16) + ks) * 512] = (bf16)f2bf(ykeep);
                kk = nkk; w = nw; bb = nb; k = nk; r = nr; vv = nv;
            }
        }
        RW_BAR();
    }
}
PH_FN void ph_rw_out(const Ctx C, ArgsP a, int l) {
    const bf16* RWR = (const bf16*)(C.ws + WS_RWR); const bf16* RWK = (const bf16*)(C.ws + WS_RWK); const bf16* RWV = (const bf16*)(C.ws + WS_RWV); const bf16* RWG = (const bf16*)(C.ws + WS_RWG); const bf16* RWY = (const bf16*)(C.ws + WS_RWY);
    bf16* YS = (bf16*)(C.ws + WS_YS);
    const float* r_k = a->in[29] + (size_t)l * 512; const float* nw = a->in[30] + (size_t)l * 512; const float* nb = a->in[31] + (size_t)l * 512;
    const int gw = C.bid * NWAVES + C.wave, NGW = C.G * NWAVES;
    for (int it = gw; it < M * 8; it += NGW) {
        const size_t row = (size_t)(it >> 3); const int h = it & 7, c = h * 64 + C.lane; const size_t g = row * 512 + c;
        const float y = bf2f(RWY[g]), r = bf2f(RWR[g]), k = bf2f(RWK[g]), v = bf2f(RWV[g]), gg = bf2f(RWG[g]);
        const float mu = wave_sum(y) * (1.0f / 64.0f); const float d = y - mu; const float var = wave_sum(d * d) * (1.0f / 64.0f);
        const float yn = d * (1.0f / sqrtf(var + 64e-5f)) * nw[c] + nb[c];
        const float bonus = wave_sum(r * k * r_k[c]) * v;
        YS[row * 2048 + 1536 + c] = (bf16)f2bf((yn + bonus) * gg);
    }
}

__device__ __forceinline__ int pi_swap23(int i) { return (i & ~12) | ((i & 4) << 1) | ((i & 8) >> 1); }
__device__ __forceinline__ void da_unit(const Ctx& C, const Args& a, int l, int b, int h, int jq, float lam, float oml) {
    const bf16* P = (const bf16*)(C.ws + WS_P); const bf16* VT = (const bf16*)(C.ws + WS_VT); bf16* YS = (bf16*)(C.ws + WS_YS);
    const float* dnorm = a.in[11] + (size_t)l * 128;
    const int comp = C.wave >> 2, wq = C.wave & 3, q = C.lane & 31, hi = C.lane >> 5;
    const size_t qrow = (size_t)b * SEQ + jq * 128 + wq * 32 + q;
    pg8::bf16x8 qf[4];
#pragma unroll
    for (int d0 = 0; d0 < 4; ++d0) qf[d0] = *(const pg8::bf16x8*)(P + qrow * NPM + C_DAQ + h * 128 + comp * 64 + 16 * d0 + 8 * hi);
    const int ntile = 2 * jq + 2, my_last = 2 * jq + (wq >= 2 ? 1 : 0);
    f32x16 O[4];
#pragma unroll
    for (int db = 0; db < 4; ++db)
#pragma unroll
        for (int r = 0; r < 16; ++r) O[db][r] = 0.f;
    float mrun = -1e30f, lrun = 0.f;
    const bf16* kg = P + ((size_t)b * SEQ + (C.tid & 63)) * NPM + C_DAK + h * 128;
    const bf16* vg = VT + ((size_t)(b * 4 + h) * 128 + (C.tid & 127)) * SEQ;
    const int kc16 = C.tid >> 6, vc8 = C.tid >> 7;
    u32x4 kr[2], vr[2];
#pragma unroll
    for (int i = 0; i < 2; ++i) { kr[i] = *(const u32x4*)(kg + (kc16 + 8 * i) * 8); vr[i] = *(const u32x4*)(vg + (vc8 + 4 * i) * 8); }
    const int pq = pi_swap23(q);
    for (int tile = 0; tile < ntile; ++tile) {
        LAS unsigned char* buf = C.lds + (tile & 1) * 32768;
#pragma unroll
        for (int i = 0; i < 2; ++i) { const int c16 = kc16 + 8 * i; *(LAS u32x4*)(buf + (c16 >> 3) * 8192 + (c16 & 7) * 1024 + (C.tid & 63) * 16) = kr[i];
            *(LAS u32x4*)(buf + 16384 + (vc8 + 4 * i) * 2048 + (C.tid & 127) * 16) = vr[i]; }
        WG_SYNC();
        if (tile + 1 < ntile) {
#pragma unroll
            for (int i = 0; i < 2; ++i) { kr[i] = *(const u32x4*)(kg + (size_t)(tile + 1) * 64 * NPM + (kc16 + 8 * i) * 8); vr[i] = *(const u32x4*)(vg + (tile + 1) * 64 + (vc8 + 4 * i) * 8); } }
        if (tile <= my_last) {
            const LAS unsigned char* kb = buf + comp * 8192; const LAS unsigned char* vb = buf + 16384;
            f32x16 p0, p1;
#pragma unroll
            for (int r = 0; r < 16; ++r) { p0[r] = 0.f; p1[r] = 0.f; }
#pragma unroll
            for (int d0 = 0; d0 < 4; ++d0) {
                const pg8::bf16x8 a0 = *(const LAS pg8::bf16x8*)(kb + (2 * d0 + hi) * 1024 + pq * 16);
                const pg8::bf16x8 a1 = *(const LAS pg8::bf16x8*)(kb + (2 * d0 + hi) * 1024 + (32 + pq) * 16);
                p0 = __builtin_amdgcn_mfma_f32_32x32x16_bf16(a0, qf[d0], p0, 0, 0, 0);
                p1 = __builtin_amdgcn_mfma_f32_32x32x16_bf16(a1, qf[d0], p1, 0, 0, 0);
            }
            float mx = fmaxf(p0[0], p1[0]);
#pragma unroll
            for (int r = 1; r < 16; ++r) mx = fmaxf(mx, fmaxf(p0[r], p1[r]));
            mx = fmaxf(mx, __shfl_xor(mx, 32));
            const float mnew = fmaxf(mrun, mx); const float alpha = __builtin_amdgcn_exp2f(mrun - mnew); mrun = mnew;
            float rs = 0.f;
#pragma unroll
            for (int r = 0; r < 16; ++r) { p0[r] = __builtin_amdgcn_exp2f(p0[r] - mnew); p1[r] = __builtin_amdgcn_exp2f(p1[r] - mnew); rs += p0[r] + p1[r]; }
            lrun = lrun * alpha + rs;
#pragma unroll
            for (int db = 0; db < 4; ++db)
#pragma unroll
                for (int r = 0; r < 16; ++r) O[db][r] *= alpha;
            pg8::bf16x8 pb[4];
            { u32x4 w;
              w.x = pk2(p0[0], p0[1]); w.y = pk2(p0[2], p0[3]); w.z = pk2(p0[4], p0[5]); w.w = pk2(p0[6], p0[7]); pb[0] = __builtin_bit_cast(pg8::bf16x8, w);
              w.x = pk2(p0[8], p0[9]); w.y = pk2(p0[10], p0[11]); w.z = pk2(p0[12], p0[13]); w.w = pk2(p0[14], p0[15]); pb[1] = __builtin_bit_cast(pg8::bf16x8, w);
              w.x = pk2(p1[0], p1[1]); w.y = pk2(p1[2], p1[3]); w.z = pk2(p1[4], p1[5]); w.w = pk2(p1[6], p1[7]); pb[2] = __builtin_bit_cast(pg8::bf16x8, w);
              w.x = pk2(p1[8], p1[9]); w.y = pk2(p1[10], p1[11]); w.z = pk2(p1[12], p1[13]); w.w = pk2(p1[14], p1[15]); pb[3] = __builtin_bit_cast(pg8::bf16x8, w); }
#pragma unroll
            for (int db = 0; db < 4; ++db)
#pragma unroll
                for (int s = 0; s < 4; ++s) {
                    const pg8::bf16x8 vf = *(const LAS pg8::bf16x8*)(vb + (2 * s + hi) * 2048 + (32 * db + q) * 16);
                    O[db] = __builtin_amdgcn_mfma_f32_32x32x16_bf16(vf, pb[s], O[db], 0, 0, 0);
                }
        }
    }
    const float ltot = lrun + __shfl_xor(lrun, 32); const float inv = 1.0f / ltot;
    WG_SYNC();
    LF X = (LF)C.lds + (wq * 32 + q) * 132;
    if (comp == 1) {
        const float sc = inv * lam;
#pragma unroll
        for (int db = 0; db < 4; ++db)
#pragma unroll
            for (int g4 = 0; g4 < 4; ++g4) *(LAS f32x4*)(X + 32 * db + 8 * g4 + 4 * hi) = (f32x4){O[db][4 * g4] * sc, O[db][4 * g4 + 1] * sc, O[db][4 * g4 + 2] * sc, O[db][4 * g4 + 3] * sc};
    }
    WG_SYNC();
    if (comp == 0) {
        float ss = 0.f;
#pragma unroll
        for (int db = 0; db < 4; ++db)
#pragma unroll
            for (int g4 = 0; g4 < 4; ++g4) { const f32x4 x = *(const LAS f32x4*)(X + 32 * db + 8 * g4 + 4 * hi);
#pragma unroll
                for (int e = 0; e < 4; ++e) { const float v = O[db][4 * g4 + e] * inv - x[e]; O[db][4 * g4 + e] = v; ss += v * v; } }
        ss += __shfl_xor(ss, 32);
        const float rs = oml / sqrtf(ss * (1.0f / 128.0f) + EPS);
#pragma unroll
        for (int db = 0; db < 4; ++db)
#pragma unroll
            for (int g4 = 0; g4 < 4; ++g4) { const int d = 32 * db + 8 * g4 + 4 * hi; const f32x4 gn = *(const f32x4*)(dnorm + d);
                u32x2 w; w.x = pk2(O[db][4 * g4] * rs * gn[0], O[db][4 * g4 + 1] * rs * gn[1]); w.y = pk2(O[db][4 * g4 + 2] * rs * gn[2], O[db][4 * g4 + 3] * rs * gn[3]);
                *(u32x2*)(YS + qrow * 2048 + h * 128 + d) = w; }
    }
    WG_SYNC();
}
#if RW_CHUNKED
__device__ const signed char ATT_BINS30[30][3] = {{63,4,3}, {62,5,2}, {61,6,1}, {60,7,0}, {59,8,-1}, {58,9,-1}, {57,10,-1}, {56,11,-1}, {55,12,-1}, {54,13,-1}, {53,14,-1}, {52,15,-1}, {51,16,-1}, {50,17,-1}, {49,18,-1}, {48,19,-1}, {47,20,-1}, {46,21,-1}, {45,22,-1}, {44,23,-1}, {43,24,-1}, {42,25,-1}, {41,26,-1}, {40,27,-1}, {39,28,-1}, {38,29,-1}, {37,30,-1}, {36,31,-1}, {35,32,-1}, {34,33,-1}};
__device__ __forceinline__ int att_bin_unit(int bin, int i) { return i < 3 ? (int)ATT_BINS30[bin][i] : -1; }
#else
__device__ const signed char ATT_BINS[24][12] = {{63,21,-1,-1,-1,-1,-1,-1,-1,-1,-1,-1}, {62,22,-1,-1,-1,-1,-1,-1,-1,-1,-1,-1}, {61,23,-1,-1,-1,-1,-1,-1,-1,-1,-1,-1}, {60,24,-1,-1,-1,-1,-1,-1,-1,-1,-1,-1}, {59,25,-1,-1,-1,-1,-1,-1,-1,-1,-1,-1}, {58,26,-1,-1,-1,-1,-1,-1,-1,-1,-1,-1}, {57,27,-1,-1,-1,-1,-1,-1,-1,-1,-1,-1}, {56,28,-1,-1,-1,-1,-1,-1,-1,-1,-1,-1}, {55,29,-1,-1,-1,-1,-1,-1,-1,-1,-1,-1}, {54,30,-1,-1,-1,-1,-1,-1,-1,-1,-1,-1}, {53,31,-1,-1,-1,-1,-1,-1,-1,-1,-1,-1}, {52,32,-1,-1,-1,-1,-1,-1,-1,-1,-1,-1}, {51,33,-1,-1,-1,-1,-1,-1,-1,-1,-1,-1}, {50,34,-1,-1,-1,-1,-1,-1,-1,-1,-1,-1}, {49,35,-1,-1,-1,-1,-1,-1,-1,-1,-1,-1}, {48,36,-1,-1,-1,-1,-1,-1,-1,-1,-1,-1}, {47,37,-1,-1,-1,-1,-1,-1,-1,-1,-1,-1}, {46,38,-1,-1,-1,-1,-1,-1,-1,-1,-1,-1}, {45,39,-1,-1,-1,-1,-1,-1,-1,-1,-1,-1}, {44,40,-1,-1,-1,-1,-1,-1,-1,-1,-1,-1}, {43,41,-1,-1,-1,-1,-1,-1,-1,-1,-1,-1}, {42,20,19,6,-1,-1,-1,-1,-1,-1,-1,-1}, {18,17,16,15,14,5,-1,-1,-1,-1,-1,-1}, {13,12,11,10,9,8,7,4,3,2,1,0}};
__device__ __forceinline__ int att_bin_unit(int bin, int i) { return i < 12 ? (int)ATT_BINS[bin][i] : -1; }
#endif
__device__ __forceinline__ void ph_da_attn(const Ctx& C, const Args& a, int l, int bh, int bin) {
    const float* q1 = a.in[7] + (size_t)l * 64; const float* k1 = a.in[8] + (size_t)l * 64; const float* q2 = a.in[9] + (size_t)l * 64; const float* k2 = a.in[10] + (size_t)l * 64;
    float s1 = 0.f, s2 = 0.f;
    for (int i = 0; i < 64; ++i) { s1 += q1[i] * k1[i]; s2 += q2[i] * k2[i]; }
    const float lam_init = 0.8f - 0.6f * expf(-0.3f * (float)l); const float lam = expf(s1) - expf(s2) + lam_init;
    for (int i = 0; i < 12; ++i) { const int jq = att_bin_unit(bin, i); if (jq < 0) break; da_unit(C, a, l, bh >> 2, bh & 3, jq, lam, 1.0f - lam_init); }
}

PH_FN void ph_final(const Ctx C, ArgsP a) {
    const float* ssq = (const float*)(C.ws + WS_SSQ); const float* fn = a->in[39];
    const int gw = C.bid * NWAVES + C.wave, NGW = C.G * NWAVES;
    for (int m = gw; m < M; m += NGW) { const float rs = pg8::row_rstd(ssq, m, M); f32x4* hr = (f32x4*)(C.h + (size_t)m * D) + C.lane; const f32x4* gr = (const f32x4*)fn + C.lane;
#pragma unroll
        for (int j = 0; j < 4; ++j) { const f32x4 v = hr[64 * j], g = gr[64 * j]; hr[64 * j] = v * rs * g; } }
}
#define RWC_PTRS \
    float* RWW = (float*)(C.ws + WS_RWW); const bf16* RWR = (const bf16*)(C.ws + WS_RWR); const bf16* RWK = (const bf16*)(C.ws + WS_RWK); const bf16* RWV = (const bf16*)(C.ws + WS_RWV); \
    bf16* RWKK = (bf16*)(C.ws + WS_RWKK); bf16* RWB = (bf16*)(C.ws + WS_RWB); bf16* RWY = (bf16*)(C.ws + WS_RWY); \
    LF LGs = (LF)C.lds; LB LP = (LB)C.lds; LB LPT = (LB)(C.lds + 9216); LB AT = (LB)(C.lds + 18432); LB LAK = AT; LB LP2 = AT; LB RT = (LB)(C.lds + 27648); LB BTl = (LB)(C.lds + 36864); LB MRB = BTl; LB KTl = (LB)(C.lds + 46080); LB MRK = KTl; \
    LB VT = (LB)(C.lds + 55296); LB BHT = (LB)(C.lds + 64512); LB KHT = (LB)(C.lds + 73728); LB XB0 = (LB)(C.lds + 82944); LB XB1 = (LB)(C.lds + 101376); LB LPT2 = (LB)(C.lds + 119808); LF rho = (LF)(C.lds + 129024); LF lgl = rho + 64; \
    const int t = C.tid >> 3, g8 = C.tid & 7, n = C.lane & 31, hi = C.lane >> 5; \
    (void)RWW; (void)RWR; (void)RWK; (void)RWV; (void)RWKK; (void)RWB; (void)RWY; (void)LGs; (void)LP; (void)LPT; (void)AT; (void)LAK; (void)LP2; (void)RT; (void)BTl; (void)MRB; (void)KTl; (void)MRK; (void)VT; (void)BHT; (void)KHT; (void)XB0; (void)XB1; (void)LPT2; (void)rho; (void)lgl; (void)t; (void)g8; (void)n; (void)hi;
PH_FN void rwc_stage0(const Ctx C, int bc, int h) {
    RWC_PTRS
    const size_t row0 = (size_t)bc * 64; const size_t g = (row0 + t) * 512 + h * 64 + g8 * 8;
    WG_SYNC();
    float lw[8]; { const f32x4 x0 = *(const f32x4*)(RWW + g), x1 = *(const f32x4*)(RWW + g + 4); lw[0] = x0[0]; lw[1] = x0[1]; lw[2] = x0[2]; lw[3] = x0[3]; lw[4] = x1[0]; lw[5] = x1[1]; lw[6] = x1[2]; lw[7] = x1[3]; }
#pragma unroll
    for (int i = 0; i < 8; ++i) LGs[t * 68 + g8 * 8 + i] = lw[i];
    WG_SYNC();
    { const int seg = C.tid >> 6, k = C.tid & 63; float run = 0.f;
#pragma unroll
      for (int i = 0; i < 8; ++i) { run += LGs[(8 * seg + i) * 68 + k]; LGs[(8 * seg + i) * 68 + k] = run; }
      WG_SYNC();
      float off = 0.f;
#pragma unroll
      for (int sg = 0; sg < 7; ++sg) { const float tot = LGs[(8 * sg + 7) * 68 + k]; off += (sg < seg) ? tot : 0.f; }
      WG_SYNC();
#pragma unroll
      for (int i = 0; i < 8; ++i) LGs[(8 * seg + i) * 68 + k] += off; }
    WG_SYNC();
    {   float rf[8], kf[8], kkf[8], bf[8], lg[8], rh[8], ll[8], o1[8], o2[8], o3[8], o4[8];
        unpack8(*(const u32x4*)(RWR + g), rf); unpack8(*(const u32x4*)(RWK + g), kf); unpack8(*(const u32x4*)(RWKK + g), kkf); unpack8(*(const u32x4*)(RWB + g), bf);
#pragma unroll
        for (int i = 0; i < 8; ++i) { const int k = g8 * 8 + i; lg[i] = LGs[t * 68 + k]; rh[i] = LGs[31 * 68 + k]; ll[i] = LGs[63 * 68 + k]; }
#pragma unroll
        for (int i = 0; i < 8; ++i) { const int k = g8 * 8 + i; const float lm1 = lg[i] - lw[i];
            const float ed = __expf(lg[i] - rh[i]), edi = __expf(rh[i] - lg[i]), el = __expf(ll[i] - lg[i]);
            o1[i] = -kkf[i] * __expf(lm1 - rh[i]); o2[i] = rf[i] * ed; o3[i] = bf[i] * edi; o4[i] = kf[i] * edi;
            XB0[k * 72 + t] = (bf16)f2bf(-kkf[i] * __expf(lm1));
            BHT[k * 72 + t] = (bf16)f2bf(bf[i] * el); KHT[k * 72 + t] = (bf16)f2bf(kf[i] * el); }
        *(LAS u32x4*)(AT + t * 72 + g8 * 8) = pack8(o1); *(LAS u32x4*)(RT + t * 72 + g8 * 8) = pack8(o2); *(LAS u32x4*)(BTl + t * 72 + g8 * 8) = pack8(o3); *(LAS u32x4*)(KTl + t * 72 + g8 * 8) = pack8(o4);
        const u32x4 vv = *(const u32x4*)(RWV + g); const unsigned vw[4] = {vv.x, vv.y, vv.z, vv.w};
#pragma unroll
        for (int i = 0; i < 4; ++i) { VT[(g8 * 8 + 2 * i) * 72 + t] = (bf16)(vw[i] & 0xffffu); VT[(g8 * 8 + 2 * i + 1) * 72 + t] = (bf16)(vw[i] >> 16); }
        if (t == 0) {
#pragma unroll
            for (int i = 0; i < 8; ++i) { rho[g8 * 8 + i] = rh[i]; lgl[g8 * 8 + i] = ll[i]; } }
    }
    WG_SYNC();
}
PH_FN void rwc_stage12(const Ctx C) {
    RWC_PTRS
    {   const int mt = C.wave >> 1, nt0 = 2 * (C.wave & 1);
        CLB Am = (mt < 2) ? (CLB)AT : (CLB)RT; const int m0 = 32 * (mt & 1);
        CLB Bm = (nt0 < 2) ? (CLB)BTl : (CLB)KTl;
        f32x16 c0 = zero16(), c1 = zero16();
        mma_nt<64>(c0, Am, 72, m0, Bm, 72, 0, C.lane); mma_nt<64>(c1, Am, 72, m0, Bm, 72, 32, C.lane);
        WG_SYNC();
#pragma unroll
        for (int r = 0; r < 16; ++r) { const int tt = m0 + crow(r, hi); const int j0 = n, j1 = 32 + n;
            if (mt < 2) { const bf16 x0 = (bf16)f2bf((j0 < tt) ? c0[r] : 0.f), x1 = (bf16)f2bf((j1 < tt) ? c1[r] : 0.f);
                if (nt0 < 2) { LP[tt * 72 + j0] = x0; LP[tt * 72 + j1] = x1; LPT[j0 * 72 + tt] = x0; LPT[j1 * 72 + tt] = x1; } else { LAK[tt * 72 + j0] = x0; LAK[tt * 72 + j1] = x1; } }
            else { const bf16 x0 = (bf16)f2bf((j0 <= tt) ? c0[r] : 0.f), x1 = (bf16)f2bf((j1 <= tt) ? c1[r] : 0.f);
                if (nt0 < 2) { MRB[tt * 72 + j0] = x0; MRB[tt * 72 + j1] = x1; } else { MRK[tt * 72 + j0] = x0; MRK[tt * 72 + j1] = x1; } } }
    }
    WG_SYNC();
    if (C.wave < 4) { const int vt = C.wave >> 1, tt0 = C.wave & 1; f32x16 c = zero16(); mma_nt<64>(c, VT, 72, 32 * vt, LAK, 72, 32 * tt0, C.lane);
#pragma unroll
        for (int r = 0; r < 16; ++r) XB0[(64 + 32 * vt + crow(r, hi)) * 72 + 32 * tt0 + n] = (bf16)f2bf(c[r]); }
    WG_SYNC();
}
PH_FN void rwc_solve(const Ctx C) {
    RWC_PTRS
    const int ct = C.wave >> 1, tt = C.wave & 1;
    const int sk = C.wave >> 2, st = (C.wave >> 1) & 1, sj = C.wave & 1;
#pragma unroll 1
    for (int i = 0; i < 6; ++i) {
        CLB Pc = (i & 1) ? (CLB)LP2 : (CLB)LP; CLB PTc = (i & 1) ? (CLB)LPT2 : (CLB)LPT; LB Pn = (i & 1) ? LP : LP2; LB PTn = (i & 1) ? LPT : LPT2;
        CLB Xc = (i & 1) ? (CLB)XB1 : (CLB)XB0; LB Xn = (i & 1) ? XB0 : XB1;
        { f32x16 acc;
#pragma unroll
          for (int r = 0; r < 16; ++r) acc[r] = bf2f(Xc[(32 * ct + crow(r, hi)) * 72 + 32 * tt + n]);
          mma_nt<64>(acc, Xc, 72, 32 * ct, Pc, 72, 32 * tt, C.lane);
#pragma unroll
          for (int r = 0; r < 16; ++r) Xn[(32 * ct + crow(r, hi)) * 72 + 32 * tt + n] = (bf16)f2bf(acc[r]); }
        if (i < 5) { f32x16 acc = zero16();
          if (sk == 0) mma_nt<64>(acc, Pc, 72, 32 * st, PTc, 72, 32 * sj, C.lane); else mma_nt<64>(acc, PTc, 72, 32 * st, Pc, 72, 32 * sj, C.lane);
          LB dst = (sk == 0) ? Pn : PTn;
#pragma unroll
          for (int r = 0; r < 16; ++r) dst[(32 * st + crow(r, hi)) * 72 + 32 * sj + n] = (bf16)f2bf(acc[r]); }
        WG_SYNC();
    }
}
PH_FN void rwc_stage4(const Ctx C, int bc, int h) {
    RWC_PTRS
    const size_t row0 = (size_t)bc * 64; CLB A2T = (CLB)XB0; CLB WT = (CLB)(XB0 + 64 * 72);
    {   const int kind = C.wave >> 1, mt = C.wave & 1;
        f32x16 c0 = zero16(), c1 = zero16();
        if (kind == 0) { mma_nt<64>(c0, BHT, 72, 32 * mt, A2T, 72, 0, C.lane); mma_nt<64>(c1, BHT, 72, 32 * mt, A2T, 72, 32, C.lane); }
        else if (kind == 1) { mma_nt<64>(c0, BHT, 72, 32 * mt, WT, 72, 0, C.lane); mma_nt<64>(c1, BHT, 72, 32 * mt, WT, 72, 32, C.lane); mma_nt<64>(c0, KHT, 72, 32 * mt, VT, 72, 0, C.lane); mma_nt<64>(c1, KHT, 72, 32 * mt, VT, 72, 32, C.lane); }
        else if (kind == 2) { mma_nt<64>(c0, MRB, 72, 32 * mt, A2T, 72, 0, C.lane); mma_nt<64>(c1, MRB, 72, 32 * mt, A2T, 72, 32, C.lane); }
        else { mma_nt<64>(c0, MRB, 72, 32 * mt, WT, 72, 0, C.lane); mma_nt<64>(c1, MRB, 72, 32 * mt, WT, 72, 32, C.lane); mma_nt<64>(c0, MRK, 72, 32 * mt, VT, 72, 0, C.lane); mma_nt<64>(c1, MRK, 72, 32 * mt, VT, 72, 32, C.lane); }
#pragma unroll
        for (int r = 0; r < 16; ++r) { const int m = 32 * mt + crow(r, hi); const size_t go = (row0 + m) * 512 + h * 64;
            if (kind == 0) { const float d = __expf(lgl[m]); RWB[go + n] = (bf16)f2bf(c0[r] + ((n == m) ? d : 0.f)); RWB[go + 32 + n] = (bf16)f2bf(c1[r] + ((32 + n == m) ? d : 0.f)); }
            else if (kind == 1) { RWW[go + n] = c0[r]; RWW[go + 32 + n] = c1[r]; }
            else if (kind == 2) { RWKK[go + n] = (bf16)f2bf(c0[r] + bf2f(RT[m * 72 + n]) * __expf(rho[n])); RWKK[go + 32 + n] = (bf16)f2bf(c1[r] + bf2f(RT[m * 72 + 32 + n]) * __expf(rho[32 + n])); }
            else { RWY[go + n] = (bf16)f2bf(c0[r]); RWY[go + 32 + n] = (bf16)f2bf(c1[r]); } }
    }
}
__device__ __forceinline__ void ph_rw_chunk(const Ctx& C, int bc) {
#pragma unroll 1
    for (int h = 0; h < 8; ++h) { rwc_stage0(C, bc, h); rwc_stage12(C); rwc_solve(C); rwc_stage4(C, bc, h); }
    WG_SYNC();
}
PH_FN void rw_scan_unit(const Ctx C, int chain) {
    const float* RWW = (const float*)(C.ws + WS_RWW); const bf16* RWKK = (const bf16*)(C.ws + WS_RWKK); const bf16* RWB = (const bf16*)(C.ws + WS_RWB); bf16* RWY = (bf16*)(C.ws + WS_RWY);
    const int b = chain >> 3, h = chain & 7; const size_t rowb = (size_t)b * SEQ;
    constexpr int BUFB = 45056, O_RQ = 0, O_PT = 9216, O_QT = 18432, O_Y0 = 35840;
    LAS unsigned char* L = C.lds;
    if (C.wave >= 4) {
        const int p = C.tid - 256, t = p >> 2, q4 = (p & 3) * 16;
        u32x4 Arq0, Arq1, Apt0, Apt1, Ay00, Ay01, Brq0, Brq1, Bpt0, Bpt1, By00, By01; f32x4 Aq0, Aq1, Aq2, Aq3, Bq0, Bq1, Bq2, Bq3;
#define SC_LOAD(S, c_) do { const size_t g_ = (rowb + (size_t)(c_) * 64 + t) * 512 + h * 64 + q4; \
            S##rq0 = *(const u32x4*)(RWKK + g_); S##rq1 = *(const u32x4*)(RWKK + g_ + 8); S##pt0 = *(const u32x4*)(RWB + g_); S##pt1 = *(const u32x4*)(RWB + g_ + 8); S##y00 = *(const u32x4*)(RWY + g_); S##y01 = *(const u32x4*)(RWY + g_ + 8); \
            S##q0 = *(const f32x4*)(RWW + g_); S##q1 = *(const f32x4*)(RWW + g_ + 4); S##q2 = *(const f32x4*)(RWW + g_ + 8); S##q3 = *(const f32x4*)(RWW + g_ + 12); } while (0)
#define SC_WRITE(S, Lb) do { \
            *(LAS u32x4*)((LB)((Lb) + O_RQ) + t * 72 + q4) = S##rq0; *(LAS u32x4*)((LB)((Lb) + O_RQ) + t * 72 + q4 + 8) = S##rq1; \
            *(LAS u32x4*)((LB)((Lb) + O_PT) + t * 72 + q4) = S##pt0; *(LAS u32x4*)((LB)((Lb) + O_PT) + t * 72 + q4 + 8) = S##pt1; \
            *(LAS u32x4*)((LB)((Lb) + O_Y0) + t * 72 + q4) = S##y00; *(LAS u32x4*)((LB)((Lb) + O_Y0) + t * 72 + q4 + 8) = S##y01; \
            { LF d_ = (LF)((Lb) + O_QT) + t * 68 + q4; *(LAS f32x4*)d_ = S##q0; *(LAS f32x4*)(d_ + 4) = S##q1; *(LAS f32x4*)(d_ + 8) = S##q2; *(LAS f32x4*)(d_ + 12) = S##q3; } } while (0)
        SC_LOAD(A, 0); SC_LOAD(B, 1);
        for (int c = 0; c < NCH; c += 2) {
            SC_WRITE(A, L); if (c + 2 < NCH) SC_LOAD(A, c + 2); RW_BAR();
            SC_WRITE(B, L + BUFB); if (c + 3 < NCH) SC_LOAD(B, c + 3); RW_BAR();
        }
        RW_BAR();
#undef SC_LOAD
#undef SC_WRITE
    } else {
        const int n = C.lane & 31, hi = C.lane >> 5, vh = C.wave & 1;
        f32x16 st0 = zero16(), st1 = zero16();
        for (int c = 0; c < NCH; ++c) {
            RW_BAR();
            if (C.wave < 2) {
                const LAS unsigned char* Lb = L + (c & 1) * BUFB;
                CLB RQ = (CLB)(Lb + O_RQ); CLB PT = (CLB)(Lb + O_PT); CLF QT = (CLF)(Lb + O_QT); CLB Y0 = (CLB)(Lb + O_Y0);
                pg8::bf16x8 sb[4];
                { u32x4 w;
                  w.x = pk2(st0[0], st0[1]); w.y = pk2(st0[2], st0[3]); w.z = pk2(st0[4], st0[5]); w.w = pk2(st0[6], st0[7]); sb[0] = __builtin_bit_cast(pg8::bf16x8, w);
                  w.x = pk2(st0[8], st0[9]); w.y = pk2(st0[10], st0[11]); w.z = pk2(st0[12], st0[13]); w.w = pk2(st0[14], st0[15]); sb[1] = __builtin_bit_cast(pg8::bf16x8, w);
                  w.x = pk2(st1[0], st1[1]); w.y = pk2(st1[2], st1[3]); w.z = pk2(st1[4], st1[5]); w.w = pk2(st1[6], st1[7]); sb[2] = __builtin_bit_cast(pg8::bf16x8, w);
                  w.x = pk2(st1[8], st1[9]); w.y = pk2(st1[10], st1[11]); w.z = pk2(st1[12], st1[13]); w.w = pk2(st1[14], st1[15]); sb[3] = __builtin_bit_cast(pg8::bf16x8, w); }
#define SC_AFRAG(X_, row_, s_) ({ const u32x2 lo_ = *(const LAS u32x2*)((X_) + (row_) * 72 + 16 * (s_) + 4 * hi), hi_ = *(const LAS u32x2*)((X_) + (row_) * 72 + 16 * (s_) + 8 + 4 * hi); \
                    u32x4 w_; w_.x = lo_.x; w_.y = lo_.y; w_.z = hi_.x; w_.w = hi_.y; __builtin_bit_cast(pg8::bf16x8, w_); })
#pragma unroll
                for (int tt = 0; tt < 2; ++tt) { f32x16 y;
#pragma unroll
                    for (int r = 0; r < 16; ++r) y[r] = bf2f(Y0[(32 * tt + crow(r, hi)) * 72 + 32 * vh + n]);
#pragma unroll
                    for (int s = 0; s < 4; ++s) y = __builtin_amdgcn_mfma_f32_32x32x16_bf16(SC_AFRAG(RQ, 32 * tt + n, s), sb[s], y, 0, 0, 0);
                    bf16* yo = RWY + (rowb + (size_t)c * 64 + 32 * tt) * 512 + h * 64 + 32 * vh + n;
#pragma unroll
                    for (int r = 0; r < 16; ++r) yo[(size_t)crow(r, hi) * 512] = (bf16)f2bf(y[r]); }
                f32x16 n0, n1;
#pragma unroll
                for (int r = 0; r < 16; ++r) { n0[r] = QT[crow(r, hi) * 68 + 32 * vh + n]; n1[r] = QT[(32 + crow(r, hi)) * 68 + 32 * vh + n]; }
#pragma unroll
                for (int s = 0; s < 4; ++s) { n0 = __builtin_amdgcn_mfma_f32_32x32x16_bf16(SC_AFRAG(PT, n, s), sb[s], n0, 0, 0, 0); n1 = __builtin_amdgcn_mfma_f32_32x32x16_bf16(SC_AFRAG(PT, 32 + n, s), sb[s], n1, 0, 0, 0); }
                st0 = n0; st1 = n1;
#undef SC_AFRAG
            }
        }
        RW_BAR();
    }
}
#ifndef REP_ATTN
#define REP_ATTN 1
#endif
#ifndef REP_W
#define REP_W 1
#endif
#ifndef REP_RWC
#define REP_RWC 1
#endif
#ifndef REP_MA
#define REP_MA 1
#endif
#ifndef REP_MAFULL
#define REP_MAFULL 1
#endif
#ifndef REP_SCANS
#define REP_SCANS 1
#endif
#ifndef REP_MC
#define REP_MC 1
#endif
#ifndef REP_GEMM
#define REP_GEMM 1
#endif
constexpr int NPH = 12, G_FINAL = 1 + NL * NPH, G_END = G_FINAL + 1;
template <int GRP>
__global__ void __launch_bounds__(NTHR, 2) hybrid_fwd(Args args) {
    constexpr bool ALL = (GRP < 0);
    constexpr bool EN_G1 = ALL || GRP == 0, EN_G2 = EN_G1, EN_G3 = EN_G1, EN_G7 = EN_G1, EN_G8 = EN_G1, EN_G9 = EN_G1;
    constexpr bool EN_PRO = ALL || GRP == 1, EN_W = EN_PRO, EN_FIN = EN_PRO, EN_MA1 = EN_PRO, EN_MA2 = EN_PRO, EN_MA3 = EN_PRO, EN_MA4 = EN_PRO;
    constexpr bool EN_MB1 = ALL || GRP == 2, EN_MB2 = EN_MB1;
    constexpr bool EN_MC1 = ALL || GRP == 3, EN_MC2 = EN_MC1, EN_MC3 = EN_MC1;
    extern __shared__ __attribute__((aligned(16))) unsigned char lds[];
    Ctx C; C.lds = (LAS unsigned char*)lds; C.ws = args.ws; C.h = args.out; C.tid = threadIdx.x; C.lane = C.tid & 63; C.wave = __builtin_amdgcn_readfirstlane(C.tid >> 6); C.bid = blockIdx.x; C.G = gridDim.x;
    LAS unsigned char* ldsl = (LAS unsigned char*)lds;
    const ArgsP ap = (ArgsP)__builtin_amdgcn_kernarg_segment_ptr();
    for (int u = C.tid; u < (LDS_BYTES - LDSCTL_OFF) / 4; u += NTHR) ((LAS unsigned*)(ldsl + LDSCTL_OFF))[u] = 0u;
    __syncthreads();
    volatile LAS unsigned* MISC = (volatile LAS unsigned*)(ldsl + MISC_OFF);
    gu32* ctl = (gu32*)(args.ws + WS_CTL);
    const int g_lo = args.g_lo, g_hi = args.g_hi;
    XcdBarrier bar; bar.bar = (unsigned*)(ctl + CW_BAR); bar.x = 0; bar.st = nullptr;
    if (g_hi - g_lo > 1) bar = xcd_barrier_post((unsigned*)(ctl + CW_BAR), MISC + 8);
#define IN(g) (g_lo <= (g) && (g) < g_hi)
#define SEAM(g) do { if (IN(g) && IN((g) + 1)) xcd_barrier(bar); } while (0)
    bf16* HB = (bf16*)(args.ws + WS_HB); float* SSQ = (float*)(args.ws + WS_SSQ);

    if (EN_PRO && IN(0)) ph_prologue(fresh(C), ap);
    SEAM(0);
#pragma unroll 1
    for (int l = 0; l < NL; ++l) {
        const int gb = 1 + NPH * l;
        if (EN_W && IN(gb + 0)) { for (int rep = 0; rep < REP_W; ++rep) ph_weights(fresh(C), ap, l); }
        SEAM(gb + 0);
#pragma unroll 1
        for (int f = 0; f < 2; ++f) {
            const int gu = gb + (f ? 10 : 1);
            if (EN_G1 && IN(gu)) {
                pg8::Gemm g{HB, (const bf16*)(args.ws + (f ? WS_WGU2 : WS_WGU1)), M, 2 * FF, D, D}; pg8::StaticOrder S; S.init(M, 2 * FF, C.G, C.bid);
                pg8::EpiSwiglu E{(bf16*)(args.ws + WS_ACT), FF, SSQ, M};
                pg8::gemm_phase<pg8::EpiSwiglu, pg8::StaticOrder, true, true>(ldsl, g, S, E);
            }
            SEAM(gu);
            if (EN_G2 && IN(gu + 1)) {
                pg8::Gemm g{(const bf16*)(args.ws + WS_ACT), (const bf16*)(args.ws + (f ? WS_WD2 : WS_WD1)), M, D, FF, FF}; pg8::StaticOrder S; S.init(M, D, C.G, C.bid);
                pg8::EpiResid E{C.h, HB, SSQ, M, 0.5f};
                pg8::gemm_phase<pg8::EpiResid, pg8::StaticOrder, false, true>(ldsl, g, S, E);
            }
            SEAM(gu + 1);
            if (f == 0) {
                if (EN_G3 && IN(gb + 3)) {
                    pg8::Gemm g{HB, (const bf16*)(args.ws + WS_WIN), M, NPM, D, D}; pg8::StaticOrder S; S.init(M, NPM, C.G, C.bid);
                    pg8::EpiScaleBf16 E{(bf16*)(args.ws + WS_P), NPM, SSQ, M};
                    pg8::gemm_phase<pg8::EpiScaleBf16, pg8::StaticOrder, true, true>(ldsl, g, S, E);
                }
                SEAM(gb + 3);
                if (IN(gb + 4)) { if (EN_MA1) ph_da_prep(fresh(C)); for (int rf = 0; rf < REP_MAFULL; ++rf) { for (int rep = 0; rep < REP_MA; ++rep) { if (EN_MA2) ph_gla_a(fresh(C), ap, l); if (EN_MA3) ph_ssd_a(fresh(C), ap, l); if (EN_MA4) ph_rw_prep(fresh(C), ap, l); } if (EN_MA4 && RW_CHUNKED) ph_rw_chunk(fresh(C), C.bid); } }
                SEAM(gb + 4);
                if (IN(gb + 5)) {
#if RW_CHUNKED
#define MB_SCANS() do { if (EN_MB2) { if (C.bid < 16) rw_scan_unit(fresh(C), C.bid); else { for (int p = C.bid - 16; p < 384; p += C.G - 16) { if (p < 128) gla_scan_part(fresh(C), p); else ssd_scan_part(fresh(C), p - 128); } } } } while (0)
                    MB_SCANS();
                    for (int rs = 1; rs < REP_SCANS; ++rs) {
                        xcd_barrier(bar); if (EN_MA2) ph_gla_a(fresh(C), ap, l); if (EN_MA3) ph_ssd_a(fresh(C), ap, l); if (EN_MA4) { ph_rw_prep(fresh(C), ap, l); ph_rw_chunk(fresh(C), C.bid); } xcd_barrier(bar); MB_SCANS(); }
                    if (C.bid >= 16) { const int a = C.bid - 16; for (int rep = 0; rep < REP_ATTN; ++rep) if (EN_MB1) ph_da_attn(fresh(C), args, l, a & 7, a >> 3); }
#else
                    if (C.bid < 64) { if (EN_MB2) { const int xcd = C.bid & 7, slot = C.bid >> 3; for (int rep = 0; rep < REP_RWC; ++rep) rw_unit(fresh(C), xcd * 2 + (slot >> 2), slot & 3); } }
                    else { const int a = C.bid - 64;
                        if (EN_MB2) { for (int p = a; p < 384; p += 192) { if (p < 128) gla_scan_part(fresh(C), p); else ssd_scan_part(fresh(C), p - 128); } }
                        for (int rep = 0; rep < REP_ATTN; ++rep) if (EN_MB1) ph_da_attn(fresh(C), args, l, a & 7, a >> 3); }
#endif
                }
                SEAM(gb + 5);
                if (IN(gb + 6)) { for (int rep = 0; rep < REP_MC; ++rep) { if (EN_MC1) ph_gla_c(fresh(C), ap, l); if (EN_MC2) ph_ssd_c(fresh(C), ap, l); if (EN_MC3) ph_rw_out(fresh(C), ap, l); } }
                SEAM(gb + 6);
                if (EN_G7 && IN(gb + 7)) {
                    pg8::Gemm g{HB, (const bf16*)(args.ws + WS_WIN) + (size_t)NPM * D, M, 4096, D, D}; pg8::StaticOrder S; S.init(M, 4096, C.G, C.bid);
                    pg8::EpiScaleBf16 E{(bf16*)(args.ws + WS_PG), 4096, SSQ, M};
                    pg8::gemm_phase<pg8::EpiScaleBf16, pg8::StaticOrder, true, true>(ldsl, g, S, E);
                }
                SEAM(gb + 7);
                if (EN_G8 && IN(gb + 8)) {
                    pg8::Gemm g{(const bf16*)(args.ws + WS_YS), (const bf16*)(args.ws + WS_WB), M, D, 512, 2048}; pg8::GroupedOrder S; S.init(M, D, 4, 512, C.G, C.bid);
                    pg8::EpiGateAcc E{(bf16*)(args.ws + WS_MERGED), (const bf16*)(args.ws + WS_PG), args.in[33] + (size_t)l * 4096};
                    pg8::gemm_phase<pg8::EpiGateAcc, pg8::GroupedOrder, true, true>(ldsl, g, S, E);
                }
                SEAM(gb + 8);
                if (EN_G9 && IN(gb + 9)) {
                    pg8::Gemm g{(const bf16*)(args.ws + WS_MERGED), (const bf16*)(args.ws + WS_WO), M, D, D, D}; pg8::StaticOrder S; S.init(M, D, C.G, C.bid);
                    pg8::EpiResid E{C.h, HB, SSQ, M, 1.0f};
                    pg8::gemm_phase<pg8::EpiResid, pg8::StaticOrder, false, true>(ldsl, g, S, E);
                }
                SEAM(gb + 9);
            }
        }
    }
    if (EN_FIN && IN(G_FINAL)) ph_final(fresh(C), ap);
#undef IN
#undef SEAM
}

#ifndef ONE_LAUNCH
#define ONE_LAUNCH 1
#endif
extern "C" void kernel_launch(void* const* d_in, const int* in_sizes, int n_in, void* d_out, int out_size, void* d_ws, size_t ws_size, hipStream_t stream) {
    static int grid = 0;
    if (grid == 0) {
        if (n_in != 40 || in_sizes[0] != M * D || out_size != M * D || ws_size < WS_END) { fprintf(stderr, "kernel_launch: unexpected shapes (n_in %d, in0 %d, out %d, ws %zu < %zu); nothing launched\n", n_in, n_in > 0 ? in_sizes[0] : -1, out_size, ws_size, (size_t)WS_END); grid = -1; return; }
        int dev = 0, cus = 0, per_cu = 0;
        if (hipGetDevice(&dev) != hipSuccess || hipDeviceGetAttribute(&cus, hipDeviceAttributeMultiprocessorCount, dev) != hipSuccess) { grid = -1; return; }
#if ONE_LAUNCH
        if (hipFuncSetAttribute((const void*)hybrid_fwd<-1>, hipFuncAttributeMaxDynamicSharedMemorySize, LDS_BYTES) != hipSuccess) { fprintf(stderr, "kernel_launch: hipFuncSetAttribute failed\n"); grid = -1; return; }
#else
        if (hipFuncSetAttribute((const void*)hybrid_fwd<0>, hipFuncAttributeMaxDynamicSharedMemorySize, LDS_BYTES) != hipSuccess || hipFuncSetAttribute((const void*)hybrid_fwd<1>, hipFuncAttributeMaxDynamicSharedMemorySize, LDS_BYTES) != hipSuccess ||
            hipFuncSetAttribute((const void*)hybrid_fwd<2>, hipFuncAttributeMaxDynamicSharedMemorySize, LDS_BYTES) != hipSuccess || hipFuncSetAttribute((const void*)hybrid_fwd<3>, hipFuncAttributeMaxDynamicSharedMemorySize, LDS_BYTES) != hipSuccess) { fprintf(stderr, "kernel_launch: hipFuncSetAttribute failed\n"); grid = -1; return; }
#endif
        if (hipOccupancyMaxActiveBlocksPerMultiprocessor(&per_cu, (const void*)hybrid_fwd<(ONE_LAUNCH ? -1 : 0)>, NTHR, LDS_BYTES) != hipSuccess || per_cu < 1) fprintf(stderr, "kernel_launch: occupancy query reports %d workgroups per CU\n", per_cu);
        (void)hipGetLastError();
        grid = cus;
        if (grid != 256) { fprintf(stderr, "kernel_launch: %d CUs; this kernel is laid out for 256 workgroups; nothing launched\n", grid); grid = -1; return; }
    }
    if (grid < 0) return;
    if (hipMemsetAsync((char*)d_ws + WS_CTL, 0, CTL_ZERO_BYTES, stream) != hipSuccess) return;
    Args a{};
    for (int i = 0; i < 40; ++i) a.in[i] = (const float*)d_in[i];
    a.out = (float*)d_out; a.ws = (unsigned char*)d_ws;
    for (int j = 0; j < 32; ++j) a.inv_freq[j] = (float)pow(10000.0, -(double)j / 32.0);
#if ONE_LAUNCH
    a.g_lo = 0; a.g_hi = G_END;
    hipLaunchKernelGGL(hybrid_fwd<-1>, dim3(grid), dim3(NTHR), LDS_BYTES, stream, a);
#else
    for (int g = 0; g < G_END; ++g) {
        a.g_lo = g; a.g_hi = g + 1;
        int grp = 1;
        if (g >= 1 && g < G_FINAL) { const int k = (g - 1) % NPH; grp = (k == 0 || k == 4) ? 1 : (k == 5) ? 2 : (k == 6) ? 3 : 0; }
        if (grp == 0) hipLaunchKernelGGL(hybrid_fwd<0>, dim3(grid), dim3(NTHR), LDS_BYTES, stream, a);
        else if (grp == 1) hipLaunchKernelGGL(hybrid_fwd<1>, dim3(grid), dim3(NTHR), LDS_BYTES, stream, a);
        else if (grp == 2) hipLaunchKernelGGL(hybrid_fwd<2>, dim3(grid), dim3(NTHR), LDS_BYTES, stream, a);
        else hipLaunchKernelGGL(hybrid_fwd<3>, dim3(grid), dim3(NTHR), LDS_BYTES, stream, a);
    }
#endif
}
```

```cpp
#include <hip/hip_runtime.h>
#include <cstdio>
#include <cstdint>
#include <cmath>

namespace pg8 {
#define PG8_LAS __attribute__((address_space(3)))
typedef unsigned short bf16_t;
typedef short bf16x8 __attribute__((ext_vector_type(8)));
typedef float f32x4 __attribute__((ext_vector_type(4)));
typedef unsigned u32x4 __attribute__((ext_vector_type(4)));
constexpr int BM = 256, BK = 64, HALF = 128, HTB = HALF * BK * 2  , STAGE_BYTES = 8 * HTB, NXCD = 8, WGM = 8;

__host__ __device__ __forceinline__ int lds_byte(int r, int c) { const int st = (r >> 4) * 2 + (c >> 5), rr = r & 15, cc = c & 31, ob = rr * 64 + cc * 2; return st * 1024 + (ob ^ (((ob >> 9) & 1) << 5)); }
__host__ __device__ __forceinline__ void stage_rc(int b, int& R, int& C) { const int st = b / 1024, sb = b % 1024, swz = sb ^ (((sb >> 9) & 1) << 5); R = (st >> 1) * 16 + swz / 64; C = (st & 1) * 32 + (swz % 64) / 2; }
__host__ __device__ __forceinline__ int perm32(int rho) { const int n = rho >> 4, i = rho & 15; return 8 * (i >> 2) + 4 * n + (i & 3); }

struct Unit { int pm, pn, z; };
struct Gemm { const bf16_t* A; const bf16_t* Bt; int M, N, K, lda; };

struct StaticOrder {
    int nM, nN, nwg, G, c;
    __host__ __device__ void init(int M, int N, int G_, int c_) { nM = M / BM; nN = N / BM; nwg = nM * nN; G = G_; c = c_; }
    __host__ __device__ bool next(int i, Unit& u) const {
        const long L = (long)i * G + c; if (L >= nwg) return false;
        int wgid = (int)L; { const int q = nwg / NXCD, r = nwg % NXCD, xcd = wgid % NXCD, off = wgid / NXCD; wgid = (xcd < r ? xcd * (q + 1) : r * (q + 1) + (xcd - r) * q) + off; }
        const int nig = WGM * nN, gid = wgid / nig, fm = gid * WGM, gsz = (nM - fm) < WGM ? (nM - fm) : WGM;
        u.pm = fm + ((wgid % nig) % gsz); u.pn = (wgid % nig) / gsz; u.z = 0; return true;
    }
    __device__ __forceinline__ void a_ready(const Unit&) const {}
    __device__ __forceinline__ void done(const Unit&) const {}
    __device__ __forceinline__ size_t a_off(const Unit&) const { return 0; }
    __device__ __forceinline__ int b_tile(const Unit& u) const { return u.pn; }
};
struct GroupedOrder {
    StaticOrder base; int NZ, Kbytes, tiles_per_group;
    __device__ void init(int M, int N, int NZ_, int K, int G_, int c_) { base.init(M, N, G_, c_); NZ = NZ_; Kbytes = K * 2; tiles_per_group = N / BM; }
    __device__ bool next(int i, Unit& u) const { const int r = i / NZ, z = i - r * NZ; if (!base.next(r, u)) return false; u.z = z; return true; }
    __device__ __forceinline__ void a_ready(const Unit&) const {}
    __device__ __forceinline__ void done(const Unit&) const {}
    __device__ __forceinline__ size_t a_off(const Unit& u) const { return (size_t)u.z * Kbytes; }
    __device__ __forceinline__ int b_tile(const Unit& u) const { return u.z * tiles_per_group + u.pn; }
};

__device__ __forceinline__ unsigned cvt_pk_bf16(float lo, float hi) { unsigned r; asm volatile("v_cvt_pk_bf16_f32 %0, %1, %2" : "=v"(r) : "v"(lo), "v"(hi)); return r; }
__device__ __forceinline__ float bf_lo(unsigned w) { return __uint_as_float(w << 16); }
__device__ __forceinline__ float bf_hi(unsigned w) { return __uint_as_float(w & 0xffff0000u); }
__device__ __forceinline__ float fast_sigmoid(float x) { return __builtin_amdgcn_rcpf(1.0f + __builtin_amdgcn_exp2f(-1.4426950408889634f * x)); }

__device__ __forceinline__ float row_rstd(const float* ssq, int row, int M_) {
    const float s = (ssq[row] + ssq[M_ + row]) + (ssq[2 * M_ + row] + ssq[3 * M_ + row]);
    return 1.0f / sqrtf(s * (1.0f / 1024.0f) + 1e-6f);
}
struct EpiScaleBf16 {
    static constexpr bool PERM = true, AFTER_DRAIN = false;
    bf16_t* O; int ldc; const float* ssq; int M_;
    __device__ __forceinline__ void operator()(const f32x4 (&acc)[2][2][4][2], const Unit& u, int wr, int wc, int fr, int fq) const {
        const int row0 = u.pm * BM + wr * 64 + fr; const int col0 = u.pn * BM + wc * 32 + 8 * fq;
#pragma unroll
        for (int ai = 0; ai < 2; ++ai)
#pragma unroll
            for (int m = 0; m < 4; ++m) { const int row = row0 + ai * HALF + m * 16; const float rs = row_rstd(ssq, row, M_); bf16_t* rowp = O + (size_t)row * ldc + col0;
#pragma unroll
                for (int bj = 0; bj < 2; ++bj) { const f32x4 v0 = acc[ai][bj][m][0] * rs, v1 = acc[ai][bj][m][1] * rs;
                    u32x4 w; w.x = cvt_pk_bf16(v0[0], v0[1]); w.y = cvt_pk_bf16(v0[2], v0[3]); w.z = cvt_pk_bf16(v1[0], v1[1]); w.w = cvt_pk_bf16(v1[2], v1[3]);
                    *(u32x4*)(rowp + bj * HALF) = w; } }
    }
};
struct EpiSwiglu {
    static constexpr bool PERM = true, AFTER_DRAIN = false;
    bf16_t* O; int ldc; const float* ssq; int M_;
    __device__ __forceinline__ void operator()(const f32x4 (&acc)[2][2][4][2], const Unit& u, int wr, int wc, int fr, int fq) const {
        const int row0 = u.pm * BM + wr * 64 + fr; const int col0 = u.pn * HALF + wc * 32 + 8 * fq;
#pragma unroll
        for (int ai = 0; ai < 2; ++ai)
#pragma unroll
            for (int m = 0; m < 4; ++m) { const int row = row0 + ai * HALF + m * 16; const float rs = row_rstd(ssq, row, M_); bf16_t* rowp = O + (size_t)row * ldc + col0;
                float o[8];
#pragma unroll
                for (int n = 0; n < 2; ++n)
#pragma unroll
                    for (int i = 0; i < 4; ++i) { const float g = acc[ai][0][m][n][i] * rs, up = acc[ai][1][m][n][i] * rs; o[n * 4 + i] = g * fast_sigmoid(g) * up; }
                u32x4 w; w.x = cvt_pk_bf16(o[0], o[1]); w.y = cvt_pk_bf16(o[2], o[3]); w.z = cvt_pk_bf16(o[4], o[5]); w.w = cvt_pk_bf16(o[6], o[7]);
                *(u32x4*)rowp = w; }
    }
};
struct EpiGateAcc {
    static constexpr bool PERM = true, AFTER_DRAIN = false;
    bf16_t* O; const bf16_t* PG; const float* gb;
    __device__ __forceinline__ void operator()(const f32x4 (&acc)[2][2][4][2], const Unit& u, int wr, int wc, int fr, int fq) const {
        const int row0 = u.pm * BM + wr * 64 + fr; const int col0 = u.pn * BM + wc * 32 + 8 * fq; const int z = u.z;
        f32x4 gbv[2][2];
#pragma unroll
        for (int bj = 0; bj < 2; ++bj)
#pragma unroll
            for (int n = 0; n < 2; ++n) gbv[bj][n] = *(const f32x4*)(gb + z * 1024 + col0 + bj * HALF + 4 * n);
#pragma unroll
        for (int ai = 0; ai < 2; ++ai)
#pragma unroll
            for (int m = 0; m < 4; ++m) { const int row = row0 + ai * HALF + m * 16;
#pragma unroll
                for (int bj = 0; bj < 2; ++bj) {
                    const u32x4 pg = *(const u32x4*)(PG + (size_t)row * 4096 + z * 1024 + col0 + bj * HALF);
                    bf16_t* op = O + (size_t)row * 1024 + col0 + bj * HALF;
                    float o[8];
                    o[0] = fast_sigmoid(bf_lo(pg.x) + gbv[bj][0][0]) * acc[ai][bj][m][0][0]; o[1] = fast_sigmoid(bf_hi(pg.x) + gbv[bj][0][1]) * acc[ai][bj][m][0][1];
                    o[2] = fast_sigmoid(bf_lo(pg.y) + gbv[bj][0][2]) * acc[ai][bj][m][0][2]; o[3] = fast_sigmoid(bf_hi(pg.y) + gbv[bj][0][3]) * acc[ai][bj][m][0][3];
                    o[4] = fast_sigmoid(bf_lo(pg.z) + gbv[bj][1][0]) * acc[ai][bj][m][1][0]; o[5] = fast_sigmoid(bf_hi(pg.z) + gbv[bj][1][1]) * acc[ai][bj][m][1][1];
                    o[6] = fast_sigmoid(bf_lo(pg.w) + gbv[bj][1][2]) * acc[ai][bj][m][1][2]; o[7] = fast_sigmoid(bf_hi(pg.w) + gbv[bj][1][3]) * acc[ai][bj][m][1][3];
                    if (z > 0) { const u32x4 pv = *(const u32x4*)op;
                        o[0] += bf_lo(pv.x); o[1] += bf_hi(pv.x); o[2] += bf_lo(pv.y); o[3] += bf_hi(pv.y); o[4] += bf_lo(pv.z); o[5] += bf_hi(pv.z); o[6] += bf_lo(pv.w); o[7] += bf_hi(pv.w); }
                    u32x4 w; w.x = cvt_pk_bf16(o[0], o[1]); w.y = cvt_pk_bf16(o[2], o[3]); w.z = cvt_pk_bf16(o[4], o[5]); w.w = cvt_pk_bf16(o[6], o[7]);
                    *(u32x4*)op = w; } }
    }
};
struct EpiResid {
    static constexpr bool PERM = true, AFTER_DRAIN = true;
    float* H; bf16_t* HB; float* ssq; int M_; float s;
    __device__ __forceinline__ void fused(f32x4 (&acc)[2][2][4][2], const Unit& u, int wr, int wc, int fr, int fq, PG8_LAS unsigned char* lds, int wid, int lane) const {
        PG8_LAS float* P = (PG8_LAS float*)lds;
        const int row0 = u.pm * BM + wr * 64 + fr; const int col0 = u.pn * BM + wc * 32 + 8 * fq;
#pragma unroll
        for (int ai = 0; ai < 2; ++ai)
#pragma unroll
            for (int m = 0; m < 4; ++m) { const int row = row0 + ai * HALF + m * 16; float q = 0.f;
#pragma unroll
                for (int bj = 0; bj < 2; ++bj) { float* hp = H + (size_t)row * 1024 + col0 + bj * HALF;
                    const f32x4 h0 = *(const f32x4*)hp + acc[ai][bj][m][0] * s, h1 = *(const f32x4*)(hp + 4) + acc[ai][bj][m][1] * s;
                    *(f32x4*)hp = h0; *(f32x4*)(hp + 4) = h1;
                    q += (h0[0] * h0[0] + h0[1] * h0[1]) + (h0[2] * h0[2] + h0[3] * h0[3]) + (h1[0] * h1[0] + h1[1] * h1[1]) + (h1[2] * h1[2] + h1[3] * h1[3]);
                    u32x4 w; w.x = cvt_pk_bf16(h0[0], h0[1]); w.y = cvt_pk_bf16(h0[2], h0[3]); w.z = cvt_pk_bf16(h1[0], h1[1]); w.w = cvt_pk_bf16(h1[2], h1[3]);
                    *(u32x4*)(HB + (size_t)row * 1024 + col0 + bj * HALF) = w; }
                q += __shfl_xor(q, 16); q += __shfl_xor(q, 32);
                if (fq == 0) P[(ai * HALF + wr * 64 + m * 16 + fr) * 4 + wc] = q; }
        asm volatile("s_waitcnt lgkmcnt(0)" ::: "memory"); __builtin_amdgcn_s_barrier(); asm volatile("" ::: "memory");
        const int t = wid * 64 + lane;
        if (t < 256) { const float q = (P[t * 4 + 0] + P[t * 4 + 1]) + (P[t * 4 + 2] + P[t * 4 + 3]); ssq[(size_t)u.pn * M_ + u.pm * BM + t] = q; }
        asm volatile("s_waitcnt lgkmcnt(0)" ::: "memory"); __builtin_amdgcn_s_barrier(); asm volatile("" ::: "memory");
    }
};
template <class Epi, class Sched, bool ALIGN_EPI = false, bool SP2 = false>
__device__ __forceinline__ void gemm_phase(PG8_LAS unsigned char* lds, const Gemm g, const Sched& S, const Epi& E) {
    int tid_ = threadIdx.x; asm volatile("" : "+v"(tid_)); const int tid = tid_, wid = __builtin_amdgcn_readfirstlane(tid >> 6), lane = tid & 63, wr = wid >> 2, wc = wid & 3, fr = lane & 15, fq = lane >> 4;
    const int K = g.K, nt = K / BK;
    unsigned voffA[2], voffB[2];
#pragma unroll
    for (int i = 0; i < 2; ++i) { int R, C; stage_rc(tid * 16 + i * 8192, R, C); const int Rb = Epi::PERM ? ((R & ~31) + perm32(R & 31)) : R;
        voffA[i] = (unsigned)(R * g.lda + C) * 2u; voffB[i] = (unsigned)(Rb * K + C) * 2u; }
    const size_t kstep = (size_t)(BK * 2);
    const size_t hstep = (size_t)HALF * K * 2;
    const size_t tstep = 2 * hstep; const size_t hstepA = (size_t)HALF * g.lda * 2, tstepA = 2 * hstepA;
    const unsigned ldsw = (unsigned)wid * 1024u;
    const int aoff = lds_byte(wr * 64 + fr, fq * 8), boff = lds_byte(wc * 32 + fr, fq * 8);
#define PG8_SA(b, h) (((b) * 2 + (h)) * HTB)
#define PG8_SB(b, h) ((4 + (b) * 2 + (h)) * HTB)
#define PG8_STAGE(bufoff, gbase, voff) do { _Pragma("unroll") for (int _i = 0; _i < 2; ++_i) \
        __builtin_amdgcn_global_load_lds((const unsigned*)((const char*)(gbase) + (voff)[_i]), (PG8_LAS unsigned*)(lds + (bufoff) + ldsw + _i * 8192), 16, 0, 0); } while (0)
#define PG8_LDA(dst, b, h) do { _Pragma("unroll") for (int m = 0; m < 4; ++m) _Pragma("unroll") for (int k = 0; k < 2; ++k) dst[m][k] = *(const PG8_LAS bf16x8*)(lds + PG8_SA(b, h) + aoff + m * 2048 + k * 1024); } while (0)
#define PG8_LDB(dst, b, h) do { _Pragma("unroll") for (int n = 0; n < 2; ++n) _Pragma("unroll") for (int k = 0; k < 2; ++k) dst[n][k] = *(const PG8_LAS bf16x8*)(lds + PG8_SB(b, h) + boff + n * 2048 + k * 1024); } while (0)
#define PG8_MMA(ai, bj, At, Bt) do { __builtin_amdgcn_s_setprio(1); _Pragma("unroll") for (int m = 0; m < 4; ++m) _Pragma("unroll") for (int n = 0; n < 2; ++n) _Pragma("unroll") for (int k = 0; k < 2; ++k) \
        acc[ai][bj][m][n] = __builtin_amdgcn_mfma_f32_16x16x32_bf16(Bt[n][k], At[m][k], acc[ai][bj][m][n], 0, 0, 0); __builtin_amdgcn_s_setprio(0); } while (0)
#define PG8_WAIT_V(n) asm volatile("s_waitcnt vmcnt(" #n ")" ::: "memory")
#define PG8_WAIT_L(n) asm volatile("s_waitcnt lgkmcnt(" #n ")" ::: "memory")
#define PG8_BAR __builtin_amdgcn_s_barrier()
#define PG8_SCHED __builtin_amdgcn_sched_barrier(0)
    Unit cur, nxt; int ui = 0;
    if (!S.next(0, cur)) return;
    f32x4 acc[2][2][4][2];
#pragma unroll
    for (int a = 0; a < 2; ++a)
#pragma unroll
        for (int b = 0; b < 2; ++b)
#pragma unroll
            for (int m = 0; m < 4; ++m)
#pragma unroll
                for (int n = 0; n < 2; ++n) acc[a][b][m][n] = (f32x4){0.f, 0.f, 0.f, 0.f};
    bf16x8 At[4][2], B0[2][2], B1[2][2];
    const char* cA = (const char*)g.A + (size_t)cur.pm * tstepA + S.a_off(cur); const char* cB = (const char*)g.Bt + (size_t)S.b_tile(cur) * tstep;
    S.a_ready(cur);
    if constexpr (SP2) {
        PG8_STAGE(PG8_SB(0, 0), cB, voffB); PG8_STAGE(PG8_SB(0, 1), cB + hstep, voffB); PG8_STAGE(PG8_SA(0, 0), cA, voffA); PG8_STAGE(PG8_SA(0, 1), cA + hstepA, voffA);
        if (wr == 1) PG8_BAR;
        PG8_WAIT_V(2); PG8_BAR;
        PG8_STAGE(PG8_SB(1, 0), cB + kstep, voffB); PG8_STAGE(PG8_SA(1, 0), cA + kstep, voffA); PG8_STAGE(PG8_SB(1, 1), cB + hstep + kstep, voffB);
        PG8_WAIT_V(6); PG8_BAR;
    } else {
        PG8_STAGE(PG8_SB(0, 0), cB, voffB); PG8_STAGE(PG8_SA(0, 0), cA, voffA); PG8_STAGE(PG8_SB(0, 1), cB + hstep, voffB); PG8_STAGE(PG8_SA(0, 1), cA + hstepA, voffA);
        if (wr == 1) PG8_BAR;
        PG8_WAIT_V(4); PG8_BAR;
        PG8_STAGE(PG8_SB(1, 0), cB + kstep, voffB); PG8_STAGE(PG8_SA(1, 0), cA + kstep, voffA); PG8_STAGE(PG8_SB(1, 1), cB + hstep + kstep, voffB);
        PG8_WAIT_V(6); PG8_BAR;
    }
    for (;;) {
        const bool has_next = S.next(ui + 1, nxt);
        const char* nA = has_next ? (const char*)g.A + (size_t)nxt.pm * tstepA + S.a_off(nxt) : cA; const char* nB = has_next ? (const char*)g.Bt + (size_t)S.b_tile(nxt) * tstep : cB;
        for (int t = 0; t < nt; t += 2) {
            const bool last = (t == nt - 2);
            const char* a1 = cA + (size_t)(t + 1) * kstep;
            const char* a2 = last ? nA : cA + (size_t)(t + 2) * kstep; const char* b2 = last ? nB : cB + (size_t)(t + 2) * kstep;
            const char* a3 = a2 + kstep; const char* b3 = b2 + kstep;
            if (last && has_next) S.a_ready(nxt);
            if constexpr (SP2) {
            PG8_LDB(B0, 0, 0); PG8_LDB(B1, 0, 1); PG8_SCHED; PG8_LDA(At, 0, 0); PG8_STAGE(PG8_SA(1, 1), a1 + hstepA, voffA);
            PG8_WAIT_V(8); PG8_WAIT_L(0); PG8_BAR; PG8_MMA(0, 0, At, B0); PG8_MMA(0, 1, At, B1); PG8_BAR; PG8_SCHED;
            PG8_LDA(At, 0, 1); PG8_STAGE(PG8_SB(0, 0), b2, voffB); PG8_STAGE(PG8_SB(0, 1), b2 + hstep, voffB); PG8_STAGE(PG8_SA(0, 0), a2, voffA);
            PG8_WAIT_V(8); PG8_WAIT_L(0); PG8_BAR; PG8_MMA(1, 0, At, B0); PG8_MMA(1, 1, At, B1); PG8_BAR; PG8_SCHED;
            PG8_LDB(B0, 1, 0); PG8_LDB(B1, 1, 1); PG8_SCHED; PG8_LDA(At, 1, 0); PG8_STAGE(PG8_SA(0, 1), a2 + hstepA, voffA);
            PG8_WAIT_V(8); PG8_WAIT_L(0); PG8_BAR; PG8_MMA(0, 0, At, B0); PG8_MMA(0, 1, At, B1); PG8_BAR; PG8_SCHED;
            PG8_LDA(At, 1, 1); PG8_STAGE(PG8_SB(1, 0), b3, voffB); PG8_STAGE(PG8_SB(1, 1), b3 + hstep, voffB); PG8_STAGE(PG8_SA(1, 0), a3, voffA);
            PG8_WAIT_V(8); PG8_WAIT_L(0); PG8_BAR; PG8_MMA(1, 0, At, B0); PG8_MMA(1, 1, At, B1); PG8_BAR; PG8_SCHED;
            } else {
            PG8_LDB(B0, 0, 0); PG8_SCHED; PG8_LDA(At, 0, 0); PG8_STAGE(PG8_SA(1, 1), a1 + hstepA, voffA);
            PG8_WAIT_L(8); PG8_BAR; PG8_WAIT_L(0); PG8_MMA(0, 0, At, B0); PG8_BAR; PG8_SCHED;
            PG8_LDB(B1, 0, 1); PG8_STAGE(PG8_SB(0, 0), b2, voffB);
            PG8_BAR; PG8_WAIT_L(0); PG8_MMA(0, 1, At, B1); PG8_BAR;
            PG8_LDA(At, 0, 1); PG8_STAGE(PG8_SA(0, 0), a2, voffA);
            PG8_BAR; PG8_WAIT_L(0); PG8_MMA(1, 0, At, B0); PG8_BAR; PG8_SCHED;
            PG8_STAGE(PG8_SB(0, 1), b2 + hstep, voffB);
            PG8_WAIT_V(6); PG8_BAR; PG8_MMA(1, 1, At, B1); PG8_BAR;
            PG8_LDB(B0, 1, 0); PG8_SCHED; PG8_LDA(At, 1, 0); PG8_STAGE(PG8_SA(0, 1), a2 + hstepA, voffA);
            PG8_WAIT_L(8); PG8_BAR; PG8_WAIT_L(0); PG8_MMA(0, 0, At, B0); PG8_BAR; PG8_SCHED;
            PG8_LDB(B1, 1, 1); PG8_STAGE(PG8_SB(1, 0), b3, voffB);
            PG8_BAR; PG8_WAIT_L(0); PG8_MMA(0, 1, At, B1); PG8_BAR;
            PG8_LDA(At, 1, 1); PG8_STAGE(PG8_SA(1, 0), a3, voffA);
            PG8_BAR; PG8_WAIT_L(0); PG8_MMA(1, 0, At, B0); PG8_BAR; PG8_SCHED;
            PG8_STAGE(PG8_SB(1, 1), b3 + hstep, voffB);
            PG8_WAIT_V(6); PG8_BAR; PG8_MMA(1, 1, At, B1); PG8_BAR;
            }
        }
        if constexpr (ALIGN_EPI) { if (wr == 0) PG8_BAR; }
        if constexpr (!Epi::AFTER_DRAIN) { E(acc, cur, wr, wc, fr, fq); S.done(cur); }
        if (!has_next) break;
#pragma unroll
        for (int a = 0; a < 2; ++a)
#pragma unroll
            for (int b = 0; b < 2; ++b)
#pragma unroll
                for (int m = 0; m < 4; ++m)
#pragma unroll
                    for (int n = 0; n < 2; ++n) acc[a][b][m][n] = (f32x4){0.f, 0.f, 0.f, 0.f};
        cur = nxt; cA = nA; cB = nB; ++ui;
        if constexpr (ALIGN_EPI) { if (wr == 1) PG8_BAR; }
    }
    PG8_WAIT_V(0);
    if constexpr (!ALIGN_EPI) { if (wr == 0) PG8_BAR; }
    PG8_BAR;
    if constexpr (Epi::AFTER_DRAIN) { E.fused(acc, cur, wr, wc, fr, fq, lds, wid, lane); S.done(cur); }
#undef PG8_SA
#undef PG8_SB
#undef PG8_STAGE
#undef PG8_LDA
#undef PG8_LDB
#undef PG8_MMA
#undef PG8_WAIT_V
#undef PG8_WAIT_L
#undef PG8_BAR
#undef PG8_SCHED
}
}

constexpr int NWAVES = 8, NTHR = 512;
constexpr int M = 16384, SEQ = 8192, D = 1024, FF = 2816, NL = 4, NCH = 128  , NBC = 256  ;
constexpr int NPM = 6656;
constexpr int NWIN = 10752;
constexpr int C_DAQ = 0, C_DAK = 512, C_DAV = 1024, C_GQ = 1536, C_GK = 1792, C_GV = 2048, C_GOG = 2560, C_SZ = 3072, C_SX = 3584, C_SB = 4096, C_SC = 4352,
              C_RR = 4608, C_RK = 5120, C_RV = 5632, C_RWL = 6144, C_RAL = 6208, C_RGL = 6272, C_GLR = 6400, C_SDT = 6416;
constexpr float EPS = 1e-6f, LOG2E = 1.4426950408889634f;

constexpr size_t MiB = 1u << 20;
constexpr size_t WS_CTL = 0, CTL_ZERO_BYTES = 1 * MiB;
constexpr size_t WS_COS = 1 * MiB, WS_SIN = 2 * MiB, WS_SSQ = 3 * MiB, WS_GLAST = 3 * MiB + 512 * 1024, WS_SDT = 4 * MiB, WS_SACUM = 4 * MiB + 512 * 1024, WS_SCDEC = 5 * MiB, WS_RW2T = 5 * MiB + 64 * 1024;
constexpr size_t WS_WGU1 = 8 * MiB, WS_WD1 = 19 * MiB, WS_WIN = 24 * MiB + 512 * 1024, WS_WB = 45 * MiB + 512 * 1024, WS_WO = 49 * MiB + 512 * 1024, WS_WGU2 = 51 * MiB + 512 * 1024, WS_WD2 = 62 * MiB + 512 * 1024;
constexpr size_t WS_HB = 68 * MiB, WS_P = 100 * MiB, WS_PG = 100 * MiB, WS_YS = 308 * MiB, WS_R1 = 372 * MiB, WS_R2 = 500 * MiB, WS_END = 644 * MiB;
constexpr size_t WS_ACT = WS_R1, WS_MERGED = WS_R1;
constexpr size_t WS_RWW = WS_R1, WS_RWR = WS_R1 + 32 * MiB, WS_RWK = WS_R1 + 48 * MiB, WS_RWV = WS_R1 + 64 * MiB, WS_RWKK = WS_R1 + 80 * MiB, WS_RWB = WS_R1 + 96 * MiB, WS_RWG = WS_R1 + 112 * MiB;
constexpr size_t WS_VT = WS_R2, WS_GKV = WS_R2 + 16 * MiB, WS_SST = WS_R2 + 48 * MiB, WS_RWY = WS_R2 + 112 * MiB;
static_assert(WS_WD2 + (size_t)D * FF * 2 <= WS_HB && WS_P + (size_t)M * NPM * 2 <= WS_YS && WS_RWY + (size_t)M * 512 * 2 <= WS_END, "d_ws map");
constexpr int CW_BAR = 4096;

constexpr int RING_BYTES = 131072, LDSCTL_OFF = RING_BYTES, MISC_OFF = LDSCTL_OFF + 320, LDS_BYTES = 147456;

#define GAS __attribute__((address_space(1)))
#define LAS __attribute__((address_space(3)))
typedef unsigned short bf16;
typedef unsigned v4u __attribute__((ext_vector_type(4)));
typedef float f32x4 __attribute__((ext_vector_type(4)));
typedef short bf16x8 __attribute__((ext_vector_type(8)));
typedef GAS unsigned gu32;
typedef GAS unsigned long long gu64;
#define RLX_AGENT __ATOMIC_RELAXED, __HIP_MEMORY_SCOPE_AGENT
#define LDS_WAIT() asm volatile("s_waitcnt lgkmcnt(0)" ::: "memory")
#define VM_WAIT() asm volatile("s_waitcnt vmcnt(0)" ::: "memory")
__device__ __forceinline__ unsigned long long rt() { return __builtin_amdgcn_s_memrealtime(); }
typedef float f32x2_cv __attribute__((ext_vector_type(2))); typedef __bf16 bf16x2_cv __attribute__((ext_vector_type(2)));
__device__ __forceinline__ unsigned pk2(float lo, float hi) { const f32x2_cv v = {lo, hi}; const bf16x2_cv b = __builtin_convertvector(v, bf16x2_cv); return __builtin_bit_cast(unsigned, b); }
__device__ __forceinline__ unsigned f2bf(float f) { return pk2(f, 0.f) & 0xffffu; }

#define XB_TMO      128
#define XB_XCNT(j)  (256  + 64 * (j))
#define XB_XSUB(j)  (1280 + 64 * (j))
#define XB_XGEN(j)  (2304 + 64 * (j))
#define XB_TOP      3328
#define XB_TOPGEN   3392
#define XCD_BAR_WORDS 3456
#define XB_SPIN_CAP (1u << 18)

__device__ __forceinline__ unsigned xb_ld(unsigned* p)              { return __hip_atomic_load(p, __ATOMIC_RELAXED, __HIP_MEMORY_SCOPE_AGENT); }
__device__ __forceinline__ unsigned xb_add(unsigned* p, unsigned v) { return __hip_atomic_fetch_add(p, v, __ATOMIC_RELAXED, __HIP_MEMORY_SCOPE_AGENT); }
__device__ __forceinline__ unsigned xb_xcc_id() { return (unsigned)__builtin_amdgcn_s_getreg((3 << 11) | 20) & 0xFu; }
#define XB_SPIN(cond, bar) do { unsigned _sp = 0; while (cond) { __builtin_amdgcn_s_sleep(1); \
    if ((++_sp & 255u) == 0u) { if (xb_ld(&(bar)[XB_TMO])) break; if (_sp > XB_SPIN_CAP) { atomicAdd(&(bar)[XB_TMO], 1u); break; } } } } while (0)

struct XcdBarrier {
    unsigned* bar; unsigned x;
    volatile LAS unsigned* st;
};

__device__ __forceinline__ XcdBarrier xcd_barrier_post(unsigned* bar, volatile LAS unsigned* st) {
    XcdBarrier b; b.bar = bar; b.x = xb_xcc_id(); b.st = st;
    if (threadIdx.x == 0) (void)xb_add(&bar[XB_XCNT(b.x)], 1u);
    return b;
}
__device__ __forceinline__ void xcd_barrier_complete(unsigned* bar, unsigned x, unsigned& nloc, unsigned& nx) {
    const unsigned G = gridDim.x * gridDim.y * gridDim.z;
    unsigned sum, cnt, mine, sp = 0u;
    for (;;) {
        sum = 0u; cnt = 0u; mine = 0u;
#pragma unroll
        for (unsigned j = 0; j < 16; ++j) { const unsigned c = xb_ld(&bar[XB_XCNT(j)]); sum += c; cnt += (c > 0u) ? 1u : 0u; mine = (j == x) ? c : mine; }
        if (sum == G) break;
        __builtin_amdgcn_s_sleep(1);
        if ((++sp & 255u) == 0u) { if (xb_ld(&bar[XB_TMO])) break; if (sp > XB_SPIN_CAP) { atomicAdd(&bar[XB_TMO], 1u); break; } }
    }
    nloc = mine > 0u ? mine : 1u; nx = cnt > 0u ? cnt : 1u;
}

__device__ __forceinline__ void xcd_barrier(const XcdBarrier& b) {
    asm volatile("s_waitcnt vmcnt(0)" ::: "memory");
    __syncthreads();
    if (threadIdx.x == 0) {
        unsigned* bar = b.bar;
        __builtin_amdgcn_s_waitcnt(0);
        unsigned nloc = b.st[0], nx = b.st[1];
        if (nloc == 0u) { xcd_barrier_complete(bar, b.x, nloc, nx); b.st[0] = nloc; b.st[1] = nx; }
        const unsigned old = xb_add(&bar[XB_XSUB(b.x)], 1u);
        const unsigned gen = old / nloc;
        if (old + 1u == (gen + 1u) * nloc) {
            __builtin_amdgcn_fence(__ATOMIC_RELEASE, "agent");
            asm volatile("s_waitcnt vmcnt(0)" ::: "memory");
            const unsigned og = xb_add(&bar[XB_TOP], 1u);
            const unsigned tg = og / nx;
            if (og + 1u == (tg + 1u) * nx) xb_add(&bar[XB_TOPGEN], 1u);
            else XB_SPIN(xb_ld(&bar[XB_TOPGEN]) == tg, bar);
            __builtin_amdgcn_fence(__ATOMIC_ACQUIRE, "agent");
            xb_add(&bar[XB_XGEN(b.x)], 1u);
            asm volatile("s_waitcnt vmcnt(0)" ::: "memory");
        } else {
            XB_SPIN(xb_ld(&bar[XB_XGEN(b.x)]) == gen, bar);
            __builtin_amdgcn_fence(__ATOMIC_ACQUIRE, "agent");
            asm volatile("s_waitcnt vmcnt(0)" ::: "memory");
        }
    }
    __syncthreads();
}

struct Args { const float* in[40]; float* out; unsigned char* ws; float inv_freq[32]; int g_lo, g_hi; };
typedef const __attribute__((address_space(4))) Args* ArgsP;
typedef LAS float* LF; typedef const LAS float* CLF;
#ifndef PH_FN
#define PH_FN __device__ __noinline__
#endif
#ifndef PH_HEAVY
#define PH_HEAVY __device__ __forceinline__
#endif
struct Ctx {
    LAS unsigned char* lds;
    unsigned char* ws; float* h;
    int tid, lane, wave, bid, G;
};
typedef unsigned u32x4 __attribute__((ext_vector_type(4)));
typedef unsigned u32x2 __attribute__((ext_vector_type(2)));
typedef float f32x2 __attribute__((ext_vector_type(2)));
typedef float f32x16 __attribute__((ext_vector_type(16)));
__device__ __forceinline__ float bf2f(bf16 x) { return __uint_as_float((unsigned)x << 16); }
__device__ __forceinline__ float bflo(unsigned w) { return __uint_as_float(w << 16); }
__device__ __forceinline__ float bfhi(unsigned w) { return __uint_as_float(w & 0xffff0000u); }
__device__ __forceinline__ void unpack8(const u32x4 w, float* o) { o[0] = bflo(w.x); o[1] = bfhi(w.x); o[2] = bflo(w.y); o[3] = bfhi(w.y); o[4] = bflo(w.z); o[5] = bfhi(w.z); o[6] = bflo(w.w); o[7] = bfhi(w.w); }
__device__ __forceinline__ u32x4 pack8(const float* o) { u32x4 w; w.x = pk2(o[0], o[1]); w.y = pk2(o[2], o[3]); w.z = pk2(o[4], o[5]); w.w = pk2(o[6], o[7]); return w; }
__device__ __forceinline__ float sigmoidf_(float x) { return 1.0f / (1.0f + __expf(-x)); }
__device__ __forceinline__ float siluf_(float x) { return x * sigmoidf_(x); }
__device__ __forceinline__ float softplusf_(float x) { return fmaxf(x, 0.f) + log1pf(__expf(-fabsf(x))); }
__device__ __forceinline__ float logsigmoidf_(float x) { return fminf(x, 0.f) - log1pf(__expf(-fabsf(x))); }
__device__ __forceinline__ float wave_sum(float v) {
#pragma unroll
    for (int o = 1; o < 64; o <<= 1) v += __shfl_xor(v, o);
    return v;
}
#define WG_SYNC() __syncthreads()
__device__ __forceinline__ Ctx fresh(const Ctx& C0) { Ctx C = C0; int t = threadIdx.x; asm volatile("" : "+v"(t)); C.tid = t; C.lane = t & 63; C.wave = __builtin_amdgcn_readfirstlane(t >> 6); return C; }

PH_FN void ph_prologue(const Ctx C, ArgsP a) {
    float* cosT = (float*)(C.ws + WS_COS); float* sinT = (float*)(C.ws + WS_SIN);
    for (int idx = C.bid * NTHR + C.tid; idx < SEQ * 32; idx += C.G * NTHR) {
        const int t = idx >> 5, j = idx & 31;
        const float ang = (float)t * a->inv_freq[j];
        const double rev = (double)ang * 0.15915494309189535;
        const float fr = (float)(rev - floor(rev));
        cosT[idx] = __builtin_amdgcn_cosf(fr); sinT[idx] = __builtin_amdgcn_sinf(fr);
    }
    const float* x = a->in[0]; bf16* hb = (bf16*)(C.ws + WS_HB); float* ssq = (float*)(C.ws + WS_SSQ);
    const int gw = C.bid * NWAVES + C.wave, NGW = C.G * NWAVES;
    for (int m = gw; m < M; m += NGW) {
        const f32x4* xr = (const f32x4*)(x + (size_t)m * D) + C.lane; f32x4* hr = (f32x4*)(C.h + (size_t)m * D) + C.lane;
        unsigned long long* o8 = (unsigned long long*)(hb + (size_t)m * D) + C.lane;
        float s = 0.f;
#pragma unroll
        for (int j = 0; j < 4; ++j) { const f32x4 v = xr[64 * j]; hr[64 * j] = v; s += (v.x * v.x + v.y * v.y) + (v.z * v.z + v.w * v.w);
            o8[64 * j] = (unsigned long long)pk2(v.x, v.y) | ((unsigned long long)pk2(v.z, v.w) << 32); }
        s = wave_sum(s);
        if (C.lane == 0) { ssq[m] = s; ssq[M + m] = 0.f; ssq[2 * M + m] = 0.f; ssq[3 * M + m] = 0.f; }
    }
}

template <class SrcF>
__device__ __forceinline__ void tr_item(const SrcF src, const float* gk, bf16* WT, int K, int kb, int nb, LAS bf16* scr, int lane) {
    const int k0 = 64 * kb, n0 = 64 * nb, kr = lane >> 4, n4 = 4 * (lane & 15);
    const int ld = src.ld(); const long co = src.col(n0 + n4); const bool ok = co >= 0; const float* colp = src.base(n0 + n4) + (ok ? co : 0);
    f32x4 v[16];
#pragma unroll
    for (int i = 0; i < 16; ++i) v[i] = ok ? *(const f32x4*)(colp + (size_t)(k0 + 4 * i + kr) * ld) : (f32x4){0.f, 0.f, 0.f, 0.f};
#pragma unroll
    for (int i = 0; i < 16; ++i) { const int kk = 4 * i + kr; const float g = gk ? gk[k0 + kk] : 1.0f;
#pragma unroll
        for (int e = 0; e < 4; ++e) scr[(n4 + e) * 72 + kk] = (bf16)f2bf(v[i][e] * g); }
    LDS_WAIT(); asm volatile("" ::: "memory");
    const int c = lane & 7;
#pragma unroll
    for (int j = 0; j < 8; ++j) { const int n = (lane >> 3) + 8 * j; *(v4u*)(WT + (size_t)(n0 + n) * K + k0 + 8 * c) = *(const LAS v4u*)(scr + n * 72 + 8 * c); }
    LDS_WAIT(); asm volatile("" ::: "memory");
}
struct SrcGU { const float* wg; const float* wu;
    __device__ __forceinline__ int ld() const { return FF; }
    __device__ __forceinline__ const float* base(int n) const { const uintptr_t sel = (uintptr_t)((n >> 7) & 1); return (const float*)((uintptr_t)wg + sel * ((uintptr_t)wu - (uintptr_t)wg)); }
    __device__ __forceinline__ long col(int n) const { return 128 * (n >> 8) + (n & 127); } };
struct SrcPlain { const float* w; int ldw;
    __device__ __forceinline__ int ld() const { return ldw; }
    __device__ __forceinline__ const float* base(int) const { return w; }
    __device__ __forceinline__ long col(int n) const { return n; } };
struct SrcWin { const float* w;
    __device__ __forceinline__ int ld() const { return 10520; }
    __device__ __forceinline__ const float* base(int) const { return w; }
    __device__ __forceinline__ long col(int n) const {
        int c;
        if (n < 3072) c = n; else if (n < 4608) c = n - 3072 + 3088; else if (n < 6400) c = n - 4608 + 4632; else if (n < 6416) c = n - 6400 + 3072; else if (n < 6424) c = n - 6416 + 4624; else if (n < 6656) c = -1; else c = n - 6656 + 6424;
        return c; } };
PH_FN void ph_weights(const Ctx C, ArgsP a, int l) {
    LAS bf16* scr = (LAS bf16*)(C.lds + C.wave * 16384);
    const int gw = C.bid * NWAVES + C.wave, NGW = C.G * NWAVES; int rot = 0;
#define W_FIRST(cnt) ({ const int f_ = (gw + NGW - rot % NGW) % NGW; rot += (cnt); f_; })
#pragma unroll 1
    for (int f = 0; f < 2; ++f) {
        const float* nrm = a->in[f ? 35 : 1] + (size_t)l * D; const float* wg = a->in[f ? 36 : 2] + (size_t)l * D * FF; const float* wu = a->in[f ? 37 : 3] + (size_t)l * D * FF; const float* wd = a->in[f ? 38 : 4] + (size_t)l * FF * D;
        bf16* Wgu = (bf16*)(C.ws + (f ? WS_WGU2 : WS_WGU1)); bf16* Wd = (bf16*)(C.ws + (f ? WS_WD2 : WS_WD1));
        const SrcGU sgu{wg, wu};
        for (int it = W_FIRST((D / 64) * (2 * FF / 64)); it < (D / 64) * (2 * FF / 64); it += NGW) tr_item(sgu, nrm, Wgu, D, it / (2 * FF / 64), it % (2 * FF / 64), scr, C.lane);
        const SrcPlain sd{wd, D};
        for (int it = W_FIRST((FF / 64) * (D / 64)); it < (FF / 64) * (D / 64); it += NGW) tr_item(sd, nullptr, Wd, FF, it / (D / 64), it % (D / 64), scr, C.lane);
    }
    { const SrcWin sw{a->in[6] + (size_t)l * D * 10520}; const float* nrm = a->in[5] + (size_t)l * D; bf16* Win = (bf16*)(C.ws + WS_WIN);
      for (int it = W_FIRST((D / 64) * (NWIN / 64)); it < (D / 64) * (NWIN / 64); it += NGW) tr_item(sw, nrm, Win, D, it / (NWIN / 64), it % (NWIN / 64), scr, C.lane); }
    { bf16* Wb = (bf16*)(C.ws + WS_WB);
      for (int it = W_FIRST(4 * (512 / 64) * (D / 64)); it < 4 * (512 / 64) * (D / 64); it += NGW) { const int z = it / ((512 / 64) * (D / 64)), r = it % ((512 / 64) * (D / 64));
          const SrcPlain sb{a->in[32] + ((size_t)l * 4 + z) * 512 * D, D}; tr_item(sb, nullptr, Wb + (size_t)z * D * 512, 512, r / (D / 64), r % (D / 64), scr, C.lane); } }
    { bf16* W2T = (bf16*)(C.ws + WS_RW2T); bf16* A2T = W2T + 512 * 64; bf16* G2T = A2T + 512 * 64;
      const SrcPlain s1{a->in[23] + (size_t)l * 64 * 512, 512}, s2{a->in[25] + (size_t)l * 64 * 512, 512}, s3{a->in[26] + (size_t)l * 128 * 512, 512};
      for (int it = W_FIRST(8); it < 8; it += NGW) tr_item(s1, nullptr, W2T, 64, 0, it, scr, C.lane);
      for (int it = W_FIRST(8); it < 8; it += NGW) tr_item(s2, nullptr, A2T, 64, 0, it, scr, C.lane);
      for (int it = W_FIRST(16); it < 16; it += NGW) tr_item(s3, nullptr, G2T, 128, it >> 3, it & 7, scr, C.lane); }
    { const SrcPlain so{a->in[34] + (size_t)l * D * D, D}; bf16* Wo = (bf16*)(C.ws + WS_WO);
      for (int it = W_FIRST((D / 64) * (D / 64)); it < (D / 64) * (D / 64); it += NGW) tr_item(so, nullptr, Wo, D, it / (D / 64), it % (D / 64), scr, C.lane); }
}

#undef W_FIRST
PH_FN void ph_da_prep(const Ctx C) {
    bf16* P = (bf16*)(C.ws + WS_P); const float* cosT = (const float*)(C.ws + WS_COS); const float* sinT = (const float*)(C.ws + WS_SIN);
    const int gw = C.bid * NWAVES + C.wave, NGW = C.G * NWAVES;
    const int hc = C.lane >> 2, ch = C.lane & 3;
    const float sc = (hc < 8) ? 0.125f * LOG2E : 1.0f;
    for (int m = gw; m < M; m += NGW) {
        const int t = m & (SEQ - 1);
        bf16* p1 = P + (size_t)m * NPM + hc * 64 + ch * 8; bf16* p2 = p1 + 32;
        float x1[8], x2[8], o1[8], o2[8];
        unpack8(*(const u32x4*)p1, x1); unpack8(*(const u32x4*)p2, x2);
        const float* cp = cosT + t * 32 + ch * 8; const float* sp = sinT + t * 32 + ch * 8;
#pragma unroll
        for (int i = 0; i < 8; ++i) { const float c = cp[i], s = sp[i]; o1[i] = (x1[i] * c - x2[i] * s) * sc; o2[i] = (x2[i] * c + x1[i] * s) * sc; }
        *(u32x4*)p1 = pack8(o1); *(u32x4*)p2 = pack8(o2);
    }
    bf16* VT = (bf16*)(C.ws + WS_VT); LAS bf16* tile = (LAS bf16*)C.lds;
    for (int it = C.bid; it < 2 * NCH * 4; it += C.G) {
        const int h = it & 3, bc = it >> 2, b = bc >> 7, tb = bc & 127; const size_t row0 = (size_t)bc * 64;
        WG_SYNC();
#pragma unroll
        for (int i = 0; i < 2; ++i) { const int q = C.tid + NTHR * i, t = q >> 4, c16 = q & 15;
            *(LAS u32x4*)(tile + t * 136 + c16 * 8) = *(const u32x4*)(P + (row0 + t) * NPM + C_DAV + h * 128 + c16 * 8); }
        WG_SYNC();
#pragma unroll
        for (int i = 0; i < 2; ++i) { const int q = C.tid + NTHR * i, d = q >> 3, tc = q & 7; unsigned w[4];
#pragma unroll
            for (int e = 0; e < 4; ++e) w[e] = (unsigned)tile[(8 * tc + 2 * e) * 136 + d] | ((unsigned)tile[(8 * tc + 2 * e + 1) * 136 + d] << 16);
            u32x4 o; o.x = w[0]; o.y = w[1]; o.z = w[2]; o.w = w[3];
            *(u32x4*)(VT + ((size_t)(b * 4 + h) * 128 + d) * SEQ + tb * 64 + 8 * tc) = o; }
    }
    WG_SYNC();
}

typedef LAS bf16* LB; typedef const LAS bf16* CLB;
__device__ __forceinline__ pg8::bf16x8 frag32(CLB X, int ld, int row0, int k0, int lane) { return *(const LAS pg8::bf16x8*)(X + (row0 + (lane & 31)) * ld + k0 + 8 * (lane >> 5)); }
template <int K> __device__ __forceinline__ void mma_nt(f32x16& acc, CLB A, int lda, int m0, CLB Bt, int ldb, int n0, int lane) {
#pragma unroll
    for (int k = 0; k < K; k += 16) acc = __builtin_amdgcn_mfma_f32_32x32x16_bf16(frag32(A, lda, m0, k, lane), frag32(Bt, ldb, n0, k, lane), acc, 0, 0, 0);
}
__device__ __forceinline__ int crow(int r, int hi) { return (r & 3) + 8 * (r >> 2) + 4 * hi; }
__device__ __forceinline__ f32x16 zero16() { f32x16 z;
#pragma unroll
    for (int r = 0; r < 16; ++r) z[r] = 0.f;
    return z; }

__device__ __forceinline__ void gla_compute_G(const Ctx& C, ArgsP a, int l, int bc, int h, LF Gs) {
    const bf16* P = (const bf16*)(C.ws + WS_P); const float* W2 = a->in[12] + (size_t)l * 16 * 256; const float* gb = a->in[13] + (size_t)l * 256;
    const int t = C.tid >> 3, kg = C.tid & 7; const size_t row = (size_t)bc * 64 + t;
    float glr[16]; unpack8(*(const u32x4*)(P + row * NPM + C_GLR), glr); unpack8(*(const u32x4*)(P + row * NPM + C_GLR + 8), glr + 8);
#pragma unroll
    for (int i = 0; i < 8; ++i) { const int k = h * 64 + kg * 8 + i; float x = gb[k];
#pragma unroll
        for (int r = 0; r < 16; ++r) x += glr[r] * W2[r * 256 + k];
        Gs[t * 68 + kg * 8 + i] = logsigmoidf_(x) * (1.0f / 16.0f); }
    WG_SYNC();
    { const int seg = C.tid >> 6, k = C.tid & 63; float run = 0.f;
#pragma unroll
      for (int i = 0; i < 8; ++i) { run += Gs[(8 * seg + i) * 68 + k]; Gs[(8 * seg + i) * 68 + k] = run; }
      WG_SYNC();
      float off = 0.f;
#pragma unroll
      for (int sg = 0; sg < 7; ++sg) { const float tot = Gs[(8 * sg + 7) * 68 + k]; off += (sg < seg) ? tot : 0.f; }
      WG_SYNC();
#pragma unroll
      for (int i = 0; i < 8; ++i) Gs[(8 * seg + i) * 68 + k] += off; }
    WG_SYNC();
}
PH_HEAVY void ph_gla_a(const Ctx C, ArgsP a, int l) {
    const bf16* P = (const bf16*)(C.ws + WS_P); float* GKV = (float*)(C.ws + WS_GKV); float* GL = (float*)(C.ws + WS_GLAST);
    LF Gs = (LF)C.lds; LB KDT = (LB)(C.lds + 17408); LB VT = (LB)(C.lds + 26624);
    for (int it = C.bid; it < NBC * 4; it += C.G) {
        const int bc = it >> 2, h = it & 3;
        WG_SYNC();
        gla_compute_G(C, a, l, bc, h, Gs);
        { const int t = C.tid >> 3, g8 = C.tid & 7; const size_t row = (size_t)bc * 64 + t;
          float kf[8]; unpack8(*(const u32x4*)(P + row * NPM + C_GK + h * 64 + g8 * 8), kf);
#pragma unroll
          for (int i = 0; i < 8; ++i) { const int k = g8 * 8 + i; KDT[k * 72 + t] = (bf16)f2bf(kf[i] * __expf(Gs[63 * 68 + k] - Gs[t * 68 + k])); }
          const u32x4 v0 = *(const u32x4*)(P + row * NPM + C_GV + h * 128 + g8 * 16), v1 = *(const u32x4*)(P + row * NPM + C_GV + h * 128 + g8 * 16 + 8);
          const unsigned vw[8] = {v0.x, v0.y, v0.z, v0.w, v1.x, v1.y, v1.z, v1.w};
#pragma unroll
          for (int i = 0; i < 8; ++i) { VT[(g8 * 16 + 2 * i) * 72 + t] = (bf16)(vw[i] & 0xffffu); VT[(g8 * 16 + 2 * i + 1) * 72 + t] = (bf16)(vw[i] >> 16); }
          if (C.tid < 64) GL[(size_t)it * 64 + C.tid] = Gs[63 * 68 + C.tid]; }
        WG_SYNC();
        { const int kt = C.wave >> 2, vt = C.wave & 3, n = C.lane & 31, hi = C.lane >> 5;
          f32x16 acc = zero16(); mma_nt<64>(acc, KDT, 72, 32 * kt, VT, 72, 32 * vt, C.lane);
          float* dst = GKV + ((size_t)it * 128 + 32 * vt + n) * 64 + 32 * kt + 4 * hi;
#pragma unroll
          for (int g = 0; g < 4; ++g) *(f32x4*)(dst + 8 * g) = (f32x4){acc[4 * g], acc[4 * g + 1], acc[4 * g + 2], acc[4 * g + 3]}; }
    }
    WG_SYNC();
}
PH_FN void gla_scan_part(const Ctx C, int part) {
    float* GKV = (float*)(C.ws + WS_GKV); const float* GL = (const float*)(C.ws + WS_GLAST);
    const int e = part * NTHR + C.tid, chain = e >> 13, idx = e & 8191, b = chain >> 2, h = chain & 3, k = idx & 63;
    float st = 0.f;
#pragma unroll 1
    for (int c0 = 0; c0 < NCH; c0 += 16) {
        float tmp[16], dec[16];
#pragma unroll
        for (int i = 0; i < 16; ++i) { const size_t item = (size_t)(b * NCH + c0 + i) * 4 + h; tmp[i] = GKV[item * 8192 + idx]; dec[i] = GL[item * 64 + k]; }
#pragma unroll
        for (int i = 0; i < 16; ++i) { const size_t item = (size_t)(b * NCH + c0 + i) * 4 + h; GKV[item * 8192 + idx] = st; st = __expf(dec[i]) * st + tmp[i]; }
    }
}
PH_HEAVY void ph_gla_c(const Ctx C, ArgsP a, int l) {
    const bf16* P = (const bf16*)(C.ws + WS_P); const float* GKV = (const float*)(C.ws + WS_GKV); bf16* YS = (bf16*)(C.ws + WS_YS);
    const float* gnorm = a->in[14] + (size_t)l * 128;
    LF Gs = (LF)C.lds; LB QD = (LB)(C.lds + 17408); LB KDR = (LB)(C.lds + 26624); LB QI = (LB)(C.lds + 35840); LB ATT = (LB)(C.lds + 45056); LB VT = (LB)(C.lds + 54272); LB ST = (LB)(C.lds + 72704); LF PS = (LF)(C.lds + 91136);
    for (int it = C.bid; it < NBC * 4; it += C.G) {
        const int bc = it >> 2, h = it & 3;
        WG_SYNC();
        gla_compute_G(C, a, l, bc, h, Gs);
        { const int t = C.tid >> 3, g8 = C.tid & 7; const size_t row = (size_t)bc * 64 + t;
          float qf[8], kf[8], o1[8], o2[8], o3[8];
          unpack8(*(const u32x4*)(P + row * NPM + C_GQ + h * 64 + g8 * 8), qf); unpack8(*(const u32x4*)(P + row * NPM + C_GK + h * 64 + g8 * 8), kf);
#pragma unroll
          for (int i = 0; i < 8; ++i) { const int k = g8 * 8 + i; const float g = Gs[t * 68 + k], d = g - Gs[32 * 68 + k]; o1[i] = qf[i] * 0.125f * __expf(d); o2[i] = kf[i] * __expf(-d); o3[i] = qf[i] * 0.125f * __expf(g); }
          *(LAS u32x4*)(QD + t * 72 + g8 * 8) = pack8(o1); *(LAS u32x4*)(KDR + t * 72 + g8 * 8) = pack8(o2); *(LAS u32x4*)(QI + t * 72 + g8 * 8) = pack8(o3);
          const u32x4 v0 = *(const u32x4*)(P + row * NPM + C_GV + h * 128 + g8 * 16), v1 = *(const u32x4*)(P + row * NPM + C_GV + h * 128 + g8 * 16 + 8);
          const unsigned vw[8] = {v0.x, v0.y, v0.z, v0.w, v1.x, v1.y, v1.z, v1.w};
#pragma unroll
          for (int i = 0; i < 8; ++i) { VT[(g8 * 16 + 2 * i) * 72 + t] = (bf16)(vw[i] & 0xffffu); VT[(g8 * 16 + 2 * i + 1) * 72 + t] = (bf16)(vw[i] >> 16); }
          const int v = C.tid >> 2, kq = (C.tid & 3) * 16; const float* sp = GKV + ((size_t)it * 128 + v) * 64 + kq;
          float s[16];
#pragma unroll
          for (int i = 0; i < 4; ++i) { const f32x4 x = *(const f32x4*)(sp + 4 * i); s[4 * i] = x[0]; s[4 * i + 1] = x[1]; s[4 * i + 2] = x[2]; s[4 * i + 3] = x[3]; }
          *(LAS u32x4*)(ST + v * 72 + kq) = pack8(s); *(LAS u32x4*)(ST + v * 72 + kq + 8) = pack8(s + 8); }
        WG_SYNC();
        const int n = C.lane & 31, hi = C.lane >> 5;
        if (C.wave < 4) {
            const int it_ = C.wave >> 1, jt = C.wave & 1;
            f32x16 acc = zero16();
            if (jt <= it_) mma_nt<64>(acc, QD, 72, 32 * it_, KDR, 72, 32 * jt, C.lane);
#pragma unroll
            for (int r = 0; r < 16; ++r) { const int i = 32 * it_ + crow(r, hi), j = 32 * jt + n; ATT[i * 72 + j] = (bf16)f2bf(j <= i ? acc[r] : 0.f); }
        }
        WG_SYNC();
        {
            const int it_ = C.wave & 1, vt = C.wave >> 1;
            f32x16 acc = zero16();
            mma_nt<64>(acc, VT, 72, 32 * vt, ATT, 72, 32 * it_, C.lane);
            mma_nt<64>(acc, ST, 72, 32 * vt, QI, 72, 32 * it_, C.lane);
            float ss = 0.f;
#pragma unroll
            for (int r = 0; r < 16; ++r) ss += acc[r] * acc[r];
            ss += __shfl_xor(ss, 32);
            if (hi == 0) PS[(32 * it_ + n) * 4 + vt] = ss;
            WG_SYNC();
            const int i = 32 * it_ + n; const float tot = (PS[i * 4] + PS[i * 4 + 1]) + (PS[i * 4 + 2] + PS[i * 4 + 3]);
            const float rs = 1.0f / sqrtf(tot * (1.0f / 128.0f) + EPS); const size_t row = (size_t)bc * 64 + i;
#pragma unroll
            for (int g = 0; g < 4; ++g) { const int v0 = 32 * vt + 8 * g + 4 * hi;
                const u32x2 ogw = *(const u32x2*)(P + row * NPM + C_GOG + h * 128 + v0); const f32x4 gn = *(const f32x4*)(gnorm + v0);
                const float og[4] = {bflo(ogw.x), bfhi(ogw.x), bflo(ogw.y), bfhi(ogw.y)}; float o4[4];
#pragma unroll
                for (int y = 0; y < 4; ++y) o4[y] = acc[4 * g + y] * rs * gn[y] * siluf_(og[y]);
                u32x2 w; w.x = pk2(o4[0], o4[1]); w.y = pk2(o4[2], o4[3]); *(u32x2*)(YS + row * 2048 + 512 + h * 128 + v0) = w; }
        }
    }
    WG_SYNC();
}

__device__ __forceinline__ void ssd_conv8(const bf16* P, const float* cw, const float* cb, int bc, int t, int ch0, float* o) {
    const int pos = (bc & 127) * 64 + t; const size_t row = (size_t)bc * 64 + t;
#pragma unroll
    for (int i = 0; i < 8; ++i) o[i] = cb[ch0 + i];
#pragma unroll
    for (int tap = 0; tap < 4; ++tap) { if (pos - 3 + tap >= 0) { float x[8]; unpack8(*(const u32x4*)(P + (row - 3 + tap) * NPM + C_SX + ch0), x);
#pragma unroll
        for (int i = 0; i < 8; ++i) o[i] += cw[tap * 1024 + ch0 + i] * x[i]; } }
#pragma unroll
    for (int i = 0; i < 8; ++i) o[i] = siluf_(o[i]);
}
PH_HEAVY void ph_ssd_a(const Ctx C, ArgsP a, int l) {
    const bf16* P = (const bf16*)(C.ws + WS_P); float* SST = (float*)(C.ws + WS_SST); float* SDT = (float*)(C.ws + WS_SDT); float* SAC = (float*)(C.ws + WS_SACUM); float* SCD = (float*)(C.ws + WS_SCDEC);
    const float* cw = a->in[15] + (size_t)l * 4 * 1024; const float* cb = a->in[16] + (size_t)l * 1024; const float* dtb = a->in[17] + (size_t)l * 8; const float* alog = a->in[18] + (size_t)l * 8;
    LB BT = (LB)C.lds; LB XDT = (LB)(C.lds + 18432); LF dtv = (LF)(C.lds + 27648); LF acu = (LF)(C.lds + 27904); LF av = (LF)(C.lds + 28160);
    for (int it = C.bid; it < NBC * 2; it += C.G) {
        const int bc = it >> 1, g = it & 1; const int t = C.tid >> 3, cg = C.tid & 7;
        WG_SYNC();
        { float o[8];
#pragma unroll
          for (int half = 0; half < 2; ++half) { ssd_conv8(P, cw, cb, bc, t, 512 + g * 128 + cg * 16 + half * 8, o);
#pragma unroll
              for (int i = 0; i < 8; ++i) BT[(cg * 16 + half * 8 + i) * 72 + t] = (bf16)f2bf(o[i]); } }
#pragma unroll 1
        for (int hh = 0; hh < 4; ++hh) {
            const int hd = 4 * g + hh; const size_t item8 = (size_t)bc * 8 + hd;
            WG_SYNC();
            if (C.tid < 64) { const size_t row = (size_t)bc * 64 + C.tid; const float dt = softplusf_(bf2f(P[row * NPM + C_SDT + hd]) + dtb[hd]); dtv[C.tid] = dt; av[C.tid] = -__expf(alog[hd]) * dt; }
            WG_SYNC();
            if (C.tid < 64) { float s = av[C.tid];
#pragma unroll
                for (int o = 1; o < 64; o <<= 1) { const float nb_ = __shfl_up(s, o); if (C.lane >= o) s += nb_; }
                acu[C.tid] = s; const size_t row = (size_t)bc * 64 + C.tid; SDT[row * 8 + hd] = dtv[C.tid]; SAC[row * 8 + hd] = s; if (C.tid == 63) SCD[item8] = __expf(s); }
            WG_SYNC();
            { float o[8]; ssd_conv8(P, cw, cb, bc, t, hd * 64 + cg * 8, o); const float sc = dtv[t] * __expf(acu[63] - acu[t]);
#pragma unroll
              for (int i = 0; i < 8; ++i) XDT[(cg * 8 + i) * 72 + t] = (bf16)f2bf(o[i] * sc); }
            WG_SYNC();
            { const int pt = C.wave >> 2, nt = C.wave & 3, n = C.lane & 31, hi = C.lane >> 5;
              f32x16 acc = zero16(); mma_nt<64>(acc, XDT, 72, 32 * pt, BT, 72, 32 * nt, C.lane);
#pragma unroll
              for (int r = 0; r < 16; ++r) SST[(item8 * 64 + 32 * pt + crow(r, hi)) * 128 + 32 * nt + n] = acc[r]; }
        }
    }
    WG_SYNC();
}
PH_FN void ssd_scan_part(const Ctx C, int part) {
    float* SST = (float*)(C.ws + WS_SST); const float* SCD = (const float*)(C.ws + WS_SCDEC);
    const int e = part * NTHR + C.tid, chain = e >> 13, idx = e & 8191, b = chain >> 3, hd = chain & 7;
    float st = 0.f;
#pragma unroll 1
    for (int c0 = 0; c0 < NCH; c0 += 16) {
        float tmp[16], dec[16];
#pragma unroll
        for (int i = 0; i < 16; ++i) { const size_t item = (size_t)(b * NCH + c0 + i) * 8 + hd; tmp[i] = SST[item * 8192 + idx]; dec[i] = SCD[item]; }
#pragma unroll
        for (int i = 0; i < 16; ++i) { const size_t item = (size_t)(b * NCH + c0 + i) * 8 + hd; SST[item * 8192 + idx] = st; st = dec[i] * st + tmp[i]; }
    }
}
PH_HEAVY void ph_ssd_c(const Ctx C, ArgsP a, int l) {
    const bf16* P = (const bf16*)(C.ws + WS_P); const float* SST = (const float*)(C.ws + WS_SST); const float* SDT = (const float*)(C.ws + WS_SDT); const float* SAC = (const float*)(C.ws + WS_SACUM); bf16* YS = (bf16*)(C.ws + WS_YS);
    const float* cw = a->in[15] + (size_t)l * 4 * 1024; const float* cb = a->in[16] + (size_t)l * 1024; const float* dpar = a->in[19] + (size_t)l * 8; const float* snorm = a->in[20] + (size_t)l * 512;
    LB BN = (LB)C.lds; LB CN = (LB)(C.lds + 17408); LF CB = (LF)(C.lds + 34816); LB SC = (LB)(C.lds + 52224); LB XST = (LB)(C.lds + 61440); LB HP = (LB)(C.lds + 70656); LB CE = (LB)(C.lds + 88064);
    LF dtv = (LF)(C.lds + 105472); LF acu = (LF)(C.lds + 105728); LF PSQ = (LF)(C.lds + 105984);
    for (int it = C.bid; it < NBC * 2; it += C.G) {
        const int bc = it >> 1, g = it & 1;
        const int t = C.tid >> 3, cg = C.tid & 7, n = C.lane & 31, hi = C.lane >> 5;
        WG_SYNC();
        { float o[8];
#pragma unroll
          for (int half = 0; half < 2; ++half) {
              ssd_conv8(P, cw, cb, bc, t, 512 + g * 128 + cg * 16 + half * 8, o); *(LAS u32x4*)(BN + t * 136 + cg * 16 + half * 8) = pack8(o);
              ssd_conv8(P, cw, cb, bc, t, 768 + g * 128 + cg * 16 + half * 8, o); *(LAS u32x4*)(CN + t * 136 + cg * 16 + half * 8) = pack8(o); } }
        WG_SYNC();
        if (C.wave < 4) {
            const int it_ = C.wave >> 1, jt = C.wave & 1;
            f32x16 acc = zero16(); mma_nt<128>(acc, CN, 136, 32 * it_, BN, 136, 32 * jt, C.lane);
#pragma unroll
            for (int r = 0; r < 16; ++r) CB[(32 * it_ + crow(r, hi)) * 68 + 32 * jt + n] = acc[r];
        }
        float yk[4][16]; float ssq = 0.f;
        const int pt = (C.wave >> 1) & 1, it2 = C.wave & 1;
#pragma unroll
        for (int hh = 0; hh < 4; ++hh) {
            const int hd = 4 * g + hh; const size_t item8 = (size_t)bc * 8 + hd;
            WG_SYNC();
            if (C.tid < 64) { const size_t row = (size_t)bc * 64 + C.tid; dtv[C.tid] = SDT[row * 8 + hd]; acu[C.tid] = SAC[row * 8 + hd]; }
            { float o[8]; ssd_conv8(P, cw, cb, bc, t, hd * 64 + cg * 8, o);
#pragma unroll
              for (int i = 0; i < 8; ++i) XST[(cg * 8 + i) * 72 + t] = (bf16)f2bf(o[i]);
              const int p = C.tid >> 3, n0 = (C.tid & 7) * 16; const float* sp = SST + (item8 * 64 + p) * 128 + n0; float s[16];
#pragma unroll
              for (int i = 0; i < 4; ++i) { const f32x4 x = *(const f32x4*)(sp + 4 * i); s[4 * i] = x[0]; s[4 * i + 1] = x[1]; s[4 * i + 2] = x[2]; s[4 * i + 3] = x[3]; }
              *(LAS u32x4*)(HP + p * 136 + n0) = pack8(s); *(LAS u32x4*)(HP + p * 136 + n0 + 8) = pack8(s + 8); }
            WG_SYNC();
            { const float ai = acu[t]; float o[8];
#pragma unroll
              for (int jj = 0; jj < 8; ++jj) { const int j = 8 * cg + jj; o[jj] = (j <= t) ? CB[t * 68 + j] * __expf(ai - acu[j]) * dtv[j] : 0.f; }
              *(LAS u32x4*)(SC + t * 72 + 8 * cg) = pack8(o);
              const float ea = __expf(ai); float c8[8];
#pragma unroll
              for (int half = 0; half < 2; ++half) { unpack8(*(const LAS u32x4*)(CN + t * 136 + cg * 16 + half * 8), c8);
#pragma unroll
                  for (int i = 0; i < 8; ++i) c8[i] *= ea;
                  *(LAS u32x4*)(CE + t * 136 + cg * 16 + half * 8) = pack8(c8); } }
            WG_SYNC();
            if (C.wave < 4) {
                f32x16 acc = zero16();
                mma_nt<64>(acc, XST, 72, 32 * pt, SC, 72, 32 * it2, C.lane);
                mma_nt<128>(acc, HP, 136, 32 * pt, CE, 136, 32 * it2, C.lane);
                const int i = 32 * it2 + n; const size_t row = (size_t)bc * 64 + i; const float dh = dpar[hd];
#pragma unroll
                for (int q4 = 0; q4 < 4; ++q4) { const int p0 = 32 * pt + 8 * q4 + 4 * hi;
                    const u32x2 zw = *(const u32x2*)(P + row * NPM + C_SZ + hd * 64 + p0); const float zf[4] = {bflo(zw.x), bfhi(zw.x), bflo(zw.y), bfhi(zw.y)};
#pragma unroll
                    for (int e = 0; e < 4; ++e) { const float xs = bf2f(XST[(p0 + e) * 72 + i]); const float v = (acc[4 * q4 + e] + dh * xs) * siluf_(zf[e]); yk[hh][4 * q4 + e] = v; ssq += v * v; } }
            }
        }
        if (C.wave < 4) { ssq += __shfl_xor(ssq, 32); if (hi == 0) PSQ[(32 * it2 + n) * 2 + pt] = ssq; }
        WG_SYNC();
        if (C.wave < 4) {
            const int i = 32 * it2 + n; const float rs = 1.0f / sqrtf((PSQ[i * 2] + PSQ[i * 2 + 1]) * (1.0f / 256.0f) + EPS); const size_t row = (size_t)bc * 64 + i;
#pragma unroll
            for (int hh = 0; hh < 4; ++hh)
#pragma unroll
                for (int q4 = 0; q4 < 4; ++q4) { const int ch = g * 256 + hh * 64 + 32 * pt + 8 * q4 + 4 * hi; const f32x4 sn = *(const f32x4*)(snorm + ch);
                    u32x2 w; w.x = pk2(yk[hh][4 * q4] * rs * sn[0], yk[hh][4 * q4 + 1] * rs * sn[1]); w.y = pk2(yk[hh][4 * q4 + 2] * rs * sn[2], yk[hh][4 * q4 + 3] * rs * sn[3]);
                    *(u32x2*)(YS + row * 2048 + 1024 + ch) = w; }
        }
    }
    WG_SYNC();
}

#ifndef RW_CHUNKED
#define RW_CHUNKED 1
#endif
__device__ __forceinline__ void rw_lerp8(const bf16* P, const float* mu, int bc, int t, int c0, float* o) {
    const size_t row = (size_t)bc * 64 + t; const bool first = ((bc & 127) == 0) && (t == 0);
    float x[8], xp[8]; unpack8(*(const u32x4*)(P + row * NPM + C_RR + c0), x);
    if (!first) unpack8(*(const u32x4*)(P + (row - 1) * NPM + C_RR + c0), xp); else {
#pragma unroll
        for (int i = 0; i < 8; ++i) xp[i] = 0.f; }
#pragma unroll
    for (int i = 0; i < 8; ++i) o[i] = x[i] + (xp[i] - x[i]) * mu[c0 + i];
}
__device__ __forceinline__ void rw_lerp4(const bf16* P, const float* mu, size_t row, bool first, int c0, float* o) {
    const u32x2 xw = *(const u32x2*)(P + row * NPM + C_RR + c0); const float x[4] = {bflo(xw.x), bfhi(xw.x), bflo(xw.y), bfhi(xw.y)};
    float xp[4] = {0.f, 0.f, 0.f, 0.f};
    if (!first) { const u32x2 pw = *(const u32x2*)(P + (row - 1) * NPM + C_RR + c0); xp[0] = bflo(pw.x); xp[1] = bfhi(pw.x); xp[2] = bflo(pw.y); xp[3] = bfhi(pw.y); }
    const f32x4 m = *(const f32x4*)(mu + c0);
#pragma unroll
    for (int i = 0; i < 4; ++i) o[i] = x[i] + (xp[i] - x[i]) * m[i];
}
#define RW_WFRAG(WT_, K_, nt_, s_) (*(const pg8::bf16x8*)((WT_) + (size_t)(head * 64 + 32 * (nt_) + n) * (K_) + 16 * (s_) + 8 * hi))
PH_FN void rwp_stage(const Ctx C, ArgsP a, int l, int bc) {
    const bf16* P = (const bf16*)(C.ws + WS_P);
    float* RWW = (float*)(C.ws + WS_RWW); bf16* RWR = (bf16*)(C.ws + WS_RWR); bf16* RWK = (bf16*)(C.ws + WS_RWK); bf16* RWV = (bf16*)(C.ws + WS_RWV); bf16* RWKK = (bf16*)(C.ws + WS_RWKK); bf16* RWB = (bf16*)(C.ws + WS_RWB); bf16* RWG = (bf16*)(C.ws + WS_RWG);
    const bf16* W2T = (const bf16*)(C.ws + WS_RW2T); const bf16* A2T = W2T + 512 * 64; const bf16* G2T = A2T + 512 * 64;
    const float* mu = a->in[21] + (size_t)l * 1792; const float* w0 = a->in[22] + (size_t)l * 512; const float* a0 = a->in[24] + (size_t)l * 512;
    const float* k_k = a->in[27] + (size_t)l * 512; const float* k_a = a->in[28] + (size_t)l * 512;
    LB WLb = (LB)C.lds; LB ALb = (LB)(C.lds + 9216); LB GLb = (LB)(C.lds + 18432);
    LB KX = (LB)(C.lds + 35840); LF w0s = (LF)(C.lds + 102400); LF a0s = w0s + 512; LF kks = a0s + 512; LF kas = kks + 512;
    (void)KX; (void)w0s; (void)a0s; (void)kks; (void)kas;
    (void)P; (void)RWW; (void)RWR; (void)RWK; (void)RWV; (void)RWKK; (void)RWB; (void)RWG; (void)W2T; (void)A2T; (void)G2T; (void)mu; (void)w0; (void)a0; (void)k_k; (void)k_a; (void)WLb; (void)ALb; (void)GLb;
        WG_SYNC();
        { const int t = C.tid >> 3, cg = C.tid & 7; float o[8];
          rw_lerp8(P, mu, bc, t, 1536 + cg * 8, o);
#pragma unroll
          for (int i = 0; i < 8; ++i) o[i] = tanhf(o[i]);
          *(LAS u32x4*)(WLb + t * 72 + cg * 8) = pack8(o);
          rw_lerp8(P, mu, bc, t, 1600 + cg * 8, o); *(LAS u32x4*)(ALb + t * 72 + cg * 8) = pack8(o);
#pragma unroll
          for (int half = 0; half < 2; ++half) { rw_lerp8(P, mu, bc, t, 1664 + cg * 16 + half * 8, o);
#pragma unroll
              for (int i = 0; i < 8; ++i) o[i] = sigmoidf_(o[i]);
              *(LAS u32x4*)(GLb + t * 136 + cg * 16 + half * 8) = pack8(o); }
          const size_t row = (size_t)bc * 64 + t;
#pragma unroll 2
          for (int j = 0; j < 8; ++j) { const int c = cg * 64 + j * 8;
              rw_lerp8(P, mu, bc, t, c, o); *(u32x4*)(RWR + row * 512 + c) = pack8(o);
              rw_lerp8(P, mu, bc, t, 1024 + c, o); *(u32x4*)(RWV + row * 512 + c) = pack8(o);
              rw_lerp8(P, mu, bc, t, 512 + c, o); *(LAS u32x4*)(KX + t * 520 + c) = pack8(o); }
          const int q = C.tid * 4; *(LAS f32x4*)(w0s + q) = *(const f32x4*)((q < 512 ? w0 : q < 1024 ? a0 - 512 : q < 1536 ? k_k - 1024 : k_a - 1536) + q); }
        WG_SYNC();
}
PH_FN void rwp_w(const Ctx C, ArgsP a, int l, int bc, int tt) {
    const bf16* P = (const bf16*)(C.ws + WS_P);
    float* RWW = (float*)(C.ws + WS_RWW); bf16* RWR = (bf16*)(C.ws + WS_RWR); bf16* RWK = (bf16*)(C.ws + WS_RWK); bf16* RWV = (bf16*)(C.ws + WS_RWV); bf16* RWKK = (bf16*)(C.ws + WS_RWKK); bf16* RWB = (bf16*)(C.ws + WS_RWB); bf16* RWG = (bf16*)(C.ws + WS_RWG);
    const bf16* W2T = (const bf16*)(C.ws + WS_RW2T); const bf16* A2T = W2T + 512 * 64; const bf16* G2T = A2T + 512 * 64;
    const float* mu = a->in[21] + (size_t)l * 1792; const float* w0 = a->in[22] + (size_t)l * 512; const float* a0 = a->in[24] + (size_t)l * 512;
    const float* k_k = a->in[27] + (size_t)l * 512; const float* k_a = a->in[28] + (size_t)l * 512;
    LB WLb = (LB)C.lds; LB ALb = (LB)(C.lds + 9216); LB GLb = (LB)(C.lds + 18432);
    LB KX = (LB)(C.lds + 35840); LF w0s = (LF)(C.lds + 102400); LF a0s = w0s + 512; LF kks = a0s + 512; LF kas = kks + 512;
    (void)KX; (void)w0s; (void)a0s; (void)kks; (void)kas;
    (void)P; (void)RWW; (void)RWR; (void)RWK; (void)RWV; (void)RWKK; (void)RWB; (void)RWG; (void)W2T; (void)A2T; (void)G2T; (void)mu; (void)w0; (void)a0; (void)k_k; (void)k_a; (void)WLb; (void)ALb; (void)GLb;
            const int head = C.wave, n = C.lane & 31, hi = C.lane >> 5; const int t = 32 * tt + n; const size_t row = (size_t)bc * 64 + t; const bool first = ((bc & 127) == 0) && (t == 0); (void)first; (void)row;
            { f32x16 c[2] = {zero16(), zero16()};
#pragma unroll
              for (int s4 = 0; s4 < 4; ++s4) { const pg8::bf16x8 fb = frag32(WLb, 72, 32 * tt, 16 * s4, C.lane);
#pragma unroll
                  for (int nt = 0; nt < 2; ++nt) c[nt] = __builtin_amdgcn_mfma_f32_32x32x16_bf16(RW_WFRAG(W2T, 64, nt, s4), fb, c[nt], 0, 0, 0); }
#pragma unroll
              for (int nt = 0; nt < 2; ++nt)
#pragma unroll
                  for (int g = 0; g < 4; ++g) { const int ch = head * 64 + 32 * nt + 8 * g + 4 * hi; const f32x4 w0v = *(const LAS f32x4*)(w0s + ch); f32x4 o;
#pragma unroll
                      for (int e = 0; e < 4; ++e) o[e] = -0.606531f * sigmoidf_(w0v[e] + c[nt][4 * g + e]);
                      *(f32x4*)(RWW + row * 512 + ch) = o; } }
}
PH_FN void rwp_g(const Ctx C, ArgsP a, int l, int bc, int tt) {
    const bf16* P = (const bf16*)(C.ws + WS_P);
    float* RWW = (float*)(C.ws + WS_RWW); bf16* RWR = (bf16*)(C.ws + WS_RWR); bf16* RWK = (bf16*)(C.ws + WS_RWK); bf16* RWV = (bf16*)(C.ws + WS_RWV); bf16* RWKK = (bf16*)(C.ws + WS_RWKK); bf16* RWB = (bf16*)(C.ws + WS_RWB); bf16* RWG = (bf16*)(C.ws + WS_RWG);
    const bf16* W2T = (const bf16*)(C.ws + WS_RW2T); const bf16* A2T = W2T + 512 * 64; const bf16* G2T = A2T + 512 * 64;
    const float* mu = a->in[21] + (size_t)l * 1792; const float* w0 = a->in[22] + (size_t)l * 512; const float* a0 = a->in[24] + (size_t)l * 512;
    const float* k_k = a->in[27] + (size_t)l * 512; const float* k_a = a->in[28] + (size_t)l * 512;
    LB WLb = (LB)C.lds; LB ALb = (LB)(C.lds + 9216); LB GLb = (LB)(C.lds + 18432);
    LB KX = (LB)(C.lds + 35840); LF w0s = (LF)(C.lds + 102400); LF a0s = w0s + 512; LF kks = a0s + 512; LF kas = kks + 512;
    (void)KX; (void)w0s; (void)a0s; (void)kks; (void)kas;
    (void)P; (void)RWW; (void)RWR; (void)RWK; (void)RWV; (void)RWKK; (void)RWB; (void)RWG; (void)W2T; (void)A2T; (void)G2T; (void)mu; (void)w0; (void)a0; (void)k_k; (void)k_a; (void)WLb; (void)ALb; (void)GLb;
            const int head = C.wave, n = C.lane & 31, hi = C.lane >> 5; const int t = 32 * tt + n; const size_t row = (size_t)bc * 64 + t; const bool first = ((bc & 127) == 0) && (t == 0); (void)first; (void)row;
            { f32x16 c[2] = {zero16(), zero16()};
#pragma unroll
              for (int s8 = 0; s8 < 8; ++s8) { const pg8::bf16x8 fb = frag32(GLb, 136, 32 * tt, 16 * s8, C.lane);
#pragma unroll
                  for (int nt = 0; nt < 2; ++nt) c[nt] = __builtin_amdgcn_mfma_f32_32x32x16_bf16(RW_WFRAG(G2T, 128, nt, s8), fb, c[nt], 0, 0, 0); }
#pragma unroll
              for (int nt = 0; nt < 2; ++nt)
#pragma unroll
                  for (int g = 0; g < 4; ++g) { const int ch = head * 64 + 32 * nt + 8 * g + 4 * hi;
                      u32x2 w; w.x = pk2(c[nt][4 * g], c[nt][4 * g + 1]); w.y = pk2(c[nt][4 * g + 2], c[nt][4 * g + 3]); *(u32x2*)(RWG + row * 512 + ch) = w; } }
}
PH_FN void rwp_ak(const Ctx C, ArgsP a, int l, int bc, int tt) {
    const bf16* P = (const bf16*)(C.ws + WS_P);
    float* RWW = (float*)(C.ws + WS_RWW); bf16* RWR = (bf16*)(C.ws + WS_RWR); bf16* RWK = (bf16*)(C.ws + WS_RWK); bf16* RWV = (bf16*)(C.ws + WS_RWV); bf16* RWKK = (bf16*)(C.ws + WS_RWKK); bf16* RWB = (bf16*)(C.ws + WS_RWB); bf16* RWG = (bf16*)(C.ws + WS_RWG);
    const bf16* W2T = (const bf16*)(C.ws + WS_RW2T); const bf16* A2T = W2T + 512 * 64; const bf16* G2T = A2T + 512 * 64;
    const float* mu = a->in[21] + (size_t)l * 1792; const float* w0 = a->in[22] + (size_t)l * 512; const float* a0 = a->in[24] + (size_t)l * 512;
    const float* k_k = a->in[27] + (size_t)l * 512; const float* k_a = a->in[28] + (size_t)l * 512;
    LB WLb = (LB)C.lds; LB ALb = (LB)(C.lds + 9216); LB GLb = (LB)(C.lds + 18432);
    LB KX = (LB)(C.lds + 35840); LF w0s = (LF)(C.lds + 102400); LF a0s = w0s + 512; LF kks = a0s + 512; LF kas = kks + 512;
    (void)KX; (void)w0s; (void)a0s; (void)kks; (void)kas;
    (void)P; (void)RWW; (void)RWR; (void)RWK; (void)RWV; (void)RWKK; (void)RWB; (void)RWG; (void)W2T; (void)A2T; (void)G2T; (void)mu; (void)w0; (void)a0; (void)k_k; (void)k_a; (void)WLb; (void)ALb; (void)GLb;
            const int head = C.wave, n = C.lane & 31, hi = C.lane >> 5; const int t = 32 * tt + n; const size_t row = (size_t)bc * 64 + t; const bool first = ((bc & 127) == 0) && (t == 0); (void)first; (void)row;
            { float ss = 0.f;
#pragma unroll
              for (int nt = 0; nt < 2; ++nt)
#pragma unroll
                  for (int g = 0; g < 4; ++g) { const int ch = head * 64 + 32 * nt + 8 * g + 4 * hi; const f32x4 kkv = *(const LAS f32x4*)(kks + ch); const u32x2 kw = *(const LAS u32x2*)(KX + t * 520 + ch);
                      const float o[4] = {bflo(kw.x), bfhi(kw.x), bflo(kw.y), bfhi(kw.y)};
#pragma unroll
                      for (int e = 0; e < 4; ++e) { const float q = o[e] * kkv[e]; ss += q * q; } }
              ss += __shfl_xor(ss, 32);
              const float inv = 1.0f / fmaxf(sqrtf(ss), 1e-12f);
#pragma unroll 1
              for (int nt = 0; nt < 2; ++nt) {
                  f32x16 c = zero16();
#pragma unroll
                  for (int s4 = 0; s4 < 4; ++s4) c = __builtin_amdgcn_mfma_f32_32x32x16_bf16(RW_WFRAG(A2T, 64, nt, s4), frag32(ALb, 72, 32 * tt, 16 * s4, C.lane), c, 0, 0, 0);
#pragma unroll
                  for (int g = 0; g < 4; ++g) { const int ch = head * 64 + 32 * nt + 8 * g + 4 * hi; const f32x4 a0v = *(const LAS f32x4*)(a0s + ch), kkv = *(const LAS f32x4*)(kks + ch), kav = *(const LAS f32x4*)(kas + ch);
                      const u32x2 kw = *(const LAS u32x2*)(KX + t * 520 + ch); const float o[4] = {bflo(kw.x), bfhi(kw.x), bflo(kw.y), bfhi(kw.y)};
                      float kkn[4], bb[4], kp[4];
#pragma unroll
                      for (int e = 0; e < 4; ++e) { const float al = sigmoidf_(a0v[e] + c[4 * g + e]), x = o[e]; kkn[e] = x * kkv[e] * inv; bb[e] = kkn[e] * al; kp[e] = x * (1.0f + (al - 1.0f) * kav[e]); }
                      u32x2 w; w.x = pk2(kkn[0], kkn[1]); w.y = pk2(kkn[2], kkn[3]); *(u32x2*)(RWKK + row * 512 + ch) = w;
                      w.x = pk2(bb[0], bb[1]); w.y = pk2(bb[2], bb[3]); *(u32x2*)(RWB + row * 512 + ch) = w;
                      w.x = pk2(kp[0], kp[1]); w.y = pk2(kp[2], kp[3]); *(u32x2*)(RWK + row * 512 + ch) = w; } } }
}
#undef RW_WFRAG
__device__ __forceinline__ void ph_rw_prep(const Ctx& C, ArgsP a, int l) {
    for (int bc = C.bid; bc < NBC; bc += C.G) { rwp_stage(C, a, l, bc);
#pragma unroll 1
        for (int tt = 0; tt < 2; ++tt) { rwp_w(C, a, l, bc, tt); rwp_g(C, a, l, bc, tt); rwp_ak(C, a, l, bc, tt); } }
    WG_SYNC();
}
template <int CTRL> __device__ __forceinline__ float dpp_get(float x) { return __builtin_bit_cast(float, __builtin_amdgcn_update_dpp(0, __builtin_bit_cast(int, x), CTRL, 0xf, 0xf, true)); }
__device__ __forceinline__ float reduce16(float x) { x += dpp_get<0xB1>(x); x += dpp_get<0x4E>(x); x += dpp_get<0x141>(x); x += dpp_get<0x140>(x); return x; }
#define RW_BAR() do { asm volatile("s_waitcnt lgkmcnt(0)" ::: "memory"); __builtin_amdgcn_s_barrier(); asm volatile("" ::: "memory"); } while (0)
PH_FN void rw_unit(const Ctx C, int chain, int rq) {
    const float* RWW = (const float*)(C.ws + WS_RWW); const bf16* RWR = (const bf16*)(C.ws + WS_RWR); const bf16* RWK = (const bf16*)(C.ws + WS_RWK); const bf16* RWV = (const bf16*)(C.ws + WS_RWV);
    const bf16* RWKK = (const bf16*)(C.ws + WS_RWKK); const bf16* RWB = (const bf16*)(C.ws + WS_RWB); bf16* RWY = (bf16*)(C.ws + WS_RWY);
    const int b = chain >> 3, h = chain & 7; const size_t rowb = (size_t)b * SEQ;
    constexpr int BUFB = 43008, O_KK = 0, O_W = 8192, O_B = 16384, O_K = 24576, O_R = 32768, O_V = 40960, NBLK = SEQ / 32;
    LAS unsigned char* L = C.lds;
    if (C.wave >= 4) {
        const int p = C.tid - 256, t = p >> 3, c8 = (p & 7) * 8;
        u32x4 rr, rk, rkk, rb; f32x4 w0, w1; unsigned rv;
#define RW_LOAD(blk) do { const size_t g_ = (rowb + (size_t)(blk) * 32 + t) * 512 + h * 64; \
            w0 = *(const f32x4*)(RWW + g_ + c8); w1 = *(const f32x4*)(RWW + g_ + c8 + 4); rr = *(const u32x4*)(RWR + g_ + c8); rk = *(const u32x4*)(RWK + g_ + c8); \
            rkk = *(const u32x4*)(RWKK + g_ + c8); rb = *(const u32x4*)(RWB + g_ + c8); rv = *(const unsigned*)(RWV + g_ + 16 * rq + (p & 7) * 2); } while (0)
#define RW_ST8(off, w_) do { float o_[8]; unpack8(w_, o_); LF d_ = (LF)(Lb + (off)) + t * 64 + c8; *(LAS f32x4*)d_ = (f32x4){o_[0], o_[1], o_[2], o_[3]}; *(LAS f32x4*)(d_ + 4) = (f32x4){o_[4], o_[5], o_[6], o_[7]}; } while (0)
        RW_LOAD(0);
        for (int blk = 0; blk < NBLK; ++blk) {
            LAS unsigned char* Lb = L + (blk & 1) * BUFB;
            { LF d = (LF)(Lb + O_W) + t * 64 + c8; *(LAS f32x4*)d = w0; *(LAS f32x4*)(d + 4) = w1; }
            RW_ST8(O_R, rr); RW_ST8(O_K, rk); RW_ST8(O_KK, rkk); RW_ST8(O_B, rb);
            { LF d = (LF)(Lb + O_V) + t * 16 + (p & 7) * 2; d[0] = bflo(rv); d[1] = bfhi(rv); }
            if (blk + 1 < NBLK) RW_LOAD(blk + 1);
            RW_BAR();
        }
        RW_BAR();
#undef RW_LOAD
#undef RW_ST8
    } else {
        const int rowl = C.lane >> 4, ks = C.lane & 15, row = 4 * C.wave + rowl;
        float S0 = 0.f, S1 = 0.f, S2 = 0.f, S3 = 0.f, ykeep = 0.f;
        bf16* yout = RWY + rowb * 512 + h * 64 + 16 * rq + row;
        for (int blk = 0; blk < NBLK; ++blk) {
            RW_BAR();
            const LAS unsigned char* Lb = L + (blk & 1) * BUFB;
            CLF pKK = (CLF)(Lb + O_KK) + 4 * ks; CLF pW = (CLF)(Lb + O_W) + 4 * ks; CLF pB = (CLF)(Lb + O_B) + 4 * ks; CLF pK = (CLF)(Lb + O_K) + 4 * ks; CLF pR = (CLF)(Lb + O_R) + 4 * ks; CLF pV = (CLF)(Lb + O_V) + row;
            f32x4 kk = *(const LAS f32x4*)pKK, w = *(const LAS f32x4*)pW, bb = *(const LAS f32x4*)pB, k = *(const LAS f32x4*)pK, r = *(const LAS f32x4*)pR; float vv = *pV;
#pragma unroll 4
            for (int t = 0; t < 32; ++t) {
                f32x4 nkk, nw, nb, nk, nr; float nv;
                const int tn = (t < 31) ? t + 1 : t;
                nkk = *(const LAS f32x4*)(pKK + tn * 64); nw = *(const LAS f32x4*)(pW + tn * 64); nb = *(const LAS f32x4*)(pB + tn * 64); nk = *(const LAS f32x4*)(pK + tn * 64); nr = *(const LAS f32x4*)(pR + tn * 64); nv = pV[tn * 16];
                float sa = (S0 * kk[0] + S1 * kk[1]) + (S2 * kk[2] + S3 * kk[3]);
                sa = -reduce16(sa);
                const float vk0 = vv * k[0], vk1 = vv * k[1], vk2 = vv * k[2], vk3 = vv * k[3];
                S0 = S0 * w[0] + (sa * bb[0] + vk0); S1 = S1 * w[1] + (sa * bb[1] + vk1); S2 = S2 * w[2] + (sa * bb[2] + vk2); S3 = S3 * w[3] + (sa * bb[3] + vk3);
                float y = (S0 * r[0] + S1 * r[1]) + (S2 * r[2] + S3 * r[3]);
                y = reduce16(y);
                if ((t & 15) == ks) ykeep = y;
                if ((t & 15) == 15) yout[(size_t)(blk * 32 + (t & 16) + ks) * 512] = (bf16)f2bf(ykeep);
                kk = nkk; w = nw; bb = nb; k = nk; r = nr; vv = nv;
            }
        }
        RW_BAR();
    }
}
PH_FN void ph_rw_out(const Ctx C, ArgsP a, int l) {
    const bf16* RWR = (const bf16*)(C.ws + WS_RWR); const bf16* RWK = (const bf16*)(C.ws + WS_RWK); const bf16* RWV = (const bf16*)(C.ws + WS_RWV); const bf16* RWG = (const bf16*)(C.ws + WS_RWG); const bf16* RWY = (const bf16*)(C.ws + WS_RWY);
    bf16* YS = (bf16*)(C.ws + WS_YS);
    const float* r_k = a->in[29] + (size_t)l * 512; const float* nw = a->in[30] + (size_t)l * 512; const float* nb = a->in[31] + (size_t)l * 512;
    const int gw = C.bid * NWAVES + C.wave, NGW = C.G * NWAVES, c0 = C.lane * 8;
    float rk[8], w8[8], b8[8];
#pragma unroll
    for (int i = 0; i < 8; ++i) { rk[i] = r_k[c0 + i]; w8[i] = nw[c0 + i]; b8[i] = nb[c0 + i]; }
    for (int row0 = gw * 2; row0 < M; row0 += NGW * 2) {
        u32x4 yw[2], rw[2], kw[2], vw[2], gw4[2];
#pragma unroll
        for (int u = 0; u < 2; ++u) { const size_t g = (size_t)(row0 + u) * 512 + c0; yw[u] = *(const u32x4*)(RWY + g); rw[u] = *(const u32x4*)(RWR + g); kw[u] = *(const u32x4*)(RWK + g); vw[u] = *(const u32x4*)(RWV + g); gw4[u] = *(const u32x4*)(RWG + g); }
#pragma unroll
        for (int u = 0; u < 2; ++u) { float y[8], r[8], k[8], v[8], gg[8], o[8]; unpack8(yw[u], y); unpack8(rw[u], r); unpack8(kw[u], k); unpack8(vw[u], v); unpack8(gw4[u], gg);
            float s = 0.f, bs = 0.f;
#pragma unroll
            for (int i = 0; i < 8; ++i) { s += y[i]; bs += r[i] * k[i] * rk[i]; }
            s += __shfl_xor(s, 1); s += __shfl_xor(s, 2); s += __shfl_xor(s, 4); bs += __shfl_xor(bs, 1); bs += __shfl_xor(bs, 2); bs += __shfl_xor(bs, 4);
            const float mu = s * (1.0f / 64.0f); float q = 0.f;
#pragma unroll
            for (int i = 0; i < 8; ++i) { y[i] -= mu; q += y[i] * y[i]; }
            q += __shfl_xor(q, 1); q += __shfl_xor(q, 2); q += __shfl_xor(q, 4);
            const float rs = 1.0f / sqrtf(q * (1.0f / 64.0f) + 64e-5f);
#pragma unroll
            for (int i = 0; i < 8; ++i) o[i] = (y[i] * rs * w8[i] + b8[i] + bs * v[i]) * gg[i];
            *(u32x4*)(YS + (size_t)(row0 + u) * 2048 + 1536 + c0) = pack8(o); }
    }
}

__device__ __forceinline__ int pi_swap23(int i) { return (i & ~12) | ((i & 4) << 1) | ((i & 8) >> 1); }
__device__ __forceinline__ void da_unit(const Ctx& C, const Args& a, int l, int b, int h, int jq, float lam, float oml) {
    const bf16* P = (const bf16*)(C.ws + WS_P); const bf16* VT = (const bf16*)(C.ws + WS_VT); bf16* YS = (bf16*)(C.ws + WS_YS);
    const float* dnorm = a.in[11] + (size_t)l * 128;
    const int comp = C.wave >> 2, wq = C.wave & 3, q = C.lane & 31, hi = C.lane >> 5;
    const size_t qrow = (size_t)b * SEQ + jq * 128 + wq * 32 + q;
    pg8::bf16x8 qf[4];
#pragma unroll
    for (int d0 = 0; d0 < 4; ++d0) qf[d0] = *(const pg8::bf16x8*)(P + qrow * NPM + C_DAQ + h * 128 + comp * 64 + 16 * d0 + 8 * hi);
    const int ntile = 2 * jq + 2, my_last = 2 * jq + (wq >= 2 ? 1 : 0);
    f32x16 O[4];
#pragma unroll
    for (int db = 0; db < 4; ++db)
#pragma unroll
        for (int r = 0; r < 16; ++r) O[db][r] = 0.f;
    float mrun = -1e30f, lrun = 0.f;
    const bf16* kg = P + ((size_t)b * SEQ + (C.tid & 63)) * NPM + C_DAK + h * 128;
    const bf16* vg = VT + ((size_t)(b * 4 + h) * 128 + (C.tid & 127)) * SEQ;
    const int kc16 = C.tid >> 6, vc8 = C.tid >> 7;
    u32x4 kr[2], vr[2];
#pragma unroll
    for (int i = 0; i < 2; ++i) { kr[i] = *(const u32x4*)(kg + (kc16 + 8 * i) * 8); vr[i] = *(const u32x4*)(vg + (vc8 + 4 * i) * 8); }
    const int pq = pi_swap23(q);
    pg8::bf16x8 pb[4] = {};
    int vs = 0, vsp = 0;
    for (int tile = 0; tile < ntile; ++tile) {
        LAS unsigned char* kbuf = C.lds + (tile & 1) * 16384; LAS unsigned char* vbuf = C.lds + 32768 + vs;
#pragma unroll
        for (int i = 0; i < 2; ++i) { const int c16 = kc16 + 8 * i; *(LAS u32x4*)(kbuf + (c16 >> 3) * 8192 + (c16 & 7) * 1024 + (C.tid & 63) * 16) = kr[i];
            *(LAS u32x4*)(vbuf + (vc8 + 4 * i) * 2048 + (C.tid & 127) * 16) = vr[i]; }
        WG_SYNC();
        if (tile + 1 < ntile) {
#pragma unroll
            for (int i = 0; i < 2; ++i) { kr[i] = *(const u32x4*)(kg + (size_t)(tile + 1) * 64 * NPM + (kc16 + 8 * i) * 8); vr[i] = *(const u32x4*)(vg + (tile + 1) * 64 + (vc8 + 4 * i) * 8); } }
#define DA_PV(vb_) do { _Pragma("unroll") for (int db = 0; db < 4; ++db) _Pragma("unroll") for (int s = 0; s < 4; ++s) { \
            const pg8::bf16x8 vf_ = *(const LAS pg8::bf16x8*)((vb_) + (2 * s + hi) * 2048 + (32 * db + q) * 16); O[db] = __builtin_amdgcn_mfma_f32_32x32x16_bf16(vf_, pb[s], O[db], 0, 0, 0); } } while (0)
        if (comp == 1 && tile >= 1 && tile - 1 <= my_last) { const LAS unsigned char* vprev = C.lds + 32768 + vsp; DA_PV(vprev); }
        if (tile <= my_last) {
            const LAS unsigned char* kb = kbuf + comp * 8192; const LAS unsigned char* vb = vbuf;
            f32x16 p0, p1;
#pragma unroll
            for (int r = 0; r < 16; ++r) { p0[r] = 0.f; p1[r] = 0.f; }
#pragma unroll
            for (int d0 = 0; d0 < 4; ++d0) {
                const pg8::bf16x8 a0 = *(const LAS pg8::bf16x8*)(kb + (2 * d0 + hi) * 1024 + pq * 16);
                const pg8::bf16x8 a1 = *(const LAS pg8::bf16x8*)(kb + (2 * d0 + hi) * 1024 + (32 + pq) * 16);
                p0 = __builtin_amdgcn_mfma_f32_32x32x16_bf16(a0, qf[d0], p0, 0, 0, 0);
                p1 = __builtin_amdgcn_mfma_f32_32x32x16_bf16(a1, qf[d0], p1, 0, 0, 0);
            }
            float mx = fmaxf(p0[0], p1[0]);
#pragma unroll
            for (int r = 1; r < 16; ++r) mx = fmaxf(mx, fmaxf(p0[r], p1[r]));
            mx = fmaxf(mx, __shfl_xor(mx, 32));
            if (__any(mx > mrun + 8.0f)) {
                const float mnew = fmaxf(mrun, mx); const float alpha = __builtin_amdgcn_exp2f(mrun - mnew); mrun = mnew; lrun *= alpha;
#pragma unroll
                for (int db = 0; db < 4; ++db)
#pragma unroll
                    for (int r = 0; r < 16; ++r) O[db][r] *= alpha;
            }
            float rs = 0.f;
#pragma unroll
            for (int r = 0; r < 16; ++r) { p0[r] = __builtin_amdgcn_exp2f(p0[r] - mrun); p1[r] = __builtin_amdgcn_exp2f(p1[r] - mrun); rs += p0[r] + p1[r]; }
            lrun += rs;
            { u32x4 w;
              w.x = pk2(p0[0], p0[1]); w.y = pk2(p0[2], p0[3]); w.z = pk2(p0[4], p0[5]); w.w = pk2(p0[6], p0[7]); pb[0] = __builtin_bit_cast(pg8::bf16x8, w);
              w.x = pk2(p0[8], p0[9]); w.y = pk2(p0[10], p0[11]); w.z = pk2(p0[12], p0[13]); w.w = pk2(p0[14], p0[15]); pb[1] = __builtin_bit_cast(pg8::bf16x8, w);
              w.x = pk2(p1[0], p1[1]); w.y = pk2(p1[2], p1[3]); w.z = pk2(p1[4], p1[5]); w.w = pk2(p1[6], p1[7]); pb[2] = __builtin_bit_cast(pg8::bf16x8, w);
              w.x = pk2(p1[8], p1[9]); w.y = pk2(p1[10], p1[11]); w.z = pk2(p1[12], p1[13]); w.w = pk2(p1[14], p1[15]); pb[3] = __builtin_bit_cast(pg8::bf16x8, w); }
            if (comp == 0) DA_PV(vb);
        }
        vsp = vs; vs = (vs == 32768) ? 0 : vs + 16384;
    }
    if (comp == 1 && my_last == ntile - 1) { const LAS unsigned char* vlast = C.lds + 32768 + vsp; DA_PV(vlast); }
#undef DA_PV
    const float ltot = lrun + __shfl_xor(lrun, 32); const float inv = 1.0f / ltot;
    WG_SYNC();
    LF X = (LF)C.lds + (wq * 32 + q) * 132;
    if (comp == 1) {
        const float sc = inv * lam;
#pragma unroll
        for (int db = 0; db < 4; ++db)
#pragma unroll
            for (int g4 = 0; g4 < 4; ++g4) *(LAS f32x4*)(X + 32 * db + 8 * g4 + 4 * hi) = (f32x4){O[db][4 * g4] * sc, O[db][4 * g4 + 1] * sc, O[db][4 * g4 + 2] * sc, O[db][4 * g4 + 3] * sc};
    }
    WG_SYNC();
    if (comp == 0) {
        float ss = 0.f;
#pragma unroll
        for (int db = 0; db < 4; ++db)
#pragma unroll
            for (int g4 = 0; g4 < 4; ++g4) { const f32x4 x = *(const LAS f32x4*)(X + 32 * db + 8 * g4 + 4 * hi);
#pragma unroll
                for (int e = 0; e < 4; ++e) { const float v = O[db][4 * g4 + e] * inv - x[e]; O[db][4 * g4 + e] = v; ss += v * v; } }
        ss += __shfl_xor(ss, 32);
        const float rs = oml / sqrtf(ss * (1.0f / 128.0f) + EPS);
#pragma unroll
        for (int db = 0; db < 4; ++db)
#pragma unroll
            for (int g4 = 0; g4 < 4; ++g4) { const int d = 32 * db + 8 * g4 + 4 * hi; const f32x4 gn = *(const f32x4*)(dnorm + d);
                u32x2 w; w.x = pk2(O[db][4 * g4] * rs * gn[0], O[db][4 * g4 + 1] * rs * gn[1]); w.y = pk2(O[db][4 * g4 + 2] * rs * gn[2], O[db][4 * g4 + 3] * rs * gn[3]);
                *(u32x2*)(YS + qrow * 2048 + h * 128 + d) = w; }
    }
    WG_SYNC();
}
#if RW_CHUNKED
__device__ const signed char ATT_BINS30[30][3] = {{63,4,3}, {62,5,2}, {61,6,1}, {60,7,0}, {59,8,-1}, {58,9,-1}, {57,10,-1}, {56,11,-1}, {55,12,-1}, {54,13,-1}, {53,14,-1}, {52,15,-1}, {51,16,-1}, {50,17,-1}, {49,18,-1}, {48,19,-1}, {47,20,-1}, {46,21,-1}, {45,22,-1}, {44,23,-1}, {43,24,-1}, {42,25,-1}, {41,26,-1}, {40,27,-1}, {39,28,-1}, {38,29,-1}, {37,30,-1}, {36,31,-1}, {35,32,-1}, {34,33,-1}};
__device__ __forceinline__ int att_bin_unit(int bin, int i) { return i < 3 ? (int)ATT_BINS30[bin][i] : -1; }
#else
__device__ const signed char ATT_BINS[24][12] = {{63,21,-1,-1,-1,-1,-1,-1,-1,-1,-1,-1}, {62,22,-1,-1,-1,-1,-1,-1,-1,-1,-1,-1}, {61,23,-1,-1,-1,-1,-1,-1,-1,-1,-1,-1}, {60,24,-1,-1,-1,-1,-1,-1,-1,-1,-1,-1}, {59,25,-1,-1,-1,-1,-1,-1,-1,-1,-1,-1}, {58,26,-1,-1,-1,-1,-1,-1,-1,-1,-1,-1}, {57,27,-1,-1,-1,-1,-1,-1,-1,-1,-1,-1}, {56,28,-1,-1,-1,-1,-1,-1,-1,-1,-1,-1}, {55,29,-1,-1,-1,-1,-1,-1,-1,-1,-1,-1}, {54,30,-1,-1,-1,-1,-1,-1,-1,-1,-1,-1}, {53,31,-1,-1,-1,-1,-1,-1,-1,-1,-1,-1}, {52,32,-1,-1,-1,-1,-1,-1,-1,-1,-1,-1}, {51,33,-1,-1,-1,-1,-1,-1,-1,-1,-1,-1}, {50,34,-1,-1,-1,-1,-1,-1,-1,-1,-1,-1}, {49,35,-1,-1,-1,-1,-1,-1,-1,-1,-1,-1}, {48,36,-1,-1,-1,-1,-1,-1,-1,-1,-1,-1}, {47,37,-1,-1,-1,-1,-1,-1,-1,-1,-1,-1}, {46,38,-1,-1,-1,-1,-1,-1,-1,-1,-1,-1}, {45,39,-1,-1,-1,-1,-1,-1,-1,-1,-1,-1}, {44,40,-1,-1,-1,-1,-1,-1,-1,-1,-1,-1}, {43,41,-1,-1,-1,-1,-1,-1,-1,-1,-1,-1}, {42,20,19,6,-1,-1,-1,-1,-1,-1,-1,-1}, {18,17,16,15,14,5,-1,-1,-1,-1,-1,-1}, {13,12,11,10,9,8,7,4,3,2,1,0}};
__device__ __forceinline__ int att_bin_unit(int bin, int i) { return i < 12 ? (int)ATT_BINS[bin][i] : -1; }
#endif
__device__ __forceinline__ void ph_da_attn(const Ctx& C, const Args& a, int l, int bh, int bin) {
    const float* q1 = a.in[7] + (size_t)l * 64; const float* k1 = a.in[8] + (size_t)l * 64; const float* q2 = a.in[9] + (size_t)l * 64; const float* k2 = a.in[10] + (size_t)l * 64;
    float s1 = 0.f, s2 = 0.f;
    for (int i = 0; i < 64; ++i) { s1 += q1[i] * k1[i]; s2 += q2[i] * k2[i]; }
    const float lam_init = 0.8f - 0.6f * expf(-0.3f * (float)l); const float lam = expf(s1) - expf(s2) + lam_init;
    for (int i = 0; i < 12; ++i) { const int jq = att_bin_unit(bin, i); if (jq < 0) break; da_unit(C, a, l, bh >> 2, bh & 3, jq, lam, 1.0f - lam_init); }
}

PH_FN void ph_final(const Ctx C, ArgsP a) {
    const float* ssq = (const float*)(C.ws + WS_SSQ); const float* fn = a->in[39];
    const int gw = C.bid * NWAVES + C.wave, NGW = C.G * NWAVES;
    for (int m = gw; m < M; m += NGW) { const float rs = pg8::row_rstd(ssq, m, M); f32x4* hr = (f32x4*)(C.h + (size_t)m * D) + C.lane; const f32x4* gr = (const f32x4*)fn + C.lane;
#pragma unroll
        for (int j = 0; j < 4; ++j) { const f32x4 v = hr[64 * j], g = gr[64 * j]; hr[64 * j] = v * rs * g; } }
}
#define RWC_PTRS \
    float* RWW = (float*)(C.ws + WS_RWW); const bf16* RWR = (const bf16*)(C.ws + WS_RWR); const bf16* RWK = (const bf16*)(C.ws + WS_RWK); const bf16* RWV = (const bf16*)(C.ws + WS_RWV); \
    bf16* RWKK = (bf16*)(C.ws + WS_RWKK); bf16* RWB = (bf16*)(C.ws + WS_RWB); bf16* RWY = (bf16*)(C.ws + WS_RWY); \
    LF LGs = (LF)C.lds; LB LP = (LB)C.lds; LB LPT = (LB)(C.lds + 9216); LB AT = (LB)(C.lds + 18432); LB LAK = AT; LB LP2 = AT; LB RT = (LB)(C.lds + 27648); LB BTl = (LB)(C.lds + 36864); LB MRB = BTl; LB KTl = (LB)(C.lds + 46080); LB MRK = KTl; \
    LB VT = (LB)(C.lds + 55296); LB BHT = (LB)(C.lds + 64512); LB KHT = (LB)(C.lds + 73728); LB XB0 = (LB)(C.lds + 82944); LB XB1 = (LB)(C.lds + 101376); LB LPT2 = (LB)(C.lds + 119808); LF rho = (LF)(C.lds + 129024); LF lgl = rho + 64; \
    const int t = C.tid >> 3, g8 = C.tid & 7, n = C.lane & 31, hi = C.lane >> 5; \
    (void)RWW; (void)RWR; (void)RWK; (void)RWV; (void)RWKK; (void)RWB; (void)RWY; (void)LGs; (void)LP; (void)LPT; (void)AT; (void)LAK; (void)LP2; (void)RT; (void)BTl; (void)MRB; (void)KTl; (void)MRK; (void)VT; (void)BHT; (void)KHT; (void)XB0; (void)XB1; (void)LPT2; (void)rho; (void)lgl; (void)t; (void)g8; (void)n; (void)hi;
PH_FN void rwc_stage0(const Ctx C, int bc, int h) {
    RWC_PTRS
    const size_t row0 = (size_t)bc * 64; const size_t g = (row0 + t) * 512 + h * 64 + g8 * 8;
    WG_SYNC();
    float lw[8]; { const f32x4 x0 = *(const f32x4*)(RWW + g), x1 = *(const f32x4*)(RWW + g + 4); lw[0] = x0[0]; lw[1] = x0[1]; lw[2] = x0[2]; lw[3] = x0[3]; lw[4] = x1[0]; lw[5] = x1[1]; lw[6] = x1[2]; lw[7] = x1[3]; }
#pragma unroll
    for (int i = 0; i < 8; ++i) LGs[t * 68 + g8 * 8 + i] = lw[i];
    WG_SYNC();
    { const int seg = C.tid >> 6, k = C.tid & 63; float run = 0.f;
#pragma unroll
      for (int i = 0; i < 8; ++i) { run += LGs[(8 * seg + i) * 68 + k]; LGs[(8 * seg + i) * 68 + k] = run; }
      WG_SYNC();
      float off = 0.f;
#pragma unroll
      for (int sg = 0; sg < 7; ++sg) { const float tot = LGs[(8 * sg + 7) * 68 + k]; off += (sg < seg) ? tot : 0.f; }
      WG_SYNC();
#pragma unroll
      for (int i = 0; i < 8; ++i) LGs[(8 * seg + i) * 68 + k] += off; }
    WG_SYNC();
    {   float rf[8], kf[8], kkf[8], bf[8], lg[8], rh[8], ll[8], o1[8], o2[8], o3[8], o4[8];
        unpack8(*(const u32x4*)(RWR + g), rf); unpack8(*(const u32x4*)(RWK + g), kf); unpack8(*(const u32x4*)(RWKK + g), kkf); unpack8(*(const u32x4*)(RWB + g), bf);
#pragma unroll
        for (int i = 0; i < 8; ++i) { const int k = g8 * 8 + i; lg[i] = LGs[t * 68 + k]; rh[i] = LGs[31 * 68 + k]; ll[i] = LGs[63 * 68 + k]; }
#pragma unroll
        for (int i = 0; i < 8; ++i) { const int k = g8 * 8 + i; const float lm1 = lg[i] - lw[i];
            const float ed = __expf(lg[i] - rh[i]), edi = __expf(rh[i] - lg[i]), el = __expf(ll[i] - lg[i]);
            o1[i] = -kkf[i] * __expf(lm1 - rh[i]); o2[i] = rf[i] * ed; o3[i] = bf[i] * edi; o4[i] = kf[i] * edi;
            XB0[k * 72 + t] = (bf16)f2bf(-kkf[i] * __expf(lm1));
            BHT[k * 72 + t] = (bf16)f2bf(bf[i] * el); KHT[k * 72 + t] = (bf16)f2bf(kf[i] * el); }
        *(LAS u32x4*)(AT + t * 72 + g8 * 8) = pack8(o1); *(LAS u32x4*)(RT + t * 72 + g8 * 8) = pack8(o2); *(LAS u32x4*)(BTl + t * 72 + g8 * 8) = pack8(o3); *(LAS u32x4*)(KTl + t * 72 + g8 * 8) = pack8(o4);
        const u32x4 vv = *(const u32x4*)(RWV + g); const unsigned vw[4] = {vv.x, vv.y, vv.z, vv.w};
#pragma unroll
        for (int i = 0; i < 4; ++i) { VT[(g8 * 8 + 2 * i) * 72 + t] = (bf16)(vw[i] & 0xffffu); VT[(g8 * 8 + 2 * i + 1) * 72 + t] = (bf16)(vw[i] >> 16); }
        if (t == 0) {
#pragma unroll
            for (int i = 0; i < 8; ++i) { rho[g8 * 8 + i] = rh[i]; lgl[g8 * 8 + i] = ll[i]; } }
    }
    WG_SYNC();
}
PH_FN void rwc_stage12(const Ctx C) {
    RWC_PTRS
    {   const int mt = C.wave >> 1, nt0 = 2 * (C.wave & 1);
        CLB Am = (mt < 2) ? (CLB)AT : (CLB)RT; const int m0 = 32 * (mt & 1);
        CLB Bm = (nt0 < 2) ? (CLB)BTl : (CLB)KTl;
        f32x16 c0 = zero16(), c1 = zero16();
        mma_nt<64>(c0, Am, 72, m0, Bm, 72, 0, C.lane); mma_nt<64>(c1, Am, 72, m0, Bm, 72, 32, C.lane);
        WG_SYNC();
#pragma unroll
        for (int r = 0; r < 16; ++r) { const int tt = m0 + crow(r, hi); const int j0 = n, j1 = 32 + n;
            if (mt < 2) { const bf16 x0 = (bf16)f2bf((j0 < tt) ? c0[r] : 0.f), x1 = (bf16)f2bf((j1 < tt) ? c1[r] : 0.f);
                if (nt0 < 2) { LP[tt * 72 + j0] = x0; LP[tt * 72 + j1] = x1; LPT[j0 * 72 + tt] = x0; LPT[j1 * 72 + tt] = x1; } else { LAK[tt * 72 + j0] = x0; LAK[tt * 72 + j1] = x1; } }
            else { const bf16 x0 = (bf16)f2bf((j0 <= tt) ? c0[r] : 0.f), x1 = (bf16)f2bf((j1 <= tt) ? c1[r] : 0.f);
                if (nt0 < 2) { MRB[tt * 72 + j0] = x0; MRB[tt * 72 + j1] = x1; } else { MRK[tt * 72 + j0] = x0; MRK[tt * 72 + j1] = x1; } } }
    }
    WG_SYNC();
    if (C.wave < 4) { const int vt = C.wave >> 1, tt0 = C.wave & 1; f32x16 c = zero16(); mma_nt<64>(c, VT, 72, 32 * vt, LAK, 72, 32 * tt0, C.lane);
#pragma unroll
        for (int r = 0; r < 16; ++r) XB0[(64 + 32 * vt + crow(r, hi)) * 72 + 32 * tt0 + n] = (bf16)f2bf(c[r]); }
    WG_SYNC();
}
PH_FN void rwc_solve(const Ctx C) {
    RWC_PTRS
    const int ct = C.wave >> 1, tt = C.wave & 1;
    const int sk = C.wave >> 2, st = (C.wave >> 1) & 1, sj = C.wave & 1;
#pragma unroll 1
    for (int i = 0; i < 6; ++i) {
        CLB Pc = (i & 1) ? (CLB)LP2 : (CLB)LP; CLB PTc = (i & 1) ? (CLB)LPT2 : (CLB)LPT; LB Pn = (i & 1) ? LP : LP2; LB PTn = (i & 1) ? LPT : LPT2;
        CLB Xc = (i & 1) ? (CLB)XB1 : (CLB)XB0; LB Xn = (i & 1) ? XB0 : XB1;
        { f32x16 acc;
#pragma unroll
          for (int r = 0; r < 16; ++r) acc[r] = bf2f(Xc[(32 * ct + crow(r, hi)) * 72 + 32 * tt + n]);
          mma_nt<64>(acc, Xc, 72, 32 * ct, Pc, 72, 32 * tt, C.lane);
#pragma unroll
          for (int r = 0; r < 16; ++r) Xn[(32 * ct + crow(r, hi)) * 72 + 32 * tt + n] = (bf16)f2bf(acc[r]); }
        if (i < 5) { f32x16 acc = zero16();
          if (sk == 0) mma_nt<64>(acc, Pc, 72, 32 * st, PTc, 72, 32 * sj, C.lane); else mma_nt<64>(acc, PTc, 72, 32 * st, Pc, 72, 32 * sj, C.lane);
          LB dst = (sk == 0) ? Pn : PTn;
#pragma unroll
          for (int r = 0; r < 16; ++r) dst[(32 * st + crow(r, hi)) * 72 + 32 * sj + n] = (bf16)f2bf(acc[r]); }
        WG_SYNC();
    }
}
PH_FN void rwc_stage4(const Ctx C, int bc, int h) {
    RWC_PTRS
    const size_t row0 = (size_t)bc * 64; CLB A2T = (CLB)XB0; CLB WT = (CLB)(XB0 + 64 * 72);
    {   const int kind = C.wave >> 1, mt = C.wave & 1;
        f32x16 c0 = zero16(), c1 = zero16();
        if (kind == 0) { mma_nt<64>(c0, BHT, 72, 32 * mt, A2T, 72, 0, C.lane); mma_nt<64>(c1, BHT, 72, 32 * mt, A2T, 72, 32, C.lane); }
        else if (kind == 1) { mma_nt<64>(c0, BHT, 72, 32 * mt, WT, 72, 0, C.lane); mma_nt<64>(c1, BHT, 72, 32 * mt, WT, 72, 32, C.lane); mma_nt<64>(c0, KHT, 72, 32 * mt, VT, 72, 0, C.lane); mma_nt<64>(c1, KHT, 72, 32 * mt, VT, 72, 32, C.lane); }
        else if (kind == 2) { mma_nt<64>(c0, MRB, 72, 32 * mt, A2T, 72, 0, C.lane); mma_nt<64>(c1, MRB, 72, 32 * mt, A2T, 72, 32, C.lane); }
        else { mma_nt<64>(c0, MRB, 72, 32 * mt, WT, 72, 0, C.lane); mma_nt<64>(c1, MRB, 72, 32 * mt, WT, 72, 32, C.lane); mma_nt<64>(c0, MRK, 72, 32 * mt, VT, 72, 0, C.lane); mma_nt<64>(c1, MRK, 72, 32 * mt, VT, 72, 32, C.lane); }
#pragma unroll
        for (int r = 0; r < 16; ++r) { const int m = 32 * mt + crow(r, hi); const size_t go = (row0 + m) * 512 + h * 64;
            if (kind == 0) { const float d = __expf(lgl[m]); RWB[go + n] = (bf16)f2bf(c0[r] + ((n == m) ? d : 0.f)); RWB[go + 32 + n] = (bf16)f2bf(c1[r] + ((32 + n == m) ? d : 0.f)); }
            else if (kind == 1) { RWW[go + n] = c0[r]; RWW[go + 32 + n] = c1[r]; }
            else if (kind == 2) { RWKK[go + n] = (bf16)f2bf(c0[r] + bf2f(RT[m * 72 + n]) * __expf(rho[n])); RWKK[go + 32 + n] = (bf16)f2bf(c1[r] + bf2f(RT[m * 72 + 32 + n]) * __expf(rho[32 + n])); }
            else { RWY[go + n] = (bf16)f2bf(c0[r]); RWY[go + 32 + n] = (bf16)f2bf(c1[r]); } }
    }
}
__device__ __forceinline__ void ph_rw_chunk(const Ctx& C, int bc) {
#pragma unroll 1
    for (int h = 0; h < 8; ++h) { rwc_stage0(C, bc, h); rwc_stage12(C); rwc_solve(C); rwc_stage4(C, bc, h); }
    WG_SYNC();
}
PH_FN void rw_scan_unit(const Ctx C, int chain) {
    const float* RWW = (const float*)(C.ws + WS_RWW); const bf16* RWKK = (const bf16*)(C.ws + WS_RWKK); const bf16* RWB = (const bf16*)(C.ws + WS_RWB); bf16* RWY = (bf16*)(C.ws + WS_RWY);
    const int b = chain >> 3, h = chain & 7; const size_t rowb = (size_t)b * SEQ;
    constexpr int BUFB = 45056, O_RQ = 0, O_PT = 9216, O_QT = 18432, O_Y0 = 35840;
    LAS unsigned char* L = C.lds;
    if (C.wave >= 4) {
        const int p = C.tid - 256, t = p >> 2, q4 = (p & 3) * 16;
        u32x4 Arq0, Arq1, Apt0, Apt1, Ay00, Ay01, Brq0, Brq1, Bpt0, Bpt1, By00, By01; f32x4 Aq0, Aq1, Aq2, Aq3, Bq0, Bq1, Bq2, Bq3;
#define SC_LOAD(S, c_) do { const size_t g_ = (rowb + (size_t)(c_) * 64 + t) * 512 + h * 64 + q4; \
            S##rq0 = *(const u32x4*)(RWKK + g_); S##rq1 = *(const u32x4*)(RWKK + g_ + 8); S##pt0 = *(const u32x4*)(RWB + g_); S##pt1 = *(const u32x4*)(RWB + g_ + 8); S##y00 = *(const u32x4*)(RWY + g_); S##y01 = *(const u32x4*)(RWY + g_ + 8); \
            S##q0 = *(const f32x4*)(RWW + g_); S##q1 = *(const f32x4*)(RWW + g_ + 4); S##q2 = *(const f32x4*)(RWW + g_ + 8); S##q3 = *(const f32x4*)(RWW + g_ + 12); } while (0)
#define SC_WRITE(S, Lb) do { \
            *(LAS u32x4*)((LB)((Lb) + O_RQ) + t * 72 + q4) = S##rq0; *(LAS u32x4*)((LB)((Lb) + O_RQ) + t * 72 + q4 + 8) = S##rq1; \
            *(LAS u32x4*)((LB)((Lb) + O_PT) + t * 72 + q4) = S##pt0; *(LAS u32x4*)((LB)((Lb) + O_PT) + t * 72 + q4 + 8) = S##pt1; \
            *(LAS u32x4*)((LB)((Lb) + O_Y0) + t * 72 + q4) = S##y00; *(LAS u32x4*)((LB)((Lb) + O_Y0) + t * 72 + q4 + 8) = S##y01; \
            { LF d_ = (LF)((Lb) + O_QT) + t * 68 + q4; *(LAS f32x4*)d_ = S##q0; *(LAS f32x4*)(d_ + 4) = S##q1; *(LAS f32x4*)(d_ + 8) = S##q2; *(LAS f32x4*)(d_ + 12) = S##q3; } } while (0)
        SC_LOAD(A, 0); SC_LOAD(B, 1);
        for (int c = 0; c < NCH; c += 2) {
            SC_WRITE(A, L); if (c + 2 < NCH) SC_LOAD(A, c + 2); RW_BAR();
            SC_WRITE(B, L + BUFB); if (c + 3 < NCH) SC_LOAD(B, c + 3); RW_BAR();
        }
        RW_BAR();
#undef SC_LOAD
#undef SC_WRITE
    } else {
        const int n = C.lane & 31, hi = C.lane >> 5, vh = C.wave & 1;
        f32x16 st0 = zero16(), st1 = zero16();
        for (int c = 0; c < NCH; ++c) {
            RW_BAR();
            if (C.wave < 2) {
                const LAS unsigned char* Lb = L + (c & 1) * BUFB;
                CLB RQ = (CLB)(Lb + O_RQ); CLB PT = (CLB)(Lb + O_PT); CLF QT = (CLF)(Lb + O_QT); CLB Y0 = (CLB)(Lb + O_Y0);
                pg8::bf16x8 sb[4];
                { u32x4 w;
                  w.x = pk2(st0[0], st0[1]); w.y = pk2(st0[2], st0[3]); w.z = pk2(st0[4], st0[5]); w.w = pk2(st0[6], st0[7]); sb[0] = __builtin_bit_cast(pg8::bf16x8, w);
                  w.x = pk2(st0[8], st0[9]); w.y = pk2(st0[10], st0[11]); w.z = pk2(st0[12], st0[13]); w.w = pk2(st0[14], st0[15]); sb[1] = __builtin_bit_cast(pg8::bf16x8, w);
                  w.x = pk2(st1[0], st1[1]); w.y = pk2(st1[2], st1[3]); w.z = pk2(st1[4], st1[5]); w.w = pk2(st1[6], st1[7]); sb[2] = __builtin_bit_cast(pg8::bf16x8, w);
                  w.x = pk2(st1[8], st1[9]); w.y = pk2(st1[10], st1[11]); w.z = pk2(st1[12], st1[13]); w.w = pk2(st1[14], st1[15]); sb[3] = __builtin_bit_cast(pg8::bf16x8, w); }
#define SC_AFRAG(X_, row_, s_) ({ const u32x2 lo_ = *(const LAS u32x2*)((X_) + (row_) * 72 + 16 * (s_) + 4 * hi), hi_ = *(const LAS u32x2*)((X_) + (row_) * 72 + 16 * (s_) + 8 + 4 * hi); \
                    u32x4 w_; w_.x = lo_.x; w_.y = lo_.y; w_.z = hi_.x; w_.w = hi_.y; __builtin_bit_cast(pg8::bf16x8, w_); })
#pragma unroll
                for (int tt = 0; tt < 2; ++tt) { f32x16 y;
#pragma unroll
                    for (int r = 0; r < 16; ++r) y[r] = bf2f(Y0[(32 * tt + crow(r, hi)) * 72 + 32 * vh + n]);
#pragma unroll
                    for (int s = 0; s < 4; ++s) y = __builtin_amdgcn_mfma_f32_32x32x16_bf16(SC_AFRAG(RQ, 32 * tt + n, s), sb[s], y, 0, 0, 0);
                    bf16* yo = RWY + (rowb + (size_t)c * 64 + 32 * tt) * 512 + h * 64 + 32 * vh + n;
#pragma unroll
                    for (int r = 0; r < 16; ++r) yo[(size_t)crow(r, hi) * 512] = (bf16)f2bf(y[r]); }
                f32x16 n0, n1;
#pragma unroll
                for (int r = 0; r < 16; ++r) { n0[r] = QT[crow(r, hi) * 68 + 32 * vh + n]; n1[r] = QT[(32 + crow(r, hi)) * 68 + 32 * vh + n]; }
#pragma unroll
                for (int s = 0; s < 4; ++s) { n0 = __builtin_amdgcn_mfma_f32_32x32x16_bf16(SC_AFRAG(PT, n, s), sb[s], n0, 0, 0, 0); n1 = __builtin_amdgcn_mfma_f32_32x32x16_bf16(SC_AFRAG(PT, 32 + n, s), sb[s], n1, 0, 0, 0); }
                st0 = n0; st1 = n1;
#undef SC_AFRAG
            }
        }
        RW_BAR();
    }
}
#ifndef REP_ATTN
#define REP_ATTN 1
#endif
#ifndef REP_W
#define REP_W 1
#endif
#ifndef REP_RWC
#define REP_RWC 1
#endif
#ifndef REP_MA
#define REP_MA 1
#endif
#ifndef REP_GLAA
#define REP_GLAA 1
#endif
#ifndef REP_SSDA
#define REP_SSDA 1
#endif
#ifndef REP_RWP
#define REP_RWP 1
#endif
#ifndef REP_GLAC
#define REP_GLAC 1
#endif
#ifndef REP_SSDC
#define REP_SSDC 1
#endif
#ifndef REP_RWO
#define REP_RWO 1
#endif
#ifndef REP_MAFULL
#define REP_MAFULL 1
#endif
#ifndef REP_SCANS
#define REP_SCANS 1
#endif
#ifndef REP_MC
#define REP_MC 1
#endif
#ifndef REP_GEMM
#define REP_GEMM 1
#endif
constexpr int NPH = 12, G_FINAL = 1 + NL * NPH, G_END = G_FINAL + 1;
template <int GRP>
__global__ void __launch_bounds__(NTHR, 2) hybrid_fwd(Args args) {
    constexpr bool ALL = (GRP < 0);
    constexpr bool EN_G1 = ALL || GRP == 0, EN_G2 = EN_G1, EN_G3 = EN_G1, EN_G7 = EN_G1, EN_G8 = EN_G1, EN_G9 = EN_G1;
    constexpr bool EN_PRO = ALL || GRP == 1, EN_W = EN_PRO, EN_FIN = EN_PRO, EN_MA1 = EN_PRO, EN_MA2 = EN_PRO, EN_MA3 = EN_PRO, EN_MA4 = EN_PRO;
    constexpr bool EN_MB1 = ALL || GRP == 2, EN_MB2 = EN_MB1;
    constexpr bool EN_MC1 = ALL || GRP == 3, EN_MC2 = EN_MC1, EN_MC3 = EN_MC1;
    extern __shared__ __attribute__((aligned(16))) unsigned char lds[];
    Ctx C; C.lds = (LAS unsigned char*)lds; C.ws = args.ws; C.h = args.out; C.tid = threadIdx.x; C.lane = C.tid & 63; C.wave = __builtin_amdgcn_readfirstlane(C.tid >> 6); C.bid = blockIdx.x; C.G = gridDim.x;
    LAS unsigned char* ldsl = (LAS unsigned char*)lds;
    const ArgsP ap = (ArgsP)__builtin_amdgcn_kernarg_segment_ptr();
    for (int u = C.tid; u < (LDS_BYTES - LDSCTL_OFF) / 4; u += NTHR) ((LAS unsigned*)(ldsl + LDSCTL_OFF))[u] = 0u;
    __syncthreads();
    volatile LAS unsigned* MISC = (volatile LAS unsigned*)(ldsl + MISC_OFF);
    gu32* ctl = (gu32*)(args.ws + WS_CTL);
    const int g_lo = args.g_lo, g_hi = args.g_hi;
    XcdBarrier bar; bar.bar = (unsigned*)(ctl + CW_BAR); bar.x = 0; bar.st = nullptr;
    if (g_hi - g_lo > 1) bar = xcd_barrier_post((unsigned*)(ctl + CW_BAR), MISC + 8);
#define IN(g) (g_lo <= (g) && (g) < g_hi)
#define SEAM(g) do { if (IN(g) && IN((g) + 1)) xcd_barrier(bar); } while (0)
    bf16* HB = (bf16*)(args.ws + WS_HB); float* SSQ = (float*)(args.ws + WS_SSQ);

    if (EN_PRO && IN(0)) ph_prologue(fresh(C), ap);
    SEAM(0);
#pragma unroll 1
    for (int l = 0; l < NL; ++l) {
        const int gb = 1 + NPH * l;
        if (EN_W && IN(gb + 0)) { for (int rep = 0; rep < REP_W; ++rep) ph_weights(fresh(C), ap, l); }
        SEAM(gb + 0);
#pragma unroll 1
        for (int f = 0; f < 2; ++f) {
            const int gu = gb + (f ? 10 : 1);
            if (EN_G1 && IN(gu)) {
                pg8::Gemm g{HB, (const bf16*)(args.ws + (f ? WS_WGU2 : WS_WGU1)), M, 2 * FF, D, D}; pg8::StaticOrder S; S.init(M, 2 * FF, C.G, C.bid);
                pg8::EpiSwiglu E{(bf16*)(args.ws + WS_ACT), FF, SSQ, M};
                pg8::gemm_phase<pg8::EpiSwiglu, pg8::StaticOrder, true, true>(ldsl, g, S, E);
            }
            SEAM(gu);
            if (EN_G2 && IN(gu + 1)) {
                pg8::Gemm g{(const bf16*)(args.ws + WS_ACT), (const bf16*)(args.ws + (f ? WS_WD2 : WS_WD1)), M, D, FF, FF}; pg8::StaticOrder S; S.init(M, D, C.G, C.bid);
                pg8::EpiResid E{C.h, HB, SSQ, M, 0.5f};
                pg8::gemm_phase<pg8::EpiResid, pg8::StaticOrder, false, true>(ldsl, g, S, E);
            }
            SEAM(gu + 1);
            if (f == 0) {
                if (EN_G3 && IN(gb + 3)) {
                    pg8::Gemm g{HB, (const bf16*)(args.ws + WS_WIN), M, NPM, D, D}; pg8::StaticOrder S; S.init(M, NPM, C.G, C.bid);
                    pg8::EpiScaleBf16 E{(bf16*)(args.ws + WS_P), NPM, SSQ, M};
                    pg8::gemm_phase<pg8::EpiScaleBf16, pg8::StaticOrder, true, true>(ldsl, g, S, E);
                }
                SEAM(gb + 3);
                if (IN(gb + 4)) { if (EN_MA1) ph_da_prep(fresh(C)); for (int rf = 0; rf < REP_MAFULL; ++rf) { for (int rep = 0; rep < REP_MA; ++rep) { for (int r2 = 0; r2 < REP_GLAA; ++r2) if (EN_MA2) ph_gla_a(fresh(C), ap, l); for (int r2 = 0; r2 < REP_SSDA; ++r2) if (EN_MA3) ph_ssd_a(fresh(C), ap, l); for (int r2 = 0; r2 < REP_RWP; ++r2) if (EN_MA4) ph_rw_prep(fresh(C), ap, l); } if (EN_MA4 && RW_CHUNKED) ph_rw_chunk(fresh(C), C.bid); } }
                SEAM(gb + 4);
                if (IN(gb + 5)) {
#if RW_CHUNKED
#define MB_SCANS() do { if (EN_MB2) { if (C.bid < 16) rw_scan_unit(fresh(C), C.bid); else { for (int p = C.bid - 16; p < 384; p += C.G - 16) { if (p < 128) gla_scan_part(fresh(C), p); else ssd_scan_part(fresh(C), p - 128); } } } } while (0)
                    MB_SCANS();
                    for (int rs = 1; rs < REP_SCANS; ++rs) {
                        xcd_barrier(bar); if (EN_MA2) ph_gla_a(fresh(C), ap, l); if (EN_MA3) ph_ssd_a(fresh(C), ap, l); if (EN_MA4) { ph_rw_prep(fresh(C), ap, l); ph_rw_chunk(fresh(C), C.bid); } xcd_barrier(bar); MB_SCANS(); }
                    if (C.bid >= 16) { const int a = C.bid - 16; for (int rep = 0; rep < REP_ATTN; ++rep) if (EN_MB1) ph_da_attn(fresh(C), args, l, a & 7, a >> 3); }
#else
                    if (C.bid < 64) { if (EN_MB2) { const int xcd = C.bid & 7, slot = C.bid >> 3; for (int rep = 0; rep < REP_RWC; ++rep) rw_unit(fresh(C), xcd * 2 + (slot >> 2), slot & 3); } }
                    else { const int a = C.bid - 64;
                        if (EN_MB2) { for (int p = a; p < 384; p += 192) { if (p < 128) gla_scan_part(fresh(C), p); else ssd_scan_part(fresh(C), p - 128); } }
                        for (int rep = 0; rep < REP_ATTN; ++rep) if (EN_MB1) ph_da_attn(fresh(C), args, l, a & 7, a >> 3); }
#endif
                }
                SEAM(gb + 5);
                if (IN(gb + 6)) { for (int rep = 0; rep < REP_MC; ++rep) { for (int r2 = 0; r2 < REP_GLAC; ++r2) if (EN_MC1) ph_gla_c(fresh(C), ap, l); for (int r2 = 0; r2 < REP_SSDC; ++r2) if (EN_MC2) ph_ssd_c(fresh(C), ap, l); for (int r2 = 0; r2 < REP_RWO; ++r2) if (EN_MC3) ph_rw_out(fresh(C), ap, l); } }
                SEAM(gb + 6);
                if (EN_G7 && IN(gb + 7)) {
                    pg8::Gemm g{HB, (const bf16*)(args.ws + WS_WIN) + (size_t)NPM * D, M, 4096, D, D}; pg8::StaticOrder S; S.init(M, 4096, C.G, C.bid);
                    pg8::EpiScaleBf16 E{(bf16*)(args.ws + WS_PG), 4096, SSQ, M};
                    pg8::gemm_phase<pg8::EpiScaleBf16, pg8::StaticOrder, true, true>(ldsl, g, S, E);
                }
                SEAM(gb + 7);
                if (EN_G8 && IN(gb + 8)) {
                    pg8::Gemm g{(const bf16*)(args.ws + WS_YS), (const bf16*)(args.ws + WS_WB), M, D, 512, 2048}; pg8::GroupedOrder S; S.init(M, D, 4, 512, C.G, C.bid);
                    pg8::EpiGateAcc E{(bf16*)(args.ws + WS_MERGED), (const bf16*)(args.ws + WS_PG), args.in[33] + (size_t)l * 4096};
                    pg8::gemm_phase<pg8::EpiGateAcc, pg8::GroupedOrder, true, true>(ldsl, g, S, E);
                }
                SEAM(gb + 8);
                if (EN_G9 && IN(gb + 9)) {
                    pg8::Gemm g{(const bf16*)(args.ws + WS_MERGED), (const bf16*)(args.ws + WS_WO), M, D, D, D}; pg8::StaticOrder S; S.init(M, D, C.G, C.bid);
                    pg8::EpiResid E{C.h, HB, SSQ, M, 1.0f};
                    pg8::gemm_phase<pg8::EpiResid, pg8::StaticOrder, false, true>(ldsl, g, S, E);
                }
                SEAM(gb + 9);
            }
        }
    }
    if (EN_FIN && IN(G_FINAL)) ph_final(fresh(C), ap);
#undef IN
#undef SEAM
}

#ifndef ONE_LAUNCH
#define ONE_LAUNCH 1
#endif
extern "C" void kernel_launch(void* const* d_in, const int* in_sizes, int n_in, void* d_out, int out_size, void* d_ws, size_t ws_size, hipStream_t stream) {
    static int grid = 0;
    if (grid == 0) {
        if (n_in != 40 || in_sizes[0] != M * D || out_size != M * D || ws_size < WS_END) { fprintf(stderr, "kernel_launch: unexpected shapes (n_in %d, in0 %d, out %d, ws %zu < %zu); nothing launched\n", n_in, n_in > 0 ? in_sizes[0] : -1, out_size, ws_size, (size_t)WS_END); grid = -1; return; }
        int dev = 0, cus = 0, per_cu = 0;
        if (hipGetDevice(&dev) != hipSuccess || hipDeviceGetAttribute(&cus, hipDeviceAttributeMultiprocessorCount, dev) != hipSuccess) { grid = -1; return; }
#if ONE_LAUNCH
        if (hipFuncSetAttribute((const void*)hybrid_fwd<-1>, hipFuncAttributeMaxDynamicSharedMemorySize, LDS_BYTES) != hipSuccess) { fprintf(stderr, "kernel_launch: hipFuncSetAttribute failed\n"); grid = -1; return; }
#else
        if (hipFuncSetAttribute((const void*)hybrid_fwd<0>, hipFuncAttributeMaxDynamicSharedMemorySize, LDS_BYTES) != hipSuccess || hipFuncSetAttribute((const void*)hybrid_fwd<1>, hipFuncAttributeMaxDynamicSharedMemorySize, LDS_BYTES) != hipSuccess ||
            hipFuncSetAttribute((const void*)hybrid_fwd<2>, hipFuncAttributeMaxDynamicSharedMemorySize, LDS_BYTES) != hipSuccess || hipFuncSetAttribute((const void*)hybrid_fwd<3>, hipFuncAttributeMaxDynamicSharedMemorySize, LDS_BYTES) != hipSuccess) { fprintf(stderr, "kernel_launch: hipFuncSetAttribute failed\n"); grid = -1; return; }
#endif
        if (hipOccupancyMaxActiveBlocksPerMultiprocessor(&per_cu, (const void*)hybrid_fwd<(ONE_LAUNCH ? -1 : 0)>, NTHR, LDS_BYTES) != hipSuccess || per_cu < 1) fprintf(stderr, "kernel_launch: occupancy query reports %d workgroups per CU\n", per_cu);
        (void)hipGetLastError();
        grid = cus;
        if (grid != 256) { fprintf(stderr, "kernel_launch: %d CUs; this kernel is laid out for 256 workgroups; nothing launched\n", grid); grid = -1; return; }
    }
    if (grid < 0) return;
    if (hipMemsetAsync((char*)d_ws + WS_CTL, 0, CTL_ZERO_BYTES, stream) != hipSuccess) return;
    Args a{};
    for (int i = 0; i < 40; ++i) a.in[i] = (const float*)d_in[i];
    a.out = (float*)d_out; a.ws = (unsigned char*)d_ws;
    for (int j = 0; j < 32; ++j) a.inv_freq[j] = (float)pow(10000.0, -(double)j / 32.0);
#if ONE_LAUNCH
    a.g_lo = 0; a.g_hi = G_END;
    hipLaunchKernelGGL(hybrid_fwd<-1>, dim3(grid), dim3(NTHR), LDS_BYTES, stream, a);
#else
    for (int g = 0; g < G_END; ++g) {
        a.g_lo = g; a.g_hi = g + 1;
        int grp = 1;
        if (g >= 1 && g < G_FINAL) { const int k = (g - 1) % NPH; grp = (k == 0 || k == 4) ? 1 : (k == 5) ? 2 : (k == 6) ? 3 : 0; }
        if (grp == 0) hipLaunchKernelGGL(hybrid_fwd<0>, dim3(grid), dim3(NTHR), LDS_BYTES, stream, a);
        else if (grp == 1) hipLaunchKernelGGL(hybrid_fwd<1>, dim3(grid), dim3(NTHR), LDS_BYTES, stream, a);
        else if (grp == 2) hipLaunchKernelGGL(hybrid_fwd<2>, dim3(grid), dim3(NTHR), LDS_BYTES, stream, a);
        else hipLaunchKernelGGL(hybrid_fwd<3>, dim3(grid), dim3(NTHR), LDS_BYTES, stream, a);
    }
#endif
}
```

```cpp
#include <hip/hip_runtime.h>
#include <cstdio>
#include <cstdint>
#include <cmath>

namespace pg8 {
#define PG8_LAS __attribute__((address_space(3)))
typedef unsigned short bf16_t;
typedef short bf16x8 __attribute__((ext_vector_type(8)));
typedef float f32x4 __attribute__((ext_vector_type(4)));
typedef unsigned u32x4 __attribute__((ext_vector_type(4)));
constexpr int BM = 256, BK = 64, HALF = 128, HTB = HALF * BK * 2  , STAGE_BYTES = 8 * HTB, NXCD = 8, WGM = 8;

__host__ __device__ __forceinline__ int lds_byte(int r, int c) { const int st = (r >> 4) * 2 + (c >> 5), rr = r & 15, cc = c & 31, ob = rr * 64 + cc * 2; return st * 1024 + (ob ^ (((ob >> 9) & 1) << 5)); }
__host__ __device__ __forceinline__ void stage_rc(int b, int& R, int& C) { const int st = b / 1024, sb = b % 1024, swz = sb ^ (((sb >> 9) & 1) << 5); R = (st >> 1) * 16 + swz / 64; C = (st & 1) * 32 + (swz % 64) / 2; }
__host__ __device__ __forceinline__ int perm32(int rho) { const int n = rho >> 4, i = rho & 15; return 8 * (i >> 2) + 4 * n + (i & 3); }

struct Unit { int pm, pn, z; };
struct Gemm { const bf16_t* A; const bf16_t* Bt; int M, N, K, lda; };

struct StaticOrder {
    int nM, nN, nwg, G, c;
    __host__ __device__ void init(int M, int N, int G_, int c_) { nM = M / BM; nN = N / BM; nwg = nM * nN; G = G_; c = c_; }
    __host__ __device__ bool next(int i, Unit& u) const {
        const long L = (long)i * G + c; if (L >= nwg) return false;
        int wgid = (int)L; { const int q = nwg / NXCD, r = nwg % NXCD, xcd = wgid % NXCD, off = wgid / NXCD; wgid = (xcd < r ? xcd * (q + 1) : r * (q + 1) + (xcd - r) * q) + off; }
        const int nig = WGM * nN, gid = wgid / nig, fm = gid * WGM, gsz = (nM - fm) < WGM ? (nM - fm) : WGM;
        u.pm = fm + ((wgid % nig) % gsz); u.pn = (wgid % nig) / gsz; u.z = 0; return true;
    }
    __device__ __forceinline__ void a_ready(const Unit&) const {}
    __device__ __forceinline__ void done(const Unit&) const {}
    __device__ __forceinline__ size_t a_off(const Unit&) const { return 0; }
    __device__ __forceinline__ int b_tile(const Unit& u) const { return u.pn; }
};
struct GroupedOrder {
    StaticOrder base; int NZ, Kbytes, tiles_per_group;
    __device__ void init(int M, int N, int NZ_, int K, int G_, int c_) { base.init(M, N, G_, c_); NZ = NZ_; Kbytes = K * 2; tiles_per_group = N / BM; }
    __device__ bool next(int i, Unit& u) const { const int r = i / NZ, z = i - r * NZ; if (!base.next(r, u)) return false; u.z = z; return true; }
    __device__ __forceinline__ void a_ready(const Unit&) const {}
    __device__ __forceinline__ void done(const Unit&) const {}
    __device__ __forceinline__ size_t a_off(const Unit& u) const { return (size_t)u.z * Kbytes; }
    __device__ __forceinline__ int b_tile(const Unit& u) const { return u.z * tiles_per_group + u.pn; }
};

__device__ __forceinline__ unsigned cvt_pk_bf16(float lo, float hi) { unsigned r; asm volatile("v_cvt_pk_bf16_f32 %0, %1, %2" : "=v"(r) : "v"(lo), "v"(hi)); return r; }
__device__ __forceinline__ float bf_lo(unsigned w) { return __uint_as_float(w << 16); }
__device__ __forceinline__ float bf_hi(unsigned w) { return __uint_as_float(w & 0xffff0000u); }
__device__ __forceinline__ float fast_sigmoid(float x) { return __builtin_amdgcn_rcpf(1.0f + __builtin_amdgcn_exp2f(-1.4426950408889634f * x)); }

__device__ __forceinline__ float row_rstd(const float* ssq, int row, int M_) {
    const float s = (ssq[row] + ssq[M_ + row]) + (ssq[2 * M_ + row] + ssq[3 * M_ + row]);
    return 1.0f / sqrtf(s * (1.0f / 1024.0f) + 1e-6f);
}
struct EpiScaleBf16 {
    static constexpr bool PERM = true, AFTER_DRAIN = false;
    bf16_t* O; int ldc; const float* ssq; int M_;
    __device__ __forceinline__ void operator()(const f32x4 (&acc)[2][2][4][2], const Unit& u, int wr, int wc, int fr, int fq) const {
        const int row0 = u.pm * BM + wr * 64 + fr; const int col0 = u.pn * BM + wc * 32 + 8 * fq;
#pragma unroll
        for (int ai = 0; ai < 2; ++ai)
#pragma unroll
            for (int m = 0; m < 4; ++m) { const int row = row0 + ai * HALF + m * 16; const float rs = row_rstd(ssq, row, M_); bf16_t* rowp = O + (size_t)row * ldc + col0;
#pragma unroll
                for (int bj = 0; bj < 2; ++bj) { const f32x4 v0 = acc[ai][bj][m][0] * rs, v1 = acc[ai][bj][m][1] * rs;
                    u32x4 w; w.x = cvt_pk_bf16(v0[0], v0[1]); w.y = cvt_pk_bf16(v0[2], v0[3]); w.z = cvt_pk_bf16(v1[0], v1[1]); w.w = cvt_pk_bf16(v1[2], v1[3]);
                    *(u32x4*)(rowp + bj * HALF) = w; } }
    }
};
struct EpiSwiglu {
    static constexpr bool PERM = true, AFTER_DRAIN = false;
    bf16_t* O; int ldc; const float* ssq; int M_;
    __device__ __forceinline__ void operator()(const f32x4 (&acc)[2][2][4][2], const Unit& u, int wr, int wc, int fr, int fq) const {
        const int row0 = u.pm * BM + wr * 64 + fr; const int col0 = u.pn * HALF + wc * 32 + 8 * fq;
#pragma unroll
        for (int ai = 0; ai < 2; ++ai)
#pragma unroll
            for (int m = 0; m < 4; ++m) { const int row = row0 + ai * HALF + m * 16; const float rs = row_rstd(ssq, row, M_); bf16_t* rowp = O + (size_t)row * ldc + col0;
                float o[8];
#pragma unroll
                for (int n = 0; n < 2; ++n)
#pragma unroll
                    for (int i = 0; i < 4; ++i) { const float g = acc[ai][0][m][n][i] * rs, up = acc[ai][1][m][n][i] * rs; o[n * 4 + i] = g * fast_sigmoid(g) * up; }
                u32x4 w; w.x = cvt_pk_bf16(o[0], o[1]); w.y = cvt_pk_bf16(o[2], o[3]); w.z = cvt_pk_bf16(o[4], o[5]); w.w = cvt_pk_bf16(o[6], o[7]);
                *(u32x4*)rowp = w; }
    }
};
struct EpiGateAcc {
    static constexpr bool PERM = true, AFTER_DRAIN = false;
    bf16_t* O; const bf16_t* PG; const float* gb;
    __device__ __forceinline__ void operator()(const f32x4 (&acc)[2][2][4][2], const Unit& u, int wr, int wc, int fr, int fq) const {
        const int row0 = u.pm * BM + wr * 64 + fr; const int col0 = u.pn * BM + wc * 32 + 8 * fq; const int z = u.z;
        f32x4 gbv[2][2];
#pragma unroll
        for (int bj = 0; bj < 2; ++bj)
#pragma unroll
            for (int n = 0; n < 2; ++n) gbv[bj][n] = *(const f32x4*)(gb + z * 1024 + col0 + bj * HALF + 4 * n);
#pragma unroll
        for (int ai = 0; ai < 2; ++ai)
#pragma unroll
            for (int m = 0; m < 4; ++m) { const int row = row0 + ai * HALF + m * 16;
#pragma unroll
                for (int bj = 0; bj < 2; ++bj) {
                    const u32x4 pg = *(const u32x4*)(PG + (size_t)row * 4096 + z * 1024 + col0 + bj * HALF);
                    bf16_t* op = O + (size_t)row * 1024 + col0 + bj * HALF;
                    float o[8];
                    o[0] = fast_sigmoid(bf_lo(pg.x) + gbv[bj][0][0]) * acc[ai][bj][m][0][0]; o[1] = fast_sigmoid(bf_hi(pg.x) + gbv[bj][0][1]) * acc[ai][bj][m][0][1];
                    o[2] = fast_sigmoid(bf_lo(pg.y) + gbv[bj][0][2]) * acc[ai][bj][m][0][2]; o[3] = fast_sigmoid(bf_hi(pg.y) + gbv[bj][0][3]) * acc[ai][bj][m][0][3];
                    o[4] = fast_sigmoid(bf_lo(pg.z) + gbv[bj][1][0]) * acc[ai][bj][m][1][0]; o[5] = fast_sigmoid(bf_hi(pg.z) + gbv[bj][1][1]) * acc[ai][bj][m][1][1];
                    o[6] = fast_sigmoid(bf_lo(pg.w) + gbv[bj][1][2]) * acc[ai][bj][m][1][2]; o[7] = fast_sigmoid(bf_hi(pg.w) + gbv[bj][1][3]) * acc[ai][bj][m][1][3];
                    if (z > 0) { const u32x4 pv = *(const u32x4*)op;
                        o[0] += bf_lo(pv.x); o[1] += bf_hi(pv.x); o[2] += bf_lo(pv.y); o[3] += bf_hi(pv.y); o[4] += bf_lo(pv.z); o[5] += bf_hi(pv.z); o[6] += bf_lo(pv.w); o[7] += bf_hi(pv.w); }
                    u32x4 w; w.x = cvt_pk_bf16(o[0], o[1]); w.y = cvt_pk_bf16(o[2], o[3]); w.z = cvt_pk_bf16(o[4], o[5]); w.w = cvt_pk_bf16(o[6], o[7]);
                    *(u32x4*)op = w; } }
    }
};
struct EpiResid {
    static constexpr bool PERM = true, AFTER_DRAIN = true;
    float* H; bf16_t* HB; float* ssq; int M_; float s;
    __device__ __forceinline__ void fused(f32x4 (&acc)[2][2][4][2], const Unit& u, int wr, int wc, int fr, int fq, PG8_LAS unsigned char* lds, int wid, int lane) const {
        PG8_LAS float* P = (PG8_LAS float*)lds;
        const int row0 = u.pm * BM + wr * 64 + fr; const int col0 = u.pn * BM + wc * 32 + 8 * fq;
#pragma unroll
        for (int ai = 0; ai < 2; ++ai)
#pragma unroll
            for (int m = 0; m < 4; ++m) { const int row = row0 + ai * HALF + m * 16; float q = 0.f;
#pragma unroll
                for (int bj = 0; bj < 2; ++bj) { float* hp = H + (size_t)row * 1024 + col0 + bj * HALF;
                    const f32x4 h0 = *(const f32x4*)hp + acc[ai][bj][m][0] * s, h1 = *(const f32x4*)(hp + 4) + acc[ai][bj][m][1] * s;
                    *(f32x4*)hp = h0; *(f32x4*)(hp + 4) = h1;
                    q += (h0[0] * h0[0] + h0[1] * h0[1]) + (h0[2] * h0[2] + h0[3] * h0[3]) + (h1[0] * h1[0] + h1[1] * h1[1]) + (h1[2] * h1[2] + h1[3] * h1[3]);
                    u32x4 w; w.x = cvt_pk_bf16(h0[0], h0[1]); w.y = cvt_pk_bf16(h0[2], h0[3]); w.z = cvt_pk_bf16(h1[0], h1[1]); w.w = cvt_pk_bf16(h1[2], h1[3]);
                    *(u32x4*)(HB + (size_t)row * 1024 + col0 + bj * HALF) = w; }
                q += __shfl_xor(q, 16); q += __shfl_xor(q, 32);
                if (fq == 0) P[(ai * HALF + wr * 64 + m * 16 + fr) * 4 + wc] = q; }
        asm volatile("s_waitcnt lgkmcnt(0)" ::: "memory"); __builtin_amdgcn_s_barrier(); asm volatile("" ::: "memory");
        const int t = wid * 64 + lane;
        if (t < 256) { const float q = (P[t * 4 + 0] + P[t * 4 + 1]) + (P[t * 4 + 2] + P[t * 4 + 3]); ssq[(size_t)u.pn * M_ + u.pm * BM + t] = q; }
        asm volatile("s_waitcnt lgkmcnt(0)" ::: "memory"); __builtin_amdgcn_s_barrier(); asm volatile("" ::: "memory");
    }
};
template <class Epi, class Sched, bool ALIGN_EPI = false, bool SP2 = false>
__device__ __forceinline__ void gemm_phase(PG8_LAS unsigned char* lds, const Gemm g, const Sched& S, const Epi& E) {
    int tid_ = threadIdx.x; asm volatile("" : "+v"(tid_)); const int tid = tid_, wid = __builtin_amdgcn_readfirstlane(tid >> 6), lane = tid & 63, wr = wid >> 2, wc = wid & 3, fr = lane & 15, fq = lane >> 4;
    const int K = g.K, nt = K / BK;
    unsigned voffA[2], voffB[2];
#pragma unroll
    for (int i = 0; i < 2; ++i) { int R, C; stage_rc(tid * 16 + i * 8192, R, C); const int Rb = Epi::PERM ? ((R & ~31) + perm32(R & 31)) : R;
        voffA[i] = (unsigned)(R * g.lda + C) * 2u; voffB[i] = (unsigned)(Rb * K + C) * 2u; }
    const size_t kstep = (size_t)(BK * 2);
    const size_t hstep = (size_t)HALF * K * 2;
    const size_t tstep = 2 * hstep; const size_t hstepA = (size_t)HALF * g.lda * 2, tstepA = 2 * hstepA;
    const unsigned ldsw = (unsigned)wid * 1024u;
    const int aoff = lds_byte(wr * 64 + fr, fq * 8), boff = lds_byte(wc * 32 + fr, fq * 8);
#define PG8_SA(b, h) (((b) * 2 + (h)) * HTB)
#define PG8_SB(b, h) ((4 + (b) * 2 + (h)) * HTB)
#define PG8_STAGE(bufoff, gbase, voff) do { _Pragma("unroll") for (int _i = 0; _i < 2; ++_i) \
        __builtin_amdgcn_global_load_lds((const unsigned*)((const char*)(gbase) + (voff)[_i]), (PG8_LAS unsigned*)(lds + (bufoff) + ldsw + _i * 8192), 16, 0, 0); } while (0)
#define PG8_LDA(dst, b, h) do { _Pragma("unroll") for (int m = 0; m < 4; ++m) _Pragma("unroll") for (int k = 0; k < 2; ++k) dst[m][k] = *(const PG8_LAS bf16x8*)(lds + PG8_SA(b, h) + aoff + m * 2048 + k * 1024); } while (0)
#define PG8_LDB(dst, b, h) do { _Pragma("unroll") for (int n = 0; n < 2; ++n) _Pragma("unroll") for (int k = 0; k < 2; ++k) dst[n][k] = *(const PG8_LAS bf16x8*)(lds + PG8_SB(b, h) + boff + n * 2048 + k * 1024); } while (0)
#define PG8_MMA(ai, bj, At, Bt) do { __builtin_amdgcn_s_setprio(1); _Pragma("unroll") for (int m = 0; m < 4; ++m) _Pragma("unroll") for (int n = 0; n < 2; ++n) _Pragma("unroll") for (int k = 0; k < 2; ++k) \
        acc[ai][bj][m][n] = __builtin_amdgcn_mfma_f32_16x16x32_bf16(Bt[n][k], At[m][k], acc[ai][bj][m][n], 0, 0, 0); __builtin_amdgcn_s_setprio(0); } while (0)
#define PG8_WAIT_V(n) asm volatile("s_waitcnt vmcnt(" #n ")" ::: "memory")
#define PG8_WAIT_L(n) asm volatile("s_waitcnt lgkmcnt(" #n ")" ::: "memory")
#define PG8_BAR __builtin_amdgcn_s_barrier()
#define PG8_SCHED __builtin_amdgcn_sched_barrier(0)
    Unit cur, nxt; int ui = 0;
    if (!S.next(0, cur)) return;
    f32x4 acc[2][2][4][2];
#pragma unroll
    for (int a = 0; a < 2; ++a)
#pragma unroll
        for (int b = 0; b < 2; ++b)
#pragma unroll
            for (int m = 0; m < 4; ++m)
#pragma unroll
                for (int n = 0; n < 2; ++n) acc[a][b][m][n] = (f32x4){0.f, 0.f, 0.f, 0.f};
    bf16x8 At[4][2], B0[2][2], B1[2][2];
    const char* cA = (const char*)g.A + (size_t)cur.pm * tstepA + S.a_off(cur); const char* cB = (const char*)g.Bt + (size_t)S.b_tile(cur) * tstep;
    S.a_ready(cur);
    if constexpr (SP2) {
        PG8_STAGE(PG8_SB(0, 0), cB, voffB); PG8_STAGE(PG8_SB(0, 1), cB + hstep, voffB); PG8_STAGE(PG8_SA(0, 0), cA, voffA); PG8_STAGE(PG8_SA(0, 1), cA + hstepA, voffA);
        if (wr == 1) PG8_BAR;
        PG8_WAIT_V(2); PG8_BAR;
        PG8_STAGE(PG8_SB(1, 0), cB + kstep, voffB); PG8_STAGE(PG8_SA(1, 0), cA + kstep, voffA); PG8_STAGE(PG8_SB(1, 1), cB + hstep + kstep, voffB);
        PG8_WAIT_V(6); PG8_BAR;
    } else {
        PG8_STAGE(PG8_SB(0, 0), cB, voffB); PG8_STAGE(PG8_SA(0, 0), cA, voffA); PG8_STAGE(PG8_SB(0, 1), cB + hstep, voffB); PG8_STAGE(PG8_SA(0, 1), cA + hstepA, voffA);
        if (wr == 1) PG8_BAR;
        PG8_WAIT_V(4); PG8_BAR;
        PG8_STAGE(PG8_SB(1, 0), cB + kstep, voffB); PG8_STAGE(PG8_SA(1, 0), cA + kstep, voffA); PG8_STAGE(PG8_SB(1, 1), cB + hstep + kstep, voffB);
        PG8_WAIT_V(6); PG8_BAR;
    }
    for (;;) {
        const bool has_next = S.next(ui + 1, nxt);
        const char* nA = has_next ? (const char*)g.A + (size_t)nxt.pm * tstepA + S.a_off(nxt) : cA; const char* nB = has_next ? (const char*)g.Bt + (size_t)S.b_tile(nxt) * tstep : cB;
        for (int t = 0; t < nt; t += 2) {
            const bool last = (t == nt - 2);
            const char* a1 = cA + (size_t)(t + 1) * kstep;
            const char* a2 = last ? nA : cA + (size_t)(t + 2) * kstep; const char* b2 = last ? nB : cB + (size_t)(t + 2) * kstep;
            const char* a3 = a2 + kstep; const char* b3 = b2 + kstep;
            if (last && has_next) S.a_ready(nxt);
            if constexpr (SP2) {
            PG8_LDB(B0, 0, 0); PG8_LDB(B1, 0, 1); PG8_SCHED; PG8_LDA(At, 0, 0); PG8_STAGE(PG8_SA(1, 1), a1 + hstepA, voffA);
            PG8_WAIT_V(8); PG8_WAIT_L(0); PG8_BAR; PG8_MMA(0, 0, At, B0); PG8_MMA(0, 1, At, B1); PG8_BAR; PG8_SCHED;
            PG8_LDA(At, 0, 1); PG8_STAGE(PG8_SB(0, 0), b2, voffB); PG8_STAGE(PG8_SB(0, 1), b2 + hstep, voffB); PG8_STAGE(PG8_SA(0, 0), a2, voffA);
            PG8_WAIT_V(8); PG8_WAIT_L(0); PG8_BAR; PG8_MMA(1, 0, At, B0); PG8_MMA(1, 1, At, B1); PG8_BAR; PG8_SCHED;
            PG8_LDB(B0, 1, 0); PG8_LDB(B1, 1, 1); PG8_SCHED; PG8_LDA(At, 1, 0); PG8_STAGE(PG8_SA(0, 1), a2 + hstepA, voffA);
            PG8_WAIT_V(8); PG8_WAIT_L(0); PG8_BAR; PG8_MMA(0, 0, At, B0); PG8_MMA(0, 1, At, B1); PG8_BAR; PG8_SCHED;
            PG8_LDA(At, 1, 1); PG8_STAGE(PG8_SB(1, 0), b3, voffB); PG8_STAGE(PG8_SB(1, 1), b3 + hstep, voffB); PG8_STAGE(PG8_SA(1, 0), a3, voffA);
            PG8_WAIT_V(8); PG8_WAIT_L(0); PG8_BAR; PG8_MMA(1, 0, At, B0); PG8_MMA(1, 1, At, B1); PG8_BAR; PG8_SCHED;
            } else {
            PG8_LDB(B0, 0, 0); PG8_SCHED; PG8_LDA(At, 0, 0); PG8_STAGE(PG8_SA(1, 1), a1 + hstepA, voffA);
            PG8_WAIT_L(8); PG8_BAR; PG8_WAIT_L(0); PG8_MMA(0, 0, At, B0); PG8_BAR; PG8_SCHED;
            PG8_LDB(B1, 0, 1); PG8_STAGE(PG8_SB(0, 0), b2, voffB);
            PG8_BAR; PG8_WAIT_L(0); PG8_MMA(0, 1, At, B1); PG8_BAR;
            PG8_LDA(At, 0, 1); PG8_STAGE(PG8_SA(0, 0), a2, voffA);
            PG8_BAR; PG8_WAIT_L(0); PG8_MMA(1, 0, At, B0); PG8_BAR; PG8_SCHED;
            PG8_STAGE(PG8_SB(0, 1), b2 + hstep, voffB);
            PG8_WAIT_V(6); PG8_BAR; PG8_MMA(1, 1, At, B1); PG8_BAR;
            PG8_LDB(B0, 1, 0); PG8_SCHED; PG8_LDA(At, 1, 0); PG8_STAGE(PG8_SA(0, 1), a2 + hstepA, voffA);
            PG8_WAIT_L(8); PG8_BAR; PG8_WAIT_L(0); PG8_MMA(0, 0, At, B0); PG8_BAR; PG8_SCHED;
            PG8_LDB(B1, 1, 1); PG8_STAGE(PG8_SB(1, 0), b3, voffB);
            PG8_BAR; PG8_WAIT_L(0); PG8_MMA(0, 1, At, B1); PG8_BAR;
            PG8_LDA(At, 1, 1); PG8_STAGE(PG8_SA(1, 0), a3, voffA);
            PG8_BAR; PG8_WAIT_L(0); PG8_MMA(1, 0, At, B0); PG8_BAR; PG8_SCHED;
            PG8_STAGE(PG8_SB(1, 1), b3 + hstep, voffB);
            PG8_WAIT_V(6); PG8_BAR; PG8_MMA(1, 1, At, B1); PG8_BAR;
            }
        }
        if constexpr (ALIGN_EPI) { if (wr == 0) PG8_BAR; }
        if constexpr (!Epi::AFTER_DRAIN) { E(acc, cur, wr, wc, fr, fq); S.done(cur); }
        if (!has_next) break;
#pragma unroll
        for (int a = 0; a < 2; ++a)
#pragma unroll
            for (int b = 0; b < 2; ++b)
#pragma unroll
                for (int m = 0; m < 4; ++m)
#pragma unroll
                    for (int n = 0; n < 2; ++n) acc[a][b][m][n] = (f32x4){0.f, 0.f, 0.f, 0.f};
        cur = nxt; cA = nA; cB = nB; ++ui;
        if constexpr (ALIGN_EPI) { if (wr == 1) PG8_BAR; }
    }
    PG8_WAIT_V(0);
    if constexpr (!ALIGN_EPI) { if (wr == 0) PG8_BAR; }
    PG8_BAR;
    if constexpr (Epi::AFTER_DRAIN) { E.fused(acc, cur, wr, wc, fr, fq, lds, wid, lane); S.done(cur); }
#undef PG8_SA
#undef PG8_SB
#undef PG8_STAGE
#undef PG8_LDA
#undef PG8_LDB
#undef PG8_MMA
#undef PG8_WAIT_V
#undef PG8_WAIT_L
#undef PG8_BAR
#undef PG8_SCHED
}
}

constexpr int NWAVES = 8, NTHR = 512;
constexpr int M = 16384, SEQ = 8192, D = 1024, FF = 2816, NL = 4, NCH = 128  , NBC = 256  ;
constexpr int NPM = 6656;
constexpr int NWIN = 10752;
constexpr int C_DAQ = 0, C_DAK = 512, C_DAV = 1024, C_GQ = 1536, C_GK = 1792, C_GV = 2048, C_GOG = 2560, C_SZ = 3072, C_SX = 3584, C_SB = 4096, C_SC = 4352,
              C_RR = 4608, C_RK = 5120, C_RV = 5632, C_RWL = 6144, C_RAL = 6208, C_RGL = 6272, C_GLR = 6400, C_SDT = 6416;
constexpr float EPS = 1e-6f, LOG2E = 1.4426950408889634f;

constexpr size_t MiB = 1u << 20;
constexpr size_t WS_CTL = 0, CTL_ZERO_BYTES = 1 * MiB;
constexpr size_t WS_COS = 1 * MiB, WS_SIN = 2 * MiB, WS_SSQ = 3 * MiB, WS_GLAST = 3 * MiB + 512 * 1024, WS_SDT = 4 * MiB, WS_SACUM = 4 * MiB + 512 * 1024, WS_SCDEC = 5 * MiB, WS_RW2T = 5 * MiB + 64 * 1024;
constexpr size_t WS_WGU1 = 8 * MiB, WS_WD1 = 19 * MiB, WS_WIN = 24 * MiB + 512 * 1024, WS_WB = 45 * MiB + 512 * 1024, WS_WO = 49 * MiB + 512 * 1024, WS_WGU2 = 51 * MiB + 512 * 1024, WS_WD2 = 62 * MiB + 512 * 1024;
constexpr size_t WS_HB = 68 * MiB, WS_P = 100 * MiB, WS_PG = 100 * MiB, WS_YS = 308 * MiB, WS_R1 = 372 * MiB, WS_R2 = 500 * MiB, WS_END = 644 * MiB;
constexpr size_t WS_ACT = WS_R1, WS_MERGED = WS_R1;
constexpr size_t WS_RWW = WS_R1, WS_RWR = WS_R1 + 32 * MiB, WS_RWK = WS_R1 + 48 * MiB, WS_RWV = WS_R1 + 64 * MiB, WS_RWKK = WS_R1 + 80 * MiB, WS_RWB = WS_R1 + 96 * MiB, WS_RWG = WS_R1 + 112 * MiB;
constexpr size_t WS_VT = WS_R2, WS_GKV = WS_R2 + 16 * MiB, WS_SST = WS_R2 + 48 * MiB, WS_RWY = WS_R2 + 112 * MiB;
static_assert(WS_WD2 + (size_t)D * FF * 2 <= WS_HB && WS_P + (size_t)M * NPM * 2 <= WS_YS && WS_RWY + (size_t)M * 512 * 2 <= WS_END, "d_ws map");
constexpr int CW_BAR = 4096;

constexpr int RING_BYTES = 131072, LDSCTL_OFF = RING_BYTES, MISC_OFF = LDSCTL_OFF + 320, LDS_BYTES = 147456;

#define GAS __attribute__((address_space(1)))
#define LAS __attribute__((address_space(3)))
typedef unsigned short bf16;
typedef unsigned v4u __attribute__((ext_vector_type(4)));
typedef float f32x4 __attribute__((ext_vector_type(4)));
typedef short bf16x8 __attribute__((ext_vector_type(8)));
typedef GAS unsigned gu32;
typedef GAS unsigned long long gu64;
#define RLX_AGENT __ATOMIC_RELAXED, __HIP_MEMORY_SCOPE_AGENT
#define LDS_WAIT() asm volatile("s_waitcnt lgkmcnt(0)" ::: "memory")
#define VM_WAIT() asm volatile("s_waitcnt vmcnt(0)" ::: "memory")
__device__ __forceinline__ unsigned long long rt() { return __builtin_amdgcn_s_memrealtime(); }
typedef float f32x2_cv __attribute__((ext_vector_type(2))); typedef __bf16 bf16x2_cv __attribute__((ext_vector_type(2)));
__device__ __forceinline__ unsigned pk2(float lo, float hi) { const f32x2_cv v = {lo, hi}; const bf16x2_cv b = __builtin_convertvector(v, bf16x2_cv); return __builtin_bit_cast(unsigned, b); }
__device__ __forceinline__ unsigned f2bf(float f) { return pk2(f, 0.f) & 0xffffu; }

#define XB_TMO      128
#define XB_XCNT(j)  (256  + 64 * (j))
#define XB_XSUB(j)  (1280 + 64 * (j))
#define XB_XGEN(j)  (2304 + 64 * (j))
#define XB_TOP      3328
#define XB_TOPGEN   3392
#define XCD_BAR_WORDS 3456
#define XB_SPIN_CAP (1u << 18)

__device__ __forceinline__ unsigned xb_ld(unsigned* p)              { return __hip_atomic_load(p, __ATOMIC_RELAXED, __HIP_MEMORY_SCOPE_AGENT); }
__device__ __forceinline__ unsigned xb_add(unsigned* p, unsigned v) { return __hip_atomic_fetch_add(p, v, __ATOMIC_RELAXED, __HIP_MEMORY_SCOPE_AGENT); }
__device__ __forceinline__ unsigned xb_xcc_id() { return (unsigned)__builtin_amdgcn_s_getreg((3 << 11) | 20) & 0xFu; }
#define XB_SPIN(cond, bar) do { unsigned _sp = 0; while (cond) { __builtin_amdgcn_s_sleep(1); \
    if ((++_sp & 255u) == 0u) { if (xb_ld(&(bar)[XB_TMO])) break; if (_sp > XB_SPIN_CAP) { atomicAdd(&(bar)[XB_TMO], 1u); break; } } } } while (0)

struct XcdBarrier {
    unsigned* bar; unsigned x;
    volatile LAS unsigned* st;
};

__device__ __forceinline__ XcdBarrier xcd_barrier_post(unsigned* bar, volatile LAS unsigned* st) {
    XcdBarrier b; b.bar = bar; b.x = xb_xcc_id(); b.st = st;
    if (threadIdx.x == 0) (void)xb_add(&bar[XB_XCNT(b.x)], 1u);
    return b;
}
__device__ __forceinline__ void xcd_barrier_complete(unsigned* bar, unsigned x, unsigned& nloc, unsigned& nx) {
    const unsigned G = gridDim.x * gridDim.y * gridDim.z;
    unsigned sum, cnt, mine, sp = 0u;
    for (;;) {
        sum = 0u; cnt = 0u; mine = 0u;
#pragma unroll
        for (unsigned j = 0; j < 16; ++j) { const unsigned c = xb_ld(&bar[XB_XCNT(j)]); sum += c; cnt += (c > 0u) ? 1u : 0u; mine = (j == x) ? c : mine; }
        if (sum == G) break;
        __builtin_amdgcn_s_sleep(1);
        if ((++sp & 255u) == 0u) { if (xb_ld(&bar[XB_TMO])) break; if (sp > XB_SPIN_CAP) { atomicAdd(&bar[XB_TMO], 1u); break; } }
    }
    nloc = mine > 0u ? mine : 1u; nx = cnt > 0u ? cnt : 1u;
}

__device__ __forceinline__ void xcd_barrier(const XcdBarrier& b) {
    asm volatile("s_waitcnt vmcnt(0)" ::: "memory");
    __syncthreads();
    if (threadIdx.x == 0) {
        unsigned* bar = b.bar;
        __builtin_amdgcn_s_waitcnt(0);
        unsigned nloc = b.st[0], nx = b.st[1];
        if (nloc == 0u) { xcd_barrier_complete(bar, b.x, nloc, nx); b.st[0] = nloc; b.st[1] = nx; }
        const unsigned old = xb_add(&bar[XB_XSUB(b.x)], 1u);
        const unsigned gen = old / nloc;
        if (old + 1u == (gen + 1u) * nloc) {
            __builtin_amdgcn_fence(__ATOMIC_RELEASE, "agent");
            asm volatile("s_waitcnt vmcnt(0)" ::: "memory");
            const unsigned og = xb_add(&bar[XB_TOP], 1u);
            const unsigned tg = og / nx;
            if (og + 1u == (tg + 1u) * nx) xb_add(&bar[XB_TOPGEN], 1u);
            else XB_SPIN(xb_ld(&bar[XB_TOPGEN]) == tg, bar);
            __builtin_amdgcn_fence(__ATOMIC_ACQUIRE, "agent");
            xb_add(&bar[XB_XGEN(b.x)], 1u);
            asm volatile("s_waitcnt vmcnt(0)" ::: "memory");
        } else {
            XB_SPIN(xb_ld(&bar[XB_XGEN(b.x)]) == gen, bar);
            __builtin_amdgcn_fence(__ATOMIC_ACQUIRE, "agent");
            asm volatile("s_waitcnt vmcnt(0)" ::: "memory");
        }
    }
    __syncthreads();
}

struct Args { const float* in[40]; float* out; unsigned char* ws; float inv_freq[32]; int g_lo, g_hi; };
struct ArgsD { const GAS float* in[40]; GAS float* out; GAS unsigned char* ws; float inv_freq[32]; int g_lo, g_hi; };
typedef const __attribute__((address_space(4))) ArgsD* ArgsP;
typedef LAS float* LF; typedef const LAS float* CLF;
#ifndef PH_FN
#define PH_FN __device__ __noinline__
#endif
#ifndef PH_HEAVY
#define PH_HEAVY __device__ __forceinline__
#endif
struct Ctx {
    LAS unsigned char* lds;
    GAS unsigned char* ws; GAS float* h;
    int tid, lane, wave, bid, G;
};
typedef unsigned u32x4 __attribute__((ext_vector_type(4)));
typedef unsigned u32x2 __attribute__((ext_vector_type(2)));
typedef float f32x2 __attribute__((ext_vector_type(2)));
typedef float f32x16 __attribute__((ext_vector_type(16)));
__device__ __forceinline__ float bf2f(bf16 x) { return __uint_as_float((unsigned)x << 16); }
__device__ __forceinline__ float bflo(unsigned w) { return __uint_as_float(w << 16); }
__device__ __forceinline__ float bfhi(unsigned w) { return __uint_as_float(w & 0xffff0000u); }
__device__ __forceinline__ void unpack8(const u32x4 w, float* o) { o[0] = bflo(w.x); o[1] = bfhi(w.x); o[2] = bflo(w.y); o[3] = bfhi(w.y); o[4] = bflo(w.z); o[5] = bfhi(w.z); o[6] = bflo(w.w); o[7] = bfhi(w.w); }
__device__ __forceinline__ u32x4 pack8(const float* o) { u32x4 w; w.x = pk2(o[0], o[1]); w.y = pk2(o[2], o[3]); w.z = pk2(o[4], o[5]); w.w = pk2(o[6], o[7]); return w; }
__device__ __forceinline__ float sigmoidf_(float x) { return 1.0f / (1.0f + __expf(-x)); }
__device__ __forceinline__ float siluf_(float x) { return x * sigmoidf_(x); }
__device__ __forceinline__ float softplusf_(float x) { return fmaxf(x, 0.f) + log1pf(__expf(-fabsf(x))); }
__device__ __forceinline__ float logsigmoidf_(float x) { return fminf(x, 0.f) - log1pf(__expf(-fabsf(x))); }
__device__ __forceinline__ float wave_sum(float v) {
#pragma unroll
    for (int o = 1; o < 64; o <<= 1) v += __shfl_xor(v, o);
    return v;
}
#define WG_SYNC() __syncthreads()
__device__ __forceinline__ Ctx fresh(const Ctx& C0) { Ctx C = C0; int t = threadIdx.x; asm volatile("" : "+v"(t)); C.tid = t; C.lane = t & 63; C.wave = __builtin_amdgcn_readfirstlane(t >> 6); return C; }

PH_FN void ph_prologue(const Ctx C, ArgsP a) {
    GAS float* cosT = (GAS float*)(C.ws + WS_COS); GAS float* sinT = (GAS float*)(C.ws + WS_SIN);
    for (int idx = C.bid * NTHR + C.tid; idx < SEQ * 32; idx += C.G * NTHR) {
        const int t = idx >> 5, j = idx & 31;
        const float ang = (float)t * a->inv_freq[j];
        const double rev = (double)ang * 0.15915494309189535;
        const float fr = (float)(rev - floor(rev));
        cosT[idx] = __builtin_amdgcn_cosf(fr); sinT[idx] = __builtin_amdgcn_sinf(fr);
    }
    const GAS float* x = a->in[0]; GAS bf16* hb = (GAS bf16*)(C.ws + WS_HB); GAS float* ssq = (GAS float*)(C.ws + WS_SSQ);
    const int gw = C.bid * NWAVES + C.wave, NGW = C.G * NWAVES;
    for (int m = gw; m < M; m += NGW) {
        const GAS f32x4* xr = (const GAS f32x4*)(x + (size_t)m * D) + C.lane; GAS f32x4* hr = (GAS f32x4*)(C.h + (size_t)m * D) + C.lane;
        GAS unsigned long long* o8 = (GAS unsigned long long*)(hb + (size_t)m * D) + C.lane;
        float s = 0.f;
#pragma unroll
        for (int j = 0; j < 4; ++j) { const f32x4 v = xr[64 * j]; hr[64 * j] = v; s += (v.x * v.x + v.y * v.y) + (v.z * v.z + v.w * v.w);
            o8[64 * j] = (unsigned long long)pk2(v.x, v.y) | ((unsigned long long)pk2(v.z, v.w) << 32); }
        s = wave_sum(s);
        if (C.lane == 0) { ssq[m] = s; ssq[M + m] = 0.f; ssq[2 * M + m] = 0.f; ssq[3 * M + m] = 0.f; }
    }
}

template <class SrcF>
__device__ __forceinline__ void tr_item(const SrcF src, const GAS float* gk, GAS bf16* WT, int K, int kb, int nb, LAS bf16* scr, int lane) {
    const int k0 = 64 * kb, n0 = 64 * nb, kr = lane >> 4, n4 = 4 * (lane & 15);
    const int ld = src.ld(); const long co = src.col(n0 + n4); const bool ok = co >= 0; const GAS float* colp = src.base(n0 + n4) + (ok ? co : 0);
    f32x4 v[16];
#pragma unroll
    for (int i = 0; i < 16; ++i) v[i] = ok ? *(const GAS f32x4*)(colp + (size_t)(k0 + 4 * i + kr) * ld) : (f32x4){0.f, 0.f, 0.f, 0.f};
#pragma unroll
    for (int i = 0; i < 16; ++i) { const int kk = 4 * i + kr; const float g = gk ? gk[k0 + kk] : 1.0f;
#pragma unroll
        for (int e = 0; e < 4; ++e) scr[(n4 + e) * 72 + kk] = (bf16)f2bf(v[i][e] * g); }
    LDS_WAIT(); asm volatile("" ::: "memory");
    const int c = lane & 7;
#pragma unroll
    for (int j = 0; j < 8; ++j) { const int n = (lane >> 3) + 8 * j; *(GAS v4u*)(WT + (size_t)(n0 + n) * K + k0 + 8 * c) = *(const LAS v4u*)(scr + n * 72 + 8 * c); }
    LDS_WAIT(); asm volatile("" ::: "memory");
}
struct SrcGU { const GAS float* wg; const GAS float* wu;
    __device__ __forceinline__ int ld() const { return FF; }
    __device__ __forceinline__ const GAS float* base(int n) const { const uintptr_t sel = (uintptr_t)((n >> 7) & 1); return (const GAS float*)((uintptr_t)wg + sel * ((uintptr_t)wu - (uintptr_t)wg)); }
    __device__ __forceinline__ long col(int n) const { return 128 * (n >> 8) + (n & 127); } };
struct SrcPlain { const GAS float* w; int ldw;
    __device__ __forceinline__ int ld() const { return ldw; }
    __device__ __forceinline__ const GAS float* base(int) const { return w; }
    __device__ __forceinline__ long col(int n) const { return n; } };
struct SrcWin { const GAS float* w;
    __device__ __forceinline__ int ld() const { return 10520; }
    __device__ __forceinline__ const GAS float* base(int) const { return w; }
    __device__ __forceinline__ long col(int n) const {
        int c;
        if (n < 3072) c = n; else if (n < 4608) c = n - 3072 + 3088; else if (n < 6400) c = n - 4608 + 4632; else if (n < 6416) c = n - 6400 + 3072; else if (n < 6424) c = n - 6416 + 4624; else if (n < 6656) c = -1; else c = n - 6656 + 6424;
        return c; } };
PH_FN void ph_weights(const Ctx C, ArgsP a, int l) {
    LAS bf16* scr = (LAS bf16*)(C.lds + C.wave * 16384);
    const int gw = C.bid * NWAVES + C.wave, NGW = C.G * NWAVES; int rot = 0;
#define W_FIRST(cnt) ({ const int f_ = (gw + NGW - rot % NGW) % NGW; rot += (cnt); f_; })
#pragma unroll 1
    for (int f = 0; f < 2; ++f) {
        const GAS float* nrm = a->in[f ? 35 : 1] + (size_t)l * D; const GAS float* wg = a->in[f ? 36 : 2] + (size_t)l * D * FF; const GAS float* wu = a->in[f ? 37 : 3] + (size_t)l * D * FF; const GAS float* wd = a->in[f ? 38 : 4] + (size_t)l * FF * D;
        GAS bf16* Wgu = (GAS bf16*)(C.ws + (f ? WS_WGU2 : WS_WGU1)); GAS bf16* Wd = (GAS bf16*)(C.ws + (f ? WS_WD2 : WS_WD1));
        const SrcGU sgu{wg, wu};
        for (int it = W_FIRST((D / 64) * (2 * FF / 64)); it < (D / 64) * (2 * FF / 64); it += NGW) tr_item(sgu, nrm, Wgu, D, it / (2 * FF / 64), it % (2 * FF / 64), scr, C.lane);
        const SrcPlain sd{wd, D};
        for (int it = W_FIRST((FF / 64) * (D / 64)); it < (FF / 64) * (D / 64); it += NGW) tr_item(sd, nullptr, Wd, FF, it / (D / 64), it % (D / 64), scr, C.lane);
    }
    { const SrcWin sw{a->in[6] + (size_t)l * D * 10520}; const GAS float* nrm = a->in[5] + (size_t)l * D; GAS bf16* Win = (GAS bf16*)(C.ws + WS_WIN);
      for (int it = W_FIRST((D / 64) * (NWIN / 64)); it < (D / 64) * (NWIN / 64); it += NGW) tr_item(sw, nrm, Win, D, it / (NWIN / 64), it % (NWIN / 64), scr, C.lane); }
    { GAS bf16* Wb = (GAS bf16*)(C.ws + WS_WB);
      for (int it = W_FIRST(4 * (512 / 64) * (D / 64)); it < 4 * (512 / 64) * (D / 64); it += NGW) { const int z = it / ((512 / 64) * (D / 64)), r = it % ((512 / 64) * (D / 64));
          const SrcPlain sb{a->in[32] + ((size_t)l * 4 + z) * 512 * D, D}; tr_item(sb, nullptr, Wb + (size_t)z * D * 512, 512, r / (D / 64), r % (D / 64), scr, C.lane); } }
    { GAS bf16* W2T = (GAS bf16*)(C.ws + WS_RW2T); GAS bf16* A2T = W2T + 512 * 64; GAS bf16* G2T = A2T + 512 * 64;
      const SrcPlain s1{a->in[23] + (size_t)l * 64 * 512, 512}, s2{a->in[25] + (size_t)l * 64 * 512, 512}, s3{a->in[26] + (size_t)l * 128 * 512, 512};
      for (int it = W_FIRST(8); it < 8; it += NGW) tr_item(s1, nullptr, W2T, 64, 0, it, scr, C.lane);
      for (int it = W_FIRST(8); it < 8; it += NGW) tr_item(s2, nullptr, A2T, 64, 0, it, scr, C.lane);
      for (int it = W_FIRST(16); it < 16; it += NGW) tr_item(s3, nullptr, G2T, 128, it >> 3, it & 7, scr, C.lane); }
    { const SrcPlain so{a->in[34] + (size_t)l * D * D, D}; GAS bf16* Wo = (GAS bf16*)(C.ws + WS_WO);
      for (int it = W_FIRST((D / 64) * (D / 64)); it < (D / 64) * (D / 64); it += NGW) tr_item(so, nullptr, Wo, D, it / (D / 64), it % (D / 64), scr, C.lane); }
}

#undef W_FIRST
PH_FN void ph_da_prep(const Ctx C) {
    GAS bf16* P = (GAS bf16*)(C.ws + WS_P); const GAS float* cosT = (const GAS float*)(C.ws + WS_COS); const GAS float* sinT = (const GAS float*)(C.ws + WS_SIN);
    const int gw = C.bid * NWAVES + C.wave, NGW = C.G * NWAVES;
    const int hc = C.lane >> 2, ch = C.lane & 3;
    const float sc = (hc < 8) ? 0.125f * LOG2E : 1.0f;
    for (int m = gw; m < M; m += NGW) {
        const int t = m & (SEQ - 1);
        GAS bf16* p1 = P + (size_t)m * NPM + hc * 64 + ch * 8; GAS bf16* p2 = p1 + 32;
        float x1[8], x2[8], o1[8], o2[8];
        unpack8(*(const GAS u32x4*)p1, x1); unpack8(*(const GAS u32x4*)p2, x2);
        const GAS float* cp = cosT + t * 32 + ch * 8; const GAS float* sp = sinT + t * 32 + ch * 8;
#pragma unroll
        for (int i = 0; i < 8; ++i) { const float c = cp[i], s = sp[i]; o1[i] = (x1[i] * c - x2[i] * s) * sc; o2[i] = (x2[i] * c + x1[i] * s) * sc; }
        *(GAS u32x4*)p1 = pack8(o1); *(GAS u32x4*)p2 = pack8(o2);
    }
    GAS bf16* VT = (GAS bf16*)(C.ws + WS_VT); LAS bf16* tile = (LAS bf16*)C.lds;
    for (int it = C.bid; it < 2 * NCH * 4; it += C.G) {
        const int h = it & 3, bc = it >> 2, b = bc >> 7, tb = bc & 127; const size_t row0 = (size_t)bc * 64;
        WG_SYNC();
#pragma unroll
        for (int i = 0; i < 2; ++i) { const int q = C.tid + NTHR * i, t = q >> 4, c16 = q & 15;
            *(LAS u32x4*)(tile + t * 136 + c16 * 8) = *(const GAS u32x4*)(P + (row0 + t) * NPM + C_DAV + h * 128 + c16 * 8); }
        WG_SYNC();
#pragma unroll
        for (int i = 0; i < 2; ++i) { const int q = C.tid + NTHR * i, d = q >> 3, tc = q & 7; unsigned w[4];
#pragma unroll
            for (int e = 0; e < 4; ++e) w[e] = (unsigned)tile[(8 * tc + 2 * e) * 136 + d] | ((unsigned)tile[(8 * tc + 2 * e + 1) * 136 + d] << 16);
            u32x4 o; o.x = w[0]; o.y = w[1]; o.z = w[2]; o.w = w[3];
            *(GAS u32x4*)(VT + ((size_t)(b * 4 + h) * 128 + d) * SEQ + tb * 64 + 8 * tc) = o; }
    }
    WG_SYNC();
}

typedef LAS bf16* LB; typedef const LAS bf16* CLB;
__device__ __forceinline__ pg8::bf16x8 frag32(CLB X, int ld, int row0, int k0, int lane) { return *(const LAS pg8::bf16x8*)(X + (row0 + (lane & 31)) * ld + k0 + 8 * (lane >> 5)); }
template <int K> __device__ __forceinline__ void mma_nt(f32x16& acc, CLB A, int lda, int m0, CLB Bt, int ldb, int n0, int lane) {
#pragma unroll
    for (int k = 0; k < K; k += 16) acc = __builtin_amdgcn_mfma_f32_32x32x16_bf16(frag32(A, lda, m0, k, lane), frag32(Bt, ldb, n0, k, lane), acc, 0, 0, 0);
}
__device__ __forceinline__ int crow(int r, int hi) { return (r & 3) + 8 * (r >> 2) + 4 * hi; }
__device__ __forceinline__ f32x16 zero16() { f32x16 z;
#pragma unroll
    for (int r = 0; r < 16; ++r) z[r] = 0.f;
    return z; }

__device__ __forceinline__ void gla_compute_G(const Ctx& C, ArgsP a, int l, int bc, int h, LF Gs) {
    const GAS bf16* P = (const GAS bf16*)(C.ws + WS_P); const GAS float* W2 = a->in[12] + (size_t)l * 16 * 256; const GAS float* gb = a->in[13] + (size_t)l * 256;
    const int t = C.tid >> 3, kg = C.tid & 7; const size_t row = (size_t)bc * 64 + t;
    float glr[16]; unpack8(*(const GAS u32x4*)(P + row * NPM + C_GLR), glr); unpack8(*(const GAS u32x4*)(P + row * NPM + C_GLR + 8), glr + 8);
#pragma unroll
    for (int i = 0; i < 8; ++i) { const int k = h * 64 + kg * 8 + i; float x = gb[k];
#pragma unroll
        for (int r = 0; r < 16; ++r) x += glr[r] * W2[r * 256 + k];
        Gs[t * 68 + kg * 8 + i] = logsigmoidf_(x) * (1.0f / 16.0f); }
    WG_SYNC();
    { const int seg = C.tid >> 6, k = C.tid & 63; float run = 0.f;
#pragma unroll
      for (int i = 0; i < 8; ++i) { run += Gs[(8 * seg + i) * 68 + k]; Gs[(8 * seg + i) * 68 + k] = run; }
      WG_SYNC();
      float off = 0.f;
#pragma unroll
      for (int sg = 0; sg < 7; ++sg) { const float tot = Gs[(8 * sg + 7) * 68 + k]; off += (sg < seg) ? tot : 0.f; }
      WG_SYNC();
#pragma unroll
      for (int i = 0; i < 8; ++i) Gs[(8 * seg + i) * 68 + k] += off; }
    WG_SYNC();
}
PH_HEAVY void ph_gla_a(const Ctx C, ArgsP a, int l) {
    const GAS bf16* P = (const GAS bf16*)(C.ws + WS_P); GAS float* GKV = (GAS float*)(C.ws + WS_GKV); GAS float* GL = (GAS float*)(C.ws + WS_GLAST);
    LF Gs = (LF)C.lds; LB KDT = (LB)(C.lds + 17408); LB VT = (LB)(C.lds + 26624);
    for (int it = C.bid; it < NBC * 4; it += C.G) {
        const int bc = it >> 2, h = it & 3;
        WG_SYNC();
        gla_compute_G(C, a, l, bc, h, Gs);
        { const int t = C.tid >> 3, g8 = C.tid & 7; const size_t row = (size_t)bc * 64 + t;
          float kf[8]; unpack8(*(const GAS u32x4*)(P + row * NPM + C_GK + h * 64 + g8 * 8), kf);
#pragma unroll
          for (int i = 0; i < 8; ++i) { const int k = g8 * 8 + i; KDT[k * 72 + t] = (bf16)f2bf(kf[i] * __expf(Gs[63 * 68 + k] - Gs[t * 68 + k])); }
          const u32x4 v0 = *(const GAS u32x4*)(P + row * NPM + C_GV + h * 128 + g8 * 16), v1 = *(const GAS u32x4*)(P + row * NPM + C_GV + h * 128 + g8 * 16 + 8);
          const unsigned vw[8] = {v0.x, v0.y, v0.z, v0.w, v1.x, v1.y, v1.z, v1.w};
#pragma unroll
          for (int i = 0; i < 8; ++i) { VT[(g8 * 16 + 2 * i) * 72 + t] = (bf16)(vw[i] & 0xffffu); VT[(g8 * 16 + 2 * i + 1) * 72 + t] = (bf16)(vw[i] >> 16); }
          if (C.tid < 64) GL[(size_t)it * 64 + C.tid] = Gs[63 * 68 + C.tid]; }
        WG_SYNC();
        { const int kt = C.wave >> 2, vt = C.wave & 3, n = C.lane & 31, hi = C.lane >> 5;
          f32x16 acc = zero16(); mma_nt<64>(acc, KDT, 72, 32 * kt, VT, 72, 32 * vt, C.lane);
          GAS float* dst = GKV + ((size_t)it * 128 + 32 * vt + n) * 64 + 32 * kt + 4 * hi;
#pragma unroll
          for (int g = 0; g < 4; ++g) *(GAS f32x4*)(dst + 8 * g) = (f32x4){acc[4 * g], acc[4 * g + 1], acc[4 * g + 2], acc[4 * g + 3]}; }
    }
    WG_SYNC();
}
PH_FN void gla_scan_part(const Ctx C, int part) {
    GAS float* GKV = (GAS float*)(C.ws + WS_GKV); const GAS float* GL = (const GAS float*)(C.ws + WS_GLAST);
    const int e = part * NTHR + C.tid, chain = e >> 13, idx = e & 8191, b = chain >> 2, h = chain & 3, k = idx & 63;
    float st = 0.f;
#pragma unroll 1
    for (int c0 = 0; c0 < NCH; c0 += 16) {
        float tmp[16], dec[16];
#pragma unroll
        for (int i = 0; i < 16; ++i) { const size_t item = (size_t)(b * NCH + c0 + i) * 4 + h; tmp[i] = GKV[item * 8192 + idx]; dec[i] = GL[item * 64 + k]; }
#pragma unroll
        for (int i = 0; i < 16; ++i) { const size_t item = (size_t)(b * NCH + c0 + i) * 4 + h; GKV[item * 8192 + idx] = st; st = __expf(dec[i]) * st + tmp[i]; }
    }
}
PH_HEAVY void ph_gla_c(const Ctx C, ArgsP a, int l) {
    const GAS bf16* P = (const GAS bf16*)(C.ws + WS_P); const GAS float* GKV = (const GAS float*)(C.ws + WS_GKV); GAS bf16* YS = (GAS bf16*)(C.ws + WS_YS);
    const GAS float* gnorm = a->in[14] + (size_t)l * 128;
    LF Gs = (LF)C.lds; LB QD = (LB)(C.lds + 17408); LB KDR = (LB)(C.lds + 26624); LB QI = (LB)(C.lds + 35840); LB ATT = (LB)(C.lds + 45056); LB VT = (LB)(C.lds + 54272); LB ST = (LB)(C.lds + 72704); LF PS = (LF)(C.lds + 91136);
    for (int it = C.bid; it < NBC * 4; it += C.G) {
        const int bc = it >> 2, h = it & 3;
        WG_SYNC();
        gla_compute_G(C, a, l, bc, h, Gs);
        { const int t = C.tid >> 3, g8 = C.tid & 7; const size_t row = (size_t)bc * 64 + t;
          float qf[8], kf[8], o1[8], o2[8], o3[8];
          unpack8(*(const GAS u32x4*)(P + row * NPM + C_GQ + h * 64 + g8 * 8), qf); unpack8(*(const GAS u32x4*)(P + row * NPM + C_GK + h * 64 + g8 * 8), kf);
#pragma unroll
          for (int i = 0; i < 8; ++i) { const int k = g8 * 8 + i; const float g = Gs[t * 68 + k], d = g - Gs[32 * 68 + k]; o1[i] = qf[i] * 0.125f * __expf(d); o2[i] = kf[i] * __expf(-d); o3[i] = qf[i] * 0.125f * __expf(g); }
          *(LAS u32x4*)(QD + t * 72 + g8 * 8) = pack8(o1); *(LAS u32x4*)(KDR + t * 72 + g8 * 8) = pack8(o2); *(LAS u32x4*)(QI + t * 72 + g8 * 8) = pack8(o3);
          const u32x4 v0 = *(const GAS u32x4*)(P + row * NPM + C_GV + h * 128 + g8 * 16), v1 = *(const GAS u32x4*)(P + row * NPM + C_GV + h * 128 + g8 * 16 + 8);
          const unsigned vw[8] = {v0.x, v0.y, v0.z, v0.w, v1.x, v1.y, v1.z, v1.w};
#pragma unroll
          for (int i = 0; i < 8; ++i) { VT[(g8 * 16 + 2 * i) * 72 + t] = (bf16)(vw[i] & 0xffffu); VT[(g8 * 16 + 2 * i + 1) * 72 + t] = (bf16)(vw[i] >> 16); }
          const int v = C.tid >> 2, kq = (C.tid & 3) * 16; const GAS float* sp = GKV + ((size_t)it * 128 + v) * 64 + kq;
          float s[16];
#pragma unroll
          for (int i = 0; i < 4; ++i) { const f32x4 x = *(const GAS f32x4*)(sp + 4 * i); s[4 * i] = x[0]; s[4 * i + 1] = x[1]; s[4 * i + 2] = x[2]; s[4 * i + 3] = x[3]; }
          *(LAS u32x4*)(ST + v * 72 + kq) = pack8(s); *(LAS u32x4*)(ST + v * 72 + kq + 8) = pack8(s + 8); }
        WG_SYNC();
        const int n = C.lane & 31, hi = C.lane >> 5;
        if (C.wave < 4) {
            const int it_ = C.wave >> 1, jt = C.wave & 1;
            f32x16 acc = zero16();
            if (jt <= it_) mma_nt<64>(acc, QD, 72, 32 * it_, KDR, 72, 32 * jt, C.lane);
#pragma unroll
            for (int r = 0; r < 16; ++r) { const int i = 32 * it_ + crow(r, hi), j = 32 * jt + n; ATT[i * 72 + j] = (bf16)f2bf(j <= i ? acc[r] : 0.f); }
        }
        WG_SYNC();
        {
            const int it_ = C.wave & 1, vt = C.wave >> 1;
            f32x16 acc = zero16();
            mma_nt<64>(acc, VT, 72, 32 * vt, ATT, 72, 32 * it_, C.lane);
            mma_nt<64>(acc, ST, 72, 32 * vt, QI, 72, 32 * it_, C.lane);
            float ss = 0.f;
#pragma unroll
            for (int r = 0; r < 16; ++r) ss += acc[r] * acc[r];
            ss += __shfl_xor(ss, 32);
            if (hi == 0) PS[(32 * it_ + n) * 4 + vt] = ss;
            WG_SYNC();
            const int i = 32 * it_ + n; const float tot = (PS[i * 4] + PS[i * 4 + 1]) + (PS[i * 4 + 2] + PS[i * 4 + 3]);
            const float rs = 1.0f / sqrtf(tot * (1.0f / 128.0f) + EPS); const size_t row = (size_t)bc * 64 + i;
#pragma unroll
            for (int g = 0; g < 4; ++g) { const int v0 = 32 * vt + 8 * g + 4 * hi;
                const u32x2 ogw = *(const GAS u32x2*)(P + row * NPM + C_GOG + h * 128 + v0); const f32x4 gn = *(const GAS f32x4*)(gnorm + v0);
                const float og[4] = {bflo(ogw.x), bfhi(ogw.x), bflo(ogw.y), bfhi(ogw.y)}; float o4[4];
#pragma unroll
                for (int y = 0; y < 4; ++y) o4[y] = acc[4 * g + y] * rs * gn[y] * siluf_(og[y]);
                u32x2 w; w.x = pk2(o4[0], o4[1]); w.y = pk2(o4[2], o4[3]); *(GAS u32x2*)(YS + row * 2048 + 512 + h * 128 + v0) = w; }
        }
    }
    WG_SYNC();
}

__device__ __forceinline__ void ssd_conv8(const GAS bf16* P, const GAS float* cw, const GAS float* cb, int bc, int t, int ch0, float* o) {
    const int pos = (bc & 127) * 64 + t; const size_t row = (size_t)bc * 64 + t;
#pragma unroll
    for (int i = 0; i < 8; ++i) o[i] = cb[ch0 + i];
#pragma unroll
    for (int tap = 0; tap < 4; ++tap) { if (pos - 3 + tap >= 0) { float x[8]; unpack8(*(const GAS u32x4*)(P + (row - 3 + tap) * NPM + C_SX + ch0), x);
#pragma unroll
        for (int i = 0; i < 8; ++i) o[i] += cw[tap * 1024 + ch0 + i] * x[i]; } }
#pragma unroll
    for (int i = 0; i < 8; ++i) o[i] = siluf_(o[i]);
}
PH_HEAVY void ph_ssd_a(const Ctx C, ArgsP a, int l) {
    const GAS bf16* P = (const GAS bf16*)(C.ws + WS_P); GAS float* SST = (GAS float*)(C.ws + WS_SST); GAS float* SDT = (GAS float*)(C.ws + WS_SDT); GAS float* SAC = (GAS float*)(C.ws + WS_SACUM); GAS float* SCD = (GAS float*)(C.ws + WS_SCDEC);
    const GAS float* cw = a->in[15] + (size_t)l * 4 * 1024; const GAS float* cb = a->in[16] + (size_t)l * 1024; const GAS float* dtb = a->in[17] + (size_t)l * 8; const GAS float* alog = a->in[18] + (size_t)l * 8;
    LB BT = (LB)C.lds; LB XDT = (LB)(C.lds + 18432); LF dtv = (LF)(C.lds + 27648); LF acu = (LF)(C.lds + 27904); LF av = (LF)(C.lds + 28160);
    for (int it = C.bid; it < NBC * 2; it += C.G) {
        const int bc = it >> 1, g = it & 1; const int t = C.tid >> 3, cg = C.tid & 7;
        WG_SYNC();
        { float o[8];
#pragma unroll
          for (int half = 0; half < 2; ++half) { ssd_conv8(P, cw, cb, bc, t, 512 + g * 128 + cg * 16 + half * 8, o);
#pragma unroll
              for (int i = 0; i < 8; ++i) BT[(cg * 16 + half * 8 + i) * 72 + t] = (bf16)f2bf(o[i]); } }
#pragma unroll 1
        for (int hh = 0; hh < 4; ++hh) {
            const int hd = 4 * g + hh; const size_t item8 = (size_t)bc * 8 + hd;
            WG_SYNC();
            if (C.tid < 64) { const size_t row = (size_t)bc * 64 + C.tid; const float dt = softplusf_(bf2f(P[row * NPM + C_SDT + hd]) + dtb[hd]); dtv[C.tid] = dt; av[C.tid] = -__expf(alog[hd]) * dt; }
            WG_SYNC();
            if (C.tid < 64) { float s = av[C.tid];
#pragma unroll
                for (int o = 1; o < 64; o <<= 1) { const float nb_ = __shfl_up(s, o); if (C.lane >= o) s += nb_; }
                acu[C.tid] = s; const size_t row = (size_t)bc * 64 + C.tid; SDT[row * 8 + hd] = dtv[C.tid]; SAC[row * 8 + hd] = s; if (C.tid == 63) SCD[item8] = __expf(s); }
            WG_SYNC();
            { float o[8]; ssd_conv8(P, cw, cb, bc, t, hd * 64 + cg * 8, o); const float sc = dtv[t] * __expf(acu[63] - acu[t]);
#pragma unroll
              for (int i = 0; i < 8; ++i) XDT[(cg * 8 + i) * 72 + t] = (bf16)f2bf(o[i] * sc); }
            WG_SYNC();
            { const int pt = C.wave >> 2, nt = C.wave & 3, n = C.lane & 31, hi = C.lane >> 5;
              f32x16 acc = zero16(); mma_nt<64>(acc, XDT, 72, 32 * pt, BT, 72, 32 * nt, C.lane);
#pragma unroll
              for (int r = 0; r < 16; ++r) SST[(item8 * 64 + 32 * pt + crow(r, hi)) * 128 + 32 * nt + n] = acc[r]; }
        }
    }
    WG_SYNC();
}
PH_FN void ssd_scan_part(const Ctx C, int part) {
    GAS float* SST = (GAS float*)(C.ws + WS_SST); const GAS float* SCD = (const GAS float*)(C.ws + WS_SCDEC);
    const int e = part * NTHR + C.tid, chain = e >> 13, idx = e & 8191, b = chain >> 3, hd = chain & 7;
    float st = 0.f;
#pragma unroll 1
    for (int c0 = 0; c0 < NCH; c0 += 16) {
        float tmp[16], dec[16];
#pragma unroll
        for (int i = 0; i < 16; ++i) { const size_t item = (size_t)(b * NCH + c0 + i) * 8 + hd; tmp[i] = SST[item * 8192 + idx]; dec[i] = SCD[item]; }
#pragma unroll
        for (int i = 0; i < 16; ++i) { const size_t item = (size_t)(b * NCH + c0 + i) * 8 + hd; SST[item * 8192 + idx] = st; st = dec[i] * st + tmp[i]; }
    }
}
PH_HEAVY void ph_ssd_c(const Ctx C, ArgsP a, int l) {
    const GAS bf16* P = (const GAS bf16*)(C.ws + WS_P); const GAS float* SST = (const GAS float*)(C.ws + WS_SST); const GAS float* SDT = (const GAS float*)(C.ws + WS_SDT); const GAS float* SAC = (const GAS float*)(C.ws + WS_SACUM); GAS bf16* YS = (GAS bf16*)(C.ws + WS_YS);
    const GAS float* cw = a->in[15] + (size_t)l * 4 * 1024; const GAS float* cb = a->in[16] + (size_t)l * 1024; const GAS float* dpar = a->in[19] + (size_t)l * 8; const GAS float* snorm = a->in[20] + (size_t)l * 512;
    LB BN = (LB)C.lds; LB CN = (LB)(C.lds + 17408); LF CB = (LF)(C.lds + 34816); LB SC = (LB)(C.lds + 52224); LB XST = (LB)(C.lds + 61440); LB HP = (LB)(C.lds + 70656); LB CE = (LB)(C.lds + 88064);
    LF dtv = (LF)(C.lds + 105472); LF acu = (LF)(C.lds + 105728); LF PSQ = (LF)(C.lds + 105984);
    for (int it = C.bid; it < NBC * 2; it += C.G) {
        const int bc = it >> 1, g = it & 1;
        const int t = C.tid >> 3, cg = C.tid & 7, n = C.lane & 31, hi = C.lane >> 5;
        WG_SYNC();
        { float o[8];
#pragma unroll
          for (int half = 0; half < 2; ++half) {
              ssd_conv8(P, cw, cb, bc, t, 512 + g * 128 + cg * 16 + half * 8, o); *(LAS u32x4*)(BN + t * 136 + cg * 16 + half * 8) = pack8(o);
              ssd_conv8(P, cw, cb, bc, t, 768 + g * 128 + cg * 16 + half * 8, o); *(LAS u32x4*)(CN + t * 136 + cg * 16 + half * 8) = pack8(o); } }
        WG_SYNC();
        if (C.wave < 4) {
            const int it_ = C.wave >> 1, jt = C.wave & 1;
            f32x16 acc = zero16(); mma_nt<128>(acc, CN, 136, 32 * it_, BN, 136, 32 * jt, C.lane);
#pragma unroll
            for (int r = 0; r < 16; ++r) CB[(32 * it_ + crow(r, hi)) * 68 + 32 * jt + n] = acc[r];
        }
        float yk[4][16]; float ssq = 0.f;
        const int pt = (C.wave >> 1) & 1, it2 = C.wave & 1;
#pragma unroll
        for (int hh = 0; hh < 4; ++hh) {
            const int hd = 4 * g + hh; const size_t item8 = (size_t)bc * 8 + hd;
            WG_SYNC();
            if (C.tid < 64) { const size_t row = (size_t)bc * 64 + C.tid; dtv[C.tid] = SDT[row * 8 + hd]; acu[C.tid] = SAC[row * 8 + hd]; }
            { float o[8]; ssd_conv8(P, cw, cb, bc, t, hd * 64 + cg * 8, o);
#pragma unroll
              for (int i = 0; i < 8; ++i) XST[(cg * 8 + i) * 72 + t] = (bf16)f2bf(o[i]);
              const int p = C.tid >> 3, n0 = (C.tid & 7) * 16; const GAS float* sp = SST + (item8 * 64 + p) * 128 + n0; float s[16];
#pragma unroll
              for (int i = 0; i < 4; ++i) { const f32x4 x = *(const GAS f32x4*)(sp + 4 * i); s[4 * i] = x[0]; s[4 * i + 1] = x[1]; s[4 * i + 2] = x[2]; s[4 * i + 3] = x[3]; }
              *(LAS u32x4*)(HP + p * 136 + n0) = pack8(s); *(LAS u32x4*)(HP + p * 136 + n0 + 8) = pack8(s + 8); }
            WG_SYNC();
            { const float ai = acu[t]; float o[8];
#pragma unroll
              for (int jj = 0; jj < 8; ++jj) { const int j = 8 * cg + jj; o[jj] = (j <= t) ? CB[t * 68 + j] * __expf(ai - acu[j]) * dtv[j] : 0.f; }
              *(LAS u32x4*)(SC + t * 72 + 8 * cg) = pack8(o);
              const float ea = __expf(ai); float c8[8];
#pragma unroll
              for (int half = 0; half < 2; ++half) { unpack8(*(const LAS u32x4*)(CN + t * 136 + cg * 16 + half * 8), c8);
#pragma unroll
                  for (int i = 0; i < 8; ++i) c8[i] *= ea;
                  *(LAS u32x4*)(CE + t * 136 + cg * 16 + half * 8) = pack8(c8); } }
            WG_SYNC();
            if (C.wave < 4) {
                f32x16 acc = zero16();
                mma_nt<64>(acc, XST, 72, 32 * pt, SC, 72, 32 * it2, C.lane);
                mma_nt<128>(acc, HP, 136, 32 * pt, CE, 136, 32 * it2, C.lane);
                const int i = 32 * it2 + n; const size_t row = (size_t)bc * 64 + i; const float dh = dpar[hd];
#pragma unroll
                for (int q4 = 0; q4 < 4; ++q4) { const int p0 = 32 * pt + 8 * q4 + 4 * hi;
                    const u32x2 zw = *(const GAS u32x2*)(P + row * NPM + C_SZ + hd * 64 + p0); const float zf[4] = {bflo(zw.x), bfhi(zw.x), bflo(zw.y), bfhi(zw.y)};
#pragma unroll
                    for (int e = 0; e < 4; ++e) { const float xs = bf2f(XST[(p0 + e) * 72 + i]); const float v = (acc[4 * q4 + e] + dh * xs) * siluf_(zf[e]); yk[hh][4 * q4 + e] = v; ssq += v * v; } }
            }
        }
        if (C.wave < 4) { ssq += __shfl_xor(ssq, 32); if (hi == 0) PSQ[(32 * it2 + n) * 2 + pt] = ssq; }
        WG_SYNC();
        if (C.wave < 4) {
            const int i = 32 * it2 + n; const float rs = 1.0f / sqrtf((PSQ[i * 2] + PSQ[i * 2 + 1]) * (1.0f / 256.0f) + EPS); const size_t row = (size_t)bc * 64 + i;
#pragma unroll
            for (int hh = 0; hh < 4; ++hh)
#pragma unroll
                for (int q4 = 0; q4 < 4; ++q4) { const int ch = g * 256 + hh * 64 + 32 * pt + 8 * q4 + 4 * hi; const f32x4 sn = *(const GAS f32x4*)(snorm + ch);
                    u32x2 w; w.x = pk2(yk[hh][4 * q4] * rs * sn[0], yk[hh][4 * q4 + 1] * rs * sn[1]); w.y = pk2(yk[hh][4 * q4 + 2] * rs * sn[2], yk[hh][4 * q4 + 3] * rs * sn[3]);
                    *(GAS u32x2*)(YS + row * 2048 + 1024 + ch) = w; }
        }
    }
    WG_SYNC();
}

#ifndef RW_CHUNKED
#define RW_CHUNKED 1
#endif
__device__ __forceinline__ void rw_lerp8(const GAS bf16* P, const GAS float* mu, int bc, int t, int c0, float* o) {
    const size_t row = (size_t)bc * 64 + t; const bool first = ((bc & 127) == 0) && (t == 0);
    float x[8], xp[8]; unpack8(*(const GAS u32x4*)(P + row * NPM + C_RR + c0), x);
    if (!first) unpack8(*(const GAS u32x4*)(P + (row - 1) * NPM + C_RR + c0), xp); else {
#pragma unroll
        for (int i = 0; i < 8; ++i) xp[i] = 0.f; }
#pragma unroll
    for (int i = 0; i < 8; ++i) o[i] = x[i] + (xp[i] - x[i]) * mu[c0 + i];
}
__device__ __forceinline__ void rw_lerp4(const GAS bf16* P, const GAS float* mu, size_t row, bool first, int c0, float* o) {
    const u32x2 xw = *(const GAS u32x2*)(P + row * NPM + C_RR + c0); const float x[4] = {bflo(xw.x), bfhi(xw.x), bflo(xw.y), bfhi(xw.y)};
    float xp[4] = {0.f, 0.f, 0.f, 0.f};
    if (!first) { const u32x2 pw = *(const GAS u32x2*)(P + (row - 1) * NPM + C_RR + c0); xp[0] = bflo(pw.x); xp[1] = bfhi(pw.x); xp[2] = bflo(pw.y); xp[3] = bfhi(pw.y); }
    const f32x4 m = *(const GAS f32x4*)(mu + c0);
#pragma unroll
    for (int i = 0; i < 4; ++i) o[i] = x[i] + (xp[i] - x[i]) * m[i];
}
#define RW_WFRAG(WT_, K_, nt_, s_) (*(const GAS pg8::bf16x8*)((WT_) + (size_t)(head * 64 + 32 * (nt_) + n) * (K_) + 16 * (s_) + 8 * hi))
#define RWP_PTRS \
    const GAS bf16* P = (const GAS bf16*)(C.ws + WS_P); \
    GAS float* RWW = (GAS float*)(C.ws + WS_RWW); GAS bf16* RWR = (GAS bf16*)(C.ws + WS_RWR); GAS bf16* RWK = (GAS bf16*)(C.ws + WS_RWK); GAS bf16* RWV = (GAS bf16*)(C.ws + WS_RWV); GAS bf16* RWKK = (GAS bf16*)(C.ws + WS_RWKK); GAS bf16* RWB = (GAS bf16*)(C.ws + WS_RWB); GAS bf16* RWG = (GAS bf16*)(C.ws + WS_RWG); \
    const GAS bf16* W2T = (const GAS bf16*)(C.ws + WS_RW2T); const GAS bf16* A2T = W2T + 512 * 64; const GAS bf16* G2T = A2T + 512 * 64;       \
    const GAS float* mu = a->in[21] + (size_t)l * 1792; const GAS float* w0 = a->in[22] + (size_t)l * 512; const GAS float* a0 = a->in[24] + (size_t)l * 512; \
    const GAS float* k_k = a->in[27] + (size_t)l * 512; const GAS float* k_a = a->in[28] + (size_t)l * 512; \
    LB WLb = (LB)C.lds; LB ALb = (LB)(C.lds + 9216); LB GLb = (LB)(C.lds + 18432);         \
    LB KX = (LB)(C.lds + 35840); LF w0s = (LF)(C.lds + 102400); LF a0s = w0s + 512; LF kks = a0s + 512; LF kas = kks + 512; LF INVs = kas + 512;     \
    (void)KX; (void)w0s; (void)a0s; (void)kks; (void)kas; (void)INVs; \
    (void)P; (void)RWW; (void)RWR; (void)RWK; (void)RWV; (void)RWKK; (void)RWB; (void)RWG; (void)W2T; (void)A2T; (void)G2T; (void)mu; (void)w0; (void)a0; (void)k_k; (void)k_a; (void)WLb; (void)ALb; (void)GLb;
#define RWP_LANE const int head = C.wave, n = C.lane & 31, hi = C.lane >> 5; const size_t row0 = (size_t)bc * 64 + 32 * tt; (void)row0;
PH_FN void rwp_stage(const Ctx C, ArgsP a, int l, int bc) {
    RWP_PTRS
    WG_SYNC();
    { const int t = C.tid >> 3, cg = C.tid & 7; float o[8];
      rw_lerp8(P, mu, bc, t, 1536 + cg * 8, o);
#pragma unroll
      for (int i = 0; i < 8; ++i) o[i] = tanhf(o[i]);
      *(LAS u32x4*)(WLb + t * 72 + cg * 8) = pack8(o);
      rw_lerp8(P, mu, bc, t, 1600 + cg * 8, o); *(LAS u32x4*)(ALb + t * 72 + cg * 8) = pack8(o);
#pragma unroll
      for (int half = 0; half < 2; ++half) { rw_lerp8(P, mu, bc, t, 1664 + cg * 16 + half * 8, o);
#pragma unroll
          for (int i = 0; i < 8; ++i) o[i] = sigmoidf_(o[i]);
          *(LAS u32x4*)(GLb + t * 136 + cg * 16 + half * 8) = pack8(o); }
      const size_t row = (size_t)bc * 64 + t;
#pragma unroll 2
      for (int j = 0; j < 8; ++j) { const int c = j * 64 + cg * 8;
          rw_lerp8(P, mu, bc, t, c, o); *(GAS u32x4*)(RWR + row * 512 + c) = pack8(o);
          rw_lerp8(P, mu, bc, t, 1024 + c, o); *(GAS u32x4*)(RWV + row * 512 + c) = pack8(o);
          rw_lerp8(P, mu, bc, t, 512 + c, o); *(LAS u32x4*)(KX + t * 520 + c) = pack8(o);
          const f32x4 k0 = *(const GAS f32x4*)(k_k + c), k1 = *(const GAS f32x4*)(k_k + c + 4); float ss = 0.f;
#pragma unroll
          for (int i = 0; i < 4; ++i) { const float q0 = o[i] * k0[i], q1 = o[4 + i] * k1[i]; ss += q0 * q0 + q1 * q1; }
          ss += __shfl_xor(ss, 1); ss += __shfl_xor(ss, 2); ss += __shfl_xor(ss, 4);
          if (cg == 0) INVs[t * 8 + j] = 1.0f / fmaxf(sqrtf(ss), 1e-12f); }
      const int q = C.tid * 4; *(LAS f32x4*)(w0s + q) = *(const GAS f32x4*)((q < 512 ? w0 : q < 1024 ? a0 - 512 : q < 1536 ? k_k - 1024 : k_a - 1536) + q); }
    WG_SYNC();
}
PH_FN void rwp_w(const Ctx C, ArgsP a, int l, int bc, int tt) {
    RWP_PTRS RWP_LANE
#pragma unroll
    for (int nt = 0; nt < 2; ++nt) { f32x16 c = zero16();
#pragma unroll
        for (int s4 = 0; s4 < 4; ++s4) c = __builtin_amdgcn_mfma_f32_32x32x16_bf16(frag32(WLb, 72, 32 * tt, 16 * s4, C.lane), RW_WFRAG(W2T, 64, nt, s4), c, 0, 0, 0);
        const int ch = head * 64 + 32 * nt + n; const float w0c = w0s[ch];
#pragma unroll
        for (int r = 0; r < 16; ++r) RWW[(row0 + crow(r, hi)) * 512 + ch] = -0.606531f * sigmoidf_(w0c + c[r]); }
}
PH_FN void rwp_g(const Ctx C, ArgsP a, int l, int bc, int tt) {
    RWP_PTRS RWP_LANE
#pragma unroll
    for (int nt = 0; nt < 2; ++nt) { f32x16 c = zero16();
#pragma unroll
        for (int s8 = 0; s8 < 8; ++s8) c = __builtin_amdgcn_mfma_f32_32x32x16_bf16(frag32(GLb, 136, 32 * tt, 16 * s8, C.lane), RW_WFRAG(G2T, 128, nt, s8), c, 0, 0, 0);
        const int ch = head * 64 + 32 * nt + n;
#pragma unroll
        for (int r = 0; r < 16; ++r) RWG[(row0 + crow(r, hi)) * 512 + ch] = (bf16)f2bf(c[r]); }
}
PH_FN void rwp_ak(const Ctx C, ArgsP a, int l, int bc, int tt) {
    RWP_PTRS RWP_LANE
#pragma unroll
    for (int nt = 0; nt < 2; ++nt) { f32x16 c = zero16();
#pragma unroll
        for (int s4 = 0; s4 < 4; ++s4) c = __builtin_amdgcn_mfma_f32_32x32x16_bf16(frag32(ALb, 72, 32 * tt, 16 * s4, C.lane), RW_WFRAG(A2T, 64, nt, s4), c, 0, 0, 0);
        const int ch = head * 64 + 32 * nt + n; const float a0c = a0s[ch], kkc = kks[ch], kac = kas[ch];
#pragma unroll
        for (int r = 0; r < 16; ++r) { const int tl = 32 * tt + crow(r, hi); const float al = sigmoidf_(a0c + c[r]), x = bf2f(KX[tl * 520 + ch]), kkn = x * kkc * INVs[tl * 8 + head];
            const size_t g = ((size_t)bc * 64 + tl) * 512 + ch;
            RWKK[g] = (bf16)f2bf(kkn); RWB[g] = (bf16)f2bf(kkn * al); RWK[g] = (bf16)f2bf(x * (1.0f + (al - 1.0f) * kac)); } }
}
#undef RW_WFRAG
#undef RWP_PTRS
#undef RWP_LANE
__device__ __forceinline__ void ph_rw_prep(const Ctx& C, ArgsP a, int l) {
    for (int bc = C.bid; bc < NBC; bc += C.G) { rwp_stage(C, a, l, bc);
#pragma unroll 1
        for (int tt = 0; tt < 2; ++tt) { rwp_w(C, a, l, bc, tt); rwp_g(C, a, l, bc, tt); rwp_ak(C, a, l, bc, tt); } }
    WG_SYNC();
}
template <int CTRL> __device__ __forceinline__ float dpp_get(float x) { return __builtin_bit_cast(float, __builtin_amdgcn_update_dpp(0, __builtin_bit_cast(int, x), CTRL, 0xf, 0xf, true)); }
__device__ __forceinline__ float reduce16(float x) { x += dpp_get<0xB1>(x); x += dpp_get<0x4E>(x); x += dpp_get<0x141>(x); x += dpp_get<0x140>(x); return x; }
#define RW_BAR() do { asm volatile("s_waitcnt lgkmcnt(0)" ::: "memory"); __builtin_amdgcn_s_barrier(); asm volatile("" ::: "memory"); } while (0)
PH_FN void rw_unit(const Ctx C, int chain, int rq) {
    const GAS float* RWW = (const GAS float*)(C.ws + WS_RWW); const GAS bf16* RWR = (const GAS bf16*)(C.ws + WS_RWR); const GAS bf16* RWK = (const GAS bf16*)(C.ws + WS_RWK); const GAS bf16* RWV = (const GAS bf16*)(C.ws + WS_RWV);
    const GAS bf16* RWKK = (const GAS bf16*)(C.ws + WS_RWKK); const GAS bf16* RWB = (const GAS bf16*)(C.ws + WS_RWB); GAS bf16* RWY = (GAS bf16*)(C.ws + WS_RWY);
    const int b = chain >> 3, h = chain & 7; const size_t rowb = (size_t)b * SEQ;
    constexpr int BUFB = 43008, O_KK = 0, O_W = 8192, O_B = 16384, O_K = 24576, O_R = 32768, O_V = 40960, NBLK = SEQ / 32;
    LAS unsigned char* L = C.lds;
    if (C.wave >= 4) {
        const int p = C.tid - 256, t = p >> 3, c8 = (p & 7) * 8;
        u32x4 rr, rk, rkk, rb; f32x4 w0, w1; unsigned rv;
#define RW_LOAD(blk) do { const size_t g_ = (rowb + (size_t)(blk) * 32 + t) * 512 + h * 64; \
            w0 = *(const GAS f32x4*)(RWW + g_ + c8); w1 = *(const GAS f32x4*)(RWW + g_ + c8 + 4); rr = *(const GAS u32x4*)(RWR + g_ + c8); rk = *(const GAS u32x4*)(RWK + g_ + c8); \
            rkk = *(const GAS u32x4*)(RWKK + g_ + c8); rb = *(const GAS u32x4*)(RWB + g_ + c8); rv = *(const GAS unsigned*)(RWV + g_ + 16 * rq + (p & 7) * 2); } while (0)
#define RW_ST8(off, w_) do { float o_[8]; unpack8(w_, o_); LF d_ = (LF)(Lb + (off)) + t * 64 + c8; *(LAS f32x4*)d_ = (f32x4){o_[0], o_[1], o_[2], o_[3]}; *(LAS f32x4*)(d_ + 4) = (f32x4){o_[4], o_[5], o_[6], o_[7]}; } while (0)
        RW_LOAD(0);
        for (int blk = 0; blk < NBLK; ++blk) {
            LAS unsigned char* Lb = L + (blk & 1) * BUFB;
            { LF d = (LF)(Lb + O_W) + t * 64 + c8; *(LAS f32x4*)d = w0; *(LAS f32x4*)(d + 4) = w1; }
            RW_ST8(O_R, rr); RW_ST8(O_K, rk); RW_ST8(O_KK, rkk); RW_ST8(O_B, rb);
            { LF d = (LF)(Lb + O_V) + t * 16 + (p & 7) * 2; d[0] = bflo(rv); d[1] = bfhi(rv); }
            if (blk + 1 < NBLK) RW_LOAD(blk + 1);
            RW_BAR();
        }
        RW_BAR();
#undef RW_LOAD
#undef RW_ST8
    } else {
        const int rowl = C.lane >> 4, ks = C.lane & 15, row = 4 * C.wave + rowl;
        float S0 = 0.f, S1 = 0.f, S2 = 0.f, S3 = 0.f, ykeep = 0.f;
        GAS bf16* yout = RWY + rowb * 512 + h * 64 + 16 * rq + row;
        for (int blk = 0; blk < NBLK; ++blk) {
            RW_BAR();
            const LAS unsigned char* Lb = L + (blk & 1) * BUFB;
            CLF pKK = (CLF)(Lb + O_KK) + 4 * ks; CLF pW = (CLF)(Lb + O_W) + 4 * ks; CLF pB = (CLF)(Lb + O_B) + 4 * ks; CLF pK = (CLF)(Lb + O_K) + 4 * ks; CLF pR = (CLF)(Lb + O_R) + 4 * ks; CLF pV = (CLF)(Lb + O_V) + row;
            f32x4 kk = *(const LAS f32x4*)pKK, w = *(const LAS f32x4*)pW, bb = *(const LAS f32x4*)pB, k = *(const LAS f32x4*)pK, r = *(const LAS f32x4*)pR; float vv = *pV;
#pragma unroll 4
            for (int t = 0; t < 32; ++t) {
                f32x4 nkk, nw, nb, nk, nr; float nv;
                const int tn = (t < 31) ? t + 1 : t;
                nkk = *(const LAS f32x4*)(pKK + tn * 64); nw = *(const LAS f32x4*)(pW + tn * 64); nb = *(const LAS f32x4*)(pB + tn * 64); nk = *(const LAS f32x4*)(pK + tn * 64); nr = *(const LAS f32x4*)(pR + tn * 64); nv = pV[tn * 16];
                float sa = (S0 * kk[0] + S1 * kk[1]) + (S2 * kk[2] + S3 * kk[3]);
                sa = -reduce16(sa);
                const float vk0 = vv * k[0], vk1 = vv * k[1], vk2 = vv * k[2], vk3 = vv * k[3];
                S0 = S0 * w[0] + (sa * bb[0] + vk0); S1 = S1 * w[1] + (sa * bb[1] + vk1); S2 = S2 * w[2] + (sa * bb[2] + vk2); S3 = S3 * w[3] + (sa * bb[3] + vk3);
                float y = (S0 * r[0] + S1 * r[1]) + (S2 * r[2] + S3 * r[3]);
                y = reduce16(y);
                if ((t & 15) == ks) ykeep = y;
                if ((t & 15) == 15) yout[(size_t)(blk * 32 + (t & 16) + ks) * 512] = (bf16)f2bf(ykeep);
                kk = nkk; w = nw; bb = nb; k = nk; r = nr; vv = nv;
            }
        }
        RW_BAR();
    }
}
PH_FN void ph_rw_out(const Ctx C, ArgsP a, int l) {
    const GAS bf16* RWR = (const GAS bf16*)(C.ws + WS_RWR); const GAS bf16* RWK = (const GAS bf16*)(C.ws + WS_RWK); const GAS bf16* RWV = (const GAS bf16*)(C.ws + WS_RWV); const GAS bf16* RWG = (const GAS bf16*)(C.ws + WS_RWG); const GAS bf16* RWY = (const GAS bf16*)(C.ws + WS_RWY);
    GAS bf16* YS = (GAS bf16*)(C.ws + WS_YS);
    const GAS float* r_k = a->in[29] + (size_t)l * 512; const GAS float* nw = a->in[30] + (size_t)l * 512; const GAS float* nb = a->in[31] + (size_t)l * 512;
    const int gw = C.bid * NWAVES + C.wave, NGW = C.G * NWAVES, c0 = C.lane * 8;
    float rk[8], w8[8], b8[8];
#pragma unroll
    for (int i = 0; i < 8; ++i) { rk[i] = r_k[c0 + i]; w8[i] = nw[c0 + i]; b8[i] = nb[c0 + i]; }
    for (int row0 = gw * 2; row0 < M; row0 += NGW * 2) {
        u32x4 yw[2], rw[2], kw[2], vw[2], gw4[2];
#pragma unroll
        for (int u = 0; u < 2; ++u) { const size_t g = (size_t)(row0 + u) * 512 + c0; yw[u] = *(const GAS u32x4*)(RWY + g); rw[u] = *(const GAS u32x4*)(RWR + g); kw[u] = *(const GAS u32x4*)(RWK + g); vw[u] = *(const GAS u32x4*)(RWV + g); gw4[u] = *(const GAS u32x4*)(RWG + g); }
#pragma unroll
        for (int u = 0; u < 2; ++u) { float y[8], r[8], k[8], v[8], gg[8], o[8]; unpack8(yw[u], y); unpack8(rw[u], r); unpack8(kw[u], k); unpack8(vw[u], v); unpack8(gw4[u], gg);
            float s = 0.f, bs = 0.f;
#pragma unroll
            for (int i = 0; i < 8; ++i) { s += y[i]; bs += r[i] * k[i] * rk[i]; }
            s += __shfl_xor(s, 1); s += __shfl_xor(s, 2); s += __shfl_xor(s, 4); bs += __shfl_xor(bs, 1); bs += __shfl_xor(bs, 2); bs += __shfl_xor(bs, 4);
            const float mu = s * (1.0f / 64.0f); float q = 0.f;
#pragma unroll
            for (int i = 0; i < 8; ++i) { y[i] -= mu; q += y[i] * y[i]; }
            q += __shfl_xor(q, 1); q += __shfl_xor(q, 2); q += __shfl_xor(q, 4);
            const float rs = 1.0f / sqrtf(q * (1.0f / 64.0f) + 64e-5f);
#pragma unroll
            for (int i = 0; i < 8; ++i) o[i] = (y[i] * rs * w8[i] + b8[i] + bs * v[i]) * gg[i];
            *(GAS u32x4*)(YS + (size_t)(row0 + u) * 2048 + 1536 + c0) = pack8(o); }
    }
}

__device__ __forceinline__ int pi_swap23(int i) { return (i & ~12) | ((i & 4) << 1) | ((i & 8) >> 1); }
__device__ __forceinline__ void da_unit(const Ctx& C, const Args& a, int l, int b, int h, int jq, float lam, float oml) {
    const GAS bf16* P = (const GAS bf16*)(C.ws + WS_P); const GAS bf16* VT = (const GAS bf16*)(C.ws + WS_VT); GAS bf16* YS = (GAS bf16*)(C.ws + WS_YS);
    const GAS float* dnorm = (const GAS float*)a.in[11] + (size_t)l * 128;
    const int comp = C.wave >> 2, wq = C.wave & 3, q = C.lane & 31, hi = C.lane >> 5;
    const size_t qrow = (size_t)b * SEQ + jq * 128 + wq * 32 + q;
    pg8::bf16x8 qf[4];
#pragma unroll
    for (int d0 = 0; d0 < 4; ++d0) qf[d0] = *(const GAS pg8::bf16x8*)(P + qrow * NPM + C_DAQ + h * 128 + comp * 64 + 16 * d0 + 8 * hi);
    const int ntile = 2 * jq + 2, my_last = 2 * jq + (wq >= 2 ? 1 : 0);
    f32x16 O[4];
#pragma unroll
    for (int db = 0; db < 4; ++db)
#pragma unroll
        for (int r = 0; r < 16; ++r) O[db][r] = 0.f;
    float mrun = 0.f, lrun = 0.f;
    f32x16 negm;
#pragma unroll
    for (int r = 0; r < 16; ++r) negm[r] = 0.f;
    const GAS bf16* kg = P + ((size_t)b * SEQ + C.lane) * NPM + C_DAK + h * 128 + C.wave * 8;
    const GAS bf16* vg = VT + ((size_t)(b * 4 + h) * 128 + 64 * (C.wave & 1) + C.lane) * SEQ + (C.wave >> 1) * 8;
    const unsigned lds0 = (unsigned)(size_t)C.lds;
    const unsigned kdst0 = lds0 + (unsigned)(C.wave >> 3) * 8192u + (unsigned)(C.wave & 7) * 1024u;
    const unsigned vdst0 = lds0 + 32768u + (unsigned)(C.wave >> 1) * 2048u + (unsigned)(C.wave & 1) * 1024u;
    const int pq = pi_swap23(q);
    pg8::bf16x8 pb[4] = {}, pbp[4] = {};
    int vs = 0, vsp = 0;
#define DA_GLDS(gp_, dst_) do { unsigned keep_; asm volatile("s_mov_b32 %0, m0\n\ts_mov_b32 m0, %2\n\ts_nop 0\n\tglobal_load_lds_dwordx4 %1, off\n\ts_mov_b32 m0, %0" : "=&s"(keep_) : "v"(gp_), "s"((unsigned)__builtin_amdgcn_readfirstlane(dst_)) : "memory"); } while (0)
#define DA_DMA(tile_, vslot_) do { const GAS bf16* kp_ = kg + (size_t)(tile_) * 64 * NPM; const GAS bf16* vp_ = vg + (tile_) * 64; const unsigned kd_ = kdst0 + (unsigned)((tile_) & 1) * 16384u, vd_ = vdst0 + (unsigned)(vslot_); \
        DA_GLDS(kp_, kd_); DA_GLDS(kp_ + 64, kd_ + 8192u); DA_GLDS(vp_, vd_); DA_GLDS(vp_ + 32, vd_ + 8192u); } while (0)
#define DA_STAGE(tile_) do { asm volatile("s_waitcnt vmcnt(0)" ::: "memory"); WG_SYNC(); if ((tile_) + 1 < ntile) DA_DMA((tile_) + 1, (vs == 32768) ? 0 : vs + 16384); } while (0)
#define DA_QK(tile_) do { const LAS unsigned char* kb_ = C.lds + ((tile_) & 1) * 16384 + comp * 8192 + hi * 1024 + pq * 16; pg8::bf16x8 ka_[8]; \
        _Pragma("unroll") for (int d0 = 0; d0 < 4; ++d0) { ka_[2 * d0] = *(const LAS pg8::bf16x8*)(kb_ + d0 * 2048); ka_[2 * d0 + 1] = *(const LAS pg8::bf16x8*)(kb_ + d0 * 2048 + 512); } \
        __builtin_amdgcn_sched_barrier(0); \
        p0 = __builtin_amdgcn_mfma_f32_32x32x16_bf16(ka_[0], qf[0], negm, 0, 0, 0); p1 = __builtin_amdgcn_mfma_f32_32x32x16_bf16(ka_[1], qf[0], negm, 0, 0, 0); \
        _Pragma("unroll") for (int d0 = 1; d0 < 4; ++d0) { p0 = __builtin_amdgcn_mfma_f32_32x32x16_bf16(ka_[2 * d0], qf[d0], p0, 0, 0, 0); p1 = __builtin_amdgcn_mfma_f32_32x32x16_bf16(ka_[2 * d0 + 1], qf[d0], p1, 0, 0, 0); } } while (0)
#define DA_PV(PB_, voff_) do { const LAS unsigned char* vb_ = C.lds + 32768 + (voff_); _Pragma("unroll") for (int db = 0; db < 4; ++db) _Pragma("unroll") for (int s = 0; s < 4; ++s) { \
            const pg8::bf16x8 vf_ = *(const LAS pg8::bf16x8*)(vb_ + (2 * s + hi) * 2048 + (32 * db + q) * 16); O[db] = __builtin_amdgcn_mfma_f32_32x32x16_bf16(vf_, PB_[s], O[db], 0, 0, 0); } } while (0)
#define DA_MX3(a_, b_, c_) __builtin_fmaxf(__builtin_fmaxf((a_), (b_)), (c_))
#define DA_SM_MAX(FIRST_, PBP_) do { \
        float ma = DA_MX3(p0[0], p0[1], p1[0]), mb = DA_MX3(p0[2], p0[3], p1[1]); ma = DA_MX3(ma, p1[2], p1[3]); \
        _Pragma("unroll") for (int r = 4; r < 16; r += 4) { ma = DA_MX3(ma, p0[r], p0[r + 1]); mb = DA_MX3(mb, p0[r + 2], p0[r + 3]); ma = DA_MX3(ma, p1[r], p1[r + 1]); mb = DA_MX3(mb, p1[r + 2], p1[r + 3]); } \
        float rm = __builtin_fmaxf(ma, mb); rm = __builtin_fmaxf(rm, __shfl_xor(rm, 32)); \
        if ((FIRST_) || __any(rm > 8.0f)) { const float dl = (FIRST_) ? rm : __builtin_fmaxf(rm, 0.f); mrun += dl; const float f = __builtin_amdgcn_exp2f(-dl); lrun *= f; \
            _Pragma("unroll") for (int r = 0; r < 16; ++r) { p0[r] -= dl; p1[r] -= dl; negm[r] = -mrun; } \
            _Pragma("unroll") for (int db = 0; db < 4; ++db) _Pragma("unroll") for (int r = 0; r < 16; ++r) O[db][r] *= f; \
            if (!(FIRST_)) { _Pragma("unroll") for (int s_ = 0; s_ < 4; ++s_) { const u32x4 w_ = __builtin_bit_cast(u32x4, PBP_[s_]); u32x4 o_; \
                o_.x = pk2(bflo(w_.x) * f, bfhi(w_.x) * f); o_.y = pk2(bflo(w_.y) * f, bfhi(w_.y) * f); o_.z = pk2(bflo(w_.z) * f, bfhi(w_.z) * f); o_.w = pk2(bflo(w_.w) * f, bfhi(w_.w) * f); PBP_[s_] = __builtin_bit_cast(pg8::bf16x8, o_); } } } } while (0)
#define DA_SM_EXP(PBO_) do { \
        _Pragma("unroll") for (int r = 0; r < 16; ++r) { p0[r] = __builtin_amdgcn_exp2f(p0[r]); p1[r] = __builtin_amdgcn_exp2f(p1[r]); } \
        { f32x2 s2 = {0.f, 0.f}; _Pragma("unroll") for (int r = 0; r < 16; r += 2) { s2 += (f32x2){p0[r], p0[r + 1]}; s2 += (f32x2){p1[r], p1[r + 1]}; } lrun += s2[0] + s2[1]; } \
        { u32x4 w; \
          w.x = pk2(p0[0], p0[1]); w.y = pk2(p0[2], p0[3]); w.z = pk2(p0[4], p0[5]); w.w = pk2(p0[6], p0[7]); PBO_[0] = __builtin_bit_cast(pg8::bf16x8, w); \
          w.x = pk2(p0[8], p0[9]); w.y = pk2(p0[10], p0[11]); w.z = pk2(p0[12], p0[13]); w.w = pk2(p0[14], p0[15]); PBO_[1] = __builtin_bit_cast(pg8::bf16x8, w); \
          w.x = pk2(p1[0], p1[1]); w.y = pk2(p1[2], p1[3]); w.z = pk2(p1[4], p1[5]); w.w = pk2(p1[6], p1[7]); PBO_[2] = __builtin_bit_cast(pg8::bf16x8, w); \
          w.x = pk2(p1[8], p1[9]); w.y = pk2(p1[10], p1[11]); w.z = pk2(p1[12], p1[13]); w.w = pk2(p1[14], p1[15]); PBO_[3] = __builtin_bit_cast(pg8::bf16x8, w); } } while (0)
#define DA_VADDR(i_) (vb_ + ((i_) & 3) * 4096 + ((i_) >> 2) * 512)
#define DA_PV_EXP(PBP_, voff_, PBO_) do { const LAS unsigned char* vb_ = C.lds + 32768 + (voff_) + hi * 2048 + q * 16; f32x2 s2_ = {0.f, 0.f}; unsigned pw_[16]; \
        pg8::bf16x8 vq_[4];   \
        vq_[0] = *(const LAS pg8::bf16x8*)DA_VADDR(0); vq_[1] = *(const LAS pg8::bf16x8*)DA_VADDR(1); vq_[2] = *(const LAS pg8::bf16x8*)DA_VADDR(2); \
        _Pragma("unroll") for (int i_ = 0; i_ < 16; ++i_) { const int db_ = i_ >> 2, s_ = i_ & 3; \
            if (i_ + 3 < 16) vq_[(i_ + 3) & 3] = *(const LAS pg8::bf16x8*)DA_VADDR(i_ + 3); \
            O[db_] = __builtin_amdgcn_mfma_f32_32x32x16_bf16(vq_[i_ & 3], PBP_[s_], O[db_], 0, 0, 0); \
            float e0_, e1_; if (i_ < 8) { e0_ = __builtin_amdgcn_exp2f(p0[2 * i_]); e1_ = __builtin_amdgcn_exp2f(p0[2 * i_ + 1]); } else { e0_ = __builtin_amdgcn_exp2f(p1[2 * i_ - 16]); e1_ = __builtin_amdgcn_exp2f(p1[2 * i_ - 15]); } \
            s2_ += (f32x2){e0_, e1_}; pw_[i_] = pk2(e0_, e1_); \
            __builtin_amdgcn_sched_barrier(0); } \
        lrun += s2_[0] + s2_[1]; \
        _Pragma("unroll") for (int k_ = 0; k_ < 4; ++k_) { u32x4 w_; w_.x = pw_[4 * k_]; w_.y = pw_[4 * k_ + 1]; w_.z = pw_[4 * k_ + 2]; w_.w = pw_[4 * k_ + 3]; PBO_[k_] = __builtin_bit_cast(pg8::bf16x8, w_); } } while (0)
    f32x16 p0, p1;
    DA_DMA(0, 0);
    DA_STAGE(0); DA_QK(0); DA_SM_MAX(true, pbp); DA_SM_EXP(pb);
    for (int tile = 1; tile <= my_last; ++tile) {
        vsp = vs; vs = (vs == 32768) ? 0 : vs + 16384;
#pragma unroll
        for (int s = 0; s < 4; ++s) pbp[s] = pb[s];
        DA_STAGE(tile); DA_QK(tile); DA_SM_MAX(false, pbp);
        DA_PV_EXP(pbp, vsp, pb);
    }
    if (my_last < ntile - 1) { const int vkeep = vs; vs = (vs == 32768) ? 0 : vs + 16384; DA_STAGE(ntile - 1); vs = vkeep; }
    DA_PV(pb, vs);
#undef DA_GLDS
#undef DA_DMA
#undef DA_STAGE
#undef DA_QK
#undef DA_PV
#undef DA_MX3
#undef DA_SM_MAX
#undef DA_SM_EXP
#undef DA_PV_EXP
#undef DA_VADDR
    const float ltot = lrun + __shfl_xor(lrun, 32); const float inv = 1.0f / ltot;
    WG_SYNC();
    LF X = (LF)C.lds + (wq * 32 + q) * 132;
    if (comp == 1) {
        const float sc = inv * lam;
#pragma unroll
        for (int db = 0; db < 4; ++db)
#pragma unroll
            for (int g4 = 0; g4 < 4; ++g4) *(LAS f32x4*)(X + 32 * db + 8 * g4 + 4 * hi) = (f32x4){O[db][4 * g4] * sc, O[db][4 * g4 + 1] * sc, O[db][4 * g4 + 2] * sc, O[db][4 * g4 + 3] * sc};
    }
    WG_SYNC();
    if (comp == 0) {
        float ss = 0.f;
#pragma unroll
        for (int db = 0; db < 4; ++db)
#pragma unroll
            for (int g4 = 0; g4 < 4; ++g4) { const f32x4 x = *(const LAS f32x4*)(X + 32 * db + 8 * g4 + 4 * hi);
#pragma unroll
                for (int e = 0; e < 4; ++e) { const float v = O[db][4 * g4 + e] * inv - x[e]; O[db][4 * g4 + e] = v; ss += v * v; } }
        ss += __shfl_xor(ss, 32);
        const float rs = oml / sqrtf(ss * (1.0f / 128.0f) + EPS);
#pragma unroll
        for (int db = 0; db < 4; ++db)
#pragma unroll
            for (int g4 = 0; g4 < 4; ++g4) { const int d = 32 * db + 8 * g4 + 4 * hi; const f32x4 gn = *(const GAS f32x4*)(dnorm + d);
                u32x2 w; w.x = pk2(O[db][4 * g4] * rs * gn[0], O[db][4 * g4 + 1] * rs * gn[1]); w.y = pk2(O[db][4 * g4 + 2] * rs * gn[2], O[db][4 * g4 + 3] * rs * gn[3]);
                *(GAS u32x2*)(YS + qrow * 2048 + h * 128 + d) = w; }
    }
    WG_SYNC();
}
#if RW_CHUNKED
__device__ const signed char ATT_BINS30[30][3] = {{63,4,3}, {62,5,2}, {61,6,1}, {60,7,0}, {59,8,-1}, {58,9,-1}, {57,10,-1}, {56,11,-1}, {55,12,-1}, {54,13,-1}, {53,14,-1}, {52,15,-1}, {51,16,-1}, {50,17,-1}, {49,18,-1}, {48,19,-1}, {47,20,-1}, {46,21,-1}, {45,22,-1}, {44,23,-1}, {43,24,-1}, {42,25,-1}, {41,26,-1}, {40,27,-1}, {39,28,-1}, {38,29,-1}, {37,30,-1}, {36,31,-1}, {35,32,-1}, {34,33,-1}};
__device__ __forceinline__ int att_bin_unit(int bin, int i) { return i < 3 ? (int)ATT_BINS30[bin][i] : -1; }
#else
__device__ const signed char ATT_BINS[24][12] = {{63,21,-1,-1,-1,-1,-1,-1,-1,-1,-1,-1}, {62,22,-1,-1,-1,-1,-1,-1,-1,-1,-1,-1}, {61,23,-1,-1,-1,-1,-1,-1,-1,-1,-1,-1}, {60,24,-1,-1,-1,-1,-1,-1,-1,-1,-1,-1}, {59,25,-1,-1,-1,-1,-1,-1,-1,-1,-1,-1}, {58,26,-1,-1,-1,-1,-1,-1,-1,-1,-1,-1}, {57,27,-1,-1,-1,-1,-1,-1,-1,-1,-1,-1}, {56,28,-1,-1,-1,-1,-1,-1,-1,-1,-1,-1}, {55,29,-1,-1,-1,-1,-1,-1,-1,-1,-1,-1}, {54,30,-1,-1,-1,-1,-1,-1,-1,-1,-1,-1}, {53,31,-1,-1,-1,-1,-1,-1,-1,-1,-1,-1}, {52,32,-1,-1,-1,-1,-1,-1,-1,-1,-1,-1}, {51,33,-1,-1,-1,-1,-1,-1,-1,-1,-1,-1}, {50,34,-1,-1,-1,-1,-1,-1,-1,-1,-1,-1}, {49,35,-1,-1,-1,-1,-1,-1,-1,-1,-1,-1}, {48,36,-1,-1,-1,-1,-1,-1,-1,-1,-1,-1}, {47,37,-1,-1,-1,-1,-1,-1,-1,-1,-1,-1}, {46,38,-1,-1,-1,-1,-1,-1,-1,-1,-1,-1}, {45,39,-1,-1,-1,-1,-1,-1,-1,-1,-1,-1}, {44,40,-1,-1,-1,-1,-1,-1,-1,-1,-1,-1}, {43,41,-1,-1,-1,-1,-1,-1,-1,-1,-1,-1}, {42,20,19,6,-1,-1,-1,-1,-1,-1,-1,-1}, {18,17,16,15,14,5,-1,-1,-1,-1,-1,-1}, {13,12,11,10,9,8,7,4,3,2,1,0}};
__device__ __forceinline__ int att_bin_unit(int bin, int i) { return i < 12 ? (int)ATT_BINS[bin][i] : -1; }
#endif
__device__ __forceinline__ void ph_da_attn(const Ctx& C, const Args& a, int l, int bh, int bin) {
    const GAS float* q1 = (const GAS float*)a.in[7] + (size_t)l * 64; const GAS float* k1 = (const GAS float*)a.in[8] + (size_t)l * 64; const GAS float* q2 = (const GAS float*)a.in[9] + (size_t)l * 64; const GAS float* k2 = (const GAS float*)a.in[10] + (size_t)l * 64;
    float s1 = 0.f, s2 = 0.f;
    for (int i = 0; i < 64; ++i) { s1 += q1[i] * k1[i]; s2 += q2[i] * k2[i]; }
    const float lam_init = 0.8f - 0.6f * expf(-0.3f * (float)l); const float lam_v = expf(s1) - expf(s2) + lam_init;
    const float lam = __uint_as_float(__builtin_amdgcn_readfirstlane(__float_as_uint(lam_v))), oml = __uint_as_float(__builtin_amdgcn_readfirstlane(__float_as_uint(1.0f - lam_init)));
    for (int i = 0; i < 12; ++i) { const int jq = att_bin_unit(bin, i); if (jq < 0) break; da_unit(C, a, l, bh >> 2, bh & 3, jq, lam, oml); }
}

PH_FN void ph_final(const Ctx C, ArgsP a) {
    const GAS float* ssq = (const GAS float*)(C.ws + WS_SSQ); const GAS float* fn = a->in[39];
    const int gw = C.bid * NWAVES + C.wave, NGW = C.G * NWAVES;
    for (int m = gw; m < M; m += NGW) { const float rs = pg8::row_rstd((const float*)ssq, m, M); GAS f32x4* hr = (GAS f32x4*)(C.h + (size_t)m * D) + C.lane; const GAS f32x4* gr = (const GAS f32x4*)fn + C.lane;
#pragma unroll
        for (int j = 0; j < 4; ++j) { const f32x4 v = hr[64 * j], g = gr[64 * j]; hr[64 * j] = v * rs * g; } }
}
#define RWC_PTRS \
    GAS float* RWW = (GAS float*)(C.ws + WS_RWW); const GAS bf16* RWR = (const GAS bf16*)(C.ws + WS_RWR); const GAS bf16* RWK = (const GAS bf16*)(C.ws + WS_RWK); const GAS bf16* RWV = (const GAS bf16*)(C.ws + WS_RWV); \
    GAS bf16* RWKK = (GAS bf16*)(C.ws + WS_RWKK); GAS bf16* RWB = (GAS bf16*)(C.ws + WS_RWB); GAS bf16* RWY = (GAS bf16*)(C.ws + WS_RWY); \
    LF LGs = (LF)C.lds; LB LP = (LB)C.lds; LB LPT = (LB)(C.lds + 9216); LB AT = (LB)(C.lds + 18432); LB LAK = AT; LB LP2 = AT; LB RT = (LB)(C.lds + 27648); LB BTl = (LB)(C.lds + 36864); LB MRB = BTl; LB KTl = (LB)(C.lds + 46080); LB MRK = KTl; \
    LB VT = (LB)(C.lds + 55296); LB BHT = (LB)(C.lds + 64512); LB KHT = (LB)(C.lds + 73728); LB XB0 = (LB)(C.lds + 82944); LB XB1 = (LB)(C.lds + 101376); LB LPT2 = (LB)(C.lds + 119808); LF rho = (LF)(C.lds + 129024); LF lgl = rho + 64; \
    const int t = C.tid >> 3, g8 = C.tid & 7, n = C.lane & 31, hi = C.lane >> 5; \
    (void)RWW; (void)RWR; (void)RWK; (void)RWV; (void)RWKK; (void)RWB; (void)RWY; (void)LGs; (void)LP; (void)LPT; (void)AT; (void)LAK; (void)LP2; (void)RT; (void)BTl; (void)MRB; (void)KTl; (void)MRK; (void)VT; (void)BHT; (void)KHT; (void)XB0; (void)XB1; (void)LPT2; (void)rho; (void)lgl; (void)t; (void)g8; (void)n; (void)hi;
PH_FN void rwc_stage0(const Ctx C, int bc, int h) {
    RWC_PTRS
    const size_t row0 = (size_t)bc * 64; const size_t g = (row0 + t) * 512 + h * 64 + g8 * 8;
    WG_SYNC();
    float lw[8]; { const f32x4 x0 = *(const GAS f32x4*)(RWW + g), x1 = *(const GAS f32x4*)(RWW + g + 4); lw[0] = x0[0]; lw[1] = x0[1]; lw[2] = x0[2]; lw[3] = x0[3]; lw[4] = x1[0]; lw[5] = x1[1]; lw[6] = x1[2]; lw[7] = x1[3]; }
#pragma unroll
    for (int i = 0; i < 8; ++i) LGs[t * 68 + g8 * 8 + i] = lw[i];
    WG_SYNC();
    { const int seg = C.tid >> 6, k = C.tid & 63; float run = 0.f;
#pragma unroll
      for (int i = 0; i < 8; ++i) { run += LGs[(8 * seg + i) * 68 + k]; LGs[(8 * seg + i) * 68 + k] = run; }
      WG_SYNC();
      float off = 0.f;
#pragma unroll
      for (int sg = 0; sg < 7; ++sg) { const float tot = LGs[(8 * sg + 7) * 68 + k]; off += (sg < seg) ? tot : 0.f; }
      WG_SYNC();
#pragma unroll
      for (int i = 0; i < 8; ++i) LGs[(8 * seg + i) * 68 + k] += off; }
    WG_SYNC();
    {   float rf[8], kf[8], kkf[8], bf[8], lg[8], rh[8], ll[8], o1[8], o2[8], o3[8], o4[8];
        unpack8(*(const GAS u32x4*)(RWR + g), rf); unpack8(*(const GAS u32x4*)(RWK + g), kf); unpack8(*(const GAS u32x4*)(RWKK + g), kkf); unpack8(*(const GAS u32x4*)(RWB + g), bf);
#pragma unroll
        for (int i = 0; i < 8; ++i) { const int k = g8 * 8 + i; lg[i] = LGs[t * 68 + k]; rh[i] = LGs[31 * 68 + k]; ll[i] = LGs[63 * 68 + k]; }
#pragma unroll
        for (int i = 0; i < 8; ++i) { const int k = g8 * 8 + i; const float lm1 = lg[i] - lw[i];
            const float ed = __expf(lg[i] - rh[i]), edi = __expf(rh[i] - lg[i]), el = __expf(ll[i] - lg[i]);
            o1[i] = -kkf[i] * __expf(lm1 - rh[i]); o2[i] = rf[i] * ed; o3[i] = bf[i] * edi; o4[i] = kf[i] * edi;
            XB0[k * 72 + t] = (bf16)f2bf(-kkf[i] * __expf(lm1));
            BHT[k * 72 + t] = (bf16)f2bf(bf[i] * el); KHT[k * 72 + t] = (bf16)f2bf(kf[i] * el); }
        *(LAS u32x4*)(AT + t * 72 + g8 * 8) = pack8(o1); *(LAS u32x4*)(RT + t * 72 + g8 * 8) = pack8(o2); *(LAS u32x4*)(BTl + t * 72 + g8 * 8) = pack8(o3); *(LAS u32x4*)(KTl + t * 72 + g8 * 8) = pack8(o4);
        const u32x4 vv = *(const GAS u32x4*)(RWV + g); const unsigned vw[4] = {vv.x, vv.y, vv.z, vv.w};
#pragma unroll
        for (int i = 0; i < 4; ++i) { VT[(g8 * 8 + 2 * i) * 72 + t] = (bf16)(vw[i] & 0xffffu); VT[(g8 * 8 + 2 * i + 1) * 72 + t] = (bf16)(vw[i] >> 16); }
        if (t == 0) {
#pragma unroll
            for (int i = 0; i < 8; ++i) { rho[g8 * 8 + i] = rh[i]; lgl[g8 * 8 + i] = ll[i]; } }
    }
    WG_SYNC();
}
PH_FN void rwc_stage12(const Ctx C) {
    RWC_PTRS
    {   const int mt = C.wave >> 1, nt0 = 2 * (C.wave & 1);
        CLB Am = (mt < 2) ? (CLB)AT : (CLB)RT; const int m0 = 32 * (mt & 1);
        CLB Bm = (nt0 < 2) ? (CLB)BTl : (CLB)KTl;
        f32x16 c0 = zero16(), c1 = zero16();
        mma_nt<64>(c0, Am, 72, m0, Bm, 72, 0, C.lane); mma_nt<64>(c1, Am, 72, m0, Bm, 72, 32, C.lane);
        WG_SYNC();
#pragma unroll
        for (int r = 0; r < 16; ++r) { const int tt = m0 + crow(r, hi); const int j0 = n, j1 = 32 + n;
            if (mt < 2) { const bf16 x0 = (bf16)f2bf((j0 < tt) ? c0[r] : 0.f), x1 = (bf16)f2bf((j1 < tt) ? c1[r] : 0.f);
                if (nt0 < 2) { LP[tt * 72 + j0] = x0; LP[tt * 72 + j1] = x1; LPT[j0 * 72 + tt] = x0; LPT[j1 * 72 + tt] = x1; } else { LAK[tt * 72 + j0] = x0; LAK[tt * 72 + j1] = x1; } }
            else { const bf16 x0 = (bf16)f2bf((j0 <= tt) ? c0[r] : 0.f), x1 = (bf16)f2bf((j1 <= tt) ? c1[r] : 0.f);
                if (nt0 < 2) { MRB[tt * 72 + j0] = x0; MRB[tt * 72 + j1] = x1; } else { MRK[tt * 72 + j0] = x0; MRK[tt * 72 + j1] = x1; } } }
    }
    WG_SYNC();
    if (C.wave < 4) { const int vt = C.wave >> 1, tt0 = C.wave & 1; f32x16 c = zero16(); mma_nt<64>(c, VT, 72, 32 * vt, LAK, 72, 32 * tt0, C.lane);
#pragma unroll
        for (int r = 0; r < 16; ++r) XB0[(64 + 32 * vt + crow(r, hi)) * 72 + 32 * tt0 + n] = (bf16)f2bf(c[r]); }
    WG_SYNC();
}
#ifndef RWC_NSTEP
#define RWC_NSTEP 6
#endif
#ifndef RWC_REP0
#define RWC_REP0 1
#endif
PH_FN void rwc_solve(const Ctx C) {
    RWC_PTRS
    const int ct = C.wave >> 1, tt = C.wave & 1;
    const int sk = C.wave >> 2, st = (C.wave >> 1) & 1, sj = C.wave & 1;
#pragma unroll 1
    for (int i = 0; i < RWC_NSTEP; ++i) {
        CLB Pc = (i & 1) ? (CLB)LP2 : (CLB)LP; CLB PTc = (i & 1) ? (CLB)LPT2 : (CLB)LPT; LB Pn = (i & 1) ? LP : LP2; LB PTn = (i & 1) ? LPT : LPT2;
        CLB Xc = (i & 1) ? (CLB)XB1 : (CLB)XB0; LB Xn = (i & 1) ? XB0 : XB1;
        { f32x16 acc;
#pragma unroll
          for (int r = 0; r < 16; ++r) acc[r] = bf2f(Xc[(32 * ct + crow(r, hi)) * 72 + 32 * tt + n]);
          mma_nt<64>(acc, Xc, 72, 32 * ct, Pc, 72, 32 * tt, C.lane);
#pragma unroll
          for (int r = 0; r < 16; ++r) Xn[(32 * ct + crow(r, hi)) * 72 + 32 * tt + n] = (bf16)f2bf(acc[r]); }
        if (i < RWC_NSTEP - 1) { f32x16 acc = zero16();
          if (sk == 0) mma_nt<64>(acc, Pc, 72, 32 * st, PTc, 72, 32 * sj, C.lane); else mma_nt<64>(acc, PTc, 72, 32 * st, Pc, 72, 32 * sj, C.lane);
          LB dst = (sk == 0) ? Pn : PTn;
#pragma unroll
          for (int r = 0; r < 16; ++r) dst[(32 * st + crow(r, hi)) * 72 + 32 * sj + n] = (bf16)f2bf(acc[r]); }
        WG_SYNC();
    }
}
PH_FN void rwc_stage4(const Ctx C, int bc, int h) {
    RWC_PTRS
    const size_t row0 = (size_t)bc * 64; CLB A2T = (CLB)XB0; CLB WT = (CLB)(XB0 + 64 * 72);
    {   const int kind = C.wave >> 1, mt = C.wave & 1;
        f32x16 c0 = zero16(), c1 = zero16();
        if (kind == 0) { mma_nt<64>(c0, BHT, 72, 32 * mt, A2T, 72, 0, C.lane); mma_nt<64>(c1, BHT, 72, 32 * mt, A2T, 72, 32, C.lane); }
        else if (kind == 1) { mma_nt<64>(c0, BHT, 72, 32 * mt, WT, 72, 0, C.lane); mma_nt<64>(c1, BHT, 72, 32 * mt, WT, 72, 32, C.lane); mma_nt<64>(c0, KHT, 72, 32 * mt, VT, 72, 0, C.lane); mma_nt<64>(c1, KHT, 72, 32 * mt, VT, 72, 32, C.lane); }
        else if (kind == 2) { mma_nt<64>(c0, MRB, 72, 32 * mt, A2T, 72, 0, C.lane); mma_nt<64>(c1, MRB, 72, 32 * mt, A2T, 72, 32, C.lane); }
        else { mma_nt<64>(c0, MRB, 72, 32 * mt, WT, 72, 0, C.lane); mma_nt<64>(c1, MRB, 72, 32 * mt, WT, 72, 32, C.lane); mma_nt<64>(c0, MRK, 72, 32 * mt, VT, 72, 0, C.lane); mma_nt<64>(c1, MRK, 72, 32 * mt, VT, 72, 32, C.lane); }
#pragma unroll
        for (int r = 0; r < 16; ++r) { const int m = 32 * mt + crow(r, hi); const size_t go = (row0 + m) * 512 + h * 64;
            if (kind == 0) { const float d = __expf(lgl[m]); RWB[go + n] = (bf16)f2bf(c0[r] + ((n == m) ? d : 0.f)); RWB[go + 32 + n] = (bf16)f2bf(c1[r] + ((32 + n == m) ? d : 0.f)); }
            else if (kind == 1) { RWW[go + n] = c0[r]; RWW[go + 32 + n] = c1[r]; }
            else if (kind == 2) { RWKK[go + n] = (bf16)f2bf(c0[r] + bf2f(RT[m * 72 + n]) * __expf(rho[n])); RWKK[go + 32 + n] = (bf16)f2bf(c1[r] + bf2f(RT[m * 72 + 32 + n]) * __expf(rho[32 + n])); }
            else { RWY[go + n] = (bf16)f2bf(c0[r]); RWY[go + 32 + n] = (bf16)f2bf(c1[r]); } }
    }
}
__device__ __forceinline__ void ph_rw_chunk(const Ctx& C, int bc) {
#pragma unroll 1
    for (int h = 0; h < 8; ++h) { for (int r0 = 0; r0 < RWC_REP0; ++r0) rwc_stage0(C, bc, h); rwc_stage12(C); rwc_solve(C); rwc_stage4(C, bc, h); }
    WG_SYNC();
}
PH_FN void rw_scan_producer(const Ctx C, int chain) {
    const float* RWW = (const float*)(unsigned char*)(C.ws + WS_RWW); const bf16* RWKK = (const bf16*)(unsigned char*)(C.ws + WS_RWKK); const bf16* RWB = (const bf16*)(unsigned char*)(C.ws + WS_RWB); bf16* RWY = (bf16*)(unsigned char*)(C.ws + WS_RWY);
    const int b = chain >> 3, h = chain & 7; const size_t rowb = (size_t)b * SEQ;
    constexpr int BUFB = 45056, O_RQ = 0, O_PT = 9216, O_QT = 18432, O_Y0 = 35840;
    LAS unsigned char* L = C.lds;
        const int p = C.tid - 256, t = p >> 2, q4 = (p & 3) * 16;
        u32x4 Arq0, Arq1, Apt0, Apt1, Ay00, Ay01, Brq0, Brq1, Bpt0, Bpt1, By00, By01; f32x4 Aq0, Aq1, Aq2, Aq3, Bq0, Bq1, Bq2, Bq3;
#define SC_LOAD(S, c_) do { const size_t g_ = (rowb + (size_t)(c_) * 64 + t) * 512 + h * 64 + q4; \
            S##rq0 = *(const u32x4*)(RWKK + g_); S##rq1 = *(const u32x4*)(RWKK + g_ + 8); S##pt0 = *(const u32x4*)(RWB + g_); S##pt1 = *(const u32x4*)(RWB + g_ + 8); S##y00 = *(const u32x4*)(RWY + g_); S##y01 = *(const u32x4*)(RWY + g_ + 8); \
            S##q0 = *(const f32x4*)(RWW + g_); S##q1 = *(const f32x4*)(RWW + g_ + 4); S##q2 = *(const f32x4*)(RWW + g_ + 8); S##q3 = *(const f32x4*)(RWW + g_ + 12); } while (0)
#define SC_WRITE(S, Lb) do { \
            *(LAS u32x4*)((LB)((Lb) + O_RQ) + t * 72 + q4) = S##rq0; *(LAS u32x4*)((LB)((Lb) + O_RQ) + t * 72 + q4 + 8) = S##rq1; \
            *(LAS u32x4*)((LB)((Lb) + O_PT) + t * 72 + q4) = S##pt0; *(LAS u32x4*)((LB)((Lb) + O_PT) + t * 72 + q4 + 8) = S##pt1; \
            *(LAS u32x4*)((LB)((Lb) + O_Y0) + t * 72 + q4) = S##y00; *(LAS u32x4*)((LB)((Lb) + O_Y0) + t * 72 + q4 + 8) = S##y01; \
            { LF d_ = (LF)((Lb) + O_QT) + t * 68 + q4; *(LAS f32x4*)d_ = S##q0; *(LAS f32x4*)(d_ + 4) = S##q1; *(LAS f32x4*)(d_ + 8) = S##q2; *(LAS f32x4*)(d_ + 12) = S##q3; } } while (0)
        SC_LOAD(A, 0); SC_LOAD(B, 1);
        for (int c = 0; c < NCH; c += 2) {
            SC_WRITE(A, L); if (c + 2 < NCH) SC_LOAD(A, c + 2); RW_BAR();
            SC_WRITE(B, L + BUFB); if (c + 3 < NCH) SC_LOAD(B, c + 3); RW_BAR();
        }
        RW_BAR();
#undef SC_LOAD
#undef SC_WRITE
}
PH_FN void rw_scan_consumer(const Ctx C, int chain) {
    const float* RWW = (const float*)(unsigned char*)(C.ws + WS_RWW); const bf16* RWKK = (const bf16*)(unsigned char*)(C.ws + WS_RWKK); const bf16* RWB = (const bf16*)(unsigned char*)(C.ws + WS_RWB); bf16* RWY = (bf16*)(unsigned char*)(C.ws + WS_RWY);
    const int b = chain >> 3, h = chain & 7; const size_t rowb = (size_t)b * SEQ;
    constexpr int BUFB = 45056, O_RQ = 0, O_PT = 9216, O_QT = 18432, O_Y0 = 35840;
    LAS unsigned char* L = C.lds;
        const int n = C.lane & 31, hi = C.lane >> 5, vh = C.wave & 1;
        f32x16 st0 = zero16(), st1 = zero16();
        for (int c = 0; c < NCH; ++c) {
            RW_BAR();
            if (C.wave < 2) {
                const LAS unsigned char* Lb = L + (c & 1) * BUFB;
                CLB RQ = (CLB)(Lb + O_RQ); CLB PT = (CLB)(Lb + O_PT); CLF QT = (CLF)(Lb + O_QT); CLB Y0 = (CLB)(Lb + O_Y0);
                pg8::bf16x8 sb[4];
                { u32x4 w;
                  w.x = pk2(st0[0], st0[1]); w.y = pk2(st0[2], st0[3]); w.z = pk2(st0[4], st0[5]); w.w = pk2(st0[6], st0[7]); sb[0] = __builtin_bit_cast(pg8::bf16x8, w);
                  w.x = pk2(st0[8], st0[9]); w.y = pk2(st0[10], st0[11]); w.z = pk2(st0[12], st0[13]); w.w = pk2(st0[14], st0[15]); sb[1] = __builtin_bit_cast(pg8::bf16x8, w);
                  w.x = pk2(st1[0], st1[1]); w.y = pk2(st1[2], st1[3]); w.z = pk2(st1[4], st1[5]); w.w = pk2(st1[6], st1[7]); sb[2] = __builtin_bit_cast(pg8::bf16x8, w);
                  w.x = pk2(st1[8], st1[9]); w.y = pk2(st1[10], st1[11]); w.z = pk2(st1[12], st1[13]); w.w = pk2(st1[14], st1[15]); sb[3] = __builtin_bit_cast(pg8::bf16x8, w); }
#define SC_AFRAG(X_, row_, s_) ({ const u32x2 lo_ = *(const LAS u32x2*)((X_) + (row_) * 72 + 16 * (s_) + 4 * hi), hi_ = *(const LAS u32x2*)((X_) + (row_) * 72 + 16 * (s_) + 8 + 4 * hi); \
                    u32x4 w_; w_.x = lo_.x; w_.y = lo_.y; w_.z = hi_.x; w_.w = hi_.y; __builtin_bit_cast(pg8::bf16x8, w_); })
#pragma unroll
                for (int tt = 0; tt < 2; ++tt) { f32x16 y;
#pragma unroll
                    for (int r = 0; r < 16; ++r) y[r] = bf2f(Y0[(32 * tt + crow(r, hi)) * 72 + 32 * vh + n]);
#pragma unroll
                    for (int s = 0; s < 4; ++s) y = __builtin_amdgcn_mfma_f32_32x32x16_bf16(SC_AFRAG(RQ, 32 * tt + n, s), sb[s], y, 0, 0, 0);
                    bf16* yo = RWY + (rowb + (size_t)c * 64 + 32 * tt) * 512 + h * 64 + 32 * vh + n;
#pragma unroll
                    for (int r = 0; r < 16; ++r) yo[(size_t)crow(r, hi) * 512] = (bf16)f2bf(y[r]); }
                f32x16 n0, n1;
#pragma unroll
                for (int r = 0; r < 16; ++r) { n0[r] = QT[crow(r, hi) * 68 + 32 * vh + n]; n1[r] = QT[(32 + crow(r, hi)) * 68 + 32 * vh + n]; }
#pragma unroll
                for (int s = 0; s < 4; ++s) { n0 = __builtin_amdgcn_mfma_f32_32x32x16_bf16(SC_AFRAG(PT, n, s), sb[s], n0, 0, 0, 0); n1 = __builtin_amdgcn_mfma_f32_32x32x16_bf16(SC_AFRAG(PT, 32 + n, s), sb[s], n1, 0, 0, 0); }
                st0 = n0; st1 = n1;
#undef SC_AFRAG
            }
        }
        RW_BAR();
}
__device__ __forceinline__ void rw_scan_unit(const Ctx& C, int chain) { if (C.wave >= 4) rw_scan_producer(C, chain); else rw_scan_consumer(C, chain); }
#ifndef REP_ATTN
#define REP_ATTN 1
#endif
#ifndef REP_W
#define REP_W 1
#endif
#ifndef REP_RWC
#define REP_RWC 1
#endif
#ifndef REP_MA
#define REP_MA 1
#endif
#ifndef REP_GLAA
#define REP_GLAA 1
#endif
#ifndef REP_SSDA
#define REP_SSDA 1
#endif
#ifndef REP_RWP
#define REP_RWP 1
#endif
#ifndef REP_GLAC
#define REP_GLAC 1
#endif
#ifndef REP_SSDC
#define REP_SSDC 1
#endif
#ifndef REP_RWO
#define REP_RWO 1
#endif
#ifndef REP_MAFULL
#define REP_MAFULL 1
#endif
#ifndef REP_SCANS
#define REP_SCANS 1
#endif
#ifndef REP_MC
#define REP_MC 1
#endif
#ifndef REP_GEMM
#define REP_GEMM 1
#endif
constexpr int NPH = 12, G_FINAL = 1 + NL * NPH, G_END = G_FINAL + 1;
template <int GRP>
__global__ void __launch_bounds__(NTHR, 2) hybrid_fwd(Args args) {
    constexpr bool ALL = (GRP < 0);
    constexpr bool EN_G1 = ALL || GRP == 0, EN_G2 = EN_G1, EN_G3 = EN_G1, EN_G7 = EN_G1, EN_G8 = EN_G1, EN_G9 = EN_G1;
    constexpr bool EN_PRO = ALL || GRP == 1, EN_W = EN_PRO, EN_FIN = EN_PRO, EN_MA1 = EN_PRO, EN_MA2 = EN_PRO, EN_MA3 = EN_PRO, EN_MA4 = EN_PRO;
    constexpr bool EN_MB1 = ALL || GRP == 2, EN_MB2 = EN_MB1;
    constexpr bool EN_MC1 = ALL || GRP == 3, EN_MC2 = EN_MC1, EN_MC3 = EN_MC1;
    extern __shared__ __attribute__((aligned(16))) unsigned char lds[];
    Ctx C; C.lds = (LAS unsigned char*)lds; C.ws = (GAS unsigned char*)args.ws; C.h = (GAS float*)args.out; C.tid = threadIdx.x; C.lane = C.tid & 63; C.wave = __builtin_amdgcn_readfirstlane(C.tid >> 6); C.bid = blockIdx.x; C.G = gridDim.x;
    LAS unsigned char* ldsl = (LAS unsigned char*)lds;
    const ArgsP ap = (ArgsP)__builtin_amdgcn_kernarg_segment_ptr();
    for (int u = C.tid; u < (LDS_BYTES - LDSCTL_OFF) / 4; u += NTHR) ((LAS unsigned*)(ldsl + LDSCTL_OFF))[u] = 0u;
    __syncthreads();
    volatile LAS unsigned* MISC = (volatile LAS unsigned*)(ldsl + MISC_OFF);
    gu32* ctl = (gu32*)(args.ws + WS_CTL);
    const int g_lo = args.g_lo, g_hi = args.g_hi;
    XcdBarrier bar; bar.bar = (unsigned*)(ctl + CW_BAR); bar.x = 0; bar.st = nullptr;
    if (g_hi - g_lo > 1) bar = xcd_barrier_post((unsigned*)(ctl + CW_BAR), MISC + 8);
#define IN(g) (g_lo <= (g) && (g) < g_hi)
#define SEAM(g) do { if (IN(g) && IN((g) + 1)) xcd_barrier(bar); } while (0)
    bf16* HB = (bf16*)(args.ws + WS_HB); float* SSQ = (float*)(args.ws + WS_SSQ);

    if (EN_PRO && IN(0)) ph_prologue(fresh(C), ap);
    SEAM(0);
#pragma unroll 1
    for (int l = 0; l < NL; ++l) {
        const int gb = 1 + NPH * l;
        if (EN_W && IN(gb + 0)) { for (int rep = 0; rep < REP_W; ++rep) ph_weights(fresh(C), ap, l); }
        SEAM(gb + 0);
#pragma unroll 1
        for (int f = 0; f < 2; ++f) {
            const int gu = gb + (f ? 10 : 1);
            if (EN_G1 && IN(gu)) {
                pg8::Gemm g{HB, (const bf16*)(args.ws + (f ? WS_WGU2 : WS_WGU1)), M, 2 * FF, D, D}; pg8::StaticOrder S; S.init(M, 2 * FF, C.G, C.bid);
                pg8::EpiSwiglu E{(bf16*)(args.ws + WS_ACT), FF, SSQ, M};
                pg8::gemm_phase<pg8::EpiSwiglu, pg8::StaticOrder, true, true>(ldsl, g, S, E);
            }
            SEAM(gu);
            if (EN_G2 && IN(gu + 1)) {
                pg8::Gemm g{(const bf16*)(args.ws + WS_ACT), (const bf16*)(args.ws + (f ? WS_WD2 : WS_WD1)), M, D, FF, FF}; pg8::StaticOrder S; S.init(M, D, C.G, C.bid);
                pg8::EpiResid E{(float*)C.h, HB, SSQ, M, 0.5f};
                pg8::gemm_phase<pg8::EpiResid, pg8::StaticOrder, false, true>(ldsl, g, S, E);
            }
            SEAM(gu + 1);
            if (f == 0) {
                if (EN_G3 && IN(gb + 3)) {
                    pg8::Gemm g{HB, (const bf16*)(args.ws + WS_WIN), M, NPM, D, D}; pg8::StaticOrder S; S.init(M, NPM, C.G, C.bid);
                    pg8::EpiScaleBf16 E{(bf16*)(args.ws + WS_P), NPM, SSQ, M};
                    pg8::gemm_phase<pg8::EpiScaleBf16, pg8::StaticOrder, true, true>(ldsl, g, S, E);
                }
                SEAM(gb + 3);
                if (IN(gb + 4)) { if (EN_MA1) ph_da_prep(fresh(C)); for (int rf = 0; rf < REP_MAFULL; ++rf) { for (int rep = 0; rep < REP_MA; ++rep) { for (int r2 = 0; r2 < REP_GLAA; ++r2) if (EN_MA2) ph_gla_a(fresh(C), ap, l); for (int r2 = 0; r2 < REP_SSDA; ++r2) if (EN_MA3) ph_ssd_a(fresh(C), ap, l); for (int r2 = 0; r2 < REP_RWP; ++r2) if (EN_MA4) ph_rw_prep(fresh(C), ap, l); } if (EN_MA4 && RW_CHUNKED) ph_rw_chunk(fresh(C), C.bid); } }
                SEAM(gb + 4);
                if (IN(gb + 5)) {
#if RW_CHUNKED
#define MB_SCANS() do { if (EN_MB2) { if (C.bid < 16) rw_scan_unit(fresh(C), C.bid); else { for (int p = C.bid - 16; p < 384; p += C.G - 16) { if (p < 128) gla_scan_part(fresh(C), p); else ssd_scan_part(fresh(C), p - 128); } } } } while (0)
                    MB_SCANS();
                    for (int rs = 1; rs < REP_SCANS; ++rs) {
                        xcd_barrier(bar); if (EN_MA2) ph_gla_a(fresh(C), ap, l); if (EN_MA3) ph_ssd_a(fresh(C), ap, l); if (EN_MA4) { ph_rw_prep(fresh(C), ap, l); ph_rw_chunk(fresh(C), C.bid); } xcd_barrier(bar); MB_SCANS(); }
                    if (C.bid >= 16) { const int a = C.bid - 16; for (int rep = 0; rep < REP_ATTN; ++rep) if (EN_MB1) ph_da_attn(fresh(C), args, l, a & 7, a >> 3); }
#else
                    if (C.bid < 64) { if (EN_MB2) { const int xcd = C.bid & 7, slot = C.bid >> 3; for (int rep = 0; rep < REP_RWC; ++rep) rw_unit(fresh(C), xcd * 2 + (slot >> 2), slot & 3); } }
                    else { const int a = C.bid - 64;
                        if (EN_MB2) { for (int p = a; p < 384; p += 192) { if (p < 128) gla_scan_part(fresh(C), p); else ssd_scan_part(fresh(C), p - 128); } }
                        for (int rep = 0; rep < REP_ATTN; ++rep) if (EN_MB1) ph_da_attn(fresh(C), args, l, a & 7, a >> 3); }
#endif
                }
                SEAM(gb + 5);
                if (IN(gb + 6)) { for (int rep = 0; rep < REP_MC; ++rep) { for (int r2 = 0; r2 < REP_GLAC; ++r2) if (EN_MC1) ph_gla_c(fresh(C), ap, l); for (int r2 = 0; r2 < REP_SSDC; ++r2) if (EN_MC2) ph_ssd_c(fresh(C), ap, l); for (int r2 = 0; r2 < REP_RWO; ++r2) if (EN_MC3) ph_rw_out(fresh(C), ap, l); } }
                SEAM(gb + 6);
                if (EN_G7 && IN(gb + 7)) {
                    pg8::Gemm g{HB, (const bf16*)(args.ws + WS_WIN) + (size_t)NPM * D, M, 4096, D, D}; pg8::StaticOrder S; S.init(M, 4096, C.G, C.bid);
                    pg8::EpiScaleBf16 E{(bf16*)(args.ws + WS_PG), 4096, SSQ, M};
                    pg8::gemm_phase<pg8::EpiScaleBf16, pg8::StaticOrder, true, true>(ldsl, g, S, E);
                }
                SEAM(gb + 7);
                if (EN_G8 && IN(gb + 8)) {
                    pg8::Gemm g{(const bf16*)(args.ws + WS_YS), (const bf16*)(args.ws + WS_WB), M, D, 512, 2048}; pg8::GroupedOrder S; S.init(M, D, 4, 512, C.G, C.bid);
                    pg8::EpiGateAcc E{(bf16*)(args.ws + WS_MERGED), (const bf16*)(args.ws + WS_PG), args.in[33] + (size_t)l * 4096};
                    pg8::gemm_phase<pg8::EpiGateAcc, pg8::GroupedOrder, true, true>(ldsl, g, S, E);
                }
                SEAM(gb + 8);
                if (EN_G9 && IN(gb + 9)) {
                    pg8::Gemm g{(const bf16*)(args.ws + WS_MERGED), (const bf16*)(args.ws + WS_WO), M, D, D, D}; pg8::StaticOrder S; S.init(M, D, C.G, C.bid);
                    pg8::EpiResid E{(float*)C.h, HB, SSQ, M, 1.0f};
                    pg8::gemm_phase<pg8::EpiResid, pg8::StaticOrder, false, true>(ldsl, g, S, E);
                }
                SEAM(gb + 9);
            }
        }
    }
    if (EN_FIN && IN(G_FINAL)) ph_final(fresh(C), ap);
#undef IN
#undef SEAM
}

#ifndef ONE_LAUNCH
#define ONE_LAUNCH 1
#endif
extern "C" void kernel_launch(void* const* d_in, const int* in_sizes, int n_in, void* d_out, int out_size, void* d_ws, size_t ws_size, hipStream_t stream) {
    static int grid = 0;
    if (grid == 0) {
        if (n_in != 40 || in_sizes[0] != M * D || out_size != M * D || ws_size < WS_END) { fprintf(stderr, "kernel_launch: unexpected shapes (n_in %d, in0 %d, out %d, ws %zu < %zu); nothing launched\n", n_in, n_in > 0 ? in_sizes[0] : -1, out_size, ws_size, (size_t)WS_END); grid = -1; return; }
        int dev = 0, cus = 0, per_cu = 0;
        if (hipGetDevice(&dev) != hipSuccess || hipDeviceGetAttribute(&cus, hipDeviceAttributeMultiprocessorCount, dev) != hipSuccess) { grid = -1; return; }
#if ONE_LAUNCH
        if (hipFuncSetAttribute((const void*)hybrid_fwd<-1>, hipFuncAttributeMaxDynamicSharedMemorySize, LDS_BYTES) != hipSuccess) { fprintf(stderr, "kernel_launch: hipFuncSetAttribute failed\n"); grid = -1; return; }
#else
        if (hipFuncSetAttribute((const void*)hybrid_fwd<0>, hipFuncAttributeMaxDynamicSharedMemorySize, LDS_BYTES) != hipSuccess || hipFuncSetAttribute((const void*)hybrid_fwd<1>, hipFuncAttributeMaxDynamicSharedMemorySize, LDS_BYTES) != hipSuccess ||
            hipFuncSetAttribute((const void*)hybrid_fwd<2>, hipFuncAttributeMaxDynamicSharedMemorySize, LDS_BYTES) != hipSuccess || hipFuncSetAttribute((const void*)hybrid_fwd<3>, hipFuncAttributeMaxDynamicSharedMemorySize, LDS_BYTES) != hipSuccess) { fprintf(stderr, "kernel_launch: hipFuncSetAttribute failed\n"); grid = -1; return; }
#endif
        if (hipOccupancyMaxActiveBlocksPerMultiprocessor(&per_cu, (const void*)hybrid_fwd<(ONE_LAUNCH ? -1 : 0)>, NTHR, LDS_BYTES) != hipSuccess || per_cu < 1) fprintf(stderr, "kernel_launch: occupancy query reports %d workgroups per CU\n", per_cu);
        (void)hipGetLastError();
        grid = cus;
        if (grid != 256) { fprintf(stderr, "kernel_launch: %d CUs; this kernel is laid out for 256 workgroups; nothing launched\n", grid); grid = -1; return; }
    }
    if (grid < 0) return;
    if (hipMemsetAsync((char*)d_ws + WS_CTL, 0, CTL_ZERO_BYTES, stream) != hipSuccess) return;
    Args a{};
    for (int i = 0; i < 40; ++i) a.in[i] = (const float*)d_in[i];
    a.out = (float*)d_out; a.ws = (unsigned char*)d_ws;
    for (int j = 0; j < 32; ++j) a.inv_freq[j] = (float)pow(10000.0, -(double)j / 32.0);
#if ONE_LAUNCH
    a.g_lo = 0; a.g_hi = G_END;
    hipLaunchKernelGGL(hybrid_fwd<-1>, dim3(grid), dim3(NTHR), LDS_BYTES, stream, a);
#else
    for (int g = 0; g < G_END; ++g) {
        a.g_lo = g; a.g_hi = g + 1;
        int grp = 1;
        if (g >= 1 && g < G_FINAL) { const int k = (g - 1) % NPH; grp = (k == 0 || k == 4) ? 1 : (k == 5) ? 2 : (k == 6) ? 3 : 0; }
        if (grp == 0) hipLaunchKernelGGL(hybrid_fwd<0>, dim3(grid), dim3(NTHR), LDS_BYTES, stream, a);
        else if (grp == 1) hipLaunchKernelGGL(hybrid_fwd<1>, dim3(grid), dim3(NTHR), LDS_BYTES, stream, a);
        else if (grp == 2) hipLaunchKernelGGL(hybrid_fwd<2>, dim3(grid), dim3(NTHR), LDS_BYTES, stream, a);
        else hipLaunchKernelGGL(hybrid_fwd<3>, dim3(grid), dim3(NTHR), LDS_BYTES, stream, a);
    }
#endif
}
```

```cpp
#include <hip/hip_runtime.h>
#include <cstdio>
#include <cstdint>
#include <cmath>

namespace pg8 {
#define PG8_LAS __attribute__((address_space(3)))
typedef unsigned short bf16_t;
typedef short bf16x8 __attribute__((ext_vector_type(8)));
typedef float f32x4 __attribute__((ext_vector_type(4)));
typedef unsigned u32x4 __attribute__((ext_vector_type(4)));
constexpr int BM = 256, BK = 64, HALF = 128, HTB = HALF * BK * 2  , STAGE_BYTES = 8 * HTB, NXCD = 8, WGM = 8;

__host__ __device__ __forceinline__ int lds_byte(int r, int c) { const int st = (r >> 4) * 2 + (c >> 5), rr = r & 15, cc = c & 31, ob = rr * 64 + cc * 2; return st * 1024 + (ob ^ (((ob >> 9) & 1) << 5)); }
__host__ __device__ __forceinline__ void stage_rc(int b, int& R, int& C) { const int st = b / 1024, sb = b % 1024, swz = sb ^ (((sb >> 9) & 1) << 5); R = (st >> 1) * 16 + swz / 64; C = (st & 1) * 32 + (swz % 64) / 2; }
__host__ __device__ __forceinline__ int perm32(int rho) { const int n = rho >> 4, i = rho & 15; return 8 * (i >> 2) + 4 * n + (i & 3); }

struct Unit { int pm, pn, z; };
struct Gemm { const bf16_t* A; const bf16_t* Bt; int M, N, K, lda; };

struct StaticOrder {
    int nM, nN, nwg, G, c;
    __host__ __device__ void init(int M, int N, int G_, int c_) { nM = M / BM; nN = N / BM; nwg = nM * nN; G = G_; c = c_; }
    __host__ __device__ bool next(int i, Unit& u) const {
        const long L = (long)i * G + c; if (L >= nwg) return false;
        int wgid = (int)L; { const int q = nwg / NXCD, r = nwg % NXCD, xcd = wgid % NXCD, off = wgid / NXCD; wgid = (xcd < r ? xcd * (q + 1) : r * (q + 1) + (xcd - r) * q) + off; }
        const int nig = WGM * nN, gid = wgid / nig, fm = gid * WGM, gsz = (nM - fm) < WGM ? (nM - fm) : WGM;
        u.pm = fm + ((wgid % nig) % gsz); u.pn = (wgid % nig) / gsz; u.z = 0; return true;
    }
    __device__ __forceinline__ void a_ready(const Unit&) const {}
    __device__ __forceinline__ void done(const Unit&) const {}
    __device__ __forceinline__ size_t a_off(const Unit&) const { return 0; }
    __device__ __forceinline__ int b_tile(const Unit& u) const { return u.pn; }
};
struct GroupedOrder {
    StaticOrder base; int NZ, Kbytes, tiles_per_group;
    __device__ void init(int M, int N, int NZ_, int K, int G_, int c_) { base.init(M, N, G_, c_); NZ = NZ_; Kbytes = K * 2; tiles_per_group = N / BM; }
    __device__ bool next(int i, Unit& u) const { const int r = i / NZ, z = i - r * NZ; if (!base.next(r, u)) return false; u.z = z; return true; }
    __device__ __forceinline__ void a_ready(const Unit&) const {}
    __device__ __forceinline__ void done(const Unit&) const {}
    __device__ __forceinline__ size_t a_off(const Unit& u) const { return (size_t)u.z * Kbytes; }
    __device__ __forceinline__ int b_tile(const Unit& u) const { return u.z * tiles_per_group + u.pn; }
};

__device__ __forceinline__ unsigned cvt_pk_bf16(float lo, float hi) { unsigned r; asm volatile("v_cvt_pk_bf16_f32 %0, %1, %2" : "=v"(r) : "v"(lo), "v"(hi)); return r; }
__device__ __forceinline__ float bf_lo(unsigned w) { return __uint_as_float(w << 16); }
__device__ __forceinline__ float bf_hi(unsigned w) { return __uint_as_float(w & 0xffff0000u); }
__device__ __forceinline__ float fast_sigmoid(float x) { return __builtin_amdgcn_rcpf(1.0f + __builtin_amdgcn_exp2f(-1.4426950408889634f * x)); }

__device__ __forceinline__ float row_rstd(const float* ssq, int row, int M_) {
    const float s = (ssq[row] + ssq[M_ + row]) + (ssq[2 * M_ + row] + ssq[3 * M_ + row]);
    return 1.0f / sqrtf(s * (1.0f / 1024.0f) + 1e-6f);
}
struct EpiScaleBf16 {
    static constexpr bool PERM = true, AFTER_DRAIN = false; static constexpr int SEG_TILES = 0;
    bf16_t* O; int ldc; const float* ssq; int M_;
    __device__ __forceinline__ void operator()(const f32x4 (&acc)[2][2][4][2], const Unit& u, int wr, int wc, int fr, int fq) const {
        const int row0 = u.pm * BM + wr * 64 + fr; const int col0 = u.pn * BM + wc * 32 + 8 * fq;
#pragma unroll
        for (int ai = 0; ai < 2; ++ai)
#pragma unroll
            for (int m = 0; m < 4; ++m) { const int row = row0 + ai * HALF + m * 16; const float rs = row_rstd(ssq, row, M_); bf16_t* rowp = O + (size_t)row * ldc + col0;
#pragma unroll
                for (int bj = 0; bj < 2; ++bj) { const f32x4 v0 = acc[ai][bj][m][0] * rs, v1 = acc[ai][bj][m][1] * rs;
                    u32x4 w; w.x = cvt_pk_bf16(v0[0], v0[1]); w.y = cvt_pk_bf16(v0[2], v0[3]); w.z = cvt_pk_bf16(v1[0], v1[1]); w.w = cvt_pk_bf16(v1[2], v1[3]);
                    *(u32x4*)(rowp + bj * HALF) = w; } }
    }
};
struct EpiSwiglu {
    static constexpr bool PERM = true, AFTER_DRAIN = false; static constexpr int SEG_TILES = 0;
    bf16_t* O; int ldc; const float* ssq; int M_;
    __device__ __forceinline__ void operator()(const f32x4 (&acc)[2][2][4][2], const Unit& u, int wr, int wc, int fr, int fq) const {
        const int row0 = u.pm * BM + wr * 64 + fr; const int col0 = u.pn * HALF + wc * 32 + 8 * fq;
#pragma unroll
        for (int ai = 0; ai < 2; ++ai)
#pragma unroll
            for (int m = 0; m < 4; ++m) { const int row = row0 + ai * HALF + m * 16; const float rs = row_rstd(ssq, row, M_); bf16_t* rowp = O + (size_t)row * ldc + col0;
                float o[8];
#pragma unroll
                for (int n = 0; n < 2; ++n)
#pragma unroll
                    for (int i = 0; i < 4; ++i) { const float g = acc[ai][0][m][n][i] * rs, up = acc[ai][1][m][n][i] * rs; o[n * 4 + i] = g * fast_sigmoid(g) * up; }
                u32x4 w; w.x = cvt_pk_bf16(o[0], o[1]); w.y = cvt_pk_bf16(o[2], o[3]); w.z = cvt_pk_bf16(o[4], o[5]); w.w = cvt_pk_bf16(o[6], o[7]);
                *(u32x4*)rowp = w; }
    }
};
struct EpiGateAcc {
    static constexpr bool PERM = true, AFTER_DRAIN = false; static constexpr int SEG_TILES = 0;
    bf16_t* O; const bf16_t* PG; const float* gb;
    __device__ __forceinline__ void operator()(const f32x4 (&acc)[2][2][4][2], const Unit& u, int wr, int wc, int fr, int fq) const {
        const int row0 = u.pm * BM + wr * 64 + fr; const int col0 = u.pn * BM + wc * 32 + 8 * fq; const int z = u.z;
        f32x4 gbv[2][2];
#pragma unroll
        for (int bj = 0; bj < 2; ++bj)
#pragma unroll
            for (int n = 0; n < 2; ++n) gbv[bj][n] = *(const f32x4*)(gb + z * 1024 + col0 + bj * HALF + 4 * n);
#pragma unroll
        for (int ai = 0; ai < 2; ++ai)
#pragma unroll
            for (int m = 0; m < 4; ++m) { const int row = row0 + ai * HALF + m * 16;
#pragma unroll
                for (int bj = 0; bj < 2; ++bj) {
                    const u32x4 pg = *(const u32x4*)(PG + (size_t)row * 4096 + z * 1024 + col0 + bj * HALF);
                    bf16_t* op = O + (size_t)row * 1024 + col0 + bj * HALF;
                    float o[8];
                    o[0] = fast_sigmoid(bf_lo(pg.x) + gbv[bj][0][0]) * acc[ai][bj][m][0][0]; o[1] = fast_sigmoid(bf_hi(pg.x) + gbv[bj][0][1]) * acc[ai][bj][m][0][1];
                    o[2] = fast_sigmoid(bf_lo(pg.y) + gbv[bj][0][2]) * acc[ai][bj][m][0][2]; o[3] = fast_sigmoid(bf_hi(pg.y) + gbv[bj][0][3]) * acc[ai][bj][m][0][3];
                    o[4] = fast_sigmoid(bf_lo(pg.z) + gbv[bj][1][0]) * acc[ai][bj][m][1][0]; o[5] = fast_sigmoid(bf_hi(pg.z) + gbv[bj][1][1]) * acc[ai][bj][m][1][1];
                    o[6] = fast_sigmoid(bf_lo(pg.w) + gbv[bj][1][2]) * acc[ai][bj][m][1][2]; o[7] = fast_sigmoid(bf_hi(pg.w) + gbv[bj][1][3]) * acc[ai][bj][m][1][3];
                    if (z > 0) { const u32x4 pv = *(const u32x4*)op;
                        o[0] += bf_lo(pv.x); o[1] += bf_hi(pv.x); o[2] += bf_lo(pv.y); o[3] += bf_hi(pv.y); o[4] += bf_lo(pv.z); o[5] += bf_hi(pv.z); o[6] += bf_lo(pv.w); o[7] += bf_hi(pv.w); }
                    u32x4 w; w.x = cvt_pk_bf16(o[0], o[1]); w.y = cvt_pk_bf16(o[2], o[3]); w.z = cvt_pk_bf16(o[4], o[5]); w.w = cvt_pk_bf16(o[6], o[7]);
                    *(u32x4*)op = w; } }
    }
};
struct EpiGateHorner {
    static constexpr bool PERM = true, AFTER_DRAIN = false; static constexpr int SEG_TILES = 8;
    bf16_t* O; const bf16_t* PG; const float* gb;
    __device__ __forceinline__ void em8(const bf16_t* pgp, const float* gbp, float* e) const {
        const u32x4 pg = *(const u32x4*)pgp; const f32x4 b0 = *(const f32x4*)gbp, b1 = *(const f32x4*)(gbp + 4);
        e[0] = __builtin_amdgcn_exp2f(-1.4426950408889634f * (bf_lo(pg.x) + b0[0])); e[1] = __builtin_amdgcn_exp2f(-1.4426950408889634f * (bf_hi(pg.x) + b0[1]));
        e[2] = __builtin_amdgcn_exp2f(-1.4426950408889634f * (bf_lo(pg.y) + b0[2])); e[3] = __builtin_amdgcn_exp2f(-1.4426950408889634f * (bf_hi(pg.y) + b0[3]));
        e[4] = __builtin_amdgcn_exp2f(-1.4426950408889634f * (bf_lo(pg.z) + b1[0])); e[5] = __builtin_amdgcn_exp2f(-1.4426950408889634f * (bf_hi(pg.z) + b1[1]));
        e[6] = __builtin_amdgcn_exp2f(-1.4426950408889634f * (bf_lo(pg.w) + b1[2])); e[7] = __builtin_amdgcn_exp2f(-1.4426950408889634f * (bf_hi(pg.w) + b1[3]));
    }
    __device__ __forceinline__ void seg(f32x4 (&acc)[2][2][4][2], const Unit& u, int z, int wr, int wc, int fr, int fq) const {
        const int row0 = u.pm * BM + wr * 64 + fr; const int col0 = u.pn * BM + wc * 32 + 8 * fq;
#pragma unroll
        for (int ai = 0; ai < 2; ++ai)
#pragma unroll
            for (int m = 0; m < 4; ++m) { const int row = row0 + ai * HALF + m * 16;
#pragma unroll
                for (int bj = 0; bj < 2; ++bj) { const int c = col0 + bj * HALF; float ea[8], eb[8];
                    em8(PG + (size_t)row * 4096 + z * 1024 + c, gb + z * 1024 + c, ea); em8(PG + (size_t)row * 4096 + (z + 1) * 1024 + c, gb + (z + 1) * 1024 + c, eb);
#pragma unroll
                    for (int i = 0; i < 4; ++i) { acc[ai][bj][m][0][i] *= (1.0f + eb[i]) * __builtin_amdgcn_rcpf(1.0f + ea[i]); acc[ai][bj][m][1][i] *= (1.0f + eb[4 + i]) * __builtin_amdgcn_rcpf(1.0f + ea[4 + i]); } }
                if (m & 1) asm volatile("" ::: "memory"); }
    }
    __device__ __forceinline__ void operator()(const f32x4 (&acc)[2][2][4][2], const Unit& u, int wr, int wc, int fr, int fq) const {
        const int row0 = u.pm * BM + wr * 64 + fr; const int col0 = u.pn * BM + wc * 32 + 8 * fq;
#pragma unroll
        for (int ai = 0; ai < 2; ++ai)
#pragma unroll
            for (int m = 0; m < 4; ++m) { const int row = row0 + ai * HALF + m * 16;
#pragma unroll
                for (int bj = 0; bj < 2; ++bj) { const int c = col0 + bj * HALF; float e[8], o[8];
                    em8(PG + (size_t)row * 4096 + 3 * 1024 + c, gb + 3 * 1024 + c, e);
#pragma unroll
                    for (int i = 0; i < 4; ++i) { o[i] = acc[ai][bj][m][0][i] * __builtin_amdgcn_rcpf(1.0f + e[i]); o[4 + i] = acc[ai][bj][m][1][i] * __builtin_amdgcn_rcpf(1.0f + e[4 + i]); }
                    u32x4 w; w.x = cvt_pk_bf16(o[0], o[1]); w.y = cvt_pk_bf16(o[2], o[3]); w.z = cvt_pk_bf16(o[4], o[5]); w.w = cvt_pk_bf16(o[6], o[7]);
                    *(u32x4*)(O + (size_t)row * 1024 + c) = w; } }
    }
};
struct EpiResid {
    static constexpr bool PERM = true, AFTER_DRAIN = true; static constexpr int SEG_TILES = 0;
    bf16_t* HB; float* ssq; int M_; float s;
    __device__ __forceinline__ void fused(f32x4 (&acc)[2][2][4][2], const Unit& u, int wr, int wc, int fr, int fq, PG8_LAS unsigned char* lds, int wid, int lane) const {
        PG8_LAS float* P = (PG8_LAS float*)lds;
        const int row0 = u.pm * BM + wr * 64 + fr; const int col0 = u.pn * BM + wc * 32 + 8 * fq;
#pragma unroll
        for (int ai = 0; ai < 2; ++ai)
#pragma unroll
            for (int m = 0; m < 4; ++m) { const int row = row0 + ai * HALF + m * 16; float q = 0.f;
#pragma unroll
                for (int bj = 0; bj < 2; ++bj) { bf16_t* hp = HB + (size_t)row * 1024 + col0 + bj * HALF; const u32x4 hw = *(const u32x4*)hp;
                    const f32x4 h0 = (f32x4){bf_lo(hw.x), bf_hi(hw.x), bf_lo(hw.y), bf_hi(hw.y)} + acc[ai][bj][m][0] * s, h1 = (f32x4){bf_lo(hw.z), bf_hi(hw.z), bf_lo(hw.w), bf_hi(hw.w)} + acc[ai][bj][m][1] * s;
                    q += (h0[0] * h0[0] + h0[1] * h0[1]) + (h0[2] * h0[2] + h0[3] * h0[3]) + (h1[0] * h1[0] + h1[1] * h1[1]) + (h1[2] * h1[2] + h1[3] * h1[3]);
                    u32x4 w; w.x = cvt_pk_bf16(h0[0], h0[1]); w.y = cvt_pk_bf16(h0[2], h0[3]); w.z = cvt_pk_bf16(h1[0], h1[1]); w.w = cvt_pk_bf16(h1[2], h1[3]);
                    *(u32x4*)hp = w; }
                q += __shfl_xor(q, 16); q += __shfl_xor(q, 32);
                if (fq == 0) P[(ai * HALF + wr * 64 + m * 16 + fr) * 4 + wc] = q; }
        asm volatile("s_waitcnt lgkmcnt(0)" ::: "memory"); __builtin_amdgcn_s_barrier(); asm volatile("" ::: "memory");
        const int t = wid * 64 + lane;
        if (t < 256) { const float q = (P[t * 4 + 0] + P[t * 4 + 1]) + (P[t * 4 + 2] + P[t * 4 + 3]); ssq[(size_t)u.pn * M_ + u.pm * BM + t] = q; }
        asm volatile("s_waitcnt lgkmcnt(0)" ::: "memory"); __builtin_amdgcn_s_barrier(); asm volatile("" ::: "memory");
    }
};
template <class Epi, class Sched, bool ALIGN_EPI = false, bool SP2 = false>
__device__ __forceinline__ void gemm_phase(PG8_LAS unsigned char* lds, const Gemm g, const Sched& S, const Epi& E) {
    int tid_ = threadIdx.x; asm volatile("" : "+v"(tid_)); const int tid = tid_, wid = __builtin_amdgcn_readfirstlane(tid >> 6), lane = tid & 63, wr = wid >> 2, wc = wid & 3, fr = lane & 15, fq = lane >> 4;
    const int K = g.K, nt = K / BK;
    unsigned voffA[2], voffB[2];
#pragma unroll
    for (int i = 0; i < 2; ++i) { int R, C; stage_rc(tid * 16 + i * 8192, R, C); const int Rb = Epi::PERM ? ((R & ~31) + perm32(R & 31)) : R;
        voffA[i] = (unsigned)(R * g.lda + C) * 2u; voffB[i] = (unsigned)(Rb * K + C) * 2u; }
    const size_t kstep = (size_t)(BK * 2);
    const size_t hstep = (size_t)HALF * K * 2;
    const size_t tstep = 2 * hstep; const size_t hstepA = (size_t)HALF * g.lda * 2, tstepA = 2 * hstepA;
    const unsigned ldsw = (unsigned)wid * 1024u;
    const int aoff = lds_byte(wr * 64 + fr, fq * 8), boff = lds_byte(wc * 32 + fr, fq * 8);
#define PG8_SA(b, h) (((b) * 2 + (h)) * HTB)
#define PG8_SB(b, h) ((4 + (b) * 2 + (h)) * HTB)
#define PG8_STAGE(bufoff, gbase, voff) do { _Pragma("unroll") for (int _i = 0; _i < 2; ++_i) \
        __builtin_amdgcn_global_load_lds((const unsigned*)((const char*)(gbase) + (voff)[_i]), (PG8_LAS unsigned*)(lds + (bufoff) + ldsw + _i * 8192), 16, 0, 0); } while (0)
#define PG8_LDA(dst, b, h) do { _Pragma("unroll") for (int m = 0; m < 4; ++m) _Pragma("unroll") for (int k = 0; k < 2; ++k) dst[m][k] = *(const PG8_LAS bf16x8*)(lds + PG8_SA(b, h) + aoff + m * 2048 + k * 1024); } while (0)
#define PG8_LDB(dst, b, h) do { _Pragma("unroll") for (int n = 0; n < 2; ++n) _Pragma("unroll") for (int k = 0; k < 2; ++k) dst[n][k] = *(const PG8_LAS bf16x8*)(lds + PG8_SB(b, h) + boff + n * 2048 + k * 1024); } while (0)
#define PG8_MMA(ai, bj, At, Bt) do { __builtin_amdgcn_s_setprio(1); _Pragma("unroll") for (int m = 0; m < 4; ++m) _Pragma("unroll") for (int n = 0; n < 2; ++n) _Pragma("unroll") for (int k = 0; k < 2; ++k) \
        acc[ai][bj][m][n] = __builtin_amdgcn_mfma_f32_16x16x32_bf16(Bt[n][k], At[m][k], acc[ai][bj][m][n], 0, 0, 0); __builtin_amdgcn_s_setprio(0); } while (0)
#define PG8_WAIT_V(n) asm volatile("s_waitcnt vmcnt(" #n ")" ::: "memory")
#define PG8_WAIT_L(n) asm volatile("s_waitcnt lgkmcnt(" #n ")" ::: "memory")
#define PG8_BAR __builtin_amdgcn_s_barrier()
#define PG8_SCHED __builtin_amdgcn_sched_barrier(0)
    Unit cur, nxt; int ui = 0;
    if (!S.next(0, cur)) return;
    f32x4 acc[2][2][4][2];
#pragma unroll
    for (int a = 0; a < 2; ++a)
#pragma unroll
        for (int b = 0; b < 2; ++b)
#pragma unroll
            for (int m = 0; m < 4; ++m)
#pragma unroll
                for (int n = 0; n < 2; ++n) acc[a][b][m][n] = (f32x4){0.f, 0.f, 0.f, 0.f};
    bf16x8 At[4][2], B0[2][2], B1[2][2];
    const char* cA = (const char*)g.A + (size_t)cur.pm * tstepA + S.a_off(cur); const char* cB = (const char*)g.Bt + (size_t)S.b_tile(cur) * tstep;
    S.a_ready(cur);
    if constexpr (SP2) {
        PG8_STAGE(PG8_SB(0, 0), cB, voffB); PG8_STAGE(PG8_SB(0, 1), cB + hstep, voffB); PG8_STAGE(PG8_SA(0, 0), cA, voffA); PG8_STAGE(PG8_SA(0, 1), cA + hstepA, voffA);
        if (wr == 1) PG8_BAR;
        PG8_WAIT_V(2); PG8_BAR;
        PG8_STAGE(PG8_SB(1, 0), cB + kstep, voffB); PG8_STAGE(PG8_SA(1, 0), cA + kstep, voffA); PG8_STAGE(PG8_SB(1, 1), cB + hstep + kstep, voffB);
        PG8_WAIT_V(6); PG8_BAR;
    } else {
        PG8_STAGE(PG8_SB(0, 0), cB, voffB); PG8_STAGE(PG8_SA(0, 0), cA, voffA); PG8_STAGE(PG8_SB(0, 1), cB + hstep, voffB); PG8_STAGE(PG8_SA(0, 1), cA + hstepA, voffA);
        if (wr == 1) PG8_BAR;
        PG8_WAIT_V(4); PG8_BAR;
        PG8_STAGE(PG8_SB(1, 0), cB + kstep, voffB); PG8_STAGE(PG8_SA(1, 0), cA + kstep, voffA); PG8_STAGE(PG8_SB(1, 1), cB + hstep + kstep, voffB);
        PG8_WAIT_V(6); PG8_BAR;
    }
    for (;;) {
        const bool has_next = S.next(ui + 1, nxt);
        const char* nA = has_next ? (const char*)g.A + (size_t)nxt.pm * tstepA + S.a_off(nxt) : cA; const char* nB = has_next ? (const char*)g.Bt + (size_t)S.b_tile(nxt) * tstep : cB;
        for (int t = 0; t < nt; t += 2) {
            const bool last = (t == nt - 2);
            const char* a1 = cA + (size_t)(t + 1) * kstep;
            const char* a2 = last ? nA : cA + (size_t)(t + 2) * kstep; const char* b2 = last ? nB : cB + (size_t)(t + 2) * kstep;
            const char* a3 = a2 + kstep; const char* b3 = b2 + kstep;
            if (last && has_next) S.a_ready(nxt);
            if constexpr (SP2) {
            PG8_LDB(B0, 0, 0); PG8_LDB(B1, 0, 1); PG8_SCHED; PG8_LDA(At, 0, 0); PG8_STAGE(PG8_SA(1, 1), a1 + hstepA, voffA);
            PG8_WAIT_V(8); PG8_WAIT_L(0); PG8_BAR; PG8_MMA(0, 0, At, B0); PG8_MMA(0, 1, At, B1); PG8_BAR; PG8_SCHED;
            PG8_LDA(At, 0, 1); PG8_STAGE(PG8_SB(0, 0), b2, voffB); PG8_STAGE(PG8_SB(0, 1), b2 + hstep, voffB); PG8_STAGE(PG8_SA(0, 0), a2, voffA);
            PG8_WAIT_V(8); PG8_WAIT_L(0); PG8_BAR; PG8_MMA(1, 0, At, B0); PG8_MMA(1, 1, At, B1); PG8_BAR; PG8_SCHED;
            PG8_LDB(B0, 1, 0); PG8_LDB(B1, 1, 1); PG8_SCHED; PG8_LDA(At, 1, 0); PG8_STAGE(PG8_SA(0, 1), a2 + hstepA, voffA);
            PG8_WAIT_V(8); PG8_WAIT_L(0); PG8_BAR; PG8_MMA(0, 0, At, B0); PG8_MMA(0, 1, At, B1); PG8_BAR; PG8_SCHED;
            PG8_LDA(At, 1, 1); PG8_STAGE(PG8_SB(1, 0), b3, voffB); PG8_STAGE(PG8_SB(1, 1), b3 + hstep, voffB); PG8_STAGE(PG8_SA(1, 0), a3, voffA);
            PG8_WAIT_V(8); PG8_WAIT_L(0); PG8_BAR; PG8_MMA(1, 0, At, B0); PG8_MMA(1, 1, At, B1); PG8_BAR; PG8_SCHED;
            } else {
            PG8_LDB(B0, 0, 0); PG8_SCHED; PG8_LDA(At, 0, 0); PG8_STAGE(PG8_SA(1, 1), a1 + hstepA, voffA);
            PG8_WAIT_L(8); PG8_BAR; PG8_WAIT_L(0); PG8_MMA(0, 0, At, B0); PG8_BAR; PG8_SCHED;
            PG8_LDB(B1, 0, 1); PG8_STAGE(PG8_SB(0, 0), b2, voffB);
            PG8_BAR; PG8_WAIT_L(0); PG8_MMA(0, 1, At, B1); PG8_BAR;
            PG8_LDA(At, 0, 1); PG8_STAGE(PG8_SA(0, 0), a2, voffA);
            PG8_BAR; PG8_WAIT_L(0); PG8_MMA(1, 0, At, B0); PG8_BAR; PG8_SCHED;
            PG8_STAGE(PG8_SB(0, 1), b2 + hstep, voffB);
            PG8_WAIT_V(6); PG8_BAR; PG8_MMA(1, 1, At, B1); PG8_BAR;
            PG8_LDB(B0, 1, 0); PG8_SCHED; PG8_LDA(At, 1, 0); PG8_STAGE(PG8_SA(0, 1), a2 + hstepA, voffA);
            PG8_WAIT_L(8); PG8_BAR; PG8_WAIT_L(0); PG8_MMA(0, 0, At, B0); PG8_BAR; PG8_SCHED;
            PG8_LDB(B1, 1, 1); PG8_STAGE(PG8_SB(1, 0), b3, voffB);
            PG8_BAR; PG8_WAIT_L(0); PG8_MMA(0, 1, At, B1); PG8_BAR;
            PG8_LDA(At, 1, 1); PG8_STAGE(PG8_SA(1, 0), a3, voffA);
            PG8_BAR; PG8_WAIT_L(0); PG8_MMA(1, 0, At, B0); PG8_BAR; PG8_SCHED;
            PG8_STAGE(PG8_SB(1, 1), b3 + hstep, voffB);
            PG8_WAIT_V(6); PG8_BAR; PG8_MMA(1, 1, At, B1); PG8_BAR;
            }
            if constexpr (Epi::SEG_TILES > 0) { if (((t + 2) % Epi::SEG_TILES) == 0 && (t + 2) < nt) { E.seg(acc, cur, (t + 2) / Epi::SEG_TILES - 1, wr, wc, fr, fq); PG8_WAIT_V(0); PG8_SCHED; } }
        }
        if constexpr (ALIGN_EPI) { if (wr == 0) PG8_BAR; }
        if constexpr (!Epi::AFTER_DRAIN) { E(acc, cur, wr, wc, fr, fq); S.done(cur); }
        if (!has_next) break;
#pragma unroll
        for (int a = 0; a < 2; ++a)
#pragma unroll
            for (int b = 0; b < 2; ++b)
#pragma unroll
                for (int m = 0; m < 4; ++m)
#pragma unroll
                    for (int n = 0; n < 2; ++n) acc[a][b][m][n] = (f32x4){0.f, 0.f, 0.f, 0.f};
        cur = nxt; cA = nA; cB = nB; ++ui;
        if constexpr (ALIGN_EPI) { if (wr == 1) PG8_BAR; }
    }
    PG8_WAIT_V(0);
    if constexpr (!ALIGN_EPI) { if (wr == 0) PG8_BAR; }
    PG8_BAR;
    if constexpr (Epi::AFTER_DRAIN) { E.fused(acc, cur, wr, wc, fr, fq, lds, wid, lane); S.done(cur); }
#undef PG8_SA
#undef PG8_SB
#undef PG8_STAGE
#undef PG8_LDA
#undef PG8_LDB
#undef PG8_MMA
#undef PG8_WAIT_V
#undef PG8_WAIT_L
#undef PG8_BAR
#undef PG8_SCHED
}
}

constexpr int NWAVES = 8, NTHR = 512;
constexpr int M = 16384, SEQ = 8192, D = 1024, FF = 2816, NL = 4, NCH = 128  , NBC = 256  ;
constexpr int NPM = 6656;
constexpr int NWIN = 10752;
constexpr int C_DAQ = 0, C_DAK = 512, C_DAV = 1024, C_GQ = 1536, C_GK = 1792, C_GV = 2048, C_GOG = 2560, C_SZ = 3072, C_SX = 3584, C_SB = 4096, C_SC = 4352,
              C_RR = 4608, C_RK = 5120, C_RV = 5632, C_RWL = 6144, C_RAL = 6208, C_RGL = 6272, C_GLR = 6400, C_SDT = 6416;
constexpr float EPS = 1e-6f, LOG2E = 1.4426950408889634f;

constexpr size_t MiB = 1u << 20;
constexpr size_t WS_CTL = 0, CTL_ZERO_BYTES = 1 * MiB;
constexpr size_t WS_COS = 1 * MiB, WS_SIN = 2 * MiB, WS_SSQ = 3 * MiB, WS_GLAST = 3 * MiB + 512 * 1024, WS_SDT = 4 * MiB, WS_SACUM = 4 * MiB + 512 * 1024, WS_SCDEC = 5 * MiB, WS_RW2T = 5 * MiB + 64 * 1024;
constexpr size_t WS_WGU1 = 8 * MiB, WS_WD1 = 19 * MiB, WS_WIN = 24 * MiB + 512 * 1024, WS_WB = 45 * MiB + 512 * 1024, WS_WO = 49 * MiB + 512 * 1024, WS_WGU2 = 51 * MiB + 512 * 1024, WS_WD2 = 62 * MiB + 512 * 1024;
constexpr size_t WS_HB = 68 * MiB, WS_P = 100 * MiB, WS_PG = 100 * MiB, WS_YS = 308 * MiB, WS_R1 = 372 * MiB, WS_R2 = 500 * MiB, WS_END = 644 * MiB;
constexpr size_t WS_ACT = WS_R1, WS_MERGED = WS_R1;
constexpr size_t WS_RWW = WS_R1, WS_RWR = WS_R1 + 32 * MiB, WS_RWK = WS_R1 + 48 * MiB, WS_RWV = WS_R1 + 64 * MiB, WS_RWKK = WS_R1 + 80 * MiB, WS_RWB = WS_R1 + 96 * MiB, WS_RWG = WS_R1 + 112 * MiB;
constexpr size_t WS_VT = WS_R2, WS_GKV = WS_R2 + 16 * MiB, WS_SST = WS_R2 + 48 * MiB, WS_RWY = WS_R2 + 112 * MiB;
static_assert(WS_WD2 + (size_t)D * FF * 2 <= WS_HB && WS_P + (size_t)M * NPM * 2 <= WS_YS && WS_RWY + (size_t)M * 512 * 2 <= WS_END, "d_ws map");
constexpr int CW_BAR = 4096;

constexpr int RING_BYTES = 131072, LDSCTL_OFF = RING_BYTES, MISC_OFF = LDSCTL_OFF + 320, LDS_BYTES = 147456;

#define GAS __attribute__((address_space(1)))
#define LAS __attribute__((address_space(3)))
typedef unsigned short bf16;
typedef unsigned v4u __attribute__((ext_vector_type(4)));
typedef float f32x4 __attribute__((ext_vector_type(4)));
typedef short bf16x8 __attribute__((ext_vector_type(8)));
typedef GAS unsigned gu32;
typedef GAS unsigned long long gu64;
#define RLX_AGENT __ATOMIC_RELAXED, __HIP_MEMORY_SCOPE_AGENT
#define LDS_WAIT() asm volatile("s_waitcnt lgkmcnt(0)" ::: "memory")
#define VM_WAIT() asm volatile("s_waitcnt vmcnt(0)" ::: "memory")
__device__ __forceinline__ unsigned long long rt() { return __builtin_amdgcn_s_memrealtime(); }
typedef float f32x2_cv __attribute__((ext_vector_type(2))); typedef __bf16 bf16x2_cv __attribute__((ext_vector_type(2)));
__device__ __forceinline__ unsigned pk2(float lo, float hi) { const f32x2_cv v = {lo, hi}; const bf16x2_cv b = __builtin_convertvector(v, bf16x2_cv); return __builtin_bit_cast(unsigned, b); }
__device__ __forceinline__ unsigned f2bf(float f) { return pk2(f, 0.f) & 0xffffu; }

#define XB_TMO      128
#define XB_XCNT(j)  (256  + 64 * (j))
#define XB_XSUB(j)  (1280 + 64 * (j))
#define XB_XGEN(j)  (2304 + 64 * (j))
#define XB_TOP      3328
#define XB_TOPGEN   3392
#define XCD_BAR_WORDS 3456
#define XB_SPIN_CAP (1u << 18)

__device__ __forceinline__ unsigned xb_ld(unsigned* p)              { return __hip_atomic_load(p, __ATOMIC_RELAXED, __HIP_MEMORY_SCOPE_AGENT); }
__device__ __forceinline__ unsigned xb_add(unsigned* p, unsigned v) { return __hip_atomic_fetch_add(p, v, __ATOMIC_RELAXED, __HIP_MEMORY_SCOPE_AGENT); }
__device__ __forceinline__ unsigned xb_xcc_id() { return (unsigned)__builtin_amdgcn_s_getreg((3 << 11) | 20) & 0xFu; }
#define XB_SPIN(cond, bar) do { unsigned _sp = 0; while (cond) { __builtin_amdgcn_s_sleep(1); \
    if ((++_sp & 255u) == 0u) { if (xb_ld(&(bar)[XB_TMO])) break; if (_sp > XB_SPIN_CAP) { atomicAdd(&(bar)[XB_TMO], 1u); break; } } } } while (0)

struct XcdBarrier {
    unsigned* bar; unsigned x;
    volatile LAS unsigned* st;
};

__device__ __forceinline__ XcdBarrier xcd_barrier_post(unsigned* bar, volatile LAS unsigned* st) {
    XcdBarrier b; b.bar = bar; b.x = xb_xcc_id(); b.st = st;
    if (threadIdx.x == 0) (void)xb_add(&bar[XB_XCNT(b.x)], 1u);
    return b;
}
__device__ __forceinline__ void xcd_barrier_complete(unsigned* bar, unsigned x, unsigned& nloc, unsigned& nx) {
    const unsigned G = gridDim.x * gridDim.y * gridDim.z;
    unsigned sum, cnt, mine, sp = 0u;
    for (;;) {
        sum = 0u; cnt = 0u; mine = 0u;
#pragma unroll
        for (unsigned j = 0; j < 16; ++j) { const unsigned c = xb_ld(&bar[XB_XCNT(j)]); sum += c; cnt += (c > 0u) ? 1u : 0u; mine = (j == x) ? c : mine; }
        if (sum == G) break;
        __builtin_amdgcn_s_sleep(1);
        if ((++sp & 255u) == 0u) { if (xb_ld(&bar[XB_TMO])) break; if (sp > XB_SPIN_CAP) { atomicAdd(&bar[XB_TMO], 1u); break; } }
    }
    nloc = mine > 0u ? mine : 1u; nx = cnt > 0u ? cnt : 1u;
}

__device__ __forceinline__ void xcd_barrier(const XcdBarrier& b) {
    asm volatile("s_waitcnt vmcnt(0)" ::: "memory");
    __syncthreads();
    if (threadIdx.x == 0) {
        unsigned* bar = b.bar;
        __builtin_amdgcn_s_waitcnt(0);
        unsigned nloc = b.st[0], nx = b.st[1];
        if (nloc == 0u) { xcd_barrier_complete(bar, b.x, nloc, nx); b.st[0] = nloc; b.st[1] = nx; }
        const unsigned old = xb_add(&bar[XB_XSUB(b.x)], 1u);
        const unsigned gen = old / nloc;
        if (old + 1u == (gen + 1u) * nloc) {
            __builtin_amdgcn_fence(__ATOMIC_RELEASE, "agent");
            asm volatile("s_waitcnt vmcnt(0)" ::: "memory");
            const unsigned og = xb_add(&bar[XB_TOP], 1u);
            const unsigned tg = og / nx;
            if (og + 1u == (tg + 1u) * nx) xb_add(&bar[XB_TOPGEN], 1u);
            else XB_SPIN(xb_ld(&bar[XB_TOPGEN]) == tg, bar);
            __builtin_amdgcn_fence(__ATOMIC_ACQUIRE, "agent");
            xb_add(&bar[XB_XGEN(b.x)], 1u);
            asm volatile("s_waitcnt vmcnt(0)" ::: "memory");
        } else {
            XB_SPIN(xb_ld(&bar[XB_XGEN(b.x)]) == gen, bar);
            __builtin_amdgcn_fence(__ATOMIC_ACQUIRE, "agent");
            asm volatile("s_waitcnt vmcnt(0)" ::: "memory");
        }
    }
    __syncthreads();
}

struct Args { const float* in[40]; float* out; unsigned char* ws; float inv_freq[32]; int g_lo, g_hi; };
struct ArgsD { const GAS float* in[40]; GAS float* out; GAS unsigned char* ws; float inv_freq[32]; int g_lo, g_hi; };
typedef const __attribute__((address_space(4))) ArgsD* ArgsP;
typedef LAS float* LF; typedef const LAS float* CLF;
#ifndef PH_FN
#define PH_FN __device__ __noinline__
#endif
#ifndef PH_HEAVY
#define PH_HEAVY __device__ __forceinline__
#endif
struct Ctx {
    LAS unsigned char* lds;
    GAS unsigned char* ws; GAS float* h;
    int tid, lane, wave, bid, G;
};
typedef unsigned u32x4 __attribute__((ext_vector_type(4)));
typedef unsigned u32x2 __attribute__((ext_vector_type(2)));
typedef float f32x2 __attribute__((ext_vector_type(2)));
typedef float f32x16 __attribute__((ext_vector_type(16)));
__device__ __forceinline__ float bf2f(bf16 x) { return __uint_as_float((unsigned)x << 16); }
__device__ __forceinline__ float bflo(unsigned w) { return __uint_as_float(w << 16); }
__device__ __forceinline__ float bfhi(unsigned w) { return __uint_as_float(w & 0xffff0000u); }
__device__ __forceinline__ void unpack8(const u32x4 w, float* o) { o[0] = bflo(w.x); o[1] = bfhi(w.x); o[2] = bflo(w.y); o[3] = bfhi(w.y); o[4] = bflo(w.z); o[5] = bfhi(w.z); o[6] = bflo(w.w); o[7] = bfhi(w.w); }
__device__ __forceinline__ u32x4 pack8(const float* o) { u32x4 w; w.x = pk2(o[0], o[1]); w.y = pk2(o[2], o[3]); w.z = pk2(o[4], o[5]); w.w = pk2(o[6], o[7]); return w; }
__device__ __forceinline__ float sigmoidf_(float x) { return 1.0f / (1.0f + __expf(-x)); }
__device__ __forceinline__ float siluf_(float x) { return x * sigmoidf_(x); }
__device__ __forceinline__ float softplusf_(float x) { return fmaxf(x, 0.f) + log1pf(__expf(-fabsf(x))); }
__device__ __forceinline__ float logsigmoidf_(float x) { return fminf(x, 0.f) - log1pf(__expf(-fabsf(x))); }
__device__ __forceinline__ float wave_sum(float v) {
#pragma unroll
    for (int o = 1; o < 64; o <<= 1) v += __shfl_xor(v, o);
    return v;
}
#define WG_SYNC() __syncthreads()
__device__ __forceinline__ Ctx fresh(const Ctx& C0) { Ctx C = C0; int t = threadIdx.x; asm volatile("" : "+v"(t)); C.tid = t; C.lane = t & 63; C.wave = __builtin_amdgcn_readfirstlane(t >> 6); return C; }

PH_FN void ph_prologue(const Ctx C, ArgsP a) {
    GAS float* cosT = (GAS float*)(C.ws + WS_COS); GAS float* sinT = (GAS float*)(C.ws + WS_SIN);
    for (int idx = C.bid * NTHR + C.tid; idx < SEQ * 32; idx += C.G * NTHR) {
        const int t = idx >> 5, j = idx & 31;
        const float ang = (float)t * a->inv_freq[j];
        const double rev = (double)ang * 0.15915494309189535;
        const float fr = (float)(rev - floor(rev));
        cosT[idx] = __builtin_amdgcn_cosf(fr); sinT[idx] = __builtin_amdgcn_sinf(fr);
    }
    const GAS float* x = a->in[0]; GAS bf16* hb = (GAS bf16*)(C.ws + WS_HB); GAS float* ssq = (GAS float*)(C.ws + WS_SSQ);
    const int gw = C.bid * NWAVES + C.wave, NGW = C.G * NWAVES;
    for (int m = gw; m < M; m += NGW) {
        const GAS f32x4* xr = (const GAS f32x4*)(x + (size_t)m * D) + C.lane;
        GAS unsigned long long* o8 = (GAS unsigned long long*)(hb + (size_t)m * D) + C.lane;
        float s = 0.f;
#pragma unroll
        for (int j = 0; j < 4; ++j) { const f32x4 v = xr[64 * j]; s += (v.x * v.x + v.y * v.y) + (v.z * v.z + v.w * v.w);
            o8[64 * j] = (unsigned long long)pk2(v.x, v.y) | ((unsigned long long)pk2(v.z, v.w) << 32); }
        s = wave_sum(s);
        if (C.lane == 0) { ssq[m] = s; ssq[M + m] = 0.f; ssq[2 * M + m] = 0.f; ssq[3 * M + m] = 0.f; }
    }
}

template <class SrcF>
__device__ __forceinline__ void tr_item(const SrcF src, const GAS float* gk, GAS bf16* WT, int K, int kb, int nb, LAS bf16* scr, int lane) {
    const int k0 = 64 * kb, n0 = 64 * nb, kr = lane >> 4, n4 = 4 * (lane & 15);
    const int ld = src.ld(); const long co = src.col(n0 + n4); const bool ok = co >= 0; const GAS float* colp = src.base(n0 + n4) + (ok ? co : 0);
    f32x4 v[16];
#pragma unroll
    for (int i = 0; i < 16; ++i) v[i] = ok ? *(const GAS f32x4*)(colp + (size_t)(k0 + 4 * i + kr) * ld) : (f32x4){0.f, 0.f, 0.f, 0.f};
#pragma unroll
    for (int i = 0; i < 16; ++i) { const int kk = 4 * i + kr; const float g = gk ? gk[k0 + kk] : 1.0f;
#pragma unroll
        for (int e = 0; e < 4; ++e) scr[(n4 + e) * 72 + kk] = (bf16)f2bf(v[i][e] * g); }
    LDS_WAIT(); asm volatile("" ::: "memory");
    const int c = lane & 7;
#pragma unroll
    for (int j = 0; j < 8; ++j) { const int n = (lane >> 3) + 8 * j; *(GAS v4u*)(WT + (size_t)(n0 + n) * K + k0 + 8 * c) = *(const LAS v4u*)(scr + n * 72 + 8 * c); }
    LDS_WAIT(); asm volatile("" ::: "memory");
}
struct SrcGU { const GAS float* wg; const GAS float* wu;
    __device__ __forceinline__ int ld() const { return FF; }
    __device__ __forceinline__ const GAS float* base(int n) const { const uintptr_t sel = (uintptr_t)((n >> 7) & 1); return (const GAS float*)((uintptr_t)wg + sel * ((uintptr_t)wu - (uintptr_t)wg)); }
    __device__ __forceinline__ long col(int n) const { return 128 * (n >> 8) + (n & 127); } };
struct SrcPlain { const GAS float* w; int ldw;
    __device__ __forceinline__ int ld() const { return ldw; }
    __device__ __forceinline__ const GAS float* base(int) const { return w; }
    __device__ __forceinline__ long col(int n) const { return n; } };
struct SrcWin { const GAS float* w;
    __device__ __forceinline__ int ld() const { return 10520; }
    __device__ __forceinline__ const GAS float* base(int) const { return w; }
    __device__ __forceinline__ long col(int n) const {
        int c;
        if (n < 3072) c = n; else if (n < 4608) c = n - 3072 + 3088; else if (n < 6400) c = n - 4608 + 4632; else if (n < 6416) c = n - 6400 + 3072; else if (n < 6424) c = n - 6416 + 4624; else if (n < 6656) c = -1; else c = n - 6656 + 6424;
        return c; } };
PH_FN void ph_weights(const Ctx C, ArgsP a, int l) {
    LAS bf16* scr = (LAS bf16*)(C.lds + C.wave * 16384);
    const int gw = C.bid * NWAVES + C.wave, NGW = C.G * NWAVES; int rot = 0;
#define W_FIRST(cnt) ({ const int f_ = (gw + NGW - rot % NGW) % NGW; rot += (cnt); f_; })
#pragma unroll 1
    for (int f = 0; f < 2; ++f) {
        const GAS float* nrm = a->in[f ? 35 : 1] + (size_t)l * D; const GAS float* wg = a->in[f ? 36 : 2] + (size_t)l * D * FF; const GAS float* wu = a->in[f ? 37 : 3] + (size_t)l * D * FF; const GAS float* wd = a->in[f ? 38 : 4] + (size_t)l * FF * D;
        GAS bf16* Wgu = (GAS bf16*)(C.ws + (f ? WS_WGU2 : WS_WGU1)); GAS bf16* Wd = (GAS bf16*)(C.ws + (f ? WS_WD2 : WS_WD1));
        const SrcGU sgu{wg, wu};
        for (int it = W_FIRST((D / 64) * (2 * FF / 64)); it < (D / 64) * (2 * FF / 64); it += NGW) tr_item(sgu, nrm, Wgu, D, it / (2 * FF / 64), it % (2 * FF / 64), scr, C.lane);
        const SrcPlain sd{wd, D};
        for (int it = W_FIRST((FF / 64) * (D / 64)); it < (FF / 64) * (D / 64); it += NGW) tr_item(sd, nullptr, Wd, FF, it / (D / 64), it % (D / 64), scr, C.lane);
    }
    { const SrcWin sw{a->in[6] + (size_t)l * D * 10520}; const GAS float* nrm = a->in[5] + (size_t)l * D; GAS bf16* Win = (GAS bf16*)(C.ws + WS_WIN);
      for (int it = W_FIRST((D / 64) * (NWIN / 64)); it < (D / 64) * (NWIN / 64); it += NGW) tr_item(sw, nrm, Win, D, it / (NWIN / 64), it % (NWIN / 64), scr, C.lane); }
    { GAS bf16* Wb = (GAS bf16*)(C.ws + WS_WB);
      for (int it = W_FIRST(4 * (512 / 64) * (D / 64)); it < 4 * (512 / 64) * (D / 64); it += NGW) { const int z = it / ((512 / 64) * (D / 64)), r = it % ((512 / 64) * (D / 64));
          const SrcPlain sb{a->in[32] + ((size_t)l * 4 + z) * 512 * D - (size_t)z * 512 * D, D}; tr_item(sb, nullptr, Wb, 2048, z * 8 + r / (D / 64), r % (D / 64), scr, C.lane); } }
    { GAS bf16* W2T = (GAS bf16*)(C.ws + WS_RW2T); GAS bf16* A2T = W2T + 512 * 64; GAS bf16* G2T = A2T + 512 * 64;
      const SrcPlain s1{a->in[23] + (size_t)l * 64 * 512, 512}, s2{a->in[25] + (size_t)l * 64 * 512, 512}, s3{a->in[26] + (size_t)l * 128 * 512, 512};
      for (int it = W_FIRST(8); it < 8; it += NGW) tr_item(s1, nullptr, W2T, 64, 0, it, scr, C.lane);
      for (int it = W_FIRST(8); it < 8; it += NGW) tr_item(s2, nullptr, A2T, 64, 0, it, scr, C.lane);
      for (int it = W_FIRST(16); it < 16; it += NGW) tr_item(s3, nullptr, G2T, 128, it >> 3, it & 7, scr, C.lane); }
    { const SrcPlain so{a->in[34] + (size_t)l * D * D, D}; GAS bf16* Wo = (GAS bf16*)(C.ws + WS_WO);
      for (int it = W_FIRST((D / 64) * (D / 64)); it < (D / 64) * (D / 64); it += NGW) tr_item(so, nullptr, Wo, D, it / (D / 64), it % (D / 64), scr, C.lane); }
}

#undef W_FIRST
PH_FN void ph_da_prep(const Ctx C) {
    GAS bf16* P = (GAS bf16*)(C.ws + WS_P); const GAS float* cosT = (const GAS float*)(C.ws + WS_COS); const GAS float* sinT = (const GAS float*)(C.ws + WS_SIN);
    const int gw = C.bid * NWAVES + C.wave, NGW = C.G * NWAVES;
    const int hc = C.lane >> 2, ch = C.lane & 3;
    const float sc = (hc < 8) ? 0.125f * LOG2E : 1.0f;
    for (int m = gw; m < M; m += NGW) {
        const int t = m & (SEQ - 1);
        GAS bf16* p1 = P + (size_t)m * NPM + hc * 64 + ch * 8; GAS bf16* p2 = p1 + 32;
        float x1[8], x2[8], o1[8], o2[8];
        unpack8(*(const GAS u32x4*)p1, x1); unpack8(*(const GAS u32x4*)p2, x2);
        const GAS float* cp = cosT + t * 32 + ch * 8; const GAS float* sp = sinT + t * 32 + ch * 8;
#pragma unroll
        for (int i = 0; i < 8; ++i) { const float c = cp[i], s = sp[i]; o1[i] = (x1[i] * c - x2[i] * s) * sc; o2[i] = (x2[i] * c + x1[i] * s) * sc; }
        *(GAS u32x4*)p1 = pack8(o1); *(GAS u32x4*)p2 = pack8(o2);
    }
    GAS bf16* VT = (GAS bf16*)(C.ws + WS_VT); LAS bf16* tile = (LAS bf16*)C.lds;
    for (int it = C.bid; it < 2 * NCH * 4; it += C.G) {
        const int h = it & 3, bc = it >> 2, b = bc >> 7, tb = bc & 127; const size_t row0 = (size_t)bc * 64;
        WG_SYNC();
#pragma unroll
        for (int i = 0; i < 2; ++i) { const int q = C.tid + NTHR * i, t = q >> 4, c16 = q & 15;
            *(LAS u32x4*)(tile + t * 136 + c16 * 8) = *(const GAS u32x4*)(P + (row0 + t) * NPM + C_DAV + h * 128 + c16 * 8); }
        WG_SYNC();
#pragma unroll
        for (int i = 0; i < 2; ++i) { const int q = C.tid + NTHR * i, d = q >> 3, tc = q & 7; unsigned w[4];
#pragma unroll
            for (int e = 0; e < 4; ++e) w[e] = (unsigned)tile[(8 * tc + 2 * e) * 136 + d] | ((unsigned)tile[(8 * tc + 2 * e + 1) * 136 + d] << 16);
            u32x4 o; o.x = w[0]; o.y = w[1]; o.z = w[2]; o.w = w[3];
            *(GAS u32x4*)(VT + ((size_t)(b * 4 + h) * 128 + d) * SEQ + tb * 64 + 8 * tc) = o; }
    }
    WG_SYNC();
}

typedef LAS bf16* LB; typedef const LAS bf16* CLB;
__device__ __forceinline__ pg8::bf16x8 frag32(CLB X, int ld, int row0, int k0, int lane) { return *(const LAS pg8::bf16x8*)(X + (row0 + (lane & 31)) * ld + k0 + 8 * (lane >> 5)); }
template <int K> __device__ __forceinline__ void mma_nt(f32x16& acc, CLB A, int lda, int m0, CLB Bt, int ldb, int n0, int lane) {
#pragma unroll
    for (int k = 0; k < K; k += 16) acc = __builtin_amdgcn_mfma_f32_32x32x16_bf16(frag32(A, lda, m0, k, lane), frag32(Bt, ldb, n0, k, lane), acc, 0, 0, 0);
}
__device__ __forceinline__ int crow(int r, int hi) { return (r & 3) + 8 * (r >> 2) + 4 * hi; }
__device__ __forceinline__ f32x16 zero16() { f32x16 z;
#pragma unroll
    for (int r = 0; r < 16; ++r) z[r] = 0.f;
    return z; }

__device__ __forceinline__ void gla_compute_G(const Ctx& C, ArgsP a, int l, int bc, int h, LF Gs) {
    const GAS bf16* P = (const GAS bf16*)(C.ws + WS_P); const GAS float* W2 = a->in[12] + (size_t)l * 16 * 256; const GAS float* gb = a->in[13] + (size_t)l * 256;
    const int t = C.tid >> 3, kg = C.tid & 7; const size_t row = (size_t)bc * 64 + t;
    float glr[16]; unpack8(*(const GAS u32x4*)(P + row * NPM + C_GLR), glr); unpack8(*(const GAS u32x4*)(P + row * NPM + C_GLR + 8), glr + 8);
#pragma unroll
    for (int i = 0; i < 8; ++i) { const int k = h * 64 + kg * 8 + i; float x = gb[k];
#pragma unroll
        for (int r = 0; r < 16; ++r) x += glr[r] * W2[r * 256 + k];
        Gs[t * 68 + kg * 8 + i] = logsigmoidf_(x) * (1.0f / 16.0f); }
    WG_SYNC();
    { const int seg = C.tid >> 6, k = C.tid & 63; float run = 0.f;
#pragma unroll
      for (int i = 0; i < 8; ++i) { run += Gs[(8 * seg + i) * 68 + k]; Gs[(8 * seg + i) * 68 + k] = run; }
      WG_SYNC();
      float off = 0.f;
#pragma unroll
      for (int sg = 0; sg < 7; ++sg) { const float tot = Gs[(8 * sg + 7) * 68 + k]; off += (sg < seg) ? tot : 0.f; }
      WG_SYNC();
#pragma unroll
      for (int i = 0; i < 8; ++i) Gs[(8 * seg + i) * 68 + k] += off; }
    WG_SYNC();
}
PH_HEAVY void ph_gla_a(const Ctx C, ArgsP a, int l) {
    const GAS bf16* P = (const GAS bf16*)(C.ws + WS_P); GAS float* GKV = (GAS float*)(C.ws + WS_GKV); GAS float* GL = (GAS float*)(C.ws + WS_GLAST);
    LF Gs = (LF)C.lds; LB KDT = (LB)(C.lds + 17408); LB VT = (LB)(C.lds + 26624);
    for (int it = C.bid; it < NBC * 4; it += C.G) {
        const int bc = it >> 2, h = it & 3;
        WG_SYNC();
        gla_compute_G(C, a, l, bc, h, Gs);
        { const int t = C.tid >> 3, g8 = C.tid & 7; const size_t row = (size_t)bc * 64 + t;
          float kf[8]; unpack8(*(const GAS u32x4*)(P + row * NPM + C_GK + h * 64 + g8 * 8), kf);
#pragma unroll
          for (int i = 0; i < 8; ++i) { const int k = g8 * 8 + i; KDT[k * 72 + t] = (bf16)f2bf(kf[i] * __expf(Gs[63 * 68 + k] - Gs[t * 68 + k])); }
          const u32x4 v0 = *(const GAS u32x4*)(P + row * NPM + C_GV + h * 128 + g8 * 16), v1 = *(const GAS u32x4*)(P + row * NPM + C_GV + h * 128 + g8 * 16 + 8);
          const unsigned vw[8] = {v0.x, v0.y, v0.z, v0.w, v1.x, v1.y, v1.z, v1.w};
#pragma unroll
          for (int i = 0; i < 8; ++i) { VT[(g8 * 16 + 2 * i) * 72 + t] = (bf16)(vw[i] & 0xffffu); VT[(g8 * 16 + 2 * i + 1) * 72 + t] = (bf16)(vw[i] >> 16); }
          if (C.tid < 64) GL[(size_t)it * 64 + C.tid] = Gs[63 * 68 + C.tid]; }
        WG_SYNC();
        { const int kt = C.wave >> 2, vt = C.wave & 3, n = C.lane & 31, hi = C.lane >> 5;
          f32x16 acc = zero16(); mma_nt<64>(acc, KDT, 72, 32 * kt, VT, 72, 32 * vt, C.lane);
          GAS float* dst = GKV + ((size_t)it * 128 + 32 * vt + n) * 64 + 32 * kt + 4 * hi;
#pragma unroll
          for (int g = 0; g < 4; ++g) *(GAS f32x4*)(dst + 8 * g) = (f32x4){acc[4 * g], acc[4 * g + 1], acc[4 * g + 2], acc[4 * g + 3]}; }
    }
    WG_SYNC();
}
PH_FN void gla_scan_part(const Ctx C, int part) {
    GAS float* GKV = (GAS float*)(C.ws + WS_GKV); const GAS float* GL = (const GAS float*)(C.ws + WS_GLAST);
    const int e = part * NTHR + C.tid, chain = e >> 13, idx = e & 8191, b = chain >> 2, h = chain & 3, k = idx & 63;
    float st = 0.f;
#pragma unroll 1
    for (int c0 = 0; c0 < NCH; c0 += 16) {
        float tmp[16], dec[16];
#pragma unroll
        for (int i = 0; i < 16; ++i) { const size_t item = (size_t)(b * NCH + c0 + i) * 4 + h; tmp[i] = GKV[item * 8192 + idx]; dec[i] = GL[item * 64 + k]; }
#pragma unroll
        for (int i = 0; i < 16; ++i) { const size_t item = (size_t)(b * NCH + c0 + i) * 4 + h; GKV[item * 8192 + idx] = st; st = __expf(dec[i]) * st + tmp[i]; }
    }
}
PH_HEAVY void ph_gla_c(const Ctx C, ArgsP a, int l) {
    const GAS bf16* P = (const GAS bf16*)(C.ws + WS_P); const GAS float* GKV = (const GAS float*)(C.ws + WS_GKV); GAS bf16* YS = (GAS bf16*)(C.ws + WS_YS);
    const GAS float* gnorm = a->in[14] + (size_t)l * 128;
    LF Gs = (LF)C.lds; LB QD = (LB)(C.lds + 17408); LB KDR = (LB)(C.lds + 26624); LB QI = (LB)(C.lds + 35840); LB ATT = (LB)(C.lds + 45056); LB VT = (LB)(C.lds + 54272); LB ST = (LB)(C.lds + 72704); LF PS = (LF)(C.lds + 91136);
    for (int it = C.bid; it < NBC * 4; it += C.G) {
        const int bc = it >> 2, h = it & 3;
        WG_SYNC();
        gla_compute_G(C, a, l, bc, h, Gs);
        { const int t = C.tid >> 3, g8 = C.tid & 7; const size_t row = (size_t)bc * 64 + t;
          float qf[8], kf[8], o1[8], o2[8], o3[8];
          unpack8(*(const GAS u32x4*)(P + row * NPM + C_GQ + h * 64 + g8 * 8), qf); unpack8(*(const GAS u32x4*)(P + row * NPM + C_GK + h * 64 + g8 * 8), kf);
#pragma unroll
          for (int i = 0; i < 8; ++i) { const int k = g8 * 8 + i; const float g = Gs[t * 68 + k], d = g - Gs[32 * 68 + k]; o1[i] = qf[i] * 0.125f * __expf(d); o2[i] = kf[i] * __expf(-d); o3[i] = qf[i] * 0.125f * __expf(g); }
          *(LAS u32x4*)(QD + t * 72 + g8 * 8) = pack8(o1); *(LAS u32x4*)(KDR + t * 72 + g8 * 8) = pack8(o2); *(LAS u32x4*)(QI + t * 72 + g8 * 8) = pack8(o3);
          const u32x4 v0 = *(const GAS u32x4*)(P + row * NPM + C_GV + h * 128 + g8 * 16), v1 = *(const GAS u32x4*)(P + row * NPM + C_GV + h * 128 + g8 * 16 + 8);
          const unsigned vw[8] = {v0.x, v0.y, v0.z, v0.w, v1.x, v1.y, v1.z, v1.w};
#pragma unroll
          for (int i = 0; i < 8; ++i) { VT[(g8 * 16 + 2 * i) * 72 + t] = (bf16)(vw[i] & 0xffffu); VT[(g8 * 16 + 2 * i + 1) * 72 + t] = (bf16)(vw[i] >> 16); }
          const int v = C.tid >> 2, kq = (C.tid & 3) * 16; const GAS float* sp = GKV + ((size_t)it * 128 + v) * 64 + kq;
          float s[16];
#pragma unroll
          for (int i = 0; i < 4; ++i) { const f32x4 x = *(const GAS f32x4*)(sp + 4 * i); s[4 * i] = x[0]; s[4 * i + 1] = x[1]; s[4 * i + 2] = x[2]; s[4 * i + 3] = x[3]; }
          *(LAS u32x4*)(ST + v * 72 + kq) = pack8(s); *(LAS u32x4*)(ST + v * 72 + kq + 8) = pack8(s + 8); }
        WG_SYNC();
        const int n = C.lane & 31, hi = C.lane >> 5;
        if (C.wave < 4) {
            const int it_ = C.wave >> 1, jt = C.wave & 1;
            f32x16 acc = zero16();
            if (jt <= it_) mma_nt<64>(acc, QD, 72, 32 * it_, KDR, 72, 32 * jt, C.lane);
#pragma unroll
            for (int r = 0; r < 16; ++r) { const int i = 32 * it_ + crow(r, hi), j = 32 * jt + n; ATT[i * 72 + j] = (bf16)f2bf(j <= i ? acc[r] : 0.f); }
        }
        WG_SYNC();
        {
            const int it_ = C.wave & 1, vt = C.wave >> 1;
            f32x16 acc = zero16();
            mma_nt<64>(acc, VT, 72, 32 * vt, ATT, 72, 32 * it_, C.lane);
            mma_nt<64>(acc, ST, 72, 32 * vt, QI, 72, 32 * it_, C.lane);
            float ss = 0.f;
#pragma unroll
            for (int r = 0; r < 16; ++r) ss += acc[r] * acc[r];
            ss += __shfl_xor(ss, 32);
            if (hi == 0) PS[(32 * it_ + n) * 4 + vt] = ss;
            WG_SYNC();
            const int i = 32 * it_ + n; const float tot = (PS[i * 4] + PS[i * 4 + 1]) + (PS[i * 4 + 2] + PS[i * 4 + 3]);
            const float rs = 1.0f / sqrtf(tot * (1.0f / 128.0f) + EPS); const size_t row = (size_t)bc * 64 + i;
#pragma unroll
            for (int g = 0; g < 4; ++g) { const int v0 = 32 * vt + 8 * g + 4 * hi;
                const u32x2 ogw = *(const GAS u32x2*)(P + row * NPM + C_GOG + h * 128 + v0); const f32x4 gn = *(const GAS f32x4*)(gnorm + v0);
                const float og[4] = {bflo(ogw.x), bfhi(ogw.x), bflo(ogw.y), bfhi(ogw.y)}; float o4[4];
#pragma unroll
                for (int y = 0; y < 4; ++y) o4[y] = acc[4 * g + y] * rs * gn[y] * siluf_(og[y]);
                u32x2 w; w.x = pk2(o4[0], o4[1]); w.y = pk2(o4[2], o4[3]); *(GAS u32x2*)(YS + row * 2048 + 512 + h * 128 + v0) = w; }
        }
    }
    WG_SYNC();
}

__device__ __forceinline__ void ssd_conv8(const GAS bf16* P, const GAS float* cw, const GAS float* cb, int bc, int t, int ch0, float* o) {
    const int pos = (bc & 127) * 64 + t; const size_t row = (size_t)bc * 64 + t;
#pragma unroll
    for (int i = 0; i < 8; ++i) o[i] = cb[ch0 + i];
#pragma unroll
    for (int tap = 0; tap < 4; ++tap) { if (pos - 3 + tap >= 0) { float x[8]; unpack8(*(const GAS u32x4*)(P + (row - 3 + tap) * NPM + C_SX + ch0), x);
#pragma unroll
        for (int i = 0; i < 8; ++i) o[i] += cw[tap * 1024 + ch0 + i] * x[i]; } }
#pragma unroll
    for (int i = 0; i < 8; ++i) o[i] = siluf_(o[i]);
}
PH_HEAVY void ph_ssd_a(const Ctx C, ArgsP a, int l) {
    const GAS bf16* P = (const GAS bf16*)(C.ws + WS_P); GAS float* SST = (GAS float*)(C.ws + WS_SST); GAS float* SDT = (GAS float*)(C.ws + WS_SDT); GAS float* SAC = (GAS float*)(C.ws + WS_SACUM); GAS float* SCD = (GAS float*)(C.ws + WS_SCDEC);
    const GAS float* cw = a->in[15] + (size_t)l * 4 * 1024; const GAS float* cb = a->in[16] + (size_t)l * 1024; const GAS float* dtb = a->in[17] + (size_t)l * 8; const GAS float* alog = a->in[18] + (size_t)l * 8;
    LB BT = (LB)C.lds; LB XDT = (LB)(C.lds + 18432); LF dtv = (LF)(C.lds + 27648); LF acu = (LF)(C.lds + 27904); LF av = (LF)(C.lds + 28160);
    for (int it = C.bid; it < NBC * 2; it += C.G) {
        const int bc = it >> 1, g = it & 1; const int t = C.tid >> 3, cg = C.tid & 7;
        WG_SYNC();
        { float o[8];
#pragma unroll
          for (int half = 0; half < 2; ++half) { ssd_conv8(P, cw, cb, bc, t, 512 + g * 128 + cg * 16 + half * 8, o);
#pragma unroll
              for (int i = 0; i < 8; ++i) BT[(cg * 16 + half * 8 + i) * 72 + t] = (bf16)f2bf(o[i]); } }
#pragma unroll 1
        for (int hh = 0; hh < 4; ++hh) {
            const int hd = 4 * g + hh; const size_t item8 = (size_t)bc * 8 + hd;
            WG_SYNC();
            if (C.tid < 64) { const size_t row = (size_t)bc * 64 + C.tid; const float dt = softplusf_(bf2f(P[row * NPM + C_SDT + hd]) + dtb[hd]); dtv[C.tid] = dt; av[C.tid] = -__expf(alog[hd]) * dt; }
            WG_SYNC();
            if (C.tid < 64) { float s = av[C.tid];
#pragma unroll
                for (int o = 1; o < 64; o <<= 1) { const float nb_ = __shfl_up(s, o); if (C.lane >= o) s += nb_; }
                acu[C.tid] = s; const size_t row = (size_t)bc * 64 + C.tid; SDT[row * 8 + hd] = dtv[C.tid]; SAC[row * 8 + hd] = s; if (C.tid == 63) SCD[item8] = __expf(s); }
            WG_SYNC();
            { float o[8]; ssd_conv8(P, cw, cb, bc, t, hd * 64 + cg * 8, o); const float sc = dtv[t] * __expf(acu[63] - acu[t]);
#pragma unroll
              for (int i = 0; i < 8; ++i) XDT[(cg * 8 + i) * 72 + t] = (bf16)f2bf(o[i] * sc); }
            WG_SYNC();
            { const int pt = C.wave >> 2, nt = C.wave & 3, n = C.lane & 31, hi = C.lane >> 5;
              f32x16 acc = zero16(); mma_nt<64>(acc, XDT, 72, 32 * pt, BT, 72, 32 * nt, C.lane);
#pragma unroll
              for (int r = 0; r < 16; ++r) SST[(item8 * 64 + 32 * pt + crow(r, hi)) * 128 + 32 * nt + n] = acc[r]; }
        }
    }
    WG_SYNC();
}
PH_FN void ssd_scan_part(const Ctx C, int part) {
    GAS float* SST = (GAS float*)(C.ws + WS_SST); const GAS float* SCD = (const GAS float*)(C.ws + WS_SCDEC);
    const int e = part * NTHR + C.tid, chain = e >> 13, idx = e & 8191, b = chain >> 3, hd = chain & 7;
    float st = 0.f;
#pragma unroll 1
    for (int c0 = 0; c0 < NCH; c0 += 16) {
        float tmp[16], dec[16];
#pragma unroll
        for (int i = 0; i < 16; ++i) { const size_t item = (size_t)(b * NCH + c0 + i) * 8 + hd; tmp[i] = SST[item * 8192 + idx]; dec[i] = SCD[item]; }
#pragma unroll
        for (int i = 0; i < 16; ++i) { const size_t item = (size_t)(b * NCH + c0 + i) * 8 + hd; SST[item * 8192 + idx] = st; st = dec[i] * st + tmp[i]; }
    }
}
PH_HEAVY void ph_ssd_c(const Ctx C, ArgsP a, int l) {
    const GAS bf16* P = (const GAS bf16*)(C.ws + WS_P); const GAS float* SST = (const GAS float*)(C.ws + WS_SST); const GAS float* SDT = (const GAS float*)(C.ws + WS_SDT); const GAS float* SAC = (const GAS float*)(C.ws + WS_SACUM); GAS bf16* YS = (GAS bf16*)(C.ws + WS_YS);
    const GAS float* cw = a->in[15] + (size_t)l * 4 * 1024; const GAS float* cb = a->in[16] + (size_t)l * 1024; const GAS float* dpar = a->in[19] + (size_t)l * 8; const GAS float* snorm = a->in[20] + (size_t)l * 512;
    LB BN = (LB)C.lds; LB CN = (LB)(C.lds + 17408); LF CB = (LF)(C.lds + 34816); LB SC = (LB)(C.lds + 52224); LB XST = (LB)(C.lds + 61440); LB HP = (LB)(C.lds + 70656); LB CE = (LB)(C.lds + 88064);
    LF dtv = (LF)(C.lds + 105472); LF acu = (LF)(C.lds + 105728); LF PSQ = (LF)(C.lds + 105984);
    for (int it = C.bid; it < NBC * 2; it += C.G) {
        const int bc = it >> 1, g = it & 1;
        const int t = C.tid >> 3, cg = C.tid & 7, n = C.lane & 31, hi = C.lane >> 5;
        WG_SYNC();
        { float o[8];
#pragma unroll
          for (int half = 0; half < 2; ++half) {
              ssd_conv8(P, cw, cb, bc, t, 512 + g * 128 + cg * 16 + half * 8, o); *(LAS u32x4*)(BN + t * 136 + cg * 16 + half * 8) = pack8(o);
              ssd_conv8(P, cw, cb, bc, t, 768 + g * 128 + cg * 16 + half * 8, o); *(LAS u32x4*)(CN + t * 136 + cg * 16 + half * 8) = pack8(o); } }
        WG_SYNC();
        if (C.wave < 4) {
            const int it_ = C.wave >> 1, jt = C.wave & 1;
            f32x16 acc = zero16(); mma_nt<128>(acc, CN, 136, 32 * it_, BN, 136, 32 * jt, C.lane);
#pragma unroll
            for (int r = 0; r < 16; ++r) CB[(32 * it_ + crow(r, hi)) * 68 + 32 * jt + n] = acc[r];
        }
        float yk[4][16]; float ssq = 0.f;
        const int pt = (C.wave >> 1) & 1, it2 = C.wave & 1;
#pragma unroll
        for (int hh = 0; hh < 4; ++hh) {
            const int hd = 4 * g + hh; const size_t item8 = (size_t)bc * 8 + hd;
            WG_SYNC();
            if (C.tid < 64) { const size_t row = (size_t)bc * 64 + C.tid; dtv[C.tid] = SDT[row * 8 + hd]; acu[C.tid] = SAC[row * 8 + hd]; }
            { float o[8]; ssd_conv8(P, cw, cb, bc, t, hd * 64 + cg * 8, o);
#pragma unroll
              for (int i = 0; i < 8; ++i) XST[(cg * 8 + i) * 72 + t] = (bf16)f2bf(o[i]);
              const int p = C.tid >> 3, n0 = (C.tid & 7) * 16; const GAS float* sp = SST + (item8 * 64 + p) * 128 + n0; float s[16];
#pragma unroll
              for (int i = 0; i < 4; ++i) { const f32x4 x = *(const GAS f32x4*)(sp + 4 * i); s[4 * i] = x[0]; s[4 * i + 1] = x[1]; s[4 * i + 2] = x[2]; s[4 * i + 3] = x[3]; }
              *(LAS u32x4*)(HP + p * 136 + n0) = pack8(s); *(LAS u32x4*)(HP + p * 136 + n0 + 8) = pack8(s + 8); }
            WG_SYNC();
            { const float ai = acu[t]; float o[8];
#pragma unroll
              for (int jj = 0; jj < 8; ++jj) { const int j = 8 * cg + jj; o[jj] = (j <= t) ? CB[t * 68 + j] * __expf(ai - acu[j]) * dtv[j] : 0.f; }
              *(LAS u32x4*)(SC + t * 72 + 8 * cg) = pack8(o);
              const float ea = __expf(ai); float c8[8];
#pragma unroll
              for (int half = 0; half < 2; ++half) { unpack8(*(const LAS u32x4*)(CN + t * 136 + cg * 16 + half * 8), c8);
#pragma unroll
                  for (int i = 0; i < 8; ++i) c8[i] *= ea;
                  *(LAS u32x4*)(CE + t * 136 + cg * 16 + half * 8) = pack8(c8); } }
            WG_SYNC();
            if (C.wave < 4) {
                f32x16 acc = zero16();
                mma_nt<64>(acc, XST, 72, 32 * pt, SC, 72, 32 * it2, C.lane);
                mma_nt<128>(acc, HP, 136, 32 * pt, CE, 136, 32 * it2, C.lane);
                const int i = 32 * it2 + n; const size_t row = (size_t)bc * 64 + i; const float dh = dpar[hd];
#pragma unroll
                for (int q4 = 0; q4 < 4; ++q4) { const int p0 = 32 * pt + 8 * q4 + 4 * hi;
                    const u32x2 zw = *(const GAS u32x2*)(P + row * NPM + C_SZ + hd * 64 + p0); const float zf[4] = {bflo(zw.x), bfhi(zw.x), bflo(zw.y), bfhi(zw.y)};
#pragma unroll
                    for (int e = 0; e < 4; ++e) { const float xs = bf2f(XST[(p0 + e) * 72 + i]); const float v = (acc[4 * q4 + e] + dh * xs) * siluf_(zf[e]); yk[hh][4 * q4 + e] = v; ssq += v * v; } }
            }
        }
        if (C.wave < 4) { ssq += __shfl_xor(ssq, 32); if (hi == 0) PSQ[(32 * it2 + n) * 2 + pt] = ssq; }
        WG_SYNC();
        if (C.wave < 4) {
            const int i = 32 * it2 + n; const float rs = 1.0f / sqrtf((PSQ[i * 2] + PSQ[i * 2 + 1]) * (1.0f / 256.0f) + EPS); const size_t row = (size_t)bc * 64 + i;
#pragma unroll
            for (int hh = 0; hh < 4; ++hh)
#pragma unroll
                for (int q4 = 0; q4 < 4; ++q4) { const int ch = g * 256 + hh * 64 + 32 * pt + 8 * q4 + 4 * hi; const f32x4 sn = *(const GAS f32x4*)(snorm + ch);
                    u32x2 w; w.x = pk2(yk[hh][4 * q4] * rs * sn[0], yk[hh][4 * q4 + 1] * rs * sn[1]); w.y = pk2(yk[hh][4 * q4 + 2] * rs * sn[2], yk[hh][4 * q4 + 3] * rs * sn[3]);
                    *(GAS u32x2*)(YS + row * 2048 + 1024 + ch) = w; }
        }
    }
    WG_SYNC();
}

#ifndef RW_CHUNKED
#define RW_CHUNKED 1
#endif
__device__ __forceinline__ void rw_lerp8(const GAS bf16* P, const GAS float* mu, int bc, int t, int c0, float* o) {
    const size_t row = (size_t)bc * 64 + t; const bool first = ((bc & 127) == 0) && (t == 0);
    float x[8], xp[8]; unpack8(*(const GAS u32x4*)(P + row * NPM + C_RR + c0), x);
    if (!first) unpack8(*(const GAS u32x4*)(P + (row - 1) * NPM + C_RR + c0), xp); else {
#pragma unroll
        for (int i = 0; i < 8; ++i) xp[i] = 0.f; }
#pragma unroll
    for (int i = 0; i < 8; ++i) o[i] = x[i] + (xp[i] - x[i]) * mu[c0 + i];
}
__device__ __forceinline__ void rw_lerp4(const GAS bf16* P, const GAS float* mu, size_t row, bool first, int c0, float* o) {
    const u32x2 xw = *(const GAS u32x2*)(P + row * NPM + C_RR + c0); const float x[4] = {bflo(xw.x), bfhi(xw.x), bflo(xw.y), bfhi(xw.y)};
    float xp[4] = {0.f, 0.f, 0.f, 0.f};
    if (!first) { const u32x2 pw = *(const GAS u32x2*)(P + (row - 1) * NPM + C_RR + c0); xp[0] = bflo(pw.x); xp[1] = bfhi(pw.x); xp[2] = bflo(pw.y); xp[3] = bfhi(pw.y); }
    const f32x4 m = *(const GAS f32x4*)(mu + c0);
#pragma unroll
    for (int i = 0; i < 4; ++i) o[i] = x[i] + (xp[i] - x[i]) * m[i];
}
#define RW_WFRAG(WT_, K_, nt_, s_) (*(const GAS pg8::bf16x8*)((WT_) + (size_t)(head * 64 + 32 * (nt_) + n) * (K_) + 16 * (s_) + 8 * hi))
#define RWP_PTRS \
    const GAS bf16* P = (const GAS bf16*)(C.ws + WS_P); \
    GAS float* RWW = (GAS float*)(C.ws + WS_RWW); GAS bf16* RWR = (GAS bf16*)(C.ws + WS_RWR); GAS bf16* RWK = (GAS bf16*)(C.ws + WS_RWK); GAS bf16* RWV = (GAS bf16*)(C.ws + WS_RWV); GAS bf16* RWKK = (GAS bf16*)(C.ws + WS_RWKK); GAS bf16* RWB = (GAS bf16*)(C.ws + WS_RWB); GAS bf16* RWG = (GAS bf16*)(C.ws + WS_RWG); \
    const GAS bf16* W2T = (const GAS bf16*)(C.ws + WS_RW2T); const GAS bf16* A2T = W2T + 512 * 64; const GAS bf16* G2T = A2T + 512 * 64;       \
    const GAS float* mu = a->in[21] + (size_t)l * 1792; const GAS float* w0 = a->in[22] + (size_t)l * 512; const GAS float* a0 = a->in[24] + (size_t)l * 512; \
    const GAS float* k_k = a->in[27] + (size_t)l * 512; const GAS float* k_a = a->in[28] + (size_t)l * 512; \
    LB WLb = (LB)C.lds; LB ALb = (LB)(C.lds + 9216); LB GLb = (LB)(C.lds + 18432);         \
    LB KX = (LB)(C.lds + 35840); LF w0s = (LF)(C.lds + 102400); LF a0s = w0s + 512; LF kks = a0s + 512; LF kas = kks + 512; LF INVs = kas + 512;     \
    (void)KX; (void)w0s; (void)a0s; (void)kks; (void)kas; (void)INVs; \
    (void)P; (void)RWW; (void)RWR; (void)RWK; (void)RWV; (void)RWKK; (void)RWB; (void)RWG; (void)W2T; (void)A2T; (void)G2T; (void)mu; (void)w0; (void)a0; (void)k_k; (void)k_a; (void)WLb; (void)ALb; (void)GLb;
#define RWP_LANE const int head = C.wave, n = C.lane & 31, hi = C.lane >> 5; const size_t row0 = (size_t)bc * 64 + 32 * tt; (void)row0;
PH_FN void rwp_stage(const Ctx C, ArgsP a, int l, int bc) {
    RWP_PTRS
    WG_SYNC();
    { const int t = C.tid >> 3, cg = C.tid & 7; float o[8];
      rw_lerp8(P, mu, bc, t, 1536 + cg * 8, o);
#pragma unroll
      for (int i = 0; i < 8; ++i) o[i] = tanhf(o[i]);
      *(LAS u32x4*)(WLb + t * 72 + cg * 8) = pack8(o);
      rw_lerp8(P, mu, bc, t, 1600 + cg * 8, o); *(LAS u32x4*)(ALb + t * 72 + cg * 8) = pack8(o);
#pragma unroll
      for (int half = 0; half < 2; ++half) { rw_lerp8(P, mu, bc, t, 1664 + cg * 16 + half * 8, o);
#pragma unroll
          for (int i = 0; i < 8; ++i) o[i] = sigmoidf_(o[i]);
          *(LAS u32x4*)(GLb + t * 136 + cg * 16 + half * 8) = pack8(o); }
      const size_t row = (size_t)bc * 64 + t;
#pragma unroll 2
      for (int j = 0; j < 8; ++j) { const int c = j * 64 + cg * 8;
          rw_lerp8(P, mu, bc, t, c, o); *(GAS u32x4*)(RWR + row * 512 + c) = pack8(o);
          rw_lerp8(P, mu, bc, t, 1024 + c, o); *(GAS u32x4*)(RWV + row * 512 + c) = pack8(o);
          rw_lerp8(P, mu, bc, t, 512 + c, o); *(LAS u32x4*)(KX + t * 520 + c) = pack8(o);
          const f32x4 k0 = *(const GAS f32x4*)(k_k + c), k1 = *(const GAS f32x4*)(k_k + c + 4); float ss = 0.f;
#pragma unroll
          for (int i = 0; i < 4; ++i) { const float q0 = o[i] * k0[i], q1 = o[4 + i] * k1[i]; ss += q0 * q0 + q1 * q1; }
          ss += __shfl_xor(ss, 1); ss += __shfl_xor(ss, 2); ss += __shfl_xor(ss, 4);
          if (cg == 0) INVs[t * 8 + j] = 1.0f / fmaxf(sqrtf(ss), 1e-12f); }
      const int q = C.tid * 4; *(LAS f32x4*)(w0s + q) = *(const GAS f32x4*)((q < 512 ? w0 : q < 1024 ? a0 - 512 : q < 1536 ? k_k - 1024 : k_a - 1536) + q); }
    WG_SYNC();
}
PH_FN void rwp_w(const Ctx C, ArgsP a, int l, int bc, int tt) {
    RWP_PTRS RWP_LANE
#pragma unroll
    for (int nt = 0; nt < 2; ++nt) { f32x16 c = zero16();
#pragma unroll
        for (int s4 = 0; s4 < 4; ++s4) c = __builtin_amdgcn_mfma_f32_32x32x16_bf16(frag32(WLb, 72, 32 * tt, 16 * s4, C.lane), RW_WFRAG(W2T, 64, nt, s4), c, 0, 0, 0);
        const int ch = head * 64 + 32 * nt + n; const float w0c = w0s[ch];
#pragma unroll
        for (int r = 0; r < 16; ++r) RWW[(row0 + crow(r, hi)) * 512 + ch] = -0.606531f * sigmoidf_(w0c + c[r]); }
}
PH_FN void rwp_g(const Ctx C, ArgsP a, int l, int bc, int tt) {
    RWP_PTRS RWP_LANE
#pragma unroll
    for (int nt = 0; nt < 2; ++nt) { f32x16 c = zero16();
#pragma unroll
        for (int s8 = 0; s8 < 8; ++s8) c = __builtin_amdgcn_mfma_f32_32x32x16_bf16(frag32(GLb, 136, 32 * tt, 16 * s8, C.lane), RW_WFRAG(G2T, 128, nt, s8), c, 0, 0, 0);
        const int ch = head * 64 + 32 * nt + n;
#pragma unroll
        for (int r = 0; r < 16; ++r) RWG[(row0 + crow(r, hi)) * 512 + ch] = (bf16)f2bf(c[r]); }
}
PH_FN void rwp_ak(const Ctx C, ArgsP a, int l, int bc, int tt) {
    RWP_PTRS RWP_LANE
#pragma unroll
    for (int nt = 0; nt < 2; ++nt) { f32x16 c = zero16();
#pragma unroll
        for (int s4 = 0; s4 < 4; ++s4) c = __builtin_amdgcn_mfma_f32_32x32x16_bf16(frag32(ALb, 72, 32 * tt, 16 * s4, C.lane), RW_WFRAG(A2T, 64, nt, s4), c, 0, 0, 0);
        const int ch = head * 64 + 32 * nt + n; const float a0c = a0s[ch], kkc = kks[ch], kac = kas[ch];
#pragma unroll
        for (int r = 0; r < 16; ++r) { const int tl = 32 * tt + crow(r, hi); const float al = sigmoidf_(a0c + c[r]), x = bf2f(KX[tl * 520 + ch]), kkn = x * kkc * INVs[tl * 8 + head];
            const size_t g = ((size_t)bc * 64 + tl) * 512 + ch;
            RWKK[g] = (bf16)f2bf(kkn); RWB[g] = (bf16)f2bf(kkn * al); RWK[g] = (bf16)f2bf(x * (1.0f + (al - 1.0f) * kac)); } }
}
#undef RW_WFRAG
#undef RWP_PTRS
#undef RWP_LANE
__device__ __forceinline__ void ph_rw_prep(const Ctx& C, ArgsP a, int l) {
    for (int bc = C.bid; bc < NBC; bc += C.G) { rwp_stage(C, a, l, bc);
#pragma unroll 1
        for (int tt = 0; tt < 2; ++tt) { rwp_w(C, a, l, bc, tt); rwp_g(C, a, l, bc, tt); rwp_ak(C, a, l, bc, tt); } }
    WG_SYNC();
}
template <int CTRL> __device__ __forceinline__ float dpp_get(float x) { return __builtin_bit_cast(float, __builtin_amdgcn_update_dpp(0, __builtin_bit_cast(int, x), CTRL, 0xf, 0xf, true)); }
__device__ __forceinline__ float reduce16(float x) { x += dpp_get<0xB1>(x); x += dpp_get<0x4E>(x); x += dpp_get<0x141>(x); x += dpp_get<0x140>(x); return x; }
#define RW_BAR() do { asm volatile("s_waitcnt lgkmcnt(0)" ::: "memory"); __builtin_amdgcn_s_barrier(); asm volatile("" ::: "memory"); } while (0)
PH_FN void rw_unit(const Ctx C, int chain, int rq) {
    const GAS float* RWW = (const GAS float*)(C.ws + WS_RWW); const GAS bf16* RWR = (const GAS bf16*)(C.ws + WS_RWR); const GAS bf16* RWK = (const GAS bf16*)(C.ws + WS_RWK); const GAS bf16* RWV = (const GAS bf16*)(C.ws + WS_RWV);
    const GAS bf16* RWKK = (const GAS bf16*)(C.ws + WS_RWKK); const GAS bf16* RWB = (const GAS bf16*)(C.ws + WS_RWB); GAS bf16* RWY = (GAS bf16*)(C.ws + WS_RWY);
    const int b = chain >> 3, h = chain & 7; const size_t rowb = (size_t)b * SEQ;
    constexpr int BUFB = 43008, O_KK = 0, O_W = 8192, O_B = 16384, O_K = 24576, O_R = 32768, O_V = 40960, NBLK = SEQ / 32;
    LAS unsigned char* L = C.lds;
    if (C.wave >= 4) {
        const int p = C.tid - 256, t = p >> 3, c8 = (p & 7) * 8;
        u32x4 rr, rk, rkk, rb; f32x4 w0, w1; unsigned rv;
#define RW_LOAD(blk) do { const size_t g_ = (rowb + (size_t)(blk) * 32 + t) * 512 + h * 64; \
            w0 = *(const GAS f32x4*)(RWW + g_ + c8); w1 = *(const GAS f32x4*)(RWW + g_ + c8 + 4); rr = *(const GAS u32x4*)(RWR + g_ + c8); rk = *(const GAS u32x4*)(RWK + g_ + c8); \
            rkk = *(const GAS u32x4*)(RWKK + g_ + c8); rb = *(const GAS u32x4*)(RWB + g_ + c8); rv = *(const GAS unsigned*)(RWV + g_ + 16 * rq + (p & 7) * 2); } while (0)
#define RW_ST8(off, w_) do { float o_[8]; unpack8(w_, o_); LF d_ = (LF)(Lb + (off)) + t * 64 + c8; *(LAS f32x4*)d_ = (f32x4){o_[0], o_[1], o_[2], o_[3]}; *(LAS f32x4*)(d_ + 4) = (f32x4){o_[4], o_[5], o_[6], o_[7]}; } while (0)
        RW_LOAD(0);
        for (int blk = 0; blk < NBLK; ++blk) {
            LAS unsigned char* Lb = L + (blk & 1) * BUFB;
            { LF d = (LF)(Lb + O_W) + t * 64 + c8; *(LAS f32x4*)d = w0; *(LAS f32x4*)(d + 4) = w1; }
            RW_ST8(O_R, rr); RW_ST8(O_K, rk); RW_ST8(O_KK, rkk); RW_ST8(O_B, rb);
            { LF d = (LF)(Lb + O_V) + t * 16 + (p & 7) * 2; d[0] = bflo(rv); d[1] = bfhi(rv); }
            if (blk + 1 < NBLK) RW_LOAD(blk + 1);
            RW_BAR();
        }
        RW_BAR();
#undef RW_LOAD
#undef RW_ST8
    } else {
        const int rowl = C.lane >> 4, ks = C.lane & 15, row = 4 * C.wave + rowl;
        float S0 = 0.f, S1 = 0.f, S2 = 0.f, S3 = 0.f, ykeep = 0.f;
        GAS bf16* yout = RWY + rowb * 512 + h * 64 + 16 * rq + row;
        for (int blk = 0; blk < NBLK; ++blk) {
            RW_BAR();
            const LAS unsigned char* Lb = L + (blk & 1) * BUFB;
            CLF pKK = (CLF)(Lb + O_KK) + 4 * ks; CLF pW = (CLF)(Lb + O_W) + 4 * ks; CLF pB = (CLF)(Lb + O_B) + 4 * ks; CLF pK = (CLF)(Lb + O_K) + 4 * ks; CLF pR = (CLF)(Lb + O_R) + 4 * ks; CLF pV = (CLF)(Lb + O_V) + row;
            f32x4 kk = *(const LAS f32x4*)pKK, w = *(const LAS f32x4*)pW, bb = *(const LAS f32x4*)pB, k = *(const LAS f32x4*)pK, r = *(const LAS f32x4*)pR; float vv = *pV;
#pragma unroll 4
            for (int t = 0; t < 32; ++t) {
                f32x4 nkk, nw, nb, nk, nr; float nv;
                const int tn = (t < 31) ? t + 1 : t;
                nkk = *(const LAS f32x4*)(pKK + tn * 64); nw = *(const LAS f32x4*)(pW + tn * 64); nb = *(const LAS f32x4*)(pB + tn * 64); nk = *(const LAS f32x4*)(pK + tn * 64); nr = *(const LAS f32x4*)(pR + tn * 64); nv = pV[tn * 16];
                float sa = (S0 * kk[0] + S1 * kk[1]) + (S2 * kk[2] + S3 * kk[3]);
                sa = -reduce16(sa);
                const float vk0 = vv * k[0], vk1 = vv * k[1], vk2 = vv * k[2], vk3 = vv * k[3];
                S0 = S0 * w[0] + (sa * bb[0] + vk0); S1 = S1 * w[1] + (sa * bb[1] + vk1); S2 = S2 * w[2] + (sa * bb[2] + vk2); S3 = S3 * w[3] + (sa * bb[3] + vk3);
                float y = (S0 * r[0] + S1 * r[1]) + (S2 * r[2] + S3 * r[3]);
                y = reduce16(y);
                if ((t & 15) == ks) ykeep = y;
                if ((t & 15) == 15) yout[(size_t)(blk * 32 + (t & 16) + ks) * 512] = (bf16)f2bf(ykeep);
                kk = nkk; w = nw; bb = nb; k = nk; r = nr; vv = nv;
            }
        }
        RW_BAR();
    }
}
PH_FN void ph_rw_out(const Ctx C, ArgsP a, int l) {
    const GAS bf16* RWR = (const GAS bf16*)(C.ws + WS_RWR); const GAS bf16* RWK = (const GAS bf16*)(C.ws + WS_RWK); const GAS bf16* RWV = (const GAS bf16*)(C.ws + WS_RWV); const GAS bf16* RWG = (const GAS bf16*)(C.ws + WS_RWG); const GAS bf16* RWY = (const GAS bf16*)(C.ws + WS_RWY);
    GAS bf16* YS = (GAS bf16*)(C.ws + WS_YS);
    const GAS float* r_k = a->in[29] + (size_t)l * 512; const GAS float* nw = a->in[30] + (size_t)l * 512; const GAS float* nb = a->in[31] + (size_t)l * 512;
    const int gw = C.bid * NWAVES + C.wave, NGW = C.G * NWAVES, c0 = C.lane * 8;
    float rk[8], w8[8], b8[8];
#pragma unroll
    for (int i = 0; i < 8; ++i) { rk[i] = r_k[c0 + i]; w8[i] = nw[c0 + i]; b8[i] = nb[c0 + i]; }
    for (int row0 = gw * 2; row0 < M; row0 += NGW * 2) {
        u32x4 yw[2], rw[2], kw[2], vw[2], gw4[2];
#pragma unroll
        for (int u = 0; u < 2; ++u) { const size_t g = (size_t)(row0 + u) * 512 + c0; yw[u] = *(const GAS u32x4*)(RWY + g); rw[u] = *(const GAS u32x4*)(RWR + g); kw[u] = *(const GAS u32x4*)(RWK + g); vw[u] = *(const GAS u32x4*)(RWV + g); gw4[u] = *(const GAS u32x4*)(RWG + g); }
#pragma unroll
        for (int u = 0; u < 2; ++u) { float y[8], r[8], k[8], v[8], gg[8], o[8]; unpack8(yw[u], y); unpack8(rw[u], r); unpack8(kw[u], k); unpack8(vw[u], v); unpack8(gw4[u], gg);
            float s = 0.f, bs = 0.f;
#pragma unroll
            for (int i = 0; i < 8; ++i) { s += y[i]; bs += r[i] * k[i] * rk[i]; }
            s += __shfl_xor(s, 1); s += __shfl_xor(s, 2); s += __shfl_xor(s, 4); bs += __shfl_xor(bs, 1); bs += __shfl_xor(bs, 2); bs += __shfl_xor(bs, 4);
            const float mu = s * (1.0f / 64.0f); float q = 0.f;
#pragma unroll
            for (int i = 0; i < 8; ++i) { y[i] -= mu; q += y[i] * y[i]; }
            q += __shfl_xor(q, 1); q += __shfl_xor(q, 2); q += __shfl_xor(q, 4);
            const float rs = 1.0f / sqrtf(q * (1.0f / 64.0f) + 64e-5f);
#pragma unroll
            for (int i = 0; i < 8; ++i) o[i] = (y[i] * rs * w8[i] + b8[i] + bs * v[i]) * gg[i];
            *(GAS u32x4*)(YS + (size_t)(row0 + u) * 2048 + 1536 + c0) = pack8(o); }
    }
}

__device__ __forceinline__ int pi_swap23(int i) { return (i & ~12) | ((i & 4) << 1) | ((i & 8) >> 1); }
__device__ __forceinline__ void da_unit(const Ctx& C, const Args& a, int l, int b, int h, int jq, float lam, float oml) {
    const GAS bf16* P = (const GAS bf16*)(C.ws + WS_P); const GAS bf16* VT = (const GAS bf16*)(C.ws + WS_VT); GAS bf16* YS = (GAS bf16*)(C.ws + WS_YS);
    const GAS float* dnorm = (const GAS float*)a.in[11] + (size_t)l * 128;
    const int comp = C.wave >> 2, wq = C.wave & 3, q = C.lane & 31, hi = C.lane >> 5;
    const size_t qrow = (size_t)b * SEQ + jq * 128 + wq * 32 + q;
    pg8::bf16x8 qf[4];
#pragma unroll
    for (int d0 = 0; d0 < 4; ++d0) qf[d0] = *(const GAS pg8::bf16x8*)(P + qrow * NPM + C_DAQ + h * 128 + comp * 64 + 16 * d0 + 8 * hi);
    const int ntile = 2 * jq + 2, my_last = 2 * jq + (wq >= 2 ? 1 : 0);
    f32x16 O[4];
#pragma unroll
    for (int db = 0; db < 4; ++db)
#pragma unroll
        for (int r = 0; r < 16; ++r) O[db][r] = 0.f;
    float mrun = 0.f, lrun = 0.f;
    f32x16 negm;
#pragma unroll
    for (int r = 0; r < 16; ++r) negm[r] = 0.f;
    const GAS bf16* kg = P + ((size_t)b * SEQ + C.lane) * NPM + C_DAK + h * 128 + C.wave * 8;
    const GAS bf16* vg = VT + ((size_t)(b * 4 + h) * 128 + 64 * (C.wave & 1) + C.lane) * SEQ + (C.wave >> 1) * 8;
    const unsigned lds0 = (unsigned)(size_t)C.lds;
    const unsigned kdst0 = lds0 + (unsigned)(C.wave >> 3) * 8192u + (unsigned)(C.wave & 7) * 1024u;
    const unsigned vdst0 = lds0 + 32768u + (unsigned)(C.wave >> 1) * 2048u + (unsigned)(C.wave & 1) * 1024u;
    const int pq = pi_swap23(q);
    pg8::bf16x8 pb[4] = {}, pbp[4] = {};
    int vs = 0, vsp = 0;
#define DA_GLDS(gp_, dst_) do { unsigned keep_; asm volatile("s_mov_b32 %0, m0\n\ts_mov_b32 m0, %2\n\ts_nop 0\n\tglobal_load_lds_dwordx4 %1, off\n\ts_mov_b32 m0, %0" : "=&s"(keep_) : "v"(gp_), "s"((unsigned)__builtin_amdgcn_readfirstlane(dst_)) : "memory"); } while (0)
#define DA_DMA(tile_, vslot_) do { const GAS bf16* kp_ = kg + (size_t)(tile_) * 64 * NPM; const GAS bf16* vp_ = vg + (tile_) * 64; const unsigned kd_ = kdst0 + (unsigned)((tile_) & 1) * 16384u, vd_ = vdst0 + (unsigned)(vslot_); \
        DA_GLDS(kp_, kd_); DA_GLDS(kp_ + 64, kd_ + 8192u); DA_GLDS(vp_, vd_); DA_GLDS(vp_ + 32, vd_ + 8192u); } while (0)
#define DA_STAGE(tile_) do { asm volatile("s_waitcnt vmcnt(0)" ::: "memory"); WG_SYNC(); if ((tile_) + 1 < ntile) DA_DMA((tile_) + 1, (vs == 32768) ? 0 : vs + 16384); } while (0)
#define DA_QK(tile_) do { const LAS unsigned char* kb_ = C.lds + ((tile_) & 1) * 16384 + comp * 8192 + hi * 1024 + pq * 16; pg8::bf16x8 ka_[8]; \
        _Pragma("unroll") for (int d0 = 0; d0 < 4; ++d0) { ka_[2 * d0] = *(const LAS pg8::bf16x8*)(kb_ + d0 * 2048); ka_[2 * d0 + 1] = *(const LAS pg8::bf16x8*)(kb_ + d0 * 2048 + 512); } \
        __builtin_amdgcn_sched_barrier(0); \
        p0 = __builtin_amdgcn_mfma_f32_32x32x16_bf16(ka_[0], qf[0], negm, 0, 0, 0); p1 = __builtin_amdgcn_mfma_f32_32x32x16_bf16(ka_[1], qf[0], negm, 0, 0, 0); \
        _Pragma("unroll") for (int d0 = 1; d0 < 4; ++d0) { p0 = __builtin_amdgcn_mfma_f32_32x32x16_bf16(ka_[2 * d0], qf[d0], p0, 0, 0, 0); p1 = __builtin_amdgcn_mfma_f32_32x32x16_bf16(ka_[2 * d0 + 1], qf[d0], p1, 0, 0, 0); } } while (0)
#define DA_PV(PB_, voff_) do { const LAS unsigned char* vb_ = C.lds + 32768 + (voff_); _Pragma("unroll") for (int db = 0; db < 4; ++db) _Pragma("unroll") for (int s = 0; s < 4; ++s) { \
            const pg8::bf16x8 vf_ = *(const LAS pg8::bf16x8*)(vb_ + (2 * s + hi) * 2048 + (32 * db + q) * 16); O[db] = __builtin_amdgcn_mfma_f32_32x32x16_bf16(vf_, PB_[s], O[db], 0, 0, 0); } } while (0)
#define DA_MX3(a_, b_, c_) __builtin_fmaxf(__builtin_fmaxf((a_), (b_)), (c_))
#define DA_SM_MAX(FIRST_, PBP_) do { \
        float ma = DA_MX3(p0[0], p0[1], p1[0]), mb = DA_MX3(p0[2], p0[3], p1[1]); ma = DA_MX3(ma, p1[2], p1[3]); \
        _Pragma("unroll") for (int r = 4; r < 16; r += 4) { ma = DA_MX3(ma, p0[r], p0[r + 1]); mb = DA_MX3(mb, p0[r + 2], p0[r + 3]); ma = DA_MX3(ma, p1[r], p1[r + 1]); mb = DA_MX3(mb, p1[r + 2], p1[r + 3]); } \
        float rm = __builtin_fmaxf(ma, mb); rm = __builtin_fmaxf(rm, __shfl_xor(rm, 32)); \
        if ((FIRST_) || __any(rm > 8.0f)) { const float dl = (FIRST_) ? rm : __builtin_fmaxf(rm, 0.f); mrun += dl; const float f = __builtin_amdgcn_exp2f(-dl); lrun *= f; \
            _Pragma("unroll") for (int r = 0; r < 16; ++r) { p0[r] -= dl; p1[r] -= dl; negm[r] = -mrun; } \
            _Pragma("unroll") for (int db = 0; db < 4; ++db) _Pragma("unroll") for (int r = 0; r < 16; ++r) O[db][r] *= f; \
            if (!(FIRST_)) { _Pragma("unroll") for (int s_ = 0; s_ < 4; ++s_) { const u32x4 w_ = __builtin_bit_cast(u32x4, PBP_[s_]); u32x4 o_; \
                o_.x = pk2(bflo(w_.x) * f, bfhi(w_.x) * f); o_.y = pk2(bflo(w_.y) * f, bfhi(w_.y) * f); o_.z = pk2(bflo(w_.z) * f, bfhi(w_.z) * f); o_.w = pk2(bflo(w_.w) * f, bfhi(w_.w) * f); PBP_[s_] = __builtin_bit_cast(pg8::bf16x8, o_); } } } } while (0)
#define DA_SM_EXP(PBO_) do { \
        _Pragma("unroll") for (int r = 0; r < 16; ++r) { p0[r] = __builtin_amdgcn_exp2f(p0[r]); p1[r] = __builtin_amdgcn_exp2f(p1[r]); } \
        { f32x2 s2 = {0.f, 0.f}; _Pragma("unroll") for (int r = 0; r < 16; r += 2) { s2 += (f32x2){p0[r], p0[r + 1]}; s2 += (f32x2){p1[r], p1[r + 1]}; } lrun += s2[0] + s2[1]; } \
        { u32x4 w; \
          w.x = pk2(p0[0], p0[1]); w.y = pk2(p0[2], p0[3]); w.z = pk2(p0[4], p0[5]); w.w = pk2(p0[6], p0[7]); PBO_[0] = __builtin_bit_cast(pg8::bf16x8, w); \
          w.x = pk2(p0[8], p0[9]); w.y = pk2(p0[10], p0[11]); w.z = pk2(p0[12], p0[13]); w.w = pk2(p0[14], p0[15]); PBO_[1] = __builtin_bit_cast(pg8::bf16x8, w); \
          w.x = pk2(p1[0], p1[1]); w.y = pk2(p1[2], p1[3]); w.z = pk2(p1[4], p1[5]); w.w = pk2(p1[6], p1[7]); PBO_[2] = __builtin_bit_cast(pg8::bf16x8, w); \
          w.x = pk2(p1[8], p1[9]); w.y = pk2(p1[10], p1[11]); w.z = pk2(p1[12], p1[13]); w.w = pk2(p1[14], p1[15]); PBO_[3] = __builtin_bit_cast(pg8::bf16x8, w); } } while (0)
#define DA_VADDR(i_) (vb_ + ((i_) & 3) * 4096 + ((i_) >> 2) * 512)
#define DA_PV_EXP(PBP_, voff_, PBO_) do { const LAS unsigned char* vb_ = C.lds + 32768 + (voff_) + hi * 2048 + q * 16; f32x2 s2_ = {0.f, 0.f}; unsigned pw_[16]; \
        pg8::bf16x8 vq_[4];   \
        vq_[0] = *(const LAS pg8::bf16x8*)DA_VADDR(0); vq_[1] = *(const LAS pg8::bf16x8*)DA_VADDR(1); vq_[2] = *(const LAS pg8::bf16x8*)DA_VADDR(2); \
        _Pragma("unroll") for (int i_ = 0; i_ < 16; ++i_) { const int db_ = i_ >> 2, s_ = i_ & 3; \
            if (i_ + 3 < 16) vq_[(i_ + 3) & 3] = *(const LAS pg8::bf16x8*)DA_VADDR(i_ + 3); \
            O[db_] = __builtin_amdgcn_mfma_f32_32x32x16_bf16(vq_[i_ & 3], PBP_[s_], O[db_], 0, 0, 0); \
            float e0_, e1_; if (i_ < 8) { e0_ = __builtin_amdgcn_exp2f(p0[2 * i_]); e1_ = __builtin_amdgcn_exp2f(p0[2 * i_ + 1]); } else { e0_ = __builtin_amdgcn_exp2f(p1[2 * i_ - 16]); e1_ = __builtin_amdgcn_exp2f(p1[2 * i_ - 15]); } \
            s2_ += (f32x2){e0_, e1_}; pw_[i_] = pk2(e0_, e1_); \
            __builtin_amdgcn_sched_barrier(0); } \
        lrun += s2_[0] + s2_[1]; \
        _Pragma("unroll") for (int k_ = 0; k_ < 4; ++k_) { u32x4 w_; w_.x = pw_[4 * k_]; w_.y = pw_[4 * k_ + 1]; w_.z = pw_[4 * k_ + 2]; w_.w = pw_[4 * k_ + 3]; PBO_[k_] = __builtin_bit_cast(pg8::bf16x8, w_); } } while (0)
    f32x16 p0, p1;
    DA_DMA(0, 0);
    DA_STAGE(0); DA_QK(0); DA_SM_MAX(true, pbp); DA_SM_EXP(pb);
    for (int tile = 1; tile <= my_last; ++tile) {
        vsp = vs; vs = (vs == 32768) ? 0 : vs + 16384;
#pragma unroll
        for (int s = 0; s < 4; ++s) pbp[s] = pb[s];
        DA_STAGE(tile); DA_QK(tile); DA_SM_MAX(false, pbp);
        DA_PV_EXP(pbp, vsp, pb);
    }
    if (my_last < ntile - 1) { const int vkeep = vs; vs = (vs == 32768) ? 0 : vs + 16384; DA_STAGE(ntile - 1); vs = vkeep; }
    DA_PV(pb, vs);
#undef DA_GLDS
#undef DA_DMA
#undef DA_STAGE
#undef DA_QK
#undef DA_PV
#undef DA_MX3
#undef DA_SM_MAX
#undef DA_SM_EXP
#undef DA_PV_EXP
#undef DA_VADDR
    const float ltot = lrun + __shfl_xor(lrun, 32); const float inv = 1.0f / ltot;
    WG_SYNC();
    LF X = (LF)C.lds + (wq * 32 + q) * 132;
    if (comp == 1) {
        const float sc = inv * lam;
#pragma unroll
        for (int db = 0; db < 4; ++db)
#pragma unroll
            for (int g4 = 0; g4 < 4; ++g4) *(LAS f32x4*)(X + 32 * db + 8 * g4 + 4 * hi) = (f32x4){O[db][4 * g4] * sc, O[db][4 * g4 + 1] * sc, O[db][4 * g4 + 2] * sc, O[db][4 * g4 + 3] * sc};
    }
    WG_SYNC();
    if (comp == 0) {
        float ss = 0.f;
#pragma unroll
        for (int db = 0; db < 4; ++db)
#pragma unroll
            for (int g4 = 0; g4 < 4; ++g4) { const f32x4 x = *(const LAS f32x4*)(X + 32 * db + 8 * g4 + 4 * hi);
#pragma unroll
                for (int e = 0; e < 4; ++e) { const float v = O[db][4 * g4 + e] * inv - x[e]; O[db][4 * g4 + e] = v; ss += v * v; } }
        ss += __shfl_xor(ss, 32);
        const float rs = oml / sqrtf(ss * (1.0f / 128.0f) + EPS);
#pragma unroll
        for (int db = 0; db < 4; ++db)
#pragma unroll
            for (int g4 = 0; g4 < 4; ++g4) { const int d = 32 * db + 8 * g4 + 4 * hi; const f32x4 gn = *(const GAS f32x4*)(dnorm + d);
                u32x2 w; w.x = pk2(O[db][4 * g4] * rs * gn[0], O[db][4 * g4 + 1] * rs * gn[1]); w.y = pk2(O[db][4 * g4 + 2] * rs * gn[2], O[db][4 * g4 + 3] * rs * gn[3]);
                *(GAS u32x2*)(YS + qrow * 2048 + h * 128 + d) = w; }
    }
    WG_SYNC();
}
#if RW_CHUNKED
__device__ const signed char ATT_BINS30[30][3] = {{63,4,3}, {62,5,2}, {61,6,1}, {60,7,0}, {59,8,-1}, {58,9,-1}, {57,10,-1}, {56,11,-1}, {55,12,-1}, {54,13,-1}, {53,14,-1}, {52,15,-1}, {51,16,-1}, {50,17,-1}, {49,18,-1}, {48,19,-1}, {47,20,-1}, {46,21,-1}, {45,22,-1}, {44,23,-1}, {43,24,-1}, {42,25,-1}, {41,26,-1}, {40,27,-1}, {39,28,-1}, {38,29,-1}, {37,30,-1}, {36,31,-1}, {35,32,-1}, {34,33,-1}};
__device__ __forceinline__ int att_bin_unit(int bin, int i) { return i < 3 ? (int)ATT_BINS30[bin][i] : -1; }
#else
__device__ const signed char ATT_BINS[24][12] = {{63,21,-1,-1,-1,-1,-1,-1,-1,-1,-1,-1}, {62,22,-1,-1,-1,-1,-1,-1,-1,-1,-1,-1}, {61,23,-1,-1,-1,-1,-1,-1,-1,-1,-1,-1}, {60,24,-1,-1,-1,-1,-1,-1,-1,-1,-1,-1}, {59,25,-1,-1,-1,-1,-1,-1,-1,-1,-1,-1}, {58,26,-1,-1,-1,-1,-1,-1,-1,-1,-1,-1}, {57,27,-1,-1,-1,-1,-1,-1,-1,-1,-1,-1}, {56,28,-1,-1,-1,-1,-1,-1,-1,-1,-1,-1}, {55,29,-1,-1,-1,-1,-1,-1,-1,-1,-1,-1}, {54,30,-1,-1,-1,-1,-1,-1,-1,-1,-1,-1}, {53,31,-1,-1,-1,-1,-1,-1,-1,-1,-1,-1}, {52,32,-1,-1,-1,-1,-1,-1,-1,-1,-1,-1}, {51,33,-1,-1,-1,-1,-1,-1,-1,-1,-1,-1}, {50,34,-1,-1,-1,-1,-1,-1,-1,-1,-1,-1}, {49,35,-1,-1,-1,-1,-1,-1,-1,-1,-1,-1}, {48,36,-1,-1,-1,-1,-1,-1,-1,-1,-1,-1}, {47,37,-1,-1,-1,-1,-1,-1,-1,-1,-1,-1}, {46,38,-1,-1,-1,-1,-1,-1,-1,-1,-1,-1}, {45,39,-1,-1,-1,-1,-1,-1,-1,-1,-1,-1}, {44,40,-1,-1,-1,-1,-1,-1,-1,-1,-1,-1}, {43,41,-1,-1,-1,-1,-1,-1,-1,-1,-1,-1}, {42,20,19,6,-1,-1,-1,-1,-1,-1,-1,-1}, {18,17,16,15,14,5,-1,-1,-1,-1,-1,-1}, {13,12,11,10,9,8,7,4,3,2,1,0}};
__device__ __forceinline__ int att_bin_unit(int bin, int i) { return i < 12 ? (int)ATT_BINS[bin][i] : -1; }
#endif
__device__ __forceinline__ void ph_da_attn(const Ctx& C, const Args& a, int l, int bh, int bin) {
    const GAS float* q1 = (const GAS float*)a.in[7] + (size_t)l * 64; const GAS float* k1 = (const GAS float*)a.in[8] + (size_t)l * 64; const GAS float* q2 = (const GAS float*)a.in[9] + (size_t)l * 64; const GAS float* k2 = (const GAS float*)a.in[10] + (size_t)l * 64;
    float s1 = 0.f, s2 = 0.f;
    for (int i = 0; i < 64; ++i) { s1 += q1[i] * k1[i]; s2 += q2[i] * k2[i]; }
    int ll = l; asm volatile("" : "+s"(ll));
    const float lam_init = 0.8f - 0.6f * expf(-0.3f * (float)ll); const float lam_v = expf(s1) - expf(s2) + lam_init;
    const float lam = __uint_as_float(__builtin_amdgcn_readfirstlane(__float_as_uint(lam_v))), oml = __uint_as_float(__builtin_amdgcn_readfirstlane(__float_as_uint(1.0f - lam_init)));
    for (int i = 0; i < 12; ++i) { const int jq = att_bin_unit(bin, i); if (jq < 0) break; da_unit(C, a, l, bh >> 2, bh & 3, jq, lam, oml); }
}

PH_FN void ph_final(const Ctx C, ArgsP a) {
    const GAS float* ssq = (const GAS float*)(C.ws + WS_SSQ); const GAS float* fn = a->in[39]; const GAS bf16* hb = (const GAS bf16*)(C.ws + WS_HB);
    const int gw = C.bid * NWAVES + C.wave, NGW = C.G * NWAVES;
    for (int m = gw; m < M; m += NGW) { const float rs = pg8::row_rstd((const float*)ssq, m, M); GAS f32x4* orow = (GAS f32x4*)(C.h + (size_t)m * D) + C.lane; const GAS f32x4* gr = (const GAS f32x4*)fn + C.lane;
        const GAS u32x2* hr = (const GAS u32x2*)(hb + (size_t)m * D) + C.lane;
#pragma unroll
        for (int j = 0; j < 4; ++j) { const u32x2 w = hr[64 * j]; const f32x4 g = gr[64 * j]; orow[64 * j] = (f32x4){bflo(w.x) * rs * g[0], bfhi(w.x) * rs * g[1], bflo(w.y) * rs * g[2], bfhi(w.y) * rs * g[3]}; } }
}
#define RWC_PTRS \
    GAS float* RWW = (GAS float*)(C.ws + WS_RWW); const GAS bf16* RWR = (const GAS bf16*)(C.ws + WS_RWR); const GAS bf16* RWK = (const GAS bf16*)(C.ws + WS_RWK); const GAS bf16* RWV = (const GAS bf16*)(C.ws + WS_RWV); \
    GAS bf16* RWKK = (GAS bf16*)(C.ws + WS_RWKK); GAS bf16* RWB = (GAS bf16*)(C.ws + WS_RWB); GAS bf16* RWY = (GAS bf16*)(C.ws + WS_RWY); \
    LF LGs = (LF)C.lds; LB LP = (LB)C.lds; LB LPT = (LB)(C.lds + 9216); LB AT = (LB)(C.lds + 18432); LB LAK = AT; LB LP2 = AT; LB RT = (LB)(C.lds + 27648); LB BTl = (LB)(C.lds + 36864); LB MRB = BTl; LB KTl = (LB)(C.lds + 46080); LB MRK = KTl; \
    LB VT = (LB)(C.lds + 55296); LB BHT = (LB)(C.lds + 64512); LB KHT = (LB)(C.lds + 73728); LB XB0 = (LB)(C.lds + 82944); LB XB1 = (LB)(C.lds + 101376); LB LPT2 = (LB)(C.lds + 119808); LF rho = (LF)(C.lds + 129024); LF lgl = rho + 64; \
    const int t = C.tid >> 3, g8 = C.tid & 7, n = C.lane & 31, hi = C.lane >> 5; \
    (void)RWW; (void)RWR; (void)RWK; (void)RWV; (void)RWKK; (void)RWB; (void)RWY; (void)LGs; (void)LP; (void)LPT; (void)AT; (void)LAK; (void)LP2; (void)RT; (void)BTl; (void)MRB; (void)KTl; (void)MRK; (void)VT; (void)BHT; (void)KHT; (void)XB0; (void)XB1; (void)LPT2; (void)rho; (void)lgl; (void)t; (void)g8; (void)n; (void)hi;
PH_FN void rwc_stage0(const Ctx C, int bc, int h) {
    RWC_PTRS
    const size_t row0 = (size_t)bc * 64; const size_t g = (row0 + t) * 512 + h * 64 + g8 * 8;
    WG_SYNC();
    float lw[8]; { const f32x4 x0 = *(const GAS f32x4*)(RWW + g), x1 = *(const GAS f32x4*)(RWW + g + 4); lw[0] = x0[0]; lw[1] = x0[1]; lw[2] = x0[2]; lw[3] = x0[3]; lw[4] = x1[0]; lw[5] = x1[1]; lw[6] = x1[2]; lw[7] = x1[3]; }
#pragma unroll
    for (int i = 0; i < 8; ++i) LGs[t * 68 + g8 * 8 + i] = lw[i];
    WG_SYNC();
    { const int seg = C.tid >> 6, k = C.tid & 63; float run = 0.f;
#pragma unroll
      for (int i = 0; i < 8; ++i) { run += LGs[(8 * seg + i) * 68 + k]; LGs[(8 * seg + i) * 68 + k] = run; }
      WG_SYNC();
      float off = 0.f;
#pragma unroll
      for (int sg = 0; sg < 7; ++sg) { const float tot = LGs[(8 * sg + 7) * 68 + k]; off += (sg < seg) ? tot : 0.f; }
      WG_SYNC();
#pragma unroll
      for (int i = 0; i < 8; ++i) LGs[(8 * seg + i) * 68 + k] += off; }
    WG_SYNC();
    {   float rf[8], kf[8], kkf[8], bf[8], lg[8], rh[8], ll[8], o1[8], o2[8], o3[8], o4[8];
        unpack8(*(const GAS u32x4*)(RWR + g), rf); unpack8(*(const GAS u32x4*)(RWK + g), kf); unpack8(*(const GAS u32x4*)(RWKK + g), kkf); unpack8(*(const GAS u32x4*)(RWB + g), bf);
#pragma unroll
        for (int i = 0; i < 8; ++i) { const int k = g8 * 8 + i; lg[i] = LGs[t * 68 + k]; rh[i] = LGs[31 * 68 + k]; ll[i] = LGs[63 * 68 + k]; }
#pragma unroll
        for (int i = 0; i < 8; ++i) { const int k = g8 * 8 + i; const float lm1 = lg[i] - lw[i];
            const float ed = __expf(lg[i] - rh[i]), edi = __expf(rh[i] - lg[i]), el = __expf(ll[i] - lg[i]);
            o1[i] = -kkf[i] * __expf(lm1 - rh[i]); o2[i] = rf[i] * ed; o3[i] = bf[i] * edi; o4[i] = kf[i] * edi;
            XB0[k * 72 + t] = (bf16)f2bf(-kkf[i] * __expf(lm1));
            BHT[k * 72 + t] = (bf16)f2bf(bf[i] * el); KHT[k * 72 + t] = (bf16)f2bf(kf[i] * el); }
        *(LAS u32x4*)(AT + t * 72 + g8 * 8) = pack8(o1); *(LAS u32x4*)(RT + t * 72 + g8 * 8) = pack8(o2); *(LAS u32x4*)(BTl + t * 72 + g8 * 8) = pack8(o3); *(LAS u32x4*)(KTl + t * 72 + g8 * 8) = pack8(o4);
        const u32x4 vv = *(const GAS u32x4*)(RWV + g); const unsigned vw[4] = {vv.x, vv.y, vv.z, vv.w};
#pragma unroll
        for (int i = 0; i < 4; ++i) { VT[(g8 * 8 + 2 * i) * 72 + t] = (bf16)(vw[i] & 0xffffu); VT[(g8 * 8 + 2 * i + 1) * 72 + t] = (bf16)(vw[i] >> 16); }
        if (t == 0) {
#pragma unroll
            for (int i = 0; i < 8; ++i) { rho[g8 * 8 + i] = rh[i]; lgl[g8 * 8 + i] = ll[i]; } }
    }
    WG_SYNC();
}
PH_FN void rwc_stage12(const Ctx C) {
    RWC_PTRS
    {   const int mt = C.wave >> 1, nt0 = 2 * (C.wave & 1);
        CLB Am = (mt < 2) ? (CLB)AT : (CLB)RT; const int m0 = 32 * (mt & 1);
        CLB Bm = (nt0 < 2) ? (CLB)BTl : (CLB)KTl;
        f32x16 c0 = zero16(), c1 = zero16();
        mma_nt<64>(c0, Am, 72, m0, Bm, 72, 0, C.lane); mma_nt<64>(c1, Am, 72, m0, Bm, 72, 32, C.lane);
        WG_SYNC();
#pragma unroll
        for (int r = 0; r < 16; ++r) { const int tt = m0 + crow(r, hi); const int j0 = n, j1 = 32 + n;
            if (mt < 2) { const bf16 x0 = (bf16)f2bf((j0 < tt) ? c0[r] : 0.f), x1 = (bf16)f2bf((j1 < tt) ? c1[r] : 0.f);
                if (nt0 < 2) { LP[tt * 72 + j0] = x0; LP[tt * 72 + j1] = x1; LPT[j0 * 72 + tt] = x0; LPT[j1 * 72 + tt] = x1; } else { LAK[tt * 72 + j0] = x0; LAK[tt * 72 + j1] = x1; } }
            else { const bf16 x0 = (bf16)f2bf((j0 <= tt) ? c0[r] : 0.f), x1 = (bf16)f2bf((j1 <= tt) ? c1[r] : 0.f);
                if (nt0 < 2) { MRB[tt * 72 + j0] = x0; MRB[tt * 72 + j1] = x1; } else { MRK[tt * 72 + j0] = x0; MRK[tt * 72 + j1] = x1; } } }
    }
    WG_SYNC();
    if (C.wave < 4) { const int vt = C.wave >> 1, tt0 = C.wave & 1; f32x16 c = zero16(); mma_nt<64>(c, VT, 72, 32 * vt, LAK, 72, 32 * tt0, C.lane);
#pragma unroll
        for (int r = 0; r < 16; ++r) XB0[(64 + 32 * vt + crow(r, hi)) * 72 + 32 * tt0 + n] = (bf16)f2bf(c[r]); }
    WG_SYNC();
}
#ifndef RWC_NSTEP
#define RWC_NSTEP 6
#endif
#ifndef RWC_REP0
#define RWC_REP0 1
#endif
PH_FN void rwc_solve(const Ctx C) {
    RWC_PTRS
    const int ct = C.wave >> 1, tt = C.wave & 1;
    const int sk = C.wave >> 2, st = (C.wave >> 1) & 1, sj = C.wave & 1;
#pragma unroll 1
    for (int i = 0; i < RWC_NSTEP; ++i) {
        CLB Pc = (i & 1) ? (CLB)LP2 : (CLB)LP; CLB PTc = (i & 1) ? (CLB)LPT2 : (CLB)LPT; LB Pn = (i & 1) ? LP : LP2; LB PTn = (i & 1) ? LPT : LPT2;
        CLB Xc = (i & 1) ? (CLB)XB1 : (CLB)XB0; LB Xn = (i & 1) ? XB0 : XB1;
        { f32x16 acc;
#pragma unroll
          for (int r = 0; r < 16; ++r) acc[r] = bf2f(Xc[(32 * ct + crow(r, hi)) * 72 + 32 * tt + n]);
          mma_nt<64>(acc, Xc, 72, 32 * ct, Pc, 72, 32 * tt, C.lane);
#pragma unroll
          for (int r = 0; r < 16; ++r) Xn[(32 * ct + crow(r, hi)) * 72 + 32 * tt + n] = (bf16)f2bf(acc[r]); }
        if (i < RWC_NSTEP - 1) { f32x16 acc = zero16();
          if (sk == 0) mma_nt<64>(acc, Pc, 72, 32 * st, PTc, 72, 32 * sj, C.lane); else mma_nt<64>(acc, PTc, 72, 32 * st, Pc, 72, 32 * sj, C.lane);
          LB dst = (sk == 0) ? Pn : PTn;
#pragma unroll
          for (int r = 0; r < 16; ++r) dst[(32 * st + crow(r, hi)) * 72 + 32 * sj + n] = (bf16)f2bf(acc[r]); }
        WG_SYNC();
    }
}
PH_FN void rwc_stage4(const Ctx C, int bc, int h) {
    RWC_PTRS
    const size_t row0 = (size_t)bc * 64; CLB A2T = (CLB)XB0; CLB WT = (CLB)(XB0 + 64 * 72);
    {   const int kind = C.wave >> 1, mt = C.wave & 1;
        f32x16 c0 = zero16(), c1 = zero16();
        if (kind == 0) { mma_nt<64>(c0, BHT, 72, 32 * mt, A2T, 72, 0, C.lane); mma_nt<64>(c1, BHT, 72, 32 * mt, A2T, 72, 32, C.lane); }
        else if (kind == 1) { mma_nt<64>(c0, BHT, 72, 32 * mt, WT, 72, 0, C.lane); mma_nt<64>(c1, BHT, 72, 32 * mt, WT, 72, 32, C.lane); mma_nt<64>(c0, KHT, 72, 32 * mt, VT, 72, 0, C.lane); mma_nt<64>(c1, KHT, 72, 32 * mt, VT, 72, 32, C.lane); }
        else if (kind == 2) { mma_nt<64>(c0, MRB, 72, 32 * mt, A2T, 72, 0, C.lane); mma_nt<64>(c1, MRB, 72, 32 * mt, A2T, 72, 32, C.lane); }
        else { mma_nt<64>(c0, MRB, 72, 32 * mt, WT, 72, 0, C.lane); mma_nt<64>(c1, MRB, 72, 32 * mt, WT, 72, 32, C.lane); mma_nt<64>(c0, MRK, 72, 32 * mt, VT, 72, 0, C.lane); mma_nt<64>(c1, MRK, 72, 32 * mt, VT, 72, 32, C.lane); }
#pragma unroll
        for (int r = 0; r < 16; ++r) { const int m = 32 * mt + crow(r, hi); const size_t go = (row0 + m) * 512 + h * 64;
            if (kind == 0) { const float d = __expf(lgl[m]); RWB[go + n] = (bf16)f2bf(c0[r] + ((n == m) ? d : 0.f)); RWB[go + 32 + n] = (bf16)f2bf(c1[r] + ((32 + n == m) ? d : 0.f)); }
            else if (kind == 1) { RWW[go + n] = c0[r]; RWW[go + 32 + n] = c1[r]; }
            else if (kind == 2) { RWKK[go + n] = (bf16)f2bf(c0[r] + bf2f(RT[m * 72 + n]) * __expf(rho[n])); RWKK[go + 32 + n] = (bf16)f2bf(c1[r] + bf2f(RT[m * 72 + 32 + n]) * __expf(rho[32 + n])); }
            else { RWY[go + n] = (bf16)f2bf(c0[r]); RWY[go + 32 + n] = (bf16)f2bf(c1[r]); } }
    }
}
__device__ __forceinline__ void ph_rw_chunk(const Ctx& C, int bc) {
#pragma unroll 1
    for (int h = 0; h < 8; ++h) { for (int r0 = 0; r0 < RWC_REP0; ++r0) rwc_stage0(C, bc, h); rwc_stage12(C); rwc_solve(C); rwc_stage4(C, bc, h); }
    WG_SYNC();
}
PH_FN void rw_scan_producer(const Ctx C, int chain) {
    const float* RWW = (const float*)(unsigned char*)(C.ws + WS_RWW); const bf16* RWKK = (const bf16*)(unsigned char*)(C.ws + WS_RWKK); const bf16* RWB = (const bf16*)(unsigned char*)(C.ws + WS_RWB); bf16* RWY = (bf16*)(unsigned char*)(C.ws + WS_RWY);
    const int b = chain >> 3, h = chain & 7; const size_t rowb = (size_t)b * SEQ;
    constexpr int BUFB = 45056, O_RQ = 0, O_PT = 9216, O_QT = 18432, O_Y0 = 35840;
    LAS unsigned char* L = C.lds;
        const int p = C.tid - 256, t = p >> 2, q4 = (p & 3) * 16;
        u32x4 Arq0, Arq1, Apt0, Apt1, Ay00, Ay01, Brq0, Brq1, Bpt0, Bpt1, By00, By01; f32x4 Aq0, Aq1, Aq2, Aq3, Bq0, Bq1, Bq2, Bq3;
#define SC_LOAD(S, c_) do { const size_t g_ = (rowb + (size_t)(c_) * 64 + t) * 512 + h * 64 + q4; \
            S##rq0 = *(const u32x4*)(RWKK + g_); S##rq1 = *(const u32x4*)(RWKK + g_ + 8); S##pt0 = *(const u32x4*)(RWB + g_); S##pt1 = *(const u32x4*)(RWB + g_ + 8); S##y00 = *(const u32x4*)(RWY + g_); S##y01 = *(const u32x4*)(RWY + g_ + 8); \
            S##q0 = *(const f32x4*)(RWW + g_); S##q1 = *(const f32x4*)(RWW + g_ + 4); S##q2 = *(const f32x4*)(RWW + g_ + 8); S##q3 = *(const f32x4*)(RWW + g_ + 12); } while (0)
#define SC_WRITE(S, Lb) do { \
            *(LAS u32x4*)((LB)((Lb) + O_RQ) + t * 72 + q4) = S##rq0; *(LAS u32x4*)((LB)((Lb) + O_RQ) + t * 72 + q4 + 8) = S##rq1; \
            *(LAS u32x4*)((LB)((Lb) + O_PT) + t * 72 + q4) = S##pt0; *(LAS u32x4*)((LB)((Lb) + O_PT) + t * 72 + q4 + 8) = S##pt1; \
            *(LAS u32x4*)((LB)((Lb) + O_Y0) + t * 72 + q4) = S##y00; *(LAS u32x4*)((LB)((Lb) + O_Y0) + t * 72 + q4 + 8) = S##y01; \
            { LF d_ = (LF)((Lb) + O_QT) + t * 68 + q4; *(LAS f32x4*)d_ = S##q0; *(LAS f32x4*)(d_ + 4) = S##q1; *(LAS f32x4*)(d_ + 8) = S##q2; *(LAS f32x4*)(d_ + 12) = S##q3; } } while (0)
        SC_LOAD(A, 0); SC_LOAD(B, 1);
        for (int c = 0; c < NCH; c += 2) {
            SC_WRITE(A, L); if (c + 2 < NCH) SC_LOAD(A, c + 2); RW_BAR();
            SC_WRITE(B, L + BUFB); if (c + 3 < NCH) SC_LOAD(B, c + 3); RW_BAR();
        }
        RW_BAR();
#undef SC_LOAD
#undef SC_WRITE
}
PH_FN void rw_scan_consumer(const Ctx C, int chain) {
    const float* RWW = (const float*)(unsigned char*)(C.ws + WS_RWW); const bf16* RWKK = (const bf16*)(unsigned char*)(C.ws + WS_RWKK); const bf16* RWB = (const bf16*)(unsigned char*)(C.ws + WS_RWB); bf16* RWY = (bf16*)(unsigned char*)(C.ws + WS_RWY);
    const int b = chain >> 3, h = chain & 7; const size_t rowb = (size_t)b * SEQ;
    constexpr int BUFB = 45056, O_RQ = 0, O_PT = 9216, O_QT = 18432, O_Y0 = 35840;
    LAS unsigned char* L = C.lds;
        const int n = C.lane & 31, hi = C.lane >> 5, vh = C.wave & 1;
        f32x16 st0 = zero16(), st1 = zero16();
        for (int c = 0; c < NCH; ++c) {
            RW_BAR();
            if (C.wave < 2) {
                const LAS unsigned char* Lb = L + (c & 1) * BUFB;
                CLB RQ = (CLB)(Lb + O_RQ); CLB PT = (CLB)(Lb + O_PT); CLF QT = (CLF)(Lb + O_QT); CLB Y0 = (CLB)(Lb + O_Y0);
                pg8::bf16x8 sb[4];
                { u32x4 w;
                  w.x = pk2(st0[0], st0[1]); w.y = pk2(st0[2], st0[3]); w.z = pk2(st0[4], st0[5]); w.w = pk2(st0[6], st0[7]); sb[0] = __builtin_bit_cast(pg8::bf16x8, w);
                  w.x = pk2(st0[8], st0[9]); w.y = pk2(st0[10], st0[11]); w.z = pk2(st0[12], st0[13]); w.w = pk2(st0[14], st0[15]); sb[1] = __builtin_bit_cast(pg8::bf16x8, w);
                  w.x = pk2(st1[0], st1[1]); w.y = pk2(st1[2], st1[3]); w.z = pk2(st1[4], st1[5]); w.w = pk2(st1[6], st1[7]); sb[2] = __builtin_bit_cast(pg8::bf16x8, w);
                  w.x = pk2(st1[8], st1[9]); w.y = pk2(st1[10], st1[11]); w.z = pk2(st1[12], st1[13]); w.w = pk2(st1[14], st1[15]); sb[3] = __builtin_bit_cast(pg8::bf16x8, w); }
#define SC_AFRAG(X_, row_, s_) ({ const u32x2 lo_ = *(const LAS u32x2*)((X_) + (row_) * 72 + 16 * (s_) + 4 * hi), hi_ = *(const LAS u32x2*)((X_) + (row_) * 72 + 16 * (s_) + 8 + 4 * hi); \
                    u32x4 w_; w_.x = lo_.x; w_.y = lo_.y; w_.z = hi_.x; w_.w = hi_.y; __builtin_bit_cast(pg8::bf16x8, w_); })
#pragma unroll
                for (int tt = 0; tt < 2; ++tt) { f32x16 y;
#pragma unroll
                    for (int r = 0; r < 16; ++r) y[r] = bf2f(Y0[(32 * tt + crow(r, hi)) * 72 + 32 * vh + n]);
#pragma unroll
                    for (int s = 0; s < 4; ++s) y = __builtin_amdgcn_mfma_f32_32x32x16_bf16(SC_AFRAG(RQ, 32 * tt + n, s), sb[s], y, 0, 0, 0);
                    bf16* yo = RWY + (rowb + (size_t)c * 64 + 32 * tt) * 512 + h * 64 + 32 * vh + n;
#pragma unroll
                    for (int r = 0; r < 16; ++r) yo[(size_t)crow(r, hi) * 512] = (bf16)f2bf(y[r]); }
                f32x16 n0, n1;
#pragma unroll
                for (int r = 0; r < 16; ++r) { n0[r] = QT[crow(r, hi) * 68 + 32 * vh + n]; n1[r] = QT[(32 + crow(r, hi)) * 68 + 32 * vh + n]; }
#pragma unroll
                for (int s = 0; s < 4; ++s) { n0 = __builtin_amdgcn_mfma_f32_32x32x16_bf16(SC_AFRAG(PT, n, s), sb[s], n0, 0, 0, 0); n1 = __builtin_amdgcn_mfma_f32_32x32x16_bf16(SC_AFRAG(PT, 32 + n, s), sb[s], n1, 0, 0, 0); }
                st0 = n0; st1 = n1;
#undef SC_AFRAG
            }
        }
        RW_BAR();
}
__device__ __forceinline__ void rw_scan_unit(const Ctx& C, int chain) { if (C.wave >= 4) rw_scan_producer(C, chain); else rw_scan_consumer(C, chain); }
#ifndef REP_ATTN
#define REP_ATTN 1
#endif
#ifndef REP_W
#define REP_W 1
#endif
#ifndef REP_RWC
#define REP_RWC 1
#endif
#ifndef REP_MA
#define REP_MA 1
#endif
#ifndef REP_GLAA
#define REP_GLAA 1
#endif
#ifndef REP_SSDA
#define REP_SSDA 1
#endif
#ifndef REP_RWP
#define REP_RWP 1
#endif
#ifndef REP_GLAC
#define REP_GLAC 1
#endif
#ifndef REP_SSDC
#define REP_SSDC 1
#endif
#ifndef REP_RWO
#define REP_RWO 1
#endif
#ifndef REP_MAFULL
#define REP_MAFULL 1
#endif
#ifndef REP_SCANS
#define REP_SCANS 1
#endif
#ifndef REP_MC
#define REP_MC 1
#endif
#ifndef REP_GEMM
#define REP_GEMM 1
#endif
constexpr int NPH = 12, G_FINAL = 1 + NL * NPH, G_END = G_FINAL + 1;
template <int GRP>
__global__ void __launch_bounds__(NTHR, 2) hybrid_fwd(Args args) {
    constexpr bool ALL = (GRP < 0);
    constexpr bool EN_G1 = ALL || GRP == 0, EN_G2 = EN_G1, EN_G3 = EN_G1, EN_G7 = EN_G1, EN_G8 = EN_G1, EN_G9 = EN_G1;
    constexpr bool EN_PRO = ALL || GRP == 1, EN_W = EN_PRO, EN_FIN = EN_PRO, EN_MA1 = EN_PRO, EN_MA2 = EN_PRO, EN_MA3 = EN_PRO, EN_MA4 = EN_PRO;
    constexpr bool EN_MB1 = ALL || GRP == 2, EN_MB2 = EN_MB1;
    constexpr bool EN_MC1 = ALL || GRP == 3, EN_MC2 = EN_MC1, EN_MC3 = EN_MC1;
    extern __shared__ __attribute__((aligned(16))) unsigned char lds[];
    Ctx C; C.lds = (LAS unsigned char*)lds; C.ws = (GAS unsigned char*)args.ws; C.h = (GAS float*)args.out; C.tid = threadIdx.x; C.lane = C.tid & 63; C.wave = __builtin_amdgcn_readfirstlane(C.tid >> 6); C.bid = blockIdx.x; C.G = gridDim.x;
    LAS unsigned char* ldsl = (LAS unsigned char*)lds;
    const ArgsP ap = (ArgsP)__builtin_amdgcn_kernarg_segment_ptr();
    for (int u = C.tid; u < (LDS_BYTES - LDSCTL_OFF) / 4; u += NTHR) ((LAS unsigned*)(ldsl + LDSCTL_OFF))[u] = 0u;
    __syncthreads();
    volatile LAS unsigned* MISC = (volatile LAS unsigned*)(ldsl + MISC_OFF);
    gu32* ctl = (gu32*)(args.ws + WS_CTL);
    const int g_lo = args.g_lo, g_hi = args.g_hi;
    XcdBarrier bar; bar.bar = (unsigned*)(ctl + CW_BAR); bar.x = 0; bar.st = nullptr;
    if (g_hi - g_lo > 1) bar = xcd_barrier_post((unsigned*)(ctl + CW_BAR), MISC + 8);
#define IN(g) (g_lo <= (g) && (g) < g_hi)
#define SEAM(g) do { if (IN(g) && IN((g) + 1)) xcd_barrier(bar); } while (0)
    bf16* HB = (bf16*)(args.ws + WS_HB); float* SSQ = (float*)(args.ws + WS_SSQ);

    if (EN_PRO && IN(0)) ph_prologue(fresh(C), ap);
    SEAM(0);
#pragma unroll 1
    for (int l = 0; l < NL; ++l) {
        const int gb = 1 + NPH * l;
        if (EN_W && IN(gb + 0)) { for (int rep = 0; rep < REP_W; ++rep) ph_weights(fresh(C), ap, l); }
        SEAM(gb + 0);
#pragma unroll 1
        for (int f = 0; f < 2; ++f) {
            const int gu = gb + (f ? 10 : 1);
            if (EN_G1 && IN(gu)) {
                pg8::Gemm g{HB, (const bf16*)(args.ws + (f ? WS_WGU2 : WS_WGU1)), M, 2 * FF, D, D}; pg8::StaticOrder S; S.init(M, 2 * FF, C.G, C.bid);
                pg8::EpiSwiglu E{(bf16*)(args.ws + WS_ACT), FF, SSQ, M};
                pg8::gemm_phase<pg8::EpiSwiglu, pg8::StaticOrder, true, true>(ldsl, g, S, E);
            }
            SEAM(gu);
            if (EN_G2 && IN(gu + 1)) {
                pg8::Gemm g{(const bf16*)(args.ws + WS_ACT), (const bf16*)(args.ws + (f ? WS_WD2 : WS_WD1)), M, D, FF, FF}; pg8::StaticOrder S; S.init(M, D, C.G, C.bid);
                pg8::EpiResid E{HB, SSQ, M, 0.5f};
                pg8::gemm_phase<pg8::EpiResid, pg8::StaticOrder, false, true>(ldsl, g, S, E);
            }
            SEAM(gu + 1);
            if (f == 0) {
                if (EN_G3 && IN(gb + 3)) {
                    pg8::Gemm g{HB, (const bf16*)(args.ws + WS_WIN), M, NPM, D, D}; pg8::StaticOrder S; S.init(M, NPM, C.G, C.bid);
                    pg8::EpiScaleBf16 E{(bf16*)(args.ws + WS_P), NPM, SSQ, M};
                    pg8::gemm_phase<pg8::EpiScaleBf16, pg8::StaticOrder, true, true>(ldsl, g, S, E);
                }
                SEAM(gb + 3);
                if (IN(gb + 4)) { if (EN_MA1) ph_da_prep(fresh(C)); for (int rf = 0; rf < REP_MAFULL; ++rf) { for (int rep = 0; rep < REP_MA; ++rep) { for (int r2 = 0; r2 < REP_GLAA; ++r2) if (EN_MA2) ph_gla_a(fresh(C), ap, l); for (int r2 = 0; r2 < REP_SSDA; ++r2) if (EN_MA3) ph_ssd_a(fresh(C), ap, l); for (int r2 = 0; r2 < REP_RWP; ++r2) if (EN_MA4) ph_rw_prep(fresh(C), ap, l); } if (EN_MA4 && RW_CHUNKED) ph_rw_chunk(fresh(C), C.bid); } }
                SEAM(gb + 4);
                if (IN(gb + 5)) {
#if RW_CHUNKED
#define MB_SCANS() do { if (EN_MB2) { if (C.bid < 16) rw_scan_unit(fresh(C), C.bid); else { for (int p = C.bid - 16; p < 384; p += C.G - 16) { if (p < 128) gla_scan_part(fresh(C), p); else ssd_scan_part(fresh(C), p - 128); } } } } while (0)
                    MB_SCANS();
                    for (int rs = 1; rs < REP_SCANS; ++rs) {
                        xcd_barrier(bar); if (EN_MA2) ph_gla_a(fresh(C), ap, l); if (EN_MA3) ph_ssd_a(fresh(C), ap, l); if (EN_MA4) { ph_rw_prep(fresh(C), ap, l); ph_rw_chunk(fresh(C), C.bid); } xcd_barrier(bar); MB_SCANS(); }
                    if (C.bid >= 16) { const int a = C.bid - 16; for (int rep = 0; rep < REP_ATTN; ++rep) if (EN_MB1) ph_da_attn(fresh(C), args, l, a & 7, a >> 3); }
#else
                    if (C.bid < 64) { if (EN_MB2) { const int xcd = C.bid & 7, slot = C.bid >> 3; for (int rep = 0; rep < REP_RWC; ++rep) rw_unit(fresh(C), xcd * 2 + (slot >> 2), slot & 3); } }
                    else { const int a = C.bid - 64;
                        if (EN_MB2) { for (int p = a; p < 384; p += 192) { if (p < 128) gla_scan_part(fresh(C), p); else ssd_scan_part(fresh(C), p - 128); } }
                        for (int rep = 0; rep < REP_ATTN; ++rep) if (EN_MB1) ph_da_attn(fresh(C), args, l, a & 7, a >> 3); }
#endif
                }
                SEAM(gb + 5);
                if (IN(gb + 6)) { for (int rep = 0; rep < REP_MC; ++rep) { for (int r2 = 0; r2 < REP_GLAC; ++r2) if (EN_MC1) ph_gla_c(fresh(C), ap, l); for (int r2 = 0; r2 < REP_SSDC; ++r2) if (EN_MC2) ph_ssd_c(fresh(C), ap, l); for (int r2 = 0; r2 < REP_RWO; ++r2) if (EN_MC3) ph_rw_out(fresh(C), ap, l); } }
                SEAM(gb + 6);
                if (EN_G7 && IN(gb + 7)) {
                    pg8::Gemm g{HB, (const bf16*)(args.ws + WS_WIN) + (size_t)NPM * D, M, 4096, D, D}; pg8::StaticOrder S; S.init(M, 4096, C.G, C.bid);
                    pg8::EpiScaleBf16 E{(bf16*)(args.ws + WS_PG), 4096, SSQ, M};
                    pg8::gemm_phase<pg8::EpiScaleBf16, pg8::StaticOrder, true, true>(ldsl, g, S, E);
                }
                SEAM(gb + 7);
                if (EN_G8 && IN(gb + 8)) {
                    pg8::Gemm g{(const bf16*)(args.ws + WS_YS), (const bf16*)(args.ws + WS_WB), M, D, 2048, 2048}; pg8::StaticOrder S; S.init(M, D, C.G, C.bid);
                    pg8::EpiGateHorner E{(bf16*)(args.ws + WS_MERGED), (const bf16*)(args.ws + WS_PG), args.in[33] + (size_t)l * 4096};
                    pg8::gemm_phase<pg8::EpiGateHorner, pg8::StaticOrder, true, true>(ldsl, g, S, E);
                }
                SEAM(gb + 8);
                if (EN_G9 && IN(gb + 9)) {
                    pg8::Gemm g{(const bf16*)(args.ws + WS_MERGED), (const bf16*)(args.ws + WS_WO), M, D, D, D}; pg8::StaticOrder S; S.init(M, D, C.G, C.bid);
                    pg8::EpiResid E{HB, SSQ, M, 1.0f};
                    pg8::gemm_phase<pg8::EpiResid, pg8::StaticOrder, false, true>(ldsl, g, S, E);
                }
                SEAM(gb + 9);
            }
        }
    }
    if (EN_FIN && IN(G_FINAL)) ph_final(fresh(C), ap);
#undef IN
#undef SEAM
}

#ifndef ONE_LAUNCH
#define ONE_LAUNCH 1
#endif
extern "C" void kernel_launch(void* const* d_in, const int* in_sizes, int n_in, void* d_out, int out_size, void* d_ws, size_t ws_size, hipStream_t stream) {
    static int grid = 0;
    if (grid == 0) {
        if (n_in != 40 || in_sizes[0] != M * D || out_size != M * D || ws_size < WS_END) { fprintf(stderr, "kernel_launch: unexpected shapes (n_in %d, in0 %d, out %d, ws %zu < %zu); nothing launched\n", n_in, n_in > 0 ? in_sizes[0] : -1, out_size, ws_size, (size_t)WS_END); grid = -1; return; }
        int dev = 0, cus = 0, per_cu = 0;
        if (hipGetDevice(&dev) != hipSuccess || hipDeviceGetAttribute(&cus, hipDeviceAttributeMultiprocessorCount, dev) != hipSuccess) { grid = -1; return; }
#if ONE_LAUNCH
        if (hipFuncSetAttribute((const void*)hybrid_fwd<-1>, hipFuncAttributeMaxDynamicSharedMemorySize, LDS_BYTES) != hipSuccess) { fprintf(stderr, "kernel_launch: hipFuncSetAttribute failed\n"); grid = -1; return; }
#else
        if (hipFuncSetAttribute((const void*)hybrid_fwd<0>, hipFuncAttributeMaxDynamicSharedMemorySize, LDS_BYTES) != hipSuccess || hipFuncSetAttribute((const void*)hybrid_fwd<1>, hipFuncAttributeMaxDynamicSharedMemorySize, LDS_BYTES) != hipSuccess ||
            hipFuncSetAttribute((const void*)hybrid_fwd<2>, hipFuncAttributeMaxDynamicSharedMemorySize, LDS_BYTES) != hipSuccess || hipFuncSetAttribute((const void*)hybrid_fwd<3>, hipFuncAttributeMaxDynamicSharedMemorySize, LDS_BYTES) != hipSuccess) { fprintf(stderr, "kernel_launch: hipFuncSetAttribute failed\n"); grid = -1; return; }
#endif
        if (hipOccupancyMaxActiveBlocksPerMultiprocessor(&per_cu, (const void*)hybrid_fwd<(ONE_LAUNCH ? -1 : 0)>, NTHR, LDS_BYTES) != hipSuccess || per_cu < 1) fprintf(stderr, "kernel_launch: occupancy query reports %d workgroups per CU\n", per_cu);
        (void)hipGetLastError();
        grid = cus;
        if (grid != 256) { fprintf(stderr, "kernel_launch: %d CUs; this kernel is laid out for 256 workgroups; nothing launched\n", grid); grid = -1; return; }
    }
    if (grid < 0) return;
    if (hipMemsetAsync((char*)d_ws + WS_CTL, 0, CTL_ZERO_BYTES, stream) != hipSuccess) return;
    Args a{};
    for (int i = 0; i < 40; ++i) a.in[i] = (const float*)d_in[i];
    a.out = (float*)d_out; a.ws = (unsigned char*)d_ws;
    for (int j = 0; j < 32; ++j) a.inv_freq[j] = (float)pow(10000.0, -(double)j / 32.0);
#if ONE_LAUNCH
    a.g_lo = 0; a.g_hi = G_END;
    hipLaunchKernelGGL(hybrid_fwd<-1>, dim3(grid), dim3(NTHR), LDS_BYTES, stream, a);
#else
    for (int g = 0; g < G_END; ++g) {
        a.g_lo = g; a.g_hi = g + 1;
        int grp = 1;
        if (g >= 1 && g < G_FINAL) { const int k = (g - 1) % NPH; grp = (k == 0 || k == 4) ? 1 : (k == 5) ? 2 : (k == 6) ? 3 : 0; }
        if (grp == 0) hipLaunchKernelGGL(hybrid_fwd<0>, dim3(grid), dim3(NTHR), LDS_BYTES, stream, a);
        else if (grp == 1) hipLaunchKernelGGL(hybrid_fwd<1>, dim3(grid), dim3(NTHR), LDS_BYTES, stream, a);
        else if (grp == 2) hipLaunchKernelGGL(hybrid_fwd<2>, dim3(grid), dim3(NTHR), LDS_BYTES, stream, a);
        else hipLaunchKernelGGL(hybrid_fwd<3>, dim3(grid), dim3(NTHR), LDS_BYTES, stream, a);
    }
#endif
}
```

```cpp
#include <hip/hip_runtime.h>
#include <cstdio>
#include <cstdint>
#include <cmath>

namespace pg8 {
#define PG8_LAS __attribute__((address_space(3)))
typedef unsigned short bf16_t;
typedef short bf16x8 __attribute__((ext_vector_type(8)));
typedef float f32x4 __attribute__((ext_vector_type(4)));
typedef unsigned u32x4 __attribute__((ext_vector_type(4)));
constexpr int BM = 256, BK = 64, HALF = 128, HTB = HALF * BK * 2  , STAGE_BYTES = 8 * HTB, NXCD = 8, WGM = 8;

__host__ __device__ __forceinline__ int lds_byte(int r, int c) { const int st = (r >> 4) * 2 + (c >> 5), rr = r & 15, cc = c & 31, ob = rr * 64 + cc * 2; return st * 1024 + (ob ^ (((ob >> 9) & 1) << 5)); }
__host__ __device__ __forceinline__ void stage_rc(int b, int& R, int& C) { const int st = b / 1024, sb = b % 1024, swz = sb ^ (((sb >> 9) & 1) << 5); R = (st >> 1) * 16 + swz / 64; C = (st & 1) * 32 + (swz % 64) / 2; }
__host__ __device__ __forceinline__ int perm32(int rho) { const int n = rho >> 4, i = rho & 15; return 8 * (i >> 2) + 4 * n + (i & 3); }

struct Unit { int pm, pn, z; };
struct Gemm { const bf16_t* A; const bf16_t* Bt; int M, N, K, lda; };

struct StaticOrder {
    int nM, nN, nwg, G, c;
    __host__ __device__ void init(int M, int N, int G_, int c_) { nM = M / BM; nN = N / BM; nwg = nM * nN; G = G_; c = c_; }
    __host__ __device__ bool next(int i, Unit& u) const {
        const long L = (long)i * G + c; if (L >= nwg) return false;
        int wgid = (int)L; { const int q = nwg / NXCD, r = nwg % NXCD, xcd = wgid % NXCD, off = wgid / NXCD; wgid = (xcd < r ? xcd * (q + 1) : r * (q + 1) + (xcd - r) * q) + off; }
        const int nig = WGM * nN, gid = wgid / nig, fm = gid * WGM, gsz = (nM - fm) < WGM ? (nM - fm) : WGM;
        u.pm = fm + ((wgid % nig) % gsz); u.pn = (wgid % nig) / gsz; u.z = 0; return true;
    }
    __device__ __forceinline__ void a_ready(const Unit&) const {}
    __device__ __forceinline__ void done(const Unit&) const {}
    __device__ __forceinline__ size_t a_off(const Unit&) const { return 0; }
    __device__ __forceinline__ int b_tile(const Unit& u) const { return u.pn; }
};
struct GroupedOrder {
    StaticOrder base; int NZ, Kbytes, tiles_per_group;
    __device__ void init(int M, int N, int NZ_, int K, int G_, int c_) { base.init(M, N, G_, c_); NZ = NZ_; Kbytes = K * 2; tiles_per_group = N / BM; }
    __device__ bool next(int i, Unit& u) const { const int r = i / NZ, z = i - r * NZ; if (!base.next(r, u)) return false; u.z = z; return true; }
    __device__ __forceinline__ void a_ready(const Unit&) const {}
    __device__ __forceinline__ void done(const Unit&) const {}
    __device__ __forceinline__ size_t a_off(const Unit& u) const { return (size_t)u.z * Kbytes; }
    __device__ __forceinline__ int b_tile(const Unit& u) const { return u.z * tiles_per_group + u.pn; }
};

__device__ __forceinline__ unsigned cvt_pk_bf16(float lo, float hi) { unsigned r; asm volatile("v_cvt_pk_bf16_f32 %0, %1, %2" : "=v"(r) : "v"(lo), "v"(hi)); return r; }
__device__ __forceinline__ float bf_lo(unsigned w) { return __uint_as_float(w << 16); }
__device__ __forceinline__ float bf_hi(unsigned w) { return __uint_as_float(w & 0xffff0000u); }
__device__ __forceinline__ float fast_sigmoid(float x) { return __builtin_amdgcn_rcpf(1.0f + __builtin_amdgcn_exp2f(-1.4426950408889634f * x)); }

__device__ __forceinline__ float row_rstd(const float* ssq, int row, int M_) {
    const float s = (ssq[row] + ssq[M_ + row]) + (ssq[2 * M_ + row] + ssq[3 * M_ + row]);
    return 1.0f / sqrtf(s * (1.0f / 1024.0f) + 1e-6f);
}
struct EpiScaleBf16 {
    static constexpr bool PERM = true, AFTER_DRAIN = false; static constexpr int SEG_TILES = 0;
    bf16_t* O; int ldc; const float* ssq; int M_;
    __device__ __forceinline__ void operator()(const f32x4 (&acc)[2][2][4][2], const Unit& u, int wr, int wc, int fr, int fq) const {
        const int row0 = u.pm * BM + wr * 64 + fr; const int col0 = u.pn * BM + wc * 32 + 8 * fq;
#pragma unroll
        for (int ai = 0; ai < 2; ++ai)
#pragma unroll
            for (int m = 0; m < 4; ++m) { const int row = row0 + ai * HALF + m * 16; const float rs = row_rstd(ssq, row, M_); bf16_t* rowp = O + (size_t)row * ldc + col0;
#pragma unroll
                for (int bj = 0; bj < 2; ++bj) { const f32x4 v0 = acc[ai][bj][m][0] * rs, v1 = acc[ai][bj][m][1] * rs;
                    u32x4 w; w.x = cvt_pk_bf16(v0[0], v0[1]); w.y = cvt_pk_bf16(v0[2], v0[3]); w.z = cvt_pk_bf16(v1[0], v1[1]); w.w = cvt_pk_bf16(v1[2], v1[3]);
                    *(u32x4*)(rowp + bj * HALF) = w; } }
    }
};
struct EpiSwiglu {
    static constexpr bool PERM = true, AFTER_DRAIN = false; static constexpr int SEG_TILES = 0;
    bf16_t* O; int ldc; const float* ssq; int M_;
    __device__ __forceinline__ void operator()(const f32x4 (&acc)[2][2][4][2], const Unit& u, int wr, int wc, int fr, int fq) const {
        const int row0 = u.pm * BM + wr * 64 + fr; const int col0 = u.pn * HALF + wc * 32 + 8 * fq;
#pragma unroll
        for (int ai = 0; ai < 2; ++ai)
#pragma unroll
            for (int m = 0; m < 4; ++m) { const int row = row0 + ai * HALF + m * 16; const float rs = row_rstd(ssq, row, M_); bf16_t* rowp = O + (size_t)row * ldc + col0;
                float o[8];
#pragma unroll
                for (int n = 0; n < 2; ++n)
#pragma unroll
                    for (int i = 0; i < 4; ++i) { const float g = acc[ai][0][m][n][i] * rs, up = acc[ai][1][m][n][i] * rs; o[n * 4 + i] = g * fast_sigmoid(g) * up; }
                u32x4 w; w.x = cvt_pk_bf16(o[0], o[1]); w.y = cvt_pk_bf16(o[2], o[3]); w.z = cvt_pk_bf16(o[4], o[5]); w.w = cvt_pk_bf16(o[6], o[7]);
                *(u32x4*)rowp = w; }
    }
};
struct EpiGateAcc {
    static constexpr bool PERM = true, AFTER_DRAIN = false; static constexpr int SEG_TILES = 0;
    bf16_t* O; const bf16_t* PG; const float* gb;
    __device__ __forceinline__ void operator()(const f32x4 (&acc)[2][2][4][2], const Unit& u, int wr, int wc, int fr, int fq) const {
        const int row0 = u.pm * BM + wr * 64 + fr; const int col0 = u.pn * BM + wc * 32 + 8 * fq; const int z = u.z;
        f32x4 gbv[2][2];
#pragma unroll
        for (int bj = 0; bj < 2; ++bj)
#pragma unroll
            for (int n = 0; n < 2; ++n) gbv[bj][n] = *(const f32x4*)(gb + z * 1024 + col0 + bj * HALF + 4 * n);
#pragma unroll
        for (int ai = 0; ai < 2; ++ai)
#pragma unroll
            for (int m = 0; m < 4; ++m) { const int row = row0 + ai * HALF + m * 16;
#pragma unroll
                for (int bj = 0; bj < 2; ++bj) {
                    const u32x4 pg = *(const u32x4*)(PG + (size_t)row * 4096 + z * 1024 + col0 + bj * HALF);
                    bf16_t* op = O + (size_t)row * 1024 + col0 + bj * HALF;
                    float o[8];
                    o[0] = fast_sigmoid(bf_lo(pg.x) + gbv[bj][0][0]) * acc[ai][bj][m][0][0]; o[1] = fast_sigmoid(bf_hi(pg.x) + gbv[bj][0][1]) * acc[ai][bj][m][0][1];
                    o[2] = fast_sigmoid(bf_lo(pg.y) + gbv[bj][0][2]) * acc[ai][bj][m][0][2]; o[3] = fast_sigmoid(bf_hi(pg.y) + gbv[bj][0][3]) * acc[ai][bj][m][0][3];
                    o[4] = fast_sigmoid(bf_lo(pg.z) + gbv[bj][1][0]) * acc[ai][bj][m][1][0]; o[5] = fast_sigmoid(bf_hi(pg.z) + gbv[bj][1][1]) * acc[ai][bj][m][1][1];
                    o[6] = fast_sigmoid(bf_lo(pg.w) + gbv[bj][1][2]) * acc[ai][bj][m][1][2]; o[7] = fast_sigmoid(bf_hi(pg.w) + gbv[bj][1][3]) * acc[ai][bj][m][1][3];
                    if (z > 0) { const u32x4 pv = *(const u32x4*)op;
                        o[0] += bf_lo(pv.x); o[1] += bf_hi(pv.x); o[2] += bf_lo(pv.y); o[3] += bf_hi(pv.y); o[4] += bf_lo(pv.z); o[5] += bf_hi(pv.z); o[6] += bf_lo(pv.w); o[7] += bf_hi(pv.w); }
                    u32x4 w; w.x = cvt_pk_bf16(o[0], o[1]); w.y = cvt_pk_bf16(o[2], o[3]); w.z = cvt_pk_bf16(o[4], o[5]); w.w = cvt_pk_bf16(o[6], o[7]);
                    *(u32x4*)op = w; } }
    }
};
struct EpiGateHorner {
    static constexpr bool PERM = true, AFTER_DRAIN = false; static constexpr int SEG_TILES = 8;
    bf16_t* O; const bf16_t* PG; const float* gb;
    __device__ __forceinline__ void em8(const bf16_t* pgp, const float* gbp, float* e) const {
        const u32x4 pg = *(const u32x4*)pgp; const f32x4 b0 = *(const f32x4*)gbp, b1 = *(const f32x4*)(gbp + 4);
        e[0] = __builtin_amdgcn_exp2f(-1.4426950408889634f * (bf_lo(pg.x) + b0[0])); e[1] = __builtin_amdgcn_exp2f(-1.4426950408889634f * (bf_hi(pg.x) + b0[1]));
        e[2] = __builtin_amdgcn_exp2f(-1.4426950408889634f * (bf_lo(pg.y) + b0[2])); e[3] = __builtin_amdgcn_exp2f(-1.4426950408889634f * (bf_hi(pg.y) + b0[3]));
        e[4] = __builtin_amdgcn_exp2f(-1.4426950408889634f * (bf_lo(pg.z) + b1[0])); e[5] = __builtin_amdgcn_exp2f(-1.4426950408889634f * (bf_hi(pg.z) + b1[1]));
        e[6] = __builtin_amdgcn_exp2f(-1.4426950408889634f * (bf_lo(pg.w) + b1[2])); e[7] = __builtin_amdgcn_exp2f(-1.4426950408889634f * (bf_hi(pg.w) + b1[3]));
    }
    __device__ __forceinline__ void seg(f32x4 (&acc)[2][2][4][2], const Unit& u, int z, int wr, int wc, int fr, int fq) const {
        const int row0 = u.pm * BM + wr * 64 + fr; const int col0 = u.pn * BM + wc * 32 + 8 * fq;
#pragma unroll
        for (int ai = 0; ai < 2; ++ai)
#pragma unroll
            for (int m = 0; m < 4; ++m) { const int row = row0 + ai * HALF + m * 16;
#pragma unroll
                for (int bj = 0; bj < 2; ++bj) { const int c = col0 + bj * HALF; float ea[8], eb[8];
                    em8(PG + (size_t)row * 4096 + z * 1024 + c, gb + z * 1024 + c, ea); em8(PG + (size_t)row * 4096 + (z + 1) * 1024 + c, gb + (z + 1) * 1024 + c, eb);
#pragma unroll
                    for (int i = 0; i < 4; ++i) { acc[ai][bj][m][0][i] *= (1.0f + eb[i]) * __builtin_amdgcn_rcpf(1.0f + ea[i]); acc[ai][bj][m][1][i] *= (1.0f + eb[4 + i]) * __builtin_amdgcn_rcpf(1.0f + ea[4 + i]); } }
                if (m & 1) asm volatile("" ::: "memory"); }
    }
    __device__ __forceinline__ void operator()(const f32x4 (&acc)[2][2][4][2], const Unit& u, int wr, int wc, int fr, int fq) const {
        const int row0 = u.pm * BM + wr * 64 + fr; const int col0 = u.pn * BM + wc * 32 + 8 * fq;
#pragma unroll
        for (int ai = 0; ai < 2; ++ai)
#pragma unroll
            for (int m = 0; m < 4; ++m) { const int row = row0 + ai * HALF + m * 16;
#pragma unroll
                for (int bj = 0; bj < 2; ++bj) { const int c = col0 + bj * HALF; float e[8], o[8];
                    em8(PG + (size_t)row * 4096 + 3 * 1024 + c, gb + 3 * 1024 + c, e);
#pragma unroll
                    for (int i = 0; i < 4; ++i) { o[i] = acc[ai][bj][m][0][i] * __builtin_amdgcn_rcpf(1.0f + e[i]); o[4 + i] = acc[ai][bj][m][1][i] * __builtin_amdgcn_rcpf(1.0f + e[4 + i]); }
                    u32x4 w; w.x = cvt_pk_bf16(o[0], o[1]); w.y = cvt_pk_bf16(o[2], o[3]); w.z = cvt_pk_bf16(o[4], o[5]); w.w = cvt_pk_bf16(o[6], o[7]);
                    *(u32x4*)(O + (size_t)row * 1024 + c) = w; } }
    }
};
struct EpiResid {
    static constexpr bool PERM = true, AFTER_DRAIN = true; static constexpr int SEG_TILES = 0;
    bf16_t* HB; float* ssq; int M_; float s;
    __device__ __forceinline__ void fused(f32x4 (&acc)[2][2][4][2], const Unit& u, int wr, int wc, int fr, int fq, PG8_LAS unsigned char* lds, int wid, int lane) const {
        PG8_LAS float* P = (PG8_LAS float*)lds;
        const int row0 = u.pm * BM + wr * 64 + fr; const int col0 = u.pn * BM + wc * 32 + 8 * fq;
#pragma unroll
        for (int ai = 0; ai < 2; ++ai)
#pragma unroll
            for (int m = 0; m < 4; ++m) { const int row = row0 + ai * HALF + m * 16; float q = 0.f;
#pragma unroll
                for (int bj = 0; bj < 2; ++bj) { bf16_t* hp = HB + (size_t)row * 1024 + col0 + bj * HALF; const u32x4 hw = *(const u32x4*)hp;
                    const f32x4 h0 = (f32x4){bf_lo(hw.x), bf_hi(hw.x), bf_lo(hw.y), bf_hi(hw.y)} + acc[ai][bj][m][0] * s, h1 = (f32x4){bf_lo(hw.z), bf_hi(hw.z), bf_lo(hw.w), bf_hi(hw.w)} + acc[ai][bj][m][1] * s;
                    q += (h0[0] * h0[0] + h0[1] * h0[1]) + (h0[2] * h0[2] + h0[3] * h0[3]) + (h1[0] * h1[0] + h1[1] * h1[1]) + (h1[2] * h1[2] + h1[3] * h1[3]);
                    u32x4 w; w.x = cvt_pk_bf16(h0[0], h0[1]); w.y = cvt_pk_bf16(h0[2], h0[3]); w.z = cvt_pk_bf16(h1[0], h1[1]); w.w = cvt_pk_bf16(h1[2], h1[3]);
                    *(u32x4*)hp = w; }
                q += __shfl_xor(q, 16); q += __shfl_xor(q, 32);
                if (fq == 0) P[(ai * HALF + wr * 64 + m * 16 + fr) * 4 + wc] = q; }
        asm volatile("s_waitcnt lgkmcnt(0)" ::: "memory"); __builtin_amdgcn_s_barrier(); asm volatile("" ::: "memory");
        const int t = wid * 64 + lane;
        if (t < 256) { const float q = (P[t * 4 + 0] + P[t * 4 + 1]) + (P[t * 4 + 2] + P[t * 4 + 3]); ssq[(size_t)u.pn * M_ + u.pm * BM + t] = q; }
        asm volatile("s_waitcnt lgkmcnt(0)" ::: "memory"); __builtin_amdgcn_s_barrier(); asm volatile("" ::: "memory");
    }
};
template <class Epi, class Sched, bool ALIGN_EPI = false, bool SP2 = false>
__device__ __forceinline__ void gemm_phase(PG8_LAS unsigned char* lds, const Gemm g, const Sched& S, const Epi& E) {
    int tid_ = threadIdx.x; asm volatile("" : "+v"(tid_)); const int tid = tid_, wid = __builtin_amdgcn_readfirstlane(tid >> 6), lane = tid & 63, wr = wid >> 2, wc = wid & 3, fr = lane & 15, fq = lane >> 4;
    const int K = g.K, nt = K / BK;
    unsigned voffA[2], voffB[2];
#pragma unroll
    for (int i = 0; i < 2; ++i) { int R, C; stage_rc(tid * 16 + i * 8192, R, C); const int Rb = Epi::PERM ? ((R & ~31) + perm32(R & 31)) : R;
        voffA[i] = (unsigned)(R * g.lda + C) * 2u; voffB[i] = (unsigned)(Rb * K + C) * 2u; }
    const size_t kstep = (size_t)(BK * 2);
    const size_t hstep = (size_t)HALF * K * 2;
    const size_t tstep = 2 * hstep; const size_t hstepA = (size_t)HALF * g.lda * 2, tstepA = 2 * hstepA;
    const unsigned ldsw = (unsigned)wid * 1024u;
    const int aoff = lds_byte(wr * 64 + fr, fq * 8), boff = lds_byte(wc * 32 + fr, fq * 8);
#define PG8_SA(b, h) (((b) * 2 + (h)) * HTB)
#define PG8_SB(b, h) ((4 + (b) * 2 + (h)) * HTB)
#define PG8_STAGE(bufoff, gbase, voff) do { _Pragma("unroll") for (int _i = 0; _i < 2; ++_i) \
        __builtin_amdgcn_global_load_lds((const unsigned*)((const char*)(gbase) + (voff)[_i]), (PG8_LAS unsigned*)(lds + (bufoff) + ldsw + _i * 8192), 16, 0, 0); } while (0)
#define PG8_LDA(dst, b, h) do { _Pragma("unroll") for (int m = 0; m < 4; ++m) _Pragma("unroll") for (int k = 0; k < 2; ++k) dst[m][k] = *(const PG8_LAS bf16x8*)(lds + PG8_SA(b, h) + aoff + m * 2048 + k * 1024); } while (0)
#define PG8_LDB(dst, b, h) do { _Pragma("unroll") for (int n = 0; n < 2; ++n) _Pragma("unroll") for (int k = 0; k < 2; ++k) dst[n][k] = *(const PG8_LAS bf16x8*)(lds + PG8_SB(b, h) + boff + n * 2048 + k * 1024); } while (0)
#define PG8_MMA(ai, bj, At, Bt) do { __builtin_amdgcn_s_setprio(1); _Pragma("unroll") for (int m = 0; m < 4; ++m) _Pragma("unroll") for (int n = 0; n < 2; ++n) _Pragma("unroll") for (int k = 0; k < 2; ++k) \
        acc[ai][bj][m][n] = __builtin_amdgcn_mfma_f32_16x16x32_bf16(Bt[n][k], At[m][k], acc[ai][bj][m][n], 0, 0, 0); __builtin_amdgcn_s_setprio(0); } while (0)
#define PG8_WAIT_V(n) asm volatile("s_waitcnt vmcnt(" #n ")" ::: "memory")
#define PG8_WAIT_L(n) asm volatile("s_waitcnt lgkmcnt(" #n ")" ::: "memory")
#define PG8_BAR __builtin_amdgcn_s_barrier()
#define PG8_SCHED __builtin_amdgcn_sched_barrier(0)
    Unit cur, nxt; int ui = 0;
    if (!S.next(0, cur)) return;
    f32x4 acc[2][2][4][2];
#pragma unroll
    for (int a = 0; a < 2; ++a)
#pragma unroll
        for (int b = 0; b < 2; ++b)
#pragma unroll
            for (int m = 0; m < 4; ++m)
#pragma unroll
                for (int n = 0; n < 2; ++n) acc[a][b][m][n] = (f32x4){0.f, 0.f, 0.f, 0.f};
    bf16x8 At[4][2], B0[2][2], B1[2][2];
    const char* cA = (const char*)g.A + (size_t)cur.pm * tstepA + S.a_off(cur); const char* cB = (const char*)g.Bt + (size_t)S.b_tile(cur) * tstep;
    S.a_ready(cur);
    if constexpr (SP2) {
        PG8_STAGE(PG8_SB(0, 0), cB, voffB); PG8_STAGE(PG8_SB(0, 1), cB + hstep, voffB); PG8_STAGE(PG8_SA(0, 0), cA, voffA); PG8_STAGE(PG8_SA(0, 1), cA + hstepA, voffA);
        if (wr == 1) PG8_BAR;
        PG8_WAIT_V(2); PG8_BAR;
        PG8_STAGE(PG8_SB(1, 0), cB + kstep, voffB); PG8_STAGE(PG8_SA(1, 0), cA + kstep, voffA); PG8_STAGE(PG8_SB(1, 1), cB + hstep + kstep, voffB);
        PG8_WAIT_V(6); PG8_BAR;
    } else {
        PG8_STAGE(PG8_SB(0, 0), cB, voffB); PG8_STAGE(PG8_SA(0, 0), cA, voffA); PG8_STAGE(PG8_SB(0, 1), cB + hstep, voffB); PG8_STAGE(PG8_SA(0, 1), cA + hstepA, voffA);
        if (wr == 1) PG8_BAR;
        PG8_WAIT_V(4); PG8_BAR;
        PG8_STAGE(PG8_SB(1, 0), cB + kstep, voffB); PG8_STAGE(PG8_SA(1, 0), cA + kstep, voffA); PG8_STAGE(PG8_SB(1, 1), cB + hstep + kstep, voffB);
        PG8_WAIT_V(6); PG8_BAR;
    }
    for (;;) {
        const bool has_next = S.next(ui + 1, nxt);
        const char* nA = has_next ? (const char*)g.A + (size_t)nxt.pm * tstepA + S.a_off(nxt) : cA; const char* nB = has_next ? (const char*)g.Bt + (size_t)S.b_tile(nxt) * tstep : cB;
        for (int t = 0; t < nt; t += 2) {
            const bool last = (t == nt - 2);
            const char* a1 = cA + (size_t)(t + 1) * kstep;
            const char* a2 = last ? nA : cA + (size_t)(t + 2) * kstep; const char* b2 = last ? nB : cB + (size_t)(t + 2) * kstep;
            const char* a3 = a2 + kstep; const char* b3 = b2 + kstep;
            if (last && has_next) S.a_ready(nxt);
            if constexpr (SP2) {
            PG8_LDB(B0, 0, 0); PG8_LDB(B1, 0, 1); PG8_SCHED; PG8_LDA(At, 0, 0); PG8_STAGE(PG8_SA(1, 1), a1 + hstepA, voffA);
            PG8_WAIT_V(8); PG8_WAIT_L(0); PG8_BAR; PG8_MMA(0, 0, At, B0); PG8_MMA(0, 1, At, B1); PG8_BAR; PG8_SCHED;
            PG8_LDA(At, 0, 1); PG8_STAGE(PG8_SB(0, 0), b2, voffB); PG8_STAGE(PG8_SB(0, 1), b2 + hstep, voffB); PG8_STAGE(PG8_SA(0, 0), a2, voffA);
            PG8_WAIT_V(8); PG8_WAIT_L(0); PG8_BAR; PG8_MMA(1, 0, At, B0); PG8_MMA(1, 1, At, B1); PG8_BAR; PG8_SCHED;
            PG8_LDB(B0, 1, 0); PG8_LDB(B1, 1, 1); PG8_SCHED; PG8_LDA(At, 1, 0); PG8_STAGE(PG8_SA(0, 1), a2 + hstepA, voffA);
            PG8_WAIT_V(8); PG8_WAIT_L(0); PG8_BAR; PG8_MMA(0, 0, At, B0); PG8_MMA(0, 1, At, B1); PG8_BAR; PG8_SCHED;
            PG8_LDA(At, 1, 1); PG8_STAGE(PG8_SB(1, 0), b3, voffB); PG8_STAGE(PG8_SB(1, 1), b3 + hstep, voffB); PG8_STAGE(PG8_SA(1, 0), a3, voffA);
            PG8_WAIT_V(8); PG8_WAIT_L(0); PG8_BAR; PG8_MMA(1, 0, At, B0); PG8_MMA(1, 1, At, B1); PG8_BAR; PG8_SCHED;
            } else {
            PG8_LDB(B0, 0, 0); PG8_SCHED; PG8_LDA(At, 0, 0); PG8_STAGE(PG8_SA(1, 1), a1 + hstepA, voffA);
            PG8_WAIT_L(8); PG8_BAR; PG8_WAIT_L(0); PG8_MMA(0, 0, At, B0); PG8_BAR; PG8_SCHED;
            PG8_LDB(B1, 0, 1); PG8_STAGE(PG8_SB(0, 0), b2, voffB);
            PG8_BAR; PG8_WAIT_L(0); PG8_MMA(0, 1, At, B1); PG8_BAR;
            PG8_LDA(At, 0, 1); PG8_STAGE(PG8_SA(0, 0), a2, voffA);
            PG8_BAR; PG8_WAIT_L(0); PG8_MMA(1, 0, At, B0); PG8_BAR; PG8_SCHED;
            PG8_STAGE(PG8_SB(0, 1), b2 + hstep, voffB);
            PG8_WAIT_V(6); PG8_BAR; PG8_MMA(1, 1, At, B1); PG8_BAR;
            PG8_LDB(B0, 1, 0); PG8_SCHED; PG8_LDA(At, 1, 0); PG8_STAGE(PG8_SA(0, 1), a2 + hstepA, voffA);
            PG8_WAIT_L(8); PG8_BAR; PG8_WAIT_L(0); PG8_MMA(0, 0, At, B0); PG8_BAR; PG8_SCHED;
            PG8_LDB(B1, 1, 1); PG8_STAGE(PG8_SB(1, 0), b3, voffB);
            PG8_BAR; PG8_WAIT_L(0); PG8_MMA(0, 1, At, B1); PG8_BAR;
            PG8_LDA(At, 1, 1); PG8_STAGE(PG8_SA(1, 0), a3, voffA);
            PG8_BAR; PG8_WAIT_L(0); PG8_MMA(1, 0, At, B0); PG8_BAR; PG8_SCHED;
            PG8_STAGE(PG8_SB(1, 1), b3 + hstep, voffB);
            PG8_WAIT_V(6); PG8_BAR; PG8_MMA(1, 1, At, B1); PG8_BAR;
            }
            if constexpr (Epi::SEG_TILES > 0) { if (((t + 2) % Epi::SEG_TILES) == 0 && (t + 2) < nt) { E.seg(acc, cur, (t + 2) / Epi::SEG_TILES - 1, wr, wc, fr, fq); PG8_WAIT_V(0); PG8_SCHED; } }
        }
        if constexpr (ALIGN_EPI) { if (wr == 0) PG8_BAR; }
        if constexpr (!Epi::AFTER_DRAIN) { E(acc, cur, wr, wc, fr, fq); S.done(cur); }
        if (!has_next) break;
#pragma unroll
        for (int a = 0; a < 2; ++a)
#pragma unroll
            for (int b = 0; b < 2; ++b)
#pragma unroll
                for (int m = 0; m < 4; ++m)
#pragma unroll
                    for (int n = 0; n < 2; ++n) acc[a][b][m][n] = (f32x4){0.f, 0.f, 0.f, 0.f};
        cur = nxt; cA = nA; cB = nB; ++ui;
        if constexpr (ALIGN_EPI) { if (wr == 1) PG8_BAR; }
    }
    PG8_WAIT_V(0);
    if constexpr (!ALIGN_EPI) { if (wr == 0) PG8_BAR; }
    PG8_BAR;
    if constexpr (Epi::AFTER_DRAIN) { E.fused(acc, cur, wr, wc, fr, fq, lds, wid, lane); S.done(cur); }
#undef PG8_SA
#undef PG8_SB
#undef PG8_STAGE
#undef PG8_LDA
#undef PG8_LDB
#undef PG8_MMA
#undef PG8_WAIT_V
#undef PG8_WAIT_L
#undef PG8_BAR
#undef PG8_SCHED
}
}

constexpr int NWAVES = 8, NTHR = 512;
constexpr int M = 16384, SEQ = 8192, D = 1024, FF = 2816, NL = 4, NCH = 128  , NBC = 256  ;
constexpr int NPM = 6656;
constexpr int NWIN = 10752;
constexpr int C_DAQ = 0, C_DAK = 512, C_DAV = 1024, C_GQ = 1536, C_GK = 1792, C_GV = 2048, C_GOG = 2560, C_SZ = 3072, C_SX = 3584, C_SB = 4096, C_SC = 4352,
              C_RR = 4608, C_RK = 5120, C_RV = 5632, C_RWL = 6144, C_RAL = 6208, C_RGL = 6272, C_GLR = 6400, C_SDT = 6416;
constexpr float EPS = 1e-6f, LOG2E = 1.4426950408889634f;

constexpr size_t MiB = 1u << 20;
constexpr size_t WS_CTL = 0, CTL_ZERO_BYTES = 1 * MiB;
constexpr size_t WS_COS = 1 * MiB, WS_SIN = 2 * MiB, WS_SSQ = 3 * MiB, WS_GLAST = 3 * MiB + 512 * 1024, WS_SDT = 4 * MiB, WS_SACUM = 4 * MiB + 512 * 1024, WS_SCDEC = 5 * MiB, WS_RW2T = 5 * MiB + 64 * 1024;
constexpr size_t WS_WGU1 = 8 * MiB, WS_WD1 = 19 * MiB, WS_WIN = 24 * MiB + 512 * 1024, WS_WB = 45 * MiB + 512 * 1024, WS_WO = 49 * MiB + 512 * 1024, WS_WGU2 = 51 * MiB + 512 * 1024, WS_WD2 = 62 * MiB + 512 * 1024;
constexpr size_t WS_HB = 68 * MiB, WS_P = 100 * MiB, WS_PG = 100 * MiB, WS_YS = 308 * MiB, WS_R1 = 372 * MiB, WS_R2 = 500 * MiB, WS_END = 644 * MiB;
constexpr size_t WS_ACT = WS_R1, WS_MERGED = WS_R1;
constexpr size_t WS_RWW = WS_R1, WS_RWR = WS_R1 + 32 * MiB, WS_RWK = WS_R1 + 48 * MiB, WS_RWV = WS_R1 + 64 * MiB, WS_RWKK = WS_R1 + 80 * MiB, WS_RWB = WS_R1 + 96 * MiB, WS_RWG = WS_R1 + 112 * MiB;
constexpr size_t WS_VT = WS_R2, WS_GKV = WS_R2 + 16 * MiB, WS_SST = WS_R2 + 48 * MiB, WS_RWY = WS_R2 + 112 * MiB;
static_assert(WS_WD2 + (size_t)D * FF * 2 <= WS_HB && WS_P + (size_t)M * NPM * 2 <= WS_YS && WS_RWY + (size_t)M * 512 * 2 <= WS_END, "d_ws map");
constexpr int CW_BAR = 4096;

constexpr int RING_BYTES = 131072, LDSCTL_OFF = RING_BYTES, MISC_OFF = LDSCTL_OFF + 320, LDS_BYTES = 147456;

#define GAS __attribute__((address_space(1)))
#define LAS __attribute__((address_space(3)))
typedef unsigned short bf16;
typedef unsigned v4u __attribute__((ext_vector_type(4)));
typedef float f32x4 __attribute__((ext_vector_type(4)));
typedef short bf16x8 __attribute__((ext_vector_type(8)));
typedef GAS unsigned gu32;
typedef GAS unsigned long long gu64;
#define RLX_AGENT __ATOMIC_RELAXED, __HIP_MEMORY_SCOPE_AGENT
#define LDS_WAIT() asm volatile("s_waitcnt lgkmcnt(0)" ::: "memory")
#define VM_WAIT() asm volatile("s_waitcnt vmcnt(0)" ::: "memory")
__device__ __forceinline__ unsigned long long rt() { return __builtin_amdgcn_s_memrealtime(); }
typedef float f32x2_cv __attribute__((ext_vector_type(2))); typedef __bf16 bf16x2_cv __attribute__((ext_vector_type(2)));
__device__ __forceinline__ unsigned pk2(float lo, float hi) { const f32x2_cv v = {lo, hi}; const bf16x2_cv b = __builtin_convertvector(v, bf16x2_cv); return __builtin_bit_cast(unsigned, b); }
__device__ __forceinline__ unsigned f2bf(float f) { return pk2(f, 0.f) & 0xffffu; }

#define XB_TMO      128
#define XB_XCNT(j)  (256  + 64 * (j))
#define XB_XSUB(j)  (1280 + 64 * (j))
#define XB_XGEN(j)  (2304 + 64 * (j))
#define XB_TOP      3328
#define XB_TOPGEN   3392
#define XCD_BAR_WORDS 3456
#define XB_SPIN_CAP (1u << 18)

__device__ __forceinline__ unsigned xb_ld(unsigned* p)              { return __hip_atomic_load(p, __ATOMIC_RELAXED, __HIP_MEMORY_SCOPE_AGENT); }
__device__ __forceinline__ unsigned xb_add(unsigned* p, unsigned v) { return __hip_atomic_fetch_add(p, v, __ATOMIC_RELAXED, __HIP_MEMORY_SCOPE_AGENT); }
__device__ __forceinline__ unsigned xb_xcc_id() { return (unsigned)__builtin_amdgcn_s_getreg((3 << 11) | 20) & 0xFu; }
#define XB_SPIN(cond, bar) do { unsigned _sp = 0; while (cond) { __builtin_amdgcn_s_sleep(1); \
    if ((++_sp & 255u) == 0u) { if (xb_ld(&(bar)[XB_TMO])) break; if (_sp > XB_SPIN_CAP) { atomicAdd(&(bar)[XB_TMO], 1u); break; } } } } while (0)

struct XcdBarrier {
    unsigned* bar; unsigned x;
    volatile LAS unsigned* st;
};

__device__ __forceinline__ XcdBarrier xcd_barrier_post(unsigned* bar, volatile LAS unsigned* st) {
    XcdBarrier b; b.bar = bar; b.x = xb_xcc_id(); b.st = st;
    if (threadIdx.x == 0) (void)xb_add(&bar[XB_XCNT(b.x)], 1u);
    return b;
}
__device__ __forceinline__ void xcd_barrier_complete(unsigned* bar, unsigned x, unsigned& nloc, unsigned& nx) {
    const unsigned G = gridDim.x * gridDim.y * gridDim.z;
    unsigned sum, cnt, mine, sp = 0u;
    for (;;) {
        sum = 0u; cnt = 0u; mine = 0u;
#pragma unroll
        for (unsigned j = 0; j < 16; ++j) { const unsigned c = xb_ld(&bar[XB_XCNT(j)]); sum += c; cnt += (c > 0u) ? 1u : 0u; mine = (j == x) ? c : mine; }
        if (sum == G) break;
        __builtin_amdgcn_s_sleep(1);
        if ((++sp & 255u) == 0u) { if (xb_ld(&bar[XB_TMO])) break; if (sp > XB_SPIN_CAP) { atomicAdd(&bar[XB_TMO], 1u); break; } }
    }
    nloc = mine > 0u ? mine : 1u; nx = cnt > 0u ? cnt : 1u;
}

__device__ __forceinline__ void xcd_barrier(const XcdBarrier& b) {
    asm volatile("s_waitcnt vmcnt(0)" ::: "memory");
    __syncthreads();
    if (threadIdx.x == 0) {
        unsigned* bar = b.bar;
        __builtin_amdgcn_s_waitcnt(0);
        unsigned nloc = b.st[0], nx = b.st[1];
        if (nloc == 0u) { xcd_barrier_complete(bar, b.x, nloc, nx); b.st[0] = nloc; b.st[1] = nx; }
        const unsigned old = xb_add(&bar[XB_XSUB(b.x)], 1u);
        const unsigned gen = old / nloc;
        if (old + 1u == (gen + 1u) * nloc) {
            __builtin_amdgcn_fence(__ATOMIC_RELEASE, "agent");
            asm volatile("s_waitcnt vmcnt(0)" ::: "memory");
            const unsigned og = xb_add(&bar[XB_TOP], 1u);
            const unsigned tg = og / nx;
            if (og + 1u == (tg + 1u) * nx) xb_add(&bar[XB_TOPGEN], 1u);
            else XB_SPIN(xb_ld(&bar[XB_TOPGEN]) == tg, bar);
            __builtin_amdgcn_fence(__ATOMIC_ACQUIRE, "agent");
            xb_add(&bar[XB_XGEN(b.x)], 1u);
            asm volatile("s_waitcnt vmcnt(0)" ::: "memory");
        } else {
            XB_SPIN(xb_ld(&bar[XB_XGEN(b.x)]) == gen, bar);
            __builtin_amdgcn_fence(__ATOMIC_ACQUIRE, "agent");
            asm volatile("s_waitcnt vmcnt(0)" ::: "memory");
        }
    }
    __syncthreads();
}

struct Args { const float* in[40]; float* out; unsigned char* ws; float inv_freq[32]; int g_lo, g_hi; };
struct ArgsD { const GAS float* in[40]; GAS float* out; GAS unsigned char* ws; float inv_freq[32]; int g_lo, g_hi; };
typedef const __attribute__((address_space(4))) ArgsD* ArgsP;
typedef LAS float* LF; typedef const LAS float* CLF;
#ifndef PH_FN
#define PH_FN __device__ __noinline__
#endif
#ifndef PH_HEAVY
#define PH_HEAVY __device__ __forceinline__
#endif
struct Ctx {
    LAS unsigned char* lds;
    GAS unsigned char* ws; GAS float* h;
    int tid, lane, wave, bid, G;
};
typedef unsigned u32x4 __attribute__((ext_vector_type(4)));
typedef unsigned u32x2 __attribute__((ext_vector_type(2)));
typedef float f32x2 __attribute__((ext_vector_type(2)));
typedef float f32x16 __attribute__((ext_vector_type(16)));
__device__ __forceinline__ float bf2f(bf16 x) { return __uint_as_float((unsigned)x << 16); }
__device__ __forceinline__ float bflo(unsigned w) { return __uint_as_float(w << 16); }
__device__ __forceinline__ float bfhi(unsigned w) { return __uint_as_float(w & 0xffff0000u); }
__device__ __forceinline__ void unpack8(const u32x4 w, float* o) { o[0] = bflo(w.x); o[1] = bfhi(w.x); o[2] = bflo(w.y); o[3] = bfhi(w.y); o[4] = bflo(w.z); o[5] = bfhi(w.z); o[6] = bflo(w.w); o[7] = bfhi(w.w); }
__device__ __forceinline__ u32x4 pack8(const float* o) { u32x4 w; w.x = pk2(o[0], o[1]); w.y = pk2(o[2], o[3]); w.z = pk2(o[4], o[5]); w.w = pk2(o[6], o[7]); return w; }
__device__ __forceinline__ float sigmoidf_(float x) { return 1.0f / (1.0f + __expf(-x)); }
__device__ __forceinline__ float siluf_(float x) { return x * sigmoidf_(x); }
__device__ __forceinline__ float softplusf_(float x) { return fmaxf(x, 0.f) + log1pf(__expf(-fabsf(x))); }
__device__ __forceinline__ float logsigmoidf_(float x) { return fminf(x, 0.f) - log1pf(__expf(-fabsf(x))); }
__device__ __forceinline__ float wave_sum(float v) {
#pragma unroll
    for (int o = 1; o < 64; o <<= 1) v += __shfl_xor(v, o);
    return v;
}
#define WG_SYNC() __syncthreads()
__device__ __forceinline__ Ctx fresh(const Ctx& C0) { Ctx C = C0; int t = threadIdx.x; asm volatile("" : "+v"(t)); C.tid = t; C.lane = t & 63; C.wave = __builtin_amdgcn_readfirstlane(t >> 6); return C; }

PH_FN void ph_prologue(const Ctx C, ArgsP a) {
    GAS float* cosT = (GAS float*)(C.ws + WS_COS); GAS float* sinT = (GAS float*)(C.ws + WS_SIN);
    for (int idx = C.bid * NTHR + C.tid; idx < SEQ * 32; idx += C.G * NTHR) {
        const int t = idx >> 5, j = idx & 31;
        const float ang = (float)t * a->inv_freq[j];
        const double rev = (double)ang * 0.15915494309189535;
        const float fr = (float)(rev - floor(rev));
        cosT[idx] = __builtin_amdgcn_cosf(fr); sinT[idx] = __builtin_amdgcn_sinf(fr);
    }
    const GAS float* x = a->in[0]; GAS bf16* hb = (GAS bf16*)(C.ws + WS_HB); GAS float* ssq = (GAS float*)(C.ws + WS_SSQ);
    const int gw = C.bid * NWAVES + C.wave, NGW = C.G * NWAVES;
    for (int m = gw; m < M; m += NGW) {
        const GAS f32x4* xr = (const GAS f32x4*)(x + (size_t)m * D) + C.lane;
        GAS unsigned long long* o8 = (GAS unsigned long long*)(hb + (size_t)m * D) + C.lane;
        float s = 0.f;
#pragma unroll
        for (int j = 0; j < 4; ++j) { const f32x4 v = xr[64 * j]; s += (v.x * v.x + v.y * v.y) + (v.z * v.z + v.w * v.w);
            o8[64 * j] = (unsigned long long)pk2(v.x, v.y) | ((unsigned long long)pk2(v.z, v.w) << 32); }
        s = wave_sum(s);
        if (C.lane == 0) { ssq[m] = s; ssq[M + m] = 0.f; ssq[2 * M + m] = 0.f; ssq[3 * M + m] = 0.f; }
    }
}

template <class SrcF>
__device__ __forceinline__ void tr_item(const SrcF src, const GAS float* gk, GAS bf16* WT, int K, int kb, int nb, LAS bf16* scr, int lane) {
    const int k0 = 64 * kb, n0 = 64 * nb, kr = lane >> 4, n4 = 4 * (lane & 15);
    const int ld = src.ld(); const long co = src.col(n0 + n4); const bool ok = co >= 0; const GAS float* colp = src.base(n0 + n4) + (ok ? co : 0);
    f32x4 v[16];
#pragma unroll
    for (int i = 0; i < 16; ++i) v[i] = ok ? *(const GAS f32x4*)(colp + (size_t)(k0 + 4 * i + kr) * ld) : (f32x4){0.f, 0.f, 0.f, 0.f};
#pragma unroll
    for (int i = 0; i < 16; ++i) { const int kk = 4 * i + kr; const float g = gk ? gk[k0 + kk] : 1.0f;
#pragma unroll
        for (int e = 0; e < 4; ++e) scr[(n4 + e) * 72 + kk] = (bf16)f2bf(v[i][e] * g); }
    LDS_WAIT(); asm volatile("" ::: "memory");
    const int c = lane & 7;
#pragma unroll
    for (int j = 0; j < 8; ++j) { const int n = (lane >> 3) + 8 * j; *(GAS v4u*)(WT + (size_t)(n0 + n) * K + k0 + 8 * c) = *(const LAS v4u*)(scr + n * 72 + 8 * c); }
    LDS_WAIT(); asm volatile("" ::: "memory");
}
struct SrcGU { const GAS float* wg; const GAS float* wu;
    __device__ __forceinline__ int ld() const { return FF; }
    __device__ __forceinline__ const GAS float* base(int n) const { const uintptr_t sel = (uintptr_t)((n >> 7) & 1); return (const GAS float*)((uintptr_t)wg + sel * ((uintptr_t)wu - (uintptr_t)wg)); }
    __device__ __forceinline__ long col(int n) const { return 128 * (n >> 8) + (n & 127); } };
struct SrcPlain { const GAS float* w; int ldw;
    __device__ __forceinline__ int ld() const { return ldw; }
    __device__ __forceinline__ const GAS float* base(int) const { return w; }
    __device__ __forceinline__ long col(int n) const { return n; } };
struct SrcWin { const GAS float* w;
    __device__ __forceinline__ int ld() const { return 10520; }
    __device__ __forceinline__ const GAS float* base(int) const { return w; }
    __device__ __forceinline__ long col(int n) const {
        int c;
        if (n < 3072) c = n; else if (n < 4608) c = n - 3072 + 3088; else if (n < 6400) c = n - 4608 + 4632; else if (n < 6416) c = n - 6400 + 3072; else if (n < 6424) c = n - 6416 + 4624; else if (n < 6656) c = -1; else c = n - 6656 + 6424;
        return c; } };
PH_FN void ph_weights(const Ctx C, ArgsP a, int l) {
    LAS bf16* scr = (LAS bf16*)(C.lds + C.wave * 16384);
    const int gw = C.bid * NWAVES + C.wave, NGW = C.G * NWAVES; int rot = 0;
#define W_FIRST(cnt) ({ const int f_ = (gw + NGW - rot % NGW) % NGW; rot += (cnt); f_; })
#pragma unroll 1
    for (int f = 0; f < 2; ++f) {
        const GAS float* nrm = a->in[f ? 35 : 1] + (size_t)l * D; const GAS float* wg = a->in[f ? 36 : 2] + (size_t)l * D * FF; const GAS float* wu = a->in[f ? 37 : 3] + (size_t)l * D * FF; const GAS float* wd = a->in[f ? 38 : 4] + (size_t)l * FF * D;
        GAS bf16* Wgu = (GAS bf16*)(C.ws + (f ? WS_WGU2 : WS_WGU1)); GAS bf16* Wd = (GAS bf16*)(C.ws + (f ? WS_WD2 : WS_WD1));
        const SrcGU sgu{wg, wu};
        for (int it = W_FIRST((D / 64) * (2 * FF / 64)); it < (D / 64) * (2 * FF / 64); it += NGW) tr_item(sgu, nrm, Wgu, D, it / (2 * FF / 64), it % (2 * FF / 64), scr, C.lane);
        const SrcPlain sd{wd, D};
        for (int it = W_FIRST((FF / 64) * (D / 64)); it < (FF / 64) * (D / 64); it += NGW) tr_item(sd, nullptr, Wd, FF, it / (D / 64), it % (D / 64), scr, C.lane);
    }
    { const SrcWin sw{a->in[6] + (size_t)l * D * 10520}; const GAS float* nrm = a->in[5] + (size_t)l * D; GAS bf16* Win = (GAS bf16*)(C.ws + WS_WIN);
      for (int it = W_FIRST((D / 64) * (NWIN / 64)); it < (D / 64) * (NWIN / 64); it += NGW) tr_item(sw, nrm, Win, D, it / (NWIN / 64), it % (NWIN / 64), scr, C.lane); }
    { GAS bf16* Wb = (GAS bf16*)(C.ws + WS_WB);
      for (int it = W_FIRST(4 * (512 / 64) * (D / 64)); it < 4 * (512 / 64) * (D / 64); it += NGW) { const int z = it / ((512 / 64) * (D / 64)), r = it % ((512 / 64) * (D / 64));
          const SrcPlain sb{a->in[32] + ((size_t)l * 4 + z) * 512 * D - (size_t)z * 512 * D, D}; tr_item(sb, nullptr, Wb, 2048, z * 8 + r / (D / 64), r % (D / 64), scr, C.lane); } }
    { GAS bf16* W2T = (GAS bf16*)(C.ws + WS_RW2T); GAS bf16* A2T = W2T + 512 * 64; GAS bf16* G2T = A2T + 512 * 64;
      const SrcPlain s1{a->in[23] + (size_t)l * 64 * 512, 512}, s2{a->in[25] + (size_t)l * 64 * 512, 512}, s3{a->in[26] + (size_t)l * 128 * 512, 512};
      for (int it = W_FIRST(8); it < 8; it += NGW) tr_item(s1, nullptr, W2T, 64, 0, it, scr, C.lane);
      for (int it = W_FIRST(8); it < 8; it += NGW) tr_item(s2, nullptr, A2T, 64, 0, it, scr, C.lane);
      for (int it = W_FIRST(16); it < 16; it += NGW) tr_item(s3, nullptr, G2T, 128, it >> 3, it & 7, scr, C.lane); }
    { const SrcPlain so{a->in[34] + (size_t)l * D * D, D}; GAS bf16* Wo = (GAS bf16*)(C.ws + WS_WO);
      for (int it = W_FIRST((D / 64) * (D / 64)); it < (D / 64) * (D / 64); it += NGW) tr_item(so, nullptr, Wo, D, it / (D / 64), it % (D / 64), scr, C.lane); }
}

#undef W_FIRST
PH_FN void ph_da_prep(const Ctx C) {
    GAS bf16* P = (GAS bf16*)(C.ws + WS_P); const GAS float* cosT = (const GAS float*)(C.ws + WS_COS); const GAS float* sinT = (const GAS float*)(C.ws + WS_SIN);
    const int gw = C.bid * NWAVES + C.wave, NGW = C.G * NWAVES;
    const int hc = C.lane >> 2, ch = C.lane & 3;
    const float sc = (hc < 8) ? 0.125f * LOG2E : 1.0f;
    for (int m = gw; m < M; m += NGW) {
        const int t = m & (SEQ - 1);
        GAS bf16* p1 = P + (size_t)m * NPM + hc * 64 + ch * 8; GAS bf16* p2 = p1 + 32;
        float x1[8], x2[8], o1[8], o2[8];
        unpack8(*(const GAS u32x4*)p1, x1); unpack8(*(const GAS u32x4*)p2, x2);
        const GAS float* cp = cosT + t * 32 + ch * 8; const GAS float* sp = sinT + t * 32 + ch * 8;
#pragma unroll
        for (int i = 0; i < 8; ++i) { const float c = cp[i], s = sp[i]; o1[i] = (x1[i] * c - x2[i] * s) * sc; o2[i] = (x2[i] * c + x1[i] * s) * sc; }
        *(GAS u32x4*)p1 = pack8(o1); *(GAS u32x4*)p2 = pack8(o2);
    }
    GAS bf16* VT = (GAS bf16*)(C.ws + WS_VT); LAS bf16* tile = (LAS bf16*)C.lds;
    for (int it = C.bid; it < 2 * NCH * 4; it += C.G) {
        const int h = it & 3, bc = it >> 2, b = bc >> 7, tb = bc & 127; const size_t row0 = (size_t)bc * 64;
        WG_SYNC();
#pragma unroll
        for (int i = 0; i < 2; ++i) { const int q = C.tid + NTHR * i, t = q >> 4, c16 = q & 15;
            *(LAS u32x4*)(tile + t * 136 + c16 * 8) = *(const GAS u32x4*)(P + (row0 + t) * NPM + C_DAV + h * 128 + c16 * 8); }
        WG_SYNC();
#pragma unroll
        for (int i = 0; i < 2; ++i) { const int q = C.tid + NTHR * i, d = q >> 3, tc = q & 7; unsigned w[4];
#pragma unroll
            for (int e = 0; e < 4; ++e) w[e] = (unsigned)tile[(8 * tc + 2 * e) * 136 + d] | ((unsigned)tile[(8 * tc + 2 * e + 1) * 136 + d] << 16);
            u32x4 o; o.x = w[0]; o.y = w[1]; o.z = w[2]; o.w = w[3];
            *(GAS u32x4*)(VT + ((size_t)(b * 4 + h) * 128 + d) * SEQ + tb * 64 + 8 * tc) = o; }
    }
    WG_SYNC();
}

typedef LAS bf16* LB; typedef const LAS bf16* CLB;
__device__ __forceinline__ pg8::bf16x8 frag32(CLB X, int ld, int row0, int k0, int lane) { return *(const LAS pg8::bf16x8*)(X + (row0 + (lane & 31)) * ld + k0 + 8 * (lane >> 5)); }
template <int K> __device__ __forceinline__ void mma_nt(f32x16& acc, CLB A, int lda, int m0, CLB Bt, int ldb, int n0, int lane) {
#pragma unroll
    for (int k = 0; k < K; k += 16) acc = __builtin_amdgcn_mfma_f32_32x32x16_bf16(frag32(A, lda, m0, k, lane), frag32(Bt, ldb, n0, k, lane), acc, 0, 0, 0);
}
__device__ __forceinline__ int crow(int r, int hi) { return (r & 3) + 8 * (r >> 2) + 4 * hi; }
__device__ __forceinline__ f32x16 zero16() { f32x16 z;
#pragma unroll
    for (int r = 0; r < 16; ++r) z[r] = 0.f;
    return z; }

__device__ __forceinline__ void gla_compute_G(const Ctx& C, ArgsP a, int l, int bc, int h, LF Gs) {
    const GAS bf16* P = (const GAS bf16*)(C.ws + WS_P); const GAS float* W2 = a->in[12] + (size_t)l * 16 * 256; const GAS float* gb = a->in[13] + (size_t)l * 256;
    const int t = C.tid >> 3, kg = C.tid & 7; const size_t row = (size_t)bc * 64 + t;
    float glr[16]; unpack8(*(const GAS u32x4*)(P + row * NPM + C_GLR), glr); unpack8(*(const GAS u32x4*)(P + row * NPM + C_GLR + 8), glr + 8);
#pragma unroll
    for (int i = 0; i < 8; ++i) { const int k = h * 64 + kg * 8 + i; float x = gb[k];
#pragma unroll
        for (int r = 0; r < 16; ++r) x += glr[r] * W2[r * 256 + k];
        Gs[t * 68 + kg * 8 + i] = logsigmoidf_(x) * (1.0f / 16.0f); }
    WG_SYNC();
    { const int seg = C.tid >> 6, k = C.tid & 63; float run = 0.f;
#pragma unroll
      for (int i = 0; i < 8; ++i) { run += Gs[(8 * seg + i) * 68 + k]; Gs[(8 * seg + i) * 68 + k] = run; }
      WG_SYNC();
      float off = 0.f;
#pragma unroll
      for (int sg = 0; sg < 7; ++sg) { const float tot = Gs[(8 * sg + 7) * 68 + k]; off += (sg < seg) ? tot : 0.f; }
      WG_SYNC();
#pragma unroll
      for (int i = 0; i < 8; ++i) Gs[(8 * seg + i) * 68 + k] += off; }
    WG_SYNC();
}
PH_HEAVY void ph_gla_a(const Ctx C, ArgsP a, int l) {
    const GAS bf16* P = (const GAS bf16*)(C.ws + WS_P); GAS bf16* GKV = (GAS bf16*)(C.ws + WS_GKV); GAS float* GL = (GAS float*)(C.ws + WS_GLAST);
    LF Gs = (LF)C.lds; LB KDT = (LB)(C.lds + 17408); LB VT = (LB)(C.lds + 26624);
    for (int it = C.bid; it < NBC * 4; it += C.G) {
        const int bc = it >> 2, h = it & 3;
        WG_SYNC();
        gla_compute_G(C, a, l, bc, h, Gs);
        { const int t = C.tid >> 3, g8 = C.tid & 7; const size_t row = (size_t)bc * 64 + t;
          float kf[8]; unpack8(*(const GAS u32x4*)(P + row * NPM + C_GK + h * 64 + g8 * 8), kf);
#pragma unroll
          for (int i = 0; i < 8; ++i) { const int k = g8 * 8 + i; KDT[k * 72 + t] = (bf16)f2bf(kf[i] * __expf(Gs[63 * 68 + k] - Gs[t * 68 + k])); }
          const u32x4 v0 = *(const GAS u32x4*)(P + row * NPM + C_GV + h * 128 + g8 * 16), v1 = *(const GAS u32x4*)(P + row * NPM + C_GV + h * 128 + g8 * 16 + 8);
          const unsigned vw[8] = {v0.x, v0.y, v0.z, v0.w, v1.x, v1.y, v1.z, v1.w};
#pragma unroll
          for (int i = 0; i < 8; ++i) { VT[(g8 * 16 + 2 * i) * 72 + t] = (bf16)(vw[i] & 0xffffu); VT[(g8 * 16 + 2 * i + 1) * 72 + t] = (bf16)(vw[i] >> 16); }
          if (C.tid < 64) GL[(size_t)it * 64 + C.tid] = Gs[63 * 68 + C.tid]; }
        WG_SYNC();
        { const int kt = C.wave >> 2, vt = C.wave & 3, n = C.lane & 31, hi = C.lane >> 5;
          f32x16 acc = zero16(); mma_nt<64>(acc, KDT, 72, 32 * kt, VT, 72, 32 * vt, C.lane);
          GAS bf16* dst = GKV + ((size_t)it * 128 + 32 * vt + n) * 64 + 32 * kt + 4 * hi;
#pragma unroll
          for (int g = 0; g < 4; ++g) { u32x2 w; w.x = pk2(acc[4 * g], acc[4 * g + 1]); w.y = pk2(acc[4 * g + 2], acc[4 * g + 3]); *(GAS u32x2*)(dst + 8 * g) = w; } }
    }
    WG_SYNC();
}
PH_FN void gla_scan_part(const Ctx C, int part) {
    GAS unsigned* GKV = (GAS unsigned*)(C.ws + WS_GKV); const GAS float* GL = (const GAS float*)(C.ws + WS_GLAST);
    const int e = part * NTHR + C.tid, chain = e >> 12, idx = e & 4095, b = chain >> 2, h = chain & 3, k = (2 * idx) & 63;
    float s0 = 0.f, s1 = 0.f;
#pragma unroll 1
    for (int c0 = 0; c0 < NCH; c0 += 16) {
        unsigned tmp[16]; f32x2 dec[16];
#pragma unroll
        for (int i = 0; i < 16; ++i) { const size_t item = (size_t)(b * NCH + c0 + i) * 4 + h; tmp[i] = GKV[item * 4096 + idx]; dec[i] = *(const GAS f32x2*)(GL + item * 64 + k); }
#pragma unroll
        for (int i = 0; i < 16; ++i) { const size_t item = (size_t)(b * NCH + c0 + i) * 4 + h; GKV[item * 4096 + idx] = pk2(s0, s1); s0 = __expf(dec[i][0]) * s0 + bflo(tmp[i]); s1 = __expf(dec[i][1]) * s1 + bfhi(tmp[i]); }
    }
}
PH_HEAVY void ph_gla_c(const Ctx C, ArgsP a, int l) {
    const GAS bf16* P = (const GAS bf16*)(C.ws + WS_P); const GAS bf16* GKV = (const GAS bf16*)(C.ws + WS_GKV); GAS bf16* YS = (GAS bf16*)(C.ws + WS_YS);
    const GAS float* gnorm = a->in[14] + (size_t)l * 128;
    LF Gs = (LF)C.lds; LB QD = (LB)(C.lds + 17408); LB KDR = (LB)(C.lds + 26624); LB QI = (LB)(C.lds + 35840); LB ATT = (LB)(C.lds + 45056); LB VT = (LB)(C.lds + 54272); LB ST = (LB)(C.lds + 72704); LF PS = (LF)(C.lds + 91136);
    for (int it = C.bid; it < NBC * 4; it += C.G) {
        const int bc = it >> 2, h = it & 3;
        WG_SYNC();
        gla_compute_G(C, a, l, bc, h, Gs);
        { const int t = C.tid >> 3, g8 = C.tid & 7; const size_t row = (size_t)bc * 64 + t;
          float qf[8], kf[8], o1[8], o2[8], o3[8];
          unpack8(*(const GAS u32x4*)(P + row * NPM + C_GQ + h * 64 + g8 * 8), qf); unpack8(*(const GAS u32x4*)(P + row * NPM + C_GK + h * 64 + g8 * 8), kf);
#pragma unroll
          for (int i = 0; i < 8; ++i) { const int k = g8 * 8 + i; const float g = Gs[t * 68 + k], d = g - Gs[32 * 68 + k]; o1[i] = qf[i] * 0.125f * __expf(d); o2[i] = kf[i] * __expf(-d); o3[i] = qf[i] * 0.125f * __expf(g); }
          *(LAS u32x4*)(QD + t * 72 + g8 * 8) = pack8(o1); *(LAS u32x4*)(KDR + t * 72 + g8 * 8) = pack8(o2); *(LAS u32x4*)(QI + t * 72 + g8 * 8) = pack8(o3);
          const u32x4 v0 = *(const GAS u32x4*)(P + row * NPM + C_GV + h * 128 + g8 * 16), v1 = *(const GAS u32x4*)(P + row * NPM + C_GV + h * 128 + g8 * 16 + 8);
          const unsigned vw[8] = {v0.x, v0.y, v0.z, v0.w, v1.x, v1.y, v1.z, v1.w};
#pragma unroll
          for (int i = 0; i < 8; ++i) { VT[(g8 * 16 + 2 * i) * 72 + t] = (bf16)(vw[i] & 0xffffu); VT[(g8 * 16 + 2 * i + 1) * 72 + t] = (bf16)(vw[i] >> 16); }
          const int v = C.tid >> 2, kq = (C.tid & 3) * 16; const GAS bf16* sp = GKV + ((size_t)it * 128 + v) * 64 + kq;
          *(LAS u32x4*)(ST + v * 72 + kq) = *(const GAS u32x4*)sp; *(LAS u32x4*)(ST + v * 72 + kq + 8) = *(const GAS u32x4*)(sp + 8); }
        WG_SYNC();
        const int n = C.lane & 31, hi = C.lane >> 5;
        if (C.wave < 4) {
            const int it_ = C.wave >> 1, jt = C.wave & 1;
            f32x16 acc = zero16();
            if (jt <= it_) mma_nt<64>(acc, QD, 72, 32 * it_, KDR, 72, 32 * jt, C.lane);
#pragma unroll
            for (int r = 0; r < 16; ++r) { const int i = 32 * it_ + crow(r, hi), j = 32 * jt + n; ATT[i * 72 + j] = (bf16)f2bf(j <= i ? acc[r] : 0.f); }
        }
        WG_SYNC();
        {
            const int it_ = C.wave & 1, vt = C.wave >> 1;
            f32x16 acc = zero16();
            mma_nt<64>(acc, VT, 72, 32 * vt, ATT, 72, 32 * it_, C.lane);
            mma_nt<64>(acc, ST, 72, 32 * vt, QI, 72, 32 * it_, C.lane);
            float ss = 0.f;
#pragma unroll
            for (int r = 0; r < 16; ++r) ss += acc[r] * acc[r];
            ss += __shfl_xor(ss, 32);
            if (hi == 0) PS[(32 * it_ + n) * 4 + vt] = ss;
            WG_SYNC();
            const int i = 32 * it_ + n; const float tot = (PS[i * 4] + PS[i * 4 + 1]) + (PS[i * 4 + 2] + PS[i * 4 + 3]);
            const float rs = 1.0f / sqrtf(tot * (1.0f / 128.0f) + EPS); const size_t row = (size_t)bc * 64 + i;
#pragma unroll
            for (int g = 0; g < 4; ++g) { const int v0 = 32 * vt + 8 * g + 4 * hi;
                const u32x2 ogw = *(const GAS u32x2*)(P + row * NPM + C_GOG + h * 128 + v0); const f32x4 gn = *(const GAS f32x4*)(gnorm + v0);
                const float og[4] = {bflo(ogw.x), bfhi(ogw.x), bflo(ogw.y), bfhi(ogw.y)}; float o4[4];
#pragma unroll
                for (int y = 0; y < 4; ++y) o4[y] = acc[4 * g + y] * rs * gn[y] * siluf_(og[y]);
                u32x2 w; w.x = pk2(o4[0], o4[1]); w.y = pk2(o4[2], o4[3]); *(GAS u32x2*)(YS + row * 2048 + 512 + h * 128 + v0) = w; }
        }
    }
    WG_SYNC();
}

__device__ __forceinline__ void ssd_conv8(const GAS bf16* P, const GAS float* cw, const GAS float* cb, int bc, int t, int ch0, float* o) {
    const int pos = (bc & 127) * 64 + t; const size_t row = (size_t)bc * 64 + t;
#pragma unroll
    for (int i = 0; i < 8; ++i) o[i] = cb[ch0 + i];
#pragma unroll
    for (int tap = 0; tap < 4; ++tap) { if (pos - 3 + tap >= 0) { float x[8]; unpack8(*(const GAS u32x4*)(P + (row - 3 + tap) * NPM + C_SX + ch0), x);
#pragma unroll
        for (int i = 0; i < 8; ++i) o[i] += cw[tap * 1024 + ch0 + i] * x[i]; } }
#pragma unroll
    for (int i = 0; i < 8; ++i) o[i] = siluf_(o[i]);
}
PH_HEAVY void ph_ssd_a(const Ctx C, ArgsP a, int l) {
    const GAS bf16* P = (const GAS bf16*)(C.ws + WS_P); GAS bf16* SST = (GAS bf16*)(C.ws + WS_SST); GAS float* SDT = (GAS float*)(C.ws + WS_SDT); GAS float* SAC = (GAS float*)(C.ws + WS_SACUM); GAS float* SCD = (GAS float*)(C.ws + WS_SCDEC);
    const GAS float* cw = a->in[15] + (size_t)l * 4 * 1024; const GAS float* cb = a->in[16] + (size_t)l * 1024; const GAS float* dtb = a->in[17] + (size_t)l * 8; const GAS float* alog = a->in[18] + (size_t)l * 8;
    LB BT = (LB)C.lds; LB XDT = (LB)(C.lds + 18432); LF dtv = (LF)(C.lds + 27648); LF acu = (LF)(C.lds + 27904); LF av = (LF)(C.lds + 28160);
    for (int it = C.bid; it < NBC * 2; it += C.G) {
        const int bc = it >> 1, g = it & 1; const int t = C.tid >> 3, cg = C.tid & 7;
        WG_SYNC();
        { float o[8];
#pragma unroll
          for (int half = 0; half < 2; ++half) { ssd_conv8(P, cw, cb, bc, t, 512 + g * 128 + cg * 16 + half * 8, o);
#pragma unroll
              for (int i = 0; i < 8; ++i) BT[(cg * 16 + half * 8 + i) * 72 + t] = (bf16)f2bf(o[i]); } }
#pragma unroll 1
        for (int hh = 0; hh < 4; ++hh) {
            const int hd = 4 * g + hh; const size_t item8 = (size_t)bc * 8 + hd;
            WG_SYNC();
            if (C.tid < 64) { const size_t row = (size_t)bc * 64 + C.tid; const float dt = softplusf_(bf2f(P[row * NPM + C_SDT + hd]) + dtb[hd]); dtv[C.tid] = dt; av[C.tid] = -__expf(alog[hd]) * dt; }
            WG_SYNC();
            if (C.tid < 64) { float s = av[C.tid];
#pragma unroll
                for (int o = 1; o < 64; o <<= 1) { const float nb_ = __shfl_up(s, o); if (C.lane >= o) s += nb_; }
                acu[C.tid] = s; const size_t row = (size_t)bc * 64 + C.tid; SDT[row * 8 + hd] = dtv[C.tid]; SAC[row * 8 + hd] = s; if (C.tid == 63) SCD[item8] = __expf(s); }
            WG_SYNC();
            { float o[8]; ssd_conv8(P, cw, cb, bc, t, hd * 64 + cg * 8, o); const float sc = dtv[t] * __expf(acu[63] - acu[t]);
#pragma unroll
              for (int i = 0; i < 8; ++i) XDT[(cg * 8 + i) * 72 + t] = (bf16)f2bf(o[i] * sc); }
            WG_SYNC();
            { const int pt = C.wave >> 2, nt = C.wave & 3, n = C.lane & 31, hi = C.lane >> 5;
              f32x16 acc = zero16(); mma_nt<64>(acc, XDT, 72, 32 * pt, BT, 72, 32 * nt, C.lane);
#pragma unroll
              for (int r = 0; r < 16; ++r) SST[(item8 * 64 + 32 * pt + crow(r, hi)) * 128 + 32 * nt + n] = (bf16)f2bf(acc[r]); }
        }
    }
    WG_SYNC();
}
PH_FN void ssd_scan_part(const Ctx C, int part) {
    GAS unsigned* SST = (GAS unsigned*)(C.ws + WS_SST); const GAS float* SCD = (const GAS float*)(C.ws + WS_SCDEC);
    const int e = part * NTHR + C.tid, chain = e >> 12, idx = e & 4095, b = chain >> 3, hd = chain & 7;
    float s0 = 0.f, s1 = 0.f;
#pragma unroll 1
    for (int c0 = 0; c0 < NCH; c0 += 16) {
        unsigned tmp[16]; float dec[16];
#pragma unroll
        for (int i = 0; i < 16; ++i) { const size_t item = (size_t)(b * NCH + c0 + i) * 8 + hd; tmp[i] = SST[item * 4096 + idx]; dec[i] = SCD[item]; }
#pragma unroll
        for (int i = 0; i < 16; ++i) { const size_t item = (size_t)(b * NCH + c0 + i) * 8 + hd; SST[item * 4096 + idx] = pk2(s0, s1); s0 = dec[i] * s0 + bflo(tmp[i]); s1 = dec[i] * s1 + bfhi(tmp[i]); }
    }
}
PH_HEAVY void ph_ssd_c(const Ctx C, ArgsP a, int l) {
    const GAS bf16* P = (const GAS bf16*)(C.ws + WS_P); const GAS bf16* SST = (const GAS bf16*)(C.ws + WS_SST); const GAS float* SDT = (const GAS float*)(C.ws + WS_SDT); const GAS float* SAC = (const GAS float*)(C.ws + WS_SACUM); GAS bf16* YS = (GAS bf16*)(C.ws + WS_YS);
    const GAS float* cw = a->in[15] + (size_t)l * 4 * 1024; const GAS float* cb = a->in[16] + (size_t)l * 1024; const GAS float* dpar = a->in[19] + (size_t)l * 8; const GAS float* snorm = a->in[20] + (size_t)l * 512;
    LB BN = (LB)C.lds; LB CN = (LB)(C.lds + 17408); LF CB = (LF)(C.lds + 34816); LB SC = (LB)(C.lds + 52224); LB XST = (LB)(C.lds + 61440); LB HP = (LB)(C.lds + 70656); LB CE = (LB)(C.lds + 88064);
    LF dtv = (LF)(C.lds + 105472); LF acu = (LF)(C.lds + 105728); LF PSQ = (LF)(C.lds + 105984);
    for (int it = C.bid; it < NBC * 2; it += C.G) {
        const int bc = it >> 1, g = it & 1;
        const int t = C.tid >> 3, cg = C.tid & 7, n = C.lane & 31, hi = C.lane >> 5;
        WG_SYNC();
        { float o[8];
#pragma unroll
          for (int half = 0; half < 2; ++half) {
              ssd_conv8(P, cw, cb, bc, t, 512 + g * 128 + cg * 16 + half * 8, o); *(LAS u32x4*)(BN + t * 136 + cg * 16 + half * 8) = pack8(o);
              ssd_conv8(P, cw, cb, bc, t, 768 + g * 128 + cg * 16 + half * 8, o); *(LAS u32x4*)(CN + t * 136 + cg * 16 + half * 8) = pack8(o); } }
        WG_SYNC();
        if (C.wave < 4) {
            const int it_ = C.wave >> 1, jt = C.wave & 1;
            f32x16 acc = zero16(); mma_nt<128>(acc, CN, 136, 32 * it_, BN, 136, 32 * jt, C.lane);
#pragma unroll
            for (int r = 0; r < 16; ++r) CB[(32 * it_ + crow(r, hi)) * 68 + 32 * jt + n] = acc[r];
        }
        float yk[4][16]; float ssq = 0.f;
        const int pt = (C.wave >> 1) & 1, it2 = C.wave & 1;
#pragma unroll
        for (int hh = 0; hh < 4; ++hh) {
            const int hd = 4 * g + hh; const size_t item8 = (size_t)bc * 8 + hd;
            WG_SYNC();
            if (C.tid < 64) { const size_t row = (size_t)bc * 64 + C.tid; dtv[C.tid] = SDT[row * 8 + hd]; acu[C.tid] = SAC[row * 8 + hd]; }
            { float o[8]; ssd_conv8(P, cw, cb, bc, t, hd * 64 + cg * 8, o);
#pragma unroll
              for (int i = 0; i < 8; ++i) XST[(cg * 8 + i) * 72 + t] = (bf16)f2bf(o[i]);
              const int p = C.tid >> 3, n0 = (C.tid & 7) * 16; const GAS bf16* sp = SST + (item8 * 64 + p) * 128 + n0;
              *(LAS u32x4*)(HP + p * 136 + n0) = *(const GAS u32x4*)sp; *(LAS u32x4*)(HP + p * 136 + n0 + 8) = *(const GAS u32x4*)(sp + 8); }
            WG_SYNC();
            { const float ai = acu[t]; float o[8];
#pragma unroll
              for (int jj = 0; jj < 8; ++jj) { const int j = 8 * cg + jj; o[jj] = (j <= t) ? CB[t * 68 + j] * __expf(ai - acu[j]) * dtv[j] : 0.f; }
              *(LAS u32x4*)(SC + t * 72 + 8 * cg) = pack8(o);
              const float ea = __expf(ai); float c8[8];
#pragma unroll
              for (int half = 0; half < 2; ++half) { unpack8(*(const LAS u32x4*)(CN + t * 136 + cg * 16 + half * 8), c8);
#pragma unroll
                  for (int i = 0; i < 8; ++i) c8[i] *= ea;
                  *(LAS u32x4*)(CE + t * 136 + cg * 16 + half * 8) = pack8(c8); } }
            WG_SYNC();
            if (C.wave < 4) {
                f32x16 acc = zero16();
                mma_nt<64>(acc, XST, 72, 32 * pt, SC, 72, 32 * it2, C.lane);
                mma_nt<128>(acc, HP, 136, 32 * pt, CE, 136, 32 * it2, C.lane);
                const int i = 32 * it2 + n; const size_t row = (size_t)bc * 64 + i; const float dh = dpar[hd];
#pragma unroll
                for (int q4 = 0; q4 < 4; ++q4) { const int p0 = 32 * pt + 8 * q4 + 4 * hi;
                    const u32x2 zw = *(const GAS u32x2*)(P + row * NPM + C_SZ + hd * 64 + p0); const float zf[4] = {bflo(zw.x), bfhi(zw.x), bflo(zw.y), bfhi(zw.y)};
#pragma unroll
                    for (int e = 0; e < 4; ++e) { const float xs = bf2f(XST[(p0 + e) * 72 + i]); const float v = (acc[4 * q4 + e] + dh * xs) * siluf_(zf[e]); yk[hh][4 * q4 + e] = v; ssq += v * v; } }
            }
        }
        if (C.wave < 4) { ssq += __shfl_xor(ssq, 32); if (hi == 0) PSQ[(32 * it2 + n) * 2 + pt] = ssq; }
        WG_SYNC();
        if (C.wave < 4) {
            const int i = 32 * it2 + n; const float rs = 1.0f / sqrtf((PSQ[i * 2] + PSQ[i * 2 + 1]) * (1.0f / 256.0f) + EPS); const size_t row = (size_t)bc * 64 + i;
#pragma unroll
            for (int hh = 0; hh < 4; ++hh)
#pragma unroll
                for (int q4 = 0; q4 < 4; ++q4) { const int ch = g * 256 + hh * 64 + 32 * pt + 8 * q4 + 4 * hi; const f32x4 sn = *(const GAS f32x4*)(snorm + ch);
                    u32x2 w; w.x = pk2(yk[hh][4 * q4] * rs * sn[0], yk[hh][4 * q4 + 1] * rs * sn[1]); w.y = pk2(yk[hh][4 * q4 + 2] * rs * sn[2], yk[hh][4 * q4 + 3] * rs * sn[3]);
                    *(GAS u32x2*)(YS + row * 2048 + 1024 + ch) = w; }
        }
    }
    WG_SYNC();
}

#ifndef RW_CHUNKED
#define RW_CHUNKED 1
#endif
__device__ __forceinline__ void rw_lerp8(const GAS bf16* P, const GAS float* mu, int bc, int t, int c0, float* o) {
    const size_t row = (size_t)bc * 64 + t; const bool first = ((bc & 127) == 0) && (t == 0);
    float x[8], xp[8]; unpack8(*(const GAS u32x4*)(P + row * NPM + C_RR + c0), x);
    if (!first) unpack8(*(const GAS u32x4*)(P + (row - 1) * NPM + C_RR + c0), xp); else {
#pragma unroll
        for (int i = 0; i < 8; ++i) xp[i] = 0.f; }
#pragma unroll
    for (int i = 0; i < 8; ++i) o[i] = x[i] + (xp[i] - x[i]) * mu[c0 + i];
}
__device__ __forceinline__ void rw_lerp4(const GAS bf16* P, const GAS float* mu, size_t row, bool first, int c0, float* o) {
    const u32x2 xw = *(const GAS u32x2*)(P + row * NPM + C_RR + c0); const float x[4] = {bflo(xw.x), bfhi(xw.x), bflo(xw.y), bfhi(xw.y)};
    float xp[4] = {0.f, 0.f, 0.f, 0.f};
    if (!first) { const u32x2 pw = *(const GAS u32x2*)(P + (row - 1) * NPM + C_RR + c0); xp[0] = bflo(pw.x); xp[1] = bfhi(pw.x); xp[2] = bflo(pw.y); xp[3] = bfhi(pw.y); }
    const f32x4 m = *(const GAS f32x4*)(mu + c0);
#pragma unroll
    for (int i = 0; i < 4; ++i) o[i] = x[i] + (xp[i] - x[i]) * m[i];
}
#define RW_WFRAG(WT_, K_, nt_, s_) (*(const GAS pg8::bf16x8*)((WT_) + (size_t)(head * 64 + 32 * (nt_) + n) * (K_) + 16 * (s_) + 8 * hi))
#define RWP_PTRS \
    const GAS bf16* P = (const GAS bf16*)(C.ws + WS_P); \
    GAS float* RWW = (GAS float*)(C.ws + WS_RWW); GAS bf16* RWR = (GAS bf16*)(C.ws + WS_RWR); GAS bf16* RWK = (GAS bf16*)(C.ws + WS_RWK); GAS bf16* RWV = (GAS bf16*)(C.ws + WS_RWV); GAS bf16* RWKK = (GAS bf16*)(C.ws + WS_RWKK); GAS bf16* RWB = (GAS bf16*)(C.ws + WS_RWB); GAS bf16* RWG = (GAS bf16*)(C.ws + WS_RWG); \
    const GAS bf16* W2T = (const GAS bf16*)(C.ws + WS_RW2T); const GAS bf16* A2T = W2T + 512 * 64; const GAS bf16* G2T = A2T + 512 * 64;       \
    const GAS float* mu = a->in[21] + (size_t)l * 1792; const GAS float* w0 = a->in[22] + (size_t)l * 512; const GAS float* a0 = a->in[24] + (size_t)l * 512; \
    const GAS float* k_k = a->in[27] + (size_t)l * 512; const GAS float* k_a = a->in[28] + (size_t)l * 512; \
    LB WLb = (LB)C.lds; LB ALb = (LB)(C.lds + 9216); LB GLb = (LB)(C.lds + 18432);         \
    LB KX = (LB)(C.lds + 35840); LF w0s = (LF)(C.lds + 102400); LF a0s = w0s + 512; LF kks = a0s + 512; LF kas = kks + 512; LF INVs = kas + 512;     \
    (void)KX; (void)w0s; (void)a0s; (void)kks; (void)kas; (void)INVs; \
    (void)P; (void)RWW; (void)RWR; (void)RWK; (void)RWV; (void)RWKK; (void)RWB; (void)RWG; (void)W2T; (void)A2T; (void)G2T; (void)mu; (void)w0; (void)a0; (void)k_k; (void)k_a; (void)WLb; (void)ALb; (void)GLb;
#define RWP_LANE const int head = C.wave, n = C.lane & 31, hi = C.lane >> 5; const size_t row0 = (size_t)bc * 64 + 32 * tt; (void)row0;
PH_FN void rwp_stage(const Ctx C, ArgsP a, int l, int bc) {
    RWP_PTRS
    WG_SYNC();
    { const int t = C.tid >> 3, cg = C.tid & 7; float o[8];
      rw_lerp8(P, mu, bc, t, 1536 + cg * 8, o);
#pragma unroll
      for (int i = 0; i < 8; ++i) o[i] = tanhf(o[i]);
      *(LAS u32x4*)(WLb + t * 72 + cg * 8) = pack8(o);
      rw_lerp8(P, mu, bc, t, 1600 + cg * 8, o); *(LAS u32x4*)(ALb + t * 72 + cg * 8) = pack8(o);
#pragma unroll
      for (int half = 0; half < 2; ++half) { rw_lerp8(P, mu, bc, t, 1664 + cg * 16 + half * 8, o);
#pragma unroll
          for (int i = 0; i < 8; ++i) o[i] = sigmoidf_(o[i]);
          *(LAS u32x4*)(GLb + t * 136 + cg * 16 + half * 8) = pack8(o); }
      const size_t row = (size_t)bc * 64 + t;
#pragma unroll 2
      for (int j = 0; j < 8; ++j) { const int c = j * 64 + cg * 8;
          rw_lerp8(P, mu, bc, t, c, o); *(GAS u32x4*)(RWR + row * 512 + c) = pack8(o);
          rw_lerp8(P, mu, bc, t, 1024 + c, o); *(GAS u32x4*)(RWV + row * 512 + c) = pack8(o);
          rw_lerp8(P, mu, bc, t, 512 + c, o); *(LAS u32x4*)(KX + t * 520 + c) = pack8(o);
          const f32x4 k0 = *(const GAS f32x4*)(k_k + c), k1 = *(const GAS f32x4*)(k_k + c + 4); float ss = 0.f;
#pragma unroll
          for (int i = 0; i < 4; ++i) { const float q0 = o[i] * k0[i], q1 = o[4 + i] * k1[i]; ss += q0 * q0 + q1 * q1; }
          ss += __shfl_xor(ss, 1); ss += __shfl_xor(ss, 2); ss += __shfl_xor(ss, 4);
          if (cg == 0) INVs[t * 8 + j] = 1.0f / fmaxf(sqrtf(ss), 1e-12f); }
      const int q = C.tid * 4; *(LAS f32x4*)(w0s + q) = *(const GAS f32x4*)((q < 512 ? w0 : q < 1024 ? a0 - 512 : q < 1536 ? k_k - 1024 : k_a - 1536) + q); }
    WG_SYNC();
}
PH_FN void rwp_w(const Ctx C, ArgsP a, int l, int bc, int tt) {
    RWP_PTRS RWP_LANE
#pragma unroll
    for (int nt = 0; nt < 2; ++nt) { f32x16 c = zero16();
#pragma unroll
        for (int s4 = 0; s4 < 4; ++s4) c = __builtin_amdgcn_mfma_f32_32x32x16_bf16(frag32(WLb, 72, 32 * tt, 16 * s4, C.lane), RW_WFRAG(W2T, 64, nt, s4), c, 0, 0, 0);
        const int ch = head * 64 + 32 * nt + n; const float w0c = w0s[ch];
#pragma unroll
        for (int r = 0; r < 16; ++r) RWW[(row0 + crow(r, hi)) * 512 + ch] = -0.606531f * sigmoidf_(w0c + c[r]); }
}
PH_FN void rwp_g(const Ctx C, ArgsP a, int l, int bc, int tt) {
    RWP_PTRS RWP_LANE
#pragma unroll
    for (int nt = 0; nt < 2; ++nt) { f32x16 c = zero16();
#pragma unroll
        for (int s8 = 0; s8 < 8; ++s8) c = __builtin_amdgcn_mfma_f32_32x32x16_bf16(frag32(GLb, 136, 32 * tt, 16 * s8, C.lane), RW_WFRAG(G2T, 128, nt, s8), c, 0, 0, 0);
        const int ch = head * 64 + 32 * nt + n;
#pragma unroll
        for (int r = 0; r < 16; ++r) RWG[(row0 + crow(r, hi)) * 512 + ch] = (bf16)f2bf(c[r]); }
}
PH_FN void rwp_ak(const Ctx C, ArgsP a, int l, int bc, int tt) {
    RWP_PTRS RWP_LANE
#pragma unroll
    for (int nt = 0; nt < 2; ++nt) { f32x16 c = zero16();
#pragma unroll
        for (int s4 = 0; s4 < 4; ++s4) c = __builtin_amdgcn_mfma_f32_32x32x16_bf16(frag32(ALb, 72, 32 * tt, 16 * s4, C.lane), RW_WFRAG(A2T, 64, nt, s4), c, 0, 0, 0);
        const int ch = head * 64 + 32 * nt + n; const float a0c = a0s[ch], kkc = kks[ch], kac = kas[ch];
#pragma unroll
        for (int r = 0; r < 16; ++r) { const int tl = 32 * tt + crow(r, hi); const float al = sigmoidf_(a0c + c[r]), x = bf2f(KX[tl * 520 + ch]), kkn = x * kkc * INVs[tl * 8 + head];
            const size_t g = ((size_t)bc * 64 + tl) * 512 + ch;
            RWKK[g] = (bf16)f2bf(kkn); RWB[g] = (bf16)f2bf(kkn * al); RWK[g] = (bf16)f2bf(x * (1.0f + (al - 1.0f) * kac)); } }
}
#undef RW_WFRAG
#undef RWP_PTRS
#undef RWP_LANE
__device__ __forceinline__ void ph_rw_prep(const Ctx& C, ArgsP a, int l) {
    for (int bc = C.bid; bc < NBC; bc += C.G) { rwp_stage(C, a, l, bc);
#pragma unroll 1
        for (int tt = 0; tt < 2; ++tt) { rwp_w(C, a, l, bc, tt); rwp_g(C, a, l, bc, tt); rwp_ak(C, a, l, bc, tt); } }
    WG_SYNC();
}
template <int CTRL> __device__ __forceinline__ float dpp_get(float x) { return __builtin_bit_cast(float, __builtin_amdgcn_update_dpp(0, __builtin_bit_cast(int, x), CTRL, 0xf, 0xf, true)); }
__device__ __forceinline__ float reduce16(float x) { x += dpp_get<0xB1>(x); x += dpp_get<0x4E>(x); x += dpp_get<0x141>(x); x += dpp_get<0x140>(x); return x; }
#define RW_BAR() do { asm volatile("s_waitcnt lgkmcnt(0)" ::: "memory"); __builtin_amdgcn_s_barrier(); asm volatile("" ::: "memory"); } while (0)
PH_FN void rw_unit(const Ctx C, int chain, int rq) {
    const GAS float* RWW = (const GAS float*)(C.ws + WS_RWW); const GAS bf16* RWR = (const GAS bf16*)(C.ws + WS_RWR); const GAS bf16* RWK = (const GAS bf16*)(C.ws + WS_RWK); const GAS bf16* RWV = (const GAS bf16*)(C.ws + WS_RWV);
    const GAS bf16* RWKK = (const GAS bf16*)(C.ws + WS_RWKK); const GAS bf16* RWB = (const GAS bf16*)(C.ws + WS_RWB); GAS bf16* RWY = (GAS bf16*)(C.ws + WS_RWY);
    const int b = chain >> 3, h = chain & 7; const size_t rowb = (size_t)b * SEQ;
    constexpr int BUFB = 43008, O_KK = 0, O_W = 8192, O_B = 16384, O_K = 24576, O_R = 32768, O_V = 40960, NBLK = SEQ / 32;
    LAS unsigned char* L = C.lds;
    if (C.wave >= 4) {
        const int p = C.tid - 256, t = p >> 3, c8 = (p & 7) * 8;
        u32x4 rr, rk, rkk, rb; f32x4 w0, w1; unsigned rv;
#define RW_LOAD(blk) do { const size_t g_ = (rowb + (size_t)(blk) * 32 + t) * 512 + h * 64; \
            w0 = *(const GAS f32x4*)(RWW + g_ + c8); w1 = *(const GAS f32x4*)(RWW + g_ + c8 + 4); rr = *(const GAS u32x4*)(RWR + g_ + c8); rk = *(const GAS u32x4*)(RWK + g_ + c8); \
            rkk = *(const GAS u32x4*)(RWKK + g_ + c8); rb = *(const GAS u32x4*)(RWB + g_ + c8); rv = *(const GAS unsigned*)(RWV + g_ + 16 * rq + (p & 7) * 2); } while (0)
#define RW_ST8(off, w_) do { float o_[8]; unpack8(w_, o_); LF d_ = (LF)(Lb + (off)) + t * 64 + c8; *(LAS f32x4*)d_ = (f32x4){o_[0], o_[1], o_[2], o_[3]}; *(LAS f32x4*)(d_ + 4) = (f32x4){o_[4], o_[5], o_[6], o_[7]}; } while (0)
        RW_LOAD(0);
        for (int blk = 0; blk < NBLK; ++blk) {
            LAS unsigned char* Lb = L + (blk & 1) * BUFB;
            { LF d = (LF)(Lb + O_W) + t * 64 + c8; *(LAS f32x4*)d = w0; *(LAS f32x4*)(d + 4) = w1; }
            RW_ST8(O_R, rr); RW_ST8(O_K, rk); RW_ST8(O_KK, rkk); RW_ST8(O_B, rb);
            { LF d = (LF)(Lb + O_V) + t * 16 + (p & 7) * 2; d[0] = bflo(rv); d[1] = bfhi(rv); }
            if (blk + 1 < NBLK) RW_LOAD(blk + 1);
            RW_BAR();
        }
        RW_BAR();
#undef RW_LOAD
#undef RW_ST8
    } else {
        const int rowl = C.lane >> 4, ks = C.lane & 15, row = 4 * C.wave + rowl;
        float S0 = 0.f, S1 = 0.f, S2 = 0.f, S3 = 0.f, ykeep = 0.f;
        GAS bf16* yout = RWY + rowb * 512 + h * 64 + 16 * rq + row;
        for (int blk = 0; blk < NBLK; ++blk) {
            RW_BAR();
            const LAS unsigned char* Lb = L + (blk & 1) * BUFB;
            CLF pKK = (CLF)(Lb + O_KK) + 4 * ks; CLF pW = (CLF)(Lb + O_W) + 4 * ks; CLF pB = (CLF)(Lb + O_B) + 4 * ks; CLF pK = (CLF)(Lb + O_K) + 4 * ks; CLF pR = (CLF)(Lb + O_R) + 4 * ks; CLF pV = (CLF)(Lb + O_V) + row;
            f32x4 kk = *(const LAS f32x4*)pKK, w = *(const LAS f32x4*)pW, bb = *(const LAS f32x4*)pB, k = *(const LAS f32x4*)pK, r = *(const LAS f32x4*)pR; float vv = *pV;
#pragma unroll 4
            for (int t = 0; t < 32; ++t) {
                f32x4 nkk, nw, nb, nk, nr; float nv;
                const int tn = (t < 31) ? t + 1 : t;
                nkk = *(const LAS f32x4*)(pKK + tn * 64); nw = *(const LAS f32x4*)(pW + tn * 64); nb = *(const LAS f32x4*)(pB + tn * 64); nk = *(const LAS f32x4*)(pK + tn * 64); nr = *(const LAS f32x4*)(pR + tn * 64); nv = pV[tn * 16];
                float sa = (S0 * kk[0] + S1 * kk[1]) + (S2 * kk[2] + S3 * kk[3]);
                sa = -reduce16(sa);
                const float vk0 = vv * k[0], vk1 = vv * k[1], vk2 = vv * k[2], vk3 = vv * k[3];
                S0 = S0 * w[0] + (sa * bb[0] + vk0); S1 = S1 * w[1] + (sa * bb[1] + vk1); S2 = S2 * w[2] + (sa * bb[2] + vk2); S3 = S3 * w[3] + (sa * bb[3] + vk3);
                float y = (S0 * r[0] + S1 * r[1]) + (S2 * r[2] + S3 * r[3]);
                y = reduce16(y);
                if ((t & 15) == ks) ykeep = y;
                if ((t & 15) == 15) yout[(size_t)(blk * 32 + (t & 16) + ks) * 512] = (bf16)f2bf(ykeep);
                kk = nkk; w = nw; bb = nb; k = nk; r = nr; vv = nv;
            }
        }
        RW_BAR();
    }
}
PH_FN void ph_rw_out(const Ctx C, ArgsP a, int l) {
    const GAS bf16* RWR = (const GAS bf16*)(C.ws + WS_RWR); const GAS bf16* RWK = (const GAS bf16*)(C.ws + WS_RWK); const GAS bf16* RWV = (const GAS bf16*)(C.ws + WS_RWV); const GAS bf16* RWG = (const GAS bf16*)(C.ws + WS_RWG); const GAS bf16* RWY = (const GAS bf16*)(C.ws + WS_RWY);
    GAS bf16* YS = (GAS bf16*)(C.ws + WS_YS);
    const GAS float* r_k = a->in[29] + (size_t)l * 512; const GAS float* nw = a->in[30] + (size_t)l * 512; const GAS float* nb = a->in[31] + (size_t)l * 512;
    const int gw = C.bid * NWAVES + C.wave, NGW = C.G * NWAVES, c0 = C.lane * 8;
    float rk[8], w8[8], b8[8];
#pragma unroll
    for (int i = 0; i < 8; ++i) { rk[i] = r_k[c0 + i]; w8[i] = nw[c0 + i]; b8[i] = nb[c0 + i]; }
    for (int row0 = gw * 2; row0 < M; row0 += NGW * 2) {
        u32x4 yw[2], rw[2], kw[2], vw[2], gw4[2];
#pragma unroll
        for (int u = 0; u < 2; ++u) { const size_t g = (size_t)(row0 + u) * 512 + c0; yw[u] = *(const GAS u32x4*)(RWY + g); rw[u] = *(const GAS u32x4*)(RWR + g); kw[u] = *(const GAS u32x4*)(RWK + g); vw[u] = *(const GAS u32x4*)(RWV + g); gw4[u] = *(const GAS u32x4*)(RWG + g); }
#pragma unroll
        for (int u = 0; u < 2; ++u) { float y[8], r[8], k[8], v[8], gg[8], o[8]; unpack8(yw[u], y); unpack8(rw[u], r); unpack8(kw[u], k); unpack8(vw[u], v); unpack8(gw4[u], gg);
            float s = 0.f, bs = 0.f;
#pragma unroll
            for (int i = 0; i < 8; ++i) { s += y[i]; bs += r[i] * k[i] * rk[i]; }
            s += __shfl_xor(s, 1); s += __shfl_xor(s, 2); s += __shfl_xor(s, 4); bs += __shfl_xor(bs, 1); bs += __shfl_xor(bs, 2); bs += __shfl_xor(bs, 4);
            const float mu = s * (1.0f / 64.0f); float q = 0.f;
#pragma unroll
            for (int i = 0; i < 8; ++i) { y[i] -= mu; q += y[i] * y[i]; }
            q += __shfl_xor(q, 1); q += __shfl_xor(q, 2); q += __shfl_xor(q, 4);
            const float rs = 1.0f / sqrtf(q * (1.0f / 64.0f) + 64e-5f);
#pragma unroll
            for (int i = 0; i < 8; ++i) o[i] = (y[i] * rs * w8[i] + b8[i] + bs * v[i]) * gg[i];
            *(GAS u32x4*)(YS + (size_t)(row0 + u) * 2048 + 1536 + c0) = pack8(o); }
    }
}

__device__ __forceinline__ int pi_swap23(int i) { return (i & ~12) | ((i & 4) << 1) | ((i & 8) >> 1); }
__device__ __forceinline__ void da_unit(const Ctx& C, const Args& a, int l, int b, int h, int jq, float lam, float oml) {
    const GAS bf16* P = (const GAS bf16*)(C.ws + WS_P); const GAS bf16* VT = (const GAS bf16*)(C.ws + WS_VT); GAS bf16* YS = (GAS bf16*)(C.ws + WS_YS);
    const GAS float* dnorm = (const GAS float*)a.in[11] + (size_t)l * 128;
    const int comp = C.wave >> 2, wq = C.wave & 3, q = C.lane & 31, hi = C.lane >> 5;
    const size_t qrow = (size_t)b * SEQ + jq * 128 + wq * 32 + q;
    pg8::bf16x8 qf[4];
#pragma unroll
    for (int d0 = 0; d0 < 4; ++d0) qf[d0] = *(const GAS pg8::bf16x8*)(P + qrow * NPM + C_DAQ + h * 128 + comp * 64 + 16 * d0 + 8 * hi);
    const int ntile = 2 * jq + 2, my_last = 2 * jq + (wq >= 2 ? 1 : 0);
    f32x16 O[4];
#pragma unroll
    for (int db = 0; db < 4; ++db)
#pragma unroll
        for (int r = 0; r < 16; ++r) O[db][r] = 0.f;
    float mrun = 0.f, lrun = 0.f;
    f32x16 negm;
#pragma unroll
    for (int r = 0; r < 16; ++r) negm[r] = 0.f;
    const GAS bf16* kg = P + ((size_t)b * SEQ + C.lane) * NPM + C_DAK + h * 128 + C.wave * 8;
    const GAS bf16* vg = VT + ((size_t)(b * 4 + h) * 128 + 64 * (C.wave & 1) + C.lane) * SEQ + (C.wave >> 1) * 8;
    const unsigned lds0 = (unsigned)(size_t)C.lds;
    const unsigned kdst0 = lds0 + (unsigned)(C.wave >> 3) * 8192u + (unsigned)(C.wave & 7) * 1024u;
    const unsigned vdst0 = lds0 + 32768u + (unsigned)(C.wave >> 1) * 2048u + (unsigned)(C.wave & 1) * 1024u;
    const int pq = pi_swap23(q);
    pg8::bf16x8 pb[4] = {}, pbp[4] = {};
    int vs = 0, vsp = 0;
#define DA_GLDS(gp_, dst_) do { unsigned keep_; asm volatile("s_mov_b32 %0, m0\n\ts_mov_b32 m0, %2\n\ts_nop 0\n\tglobal_load_lds_dwordx4 %1, off\n\ts_mov_b32 m0, %0" : "=&s"(keep_) : "v"(gp_), "s"((unsigned)__builtin_amdgcn_readfirstlane(dst_)) : "memory"); } while (0)
#define DA_DMA(tile_, vslot_) do { const GAS bf16* kp_ = kg + (size_t)(tile_) * 64 * NPM; const GAS bf16* vp_ = vg + (tile_) * 64; const unsigned kd_ = kdst0 + (unsigned)((tile_) & 1) * 16384u, vd_ = vdst0 + (unsigned)(vslot_); \
        DA_GLDS(kp_, kd_); DA_GLDS(kp_ + 64, kd_ + 8192u); DA_GLDS(vp_, vd_); DA_GLDS(vp_ + 32, vd_ + 8192u); } while (0)
#define DA_STAGE(tile_) do { asm volatile("s_waitcnt vmcnt(0)" ::: "memory"); WG_SYNC(); if ((tile_) + 1 < ntile) DA_DMA((tile_) + 1, (vs == 32768) ? 0 : vs + 16384); } while (0)
#define DA_QK(tile_) do { const LAS unsigned char* kb_ = C.lds + ((tile_) & 1) * 16384 + comp * 8192 + hi * 1024 + pq * 16; pg8::bf16x8 ka_[8]; \
        _Pragma("unroll") for (int d0 = 0; d0 < 4; ++d0) { ka_[2 * d0] = *(const LAS pg8::bf16x8*)(kb_ + d0 * 2048); ka_[2 * d0 + 1] = *(const LAS pg8::bf16x8*)(kb_ + d0 * 2048 + 512); } \
        __builtin_amdgcn_sched_barrier(0); \
        p0 = __builtin_amdgcn_mfma_f32_32x32x16_bf16(ka_[0], qf[0], negm, 0, 0, 0); p1 = __builtin_amdgcn_mfma_f32_32x32x16_bf16(ka_[1], qf[0], negm, 0, 0, 0); \
        _Pragma("unroll") for (int d0 = 1; d0 < 4; ++d0) { p0 = __builtin_amdgcn_mfma_f32_32x32x16_bf16(ka_[2 * d0], qf[d0], p0, 0, 0, 0); p1 = __builtin_amdgcn_mfma_f32_32x32x16_bf16(ka_[2 * d0 + 1], qf[d0], p1, 0, 0, 0); } } while (0)
#define DA_PV(PB_, voff_) do { const LAS unsigned char* vb_ = C.lds + 32768 + (voff_); _Pragma("unroll") for (int db = 0; db < 4; ++db) _Pragma("unroll") for (int s = 0; s < 4; ++s) { \
            const pg8::bf16x8 vf_ = *(const LAS pg8::bf16x8*)(vb_ + (2 * s + hi) * 2048 + (32 * db + q) * 16); O[db] = __builtin_amdgcn_mfma_f32_32x32x16_bf16(vf_, PB_[s], O[db], 0, 0, 0); } } while (0)
#define DA_MX3(a_, b_, c_) __builtin_fmaxf(__builtin_fmaxf((a_), (b_)), (c_))
#define DA_SM_MAX(FIRST_, PBP_) do { \
        float ma = DA_MX3(p0[0], p0[1], p1[0]), mb = DA_MX3(p0[2], p0[3], p1[1]); ma = DA_MX3(ma, p1[2], p1[3]); \
        _Pragma("unroll") for (int r = 4; r < 16; r += 4) { ma = DA_MX3(ma, p0[r], p0[r + 1]); mb = DA_MX3(mb, p0[r + 2], p0[r + 3]); ma = DA_MX3(ma, p1[r], p1[r + 1]); mb = DA_MX3(mb, p1[r + 2], p1[r + 3]); } \
        float rm = __builtin_fmaxf(ma, mb); rm = __builtin_fmaxf(rm, __shfl_xor(rm, 32)); \
        if ((FIRST_) || __any(rm > 8.0f)) { const float dl = (FIRST_) ? rm : __builtin_fmaxf(rm, 0.f); mrun += dl; const float f = __builtin_amdgcn_exp2f(-dl); lrun *= f; \
            _Pragma("unroll") for (int r = 0; r < 16; ++r) { p0[r] -= dl; p1[r] -= dl; negm[r] = -mrun; } \
            _Pragma("unroll") for (int db = 0; db < 4; ++db) _Pragma("unroll") for (int r = 0; r < 16; ++r) O[db][r] *= f; \
            if (!(FIRST_)) { _Pragma("unroll") for (int s_ = 0; s_ < 4; ++s_) { const u32x4 w_ = __builtin_bit_cast(u32x4, PBP_[s_]); u32x4 o_; \
                o_.x = pk2(bflo(w_.x) * f, bfhi(w_.x) * f); o_.y = pk2(bflo(w_.y) * f, bfhi(w_.y) * f); o_.z = pk2(bflo(w_.z) * f, bfhi(w_.z) * f); o_.w = pk2(bflo(w_.w) * f, bfhi(w_.w) * f); PBP_[s_] = __builtin_bit_cast(pg8::bf16x8, o_); } } } } while (0)
#define DA_SM_EXP(PBO_) do { \
        _Pragma("unroll") for (int r = 0; r < 16; ++r) { p0[r] = __builtin_amdgcn_exp2f(p0[r]); p1[r] = __builtin_amdgcn_exp2f(p1[r]); } \
        { f32x2 s2 = {0.f, 0.f}; _Pragma("unroll") for (int r = 0; r < 16; r += 2) { s2 += (f32x2){p0[r], p0[r + 1]}; s2 += (f32x2){p1[r], p1[r + 1]}; } lrun += s2[0] + s2[1]; } \
        { u32x4 w; \
          w.x = pk2(p0[0], p0[1]); w.y = pk2(p0[2], p0[3]); w.z = pk2(p0[4], p0[5]); w.w = pk2(p0[6], p0[7]); PBO_[0] = __builtin_bit_cast(pg8::bf16x8, w); \
          w.x = pk2(p0[8], p0[9]); w.y = pk2(p0[10], p0[11]); w.z = pk2(p0[12], p0[13]); w.w = pk2(p0[14], p0[15]); PBO_[1] = __builtin_bit_cast(pg8::bf16x8, w); \
          w.x = pk2(p1[0], p1[1]); w.y = pk2(p1[2], p1[3]); w.z = pk2(p1[4], p1[5]); w.w = pk2(p1[6], p1[7]); PBO_[2] = __builtin_bit_cast(pg8::bf16x8, w); \
          w.x = pk2(p1[8], p1[9]); w.y = pk2(p1[10], p1[11]); w.z = pk2(p1[12], p1[13]); w.w = pk2(p1[14], p1[15]); PBO_[3] = __builtin_bit_cast(pg8::bf16x8, w); } } while (0)
#define DA_VADDR(i_) (vb_ + ((i_) & 3) * 4096 + ((i_) >> 2) * 512)
#define DA_PV_EXP(PBP_, voff_, PBO_) do { const LAS unsigned char* vb_ = C.lds + 32768 + (voff_) + hi * 2048 + q * 16; f32x2 s2_ = {0.f, 0.f}; unsigned pw_[16]; \
        pg8::bf16x8 vq_[4];   \
        vq_[0] = *(const LAS pg8::bf16x8*)DA_VADDR(0); vq_[1] = *(const LAS pg8::bf16x8*)DA_VADDR(1); vq_[2] = *(const LAS pg8::bf16x8*)DA_VADDR(2); \
        _Pragma("unroll") for (int i_ = 0; i_ < 16; ++i_) { const int db_ = i_ >> 2, s_ = i_ & 3; \
            if (i_ + 3 < 16) vq_[(i_ + 3) & 3] = *(const LAS pg8::bf16x8*)DA_VADDR(i_ + 3); \
            O[db_] = __builtin_amdgcn_mfma_f32_32x32x16_bf16(vq_[i_ & 3], PBP_[s_], O[db_], 0, 0, 0); \
            float e0_, e1_; if (i_ < 8) { e0_ = __builtin_amdgcn_exp2f(p0[2 * i_]); e1_ = __builtin_amdgcn_exp2f(p0[2 * i_ + 1]); } else { e0_ = __builtin_amdgcn_exp2f(p1[2 * i_ - 16]); e1_ = __builtin_amdgcn_exp2f(p1[2 * i_ - 15]); } \
            s2_ += (f32x2){e0_, e1_}; pw_[i_] = pk2(e0_, e1_); \
            __builtin_amdgcn_sched_barrier(0); } \
        lrun += s2_[0] + s2_[1]; \
        _Pragma("unroll") for (int k_ = 0; k_ < 4; ++k_) { u32x4 w_; w_.x = pw_[4 * k_]; w_.y = pw_[4 * k_ + 1]; w_.z = pw_[4 * k_ + 2]; w_.w = pw_[4 * k_ + 3]; PBO_[k_] = __builtin_bit_cast(pg8::bf16x8, w_); } } while (0)
    f32x16 p0, p1;
    DA_DMA(0, 0);
    DA_STAGE(0); DA_QK(0); DA_SM_MAX(true, pbp); DA_SM_EXP(pb);
    for (int tile = 1; tile <= my_last; ++tile) {
        vsp = vs; vs = (vs == 32768) ? 0 : vs + 16384;
#pragma unroll
        for (int s = 0; s < 4; ++s) pbp[s] = pb[s];
        DA_STAGE(tile); DA_QK(tile); DA_SM_MAX(false, pbp);
        DA_PV_EXP(pbp, vsp, pb);
    }
    if (my_last < ntile - 1) { const int vkeep = vs; vs = (vs == 32768) ? 0 : vs + 16384; DA_STAGE(ntile - 1); vs = vkeep; }
    DA_PV(pb, vs);
#undef DA_GLDS
#undef DA_DMA
#undef DA_STAGE
#undef DA_QK
#undef DA_PV
#undef DA_MX3
#undef DA_SM_MAX
#undef DA_SM_EXP
#undef DA_PV_EXP
#undef DA_VADDR
    const float ltot = lrun + __shfl_xor(lrun, 32); const float inv = 1.0f / ltot;
    WG_SYNC();
    LF X = (LF)C.lds + (wq * 32 + q) * 132;
    if (comp == 1) {
        const float sc = inv * lam;
#pragma unroll
        for (int db = 0; db < 4; ++db)
#pragma unroll
            for (int g4 = 0; g4 < 4; ++g4) *(LAS f32x4*)(X + 32 * db + 8 * g4 + 4 * hi) = (f32x4){O[db][4 * g4] * sc, O[db][4 * g4 + 1] * sc, O[db][4 * g4 + 2] * sc, O[db][4 * g4 + 3] * sc};
    }
    WG_SYNC();
    if (comp == 0) {
        float ss = 0.f;
#pragma unroll
        for (int db = 0; db < 4; ++db)
#pragma unroll
            for (int g4 = 0; g4 < 4; ++g4) { const f32x4 x = *(const LAS f32x4*)(X + 32 * db + 8 * g4 + 4 * hi);
#pragma unroll
                for (int e = 0; e < 4; ++e) { const float v = O[db][4 * g4 + e] * inv - x[e]; O[db][4 * g4 + e] = v; ss += v * v; } }
        ss += __shfl_xor(ss, 32);
        const float rs = oml / sqrtf(ss * (1.0f / 128.0f) + EPS);
#pragma unroll
        for (int db = 0; db < 4; ++db)
#pragma unroll
            for (int g4 = 0; g4 < 4; ++g4) { const int d = 32 * db + 8 * g4 + 4 * hi; const f32x4 gn = *(const GAS f32x4*)(dnorm + d);
                u32x2 w; w.x = pk2(O[db][4 * g4] * rs * gn[0], O[db][4 * g4 + 1] * rs * gn[1]); w.y = pk2(O[db][4 * g4 + 2] * rs * gn[2], O[db][4 * g4 + 3] * rs * gn[3]);
                *(GAS u32x2*)(YS + qrow * 2048 + h * 128 + d) = w; }
    }
    WG_SYNC();
}
#if RW_CHUNKED
__device__ const signed char ATT_BINS30[30][3] = {{63,4,3}, {62,5,2}, {61,6,1}, {60,7,0}, {59,8,-1}, {58,9,-1}, {57,10,-1}, {56,11,-1}, {55,12,-1}, {54,13,-1}, {53,14,-1}, {52,15,-1}, {51,16,-1}, {50,17,-1}, {49,18,-1}, {48,19,-1}, {47,20,-1}, {46,21,-1}, {45,22,-1}, {44,23,-1}, {43,24,-1}, {42,25,-1}, {41,26,-1}, {40,27,-1}, {39,28,-1}, {38,29,-1}, {37,30,-1}, {36,31,-1}, {35,32,-1}, {34,33,-1}};
__device__ __forceinline__ int att_bin_unit(int bin, int i) { return i < 3 ? (int)ATT_BINS30[bin][i] : -1; }
#else
__device__ const signed char ATT_BINS[24][12] = {{63,21,-1,-1,-1,-1,-1,-1,-1,-1,-1,-1}, {62,22,-1,-1,-1,-1,-1,-1,-1,-1,-1,-1}, {61,23,-1,-1,-1,-1,-1,-1,-1,-1,-1,-1}, {60,24,-1,-1,-1,-1,-1,-1,-1,-1,-1,-1}, {59,25,-1,-1,-1,-1,-1,-1,-1,-1,-1,-1}, {58,26,-1,-1,-1,-1,-1,-1,-1,-1,-1,-1}, {57,27,-1,-1,-1,-1,-1,-1,-1,-1,-1,-1}, {56,28,-1,-1,-1,-1,-1,-1,-1,-1,-1,-1}, {55,29,-1,-1,-1,-1,-1,-1,-1,-1,-1,-1}, {54,30,-1,-1,-1,-1,-1,-1,-1,-1,-1,-1}, {53,31,-1,-1,-1,-1,-1,-1,-1,-1,-1,-1}, {52,32,-1,-1,-1,-1,-1,-1,-1,-1,-1,-1}, {51,33,-1,-1,-1,-1,-1,-1,-1,-1,-1,-1}, {50,34,-1,-1,-1,-1,-1,-1,-1,-1,-1,-1}, {49,35,-1,-1,-1,-1,-1,-1,-1,-1,-1,-1}, {48,36,-1,-1,-1,-1,-1,-1,-1,-1,-1,-1}, {47,37,-1,-1,-1,-1,-1,-1,-1,-1,-1,-1}, {46,38,-1,-1,-1,-1,-1,-1,-1,-1,-1,-1}, {45,39,-1,-1,-1,-1,-1,-1,-1,-1,-1,-1}, {44,40,-1,-1,-1,-1,-1,-1,-1,-1,-1,-1}, {43,41,-1,-1,-1,-1,-1,-1,-1,-1,-1,-1}, {42,20,19,6,-1,-1,-1,-1,-1,-1,-1,-1}, {18,17,16,15,14,5,-1,-1,-1,-1,-1,-1}, {13,12,11,10,9,8,7,4,3,2,1,0}};
__device__ __forceinline__ int att_bin_unit(int bin, int i) { return i < 12 ? (int)ATT_BINS[bin][i] : -1; }
#endif
__device__ __forceinline__ void ph_da_attn(const Ctx& C, const Args& a, int l, int bh, int bin) {
    const GAS float* q1 = (const GAS float*)a.in[7] + (size_t)l * 64; const GAS float* k1 = (const GAS float*)a.in[8] + (size_t)l * 64; const GAS float* q2 = (const GAS float*)a.in[9] + (size_t)l * 64; const GAS float* k2 = (const GAS float*)a.in[10] + (size_t)l * 64;
    float s1 = 0.f, s2 = 0.f;
    for (int i = 0; i < 64; ++i) { s1 += q1[i] * k1[i]; s2 += q2[i] * k2[i]; }
    int ll = l; asm volatile("" : "+s"(ll));
    const float lam_init = 0.8f - 0.6f * expf(-0.3f * (float)ll); const float lam_v = expf(s1) - expf(s2) + lam_init;
    const float lam = __uint_as_float(__builtin_amdgcn_readfirstlane(__float_as_uint(lam_v))), oml = __uint_as_float(__builtin_amdgcn_readfirstlane(__float_as_uint(1.0f - lam_init)));
    for (int i = 0; i < 12; ++i) { const int jq = att_bin_unit(bin, i); if (jq < 0) break; da_unit(C, a, l, bh >> 2, bh & 3, jq, lam, oml); }
}

PH_FN void ph_final(const Ctx C, ArgsP a) {
    const GAS float* ssq = (const GAS float*)(C.ws + WS_SSQ); const GAS float* fn = a->in[39]; const GAS bf16* hb = (const GAS bf16*)(C.ws + WS_HB);
    const int gw = C.bid * NWAVES + C.wave, NGW = C.G * NWAVES;
    for (int m = gw; m < M; m += NGW) { const float rs = pg8::row_rstd((const float*)ssq, m, M); GAS f32x4* orow = (GAS f32x4*)(C.h + (size_t)m * D) + C.lane; const GAS f32x4* gr = (const GAS f32x4*)fn + C.lane;
        const GAS u32x2* hr = (const GAS u32x2*)(hb + (size_t)m * D) + C.lane;
#pragma unroll
        for (int j = 0; j < 4; ++j) { const u32x2 w = hr[64 * j]; const f32x4 g = gr[64 * j]; orow[64 * j] = (f32x4){bflo(w.x) * rs * g[0], bfhi(w.x) * rs * g[1], bflo(w.y) * rs * g[2], bfhi(w.y) * rs * g[3]}; } }
}
#define RWC_PTRS \
    GAS float* RWW = (GAS float*)(C.ws + WS_RWW); const GAS bf16* RWR = (const GAS bf16*)(C.ws + WS_RWR); const GAS bf16* RWK = (const GAS bf16*)(C.ws + WS_RWK); const GAS bf16* RWV = (const GAS bf16*)(C.ws + WS_RWV); \
    GAS bf16* RWKK = (GAS bf16*)(C.ws + WS_RWKK); GAS bf16* RWB = (GAS bf16*)(C.ws + WS_RWB); GAS bf16* RWY = (GAS bf16*)(C.ws + WS_RWY); \
    LF LGs = (LF)C.lds; LB LP = (LB)C.lds; LB LPT = (LB)(C.lds + 9216); LB AT = (LB)(C.lds + 18432); LB LAK = AT; LB LP2 = AT; LB RT = (LB)(C.lds + 27648); LB BTl = (LB)(C.lds + 36864); LB MRB = BTl; LB KTl = (LB)(C.lds + 46080); LB MRK = KTl; \
    LB VT = (LB)(C.lds + 55296); LB BHT = (LB)(C.lds + 64512); LB KHT = (LB)(C.lds + 73728); LB XB0 = (LB)(C.lds + 82944); LB XB1 = (LB)(C.lds + 101376); LB LPT2 = (LB)(C.lds + 119808); LF rho = (LF)(C.lds + 129024); LF lgl = rho + 64; \
    const int t = C.tid >> 3, g8 = C.tid & 7, n = C.lane & 31, hi = C.lane >> 5; \
    (void)RWW; (void)RWR; (void)RWK; (void)RWV; (void)RWKK; (void)RWB; (void)RWY; (void)LGs; (void)LP; (void)LPT; (void)AT; (void)LAK; (void)LP2; (void)RT; (void)BTl; (void)MRB; (void)KTl; (void)MRK; (void)VT; (void)BHT; (void)KHT; (void)XB0; (void)XB1; (void)LPT2; (void)rho; (void)lgl; (void)t; (void)g8; (void)n; (void)hi;
PH_FN void rwc_stage0(const Ctx C, int bc, int h) {
    RWC_PTRS
    const size_t row0 = (size_t)bc * 64; const size_t g = (row0 + t) * 512 + h * 64 + g8 * 8;
    WG_SYNC();
    float lw[8]; { const f32x4 x0 = *(const GAS f32x4*)(RWW + g), x1 = *(const GAS f32x4*)(RWW + g + 4); lw[0] = x0[0]; lw[1] = x0[1]; lw[2] = x0[2]; lw[3] = x0[3]; lw[4] = x1[0]; lw[5] = x1[1]; lw[6] = x1[2]; lw[7] = x1[3]; }
#pragma unroll
    for (int i = 0; i < 8; ++i) LGs[t * 68 + g8 * 8 + i] = lw[i];
    WG_SYNC();
    { const int seg = C.tid >> 6, k = C.tid & 63; float run = 0.f;
#pragma unroll
      for (int i = 0; i < 8; ++i) { run += LGs[(8 * seg + i) * 68 + k]; LGs[(8 * seg + i) * 68 + k] = run; }
      WG_SYNC();
      float off = 0.f;
#pragma unroll
      for (int sg = 0; sg < 7; ++sg) { const float tot = LGs[(8 * sg + 7) * 68 + k]; off += (sg < seg) ? tot : 0.f; }
      WG_SYNC();
#pragma unroll
      for (int i = 0; i < 8; ++i) LGs[(8 * seg + i) * 68 + k] += off; }
    WG_SYNC();
    {   float rf[8], kf[8], kkf[8], bf[8], lg[8], rh[8], ll[8], o1[8], o2[8], o3[8], o4[8];
        unpack8(*(const GAS u32x4*)(RWR + g), rf); unpack8(*(const GAS u32x4*)(RWK + g), kf); unpack8(*(const GAS u32x4*)(RWKK + g), kkf); unpack8(*(const GAS u32x4*)(RWB + g), bf);
#pragma unroll
        for (int i = 0; i < 8; ++i) { const int k = g8 * 8 + i; lg[i] = LGs[t * 68 + k]; rh[i] = LGs[31 * 68 + k]; ll[i] = LGs[63 * 68 + k]; }
#pragma unroll
        for (int i = 0; i < 8; ++i) { const int k = g8 * 8 + i; const float lm1 = lg[i] - lw[i];
            const float ed = __expf(lg[i] - rh[i]), edi = __expf(rh[i] - lg[i]), el = __expf(ll[i] - lg[i]);
            o1[i] = -kkf[i] * __expf(lm1 - rh[i]); o2[i] = rf[i] * ed; o3[i] = bf[i] * edi; o4[i] = kf[i] * edi;
            XB0[k * 72 + t] = (bf16)f2bf(-kkf[i] * __expf(lm1));
            BHT[k * 72 + t] = (bf16)f2bf(bf[i] * el); KHT[k * 72 + t] = (bf16)f2bf(kf[i] * el); }
        *(LAS u32x4*)(AT + t * 72 + g8 * 8) = pack8(o1); *(LAS u32x4*)(RT + t * 72 + g8 * 8) = pack8(o2); *(LAS u32x4*)(BTl + t * 72 + g8 * 8) = pack8(o3); *(LAS u32x4*)(KTl + t * 72 + g8 * 8) = pack8(o4);
        const u32x4 vv = *(const GAS u32x4*)(RWV + g); const unsigned vw[4] = {vv.x, vv.y, vv.z, vv.w};
#pragma unroll
        for (int i = 0; i < 4; ++i) { VT[(g8 * 8 + 2 * i) * 72 + t] = (bf16)(vw[i] & 0xffffu); VT[(g8 * 8 + 2 * i + 1) * 72 + t] = (bf16)(vw[i] >> 16); }
        if (t == 0) {
#pragma unroll
            for (int i = 0; i < 8; ++i) { rho[g8 * 8 + i] = rh[i]; lgl[g8 * 8 + i] = ll[i]; } }
    }
    WG_SYNC();
}
PH_FN void rwc_stage12(const Ctx C) {
    RWC_PTRS
    {   const int mt = C.wave >> 1, nt0 = 2 * (C.wave & 1);
        CLB Am = (mt < 2) ? (CLB)AT : (CLB)RT; const int m0 = 32 * (mt & 1);
        CLB Bm = (nt0 < 2) ? (CLB)BTl : (CLB)KTl;
        f32x16 c0 = zero16(), c1 = zero16();
        mma_nt<64>(c0, Am, 72, m0, Bm, 72, 0, C.lane); mma_nt<64>(c1, Am, 72, m0, Bm, 72, 32, C.lane);
        WG_SYNC();
#pragma unroll
        for (int r = 0; r < 16; ++r) { const int tt = m0 + crow(r, hi); const int j0 = n, j1 = 32 + n;
            if (mt < 2) { const bf16 x0 = (bf16)f2bf((j0 < tt) ? c0[r] : 0.f), x1 = (bf16)f2bf((j1 < tt) ? c1[r] : 0.f);
                if (nt0 < 2) { LP[tt * 72 + j0] = x0; LP[tt * 72 + j1] = x1; LPT[j0 * 72 + tt] = x0; LPT[j1 * 72 + tt] = x1; } else { LAK[tt * 72 + j0] = x0; LAK[tt * 72 + j1] = x1; } }
            else { const bf16 x0 = (bf16)f2bf((j0 <= tt) ? c0[r] : 0.f), x1 = (bf16)f2bf((j1 <= tt) ? c1[r] : 0.f);
                if (nt0 < 2) { MRB[tt * 72 + j0] = x0; MRB[tt * 72 + j1] = x1; } else { MRK[tt * 72 + j0] = x0; MRK[tt * 72 + j1] = x1; } } }
    }
    WG_SYNC();
    if (C.wave < 4) { const int vt = C.wave >> 1, tt0 = C.wave & 1; f32x16 c = zero16(); mma_nt<64>(c, VT, 72, 32 * vt, LAK, 72, 32 * tt0, C.lane);
#pragma unroll
        for (int r = 0; r < 16; ++r) XB0[(64 + 32 * vt + crow(r, hi)) * 72 + 32 * tt0 + n] = (bf16)f2bf(c[r]); }
    WG_SYNC();
}
#ifndef RWC_NSTEP
#define RWC_NSTEP 6
#endif
#ifndef RWC_REP0
#define RWC_REP0 1
#endif
PH_FN void rwc_solve(const Ctx C) {
    RWC_PTRS
    const int ct = C.wave >> 1, tt = C.wave & 1;
    const int sk = C.wave >> 2, st = (C.wave >> 1) & 1, sj = C.wave & 1;
#pragma unroll 1
    for (int i = 0; i < RWC_NSTEP; ++i) {
        CLB Pc = (i & 1) ? (CLB)LP2 : (CLB)LP; CLB PTc = (i & 1) ? (CLB)LPT2 : (CLB)LPT; LB Pn = (i & 1) ? LP : LP2; LB PTn = (i & 1) ? LPT : LPT2;
        CLB Xc = (i & 1) ? (CLB)XB1 : (CLB)XB0; LB Xn = (i & 1) ? XB0 : XB1;
        { f32x16 acc;
#pragma unroll
          for (int r = 0; r < 16; ++r) acc[r] = bf2f(Xc[(32 * ct + crow(r, hi)) * 72 + 32 * tt + n]);
          mma_nt<64>(acc, Xc, 72, 32 * ct, Pc, 72, 32 * tt, C.lane);
#pragma unroll
          for (int r = 0; r < 16; ++r) Xn[(32 * ct + crow(r, hi)) * 72 + 32 * tt + n] = (bf16)f2bf(acc[r]); }
        if (i < RWC_NSTEP - 1) { f32x16 acc = zero16();
          if (sk == 0) mma_nt<64>(acc, Pc, 72, 32 * st, PTc, 72, 32 * sj, C.lane); else mma_nt<64>(acc, PTc, 72, 32 * st, Pc, 72, 32 * sj, C.lane);
          LB dst = (sk == 0) ? Pn : PTn;
#pragma unroll
          for (int r = 0; r < 16; ++r) dst[(32 * st + crow(r, hi)) * 72 + 32 * sj + n] = (bf16)f2bf(acc[r]); }
        WG_SYNC();
    }
}
PH_FN void rwc_stage4(const Ctx C, int bc, int h) {
    RWC_PTRS
    const size_t row0 = (size_t)bc * 64; CLB A2T = (CLB)XB0; CLB WT = (CLB)(XB0 + 64 * 72);
    {   const int kind = C.wave >> 1, mt = C.wave & 1;
        f32x16 c0 = zero16(), c1 = zero16();
        if (kind == 0) { mma_nt<64>(c0, BHT, 72, 32 * mt, A2T, 72, 0, C.lane); mma_nt<64>(c1, BHT, 72, 32 * mt, A2T, 72, 32, C.lane); }
        else if (kind == 1) { mma_nt<64>(c0, BHT, 72, 32 * mt, WT, 72, 0, C.lane); mma_nt<64>(c1, BHT, 72, 32 * mt, WT, 72, 32, C.lane); mma_nt<64>(c0, KHT, 72, 32 * mt, VT, 72, 0, C.lane); mma_nt<64>(c1, KHT, 72, 32 * mt, VT, 72, 32, C.lane); }
        else if (kind == 2) { mma_nt<64>(c0, MRB, 72, 32 * mt, A2T, 72, 0, C.lane); mma_nt<64>(c1, MRB, 72, 32 * mt, A2T, 72, 32, C.lane); }
        else { mma_nt<64>(c0, MRB, 72, 32 * mt, WT, 72, 0, C.lane); mma_nt<64>(c1, MRB, 72, 32 * mt, WT, 72, 32, C.lane); mma_nt<64>(c0, MRK, 72, 32 * mt, VT, 72, 0, C.lane); mma_nt<64>(c1, MRK, 72, 32 * mt, VT, 72, 32, C.lane); }
#pragma unroll
        for (int r = 0; r < 16; ++r) { const int m = 32 * mt + crow(r, hi); const size_t go = (row0 + m) * 512 + h * 64;
            if (kind == 0) { const float d = __expf(lgl[m]); RWB[go + n] = (bf16)f2bf(c0[r] + ((n == m) ? d : 0.f)); RWB[go + 32 + n] = (bf16)f2bf(c1[r] + ((32 + n == m) ? d : 0.f)); }
            else if (kind == 1) { RWW[go + n] = c0[r]; RWW[go + 32 + n] = c1[r]; }
            else if (kind == 2) { RWKK[go + n] = (bf16)f2bf(c0[r] + bf2f(RT[m * 72 + n]) * __expf(rho[n])); RWKK[go + 32 + n] = (bf16)f2bf(c1[r] + bf2f(RT[m * 72 + 32 + n]) * __expf(rho[32 + n])); }
            else { RWY[go + n] = (bf16)f2bf(c0[r]); RWY[go + 32 + n] = (bf16)f2bf(c1[r]); } }
    }
}
__device__ __forceinline__ void ph_rw_chunk(const Ctx& C, int bc) {
#pragma unroll 1
    for (int h = 0; h < 8; ++h) { for (int r0 = 0; r0 < RWC_REP0; ++r0) rwc_stage0(C, bc, h); rwc_stage12(C); rwc_solve(C); rwc_stage4(C, bc, h); }
    WG_SYNC();
}
PH_FN void rw_scan_producer(const Ctx C, int chain) {
    const float* RWW = (const float*)(unsigned char*)(C.ws + WS_RWW); const bf16* RWKK = (const bf16*)(unsigned char*)(C.ws + WS_RWKK); const bf16* RWB = (const bf16*)(unsigned char*)(C.ws + WS_RWB); bf16* RWY = (bf16*)(unsigned char*)(C.ws + WS_RWY);
    const int b = chain >> 3, h = chain & 7; const size_t rowb = (size_t)b * SEQ;
    constexpr int BUFB = 45056, O_RQ = 0, O_PT = 9216, O_QT = 18432, O_Y0 = 35840;
    LAS unsigned char* L = C.lds;
        const int p = C.tid - 256, t = p >> 2, q4 = (p & 3) * 16;
        u32x4 Arq0, Arq1, Apt0, Apt1, Ay00, Ay01, Brq0, Brq1, Bpt0, Bpt1, By00, By01; f32x4 Aq0, Aq1, Aq2, Aq3, Bq0, Bq1, Bq2, Bq3;
#define SC_LOAD(S, c_) do { const size_t g_ = (rowb + (size_t)(c_) * 64 + t) * 512 + h * 64 + q4; \
            S##rq0 = *(const u32x4*)(RWKK + g_); S##rq1 = *(const u32x4*)(RWKK + g_ + 8); S##pt0 = *(const u32x4*)(RWB + g_); S##pt1 = *(const u32x4*)(RWB + g_ + 8); S##y00 = *(const u32x4*)(RWY + g_); S##y01 = *(const u32x4*)(RWY + g_ + 8); \
            S##q0 = *(const f32x4*)(RWW + g_); S##q1 = *(const f32x4*)(RWW + g_ + 4); S##q2 = *(const f32x4*)(RWW + g_ + 8); S##q3 = *(const f32x4*)(RWW + g_ + 12); } while (0)
#define SC_WRITE(S, Lb) do { \
            *(LAS u32x4*)((LB)((Lb) + O_RQ) + t * 72 + q4) = S##rq0; *(LAS u32x4*)((LB)((Lb) + O_RQ) + t * 72 + q4 + 8) = S##rq1; \
            *(LAS u32x4*)((LB)((Lb) + O_PT) + t * 72 + q4) = S##pt0; *(LAS u32x4*)((LB)((Lb) + O_PT) + t * 72 + q4 + 8) = S##pt1; \
            *(LAS u32x4*)((LB)((Lb) + O_Y0) + t * 72 + q4) = S##y00; *(LAS u32x4*)((LB)((Lb) + O_Y0) + t * 72 + q4 + 8) = S##y01; \
            { LF d_ = (LF)((Lb) + O_QT) + t * 68 + q4; *(LAS f32x4*)d_ = S##q0; *(LAS f32x4*)(d_ + 4) = S##q1; *(LAS f32x4*)(d_ + 8) = S##q2; *(LAS f32x4*)(d_ + 12) = S##q3; } } while (0)
        SC_LOAD(A, 0); SC_LOAD(B, 1);
        for (int c = 0; c < NCH; c += 2) {
            SC_WRITE(A, L); if (c + 2 < NCH) SC_LOAD(A, c + 2); RW_BAR();
            SC_WRITE(B, L + BUFB); if (c + 3 < NCH) SC_LOAD(B, c + 3); RW_BAR();
        }
        RW_BAR();
#undef SC_LOAD
#undef SC_WRITE
}
PH_FN void rw_scan_consumer(const Ctx C, int chain) {
    const float* RWW = (const float*)(unsigned char*)(C.ws + WS_RWW); const bf16* RWKK = (const bf16*)(unsigned char*)(C.ws + WS_RWKK); const bf16* RWB = (const bf16*)(unsigned char*)(C.ws + WS_RWB); bf16* RWY = (bf16*)(unsigned char*)(C.ws + WS_RWY);
    const int b = chain >> 3, h = chain & 7; const size_t rowb = (size_t)b * SEQ;
    constexpr int BUFB = 45056, O_RQ = 0, O_PT = 9216, O_QT = 18432, O_Y0 = 35840;
    LAS unsigned char* L = C.lds;
        const int n = C.lane & 31, hi = C.lane >> 5, vh = C.wave & 1;
        f32x16 st0 = zero16(), st1 = zero16();
        for (int c = 0; c < NCH; ++c) {
            RW_BAR();
            if (C.wave < 2) {
                const LAS unsigned char* Lb = L + (c & 1) * BUFB;
                CLB RQ = (CLB)(Lb + O_RQ); CLB PT = (CLB)(Lb + O_PT); CLF QT = (CLF)(Lb + O_QT); CLB Y0 = (CLB)(Lb + O_Y0);
                pg8::bf16x8 sb[4];
                { u32x4 w;
                  w.x = pk2(st0[0], st0[1]); w.y = pk2(st0[2], st0[3]); w.z = pk2(st0[4], st0[5]); w.w = pk2(st0[6], st0[7]); sb[0] = __builtin_bit_cast(pg8::bf16x8, w);
                  w.x = pk2(st0[8], st0[9]); w.y = pk2(st0[10], st0[11]); w.z = pk2(st0[12], st0[13]); w.w = pk2(st0[14], st0[15]); sb[1] = __builtin_bit_cast(pg8::bf16x8, w);
                  w.x = pk2(st1[0], st1[1]); w.y = pk2(st1[2], st1[3]); w.z = pk2(st1[4], st1[5]); w.w = pk2(st1[6], st1[7]); sb[2] = __builtin_bit_cast(pg8::bf16x8, w);
                  w.x = pk2(st1[8], st1[9]); w.y = pk2(st1[10], st1[11]); w.z = pk2(st1[12], st1[13]); w.w = pk2(st1[14], st1[15]); sb[3] = __builtin_bit_cast(pg8::bf16x8, w); }
#define SC_AFRAG(X_, row_, s_) ({ const u32x2 lo_ = *(const LAS u32x2*)((X_) + (row_) * 72 + 16 * (s_) + 4 * hi), hi_ = *(const LAS u32x2*)((X_) + (row_) * 72 + 16 * (s_) + 8 + 4 * hi); \
                    u32x4 w_; w_.x = lo_.x; w_.y = lo_.y; w_.z = hi_.x; w_.w = hi_.y; __builtin_bit_cast(pg8::bf16x8, w_); })
#pragma unroll
                for (int tt = 0; tt < 2; ++tt) { f32x16 y;
#pragma unroll
                    for (int r = 0; r < 16; ++r) y[r] = bf2f(Y0[(32 * tt + crow(r, hi)) * 72 + 32 * vh + n]);
#pragma unroll
                    for (int s = 0; s < 4; ++s) y = __builtin_amdgcn_mfma_f32_32x32x16_bf16(SC_AFRAG(RQ, 32 * tt + n, s), sb[s], y, 0, 0, 0);
                    bf16* yo = RWY + (rowb + (size_t)c * 64 + 32 * tt) * 512 + h * 64 + 32 * vh + n;
#pragma unroll
                    for (int r = 0; r < 16; ++r) yo[(size_t)crow(r, hi) * 512] = (bf16)f2bf(y[r]); }
                f32x16 n0, n1;
#pragma unroll
                for (int r = 0; r < 16; ++r) { n0[r] = QT[crow(r, hi) * 68 + 32 * vh + n]; n1[r] = QT[(32 + crow(r, hi)) * 68 + 32 * vh + n]; }
#pragma unroll
                for (int s = 0; s < 4; ++s) { n0 = __builtin_amdgcn_mfma_f32_32x32x16_bf16(SC_AFRAG(PT, n, s), sb[s], n0, 0, 0, 0); n1 = __builtin_amdgcn_mfma_f32_32x32x16_bf16(SC_AFRAG(PT, 32 + n, s), sb[s], n1, 0, 0, 0); }
                st0 = n0; st1 = n1;
#undef SC_AFRAG
            }
        }
        RW_BAR();
}
__device__ __forceinline__ void rw_scan_unit(const Ctx& C, int chain) { if (C.wave >= 4) rw_scan_producer(C, chain); else rw_scan_consumer(C, chain); }
#ifndef REP_ATTN
#define REP_ATTN 1
#endif
#ifndef REP_W
#define REP_W 1
#endif
#ifndef REP_RWC
#define REP_RWC 1
#endif
#ifndef REP_MA
#define REP_MA 1
#endif
#ifndef REP_GLAA
#define REP_GLAA 1
#endif
#ifndef REP_SSDA
#define REP_SSDA 1
#endif
#ifndef REP_RWP
#define REP_RWP 1
#endif
#ifndef REP_GLAC
#define REP_GLAC 1
#endif
#ifndef REP_SSDC
#define REP_SSDC 1
#endif
#ifndef REP_RWO
#define REP_RWO 1
#endif
#ifndef REP_MAFULL
#define REP_MAFULL 1
#endif
#ifndef REP_SCANS
#define REP_SCANS 1
#endif
#ifndef REP_MC
#define REP_MC 1
#endif
#ifndef REP_GEMM
#define REP_GEMM 1
#endif
constexpr int NPH = 12, G_FINAL = 1 + NL * NPH, G_END = G_FINAL + 1;
template <int GRP>
__global__ void __launch_bounds__(NTHR, 2) hybrid_fwd(Args args) {
    constexpr bool ALL = (GRP < 0);
    constexpr bool EN_G1 = ALL || GRP == 0, EN_G2 = EN_G1, EN_G3 = EN_G1, EN_G7 = EN_G1, EN_G8 = EN_G1, EN_G9 = EN_G1;
    constexpr bool EN_PRO = ALL || GRP == 1, EN_W = EN_PRO, EN_FIN = EN_PRO, EN_MA1 = EN_PRO, EN_MA2 = EN_PRO, EN_MA3 = EN_PRO, EN_MA4 = EN_PRO;
    constexpr bool EN_MB1 = ALL || GRP == 2, EN_MB2 = EN_MB1;
    constexpr bool EN_MC1 = ALL || GRP == 3, EN_MC2 = EN_MC1, EN_MC3 = EN_MC1;
    extern __shared__ __attribute__((aligned(16))) unsigned char lds[];
    Ctx C; C.lds = (LAS unsigned char*)lds; C.ws = (GAS unsigned char*)args.ws; C.h = (GAS float*)args.out; C.tid = threadIdx.x; C.lane = C.tid & 63; C.wave = __builtin_amdgcn_readfirstlane(C.tid >> 6); C.bid = blockIdx.x; C.G = gridDim.x;
    LAS unsigned char* ldsl = (LAS unsigned char*)lds;
    const ArgsP ap = (ArgsP)__builtin_amdgcn_kernarg_segment_ptr();
    for (int u = C.tid; u < (LDS_BYTES - LDSCTL_OFF) / 4; u += NTHR) ((LAS unsigned*)(ldsl + LDSCTL_OFF))[u] = 0u;
    __syncthreads();
    volatile LAS unsigned* MISC = (volatile LAS unsigned*)(ldsl + MISC_OFF);
    gu32* ctl = (gu32*)(args.ws + WS_CTL);
    const int g_lo = args.g_lo, g_hi = args.g_hi;
    XcdBarrier bar; bar.bar = (unsigned*)(ctl + CW_BAR); bar.x = 0; bar.st = nullptr;
    if (g_hi - g_lo > 1) bar = xcd_barrier_post((unsigned*)(ctl + CW_BAR), MISC + 8);
#define IN(g) (g_lo <= (g) && (g) < g_hi)
#define SEAM(g) do { if (IN(g) && IN((g) + 1)) xcd_barrier(bar); } while (0)
    bf16* HB = (bf16*)(args.ws + WS_HB); float* SSQ = (float*)(args.ws + WS_SSQ);

    if (IN(0)) { if (EN_PRO) ph_prologue(fresh(C), ap); if (EN_W) ph_weights(fresh(C), ap, 0); }
    SEAM(0);
#pragma unroll 1
    for (int l = 0; l < NL; ++l) {
        const int gb = 1 + NPH * l;
        if (EN_W && IN(gb + 0) && l > 0) { for (int rep = 0; rep < REP_W; ++rep) ph_weights(fresh(C), ap, l); }
        if (l > 0) SEAM(gb + 0);
#pragma unroll 1
        for (int f = 0; f < 2; ++f) {
            const int gu = gb + (f ? 10 : 1);
            if (EN_G1 && IN(gu)) {
                pg8::Gemm g{HB, (const bf16*)(args.ws + (f ? WS_WGU2 : WS_WGU1)), M, 2 * FF, D, D}; pg8::StaticOrder S; S.init(M, 2 * FF, C.G, C.bid);
                pg8::EpiSwiglu E{(bf16*)(args.ws + WS_ACT), FF, SSQ, M};
                pg8::gemm_phase<pg8::EpiSwiglu, pg8::StaticOrder, true, true>(ldsl, g, S, E);
            }
            SEAM(gu);
            if (EN_G2 && IN(gu + 1)) {
                pg8::Gemm g{(const bf16*)(args.ws + WS_ACT), (const bf16*)(args.ws + (f ? WS_WD2 : WS_WD1)), M, D, FF, FF}; pg8::StaticOrder S; S.init(M, D, C.G, C.bid);
                pg8::EpiResid E{HB, SSQ, M, 0.5f};
                pg8::gemm_phase<pg8::EpiResid, pg8::StaticOrder, false, true>(ldsl, g, S, E);
            }
            SEAM(gu + 1);
            if (f == 0) {
                if (EN_G3 && IN(gb + 3)) {
                    pg8::Gemm g{HB, (const bf16*)(args.ws + WS_WIN), M, NPM, D, D}; pg8::StaticOrder S; S.init(M, NPM, C.G, C.bid);
                    pg8::EpiScaleBf16 E{(bf16*)(args.ws + WS_P), NPM, SSQ, M};
                    pg8::gemm_phase<pg8::EpiScaleBf16, pg8::StaticOrder, true, true>(ldsl, g, S, E);
                }
                SEAM(gb + 3);
                if (IN(gb + 4)) { if (EN_MA1) ph_da_prep(fresh(C)); for (int rf = 0; rf < REP_MAFULL; ++rf) { for (int rep = 0; rep < REP_MA; ++rep) { for (int r2 = 0; r2 < REP_GLAA; ++r2) if (EN_MA2) ph_gla_a(fresh(C), ap, l); for (int r2 = 0; r2 < REP_SSDA; ++r2) if (EN_MA3) ph_ssd_a(fresh(C), ap, l); for (int r2 = 0; r2 < REP_RWP; ++r2) if (EN_MA4) ph_rw_prep(fresh(C), ap, l); } if (EN_MA4 && RW_CHUNKED) ph_rw_chunk(fresh(C), C.bid); } }
                SEAM(gb + 4);
                if (IN(gb + 5)) {
#if RW_CHUNKED
#define MB_SCANS() do { if (EN_MB2) { if (C.bid < 16) rw_scan_unit(fresh(C), C.bid); else { for (int p = C.bid - 16; p < 192; p += C.G - 16) { if (p < 64) gla_scan_part(fresh(C), p); else ssd_scan_part(fresh(C), p - 64); } } } } while (0)
                    MB_SCANS();
                    for (int rs = 1; rs < REP_SCANS; ++rs) {
                        xcd_barrier(bar); if (EN_MA2) ph_gla_a(fresh(C), ap, l); if (EN_MA3) ph_ssd_a(fresh(C), ap, l); if (EN_MA4) { ph_rw_prep(fresh(C), ap, l); ph_rw_chunk(fresh(C), C.bid); } xcd_barrier(bar); MB_SCANS(); }
                    if (C.bid >= 16) { const int a = C.bid - 16; for (int rep = 0; rep < REP_ATTN; ++rep) if (EN_MB1) ph_da_attn(fresh(C), args, l, a & 7, a >> 3); }
#else
                    if (C.bid < 64) { if (EN_MB2) { const int xcd = C.bid & 7, slot = C.bid >> 3; for (int rep = 0; rep < REP_RWC; ++rep) rw_unit(fresh(C), xcd * 2 + (slot >> 2), slot & 3); } }
                    else { const int a = C.bid - 64;
                        if (EN_MB2) { for (int p = a; p < 192; p += 192) { if (p < 64) gla_scan_part(fresh(C), p); else ssd_scan_part(fresh(C), p - 64); } }
                        for (int rep = 0; rep < REP_ATTN; ++rep) if (EN_MB1) ph_da_attn(fresh(C), args, l, a & 7, a >> 3); }
#endif
                }
                SEAM(gb + 5);
                if (IN(gb + 6)) { for (int rep = 0; rep < REP_MC; ++rep) { for (int r2 = 0; r2 < REP_GLAC; ++r2) if (EN_MC1) ph_gla_c(fresh(C), ap, l); for (int r2 = 0; r2 < REP_SSDC; ++r2) if (EN_MC2) ph_ssd_c(fresh(C), ap, l); for (int r2 = 0; r2 < REP_RWO; ++r2) if (EN_MC3) ph_rw_out(fresh(C), ap, l); } }
                SEAM(gb + 6);
                if (EN_G7 && IN(gb + 7)) {
                    pg8::Gemm g{HB, (const bf16*)(args.ws + WS_WIN) + (size_t)NPM * D, M, 4096, D, D}; pg8::StaticOrder S; S.init(M, 4096, C.G, C.bid);
                    pg8::EpiScaleBf16 E{(bf16*)(args.ws + WS_PG), 4096, SSQ, M};
                    pg8::gemm_phase<pg8::EpiScaleBf16, pg8::StaticOrder, true, true>(ldsl, g, S, E);
                }
                SEAM(gb + 7);
                if (EN_G8 && IN(gb + 8)) {
                    pg8::Gemm g{(const bf16*)(args.ws + WS_YS), (const bf16*)(args.ws + WS_WB), M, D, 2048, 2048}; pg8::StaticOrder S; S.init(M, D, C.G, C.bid);
                    pg8::EpiGateHorner E{(bf16*)(args.ws + WS_MERGED), (const bf16*)(args.ws + WS_PG), args.in[33] + (size_t)l * 4096};
                    pg8::gemm_phase<pg8::EpiGateHorner, pg8::StaticOrder, true, true>(ldsl, g, S, E);
                }
                SEAM(gb + 8);
                if (EN_G9 && IN(gb + 9)) {
                    pg8::Gemm g{(const bf16*)(args.ws + WS_MERGED), (const bf16*)(args.ws + WS_WO), M, D, D, D}; pg8::StaticOrder S; S.init(M, D, C.G, C.bid);
                    pg8::EpiResid E{HB, SSQ, M, 1.0f};
                    pg8::gemm_phase<pg8::EpiResid, pg8::StaticOrder, false, true>(ldsl, g, S, E);
                }
                SEAM(gb + 9);
            }
        }
    }
    if (EN_FIN && IN(G_FINAL)) ph_final(fresh(C), ap);
#undef IN
#undef SEAM
}

#ifndef ONE_LAUNCH
#define ONE_LAUNCH 1
#endif
extern "C" void kernel_launch(void* const* d_in, const int* in_sizes, int n_in, void* d_out, int out_size, void* d_ws, size_t ws_size, hipStream_t stream) {
    static int grid = 0;
    if (grid == 0) {
        if (n_in != 40 || in_sizes[0] != M * D || out_size != M * D || ws_size < WS_END) { fprintf(stderr, "kernel_launch: unexpected shapes (n_in %d, in0 %d, out %d, ws %zu < %zu); nothing launched\n", n_in, n_in > 0 ? in_sizes[0] : -1, out_size, ws_size, (size_t)WS_END); grid = -1; return; }
        int dev = 0, cus = 0, per_cu = 0;
        if (hipGetDevice(&dev) != hipSuccess || hipDeviceGetAttribute(&cus, hipDeviceAttributeMultiprocessorCount, dev) != hipSuccess) { grid = -1; return; }
#if ONE_LAUNCH
        if (hipFuncSetAttribute((const void*)hybrid_fwd<-1>, hipFuncAttributeMaxDynamicSharedMemorySize, LDS_BYTES) != hipSuccess) { fprintf(stderr, "kernel_launch: hipFuncSetAttribute failed\n"); grid = -1; return; }
#else
        if (hipFuncSetAttribute((const void*)hybrid_fwd<0>, hipFuncAttributeMaxDynamicSharedMemorySize, LDS_BYTES) != hipSuccess || hipFuncSetAttribute((const void*)hybrid_fwd<1>, hipFuncAttributeMaxDynamicSharedMemorySize, LDS_BYTES) != hipSuccess ||
            hipFuncSetAttribute((const void*)hybrid_fwd<2>, hipFuncAttributeMaxDynamicSharedMemorySize, LDS_BYTES) != hipSuccess || hipFuncSetAttribute((const void*)hybrid_fwd<3>, hipFuncAttributeMaxDynamicSharedMemorySize, LDS_BYTES) != hipSuccess) { fprintf(stderr, "kernel_launch: hipFuncSetAttribute failed\n"); grid = -1; return; }
#endif
        if (hipOccupancyMaxActiveBlocksPerMultiprocessor(&per_cu, (const void*)hybrid_fwd<(ONE_LAUNCH ? -1 : 0)>, NTHR, LDS_BYTES) != hipSuccess || per_cu < 1) fprintf(stderr, "kernel_launch: occupancy query reports %d workgroups per CU\n", per_cu);
        (void)hipGetLastError();
        grid = cus;
        if (grid != 256) { fprintf(stderr, "kernel_launch: %d CUs; this kernel is laid out for 256 workgroups; nothing launched\n", grid); grid = -1; return; }
    }
    if (grid < 0) return;
    if (hipMemsetAsync((char*)d_ws + WS_CTL, 0, CTL_ZERO_BYTES, stream) != hipSuccess) return;
    Args a{};
    for (int i = 0; i < 40; ++i) a.in[i] = (const float*)d_in[i];
    a.out = (float*)d_out; a.ws = (unsigned char*)d_ws;
    for (int j = 0; j < 32; ++j) a.inv_freq[j] = (float)pow(10000.0, -(double)j / 32.0);
#if ONE_LAUNCH
    a.g_lo = 0; a.g_hi = G_END;
    hipLaunchKernelGGL(hybrid_fwd<-1>, dim3(grid), dim3(NTHR), LDS_BYTES, stream, a);
#else
    for (int g = 0; g < G_END; ++g) {
        a.g_lo = g; a.g_hi = g + 1;
        int grp = 1;
        if (g >= 1 && g < G_FINAL) { const int k = (g - 1) % NPH; grp = (k == 0 || k == 4) ? 1 : (k == 5) ? 2 : (k == 6) ? 3 : 0; }
        if (grp == 0) hipLaunchKernelGGL(hybrid_fwd<0>, dim3(grid), dim3(NTHR), LDS_BYTES, stream, a);
        else if (grp == 1) hipLaunchKernelGGL(hybrid_fwd<1>, dim3(grid), dim3(NTHR), LDS_BYTES, stream, a);
        else if (grp == 2) hipLaunchKernelGGL(hybrid_fwd<2>, dim3(grid), dim3(NTHR), LDS_BYTES, stream, a);
        else hipLaunchKernelGGL(hybrid_fwd<3>, dim3(grid), dim3(NTHR), LDS_BYTES, stream, a);
    }
#endif
}
```

```cpp
#include <hip/hip_runtime.h>
#include <cstdio>
#include <cstdint>
#include <cmath>

namespace pg8 {
#define PG8_LAS __attribute__((address_space(3)))
typedef unsigned short bf16_t;
typedef short bf16x8 __attribute__((ext_vector_type(8)));
typedef float f32x4 __attribute__((ext_vector_type(4)));
typedef unsigned u32x4 __attribute__((ext_vector_type(4)));
constexpr int BM = 256, BK = 64, HALF = 128, HTB = HALF * BK * 2  , STAGE_BYTES = 8 * HTB, NXCD = 8, WGM = 8;

__host__ __device__ __forceinline__ int lds_byte(int r, int c) { const int st = (r >> 4) * 2 + (c >> 5), rr = r & 15, cc = c & 31, ob = rr * 64 + cc * 2; return st * 1024 + (ob ^ (((ob >> 9) & 1) << 5)); }
__host__ __device__ __forceinline__ void stage_rc(int b, int& R, int& C) { const int st = b / 1024, sb = b % 1024, swz = sb ^ (((sb >> 9) & 1) << 5); R = (st >> 1) * 16 + swz / 64; C = (st & 1) * 32 + (swz % 64) / 2; }
__host__ __device__ __forceinline__ int perm32(int rho) { const int n = rho >> 4, i = rho & 15; return 8 * (i >> 2) + 4 * n + (i & 3); }

struct Unit { int pm, pn, z; };
struct Gemm { const bf16_t* A; const bf16_t* Bt; int M, N, K, lda; };

struct StaticOrder {
    int nM, nN, nwg, G, c;
    __host__ __device__ void init(int M, int N, int G_, int c_) { nM = M / BM; nN = N / BM; nwg = nM * nN; G = G_; c = c_; }
    __host__ __device__ bool next(int i, Unit& u) const {
        const long L = (long)i * G + c; if (L >= nwg) return false;
        int wgid = (int)L; { const int q = nwg / NXCD, r = nwg % NXCD, xcd = wgid % NXCD, off = wgid / NXCD; wgid = (xcd < r ? xcd * (q + 1) : r * (q + 1) + (xcd - r) * q) + off; }
        const int nig = WGM * nN, gid = wgid / nig, fm = gid * WGM, gsz = (nM - fm) < WGM ? (nM - fm) : WGM;
        u.pm = fm + ((wgid % nig) % gsz); u.pn = (wgid % nig) / gsz; u.z = 0; return true;
    }
    __device__ __forceinline__ void a_ready(const Unit&) const {}
    __device__ __forceinline__ void done(const Unit&) const {}
    __device__ __forceinline__ size_t a_off(const Unit&) const { return 0; }
    __device__ __forceinline__ int b_tile(const Unit& u) const { return u.pn; }
};
struct GroupedOrder {
    StaticOrder base; int NZ, Kbytes, tiles_per_group;
    __device__ void init(int M, int N, int NZ_, int K, int G_, int c_) { base.init(M, N, G_, c_); NZ = NZ_; Kbytes = K * 2; tiles_per_group = N / BM; }
    __device__ bool next(int i, Unit& u) const { const int r = i / NZ, z = i - r * NZ; if (!base.next(r, u)) return false; u.z = z; return true; }
    __device__ __forceinline__ void a_ready(const Unit&) const {}
    __device__ __forceinline__ void done(const Unit&) const {}
    __device__ __forceinline__ size_t a_off(const Unit& u) const { return (size_t)u.z * Kbytes; }
    __device__ __forceinline__ int b_tile(const Unit& u) const { return u.z * tiles_per_group + u.pn; }
};

__device__ __forceinline__ unsigned cvt_pk_bf16(float lo, float hi) { unsigned r; asm volatile("v_cvt_pk_bf16_f32 %0, %1, %2" : "=v"(r) : "v"(lo), "v"(hi)); return r; }
__device__ __forceinline__ float bf_lo(unsigned w) { return __uint_as_float(w << 16); }
__device__ __forceinline__ float bf_hi(unsigned w) { return __uint_as_float(w & 0xffff0000u); }
__device__ __forceinline__ float fast_sigmoid(float x) { return __builtin_amdgcn_rcpf(1.0f + __builtin_amdgcn_exp2f(-1.4426950408889634f * x)); }

__device__ __forceinline__ float row_rstd(const float* ssq, int row, int M_) {
    const float s = (ssq[row] + ssq[M_ + row]) + (ssq[2 * M_ + row] + ssq[3 * M_ + row]);
    return 1.0f / sqrtf(s * (1.0f / 1024.0f) + 1e-6f);
}
struct EpiScaleBf16 {
    static constexpr bool PERM = true, AFTER_DRAIN = false; static constexpr int SEG_TILES = 0;
    bf16_t* O; int ldc; const float* ssq; int M_;
    __device__ __forceinline__ void operator()(const f32x4 (&acc)[2][2][4][2], const Unit& u, int wr, int wc, int fr, int fq) const {
        const int row0 = u.pm * BM + wr * 64 + fr; const int col0 = u.pn * BM + wc * 32 + 8 * fq;
#pragma unroll
        for (int ai = 0; ai < 2; ++ai)
#pragma unroll
            for (int m = 0; m < 4; ++m) { const int row = row0 + ai * HALF + m * 16; const float rs = row_rstd(ssq, row, M_); bf16_t* rowp = O + (size_t)row * ldc + col0;
#pragma unroll
                for (int bj = 0; bj < 2; ++bj) { const f32x4 v0 = acc[ai][bj][m][0] * rs, v1 = acc[ai][bj][m][1] * rs;
                    u32x4 w; w.x = cvt_pk_bf16(v0[0], v0[1]); w.y = cvt_pk_bf16(v0[2], v0[3]); w.z = cvt_pk_bf16(v1[0], v1[1]); w.w = cvt_pk_bf16(v1[2], v1[3]);
                    *(u32x4*)(rowp + bj * HALF) = w; } }
    }
};
struct EpiSwiglu {
    static constexpr bool PERM = true, AFTER_DRAIN = false; static constexpr int SEG_TILES = 0;
    bf16_t* O; int ldc; const float* ssq; int M_;
    __device__ __forceinline__ void operator()(const f32x4 (&acc)[2][2][4][2], const Unit& u, int wr, int wc, int fr, int fq) const {
        const int row0 = u.pm * BM + wr * 64 + fr; const int col0 = u.pn * HALF + wc * 32 + 8 * fq;
#pragma unroll
        for (int ai = 0; ai < 2; ++ai)
#pragma unroll
            for (int m = 0; m < 4; ++m) { const int row = row0 + ai * HALF + m * 16; const float rs = row_rstd(ssq, row, M_); bf16_t* rowp = O + (size_t)row * ldc + col0;
                float o[8];
#pragma unroll
                for (int n = 0; n < 2; ++n)
#pragma unroll
                    for (int i = 0; i < 4; ++i) { const float g = acc[ai][0][m][n][i] * rs, up = acc[ai][1][m][n][i] * rs; o[n * 4 + i] = g * fast_sigmoid(g) * up; }
                u32x4 w; w.x = cvt_pk_bf16(o[0], o[1]); w.y = cvt_pk_bf16(o[2], o[3]); w.z = cvt_pk_bf16(o[4], o[5]); w.w = cvt_pk_bf16(o[6], o[7]);
                *(u32x4*)rowp = w; }
    }
};
struct EpiGateAcc {
    static constexpr bool PERM = true, AFTER_DRAIN = false; static constexpr int SEG_TILES = 0;
    bf16_t* O; const bf16_t* PG; const float* gb;
    __device__ __forceinline__ void operator()(const f32x4 (&acc)[2][2][4][2], const Unit& u, int wr, int wc, int fr, int fq) const {
        const int row0 = u.pm * BM + wr * 64 + fr; const int col0 = u.pn * BM + wc * 32 + 8 * fq; const int z = u.z;
        f32x4 gbv[2][2];
#pragma unroll
        for (int bj = 0; bj < 2; ++bj)
#pragma unroll
            for (int n = 0; n < 2; ++n) gbv[bj][n] = *(const f32x4*)(gb + z * 1024 + col0 + bj * HALF + 4 * n);
#pragma unroll
        for (int ai = 0; ai < 2; ++ai)
#pragma unroll
            for (int m = 0; m < 4; ++m) { const int row = row0 + ai * HALF + m * 16;
#pragma unroll
                for (int bj = 0; bj < 2; ++bj) {
                    const u32x4 pg = *(const u32x4*)(PG + (size_t)row * 4096 + z * 1024 + col0 + bj * HALF);
                    bf16_t* op = O + (size_t)row * 1024 + col0 + bj * HALF;
                    float o[8];
                    o[0] = fast_sigmoid(bf_lo(pg.x) + gbv[bj][0][0]) * acc[ai][bj][m][0][0]; o[1] = fast_sigmoid(bf_hi(pg.x) + gbv[bj][0][1]) * acc[ai][bj][m][0][1];
                    o[2] = fast_sigmoid(bf_lo(pg.y) + gbv[bj][0][2]) * acc[ai][bj][m][0][2]; o[3] = fast_sigmoid(bf_hi(pg.y) + gbv[bj][0][3]) * acc[ai][bj][m][0][3];
                    o[4] = fast_sigmoid(bf_lo(pg.z) + gbv[bj][1][0]) * acc[ai][bj][m][1][0]; o[5] = fast_sigmoid(bf_hi(pg.z) + gbv[bj][1][1]) * acc[ai][bj][m][1][1];
                    o[6] = fast_sigmoid(bf_lo(pg.w) + gbv[bj][1][2]) * acc[ai][bj][m][1][2]; o[7] = fast_sigmoid(bf_hi(pg.w) + gbv[bj][1][3]) * acc[ai][bj][m][1][3];
                    if (z > 0) { const u32x4 pv = *(const u32x4*)op;
                        o[0] += bf_lo(pv.x); o[1] += bf_hi(pv.x); o[2] += bf_lo(pv.y); o[3] += bf_hi(pv.y); o[4] += bf_lo(pv.z); o[5] += bf_hi(pv.z); o[6] += bf_lo(pv.w); o[7] += bf_hi(pv.w); }
                    u32x4 w; w.x = cvt_pk_bf16(o[0], o[1]); w.y = cvt_pk_bf16(o[2], o[3]); w.z = cvt_pk_bf16(o[4], o[5]); w.w = cvt_pk_bf16(o[6], o[7]);
                    *(u32x4*)op = w; } }
    }
};
struct EpiGateHorner {
    static constexpr bool PERM = true, AFTER_DRAIN = false; static constexpr int SEG_TILES = 8;
    bf16_t* O; const bf16_t* PG; const float* gb;
    __device__ __forceinline__ void em8(const bf16_t* pgp, const float* gbp, float* e) const {
        const u32x4 pg = *(const u32x4*)pgp; const f32x4 b0 = *(const f32x4*)gbp, b1 = *(const f32x4*)(gbp + 4);
        e[0] = __builtin_amdgcn_exp2f(-1.4426950408889634f * (bf_lo(pg.x) + b0[0])); e[1] = __builtin_amdgcn_exp2f(-1.4426950408889634f * (bf_hi(pg.x) + b0[1]));
        e[2] = __builtin_amdgcn_exp2f(-1.4426950408889634f * (bf_lo(pg.y) + b0[2])); e[3] = __builtin_amdgcn_exp2f(-1.4426950408889634f * (bf_hi(pg.y) + b0[3]));
        e[4] = __builtin_amdgcn_exp2f(-1.4426950408889634f * (bf_lo(pg.z) + b1[0])); e[5] = __builtin_amdgcn_exp2f(-1.4426950408889634f * (bf_hi(pg.z) + b1[1]));
        e[6] = __builtin_amdgcn_exp2f(-1.4426950408889634f * (bf_lo(pg.w) + b1[2])); e[7] = __builtin_amdgcn_exp2f(-1.4426950408889634f * (bf_hi(pg.w) + b1[3]));
    }
    __device__ __forceinline__ void seg(f32x4 (&acc)[2][2][4][2], const Unit& u, int z, int wr, int wc, int fr, int fq) const {
        const int row0 = u.pm * BM + wr * 64 + fr; const int col0 = u.pn * BM + wc * 32 + 8 * fq;
#pragma unroll
        for (int ai = 0; ai < 2; ++ai)
#pragma unroll
            for (int m = 0; m < 4; ++m) { const int row = row0 + ai * HALF + m * 16;
#pragma unroll
                for (int bj = 0; bj < 2; ++bj) { const int c = col0 + bj * HALF; float ea[8], eb[8];
                    em8(PG + (size_t)row * 4096 + z * 1024 + c, gb + z * 1024 + c, ea); em8(PG + (size_t)row * 4096 + (z + 1) * 1024 + c, gb + (z + 1) * 1024 + c, eb);
#pragma unroll
                    for (int i = 0; i < 4; ++i) { acc[ai][bj][m][0][i] *= (1.0f + eb[i]) * __builtin_amdgcn_rcpf(1.0f + ea[i]); acc[ai][bj][m][1][i] *= (1.0f + eb[4 + i]) * __builtin_amdgcn_rcpf(1.0f + ea[4 + i]); } }
                if (m & 1) asm volatile("" ::: "memory"); }
    }
    __device__ __forceinline__ void operator()(const f32x4 (&acc)[2][2][4][2], const Unit& u, int wr, int wc, int fr, int fq) const {
        const int row0 = u.pm * BM + wr * 64 + fr; const int col0 = u.pn * BM + wc * 32 + 8 * fq;
#pragma unroll
        for (int ai = 0; ai < 2; ++ai)
#pragma unroll
            for (int m = 0; m < 4; ++m) { const int row = row0 + ai * HALF + m * 16;
#pragma unroll
                for (int bj = 0; bj < 2; ++bj) { const int c = col0 + bj * HALF; float e[8], o[8];
                    em8(PG + (size_t)row * 4096 + 3 * 1024 + c, gb + 3 * 1024 + c, e);
#pragma unroll
                    for (int i = 0; i < 4; ++i) { o[i] = acc[ai][bj][m][0][i] * __builtin_amdgcn_rcpf(1.0f + e[i]); o[4 + i] = acc[ai][bj][m][1][i] * __builtin_amdgcn_rcpf(1.0f + e[4 + i]); }
                    u32x4 w; w.x = cvt_pk_bf16(o[0], o[1]); w.y = cvt_pk_bf16(o[2], o[3]); w.z = cvt_pk_bf16(o[4], o[5]); w.w = cvt_pk_bf16(o[6], o[7]);
                    *(u32x4*)(O + (size_t)row * 1024 + c) = w; } }
    }
};
struct EpiResid {
    static constexpr bool PERM = true, AFTER_DRAIN = true; static constexpr int SEG_TILES = 0;
    bf16_t* HB; float* ssq; int M_; float s;
    __device__ __forceinline__ void fused(f32x4 (&acc)[2][2][4][2], const Unit& u, int wr, int wc, int fr, int fq, PG8_LAS unsigned char* lds, int wid, int lane) const {
        PG8_LAS float* P = (PG8_LAS float*)lds;
        const int row0 = u.pm * BM + wr * 64 + fr; const int col0 = u.pn * BM + wc * 32 + 8 * fq;
#pragma unroll
        for (int ai = 0; ai < 2; ++ai)
#pragma unroll
            for (int m = 0; m < 4; ++m) { const int row = row0 + ai * HALF + m * 16; float q = 0.f;
#pragma unroll
                for (int bj = 0; bj < 2; ++bj) { bf16_t* hp = HB + (size_t)row * 1024 + col0 + bj * HALF; const u32x4 hw = *(const u32x4*)hp;
                    const f32x4 h0 = (f32x4){bf_lo(hw.x), bf_hi(hw.x), bf_lo(hw.y), bf_hi(hw.y)} + acc[ai][bj][m][0] * s, h1 = (f32x4){bf_lo(hw.z), bf_hi(hw.z), bf_lo(hw.w), bf_hi(hw.w)} + acc[ai][bj][m][1] * s;
                    q += (h0[0] * h0[0] + h0[1] * h0[1]) + (h0[2] * h0[2] + h0[3] * h0[3]) + (h1[0] * h1[0] + h1[1] * h1[1]) + (h1[2] * h1[2] + h1[3] * h1[3]);
                    u32x4 w; w.x = cvt_pk_bf16(h0[0], h0[1]); w.y = cvt_pk_bf16(h0[2], h0[3]); w.z = cvt_pk_bf16(h1[0], h1[1]); w.w = cvt_pk_bf16(h1[2], h1[3]);
                    *(u32x4*)hp = w; }
                q += __shfl_xor(q, 16); q += __shfl_xor(q, 32);
                if (fq == 0) P[(ai * HALF + wr * 64 + m * 16 + fr) * 4 + wc] = q; }
        asm volatile("s_waitcnt lgkmcnt(0)" ::: "memory"); __builtin_amdgcn_s_barrier(); asm volatile("" ::: "memory");
        const int t = wid * 64 + lane;
        if (t < 256) { const float q = (P[t * 4 + 0] + P[t * 4 + 1]) + (P[t * 4 + 2] + P[t * 4 + 3]); ssq[(size_t)u.pn * M_ + u.pm * BM + t] = q; }
        asm volatile("s_waitcnt lgkmcnt(0)" ::: "memory"); __builtin_amdgcn_s_barrier(); asm volatile("" ::: "memory");
    }
};
template <class Epi, class Sched, bool ALIGN_EPI = false, bool SP2 = false>
__device__ __forceinline__ void gemm_phase(PG8_LAS unsigned char* lds, const Gemm g, const Sched& S, const Epi& E) {
    int tid_ = threadIdx.x; asm volatile("" : "+v"(tid_)); const int tid = tid_, wid = __builtin_amdgcn_readfirstlane(tid >> 6), lane = tid & 63, wr = wid >> 2, wc = wid & 3, fr = lane & 15, fq = lane >> 4;
    const int K = g.K, nt = K / BK;
    unsigned voffA[2], voffB[2];
#pragma unroll
    for (int i = 0; i < 2; ++i) { int R, C; stage_rc(tid * 16 + i * 8192, R, C); const int Rb = Epi::PERM ? ((R & ~31) + perm32(R & 31)) : R;
        voffA[i] = (unsigned)(R * g.lda + C) * 2u; voffB[i] = (unsigned)(Rb * K + C) * 2u; }
    const size_t kstep = (size_t)(BK * 2);
    const size_t hstep = (size_t)HALF * K * 2;
    const size_t tstep = 2 * hstep; const size_t hstepA = (size_t)HALF * g.lda * 2, tstepA = 2 * hstepA;
    const unsigned ldsw = (unsigned)wid * 1024u;
    const int aoff = lds_byte(wr * 64 + fr, fq * 8), boff = lds_byte(wc * 32 + fr, fq * 8);
#define PG8_SA(b, h) (((b) * 2 + (h)) * HTB)
#define PG8_SB(b, h) ((4 + (b) * 2 + (h)) * HTB)
#define PG8_STAGE(bufoff, gbase, voff) do { _Pragma("unroll") for (int _i = 0; _i < 2; ++_i) \
        __builtin_amdgcn_global_load_lds((const unsigned*)((const char*)(gbase) + (voff)[_i]), (PG8_LAS unsigned*)(lds + (bufoff) + ldsw + _i * 8192), 16, 0, 0); } while (0)
#define PG8_LDA(dst, b, h) do { _Pragma("unroll") for (int m = 0; m < 4; ++m) _Pragma("unroll") for (int k = 0; k < 2; ++k) dst[m][k] = *(const PG8_LAS bf16x8*)(lds + PG8_SA(b, h) + aoff + m * 2048 + k * 1024); } while (0)
#define PG8_LDB(dst, b, h) do { _Pragma("unroll") for (int n = 0; n < 2; ++n) _Pragma("unroll") for (int k = 0; k < 2; ++k) dst[n][k] = *(const PG8_LAS bf16x8*)(lds + PG8_SB(b, h) + boff + n * 2048 + k * 1024); } while (0)
#define PG8_MMA(ai, bj, At, Bt) do { __builtin_amdgcn_s_setprio(1); _Pragma("unroll") for (int m = 0; m < 4; ++m) _Pragma("unroll") for (int n = 0; n < 2; ++n) _Pragma("unroll") for (int k = 0; k < 2; ++k) \
        acc[ai][bj][m][n] = __builtin_amdgcn_mfma_f32_16x16x32_bf16(Bt[n][k], At[m][k], acc[ai][bj][m][n], 0, 0, 0); __builtin_amdgcn_s_setprio(0); } while (0)
#define PG8_WAIT_V(n) asm volatile("s_waitcnt vmcnt(" #n ")" ::: "memory")
#define PG8_WAIT_L(n) asm volatile("s_waitcnt lgkmcnt(" #n ")" ::: "memory")
#define PG8_BAR __builtin_amdgcn_s_barrier()
#define PG8_SCHED __builtin_amdgcn_sched_barrier(0)
    Unit cur, nxt; int ui = 0;
    if (!S.next(0, cur)) return;
    f32x4 acc[2][2][4][2];
#pragma unroll
    for (int a = 0; a < 2; ++a)
#pragma unroll
        for (int b = 0; b < 2; ++b)
#pragma unroll
            for (int m = 0; m < 4; ++m)
#pragma unroll
                for (int n = 0; n < 2; ++n) acc[a][b][m][n] = (f32x4){0.f, 0.f, 0.f, 0.f};
    bf16x8 At[4][2], B0[2][2], B1[2][2];
    const char* cA = (const char*)g.A + (size_t)cur.pm * tstepA + S.a_off(cur); const char* cB = (const char*)g.Bt + (size_t)S.b_tile(cur) * tstep;
    S.a_ready(cur);
    if constexpr (SP2) {
        PG8_STAGE(PG8_SB(0, 0), cB, voffB); PG8_STAGE(PG8_SB(0, 1), cB + hstep, voffB); PG8_STAGE(PG8_SA(0, 0), cA, voffA); PG8_STAGE(PG8_SA(0, 1), cA + hstepA, voffA);
        if (wr == 1) PG8_BAR;
        PG8_WAIT_V(2); PG8_BAR;
        PG8_STAGE(PG8_SB(1, 0), cB + kstep, voffB); PG8_STAGE(PG8_SA(1, 0), cA + kstep, voffA); PG8_STAGE(PG8_SB(1, 1), cB + hstep + kstep, voffB);
        PG8_WAIT_V(6); PG8_BAR;
    } else {
        PG8_STAGE(PG8_SB(0, 0), cB, voffB); PG8_STAGE(PG8_SA(0, 0), cA, voffA); PG8_STAGE(PG8_SB(0, 1), cB + hstep, voffB); PG8_STAGE(PG8_SA(0, 1), cA + hstepA, voffA);
        if (wr == 1) PG8_BAR;
        PG8_WAIT_V(4); PG8_BAR;
        PG8_STAGE(PG8_SB(1, 0), cB + kstep, voffB); PG8_STAGE(PG8_SA(1, 0), cA + kstep, voffA); PG8_STAGE(PG8_SB(1, 1), cB + hstep + kstep, voffB);
        PG8_WAIT_V(6); PG8_BAR;
    }
    for (;;) {
        const bool has_next = S.next(ui + 1, nxt);
        const char* nA = has_next ? (const char*)g.A + (size_t)nxt.pm * tstepA + S.a_off(nxt) : cA; const char* nB = has_next ? (const char*)g.Bt + (size_t)S.b_tile(nxt) * tstep : cB;
        for (int t = 0; t < nt; t += 2) {
            const bool last = (t == nt - 2);
            const char* a1 = cA + (size_t)(t + 1) * kstep;
            const char* a2 = last ? nA : cA + (size_t)(t + 2) * kstep; const char* b2 = last ? nB : cB + (size_t)(t + 2) * kstep;
            const char* a3 = a2 + kstep; const char* b3 = b2 + kstep;
            if (last && has_next) S.a_ready(nxt);
            if constexpr (SP2) {
            PG8_LDB(B0, 0, 0); PG8_LDB(B1, 0, 1); PG8_SCHED; PG8_LDA(At, 0, 0); PG8_STAGE(PG8_SA(1, 1), a1 + hstepA, voffA);
            PG8_WAIT_V(8); PG8_WAIT_L(0); PG8_BAR; PG8_MMA(0, 0, At, B0); PG8_MMA(0, 1, At, B1); PG8_BAR; PG8_SCHED;
            PG8_LDA(At, 0, 1); PG8_STAGE(PG8_SB(0, 0), b2, voffB); PG8_STAGE(PG8_SB(0, 1), b2 + hstep, voffB); PG8_STAGE(PG8_SA(0, 0), a2, voffA);
            PG8_WAIT_V(8); PG8_WAIT_L(0); PG8_BAR; PG8_MMA(1, 0, At, B0); PG8_MMA(1, 1, At, B1); PG8_BAR; PG8_SCHED;
            PG8_LDB(B0, 1, 0); PG8_LDB(B1, 1, 1); PG8_SCHED; PG8_LDA(At, 1, 0); PG8_STAGE(PG8_SA(0, 1), a2 + hstepA, voffA);
            PG8_WAIT_V(8); PG8_WAIT_L(0); PG8_BAR; PG8_MMA(0, 0, At, B0); PG8_MMA(0, 1, At, B1); PG8_BAR; PG8_SCHED;
            PG8_LDA(At, 1, 1); PG8_STAGE(PG8_SB(1, 0), b3, voffB); PG8_STAGE(PG8_SB(1, 1), b3 + hstep, voffB); PG8_STAGE(PG8_SA(1, 0), a3, voffA);
            PG8_WAIT_V(8); PG8_WAIT_L(0); PG8_BAR; PG8_MMA(1, 0, At, B0); PG8_MMA(1, 1, At, B1); PG8_BAR; PG8_SCHED;
            } else {
            PG8_LDB(B0, 0, 0); PG8_SCHED; PG8_LDA(At, 0, 0); PG8_STAGE(PG8_SA(1, 1), a1 + hstepA, voffA);
            PG8_WAIT_L(8); PG8_BAR; PG8_WAIT_L(0); PG8_MMA(0, 0, At, B0); PG8_BAR; PG8_SCHED;
            PG8_LDB(B1, 0, 1); PG8_STAGE(PG8_SB(0, 0), b2, voffB);
            PG8_BAR; PG8_WAIT_L(0); PG8_MMA(0, 1, At, B1); PG8_BAR;
            PG8_LDA(At, 0, 1); PG8_STAGE(PG8_SA(0, 0), a2, voffA);
            PG8_BAR; PG8_WAIT_L(0); PG8_MMA(1, 0, At, B0); PG8_BAR; PG8_SCHED;
            PG8_STAGE(PG8_SB(0, 1), b2 + hstep, voffB);
            PG8_WAIT_V(6); PG8_BAR; PG8_MMA(1, 1, At, B1); PG8_BAR;
            PG8_LDB(B0, 1, 0); PG8_SCHED; PG8_LDA(At, 1, 0); PG8_STAGE(PG8_SA(0, 1), a2 + hstepA, voffA);
            PG8_WAIT_L(8); PG8_BAR; PG8_WAIT_L(0); PG8_MMA(0, 0, At, B0); PG8_BAR; PG8_SCHED;
            PG8_LDB(B1, 1, 1); PG8_STAGE(PG8_SB(1, 0), b3, voffB);
            PG8_BAR; PG8_WAIT_L(0); PG8_MMA(0, 1, At, B1); PG8_BAR;
            PG8_LDA(At, 1, 1); PG8_STAGE(PG8_SA(1, 0), a3, voffA);
            PG8_BAR; PG8_WAIT_L(0); PG8_MMA(1, 0, At, B0); PG8_BAR; PG8_SCHED;
            PG8_STAGE(PG8_SB(1, 1), b3 + hstep, voffB);
            PG8_WAIT_V(6); PG8_BAR; PG8_MMA(1, 1, At, B1); PG8_BAR;
            }
            if constexpr (Epi::SEG_TILES > 0) { if (((t + 2) % Epi::SEG_TILES) == 0 && (t + 2) < nt) { E.seg(acc, cur, (t + 2) / Epi::SEG_TILES - 1, wr, wc, fr, fq); PG8_WAIT_V(0); PG8_SCHED; } }
        }
        if constexpr (ALIGN_EPI) { if (wr == 0) PG8_BAR; }
        if constexpr (!Epi::AFTER_DRAIN) { E(acc, cur, wr, wc, fr, fq); S.done(cur); }
        if (!has_next) break;
#pragma unroll
        for (int a = 0; a < 2; ++a)
#pragma unroll
            for (int b = 0; b < 2; ++b)
#pragma unroll
                for (int m = 0; m < 4; ++m)
#pragma unroll
                    for (int n = 0; n < 2; ++n) acc[a][b][m][n] = (f32x4){0.f, 0.f, 0.f, 0.f};
        cur = nxt; cA = nA; cB = nB; ++ui;
        if constexpr (ALIGN_EPI) { if (wr == 1) PG8_BAR; }
    }
    PG8_WAIT_V(0);
    if constexpr (!ALIGN_EPI) { if (wr == 0) PG8_BAR; }
    PG8_BAR;
    if constexpr (Epi::AFTER_DRAIN) { E.fused(acc, cur, wr, wc, fr, fq, lds, wid, lane); S.done(cur); }
#undef PG8_SA
#undef PG8_SB
#undef PG8_STAGE
#undef PG8_LDA
#undef PG8_LDB
#undef PG8_MMA
#undef PG8_WAIT_V
#undef PG8_WAIT_L
#undef PG8_BAR
#undef PG8_SCHED
}
}

constexpr int NWAVES = 8, NTHR = 512;
constexpr int M = 16384, SEQ = 8192, D = 1024, FF = 2816, NL = 4, NCH = 128  , NBC = 256  ;
constexpr int NPM = 6656;
constexpr int NWIN = 10752;
constexpr int C_DAQ = 0, C_DAK = 512, C_DAV = 1024, C_GQ = 1536, C_GK = 1792, C_GV = 2048, C_GOG = 2560, C_SZ = 3072, C_SX = 3584, C_SB = 4096, C_SC = 4352,
              C_RR = 4608, C_RK = 5120, C_RV = 5632, C_RWL = 6144, C_RAL = 6208, C_RGL = 6272, C_GLR = 6400, C_SDT = 6416;
constexpr float EPS = 1e-6f, LOG2E = 1.4426950408889634f;

constexpr size_t MiB = 1u << 20;
constexpr size_t WS_CTL = 0, CTL_ZERO_BYTES = 1 * MiB;
constexpr size_t WS_COS = 1 * MiB, WS_SIN = 2 * MiB, WS_SSQ = 3 * MiB, WS_GLAST = 3 * MiB + 512 * 1024, WS_SDT = 4 * MiB, WS_SACUM = 4 * MiB + 512 * 1024, WS_SCDEC = 5 * MiB, WS_RW2T = 5 * MiB + 64 * 1024;
constexpr size_t WS_WGU1 = 8 * MiB, WS_WD1 = 19 * MiB, WS_WIN = 24 * MiB + 512 * 1024, WS_WB = 45 * MiB + 512 * 1024, WS_WO = 49 * MiB + 512 * 1024, WS_WGU2 = 51 * MiB + 512 * 1024, WS_WD2 = 62 * MiB + 512 * 1024;
constexpr size_t WS_HB = 68 * MiB, WS_P = 100 * MiB, WS_PG = 100 * MiB, WS_YS = 308 * MiB, WS_R1 = 372 * MiB, WS_R2 = 500 * MiB, WS_END = 644 * MiB;
constexpr size_t WS_ACT = WS_R1, WS_MERGED = WS_R1;
constexpr size_t WS_RWW = WS_R1, WS_RWR = WS_R1 + 32 * MiB, WS_RWK = WS_R1 + 48 * MiB, WS_RWV = WS_R1 + 64 * MiB, WS_RWKK = WS_R1 + 80 * MiB, WS_RWB = WS_R1 + 96 * MiB, WS_RWG = WS_R1 + 112 * MiB;
constexpr size_t WS_VT = WS_R2, WS_GKV = WS_R2 + 16 * MiB, WS_SST = WS_R2 + 48 * MiB, WS_RWY = WS_R2 + 112 * MiB;
static_assert(WS_WD2 + (size_t)D * FF * 2 <= WS_HB && WS_P + (size_t)M * NPM * 2 <= WS_YS && WS_RWY + (size_t)M * 512 * 2 <= WS_END, "d_ws map");
constexpr int CW_BAR = 4096;

constexpr int RING_BYTES = 131072, LDSCTL_OFF = RING_BYTES, MISC_OFF = LDSCTL_OFF + 320, LDS_BYTES = 147456;

#define GAS __attribute__((address_space(1)))
#define LAS __attribute__((address_space(3)))
typedef unsigned short bf16;
typedef unsigned v4u __attribute__((ext_vector_type(4)));
typedef float f32x4 __attribute__((ext_vector_type(4)));
typedef short bf16x8 __attribute__((ext_vector_type(8)));
typedef GAS unsigned gu32;
typedef GAS unsigned long long gu64;
#define RLX_AGENT __ATOMIC_RELAXED, __HIP_MEMORY_SCOPE_AGENT
#define LDS_WAIT() asm volatile("s_waitcnt lgkmcnt(0)" ::: "memory")
#define VM_WAIT() asm volatile("s_waitcnt vmcnt(0)" ::: "memory")
__device__ __forceinline__ unsigned long long rt() { return __builtin_amdgcn_s_memrealtime(); }
typedef float f32x2_cv __attribute__((ext_vector_type(2))); typedef __bf16 bf16x2_cv __attribute__((ext_vector_type(2)));
__device__ __forceinline__ unsigned pk2(float lo, float hi) { const f32x2_cv v = {lo, hi}; const bf16x2_cv b = __builtin_convertvector(v, bf16x2_cv); return __builtin_bit_cast(unsigned, b); }
__device__ __forceinline__ unsigned f2bf(float f) { return pk2(f, 0.f) & 0xffffu; }

#define XB_TMO      128
#define XB_XCNT(j)  (256  + 64 * (j))
#define XB_XSUB(j)  (1280 + 64 * (j))
#define XB_XGEN(j)  (2304 + 64 * (j))
#define XB_TOP      3328
#define XB_TOPGEN   3392
#define XCD_BAR_WORDS 3456
#define XB_SPIN_CAP (1u << 18)

__device__ __forceinline__ unsigned xb_ld(unsigned* p)              { return __hip_atomic_load(p, __ATOMIC_RELAXED, __HIP_MEMORY_SCOPE_AGENT); }
__device__ __forceinline__ unsigned xb_add(unsigned* p, unsigned v) { return __hip_atomic_fetch_add(p, v, __ATOMIC_RELAXED, __HIP_MEMORY_SCOPE_AGENT); }
__device__ __forceinline__ unsigned xb_xcc_id() { return (unsigned)__builtin_amdgcn_s_getreg((3 << 11) | 20) & 0xFu; }
#define XB_SPIN(cond, bar) do { unsigned _sp = 0; while (cond) { __builtin_amdgcn_s_sleep(1); \
    if ((++_sp & 255u) == 0u) { if (xb_ld(&(bar)[XB_TMO])) break; if (_sp > XB_SPIN_CAP) { atomicAdd(&(bar)[XB_TMO], 1u); break; } } } } while (0)

struct XcdBarrier {
    unsigned* bar; unsigned x;
    volatile LAS unsigned* st;
};

__device__ __forceinline__ XcdBarrier xcd_barrier_post(unsigned* bar, volatile LAS unsigned* st) {
    XcdBarrier b; b.bar = bar; b.x = xb_xcc_id(); b.st = st;
    if (threadIdx.x == 0) (void)xb_add(&bar[XB_XCNT(b.x)], 1u);
    return b;
}
__device__ __forceinline__ void xcd_barrier_complete(unsigned* bar, unsigned x, unsigned& nloc, unsigned& nx) {
    const unsigned G = gridDim.x * gridDim.y * gridDim.z;
    unsigned sum, cnt, mine, sp = 0u;
    for (;;) {
        sum = 0u; cnt = 0u; mine = 0u;
#pragma unroll
        for (unsigned j = 0; j < 16; ++j) { const unsigned c = xb_ld(&bar[XB_XCNT(j)]); sum += c; cnt += (c > 0u) ? 1u : 0u; mine = (j == x) ? c : mine; }
        if (sum == G) break;
        __builtin_amdgcn_s_sleep(1);
        if ((++sp & 255u) == 0u) { if (xb_ld(&bar[XB_TMO])) break; if (sp > XB_SPIN_CAP) { atomicAdd(&bar[XB_TMO], 1u); break; } }
    }
    nloc = mine > 0u ? mine : 1u; nx = cnt > 0u ? cnt : 1u;
}

__device__ __forceinline__ void xcd_barrier(const XcdBarrier& b) {
    asm volatile("s_waitcnt vmcnt(0)" ::: "memory");
    __syncthreads();
    if (threadIdx.x == 0) {
        unsigned* bar = b.bar;
        __builtin_amdgcn_s_waitcnt(0);
        unsigned nloc = b.st[0], nx = b.st[1];
        if (nloc == 0u) { xcd_barrier_complete(bar, b.x, nloc, nx); b.st[0] = nloc; b.st[1] = nx; }
        const unsigned old = xb_add(&bar[XB_XSUB(b.x)], 1u);
        const unsigned gen = old / nloc;
        if (old + 1u == (gen + 1u) * nloc) {
            __builtin_amdgcn_fence(__ATOMIC_RELEASE, "agent");
            asm volatile("s_waitcnt vmcnt(0)" ::: "memory");
            const unsigned og = xb_add(&bar[XB_TOP], 1u);
            const unsigned tg = og / nx;
            if (og + 1u == (tg + 1u) * nx) xb_add(&bar[XB_TOPGEN], 1u);
            else XB_SPIN(xb_ld(&bar[XB_TOPGEN]) == tg, bar);
            __builtin_amdgcn_fence(__ATOMIC_ACQUIRE, "agent");
            xb_add(&bar[XB_XGEN(b.x)], 1u);
            asm volatile("s_waitcnt vmcnt(0)" ::: "memory");
        } else {
            XB_SPIN(xb_ld(&bar[XB_XGEN(b.x)]) == gen, bar);
            __builtin_amdgcn_fence(__ATOMIC_ACQUIRE, "agent");
            asm volatile("s_waitcnt vmcnt(0)" ::: "memory");
        }
    }
    __syncthreads();
}

struct Args { const float* in[40]; float* out; unsigned char* ws; float inv_freq[32]; int g_lo, g_hi; };
struct ArgsD { const GAS float* in[40]; GAS float* out; GAS unsigned char* ws; float inv_freq[32]; int g_lo, g_hi; };
typedef const __attribute__((address_space(4))) ArgsD* ArgsP;
typedef LAS float* LF; typedef const LAS float* CLF;
#ifndef PH_FN
#define PH_FN __device__ __noinline__
#endif
#ifndef PH_HEAVY
#define PH_HEAVY __device__ __forceinline__
#endif
struct Ctx {
    LAS unsigned char* lds;
    GAS unsigned char* ws; GAS float* h;
    int tid, lane, wave, bid, G;
};
typedef unsigned u32x4 __attribute__((ext_vector_type(4)));
typedef unsigned u32x2 __attribute__((ext_vector_type(2)));
typedef float f32x2 __attribute__((ext_vector_type(2)));
typedef float f32x16 __attribute__((ext_vector_type(16)));
__device__ __forceinline__ float bf2f(bf16 x) { return __uint_as_float((unsigned)x << 16); }
__device__ __forceinline__ float bflo(unsigned w) { return __uint_as_float(w << 16); }
__device__ __forceinline__ float bfhi(unsigned w) { return __uint_as_float(w & 0xffff0000u); }
__device__ __forceinline__ void unpack8(const u32x4 w, float* o) { o[0] = bflo(w.x); o[1] = bfhi(w.x); o[2] = bflo(w.y); o[3] = bfhi(w.y); o[4] = bflo(w.z); o[5] = bfhi(w.z); o[6] = bflo(w.w); o[7] = bfhi(w.w); }
__device__ __forceinline__ u32x4 pack8(const float* o) { u32x4 w; w.x = pk2(o[0], o[1]); w.y = pk2(o[2], o[3]); w.z = pk2(o[4], o[5]); w.w = pk2(o[6], o[7]); return w; }
__device__ __forceinline__ float sigmoidf_(float x) { return 1.0f / (1.0f + __expf(-x)); }
__device__ __forceinline__ float siluf_(float x) { return x * sigmoidf_(x); }
__device__ __forceinline__ float softplusf_(float x) { return fmaxf(x, 0.f) + log1pf(__expf(-fabsf(x))); }
__device__ __forceinline__ float logsigmoidf_(float x) { return fminf(x, 0.f) - log1pf(__expf(-fabsf(x))); }
__device__ __forceinline__ float wave_sum(float v) {
#pragma unroll
    for (int o = 1; o < 64; o <<= 1) v += __shfl_xor(v, o);
    return v;
}
#define WG_SYNC() __syncthreads()
__device__ __forceinline__ Ctx fresh(const Ctx& C0) { Ctx C = C0; int t = threadIdx.x; asm volatile("" : "+v"(t)); C.tid = t; C.lane = t & 63; C.wave = __builtin_amdgcn_readfirstlane(t >> 6); return C; }

PH_FN void ph_prologue(const Ctx C, ArgsP a) {
    GAS float* cosT = (GAS float*)(C.ws + WS_COS); GAS float* sinT = (GAS float*)(C.ws + WS_SIN);
    for (int idx = C.bid * NTHR + C.tid; idx < SEQ * 32; idx += C.G * NTHR) {
        const int t = idx >> 5, j = idx & 31;
        const float ang = (float)t * a->inv_freq[j];
        const double rev = (double)ang * 0.15915494309189535;
        const float fr = (float)(rev - floor(rev));
        cosT[idx] = __builtin_amdgcn_cosf(fr); sinT[idx] = __builtin_amdgcn_sinf(fr);
    }
    const GAS float* x = a->in[0]; GAS bf16* hb = (GAS bf16*)(C.ws + WS_HB); GAS float* ssq = (GAS float*)(C.ws + WS_SSQ);
    const int gw = C.bid * NWAVES + C.wave, NGW = C.G * NWAVES;
    for (int m = gw; m < M; m += NGW) {
        const GAS f32x4* xr = (const GAS f32x4*)(x + (size_t)m * D) + C.lane;
        GAS unsigned long long* o8 = (GAS unsigned long long*)(hb + (size_t)m * D) + C.lane;
        float s = 0.f;
#pragma unroll
        for (int j = 0; j < 4; ++j) { const f32x4 v = xr[64 * j]; s += (v.x * v.x + v.y * v.y) + (v.z * v.z + v.w * v.w);
            o8[64 * j] = (unsigned long long)pk2(v.x, v.y) | ((unsigned long long)pk2(v.z, v.w) << 32); }
        s = wave_sum(s);
        if (C.lane == 0) { ssq[m] = s; ssq[M + m] = 0.f; ssq[2 * M + m] = 0.f; ssq[3 * M + m] = 0.f; }
    }
}

template <class SrcF>
__device__ __forceinline__ void tr_item(const SrcF src, const GAS float* gk, GAS bf16* WT, int K, int kb, int nb, LAS bf16* scr, int lane) {
    const int k0 = 64 * kb, n0 = 64 * nb, kr = lane >> 4, n4 = 4 * (lane & 15);
    const int ld = src.ld(); const long co = src.col(n0 + n4); const bool ok = co >= 0; const GAS float* colp = src.base(n0 + n4) + (ok ? co : 0);
    f32x4 v[16];
#pragma unroll
    for (int i = 0; i < 16; ++i) v[i] = ok ? *(const GAS f32x4*)(colp + (size_t)(k0 + 4 * i + kr) * ld) : (f32x4){0.f, 0.f, 0.f, 0.f};
#pragma unroll
    for (int i = 0; i < 16; ++i) { const int kk = 4 * i + kr; const float g = gk ? gk[k0 + kk] : 1.0f;
#pragma unroll
        for (int e = 0; e < 4; ++e) scr[(n4 + e) * 72 + kk] = (bf16)f2bf(v[i][e] * g); }
    LDS_WAIT(); asm volatile("" ::: "memory");
    const int c = lane & 7;
#pragma unroll
    for (int j = 0; j < 8; ++j) { const int n = (lane >> 3) + 8 * j; *(GAS v4u*)(WT + (size_t)(n0 + n) * K + k0 + 8 * c) = *(const LAS v4u*)(scr + n * 72 + 8 * c); }
    LDS_WAIT(); asm volatile("" ::: "memory");
}
struct SrcGU { const GAS float* wg; const GAS float* wu;
    __device__ __forceinline__ int ld() const { return FF; }
    __device__ __forceinline__ const GAS float* base(int n) const { const uintptr_t sel = (uintptr_t)((n >> 7) & 1); return (const GAS float*)((uintptr_t)wg + sel * ((uintptr_t)wu - (uintptr_t)wg)); }
    __device__ __forceinline__ long col(int n) const { return 128 * (n >> 8) + (n & 127); } };
struct SrcPlain { const GAS float* w; int ldw;
    __device__ __forceinline__ int ld() const { return ldw; }
    __device__ __forceinline__ const GAS float* base(int) const { return w; }
    __device__ __forceinline__ long col(int n) const { return n; } };
struct SrcWin { const GAS float* w;
    __device__ __forceinline__ int ld() const { return 10520; }
    __device__ __forceinline__ const GAS float* base(int) const { return w; }
    __device__ __forceinline__ long col(int n) const {
        int c;
        if (n < 3072) c = n; else if (n < 4608) c = n - 3072 + 3088; else if (n < 6400) c = n - 4608 + 4632; else if (n < 6416) c = n - 6400 + 3072; else if (n < 6424) c = n - 6416 + 4624; else if (n < 6656) c = -1; else c = n - 6656 + 6424;
        return c; } };
PH_FN void ph_weights(const Ctx C, ArgsP a, int l) {
    LAS bf16* scr = (LAS bf16*)(C.lds + C.wave * 16384);
    const int gw = C.bid * NWAVES + C.wave, NGW = C.G * NWAVES; int rot = 0;
#define W_FIRST(cnt) ({ const int f_ = (gw + NGW - rot % NGW) % NGW; rot += (cnt); f_; })
#pragma unroll 1
    for (int f = 0; f < 2; ++f) {
        const GAS float* nrm = a->in[f ? 35 : 1] + (size_t)l * D; const GAS float* wg = a->in[f ? 36 : 2] + (size_t)l * D * FF; const GAS float* wu = a->in[f ? 37 : 3] + (size_t)l * D * FF; const GAS float* wd = a->in[f ? 38 : 4] + (size_t)l * FF * D;
        GAS bf16* Wgu = (GAS bf16*)(C.ws + (f ? WS_WGU2 : WS_WGU1)); GAS bf16* Wd = (GAS bf16*)(C.ws + (f ? WS_WD2 : WS_WD1));
        const SrcGU sgu{wg, wu};
        for (int it = W_FIRST((D / 64) * (2 * FF / 64)); it < (D / 64) * (2 * FF / 64); it += NGW) tr_item(sgu, nrm, Wgu, D, it / (2 * FF / 64), it % (2 * FF / 64), scr, C.lane);
        const SrcPlain sd{wd, D};
        for (int it = W_FIRST((FF / 64) * (D / 64)); it < (FF / 64) * (D / 64); it += NGW) tr_item(sd, nullptr, Wd, FF, it / (D / 64), it % (D / 64), scr, C.lane);
    }
    { const SrcWin sw{a->in[6] + (size_t)l * D * 10520}; const GAS float* nrm = a->in[5] + (size_t)l * D; GAS bf16* Win = (GAS bf16*)(C.ws + WS_WIN);
      for (int it = W_FIRST((D / 64) * (NWIN / 64)); it < (D / 64) * (NWIN / 64); it += NGW) tr_item(sw, nrm, Win, D, it / (NWIN / 64), it % (NWIN / 64), scr, C.lane); }
    { GAS bf16* Wb = (GAS bf16*)(C.ws + WS_WB);
      for (int it = W_FIRST(4 * (512 / 64) * (D / 64)); it < 4 * (512 / 64) * (D / 64); it += NGW) { const int z = it / ((512 / 64) * (D / 64)), r = it % ((512 / 64) * (D / 64));
          const SrcPlain sb{a->in[32] + ((size_t)l * 4 + z) * 512 * D - (size_t)z * 512 * D, D}; tr_item(sb, nullptr, Wb, 2048, z * 8 + r / (D / 64), r % (D / 64), scr, C.lane); } }
    { GAS bf16* W2T = (GAS bf16*)(C.ws + WS_RW2T); GAS bf16* A2T = W2T + 512 * 64; GAS bf16* G2T = A2T + 512 * 64;
      const SrcPlain s1{a->in[23] + (size_t)l * 64 * 512, 512}, s2{a->in[25] + (size_t)l * 64 * 512, 512}, s3{a->in[26] + (size_t)l * 128 * 512, 512};
      for (int it = W_FIRST(8); it < 8; it += NGW) tr_item(s1, nullptr, W2T, 64, 0, it, scr, C.lane);
      for (int it = W_FIRST(8); it < 8; it += NGW) tr_item(s2, nullptr, A2T, 64, 0, it, scr, C.lane);
      for (int it = W_FIRST(16); it < 16; it += NGW) tr_item(s3, nullptr, G2T, 128, it >> 3, it & 7, scr, C.lane); }
    { const SrcPlain so{a->in[34] + (size_t)l * D * D, D}; GAS bf16* Wo = (GAS bf16*)(C.ws + WS_WO);
      for (int it = W_FIRST((D / 64) * (D / 64)); it < (D / 64) * (D / 64); it += NGW) tr_item(so, nullptr, Wo, D, it / (D / 64), it % (D / 64), scr, C.lane); }
}

#undef W_FIRST
PH_FN void ph_da_prep(const Ctx C) {
    GAS bf16* P = (GAS bf16*)(C.ws + WS_P); const GAS float* cosT = (const GAS float*)(C.ws + WS_COS); const GAS float* sinT = (const GAS float*)(C.ws + WS_SIN);
    const int gw = C.bid * NWAVES + C.wave, NGW = C.G * NWAVES;
    const int hc = C.lane >> 2, ch = C.lane & 3;
    const float sc = (hc < 8) ? 0.125f * LOG2E : 1.0f;
    for (int m = gw; m < M; m += NGW) {
        const int t = m & (SEQ - 1);
        GAS bf16* p1 = P + (size_t)m * NPM + hc * 64 + ch * 8; GAS bf16* p2 = p1 + 32;
        float x1[8], x2[8], o1[8], o2[8];
        unpack8(*(const GAS u32x4*)p1, x1); unpack8(*(const GAS u32x4*)p2, x2);
        const GAS float* cp = cosT + t * 32 + ch * 8; const GAS float* sp = sinT + t * 32 + ch * 8;
#pragma unroll
        for (int i = 0; i < 8; ++i) { const float c = cp[i], s = sp[i]; o1[i] = (x1[i] * c - x2[i] * s) * sc; o2[i] = (x2[i] * c + x1[i] * s) * sc; }
        *(GAS u32x4*)p1 = pack8(o1); *(GAS u32x4*)p2 = pack8(o2);
    }
    GAS bf16* VT = (GAS bf16*)(C.ws + WS_VT); LAS bf16* tile = (LAS bf16*)C.lds;
    for (int it = C.bid; it < 2 * NCH * 4; it += C.G) {
        const int h = it & 3, bc = it >> 2, b = bc >> 7, tb = bc & 127; const size_t row0 = (size_t)bc * 64;
        WG_SYNC();
#pragma unroll
        for (int i = 0; i < 2; ++i) { const int q = C.tid + NTHR * i, t = q >> 4, c16 = q & 15;
            *(LAS u32x4*)(tile + t * 136 + c16 * 8) = *(const GAS u32x4*)(P + (row0 + t) * NPM + C_DAV + h * 128 + c16 * 8); }
        WG_SYNC();
#pragma unroll
        for (int i = 0; i < 2; ++i) { const int q = C.tid + NTHR * i, d = q >> 3, tc = q & 7; unsigned w[4];
#pragma unroll
            for (int e = 0; e < 4; ++e) w[e] = (unsigned)tile[(8 * tc + 2 * e) * 136 + d] | ((unsigned)tile[(8 * tc + 2 * e + 1) * 136 + d] << 16);
            u32x4 o; o.x = w[0]; o.y = w[1]; o.z = w[2]; o.w = w[3];
            *(GAS u32x4*)(VT + ((size_t)(b * 4 + h) * 128 + d) * SEQ + tb * 64 + 8 * tc) = o; }
    }
    WG_SYNC();
}

typedef LAS bf16* LB; typedef const LAS bf16* CLB;
__device__ __forceinline__ pg8::bf16x8 frag32(CLB X, int ld, int row0, int k0, int lane) { return *(const LAS pg8::bf16x8*)(X + (row0 + (lane & 31)) * ld + k0 + 8 * (lane >> 5)); }
template <int K> __device__ __forceinline__ void mma_nt(f32x16& acc, CLB A, int lda, int m0, CLB Bt, int ldb, int n0, int lane) {
#pragma unroll
    for (int k = 0; k < K; k += 16) acc = __builtin_amdgcn_mfma_f32_32x32x16_bf16(frag32(A, lda, m0, k, lane), frag32(Bt, ldb, n0, k, lane), acc, 0, 0, 0);
}
__device__ __forceinline__ int crow(int r, int hi) { return (r & 3) + 8 * (r >> 2) + 4 * hi; }
__device__ __forceinline__ f32x16 zero16() { f32x16 z;
#pragma unroll
    for (int r = 0; r < 16; ++r) z[r] = 0.f;
    return z; }

__device__ __forceinline__ void gla_compute_G(const Ctx& C, ArgsP a, int l, int bc, int h, LF Gs) {
    const GAS bf16* P = (const GAS bf16*)(C.ws + WS_P); const GAS float* W2 = a->in[12] + (size_t)l * 16 * 256; const GAS float* gb = a->in[13] + (size_t)l * 256;
    const int t = C.tid >> 3, kg = C.tid & 7; const size_t row = (size_t)bc * 64 + t;
    float glr[16]; unpack8(*(const GAS u32x4*)(P + row * NPM + C_GLR), glr); unpack8(*(const GAS u32x4*)(P + row * NPM + C_GLR + 8), glr + 8);
#pragma unroll
    for (int i = 0; i < 8; ++i) { const int k = h * 64 + kg * 8 + i; float x = gb[k];
#pragma unroll
        for (int r = 0; r < 16; ++r) x += glr[r] * W2[r * 256 + k];
        Gs[t * 68 + kg * 8 + i] = logsigmoidf_(x) * (1.0f / 16.0f); }
    WG_SYNC();
    { const int seg = C.tid >> 6, k = C.tid & 63; float run = 0.f;
#pragma unroll
      for (int i = 0; i < 8; ++i) { run += Gs[(8 * seg + i) * 68 + k]; Gs[(8 * seg + i) * 68 + k] = run; }
      WG_SYNC();
      float off = 0.f;
#pragma unroll
      for (int sg = 0; sg < 7; ++sg) { const float tot = Gs[(8 * sg + 7) * 68 + k]; off += (sg < seg) ? tot : 0.f; }
      WG_SYNC();
#pragma unroll
      for (int i = 0; i < 8; ++i) Gs[(8 * seg + i) * 68 + k] += off; }
    WG_SYNC();
}
PH_HEAVY void ph_gla_a(const Ctx C, ArgsP a, int l) {
    const GAS bf16* P = (const GAS bf16*)(C.ws + WS_P); GAS bf16* GKV = (GAS bf16*)(C.ws + WS_GKV); GAS float* GL = (GAS float*)(C.ws + WS_GLAST);
    LF Gs = (LF)C.lds; LB KDT = (LB)(C.lds + 17408); LB VT = (LB)(C.lds + 26624);
    for (int it = C.bid; it < NBC * 4; it += C.G) {
        const int bc = it >> 2, h = it & 3;
        WG_SYNC();
        gla_compute_G(C, a, l, bc, h, Gs);
        { const int t = C.tid >> 3, g8 = C.tid & 7; const size_t row = (size_t)bc * 64 + t;
          float kf[8]; unpack8(*(const GAS u32x4*)(P + row * NPM + C_GK + h * 64 + g8 * 8), kf);
#pragma unroll
          for (int i = 0; i < 8; ++i) { const int k = g8 * 8 + i; KDT[k * 72 + t] = (bf16)f2bf(kf[i] * __expf(Gs[63 * 68 + k] - Gs[t * 68 + k])); }
          const u32x4 v0 = *(const GAS u32x4*)(P + row * NPM + C_GV + h * 128 + g8 * 16), v1 = *(const GAS u32x4*)(P + row * NPM + C_GV + h * 128 + g8 * 16 + 8);
          const unsigned vw[8] = {v0.x, v0.y, v0.z, v0.w, v1.x, v1.y, v1.z, v1.w};
#pragma unroll
          for (int i = 0; i < 8; ++i) { VT[(g8 * 16 + 2 * i) * 72 + t] = (bf16)(vw[i] & 0xffffu); VT[(g8 * 16 + 2 * i + 1) * 72 + t] = (bf16)(vw[i] >> 16); }
          if (C.tid < 64) GL[(size_t)it * 64 + C.tid] = Gs[63 * 68 + C.tid]; }
        WG_SYNC();
        { const int kt = C.wave >> 2, vt = C.wave & 3, n = C.lane & 31, hi = C.lane >> 5;
          f32x16 acc = zero16(); mma_nt<64>(acc, KDT, 72, 32 * kt, VT, 72, 32 * vt, C.lane);
          GAS bf16* dst = GKV + ((size_t)it * 128 + 32 * vt + n) * 64 + 32 * kt + 4 * hi;
#pragma unroll
          for (int g = 0; g < 4; ++g) { u32x2 w; w.x = pk2(acc[4 * g], acc[4 * g + 1]); w.y = pk2(acc[4 * g + 2], acc[4 * g + 3]); *(GAS u32x2*)(dst + 8 * g) = w; } }
    }
    WG_SYNC();
}
PH_FN void gla_scan_part(const Ctx C, int part) {
    GAS unsigned* GKV = (GAS unsigned*)(C.ws + WS_GKV); const GAS float* GL = (const GAS float*)(C.ws + WS_GLAST);
    const int e = part * NTHR + C.tid, chain = e >> 12, idx = e & 4095, b = chain >> 2, h = chain & 3, k = (2 * idx) & 63;
    float s0 = 0.f, s1 = 0.f;
#pragma unroll 1
    for (int c0 = 0; c0 < NCH; c0 += 16) {
        unsigned tmp[16]; f32x2 dec[16];
#pragma unroll
        for (int i = 0; i < 16; ++i) { const size_t item = (size_t)(b * NCH + c0 + i) * 4 + h; tmp[i] = GKV[item * 4096 + idx]; dec[i] = *(const GAS f32x2*)(GL + item * 64 + k); }
#pragma unroll
        for (int i = 0; i < 16; ++i) { const size_t item = (size_t)(b * NCH + c0 + i) * 4 + h; GKV[item * 4096 + idx] = pk2(s0, s1); s0 = __expf(dec[i][0]) * s0 + bflo(tmp[i]); s1 = __expf(dec[i][1]) * s1 + bfhi(tmp[i]); }
    }
}
PH_HEAVY void ph_gla_c(const Ctx C, ArgsP a, int l) {
    const GAS bf16* P = (const GAS bf16*)(C.ws + WS_P); const GAS bf16* GKV = (const GAS bf16*)(C.ws + WS_GKV); GAS bf16* YS = (GAS bf16*)(C.ws + WS_YS);
    const GAS float* gnorm = a->in[14] + (size_t)l * 128;
    LF Gs = (LF)C.lds; LB QD = (LB)(C.lds + 17408); LB KDR = (LB)(C.lds + 26624); LB QI = (LB)(C.lds + 35840); LB ATT = (LB)(C.lds + 45056); LB VT = (LB)(C.lds + 54272); LB ST = (LB)(C.lds + 72704); LF PS = (LF)(C.lds + 91136);
    for (int it = C.bid; it < NBC * 4; it += C.G) {
        const int bc = it >> 2, h = it & 3;
        WG_SYNC();
        gla_compute_G(C, a, l, bc, h, Gs);
        { const int t = C.tid >> 3, g8 = C.tid & 7; const size_t row = (size_t)bc * 64 + t;
          float qf[8], kf[8], o1[8], o2[8], o3[8];
          unpack8(*(const GAS u32x4*)(P + row * NPM + C_GQ + h * 64 + g8 * 8), qf); unpack8(*(const GAS u32x4*)(P + row * NPM + C_GK + h * 64 + g8 * 8), kf);
#pragma unroll
          for (int i = 0; i < 8; ++i) { const int k = g8 * 8 + i; const float g = Gs[t * 68 + k], d = g - Gs[32 * 68 + k]; o1[i] = qf[i] * 0.125f * __expf(d); o2[i] = kf[i] * __expf(-d); o3[i] = qf[i] * 0.125f * __expf(g); }
          *(LAS u32x4*)(QD + t * 72 + g8 * 8) = pack8(o1); *(LAS u32x4*)(KDR + t * 72 + g8 * 8) = pack8(o2); *(LAS u32x4*)(QI + t * 72 + g8 * 8) = pack8(o3);
          const u32x4 v0 = *(const GAS u32x4*)(P + row * NPM + C_GV + h * 128 + g8 * 16), v1 = *(const GAS u32x4*)(P + row * NPM + C_GV + h * 128 + g8 * 16 + 8);
          const unsigned vw[8] = {v0.x, v0.y, v0.z, v0.w, v1.x, v1.y, v1.z, v1.w};
#pragma unroll
          for (int i = 0; i < 8; ++i) { VT[(g8 * 16 + 2 * i) * 72 + t] = (bf16)(vw[i] & 0xffffu); VT[(g8 * 16 + 2 * i + 1) * 72 + t] = (bf16)(vw[i] >> 16); }
          const int v = C.tid >> 2, kq = (C.tid & 3) * 16; const GAS bf16* sp = GKV + ((size_t)it * 128 + v) * 64 + kq;
          *(LAS u32x4*)(ST + v * 72 + kq) = *(const GAS u32x4*)sp; *(LAS u32x4*)(ST + v * 72 + kq + 8) = *(const GAS u32x4*)(sp + 8); }
        WG_SYNC();
        const int n = C.lane & 31, hi = C.lane >> 5;
        if (C.wave < 4) {
            const int it_ = C.wave >> 1, jt = C.wave & 1;
            f32x16 acc = zero16();
            if (jt <= it_) mma_nt<64>(acc, QD, 72, 32 * it_, KDR, 72, 32 * jt, C.lane);
#pragma unroll
            for (int r = 0; r < 16; ++r) { const int i = 32 * it_ + crow(r, hi), j = 32 * jt + n; ATT[i * 72 + j] = (bf16)f2bf(j <= i ? acc[r] : 0.f); }
        }
        WG_SYNC();
        {
            const int it_ = C.wave & 1, vt = C.wave >> 1;
            f32x16 acc = zero16();
            mma_nt<64>(acc, VT, 72, 32 * vt, ATT, 72, 32 * it_, C.lane);
            mma_nt<64>(acc, ST, 72, 32 * vt, QI, 72, 32 * it_, C.lane);
            float ss = 0.f;
#pragma unroll
            for (int r = 0; r < 16; ++r) ss += acc[r] * acc[r];
            ss += __shfl_xor(ss, 32);
            if (hi == 0) PS[(32 * it_ + n) * 4 + vt] = ss;
            WG_SYNC();
            const int i = 32 * it_ + n; const float tot = (PS[i * 4] + PS[i * 4 + 1]) + (PS[i * 4 + 2] + PS[i * 4 + 3]);
            const float rs = 1.0f / sqrtf(tot * (1.0f / 128.0f) + EPS); const size_t row = (size_t)bc * 64 + i;
#pragma unroll
            for (int g = 0; g < 4; ++g) { const int v0 = 32 * vt + 8 * g + 4 * hi;
                const u32x2 ogw = *(const GAS u32x2*)(P + row * NPM + C_GOG + h * 128 + v0); const f32x4 gn = *(const GAS f32x4*)(gnorm + v0);
                const float og[4] = {bflo(ogw.x), bfhi(ogw.x), bflo(ogw.y), bfhi(ogw.y)}; float o4[4];
#pragma unroll
                for (int y = 0; y < 4; ++y) o4[y] = acc[4 * g + y] * rs * gn[y] * siluf_(og[y]);
                u32x2 w; w.x = pk2(o4[0], o4[1]); w.y = pk2(o4[2], o4[3]); *(GAS u32x2*)(YS + row * 2048 + 512 + h * 128 + v0) = w; }
        }
    }
    WG_SYNC();
}

__device__ __forceinline__ void ssd_conv8(const GAS bf16* P, const GAS float* cw, const GAS float* cb, int bc, int t, int ch0, float* o) {
    const int pos = (bc & 127) * 64 + t; const size_t row = (size_t)bc * 64 + t;
#pragma unroll
    for (int i = 0; i < 8; ++i) o[i] = cb[ch0 + i];
#pragma unroll
    for (int tap = 0; tap < 4; ++tap) { if (pos - 3 + tap >= 0) { float x[8]; unpack8(*(const GAS u32x4*)(P + (row - 3 + tap) * NPM + C_SX + ch0), x);
#pragma unroll
        for (int i = 0; i < 8; ++i) o[i] += cw[tap * 1024 + ch0 + i] * x[i]; } }
#pragma unroll
    for (int i = 0; i < 8; ++i) o[i] = siluf_(o[i]);
}
PH_HEAVY void ph_ssd_a(const Ctx C, ArgsP a, int l) {
    const GAS bf16* P = (const GAS bf16*)(C.ws + WS_P); GAS bf16* SST = (GAS bf16*)(C.ws + WS_SST); GAS float* SDT = (GAS float*)(C.ws + WS_SDT); GAS float* SAC = (GAS float*)(C.ws + WS_SACUM); GAS float* SCD = (GAS float*)(C.ws + WS_SCDEC);
    const GAS float* cw = a->in[15] + (size_t)l * 4 * 1024; const GAS float* cb = a->in[16] + (size_t)l * 1024; const GAS float* dtb = a->in[17] + (size_t)l * 8; const GAS float* alog = a->in[18] + (size_t)l * 8;
    LB BT = (LB)C.lds; LB XDT = (LB)(C.lds + 18432); LF dtv = (LF)(C.lds + 27648); LF acu = (LF)(C.lds + 27904); LF av = (LF)(C.lds + 28160);
    for (int it = C.bid; it < NBC * 2; it += C.G) {
        const int bc = it >> 1, g = it & 1; const int t = C.tid >> 3, cg = C.tid & 7;
        WG_SYNC();
        { float o[8];
#pragma unroll
          for (int half = 0; half < 2; ++half) { ssd_conv8(P, cw, cb, bc, t, 512 + g * 128 + cg * 16 + half * 8, o);
#pragma unroll
              for (int i = 0; i < 8; ++i) BT[(cg * 16 + half * 8 + i) * 72 + t] = (bf16)f2bf(o[i]); } }
#pragma unroll 1
        for (int hh = 0; hh < 4; ++hh) {
            const int hd = 4 * g + hh; const size_t item8 = (size_t)bc * 8 + hd;
            WG_SYNC();
            if (C.tid < 64) { const size_t row = (size_t)bc * 64 + C.tid; const float dt = softplusf_(bf2f(P[row * NPM + C_SDT + hd]) + dtb[hd]); dtv[C.tid] = dt; av[C.tid] = -__expf(alog[hd]) * dt; }
            WG_SYNC();
            if (C.tid < 64) { float s = av[C.tid];
#pragma unroll
                for (int o = 1; o < 64; o <<= 1) { const float nb_ = __shfl_up(s, o); if (C.lane >= o) s += nb_; }
                acu[C.tid] = s; const size_t row = (size_t)bc * 64 + C.tid; SDT[row * 8 + hd] = dtv[C.tid]; SAC[row * 8 + hd] = s; if (C.tid == 63) SCD[item8] = __expf(s); }
            WG_SYNC();
            { float o[8]; ssd_conv8(P, cw, cb, bc, t, hd * 64 + cg * 8, o); const float sc = dtv[t] * __expf(acu[63] - acu[t]);
#pragma unroll
              for (int i = 0; i < 8; ++i) XDT[(cg * 8 + i) * 72 + t] = (bf16)f2bf(o[i] * sc); }
            WG_SYNC();
            { const int pt = C.wave >> 2, nt = C.wave & 3, n = C.lane & 31, hi = C.lane >> 5;
              f32x16 acc = zero16(); mma_nt<64>(acc, XDT, 72, 32 * pt, BT, 72, 32 * nt, C.lane);
#pragma unroll
              for (int r = 0; r < 16; ++r) SST[(item8 * 64 + 32 * pt + crow(r, hi)) * 128 + 32 * nt + n] = (bf16)f2bf(acc[r]); }
        }
    }
    WG_SYNC();
}
PH_FN void ssd_scan_part(const Ctx C, int part) {
    GAS unsigned* SST = (GAS unsigned*)(C.ws + WS_SST); const GAS float* SCD = (const GAS float*)(C.ws + WS_SCDEC);
    const int e = part * NTHR + C.tid, chain = e >> 12, idx = e & 4095, b = chain >> 3, hd = chain & 7;
    float s0 = 0.f, s1 = 0.f;
#pragma unroll 1
    for (int c0 = 0; c0 < NCH; c0 += 16) {
        unsigned tmp[16]; float dec[16];
#pragma unroll
        for (int i = 0; i < 16; ++i) { const size_t item = (size_t)(b * NCH + c0 + i) * 8 + hd; tmp[i] = SST[item * 4096 + idx]; dec[i] = SCD[item]; }
#pragma unroll
        for (int i = 0; i < 16; ++i) { const size_t item = (size_t)(b * NCH + c0 + i) * 8 + hd; SST[item * 4096 + idx] = pk2(s0, s1); s0 = dec[i] * s0 + bflo(tmp[i]); s1 = dec[i] * s1 + bfhi(tmp[i]); }
    }
}
PH_HEAVY void ph_ssd_c(const Ctx C, ArgsP a, int l) {
    const GAS bf16* P = (const GAS bf16*)(C.ws + WS_P); const GAS bf16* SST = (const GAS bf16*)(C.ws + WS_SST); const GAS float* SDT = (const GAS float*)(C.ws + WS_SDT); const GAS float* SAC = (const GAS float*)(C.ws + WS_SACUM); GAS bf16* YS = (GAS bf16*)(C.ws + WS_YS);
    const GAS float* cw = a->in[15] + (size_t)l * 4 * 1024; const GAS float* cb = a->in[16] + (size_t)l * 1024; const GAS float* dpar = a->in[19] + (size_t)l * 8; const GAS float* snorm = a->in[20] + (size_t)l * 512;
    LB BN = (LB)C.lds; LB CN = (LB)(C.lds + 17408); LF CB = (LF)(C.lds + 34816); LB SC = (LB)(C.lds + 52224); LB XST = (LB)(C.lds + 61440); LB HP = (LB)(C.lds + 70656); LB CE = (LB)(C.lds + 88064);
    LF dtv = (LF)(C.lds + 105472); LF acu = (LF)(C.lds + 105728); LF PSQ = (LF)(C.lds + 105984);
    for (int it = C.bid; it < NBC * 2; it += C.G) {
        const int bc = it >> 1, g = it & 1;
        const int t = C.tid >> 3, cg = C.tid & 7, n = C.lane & 31, hi = C.lane >> 5;
        WG_SYNC();
        { float o[8];
#pragma unroll
          for (int half = 0; half < 2; ++half) {
              ssd_conv8(P, cw, cb, bc, t, 512 + g * 128 + cg * 16 + half * 8, o); *(LAS u32x4*)(BN + t * 136 + cg * 16 + half * 8) = pack8(o);
              ssd_conv8(P, cw, cb, bc, t, 768 + g * 128 + cg * 16 + half * 8, o); *(LAS u32x4*)(CN + t * 136 + cg * 16 + half * 8) = pack8(o); } }
        WG_SYNC();
        if (C.wave < 4) {
            const int it_ = C.wave >> 1, jt = C.wave & 1;
            f32x16 acc = zero16(); mma_nt<128>(acc, CN, 136, 32 * it_, BN, 136, 32 * jt, C.lane);
#pragma unroll
            for (int r = 0; r < 16; ++r) CB[(32 * it_ + crow(r, hi)) * 68 + 32 * jt + n] = acc[r];
        }
        float yk[4][16]; float ssq = 0.f;
        const int pt = (C.wave >> 1) & 1, it2 = C.wave & 1;
#pragma unroll
        for (int hh = 0; hh < 4; ++hh) {
            const int hd = 4 * g + hh; const size_t item8 = (size_t)bc * 8 + hd;
            WG_SYNC();
            if (C.tid < 64) { const size_t row = (size_t)bc * 64 + C.tid; dtv[C.tid] = SDT[row * 8 + hd]; acu[C.tid] = SAC[row * 8 + hd]; }
            { float o[8]; ssd_conv8(P, cw, cb, bc, t, hd * 64 + cg * 8, o);
#pragma unroll
              for (int i = 0; i < 8; ++i) XST[(cg * 8 + i) * 72 + t] = (bf16)f2bf(o[i]);
              const int p = C.tid >> 3, n0 = (C.tid & 7) * 16; const GAS bf16* sp = SST + (item8 * 64 + p) * 128 + n0;
              *(LAS u32x4*)(HP + p * 136 + n0) = *(const GAS u32x4*)sp; *(LAS u32x4*)(HP + p * 136 + n0 + 8) = *(const GAS u32x4*)(sp + 8); }
            WG_SYNC();
            { const float ai = acu[t]; float o[8];
#pragma unroll
              for (int jj = 0; jj < 8; ++jj) { const int j = 8 * cg + jj; o[jj] = (j <= t) ? CB[t * 68 + j] * __expf(ai - acu[j]) * dtv[j] : 0.f; }
              *(LAS u32x4*)(SC + t * 72 + 8 * cg) = pack8(o);
              const float ea = __expf(ai); float c8[8];
#pragma unroll
              for (int half = 0; half < 2; ++half) { unpack8(*(const LAS u32x4*)(CN + t * 136 + cg * 16 + half * 8), c8);
#pragma unroll
                  for (int i = 0; i < 8; ++i) c8[i] *= ea;
                  *(LAS u32x4*)(CE + t * 136 + cg * 16 + half * 8) = pack8(c8); } }
            WG_SYNC();
            if (C.wave < 4) {
                f32x16 acc = zero16();
                mma_nt<64>(acc, XST, 72, 32 * pt, SC, 72, 32 * it2, C.lane);
                mma_nt<128>(acc, HP, 136, 32 * pt, CE, 136, 32 * it2, C.lane);
                const int i = 32 * it2 + n; const size_t row = (size_t)bc * 64 + i; const float dh = dpar[hd];
#pragma unroll
                for (int q4 = 0; q4 < 4; ++q4) { const int p0 = 32 * pt + 8 * q4 + 4 * hi;
                    const u32x2 zw = *(const GAS u32x2*)(P + row * NPM + C_SZ + hd * 64 + p0); const float zf[4] = {bflo(zw.x), bfhi(zw.x), bflo(zw.y), bfhi(zw.y)};
#pragma unroll
                    for (int e = 0; e < 4; ++e) { const float xs = bf2f(XST[(p0 + e) * 72 + i]); const float v = (acc[4 * q4 + e] + dh * xs) * siluf_(zf[e]); yk[hh][4 * q4 + e] = v; ssq += v * v; } }
            }
        }
        if (C.wave < 4) { ssq += __shfl_xor(ssq, 32); if (hi == 0) PSQ[(32 * it2 + n) * 2 + pt] = ssq; }
        WG_SYNC();
        if (C.wave < 4) {
            const int i = 32 * it2 + n; const float rs = 1.0f / sqrtf((PSQ[i * 2] + PSQ[i * 2 + 1]) * (1.0f / 256.0f) + EPS); const size_t row = (size_t)bc * 64 + i;
#pragma unroll
            for (int hh = 0; hh < 4; ++hh)
#pragma unroll
                for (int q4 = 0; q4 < 4; ++q4) { const int ch = g * 256 + hh * 64 + 32 * pt + 8 * q4 + 4 * hi; const f32x4 sn = *(const GAS f32x4*)(snorm + ch);
                    u32x2 w; w.x = pk2(yk[hh][4 * q4] * rs * sn[0], yk[hh][4 * q4 + 1] * rs * sn[1]); w.y = pk2(yk[hh][4 * q4 + 2] * rs * sn[2], yk[hh][4 * q4 + 3] * rs * sn[3]);
                    *(GAS u32x2*)(YS + row * 2048 + 1024 + ch) = w; }
        }
    }
    WG_SYNC();
}

#ifndef RW_CHUNKED
#define RW_CHUNKED 1
#endif
__device__ __forceinline__ void rw_lerp8(const GAS bf16* P, const GAS float* mu, int bc, int t, int c0, float* o) {
    const size_t row = (size_t)bc * 64 + t; const bool first = ((bc & 127) == 0) && (t == 0);
    float x[8], xp[8]; unpack8(*(const GAS u32x4*)(P + row * NPM + C_RR + c0), x);
    if (!first) unpack8(*(const GAS u32x4*)(P + (row - 1) * NPM + C_RR + c0), xp); else {
#pragma unroll
        for (int i = 0; i < 8; ++i) xp[i] = 0.f; }
#pragma unroll
    for (int i = 0; i < 8; ++i) o[i] = x[i] + (xp[i] - x[i]) * mu[c0 + i];
}
__device__ __forceinline__ void rw_lerp4(const GAS bf16* P, const GAS float* mu, size_t row, bool first, int c0, float* o) {
    const u32x2 xw = *(const GAS u32x2*)(P + row * NPM + C_RR + c0); const float x[4] = {bflo(xw.x), bfhi(xw.x), bflo(xw.y), bfhi(xw.y)};
    float xp[4] = {0.f, 0.f, 0.f, 0.f};
    if (!first) { const u32x2 pw = *(const GAS u32x2*)(P + (row - 1) * NPM + C_RR + c0); xp[0] = bflo(pw.x); xp[1] = bfhi(pw.x); xp[2] = bflo(pw.y); xp[3] = bfhi(pw.y); }
    const f32x4 m = *(const GAS f32x4*)(mu + c0);
#pragma unroll
    for (int i = 0; i < 4; ++i) o[i] = x[i] + (xp[i] - x[i]) * m[i];
}
#define RW_WFRAG(WT_, K_, nt_, s_) (*(const GAS pg8::bf16x8*)((WT_) + (size_t)(head * 64 + 32 * (nt_) + n) * (K_) + 16 * (s_) + 8 * hi))
#define RWP_PTRS \
    const GAS bf16* P = (const GAS bf16*)(C.ws + WS_P); \
    GAS float* RWW = (GAS float*)(C.ws + WS_RWW); GAS bf16* RWR = (GAS bf16*)(C.ws + WS_RWR); GAS bf16* RWK = (GAS bf16*)(C.ws + WS_RWK); GAS bf16* RWV = (GAS bf16*)(C.ws + WS_RWV); GAS bf16* RWKK = (GAS bf16*)(C.ws + WS_RWKK); GAS bf16* RWB = (GAS bf16*)(C.ws + WS_RWB); GAS bf16* RWG = (GAS bf16*)(C.ws + WS_RWG); \
    const GAS bf16* W2T = (const GAS bf16*)(C.ws + WS_RW2T); const GAS bf16* A2T = W2T + 512 * 64; const GAS bf16* G2T = A2T + 512 * 64;       \
    const GAS float* mu = a->in[21] + (size_t)l * 1792; const GAS float* w0 = a->in[22] + (size_t)l * 512; const GAS float* a0 = a->in[24] + (size_t)l * 512; \
    const GAS float* k_k = a->in[27] + (size_t)l * 512; const GAS float* k_a = a->in[28] + (size_t)l * 512; \
    LB WLb = (LB)C.lds; LB ALb = (LB)(C.lds + 9216); LB GLb = (LB)(C.lds + 18432);         \
    LB KX = (LB)(C.lds + 35840); LF w0s = (LF)(C.lds + 102400); LF a0s = w0s + 512; LF kks = a0s + 512; LF kas = kks + 512; LF INVs = kas + 512;     \
    (void)KX; (void)w0s; (void)a0s; (void)kks; (void)kas; (void)INVs; \
    (void)P; (void)RWW; (void)RWR; (void)RWK; (void)RWV; (void)RWKK; (void)RWB; (void)RWG; (void)W2T; (void)A2T; (void)G2T; (void)mu; (void)w0; (void)a0; (void)k_k; (void)k_a; (void)WLb; (void)ALb; (void)GLb;
#define RWP_LANE const int head = C.wave, n = C.lane & 31, hi = C.lane >> 5; const size_t row0 = (size_t)bc * 64 + 32 * tt; (void)row0;
PH_FN void rwp_stage(const Ctx C, ArgsP a, int l, int bc) {
    RWP_PTRS
    WG_SYNC();
    { const int t = C.tid >> 3, cg = C.tid & 7; float o[8];
      rw_lerp8(P, mu, bc, t, 1536 + cg * 8, o);
#pragma unroll
      for (int i = 0; i < 8; ++i) o[i] = tanhf(o[i]);
      *(LAS u32x4*)(WLb + t * 72 + cg * 8) = pack8(o);
      rw_lerp8(P, mu, bc, t, 1600 + cg * 8, o); *(LAS u32x4*)(ALb + t * 72 + cg * 8) = pack8(o);
#pragma unroll
      for (int half = 0; half < 2; ++half) { rw_lerp8(P, mu, bc, t, 1664 + cg * 16 + half * 8, o);
#pragma unroll
          for (int i = 0; i < 8; ++i) o[i] = sigmoidf_(o[i]);
          *(LAS u32x4*)(GLb + t * 136 + cg * 16 + half * 8) = pack8(o); }
      const size_t row = (size_t)bc * 64 + t;
#pragma unroll 2
      for (int j = 0; j < 8; ++j) { const int c = j * 64 + cg * 8;
          rw_lerp8(P, mu, bc, t, c, o); *(GAS u32x4*)(RWR + row * 512 + c) = pack8(o);
          rw_lerp8(P, mu, bc, t, 1024 + c, o); *(GAS u32x4*)(RWV + row * 512 + c) = pack8(o);
          rw_lerp8(P, mu, bc, t, 512 + c, o); *(LAS u32x4*)(KX + t * 520 + c) = pack8(o);
          const f32x4 k0 = *(const GAS f32x4*)(k_k + c), k1 = *(const GAS f32x4*)(k_k + c + 4); float ss = 0.f;
#pragma unroll
          for (int i = 0; i < 4; ++i) { const float q0 = o[i] * k0[i], q1 = o[4 + i] * k1[i]; ss += q0 * q0 + q1 * q1; }
          ss += __shfl_xor(ss, 1); ss += __shfl_xor(ss, 2); ss += __shfl_xor(ss, 4);
          if (cg == 0) INVs[t * 8 + j] = 1.0f / fmaxf(sqrtf(ss), 1e-12f); }
      const int q = C.tid * 4; *(LAS f32x4*)(w0s + q) = *(const GAS f32x4*)((q < 512 ? w0 : q < 1024 ? a0 - 512 : q < 1536 ? k_k - 1024 : k_a - 1536) + q); }
    WG_SYNC();
}
PH_FN void rwp_w(const Ctx C, ArgsP a, int l, int bc, int tt) {
    RWP_PTRS RWP_LANE
#pragma unroll
    for (int nt = 0; nt < 2; ++nt) { f32x16 c = zero16();
#pragma unroll
        for (int s4 = 0; s4 < 4; ++s4) c = __builtin_amdgcn_mfma_f32_32x32x16_bf16(frag32(WLb, 72, 32 * tt, 16 * s4, C.lane), RW_WFRAG(W2T, 64, nt, s4), c, 0, 0, 0);
        const int ch = head * 64 + 32 * nt + n; const float w0c = w0s[ch];
#pragma unroll
        for (int r = 0; r < 16; ++r) RWW[(row0 + crow(r, hi)) * 512 + ch] = -0.606531f * sigmoidf_(w0c + c[r]); }
}
PH_FN void rwp_g(const Ctx C, ArgsP a, int l, int bc, int tt) {
    RWP_PTRS RWP_LANE
#pragma unroll
    for (int nt = 0; nt < 2; ++nt) { f32x16 c = zero16();
#pragma unroll
        for (int s8 = 0; s8 < 8; ++s8) c = __builtin_amdgcn_mfma_f32_32x32x16_bf16(frag32(GLb, 136, 32 * tt, 16 * s8, C.lane), RW_WFRAG(G2T, 128, nt, s8), c, 0, 0, 0);
        const int ch = head * 64 + 32 * nt + n;
#pragma unroll
        for (int r = 0; r < 16; ++r) RWG[(row0 + crow(r, hi)) * 512 + ch] = (bf16)f2bf(c[r]); }
}
PH_FN void rwp_ak(const Ctx C, ArgsP a, int l, int bc, int tt) {
    RWP_PTRS RWP_LANE
#pragma unroll
    for (int nt = 0; nt < 2; ++nt) { f32x16 c = zero16();
#pragma unroll
        for (int s4 = 0; s4 < 4; ++s4) c = __builtin_amdgcn_mfma_f32_32x32x16_bf16(frag32(ALb, 72, 32 * tt, 16 * s4, C.lane), RW_WFRAG(A2T, 64, nt, s4), c, 0, 0, 0);
        const int ch = head * 64 + 32 * nt + n; const float a0c = a0s[ch], kkc = kks[ch], kac = kas[ch];
#pragma unroll
        for (int r = 0; r < 16; ++r) { const int tl = 32 * tt + crow(r, hi); const float al = sigmoidf_(a0c + c[r]), x = bf2f(KX[tl * 520 + ch]), kkn = x * kkc * INVs[tl * 8 + head];
            const size_t g = ((size_t)bc * 64 + tl) * 512 + ch;
            RWKK[g] = (bf16)f2bf(kkn); RWB[g] = (bf16)f2bf(kkn * al); RWK[g] = (bf16)f2bf(x * (1.0f + (al - 1.0f) * kac)); } }
}
#undef RW_WFRAG
#undef RWP_PTRS
#undef RWP_LANE
__device__ __forceinline__ void ph_rw_prep(const Ctx& C, ArgsP a, int l) {
    for (int bc = C.bid; bc < NBC; bc += C.G) { rwp_stage(C, a, l, bc);
#pragma unroll 1
        for (int tt = 0; tt < 2; ++tt) { rwp_w(C, a, l, bc, tt); rwp_g(C, a, l, bc, tt); rwp_ak(C, a, l, bc, tt); } }
    WG_SYNC();
}
template <int CTRL> __device__ __forceinline__ float dpp_get(float x) { return __builtin_bit_cast(float, __builtin_amdgcn_update_dpp(0, __builtin_bit_cast(int, x), CTRL, 0xf, 0xf, true)); }
__device__ __forceinline__ float reduce16(float x) { x += dpp_get<0xB1>(x); x += dpp_get<0x4E>(x); x += dpp_get<0x141>(x); x += dpp_get<0x140>(x); return x; }
#define RW_BAR() do { asm volatile("s_waitcnt lgkmcnt(0)" ::: "memory"); __builtin_amdgcn_s_barrier(); asm volatile("" ::: "memory"); } while (0)
PH_FN void rw_unit(const Ctx C, int chain, int rq) {
    const GAS float* RWW = (const GAS float*)(C.ws + WS_RWW); const GAS bf16* RWR = (const GAS bf16*)(C.ws + WS_RWR); const GAS bf16* RWK = (const GAS bf16*)(C.ws + WS_RWK); const GAS bf16* RWV = (const GAS bf16*)(C.ws + WS_RWV);
    const GAS bf16* RWKK = (const GAS bf16*)(C.ws + WS_RWKK); const GAS bf16* RWB = (const GAS bf16*)(C.ws + WS_RWB); GAS bf16* RWY = (GAS bf16*)(C.ws + WS_RWY);
    const int b = chain >> 3, h = chain & 7; const size_t rowb = (size_t)b * SEQ;
    constexpr int BUFB = 43008, O_KK = 0, O_W = 8192, O_B = 16384, O_K = 24576, O_R = 32768, O_V = 40960, NBLK = SEQ / 32;
    LAS unsigned char* L = C.lds;
    if (C.wave >= 4) {
        const int p = C.tid - 256, t = p >> 3, c8 = (p & 7) * 8;
        u32x4 rr, rk, rkk, rb; f32x4 w0, w1; unsigned rv;
#define RW_LOAD(blk) do { const size_t g_ = (rowb + (size_t)(blk) * 32 + t) * 512 + h * 64; \
            w0 = *(const GAS f32x4*)(RWW + g_ + c8); w1 = *(const GAS f32x4*)(RWW + g_ + c8 + 4); rr = *(const GAS u32x4*)(RWR + g_ + c8); rk = *(const GAS u32x4*)(RWK + g_ + c8); \
            rkk = *(const GAS u32x4*)(RWKK + g_ + c8); rb = *(const GAS u32x4*)(RWB + g_ + c8); rv = *(const GAS unsigned*)(RWV + g_ + 16 * rq + (p & 7) * 2); } while (0)
#define RW_ST8(off, w_) do { float o_[8]; unpack8(w_, o_); LF d_ = (LF)(Lb + (off)) + t * 64 + c8; *(LAS f32x4*)d_ = (f32x4){o_[0], o_[1], o_[2], o_[3]}; *(LAS f32x4*)(d_ + 4) = (f32x4){o_[4], o_[5], o_[6], o_[7]}; } while (0)
        RW_LOAD(0);
        for (int blk = 0; blk < NBLK; ++blk) {
            LAS unsigned char* Lb = L + (blk & 1) * BUFB;
            { LF d = (LF)(Lb + O_W) + t * 64 + c8; *(LAS f32x4*)d = w0; *(LAS f32x4*)(d + 4) = w1; }
            RW_ST8(O_R, rr); RW_ST8(O_K, rk); RW_ST8(O_KK, rkk); RW_ST8(O_B, rb);
            { LF d = (LF)(Lb + O_V) + t * 16 + (p & 7) * 2; d[0] = bflo(rv); d[1] = bfhi(rv); }
            if (blk + 1 < NBLK) RW_LOAD(blk + 1);
            RW_BAR();
        }
        RW_BAR();
#undef RW_LOAD
#undef RW_ST8
    } else {
        const int rowl = C.lane >> 4, ks = C.lane & 15, row = 4 * C.wave + rowl;
        float S0 = 0.f, S1 = 0.f, S2 = 0.f, S3 = 0.f, ykeep = 0.f;
        GAS bf16* yout = RWY + rowb * 512 + h * 64 + 16 * rq + row;
        for (int blk = 0; blk < NBLK; ++blk) {
            RW_BAR();
            const LAS unsigned char* Lb = L + (blk & 1) * BUFB;
            CLF pKK = (CLF)(Lb + O_KK) + 4 * ks; CLF pW = (CLF)(Lb + O_W) + 4 * ks; CLF pB = (CLF)(Lb + O_B) + 4 * ks; CLF pK = (CLF)(Lb + O_K) + 4 * ks; CLF pR = (CLF)(Lb + O_R) + 4 * ks; CLF pV = (CLF)(Lb + O_V) + row;
            f32x4 kk = *(const LAS f32x4*)pKK, w = *(const LAS f32x4*)pW, bb = *(const LAS f32x4*)pB, k = *(const LAS f32x4*)pK, r = *(const LAS f32x4*)pR; float vv = *pV;
#pragma unroll 4
            for (int t = 0; t < 32; ++t) {
                f32x4 nkk, nw, nb, nk, nr; float nv;
                const int tn = (t < 31) ? t + 1 : t;
                nkk = *(const LAS f32x4*)(pKK + tn * 64); nw = *(const LAS f32x4*)(pW + tn * 64); nb = *(const LAS f32x4*)(pB + tn * 64); nk = *(const LAS f32x4*)(pK + tn * 64); nr = *(const LAS f32x4*)(pR + tn * 64); nv = pV[tn * 16];
                float sa = (S0 * kk[0] + S1 * kk[1]) + (S2 * kk[2] + S3 * kk[3]);
                sa = -reduce16(sa);
                const float vk0 = vv * k[0], vk1 = vv * k[1], vk2 = vv * k[2], vk3 = vv * k[3];
                S0 = S0 * w[0] + (sa * bb[0] + vk0); S1 = S1 * w[1] + (sa * bb[1] + vk1); S2 = S2 * w[2] + (sa * bb[2] + vk2); S3 = S3 * w[3] + (sa * bb[3] + vk3);
                float y = (S0 * r[0] + S1 * r[1]) + (S2 * r[2] + S3 * r[3]);
                y = reduce16(y);
                if ((t & 15) == ks) ykeep = y;
                if ((t & 15) == 15) yout[(size_t)(blk * 32 + (t & 16) + ks) * 512] = (bf16)f2bf(ykeep);
                kk = nkk; w = nw; bb = nb; k = nk; r = nr; vv = nv;
            }
        }
        RW_BAR();
    }
}
PH_FN void ph_rw_out(const Ctx C, ArgsP a, int l) {
    const GAS bf16* RWR = (const GAS bf16*)(C.ws + WS_RWR); const GAS bf16* RWK = (const GAS bf16*)(C.ws + WS_RWK); const GAS bf16* RWV = (const GAS bf16*)(C.ws + WS_RWV); const GAS bf16* RWG = (const GAS bf16*)(C.ws + WS_RWG); const GAS bf16* RWY = (const GAS bf16*)(C.ws + WS_RWY);
    GAS bf16* YS = (GAS bf16*)(C.ws + WS_YS);
    const GAS float* r_k = a->in[29] + (size_t)l * 512; const GAS float* nw = a->in[30] + (size_t)l * 512; const GAS float* nb = a->in[31] + (size_t)l * 512;
    const int gw = C.bid * NWAVES + C.wave, NGW = C.G * NWAVES, c0 = C.lane * 8;
    float rk[8], w8[8], b8[8];
#pragma unroll
    for (int i = 0; i < 8; ++i) { rk[i] = r_k[c0 + i]; w8[i] = nw[c0 + i]; b8[i] = nb[c0 + i]; }
    for (int row0 = gw * 2; row0 < M; row0 += NGW * 2) {
        u32x4 yw[2], rw[2], kw[2], vw[2], gw4[2];
#pragma unroll
        for (int u = 0; u < 2; ++u) { const size_t g = (size_t)(row0 + u) * 512 + c0; yw[u] = *(const GAS u32x4*)(RWY + g); rw[u] = *(const GAS u32x4*)(RWR + g); kw[u] = *(const GAS u32x4*)(RWK + g); vw[u] = *(const GAS u32x4*)(RWV + g); gw4[u] = *(const GAS u32x4*)(RWG + g); }
#pragma unroll
        for (int u = 0; u < 2; ++u) { float y[8], r[8], k[8], v[8], gg[8], o[8]; unpack8(yw[u], y); unpack8(rw[u], r); unpack8(kw[u], k); unpack8(vw[u], v); unpack8(gw4[u], gg);
            float s = 0.f, bs = 0.f;
#pragma unroll
            for (int i = 0; i < 8; ++i) { s += y[i]; bs += r[i] * k[i] * rk[i]; }
            s += __shfl_xor(s, 1); s += __shfl_xor(s, 2); s += __shfl_xor(s, 4); bs += __shfl_xor(bs, 1); bs += __shfl_xor(bs, 2); bs += __shfl_xor(bs, 4);
            const float mu = s * (1.0f / 64.0f); float q = 0.f;
#pragma unroll
            for (int i = 0; i < 8; ++i) { y[i] -= mu; q += y[i] * y[i]; }
            q += __shfl_xor(q, 1); q += __shfl_xor(q, 2); q += __shfl_xor(q, 4);
            const float rs = 1.0f / sqrtf(q * (1.0f / 64.0f) + 64e-5f);
#pragma unroll
            for (int i = 0; i < 8; ++i) o[i] = (y[i] * rs * w8[i] + b8[i] + bs * v[i]) * gg[i];
            *(GAS u32x4*)(YS + (size_t)(row0 + u) * 2048 + 1536 + c0) = pack8(o); }
    }
}

__device__ __forceinline__ int pi_swap23(int i) { return (i & ~12) | ((i & 4) << 1) | ((i & 8) >> 1); }
__device__ __forceinline__ void da_unit(const Ctx& C, const Args& a, int l, int b, int h, int jq, float lam, float oml) {
    const GAS bf16* P = (const GAS bf16*)(C.ws + WS_P); const GAS bf16* VT = (const GAS bf16*)(C.ws + WS_VT); GAS bf16* YS = (GAS bf16*)(C.ws + WS_YS);
    const GAS float* dnorm = (const GAS float*)a.in[11] + (size_t)l * 128;
    const int comp = C.wave >> 2, wq = C.wave & 3, q = C.lane & 31, hi = C.lane >> 5;
    const size_t qrow = (size_t)b * SEQ + jq * 128 + wq * 32 + q;
    pg8::bf16x8 qf[4];
#pragma unroll
    for (int d0 = 0; d0 < 4; ++d0) qf[d0] = *(const GAS pg8::bf16x8*)(P + qrow * NPM + C_DAQ + h * 128 + comp * 64 + 16 * d0 + 8 * hi);
    const int ntile = 2 * jq + 2, my_last = 2 * jq + (wq >= 2 ? 1 : 0);
    f32x16 O[4];
#pragma unroll
    for (int db = 0; db < 4; ++db)
#pragma unroll
        for (int r = 0; r < 16; ++r) O[db][r] = 0.f;
    float mrun = 0.f, lrun = 0.f;
    f32x16 negm;
#pragma unroll
    for (int r = 0; r < 16; ++r) negm[r] = 0.f;
    const GAS bf16* kgb = P + (size_t)b * SEQ * NPM + C_DAK + h * 128 + C.wave * 8;
    const GAS bf16* vgb = VT + ((size_t)(b * 4 + h) * 128 + 64 * (C.wave & 1)) * SEQ + (C.wave >> 1) * 8;
    const unsigned koff = (unsigned)C.lane * (unsigned)(NPM * 2), voff = (unsigned)C.lane * (unsigned)(SEQ * 2);
    const unsigned lds0 = (unsigned)(size_t)C.lds;
    const unsigned kdst0 = lds0 + (unsigned)(C.wave >> 3) * 8192u + (unsigned)(C.wave & 7) * 1024u;
    const unsigned vdst0 = lds0 + 32768u + (unsigned)(C.wave >> 1) * 2048u + (unsigned)(C.wave & 1) * 1024u;
    const int pq = pi_swap23(q);
    pg8::bf16x8 pb[4] = {};
    int vs = 0, vsp = 0;
#define DA_GLDS(base_, off_, dst_) do { unsigned keep_; asm volatile("s_mov_b32 %0, m0\n\ts_mov_b32 m0, %3\n\ts_nop 0\n\tglobal_load_lds_dwordx4 %1, %2\n\ts_mov_b32 m0, %0" : "=&s"(keep_) : "v"(off_), "s"(base_), "s"((unsigned)__builtin_amdgcn_readfirstlane(dst_)) : "memory"); } while (0)
#define DA_DMA(tile_, vslot_) do { const GAS bf16* kp_ = kgb + (size_t)(tile_) * 64 * NPM; const GAS bf16* vp_ = vgb + (tile_) * 64; const unsigned kd_ = kdst0 + (unsigned)((tile_) & 1) * 16384u, vd_ = vdst0 + (unsigned)(vslot_); \
        DA_GLDS(kp_, koff, kd_); DA_GLDS(kp_ + 64, koff, kd_ + 8192u); DA_GLDS(vp_, voff, vd_); DA_GLDS(vp_ + 32, voff, vd_ + 8192u); } while (0)
#define DA_STAGE(tile_) do { asm volatile("s_waitcnt vmcnt(0)" ::: "memory"); WG_SYNC(); if ((tile_) + 1 < ntile) DA_DMA((tile_) + 1, (vs == 32768) ? 0 : vs + 16384); } while (0)
#define DA_QK(tile_) do { const LAS unsigned char* kb_ = C.lds + ((tile_) & 1) * 16384 + comp * 8192 + hi * 1024 + pq * 16; pg8::bf16x8 ka_[8]; \
        _Pragma("unroll") for (int d0 = 0; d0 < 4; ++d0) { ka_[2 * d0] = *(const LAS pg8::bf16x8*)(kb_ + d0 * 2048); ka_[2 * d0 + 1] = *(const LAS pg8::bf16x8*)(kb_ + d0 * 2048 + 512); } \
        __builtin_amdgcn_sched_barrier(0); \
        p0 = __builtin_amdgcn_mfma_f32_32x32x16_bf16(ka_[0], qf[0], negm, 0, 0, 0); p1 = __builtin_amdgcn_mfma_f32_32x32x16_bf16(ka_[1], qf[0], negm, 0, 0, 0); \
        _Pragma("unroll") for (int d0 = 1; d0 < 4; ++d0) { p0 = __builtin_amdgcn_mfma_f32_32x32x16_bf16(ka_[2 * d0], qf[d0], p0, 0, 0, 0); p1 = __builtin_amdgcn_mfma_f32_32x32x16_bf16(ka_[2 * d0 + 1], qf[d0], p1, 0, 0, 0); } } while (0)
#define DA_PV(PB_, voff_) do { const LAS unsigned char* vb_ = C.lds + 32768 + (voff_); _Pragma("unroll") for (int db = 0; db < 4; ++db) _Pragma("unroll") for (int s = 0; s < 4; ++s) { \
            const pg8::bf16x8 vf_ = *(const LAS pg8::bf16x8*)(vb_ + (2 * s + hi) * 2048 + (32 * db + q) * 16); O[db] = __builtin_amdgcn_mfma_f32_32x32x16_bf16(vf_, PB_[s], O[db], 0, 0, 0); } } while (0)
#define DA_MX3(a_, b_, c_) __builtin_fmaxf(__builtin_fmaxf((a_), (b_)), (c_))
#define DA_SM_MAX(FIRST_, PBP_) do { \
        float ma = DA_MX3(p0[0], p0[1], p1[0]), mb = DA_MX3(p0[2], p0[3], p1[1]); ma = DA_MX3(ma, p1[2], p1[3]); \
        _Pragma("unroll") for (int r = 4; r < 16; r += 4) { ma = DA_MX3(ma, p0[r], p0[r + 1]); mb = DA_MX3(mb, p0[r + 2], p0[r + 3]); ma = DA_MX3(ma, p1[r], p1[r + 1]); mb = DA_MX3(mb, p1[r + 2], p1[r + 3]); } \
        float rm = __builtin_fmaxf(ma, mb); rm = __builtin_fmaxf(rm, __shfl_xor(rm, 32)); \
        if ((FIRST_) || __any(rm > 8.0f)) { const float dl = (FIRST_) ? rm : __builtin_fmaxf(rm, 0.f); mrun += dl; const float f = __builtin_amdgcn_exp2f(-dl); lrun *= f; \
            _Pragma("unroll") for (int r = 0; r < 16; ++r) { p0[r] -= dl; p1[r] -= dl; negm[r] = -mrun; } \
            _Pragma("unroll") for (int db = 0; db < 4; ++db) _Pragma("unroll") for (int r = 0; r < 16; ++r) O[db][r] *= f; \
            if (!(FIRST_)) { _Pragma("unroll") for (int s_ = 0; s_ < 4; ++s_) { const u32x4 w_ = __builtin_bit_cast(u32x4, PBP_[s_]); u32x4 o_; \
                o_.x = pk2(bflo(w_.x) * f, bfhi(w_.x) * f); o_.y = pk2(bflo(w_.y) * f, bfhi(w_.y) * f); o_.z = pk2(bflo(w_.z) * f, bfhi(w_.z) * f); o_.w = pk2(bflo(w_.w) * f, bfhi(w_.w) * f); PBP_[s_] = __builtin_bit_cast(pg8::bf16x8, o_); } } } } while (0)
#define DA_SM_EXP(PBO_) do { \
        _Pragma("unroll") for (int r = 0; r < 16; ++r) { p0[r] = __builtin_amdgcn_exp2f(p0[r]); p1[r] = __builtin_amdgcn_exp2f(p1[r]); } \
        { f32x2 s2 = {0.f, 0.f}; _Pragma("unroll") for (int r = 0; r < 16; r += 2) { s2 += (f32x2){p0[r], p0[r + 1]}; s2 += (f32x2){p1[r], p1[r + 1]}; } lrun += s2[0] + s2[1]; } \
        { u32x4 w; \
          w.x = pk2(p0[0], p0[1]); w.y = pk2(p0[2], p0[3]); w.z = pk2(p0[4], p0[5]); w.w = pk2(p0[6], p0[7]); PBO_[0] = __builtin_bit_cast(pg8::bf16x8, w); \
          w.x = pk2(p0[8], p0[9]); w.y = pk2(p0[10], p0[11]); w.z = pk2(p0[12], p0[13]); w.w = pk2(p0[14], p0[15]); PBO_[1] = __builtin_bit_cast(pg8::bf16x8, w); \
          w.x = pk2(p1[0], p1[1]); w.y = pk2(p1[2], p1[3]); w.z = pk2(p1[4], p1[5]); w.w = pk2(p1[6], p1[7]); PBO_[2] = __builtin_bit_cast(pg8::bf16x8, w); \
          w.x = pk2(p1[8], p1[9]); w.y = pk2(p1[10], p1[11]); w.z = pk2(p1[12], p1[13]); w.w = pk2(p1[14], p1[15]); PBO_[3] = __builtin_bit_cast(pg8::bf16x8, w); } } while (0)
#define DA_VADDR(i_) (vb_ + ((i_) & 3) * 4096 + ((i_) >> 2) * 512)
#define DA_PV_EXP(PBP_, voff_, PBO_) do { const LAS unsigned char* vb_ = C.lds + 32768 + (voff_) + hi * 2048 + q * 16; f32x2 s2_ = {0.f, 0.f}; unsigned pw_[16]; \
        pg8::bf16x8 vq_[4];   \
        vq_[0] = *(const LAS pg8::bf16x8*)DA_VADDR(0); vq_[1] = *(const LAS pg8::bf16x8*)DA_VADDR(1); vq_[2] = *(const LAS pg8::bf16x8*)DA_VADDR(2); \
        _Pragma("unroll") for (int i_ = 0; i_ < 16; ++i_) { const int db_ = i_ >> 2, s_ = i_ & 3; \
            if (i_ + 3 < 16) vq_[(i_ + 3) & 3] = *(const LAS pg8::bf16x8*)DA_VADDR(i_ + 3); \
            O[db_] = __builtin_amdgcn_mfma_f32_32x32x16_bf16(vq_[i_ & 3], PBP_[s_], O[db_], 0, 0, 0); \
            float e0_, e1_; if (i_ < 8) { e0_ = __builtin_amdgcn_exp2f(p0[2 * i_]); e1_ = __builtin_amdgcn_exp2f(p0[2 * i_ + 1]); } else { e0_ = __builtin_amdgcn_exp2f(p1[2 * i_ - 16]); e1_ = __builtin_amdgcn_exp2f(p1[2 * i_ - 15]); } \
            s2_ += (f32x2){e0_, e1_}; pw_[i_] = pk2(e0_, e1_); \
            __builtin_amdgcn_sched_barrier(0); } \
        lrun += s2_[0] + s2_[1]; \
        _Pragma("unroll") for (int k_ = 0; k_ < 4; ++k_) { u32x4 w_; w_.x = pw_[4 * k_]; w_.y = pw_[4 * k_ + 1]; w_.z = pw_[4 * k_ + 2]; w_.w = pw_[4 * k_ + 3]; PBO_[k_] = __builtin_bit_cast(pg8::bf16x8, w_); } } while (0)
    f32x16 p0, p1;
    if (comp == 0) __builtin_amdgcn_s_setprio(1);
    DA_DMA(0, 0);
    DA_STAGE(0); DA_QK(0); DA_SM_MAX(true, pb); DA_SM_EXP(pb);
    for (int tile = 1; tile <= my_last; ++tile) {
        vsp = vs; vs = (vs == 32768) ? 0 : vs + 16384;
        DA_STAGE(tile); DA_QK(tile); DA_SM_MAX(false, pb);
        DA_PV_EXP(pb, vsp, pb);
    }
    if (my_last < ntile - 1) { const int vkeep = vs; vs = (vs == 32768) ? 0 : vs + 16384; DA_STAGE(ntile - 1); vs = vkeep; }
    __builtin_amdgcn_s_setprio(0);
    DA_PV(pb, vs);
#undef DA_GLDS
#undef DA_DMA
#undef DA_STAGE
#undef DA_QK
#undef DA_PV
#undef DA_MX3
#undef DA_SM_MAX
#undef DA_SM_EXP
#undef DA_PV_EXP
#undef DA_VADDR
    const float ltot = lrun + __shfl_xor(lrun, 32); const float inv = 1.0f / ltot;
    WG_SYNC();
    LF X = (LF)C.lds + (wq * 32 + q) * 132;
    if (comp == 1) {
        const float sc = inv * lam;
#pragma unroll
        for (int db = 0; db < 4; ++db)
#pragma unroll
            for (int g4 = 0; g4 < 4; ++g4) *(LAS f32x4*)(X + 32 * db + 8 * g4 + 4 * hi) = (f32x4){O[db][4 * g4] * sc, O[db][4 * g4 + 1] * sc, O[db][4 * g4 + 2] * sc, O[db][4 * g4 + 3] * sc};
    }
    WG_SYNC();
    if (comp == 0) {
        float ss = 0.f;
#pragma unroll
        for (int db = 0; db < 4; ++db)
#pragma unroll
            for (int g4 = 0; g4 < 4; ++g4) { const f32x4 x = *(const LAS f32x4*)(X + 32 * db + 8 * g4 + 4 * hi);
#pragma unroll
                for (int e = 0; e < 4; ++e) { const float v = O[db][4 * g4 + e] * inv - x[e]; O[db][4 * g4 + e] = v; ss += v * v; } }
        ss += __shfl_xor(ss, 32);
        const float rs = oml / sqrtf(ss * (1.0f / 128.0f) + EPS);
#pragma unroll
        for (int db = 0; db < 4; ++db)
#pragma unroll
            for (int g4 = 0; g4 < 4; ++g4) { const int d = 32 * db + 8 * g4 + 4 * hi; const f32x4 gn = *(const GAS f32x4*)(dnorm + d);
                u32x2 w; w.x = pk2(O[db][4 * g4] * rs * gn[0], O[db][4 * g4 + 1] * rs * gn[1]); w.y = pk2(O[db][4 * g4 + 2] * rs * gn[2], O[db][4 * g4 + 3] * rs * gn[3]);
                *(GAS u32x2*)(YS + qrow * 2048 + h * 128 + d) = w; }
    }
    WG_SYNC();
}
#if RW_CHUNKED
__device__ const signed char ATT_BINS30[30][3] = {{63,4,3}, {62,5,2}, {61,6,1}, {60,7,0}, {59,8,-1}, {58,9,-1}, {57,10,-1}, {56,11,-1}, {55,12,-1}, {54,13,-1}, {53,14,-1}, {52,15,-1}, {51,16,-1}, {50,17,-1}, {49,18,-1}, {48,19,-1}, {47,20,-1}, {46,21,-1}, {45,22,-1}, {44,23,-1}, {43,24,-1}, {42,25,-1}, {41,26,-1}, {40,27,-1}, {39,28,-1}, {38,29,-1}, {37,30,-1}, {36,31,-1}, {35,32,-1}, {34,33,-1}};
__device__ __forceinline__ int att_bin_unit(int bin, int i) { return i < 3 ? (int)ATT_BINS30[bin][i] : -1; }
#else
__device__ const signed char ATT_BINS[24][12] = {{63,21,-1,-1,-1,-1,-1,-1,-1,-1,-1,-1}, {62,22,-1,-1,-1,-1,-1,-1,-1,-1,-1,-1}, {61,23,-1,-1,-1,-1,-1,-1,-1,-1,-1,-1}, {60,24,-1,-1,-1,-1,-1,-1,-1,-1,-1,-1}, {59,25,-1,-1,-1,-1,-1,-1,-1,-1,-1,-1}, {58,26,-1,-1,-1,-1,-1,-1,-1,-1,-1,-1}, {57,27,-1,-1,-1,-1,-1,-1,-1,-1,-1,-1}, {56,28,-1,-1,-1,-1,-1,-1,-1,-1,-1,-1}, {55,29,-1,-1,-1,-1,-1,-1,-1,-1,-1,-1}, {54,30,-1,-1,-1,-1,-1,-1,-1,-1,-1,-1}, {53,31,-1,-1,-1,-1,-1,-1,-1,-1,-1,-1}, {52,32,-1,-1,-1,-1,-1,-1,-1,-1,-1,-1}, {51,33,-1,-1,-1,-1,-1,-1,-1,-1,-1,-1}, {50,34,-1,-1,-1,-1,-1,-1,-1,-1,-1,-1}, {49,35,-1,-1,-1,-1,-1,-1,-1,-1,-1,-1}, {48,36,-1,-1,-1,-1,-1,-1,-1,-1,-1,-1}, {47,37,-1,-1,-1,-1,-1,-1,-1,-1,-1,-1}, {46,38,-1,-1,-1,-1,-1,-1,-1,-1,-1,-1}, {45,39,-1,-1,-1,-1,-1,-1,-1,-1,-1,-1}, {44,40,-1,-1,-1,-1,-1,-1,-1,-1,-1,-1}, {43,41,-1,-1,-1,-1,-1,-1,-1,-1,-1,-1}, {42,20,19,6,-1,-1,-1,-1,-1,-1,-1,-1}, {18,17,16,15,14,5,-1,-1,-1,-1,-1,-1}, {13,12,11,10,9,8,7,4,3,2,1,0}};
__device__ __forceinline__ int att_bin_unit(int bin, int i) { return i < 12 ? (int)ATT_BINS[bin][i] : -1; }
#endif
__device__ __forceinline__ void ph_da_attn(const Ctx& C, const Args& a, int l, int bh, int bin) {
    const GAS float* q1 = (const GAS float*)a.in[7] + (size_t)l * 64; const GAS float* k1 = (const GAS float*)a.in[8] + (size_t)l * 64; const GAS float* q2 = (const GAS float*)a.in[9] + (size_t)l * 64; const GAS float* k2 = (const GAS float*)a.in[10] + (size_t)l * 64;
    float s1 = 0.f, s2 = 0.f;
    for (int i = 0; i < 64; ++i) { s1 += q1[i] * k1[i]; s2 += q2[i] * k2[i]; }
    int ll = l; asm volatile("" : "+s"(ll));
    const float lam_init = 0.8f - 0.6f * expf(-0.3f * (float)ll); const float lam_v = expf(s1) - expf(s2) + lam_init;
    const float lam = __uint_as_float(__builtin_amdgcn_readfirstlane(__float_as_uint(lam_v))), oml = __uint_as_float(__builtin_amdgcn_readfirstlane(__float_as_uint(1.0f - lam_init)));
    for (int i = 0; i < 12; ++i) { const int jq = att_bin_unit(bin, i); if (jq < 0) break; da_unit(C, a, l, bh >> 2, bh & 3, jq, lam, oml); }
}

PH_FN void ph_final(const Ctx C, ArgsP a) {
    const GAS float* ssq = (const GAS float*)(C.ws + WS_SSQ); const GAS float* fn = a->in[39]; const GAS bf16* hb = (const GAS bf16*)(C.ws + WS_HB);
    const int gw = C.bid * NWAVES + C.wave, NGW = C.G * NWAVES;
    for (int m = gw; m < M; m += NGW) { const float rs = pg8::row_rstd((const float*)ssq, m, M); GAS f32x4* orow = (GAS f32x4*)(C.h + (size_t)m * D) + C.lane; const GAS f32x4* gr = (const GAS f32x4*)fn + C.lane;
        const GAS u32x2* hr = (const GAS u32x2*)(hb + (size_t)m * D) + C.lane;
#pragma unroll
        for (int j = 0; j < 4; ++j) { const u32x2 w = hr[64 * j]; const f32x4 g = gr[64 * j]; orow[64 * j] = (f32x4){bflo(w.x) * rs * g[0], bfhi(w.x) * rs * g[1], bflo(w.y) * rs * g[2], bfhi(w.y) * rs * g[3]}; } }
}
#define RWC_PTRS \
    GAS float* RWW = (GAS float*)(C.ws + WS_RWW); const GAS bf16* RWR = (const GAS bf16*)(C.ws + WS_RWR); const GAS bf16* RWK = (const GAS bf16*)(C.ws + WS_RWK); const GAS bf16* RWV = (const GAS bf16*)(C.ws + WS_RWV); \
    GAS bf16* RWKK = (GAS bf16*)(C.ws + WS_RWKK); GAS bf16* RWB = (GAS bf16*)(C.ws + WS_RWB); GAS bf16* RWY = (GAS bf16*)(C.ws + WS_RWY); \
    LF LGs = (LF)C.lds; LB LP = (LB)C.lds; LB LPT = (LB)(C.lds + 9216); LB AT = (LB)(C.lds + 18432); LB LAK = AT; LB LP2 = AT; LB RT = (LB)(C.lds + 27648); LB BTl = (LB)(C.lds + 36864); LB MRB = BTl; LB KTl = (LB)(C.lds + 46080); LB MRK = KTl; \
    LB VT = (LB)(C.lds + 55296); LB BHT = (LB)(C.lds + 64512); LB KHT = (LB)(C.lds + 73728); LB XB0 = (LB)(C.lds + 82944); LB XB1 = (LB)(C.lds + 101376); LB LPT2 = (LB)(C.lds + 119808); LF rho = (LF)(C.lds + 129024); LF lgl = rho + 64; \
    const int t = C.tid >> 3, g8 = C.tid & 7, n = C.lane & 31, hi = C.lane >> 5; \
    (void)RWW; (void)RWR; (void)RWK; (void)RWV; (void)RWKK; (void)RWB; (void)RWY; (void)LGs; (void)LP; (void)LPT; (void)AT; (void)LAK; (void)LP2; (void)RT; (void)BTl; (void)MRB; (void)KTl; (void)MRK; (void)VT; (void)BHT; (void)KHT; (void)XB0; (void)XB1; (void)LPT2; (void)rho; (void)lgl; (void)t; (void)g8; (void)n; (void)hi;
PH_FN void rwc_stage0(const Ctx C, int bc, int h) {
    RWC_PTRS
    const size_t row0 = (size_t)bc * 64; const size_t g = (row0 + t) * 512 + h * 64 + g8 * 8;
    WG_SYNC();
    float lw[8]; { const f32x4 x0 = *(const GAS f32x4*)(RWW + g), x1 = *(const GAS f32x4*)(RWW + g + 4); lw[0] = x0[0]; lw[1] = x0[1]; lw[2] = x0[2]; lw[3] = x0[3]; lw[4] = x1[0]; lw[5] = x1[1]; lw[6] = x1[2]; lw[7] = x1[3]; }
#pragma unroll
    for (int i = 0; i < 8; ++i) LGs[t * 68 + g8 * 8 + i] = lw[i];
    WG_SYNC();
    { const int seg = C.tid >> 6, k = C.tid & 63; float run = 0.f;
#pragma unroll
      for (int i = 0; i < 8; ++i) { run += LGs[(8 * seg + i) * 68 + k]; LGs[(8 * seg + i) * 68 + k] = run; }
      WG_SYNC();
      float off = 0.f;
#pragma unroll
      for (int sg = 0; sg < 7; ++sg) { const float tot = LGs[(8 * sg + 7) * 68 + k]; off += (sg < seg) ? tot : 0.f; }
      WG_SYNC();
#pragma unroll
      for (int i = 0; i < 8; ++i) LGs[(8 * seg + i) * 68 + k] += off; }
    WG_SYNC();
    {   float rf[8], kf[8], kkf[8], bf[8], lg[8], rh[8], ll[8], o1[8], o2[8], o3[8], o4[8];
        unpack8(*(const GAS u32x4*)(RWR + g), rf); unpack8(*(const GAS u32x4*)(RWK + g), kf); unpack8(*(const GAS u32x4*)(RWKK + g), kkf); unpack8(*(const GAS u32x4*)(RWB + g), bf);
#pragma unroll
        for (int i = 0; i < 8; ++i) { const int k = g8 * 8 + i; lg[i] = LGs[t * 68 + k]; rh[i] = LGs[31 * 68 + k]; ll[i] = LGs[63 * 68 + k]; }
#pragma unroll
        for (int i = 0; i < 8; ++i) { const int k = g8 * 8 + i; const float lm1 = lg[i] - lw[i];
            const float ed = __expf(lg[i] - rh[i]), edi = __expf(rh[i] - lg[i]), el = __expf(ll[i] - lg[i]);
            o1[i] = -kkf[i] * __expf(lm1 - rh[i]); o2[i] = rf[i] * ed; o3[i] = bf[i] * edi; o4[i] = kf[i] * edi;
            XB0[k * 72 + t] = (bf16)f2bf(-kkf[i] * __expf(lm1));
            BHT[k * 72 + t] = (bf16)f2bf(bf[i] * el); KHT[k * 72 + t] = (bf16)f2bf(kf[i] * el); }
        *(LAS u32x4*)(AT + t * 72 + g8 * 8) = pack8(o1); *(LAS u32x4*)(RT + t * 72 + g8 * 8) = pack8(o2); *(LAS u32x4*)(BTl + t * 72 + g8 * 8) = pack8(o3); *(LAS u32x4*)(KTl + t * 72 + g8 * 8) = pack8(o4);
        const u32x4 vv = *(const GAS u32x4*)(RWV + g); const unsigned vw[4] = {vv.x, vv.y, vv.z, vv.w};
#pragma unroll
        for (int i = 0; i < 4; ++i) { VT[(g8 * 8 + 2 * i) * 72 + t] = (bf16)(vw[i] & 0xffffu); VT[(g8 * 8 + 2 * i + 1) * 72 + t] = (bf16)(vw[i] >> 16); }
        if (t == 0) {
#pragma unroll
            for (int i = 0; i < 8; ++i) { rho[g8 * 8 + i] = rh[i]; lgl[g8 * 8 + i] = ll[i]; } }
    }
    WG_SYNC();
}
PH_FN void rwc_stage12(const Ctx C) {
    RWC_PTRS
    {   const int mt = C.wave >> 1, nt0 = 2 * (C.wave & 1);
        CLB Am = (mt < 2) ? (CLB)AT : (CLB)RT; const int m0 = 32 * (mt & 1);
        CLB Bm = (nt0 < 2) ? (CLB)BTl : (CLB)KTl;
        f32x16 c0 = zero16(), c1 = zero16();
        mma_nt<64>(c0, Am, 72, m0, Bm, 72, 0, C.lane); mma_nt<64>(c1, Am, 72, m0, Bm, 72, 32, C.lane);
        WG_SYNC();
#pragma unroll
        for (int r = 0; r < 16; ++r) { const int tt = m0 + crow(r, hi); const int j0 = n, j1 = 32 + n;
            if (mt < 2) { const bf16 x0 = (bf16)f2bf((j0 < tt) ? c0[r] : 0.f), x1 = (bf16)f2bf((j1 < tt) ? c1[r] : 0.f);
                if (nt0 < 2) { LP[tt * 72 + j0] = x0; LP[tt * 72 + j1] = x1; LPT[j0 * 72 + tt] = x0; LPT[j1 * 72 + tt] = x1; } else { LAK[tt * 72 + j0] = x0; LAK[tt * 72 + j1] = x1; } }
            else { const bf16 x0 = (bf16)f2bf((j0 <= tt) ? c0[r] : 0.f), x1 = (bf16)f2bf((j1 <= tt) ? c1[r] : 0.f);
                if (nt0 < 2) { MRB[tt * 72 + j0] = x0; MRB[tt * 72 + j1] = x1; } else { MRK[tt * 72 + j0] = x0; MRK[tt * 72 + j1] = x1; } } }
    }
    WG_SYNC();
    if (C.wave < 4) { const int vt = C.wave >> 1, tt0 = C.wave & 1; f32x16 c = zero16(); mma_nt<64>(c, VT, 72, 32 * vt, LAK, 72, 32 * tt0, C.lane);
#pragma unroll
        for (int r = 0; r < 16; ++r) XB0[(64 + 32 * vt + crow(r, hi)) * 72 + 32 * tt0 + n] = (bf16)f2bf(c[r]); }
    WG_SYNC();
}
#ifndef RWC_NSTEP
#define RWC_NSTEP 6
#endif
#ifndef RWC_REP0
#define RWC_REP0 1
#endif
PH_FN void rwc_solve(const Ctx C) {
    RWC_PTRS
    const int ct = C.wave >> 1, tt = C.wave & 1;
    const int sk = C.wave >> 2, st = (C.wave >> 1) & 1, sj = C.wave & 1;
#pragma unroll 1
    for (int i = 0; i < RWC_NSTEP; ++i) {
        CLB Pc = (i & 1) ? (CLB)LP2 : (CLB)LP; CLB PTc = (i & 1) ? (CLB)LPT2 : (CLB)LPT; LB Pn = (i & 1) ? LP : LP2; LB PTn = (i & 1) ? LPT : LPT2;
        CLB Xc = (i & 1) ? (CLB)XB1 : (CLB)XB0; LB Xn = (i & 1) ? XB0 : XB1;
        { f32x16 acc;
#pragma unroll
          for (int r = 0; r < 16; ++r) acc[r] = bf2f(Xc[(32 * ct + crow(r, hi)) * 72 + 32 * tt + n]);
          mma_nt<64>(acc, Xc, 72, 32 * ct, Pc, 72, 32 * tt, C.lane);
#pragma unroll
          for (int r = 0; r < 16; ++r) Xn[(32 * ct + crow(r, hi)) * 72 + 32 * tt + n] = (bf16)f2bf(acc[r]); }
        if (i < RWC_NSTEP - 1) { f32x16 acc = zero16();
          if (sk == 0) mma_nt<64>(acc, Pc, 72, 32 * st, PTc, 72, 32 * sj, C.lane); else mma_nt<64>(acc, PTc, 72, 32 * st, Pc, 72, 32 * sj, C.lane);
          LB dst = (sk == 0) ? Pn : PTn;
#pragma unroll
          for (int r = 0; r < 16; ++r) dst[(32 * st + crow(r, hi)) * 72 + 32 * sj + n] = (bf16)f2bf(acc[r]); }
        WG_SYNC();
    }
}
PH_FN void rwc_stage4(const Ctx C, int bc, int h) {
    RWC_PTRS
    const size_t row0 = (size_t)bc * 64; CLB A2T = (CLB)XB0; CLB WT = (CLB)(XB0 + 64 * 72);
    {   const int kind = C.wave >> 1, mt = C.wave & 1;
        f32x16 c0 = zero16(), c1 = zero16();
        if (kind == 0) { mma_nt<64>(c0, BHT, 72, 32 * mt, A2T, 72, 0, C.lane); mma_nt<64>(c1, BHT, 72, 32 * mt, A2T, 72, 32, C.lane); }
        else if (kind == 1) { mma_nt<64>(c0, BHT, 72, 32 * mt, WT, 72, 0, C.lane); mma_nt<64>(c1, BHT, 72, 32 * mt, WT, 72, 32, C.lane); mma_nt<64>(c0, KHT, 72, 32 * mt, VT, 72, 0, C.lane); mma_nt<64>(c1, KHT, 72, 32 * mt, VT, 72, 32, C.lane); }
        else if (kind == 2) { mma_nt<64>(c0, MRB, 72, 32 * mt, A2T, 72, 0, C.lane); mma_nt<64>(c1, MRB, 72, 32 * mt, A2T, 72, 32, C.lane); }
        else { mma_nt<64>(c0, MRB, 72, 32 * mt, WT, 72, 0, C.lane); mma_nt<64>(c1, MRB, 72, 32 * mt, WT, 72, 32, C.lane); mma_nt<64>(c0, MRK, 72, 32 * mt, VT, 72, 0, C.lane); mma_nt<64>(c1, MRK, 72, 32 * mt, VT, 72, 32, C.lane); }
#pragma unroll
        for (int r = 0; r < 16; ++r) { const int m = 32 * mt + crow(r, hi); const size_t go = (row0 + m) * 512 + h * 64;
            if (kind == 0) { const float d = __expf(lgl[m]); RWB[go + n] = (bf16)f2bf(c0[r] + ((n == m) ? d : 0.f)); RWB[go + 32 + n] = (bf16)f2bf(c1[r] + ((32 + n == m) ? d : 0.f)); }
            else if (kind == 1) { RWW[go + n] = c0[r]; RWW[go + 32 + n] = c1[r]; }
            else if (kind == 2) { RWKK[go + n] = (bf16)f2bf(c0[r] + bf2f(RT[m * 72 + n]) * __expf(rho[n])); RWKK[go + 32 + n] = (bf16)f2bf(c1[r] + bf2f(RT[m * 72 + 32 + n]) * __expf(rho[32 + n])); }
            else { RWY[go + n] = (bf16)f2bf(c0[r]); RWY[go + 32 + n] = (bf16)f2bf(c1[r]); } }
    }
}
__device__ __forceinline__ void ph_rw_chunk(const Ctx& C, int bc) {
#pragma unroll 1
    for (int h = 0; h < 8; ++h) { for (int r0 = 0; r0 < RWC_REP0; ++r0) rwc_stage0(C, bc, h); rwc_stage12(C); rwc_solve(C); rwc_stage4(C, bc, h); }
    WG_SYNC();
}
PH_FN void rw_scan_producer(const Ctx C, int chain) {
    const float* RWW = (const float*)(unsigned char*)(C.ws + WS_RWW); const bf16* RWKK = (const bf16*)(unsigned char*)(C.ws + WS_RWKK); const bf16* RWB = (const bf16*)(unsigned char*)(C.ws + WS_RWB); bf16* RWY = (bf16*)(unsigned char*)(C.ws + WS_RWY);
    const int b = chain >> 3, h = chain & 7; const size_t rowb = (size_t)b * SEQ;
    constexpr int BUFB = 45056, O_RQ = 0, O_PT = 9216, O_QT = 18432, O_Y0 = 35840;
    LAS unsigned char* L = C.lds;
        const int p = C.tid - 256, t = p >> 2, q4 = (p & 3) * 16;
        u32x4 Arq0, Arq1, Apt0, Apt1, Ay00, Ay01, Brq0, Brq1, Bpt0, Bpt1, By00, By01; f32x4 Aq0, Aq1, Aq2, Aq3, Bq0, Bq1, Bq2, Bq3;
#define SC_LOAD(S, c_) do { const size_t g_ = (rowb + (size_t)(c_) * 64 + t) * 512 + h * 64 + q4; \
            S##rq0 = *(const u32x4*)(RWKK + g_); S##rq1 = *(const u32x4*)(RWKK + g_ + 8); S##pt0 = *(const u32x4*)(RWB + g_); S##pt1 = *(const u32x4*)(RWB + g_ + 8); S##y00 = *(const u32x4*)(RWY + g_); S##y01 = *(const u32x4*)(RWY + g_ + 8); \
            S##q0 = *(const f32x4*)(RWW + g_); S##q1 = *(const f32x4*)(RWW + g_ + 4); S##q2 = *(const f32x4*)(RWW + g_ + 8); S##q3 = *(const f32x4*)(RWW + g_ + 12); } while (0)
#define SC_WRITE(S, Lb) do { \
            *(LAS u32x4*)((LB)((Lb) + O_RQ) + t * 72 + q4) = S##rq0; *(LAS u32x4*)((LB)((Lb) + O_RQ) + t * 72 + q4 + 8) = S##rq1; \
            *(LAS u32x4*)((LB)((Lb) + O_PT) + t * 72 + q4) = S##pt0; *(LAS u32x4*)((LB)((Lb) + O_PT) + t * 72 + q4 + 8) = S##pt1; \
            *(LAS u32x4*)((LB)((Lb) + O_Y0) + t * 72 + q4) = S##y00; *(LAS u32x4*)((LB)((Lb) + O_Y0) + t * 72 + q4 + 8) = S##y01; \
            { LF d_ = (LF)((Lb) + O_QT) + t * 68 + q4; *(LAS f32x4*)d_ = S##q0; *(LAS f32x4*)(d_ + 4) = S##q1; *(LAS f32x4*)(d_ + 8) = S##q2; *(LAS f32x4*)(d_ + 12) = S##q3; } } while (0)
        SC_LOAD(A, 0); SC_LOAD(B, 1);
        for (int c = 0; c < NCH; c += 2) {
            SC_WRITE(A, L); if (c + 2 < NCH) SC_LOAD(A, c + 2); RW_BAR();
            SC_WRITE(B, L + BUFB); if (c + 3 < NCH) SC_LOAD(B, c + 3); RW_BAR();
        }
        RW_BAR();
#undef SC_LOAD
#undef SC_WRITE
}
PH_FN void rw_scan_consumer(const Ctx C, int chain) {
    const float* RWW = (const float*)(unsigned char*)(C.ws + WS_RWW); const bf16* RWKK = (const bf16*)(unsigned char*)(C.ws + WS_RWKK); const bf16* RWB = (const bf16*)(unsigned char*)(C.ws + WS_RWB); bf16* RWY = (bf16*)(unsigned char*)(C.ws + WS_RWY);
    const int b = chain >> 3, h = chain & 7; const size_t rowb = (size_t)b * SEQ;
    constexpr int BUFB = 45056, O_RQ = 0, O_PT = 9216, O_QT = 18432, O_Y0 = 35840;
    LAS unsigned char* L = C.lds;
        const int n = C.lane & 31, hi = C.lane >> 5, vh = C.wave & 1;
        f32x16 st0 = zero16(), st1 = zero16();
        for (int c = 0; c < NCH; ++c) {
            RW_BAR();
            if (C.wave < 2) {
                const LAS unsigned char* Lb = L + (c & 1) * BUFB;
                CLB RQ = (CLB)(Lb + O_RQ); CLB PT = (CLB)(Lb + O_PT); CLF QT = (CLF)(Lb + O_QT); CLB Y0 = (CLB)(Lb + O_Y0);
                pg8::bf16x8 sb[4];
                { u32x4 w;
                  w.x = pk2(st0[0], st0[1]); w.y = pk2(st0[2], st0[3]); w.z = pk2(st0[4], st0[5]); w.w = pk2(st0[6], st0[7]); sb[0] = __builtin_bit_cast(pg8::bf16x8, w);
                  w.x = pk2(st0[8], st0[9]); w.y = pk2(st0[10], st0[11]); w.z = pk2(st0[12], st0[13]); w.w = pk2(st0[14], st0[15]); sb[1] = __builtin_bit_cast(pg8::bf16x8, w);
                  w.x = pk2(st1[0], st1[1]); w.y = pk2(st1[2], st1[3]); w.z = pk2(st1[4], st1[5]); w.w = pk2(st1[6], st1[7]); sb[2] = __builtin_bit_cast(pg8::bf16x8, w);
                  w.x = pk2(st1[8], st1[9]); w.y = pk2(st1[10], st1[11]); w.z = pk2(st1[12], st1[13]); w.w = pk2(st1[14], st1[15]); sb[3] = __builtin_bit_cast(pg8::bf16x8, w); }
#define SC_AFRAG(X_, row_, s_) ({ const u32x2 lo_ = *(const LAS u32x2*)((X_) + (row_) * 72 + 16 * (s_) + 4 * hi), hi_ = *(const LAS u32x2*)((X_) + (row_) * 72 + 16 * (s_) + 8 + 4 * hi); \
                    u32x4 w_; w_.x = lo_.x; w_.y = lo_.y; w_.z = hi_.x; w_.w = hi_.y; __builtin_bit_cast(pg8::bf16x8, w_); })
#pragma unroll
                for (int tt = 0; tt < 2; ++tt) { f32x16 y;
#pragma unroll
                    for (int r = 0; r < 16; ++r) y[r] = bf2f(Y0[(32 * tt + crow(r, hi)) * 72 + 32 * vh + n]);
#pragma unroll
                    for (int s = 0; s < 4; ++s) y = __builtin_amdgcn_mfma_f32_32x32x16_bf16(SC_AFRAG(RQ, 32 * tt + n, s), sb[s], y, 0, 0, 0);
                    bf16* yo = RWY + (rowb + (size_t)c * 64 + 32 * tt) * 512 + h * 64 + 32 * vh + n;
#pragma unroll
                    for (int r = 0; r < 16; ++r) yo[(size_t)crow(r, hi) * 512] = (bf16)f2bf(y[r]); }
                f32x16 n0, n1;
#pragma unroll
                for (int r = 0; r < 16; ++r) { n0[r] = QT[crow(r, hi) * 68 + 32 * vh + n]; n1[r] = QT[(32 + crow(r, hi)) * 68 + 32 * vh + n]; }
#pragma unroll
                for (int s = 0; s < 4; ++s) { n0 = __builtin_amdgcn_mfma_f32_32x32x16_bf16(SC_AFRAG(PT, n, s), sb[s], n0, 0, 0, 0); n1 = __builtin_amdgcn_mfma_f32_32x32x16_bf16(SC_AFRAG(PT, 32 + n, s), sb[s], n1, 0, 0, 0); }
                st0 = n0; st1 = n1;
#undef SC_AFRAG
            }
        }
        RW_BAR();
}
__device__ __forceinline__ void rw_scan_unit(const Ctx& C, int chain) { if (C.wave >= 4) rw_scan_producer(C, chain); else rw_scan_consumer(C, chain); }
#ifndef REP_ATTN
#define REP_ATTN 1
#endif
#ifndef REP_W
#define REP_W 1
#endif
#ifndef REP_RWC
#define REP_RWC 1
#endif
#ifndef REP_MA
#define REP_MA 1
#endif
#ifndef REP_GLAA
#define REP_GLAA 1
#endif
#ifndef REP_SSDA
#define REP_SSDA 1
#endif
#ifndef REP_RWP
#define REP_RWP 1
#endif
#ifndef REP_GLAC
#define REP_GLAC 1
#endif
#ifndef REP_SSDC
#define REP_SSDC 1
#endif
#ifndef REP_RWO
#define REP_RWO 1
#endif
#ifndef REP_MAFULL
#define REP_MAFULL 1
#endif
#ifndef REP_SCANS
#define REP_SCANS 1
#endif
#ifndef REP_MC
#define REP_MC 1
#endif
#ifndef REP_GEMM
#define REP_GEMM 1
#endif
constexpr int NPH = 12, G_FINAL = 1 + NL * NPH, G_END = G_FINAL + 1;
template <int GRP>
__global__ void __launch_bounds__(NTHR, 2) hybrid_fwd(Args args) {
    constexpr bool ALL = (GRP < 0);
    constexpr bool EN_G1 = ALL || GRP == 0, EN_G2 = EN_G1, EN_G3 = EN_G1, EN_G7 = EN_G1, EN_G8 = EN_G1, EN_G9 = EN_G1;
    constexpr bool EN_PRO = ALL || GRP == 1, EN_W = EN_PRO, EN_FIN = EN_PRO, EN_MA1 = EN_PRO, EN_MA2 = EN_PRO, EN_MA3 = EN_PRO, EN_MA4 = EN_PRO;
    constexpr bool EN_MB1 = ALL || GRP == 2, EN_MB2 = EN_MB1;
    constexpr bool EN_MC1 = ALL || GRP == 3, EN_MC2 = EN_MC1, EN_MC3 = EN_MC1;
    extern __shared__ __attribute__((aligned(16))) unsigned char lds[];
    Ctx C; C.lds = (LAS unsigned char*)lds; C.ws = (GAS unsigned char*)args.ws; C.h = (GAS float*)args.out; C.tid = threadIdx.x; C.lane = C.tid & 63; C.wave = __builtin_amdgcn_readfirstlane(C.tid >> 6); C.bid = blockIdx.x; C.G = gridDim.x;
    LAS unsigned char* ldsl = (LAS unsigned char*)lds;
    const ArgsP ap = (ArgsP)__builtin_amdgcn_kernarg_segment_ptr();
    for (int u = C.tid; u < (LDS_BYTES - LDSCTL_OFF) / 4; u += NTHR) ((LAS unsigned*)(ldsl + LDSCTL_OFF))[u] = 0u;
    __syncthreads();
    volatile LAS unsigned* MISC = (volatile LAS unsigned*)(ldsl + MISC_OFF);
    gu32* ctl = (gu32*)(args.ws + WS_CTL);
    const int g_lo = args.g_lo, g_hi = args.g_hi;
    XcdBarrier bar; bar.bar = (unsigned*)(ctl + CW_BAR); bar.x = 0; bar.st = nullptr;
    if (g_hi - g_lo > 1) bar = xcd_barrier_post((unsigned*)(ctl + CW_BAR), MISC + 8);
#define IN(g) (g_lo <= (g) && (g) < g_hi)
#define SEAM(g) do { if (IN(g) && IN((g) + 1)) xcd_barrier(bar); } while (0)
    bf16* HB = (bf16*)(args.ws + WS_HB); float* SSQ = (float*)(args.ws + WS_SSQ);

    if (IN(0)) { if (EN_PRO) ph_prologue(fresh(C), ap); if (EN_W) ph_weights(fresh(C), ap, 0); }
    SEAM(0);
#pragma unroll 1
    for (int l = 0; l < NL; ++l) {
        const int gb = 1 + NPH * l;
        if (EN_W && IN(gb + 0) && l > 0) { for (int rep = 0; rep < REP_W; ++rep) ph_weights(fresh(C), ap, l); }
        if (l > 0) SEAM(gb + 0);
#pragma unroll 1
        for (int f = 0; f < 2; ++f) {
            const int gu = gb + (f ? 10 : 1);
            if (EN_G1 && IN(gu)) {
                pg8::Gemm g{HB, (const bf16*)(args.ws + (f ? WS_WGU2 : WS_WGU1)), M, 2 * FF, D, D}; pg8::StaticOrder S; S.init(M, 2 * FF, C.G, C.bid);
                pg8::EpiSwiglu E{(bf16*)(args.ws + WS_ACT), FF, SSQ, M};
                pg8::gemm_phase<pg8::EpiSwiglu, pg8::StaticOrder, true, true>(ldsl, g, S, E);
            }
            SEAM(gu);
            if (EN_G2 && IN(gu + 1)) {
                pg8::Gemm g{(const bf16*)(args.ws + WS_ACT), (const bf16*)(args.ws + (f ? WS_WD2 : WS_WD1)), M, D, FF, FF}; pg8::StaticOrder S; S.init(M, D, C.G, C.bid);
                pg8::EpiResid E{HB, SSQ, M, 0.5f};
                pg8::gemm_phase<pg8::EpiResid, pg8::StaticOrder, false, true>(ldsl, g, S, E);
            }
            SEAM(gu + 1);
            if (f == 0) {
                if (EN_G3 && IN(gb + 3)) {
                    pg8::Gemm g{HB, (const bf16*)(args.ws + WS_WIN), M, NPM, D, D}; pg8::StaticOrder S; S.init(M, NPM, C.G, C.bid);
                    pg8::EpiScaleBf16 E{(bf16*)(args.ws + WS_P), NPM, SSQ, M};
                    pg8::gemm_phase<pg8::EpiScaleBf16, pg8::StaticOrder, true, true>(ldsl, g, S, E);
                }
                SEAM(gb + 3);
                if (IN(gb + 4)) { if (EN_MA1) ph_da_prep(fresh(C)); for (int rf = 0; rf < REP_MAFULL; ++rf) { for (int rep = 0; rep < REP_MA; ++rep) { for (int r2 = 0; r2 < REP_GLAA; ++r2) if (EN_MA2) ph_gla_a(fresh(C), ap, l); for (int r2 = 0; r2 < REP_SSDA; ++r2) if (EN_MA3) ph_ssd_a(fresh(C), ap, l); for (int r2 = 0; r2 < REP_RWP; ++r2) if (EN_MA4) ph_rw_prep(fresh(C), ap, l); } if (EN_MA4 && RW_CHUNKED) ph_rw_chunk(fresh(C), C.bid); } }
                SEAM(gb + 4);
                if (IN(gb + 5)) {
#if RW_CHUNKED
#define MB_SCANS() do { if (EN_MB2) { if (C.bid < 16) rw_scan_unit(fresh(C), C.bid); else { for (int p = C.bid - 16; p < 192; p += C.G - 16) { if (p < 64) gla_scan_part(fresh(C), p); else ssd_scan_part(fresh(C), p - 64); } } } } while (0)
                    MB_SCANS();
                    for (int rs = 1; rs < REP_SCANS; ++rs) {
                        xcd_barrier(bar); if (EN_MA2) ph_gla_a(fresh(C), ap, l); if (EN_MA3) ph_ssd_a(fresh(C), ap, l); if (EN_MA4) { ph_rw_prep(fresh(C), ap, l); ph_rw_chunk(fresh(C), C.bid); } xcd_barrier(bar); MB_SCANS(); }
                    if (C.bid >= 16) { const int a = C.bid - 16; for (int rep = 0; rep < REP_ATTN; ++rep) if (EN_MB1) ph_da_attn(fresh(C), args, l, a & 7, a >> 3); }
#else
                    if (C.bid < 64) { if (EN_MB2) { const int xcd = C.bid & 7, slot = C.bid >> 3; for (int rep = 0; rep < REP_RWC; ++rep) rw_unit(fresh(C), xcd * 2 + (slot >> 2), slot & 3); } }
                    else { const int a = C.bid - 64;
                        if (EN_MB2) { for (int p = a; p < 192; p += 192) { if (p < 64) gla_scan_part(fresh(C), p); else ssd_scan_part(fresh(C), p - 64); } }
                        for (int rep = 0; rep < REP_ATTN; ++rep) if (EN_MB1) ph_da_attn(fresh(C), args, l, a & 7, a >> 3); }
#endif
                }
                SEAM(gb + 5);
                if (IN(gb + 6)) { for (int rep = 0; rep < REP_MC; ++rep) { for (int r2 = 0; r2 < REP_GLAC; ++r2) if (EN_MC1) ph_gla_c(fresh(C), ap, l); for (int r2 = 0; r2 < REP_SSDC; ++r2) if (EN_MC2) ph_ssd_c(fresh(C), ap, l); for (int r2 = 0; r2 < REP_RWO; ++r2) if (EN_MC3) ph_rw_out(fresh(C), ap, l); } }
                SEAM(gb + 6);
                if (EN_G7 && IN(gb + 7)) {
                    pg8::Gemm g{HB, (const bf16*)(args.ws + WS_WIN) + (size_t)NPM * D, M, 4096, D, D}; pg8::StaticOrder S; S.init(M, 4096, C.G, C.bid);
                    pg8::EpiScaleBf16 E{(bf16*)(args.ws + WS_PG), 4096, SSQ, M};
                    pg8::gemm_phase<pg8::EpiScaleBf16, pg8::StaticOrder, true, true>(ldsl, g, S, E);
                }
                SEAM(gb + 7);
                if (EN_G8 && IN(gb + 8)) {
                    pg8::Gemm g{(const bf16*)(args.ws + WS_YS), (const bf16*)(args.ws + WS_WB), M, D, 2048, 2048}; pg8::StaticOrder S; S.init(M, D, C.G, C.bid);
                    pg8::EpiGateHorner E{(bf16*)(args.ws + WS_MERGED), (const bf16*)(args.ws + WS_PG), args.in[33] + (size_t)l * 4096};
                    pg8::gemm_phase<pg8::EpiGateHorner, pg8::StaticOrder, true, true>(ldsl, g, S, E);
                }
                SEAM(gb + 8);
                if (EN_G9 && IN(gb + 9)) {
                    pg8::Gemm g{(const bf16*)(args.ws + WS_MERGED), (const bf16*)(args.ws + WS_WO), M, D, D, D}; pg8::StaticOrder S; S.init(M, D, C.G, C.bid);
                    pg8::EpiResid E{HB, SSQ, M, 1.0f};
                    pg8::gemm_phase<pg8::EpiResid, pg8::StaticOrder, false, true>(ldsl, g, S, E);
                }
                SEAM(gb + 9);
            }
        }
    }
    if (EN_FIN && IN(G_FINAL)) ph_final(fresh(C), ap);
#undef IN
#undef SEAM
}

#ifndef ONE_LAUNCH
#define ONE_LAUNCH 1
#endif
extern "C" void kernel_launch(void* const* d_in, const int* in_sizes, int n_in, void* d_out, int out_size, void* d_ws, size_t ws_size, hipStream_t stream) {
    static int grid = 0;
    if (grid == 0) {
        if (n_in != 40 || in_sizes[0] != M * D || out_size != M * D || ws_size < WS_END) { fprintf(stderr, "kernel_launch: unexpected shapes (n_in %d, in0 %d, out %d, ws %zu < %zu); nothing launched\n", n_in, n_in > 0 ? in_sizes[0] : -1, out_size, ws_size, (size_t)WS_END); grid = -1; return; }
        int dev = 0, cus = 0, per_cu = 0;
        if (hipGetDevice(&dev) != hipSuccess || hipDeviceGetAttribute(&cus, hipDeviceAttributeMultiprocessorCount, dev) != hipSuccess) { grid = -1; return; }
#if ONE_LAUNCH
        if (hipFuncSetAttribute((const void*)hybrid_fwd<-1>, hipFuncAttributeMaxDynamicSharedMemorySize, LDS_BYTES) != hipSuccess) { fprintf(stderr, "kernel_launch: hipFuncSetAttribute failed\n"); grid = -1; return; }
#else
        if (hipFuncSetAttribute((const void*)hybrid_fwd<0>, hipFuncAttributeMaxDynamicSharedMemorySize, LDS_BYTES) != hipSuccess || hipFuncSetAttribute((const void*)hybrid_fwd<1>, hipFuncAttributeMaxDynamicSharedMemorySize, LDS_BYTES) != hipSuccess ||
            hipFuncSetAttribute((const void*)hybrid_fwd<2>, hipFuncAttributeMaxDynamicSharedMemorySize, LDS_BYTES) != hipSuccess || hipFuncSetAttribute((const void*)hybrid_fwd<3>, hipFuncAttributeMaxDynamicSharedMemorySize, LDS_BYTES) != hipSuccess) { fprintf(stderr, "kernel_launch: hipFuncSetAttribute failed\n"); grid = -1; return; }
#endif
        if (hipOccupancyMaxActiveBlocksPerMultiprocessor(&per_cu, (const void*)hybrid_fwd<(ONE_LAUNCH ? -1 : 0)>, NTHR, LDS_BYTES) != hipSuccess || per_cu < 1) fprintf(stderr, "kernel_launch: occupancy query reports %d workgroups per CU\n", per_cu);
        (void)hipGetLastError();
        grid = cus;
        if (grid != 256) { fprintf(stderr, "kernel_launch: %d CUs; this kernel is laid out for 256 workgroups; nothing launched\n", grid); grid = -1; return; }
    }
    if (grid < 0) return;
    if (hipMemsetAsync((char*)d_ws + WS_CTL, 0, CTL_ZERO_BYTES, stream) != hipSuccess) return;
    Args a{};
    for (int i = 0; i < 40; ++i) a.in[i] = (const float*)d_in[i];
    a.out = (float*)d_out; a.ws = (unsigned char*)d_ws;
    for (int j = 0; j < 32; ++j) a.inv_freq[j] = (float)pow(10000.0, -(double)j / 32.0);
#if ONE_LAUNCH
    a.g_lo = 0; a.g_hi = G_END;
    hipLaunchKernelGGL(hybrid_fwd<-1>, dim3(grid), dim3(NTHR), LDS_BYTES, stream, a);
#else
    for (int g = 0; g < G_END; ++g) {
        a.g_lo = g; a.g_hi = g + 1;
        int grp = 1;
        if (g >= 1 && g < G_FINAL) { const int k = (g - 1) % NPH; grp = (k == 0 || k == 4) ? 1 : (k == 5) ? 2 : (k == 6) ? 3 : 0; }
        if (grp == 0) hipLaunchKernelGGL(hybrid_fwd<0>, dim3(grid), dim3(NTHR), LDS_BYTES, stream, a);
        else if (grp == 1) hipLaunchKernelGGL(hybrid_fwd<1>, dim3(grid), dim3(NTHR), LDS_BYTES, stream, a);
        else if (grp == 2) hipLaunchKernelGGL(hybrid_fwd<2>, dim3(grid), dim3(NTHR), LDS_BYTES, stream, a);
        else hipLaunchKernelGGL(hybrid_fwd<3>, dim3(grid), dim3(NTHR), LDS_BYTES, stream, a);
    }
#endif
}
```

```cpp
#include <hip/hip_runtime.h>
#include <cstdio>
#include <cstdint>
#include <cmath>

namespace pg8 {
#define PG8_LAS __attribute__((address_space(3)))
typedef unsigned short bf16_t;
typedef short bf16x8 __attribute__((ext_vector_type(8)));
typedef float f32x4 __attribute__((ext_vector_type(4)));
typedef unsigned u32x4 __attribute__((ext_vector_type(4)));
constexpr int BM = 256, BK = 64, HALF = 128, HTB = HALF * BK * 2  , STAGE_BYTES = 8 * HTB, NXCD = 8, WGM = 8;

__host__ __device__ __forceinline__ int lds_byte(int r, int c) { const int st = (r >> 4) * 2 + (c >> 5), rr = r & 15, cc = c & 31, ob = rr * 64 + cc * 2; return st * 1024 + (ob ^ (((ob >> 9) & 1) << 5)); }
__host__ __device__ __forceinline__ void stage_rc(int b, int& R, int& C) { const int st = b / 1024, sb = b % 1024, swz = sb ^ (((sb >> 9) & 1) << 5); R = (st >> 1) * 16 + swz / 64; C = (st & 1) * 32 + (swz % 64) / 2; }
__host__ __device__ __forceinline__ int perm32(int rho) { const int n = rho >> 4, i = rho & 15; return 8 * (i >> 2) + 4 * n + (i & 3); }

struct Unit { int pm, pn, z; };
struct Gemm { const bf16_t* A; const bf16_t* Bt; int M, N, K, lda; };

struct StaticOrder {
    int nM, nN, nwg, G, c;
    __host__ __device__ void init(int M, int N, int G_, int c_) { nM = M / BM; nN = N / BM; nwg = nM * nN; G = G_; c = c_; }
    __host__ __device__ bool next(int i, Unit& u) const {
        const long L = (long)i * G + c; if (L >= nwg) return false;
        int wgid = (int)L; { const int q = nwg / NXCD, r = nwg % NXCD, xcd = wgid % NXCD, off = wgid / NXCD; wgid = (xcd < r ? xcd * (q + 1) : r * (q + 1) + (xcd - r) * q) + off; }
        const int nig = WGM * nN, gid = wgid / nig, fm = gid * WGM, gsz = (nM - fm) < WGM ? (nM - fm) : WGM;
        u.pm = fm + ((wgid % nig) % gsz); u.pn = (wgid % nig) / gsz; u.z = 0; return true;
    }
    __device__ __forceinline__ void a_ready(const Unit&) const {}
    __device__ __forceinline__ void done(const Unit&) const {}
    __device__ __forceinline__ size_t a_off(const Unit&) const { return 0; }
    __device__ __forceinline__ int b_tile(const Unit& u) const { return u.pn; }
};
struct GroupedOrder {
    StaticOrder base; int NZ, Kbytes, tiles_per_group;
    __device__ void init(int M, int N, int NZ_, int K, int G_, int c_) { base.init(M, N, G_, c_); NZ = NZ_; Kbytes = K * 2; tiles_per_group = N / BM; }
    __device__ bool next(int i, Unit& u) const { const int r = i / NZ, z = i - r * NZ; if (!base.next(r, u)) return false; u.z = z; return true; }
    __device__ __forceinline__ void a_ready(const Unit&) const {}
    __device__ __forceinline__ void done(const Unit&) const {}
    __device__ __forceinline__ size_t a_off(const Unit& u) const { return (size_t)u.z * Kbytes; }
    __device__ __forceinline__ int b_tile(const Unit& u) const { return u.z * tiles_per_group + u.pn; }
};

__device__ __forceinline__ unsigned cvt_pk_bf16(float lo, float hi) { unsigned r; asm volatile("v_cvt_pk_bf16_f32 %0, %1, %2" : "=v"(r) : "v"(lo), "v"(hi)); return r; }
__device__ __forceinline__ float bf_lo(unsigned w) { return __uint_as_float(w << 16); }
__device__ __forceinline__ float bf_hi(unsigned w) { return __uint_as_float(w & 0xffff0000u); }
__device__ __forceinline__ float fast_sigmoid(float x) { return __builtin_amdgcn_rcpf(1.0f + __builtin_amdgcn_exp2f(-1.4426950408889634f * x)); }

__device__ __forceinline__ float row_rstd(const float* ssq, int row, int M_) {
    const f32x4 p = *(const f32x4*)(ssq + (size_t)row * 4); const float s = (p[0] + p[1]) + (p[2] + p[3]); (void)M_;
    return 1.0f / sqrtf(s * (1.0f / 1024.0f) + 1e-6f);
}
struct EpiScaleBf16 {
    static constexpr bool PERM = true, AFTER_DRAIN = false; static constexpr int SEG_TILES = 0;
    bf16_t* O; int ldc; const float* ssq; int M_;
    __device__ __forceinline__ void operator()(const f32x4 (&acc)[2][2][4][2], const Unit& u, int wr, int wc, int fr, int fq) const {
        const int row0 = u.pm * BM + wr * 64 + fr; const int col0 = u.pn * BM + wc * 32 + 8 * fq;
#pragma unroll
        for (int ai = 0; ai < 2; ++ai)
#pragma unroll
            for (int m = 0; m < 4; ++m) { const int row = row0 + ai * HALF + m * 16; const float rs = row_rstd(ssq, row, M_); bf16_t* rowp = O + (size_t)row * ldc + col0;
#pragma unroll
                for (int bj = 0; bj < 2; ++bj) { const f32x4 v0 = acc[ai][bj][m][0] * rs, v1 = acc[ai][bj][m][1] * rs;
                    u32x4 w; w.x = cvt_pk_bf16(v0[0], v0[1]); w.y = cvt_pk_bf16(v0[2], v0[3]); w.z = cvt_pk_bf16(v1[0], v1[1]); w.w = cvt_pk_bf16(v1[2], v1[3]);
                    *(u32x4*)(rowp + bj * HALF) = w; } }
    }
};
struct EpiSwiglu {
    static constexpr bool PERM = true, AFTER_DRAIN = false; static constexpr int SEG_TILES = 0;
    bf16_t* O; int ldc; const float* ssq; int M_;
    __device__ __forceinline__ void operator()(const f32x4 (&acc)[2][2][4][2], const Unit& u, int wr, int wc, int fr, int fq) const {
        const int row0 = u.pm * BM + wr * 64 + fr; const int col0 = u.pn * HALF + wc * 32 + 8 * fq;
#pragma unroll
        for (int ai = 0; ai < 2; ++ai)
#pragma unroll
            for (int m = 0; m < 4; ++m) { const int row = row0 + ai * HALF + m * 16; const float rs = row_rstd(ssq, row, M_); bf16_t* rowp = O + (size_t)row * ldc + col0;
                float o[8];
#pragma unroll
                for (int n = 0; n < 2; ++n)
#pragma unroll
                    for (int i = 0; i < 4; ++i) { const float g = acc[ai][0][m][n][i] * rs, up = acc[ai][1][m][n][i] * rs; o[n * 4 + i] = g * fast_sigmoid(g) * up; }
                u32x4 w; w.x = cvt_pk_bf16(o[0], o[1]); w.y = cvt_pk_bf16(o[2], o[3]); w.z = cvt_pk_bf16(o[4], o[5]); w.w = cvt_pk_bf16(o[6], o[7]);
                *(u32x4*)rowp = w; }
    }
};
struct EpiGateAcc {
    static constexpr bool PERM = true, AFTER_DRAIN = false; static constexpr int SEG_TILES = 0;
    bf16_t* O; const bf16_t* PG; const float* gb;
    __device__ __forceinline__ void operator()(const f32x4 (&acc)[2][2][4][2], const Unit& u, int wr, int wc, int fr, int fq) const {
        const int row0 = u.pm * BM + wr * 64 + fr; const int col0 = u.pn * BM + wc * 32 + 8 * fq; const int z = u.z;
        f32x4 gbv[2][2];
#pragma unroll
        for (int bj = 0; bj < 2; ++bj)
#pragma unroll
            for (int n = 0; n < 2; ++n) gbv[bj][n] = *(const f32x4*)(gb + z * 1024 + col0 + bj * HALF + 4 * n);
#pragma unroll
        for (int ai = 0; ai < 2; ++ai)
#pragma unroll
            for (int m = 0; m < 4; ++m) { const int row = row0 + ai * HALF + m * 16;
#pragma unroll
                for (int bj = 0; bj < 2; ++bj) {
                    const u32x4 pg = *(const u32x4*)(PG + (size_t)row * 4096 + z * 1024 + col0 + bj * HALF);
                    bf16_t* op = O + (size_t)row * 1024 + col0 + bj * HALF;
                    float o[8];
                    o[0] = fast_sigmoid(bf_lo(pg.x) + gbv[bj][0][0]) * acc[ai][bj][m][0][0]; o[1] = fast_sigmoid(bf_hi(pg.x) + gbv[bj][0][1]) * acc[ai][bj][m][0][1];
                    o[2] = fast_sigmoid(bf_lo(pg.y) + gbv[bj][0][2]) * acc[ai][bj][m][0][2]; o[3] = fast_sigmoid(bf_hi(pg.y) + gbv[bj][0][3]) * acc[ai][bj][m][0][3];
                    o[4] = fast_sigmoid(bf_lo(pg.z) + gbv[bj][1][0]) * acc[ai][bj][m][1][0]; o[5] = fast_sigmoid(bf_hi(pg.z) + gbv[bj][1][1]) * acc[ai][bj][m][1][1];
                    o[6] = fast_sigmoid(bf_lo(pg.w) + gbv[bj][1][2]) * acc[ai][bj][m][1][2]; o[7] = fast_sigmoid(bf_hi(pg.w) + gbv[bj][1][3]) * acc[ai][bj][m][1][3];
                    if (z > 0) { const u32x4 pv = *(const u32x4*)op;
                        o[0] += bf_lo(pv.x); o[1] += bf_hi(pv.x); o[2] += bf_lo(pv.y); o[3] += bf_hi(pv.y); o[4] += bf_lo(pv.z); o[5] += bf_hi(pv.z); o[6] += bf_lo(pv.w); o[7] += bf_hi(pv.w); }
                    u32x4 w; w.x = cvt_pk_bf16(o[0], o[1]); w.y = cvt_pk_bf16(o[2], o[3]); w.z = cvt_pk_bf16(o[4], o[5]); w.w = cvt_pk_bf16(o[6], o[7]);
                    *(u32x4*)op = w; } }
    }
};
struct EpiGateHorner {
    static constexpr bool PERM = true, AFTER_DRAIN = false; static constexpr int SEG_TILES = 8;
    bf16_t* O; const bf16_t* PG; const float* gb;
    __device__ __forceinline__ void em8(const bf16_t* pgp, const float* gbp, float* e) const {
        const u32x4 pg = *(const u32x4*)pgp; const f32x4 b0 = *(const f32x4*)gbp, b1 = *(const f32x4*)(gbp + 4);
        e[0] = __builtin_amdgcn_exp2f(-1.4426950408889634f * (bf_lo(pg.x) + b0[0])); e[1] = __builtin_amdgcn_exp2f(-1.4426950408889634f * (bf_hi(pg.x) + b0[1]));
        e[2] = __builtin_amdgcn_exp2f(-1.4426950408889634f * (bf_lo(pg.y) + b0[2])); e[3] = __builtin_amdgcn_exp2f(-1.4426950408889634f * (bf_hi(pg.y) + b0[3]));
        e[4] = __builtin_amdgcn_exp2f(-1.4426950408889634f * (bf_lo(pg.z) + b1[0])); e[5] = __builtin_amdgcn_exp2f(-1.4426950408889634f * (bf_hi(pg.z) + b1[1]));
        e[6] = __builtin_amdgcn_exp2f(-1.4426950408889634f * (bf_lo(pg.w) + b1[2])); e[7] = __builtin_amdgcn_exp2f(-1.4426950408889634f * (bf_hi(pg.w) + b1[3]));
    }
    __device__ __forceinline__ void seg(f32x4 (&acc)[2][2][4][2], const Unit& u, int z, int wr, int wc, int fr, int fq) const {
        const int row0 = u.pm * BM + wr * 64 + fr; const int col0 = u.pn * BM + wc * 32 + 8 * fq;
#pragma unroll
        for (int ai = 0; ai < 2; ++ai)
#pragma unroll
            for (int m = 0; m < 4; ++m) { const int row = row0 + ai * HALF + m * 16;
#pragma unroll
                for (int bj = 0; bj < 2; ++bj) { const int c = col0 + bj * HALF; float ea[8], eb[8];
                    em8(PG + (size_t)row * 4096 + z * 1024 + c, gb + z * 1024 + c, ea); em8(PG + (size_t)row * 4096 + (z + 1) * 1024 + c, gb + (z + 1) * 1024 + c, eb);
#pragma unroll
                    for (int i = 0; i < 4; ++i) { acc[ai][bj][m][0][i] *= (1.0f + eb[i]) * __builtin_amdgcn_rcpf(1.0f + ea[i]); acc[ai][bj][m][1][i] *= (1.0f + eb[4 + i]) * __builtin_amdgcn_rcpf(1.0f + ea[4 + i]); } }
                if (m & 1) asm volatile("" ::: "memory"); }
    }
    __device__ __forceinline__ void operator()(const f32x4 (&acc)[2][2][4][2], const Unit& u, int wr, int wc, int fr, int fq) const {
        const int row0 = u.pm * BM + wr * 64 + fr; const int col0 = u.pn * BM + wc * 32 + 8 * fq;
#pragma unroll
        for (int ai = 0; ai < 2; ++ai)
#pragma unroll
            for (int m = 0; m < 4; ++m) { const int row = row0 + ai * HALF + m * 16;
#pragma unroll
                for (int bj = 0; bj < 2; ++bj) { const int c = col0 + bj * HALF; float e[8], o[8];
                    em8(PG + (size_t)row * 4096 + 3 * 1024 + c, gb + 3 * 1024 + c, e);
#pragma unroll
                    for (int i = 0; i < 4; ++i) { o[i] = acc[ai][bj][m][0][i] * __builtin_amdgcn_rcpf(1.0f + e[i]); o[4 + i] = acc[ai][bj][m][1][i] * __builtin_amdgcn_rcpf(1.0f + e[4 + i]); }
                    u32x4 w; w.x = cvt_pk_bf16(o[0], o[1]); w.y = cvt_pk_bf16(o[2], o[3]); w.z = cvt_pk_bf16(o[4], o[5]); w.w = cvt_pk_bf16(o[6], o[7]);
                    *(u32x4*)(O + (size_t)row * 1024 + c) = w; } }
    }
};
struct EpiResid {
    static constexpr bool PERM = true, AFTER_DRAIN = true; static constexpr int SEG_TILES = 0;
    bf16_t* HB; float* ssq; int M_; float s;
    __device__ __forceinline__ void fused(f32x4 (&acc)[2][2][4][2], const Unit& u, int wr, int wc, int fr, int fq, PG8_LAS unsigned char* lds, int wid, int lane) const {
        PG8_LAS float* P = (PG8_LAS float*)lds;
        const int row0 = u.pm * BM + wr * 64 + fr; const int col0 = u.pn * BM + wc * 32 + 8 * fq;
#pragma unroll
        for (int ai = 0; ai < 2; ++ai)
#pragma unroll
            for (int m = 0; m < 4; ++m) { const int row = row0 + ai * HALF + m * 16; float q = 0.f;
#pragma unroll
                for (int bj = 0; bj < 2; ++bj) { bf16_t* hp = HB + (size_t)row * 1024 + col0 + bj * HALF; const u32x4 hw = *(const u32x4*)hp;
                    const f32x4 h0 = (f32x4){bf_lo(hw.x), bf_hi(hw.x), bf_lo(hw.y), bf_hi(hw.y)} + acc[ai][bj][m][0] * s, h1 = (f32x4){bf_lo(hw.z), bf_hi(hw.z), bf_lo(hw.w), bf_hi(hw.w)} + acc[ai][bj][m][1] * s;
                    q += (h0[0] * h0[0] + h0[1] * h0[1]) + (h0[2] * h0[2] + h0[3] * h0[3]) + (h1[0] * h1[0] + h1[1] * h1[1]) + (h1[2] * h1[2] + h1[3] * h1[3]);
                    u32x4 w; w.x = cvt_pk_bf16(h0[0], h0[1]); w.y = cvt_pk_bf16(h0[2], h0[3]); w.z = cvt_pk_bf16(h1[0], h1[1]); w.w = cvt_pk_bf16(h1[2], h1[3]);
                    *(u32x4*)hp = w; }
                q += __shfl_xor(q, 16); q += __shfl_xor(q, 32);
                if (fq == 0) P[(ai * HALF + wr * 64 + m * 16 + fr) * 4 + wc] = q; }
        asm volatile("s_waitcnt lgkmcnt(0)" ::: "memory"); __builtin_amdgcn_s_barrier(); asm volatile("" ::: "memory");
        const int t = wid * 64 + lane;
        if (t < 256) { const float q = (P[t * 4 + 0] + P[t * 4 + 1]) + (P[t * 4 + 2] + P[t * 4 + 3]); ssq[(size_t)(u.pm * BM + t) * 4 + u.pn] = q; }
        asm volatile("s_waitcnt lgkmcnt(0)" ::: "memory"); __builtin_amdgcn_s_barrier(); asm volatile("" ::: "memory");
    }
};
template <class Epi, class Sched, bool ALIGN_EPI = false, bool SP2 = false>
__device__ __forceinline__ void gemm_phase(PG8_LAS unsigned char* lds, const Gemm g, const Sched& S, const Epi& E) {
    int tid_ = threadIdx.x; asm volatile("" : "+v"(tid_)); const int tid = tid_, wid = __builtin_amdgcn_readfirstlane(tid >> 6), lane = tid & 63, wr = wid >> 2, wc = wid & 3, fr = lane & 15, fq = lane >> 4;
    const int K = g.K, nt = K / BK;
    unsigned voffA[2], voffB[2];
#pragma unroll
    for (int i = 0; i < 2; ++i) { int R, C; stage_rc(tid * 16 + i * 8192, R, C); const int Rb = Epi::PERM ? ((R & ~31) + perm32(R & 31)) : R;
        voffA[i] = (unsigned)(R * g.lda + C) * 2u; voffB[i] = (unsigned)(Rb * K + C) * 2u; }
    const size_t kstep = (size_t)(BK * 2);
    const size_t hstep = (size_t)HALF * K * 2;
    const size_t tstep = 2 * hstep; const size_t hstepA = (size_t)HALF * g.lda * 2, tstepA = 2 * hstepA;
    const unsigned ldsw = (unsigned)wid * 1024u;
    const int aoff = lds_byte(wr * 64 + fr, fq * 8), boff = lds_byte(wc * 32 + fr, fq * 8);
#define PG8_SA(b, h) (((b) * 2 + (h)) * HTB)
#define PG8_SB(b, h) ((4 + (b) * 2 + (h)) * HTB)
#define PG8_STAGE(bufoff, gbase, voff) do { _Pragma("unroll") for (int _i = 0; _i < 2; ++_i) \
        __builtin_amdgcn_global_load_lds((const unsigned*)((const char*)(gbase) + (voff)[_i]), (PG8_LAS unsigned*)(lds + (bufoff) + ldsw + _i * 8192), 16, 0, 0); } while (0)
#define PG8_LDA(dst, b, h) do { _Pragma("unroll") for (int m = 0; m < 4; ++m) _Pragma("unroll") for (int k = 0; k < 2; ++k) dst[m][k] = *(const PG8_LAS bf16x8*)(lds + PG8_SA(b, h) + aoff + m * 2048 + k * 1024); } while (0)
#define PG8_LDB(dst, b, h) do { _Pragma("unroll") for (int n = 0; n < 2; ++n) _Pragma("unroll") for (int k = 0; k < 2; ++k) dst[n][k] = *(const PG8_LAS bf16x8*)(lds + PG8_SB(b, h) + boff + n * 2048 + k * 1024); } while (0)
#define PG8_MMA(ai, bj, At, Bt) do { __builtin_amdgcn_s_setprio(1); _Pragma("unroll") for (int m = 0; m < 4; ++m) _Pragma("unroll") for (int n = 0; n < 2; ++n) _Pragma("unroll") for (int k = 0; k < 2; ++k) \
        acc[ai][bj][m][n] = __builtin_amdgcn_mfma_f32_16x16x32_bf16(Bt[n][k], At[m][k], acc[ai][bj][m][n], 0, 0, 0); __builtin_amdgcn_s_setprio(0); } while (0)
#define PG8_WAIT_V(n) asm volatile("s_waitcnt vmcnt(" #n ")" ::: "memory")
#define PG8_WAIT_L(n) asm volatile("s_waitcnt lgkmcnt(" #n ")" ::: "memory")
#define PG8_BAR __builtin_amdgcn_s_barrier()
#define PG8_SCHED __builtin_amdgcn_sched_barrier(0)
    Unit cur, nxt; int ui = 0;
    if (!S.next(0, cur)) return;
    f32x4 acc[2][2][4][2];
#pragma unroll
    for (int a = 0; a < 2; ++a)
#pragma unroll
        for (int b = 0; b < 2; ++b)
#pragma unroll
            for (int m = 0; m < 4; ++m)
#pragma unroll
                for (int n = 0; n < 2; ++n) acc[a][b][m][n] = (f32x4){0.f, 0.f, 0.f, 0.f};
    bf16x8 At[4][2], B0[2][2], B1[2][2];
    const char* cA = (const char*)g.A + (size_t)cur.pm * tstepA + S.a_off(cur); const char* cB = (const char*)g.Bt + (size_t)S.b_tile(cur) * tstep;
    S.a_ready(cur);
    if constexpr (SP2) {
        PG8_STAGE(PG8_SB(0, 0), cB, voffB); PG8_STAGE(PG8_SB(0, 1), cB + hstep, voffB); PG8_STAGE(PG8_SA(0, 0), cA, voffA); PG8_STAGE(PG8_SA(0, 1), cA + hstepA, voffA);
        if (wr == 1) PG8_BAR;
        PG8_WAIT_V(2); PG8_BAR;
        PG8_STAGE(PG8_SB(1, 0), cB + kstep, voffB); PG8_STAGE(PG8_SA(1, 0), cA + kstep, voffA); PG8_STAGE(PG8_SB(1, 1), cB + hstep + kstep, voffB);
        PG8_WAIT_V(6); PG8_BAR;
    } else {
        PG8_STAGE(PG8_SB(0, 0), cB, voffB); PG8_STAGE(PG8_SA(0, 0), cA, voffA); PG8_STAGE(PG8_SB(0, 1), cB + hstep, voffB); PG8_STAGE(PG8_SA(0, 1), cA + hstepA, voffA);
        if (wr == 1) PG8_BAR;
        PG8_WAIT_V(4); PG8_BAR;
        PG8_STAGE(PG8_SB(1, 0), cB + kstep, voffB); PG8_STAGE(PG8_SA(1, 0), cA + kstep, voffA); PG8_STAGE(PG8_SB(1, 1), cB + hstep + kstep, voffB);
        PG8_WAIT_V(6); PG8_BAR;
    }
    for (;;) {
        const bool has_next = S.next(ui + 1, nxt);
        const char* nA = has_next ? (const char*)g.A + (size_t)nxt.pm * tstepA + S.a_off(nxt) : cA; const char* nB = has_next ? (const char*)g.Bt + (size_t)S.b_tile(nxt) * tstep : cB;
        for (int t = 0; t < nt; t += 2) {
            const bool last = (t == nt - 2);
            const char* a1 = cA + (size_t)(t + 1) * kstep;
            const char* a2 = last ? nA : cA + (size_t)(t + 2) * kstep; const char* b2 = last ? nB : cB + (size_t)(t + 2) * kstep;
            const char* a3 = a2 + kstep; const char* b3 = b2 + kstep;
            if (last && has_next) S.a_ready(nxt);
            if constexpr (SP2) {
            PG8_LDB(B0, 0, 0); PG8_LDB(B1, 0, 1); PG8_SCHED; PG8_LDA(At, 0, 0); PG8_STAGE(PG8_SA(1, 1), a1 + hstepA, voffA);
            PG8_WAIT_V(8); PG8_WAIT_L(0); PG8_BAR; PG8_MMA(0, 0, At, B0); PG8_MMA(0, 1, At, B1); PG8_BAR; PG8_SCHED;
            PG8_LDA(At, 0, 1); PG8_STAGE(PG8_SB(0, 0), b2, voffB); PG8_STAGE(PG8_SB(0, 1), b2 + hstep, voffB); PG8_STAGE(PG8_SA(0, 0), a2, voffA);
            PG8_WAIT_V(8); PG8_WAIT_L(0); PG8_BAR; PG8_MMA(1, 0, At, B0); PG8_MMA(1, 1, At, B1); PG8_BAR; PG8_SCHED;
            PG8_LDB(B0, 1, 0); PG8_LDB(B1, 1, 1); PG8_SCHED; PG8_LDA(At, 1, 0); PG8_STAGE(PG8_SA(0, 1), a2 + hstepA, voffA);
            PG8_WAIT_V(8); PG8_WAIT_L(0); PG8_BAR; PG8_MMA(0, 0, At, B0); PG8_MMA(0, 1, At, B1); PG8_BAR; PG8_SCHED;
            PG8_LDA(At, 1, 1); PG8_STAGE(PG8_SB(1, 0), b3, voffB); PG8_STAGE(PG8_SB(1, 1), b3 + hstep, voffB); PG8_STAGE(PG8_SA(1, 0), a3, voffA);
            PG8_WAIT_V(8); PG8_WAIT_L(0); PG8_BAR; PG8_MMA(1, 0, At, B0); PG8_MMA(1, 1, At, B1); PG8_BAR; PG8_SCHED;
            } else {
            PG8_LDB(B0, 0, 0); PG8_SCHED; PG8_LDA(At, 0, 0); PG8_STAGE(PG8_SA(1, 1), a1 + hstepA, voffA);
            PG8_WAIT_L(8); PG8_BAR; PG8_WAIT_L(0); PG8_MMA(0, 0, At, B0); PG8_BAR; PG8_SCHED;
            PG8_LDB(B1, 0, 1); PG8_STAGE(PG8_SB(0, 0), b2, voffB);
            PG8_BAR; PG8_WAIT_L(0); PG8_MMA(0, 1, At, B1); PG8_BAR;
            PG8_LDA(At, 0, 1); PG8_STAGE(PG8_SA(0, 0), a2, voffA);
            PG8_BAR; PG8_WAIT_L(0); PG8_MMA(1, 0, At, B0); PG8_BAR; PG8_SCHED;
            PG8_STAGE(PG8_SB(0, 1), b2 + hstep, voffB);
            PG8_WAIT_V(6); PG8_BAR; PG8_MMA(1, 1, At, B1); PG8_BAR;
            PG8_LDB(B0, 1, 0); PG8_SCHED; PG8_LDA(At, 1, 0); PG8_STAGE(PG8_SA(0, 1), a2 + hstepA, voffA);
            PG8_WAIT_L(8); PG8_BAR; PG8_WAIT_L(0); PG8_MMA(0, 0, At, B0); PG8_BAR; PG8_SCHED;
            PG8_LDB(B1, 1, 1); PG8_STAGE(PG8_SB(1, 0), b3, voffB);
            PG8_BAR; PG8_WAIT_L(0); PG8_MMA(0, 1, At, B1); PG8_BAR;
            PG8_LDA(At, 1, 1); PG8_STAGE(PG8_SA(1, 0), a3, voffA);
            PG8_BAR; PG8_WAIT_L(0); PG8_MMA(1, 0, At, B0); PG8_BAR; PG8_SCHED;
            PG8_STAGE(PG8_SB(1, 1), b3 + hstep, voffB);
            PG8_WAIT_V(6); PG8_BAR; PG8_MMA(1, 1, At, B1); PG8_BAR;
            }
            if constexpr (Epi::SEG_TILES > 0) { if (((t + 2) % Epi::SEG_TILES) == 0 && (t + 2) < nt) { E.seg(acc, cur, (t + 2) / Epi::SEG_TILES - 1, wr, wc, fr, fq); PG8_WAIT_V(0); PG8_SCHED; } }
        }
        if constexpr (ALIGN_EPI) { if (wr == 0) PG8_BAR; }
        if constexpr (!Epi::AFTER_DRAIN) { E(acc, cur, wr, wc, fr, fq); S.done(cur); }
        if (!has_next) break;
#pragma unroll
        for (int a = 0; a < 2; ++a)
#pragma unroll
            for (int b = 0; b < 2; ++b)
#pragma unroll
                for (int m = 0; m < 4; ++m)
#pragma unroll
                    for (int n = 0; n < 2; ++n) acc[a][b][m][n] = (f32x4){0.f, 0.f, 0.f, 0.f};
        cur = nxt; cA = nA; cB = nB; ++ui;
        if constexpr (ALIGN_EPI) { if (wr == 1) PG8_BAR; }
    }
    PG8_WAIT_V(0);
    if constexpr (!ALIGN_EPI) { if (wr == 0) PG8_BAR; }
    PG8_BAR;
    if constexpr (Epi::AFTER_DRAIN) { E.fused(acc, cur, wr, wc, fr, fq, lds, wid, lane); S.done(cur); }
#undef PG8_SA
#undef PG8_SB
#undef PG8_STAGE
#undef PG8_LDA
#undef PG8_LDB
#undef PG8_MMA
#undef PG8_WAIT_V
#undef PG8_WAIT_L
#undef PG8_BAR
#undef PG8_SCHED
}
}

constexpr int NWAVES = 8, NTHR = 512;
constexpr int M = 16384, SEQ = 8192, D = 1024, FF = 2816, NL = 4, NCH = 128  , NBC = 256  ;
constexpr int NPM = 6656;
constexpr int NWIN = 10752;
constexpr int C_DAQ = 0, C_DAK = 512, C_DAV = 1024, C_GQ = 1536, C_GK = 1792, C_GV = 2048, C_GOG = 2560, C_SZ = 3072, C_SX = 3584, C_SB = 4096, C_SC = 4352,
              C_RR = 4608, C_RK = 5120, C_RV = 5632, C_RWL = 6144, C_RAL = 6208, C_RGL = 6272, C_GLR = 6400, C_SDT = 6416;
constexpr float EPS = 1e-6f, LOG2E = 1.4426950408889634f;

constexpr size_t MiB = 1u << 20;
constexpr size_t WS_CTL = 0, CTL_ZERO_BYTES = 1 * MiB;
constexpr size_t WS_COS = 1 * MiB, WS_SIN = 2 * MiB, WS_SSQ = 3 * MiB, WS_GLAST = 3 * MiB + 512 * 1024, WS_SDT = 4 * MiB, WS_SACUM = 4 * MiB + 512 * 1024, WS_SCDEC = 5 * MiB, WS_RW2T = 5 * MiB + 64 * 1024;
constexpr size_t WS_WGU1 = 8 * MiB, WS_WD1 = 19 * MiB, WS_WIN = 24 * MiB + 512 * 1024, WS_WB = 45 * MiB + 512 * 1024, WS_WO = 49 * MiB + 512 * 1024, WS_WGU2 = 51 * MiB + 512 * 1024, WS_WD2 = 62 * MiB + 512 * 1024;
constexpr size_t WS_HB = 68 * MiB, WS_P = 100 * MiB, WS_PG = 100 * MiB, WS_YS = 308 * MiB, WS_R1 = 372 * MiB, WS_R2 = 500 * MiB, WS_END = 644 * MiB;
constexpr size_t WS_ACT = WS_R1, WS_MERGED = WS_R1;
constexpr size_t WS_RWW = WS_R1, WS_RWR = WS_R1 + 32 * MiB, WS_RWK = WS_R1 + 48 * MiB, WS_RWV = WS_R1 + 64 * MiB, WS_RWKK = WS_R1 + 80 * MiB, WS_RWB = WS_R1 + 96 * MiB, WS_RWG = WS_R1 + 112 * MiB;
constexpr size_t WS_VT = WS_R2, WS_GKV = WS_R2 + 16 * MiB, WS_SST = WS_R2 + 48 * MiB, WS_RWY = WS_R2 + 112 * MiB;
static_assert(WS_WD2 + (size_t)D * FF * 2 <= WS_HB && WS_P + (size_t)M * NPM * 2 <= WS_YS && WS_RWY + (size_t)M * 512 * 2 <= WS_END, "d_ws map");
constexpr int CW_BAR = 4096;

constexpr int RING_BYTES = 131072, LDSCTL_OFF = RING_BYTES, MISC_OFF = LDSCTL_OFF + 320, LDS_BYTES = 147456;

#define GAS __attribute__((address_space(1)))
#define LAS __attribute__((address_space(3)))
typedef unsigned short bf16;
typedef unsigned v4u __attribute__((ext_vector_type(4)));
typedef float f32x4 __attribute__((ext_vector_type(4)));
typedef short bf16x8 __attribute__((ext_vector_type(8)));
typedef GAS unsigned gu32;
typedef GAS unsigned long long gu64;
#define RLX_AGENT __ATOMIC_RELAXED, __HIP_MEMORY_SCOPE_AGENT
#define LDS_WAIT() asm volatile("s_waitcnt lgkmcnt(0)" ::: "memory")
#define VM_WAIT() asm volatile("s_waitcnt vmcnt(0)" ::: "memory")
__device__ __forceinline__ unsigned long long rt() { return __builtin_amdgcn_s_memrealtime(); }
typedef float f32x2_cv __attribute__((ext_vector_type(2))); typedef __bf16 bf16x2_cv __attribute__((ext_vector_type(2)));
__device__ __forceinline__ unsigned pk2(float lo, float hi) { const f32x2_cv v = {lo, hi}; const bf16x2_cv b = __builtin_convertvector(v, bf16x2_cv); return __builtin_bit_cast(unsigned, b); }
__device__ __forceinline__ unsigned f2bf(float f) { return pk2(f, 0.f) & 0xffffu; }

#define XB_TMO      128
#define XB_XCNT(j)  (256  + 64 * (j))
#define XB_XSUB(j)  (1280 + 64 * (j))
#define XB_XGEN(j)  (2304 + 64 * (j))
#define XB_TOP      3328
#define XB_TOPGEN   3392
#define XCD_BAR_WORDS 3456
#define XB_SPIN_CAP (1u << 18)

__device__ __forceinline__ unsigned xb_ld(unsigned* p)              { return __hip_atomic_load(p, __ATOMIC_RELAXED, __HIP_MEMORY_SCOPE_AGENT); }
__device__ __forceinline__ unsigned xb_add(unsigned* p, unsigned v) { return __hip_atomic_fetch_add(p, v, __ATOMIC_RELAXED, __HIP_MEMORY_SCOPE_AGENT); }
__device__ __forceinline__ unsigned xb_xcc_id() { return (unsigned)__builtin_amdgcn_s_getreg((3 << 11) | 20) & 0xFu; }
#define XB_SPIN(cond, bar) do { unsigned _sp = 0; while (cond) { __builtin_amdgcn_s_sleep(1); \
    if ((++_sp & 255u) == 0u) { if (xb_ld(&(bar)[XB_TMO])) break; if (_sp > XB_SPIN_CAP) { atomicAdd(&(bar)[XB_TMO], 1u); break; } } } } while (0)

struct XcdBarrier {
    unsigned* bar; unsigned x;
    volatile LAS unsigned* st;
};

__device__ __forceinline__ XcdBarrier xcd_barrier_post(unsigned* bar, volatile LAS unsigned* st) {
    XcdBarrier b; b.bar = bar; b.x = xb_xcc_id(); b.st = st;
    if (threadIdx.x == 0) (void)xb_add(&bar[XB_XCNT(b.x)], 1u);
    return b;
}
__device__ __forceinline__ void xcd_barrier_complete(unsigned* bar, unsigned x, unsigned& nloc, unsigned& nx) {
    const unsigned G = gridDim.x * gridDim.y * gridDim.z;
    unsigned sum, cnt, mine, sp = 0u;
    for (;;) {
        sum = 0u; cnt = 0u; mine = 0u;
#pragma unroll
        for (unsigned j = 0; j < 16; ++j) { const unsigned c = xb_ld(&bar[XB_XCNT(j)]); sum += c; cnt += (c > 0u) ? 1u : 0u; mine = (j == x) ? c : mine; }
        if (sum == G) break;
        __builtin_amdgcn_s_sleep(1);
        if ((++sp & 255u) == 0u) { if (xb_ld(&bar[XB_TMO])) break; if (sp > XB_SPIN_CAP) { atomicAdd(&bar[XB_TMO], 1u); break; } }
    }
    nloc = mine > 0u ? mine : 1u; nx = cnt > 0u ? cnt : 1u;
}

__device__ __forceinline__ void xcd_barrier(const XcdBarrier& b) {
    asm volatile("s_waitcnt vmcnt(0)" ::: "memory");
    __syncthreads();
    if (threadIdx.x == 0) {
        unsigned* bar = b.bar;
        __builtin_amdgcn_s_waitcnt(0);
        unsigned nloc = b.st[0], nx = b.st[1];
        if (nloc == 0u) { xcd_barrier_complete(bar, b.x, nloc, nx); b.st[0] = nloc; b.st[1] = nx; }
        const unsigned old = xb_add(&bar[XB_XSUB(b.x)], 1u);
        const unsigned gen = old / nloc;
        if (old + 1u == (gen + 1u) * nloc) {
            __builtin_amdgcn_fence(__ATOMIC_RELEASE, "agent");
            asm volatile("s_waitcnt vmcnt(0)" ::: "memory");
            const unsigned og = xb_add(&bar[XB_TOP], 1u);
            const unsigned tg = og / nx;
            if (og + 1u == (tg + 1u) * nx) xb_add(&bar[XB_TOPGEN], 1u);
            else XB_SPIN(xb_ld(&bar[XB_TOPGEN]) == tg, bar);
            __builtin_amdgcn_fence(__ATOMIC_ACQUIRE, "agent");
            xb_add(&bar[XB_XGEN(b.x)], 1u);
            asm volatile("s_waitcnt vmcnt(0)" ::: "memory");
        } else {
            XB_SPIN(xb_ld(&bar[XB_XGEN(b.x)]) == gen, bar);
            __builtin_amdgcn_fence(__ATOMIC_ACQUIRE, "agent");
            asm volatile("s_waitcnt vmcnt(0)" ::: "memory");
        }
    }
    __syncthreads();
}

struct Args { const float* in[40]; float* out; unsigned char* ws; float inv_freq[32]; int g_lo, g_hi; };
struct ArgsD { const GAS float* in[40]; GAS float* out; GAS unsigned char* ws; float inv_freq[32]; int g_lo, g_hi; };
typedef const __attribute__((address_space(4))) ArgsD* ArgsP;
typedef LAS float* LF; typedef const LAS float* CLF;
#ifndef PH_FN
#define PH_FN __device__ __noinline__
#endif
#ifndef PH_HEAVY
#define PH_HEAVY __device__ __forceinline__
#endif
struct Ctx {
    LAS unsigned char* lds;
    GAS unsigned char* ws; GAS float* h;
    int tid, lane, wave, bid, G;
};
typedef unsigned u32x4 __attribute__((ext_vector_type(4)));
typedef unsigned u32x2 __attribute__((ext_vector_type(2)));
typedef float f32x2 __attribute__((ext_vector_type(2)));
typedef float f32x16 __attribute__((ext_vector_type(16)));
__device__ __forceinline__ float bf2f(bf16 x) { return __uint_as_float((unsigned)x << 16); }
__device__ __forceinline__ float bflo(unsigned w) { return __uint_as_float(w << 16); }
__device__ __forceinline__ float bfhi(unsigned w) { return __uint_as_float(w & 0xffff0000u); }
__device__ __forceinline__ void unpack8(const u32x4 w, float* o) { o[0] = bflo(w.x); o[1] = bfhi(w.x); o[2] = bflo(w.y); o[3] = bfhi(w.y); o[4] = bflo(w.z); o[5] = bfhi(w.z); o[6] = bflo(w.w); o[7] = bfhi(w.w); }
__device__ __forceinline__ u32x4 pack8(const float* o) { u32x4 w; w.x = pk2(o[0], o[1]); w.y = pk2(o[2], o[3]); w.z = pk2(o[4], o[5]); w.w = pk2(o[6], o[7]); return w; }
__device__ __forceinline__ float sigmoidf_(float x) { return 1.0f / (1.0f + __expf(-x)); }
__device__ __forceinline__ float siluf_(float x) { return x * sigmoidf_(x); }
__device__ __forceinline__ float softplusf_(float x) { return fmaxf(x, 0.f) + log1pf(__expf(-fabsf(x))); }
__device__ __forceinline__ float logsigmoidf_(float x) { return fminf(x, 0.f) - log1pf(__expf(-fabsf(x))); }
__device__ __forceinline__ float wave_sum(float v) {
#pragma unroll
    for (int o = 1; o < 64; o <<= 1) v += __shfl_xor(v, o);
    return v;
}
#define WG_SYNC() __syncthreads()
__device__ __forceinline__ Ctx fresh(const Ctx& C0) { Ctx C = C0; int t = threadIdx.x; asm volatile("" : "+v"(t)); C.tid = t; C.lane = t & 63; C.wave = __builtin_amdgcn_readfirstlane(t >> 6); return C; }

PH_FN void ph_prologue(const Ctx C, ArgsP a) {
    GAS float* cosT = (GAS float*)(C.ws + WS_COS); GAS float* sinT = (GAS float*)(C.ws + WS_SIN);
    for (int idx = C.bid * NTHR + C.tid; idx < SEQ * 32; idx += C.G * NTHR) {
        const int t = idx >> 5, j = idx & 31;
        const float ang = (float)t * a->inv_freq[j];
        const double rev = (double)ang * 0.15915494309189535;
        const float fr = (float)(rev - floor(rev));
        cosT[idx] = __builtin_amdgcn_cosf(fr); sinT[idx] = __builtin_amdgcn_sinf(fr);
    }
    const GAS float* x = a->in[0]; GAS bf16* hb = (GAS bf16*)(C.ws + WS_HB); GAS float* ssq = (GAS float*)(C.ws + WS_SSQ);
    const int gw = C.bid * NWAVES + C.wave, NGW = C.G * NWAVES;
    for (int m = gw; m < M; m += NGW) {
        const GAS f32x4* xr = (const GAS f32x4*)(x + (size_t)m * D) + C.lane;
        GAS unsigned long long* o8 = (GAS unsigned long long*)(hb + (size_t)m * D) + C.lane;
        float s = 0.f;
#pragma unroll
        for (int j = 0; j < 4; ++j) { const f32x4 v = xr[64 * j]; s += (v.x * v.x + v.y * v.y) + (v.z * v.z + v.w * v.w);
            o8[64 * j] = (unsigned long long)pk2(v.x, v.y) | ((unsigned long long)pk2(v.z, v.w) << 32); }
        s = wave_sum(s);
        if (C.lane == 0) *(GAS f32x4*)(ssq + (size_t)m * 4) = (f32x4){s, 0.f, 0.f, 0.f};
    }
}

template <class SrcF>
__device__ __forceinline__ void tr_item(const SrcF src, const GAS float* gk, GAS bf16* WT, int K, int kb, int nb, LAS bf16* scr, int lane) {
    const int k0 = 64 * kb, n0 = 64 * nb, kr = lane >> 4, n4 = 4 * (lane & 15);
    const int ld = src.ld(); const long co = src.col(n0 + n4); const bool ok = co >= 0; const GAS float* colp = src.base(n0 + n4) + (ok ? co : 0);
    f32x4 v[16];
#pragma unroll
    for (int i = 0; i < 16; ++i) v[i] = ok ? *(const GAS f32x4*)(colp + (size_t)(k0 + 4 * i + kr) * ld) : (f32x4){0.f, 0.f, 0.f, 0.f};
#pragma unroll
    for (int i = 0; i < 16; ++i) { const int kk = 4 * i + kr; const float g = gk ? gk[k0 + kk] : 1.0f;
#pragma unroll
        for (int e = 0; e < 4; ++e) scr[(n4 + e) * 72 + kk] = (bf16)f2bf(v[i][e] * g); }
    LDS_WAIT(); asm volatile("" ::: "memory");
    const int c = lane & 7;
#pragma unroll
    for (int j = 0; j < 8; ++j) { const int n = (lane >> 3) + 8 * j; *(GAS v4u*)(WT + (size_t)(n0 + n) * K + k0 + 8 * c) = *(const LAS v4u*)(scr + n * 72 + 8 * c); }
    LDS_WAIT(); asm volatile("" ::: "memory");
}
struct SrcGU { const GAS float* wg; const GAS float* wu;
    __device__ __forceinline__ int ld() const { return FF; }
    __device__ __forceinline__ const GAS float* base(int n) const { const uintptr_t sel = (uintptr_t)((n >> 7) & 1); return (const GAS float*)((uintptr_t)wg + sel * ((uintptr_t)wu - (uintptr_t)wg)); }
    __device__ __forceinline__ long col(int n) const { return 128 * (n >> 8) + (n & 127); } };
struct SrcPlain { const GAS float* w; int ldw;
    __device__ __forceinline__ int ld() const { return ldw; }
    __device__ __forceinline__ const GAS float* base(int) const { return w; }
    __device__ __forceinline__ long col(int n) const { return n; } };
struct SrcWin { const GAS float* w;
    __device__ __forceinline__ int ld() const { return 10520; }
    __device__ __forceinline__ const GAS float* base(int) const { return w; }
    __device__ __forceinline__ long col(int n) const {
        int c;
        if (n < 3072) c = n; else if (n < 4608) c = n - 3072 + 3088; else if (n < 6400) c = n - 4608 + 4632; else if (n < 6416) c = n - 6400 + 3072; else if (n < 6424) c = n - 6416 + 4624; else if (n < 6656) c = -1; else c = n - 6656 + 6424;
        return c; } };
PH_FN void ph_weights(const Ctx C, ArgsP a, int l) {
    LAS bf16* scr = (LAS bf16*)(C.lds + C.wave * 16384);
    const int gw = C.bid * NWAVES + C.wave, NGW = C.G * NWAVES; int rot = 0;
#define W_FIRST(cnt) ({ const int f_ = (gw + NGW - rot % NGW) % NGW; rot += (cnt); f_; })
#pragma unroll 1
    for (int f = 0; f < 2; ++f) {
        const GAS float* nrm = a->in[f ? 35 : 1] + (size_t)l * D; const GAS float* wg = a->in[f ? 36 : 2] + (size_t)l * D * FF; const GAS float* wu = a->in[f ? 37 : 3] + (size_t)l * D * FF; const GAS float* wd = a->in[f ? 38 : 4] + (size_t)l * FF * D;
        GAS bf16* Wgu = (GAS bf16*)(C.ws + (f ? WS_WGU2 : WS_WGU1)); GAS bf16* Wd = (GAS bf16*)(C.ws + (f ? WS_WD2 : WS_WD1));
        const SrcGU sgu{wg, wu};
        for (int it = W_FIRST((D / 64) * (2 * FF / 64)); it < (D / 64) * (2 * FF / 64); it += NGW) tr_item(sgu, nrm, Wgu, D, it / (2 * FF / 64), it % (2 * FF / 64), scr, C.lane);
        const SrcPlain sd{wd, D};
        for (int it = W_FIRST((FF / 64) * (D / 64)); it < (FF / 64) * (D / 64); it += NGW) tr_item(sd, nullptr, Wd, FF, it / (D / 64), it % (D / 64), scr, C.lane);
    }
    { const SrcWin sw{a->in[6] + (size_t)l * D * 10520}; const GAS float* nrm = a->in[5] + (size_t)l * D; GAS bf16* Win = (GAS bf16*)(C.ws + WS_WIN);
      for (int it = W_FIRST((D / 64) * (NWIN / 64)); it < (D / 64) * (NWIN / 64); it += NGW) tr_item(sw, nrm, Win, D, it / (NWIN / 64), it % (NWIN / 64), scr, C.lane); }
    { GAS bf16* Wb = (GAS bf16*)(C.ws + WS_WB);
      for (int it = W_FIRST(4 * (512 / 64) * (D / 64)); it < 4 * (512 / 64) * (D / 64); it += NGW) { const int z = it / ((512 / 64) * (D / 64)), r = it % ((512 / 64) * (D / 64));
          const SrcPlain sb{a->in[32] + ((size_t)l * 4 + z) * 512 * D - (size_t)z * 512 * D, D}; tr_item(sb, nullptr, Wb, 2048, z * 8 + r / (D / 64), r % (D / 64), scr, C.lane); } }
    { GAS bf16* W2T = (GAS bf16*)(C.ws + WS_RW2T); GAS bf16* A2T = W2T + 512 * 64; GAS bf16* G2T = A2T + 512 * 64;
      const SrcPlain s1{a->in[23] + (size_t)l * 64 * 512, 512}, s2{a->in[25] + (size_t)l * 64 * 512, 512}, s3{a->in[26] + (size_t)l * 128 * 512, 512};
      for (int it = W_FIRST(8); it < 8; it += NGW) tr_item(s1, nullptr, W2T, 64, 0, it, scr, C.lane);
      for (int it = W_FIRST(8); it < 8; it += NGW) tr_item(s2, nullptr, A2T, 64, 0, it, scr, C.lane);
      for (int it = W_FIRST(16); it < 16; it += NGW) tr_item(s3, nullptr, G2T, 128, it >> 3, it & 7, scr, C.lane); }
    { const SrcPlain so{a->in[34] + (size_t)l * D * D, D}; GAS bf16* Wo = (GAS bf16*)(C.ws + WS_WO);
      for (int it = W_FIRST((D / 64) * (D / 64)); it < (D / 64) * (D / 64); it += NGW) tr_item(so, nullptr, Wo, D, it / (D / 64), it % (D / 64), scr, C.lane); }
}

#undef W_FIRST
PH_FN void ph_da_prep(const Ctx C) {
    GAS bf16* P = (GAS bf16*)(C.ws + WS_P); const GAS float* cosT = (const GAS float*)(C.ws + WS_COS); const GAS float* sinT = (const GAS float*)(C.ws + WS_SIN);
    const int gw = C.bid * NWAVES + C.wave, NGW = C.G * NWAVES;
    const int hc = C.lane >> 2, ch = C.lane & 3;
    const float sc = (hc < 8) ? 0.125f * LOG2E : 1.0f;
    for (int m = gw; m < M; m += NGW) {
        const int t = m & (SEQ - 1);
        GAS bf16* p1 = P + (size_t)m * NPM + hc * 64 + ch * 8; GAS bf16* p2 = p1 + 32;
        float x1[8], x2[8], o1[8], o2[8];
        unpack8(*(const GAS u32x4*)p1, x1); unpack8(*(const GAS u32x4*)p2, x2);
        const GAS float* cp = cosT + t * 32 + ch * 8; const GAS float* sp = sinT + t * 32 + ch * 8;
#pragma unroll
        for (int i = 0; i < 8; ++i) { const float c = cp[i], s = sp[i]; o1[i] = (x1[i] * c - x2[i] * s) * sc; o2[i] = (x2[i] * c + x1[i] * s) * sc; }
        *(GAS u32x4*)p1 = pack8(o1); *(GAS u32x4*)p2 = pack8(o2);
    }
    GAS bf16* VT = (GAS bf16*)(C.ws + WS_VT); LAS bf16* tile = (LAS bf16*)C.lds;
    for (int it = C.bid; it < 2 * NCH * 4; it += C.G) {
        const int h = it & 3, bc = it >> 2, b = bc >> 7, tb = bc & 127; const size_t row0 = (size_t)bc * 64;
        WG_SYNC();
#pragma unroll
        for (int i = 0; i < 2; ++i) { const int q = C.tid + NTHR * i, t = q >> 4, c16 = q & 15;
            *(LAS u32x4*)(tile + t * 136 + c16 * 8) = *(const GAS u32x4*)(P + (row0 + t) * NPM + C_DAV + h * 128 + c16 * 8); }
        WG_SYNC();
#pragma unroll
        for (int i = 0; i < 2; ++i) { const int q = C.tid + NTHR * i, d = q >> 3, tc = q & 7; unsigned w[4];
#pragma unroll
            for (int e = 0; e < 4; ++e) w[e] = (unsigned)tile[(8 * tc + 2 * e) * 136 + d] | ((unsigned)tile[(8 * tc + 2 * e + 1) * 136 + d] << 16);
            u32x4 o; o.x = w[0]; o.y = w[1]; o.z = w[2]; o.w = w[3];
            *(GAS u32x4*)(VT + ((size_t)(b * 4 + h) * 128 + d) * SEQ + tb * 64 + 8 * tc) = o; }
    }
    WG_SYNC();
}

typedef LAS bf16* LB; typedef const LAS bf16* CLB;
__device__ __forceinline__ pg8::bf16x8 frag32(CLB X, int ld, int row0, int k0, int lane) { return *(const LAS pg8::bf16x8*)(X + (row0 + (lane & 31)) * ld + k0 + 8 * (lane >> 5)); }
template <int K> __device__ __forceinline__ void mma_nt(f32x16& acc, CLB A, int lda, int m0, CLB Bt, int ldb, int n0, int lane) {
#pragma unroll
    for (int k = 0; k < K; k += 16) acc = __builtin_amdgcn_mfma_f32_32x32x16_bf16(frag32(A, lda, m0, k, lane), frag32(Bt, ldb, n0, k, lane), acc, 0, 0, 0);
}
__device__ __forceinline__ int crow(int r, int hi) { return (r & 3) + 8 * (r >> 2) + 4 * hi; }
__device__ __forceinline__ f32x16 zero16() { f32x16 z;
#pragma unroll
    for (int r = 0; r < 16; ++r) z[r] = 0.f;
    return z; }

__device__ __forceinline__ void gla_compute_G(const Ctx& C, ArgsP a, int l, int bc, int h, LF Gs) {
    const GAS bf16* P = (const GAS bf16*)(C.ws + WS_P); const GAS float* W2 = a->in[12] + (size_t)l * 16 * 256; const GAS float* gb = a->in[13] + (size_t)l * 256;
    const int t = C.tid >> 3, kg = C.tid & 7; const size_t row = (size_t)bc * 64 + t;
    float glr[16]; unpack8(*(const GAS u32x4*)(P + row * NPM + C_GLR), glr); unpack8(*(const GAS u32x4*)(P + row * NPM + C_GLR + 8), glr + 8);
#pragma unroll
    for (int i = 0; i < 8; ++i) { const int k = h * 64 + kg * 8 + i; float x = gb[k];
#pragma unroll
        for (int r = 0; r < 16; ++r) x += glr[r] * W2[r * 256 + k];
        Gs[t * 68 + kg * 8 + i] = logsigmoidf_(x) * (1.0f / 16.0f); }
    WG_SYNC();
    { const int seg = C.tid >> 6, k = C.tid & 63; float run = 0.f;
#pragma unroll
      for (int i = 0; i < 8; ++i) { run += Gs[(8 * seg + i) * 68 + k]; Gs[(8 * seg + i) * 68 + k] = run; }
      WG_SYNC();
      float off = 0.f;
#pragma unroll
      for (int sg = 0; sg < 7; ++sg) { const float tot = Gs[(8 * sg + 7) * 68 + k]; off += (sg < seg) ? tot : 0.f; }
      WG_SYNC();
#pragma unroll
      for (int i = 0; i < 8; ++i) Gs[(8 * seg + i) * 68 + k] += off; }
    WG_SYNC();
}
PH_HEAVY void ph_gla_a(const Ctx C, ArgsP a, int l) {
    const GAS bf16* P = (const GAS bf16*)(C.ws + WS_P); GAS bf16* GKV = (GAS bf16*)(C.ws + WS_GKV); GAS float* GL = (GAS float*)(C.ws + WS_GLAST);
    LF Gs = (LF)C.lds; LB KDT = (LB)(C.lds + 17408); LB VT = (LB)(C.lds + 26624);
    for (int it = C.bid; it < NBC * 4; it += C.G) {
        const int bc = it >> 2, h = it & 3;
        WG_SYNC();
        gla_compute_G(C, a, l, bc, h, Gs);
        { const int t = C.tid >> 3, g8 = C.tid & 7; const size_t row = (size_t)bc * 64 + t;
          float kf[8]; unpack8(*(const GAS u32x4*)(P + row * NPM + C_GK + h * 64 + g8 * 8), kf);
#pragma unroll
          for (int i = 0; i < 8; ++i) { const int k = g8 * 8 + i; KDT[k * 72 + t] = (bf16)f2bf(kf[i] * __expf(Gs[63 * 68 + k] - Gs[t * 68 + k])); }
          const u32x4 v0 = *(const GAS u32x4*)(P + row * NPM + C_GV + h * 128 + g8 * 16), v1 = *(const GAS u32x4*)(P + row * NPM + C_GV + h * 128 + g8 * 16 + 8);
          const unsigned vw[8] = {v0.x, v0.y, v0.z, v0.w, v1.x, v1.y, v1.z, v1.w};
#pragma unroll
          for (int i = 0; i < 8; ++i) { VT[(g8 * 16 + 2 * i) * 72 + t] = (bf16)(vw[i] & 0xffffu); VT[(g8 * 16 + 2 * i + 1) * 72 + t] = (bf16)(vw[i] >> 16); }
          if (C.tid < 64) GL[(size_t)it * 64 + C.tid] = Gs[63 * 68 + C.tid]; }
        WG_SYNC();
        { const int kt = C.wave >> 2, vt = C.wave & 3, n = C.lane & 31, hi = C.lane >> 5;
          f32x16 acc = zero16(); mma_nt<64>(acc, KDT, 72, 32 * kt, VT, 72, 32 * vt, C.lane);
          GAS bf16* dst = GKV + ((size_t)it * 128 + 32 * vt + n) * 64 + 32 * kt + 4 * hi;
#pragma unroll
          for (int g = 0; g < 4; ++g) { u32x2 w; w.x = pk2(acc[4 * g], acc[4 * g + 1]); w.y = pk2(acc[4 * g + 2], acc[4 * g + 3]); *(GAS u32x2*)(dst + 8 * g) = w; } }
    }
    WG_SYNC();
}
PH_FN void gla_scan_part(const Ctx C, int part) {
    GAS unsigned* GKV = (GAS unsigned*)(C.ws + WS_GKV); const GAS float* GL = (const GAS float*)(C.ws + WS_GLAST);
    const int e = part * NTHR + C.tid, chain = e >> 12, idx = e & 4095, b = chain >> 2, h = chain & 3, k = (2 * idx) & 63;
    float s0 = 0.f, s1 = 0.f;
#pragma unroll 1
    for (int c0 = 0; c0 < NCH; c0 += 16) {
        unsigned tmp[16]; f32x2 dec[16];
#pragma unroll
        for (int i = 0; i < 16; ++i) { const size_t item = (size_t)(b * NCH + c0 + i) * 4 + h; tmp[i] = GKV[item * 4096 + idx]; dec[i] = *(const GAS f32x2*)(GL + item * 64 + k); }
#pragma unroll
        for (int i = 0; i < 16; ++i) { const size_t item = (size_t)(b * NCH + c0 + i) * 4 + h; GKV[item * 4096 + idx] = pk2(s0, s1); s0 = __expf(dec[i][0]) * s0 + bflo(tmp[i]); s1 = __expf(dec[i][1]) * s1 + bfhi(tmp[i]); }
    }
}
PH_HEAVY void ph_gla_c(const Ctx C, ArgsP a, int l) {
    const GAS bf16* P = (const GAS bf16*)(C.ws + WS_P); const GAS bf16* GKV = (const GAS bf16*)(C.ws + WS_GKV); GAS bf16* YS = (GAS bf16*)(C.ws + WS_YS);
    const GAS float* gnorm = a->in[14] + (size_t)l * 128;
    LF Gs = (LF)C.lds; LB QD = (LB)(C.lds + 17408); LB KDR = (LB)(C.lds + 26624); LB QI = (LB)(C.lds + 35840); LB ATT = (LB)(C.lds + 45056); LB VT = (LB)(C.lds + 54272); LB ST = (LB)(C.lds + 72704); LF PS = (LF)(C.lds + 91136);
    for (int it = C.bid; it < NBC * 4; it += C.G) {
        const int bc = it >> 2, h = it & 3;
        WG_SYNC();
        gla_compute_G(C, a, l, bc, h, Gs);
        { const int t = C.tid >> 3, g8 = C.tid & 7; const size_t row = (size_t)bc * 64 + t;
          float qf[8], kf[8], o1[8], o2[8], o3[8];
          unpack8(*(const GAS u32x4*)(P + row * NPM + C_GQ + h * 64 + g8 * 8), qf); unpack8(*(const GAS u32x4*)(P + row * NPM + C_GK + h * 64 + g8 * 8), kf);
#pragma unroll
          for (int i = 0; i < 8; ++i) { const int k = g8 * 8 + i; const float g = Gs[t * 68 + k], d = g - Gs[32 * 68 + k]; o1[i] = qf[i] * 0.125f * __expf(d); o2[i] = kf[i] * __expf(-d); o3[i] = qf[i] * 0.125f * __expf(g); }
          *(LAS u32x4*)(QD + t * 72 + g8 * 8) = pack8(o1); *(LAS u32x4*)(KDR + t * 72 + g8 * 8) = pack8(o2); *(LAS u32x4*)(QI + t * 72 + g8 * 8) = pack8(o3);
          const u32x4 v0 = *(const GAS u32x4*)(P + row * NPM + C_GV + h * 128 + g8 * 16), v1 = *(const GAS u32x4*)(P + row * NPM + C_GV + h * 128 + g8 * 16 + 8);
          const unsigned vw[8] = {v0.x, v0.y, v0.z, v0.w, v1.x, v1.y, v1.z, v1.w};
#pragma unroll
          for (int i = 0; i < 8; ++i) { VT[(g8 * 16 + 2 * i) * 72 + t] = (bf16)(vw[i] & 0xffffu); VT[(g8 * 16 + 2 * i + 1) * 72 + t] = (bf16)(vw[i] >> 16); }
          const int v = C.tid >> 2, kq = (C.tid & 3) * 16; const GAS bf16* sp = GKV + ((size_t)it * 128 + v) * 64 + kq;
          *(LAS u32x4*)(ST + v * 72 + kq) = *(const GAS u32x4*)sp; *(LAS u32x4*)(ST + v * 72 + kq + 8) = *(const GAS u32x4*)(sp + 8); }
        WG_SYNC();
        const int n = C.lane & 31, hi = C.lane >> 5;
        if (C.wave < 4) {
            const int it_ = C.wave >> 1, jt = C.wave & 1;
            f32x16 acc = zero16();
            if (jt <= it_) mma_nt<64>(acc, QD, 72, 32 * it_, KDR, 72, 32 * jt, C.lane);
#pragma unroll
            for (int r = 0; r < 16; ++r) { const int i = 32 * it_ + crow(r, hi), j = 32 * jt + n; ATT[i * 72 + j] = (bf16)f2bf(j <= i ? acc[r] : 0.f); }
        }
        WG_SYNC();
        {
            const int it_ = C.wave & 1, vt = C.wave >> 1;
            f32x16 acc = zero16();
            mma_nt<64>(acc, VT, 72, 32 * vt, ATT, 72, 32 * it_, C.lane);
            mma_nt<64>(acc, ST, 72, 32 * vt, QI, 72, 32 * it_, C.lane);
            float ss = 0.f;
#pragma unroll
            for (int r = 0; r < 16; ++r) ss += acc[r] * acc[r];
            ss += __shfl_xor(ss, 32);
            if (hi == 0) PS[(32 * it_ + n) * 4 + vt] = ss;
            WG_SYNC();
            const int i = 32 * it_ + n; const float tot = (PS[i * 4] + PS[i * 4 + 1]) + (PS[i * 4 + 2] + PS[i * 4 + 3]);
            const float rs = 1.0f / sqrtf(tot * (1.0f / 128.0f) + EPS); const size_t row = (size_t)bc * 64 + i;
#pragma unroll
            for (int g = 0; g < 4; ++g) { const int v0 = 32 * vt + 8 * g + 4 * hi;
                const u32x2 ogw = *(const GAS u32x2*)(P + row * NPM + C_GOG + h * 128 + v0); const f32x4 gn = *(const GAS f32x4*)(gnorm + v0);
                const float og[4] = {bflo(ogw.x), bfhi(ogw.x), bflo(ogw.y), bfhi(ogw.y)}; float o4[4];
#pragma unroll
                for (int y = 0; y < 4; ++y) o4[y] = acc[4 * g + y] * rs * gn[y] * siluf_(og[y]);
                u32x2 w; w.x = pk2(o4[0], o4[1]); w.y = pk2(o4[2], o4[3]); *(GAS u32x2*)(YS + row * 2048 + 512 + h * 128 + v0) = w; }
        }
    }
    WG_SYNC();
}

__device__ __forceinline__ void ssd_conv8(const GAS bf16* P, const GAS float* cw, const GAS float* cb, int bc, int t, int ch0, float* o) {
    const int pos = (bc & 127) * 64 + t; const size_t row = (size_t)bc * 64 + t;
#pragma unroll
    for (int i = 0; i < 8; ++i) o[i] = cb[ch0 + i];
#pragma unroll
    for (int tap = 0; tap < 4; ++tap) { if (pos - 3 + tap >= 0) { float x[8]; unpack8(*(const GAS u32x4*)(P + (row - 3 + tap) * NPM + C_SX + ch0), x);
#pragma unroll
        for (int i = 0; i < 8; ++i) o[i] += cw[tap * 1024 + ch0 + i] * x[i]; } }
#pragma unroll
    for (int i = 0; i < 8; ++i) o[i] = siluf_(o[i]);
}
PH_HEAVY void ph_ssd_a(const Ctx C, ArgsP a, int l) {
    const GAS bf16* P = (const GAS bf16*)(C.ws + WS_P); GAS bf16* SST = (GAS bf16*)(C.ws + WS_SST); GAS float* SDT = (GAS float*)(C.ws + WS_SDT); GAS float* SAC = (GAS float*)(C.ws + WS_SACUM); GAS float* SCD = (GAS float*)(C.ws + WS_SCDEC);
    const GAS float* cw = a->in[15] + (size_t)l * 4 * 1024; const GAS float* cb = a->in[16] + (size_t)l * 1024; const GAS float* dtb = a->in[17] + (size_t)l * 8; const GAS float* alog = a->in[18] + (size_t)l * 8;
    LB BT = (LB)C.lds; LB XDT = (LB)(C.lds + 18432); LF dtv = (LF)(C.lds + 27648); LF acu = (LF)(C.lds + 27904); LF av = (LF)(C.lds + 28160);
    for (int it = C.bid; it < NBC * 2; it += C.G) {
        const int bc = it >> 1, g = it & 1; const int t = C.tid >> 3, cg = C.tid & 7;
        WG_SYNC();
        { float o[8];
#pragma unroll
          for (int half = 0; half < 2; ++half) { ssd_conv8(P, cw, cb, bc, t, 512 + g * 128 + cg * 16 + half * 8, o);
#pragma unroll
              for (int i = 0; i < 8; ++i) BT[(cg * 16 + half * 8 + i) * 72 + t] = (bf16)f2bf(o[i]); } }
#pragma unroll 1
        for (int hh = 0; hh < 4; ++hh) {
            const int hd = 4 * g + hh; const size_t item8 = (size_t)bc * 8 + hd;
            WG_SYNC();
            if (C.tid < 64) { const size_t row = (size_t)bc * 64 + C.tid; const float dt = softplusf_(bf2f(P[row * NPM + C_SDT + hd]) + dtb[hd]); dtv[C.tid] = dt; av[C.tid] = -__expf(alog[hd]) * dt; }
            WG_SYNC();
            if (C.tid < 64) { float s = av[C.tid];
#pragma unroll
                for (int o = 1; o < 64; o <<= 1) { const float nb_ = __shfl_up(s, o); if (C.lane >= o) s += nb_; }
                acu[C.tid] = s; const size_t row = (size_t)bc * 64 + C.tid; SDT[row * 8 + hd] = dtv[C.tid]; SAC[row * 8 + hd] = s; if (C.tid == 63) SCD[item8] = __expf(s); }
            WG_SYNC();
            { float o[8]; ssd_conv8(P, cw, cb, bc, t, hd * 64 + cg * 8, o); const float sc = dtv[t] * __expf(acu[63] - acu[t]);
#pragma unroll
              for (int i = 0; i < 8; ++i) XDT[(cg * 8 + i) * 72 + t] = (bf16)f2bf(o[i] * sc); }
            WG_SYNC();
            { const int pt = C.wave >> 2, nt = C.wave & 3, n = C.lane & 31, hi = C.lane >> 5;
              f32x16 acc = zero16(); mma_nt<64>(acc, XDT, 72, 32 * pt, BT, 72, 32 * nt, C.lane);
#pragma unroll
              for (int r = 0; r < 16; ++r) SST[(item8 * 64 + 32 * pt + crow(r, hi)) * 128 + 32 * nt + n] = (bf16)f2bf(acc[r]); }
        }
    }
    WG_SYNC();
}
PH_FN void ssd_scan_part(const Ctx C, int part) {
    GAS unsigned* SST = (GAS unsigned*)(C.ws + WS_SST); const GAS float* SCD = (const GAS float*)(C.ws + WS_SCDEC);
    const int e = part * NTHR + C.tid, chain = e >> 12, idx = e & 4095, b = chain >> 3, hd = chain & 7;
    float s0 = 0.f, s1 = 0.f;
#pragma unroll 1
    for (int c0 = 0; c0 < NCH; c0 += 16) {
        unsigned tmp[16]; float dec[16];
#pragma unroll
        for (int i = 0; i < 16; ++i) { const size_t item = (size_t)(b * NCH + c0 + i) * 8 + hd; tmp[i] = SST[item * 4096 + idx]; dec[i] = SCD[item]; }
#pragma unroll
        for (int i = 0; i < 16; ++i) { const size_t item = (size_t)(b * NCH + c0 + i) * 8 + hd; SST[item * 4096 + idx] = pk2(s0, s1); s0 = dec[i] * s0 + bflo(tmp[i]); s1 = dec[i] * s1 + bfhi(tmp[i]); }
    }
}
PH_HEAVY void ph_ssd_c(const Ctx C, ArgsP a, int l) {
    const GAS bf16* P = (const GAS bf16*)(C.ws + WS_P); const GAS bf16* SST = (const GAS bf16*)(C.ws + WS_SST); const GAS float* SDT = (const GAS float*)(C.ws + WS_SDT); const GAS float* SAC = (const GAS float*)(C.ws + WS_SACUM); GAS bf16* YS = (GAS bf16*)(C.ws + WS_YS);
    const GAS float* cw = a->in[15] + (size_t)l * 4 * 1024; const GAS float* cb = a->in[16] + (size_t)l * 1024; const GAS float* dpar = a->in[19] + (size_t)l * 8; const GAS float* snorm = a->in[20] + (size_t)l * 512;
    LB BN = (LB)C.lds; LB CN = (LB)(C.lds + 17408); LF CB = (LF)(C.lds + 34816); LF dtv = (LF)(C.lds + 123904); LF acu = dtv + 128; LF PSQ = (LF)(C.lds + 124928);
    const int hs = C.wave >> 2;
    LB SCw = (LB)(C.lds + 52224 + hs * 35840); LB XSTw = SCw + 64 * 72; LB HPw = XSTw + 64 * 72;
    for (int it = C.bid; it < NBC * 2; it += C.G) {
        const int bc = it >> 1, g = it & 1;
        const int t = C.tid >> 3, cg = C.tid & 7, n = C.lane & 31, hi = C.lane >> 5;
        WG_SYNC();
        { float o[8];
#pragma unroll
          for (int half = 0; half < 2; ++half) {
              ssd_conv8(P, cw, cb, bc, t, 512 + g * 128 + cg * 16 + half * 8, o); *(LAS u32x4*)(BN + t * 136 + cg * 16 + half * 8) = pack8(o);
              ssd_conv8(P, cw, cb, bc, t, 768 + g * 128 + cg * 16 + half * 8, o); *(LAS u32x4*)(CN + t * 136 + cg * 16 + half * 8) = pack8(o); } }
        WG_SYNC();
        if (C.wave < 4) {
            const int it_ = C.wave >> 1, jt = C.wave & 1;
            f32x16 acc = zero16(); mma_nt<128>(acc, CN, 136, 32 * it_, BN, 136, 32 * jt, C.lane);
#pragma unroll
            for (int r = 0; r < 16; ++r) CB[(32 * it_ + crow(r, hi)) * 68 + 32 * jt + n] = acc[r];
        }
        float yk[2][16]; float ssq = 0.f;
        const int pt = (C.wave >> 1) & 1, it2 = C.wave & 1;
#pragma unroll
        for (int hp = 0; hp < 2; ++hp) {
            WG_SYNC();
            if (C.tid < 128) { const int s = C.tid >> 6, i = C.tid & 63, hd = 4 * g + 2 * hp + s; const size_t row = (size_t)bc * 64 + i; dtv[s * 64 + i] = SDT[row * 8 + hd]; acu[s * 64 + i] = SAC[row * 8 + hd]; }
#pragma unroll
            for (int s = 0; s < 2; ++s) { const int hd = 4 * g + 2 * hp + s; const size_t item8 = (size_t)bc * 8 + hd; LB XSTs = (LB)(C.lds + 52224 + s * 35840) + 64 * 72; LB HPs = XSTs + 64 * 72;
                float o[8]; ssd_conv8(P, cw, cb, bc, t, hd * 64 + cg * 8, o);
#pragma unroll
                for (int i = 0; i < 8; ++i) XSTs[(cg * 8 + i) * 72 + t] = (bf16)f2bf(o[i]);
                const int p = C.tid >> 3, n0 = (C.tid & 7) * 16; const GAS bf16* sp = SST + (item8 * 64 + p) * 128 + n0;
                *(LAS u32x4*)(HPs + p * 136 + n0) = *(const GAS u32x4*)sp; *(LAS u32x4*)(HPs + p * 136 + n0 + 8) = *(const GAS u32x4*)(sp + 8); }
            WG_SYNC();
#pragma unroll
            for (int s = 0; s < 2; ++s) { LB SCs = (LB)(C.lds + 52224 + s * 35840); const float ai = acu[s * 64 + t]; float o[8];
#pragma unroll
                for (int jj = 0; jj < 8; ++jj) { const int j = 8 * cg + jj; o[jj] = (j <= t) ? CB[t * 68 + j] * __expf(ai - acu[s * 64 + j]) * dtv[s * 64 + j] : 0.f; }
                *(LAS u32x4*)(SCs + t * 72 + 8 * cg) = pack8(o); }
            WG_SYNC();
            {
                const int hd = 4 * g + 2 * hp + hs; const int i = 32 * it2 + n; const size_t row = (size_t)bc * 64 + i; const float dh = dpar[hd];
                f32x16 acc = zero16();
                mma_nt<128>(acc, HPw, 136, 32 * pt, CN, 136, 32 * it2, C.lane);
                const float ea = __expf(acu[hs * 64 + i]);
#pragma unroll
                for (int r = 0; r < 16; ++r) acc[r] *= ea;
                mma_nt<64>(acc, XSTw, 72, 32 * pt, SCw, 72, 32 * it2, C.lane);
#pragma unroll
                for (int q4 = 0; q4 < 4; ++q4) { const int p0 = 32 * pt + 8 * q4 + 4 * hi;
                    const u32x2 zw = *(const GAS u32x2*)(P + row * NPM + C_SZ + hd * 64 + p0); const float zf[4] = {bflo(zw.x), bfhi(zw.x), bflo(zw.y), bfhi(zw.y)};
#pragma unroll
                    for (int e = 0; e < 4; ++e) { const float xs = bf2f(XSTw[(p0 + e) * 72 + i]); const float v = (acc[4 * q4 + e] + dh * xs) * siluf_(zf[e]); yk[hp][4 * q4 + e] = v; ssq += v * v; } }
            }
        }
        { ssq += __shfl_xor(ssq, 32); if (hi == 0) PSQ[(32 * it2 + n) * 4 + pt * 2 + hs] = ssq; }
        WG_SYNC();
        {   const int i = 32 * it2 + n; const f32x4 ps = *(const LAS f32x4*)(PSQ + i * 4); const float rs = 1.0f / sqrtf(((ps[0] + ps[1]) + (ps[2] + ps[3])) * (1.0f / 256.0f) + EPS); const size_t row = (size_t)bc * 64 + i;
#pragma unroll
            for (int hp = 0; hp < 2; ++hp)
#pragma unroll
                for (int q4 = 0; q4 < 4; ++q4) { const int ch = g * 256 + (2 * hp + hs) * 64 + 32 * pt + 8 * q4 + 4 * hi; const f32x4 sn = *(const GAS f32x4*)(snorm + ch);
                    u32x2 w; w.x = pk2(yk[hp][4 * q4] * rs * sn[0], yk[hp][4 * q4 + 1] * rs * sn[1]); w.y = pk2(yk[hp][4 * q4 + 2] * rs * sn[2], yk[hp][4 * q4 + 3] * rs * sn[3]);
                    *(GAS u32x2*)(YS + row * 2048 + 1024 + ch) = w; }
        }
    }
    WG_SYNC();
}

#ifndef RW_CHUNKED
#define RW_CHUNKED 1
#endif
__device__ __forceinline__ void rw_lerp8(const GAS bf16* P, const GAS float* mu, int bc, int t, int c0, float* o) {
    const size_t row = (size_t)bc * 64 + t; const bool first = ((bc & 127) == 0) && (t == 0);
    float x[8], xp[8]; unpack8(*(const GAS u32x4*)(P + row * NPM + C_RR + c0), x);
    if (!first) unpack8(*(const GAS u32x4*)(P + (row - 1) * NPM + C_RR + c0), xp); else {
#pragma unroll
        for (int i = 0; i < 8; ++i) xp[i] = 0.f; }
#pragma unroll
    for (int i = 0; i < 8; ++i) o[i] = x[i] + (xp[i] - x[i]) * mu[c0 + i];
}
__device__ __forceinline__ void rw_lerp4(const GAS bf16* P, const GAS float* mu, size_t row, bool first, int c0, float* o) {
    const u32x2 xw = *(const GAS u32x2*)(P + row * NPM + C_RR + c0); const float x[4] = {bflo(xw.x), bfhi(xw.x), bflo(xw.y), bfhi(xw.y)};
    float xp[4] = {0.f, 0.f, 0.f, 0.f};
    if (!first) { const u32x2 pw = *(const GAS u32x2*)(P + (row - 1) * NPM + C_RR + c0); xp[0] = bflo(pw.x); xp[1] = bfhi(pw.x); xp[2] = bflo(pw.y); xp[3] = bfhi(pw.y); }
    const f32x4 m = *(const GAS f32x4*)(mu + c0);
#pragma unroll
    for (int i = 0; i < 4; ++i) o[i] = x[i] + (xp[i] - x[i]) * m[i];
}
#define RW_WFRAG(WT_, K_, nt_, s_) (*(const GAS pg8::bf16x8*)((WT_) + (size_t)(head * 64 + 32 * (nt_) + n) * (K_) + 16 * (s_) + 8 * hi))
#define RWP_PTRS \
    const GAS bf16* P = (const GAS bf16*)(C.ws + WS_P); \
    GAS float* RWW = (GAS float*)(C.ws + WS_RWW); GAS bf16* RWR = (GAS bf16*)(C.ws + WS_RWR); GAS bf16* RWK = (GAS bf16*)(C.ws + WS_RWK); GAS bf16* RWV = (GAS bf16*)(C.ws + WS_RWV); GAS bf16* RWKK = (GAS bf16*)(C.ws + WS_RWKK); GAS bf16* RWB = (GAS bf16*)(C.ws + WS_RWB); GAS bf16* RWG = (GAS bf16*)(C.ws + WS_RWG); \
    const GAS bf16* W2T = (const GAS bf16*)(C.ws + WS_RW2T); const GAS bf16* A2T = W2T + 512 * 64; const GAS bf16* G2T = A2T + 512 * 64;       \
    const GAS float* mu = a->in[21] + (size_t)l * 1792; const GAS float* w0 = a->in[22] + (size_t)l * 512; const GAS float* a0 = a->in[24] + (size_t)l * 512; \
    const GAS float* k_k = a->in[27] + (size_t)l * 512; const GAS float* k_a = a->in[28] + (size_t)l * 512; \
    LB WLb = (LB)C.lds; LB ALb = (LB)(C.lds + 9216); LB GLb = (LB)(C.lds + 18432);         \
    LB KX = (LB)(C.lds + 35840); LF w0s = (LF)(C.lds + 102400); LF a0s = w0s + 512; LF kks = a0s + 512; LF kas = kks + 512; LF INVs = kas + 512;     \
    (void)KX; (void)w0s; (void)a0s; (void)kks; (void)kas; (void)INVs; \
    (void)P; (void)RWW; (void)RWR; (void)RWK; (void)RWV; (void)RWKK; (void)RWB; (void)RWG; (void)W2T; (void)A2T; (void)G2T; (void)mu; (void)w0; (void)a0; (void)k_k; (void)k_a; (void)WLb; (void)ALb; (void)GLb;
#define RWP_LANE const int head = C.wave, n = C.lane & 31, hi = C.lane >> 5; const size_t row0 = (size_t)bc * 64 + 32 * tt; (void)row0;
PH_FN void rwp_stage(const Ctx C, ArgsP a, int l, int bc) {
    RWP_PTRS
    WG_SYNC();
    { const int t = C.tid >> 3, cg = C.tid & 7; float o[8];
      rw_lerp8(P, mu, bc, t, 1536 + cg * 8, o);
#pragma unroll
      for (int i = 0; i < 8; ++i) o[i] = tanhf(o[i]);
      *(LAS u32x4*)(WLb + t * 72 + cg * 8) = pack8(o);
      rw_lerp8(P, mu, bc, t, 1600 + cg * 8, o); *(LAS u32x4*)(ALb + t * 72 + cg * 8) = pack8(o);
#pragma unroll
      for (int half = 0; half < 2; ++half) { rw_lerp8(P, mu, bc, t, 1664 + cg * 16 + half * 8, o);
#pragma unroll
          for (int i = 0; i < 8; ++i) o[i] = sigmoidf_(o[i]);
          *(LAS u32x4*)(GLb + t * 136 + cg * 16 + half * 8) = pack8(o); }
      const size_t row = (size_t)bc * 64 + t;
#pragma unroll 2
      for (int j = 0; j < 8; ++j) { const int c = j * 64 + cg * 8;
          rw_lerp8(P, mu, bc, t, c, o); *(GAS u32x4*)(RWR + row * 512 + c) = pack8(o);
          rw_lerp8(P, mu, bc, t, 1024 + c, o); *(GAS u32x4*)(RWV + row * 512 + c) = pack8(o);
          rw_lerp8(P, mu, bc, t, 512 + c, o); *(LAS u32x4*)(KX + t * 520 + c) = pack8(o);
          const f32x4 k0 = *(const GAS f32x4*)(k_k + c), k1 = *(const GAS f32x4*)(k_k + c + 4); float ss = 0.f;
#pragma unroll
          for (int i = 0; i < 4; ++i) { const float q0 = o[i] * k0[i], q1 = o[4 + i] * k1[i]; ss += q0 * q0 + q1 * q1; }
          ss += __shfl_xor(ss, 1); ss += __shfl_xor(ss, 2); ss += __shfl_xor(ss, 4);
          if (cg == 0) INVs[t * 8 + j] = 1.0f / fmaxf(sqrtf(ss), 1e-12f); }
      const int q = C.tid * 4; *(LAS f32x4*)(w0s + q) = *(const GAS f32x4*)((q < 512 ? w0 : q < 1024 ? a0 - 512 : q < 1536 ? k_k - 1024 : k_a - 1536) + q); }
    WG_SYNC();
}
PH_FN void rwp_w(const Ctx C, ArgsP a, int l, int bc, int tt) {
    RWP_PTRS RWP_LANE
#pragma unroll
    for (int nt = 0; nt < 2; ++nt) { f32x16 c = zero16();
#pragma unroll
        for (int s4 = 0; s4 < 4; ++s4) c = __builtin_amdgcn_mfma_f32_32x32x16_bf16(frag32(WLb, 72, 32 * tt, 16 * s4, C.lane), RW_WFRAG(W2T, 64, nt, s4), c, 0, 0, 0);
        const int ch = head * 64 + 32 * nt + n; const float w0c = w0s[ch];
#pragma unroll
        for (int r = 0; r < 16; ++r) RWW[(row0 + crow(r, hi)) * 512 + ch] = -0.606531f * sigmoidf_(w0c + c[r]); }
}
PH_FN void rwp_g(const Ctx C, ArgsP a, int l, int bc, int tt) {
    RWP_PTRS RWP_LANE
#pragma unroll
    for (int nt = 0; nt < 2; ++nt) { f32x16 c = zero16();
#pragma unroll
        for (int s8 = 0; s8 < 8; ++s8) c = __builtin_amdgcn_mfma_f32_32x32x16_bf16(frag32(GLb, 136, 32 * tt, 16 * s8, C.lane), RW_WFRAG(G2T, 128, nt, s8), c, 0, 0, 0);
        const int ch = head * 64 + 32 * nt + n;
#pragma unroll
        for (int r = 0; r < 16; ++r) RWG[(row0 + crow(r, hi)) * 512 + ch] = (bf16)f2bf(c[r]); }
}
PH_FN void rwp_ak(const Ctx C, ArgsP a, int l, int bc, int tt) {
    RWP_PTRS RWP_LANE
#pragma unroll
    for (int nt = 0; nt < 2; ++nt) { f32x16 c = zero16();
#pragma unroll
        for (int s4 = 0; s4 < 4; ++s4) c = __builtin_amdgcn_mfma_f32_32x32x16_bf16(frag32(ALb, 72, 32 * tt, 16 * s4, C.lane), RW_WFRAG(A2T, 64, nt, s4), c, 0, 0, 0);
        const int ch = head * 64 + 32 * nt + n; const float a0c = a0s[ch], kkc = kks[ch], kac = kas[ch];
#pragma unroll
        for (int r = 0; r < 16; ++r) { const int tl = 32 * tt + crow(r, hi); const float al = sigmoidf_(a0c + c[r]), x = bf2f(KX[tl * 520 + ch]), kkn = x * kkc * INVs[tl * 8 + head];
            const size_t g = ((size_t)bc * 64 + tl) * 512 + ch;
            RWKK[g] = (bf16)f2bf(kkn); RWB[g] = (bf16)f2bf(kkn * al); RWK[g] = (bf16)f2bf(x * (1.0f + (al - 1.0f) * kac)); } }
}
#undef RW_WFRAG
#undef RWP_PTRS
#undef RWP_LANE
__device__ __forceinline__ void ph_rw_prep(const Ctx& C, ArgsP a, int l) {
    for (int bc = C.bid; bc < NBC; bc += C.G) { rwp_stage(C, a, l, bc);
#pragma unroll 1
        for (int tt = 0; tt < 2; ++tt) { rwp_w(C, a, l, bc, tt); rwp_g(C, a, l, bc, tt); rwp_ak(C, a, l, bc, tt); } }
    WG_SYNC();
}
template <int CTRL> __device__ __forceinline__ float dpp_get(float x) { return __builtin_bit_cast(float, __builtin_amdgcn_update_dpp(0, __builtin_bit_cast(int, x), CTRL, 0xf, 0xf, true)); }
__device__ __forceinline__ float reduce16(float x) { x += dpp_get<0xB1>(x); x += dpp_get<0x4E>(x); x += dpp_get<0x141>(x); x += dpp_get<0x140>(x); return x; }
#define RW_BAR() do { asm volatile("s_waitcnt lgkmcnt(0)" ::: "memory"); __builtin_amdgcn_s_barrier(); asm volatile("" ::: "memory"); } while (0)
PH_FN void rw_unit(const Ctx C, int chain, int rq) {
    const GAS float* RWW = (const GAS float*)(C.ws + WS_RWW); const GAS bf16* RWR = (const GAS bf16*)(C.ws + WS_RWR); const GAS bf16* RWK = (const GAS bf16*)(C.ws + WS_RWK); const GAS bf16* RWV = (const GAS bf16*)(C.ws + WS_RWV);
    const GAS bf16* RWKK = (const GAS bf16*)(C.ws + WS_RWKK); const GAS bf16* RWB = (const GAS bf16*)(C.ws + WS_RWB); GAS bf16* RWY = (GAS bf16*)(C.ws + WS_RWY);
    const int b = chain >> 3, h = chain & 7; const size_t rowb = (size_t)b * SEQ;
    constexpr int BUFB = 43008, O_KK = 0, O_W = 8192, O_B = 16384, O_K = 24576, O_R = 32768, O_V = 40960, NBLK = SEQ / 32;
    LAS unsigned char* L = C.lds;
    if (C.wave >= 4) {
        const int p = C.tid - 256, t = p >> 3, c8 = (p & 7) * 8;
        u32x4 rr, rk, rkk, rb; f32x4 w0, w1; unsigned rv;
#define RW_LOAD(blk) do { const size_t g_ = (rowb + (size_t)(blk) * 32 + t) * 512 + h * 64; \
            w0 = *(const GAS f32x4*)(RWW + g_ + c8); w1 = *(const GAS f32x4*)(RWW + g_ + c8 + 4); rr = *(const GAS u32x4*)(RWR + g_ + c8); rk = *(const GAS u32x4*)(RWK + g_ + c8); \
            rkk = *(const GAS u32x4*)(RWKK + g_ + c8); rb = *(const GAS u32x4*)(RWB + g_ + c8); rv = *(const GAS unsigned*)(RWV + g_ + 16 * rq + (p & 7) * 2); } while (0)
#define RW_ST8(off, w_) do { float o_[8]; unpack8(w_, o_); LF d_ = (LF)(Lb + (off)) + t * 64 + c8; *(LAS f32x4*)d_ = (f32x4){o_[0], o_[1], o_[2], o_[3]}; *(LAS f32x4*)(d_ + 4) = (f32x4){o_[4], o_[5], o_[6], o_[7]}; } while (0)
        RW_LOAD(0);
        for (int blk = 0; blk < NBLK; ++blk) {
            LAS unsigned char* Lb = L + (blk & 1) * BUFB;
            { LF d = (LF)(Lb + O_W) + t * 64 + c8; *(LAS f32x4*)d = w0; *(LAS f32x4*)(d + 4) = w1; }
            RW_ST8(O_R, rr); RW_ST8(O_K, rk); RW_ST8(O_KK, rkk); RW_ST8(O_B, rb);
            { LF d = (LF)(Lb + O_V) + t * 16 + (p & 7) * 2; d[0] = bflo(rv); d[1] = bfhi(rv); }
            if (blk + 1 < NBLK) RW_LOAD(blk + 1);
            RW_BAR();
        }
        RW_BAR();
#undef RW_LOAD
#undef RW_ST8
    } else {
        const int rowl = C.lane >> 4, ks = C.lane & 15, row = 4 * C.wave + rowl;
        float S0 = 0.f, S1 = 0.f, S2 = 0.f, S3 = 0.f, ykeep = 0.f;
        GAS bf16* yout = RWY + rowb * 512 + h * 64 + 16 * rq + row;
        for (int blk = 0; blk < NBLK; ++blk) {
            RW_BAR();
            const LAS unsigned char* Lb = L + (blk & 1) * BUFB;
            CLF pKK = (CLF)(Lb + O_KK) + 4 * ks; CLF pW = (CLF)(Lb + O_W) + 4 * ks; CLF pB = (CLF)(Lb + O_B) + 4 * ks; CLF pK = (CLF)(Lb + O_K) + 4 * ks; CLF pR = (CLF)(Lb + O_R) + 4 * ks; CLF pV = (CLF)(Lb + O_V) + row;
            f32x4 kk = *(const LAS f32x4*)pKK, w = *(const LAS f32x4*)pW, bb = *(const LAS f32x4*)pB, k = *(const LAS f32x4*)pK, r = *(const LAS f32x4*)pR; float vv = *pV;
#pragma unroll 4
            for (int t = 0; t < 32; ++t) {
                f32x4 nkk, nw, nb, nk, nr; float nv;
                const int tn = (t < 31) ? t + 1 : t;
                nkk = *(const LAS f32x4*)(pKK + tn * 64); nw = *(const LAS f32x4*)(pW + tn * 64); nb = *(const LAS f32x4*)(pB + tn * 64); nk = *(const LAS f32x4*)(pK + tn * 64); nr = *(const LAS f32x4*)(pR + tn * 64); nv = pV[tn * 16];
                float sa = (S0 * kk[0] + S1 * kk[1]) + (S2 * kk[2] + S3 * kk[3]);
                sa = -reduce16(sa);
                const float vk0 = vv * k[0], vk1 = vv * k[1], vk2 = vv * k[2], vk3 = vv * k[3];
                S0 = S0 * w[0] + (sa * bb[0] + vk0); S1 = S1 * w[1] + (sa * bb[1] + vk1); S2 = S2 * w[2] + (sa * bb[2] + vk2); S3 = S3 * w[3] + (sa * bb[3] + vk3);
                float y = (S0 * r[0] + S1 * r[1]) + (S2 * r[2] + S3 * r[3]);
                y = reduce16(y);
                if ((t & 15) == ks) ykeep = y;
                if ((t & 15) == 15) yout[(size_t)(blk * 32 + (t & 16) + ks) * 512] = (bf16)f2bf(ykeep);
                kk = nkk; w = nw; bb = nb; k = nk; r = nr; vv = nv;
            }
        }
        RW_BAR();
    }
}
PH_FN void ph_rw_out(const Ctx C, ArgsP a, int l) {
    const GAS bf16* RWR = (const GAS bf16*)(C.ws + WS_RWR); const GAS bf16* RWK = (const GAS bf16*)(C.ws + WS_RWK); const GAS bf16* RWV = (const GAS bf16*)(C.ws + WS_RWV); const GAS bf16* RWG = (const GAS bf16*)(C.ws + WS_RWG); const GAS bf16* RWY = (const GAS bf16*)(C.ws + WS_RWY);
    GAS bf16* YS = (GAS bf16*)(C.ws + WS_YS);
    const GAS float* r_k = a->in[29] + (size_t)l * 512; const GAS float* nw = a->in[30] + (size_t)l * 512; const GAS float* nb = a->in[31] + (size_t)l * 512;
    const int gw = C.bid * NWAVES + C.wave, NGW = C.G * NWAVES, c0 = C.lane * 8;
    float rk[8], w8[8], b8[8];
#pragma unroll
    for (int i = 0; i < 8; ++i) { rk[i] = r_k[c0 + i]; w8[i] = nw[c0 + i]; b8[i] = nb[c0 + i]; }
    for (int row0 = gw * 2; row0 < M; row0 += NGW * 2) {
        u32x4 yw[2], rw[2], kw[2], vw[2], gw4[2];
#pragma unroll
        for (int u = 0; u < 2; ++u) { const size_t g = (size_t)(row0 + u) * 512 + c0; yw[u] = *(const GAS u32x4*)(RWY + g); rw[u] = *(const GAS u32x4*)(RWR + g); kw[u] = *(const GAS u32x4*)(RWK + g); vw[u] = *(const GAS u32x4*)(RWV + g); gw4[u] = *(const GAS u32x4*)(RWG + g); }
#pragma unroll
        for (int u = 0; u < 2; ++u) { float y[8], r[8], k[8], v[8], gg[8], o[8]; unpack8(yw[u], y); unpack8(rw[u], r); unpack8(kw[u], k); unpack8(vw[u], v); unpack8(gw4[u], gg);
            float s = 0.f, bs = 0.f;
#pragma unroll
            for (int i = 0; i < 8; ++i) { s += y[i]; bs += r[i] * k[i] * rk[i]; }
            s += __shfl_xor(s, 1); s += __shfl_xor(s, 2); s += __shfl_xor(s, 4); bs += __shfl_xor(bs, 1); bs += __shfl_xor(bs, 2); bs += __shfl_xor(bs, 4);
            const float mu = s * (1.0f / 64.0f); float q = 0.f;
#pragma unroll
            for (int i = 0; i < 8; ++i) { y[i] -= mu; q += y[i] * y[i]; }
            q += __shfl_xor(q, 1); q += __shfl_xor(q, 2); q += __shfl_xor(q, 4);
            const float rs = 1.0f / sqrtf(q * (1.0f / 64.0f) + 64e-5f);
#pragma unroll
            for (int i = 0; i < 8; ++i) o[i] = (y[i] * rs * w8[i] + b8[i] + bs * v[i]) * gg[i];
            *(GAS u32x4*)(YS + (size_t)(row0 + u) * 2048 + 1536 + c0) = pack8(o); }
    }
}

__device__ __forceinline__ int pi_swap23(int i) { return (i & ~12) | ((i & 4) << 1) | ((i & 8) >> 1); }
__device__ __forceinline__ void da_unit(const Ctx& C, const Args& a, int l, int b, int h, int jq, float lam, float oml) {
    const GAS bf16* P = (const GAS bf16*)(C.ws + WS_P); const GAS bf16* VT = (const GAS bf16*)(C.ws + WS_VT); GAS bf16* YS = (GAS bf16*)(C.ws + WS_YS);
    const GAS float* dnorm = (const GAS float*)a.in[11] + (size_t)l * 128;
    const int comp = C.wave >> 2, wq = C.wave & 3, q = C.lane & 31, hi = C.lane >> 5;
    const size_t qrow = (size_t)b * SEQ + jq * 128 + wq * 32 + q;
    pg8::bf16x8 qf[4];
#pragma unroll
    for (int d0 = 0; d0 < 4; ++d0) qf[d0] = *(const GAS pg8::bf16x8*)(P + qrow * NPM + C_DAQ + h * 128 + comp * 64 + 16 * d0 + 8 * hi);
    const int ntile = 2 * jq + 2, my_last = 2 * jq + (wq >= 2 ? 1 : 0);
    f32x16 O[4];
#pragma unroll
    for (int db = 0; db < 4; ++db)
#pragma unroll
        for (int r = 0; r < 16; ++r) O[db][r] = 0.f;
    float mrun = 0.f, lrun = 0.f;
    f32x16 negm;
#pragma unroll
    for (int r = 0; r < 16; ++r) negm[r] = 0.f;
    const GAS bf16* kgb = P + (size_t)b * SEQ * NPM + C_DAK + h * 128 + C.wave * 8;
    const GAS bf16* vgb = VT + ((size_t)(b * 4 + h) * 128 + 64 * (C.wave & 1)) * SEQ + (C.wave >> 1) * 8;
    const unsigned koff = (unsigned)C.lane * (unsigned)(NPM * 2), voff = (unsigned)C.lane * (unsigned)(SEQ * 2);
    const unsigned lds0 = (unsigned)(size_t)C.lds;
    const unsigned kdst0 = lds0 + (unsigned)(C.wave >> 3) * 8192u + (unsigned)(C.wave & 7) * 1024u;
    const unsigned vdst0 = lds0 + 32768u + (unsigned)(C.wave >> 1) * 2048u + (unsigned)(C.wave & 1) * 1024u;
    const int pq = pi_swap23(q);
    pg8::bf16x8 pb[4] = {};
    int vs = 0, vsp = 0;
#define DA_GLDS(base_, off_, dst_) do { unsigned keep_; asm volatile("s_mov_b32 %0, m0\n\ts_mov_b32 m0, %3\n\ts_nop 0\n\tglobal_load_lds_dwordx4 %1, %2\n\ts_mov_b32 m0, %0" : "=&s"(keep_) : "v"(off_), "s"(base_), "s"((unsigned)__builtin_amdgcn_readfirstlane(dst_)) : "memory"); } while (0)
#define DA_DMA(tile_, vslot_) do { const GAS bf16* kp_ = kgb + (size_t)(tile_) * 64 * NPM; const GAS bf16* vp_ = vgb + (tile_) * 64; const unsigned kd_ = kdst0 + (unsigned)((tile_) & 1) * 16384u, vd_ = vdst0 + (unsigned)(vslot_); \
        DA_GLDS(kp_, koff, kd_); DA_GLDS(kp_ + 64, koff, kd_ + 8192u); DA_GLDS(vp_, voff, vd_); DA_GLDS(vp_ + 32, voff, vd_ + 8192u); } while (0)
#define DA_STAGE(tile_) do { asm volatile("s_waitcnt vmcnt(0)" ::: "memory"); WG_SYNC(); if ((tile_) + 1 < ntile) DA_DMA((tile_) + 1, (vs == 32768) ? 0 : vs + 16384); } while (0)
#define DA_QK(tile_) do { const LAS unsigned char* kb_ = C.lds + ((tile_) & 1) * 16384 + comp * 8192 + hi * 1024 + pq * 16; pg8::bf16x8 ka_[8]; \
        _Pragma("unroll") for (int d0 = 0; d0 < 4; ++d0) { ka_[2 * d0] = *(const LAS pg8::bf16x8*)(kb_ + d0 * 2048); ka_[2 * d0 + 1] = *(const LAS pg8::bf16x8*)(kb_ + d0 * 2048 + 512); } \
        __builtin_amdgcn_sched_barrier(0); \
        p0 = __builtin_amdgcn_mfma_f32_32x32x16_bf16(ka_[0], qf[0], negm, 0, 0, 0); p1 = __builtin_amdgcn_mfma_f32_32x32x16_bf16(ka_[1], qf[0], negm, 0, 0, 0); \
        _Pragma("unroll") for (int d0 = 1; d0 < 4; ++d0) { p0 = __builtin_amdgcn_mfma_f32_32x32x16_bf16(ka_[2 * d0], qf[d0], p0, 0, 0, 0); p1 = __builtin_amdgcn_mfma_f32_32x32x16_bf16(ka_[2 * d0 + 1], qf[d0], p1, 0, 0, 0); } } while (0)
#define DA_PV(PB_, voff_) do { const LAS unsigned char* vb_ = C.lds + 32768 + (voff_); _Pragma("unroll") for (int db = 0; db < 4; ++db) _Pragma("unroll") for (int s = 0; s < 4; ++s) { \
            const pg8::bf16x8 vf_ = *(const LAS pg8::bf16x8*)(vb_ + (2 * s + hi) * 2048 + (32 * db + q) * 16); O[db] = __builtin_amdgcn_mfma_f32_32x32x16_bf16(vf_, PB_[s], O[db], 0, 0, 0); } } while (0)
#define DA_MX3(a_, b_, c_) __builtin_fmaxf(__builtin_fmaxf((a_), (b_)), (c_))
#define DA_SM_MAX(FIRST_, PBP_) do { \
        float ma = DA_MX3(p0[0], p0[1], p1[0]), mb = DA_MX3(p0[2], p0[3], p1[1]); ma = DA_MX3(ma, p1[2], p1[3]); \
        _Pragma("unroll") for (int r = 4; r < 16; r += 4) { ma = DA_MX3(ma, p0[r], p0[r + 1]); mb = DA_MX3(mb, p0[r + 2], p0[r + 3]); ma = DA_MX3(ma, p1[r], p1[r + 1]); mb = DA_MX3(mb, p1[r + 2], p1[r + 3]); } \
        float rm = __builtin_fmaxf(ma, mb); rm = __builtin_fmaxf(rm, __shfl_xor(rm, 32)); \
        if ((FIRST_) || __any(rm > 8.0f)) { const float dl = (FIRST_) ? rm : __builtin_fmaxf(rm, 0.f); mrun += dl; const float f = __builtin_amdgcn_exp2f(-dl); lrun *= f; \
            _Pragma("unroll") for (int r = 0; r < 16; ++r) { p0[r] -= dl; p1[r] -= dl; negm[r] = -mrun; } \
            _Pragma("unroll") for (int db = 0; db < 4; ++db) _Pragma("unroll") for (int r = 0; r < 16; ++r) O[db][r] *= f; \
            if (!(FIRST_)) { _Pragma("unroll") for (int s_ = 0; s_ < 4; ++s_) { const u32x4 w_ = __builtin_bit_cast(u32x4, PBP_[s_]); u32x4 o_; \
                o_.x = pk2(bflo(w_.x) * f, bfhi(w_.x) * f); o_.y = pk2(bflo(w_.y) * f, bfhi(w_.y) * f); o_.z = pk2(bflo(w_.z) * f, bfhi(w_.z) * f); o_.w = pk2(bflo(w_.w) * f, bfhi(w_.w) * f); PBP_[s_] = __builtin_bit_cast(pg8::bf16x8, o_); } } } } while (0)
#define DA_SM_EXP(PBO_) do { \
        _Pragma("unroll") for (int r = 0; r < 16; ++r) { p0[r] = __builtin_amdgcn_exp2f(p0[r]); p1[r] = __builtin_amdgcn_exp2f(p1[r]); } \
        { f32x2 s2 = {0.f, 0.f}; _Pragma("unroll") for (int r = 0; r < 16; r += 2) { s2 += (f32x2){p0[r], p0[r + 1]}; s2 += (f32x2){p1[r], p1[r + 1]}; } lrun += s2[0] + s2[1]; } \
        { u32x4 w; \
          w.x = pk2(p0[0], p0[1]); w.y = pk2(p0[2], p0[3]); w.z = pk2(p0[4], p0[5]); w.w = pk2(p0[6], p0[7]); PBO_[0] = __builtin_bit_cast(pg8::bf16x8, w); \
          w.x = pk2(p0[8], p0[9]); w.y = pk2(p0[10], p0[11]); w.z = pk2(p0[12], p0[13]); w.w = pk2(p0[14], p0[15]); PBO_[1] = __builtin_bit_cast(pg8::bf16x8, w); \
          w.x = pk2(p1[0], p1[1]); w.y = pk2(p1[2], p1[3]); w.z = pk2(p1[4], p1[5]); w.w = pk2(p1[6], p1[7]); PBO_[2] = __builtin_bit_cast(pg8::bf16x8, w); \
          w.x = pk2(p1[8], p1[9]); w.y = pk2(p1[10], p1[11]); w.z = pk2(p1[12], p1[13]); w.w = pk2(p1[14], p1[15]); PBO_[3] = __builtin_bit_cast(pg8::bf16x8, w); } } while (0)
#define DA_VADDR(i_) (vb_ + ((i_) & 3) * 4096 + ((i_) >> 2) * 512)
#define DA_PV_EXP(PBP_, voff_, PBO_) do { const LAS unsigned char* vb_ = C.lds + 32768 + (voff_) + hi * 2048 + q * 16; f32x2 s2_ = {0.f, 0.f}; unsigned pw_[16]; \
        pg8::bf16x8 vq_[4];   \
        vq_[0] = *(const LAS pg8::bf16x8*)DA_VADDR(0); vq_[1] = *(const LAS pg8::bf16x8*)DA_VADDR(1); vq_[2] = *(const LAS pg8::bf16x8*)DA_VADDR(2); \
        _Pragma("unroll") for (int i_ = 0; i_ < 16; ++i_) { const int db_ = i_ >> 2, s_ = i_ & 3; \
            if (i_ + 3 < 16) vq_[(i_ + 3) & 3] = *(const LAS pg8::bf16x8*)DA_VADDR(i_ + 3); \
            O[db_] = __builtin_amdgcn_mfma_f32_32x32x16_bf16(vq_[i_ & 3], PBP_[s_], O[db_], 0, 0, 0); \
            float e0_, e1_; if (i_ < 8) { e0_ = __builtin_amdgcn_exp2f(p0[2 * i_]); e1_ = __builtin_amdgcn_exp2f(p0[2 * i_ + 1]); } else { e0_ = __builtin_amdgcn_exp2f(p1[2 * i_ - 16]); e1_ = __builtin_amdgcn_exp2f(p1[2 * i_ - 15]); } \
            s2_ += (f32x2){e0_, e1_}; pw_[i_] = pk2(e0_, e1_); \
            __builtin_amdgcn_sched_barrier(0); } \
        lrun += s2_[0] + s2_[1]; \
        _Pragma("unroll") for (int k_ = 0; k_ < 4; ++k_) { u32x4 w_; w_.x = pw_[4 * k_]; w_.y = pw_[4 * k_ + 1]; w_.z = pw_[4 * k_ + 2]; w_.w = pw_[4 * k_ + 3]; PBO_[k_] = __builtin_bit_cast(pg8::bf16x8, w_); } } while (0)
    f32x16 p0, p1;
    if (comp == 0) __builtin_amdgcn_s_setprio(1);
    DA_DMA(0, 0);
    DA_STAGE(0); DA_QK(0); DA_SM_MAX(true, pb); DA_SM_EXP(pb);
    for (int tile = 1; tile <= my_last; ++tile) {
        vsp = vs; vs = (vs == 32768) ? 0 : vs + 16384;
        DA_STAGE(tile); DA_QK(tile); DA_SM_MAX(false, pb);
        DA_PV_EXP(pb, vsp, pb);
    }
    if (my_last < ntile - 1) { const int vkeep = vs; vs = (vs == 32768) ? 0 : vs + 16384; DA_STAGE(ntile - 1); vs = vkeep; }
    __builtin_amdgcn_s_setprio(0);
    DA_PV(pb, vs);
#undef DA_GLDS
#undef DA_DMA
#undef DA_STAGE
#undef DA_QK
#undef DA_PV
#undef DA_MX3
#undef DA_SM_MAX
#undef DA_SM_EXP
#undef DA_PV_EXP
#undef DA_VADDR
    const float ltot = lrun + __shfl_xor(lrun, 32); const float inv = 1.0f / ltot;
    WG_SYNC();
    LF X = (LF)C.lds + (wq * 32 + q) * 132;
    if (comp == 1) {
        const float sc = inv * lam;
#pragma unroll
        for (int db = 0; db < 4; ++db)
#pragma unroll
            for (int g4 = 0; g4 < 4; ++g4) *(LAS f32x4*)(X + 32 * db + 8 * g4 + 4 * hi) = (f32x4){O[db][4 * g4] * sc, O[db][4 * g4 + 1] * sc, O[db][4 * g4 + 2] * sc, O[db][4 * g4 + 3] * sc};
    }
    WG_SYNC();
    if (comp == 0) {
        float ss = 0.f;
#pragma unroll
        for (int db = 0; db < 4; ++db)
#pragma unroll
            for (int g4 = 0; g4 < 4; ++g4) { const f32x4 x = *(const LAS f32x4*)(X + 32 * db + 8 * g4 + 4 * hi);
#pragma unroll
                for (int e = 0; e < 4; ++e) { const float v = O[db][4 * g4 + e] * inv - x[e]; O[db][4 * g4 + e] = v; ss += v * v; } }
        ss += __shfl_xor(ss, 32);
        const float rs = oml / sqrtf(ss * (1.0f / 128.0f) + EPS);
#pragma unroll
        for (int db = 0; db < 4; ++db)
#pragma unroll
            for (int g4 = 0; g4 < 4; ++g4) { const int d = 32 * db + 8 * g4 + 4 * hi; const f32x4 gn = *(const GAS f32x4*)(dnorm + d);
                u32x2 w; w.x = pk2(O[db][4 * g4] * rs * gn[0], O[db][4 * g4 + 1] * rs * gn[1]); w.y = pk2(O[db][4 * g4 + 2] * rs * gn[2], O[db][4 * g4 + 3] * rs * gn[3]);
                *(GAS u32x2*)(YS + qrow * 2048 + h * 128 + d) = w; }
    }
    WG_SYNC();
}
#if RW_CHUNKED
__device__ const signed char ATT_BINS30[30][3] = {{63,4,3}, {62,5,2}, {61,6,1}, {60,7,0}, {59,8,-1}, {58,9,-1}, {57,10,-1}, {56,11,-1}, {55,12,-1}, {54,13,-1}, {53,14,-1}, {52,15,-1}, {51,16,-1}, {50,17,-1}, {49,18,-1}, {48,19,-1}, {47,20,-1}, {46,21,-1}, {45,22,-1}, {44,23,-1}, {43,24,-1}, {42,25,-1}, {41,26,-1}, {40,27,-1}, {39,28,-1}, {38,29,-1}, {37,30,-1}, {36,31,-1}, {35,32,-1}, {34,33,-1}};
__device__ __forceinline__ int att_bin_unit(int bin, int i) { return i < 3 ? (int)ATT_BINS30[bin][i] : -1; }
#else
__device__ const signed char ATT_BINS[24][12] = {{63,21,-1,-1,-1,-1,-1,-1,-1,-1,-1,-1}, {62,22,-1,-1,-1,-1,-1,-1,-1,-1,-1,-1}, {61,23,-1,-1,-1,-1,-1,-1,-1,-1,-1,-1}, {60,24,-1,-1,-1,-1,-1,-1,-1,-1,-1,-1}, {59,25,-1,-1,-1,-1,-1,-1,-1,-1,-1,-1}, {58,26,-1,-1,-1,-1,-1,-1,-1,-1,-1,-1}, {57,27,-1,-1,-1,-1,-1,-1,-1,-1,-1,-1}, {56,28,-1,-1,-1,-1,-1,-1,-1,-1,-1,-1}, {55,29,-1,-1,-1,-1,-1,-1,-1,-1,-1,-1}, {54,30,-1,-1,-1,-1,-1,-1,-1,-1,-1,-1}, {53,31,-1,-1,-1,-1,-1,-1,-1,-1,-1,-1}, {52,32,-1,-1,-1,-1,-1,-1,-1,-1,-1,-1}, {51,33,-1,-1,-1,-1,-1,-1,-1,-1,-1,-1}, {50,34,-1,-1,-1,-1,-1,-1,-1,-1,-1,-1}, {49,35,-1,-1,-1,-1,-1,-1,-1,-1,-1,-1}, {48,36,-1,-1,-1,-1,-1,-1,-1,-1,-1,-1}, {47,37,-1,-1,-1,-1,-1,-1,-1,-1,-1,-1}, {46,38,-1,-1,-1,-1,-1,-1,-1,-1,-1,-1}, {45,39,-1,-1,-1,-1,-1,-1,-1,-1,-1,-1}, {44,40,-1,-1,-1,-1,-1,-1,-1,-1,-1,-1}, {43,41,-1,-1,-1,-1,-1,-1,-1,-1,-1,-1}, {42,20,19,6,-1,-1,-1,-1,-1,-1,-1,-1}, {18,17,16,15,14,5,-1,-1,-1,-1,-1,-1}, {13,12,11,10,9,8,7,4,3,2,1,0}};
__device__ __forceinline__ int att_bin_unit(int bin, int i) { return i < 12 ? (int)ATT_BINS[bin][i] : -1; }
#endif
__device__ __forceinline__ void ph_da_attn(const Ctx& C, const Args& a, int l, int bh, int bin) {
    const GAS float* q1 = (const GAS float*)a.in[7] + (size_t)l * 64; const GAS float* k1 = (const GAS float*)a.in[8] + (size_t)l * 64; const GAS float* q2 = (const GAS float*)a.in[9] + (size_t)l * 64; const GAS float* k2 = (const GAS float*)a.in[10] + (size_t)l * 64;
    float s1 = 0.f, s2 = 0.f;
    for (int i = 0; i < 64; ++i) { s1 += q1[i] * k1[i]; s2 += q2[i] * k2[i]; }
    int ll = l; asm volatile("" : "+s"(ll));
    const float lam_init = 0.8f - 0.6f * expf(-0.3f * (float)ll); const float lam_v = expf(s1) - expf(s2) + lam_init;
    const float lam = __uint_as_float(__builtin_amdgcn_readfirstlane(__float_as_uint(lam_v))), oml = __uint_as_float(__builtin_amdgcn_readfirstlane(__float_as_uint(1.0f - lam_init)));
    for (int i = 0; i < 12; ++i) { const int jq = att_bin_unit(bin, i); if (jq < 0) break; da_unit(C, a, l, bh >> 2, bh & 3, jq, lam, oml); }
}

PH_FN void ph_final(const Ctx C, ArgsP a) {
    const GAS float* ssq = (const GAS float*)(C.ws + WS_SSQ); const GAS float* fn = a->in[39]; const GAS bf16* hb = (const GAS bf16*)(C.ws + WS_HB);
    const int gw = C.bid * NWAVES + C.wave, NGW = C.G * NWAVES;
    for (int m = gw; m < M; m += NGW) { const float rs = pg8::row_rstd((const float*)ssq, m, M); GAS f32x4* orow = (GAS f32x4*)(C.h + (size_t)m * D) + C.lane; const GAS f32x4* gr = (const GAS f32x4*)fn + C.lane;
        const GAS u32x2* hr = (const GAS u32x2*)(hb + (size_t)m * D) + C.lane;
#pragma unroll
        for (int j = 0; j < 4; ++j) { const u32x2 w = hr[64 * j]; const f32x4 g = gr[64 * j]; orow[64 * j] = (f32x4){bflo(w.x) * rs * g[0], bfhi(w.x) * rs * g[1], bflo(w.y) * rs * g[2], bfhi(w.y) * rs * g[3]}; } }
}
#define RWC_PTRS \
    GAS float* RWW = (GAS float*)(C.ws + WS_RWW); const GAS bf16* RWR = (const GAS bf16*)(C.ws + WS_RWR); const GAS bf16* RWK = (const GAS bf16*)(C.ws + WS_RWK); const GAS bf16* RWV = (const GAS bf16*)(C.ws + WS_RWV); \
    GAS bf16* RWKK = (GAS bf16*)(C.ws + WS_RWKK); GAS bf16* RWB = (GAS bf16*)(C.ws + WS_RWB); GAS bf16* RWY = (GAS bf16*)(C.ws + WS_RWY); \
    LF LGs = (LF)C.lds; LB LP = (LB)C.lds; LB LPT = (LB)(C.lds + 9216); LB AT = (LB)(C.lds + 18432); LB LAK = AT; LB LP2 = AT; LB RT = (LB)(C.lds + 27648); LB BTl = (LB)(C.lds + 36864); LB MRB = BTl; LB KTl = (LB)(C.lds + 46080); LB MRK = KTl; \
    LB VT = (LB)(C.lds + 55296); LB BHT = (LB)(C.lds + 64512); LB KHT = (LB)(C.lds + 73728); LB XB0 = (LB)(C.lds + 82944); LB XB1 = (LB)(C.lds + 101376); LB LPT2 = (LB)(C.lds + 119808); LF rho = (LF)(C.lds + 129024); LF lgl = rho + 64; \
    const int t = C.tid >> 3, g8 = C.tid & 7, n = C.lane & 31, hi = C.lane >> 5; \
    (void)RWW; (void)RWR; (void)RWK; (void)RWV; (void)RWKK; (void)RWB; (void)RWY; (void)LGs; (void)LP; (void)LPT; (void)AT; (void)LAK; (void)LP2; (void)RT; (void)BTl; (void)MRB; (void)KTl; (void)MRK; (void)VT; (void)BHT; (void)KHT; (void)XB0; (void)XB1; (void)LPT2; (void)rho; (void)lgl; (void)t; (void)g8; (void)n; (void)hi;
PH_FN void rwc_stage0(const Ctx C, int bc, int h) {
    RWC_PTRS
    const size_t row0 = (size_t)bc * 64; const size_t g = (row0 + t) * 512 + h * 64 + g8 * 8;
    WG_SYNC();
    float lw[8]; { const f32x4 x0 = *(const GAS f32x4*)(RWW + g), x1 = *(const GAS f32x4*)(RWW + g + 4); lw[0] = x0[0]; lw[1] = x0[1]; lw[2] = x0[2]; lw[3] = x0[3]; lw[4] = x1[0]; lw[5] = x1[1]; lw[6] = x1[2]; lw[7] = x1[3]; }
#pragma unroll
    for (int i = 0; i < 8; ++i) LGs[t * 68 + g8 * 8 + i] = lw[i];
    WG_SYNC();
    { const int seg = C.tid >> 6, k = C.tid & 63; float run = 0.f;
#pragma unroll
      for (int i = 0; i < 8; ++i) { run += LGs[(8 * seg + i) * 68 + k]; LGs[(8 * seg + i) * 68 + k] = run; }
      WG_SYNC();
      float off = 0.f;
#pragma unroll
      for (int sg = 0; sg < 7; ++sg) { const float tot = LGs[(8 * sg + 7) * 68 + k]; off += (sg < seg) ? tot : 0.f; }
      WG_SYNC();
#pragma unroll
      for (int i = 0; i < 8; ++i) LGs[(8 * seg + i) * 68 + k] += off; }
    WG_SYNC();
    {   float rf[8], kf[8], kkf[8], bf[8], lg[8], rh[8], ll[8], o1[8], o2[8], o3[8], o4[8];
        unpack8(*(const GAS u32x4*)(RWR + g), rf); unpack8(*(const GAS u32x4*)(RWK + g), kf); unpack8(*(const GAS u32x4*)(RWKK + g), kkf); unpack8(*(const GAS u32x4*)(RWB + g), bf);
#pragma unroll
        for (int i = 0; i < 8; ++i) { const int k = g8 * 8 + i; lg[i] = LGs[t * 68 + k]; rh[i] = LGs[31 * 68 + k]; ll[i] = LGs[63 * 68 + k]; }
#pragma unroll
        for (int i = 0; i < 8; ++i) { const int k = g8 * 8 + i; const float lm1 = lg[i] - lw[i];
            const float ed = __expf(lg[i] - rh[i]), edi = __expf(rh[i] - lg[i]), el = __expf(ll[i] - lg[i]);
            o1[i] = -kkf[i] * __expf(lm1 - rh[i]); o2[i] = rf[i] * ed; o3[i] = bf[i] * edi; o4[i] = kf[i] * edi;
            XB0[k * 72 + t] = (bf16)f2bf(-kkf[i] * __expf(lm1));
            BHT[k * 72 + t] = (bf16)f2bf(bf[i] * el); KHT[k * 72 + t] = (bf16)f2bf(kf[i] * el); }
        *(LAS u32x4*)(AT + t * 72 + g8 * 8) = pack8(o1); *(LAS u32x4*)(RT + t * 72 + g8 * 8) = pack8(o2); *(LAS u32x4*)(BTl + t * 72 + g8 * 8) = pack8(o3); *(LAS u32x4*)(KTl + t * 72 + g8 * 8) = pack8(o4);
        const u32x4 vv = *(const GAS u32x4*)(RWV + g); const unsigned vw[4] = {vv.x, vv.y, vv.z, vv.w};
#pragma unroll
        for (int i = 0; i < 4; ++i) { VT[(g8 * 8 + 2 * i) * 72 + t] = (bf16)(vw[i] & 0xffffu); VT[(g8 * 8 + 2 * i + 1) * 72 + t] = (bf16)(vw[i] >> 16); }
        if (t == 0) {
#pragma unroll
            for (int i = 0; i < 8; ++i) { rho[g8 * 8 + i] = rh[i]; lgl[g8 * 8 + i] = ll[i]; } }
    }
    WG_SYNC();
}
PH_FN void rwc_stage12(const Ctx C) {
    RWC_PTRS
    {   const int mt = C.wave >> 1, nt0 = 2 * (C.wave & 1);
        CLB Am = (mt < 2) ? (CLB)AT : (CLB)RT; const int m0 = 32 * (mt & 1);
        CLB Bm = (nt0 < 2) ? (CLB)BTl : (CLB)KTl;
        f32x16 c0 = zero16(), c1 = zero16();
        mma_nt<64>(c0, Am, 72, m0, Bm, 72, 0, C.lane); mma_nt<64>(c1, Am, 72, m0, Bm, 72, 32, C.lane);
        WG_SYNC();
#pragma unroll
        for (int r = 0; r < 16; ++r) { const int tt = m0 + crow(r, hi); const int j0 = n, j1 = 32 + n;
            if (mt < 2) { const bf16 x0 = (bf16)f2bf((j0 < tt) ? c0[r] : 0.f), x1 = (bf16)f2bf((j1 < tt) ? c1[r] : 0.f);
                if (nt0 < 2) { LP[tt * 72 + j0] = x0; LP[tt * 72 + j1] = x1; LPT[j0 * 72 + tt] = x0; LPT[j1 * 72 + tt] = x1; } else { LAK[tt * 72 + j0] = x0; LAK[tt * 72 + j1] = x1; } }
            else { const bf16 x0 = (bf16)f2bf((j0 <= tt) ? c0[r] : 0.f), x1 = (bf16)f2bf((j1 <= tt) ? c1[r] : 0.f);
                if (nt0 < 2) { MRB[tt * 72 + j0] = x0; MRB[tt * 72 + j1] = x1; } else { MRK[tt * 72 + j0] = x0; MRK[tt * 72 + j1] = x1; } } }
    }
    WG_SYNC();
    if (C.wave < 4) { const int vt = C.wave >> 1, tt0 = C.wave & 1; f32x16 c = zero16(); mma_nt<64>(c, VT, 72, 32 * vt, LAK, 72, 32 * tt0, C.lane);
#pragma unroll
        for (int r = 0; r < 16; ++r) XB0[(64 + 32 * vt + crow(r, hi)) * 72 + 32 * tt0 + n] = (bf16)f2bf(c[r]); }
    WG_SYNC();
}
#ifndef RWC_NSTEP
#define RWC_NSTEP 6
#endif
#ifndef RWC_REP0
#define RWC_REP0 1
#endif
PH_FN void rwc_solve(const Ctx C) {
    RWC_PTRS
    const int ct = C.wave >> 1, tt = C.wave & 1;
    const int sk = C.wave >> 2, st = (C.wave >> 1) & 1, sj = C.wave & 1;
#pragma unroll 1
    for (int i = 0; i < RWC_NSTEP; ++i) {
        CLB Pc = (i & 1) ? (CLB)LP2 : (CLB)LP; CLB PTc = (i & 1) ? (CLB)LPT2 : (CLB)LPT; LB Pn = (i & 1) ? LP : LP2; LB PTn = (i & 1) ? LPT : LPT2;
        CLB Xc = (i & 1) ? (CLB)XB1 : (CLB)XB0; LB Xn = (i & 1) ? XB0 : XB1;
        { f32x16 acc;
#pragma unroll
          for (int r = 0; r < 16; ++r) acc[r] = bf2f(Xc[(32 * ct + crow(r, hi)) * 72 + 32 * tt + n]);
          mma_nt<64>(acc, Xc, 72, 32 * ct, Pc, 72, 32 * tt, C.lane);
#pragma unroll
          for (int r = 0; r < 16; ++r) Xn[(32 * ct + crow(r, hi)) * 72 + 32 * tt + n] = (bf16)f2bf(acc[r]); }
        if (i < RWC_NSTEP - 1) { f32x16 acc = zero16();
          if (sk == 0) mma_nt<64>(acc, Pc, 72, 32 * st, PTc, 72, 32 * sj, C.lane); else mma_nt<64>(acc, PTc, 72, 32 * st, Pc, 72, 32 * sj, C.lane);
          LB dst = (sk == 0) ? Pn : PTn;
#pragma unroll
          for (int r = 0; r < 16; ++r) dst[(32 * st + crow(r, hi)) * 72 + 32 * sj + n] = (bf16)f2bf(acc[r]); }
        WG_SYNC();
    }
}
PH_FN void rwc_stage4(const Ctx C, int bc, int h) {
    RWC_PTRS
    const size_t row0 = (size_t)bc * 64; CLB A2T = (CLB)XB0; CLB WT = (CLB)(XB0 + 64 * 72);
    {   const int kind = C.wave >> 1, mt = C.wave & 1;
        f32x16 c0 = zero16(), c1 = zero16();
        if (kind == 0) { mma_nt<64>(c0, BHT, 72, 32 * mt, A2T, 72, 0, C.lane); mma_nt<64>(c1, BHT, 72, 32 * mt, A2T, 72, 32, C.lane); }
        else if (kind == 1) { mma_nt<64>(c0, BHT, 72, 32 * mt, WT, 72, 0, C.lane); mma_nt<64>(c1, BHT, 72, 32 * mt, WT, 72, 32, C.lane); mma_nt<64>(c0, KHT, 72, 32 * mt, VT, 72, 0, C.lane); mma_nt<64>(c1, KHT, 72, 32 * mt, VT, 72, 32, C.lane); }
        else if (kind == 2) { mma_nt<64>(c0, MRB, 72, 32 * mt, A2T, 72, 0, C.lane); mma_nt<64>(c1, MRB, 72, 32 * mt, A2T, 72, 32, C.lane); }
        else { mma_nt<64>(c0, MRB, 72, 32 * mt, WT, 72, 0, C.lane); mma_nt<64>(c1, MRB, 72, 32 * mt, WT, 72, 32, C.lane); mma_nt<64>(c0, MRK, 72, 32 * mt, VT, 72, 0, C.lane); mma_nt<64>(c1, MRK, 72, 32 * mt, VT, 72, 32, C.lane); }
#pragma unroll
        for (int r = 0; r < 16; ++r) { const int m = 32 * mt + crow(r, hi); const size_t go = (row0 + m) * 512 + h * 64;
            if (kind == 0) { const float d = __expf(lgl[m]); RWB[go + n] = (bf16)f2bf(c0[r] + ((n == m) ? d : 0.f)); RWB[go + 32 + n] = (bf16)f2bf(c1[r] + ((32 + n == m) ? d : 0.f)); }
            else if (kind == 1) { RWW[go + n] = c0[r]; RWW[go + 32 + n] = c1[r]; }
            else if (kind == 2) { RWKK[go + n] = (bf16)f2bf(c0[r] + bf2f(RT[m * 72 + n]) * __expf(rho[n])); RWKK[go + 32 + n] = (bf16)f2bf(c1[r] + bf2f(RT[m * 72 + 32 + n]) * __expf(rho[32 + n])); }
            else { RWY[go + n] = (bf16)f2bf(c0[r]); RWY[go + 32 + n] = (bf16)f2bf(c1[r]); } }
    }
}
__device__ __forceinline__ void ph_rw_chunk(const Ctx& C, int bc) {
#pragma unroll 1
    for (int h = 0; h < 8; ++h) { for (int r0 = 0; r0 < RWC_REP0; ++r0) rwc_stage0(C, bc, h); rwc_stage12(C); rwc_solve(C); rwc_stage4(C, bc, h); }
    WG_SYNC();
}
PH_FN void rw_scan_producer(const Ctx C, int chain) {
    const float* RWW = (const float*)(unsigned char*)(C.ws + WS_RWW); const bf16* RWKK = (const bf16*)(unsigned char*)(C.ws + WS_RWKK); const bf16* RWB = (const bf16*)(unsigned char*)(C.ws + WS_RWB); bf16* RWY = (bf16*)(unsigned char*)(C.ws + WS_RWY);
    const int b = chain >> 3, h = chain & 7; const size_t rowb = (size_t)b * SEQ;
    constexpr int BUFB = 45056, O_RQ = 0, O_PT = 9216, O_QT = 18432, O_Y0 = 35840;
    LAS unsigned char* L = C.lds;
        const int p = C.tid - 256, t = p >> 2, q4 = (p & 3) * 16;
        u32x4 Arq0, Arq1, Apt0, Apt1, Ay00, Ay01, Brq0, Brq1, Bpt0, Bpt1, By00, By01; f32x4 Aq0, Aq1, Aq2, Aq3, Bq0, Bq1, Bq2, Bq3;
#define SC_LOAD(S, c_) do { const size_t g_ = (rowb + (size_t)(c_) * 64 + t) * 512 + h * 64 + q4; \
            S##rq0 = *(const u32x4*)(RWKK + g_); S##rq1 = *(const u32x4*)(RWKK + g_ + 8); S##pt0 = *(const u32x4*)(RWB + g_); S##pt1 = *(const u32x4*)(RWB + g_ + 8); S##y00 = *(const u32x4*)(RWY + g_); S##y01 = *(const u32x4*)(RWY + g_ + 8); \
            S##q0 = *(const f32x4*)(RWW + g_); S##q1 = *(const f32x4*)(RWW + g_ + 4); S##q2 = *(const f32x4*)(RWW + g_ + 8); S##q3 = *(const f32x4*)(RWW + g_ + 12); } while (0)
#define SC_WRITE(S, Lb) do { \
            *(LAS u32x4*)((LB)((Lb) + O_RQ) + t * 72 + q4) = S##rq0; *(LAS u32x4*)((LB)((Lb) + O_RQ) + t * 72 + q4 + 8) = S##rq1; \
            *(LAS u32x4*)((LB)((Lb) + O_PT) + t * 72 + q4) = S##pt0; *(LAS u32x4*)((LB)((Lb) + O_PT) + t * 72 + q4 + 8) = S##pt1; \
            *(LAS u32x4*)((LB)((Lb) + O_Y0) + t * 72 + q4) = S##y00; *(LAS u32x4*)((LB)((Lb) + O_Y0) + t * 72 + q4 + 8) = S##y01; \
            { LF d_ = (LF)((Lb) + O_QT) + t * 68 + q4; *(LAS f32x4*)d_ = S##q0; *(LAS f32x4*)(d_ + 4) = S##q1; *(LAS f32x4*)(d_ + 8) = S##q2; *(LAS f32x4*)(d_ + 12) = S##q3; } } while (0)
        SC_LOAD(A, 0); SC_LOAD(B, 1);
        for (int c = 0; c < NCH; c += 2) {
            SC_WRITE(A, L); if (c + 2 < NCH) SC_LOAD(A, c + 2); RW_BAR();
            SC_WRITE(B, L + BUFB); if (c + 3 < NCH) SC_LOAD(B, c + 3); RW_BAR();
        }
        RW_BAR();
#undef SC_LOAD
#undef SC_WRITE
}
PH_FN void rw_scan_consumer(const Ctx C, int chain) {
    const float* RWW = (const float*)(unsigned char*)(C.ws + WS_RWW); const bf16* RWKK = (const bf16*)(unsigned char*)(C.ws + WS_RWKK); const bf16* RWB = (const bf16*)(unsigned char*)(C.ws + WS_RWB); bf16* RWY = (bf16*)(unsigned char*)(C.ws + WS_RWY);
    const int b = chain >> 3, h = chain & 7; const size_t rowb = (size_t)b * SEQ;
    constexpr int BUFB = 45056, O_RQ = 0, O_PT = 9216, O_QT = 18432, O_Y0 = 35840;
    LAS unsigned char* L = C.lds;
        const int n = C.lane & 31, hi = C.lane >> 5, vh = C.wave & 1;
        f32x16 st0 = zero16(), st1 = zero16();
        for (int c = 0; c < NCH; ++c) {
            RW_BAR();
            if (C.wave < 2) {
                const LAS unsigned char* Lb = L + (c & 1) * BUFB;
                CLB RQ = (CLB)(Lb + O_RQ); CLB PT = (CLB)(Lb + O_PT); CLF QT = (CLF)(Lb + O_QT); CLB Y0 = (CLB)(Lb + O_Y0);
                pg8::bf16x8 sb[4];
                { u32x4 w;
                  w.x = pk2(st0[0], st0[1]); w.y = pk2(st0[2], st0[3]); w.z = pk2(st0[4], st0[5]); w.w = pk2(st0[6], st0[7]); sb[0] = __builtin_bit_cast(pg8::bf16x8, w);
                  w.x = pk2(st0[8], st0[9]); w.y = pk2(st0[10], st0[11]); w.z = pk2(st0[12], st0[13]); w.w = pk2(st0[14], st0[15]); sb[1] = __builtin_bit_cast(pg8::bf16x8, w);
                  w.x = pk2(st1[0], st1[1]); w.y = pk2(st1[2], st1[3]); w.z = pk2(st1[4], st1[5]); w.w = pk2(st1[6], st1[7]); sb[2] = __builtin_bit_cast(pg8::bf16x8, w);
                  w.x = pk2(st1[8], st1[9]); w.y = pk2(st1[10], st1[11]); w.z = pk2(st1[12], st1[13]); w.w = pk2(st1[14], st1[15]); sb[3] = __builtin_bit_cast(pg8::bf16x8, w); }
#define SC_AFRAG(X_, row_, s_) ({ const u32x2 lo_ = *(const LAS u32x2*)((X_) + (row_) * 72 + 16 * (s_) + 4 * hi), hi_ = *(const LAS u32x2*)((X_) + (row_) * 72 + 16 * (s_) + 8 + 4 * hi); \
                    u32x4 w_; w_.x = lo_.x; w_.y = lo_.y; w_.z = hi_.x; w_.w = hi_.y; __builtin_bit_cast(pg8::bf16x8, w_); })
#pragma unroll
                for (int tt = 0; tt < 2; ++tt) { f32x16 y;
#pragma unroll
                    for (int r = 0; r < 16; ++r) y[r] = bf2f(Y0[(32 * tt + crow(r, hi)) * 72 + 32 * vh + n]);
#pragma unroll
                    for (int s = 0; s < 4; ++s) y = __builtin_amdgcn_mfma_f32_32x32x16_bf16(SC_AFRAG(RQ, 32 * tt + n, s), sb[s], y, 0, 0, 0);
                    bf16* yo = RWY + (rowb + (size_t)c * 64 + 32 * tt) * 512 + h * 64 + 32 * vh + n;
#pragma unroll
                    for (int r = 0; r < 16; ++r) yo[(size_t)crow(r, hi) * 512] = (bf16)f2bf(y[r]); }
                f32x16 n0, n1;
#pragma unroll
                for (int r = 0; r < 16; ++r) { n0[r] = QT[crow(r, hi) * 68 + 32 * vh + n]; n1[r] = QT[(32 + crow(r, hi)) * 68 + 32 * vh + n]; }
#pragma unroll
                for (int s = 0; s < 4; ++s) { n0 = __builtin_amdgcn_mfma_f32_32x32x16_bf16(SC_AFRAG(PT, n, s), sb[s], n0, 0, 0, 0); n1 = __builtin_amdgcn_mfma_f32_32x32x16_bf16(SC_AFRAG(PT, 32 + n, s), sb[s], n1, 0, 0, 0); }
                st0 = n0; st1 = n1;
#undef SC_AFRAG
            }
        }
        RW_BAR();
}
__device__ __forceinline__ void rw_scan_unit(const Ctx& C, int chain) { if (C.wave >= 4) rw_scan_producer(C, chain); else rw_scan_consumer(C, chain); }
#ifndef REP_ATTN
#define REP_ATTN 1
#endif
#ifndef REP_W
#define REP_W 1
#endif
#ifndef REP_RWC
#define REP_RWC 1
#endif
#ifndef REP_MA
#define REP_MA 1
#endif
#ifndef REP_GLAA
#define REP_GLAA 1
#endif
#ifndef REP_SSDA
#define REP_SSDA 1
#endif
#ifndef REP_RWP
#define REP_RWP 1
#endif
#ifndef REP_GLAC
#define REP_GLAC 1
#endif
#ifndef REP_SSDC
#define REP_SSDC 1
#endif
#ifndef REP_RWO
#define REP_RWO 1
#endif
#ifndef REP_MAFULL
#define REP_MAFULL 1
#endif
#ifndef REP_SCANS
#define REP_SCANS 1
#endif
#ifndef REP_MC
#define REP_MC 1
#endif
#ifndef REP_GEMM
#define REP_GEMM 1
#endif
constexpr int NPH = 12, G_FINAL = 1 + NL * NPH, G_END = G_FINAL + 1;
template <int GRP>
__global__ void __launch_bounds__(NTHR, 2) hybrid_fwd(Args args) {
    constexpr bool ALL = (GRP < 0);
    constexpr bool EN_G1 = ALL || GRP == 0, EN_G2 = EN_G1, EN_G3 = EN_G1, EN_G7 = EN_G1, EN_G8 = EN_G1, EN_G9 = EN_G1;
    constexpr bool EN_PRO = ALL || GRP == 1, EN_W = EN_PRO, EN_FIN = EN_PRO, EN_MA1 = EN_PRO, EN_MA2 = EN_PRO, EN_MA3 = EN_PRO, EN_MA4 = EN_PRO;
    constexpr bool EN_MB1 = ALL || GRP == 2, EN_MB2 = EN_MB1;
    constexpr bool EN_MC1 = ALL || GRP == 3, EN_MC2 = EN_MC1, EN_MC3 = EN_MC1;
    extern __shared__ __attribute__((aligned(16))) unsigned char lds[];
    Ctx C; C.lds = (LAS unsigned char*)lds; C.ws = (GAS unsigned char*)args.ws; C.h = (GAS float*)args.out; C.tid = threadIdx.x; C.lane = C.tid & 63; C.wave = __builtin_amdgcn_readfirstlane(C.tid >> 6); C.bid = blockIdx.x; C.G = gridDim.x;
    LAS unsigned char* ldsl = (LAS unsigned char*)lds;
    const ArgsP ap = (ArgsP)__builtin_amdgcn_kernarg_segment_ptr();
    for (int u = C.tid; u < (LDS_BYTES - LDSCTL_OFF) / 4; u += NTHR) ((LAS unsigned*)(ldsl + LDSCTL_OFF))[u] = 0u;
    __syncthreads();
    volatile LAS unsigned* MISC = (volatile LAS unsigned*)(ldsl + MISC_OFF);
    gu32* ctl = (gu32*)(args.ws + WS_CTL);
    const int g_lo = args.g_lo, g_hi = args.g_hi;
    XcdBarrier bar; bar.bar = (unsigned*)(ctl + CW_BAR); bar.x = 0; bar.st = nullptr;
    if (g_hi - g_lo > 1) bar = xcd_barrier_post((unsigned*)(ctl + CW_BAR), MISC + 8);
#define IN(g) (g_lo <= (g) && (g) < g_hi)
#define SEAM(g) do { if (IN(g) && IN((g) + 1)) xcd_barrier(bar); } while (0)
    bf16* HB = (bf16*)(args.ws + WS_HB); float* SSQ = (float*)(args.ws + WS_SSQ);

    if (IN(0)) { if (EN_PRO) ph_prologue(fresh(C), ap); if (EN_W) ph_weights(fresh(C), ap, 0); }
    SEAM(0);
#pragma unroll 1
    for (int l = 0; l < NL; ++l) {
        const int gb = 1 + NPH * l;
        if (EN_W && IN(gb + 0) && l > 0) { for (int rep = 0; rep < REP_W; ++rep) ph_weights(fresh(C), ap, l); }
        if (l > 0) SEAM(gb + 0);
#pragma unroll 1
        for (int f = 0; f < 2; ++f) {
            const int gu = gb + (f ? 10 : 1);
            if (EN_G1 && IN(gu)) {
                pg8::Gemm g{HB, (const bf16*)(args.ws + (f ? WS_WGU2 : WS_WGU1)), M, 2 * FF, D, D}; pg8::StaticOrder S; S.init(M, 2 * FF, C.G, C.bid);
                pg8::EpiSwiglu E{(bf16*)(args.ws + WS_ACT), FF, SSQ, M};
                pg8::gemm_phase<pg8::EpiSwiglu, pg8::StaticOrder, true, true>(ldsl, g, S, E);
            }
            SEAM(gu);
            if (EN_G2 && IN(gu + 1)) {
                pg8::Gemm g{(const bf16*)(args.ws + WS_ACT), (const bf16*)(args.ws + (f ? WS_WD2 : WS_WD1)), M, D, FF, FF}; pg8::StaticOrder S; S.init(M, D, C.G, C.bid);
                pg8::EpiResid E{HB, SSQ, M, 0.5f};
                pg8::gemm_phase<pg8::EpiResid, pg8::StaticOrder, false, true>(ldsl, g, S, E);
            }
            SEAM(gu + 1);
            if (f == 0) {
                if (EN_G3 && IN(gb + 3)) {
                    pg8::Gemm g{HB, (const bf16*)(args.ws + WS_WIN), M, NPM, D, D}; pg8::StaticOrder S; S.init(M, NPM, C.G, C.bid);
                    pg8::EpiScaleBf16 E{(bf16*)(args.ws + WS_P), NPM, SSQ, M};
                    pg8::gemm_phase<pg8::EpiScaleBf16, pg8::StaticOrder, true, true>(ldsl, g, S, E);
                }
                SEAM(gb + 3);
                if (IN(gb + 4)) { if (EN_MA1) ph_da_prep(fresh(C)); for (int rf = 0; rf < REP_MAFULL; ++rf) { for (int rep = 0; rep < REP_MA; ++rep) { for (int r2 = 0; r2 < REP_GLAA; ++r2) if (EN_MA2) ph_gla_a(fresh(C), ap, l); for (int r2 = 0; r2 < REP_SSDA; ++r2) if (EN_MA3) ph_ssd_a(fresh(C), ap, l); for (int r2 = 0; r2 < REP_RWP; ++r2) if (EN_MA4) ph_rw_prep(fresh(C), ap, l); } if (EN_MA4 && RW_CHUNKED) ph_rw_chunk(fresh(C), C.bid); } }
                SEAM(gb + 4);
                if (IN(gb + 5)) {
#if RW_CHUNKED
#define MB_SCANS() do { if (EN_MB2) { if (C.bid < 16) rw_scan_unit(fresh(C), C.bid); else { for (int p = C.bid - 16; p < 192; p += C.G - 16) { if (p < 64) gla_scan_part(fresh(C), p); else ssd_scan_part(fresh(C), p - 64); } } } } while (0)
                    MB_SCANS();
                    for (int rs = 1; rs < REP_SCANS; ++rs) {
                        xcd_barrier(bar); if (EN_MA2) ph_gla_a(fresh(C), ap, l); if (EN_MA3) ph_ssd_a(fresh(C), ap, l); if (EN_MA4) { ph_rw_prep(fresh(C), ap, l); ph_rw_chunk(fresh(C), C.bid); } xcd_barrier(bar); MB_SCANS(); }
                    if (C.bid >= 16) { const int a = C.bid - 16; for (int rep = 0; rep < REP_ATTN; ++rep) if (EN_MB1) ph_da_attn(fresh(C), args, l, a & 7, a >> 3); }
#else
                    if (C.bid < 64) { if (EN_MB2) { const int xcd = C.bid & 7, slot = C.bid >> 3; for (int rep = 0; rep < REP_RWC; ++rep) rw_unit(fresh(C), xcd * 2 + (slot >> 2), slot & 3); } }
                    else { const int a = C.bid - 64;
                        if (EN_MB2) { for (int p = a; p < 192; p += 192) { if (p < 64) gla_scan_part(fresh(C), p); else ssd_scan_part(fresh(C), p - 64); } }
                        for (int rep = 0; rep < REP_ATTN; ++rep) if (EN_MB1) ph_da_attn(fresh(C), args, l, a & 7, a >> 3); }
#endif
                }
                SEAM(gb + 5);
                if (IN(gb + 6)) { for (int rep = 0; rep < REP_MC; ++rep) { for (int r2 = 0; r2 < REP_GLAC; ++r2) if (EN_MC1) ph_gla_c(fresh(C), ap, l); for (int r2 = 0; r2 < REP_SSDC; ++r2) if (EN_MC2) ph_ssd_c(fresh(C), ap, l); for (int r2 = 0; r2 < REP_RWO; ++r2) if (EN_MC3) ph_rw_out(fresh(C), ap, l); } }
                SEAM(gb + 6);
                if (EN_G7 && IN(gb + 7)) {
                    pg8::Gemm g{HB, (const bf16*)(args.ws + WS_WIN) + (size_t)NPM * D, M, 4096, D, D}; pg8::StaticOrder S; S.init(M, 4096, C.G, C.bid);
                    pg8::EpiScaleBf16 E{(bf16*)(args.ws + WS_PG), 4096, SSQ, M};
                    pg8::gemm_phase<pg8::EpiScaleBf16, pg8::StaticOrder, true, true>(ldsl, g, S, E);
                }
                SEAM(gb + 7);
                if (EN_G8 && IN(gb + 8)) {
                    pg8::Gemm g{(const bf16*)(args.ws + WS_YS), (const bf16*)(args.ws + WS_WB), M, D, 2048, 2048}; pg8::StaticOrder S; S.init(M, D, C.G, C.bid);
                    pg8::EpiGateHorner E{(bf16*)(args.ws + WS_MERGED), (const bf16*)(args.ws + WS_PG), args.in[33] + (size_t)l * 4096};
                    pg8::gemm_phase<pg8::EpiGateHorner, pg8::StaticOrder, true, true>(ldsl, g, S, E);
                }
                SEAM(gb + 8);
                if (EN_G9 && IN(gb + 9)) {
                    pg8::Gemm g{(const bf16*)(args.ws + WS_MERGED), (const bf16*)(args.ws + WS_WO), M, D, D, D}; pg8::StaticOrder S; S.init(M, D, C.G, C.bid);
                    pg8::EpiResid E{HB, SSQ, M, 1.0f};
                    pg8::gemm_phase<pg8::EpiResid, pg8::StaticOrder, false, true>(ldsl, g, S, E);
                }
                SEAM(gb + 9);
            }
        }
    }
    if (EN_FIN && IN(G_FINAL)) ph_final(fresh(C), ap);
#undef IN
#undef SEAM
}

#ifndef ONE_LAUNCH
#define ONE_LAUNCH 1
#endif
extern "C" void kernel_launch(void* const* d_in, const int* in_sizes, int n_in, void* d_out, int out_size, void* d_ws, size_t ws_size, hipStream_t stream) {
    static int grid = 0;
    if (grid == 0) {
        if (n_in != 40 || in_sizes[0] != M * D || out_size != M * D || ws_size < WS_END) { fprintf(stderr, "kernel_launch: unexpected shapes (n_in %d, in0 %d, out %d, ws %zu < %zu); nothing launched\n", n_in, n_in > 0 ? in_sizes[0] : -1, out_size, ws_size, (size_t)WS_END); grid = -1; return; }
        int dev = 0, cus = 0, per_cu = 0;
        if (hipGetDevice(&dev) != hipSuccess || hipDeviceGetAttribute(&cus, hipDeviceAttributeMultiprocessorCount, dev) != hipSuccess) { grid = -1; return; }
#if ONE_LAUNCH
        if (hipFuncSetAttribute((const void*)hybrid_fwd<-1>, hipFuncAttributeMaxDynamicSharedMemorySize, LDS_BYTES) != hipSuccess) { fprintf(stderr, "kernel_launch: hipFuncSetAttribute failed\n"); grid = -1; return; }
#else
        if (hipFuncSetAttribute((const void*)hybrid_fwd<0>, hipFuncAttributeMaxDynamicSharedMemorySize, LDS_BYTES) != hipSuccess || hipFuncSetAttribute((const void*)hybrid_fwd<1>, hipFuncAttributeMaxDynamicSharedMemorySize, LDS_BYTES) != hipSuccess ||
            hipFuncSetAttribute((const void*)hybrid_fwd<2>, hipFuncAttributeMaxDynamicSharedMemorySize, LDS_BYTES) != hipSuccess || hipFuncSetAttribute((const void*)hybrid_fwd<3>, hipFuncAttributeMaxDynamicSharedMemorySize, LDS_BYTES) != hipSuccess) { fprintf(stderr, "kernel_launch: hipFuncSetAttribute failed\n"); grid = -1; return; }
#endif
        if (hipOccupancyMaxActiveBlocksPerMultiprocessor(&per_cu, (const void*)hybrid_fwd<(ONE_LAUNCH ? -1 : 0)>, NTHR, LDS_BYTES) != hipSuccess || per_cu < 1) fprintf(stderr, "kernel_launch: occupancy query reports %d workgroups per CU\n", per_cu);
        (void)hipGetLastError();
        grid = cus;
        if (grid != 256) { fprintf(stderr, "kernel_launch: %d CUs; this kernel is laid out for 256 workgroups; nothing launched\n", grid); grid = -1; return; }
    }
    if (grid < 0) return;
    if (hipMemsetAsync((char*)d_ws + WS_CTL, 0, CTL_ZERO_BYTES, stream) != hipSuccess) return;
    Args a{};
    for (int i = 0; i < 40; ++i) a.in[i] = (const float*)d_in[i];
    a.out = (float*)d_out; a.ws = (unsigned char*)d_ws;
    for (int j = 0; j < 32; ++j) a.inv_freq[j] = (float)pow(10000.0, -(double)j / 32.0);
#if ONE_LAUNCH
    a.g_lo = 0; a.g_hi = G_END;
    hipLaunchKernelGGL(hybrid_fwd<-1>, dim3(grid), dim3(NTHR), LDS_BYTES, stream, a);
#else
    for (int g = 0; g < G_END; ++g) {
        a.g_lo = g; a.g_hi = g + 1;
        int grp = 1;
        if (g >= 1 && g < G_FINAL) { const int k = (g - 1) % NPH; grp = (k == 0 || k == 4) ? 1 : (k == 5) ? 2 : (k == 6) ? 3 : 0; }
        if (grp == 0) hipLaunchKernelGGL(hybrid_fwd<0>, dim3(grid), dim3(NTHR), LDS_BYTES, stream, a);
        else if (grp == 1) hipLaunchKernelGGL(hybrid_fwd<1>, dim3(grid), dim3(NTHR), LDS_BYTES, stream, a);
        else if (grp == 2) hipLaunchKernelGGL(hybrid_fwd<2>, dim3(grid), dim3(NTHR), LDS_BYTES, stream, a);
        else hipLaunchKernelGGL(hybrid_fwd<3>, dim3(grid), dim3(NTHR), LDS_BYTES, stream, a);
    }
#endif
}
```

```cpp
#include <hip/hip_runtime.h>
#include <cstdio>
#include <cstdint>
#include <cmath>

namespace pg8 {
#define PG8_LAS __attribute__((address_space(3)))
typedef unsigned short bf16_t;
typedef short bf16x8 __attribute__((ext_vector_type(8)));
typedef float f32x4 __attribute__((ext_vector_type(4)));
typedef unsigned u32x4 __attribute__((ext_vector_type(4)));
constexpr int BM = 256, BK = 64, HALF = 128, HTB = HALF * BK * 2  , STAGE_BYTES = 8 * HTB, NXCD = 8, WGM = 8;

__host__ __device__ __forceinline__ int lds_byte(int r, int c) { const int st = (r >> 4) * 2 + (c >> 5), rr = r & 15, cc = c & 31, ob = rr * 64 + cc * 2; return st * 1024 + (ob ^ (((ob >> 9) & 1) << 5)); }
__host__ __device__ __forceinline__ void stage_rc(int b, int& R, int& C) { const int st = b / 1024, sb = b % 1024, swz = sb ^ (((sb >> 9) & 1) << 5); R = (st >> 1) * 16 + swz / 64; C = (st & 1) * 32 + (swz % 64) / 2; }
__host__ __device__ __forceinline__ int perm32(int rho) { const int n = rho >> 4, i = rho & 15; return 8 * (i >> 2) + 4 * n + (i & 3); }

struct Unit { int pm, pn, z; };
struct Gemm { const bf16_t* A; const bf16_t* Bt; int M, N, K, lda; };

struct StaticOrder {
    int nM, nN, nwg, G, c;
    __host__ __device__ void init(int M, int N, int G_, int c_) { nM = M / BM; nN = N / BM; nwg = nM * nN; G = G_; c = c_; }
    __host__ __device__ bool next(int i, Unit& u) const {
        const long L = (long)i * G + c; if (L >= nwg) return false;
        int wgid = (int)L; { const int q = nwg / NXCD, r = nwg % NXCD, xcd = wgid % NXCD, off = wgid / NXCD; wgid = (xcd < r ? xcd * (q + 1) : r * (q + 1) + (xcd - r) * q) + off; }
        const int nig = WGM * nN, gid = wgid / nig, fm = gid * WGM, gsz = (nM - fm) < WGM ? (nM - fm) : WGM;
        u.pm = fm + ((wgid % nig) % gsz); u.pn = (wgid % nig) / gsz; u.z = 0; return true;
    }
    __device__ __forceinline__ void a_ready(const Unit&) const {}
    __device__ __forceinline__ void done(const Unit&) const {}
    __device__ __forceinline__ size_t a_off(const Unit&) const { return 0; }
    __device__ __forceinline__ int b_tile(const Unit& u) const { return u.pn; }
};
__device__ __forceinline__ unsigned cvt_pk_bf16(float lo, float hi) { unsigned r; asm volatile("v_cvt_pk_bf16_f32 %0, %1, %2" : "=v"(r) : "v"(lo), "v"(hi)); return r; }
typedef float f32x2_pg __attribute__((ext_vector_type(2))); typedef __bf16 bf16x2_pg __attribute__((ext_vector_type(2)));
__device__ __forceinline__ unsigned cvt_pk_bf16_c(float lo, float hi) { const f32x2_pg v = {lo, hi}; const bf16x2_pg b = __builtin_convertvector(v, bf16x2_pg); return __builtin_bit_cast(unsigned, b); }
__device__ __forceinline__ float bf_lo(unsigned w) { return __uint_as_float(w << 16); }
__device__ __forceinline__ float bf_hi(unsigned w) { return __uint_as_float(w & 0xffff0000u); }
__device__ __forceinline__ float fast_sigmoid(float x) { return __builtin_amdgcn_rcpf(1.0f + __builtin_amdgcn_exp2f(-1.4426950408889634f * x)); }

__device__ __forceinline__ float row_rstd(const float* ssq, int row, int M_) {
    const f32x4 p = *(const f32x4*)(ssq + (size_t)row * 4); const float s = (p[0] + p[1]) + (p[2] + p[3]); (void)M_;
    return __builtin_amdgcn_rsqf(s * (1.0f / 1024.0f) + 1e-6f);
}
__device__ __forceinline__ void row_rstd8(const float* ssq, int row0, float (&rs)[8]) {
    f32x4 p[8];
#pragma unroll
    for (int j = 0; j < 8; ++j) p[j] = *(const f32x4*)(ssq + (size_t)(row0 + (j >> 2) * HALF + (j & 3) * 16) * 4);
#pragma unroll
    for (int j = 0; j < 8; ++j) rs[j] = __builtin_amdgcn_rsqf(((p[j][0] + p[j][1]) + (p[j][2] + p[j][3])) * (1.0f / 1024.0f) + 1e-6f);
    asm volatile("" ::: "memory");
}
constexpr int RS_OFF = 131072 + 1024, RS_SLOT = 4096;
__device__ __forceinline__ void row_rstd8_lds(const PG8_LAS float* rsl, int wr, int fr, float (&rs)[8]) {
    f32x4 p[8];
#pragma unroll
    for (int j = 0; j < 8; ++j) p[j] = *(const PG8_LAS f32x4*)(rsl + ((j >> 2) * HALF + wr * 64 + (j & 3) * 16 + fr) * 4);
#pragma unroll
    for (int j = 0; j < 8; ++j) rs[j] = __builtin_amdgcn_rsqf(((p[j][0] + p[j][1]) + (p[j][2] + p[j][3])) * (1.0f / 1024.0f) + 1e-6f);
}
struct EpiScaleBf16 {
    static constexpr bool PERM = true, AFTER_DRAIN = false, RSTD_LDS = true; static constexpr int SEG_TILES = 0; struct Pre {};
    bf16_t* O; int ldc; const float* ssq; int M_;
    __device__ __forceinline__ void operator()(const f32x4 (&acc)[2][2][4][2], const Unit& u, int wr, int wc, int fr, int fq, const PG8_LAS float* rsl) const {
        const int row0 = u.pm * BM + wr * 64 + fr; const int col0 = u.pn * BM + wc * 32 + 8 * fq; float rs8[8]; row_rstd8_lds(rsl, wr, fr, rs8);
#pragma unroll
        for (int ai = 0; ai < 2; ++ai)
#pragma unroll
            for (int m = 0; m < 4; ++m) { const int row = row0 + ai * HALF + m * 16; const float rs = rs8[ai * 4 + m]; bf16_t* rowp = O + (size_t)row * ldc + col0;
#pragma unroll
                for (int bj = 0; bj < 2; ++bj) { const f32x4 v0 = acc[ai][bj][m][0] * rs, v1 = acc[ai][bj][m][1] * rs;
                    u32x4 w; w.x = cvt_pk_bf16(v0[0], v0[1]); w.y = cvt_pk_bf16(v0[2], v0[3]); w.z = cvt_pk_bf16(v1[0], v1[1]); w.w = cvt_pk_bf16(v1[2], v1[3]);
                    *(u32x4*)(rowp + bj * HALF) = w; } }
    }
};
struct EpiMixRope {
    static constexpr bool PERM = true, AFTER_DRAIN = false, RSTD_LDS = true; static constexpr int SEG_TILES = 0; struct Pre {};
    bf16_t* O; int ldc; const float* ssq; int M_; const float* cosT; const float* sinT;
    __device__ __forceinline__ void operator()(const f32x4 (&acc)[2][2][4][2], const Unit& u, int wr, int wc, int fr, int fq, const PG8_LAS float* rsl) const {
        const int row0 = u.pm * BM + wr * 64 + fr; float rs8[8]; row_rstd8_lds(rsl, wr, fr, rs8);
        if (u.pn < 4) {
            const int colq = (4 * u.pn + wc) * 64 + 8 * fq; const float sc = (u.pn < 2) ? 0.125f * 1.4426950408889634f : 1.0f;
#pragma unroll
            for (int ai = 0; ai < 2; ++ai)
#pragma unroll
                for (int m = 0; m < 4; ++m) { const int row = row0 + ai * HALF + m * 16; const float rs = rs8[ai * 4 + m] * sc; const int t = row & 8191;
                    const float* cp = cosT + t * 32 + 8 * fq; const float* sp = sinT + t * 32 + 8 * fq;
                    const f32x4 c0 = *(const f32x4*)cp, c1 = *(const f32x4*)(cp + 4), s0 = *(const f32x4*)sp, s1 = *(const f32x4*)(sp + 4);
                    const f32x4 xa0 = acc[ai][0][m][0] * rs, xa1 = acc[ai][0][m][1] * rs, xb0 = acc[ai][1][m][0] * rs, xb1 = acc[ai][1][m][1] * rs;
                    const f32x4 p0 = xa0 * c0 - xb0 * s0, p1 = xa1 * c1 - xb1 * s1, q0 = xb0 * c0 + xa0 * s0, q1 = xb1 * c1 + xa1 * s1;
                    bf16_t* rowp = O + (size_t)row * ldc + colq;
                    u32x4 w; w.x = cvt_pk_bf16(p0[0], p0[1]); w.y = cvt_pk_bf16(p0[2], p0[3]); w.z = cvt_pk_bf16(p1[0], p1[1]); w.w = cvt_pk_bf16(p1[2], p1[3]); *(u32x4*)rowp = w;
                    w.x = cvt_pk_bf16(q0[0], q0[1]); w.y = cvt_pk_bf16(q0[2], q0[3]); w.z = cvt_pk_bf16(q1[0], q1[1]); w.w = cvt_pk_bf16(q1[2], q1[3]); *(u32x4*)(rowp + 32) = w; }
        } else {
            const int col0 = u.pn * BM + wc * 32 + 8 * fq;
#pragma unroll
            for (int ai = 0; ai < 2; ++ai)
#pragma unroll
                for (int m = 0; m < 4; ++m) { const int row = row0 + ai * HALF + m * 16; const float rs = rs8[ai * 4 + m]; bf16_t* rowp = O + (size_t)row * ldc + col0;
#pragma unroll
                    for (int bj = 0; bj < 2; ++bj) { const f32x4 v0 = acc[ai][bj][m][0] * rs, v1 = acc[ai][bj][m][1] * rs;
                        u32x4 w; w.x = cvt_pk_bf16(v0[0], v0[1]); w.y = cvt_pk_bf16(v0[2], v0[3]); w.z = cvt_pk_bf16(v1[0], v1[1]); w.w = cvt_pk_bf16(v1[2], v1[3]);
                        *(u32x4*)(rowp + bj * HALF) = w; } }
        }
    }
};
struct EpiSwiglu {
    static constexpr bool PERM = true, AFTER_DRAIN = false, RSTD_LDS = true; static constexpr int SEG_TILES = 0; struct Pre {};
    bf16_t* O; int ldc; const float* ssq; int M_;
    __device__ __forceinline__ void operator()(const f32x4 (&acc)[2][2][4][2], const Unit& u, int wr, int wc, int fr, int fq, const PG8_LAS float* rsl) const {
        const int row0 = u.pm * BM + wr * 64 + fr; const int col0 = u.pn * HALF + wc * 32 + 8 * fq; float rs8[8]; row_rstd8_lds(rsl, wr, fr, rs8);
#pragma unroll
        for (int ai = 0; ai < 2; ++ai)
#pragma unroll
            for (int m = 0; m < 4; ++m) { const int row = row0 + ai * HALF + m * 16; const float rs = rs8[ai * 4 + m]; bf16_t* rowp = O + (size_t)row * ldc + col0;
                float o[8];
#pragma unroll
                for (int n = 0; n < 2; ++n)
#pragma unroll
                    for (int i = 0; i < 4; ++i) { const float g = acc[ai][0][m][n][i] * rs, up = acc[ai][1][m][n][i] * rs; o[n * 4 + i] = g * fast_sigmoid(g) * up; }
                u32x4 w; w.x = cvt_pk_bf16(o[0], o[1]); w.y = cvt_pk_bf16(o[2], o[3]); w.z = cvt_pk_bf16(o[4], o[5]); w.w = cvt_pk_bf16(o[6], o[7]);
                *(u32x4*)rowp = w; }
    }
};
struct EpiGateRatio {
    static constexpr bool PERM = true, AFTER_DRAIN = false, RSTD_LDS = true; static constexpr int SEG_TILES = 0; struct Pre {};
    bf16_t* O; const float* gb; const float* ssq; int M_;
    __device__ __forceinline__ void operator()(const f32x4 (&acc)[2][2][4][2], const Unit& u, int wr, int wc, int fr, int fq, const PG8_LAS float* rsl) const {
        const int row0 = u.pm * BM + wr * 64 + fr; const int ch0 = u.pn * 64 + wc * 16 + 4 * fq;
        f32x4 b[4];
#pragma unroll
        for (int z = 0; z < 4; ++z) b[z] = *(const f32x4*)(gb + z * 1024 + ch0);
        float rs8[8]; row_rstd8_lds(rsl, wr, fr, rs8);
#pragma unroll
        for (int ai = 0; ai < 2; ++ai)
#pragma unroll
            for (int m = 0; m < 4; ++m) { const int row = row0 + ai * HALF + m * 16; const float rs = rs8[ai * 4 + m]; bf16_t* rowp = O + (size_t)row * 4096 + ch0;
                unsigned w[4][2];
#pragma unroll
                for (int h = 0; h < 2; ++h) { float d[4][2];
#pragma unroll
                    for (int z = 0; z < 4; ++z) {
                        d[z][0] = 1.0f + __builtin_amdgcn_exp2f(-1.4426950408889634f * (acc[ai][z >> 1][m][z & 1][2 * h] * rs + b[z][2 * h]));
                        d[z][1] = 1.0f + __builtin_amdgcn_exp2f(-1.4426950408889634f * (acc[ai][z >> 1][m][z & 1][2 * h + 1] * rs + b[z][2 * h + 1])); }
#pragma unroll
                    for (int z = 0; z < 4; ++z) { const float r0 = __builtin_amdgcn_rcpf(d[z][0]), r1 = __builtin_amdgcn_rcpf(d[z][1]);
                        w[z][h] = z < 3 ? cvt_pk_bf16_c(d[z < 3 ? z + 1 : 3][0] * r0, d[z < 3 ? z + 1 : 3][1] * r1) : cvt_pk_bf16_c(r0, r1); } }
#pragma unroll
                for (int z = 0; z < 4; ++z) { uint2 v; v.x = w[z][0]; v.y = w[z][1]; *(uint2*)(rowp + z * 1024) = v; } }
    }
};
struct EpiGateHorner {
    static constexpr bool PERM = true, AFTER_DRAIN = false, RSTD_LDS = false; static constexpr int SEG_TILES = 8; struct Pre {};
    bf16_t* O; const bf16_t* PG;
    __device__ __forceinline__ void seg(f32x4 (&acc)[2][2][4][2], const Unit& u, int z, int wr, int wc, int fr, int fq) const {
        int row0 = u.pm * BM + wr * 64 + fr; const int col0 = u.pn * BM + wc * 32 + 8 * fq; asm volatile("" : "+v"(row0));
#pragma unroll
        for (int ai = 0; ai < 2; ++ai)
#pragma unroll
            for (int m = 0; m < 4; ++m) { const int row = row0 + ai * HALF + m * 16;
#pragma unroll
                for (int bj = 0; bj < 2; ++bj) { const u32x4 f = *(const u32x4*)(PG + (size_t)row * 4096 + z * 1024 + col0 + bj * HALF);
                    acc[ai][bj][m][0] *= (f32x4){bf_lo(f.x), bf_hi(f.x), bf_lo(f.y), bf_hi(f.y)}; acc[ai][bj][m][1] *= (f32x4){bf_lo(f.z), bf_hi(f.z), bf_lo(f.w), bf_hi(f.w)}; }
                if (m == 3) asm volatile("" ::: "memory"); }
    }
    __device__ __forceinline__ void operator()(const f32x4 (&acc)[2][2][4][2], const Unit& u, int wr, int wc, int fr, int fq) const {
        const int row0 = u.pm * BM + wr * 64 + fr; const int col0 = u.pn * BM + wc * 32 + 8 * fq;
#pragma unroll
        for (int ai = 0; ai < 2; ++ai) { u32x4 f[4][2];
#pragma unroll
            for (int m = 0; m < 4; ++m)
#pragma unroll
                for (int bj = 0; bj < 2; ++bj) f[m][bj] = *(const u32x4*)(PG + (size_t)(row0 + ai * HALF + m * 16) * 4096 + 3 * 1024 + col0 + bj * HALF);
            asm volatile("" ::: "memory");
#pragma unroll
            for (int m = 0; m < 4; ++m) { const int row = row0 + ai * HALF + m * 16;
#pragma unroll
                for (int bj = 0; bj < 2; ++bj) { const u32x4 g = f[m][bj];
                    const f32x4 o0 = acc[ai][bj][m][0] * (f32x4){bf_lo(g.x), bf_hi(g.x), bf_lo(g.y), bf_hi(g.y)}, o1 = acc[ai][bj][m][1] * (f32x4){bf_lo(g.z), bf_hi(g.z), bf_lo(g.w), bf_hi(g.w)};
                    u32x4 w; w.x = cvt_pk_bf16(o0[0], o0[1]); w.y = cvt_pk_bf16(o0[2], o0[3]); w.z = cvt_pk_bf16(o1[0], o1[1]); w.w = cvt_pk_bf16(o1[2], o1[3]);
                    *(u32x4*)(O + (size_t)row * 1024 + col0 + bj * HALF) = w; } }
            asm volatile("" ::: "memory"); }
    }
};
struct EpiResid {
    static constexpr bool PERM = true, AFTER_DRAIN = true, RSTD_LDS = false; static constexpr int SEG_TILES = 0;
    bf16_t* HB; float* ssq; int M_; float s;
    struct Pre { u32x4 hv[2][4][2]; };
    __device__ __forceinline__ void prefetch(Pre& pre, const Unit& u, int wr, int wc, int fr, int fq) const {
        const int row0 = u.pm * BM + wr * 64 + fr; const int col0 = u.pn * BM + wc * 32 + 8 * fq;
#pragma unroll
        for (int ai = 0; ai < 2; ++ai)
#pragma unroll
            for (int m = 0; m < 4; ++m)
#pragma unroll
                for (int bj = 0; bj < 2; ++bj) pre.hv[ai][m][bj] = *(const u32x4*)(HB + (size_t)(row0 + ai * HALF + m * 16) * 1024 + col0 + bj * HALF);
    }
    __device__ __forceinline__ void fused(f32x4 (&acc)[2][2][4][2], const Unit& u, int wr, int wc, int fr, int fq, PG8_LAS unsigned char* lds, int wid, int lane, const Pre& pre) const {
        PG8_LAS float* P = (PG8_LAS float*)lds;
        const int row0 = u.pm * BM + wr * 64 + fr; const int col0 = u.pn * BM + wc * 32 + 8 * fq;
#pragma unroll
        for (int ai = 0; ai < 2; ++ai) {
#pragma unroll
            for (int m = 0; m < 4; ++m) { const int row = row0 + ai * HALF + m * 16; float q = 0.f;
#pragma unroll
                for (int bj = 0; bj < 2; ++bj) { bf16_t* hp = HB + (size_t)row * 1024 + col0 + bj * HALF; const u32x4 hw = pre.hv[ai][m][bj];
                    const f32x4 h0 = (f32x4){bf_lo(hw.x), bf_hi(hw.x), bf_lo(hw.y), bf_hi(hw.y)} + acc[ai][bj][m][0] * s, h1 = (f32x4){bf_lo(hw.z), bf_hi(hw.z), bf_lo(hw.w), bf_hi(hw.w)} + acc[ai][bj][m][1] * s;
                    q += (h0[0] * h0[0] + h0[1] * h0[1]) + (h0[2] * h0[2] + h0[3] * h0[3]) + (h1[0] * h1[0] + h1[1] * h1[1]) + (h1[2] * h1[2] + h1[3] * h1[3]);
                    u32x4 w; w.x = cvt_pk_bf16(h0[0], h0[1]); w.y = cvt_pk_bf16(h0[2], h0[3]); w.z = cvt_pk_bf16(h1[0], h1[1]); w.w = cvt_pk_bf16(h1[2], h1[3]);
                    *(u32x4*)hp = w; }
                q += __shfl_xor(q, 16); q += __shfl_xor(q, 32);
                if (fq == 0) P[(ai * HALF + wr * 64 + m * 16 + fr) * 4 + wc] = q; } }
        asm volatile("s_waitcnt lgkmcnt(0)" ::: "memory"); __builtin_amdgcn_s_barrier(); asm volatile("" ::: "memory");
        const int t = wid * 64 + lane;
        if (t < 256) { const float q = (P[t * 4 + 0] + P[t * 4 + 1]) + (P[t * 4 + 2] + P[t * 4 + 3]); ssq[(size_t)(u.pm * BM + t) * 4 + u.pn] = q; }
        asm volatile("s_waitcnt lgkmcnt(0)" ::: "memory"); __builtin_amdgcn_s_barrier(); asm volatile("" ::: "memory");
    }
};
template <class Epi, class Sched, bool ALIGN_EPI = false, bool SP2 = false>
__device__ __forceinline__ void gemm_phase(PG8_LAS unsigned char* lds, const Gemm g, const Sched& S, const Epi& E) {
    int tid_ = threadIdx.x; asm volatile("" : "+v"(tid_)); const int tid = tid_, wid = __builtin_amdgcn_readfirstlane(tid >> 6), lane = tid & 63, wr = wid >> 2, wc = wid & 3, fr = lane & 15, fq = lane >> 4;
    const int K = g.K, nt = K / BK;
    unsigned voffA[2], voffB[2];
#pragma unroll
    for (int i = 0; i < 2; ++i) { int R, C; stage_rc(tid * 16 + i * 8192, R, C); const int Rb = Epi::PERM ? ((R & ~31) + perm32(R & 31)) : R;
        voffA[i] = (unsigned)(R * g.lda + C) * 2u; voffB[i] = (unsigned)(Rb * K + C) * 2u; }
    const size_t kstep = (size_t)(BK * 2);
    const size_t hstep = (size_t)HALF * K * 2;
    const size_t tstep = 2 * hstep; const size_t hstepA = (size_t)HALF * g.lda * 2, tstepA = 2 * hstepA;
    const unsigned ldsw = (unsigned)wid * 1024u;
    const int aoff = lds_byte(wr * 64 + fr, fq * 8), boff = lds_byte(wc * 32 + fr, fq * 8);
#define PG8_SA(b, h) (((b) * 2 + (h)) * HTB)
#define PG8_SB(b, h) ((4 + (b) * 2 + (h)) * HTB)
#define PG8_STAGE(bufoff, gbase, voff) do { _Pragma("unroll") for (int _i = 0; _i < 2; ++_i) \
        __builtin_amdgcn_global_load_lds((const unsigned*)((const char*)(gbase) + (voff)[_i]), (PG8_LAS unsigned*)(lds + (bufoff) + ldsw + _i * 8192), 16, 0, 0); } while (0)
#define PG8_LDA(dst, b, h) do { _Pragma("unroll") for (int m = 0; m < 4; ++m) _Pragma("unroll") for (int k = 0; k < 2; ++k) dst[m][k] = *(const PG8_LAS bf16x8*)(lds + PG8_SA(b, h) + aoff + m * 2048 + k * 1024); } while (0)
#define PG8_LDB(dst, b, h) do { _Pragma("unroll") for (int n = 0; n < 2; ++n) _Pragma("unroll") for (int k = 0; k < 2; ++k) dst[n][k] = *(const PG8_LAS bf16x8*)(lds + PG8_SB(b, h) + boff + n * 2048 + k * 1024); } while (0)
#define PG8_MMA(ai, bj, At, Bt) do { __builtin_amdgcn_s_setprio(1); _Pragma("unroll") for (int m = 0; m < 4; ++m) _Pragma("unroll") for (int n = 0; n < 2; ++n) _Pragma("unroll") for (int k = 0; k < 2; ++k) \
        acc[ai][bj][m][n] = __builtin_amdgcn_mfma_f32_16x16x32_bf16(Bt[n][k], At[m][k], acc[ai][bj][m][n], 0, 0, 0); __builtin_amdgcn_s_setprio(0); } while (0)
#define PG8_WAIT_V(n) asm volatile("s_waitcnt vmcnt(" #n ")" ::: "memory")
#define PG8_WAIT_L(n) asm volatile("s_waitcnt lgkmcnt(" #n ")" ::: "memory")
#define PG8_BAR __builtin_amdgcn_s_barrier()
#define PG8_SCHED __builtin_amdgcn_sched_barrier(0)
#define PG8_RSTD_DMA(unit, idx) do { if constexpr (Epi::RSTD_LDS) { if (wr == 0) \
        __builtin_amdgcn_global_load_lds((const unsigned*)(E.ssq + ((size_t)(unit).pm * BM + tid) * 4), (PG8_LAS unsigned*)(lds + RS_OFF + ((idx) & 1) * RS_SLOT + wid * 1024), 16, 0, 0); } } while (0)
    Unit cur, nxt; int ui = 0;
    if (!S.next(0, cur)) return;
    f32x4 acc[2][2][4][2];
#pragma unroll
    for (int a = 0; a < 2; ++a)
#pragma unroll
        for (int b = 0; b < 2; ++b)
#pragma unroll
            for (int m = 0; m < 4; ++m)
#pragma unroll
                for (int n = 0; n < 2; ++n) acc[a][b][m][n] = (f32x4){0.f, 0.f, 0.f, 0.f};
    bf16x8 At[4][2], B0[2][2], B1[2][2];
    const char* cA = (const char*)g.A + (size_t)cur.pm * tstepA + S.a_off(cur); const char* cB = (const char*)g.Bt + (size_t)S.b_tile(cur) * tstep;
    S.a_ready(cur);
    PG8_RSTD_DMA(cur, 0);
    if constexpr (SP2) {
        PG8_STAGE(PG8_SB(0, 0), cB, voffB); PG8_STAGE(PG8_SB(0, 1), cB + hstep, voffB); PG8_STAGE(PG8_SA(0, 0), cA, voffA); PG8_STAGE(PG8_SA(0, 1), cA + hstepA, voffA);
        if (wr == 1) PG8_BAR;
        PG8_WAIT_V(2); PG8_BAR;
        PG8_STAGE(PG8_SB(1, 0), cB + kstep, voffB); PG8_STAGE(PG8_SA(1, 0), cA + kstep, voffA); PG8_STAGE(PG8_SB(1, 1), cB + hstep + kstep, voffB);
        PG8_WAIT_V(6); PG8_BAR;
    } else {
        PG8_STAGE(PG8_SB(0, 0), cB, voffB); PG8_STAGE(PG8_SA(0, 0), cA, voffA); PG8_STAGE(PG8_SB(0, 1), cB + hstep, voffB); PG8_STAGE(PG8_SA(0, 1), cA + hstepA, voffA);
        if (wr == 1) PG8_BAR;
        PG8_WAIT_V(4); PG8_BAR;
        PG8_STAGE(PG8_SB(1, 0), cB + kstep, voffB); PG8_STAGE(PG8_SA(1, 0), cA + kstep, voffA); PG8_STAGE(PG8_SB(1, 1), cB + hstep + kstep, voffB);
        PG8_WAIT_V(6); PG8_BAR;
    }
    for (;;) {
        const bool has_next = S.next(ui + 1, nxt);
        const char* nA = has_next ? (const char*)g.A + (size_t)nxt.pm * tstepA + S.a_off(nxt) : cA; const char* nB = has_next ? (const char*)g.Bt + (size_t)S.b_tile(nxt) * tstep : cB;
        for (int t = 0; t < nt; t += 2) {
            const bool last = (t == nt - 2);
            const char* a1 = cA + (size_t)(t + 1) * kstep;
            const char* a2 = last ? nA : cA + (size_t)(t + 2) * kstep; const char* b2 = last ? nB : cB + (size_t)(t + 2) * kstep;
            const char* a3 = a2 + kstep; const char* b3 = b2 + kstep;
            if (last && has_next) S.a_ready(nxt);
            if constexpr (SP2) {
            PG8_LDB(B0, 0, 0); PG8_LDB(B1, 0, 1); PG8_SCHED; PG8_LDA(At, 0, 0); PG8_STAGE(PG8_SA(1, 1), a1 + hstepA, voffA);
            PG8_WAIT_V(8); PG8_WAIT_L(0); PG8_BAR; PG8_MMA(0, 0, At, B0); PG8_MMA(0, 1, At, B1); PG8_BAR; PG8_SCHED;
            PG8_LDA(At, 0, 1); PG8_STAGE(PG8_SB(0, 0), b2, voffB); PG8_STAGE(PG8_SB(0, 1), b2 + hstep, voffB); PG8_STAGE(PG8_SA(0, 0), a2, voffA);
            PG8_WAIT_V(8); PG8_WAIT_L(0); PG8_BAR; PG8_MMA(1, 0, At, B0); PG8_MMA(1, 1, At, B1); PG8_BAR; PG8_SCHED;
            PG8_LDB(B0, 1, 0); PG8_LDB(B1, 1, 1); PG8_SCHED; PG8_LDA(At, 1, 0); PG8_STAGE(PG8_SA(0, 1), a2 + hstepA, voffA);
            PG8_WAIT_V(8); PG8_WAIT_L(0); PG8_BAR; PG8_MMA(0, 0, At, B0); PG8_MMA(0, 1, At, B1); PG8_BAR; PG8_SCHED;
            PG8_LDA(At, 1, 1); PG8_STAGE(PG8_SB(1, 0), b3, voffB); PG8_STAGE(PG8_SB(1, 1), b3 + hstep, voffB); PG8_STAGE(PG8_SA(1, 0), a3, voffA);
            PG8_WAIT_V(8); PG8_WAIT_L(0); PG8_BAR; PG8_MMA(1, 0, At, B0); PG8_MMA(1, 1, At, B1); PG8_BAR; PG8_SCHED;
            } else {
            PG8_LDB(B0, 0, 0); PG8_SCHED; PG8_LDA(At, 0, 0); PG8_STAGE(PG8_SA(1, 1), a1 + hstepA, voffA);
            PG8_WAIT_L(8); PG8_BAR; PG8_WAIT_L(0); PG8_MMA(0, 0, At, B0); PG8_BAR; PG8_SCHED;
            PG8_LDB(B1, 0, 1); PG8_STAGE(PG8_SB(0, 0), b2, voffB);
            PG8_BAR; PG8_WAIT_L(0); PG8_MMA(0, 1, At, B1); PG8_BAR;
            PG8_LDA(At, 0, 1); PG8_STAGE(PG8_SA(0, 0), a2, voffA);
            PG8_BAR; PG8_WAIT_L(0); PG8_MMA(1, 0, At, B0); PG8_BAR; PG8_SCHED;
            PG8_STAGE(PG8_SB(0, 1), b2 + hstep, voffB);
            PG8_WAIT_V(6); PG8_BAR; PG8_MMA(1, 1, At, B1); PG8_BAR;
            PG8_LDB(B0, 1, 0); PG8_SCHED; PG8_LDA(At, 1, 0); PG8_STAGE(PG8_SA(0, 1), a2 + hstepA, voffA);
            PG8_WAIT_L(8); PG8_BAR; PG8_WAIT_L(0); PG8_MMA(0, 0, At, B0); PG8_BAR; PG8_SCHED;
            PG8_LDB(B1, 1, 1); PG8_STAGE(PG8_SB(1, 0), b3, voffB);
            PG8_BAR; PG8_WAIT_L(0); PG8_MMA(0, 1, At, B1); PG8_BAR;
            PG8_LDA(At, 1, 1); PG8_STAGE(PG8_SA(1, 0), a3, voffA);
            PG8_BAR; PG8_WAIT_L(0); PG8_MMA(1, 0, At, B0); PG8_BAR; PG8_SCHED;
            PG8_STAGE(PG8_SB(1, 1), b3 + hstep, voffB);
            PG8_WAIT_V(6); PG8_BAR; PG8_MMA(1, 1, At, B1); PG8_BAR;
            }
            if constexpr (Epi::SEG_TILES > 0) { if (((t + 2) % Epi::SEG_TILES) == 0 && (t + 2) < nt) { E.seg(acc, cur, (t + 2) / Epi::SEG_TILES - 1, wr, wc, fr, fq); PG8_WAIT_V(0); PG8_SCHED; } }
        }
        if constexpr (ALIGN_EPI) { if (wr == 0) PG8_BAR; }
        if constexpr (!Epi::AFTER_DRAIN) { if constexpr (Epi::RSTD_LDS) E(acc, cur, wr, wc, fr, fq, (const PG8_LAS float*)(lds + RS_OFF + (ui & 1) * RS_SLOT)); else E(acc, cur, wr, wc, fr, fq); S.done(cur); }
        if (!has_next) break;
#pragma unroll
        for (int a = 0; a < 2; ++a)
#pragma unroll
            for (int b = 0; b < 2; ++b)
#pragma unroll
                for (int m = 0; m < 4; ++m)
#pragma unroll
                    for (int n = 0; n < 2; ++n) acc[a][b][m][n] = (f32x4){0.f, 0.f, 0.f, 0.f};
        cur = nxt; cA = nA; cB = nB; ++ui;
        PG8_RSTD_DMA(cur, ui);
        if constexpr (ALIGN_EPI) { if (wr == 1) PG8_BAR; }
    }
    typename Epi::Pre pre;
    if constexpr (Epi::AFTER_DRAIN) E.prefetch(pre, cur, wr, wc, fr, fq);
    PG8_WAIT_V(0);
    if constexpr (!ALIGN_EPI) { if (wr == 0) PG8_BAR; }
    PG8_BAR;
    if constexpr (Epi::AFTER_DRAIN) { E.fused(acc, cur, wr, wc, fr, fq, lds, wid, lane, pre); S.done(cur); }
#undef PG8_SA
#undef PG8_SB
#undef PG8_STAGE
#undef PG8_LDA
#undef PG8_LDB
#undef PG8_MMA
#undef PG8_WAIT_V
#undef PG8_WAIT_L
#undef PG8_BAR
#undef PG8_SCHED
#undef PG8_RSTD_DMA
}
}

constexpr int NWAVES = 8, NTHR = 512;
constexpr int M = 16384, SEQ = 8192, D = 1024, FF = 2816, NL = 4, NCH = 128  , NBC = 256  ;
constexpr int NPM = 6656;
constexpr int NWIN = 10752;
constexpr int C_DAQ = 0, C_DAK = 512, C_DAV = 1024, C_GQ = 1536, C_GK = 1792, C_GV = 2048, C_GOG = 2560, C_SZ = 3072, C_SX = 3584, C_SB = 4096, C_SC = 4352,
              C_RR = 4608, C_RK = 5120, C_RV = 5632, C_RWL = 6144, C_RAL = 6208, C_RGL = 6272, C_GLR = 6400, C_SDT = 6416;
constexpr float EPS = 1e-6f, LOG2E = 1.4426950408889634f;

constexpr size_t MiB = 1u << 20;
constexpr size_t WS_CTL = 0, CTL_ZERO_BYTES = 1 * MiB;
constexpr size_t WS_COS = 1 * MiB, WS_SIN = 2 * MiB, WS_SSQ = 3 * MiB, WS_GLAST = 3 * MiB + 512 * 1024, WS_SDT = 4 * MiB, WS_SACUM = 4 * MiB + 512 * 1024, WS_SCDEC = 5 * MiB, WS_RW2T = 5 * MiB + 64 * 1024;
constexpr size_t WS_WGU1 = 8 * MiB, WS_WD1 = 19 * MiB, WS_WIN = 24 * MiB + 512 * 1024, WS_WB = 45 * MiB + 512 * 1024, WS_WO = 49 * MiB + 512 * 1024, WS_WGU2 = 51 * MiB + 512 * 1024, WS_WD2 = 62 * MiB + 512 * 1024;
constexpr size_t WS_HB = 68 * MiB, WS_P = 100 * MiB, WS_PG = 100 * MiB, WS_YS = 308 * MiB, WS_R1 = 372 * MiB, WS_R2 = 500 * MiB, WS_END = 644 * MiB;
constexpr size_t WS_ACT = WS_R1, WS_MERGED = WS_R1;
constexpr size_t WS_RWW = WS_R1, WS_RWR = WS_R1 + 32 * MiB, WS_RWK = WS_R1 + 48 * MiB, WS_RWV = WS_R1 + 64 * MiB, WS_RWKK = WS_R1 + 80 * MiB, WS_RWB = WS_R1 + 96 * MiB, WS_RWG = WS_R1 + 112 * MiB;
constexpr size_t WS_VT = WS_R2, WS_GKV = WS_R2 + 16 * MiB, WS_SST = WS_R2 + 48 * MiB, WS_RWY = WS_R2 + 112 * MiB;
static_assert(WS_WD2 + (size_t)D * FF * 2 <= WS_HB && WS_P + (size_t)M * NPM * 2 <= WS_YS && WS_RWY + (size_t)M * 512 * 2 <= WS_END, "d_ws map");
constexpr int CW_BAR = 4096;

constexpr int RING_BYTES = 131072, LDSCTL_OFF = RING_BYTES, MISC_OFF = LDSCTL_OFF + 320, LDS_BYTES = 147456;

#define GAS __attribute__((address_space(1)))
#define LAS __attribute__((address_space(3)))
typedef unsigned short bf16;
typedef unsigned v4u __attribute__((ext_vector_type(4)));
typedef float f32x4 __attribute__((ext_vector_type(4)));
typedef short bf16x8 __attribute__((ext_vector_type(8)));
typedef GAS unsigned gu32;
typedef GAS unsigned long long gu64;
#define RLX_AGENT __ATOMIC_RELAXED, __HIP_MEMORY_SCOPE_AGENT
#define LDS_WAIT() asm volatile("s_waitcnt lgkmcnt(0)" ::: "memory")
#define VM_WAIT() asm volatile("s_waitcnt vmcnt(0)" ::: "memory")
__device__ __forceinline__ unsigned long long rt() { return __builtin_amdgcn_s_memrealtime(); }
typedef float f32x2_cv __attribute__((ext_vector_type(2))); typedef __bf16 bf16x2_cv __attribute__((ext_vector_type(2)));
__device__ __forceinline__ unsigned pk2(float lo, float hi) { const f32x2_cv v = {lo, hi}; const bf16x2_cv b = __builtin_convertvector(v, bf16x2_cv); return __builtin_bit_cast(unsigned, b); }
__device__ __forceinline__ unsigned f2bf(float f) { return pk2(f, 0.f) & 0xffffu; }

#define XB_TMO      128
#define XB_XCNT(j)  (256  + 64 * (j))
#define XB_XSUB(j)  (1280 + 64 * (j))
#define XB_XGEN(j)  (2304 + 64 * (j))
#define XB_TOP      3328
#define XB_TOPGEN   3392
#define XCD_BAR_WORDS 3456
#define XB_SPIN_CAP (1u << 18)

__device__ __forceinline__ unsigned xb_ld(unsigned* p)              { return __hip_atomic_load(p, __ATOMIC_RELAXED, __HIP_MEMORY_SCOPE_AGENT); }
__device__ __forceinline__ unsigned xb_add(unsigned* p, unsigned v) { return __hip_atomic_fetch_add(p, v, __ATOMIC_RELAXED, __HIP_MEMORY_SCOPE_AGENT); }
__device__ __forceinline__ unsigned xb_xcc_id() { return (unsigned)__builtin_amdgcn_s_getreg((3 << 11) | 20) & 0xFu; }
#define XB_SPIN(cond, bar) do { unsigned _sp = 0; while (cond) { __builtin_amdgcn_s_sleep(1); \
    if ((++_sp & 255u) == 0u) { if (xb_ld(&(bar)[XB_TMO])) break; if (_sp > XB_SPIN_CAP) { atomicAdd(&(bar)[XB_TMO], 1u); break; } } } } while (0)

struct XcdBarrier {
    unsigned* bar; unsigned x;
    volatile LAS unsigned* st;
};

__device__ __forceinline__ XcdBarrier xcd_barrier_post(unsigned* bar, volatile LAS unsigned* st) {
    XcdBarrier b; b.bar = bar; b.x = xb_xcc_id(); b.st = st;
    if (threadIdx.x == 0) (void)xb_add(&bar[XB_XCNT(b.x)], 1u);
    return b;
}
__device__ __forceinline__ void xcd_barrier_complete(unsigned* bar, unsigned x, unsigned& nloc, unsigned& nx) {
    const unsigned G = gridDim.x * gridDim.y * gridDim.z;
    unsigned sum, cnt, mine, sp = 0u;
    for (;;) {
        sum = 0u; cnt = 0u; mine = 0u;
#pragma unroll
        for (unsigned j = 0; j < 16; ++j) { const unsigned c = xb_ld(&bar[XB_XCNT(j)]); sum += c; cnt += (c > 0u) ? 1u : 0u; mine = (j == x) ? c : mine; }
        if (sum == G) break;
        __builtin_amdgcn_s_sleep(1);
        if ((++sp & 255u) == 0u) { if (xb_ld(&bar[XB_TMO])) break; if (sp > XB_SPIN_CAP) { atomicAdd(&bar[XB_TMO], 1u); break; } }
    }
    nloc = mine > 0u ? mine : 1u; nx = cnt > 0u ? cnt : 1u;
}

__device__ __forceinline__ void xcd_barrier(const XcdBarrier& b) {
    asm volatile("s_waitcnt vmcnt(0)" ::: "memory");
    __syncthreads();
    if (threadIdx.x == 0) {
        unsigned* bar = b.bar;
        __builtin_amdgcn_s_waitcnt(0);
        unsigned nloc = b.st[0], nx = b.st[1];
        if (nloc == 0u) { xcd_barrier_complete(bar, b.x, nloc, nx); b.st[0] = nloc; b.st[1] = nx; }
        const unsigned old = xb_add(&bar[XB_XSUB(b.x)], 1u);
        const unsigned gen = old / nloc;
        if (old + 1u == (gen + 1u) * nloc) {
            __builtin_amdgcn_fence(__ATOMIC_RELEASE, "agent");
            asm volatile("s_waitcnt vmcnt(0)" ::: "memory");
            const unsigned og = xb_add(&bar[XB_TOP], 1u);
            const unsigned tg = og / nx;
            if (og + 1u == (tg + 1u) * nx) xb_add(&bar[XB_TOPGEN], 1u);
            else XB_SPIN(xb_ld(&bar[XB_TOPGEN]) == tg, bar);
            __builtin_amdgcn_fence(__ATOMIC_ACQUIRE, "agent");
            xb_add(&bar[XB_XGEN(b.x)], 1u);
            asm volatile("s_waitcnt vmcnt(0)" ::: "memory");
        } else {
            XB_SPIN(xb_ld(&bar[XB_XGEN(b.x)]) == gen, bar);
            __builtin_amdgcn_fence(__ATOMIC_ACQUIRE, "agent");
            asm volatile("s_waitcnt vmcnt(0)" ::: "memory");
        }
    }
    __syncthreads();
}

struct Args { const float* in[40]; float* out; unsigned char* ws; float inv_freq[32]; int g_lo, g_hi; };
struct ArgsD { const GAS float* in[40]; GAS float* out; GAS unsigned char* ws; float inv_freq[32]; int g_lo, g_hi; };
typedef const __attribute__((address_space(4))) ArgsD* ArgsP;
typedef LAS float* LF; typedef const LAS float* CLF;
#ifndef PH_FN
#define PH_FN __device__ __noinline__
#endif
#ifndef PH_HEAVY
#define PH_HEAVY __device__ __forceinline__
#endif
struct Ctx {
    LAS unsigned char* lds;
    GAS unsigned char* ws; GAS float* h;
    int tid, lane, wave, bid, G;
};
typedef unsigned u32x4 __attribute__((ext_vector_type(4)));
typedef unsigned u32x2 __attribute__((ext_vector_type(2)));
typedef float f32x2 __attribute__((ext_vector_type(2)));
typedef float f32x16 __attribute__((ext_vector_type(16)));
__device__ __forceinline__ float bf2f(bf16 x) { return __uint_as_float((unsigned)x << 16); }
__device__ __forceinline__ float bflo(unsigned w) { return __uint_as_float(w << 16); }
__device__ __forceinline__ float bfhi(unsigned w) { return __uint_as_float(w & 0xffff0000u); }
__device__ __forceinline__ void unpack8(const u32x4 w, float* o) { o[0] = bflo(w.x); o[1] = bfhi(w.x); o[2] = bflo(w.y); o[3] = bfhi(w.y); o[4] = bflo(w.z); o[5] = bfhi(w.z); o[6] = bflo(w.w); o[7] = bfhi(w.w); }
__device__ __forceinline__ u32x4 pack8(const float* o) { u32x4 w; w.x = pk2(o[0], o[1]); w.y = pk2(o[2], o[3]); w.z = pk2(o[4], o[5]); w.w = pk2(o[6], o[7]); return w; }
__device__ __forceinline__ float sigmoidf_(float x) { return 1.0f / (1.0f + __expf(-x)); }
__device__ __forceinline__ float siluf_(float x) { return x * sigmoidf_(x); }
__device__ __forceinline__ float softplusf_(float x) { return fmaxf(x, 0.f) + log1pf(__expf(-fabsf(x))); }
__device__ __forceinline__ float logsigmoidf_(float x) { return fminf(x, 0.f) - log1pf(__expf(-fabsf(x))); }
__device__ __forceinline__ float wave_sum(float v) {
#pragma unroll
    for (int o = 1; o < 64; o <<= 1) v += __shfl_xor(v, o);
    return v;
}
#define WG_SYNC() __syncthreads()
#define RW_BAR() do { asm volatile("s_waitcnt lgkmcnt(0)" ::: "memory"); __builtin_amdgcn_s_barrier(); asm volatile("" ::: "memory"); } while (0)
__device__ __forceinline__ Ctx fresh(const Ctx& C0) { Ctx C = C0; int t = threadIdx.x; asm volatile("" : "+v"(t)); C.tid = t; C.lane = t & 63; C.wave = __builtin_amdgcn_readfirstlane(t >> 6); return C; }

PH_FN void ph_prologue(const Ctx C, ArgsP a) {
    GAS float* cosT = (GAS float*)(C.ws + WS_COS); GAS float* sinT = (GAS float*)(C.ws + WS_SIN);
    for (int idx = C.bid * NTHR + C.tid; idx < SEQ * 32; idx += C.G * NTHR) {
        const int t = idx >> 5, j = idx & 31;
        const float ang = (float)t * a->inv_freq[j];
        const double rev = (double)ang * 0.15915494309189535;
        const float fr = (float)(rev - floor(rev));
        cosT[idx] = __builtin_amdgcn_cosf(fr); sinT[idx] = __builtin_amdgcn_sinf(fr);
    }
    const GAS float* x = a->in[0]; GAS bf16* hb = (GAS bf16*)(C.ws + WS_HB); GAS float* ssq = (GAS float*)(C.ws + WS_SSQ);
    const int gw = C.bid * NWAVES + C.wave, NGW = C.G * NWAVES;
    for (int m = gw; m < M; m += NGW) {
        const GAS f32x4* xr = (const GAS f32x4*)(x + (size_t)m * D) + C.lane;
        GAS unsigned long long* o8 = (GAS unsigned long long*)(hb + (size_t)m * D) + C.lane;
        float s = 0.f;
#pragma unroll
        for (int j = 0; j < 4; ++j) { const f32x4 v = xr[64 * j]; s += (v.x * v.x + v.y * v.y) + (v.z * v.z + v.w * v.w);
            o8[64 * j] = (unsigned long long)pk2(v.x, v.y) | ((unsigned long long)pk2(v.z, v.w) << 32); }
        s = wave_sum(s);
        if (C.lane == 0) *(GAS f32x4*)(ssq + (size_t)m * 4) = (f32x4){s, 0.f, 0.f, 0.f};
    }
}

template <class SrcF>
__device__ __forceinline__ void tr_item(const SrcF src, const GAS float* gk, GAS bf16* WT, int K, int kb, int nb, LAS bf16* scr, int lane) {
    const int k0 = 64 * kb, n0 = 64 * nb, kr = lane >> 4, n4 = 4 * (lane & 15);
    const int ld = src.ld(); const long co = src.col(n0 + n4); const bool ok = co >= 0; const GAS float* colp = src.base(n0 + n4) + (ok ? co : 0);
    f32x4 v[16];
#pragma unroll
    for (int i = 0; i < 16; ++i) v[i] = ok ? *(const GAS f32x4*)(colp + (size_t)(k0 + 4 * i + kr) * ld) : (f32x4){0.f, 0.f, 0.f, 0.f};
#pragma unroll
    for (int i = 0; i < 16; ++i) { const int kk = 4 * i + kr; const float g = gk ? gk[k0 + kk] : 1.0f;
#pragma unroll
        for (int e = 0; e < 4; ++e) scr[(n4 + e) * 72 + kk] = (bf16)f2bf(v[i][e] * g); }
    LDS_WAIT(); asm volatile("" ::: "memory");
    const int c = lane & 7;
#pragma unroll
    for (int j = 0; j < 8; ++j) { const int n = (lane >> 3) + 8 * j; *(GAS v4u*)(WT + (size_t)(n0 + n) * K + k0 + 8 * c) = *(const LAS v4u*)(scr + n * 72 + 8 * c); }
    LDS_WAIT(); asm volatile("" ::: "memory");
}
struct SrcGU { const GAS float* wg; const GAS float* wu;
    __device__ __forceinline__ int ld() const { return FF; }
    __device__ __forceinline__ const GAS float* base(int n) const { const uintptr_t sel = (uintptr_t)((n >> 7) & 1); return (const GAS float*)((uintptr_t)wg + sel * ((uintptr_t)wu - (uintptr_t)wg)); }
    __device__ __forceinline__ long col(int n) const { return 128 * (n >> 8) + (n & 127); } };
struct SrcPlain { const GAS float* w; int ldw;
    __device__ __forceinline__ int ld() const { return ldw; }
    __device__ __forceinline__ const GAS float* base(int) const { return w; }
    __device__ __forceinline__ long col(int n) const { return n; } };
struct SrcWin { const GAS float* w;
    __device__ __forceinline__ int ld() const { return 10520; }
    __device__ __forceinline__ const GAS float* base(int) const { return w; }
    __device__ __forceinline__ long col(int n) const {
        int c;
        if (n < 1024) { const int cl = n & 255; c = (4 * (n >> 8) + ((cl >> 5) & 3)) * 64 + 32 * (cl >> 7) + 8 * ((cl >> 3) & 3) + 4 * ((cl >> 2) & 1) + (cl & 3); }
        else if (n < 3072) c = n; else if (n < 4608) c = n - 3072 + 3088; else if (n < 6400) c = n - 4608 + 4632; else if (n < 6416) c = n - 6400 + 3072; else if (n < 6424) c = n - 6416 + 4624; else if (n < 6656) c = -1;
        else { const int m = n - 6656, pn = m >> 8, cl = m & 255, z = 2 * (cl >> 7) + ((cl >> 2) & 1), ch = 64 * pn + 16 * ((cl >> 5) & 3) + 4 * ((cl >> 3) & 3) + (cl & 3); c = 6424 + z * 1024 + ch; }
        return c; } };
PH_FN void ph_weights(const Ctx C, ArgsP a, int l, int mask, int gw, int NGW) {
    LAS bf16* scr = (LAS bf16*)(C.lds + C.wave * 16384);
    int rot = 0;
#define W_FIRST(cnt) ({ const int f_ = (gw + NGW - rot % NGW) % NGW; rot += (cnt); f_; })
#pragma unroll 1
    for (int f = 0; f < 2; ++f) { if (!(mask & (1 << f))) continue;
        const GAS float* nrm = a->in[f ? 35 : 1] + (size_t)l * D; const GAS float* wg = a->in[f ? 36 : 2] + (size_t)l * D * FF; const GAS float* wu = a->in[f ? 37 : 3] + (size_t)l * D * FF; const GAS float* wd = a->in[f ? 38 : 4] + (size_t)l * FF * D;
        GAS bf16* Wgu = (GAS bf16*)(C.ws + (f ? WS_WGU2 : WS_WGU1)); GAS bf16* Wd = (GAS bf16*)(C.ws + (f ? WS_WD2 : WS_WD1));
        const SrcGU sgu{wg, wu};
        for (int it = W_FIRST((D / 64) * (2 * FF / 64)); it < (D / 64) * (2 * FF / 64); it += NGW) tr_item(sgu, nrm, Wgu, D, it / (2 * FF / 64), it % (2 * FF / 64), scr, C.lane);
        const SrcPlain sd{wd, D};
        for (int it = W_FIRST((FF / 64) * (D / 64)); it < (FF / 64) * (D / 64); it += NGW) tr_item(sd, nullptr, Wd, FF, it / (D / 64), it % (D / 64), scr, C.lane);
    }
    if (mask & 4)
    { const SrcWin sw{a->in[6] + (size_t)l * D * 10520}; const GAS float* nrm = a->in[5] + (size_t)l * D; GAS bf16* Win = (GAS bf16*)(C.ws + WS_WIN);
      for (int it = W_FIRST((D / 64) * (NWIN / 64)); it < (D / 64) * (NWIN / 64); it += NGW) tr_item(sw, nrm, Win, D, it / (NWIN / 64), it % (NWIN / 64), scr, C.lane); }
    if (!(mask & 8)) return;
    { GAS bf16* Wb = (GAS bf16*)(C.ws + WS_WB);
      for (int it = W_FIRST(4 * (512 / 64) * (D / 64)); it < 4 * (512 / 64) * (D / 64); it += NGW) { const int z = it / ((512 / 64) * (D / 64)), r = it % ((512 / 64) * (D / 64));
          const SrcPlain sb{a->in[32] + ((size_t)l * 4 + z) * 512 * D - (size_t)z * 512 * D, D}; tr_item(sb, nullptr, Wb, 2048, z * 8 + r / (D / 64), r % (D / 64), scr, C.lane); } }
    { GAS bf16* W2T = (GAS bf16*)(C.ws + WS_RW2T); GAS bf16* A2T = W2T + 512 * 64; GAS bf16* G2T = A2T + 512 * 64;
      const SrcPlain s1{a->in[23] + (size_t)l * 64 * 512, 512}, s2{a->in[25] + (size_t)l * 64 * 512, 512}, s3{a->in[26] + (size_t)l * 128 * 512, 512};
      for (int it = W_FIRST(8); it < 8; it += NGW) tr_item(s1, nullptr, W2T, 64, 0, it, scr, C.lane);
      for (int it = W_FIRST(8); it < 8; it += NGW) tr_item(s2, nullptr, A2T, 64, 0, it, scr, C.lane);
      for (int it = W_FIRST(16); it < 16; it += NGW) tr_item(s3, nullptr, G2T, 128, it >> 3, it & 7, scr, C.lane); }
    { const SrcPlain so{a->in[34] + (size_t)l * D * D, D}; GAS bf16* Wo = (GAS bf16*)(C.ws + WS_WO);
      for (int it = W_FIRST((D / 64) * (D / 64)); it < (D / 64) * (D / 64); it += NGW) tr_item(so, nullptr, Wo, D, it / (D / 64), it % (D / 64), scr, C.lane); }
}

#undef W_FIRST

typedef LAS bf16* LB; typedef const LAS bf16* CLB;
__device__ __forceinline__ pg8::bf16x8 frag32(CLB X, int ld, int row0, int k0, int lane) { return *(const LAS pg8::bf16x8*)(X + (row0 + (lane & 31)) * ld + k0 + 8 * (lane >> 5)); }
template <int K> __device__ __forceinline__ void mma_nt(f32x16& acc, CLB A, int lda, int m0, CLB Bt, int ldb, int n0, int lane) {
#pragma unroll
    for (int k = 0; k < K; k += 16) acc = __builtin_amdgcn_mfma_f32_32x32x16_bf16(frag32(A, lda, m0, k, lane), frag32(Bt, ldb, n0, k, lane), acc, 0, 0, 0);
}
__device__ __forceinline__ int crow(int r, int hi) { return (r & 3) + 8 * (r >> 2) + 4 * hi; }
__device__ __forceinline__ f32x16 zero16() { f32x16 z;
#pragma unroll
    for (int r = 0; r < 16; ++r) z[r] = 0.f;
    return z; }

__device__ __forceinline__ void gla_compute_G(const Ctx& C, ArgsP a, int l, int bc, int h, LF Gs) {
    const GAS bf16* P = (const GAS bf16*)(C.ws + WS_P); const GAS float* W2 = a->in[12] + (size_t)l * 16 * 256; const GAS float* gb = a->in[13] + (size_t)l * 256;
    const int t = C.tid >> 3, kg = C.tid & 7; const size_t row = (size_t)bc * 64 + t;
    float glr[16]; unpack8(*(const GAS u32x4*)(P + row * NPM + C_GLR), glr); unpack8(*(const GAS u32x4*)(P + row * NPM + C_GLR + 8), glr + 8);
#pragma unroll
    for (int i = 0; i < 8; ++i) { const int k = h * 64 + kg * 8 + i; float x = gb[k];
#pragma unroll
        for (int r = 0; r < 16; ++r) x += glr[r] * W2[r * 256 + k];
        Gs[t * 68 + kg * 8 + i] = logsigmoidf_(x) * (1.0f / 16.0f); }
    RW_BAR();
    { const int seg = C.tid >> 6, k = C.tid & 63; float run = 0.f;
#pragma unroll
      for (int i = 0; i < 8; ++i) { run += Gs[(8 * seg + i) * 68 + k]; Gs[(8 * seg + i) * 68 + k] = run; }
      RW_BAR();
      float off = 0.f;
#pragma unroll
      for (int sg = 0; sg < 7; ++sg) { const float tot = Gs[(8 * sg + 7) * 68 + k]; off += (sg < seg) ? tot : 0.f; }
      RW_BAR();
#pragma unroll
      for (int i = 0; i < 8; ++i) Gs[(8 * seg + i) * 68 + k] += off; }
    RW_BAR();
}
PH_HEAVY void ph_gla_a(const Ctx C, ArgsP a, int l) {
    const GAS bf16* P = (const GAS bf16*)(C.ws + WS_P); GAS bf16* GKV = (GAS bf16*)(C.ws + WS_GKV); GAS float* GL = (GAS float*)(C.ws + WS_GLAST); GAS bf16* YSg = (GAS bf16*)(C.ws + WS_YS);
    LF Gs = (LF)C.lds; LB KDT = (LB)(C.lds + 17408); LB VT = (LB)(C.lds + 26624);
    for (int it = C.bid; it < NBC * 4; it += C.G) {
        const int bc = it >> 2, h = it & 3;
        const u32x4 kw_ = *(const GAS u32x4*)(P + ((size_t)bc * 64 + (C.tid >> 3)) * NPM + C_GK + h * 64 + (C.tid & 7) * 8);
        const u32x4 v0 = *(const GAS u32x4*)(P + ((size_t)bc * 64 + (C.tid >> 3)) * NPM + C_GV + h * 128 + (C.tid & 7) * 16), v1 = *(const GAS u32x4*)(P + ((size_t)bc * 64 + (C.tid >> 3)) * NPM + C_GV + h * 128 + (C.tid & 7) * 16 + 8);
        RW_BAR();
        gla_compute_G(C, a, l, bc, h, Gs);
        { const int t = C.tid >> 3, g8 = C.tid & 7; const size_t row = (size_t)bc * 64 + t;
          { GAS float* gst = (GAS float*)(YSg + row * 2048 + 512 + h * 128) + g8 * 8; *(GAS f32x4*)gst = *(const LAS f32x4*)(Gs + t * 68 + g8 * 8); *(GAS f32x4*)(gst + 4) = *(const LAS f32x4*)(Gs + t * 68 + g8 * 8 + 4); }
          float kf[8]; unpack8(kw_, kf);
#pragma unroll
          for (int i = 0; i < 8; ++i) { const int k = g8 * 8 + i; KDT[k * 72 + t] = (bf16)f2bf(kf[i] * __expf(Gs[63 * 68 + k] - Gs[t * 68 + k])); }
          const unsigned vw[8] = {v0.x, v0.y, v0.z, v0.w, v1.x, v1.y, v1.z, v1.w};
#pragma unroll
          for (int i = 0; i < 8; ++i) { VT[(g8 * 16 + 2 * i) * 72 + t] = (bf16)(vw[i] & 0xffffu); VT[(g8 * 16 + 2 * i + 1) * 72 + t] = (bf16)(vw[i] >> 16); }
          if (C.tid < 64) GL[(size_t)it * 64 + C.tid] = Gs[63 * 68 + C.tid]; }
        RW_BAR();
        { const int kt = C.wave >> 2, vt = C.wave & 3, n = C.lane & 31, hi = C.lane >> 5;
          f32x16 acc = zero16(); mma_nt<64>(acc, KDT, 72, 32 * kt, VT, 72, 32 * vt, C.lane);
          GAS bf16* dst = GKV + ((size_t)it * 128 + 32 * vt + n) * 64 + 32 * kt + 4 * hi;
#pragma unroll
          for (int g = 0; g < 4; ++g) { u32x2 w; w.x = pk2(acc[4 * g], acc[4 * g + 1]); w.y = pk2(acc[4 * g + 2], acc[4 * g + 3]); *(GAS u32x2*)(dst + 8 * g) = w; } }
    }
    WG_SYNC();
}
PH_FN void gla_scan_part(const Ctx C, int part) {
    GAS unsigned* GKV = (GAS unsigned*)(C.ws + WS_GKV); const GAS float* GL = (const GAS float*)(C.ws + WS_GLAST);
    const int part_ = __builtin_amdgcn_readfirstlane(part), chain = part_ >> 3, idx = (part_ & 7) * NTHR + C.tid,     b = chain >> 2, h = chain & 3, k = (2 * idx) & 63;
    float s0 = 0.f, s1 = 0.f;
    unsigned tA[8], tB[8]; f32x2 dA[8], dB[8];
    GAS unsigned* gp = GKV + ((size_t)(b * NCH) * 4 + h) * 4096 + idx; const GAS float* lp = GL + ((size_t)(b * NCH) * 4 + h) * 64 + k;
#define GS_LOAD(T, D, c0_) do { GAS unsigned* g_ = gp + (size_t)(c0_) * 16384; const GAS float* l_ = lp + (size_t)(c0_) * 256; _Pragma("unroll") for (int i = 0; i < 8; ++i) { T[i] = g_[i * 16384]; D[i] = *(const GAS f32x2*)(l_ + i * 256); } } while (0)
#define GS_PROC(T, D, c0_) do { GAS unsigned* g_ = gp + (size_t)(c0_) * 16384; _Pragma("unroll") for (int i = 0; i < 8; ++i) { g_[i * 16384] = pk2(s0, s1); s0 = __expf(D[i][0]) * s0 + bflo(T[i]); s1 = __expf(D[i][1]) * s1 + bfhi(T[i]); } } while (0)
    GS_LOAD(tA, dA, 0);
#pragma unroll 1
    for (int c0 = 0; c0 < NCH; c0 += 16) { GS_LOAD(tB, dB, c0 + 8); GS_PROC(tA, dA, c0); if (c0 + 16 < NCH) GS_LOAD(tA, dA, c0 + 16); GS_PROC(tB, dB, c0 + 8); }
#undef GS_LOAD
#undef GS_PROC
}
PH_HEAVY void ph_gla_c(const Ctx C, ArgsP a, int l) {
    const GAS bf16* P = (const GAS bf16*)(C.ws + WS_P); const GAS bf16* GKV = (const GAS bf16*)(C.ws + WS_GKV); GAS bf16* YS = (GAS bf16*)(C.ws + WS_YS);
    const GAS float* gnorm = a->in[14] + (size_t)l * 128;
    LF Gs = (LF)C.lds; LB QD = (LB)(C.lds + 17408); LB KDR = (LB)(C.lds + 26624); LB QI = (LB)(C.lds + 35840); LB ATT = (LB)(C.lds + 45056); LB VT = (LB)(C.lds + 54272); LB ST = (LB)(C.lds + 72704); LF PS = (LF)(C.lds + 91136);
    for (int it = C.bid; it < NBC * 4; it += C.G) {
        const int bc = it >> 2, h = it & 3;
        { const int t = C.tid >> 3, g8 = C.tid & 7; const size_t row = (size_t)bc * 64 + t;
          const GAS float* gst = (const GAS float*)(YS + row * 2048 + 512 + h * 128) + g8 * 8; const f32x4 gs0 = *(const GAS f32x4*)gst, gs1 = *(const GAS f32x4*)(gst + 4);
          const u32x4 qw = *(const GAS u32x4*)(P + row * NPM + C_GQ + h * 64 + g8 * 8), kw = *(const GAS u32x4*)(P + row * NPM + C_GK + h * 64 + g8 * 8);
          const u32x4 v0 = *(const GAS u32x4*)(P + row * NPM + C_GV + h * 128 + g8 * 16), v1 = *(const GAS u32x4*)(P + row * NPM + C_GV + h * 128 + g8 * 16 + 8);
          const int v = C.tid >> 2, kq = (C.tid & 3) * 16; const GAS bf16* sp = GKV + ((size_t)it * 128 + v) * 64 + kq; const u32x4 st0 = *(const GAS u32x4*)sp, st1 = *(const GAS u32x4*)(sp + 8);
          __builtin_amdgcn_sched_barrier(0);
          RW_BAR();
          *(LAS f32x4*)(Gs + t * 68 + g8 * 8) = gs0; *(LAS f32x4*)(Gs + t * 68 + g8 * 8 + 4) = gs1;
          RW_BAR();
          float qf[8], kf[8], o1[8], o2[8], o3[8];
          unpack8(qw, qf); unpack8(kw, kf);
#pragma unroll
          for (int i = 0; i < 8; ++i) { const int k = g8 * 8 + i; const float g = Gs[t * 68 + k], d = g - Gs[32 * 68 + k]; o1[i] = qf[i] * 0.125f * __expf(d); o2[i] = kf[i] * __expf(-d); o3[i] = qf[i] * 0.125f * __expf(g); }
          *(LAS u32x4*)(QD + t * 72 + g8 * 8) = pack8(o1); *(LAS u32x4*)(KDR + t * 72 + g8 * 8) = pack8(o2); *(LAS u32x4*)(QI + t * 72 + g8 * 8) = pack8(o3);
          const unsigned vw[8] = {v0.x, v0.y, v0.z, v0.w, v1.x, v1.y, v1.z, v1.w};
#pragma unroll
          for (int i = 0; i < 8; ++i) { VT[(g8 * 16 + 2 * i) * 72 + t] = (bf16)(vw[i] & 0xffffu); VT[(g8 * 16 + 2 * i + 1) * 72 + t] = (bf16)(vw[i] >> 16); }
          *(LAS u32x4*)(ST + v * 72 + kq) = st0; *(LAS u32x4*)(ST + v * 72 + kq + 8) = st1; }
        RW_BAR();
        const int n = C.lane & 31, hi = C.lane >> 5;
        if (C.wave < 4) {
            const int it_ = C.wave >> 1, jt = C.wave & 1;
            f32x16 acc = zero16();
            if (jt <= it_) mma_nt<64>(acc, QD, 72, 32 * it_, KDR, 72, 32 * jt, C.lane);
#pragma unroll
            for (int r = 0; r < 16; ++r) { const int i = 32 * it_ + crow(r, hi), j = 32 * jt + n; ATT[i * 72 + j] = (bf16)f2bf(j <= i ? acc[r] : 0.f); }
        }
        RW_BAR();
        {
            const int it_ = C.wave & 1, vt = C.wave >> 1;
            f32x16 acc = zero16();
            mma_nt<64>(acc, VT, 72, 32 * vt, ATT, 72, 32 * it_, C.lane);
            mma_nt<64>(acc, ST, 72, 32 * vt, QI, 72, 32 * it_, C.lane);
            float ss = 0.f;
#pragma unroll
            for (int r = 0; r < 16; ++r) ss += acc[r] * acc[r];
            ss += __shfl_xor(ss, 32);
            if (hi == 0) PS[(32 * it_ + n) * 4 + vt] = ss;
            const int i = 32 * it_ + n; const size_t row = (size_t)bc * 64 + i;
            u32x2 ogq[4]; f32x4 gnq[4];
#pragma unroll
            for (int g = 0; g < 4; ++g) { const int v0 = 32 * vt + 8 * g + 4 * hi; ogq[g] = *(const GAS u32x2*)(P + row * NPM + C_GOG + h * 128 + v0); gnq[g] = *(const GAS f32x4*)(gnorm + v0); }
            RW_BAR();
            const float tot = (PS[i * 4] + PS[i * 4 + 1]) + (PS[i * 4 + 2] + PS[i * 4 + 3]);
            const float rs = 1.0f / sqrtf(tot * (1.0f / 128.0f) + EPS);
#pragma unroll
            for (int g = 0; g < 4; ++g) { const int v0 = 32 * vt + 8 * g + 4 * hi;
                const u32x2 ogw = ogq[g]; const f32x4 gn = gnq[g];
                const float og[4] = {bflo(ogw.x), bfhi(ogw.x), bflo(ogw.y), bfhi(ogw.y)}; float o4[4];
#pragma unroll
                for (int y = 0; y < 4; ++y) o4[y] = acc[4 * g + y] * rs * gn[y] * siluf_(og[y]);
                u32x2 w; w.x = pk2(o4[0], o4[1]); w.y = pk2(o4[2], o4[3]); *(GAS u32x2*)(YS + row * 2048 + 512 + h * 128 + v0) = w; }
        }
    }
    WG_SYNC();
}

__device__ __forceinline__ void ssd_conv8(const GAS bf16* P, const GAS float* cw, const GAS float* cb, int bc, int t, int ch0, float* o) {
    const int pos = (bc & 127) * 64 + t; const size_t row = (size_t)bc * 64 + t;
#pragma unroll
    for (int i = 0; i < 8; ++i) o[i] = cb[ch0 + i];
#pragma unroll
    for (int tap = 0; tap < 4; ++tap) { if (pos - 3 + tap >= 0) { float x[8]; unpack8(*(const GAS u32x4*)(P + (row - 3 + tap) * NPM + C_SX + ch0), x);
#pragma unroll
        for (int i = 0; i < 8; ++i) o[i] += cw[tap * 1024 + ch0 + i] * x[i]; } }
#pragma unroll
    for (int i = 0; i < 8; ++i) o[i] = siluf_(o[i]);
}
struct ConvIn { u32x4 x[4]; };
__device__ __forceinline__ ConvIn ssd_conv_ld(const GAS bf16* P, int bc, int t, int ch0) {
    const int pos = (bc & 127) * 64 + t; const size_t row = (size_t)bc * 64 + t; ConvIn r;
#pragma unroll
    for (int tap = 0; tap < 4; ++tap) { const bool in = pos - 3 + tap >= 0; r.x[tap] = *(const GAS u32x4*)(P + (row - (in ? 3 - tap : 0)) * NPM + C_SX + ch0); }
    return r;
}
__device__ __forceinline__ void ssd_conv_fin(const ConvIn& in, const LAS float* cws, int bc, int t, int ch0, float* o) {
    const int pos = (bc & 127) * 64 + t;
    { const f32x4 b0 = *(const LAS f32x4*)(cws + 4096 + ch0), b1 = *(const LAS f32x4*)(cws + 4096 + ch0 + 4);
#pragma unroll
      for (int i = 0; i < 4; ++i) { o[i] = b0[i]; o[4 + i] = b1[i]; } }
#pragma unroll
    for (int tap = 0; tap < 4; ++tap) { const bool inr = pos - 3 + tap >= 0; float x[8]; unpack8(in.x[tap], x);
        const f32x4 w0 = *(const LAS f32x4*)(cws + tap * 1024 + ch0), w1 = *(const LAS f32x4*)(cws + tap * 1024 + ch0 + 4);
#pragma unroll
        for (int i = 0; i < 4; ++i) { o[i] += w0[i] * (inr ? x[i] : 0.f); o[4 + i] += w1[i] * (inr ? x[4 + i] : 0.f); } }
#pragma unroll
    for (int i = 0; i < 8; ++i) o[i] = siluf_(o[i]);
}
__device__ __forceinline__ void ssd_conv_weights(const Ctx& C, const GAS float* cw, const GAS float* cb, LAS float* cws) {
    for (int q = C.tid * 4; q < 5120; q += NTHR * 4) *(LAS f32x4*)(cws + q) = (q < 4096) ? *(const GAS f32x4*)(cw + q) : *(const GAS f32x4*)(cb + (q - 4096));
}
PH_HEAVY void ph_ssd_a(const Ctx C, ArgsP a, int l) {
    const GAS bf16* P = (const GAS bf16*)(C.ws + WS_P); GAS bf16* SST = (GAS bf16*)(C.ws + WS_SST); GAS float* SDT = (GAS float*)(C.ws + WS_SDT); GAS float* SAC = (GAS float*)(C.ws + WS_SACUM); GAS float* SCD = (GAS float*)(C.ws + WS_SCDEC); GAS bf16* YSs = (GAS bf16*)(C.ws + WS_YS);
    const GAS float* cw = a->in[15] + (size_t)l * 4 * 1024; const GAS float* cb = a->in[16] + (size_t)l * 1024; const GAS float* dtb = a->in[17] + (size_t)l * 8; const GAS float* alog = a->in[18] + (size_t)l * 8;
    LB BT = (LB)C.lds; LB XDT = (LB)(C.lds + 18432); LF dtv = (LF)(C.lds + 55296); LF acu = dtv + 256; LF cws = (LF)(C.lds + 57344);
    WG_SYNC();
    ssd_conv_weights(C, cw, cb, cws);
    for (int it = C.bid; it < NBC * 2; it += C.G) {
        const int bc = it >> 1, g = it & 1; const int t = C.tid >> 3, cg = C.tid & 7;
        const ConvIn ib0 = ssd_conv_ld(P, bc, t, 512 + g * 128 + cg * 16), ib1 = ssd_conv_ld(P, bc, t, 512 + g * 128 + cg * 16 + 8);
        ConvIn ix[4];
#pragma unroll
        for (int hh = 0; hh < 4; ++hh) ix[hh] = ssd_conv_ld(P, bc, t, (4 * g + hh) * 64 + cg * 8);
        const int hw = 4 * g + (C.wave & 3); const size_t rowd = (size_t)bc * 64 + C.lane;
        const bf16 dtraw = P[rowd * NPM + C_SDT + hw]; const float dtb_ = dtb[hw], al_ = alog[hw];
        __builtin_amdgcn_sched_barrier(0);
        RW_BAR();
        if (C.wave < 4) { const float dt = softplusf_(bf2f(dtraw) + dtb_); float s = -__expf(al_) * dt;
#pragma unroll
            for (int o = 1; o < 64; o <<= 1) { const float nb_ = __shfl_up(s, o); if (C.lane >= o) s += nb_; }
            dtv[C.wave * 64 + C.lane] = dt; acu[C.wave * 64 + C.lane] = s; SDT[rowd * 8 + hw] = dt; SAC[rowd * 8 + hw] = s; if (C.lane == 63) SCD[(size_t)bc * 8 + hw] = __expf(s); }
        float xo[4][8];
        { float o[8];
          ssd_conv_fin(ib0, cws, bc, t, 512 + g * 128 + cg * 16, o);
#pragma unroll
          for (int i = 0; i < 8; ++i) BT[(cg * 16 + i) * 72 + t] = (bf16)f2bf(o[i]);
          ssd_conv_fin(ib1, cws, bc, t, 512 + g * 128 + cg * 16 + 8, o);
#pragma unroll
          for (int i = 0; i < 8; ++i) BT[(cg * 16 + 8 + i) * 72 + t] = (bf16)f2bf(o[i]); }
#pragma unroll
        for (int hh = 0; hh < 4; ++hh) { ssd_conv_fin(ix[hh], cws, bc, t, (4 * g + hh) * 64 + cg * 8, xo[hh]);
            *(GAS u32x4*)(YSs + ((size_t)bc * 64 + t) * 2048 + 1024 + (4 * g + hh) * 64 + cg * 8) = pack8(xo[hh]); }
        RW_BAR();
#pragma unroll
        for (int hh = 0; hh < 4; ++hh) { const float sc = dtv[hh * 64 + t] * __expf(acu[hh * 64 + 63] - acu[hh * 64 + t]);
#pragma unroll
            for (int i = 0; i < 8; ++i) XDT[hh * 4608 + (cg * 8 + i) * 72 + t] = (bf16)f2bf(xo[hh][i] * sc); }
        RW_BAR();
        { const int pt = C.wave >> 2, nt = C.wave & 3, n = C.lane & 31, hi = C.lane >> 5;
#pragma unroll
          for (int hh = 0; hh < 4; ++hh) { const size_t item8 = (size_t)bc * 8 + 4 * g + hh;
              f32x16 acc = zero16(); mma_nt<64>(acc, XDT + hh * 4608, 72, 32 * pt, BT, 72, 32 * nt, C.lane);
#pragma unroll
              for (int r = 0; r < 16; ++r) SST[(item8 * 64 + 32 * pt + crow(r, hi)) * 128 + 32 * nt + n] = (bf16)f2bf(acc[r]); } }
    }
    WG_SYNC();
}
PH_FN void ssd_scan_part(const Ctx C, int part) {
    GAS unsigned* SST = (GAS unsigned*)(C.ws + WS_SST); const GAS float* SCD = (const GAS float*)(C.ws + WS_SCDEC);
    const int part_ = __builtin_amdgcn_readfirstlane(part), chain = part_ >> 3, idx = (part_ & 7) * NTHR + C.tid, b = chain >> 3, hd = chain & 7;
    float s0 = 0.f, s1 = 0.f;
    unsigned tA[8], tB[8]; float dA[8], dB[8];
    GAS unsigned* gp = SST + ((size_t)(b * NCH) * 8 + hd) * 4096 + idx; const GAS float* lp = SCD + (size_t)(b * NCH) * 8 + hd;
#define SS_LOAD(T, D, c0_) do { GAS unsigned* g_ = gp + (size_t)(c0_) * 32768; const GAS float* l_ = lp + (size_t)(c0_) * 8; _Pragma("unroll") for (int i = 0; i < 8; ++i) { T[i] = g_[i * 32768]; D[i] = l_[i * 8]; } } while (0)
#define SS_PROC(T, D, c0_) do { GAS unsigned* g_ = gp + (size_t)(c0_) * 32768; _Pragma("unroll") for (int i = 0; i < 8; ++i) { g_[i * 32768] = pk2(s0, s1); s0 = D[i] * s0 + bflo(T[i]); s1 = D[i] * s1 + bfhi(T[i]); } } while (0)
    SS_LOAD(tA, dA, 0);
#pragma unroll 1
    for (int c0 = 0; c0 < NCH; c0 += 16) { SS_LOAD(tB, dB, c0 + 8); SS_PROC(tA, dA, c0); if (c0 + 16 < NCH) SS_LOAD(tA, dA, c0 + 16); SS_PROC(tB, dB, c0 + 8); }
#undef SS_LOAD
#undef SS_PROC
}
PH_HEAVY void ph_ssd_c(const Ctx C, ArgsP a, int l) {
    const GAS bf16* P = (const GAS bf16*)(C.ws + WS_P); const GAS bf16* SST = (const GAS bf16*)(C.ws + WS_SST); const GAS float* SDT = (const GAS float*)(C.ws + WS_SDT); const GAS float* SAC = (const GAS float*)(C.ws + WS_SACUM); GAS bf16* YS = (GAS bf16*)(C.ws + WS_YS);
    const GAS float* cw = a->in[15] + (size_t)l * 4 * 1024; const GAS float* cb = a->in[16] + (size_t)l * 1024; const GAS float* dpar = a->in[19] + (size_t)l * 8; const GAS float* snorm = a->in[20] + (size_t)l * 512;
    LB BN = (LB)C.lds; LB CN = (LB)(C.lds + 17408); LF CB = (LF)(C.lds + 34816); LF dtv = (LF)(C.lds + 123904); LF acu = dtv + 128; LF PSQ = (LF)(C.lds + 124928); LF cwt = (LF)(C.lds + 125952);
    const int hs = C.wave >> 2;
    LB SCw = (LB)(C.lds + 52224 + hs * 35840); LB XSTw = SCw + 64 * 72; LB HPw = XSTw + 64 * 72;
    WG_SYNC();
    { const int g0 = C.bid & 1, j = C.tid & 255, ch = (j < 128 ? 512 + g0 * 128 + j : 768 + g0 * 128 + (j - 128));
      if (C.tid < 256) { cwt[j] = cw[ch]; cwt[256 + j] = cw[1024 + ch]; cwt[1024 + j] = cb[ch]; } else { cwt[512 + j] = cw[2048 + ch]; cwt[768 + j] = cw[3072 + ch]; } }
    for (int it = C.bid; it < NBC * 2; it += C.G) {
        const int bc = it >> 1, g = it & 1;
        const int t = C.tid >> 3, cg = C.tid & 7, n = C.lane & 31, hi = C.lane >> 5;
        ConvIn ibc[4];
#pragma unroll
        for (int q = 0; q < 4; ++q) ibc[q] = ssd_conv_ld(P, bc, t, 512 + (q >> 1) * 256 + g * 128 + cg * 16 + (q & 1) * 8);
        u32x4 xw[4];
#pragma unroll
        for (int hh = 0; hh < 4; ++hh) xw[hh] = *(const GAS u32x4*)(YS + ((size_t)bc * 64 + t) * 2048 + 1024 + (4 * g + hh) * 64 + cg * 8);
        u32x4 hq[2][4]; float dq[2][2];
#define SSC_LD(hp_) do { _Pragma("unroll") for (int s_ = 0; s_ < 2; ++s_) { const size_t item8_ = (size_t)bc * 8 + 4 * g + 2 * (hp_) + s_; const GAS bf16* sp_ = SST + (item8_ * 64 + (C.tid >> 3)) * 128 + (C.tid & 7) * 16; \
            hq[hp_][2 * s_] = *(const GAS u32x4*)sp_; hq[hp_][2 * s_ + 1] = *(const GAS u32x4*)(sp_ + 8); } \
          { const int s_ = (C.tid >> 6) & 1, i_ = C.tid & 63, hd_ = 4 * g + 2 * (hp_) + s_; const size_t row_ = (size_t)bc * 64 + i_; dq[hp_][0] = SDT[row_ * 8 + hd_]; dq[hp_][1] = SAC[row_ * 8 + hd_]; } } while (0)
        SSC_LD(0);
        __builtin_amdgcn_sched_barrier(0);
        RW_BAR();
        { float o[8];
#pragma unroll
          for (int q = 0; q < 4; ++q) { const int lj = (q >> 1) * 128 + cg * 16 + (q & 1) * 8; const int pos = (bc & 127) * 64 + t;
              { const f32x4 b0 = *(const LAS f32x4*)(cwt + 1024 + lj), b1 = *(const LAS f32x4*)(cwt + 1024 + lj + 4);
#pragma unroll
                for (int i = 0; i < 4; ++i) { o[i] = b0[i]; o[4 + i] = b1[i]; } }
#pragma unroll
              for (int tap = 0; tap < 4; ++tap) { const bool inr = pos - 3 + tap >= 0; float x[8]; unpack8(ibc[q].x[tap], x);
                  const f32x4 w0 = *(const LAS f32x4*)(cwt + tap * 256 + lj), w1 = *(const LAS f32x4*)(cwt + tap * 256 + lj + 4);
#pragma unroll
                  for (int i = 0; i < 4; ++i) { o[i] += w0[i] * (inr ? x[i] : 0.f); o[4 + i] += w1[i] * (inr ? x[4 + i] : 0.f); } }
#pragma unroll
              for (int i = 0; i < 8; ++i) o[i] = siluf_(o[i]);
              *(LAS u32x4*)(((q >> 1) ? CN : BN) + t * 136 + cg * 16 + (q & 1) * 8) = pack8(o); } }
        RW_BAR();
        if (C.wave < 4) {
            const int it_ = C.wave >> 1, jt = C.wave & 1;
            f32x16 acc = zero16(); mma_nt<128>(acc, CN, 136, 32 * it_, BN, 136, 32 * jt, C.lane);
#pragma unroll
            for (int r = 0; r < 16; ++r) CB[(32 * it_ + crow(r, hi)) * 68 + 32 * jt + n] = acc[r];
        }
        float yk[2][16]; float ssq = 0.f;
        const int pt = (C.wave >> 1) & 1, it2 = C.wave & 1;
#pragma unroll
        for (int hp = 0; hp < 2; ++hp) {
            RW_BAR();
            if (C.tid < 128) { dtv[C.tid] = dq[hp][0]; acu[C.tid] = dq[hp][1]; }
#pragma unroll
            for (int s = 0; s < 2; ++s) { const int hd = 4 * g + 2 * hp + s; const size_t item8 = (size_t)bc * 8 + hd; LB XSTs = (LB)(C.lds + 52224 + s * 35840) + 64 * 72; LB HPs = XSTs + 64 * 72;
                { const u32x4 xq = xw[2 * hp + s]; const unsigned xv[4] = {xq.x, xq.y, xq.z, xq.w};
#pragma unroll
                  for (int i = 0; i < 4; ++i) { XSTs[(cg * 8 + 2 * i) * 72 + t] = (bf16)(xv[i] & 0xffffu); XSTs[(cg * 8 + 2 * i + 1) * 72 + t] = (bf16)(xv[i] >> 16); } }
                const int p = C.tid >> 3, n0 = (C.tid & 7) * 16; (void)item8;
                *(LAS u32x4*)(HPs + p * 136 + n0) = hq[hp][2 * s]; *(LAS u32x4*)(HPs + p * 136 + n0 + 8) = hq[hp][2 * s + 1]; }
            if (hp == 0) SSC_LD(1);
            RW_BAR();
#pragma unroll
            for (int s = 0; s < 2; ++s) { LB SCs = (LB)(C.lds + 52224 + s * 35840); const float ai = acu[s * 64 + t]; float o[8];
#pragma unroll
                for (int jj = 0; jj < 8; ++jj) { const int j = 8 * cg + jj; o[jj] = (j <= t) ? CB[t * 68 + j] * __expf(ai - acu[s * 64 + j]) * dtv[s * 64 + j] : 0.f; }
                *(LAS u32x4*)(SCs + t * 72 + 8 * cg) = pack8(o); }
            RW_BAR();
            {
                const int hd = 4 * g + 2 * hp + hs; const int i = 32 * it2 + n; const size_t row = (size_t)bc * 64 + i; const float dh = dpar[hd];
                u32x2 zq[4];
#pragma unroll
                for (int q4 = 0; q4 < 4; ++q4) zq[q4] = *(const GAS u32x2*)(P + row * NPM + C_SZ + hd * 64 + 32 * pt + 8 * q4 + 4 * hi);
                __builtin_amdgcn_sched_barrier(0);
                f32x16 acc = zero16();
                mma_nt<128>(acc, HPw, 136, 32 * pt, CN, 136, 32 * it2, C.lane);
                const float ea = __expf(acu[hs * 64 + i]);
#pragma unroll
                for (int r = 0; r < 16; ++r) acc[r] *= ea;
                mma_nt<64>(acc, XSTw, 72, 32 * pt, SCw, 72, 32 * it2, C.lane);
#pragma unroll
                for (int q4 = 0; q4 < 4; ++q4) { const int p0 = 32 * pt + 8 * q4 + 4 * hi;
                    const u32x2 zw = zq[q4]; const float zf[4] = {bflo(zw.x), bfhi(zw.x), bflo(zw.y), bfhi(zw.y)};
#pragma unroll
                    for (int e = 0; e < 4; ++e) { const float xs = bf2f(XSTw[(p0 + e) * 72 + i]); const float v = (acc[4 * q4 + e] + dh * xs) * siluf_(zf[e]); yk[hp][4 * q4 + e] = v; ssq += v * v; } }
            }
        }
        { ssq += __shfl_xor(ssq, 32); if (hi == 0) PSQ[(32 * it2 + n) * 4 + pt * 2 + hs] = ssq; }
        RW_BAR();
        {   const int i = 32 * it2 + n; const f32x4 ps = *(const LAS f32x4*)(PSQ + i * 4); const float rs = 1.0f / sqrtf(((ps[0] + ps[1]) + (ps[2] + ps[3])) * (1.0f / 256.0f) + EPS); const size_t row = (size_t)bc * 64 + i;
#pragma unroll
            for (int hp = 0; hp < 2; ++hp)
#pragma unroll
                for (int q4 = 0; q4 < 4; ++q4) { const int ch = g * 256 + (2 * hp + hs) * 64 + 32 * pt + 8 * q4 + 4 * hi; const f32x4 sn = *(const GAS f32x4*)(snorm + ch);
                    u32x2 w; w.x = pk2(yk[hp][4 * q4] * rs * sn[0], yk[hp][4 * q4 + 1] * rs * sn[1]); w.y = pk2(yk[hp][4 * q4 + 2] * rs * sn[2], yk[hp][4 * q4 + 3] * rs * sn[3]);
                    *(GAS u32x2*)(YS + row * 2048 + 1024 + ch) = w; }
        }
    }
    WG_SYNC();
}
#undef SSC_LD

struct LerpIn { u32x4 x, xp; };
__device__ __forceinline__ LerpIn rw_lerp_ld(const GAS bf16* P, size_t row, bool first, int c0) {
    LerpIn r; r.x = *(const GAS u32x4*)(P + row * NPM + C_RR + c0); r.xp = *(const GAS u32x4*)(P + (row - (first ? 0 : 1)) * NPM + C_RR + c0); return r; }
__device__ __forceinline__ void rw_lerp_fin(const LerpIn& in, bool first, const LAS float* mus, float* o) {
    float x[8], xp[8]; unpack8(in.x, x); unpack8(in.xp, xp); const f32x4 m0 = *(const LAS f32x4*)mus, m1 = *(const LAS f32x4*)(mus + 4);
#pragma unroll
    for (int i = 0; i < 8; ++i) { const float d = (first ? 0.f : xp[i]) - x[i]; o[i] = x[i] + d * (i < 4 ? m0[i] : m1[i - 4]); }
}
#define RW_WFRAG(WT_, K_, nt_, s_) (*(const GAS pg8::bf16x8*)((WT_) + (size_t)(head * 64 + 32 * (nt_) + n) * (K_) + 16 * (s_) + 8 * hi))
#define RWP_PTRS \
    const GAS bf16* P = (const GAS bf16*)(C.ws + WS_P); \
    GAS float* RWW = (GAS float*)(C.ws + WS_RWW); GAS bf16* RWR = (GAS bf16*)(C.ws + WS_RWR); GAS bf16* RWK = (GAS bf16*)(C.ws + WS_RWK); GAS bf16* RWV = (GAS bf16*)(C.ws + WS_RWV); GAS bf16* RWKK = (GAS bf16*)(C.ws + WS_RWKK); GAS bf16* RWB = (GAS bf16*)(C.ws + WS_RWB); GAS bf16* RWG = (GAS bf16*)(C.ws + WS_RWG); \
    const GAS bf16* W2T = (const GAS bf16*)(C.ws + WS_RW2T); const GAS bf16* A2T = W2T + 512 * 64; const GAS bf16* G2T = A2T + 512 * 64;       \
    const GAS float* mu = a->in[21] + (size_t)l * 1792; const GAS float* w0 = a->in[22] + (size_t)l * 512; const GAS float* a0 = a->in[24] + (size_t)l * 512; \
    const GAS float* k_k = a->in[27] + (size_t)l * 512; const GAS float* k_a = a->in[28] + (size_t)l * 512; \
    LB WLb = (LB)C.lds; LB ALb = (LB)(C.lds + 9216); LB GLb = (LB)(C.lds + 18432);         \
    LB KX = (LB)(C.lds + 35840); LF w0s = (LF)(C.lds + 102400); LF a0s = w0s + 512; LF kks = a0s + 512; LF kas = kks + 512; LF INVs = kas + 512; LF mus = INVs + 512;     \
    (void)mus; (void)KX; (void)w0s; (void)a0s; (void)kks; (void)kas; (void)INVs; \
    (void)P; (void)RWW; (void)RWR; (void)RWK; (void)RWV; (void)RWKK; (void)RWB; (void)RWG; (void)W2T; (void)A2T; (void)G2T; (void)mu; (void)w0; (void)a0; (void)k_k; (void)k_a; (void)WLb; (void)ALb; (void)GLb;
#define RWP_LANE const int head = C.wave, n = C.lane & 31, hi = C.lane >> 5; const size_t row0 = (size_t)bc * 64 + 32 * tt; (void)row0;
PH_FN void rwp_stage(const Ctx C, ArgsP a, int l, int bc) {
    RWP_PTRS
    const int t = C.tid >> 3, cg = C.tid & 7; const size_t row = (size_t)bc * 64 + t; const bool first = ((bc & 127) == 0) && (t == 0);
    const LerpIn iw = rw_lerp_ld(P, row, first, 1536 + cg * 8), ia = rw_lerp_ld(P, row, first, 1600 + cg * 8), ig0 = rw_lerp_ld(P, row, first, 1664 + cg * 16), ig1 = rw_lerp_ld(P, row, first, 1664 + cg * 16 + 8);
    LerpIn cr = rw_lerp_ld(P, row, first, cg * 8), cv = rw_lerp_ld(P, row, first, 1024 + cg * 8), ck = rw_lerp_ld(P, row, first, 512 + cg * 8);
    const int q = C.tid * 4; const f32x4 pv = *(const GAS f32x4*)((q < 512 ? w0 : q < 1024 ? a0 - 512 : q < 1536 ? k_k - 1024 : k_a - 1536) + q); const f32x4 mv = *(const GAS f32x4*)(mu + (C.tid < 448 ? q : 0));
    WG_SYNC();
    *(LAS f32x4*)(w0s + q) = pv; if (C.tid < 448) *(LAS f32x4*)(mus + q) = mv;
    WG_SYNC();
    { float o[8];
      rw_lerp_fin(iw, first, mus + 1536 + cg * 8, o);
#pragma unroll
      for (int i = 0; i < 8; ++i) o[i] = tanhf(o[i]);
      *(LAS u32x4*)(WLb + t * 72 + cg * 8) = pack8(o);
      rw_lerp_fin(ia, first, mus + 1600 + cg * 8, o); *(LAS u32x4*)(ALb + t * 72 + cg * 8) = pack8(o);
      rw_lerp_fin(ig0, first, mus + 1664 + cg * 16, o);
#pragma unroll
      for (int i = 0; i < 8; ++i) o[i] = sigmoidf_(o[i]);
      *(LAS u32x4*)(GLb + t * 136 + cg * 16) = pack8(o);
      rw_lerp_fin(ig1, first, mus + 1664 + cg * 16 + 8, o);
#pragma unroll
      for (int i = 0; i < 8; ++i) o[i] = sigmoidf_(o[i]);
      *(LAS u32x4*)(GLb + t * 136 + cg * 16 + 8) = pack8(o);
#pragma unroll
      for (int j = 0; j < 8; ++j) { const int c = j * 64 + cg * 8;
          LerpIn nr = cr, nv = cv, nk = ck;
          if (j < 7) { nr = rw_lerp_ld(P, row, first, c + 64); nv = rw_lerp_ld(P, row, first, 1024 + c + 64); nk = rw_lerp_ld(P, row, first, 512 + c + 64); }
          rw_lerp_fin(cr, first, mus + c, o); *(GAS u32x4*)(RWR + row * 512 + c) = pack8(o);
          rw_lerp_fin(cv, first, mus + 1024 + c, o); *(GAS u32x4*)(RWV + row * 512 + c) = pack8(o);
          rw_lerp_fin(ck, first, mus + 512 + c, o); *(LAS u32x4*)(KX + t * 520 + c) = pack8(o);
          const f32x4 k0 = *(const LAS f32x4*)(kks + c), k1 = *(const LAS f32x4*)(kks + c + 4); float ss = 0.f;
#pragma unroll
          for (int i = 0; i < 4; ++i) { const float q0 = o[i] * k0[i], q1 = o[4 + i] * k1[i]; ss += q0 * q0 + q1 * q1; }
          ss += __shfl_xor(ss, 1); ss += __shfl_xor(ss, 2); ss += __shfl_xor(ss, 4);
          if (cg == 0) INVs[t * 8 + j] = 1.0f / fmaxf(sqrtf(ss), 1e-12f);
          cr = nr; cv = nv; ck = nk; } }
    WG_SYNC();
}
PH_FN void rwp_w(const Ctx C, ArgsP a, int l, int bc, int tt) {
    RWP_PTRS RWP_LANE
    pg8::bf16x8 wf[2][4]; f32x16 c[2] = {zero16(), zero16()};
#pragma unroll
    for (int nt = 0; nt < 2; ++nt)
#pragma unroll
        for (int s4 = 0; s4 < 4; ++s4) wf[nt][s4] = RW_WFRAG(W2T, 64, nt, s4);
#pragma unroll
    for (int s4 = 0; s4 < 4; ++s4) { const pg8::bf16x8 af = frag32(WLb, 72, 32 * tt, 16 * s4, C.lane);
#pragma unroll
        for (int nt = 0; nt < 2; ++nt) c[nt] = __builtin_amdgcn_mfma_f32_32x32x16_bf16(af, wf[nt][s4], c[nt], 0, 0, 0); }
#pragma unroll
    for (int nt = 0; nt < 2; ++nt) { const int ch = head * 64 + 32 * nt + n; const float w0c = w0s[ch];
#pragma unroll
        for (int r = 0; r < 16; ++r) RWW[(row0 + crow(r, hi)) * 512 + ch] = -0.606531f * sigmoidf_(w0c + c[nt][r]); }
}
PH_FN void rwp_g(const Ctx C, ArgsP a, int l, int bc, int tt) {
    RWP_PTRS RWP_LANE
    pg8::bf16x8 wf[2][8]; f32x16 c[2] = {zero16(), zero16()};
#pragma unroll
    for (int nt = 0; nt < 2; ++nt)
#pragma unroll
        for (int s8 = 0; s8 < 8; ++s8) wf[nt][s8] = RW_WFRAG(G2T, 128, nt, s8);
#pragma unroll
    for (int s8 = 0; s8 < 8; ++s8) { const pg8::bf16x8 af = frag32(GLb, 136, 32 * tt, 16 * s8, C.lane);
#pragma unroll
        for (int nt = 0; nt < 2; ++nt) c[nt] = __builtin_amdgcn_mfma_f32_32x32x16_bf16(af, wf[nt][s8], c[nt], 0, 0, 0); }
#pragma unroll
    for (int nt = 0; nt < 2; ++nt) { const int ch = head * 64 + 32 * nt + n;
#pragma unroll
        for (int r = 0; r < 16; ++r) RWG[(row0 + crow(r, hi)) * 512 + ch] = (bf16)f2bf(c[nt][r]); }
}
PH_FN void rwp_ak(const Ctx C, ArgsP a, int l, int bc, int tt) {
    RWP_PTRS RWP_LANE
    pg8::bf16x8 wf[2][4]; f32x16 c[2] = {zero16(), zero16()};
#pragma unroll
    for (int nt = 0; nt < 2; ++nt)
#pragma unroll
        for (int s4 = 0; s4 < 4; ++s4) wf[nt][s4] = RW_WFRAG(A2T, 64, nt, s4);
#pragma unroll
    for (int s4 = 0; s4 < 4; ++s4) { const pg8::bf16x8 af = frag32(ALb, 72, 32 * tt, 16 * s4, C.lane);
#pragma unroll
        for (int nt = 0; nt < 2; ++nt) c[nt] = __builtin_amdgcn_mfma_f32_32x32x16_bf16(af, wf[nt][s4], c[nt], 0, 0, 0); }
#pragma unroll
    for (int nt = 0; nt < 2; ++nt) { const int ch = head * 64 + 32 * nt + n; const float a0c = a0s[ch], kkc = kks[ch], kac = kas[ch];
#pragma unroll
        for (int r = 0; r < 16; ++r) { const int tl = 32 * tt + crow(r, hi); const float al = sigmoidf_(a0c + c[nt][r]), x = bf2f(KX[tl * 520 + ch]), kkn = x * kkc * INVs[tl * 8 + head];
            const size_t g = ((size_t)bc * 64 + tl) * 512 + ch;
            RWKK[g] = (bf16)f2bf(kkn); RWB[g] = (bf16)f2bf(kkn * al); RWK[g] = (bf16)f2bf(x * (1.0f + (al - 1.0f) * kac)); } }
}
#undef RW_WFRAG
#undef RWP_PTRS
#undef RWP_LANE
__device__ __forceinline__ void ph_rw_prep(const Ctx& C, ArgsP a, int l) {
    for (int bc = C.bid; bc < NBC; bc += C.G) { rwp_stage(C, a, l, bc);
#pragma unroll 1
        for (int tt = 0; tt < 2; ++tt) { rwp_w(C, a, l, bc, tt); rwp_g(C, a, l, bc, tt); rwp_ak(C, a, l, bc, tt); } }
    WG_SYNC();
}
PH_FN void ph_rw_out(const Ctx C, ArgsP a, int l) {
    const GAS bf16* RWR = (const GAS bf16*)(C.ws + WS_RWR); const GAS bf16* RWK = (const GAS bf16*)(C.ws + WS_RWK); const GAS bf16* RWV = (const GAS bf16*)(C.ws + WS_RWV); const GAS bf16* RWG = (const GAS bf16*)(C.ws + WS_RWG); const GAS bf16* RWY = (const GAS bf16*)(C.ws + WS_RWY);
    GAS bf16* YS = (GAS bf16*)(C.ws + WS_YS);
    const GAS float* r_k = a->in[29] + (size_t)l * 512; const GAS float* nw = a->in[30] + (size_t)l * 512; const GAS float* nb = a->in[31] + (size_t)l * 512;
    const int gw = C.bid * NWAVES + C.wave, NGW = C.G * NWAVES, c0 = C.lane * 8;
    float rk[8], w8[8], b8[8];
#pragma unroll
    for (int i = 0; i < 8; ++i) { rk[i] = r_k[c0 + i]; w8[i] = nw[c0 + i]; b8[i] = nb[c0 + i]; }
    u32x4 nyw[2], nrw[2], nkw[2], nvw[2], ngw[2];
#define RWO_LD(r0_) do { _Pragma("unroll") for (int u = 0; u < 2; ++u) { const size_t g = (size_t)((r0_) + u) * 512 + c0; nyw[u] = *(const GAS u32x4*)(RWY + g); nrw[u] = *(const GAS u32x4*)(RWR + g); nkw[u] = *(const GAS u32x4*)(RWK + g); nvw[u] = *(const GAS u32x4*)(RWV + g); ngw[u] = *(const GAS u32x4*)(RWG + g); } } while (0)
    if (gw * 2 < M) RWO_LD(gw * 2);
#pragma unroll 1
    for (int row0 = gw * 2; row0 < M; row0 += NGW * 2) {
        u32x4 yw[2], rw[2], kw[2], vw[2], gw4[2];
#pragma unroll
        for (int u = 0; u < 2; ++u) { yw[u] = nyw[u]; rw[u] = nrw[u]; kw[u] = nkw[u]; vw[u] = nvw[u]; gw4[u] = ngw[u]; }
        if (row0 + NGW * 2 < M) RWO_LD(row0 + NGW * 2);
#pragma unroll
        for (int u = 0; u < 2; ++u) { float y[8], r[8], k[8], v[8], gg[8], o[8]; unpack8(yw[u], y); unpack8(rw[u], r); unpack8(kw[u], k); unpack8(vw[u], v); unpack8(gw4[u], gg);
            float s = 0.f, bs = 0.f;
#pragma unroll
            for (int i = 0; i < 8; ++i) { s += y[i]; bs += r[i] * k[i] * rk[i]; }
            s += __shfl_xor(s, 1); s += __shfl_xor(s, 2); s += __shfl_xor(s, 4); bs += __shfl_xor(bs, 1); bs += __shfl_xor(bs, 2); bs += __shfl_xor(bs, 4);
            const float mu = s * (1.0f / 64.0f); float q = 0.f;
#pragma unroll
            for (int i = 0; i < 8; ++i) { y[i] -= mu; q += y[i] * y[i]; }
            q += __shfl_xor(q, 1); q += __shfl_xor(q, 2); q += __shfl_xor(q, 4);
            const float rs = 1.0f / sqrtf(q * (1.0f / 64.0f) + 64e-5f);
#pragma unroll
            for (int i = 0; i < 8; ++i) o[i] = (y[i] * rs * w8[i] + b8[i] + bs * v[i]) * gg[i];
            *(GAS u32x4*)(YS + (size_t)(row0 + u) * 2048 + 1536 + c0) = pack8(o); }
    }
#undef RWO_LD
}

__device__ __forceinline__ int pi_swap23(int i) { return (i & ~12) | ((i & 4) << 1) | ((i & 8) >> 1); }
__device__ __forceinline__ void da_unit(const Ctx& C, const Args& a, int l, int b, int h, int jq, float lam, float oml) {
    const GAS bf16* P = (const GAS bf16*)(C.ws + WS_P); GAS bf16* YS = (GAS bf16*)(C.ws + WS_YS);
    const GAS float* dnorm = (const GAS float*)a.in[11] + (size_t)l * 128;
    const int comp = C.wave >> 2, wq = C.wave & 3, q = C.lane & 31, hi = C.lane >> 5;
    const size_t qrow = (size_t)b * SEQ + jq * 128 + wq * 32 + q;
    pg8::bf16x8 qf[4];
#pragma unroll
    for (int d0 = 0; d0 < 4; ++d0) qf[d0] = *(const GAS pg8::bf16x8*)(P + qrow * NPM + C_DAQ + h * 128 + comp * 64 + 16 * d0 + 8 * hi);
    const int ntile = 2 * jq + 2, my_last = 2 * jq + (wq >= 2 ? 1 : 0);
    f32x16 O[4];
#pragma unroll
    for (int db = 0; db < 4; ++db)
#pragma unroll
        for (int r = 0; r < 16; ++r) O[db][r] = 0.f;
    float mrun = 0.f, lrun = 0.f;
    f32x16 negm;
#pragma unroll
    for (int r = 0; r < 16; ++r) negm[r] = 0.f;
    const GAS bf16* kgb = P + (size_t)b * SEQ * NPM + C_DAK + h * 128 + C.wave * 8;
    const GAS bf16* vgb = P + (size_t)b * SEQ * NPM + C_DAV + h * 128;
    const unsigned vslot_p = (unsigned)C.wave * 64u + (unsigned)C.lane, vrow_p = 8u * (vslot_p >> 7) + ((vslot_p >> 2) & 7u), vch_p = 4u * ((vslot_p >> 5) & 3u) + ((vslot_p & 3u) ^ ((vrow_p >> 2) & 3u));
    const unsigned koff = (unsigned)C.lane * (unsigned)(NPM * 2), voff = vrow_p * (unsigned)(NPM * 2) + vch_p * 16u;
    const unsigned lds0 = (unsigned)(size_t)C.lds;
    const unsigned kdst0 = lds0 + (unsigned)(C.wave >> 3) * 8192u + (unsigned)(C.wave & 7) * 1024u;
    const unsigned vdst0 = lds0 + 49152u + (unsigned)C.wave * 1024u;
    const unsigned vtr_c = 2u * ((unsigned)(C.lane >> 4) & 1u) + (((unsigned)C.lane & 3u) >> 1), vtr_q = ((unsigned)C.lane & 15u) >> 2;
    const unsigned vtb0 = 2048u * (unsigned)hi + 64u * vtr_q + 8u * ((unsigned)C.lane & 1u) + 16u * (vtr_c ^ ((2u * (unsigned)hi) & 3u));
    const unsigned vtb1 = 2048u * (unsigned)hi + 64u * (4u + vtr_q) + 8u * ((unsigned)C.lane & 1u) + 16u * (vtr_c ^ ((2u * (unsigned)hi + 1u) & 3u));
    typedef short v4i16_da __attribute__((ext_vector_type(4)));
#define DA_VTR(base_, off_) ({ const v4i16_da lo_ = __builtin_amdgcn_ds_read_tr16_b64_v4i16((LAS v4i16_da*)((base_) + vtb0 + (off_))), hi_ = __builtin_amdgcn_ds_read_tr16_b64_v4i16((LAS v4i16_da*)((base_) + vtb1 + (off_))); \
        (pg8::bf16x8)__builtin_shufflevector(lo_, hi_, 0, 1, 2, 3, 4, 5, 6, 7); })
    const int pq = pi_swap23(q);
    pg8::bf16x8 pb[4] = {};
    int ks = 0;
#define DA_ROT(x_) (((x_) == 32768) ? 0 : (x_) + 16384)
#define DA_GLDS(base_, off_, dst_) do { unsigned keep_; asm volatile("s_mov_b32 %0, m0\n\ts_mov_b32 m0, %3\n\ts_nop 0\n\tglobal_load_lds_dwordx4 %1, %2\n\ts_mov_b32 m0, %0" : "=&s"(keep_) : "v"(off_), "s"(base_), "s"((unsigned)__builtin_amdgcn_readfirstlane(dst_)) : "memory"); } while (0)
#define DA_DMA(tile_, kslot_) do { const GAS bf16* kp_ = kgb + (size_t)(tile_) * 64 * NPM; const GAS bf16* vp_ = vgb + (size_t)(tile_) * 64 * NPM; const unsigned kd_ = kdst0 + (unsigned)(kslot_), vd_ = vdst0 + (unsigned)((tile_) & 3) * 16384u; \
        DA_GLDS(kp_, koff, kd_); DA_GLDS(kp_ + 64, koff, kd_ + 8192u); DA_GLDS(vp_, voff, vd_); DA_GLDS(vp_ + 32 * NPM, voff, vd_ + 8192u); } while (0)
#define DA_STAGE(tile_) do { if ((tile_) + 1 < ntile) asm volatile("s_waitcnt vmcnt(4)" ::: "memory"); else asm volatile("s_waitcnt vmcnt(0)" ::: "memory"); RW_BAR(); if ((tile_) + 2 < ntile) DA_DMA((tile_) + 2, DA_ROT(DA_ROT(ks))); } while (0)
#define DA_QK(tile_) do { const LAS unsigned char* kb_ = C.lds + ks + comp * 8192 + hi * 1024 + pq * 16; pg8::bf16x8 ka_[8]; \
        _Pragma("unroll") for (int d0 = 0; d0 < 4; ++d0) { ka_[2 * d0] = *(const LAS pg8::bf16x8*)(kb_ + d0 * 2048); ka_[2 * d0 + 1] = *(const LAS pg8::bf16x8*)(kb_ + d0 * 2048 + 512); } \
        __builtin_amdgcn_sched_barrier(0); \
        p0 = __builtin_amdgcn_mfma_f32_32x32x16_bf16(ka_[0], qf[0], negm, 0, 0, 0); p1 = __builtin_amdgcn_mfma_f32_32x32x16_bf16(ka_[1], qf[0], negm, 0, 0, 0); \
        _Pragma("unroll") for (int d0 = 1; d0 < 4; ++d0) { p0 = __builtin_amdgcn_mfma_f32_32x32x16_bf16(ka_[2 * d0], qf[d0], p0, 0, 0, 0); p1 = __builtin_amdgcn_mfma_f32_32x32x16_bf16(ka_[2 * d0 + 1], qf[d0], p1, 0, 0, 0); } } while (0)
#define DA_PV(PB_, voff_) do { const LAS unsigned char* vb_ = C.lds + 49152 + (voff_); _Pragma("unroll") for (int db = 0; db < 4; ++db) _Pragma("unroll") for (int s = 0; s < 4; ++s) { \
            const pg8::bf16x8 vf_ = DA_VTR(vb_, 4096 * s + 512 * db); O[db] = __builtin_amdgcn_mfma_f32_32x32x16_bf16(vf_, PB_[s], O[db], 0, 0, 0); } } while (0)
#define DA_MX3(a_, b_, c_) __builtin_fmaxf(__builtin_fmaxf((a_), (b_)), (c_))
#define DA_SM_MAX(FIRST_, PBP_) do { \
        float ma = DA_MX3(p0[0], p0[1], p1[0]), mb = DA_MX3(p0[2], p0[3], p1[1]); ma = DA_MX3(ma, p1[2], p1[3]); \
        _Pragma("unroll") for (int r = 4; r < 16; r += 4) { ma = DA_MX3(ma, p0[r], p0[r + 1]); mb = DA_MX3(mb, p0[r + 2], p0[r + 3]); ma = DA_MX3(ma, p1[r], p1[r + 1]); mb = DA_MX3(mb, p1[r + 2], p1[r + 3]); } \
        float rm = __builtin_fmaxf(ma, mb); { const auto rr_ = __builtin_amdgcn_permlane32_swap(__float_as_uint(rm), __float_as_uint(rm), false, false); rm = __builtin_fmaxf(__uint_as_float(rr_[0]), __uint_as_float(rr_[1])); }   \
        if ((FIRST_) || __any(rm > 8.0f)) { const float dl = (FIRST_) ? rm : __builtin_fmaxf(rm, 0.f); mrun += dl; const float f = __builtin_amdgcn_exp2f(-dl); lrun *= f; \
            _Pragma("unroll") for (int r = 0; r < 16; ++r) { p0[r] -= dl; p1[r] -= dl; negm[r] = -mrun; } \
            _Pragma("unroll") for (int db = 0; db < 4; ++db) _Pragma("unroll") for (int r = 0; r < 16; ++r) O[db][r] *= f; \
            if (!(FIRST_)) { _Pragma("unroll") for (int s_ = 0; s_ < 4; ++s_) { const u32x4 w_ = __builtin_bit_cast(u32x4, PBP_[s_]); u32x4 o_; \
                o_.x = pk2(bflo(w_.x) * f, bfhi(w_.x) * f); o_.y = pk2(bflo(w_.y) * f, bfhi(w_.y) * f); o_.z = pk2(bflo(w_.z) * f, bfhi(w_.z) * f); o_.w = pk2(bflo(w_.w) * f, bfhi(w_.w) * f); PBP_[s_] = __builtin_bit_cast(pg8::bf16x8, o_); } } } } while (0)
#define DA_SM_EXP(PBO_) do { \
        _Pragma("unroll") for (int r = 0; r < 16; ++r) { p0[r] = __builtin_amdgcn_exp2f(p0[r]); p1[r] = __builtin_amdgcn_exp2f(p1[r]); } \
        { f32x2 s2 = {0.f, 0.f}; _Pragma("unroll") for (int r = 0; r < 16; r += 2) { s2 += (f32x2){p0[r], p0[r + 1]}; s2 += (f32x2){p1[r], p1[r + 1]}; } lrun += s2[0] + s2[1]; } \
        { u32x4 w; \
          w.x = pk2(p0[0], p0[1]); w.y = pk2(p0[2], p0[3]); w.z = pk2(p0[4], p0[5]); w.w = pk2(p0[6], p0[7]); PBO_[0] = __builtin_bit_cast(pg8::bf16x8, w); \
          w.x = pk2(p0[8], p0[9]); w.y = pk2(p0[10], p0[11]); w.z = pk2(p0[12], p0[13]); w.w = pk2(p0[14], p0[15]); PBO_[1] = __builtin_bit_cast(pg8::bf16x8, w); \
          w.x = pk2(p1[0], p1[1]); w.y = pk2(p1[2], p1[3]); w.z = pk2(p1[4], p1[5]); w.w = pk2(p1[6], p1[7]); PBO_[2] = __builtin_bit_cast(pg8::bf16x8, w); \
          w.x = pk2(p1[8], p1[9]); w.y = pk2(p1[10], p1[11]); w.z = pk2(p1[12], p1[13]); w.w = pk2(p1[14], p1[15]); PBO_[3] = __builtin_bit_cast(pg8::bf16x8, w); } } while (0)
#define DA_VADDR(i_) (((i_) & 3) * 4096 + ((i_) >> 2) * 512)
#define DA_PV_EXP(PBP_, voff_, PBO_) do { const LAS unsigned char* vb_ = C.lds + 49152 + (voff_); f32x2 s2_ = {0.f, 0.f}; unsigned pw_[16]; \
        pg8::bf16x8 vq_[4];   \
        vq_[0] = DA_VTR(vb_, DA_VADDR(0)); vq_[1] = DA_VTR(vb_, DA_VADDR(1)); vq_[2] = DA_VTR(vb_, DA_VADDR(2)); \
        _Pragma("unroll") for (int i_ = 0; i_ < 16; ++i_) { const int db_ = i_ >> 2, s_ = i_ & 3; \
            if (i_ + 3 < 16) vq_[(i_ + 3) & 3] = DA_VTR(vb_, DA_VADDR(i_ + 3)); \
            O[db_] = __builtin_amdgcn_mfma_f32_32x32x16_bf16(vq_[i_ & 3], PBP_[s_], O[db_], 0, 0, 0); \
            float e0_, e1_; if (i_ < 8) { e0_ = __builtin_amdgcn_exp2f(p0[2 * i_]); e1_ = __builtin_amdgcn_exp2f(p0[2 * i_ + 1]); } else { e0_ = __builtin_amdgcn_exp2f(p1[2 * i_ - 16]); e1_ = __builtin_amdgcn_exp2f(p1[2 * i_ - 15]); } \
            s2_ += (f32x2){e0_, e1_}; pw_[i_] = pk2(e0_, e1_); \
            __builtin_amdgcn_sched_barrier(0); } \
        lrun += s2_[0] + s2_[1]; \
        _Pragma("unroll") for (int k_ = 0; k_ < 4; ++k_) { u32x4 w_; w_.x = pw_[4 * k_]; w_.y = pw_[4 * k_ + 1]; w_.z = pw_[4 * k_ + 2]; w_.w = pw_[4 * k_ + 3]; PBO_[k_] = __builtin_bit_cast(pg8::bf16x8, w_); } } while (0)
    f32x16 p0, p1;
    if (comp == 0) __builtin_amdgcn_s_setprio(1);
    DA_DMA(0, 0); DA_DMA(1, 16384);
    DA_STAGE(0); DA_QK(0); DA_SM_MAX(true, pb); DA_SM_EXP(pb);
    for (int tile = 1; tile <= my_last; ++tile) {
        ks = DA_ROT(ks);
        DA_STAGE(tile); DA_QK(tile); DA_SM_MAX(false, pb);
        DA_PV_EXP(pb, ((tile - 1) & 3) * 16384, pb);
    }
    if (my_last < ntile - 1) { ks = DA_ROT(ks); DA_STAGE(ntile - 1); }
    __builtin_amdgcn_s_setprio(0);
    DA_PV(pb, (my_last & 3) * 16384);
#undef DA_GLDS
#undef DA_ROT
#undef DA_DMA
#undef DA_STAGE
#undef DA_QK
#undef DA_PV
#undef DA_MX3
#undef DA_SM_MAX
#undef DA_SM_EXP
#undef DA_PV_EXP
#undef DA_VADDR
#undef DA_VTR
    const float ltot = lrun + __shfl_xor(lrun, 32); const float inv = 1.0f / ltot;
    WG_SYNC();
    LF X = (LF)C.lds + (wq * 32 + q) * 132;
    if (comp == 1) {
        const float sc = inv * lam;
#pragma unroll
        for (int db = 0; db < 4; ++db)
#pragma unroll
            for (int g4 = 0; g4 < 4; ++g4) *(LAS f32x4*)(X + 32 * db + 8 * g4 + 4 * hi) = (f32x4){O[db][4 * g4] * sc, O[db][4 * g4 + 1] * sc, O[db][4 * g4 + 2] * sc, O[db][4 * g4 + 3] * sc};
    }
    WG_SYNC();
    if (comp == 0) {
        float ss = 0.f;
#pragma unroll
        for (int db = 0; db < 4; ++db)
#pragma unroll
            for (int g4 = 0; g4 < 4; ++g4) { const f32x4 x = *(const LAS f32x4*)(X + 32 * db + 8 * g4 + 4 * hi);
#pragma unroll
                for (int e = 0; e < 4; ++e) { const float v = O[db][4 * g4 + e] * inv - x[e]; O[db][4 * g4 + e] = v; ss += v * v; } }
        ss += __shfl_xor(ss, 32);
        const float rs = oml / sqrtf(ss * (1.0f / 128.0f) + EPS);
#pragma unroll
        for (int db = 0; db < 4; ++db)
#pragma unroll
            for (int g4 = 0; g4 < 4; ++g4) { const int d = 32 * db + 8 * g4 + 4 * hi; const f32x4 gn = *(const GAS f32x4*)(dnorm + d);
                u32x2 w; w.x = pk2(O[db][4 * g4] * rs * gn[0], O[db][4 * g4 + 1] * rs * gn[1]); w.y = pk2(O[db][4 * g4 + 2] * rs * gn[2], O[db][4 * g4 + 3] * rs * gn[3]);
                *(GAS u32x2*)(YS + qrow * 2048 + h * 128 + d) = w; }
    }
    WG_SYNC();
}
__device__ const signed char ATT_BINS30[30][3] = {{63,4,3}, {62,5,2}, {61,6,1}, {60,7,0}, {59,8,-1}, {58,9,-1}, {57,10,-1}, {56,11,-1}, {55,12,-1}, {54,13,-1}, {53,14,-1}, {52,15,-1}, {51,16,-1}, {50,17,-1}, {49,18,-1}, {48,19,-1}, {47,20,-1}, {46,21,-1}, {45,22,-1}, {44,23,-1}, {43,24,-1}, {42,25,-1}, {41,26,-1}, {40,27,-1}, {39,28,-1}, {38,29,-1}, {37,30,-1}, {36,31,-1}, {35,32,-1}, {34,33,-1}};
__device__ __forceinline__ int att_bin_unit(int bin, int i) { return i < 3 ? (int)ATT_BINS30[bin][i] : -1; }
__device__ __forceinline__ void ph_da_attn(const Ctx& C, const Args& a, int l, int bh, int bin) {
    const GAS float* q1 = (const GAS float*)a.in[7] + (size_t)l * 64; const GAS float* k1 = (const GAS float*)a.in[8] + (size_t)l * 64; const GAS float* q2 = (const GAS float*)a.in[9] + (size_t)l * 64; const GAS float* k2 = (const GAS float*)a.in[10] + (size_t)l * 64;
    float s1 = 0.f, s2 = 0.f;
    for (int i = 0; i < 64; ++i) { s1 += q1[i] * k1[i]; s2 += q2[i] * k2[i]; }
    int ll = l; asm volatile("" : "+s"(ll));
    const float lam_init = 0.8f - 0.6f * expf(-0.3f * (float)ll); const float lam_v = expf(s1) - expf(s2) + lam_init;
    const float lam = __uint_as_float(__builtin_amdgcn_readfirstlane(__float_as_uint(lam_v))), oml = __uint_as_float(__builtin_amdgcn_readfirstlane(__float_as_uint(1.0f - lam_init)));
    for (int i = 0; i < 12; ++i) { const int jq = att_bin_unit(bin, i); if (jq < 0) break; da_unit(C, a, l, bh >> 2, bh & 3, jq, lam, oml); }
}

PH_FN void ph_final(const Ctx C, ArgsP a) {
    const GAS float* ssq = (const GAS float*)(C.ws + WS_SSQ); const GAS float* fn = a->in[39]; const GAS bf16* hb = (const GAS bf16*)(C.ws + WS_HB);
    const int gw = C.bid * NWAVES + C.wave, NGW = C.G * NWAVES;
    for (int m = gw; m < M; m += NGW) { const float rs = pg8::row_rstd((const float*)ssq, m, M); GAS f32x4* orow = (GAS f32x4*)(C.h + (size_t)m * D) + C.lane; const GAS f32x4* gr = (const GAS f32x4*)fn + C.lane;
        const GAS u32x2* hr = (const GAS u32x2*)(hb + (size_t)m * D) + C.lane;
#pragma unroll
        for (int j = 0; j < 4; ++j) { const u32x2 w = hr[64 * j]; const f32x4 g = gr[64 * j]; orow[64 * j] = (f32x4){bflo(w.x) * rs * g[0], bfhi(w.x) * rs * g[1], bflo(w.y) * rs * g[2], bfhi(w.y) * rs * g[3]}; } }
}
#define RWC_PTRS \
    GAS float* RWW = (GAS float*)(C.ws + WS_RWW); const GAS bf16* RWR = (const GAS bf16*)(C.ws + WS_RWR); const GAS bf16* RWK = (const GAS bf16*)(C.ws + WS_RWK); const GAS bf16* RWV = (const GAS bf16*)(C.ws + WS_RWV); \
    GAS bf16* RWKK = (GAS bf16*)(C.ws + WS_RWKK); GAS bf16* RWB = (GAS bf16*)(C.ws + WS_RWB); GAS bf16* RWY = (GAS bf16*)(C.ws + WS_RWY); \
    LF LGs = (LF)C.lds; LB LP = (LB)C.lds; LB LPT = (LB)(C.lds + 9216); LB AT = (LB)(C.lds + 18432); LB LAK = AT; LB LP2 = AT; LB RT = (LB)(C.lds + 27648); LB BTl = (LB)(C.lds + 36864); LB MRB = BTl; LB KTl = (LB)(C.lds + 46080); LB MRK = KTl; \
    LB VT = (LB)(C.lds + 55296); LB BHT = (LB)(C.lds + 64512); LB KHT = (LB)(C.lds + 73728); LB XB0 = (LB)(C.lds + 82944); LB XB1 = (LB)(C.lds + 101376); LB LPT2 = (LB)(C.lds + 119808); LF rho = (LF)(C.lds + 129024); LF lgl = rho + 64; \
    const int t = C.tid >> 3, g8 = C.tid & 7, n = C.lane & 31, hi = C.lane >> 5; \
    (void)RWW; (void)RWR; (void)RWK; (void)RWV; (void)RWKK; (void)RWB; (void)RWY; (void)LGs; (void)LP; (void)LPT; (void)AT; (void)LAK; (void)LP2; (void)RT; (void)BTl; (void)MRB; (void)KTl; (void)MRK; (void)VT; (void)BHT; (void)KHT; (void)XB0; (void)XB1; (void)LPT2; (void)rho; (void)lgl; (void)t; (void)g8; (void)n; (void)hi;
struct S0In { f32x4 x0, x1; u32x4 rv, kv, kkv, bv, vv; };
__device__ __forceinline__ S0In rwc_s0_load(const Ctx& C, int bc, int h) {
    RWC_PTRS
    const size_t g = ((size_t)bc * 64 + t) * 512 + h * 64 + g8 * 8; S0In in;
    in.rv = *(const GAS u32x4*)(RWR + g); in.kv = *(const GAS u32x4*)(RWK + g); in.kkv = *(const GAS u32x4*)(RWKK + g); in.bv = *(const GAS u32x4*)(RWB + g); in.vv = *(const GAS u32x4*)(RWV + g);
    in.x0 = *(const GAS f32x4*)(RWW + g); in.x1 = *(const GAS f32x4*)(RWW + g + 4); return in;
}
__device__ __forceinline__ void rwc_stage0_body(const Ctx& C, int bc, int h, const S0In& in) {
    RWC_PTRS
    LF TOT = (LF)C.lds;
    float lw[8] = {in.x0[0], in.x0[1], in.x0[2], in.x0[3], in.x1[0], in.x1[1], in.x1[2], in.x1[3]}, lg[8], rh[8], ll[8];
#pragma unroll
    for (int i = 0; i < 8; ++i) lg[i] = lw[i];
#pragma unroll
    for (int st = 1; st < 8; ++st) {
#pragma unroll
        for (int i = 0; i < 8; ++i) { const float nb_ = __shfl_up(lg[i], 8); if ((t & 7) == st) lg[i] += nb_; } }
    if ((t & 7) == 7) { *(LAS f32x4*)(TOT + C.wave * 64 + g8 * 8) = (f32x4){lg[0], lg[1], lg[2], lg[3]}; *(LAS f32x4*)(TOT + C.wave * 64 + g8 * 8 + 4) = (f32x4){lg[4], lg[5], lg[6], lg[7]}; }
    RW_BAR();
    {   float off[8], run[8];
#pragma unroll
        for (int i = 0; i < 8; ++i) { off[i] = 0.f; run[i] = 0.f; }
#pragma unroll
        for (int w = 0; w < 8; ++w) { const f32x4 a0 = *(const LAS f32x4*)(TOT + w * 64 + g8 * 8), a1 = *(const LAS f32x4*)(TOT + w * 64 + g8 * 8 + 4);
#pragma unroll
            for (int i = 0; i < 8; ++i) { const float v = i < 4 ? a0[i & 3] : a1[i & 3]; off[i] += (w < C.wave) ? v : 0.f; run[i] += v; if (w == 3) rh[i] = run[i]; } }
#pragma unroll
        for (int i = 0; i < 8; ++i) { lg[i] += off[i]; ll[i] = run[i]; } }
    {   float rf[8], kf[8], kkf[8], bf[8], o1[8], o2[8], o3[8], o4[8];
        unpack8(in.rv, rf); unpack8(in.kv, kf); unpack8(in.kkv, kkf); unpack8(in.bv, bf);
#pragma unroll
        for (int i = 0; i < 8; ++i) { const int k = g8 * 8 + i; const float lm1 = lg[i] - lw[i];
            const float ed = __expf(lg[i] - rh[i]), edi = __expf(rh[i] - lg[i]), el = __expf(ll[i] - lg[i]);
            o1[i] = -kkf[i] * __expf(lm1 - rh[i]); o2[i] = rf[i] * ed; o3[i] = bf[i] * edi; o4[i] = kf[i] * edi;
            XB0[k * 72 + t] = (bf16)f2bf(-kkf[i] * __expf(lm1));
            BHT[k * 72 + t] = (bf16)f2bf(bf[i] * el); KHT[k * 72 + t] = (bf16)f2bf(kf[i] * el); }
        *(LAS u32x4*)(AT + t * 72 + g8 * 8) = pack8(o1); *(LAS u32x4*)(RT + t * 72 + g8 * 8) = pack8(o2); *(LAS u32x4*)(BTl + t * 72 + g8 * 8) = pack8(o3); *(LAS u32x4*)(KTl + t * 72 + g8 * 8) = pack8(o4);
        const unsigned vw[4] = {in.vv.x, in.vv.y, in.vv.z, in.vv.w};
#pragma unroll
        for (int i = 0; i < 4; ++i) { VT[(g8 * 8 + 2 * i) * 72 + t] = (bf16)(vw[i] & 0xffffu); VT[(g8 * 8 + 2 * i + 1) * 72 + t] = (bf16)(vw[i] >> 16); }
        if (t == 0) {
#pragma unroll
            for (int i = 0; i < 8; ++i) { rho[g8 * 8 + i] = rh[i]; lgl[g8 * 8 + i] = ll[i]; } }
    }
    RW_BAR();
}
PH_FN void rwc_stage0(const Ctx C, int bc, int h) { const S0In in = rwc_s0_load(C, bc, h); rwc_stage0_body(C, bc, h, in); }
PH_FN void rwc_stage12(const Ctx C) {
    RWC_PTRS
    {   const int mt = C.wave >> 1, nt0 = 2 * (C.wave & 1);
        CLB Am = (mt < 2) ? (CLB)AT : (CLB)RT; const int m0 = 32 * (mt & 1);
        CLB Bm = (nt0 < 2) ? (CLB)BTl : (CLB)KTl;
        f32x16 c0 = zero16(), c1 = zero16();
        mma_nt<64>(c0, Am, 72, m0, Bm, 72, 0, C.lane); mma_nt<64>(c1, Am, 72, m0, Bm, 72, 32, C.lane);
        RW_BAR();
#pragma unroll
        for (int r = 0; r < 16; ++r) { const int tt = m0 + crow(r, hi); const int j0 = n, j1 = 32 + n;
            if (mt < 2) { const bf16 x0 = (bf16)f2bf((j0 < tt) ? c0[r] : 0.f), x1 = (bf16)f2bf((j1 < tt) ? c1[r] : 0.f);
                if (nt0 < 2) { LP[tt * 72 + j0] = x0; LP[tt * 72 + j1] = x1; LPT[j0 * 72 + tt] = x0; LPT[j1 * 72 + tt] = x1; } else { LAK[tt * 72 + j0] = x0; LAK[tt * 72 + j1] = x1; } }
            else { const bf16 x0 = (bf16)f2bf((j0 <= tt) ? c0[r] : 0.f), x1 = (bf16)f2bf((j1 <= tt) ? c1[r] : 0.f);
                if (nt0 < 2) { MRB[tt * 72 + j0] = x0; MRB[tt * 72 + j1] = x1; } else { MRK[tt * 72 + j0] = x0; MRK[tt * 72 + j1] = x1; } } }
    }
    RW_BAR();
    if (C.wave < 4) { const int vt = C.wave >> 1, tt0 = C.wave & 1; f32x16 c = zero16(); mma_nt<64>(c, VT, 72, 32 * vt, LAK, 72, 32 * tt0, C.lane);
#pragma unroll
        for (int r = 0; r < 16; ++r) XB0[(64 + 32 * vt + crow(r, hi)) * 72 + 32 * tt0 + n] = (bf16)f2bf(c[r]); }
    RW_BAR();
}
#ifndef RWC_NSTEP
#define RWC_NSTEP 6
#endif
#ifndef RWC_REP0
#define RWC_REP0 1
#endif
PH_FN void rwc_solve(const Ctx C) {
    RWC_PTRS
    const int ct = C.wave >> 1, tt = C.wave & 1;
    const int sk = C.wave >> 2, st = (C.wave >> 1) & 1, sj = C.wave & 1;
#pragma unroll 1
    for (int i = 0; i < RWC_NSTEP; ++i) {
        CLB Pc = (i & 1) ? (CLB)LP2 : (CLB)LP; CLB PTc = (i & 1) ? (CLB)LPT2 : (CLB)LPT; LB Pn = (i & 1) ? LP : LP2; LB PTn = (i & 1) ? LPT : LPT2;
        CLB Xc = (i & 1) ? (CLB)XB1 : (CLB)XB0; LB Xn = (i & 1) ? XB0 : XB1;
        { f32x16 acc;
#pragma unroll
          for (int r = 0; r < 16; ++r) acc[r] = bf2f(Xc[(32 * ct + crow(r, hi)) * 72 + 32 * tt + n]);
          mma_nt<64>(acc, Xc, 72, 32 * ct, Pc, 72, 32 * tt, C.lane);
#pragma unroll
          for (int r = 0; r < 16; ++r) Xn[(32 * ct + crow(r, hi)) * 72 + 32 * tt + n] = (bf16)f2bf(acc[r]); }
        if (i < RWC_NSTEP - 1) { f32x16 acc = zero16();
          if (sk == 0) mma_nt<64>(acc, Pc, 72, 32 * st, PTc, 72, 32 * sj, C.lane); else mma_nt<64>(acc, PTc, 72, 32 * st, Pc, 72, 32 * sj, C.lane);
          LB dst = (sk == 0) ? Pn : PTn;
#pragma unroll
          for (int r = 0; r < 16; ++r) dst[(32 * st + crow(r, hi)) * 72 + 32 * sj + n] = (bf16)f2bf(acc[r]); }
        RW_BAR();
    }
}
__device__ __forceinline__ void rwc_stage4_body(const Ctx& C, int bc, int h) {
    RWC_PTRS
    const size_t row0 = (size_t)bc * 64; CLB A2T = (CLB)XB0; CLB WT = (CLB)(XB0 + 64 * 72);
    {   const int kind = C.wave >> 1, mt = C.wave & 1;
        f32x16 c0 = zero16(), c1 = zero16();
        if (kind == 0) { mma_nt<64>(c0, BHT, 72, 32 * mt, A2T, 72, 0, C.lane); mma_nt<64>(c1, BHT, 72, 32 * mt, A2T, 72, 32, C.lane); }
        else if (kind == 1) { mma_nt<64>(c0, BHT, 72, 32 * mt, WT, 72, 0, C.lane); mma_nt<64>(c1, BHT, 72, 32 * mt, WT, 72, 32, C.lane); mma_nt<64>(c0, KHT, 72, 32 * mt, VT, 72, 0, C.lane); mma_nt<64>(c1, KHT, 72, 32 * mt, VT, 72, 32, C.lane); }
        else if (kind == 2) { mma_nt<64>(c0, MRB, 72, 32 * mt, A2T, 72, 0, C.lane); mma_nt<64>(c1, MRB, 72, 32 * mt, A2T, 72, 32, C.lane); }
        else { mma_nt<64>(c0, MRB, 72, 32 * mt, WT, 72, 0, C.lane); mma_nt<64>(c1, MRB, 72, 32 * mt, WT, 72, 32, C.lane); mma_nt<64>(c0, MRK, 72, 32 * mt, VT, 72, 0, C.lane); mma_nt<64>(c1, MRK, 72, 32 * mt, VT, 72, 32, C.lane); }
#pragma unroll
        for (int r = 0; r < 16; ++r) { const int m = 32 * mt + crow(r, hi); const size_t go = (row0 + m) * 512 + h * 64;
            if (kind == 0) { const float d = __expf(lgl[m]); RWB[go + n] = (bf16)f2bf(c0[r] + ((n == m) ? d : 0.f)); RWB[go + 32 + n] = (bf16)f2bf(c1[r] + ((32 + n == m) ? d : 0.f)); }
            else if (kind == 1) { RWW[go + n] = c0[r]; RWW[go + 32 + n] = c1[r]; }
            else if (kind == 2) { RWKK[go + n] = (bf16)f2bf(c0[r] + bf2f(RT[m * 72 + n]) * __expf(rho[n])); RWKK[go + 32 + n] = (bf16)f2bf(c1[r] + bf2f(RT[m * 72 + 32 + n]) * __expf(rho[32 + n])); }
            else { RWY[go + n] = (bf16)f2bf(c0[r]); RWY[go + 32 + n] = (bf16)f2bf(c1[r]); } }
    }
}
PH_FN void rwc_stage4(const Ctx C, int bc, int h) { rwc_stage4_body(C, bc, h); }
PH_FN void rwc_stage40(const Ctx C, int bc, int h) {
    const S0In in = rwc_s0_load(C, bc, h + 1); __builtin_amdgcn_sched_barrier(0);
    rwc_stage4_body(C, bc, h);
    rwc_stage0_body(C, bc, h + 1, in);
}
__device__ __forceinline__ void ph_rw_chunk(const Ctx& C, int bc) {
    rwc_stage0(C, bc, 0);
#pragma unroll 1
    for (int h = 0; h < 8; ++h) { rwc_stage12(C); rwc_solve(C); if (h < 7) rwc_stage40(C, bc, h); else rwc_stage4(C, bc, h); }
    WG_SYNC();
}
PH_FN void rw_scan_producer(const Ctx C, int chain) {
    const float* RWW = (const float*)(unsigned char*)(C.ws + WS_RWW); const bf16* RWKK = (const bf16*)(unsigned char*)(C.ws + WS_RWKK); const bf16* RWB = (const bf16*)(unsigned char*)(C.ws + WS_RWB); bf16* RWY = (bf16*)(unsigned char*)(C.ws + WS_RWY);
    const int b = chain >> 3, h = chain & 7; const size_t rowb = (size_t)b * SEQ;
    constexpr int BUFB = 45056, O_RQ = 0, O_PT = 9216, O_QT = 18432, O_Y0 = 35840;
    LAS unsigned char* L = C.lds;
        const int p = C.tid - 256, t = p >> 2, q4 = (p & 3) * 16;
        u32x4 Arq0, Arq1, Apt0, Apt1, Ay00, Ay01, Brq0, Brq1, Bpt0, Bpt1, By00, By01; f32x4 Aq0, Aq1, Aq2, Aq3, Bq0, Bq1, Bq2, Bq3;
#define SC_LOAD(S, c_) do { const size_t g_ = (rowb + (size_t)(c_) * 64 + t) * 512 + h * 64 + q4; \
            S##rq0 = *(const u32x4*)(RWKK + g_); S##rq1 = *(const u32x4*)(RWKK + g_ + 8); S##pt0 = *(const u32x4*)(RWB + g_); S##pt1 = *(const u32x4*)(RWB + g_ + 8); S##y00 = *(const u32x4*)(RWY + g_); S##y01 = *(const u32x4*)(RWY + g_ + 8); \
            S##q0 = *(const f32x4*)(RWW + g_); S##q1 = *(const f32x4*)(RWW + g_ + 4); S##q2 = *(const f32x4*)(RWW + g_ + 8); S##q3 = *(const f32x4*)(RWW + g_ + 12); } while (0)
#define SC_WRITE(S, Lb) do { \
            *(LAS u32x4*)((LB)((Lb) + O_RQ) + t * 72 + q4) = S##rq0; *(LAS u32x4*)((LB)((Lb) + O_RQ) + t * 72 + q4 + 8) = S##rq1; \
            *(LAS u32x4*)((LB)((Lb) + O_PT) + t * 72 + q4) = S##pt0; *(LAS u32x4*)((LB)((Lb) + O_PT) + t * 72 + q4 + 8) = S##pt1; \
            *(LAS u32x4*)((LB)((Lb) + O_Y0) + t * 72 + q4) = S##y00; *(LAS u32x4*)((LB)((Lb) + O_Y0) + t * 72 + q4 + 8) = S##y01; \
            { LF d_ = (LF)((Lb) + O_QT) + t * 68 + q4; *(LAS f32x4*)d_ = S##q0; *(LAS f32x4*)(d_ + 4) = S##q1; *(LAS f32x4*)(d_ + 8) = S##q2; *(LAS f32x4*)(d_ + 12) = S##q3; } } while (0)
        SC_LOAD(A, 0); SC_LOAD(B, 1);
        for (int c = 0; c < NCH; c += 2) {
            SC_WRITE(A, L); if (c + 2 < NCH) SC_LOAD(A, c + 2); RW_BAR();
            SC_WRITE(B, L + BUFB); if (c + 3 < NCH) SC_LOAD(B, c + 3); RW_BAR();
        }
        RW_BAR();
#undef SC_LOAD
#undef SC_WRITE
}
PH_FN void rw_scan_consumer(const Ctx C, int chain) {
    const float* RWW = (const float*)(unsigned char*)(C.ws + WS_RWW); const bf16* RWKK = (const bf16*)(unsigned char*)(C.ws + WS_RWKK); const bf16* RWB = (const bf16*)(unsigned char*)(C.ws + WS_RWB); bf16* RWY = (bf16*)(unsigned char*)(C.ws + WS_RWY);
    const int b = chain >> 3, h = chain & 7; const size_t rowb = (size_t)b * SEQ;
    constexpr int BUFB = 45056, O_RQ = 0, O_PT = 9216, O_QT = 18432, O_Y0 = 35840;
    LAS unsigned char* L = C.lds;
        const int n = C.lane & 31, hi = C.lane >> 5, vh = C.wave & 1;
        f32x16 st0 = zero16(), st1 = zero16();
        for (int c = 0; c < NCH; ++c) {
            RW_BAR();
            if (C.wave < 2) {
                const LAS unsigned char* Lb = L + (c & 1) * BUFB;
                CLB RQ = (CLB)(Lb + O_RQ); CLB PT = (CLB)(Lb + O_PT); CLF QT = (CLF)(Lb + O_QT); CLB Y0 = (CLB)(Lb + O_Y0);
                pg8::bf16x8 sb[4];
                { u32x4 w;
                  w.x = pk2(st0[0], st0[1]); w.y = pk2(st0[2], st0[3]); w.z = pk2(st0[4], st0[5]); w.w = pk2(st0[6], st0[7]); sb[0] = __builtin_bit_cast(pg8::bf16x8, w);
                  w.x = pk2(st0[8], st0[9]); w.y = pk2(st0[10], st0[11]); w.z = pk2(st0[12], st0[13]); w.w = pk2(st0[14], st0[15]); sb[1] = __builtin_bit_cast(pg8::bf16x8, w);
                  w.x = pk2(st1[0], st1[1]); w.y = pk2(st1[2], st1[3]); w.z = pk2(st1[4], st1[5]); w.w = pk2(st1[6], st1[7]); sb[2] = __builtin_bit_cast(pg8::bf16x8, w);
                  w.x = pk2(st1[8], st1[9]); w.y = pk2(st1[10], st1[11]); w.z = pk2(st1[12], st1[13]); w.w = pk2(st1[14], st1[15]); sb[3] = __builtin_bit_cast(pg8::bf16x8, w); }
#define SC_AFRAG(X_, row_, s_) ({ const u32x2 lo_ = *(const LAS u32x2*)((X_) + (row_) * 72 + 16 * (s_) + 4 * hi), hi_ = *(const LAS u32x2*)((X_) + (row_) * 72 + 16 * (s_) + 8 + 4 * hi); \
                    u32x4 w_; w_.x = lo_.x; w_.y = lo_.y; w_.z = hi_.x; w_.w = hi_.y; __builtin_bit_cast(pg8::bf16x8, w_); })
#pragma unroll
                for (int tt = 0; tt < 2; ++tt) { f32x16 y;
#pragma unroll
                    for (int r = 0; r < 16; ++r) y[r] = bf2f(Y0[(32 * tt + crow(r, hi)) * 72 + 32 * vh + n]);
#pragma unroll
                    for (int s = 0; s < 4; ++s) y = __builtin_amdgcn_mfma_f32_32x32x16_bf16(SC_AFRAG(RQ, 32 * tt + n, s), sb[s], y, 0, 0, 0);
                    bf16* yo = RWY + (rowb + (size_t)c * 64 + 32 * tt) * 512 + h * 64 + 32 * vh + n;
#pragma unroll
                    for (int r = 0; r < 16; ++r) yo[(size_t)crow(r, hi) * 512] = (bf16)f2bf(y[r]); }
                f32x16 n0, n1;
#pragma unroll
                for (int r = 0; r < 16; ++r) { n0[r] = QT[crow(r, hi) * 68 + 32 * vh + n]; n1[r] = QT[(32 + crow(r, hi)) * 68 + 32 * vh + n]; }
#pragma unroll
                for (int s = 0; s < 4; ++s) { n0 = __builtin_amdgcn_mfma_f32_32x32x16_bf16(SC_AFRAG(PT, n, s), sb[s], n0, 0, 0, 0); n1 = __builtin_amdgcn_mfma_f32_32x32x16_bf16(SC_AFRAG(PT, 32 + n, s), sb[s], n1, 0, 0, 0); }
                st0 = n0; st1 = n1;
#undef SC_AFRAG
            }
        }
        RW_BAR();
}
__device__ __forceinline__ void rw_scan_unit(const Ctx& C, int chain) { if (C.wave >= 4) rw_scan_producer(C, chain); else rw_scan_consumer(C, chain); }
#ifndef REP_ATTN
#define REP_ATTN 1
#endif
#ifndef REP_W
#define REP_W 1
#endif
#ifndef REP_RWC
#define REP_RWC 1
#endif
#ifndef REP_MA
#define REP_MA 1
#endif
#ifndef REP_GLAA
#define REP_GLAA 1
#endif
#ifndef REP_SSDA
#define REP_SSDA 1
#endif
#ifndef REP_RWP
#define REP_RWP 1
#endif
#ifndef REP_GLAC
#define REP_GLAC 1
#endif
#ifndef REP_SSDC
#define REP_SSDC 1
#endif
#ifndef REP_RWO
#define REP_RWO 1
#endif
#ifndef REP_MAFULL
#define REP_MAFULL 1
#endif
#ifndef REP_SCANS
#define REP_SCANS 1
#endif
#ifndef REP_MC
#define REP_MC 1
#endif
#ifndef REP_GEMM
#define REP_GEMM 1
#endif
constexpr int NPH = 12, G_FINAL = 1 + NL * NPH, G_END = G_FINAL + 1;
template <int GRP>
__global__ void __launch_bounds__(NTHR, 2) hybrid_fwd(Args args) {
    constexpr bool ALL = (GRP < 0);
    constexpr bool EN_G1 = ALL || GRP == 0, EN_G2 = EN_G1, EN_G3 = EN_G1, EN_G7 = EN_G1, EN_G8 = EN_G1, EN_G9 = EN_G1;
    constexpr bool EN_PRO = ALL || GRP == 1, EN_W = EN_PRO, EN_FIN = EN_PRO, EN_MA1 = EN_PRO, EN_MA2 = EN_PRO, EN_MA3 = EN_PRO, EN_MA4 = EN_PRO;
    constexpr bool EN_MB1 = ALL || GRP == 2, EN_MB2 = EN_MB1;
    constexpr bool EN_MC1 = ALL || GRP == 3, EN_MC2 = EN_MC1, EN_MC3 = EN_MC1;
    extern __shared__ __attribute__((aligned(16))) unsigned char lds[];
    Ctx C; C.lds = (LAS unsigned char*)lds; C.ws = (GAS unsigned char*)args.ws; C.h = (GAS float*)args.out; C.tid = threadIdx.x; C.lane = C.tid & 63; C.wave = __builtin_amdgcn_readfirstlane(C.tid >> 6); C.bid = blockIdx.x; C.G = gridDim.x;
    LAS unsigned char* ldsl = (LAS unsigned char*)lds;
    const ArgsP ap = (ArgsP)__builtin_amdgcn_kernarg_segment_ptr();
    for (int u = C.tid; u < (LDS_BYTES - LDSCTL_OFF) / 4; u += NTHR) ((LAS unsigned*)(ldsl + LDSCTL_OFF))[u] = 0u;
    __syncthreads();
    volatile LAS unsigned* MISC = (volatile LAS unsigned*)(ldsl + MISC_OFF);
    gu32* ctl = (gu32*)(args.ws + WS_CTL);
    const int g_lo = args.g_lo, g_hi = args.g_hi;
    XcdBarrier bar; bar.bar = (unsigned*)(ctl + CW_BAR); bar.x = 0; bar.st = nullptr;
    if (g_hi - g_lo > 1) bar = xcd_barrier_post((unsigned*)(ctl + CW_BAR), MISC + 8);
#define IN(g) (g_lo <= (g) && (g) < g_hi)
#define SEAM(g) do { if (IN(g) && IN((g) + 1)) xcd_barrier(bar); } while (0)
    bf16* HB = (bf16*)(args.ws + WS_HB); float* SSQ = (float*)(args.ws + WS_SSQ);

    if (IN(0)) { if (EN_PRO) ph_prologue(fresh(C), ap); if (EN_W) ph_weights(fresh(C), ap, 0, 13, C.bid * NWAVES + C.wave, C.G * NWAVES); }
    SEAM(0);
#define W_TAIL(layer, mask) do { if (EN_W && C.bid >= 128 && (layer) < NL) ph_weights(fresh(C), ap, (layer), (mask), (C.bid - 128) * NWAVES + C.wave, 128 * NWAVES); } while (0)
#pragma unroll 1
    for (int l = 0; l < NL; ++l) {
        const int gb = 1 + NPH * l;
#pragma unroll 1
        for (int f = 0; f < 2; ++f) {
            const int gu = gb + (f ? 10 : 1);
            if (EN_G1 && IN(gu)) {
                pg8::Gemm g{HB, (const bf16*)(args.ws + (f ? WS_WGU2 : WS_WGU1)), M, 2 * FF, D, D}; pg8::StaticOrder S; S.init(M, 2 * FF, C.G, C.bid);
                pg8::EpiSwiglu E{(bf16*)(args.ws + WS_ACT), FF, SSQ, M};
                pg8::gemm_phase<pg8::EpiSwiglu, pg8::StaticOrder, true, true>(ldsl, g, S, E);
                if (f == 0) W_TAIL(l, l > 0 ? 10 : 2); else W_TAIL(l + 1, 4);
            }
            SEAM(gu);
            if (EN_G2 && IN(gu + 1)) {
                pg8::Gemm g{(const bf16*)(args.ws + WS_ACT), (const bf16*)(args.ws + (f ? WS_WD2 : WS_WD1)), M, D, FF, FF}; pg8::StaticOrder S; S.init(M, D, C.G, C.bid);
                pg8::EpiResid E{HB, SSQ, M, 0.5f};
                pg8::gemm_phase<pg8::EpiResid, pg8::StaticOrder, false, true>(ldsl, g, S, E);
            }
            SEAM(gu + 1);
            if (f == 0) {
                if (EN_G3 && IN(gb + 3)) {
                    pg8::Gemm g{HB, (const bf16*)(args.ws + WS_WIN), M, NPM, D, D}; pg8::StaticOrder S; S.init(M, NPM, C.G, C.bid);
                    pg8::EpiMixRope E{(bf16*)(args.ws + WS_P), NPM, SSQ, M, (const float*)(args.ws + WS_COS), (const float*)(args.ws + WS_SIN)};
                    pg8::gemm_phase<pg8::EpiMixRope, pg8::StaticOrder, true, true>(ldsl, g, S, E);
                    W_TAIL(l + 1, 1);
                }
                SEAM(gb + 3);
                if (IN(gb + 4)) { for (int rf = 0; rf < REP_MAFULL; ++rf) { for (int rep = 0; rep < REP_MA; ++rep) { for (int r2 = 0; r2 < REP_GLAA; ++r2) if (EN_MA2) ph_gla_a(fresh(C), ap, l); for (int r2 = 0; r2 < REP_SSDA; ++r2) if (EN_MA3) ph_ssd_a(fresh(C), ap, l); for (int r2 = 0; r2 < REP_RWP; ++r2) if (EN_MA4) ph_rw_prep(fresh(C), ap, l); } if (EN_MA4) ph_rw_chunk(fresh(C), C.bid); } }
                SEAM(gb + 4);
                if (IN(gb + 5)) {
#define MB_SCANS() do { if (EN_MB2) { if (C.bid < 16) rw_scan_unit(fresh(C), C.bid); else { for (int p = C.bid - 16; p < 192; p += C.G - 16) { if (p < 64) gla_scan_part(fresh(C), p); else ssd_scan_part(fresh(C), p - 64); } } } } while (0)
                    MB_SCANS();
                    for (int rs = 1; rs < REP_SCANS; ++rs) {
                        xcd_barrier(bar); if (EN_MA2) ph_gla_a(fresh(C), ap, l); if (EN_MA3) ph_ssd_a(fresh(C), ap, l); if (EN_MA4) { ph_rw_prep(fresh(C), ap, l); ph_rw_chunk(fresh(C), C.bid); } xcd_barrier(bar); MB_SCANS(); }
                    if (C.bid >= 16) { const int a = C.bid - 16; for (int rep = 0; rep < REP_ATTN; ++rep) if (EN_MB1) ph_da_attn(fresh(C), args, l, a & 7, ((a >> 3) + 6) % 30);     }
                }
                SEAM(gb + 5);
                if (IN(gb + 6)) { for (int rep = 0; rep < REP_MC; ++rep) { for (int r2 = 0; r2 < REP_GLAC; ++r2) if (EN_MC1) ph_gla_c(fresh(C), ap, l); for (int r2 = 0; r2 < REP_SSDC; ++r2) if (EN_MC2) ph_ssd_c(fresh(C), ap, l); for (int r2 = 0; r2 < REP_RWO; ++r2) if (EN_MC3) ph_rw_out(fresh(C), ap, l); } }
                SEAM(gb + 6);
                if (EN_G7 && IN(gb + 7)) {
                    pg8::Gemm g{HB, (const bf16*)(args.ws + WS_WIN) + (size_t)NPM * D, M, 4096, D, D}; pg8::StaticOrder S; S.init(M, 4096, C.G, C.bid);
                    pg8::EpiGateRatio E{(bf16*)(args.ws + WS_PG), args.in[33] + (size_t)l * 4096, SSQ, M};
                    pg8::gemm_phase<pg8::EpiGateRatio, pg8::StaticOrder, true, true>(ldsl, g, S, E);
                }
                SEAM(gb + 7);
                if (EN_G8 && IN(gb + 8)) {
                    pg8::Gemm g{(const bf16*)(args.ws + WS_YS), (const bf16*)(args.ws + WS_WB), M, D, 2048, 2048}; pg8::StaticOrder S; S.init(M, D, C.G, C.bid);
                    pg8::EpiGateHorner E{(bf16*)(args.ws + WS_MERGED), (const bf16*)(args.ws + WS_PG)};
                    pg8::gemm_phase<pg8::EpiGateHorner, pg8::StaticOrder, true, true>(ldsl, g, S, E);
                }
                SEAM(gb + 8);
                if (EN_G9 && IN(gb + 9)) {
                    pg8::Gemm g{(const bf16*)(args.ws + WS_MERGED), (const bf16*)(args.ws + WS_WO), M, D, D, D}; pg8::StaticOrder S; S.init(M, D, C.G, C.bid);
                    pg8::EpiResid E{HB, SSQ, M, 1.0f};
                    pg8::gemm_phase<pg8::EpiResid, pg8::StaticOrder, false, true>(ldsl, g, S, E);
                }
                SEAM(gb + 9);
            }
        }
    }
    if (EN_FIN && IN(G_FINAL)) ph_final(fresh(C), ap);
#undef IN
#undef SEAM
}

#ifndef ONE_LAUNCH
#define ONE_LAUNCH 1
#endif
extern "C" void kernel_launch(void* const* d_in, const int* in_sizes, int n_in, void* d_out, int out_size, void* d_ws, size_t ws_size, hipStream_t stream) {
    static int grid = 0;
    if (grid == 0) {
        if (n_in != 40 || in_sizes[0] != M * D || out_size != M * D || ws_size < WS_END) { fprintf(stderr, "kernel_launch: unexpected shapes (n_in %d, in0 %d, out %d, ws %zu < %zu); nothing launched\n", n_in, n_in > 0 ? in_sizes[0] : -1, out_size, ws_size, (size_t)WS_END); grid = -1; return; }
        int dev = 0, cus = 0, per_cu = 0;
        if (hipGetDevice(&dev) != hipSuccess || hipDeviceGetAttribute(&cus, hipDeviceAttributeMultiprocessorCount, dev) != hipSuccess) { grid = -1; return; }
#if ONE_LAUNCH
        if (hipFuncSetAttribute((const void*)hybrid_fwd<-1>, hipFuncAttributeMaxDynamicSharedMemorySize, LDS_BYTES) != hipSuccess) { fprintf(stderr, "kernel_launch: hipFuncSetAttribute failed\n"); grid = -1; return; }
#else
        if (hipFuncSetAttribute((const void*)hybrid_fwd<0>, hipFuncAttributeMaxDynamicSharedMemorySize, LDS_BYTES) != hipSuccess || hipFuncSetAttribute((const void*)hybrid_fwd<1>, hipFuncAttributeMaxDynamicSharedMemorySize, LDS_BYTES) != hipSuccess ||
            hipFuncSetAttribute((const void*)hybrid_fwd<2>, hipFuncAttributeMaxDynamicSharedMemorySize, LDS_BYTES) != hipSuccess || hipFuncSetAttribute((const void*)hybrid_fwd<3>, hipFuncAttributeMaxDynamicSharedMemorySize, LDS_BYTES) != hipSuccess) { fprintf(stderr, "kernel_launch: hipFuncSetAttribute failed\n"); grid = -1; return; }
#endif
        if (hipOccupancyMaxActiveBlocksPerMultiprocessor(&per_cu, (const void*)hybrid_fwd<(ONE_LAUNCH ? -1 : 0)>, NTHR, LDS_BYTES) != hipSuccess || per_cu < 1) { fprintf(stderr, "kernel_launch: occupancy query reports %d workgroups per CU: the grid would not be resident; nothing launched\n", per_cu); (void)hipGetLastError(); grid = -1; return; }
        (void)hipGetLastError();
        grid = cus;
        if (grid != 256) { fprintf(stderr, "kernel_launch: %d CUs; this kernel is laid out for 256 workgroups; nothing launched\n", grid); grid = -1; return; }
    }
    if (grid < 0) return;
    if (hipMemsetAsync((char*)d_ws + WS_CTL, 0, CTL_ZERO_BYTES, stream) != hipSuccess) return;
    Args a{};
    for (int i = 0; i < 40; ++i) a.in[i] = (const float*)d_in[i];
    a.out = (float*)d_out; a.ws = (unsigned char*)d_ws;
    for (int j = 0; j < 32; ++j) a.inv_freq[j] = (float)pow(10000.0, -(double)j / 32.0);
#if ONE_LAUNCH
    a.g_lo = 0; a.g_hi = G_END;
    hipLaunchKernelGGL(hybrid_fwd<-1>, dim3(grid), dim3(NTHR), LDS_BYTES, stream, a);
#else
    for (int g = 0; g < G_END; ++g) {
        a.g_lo = g; a.g_hi = g + 1;
        int grp = 1;
        if (g >= 1 && g < G_FINAL) { const int k = (g - 1) % NPH; grp = (k == 0 || k == 4) ? 1 : (k == 5) ? 2 : (k == 6) ? 3 : 0; }
        if (grp == 0) hipLaunchKernelGGL(hybrid_fwd<0>, dim3(grid), dim3(NTHR), LDS_BYTES, stream, a);
        else if (grp == 1) hipLaunchKernelGGL(hybrid_fwd<1>, dim3(grid), dim3(NTHR), LDS_BYTES, stream, a);
        else if (grp == 2) hipLaunchKernelGGL(hybrid_fwd<2>, dim3(grid), dim3(NTHR), LDS_BYTES, stream, a);
        else hipLaunchKernelGGL(hybrid_fwd<3>, dim3(grid), dim3(NTHR), LDS_BYTES, stream, a);
    }
#endif
}
```

```cpp
#include <hip/hip_runtime.h>
#include <cstdio>
#include <cstdint>
#include <cmath>

namespace pg8 {
#define PG8_LAS __attribute__((address_space(3)))
typedef unsigned short bf16_t;
typedef short bf16x8 __attribute__((ext_vector_type(8)));
typedef float f32x4 __attribute__((ext_vector_type(4)));
typedef unsigned u32x4 __attribute__((ext_vector_type(4)));
constexpr int BM = 256, BK = 64, HALF = 128, HTB = HALF * BK * 2  , STAGE_BYTES = 8 * HTB, NXCD = 8, WGM = 8;

__host__ __device__ __forceinline__ int lds_byte(int r, int c) { const int st = (r >> 4) * 2 + (c >> 5), rr = r & 15, cc = c & 31, ob = rr * 64 + cc * 2; return st * 1024 + (ob ^ (((ob >> 9) & 1) << 5)); }
__host__ __device__ __forceinline__ void stage_rc(int b, int& R, int& C) { const int st = b / 1024, sb = b % 1024, swz = sb ^ (((sb >> 9) & 1) << 5); R = (st >> 1) * 16 + swz / 64; C = (st & 1) * 32 + (swz % 64) / 2; }
__host__ __device__ __forceinline__ int perm32(int rho) { const int n = rho >> 4, i = rho & 15; return 8 * (i >> 2) + 4 * n + (i & 3); }

struct Unit { int pm, pn, z; };
struct Gemm { const bf16_t* A; const bf16_t* Bt; int M, N, K, lda; };

struct StaticOrder {
    int nM, nN, nwg, G, c;
    __host__ __device__ void init(int M, int N, int G_, int c_) { nM = M / BM; nN = N / BM; nwg = nM * nN; G = G_; c = c_; }
    __host__ __device__ bool next(int i, Unit& u) const {
        const long L = (long)i * G + c; if (L >= nwg) return false;
        int wgid = (int)L; { const int q = nwg / NXCD, r = nwg % NXCD, xcd = wgid % NXCD, off = wgid / NXCD; wgid = (xcd < r ? xcd * (q + 1) : r * (q + 1) + (xcd - r) * q) + off; }
        const int nig = WGM * nN, gid = wgid / nig, fm = gid * WGM, gsz = (nM - fm) < WGM ? (nM - fm) : WGM;
        u.pm = fm + ((wgid % nig) % gsz); u.pn = (wgid % nig) / gsz; u.z = 0; return true;
    }
    __device__ __forceinline__ void a_ready(const Unit&) const {}
    __device__ __forceinline__ void done(const Unit&) const {}
    __device__ __forceinline__ size_t a_off(const Unit&) const { return 0; }
    __device__ __forceinline__ int b_tile(const Unit& u) const { return u.pn; }
};
__device__ __forceinline__ unsigned cvt_pk_bf16(float lo, float hi) { unsigned r; asm volatile("v_cvt_pk_bf16_f32 %0, %1, %2" : "=v"(r) : "v"(lo), "v"(hi)); return r; }
typedef float f32x2_pg __attribute__((ext_vector_type(2))); typedef __bf16 bf16x2_pg __attribute__((ext_vector_type(2)));
__device__ __forceinline__ unsigned cvt_pk_bf16_c(float lo, float hi) { const f32x2_pg v = {lo, hi}; const bf16x2_pg b = __builtin_convertvector(v, bf16x2_pg); return __builtin_bit_cast(unsigned, b); }
__device__ __forceinline__ float bf_lo(unsigned w) { return __uint_as_float(w << 16); }
__device__ __forceinline__ float bf_hi(unsigned w) { return __uint_as_float(w & 0xffff0000u); }
__device__ __forceinline__ float fast_sigmoid(float x) { return __builtin_amdgcn_rcpf(1.0f + __builtin_amdgcn_exp2f(-1.4426950408889634f * x)); }

__device__ __forceinline__ float row_rstd(const float* ssq, int row, int M_) {
    const f32x4 p = *(const f32x4*)(ssq + (size_t)row * 4); const float s = (p[0] + p[1]) + (p[2] + p[3]); (void)M_;
    return __builtin_amdgcn_rsqf(s * (1.0f / 1024.0f) + 1e-6f);
}
__device__ __forceinline__ void row_rstd8(const float* ssq, int row0, float (&rs)[8]) {
    f32x4 p[8];
#pragma unroll
    for (int j = 0; j < 8; ++j) p[j] = *(const f32x4*)(ssq + (size_t)(row0 + (j >> 2) * HALF + (j & 3) * 16) * 4);
#pragma unroll
    for (int j = 0; j < 8; ++j) rs[j] = __builtin_amdgcn_rsqf(((p[j][0] + p[j][1]) + (p[j][2] + p[j][3])) * (1.0f / 1024.0f) + 1e-6f);
    asm volatile("" ::: "memory");
}
constexpr int RS_OFF = 131072 + 1024, RS_SLOT = 4096;
__device__ __forceinline__ void row_rstd8_lds(const PG8_LAS float* rsl, int wr, int fr, float (&rs)[8]) {
    f32x4 p[8];
#pragma unroll
    for (int j = 0; j < 8; ++j) p[j] = *(const PG8_LAS f32x4*)(rsl + ((j >> 2) * HALF + wr * 64 + (j & 3) * 16 + fr) * 4);
#pragma unroll
    for (int j = 0; j < 8; ++j) rs[j] = __builtin_amdgcn_rsqf(((p[j][0] + p[j][1]) + (p[j][2] + p[j][3])) * (1.0f / 1024.0f) + 1e-6f);
}
struct EpiScaleBf16 {
    static constexpr bool PERM = true, AFTER_DRAIN = false, RSTD_LDS = true; static constexpr int SEG_TILES = 0; struct Pre {};
    bf16_t* O; int ldc; const float* ssq; int M_;
    __device__ __forceinline__ void operator()(const f32x4 (&acc)[2][2][4][2], const Unit& u, int wr, int wc, int fr, int fq, const PG8_LAS float* rsl) const {
        const int row0 = u.pm * BM + wr * 64 + fr; const int col0 = u.pn * BM + wc * 32 + 8 * fq; float rs8[8]; row_rstd8_lds(rsl, wr, fr, rs8);
#pragma unroll
        for (int ai = 0; ai < 2; ++ai)
#pragma unroll
            for (int m = 0; m < 4; ++m) { const int row = row0 + ai * HALF + m * 16; const float rs = rs8[ai * 4 + m]; bf16_t* rowp = O + (size_t)row * ldc + col0;
#pragma unroll
                for (int bj = 0; bj < 2; ++bj) { const f32x4 v0 = acc[ai][bj][m][0] * rs, v1 = acc[ai][bj][m][1] * rs;
                    u32x4 w; w.x = cvt_pk_bf16(v0[0], v0[1]); w.y = cvt_pk_bf16(v0[2], v0[3]); w.z = cvt_pk_bf16(v1[0], v1[1]); w.w = cvt_pk_bf16(v1[2], v1[3]);
                    *(u32x4*)(rowp + bj * HALF) = w; } }
    }
};
struct EpiMixRope {
    static constexpr bool PERM = true, AFTER_DRAIN = false, RSTD_LDS = true; static constexpr int SEG_TILES = 0; struct Pre {};
    bf16_t* O; int ldc; const float* ssq; int M_; const float* cosT; const float* sinT;
    __device__ __forceinline__ void operator()(const f32x4 (&acc)[2][2][4][2], const Unit& u, int wr, int wc, int fr, int fq, const PG8_LAS float* rsl) const {
        const int row0 = u.pm * BM + wr * 64 + fr; float rs8[8]; row_rstd8_lds(rsl, wr, fr, rs8);
        if (u.pn < 4) {
            const int colq = (4 * u.pn + wc) * 64 + 8 * fq; const float sc = (u.pn < 2) ? 0.125f * 1.4426950408889634f : 1.0f;
#pragma unroll
            for (int ai = 0; ai < 2; ++ai)
#pragma unroll
                for (int m = 0; m < 4; ++m) { const int row = row0 + ai * HALF + m * 16; const float rs = rs8[ai * 4 + m] * sc; const int t = row & 8191;
                    const float* cp = cosT + t * 32 + 8 * fq; const float* sp = sinT + t * 32 + 8 * fq;
                    const f32x4 c0 = *(const f32x4*)cp, c1 = *(const f32x4*)(cp + 4), s0 = *(const f32x4*)sp, s1 = *(const f32x4*)(sp + 4);
                    const f32x4 xa0 = acc[ai][0][m][0] * rs, xa1 = acc[ai][0][m][1] * rs, xb0 = acc[ai][1][m][0] * rs, xb1 = acc[ai][1][m][1] * rs;
                    const f32x4 p0 = xa0 * c0 - xb0 * s0, p1 = xa1 * c1 - xb1 * s1, q0 = xb0 * c0 + xa0 * s0, q1 = xb1 * c1 + xa1 * s1;
                    bf16_t* rowp = O + (size_t)row * ldc + colq;
                    u32x4 w; w.x = cvt_pk_bf16(p0[0], p0[1]); w.y = cvt_pk_bf16(p0[2], p0[3]); w.z = cvt_pk_bf16(p1[0], p1[1]); w.w = cvt_pk_bf16(p1[2], p1[3]); *(u32x4*)rowp = w;
                    w.x = cvt_pk_bf16(q0[0], q0[1]); w.y = cvt_pk_bf16(q0[2], q0[3]); w.z = cvt_pk_bf16(q1[0], q1[1]); w.w = cvt_pk_bf16(q1[2], q1[3]); *(u32x4*)(rowp + 32) = w; }
        } else {
            const int col0 = u.pn * BM + wc * 32 + 8 * fq;
#pragma unroll
            for (int ai = 0; ai < 2; ++ai)
#pragma unroll
                for (int m = 0; m < 4; ++m) { const int row = row0 + ai * HALF + m * 16; const float rs = rs8[ai * 4 + m]; bf16_t* rowp = O + (size_t)row * ldc + col0;
#pragma unroll
                    for (int bj = 0; bj < 2; ++bj) { const f32x4 v0 = acc[ai][bj][m][0] * rs, v1 = acc[ai][bj][m][1] * rs;
                        u32x4 w; w.x = cvt_pk_bf16(v0[0], v0[1]); w.y = cvt_pk_bf16(v0[2], v0[3]); w.z = cvt_pk_bf16(v1[0], v1[1]); w.w = cvt_pk_bf16(v1[2], v1[3]);
                        *(u32x4*)(rowp + bj * HALF) = w; } }
        }
    }
};
struct EpiSwiglu {
    static constexpr bool PERM = true, AFTER_DRAIN = false, RSTD_LDS = true; static constexpr int SEG_TILES = 0; struct Pre {};
    bf16_t* O; int ldc; const float* ssq; int M_;
    __device__ __forceinline__ void operator()(const f32x4 (&acc)[2][2][4][2], const Unit& u, int wr, int wc, int fr, int fq, const PG8_LAS float* rsl) const {
        const int row0 = u.pm * BM + wr * 64 + fr; const int col0 = u.pn * HALF + wc * 32 + 8 * fq; float rs8[8]; row_rstd8_lds(rsl, wr, fr, rs8);
#pragma unroll
        for (int ai = 0; ai < 2; ++ai)
#pragma unroll
            for (int m = 0; m < 4; ++m) { const int row = row0 + ai * HALF + m * 16; const float rs = rs8[ai * 4 + m]; bf16_t* rowp = O + (size_t)row * ldc + col0;
                float o[8];
#pragma unroll
                for (int n = 0; n < 2; ++n)
#pragma unroll
                    for (int i = 0; i < 4; ++i) { const float g = acc[ai][0][m][n][i] * rs, up = acc[ai][1][m][n][i] * rs; o[n * 4 + i] = g * fast_sigmoid(g) * up; }
                u32x4 w; w.x = cvt_pk_bf16(o[0], o[1]); w.y = cvt_pk_bf16(o[2], o[3]); w.z = cvt_pk_bf16(o[4], o[5]); w.w = cvt_pk_bf16(o[6], o[7]);
                *(u32x4*)rowp = w; }
    }
};
struct EpiGateRatio {
    static constexpr bool PERM = true, AFTER_DRAIN = false, RSTD_LDS = true; static constexpr int SEG_TILES = 0; struct Pre {};
    bf16_t* O; const float* gb; const float* ssq; int M_;
    __device__ __forceinline__ void operator()(const f32x4 (&acc)[2][2][4][2], const Unit& u, int wr, int wc, int fr, int fq, const PG8_LAS float* rsl) const {
        const int row0 = u.pm * BM + wr * 64 + fr; const int ch0 = u.pn * 64 + wc * 16 + 4 * fq;
        f32x4 b[4];
#pragma unroll
        for (int z = 0; z < 4; ++z) b[z] = *(const f32x4*)(gb + z * 1024 + ch0);
        float rs8[8]; row_rstd8_lds(rsl, wr, fr, rs8);
#pragma unroll
        for (int ai = 0; ai < 2; ++ai)
#pragma unroll
            for (int m = 0; m < 4; ++m) { const int row = row0 + ai * HALF + m * 16; const float rs = rs8[ai * 4 + m]; bf16_t* rowp = O + (size_t)row * 4096 + ch0;
                unsigned w[4][2];
#pragma unroll
                for (int h = 0; h < 2; ++h) { float d[4][2];
#pragma unroll
                    for (int z = 0; z < 4; ++z) {
                        d[z][0] = 1.0f + __builtin_amdgcn_exp2f(-1.4426950408889634f * (acc[ai][z >> 1][m][z & 1][2 * h] * rs + b[z][2 * h]));
                        d[z][1] = 1.0f + __builtin_amdgcn_exp2f(-1.4426950408889634f * (acc[ai][z >> 1][m][z & 1][2 * h + 1] * rs + b[z][2 * h + 1])); }
#pragma unroll
                    for (int z = 0; z < 4; ++z) { const float r0 = __builtin_amdgcn_rcpf(d[z][0]), r1 = __builtin_amdgcn_rcpf(d[z][1]);
                        w[z][h] = z < 3 ? cvt_pk_bf16_c(d[z < 3 ? z + 1 : 3][0] * r0, d[z < 3 ? z + 1 : 3][1] * r1) : cvt_pk_bf16_c(r0, r1); } }
#pragma unroll
                for (int z = 0; z < 4; ++z) { uint2 v; v.x = w[z][0]; v.y = w[z][1]; *(uint2*)(rowp + z * 1024) = v; } }
    }
};
struct EpiGateHorner {
    static constexpr bool PERM = true, AFTER_DRAIN = false, RSTD_LDS = false; static constexpr int SEG_TILES = 8; struct Pre {};
    bf16_t* O; const bf16_t* PG;
    __device__ __forceinline__ void seg(f32x4 (&acc)[2][2][4][2], const Unit& u, int z, int wr, int wc, int fr, int fq) const {
        int row0 = u.pm * BM + wr * 64 + fr; const int col0 = u.pn * BM + wc * 32 + 8 * fq; asm volatile("" : "+v"(row0));
#pragma unroll
        for (int ai = 0; ai < 2; ++ai)
#pragma unroll
            for (int m = 0; m < 4; ++m) { const int row = row0 + ai * HALF + m * 16;
#pragma unroll
                for (int bj = 0; bj < 2; ++bj) { const u32x4 f = *(const u32x4*)(PG + (size_t)row * 4096 + z * 1024 + col0 + bj * HALF);
                    acc[ai][bj][m][0] *= (f32x4){bf_lo(f.x), bf_hi(f.x), bf_lo(f.y), bf_hi(f.y)}; acc[ai][bj][m][1] *= (f32x4){bf_lo(f.z), bf_hi(f.z), bf_lo(f.w), bf_hi(f.w)}; }
                if (m == 3) asm volatile("" ::: "memory"); }
    }
    __device__ __forceinline__ void operator()(const f32x4 (&acc)[2][2][4][2], const Unit& u, int wr, int wc, int fr, int fq) const {
        const int row0 = u.pm * BM + wr * 64 + fr; const int col0 = u.pn * BM + wc * 32 + 8 * fq;
#pragma unroll
        for (int ai = 0; ai < 2; ++ai) { u32x4 f[4][2];
#pragma unroll
            for (int m = 0; m < 4; ++m)
#pragma unroll
                for (int bj = 0; bj < 2; ++bj) f[m][bj] = *(const u32x4*)(PG + (size_t)(row0 + ai * HALF + m * 16) * 4096 + 3 * 1024 + col0 + bj * HALF);
            asm volatile("" ::: "memory");
#pragma unroll
            for (int m = 0; m < 4; ++m) { const int row = row0 + ai * HALF + m * 16;
#pragma unroll
                for (int bj = 0; bj < 2; ++bj) { const u32x4 g = f[m][bj];
                    const f32x4 o0 = acc[ai][bj][m][0] * (f32x4){bf_lo(g.x), bf_hi(g.x), bf_lo(g.y), bf_hi(g.y)}, o1 = acc[ai][bj][m][1] * (f32x4){bf_lo(g.z), bf_hi(g.z), bf_lo(g.w), bf_hi(g.w)};
                    u32x4 w; w.x = cvt_pk_bf16(o0[0], o0[1]); w.y = cvt_pk_bf16(o0[2], o0[3]); w.z = cvt_pk_bf16(o1[0], o1[1]); w.w = cvt_pk_bf16(o1[2], o1[3]);
                    *(u32x4*)(O + (size_t)row * 1024 + col0 + bj * HALF) = w; } }
            asm volatile("" ::: "memory"); }
    }
};
struct EpiResid {
    static constexpr bool PERM = true, AFTER_DRAIN = true, RSTD_LDS = false; static constexpr int SEG_TILES = 0;
    bf16_t* HB; float* ssq; int M_; float s;
    struct Pre { u32x4 hv[2][4][2]; };
    __device__ __forceinline__ void prefetch(Pre& pre, const Unit& u, int wr, int wc, int fr, int fq) const {
        const int row0 = u.pm * BM + wr * 64 + fr; const int col0 = u.pn * BM + wc * 32 + 8 * fq;
#pragma unroll
        for (int ai = 0; ai < 2; ++ai)
#pragma unroll
            for (int m = 0; m < 4; ++m)
#pragma unroll
                for (int bj = 0; bj < 2; ++bj) pre.hv[ai][m][bj] = *(const u32x4*)(HB + (size_t)(row0 + ai * HALF + m * 16) * 1024 + col0 + bj * HALF);
    }
    __device__ __forceinline__ void fused(f32x4 (&acc)[2][2][4][2], const Unit& u, int wr, int wc, int fr, int fq, PG8_LAS unsigned char* lds, int wid, int lane, const Pre& pre) const {
        PG8_LAS float* P = (PG8_LAS float*)lds;
        const int row0 = u.pm * BM + wr * 64 + fr; const int col0 = u.pn * BM + wc * 32 + 8 * fq;
#pragma unroll
        for (int ai = 0; ai < 2; ++ai) {
#pragma unroll
            for (int m = 0; m < 4; ++m) { const int row = row0 + ai * HALF + m * 16; float q = 0.f;
#pragma unroll
                for (int bj = 0; bj < 2; ++bj) { bf16_t* hp = HB + (size_t)row * 1024 + col0 + bj * HALF; const u32x4 hw = pre.hv[ai][m][bj];
                    const f32x4 h0 = (f32x4){bf_lo(hw.x), bf_hi(hw.x), bf_lo(hw.y), bf_hi(hw.y)} + acc[ai][bj][m][0] * s, h1 = (f32x4){bf_lo(hw.z), bf_hi(hw.z), bf_lo(hw.w), bf_hi(hw.w)} + acc[ai][bj][m][1] * s;
                    q += (h0[0] * h0[0] + h0[1] * h0[1]) + (h0[2] * h0[2] + h0[3] * h0[3]) + (h1[0] * h1[0] + h1[1] * h1[1]) + (h1[2] * h1[2] + h1[3] * h1[3]);
                    u32x4 w; w.x = cvt_pk_bf16(h0[0], h0[1]); w.y = cvt_pk_bf16(h0[2], h0[3]); w.z = cvt_pk_bf16(h1[0], h1[1]); w.w = cvt_pk_bf16(h1[2], h1[3]);
                    *(u32x4*)hp = w; }
                q += __shfl_xor(q, 16); q += __shfl_xor(q, 32);
                if (fq == 0) P[(ai * HALF + wr * 64 + m * 16 + fr) * 4 + wc] = q; } }
        asm volatile("s_waitcnt lgkmcnt(0)" ::: "memory"); __builtin_amdgcn_s_barrier(); asm volatile("" ::: "memory");
        const int t = wid * 64 + lane;
        if (t < 256) { const float q = (P[t * 4 + 0] + P[t * 4 + 1]) + (P[t * 4 + 2] + P[t * 4 + 3]); ssq[(size_t)(u.pm * BM + t) * 4 + u.pn] = q; }
        asm volatile("s_waitcnt lgkmcnt(0)" ::: "memory"); __builtin_amdgcn_s_barrier(); asm volatile("" ::: "memory");
    }
};
template <class Epi, class Sched, bool ALIGN_EPI = false, bool SP2 = false>
__device__ __forceinline__ void gemm_phase(PG8_LAS unsigned char* lds, const Gemm g, const Sched& S, const Epi& E) {
    int tid_ = threadIdx.x; asm volatile("" : "+v"(tid_)); const int tid = tid_, wid = __builtin_amdgcn_readfirstlane(tid >> 6), lane = tid & 63, wr = wid >> 2, wc = wid & 3, fr = lane & 15, fq = lane >> 4;
    const int K = g.K, nt = K / BK;
    unsigned voffA[2], voffB[2];
#pragma unroll
    for (int i = 0; i < 2; ++i) { int R, C; stage_rc(tid * 16 + i * 8192, R, C); const int Rb = Epi::PERM ? ((R & ~31) + perm32(R & 31)) : R;
        voffA[i] = (unsigned)(R * g.lda + C) * 2u; voffB[i] = (unsigned)(Rb * K + C) * 2u; }
    const size_t kstep = (size_t)(BK * 2);
    const size_t hstep = (size_t)HALF * K * 2;
    const size_t tstep = 2 * hstep; const size_t hstepA = (size_t)HALF * g.lda * 2, tstepA = 2 * hstepA;
    const unsigned ldsw = (unsigned)wid * 1024u;
    const int aoff = lds_byte(wr * 64 + fr, fq * 8), boff = lds_byte(wc * 32 + fr, fq * 8);
#define PG8_SA(b, h) (((b) * 2 + (h)) * HTB)
#define PG8_SB(b, h) ((4 + (b) * 2 + (h)) * HTB)
#define PG8_STAGE(bufoff, gbase, voff) do { _Pragma("unroll") for (int _i = 0; _i < 2; ++_i) \
        __builtin_amdgcn_global_load_lds((const unsigned*)((const char*)(gbase) + (voff)[_i]), (PG8_LAS unsigned*)(lds + (bufoff) + ldsw + _i * 8192), 16, 0, 0); } while (0)
#define PG8_LDA(dst, b, h) do { _Pragma("unroll") for (int m = 0; m < 4; ++m) _Pragma("unroll") for (int k = 0; k < 2; ++k) dst[m][k] = *(const PG8_LAS bf16x8*)(lds + PG8_SA(b, h) + aoff + m * 2048 + k * 1024); } while (0)
#define PG8_LDB(dst, b, h) do { _Pragma("unroll") for (int n = 0; n < 2; ++n) _Pragma("unroll") for (int k = 0; k < 2; ++k) dst[n][k] = *(const PG8_LAS bf16x8*)(lds + PG8_SB(b, h) + boff + n * 2048 + k * 1024); } while (0)
#define PG8_MMA(ai, bj, At, Bt) do { __builtin_amdgcn_s_setprio(1); _Pragma("unroll") for (int m = 0; m < 4; ++m) _Pragma("unroll") for (int n = 0; n < 2; ++n) _Pragma("unroll") for (int k = 0; k < 2; ++k) \
        acc[ai][bj][m][n] = __builtin_amdgcn_mfma_f32_16x16x32_bf16(Bt[n][k], At[m][k], acc[ai][bj][m][n], 0, 0, 0); __builtin_amdgcn_s_setprio(0); } while (0)
#define PG8_WAIT_V(n) asm volatile("s_waitcnt vmcnt(" #n ")" ::: "memory")
#define PG8_WAIT_L(n) asm volatile("s_waitcnt lgkmcnt(" #n ")" ::: "memory")
#define PG8_BAR __builtin_amdgcn_s_barrier()
#define PG8_SCHED __builtin_amdgcn_sched_barrier(0)
#define PG8_RSTD_DMA(unit, idx) do { if constexpr (Epi::RSTD_LDS) { if (wr == 0) \
        __builtin_amdgcn_global_load_lds((const unsigned*)(E.ssq + ((size_t)(unit).pm * BM + tid) * 4), (PG8_LAS unsigned*)(lds + RS_OFF + ((idx) & 1) * RS_SLOT + wid * 1024), 16, 0, 0); } } while (0)
    Unit cur, nxt; int ui = 0;
    if (!S.next(0, cur)) return;
    f32x4 acc[2][2][4][2];
#pragma unroll
    for (int a = 0; a < 2; ++a)
#pragma unroll
        for (int b = 0; b < 2; ++b)
#pragma unroll
            for (int m = 0; m < 4; ++m)
#pragma unroll
                for (int n = 0; n < 2; ++n) acc[a][b][m][n] = (f32x4){0.f, 0.f, 0.f, 0.f};
    bf16x8 At[4][2], B0[2][2], B1[2][2];
    const char* cA = (const char*)g.A + (size_t)cur.pm * tstepA + S.a_off(cur); const char* cB = (const char*)g.Bt + (size_t)S.b_tile(cur) * tstep;
    S.a_ready(cur);
    PG8_RSTD_DMA(cur, 0);
    if constexpr (SP2) {
        PG8_STAGE(PG8_SB(0, 0), cB, voffB); PG8_STAGE(PG8_SB(0, 1), cB + hstep, voffB); PG8_STAGE(PG8_SA(0, 0), cA, voffA); PG8_STAGE(PG8_SA(0, 1), cA + hstepA, voffA);
        if (wr == 1) PG8_BAR;
        PG8_WAIT_V(2); PG8_BAR;
        PG8_STAGE(PG8_SB(1, 0), cB + kstep, voffB); PG8_STAGE(PG8_SA(1, 0), cA + kstep, voffA); PG8_STAGE(PG8_SB(1, 1), cB + hstep + kstep, voffB);
        PG8_WAIT_V(6); PG8_BAR;
    } else {
        PG8_STAGE(PG8_SB(0, 0), cB, voffB); PG8_STAGE(PG8_SA(0, 0), cA, voffA); PG8_STAGE(PG8_SB(0, 1), cB + hstep, voffB); PG8_STAGE(PG8_SA(0, 1), cA + hstepA, voffA);
        if (wr == 1) PG8_BAR;
        PG8_WAIT_V(4); PG8_BAR;
        PG8_STAGE(PG8_SB(1, 0), cB + kstep, voffB); PG8_STAGE(PG8_SA(1, 0), cA + kstep, voffA); PG8_STAGE(PG8_SB(1, 1), cB + hstep + kstep, voffB);
        PG8_WAIT_V(6); PG8_BAR;
    }
    for (;;) {
        const bool has_next = S.next(ui + 1, nxt);
        const char* nA = has_next ? (const char*)g.A + (size_t)nxt.pm * tstepA + S.a_off(nxt) : cA; const char* nB = has_next ? (const char*)g.Bt + (size_t)S.b_tile(nxt) * tstep : cB;
        for (int t = 0; t < nt; t += 2) {
            const bool last = (t == nt - 2);
            const char* a1 = cA + (size_t)(t + 1) * kstep;
            const char* a2 = last ? nA : cA + (size_t)(t + 2) * kstep; const char* b2 = last ? nB : cB + (size_t)(t + 2) * kstep;
            const char* a3 = a2 + kstep; const char* b3 = b2 + kstep;
            if (last && has_next) S.a_ready(nxt);
            if constexpr (SP2) {
            PG8_LDB(B0, 0, 0); PG8_LDB(B1, 0, 1); PG8_SCHED; PG8_LDA(At, 0, 0); PG8_STAGE(PG8_SA(1, 1), a1 + hstepA, voffA);
            PG8_WAIT_V(8); PG8_WAIT_L(0); PG8_BAR; PG8_MMA(0, 0, At, B0); PG8_MMA(0, 1, At, B1); PG8_BAR; PG8_SCHED;
            PG8_LDA(At, 0, 1); PG8_STAGE(PG8_SB(0, 0), b2, voffB); PG8_STAGE(PG8_SB(0, 1), b2 + hstep, voffB); PG8_STAGE(PG8_SA(0, 0), a2, voffA);
            PG8_WAIT_V(8); PG8_WAIT_L(0); PG8_BAR; PG8_MMA(1, 0, At, B0); PG8_MMA(1, 1, At, B1); PG8_BAR; PG8_SCHED;
            PG8_LDB(B0, 1, 0); PG8_LDB(B1, 1, 1); PG8_SCHED; PG8_LDA(At, 1, 0); PG8_STAGE(PG8_SA(0, 1), a2 + hstepA, voffA);
            PG8_WAIT_V(8); PG8_WAIT_L(0); PG8_BAR; PG8_MMA(0, 0, At, B0); PG8_MMA(0, 1, At, B1); PG8_BAR; PG8_SCHED;
            PG8_LDA(At, 1, 1); PG8_STAGE(PG8_SB(1, 0), b3, voffB); PG8_STAGE(PG8_SB(1, 1), b3 + hstep, voffB); PG8_STAGE(PG8_SA(1, 0), a3, voffA);
            PG8_WAIT_V(8); PG8_WAIT_L(0); PG8_BAR; PG8_MMA(1, 0, At, B0); PG8_MMA(1, 1, At, B1); PG8_BAR; PG8_SCHED;
            } else {
            PG8_LDB(B0, 0, 0); PG8_SCHED; PG8_LDA(At, 0, 0); PG8_STAGE(PG8_SA(1, 1), a1 + hstepA, voffA);
            PG8_WAIT_L(8); PG8_BAR; PG8_WAIT_L(0); PG8_MMA(0, 0, At, B0); PG8_BAR; PG8_SCHED;
            PG8_LDB(B1, 0, 1); PG8_STAGE(PG8_SB(0, 0), b2, voffB);
            PG8_BAR; PG8_WAIT_L(0); PG8_MMA(0, 1, At, B1); PG8_BAR;
            PG8_LDA(At, 0, 1); PG8_STAGE(PG8_SA(0, 0), a2, voffA);
            PG8_BAR; PG8_WAIT_L(0); PG8_MMA(1, 0, At, B0); PG8_BAR; PG8_SCHED;
            PG8_STAGE(PG8_SB(0, 1), b2 + hstep, voffB);
            PG8_WAIT_V(6); PG8_BAR; PG8_MMA(1, 1, At, B1); PG8_BAR;
            PG8_LDB(B0, 1, 0); PG8_SCHED; PG8_LDA(At, 1, 0); PG8_STAGE(PG8_SA(0, 1), a2 + hstepA, voffA);
            PG8_WAIT_L(8); PG8_BAR; PG8_WAIT_L(0); PG8_MMA(0, 0, At, B0); PG8_BAR; PG8_SCHED;
            PG8_LDB(B1, 1, 1); PG8_STAGE(PG8_SB(1, 0), b3, voffB);
            PG8_BAR; PG8_WAIT_L(0); PG8_MMA(0, 1, At, B1); PG8_BAR;
            PG8_LDA(At, 1, 1); PG8_STAGE(PG8_SA(1, 0), a3, voffA);
            PG8_BAR; PG8_WAIT_L(0); PG8_MMA(1, 0, At, B0); PG8_BAR; PG8_SCHED;
            PG8_STAGE(PG8_SB(1, 1), b3 + hstep, voffB);
            PG8_WAIT_V(6); PG8_BAR; PG8_MMA(1, 1, At, B1); PG8_BAR;
            }
            if constexpr (Epi::SEG_TILES > 0) { if (((t + 2) % Epi::SEG_TILES) == 0 && (t + 2) < nt) { E.seg(acc, cur, (t + 2) / Epi::SEG_TILES - 1, wr, wc, fr, fq); PG8_WAIT_V(0); PG8_SCHED; } }
        }
        if constexpr (ALIGN_EPI) { if (wr == 0) PG8_BAR; }
        if constexpr (!Epi::AFTER_DRAIN) { if constexpr (Epi::RSTD_LDS) E(acc, cur, wr, wc, fr, fq, (const PG8_LAS float*)(lds + RS_OFF + (ui & 1) * RS_SLOT)); else E(acc, cur, wr, wc, fr, fq); S.done(cur); }
        if (!has_next) break;
#pragma unroll
        for (int a = 0; a < 2; ++a)
#pragma unroll
            for (int b = 0; b < 2; ++b)
#pragma unroll
                for (int m = 0; m < 4; ++m)
#pragma unroll
                    for (int n = 0; n < 2; ++n) acc[a][b][m][n] = (f32x4){0.f, 0.f, 0.f, 0.f};
        cur = nxt; cA = nA; cB = nB; ++ui;
        PG8_RSTD_DMA(cur, ui);
        if constexpr (ALIGN_EPI) { if (wr == 1) PG8_BAR; }
    }
    typename Epi::Pre pre;
    if constexpr (Epi::AFTER_DRAIN) E.prefetch(pre, cur, wr, wc, fr, fq);
    PG8_WAIT_V(0);
    if constexpr (!ALIGN_EPI) { if (wr == 0) PG8_BAR; }
    PG8_BAR;
    if constexpr (Epi::AFTER_DRAIN) { E.fused(acc, cur, wr, wc, fr, fq, lds, wid, lane, pre); S.done(cur); }
#undef PG8_SA
#undef PG8_SB
#undef PG8_STAGE
#undef PG8_LDA
#undef PG8_LDB
#undef PG8_MMA
#undef PG8_WAIT_V
#undef PG8_WAIT_L
#undef PG8_BAR
#undef PG8_SCHED
#undef PG8_RSTD_DMA
}
}

constexpr int NWAVES = 8, NTHR = 512;
constexpr int M = 16384, SEQ = 8192, D = 1024, FF = 2816, NL = 4, NCH = 128  , NBC = 256  ;
constexpr int NPM = 6656;
constexpr int NWIN = 10752;
constexpr int C_DAQ = 0, C_DAK = 512, C_DAV = 1024, C_GQ = 1536, C_GK = 1792, C_GV = 2048, C_GOG = 2560, C_SZ = 3072, C_SX = 3584, C_SB = 4096, C_SC = 4352,
              C_RR = 4608, C_RK = 5120, C_RV = 5632, C_RWL = 6144, C_RAL = 6208, C_RGL = 6272, C_GLR = 6400, C_SDT = 6416;
constexpr float EPS = 1e-6f, LOG2E = 1.4426950408889634f;

constexpr size_t MiB = 1u << 20;
constexpr size_t WS_CTL = 0, CTL_ZERO_BYTES = 1 * MiB;
constexpr size_t WS_COS = 1 * MiB, WS_SIN = 2 * MiB, WS_SSQ = 3 * MiB, WS_GLAST = 3 * MiB + 512 * 1024, WS_SDT = 4 * MiB, WS_SACUM = 4 * MiB + 512 * 1024, WS_SCDEC = 5 * MiB, WS_RW2T = 5 * MiB + 64 * 1024;
constexpr size_t WS_WGU1 = 8 * MiB, WS_WD1 = 19 * MiB, WS_WIN = 24 * MiB + 512 * 1024, WS_WB = 45 * MiB + 512 * 1024, WS_WO = 49 * MiB + 512 * 1024, WS_WGU2 = 51 * MiB + 512 * 1024, WS_WD2 = 62 * MiB + 512 * 1024;
constexpr size_t WS_HB = 68 * MiB, WS_P = 100 * MiB, WS_PG = 100 * MiB, WS_YS = 308 * MiB, WS_R1 = 372 * MiB, WS_R2 = 500 * MiB, WS_END = 644 * MiB;
constexpr size_t WS_ACT = WS_R1, WS_MERGED = WS_R1;
constexpr size_t WS_RWW = WS_R1, WS_RWR = WS_R1 + 32 * MiB, WS_RWK = WS_R1 + 48 * MiB, WS_RWV = WS_R1 + 64 * MiB, WS_RWKK = WS_R1 + 80 * MiB, WS_RWB = WS_R1 + 96 * MiB, WS_RWG = WS_R1 + 112 * MiB;
constexpr size_t WS_VT = WS_R2, WS_GKV = WS_R2 + 16 * MiB, WS_SST = WS_R2 + 48 * MiB, WS_RWY = WS_R2 + 112 * MiB;
static_assert(WS_WD2 + (size_t)D * FF * 2 <= WS_HB && WS_P + (size_t)M * NPM * 2 <= WS_YS && WS_RWY + (size_t)M * 512 * 2 <= WS_END, "d_ws map");
constexpr int CW_BAR = 4096;

constexpr int RING_BYTES = 131072, LDSCTL_OFF = RING_BYTES, MISC_OFF = LDSCTL_OFF + 320, LDS_BYTES = 147456;

#define GAS __attribute__((address_space(1)))
#define LAS __attribute__((address_space(3)))
typedef unsigned short bf16;
typedef unsigned v4u __attribute__((ext_vector_type(4)));
typedef float f32x4 __attribute__((ext_vector_type(4)));
typedef short bf16x8 __attribute__((ext_vector_type(8)));
typedef GAS unsigned gu32;
typedef GAS unsigned long long gu64;
#define RLX_AGENT __ATOMIC_RELAXED, __HIP_MEMORY_SCOPE_AGENT
#define LDS_WAIT() asm volatile("s_waitcnt lgkmcnt(0)" ::: "memory")
#define VM_WAIT() asm volatile("s_waitcnt vmcnt(0)" ::: "memory")
__device__ __forceinline__ unsigned long long rt() { return __builtin_amdgcn_s_memrealtime(); }
typedef float f32x2_cv __attribute__((ext_vector_type(2))); typedef __bf16 bf16x2_cv __attribute__((ext_vector_type(2)));
__device__ __forceinline__ unsigned pk2(float lo, float hi) { const f32x2_cv v = {lo, hi}; const bf16x2_cv b = __builtin_convertvector(v, bf16x2_cv); return __builtin_bit_cast(unsigned, b); }
__device__ __forceinline__ unsigned f2bf(float f) { return pk2(f, 0.f) & 0xffffu; }

#define XB_TMO      128
#define XB_XCNT(j)  (256  + 64 * (j))
#define XB_XSUB(j)  (1280 + 64 * (j))
#define XB_XGEN(j)  (2304 + 64 * (j))
#define XB_TOP      3328
#define XB_TOPGEN   3392
#define XCD_BAR_WORDS 3456
#define XB_SPIN_CAP (1u << 18)

__device__ __forceinline__ unsigned xb_ld(unsigned* p)              { return __hip_atomic_load(p, __ATOMIC_RELAXED, __HIP_MEMORY_SCOPE_AGENT); }
__device__ __forceinline__ unsigned xb_add(unsigned* p, unsigned v) { return __hip_atomic_fetch_add(p, v, __ATOMIC_RELAXED, __HIP_MEMORY_SCOPE_AGENT); }
__device__ __forceinline__ unsigned xb_xcc_id() { return (unsigned)__builtin_amdgcn_s_getreg((3 << 11) | 20) & 0xFu; }
#define XB_SPIN(cond, bar) do { unsigned _sp = 0; while (cond) { __builtin_amdgcn_s_sleep(1); \
    if ((++_sp & 255u) == 0u) { if (xb_ld(&(bar)[XB_TMO])) break; if (_sp > XB_SPIN_CAP) { atomicAdd(&(bar)[XB_TMO], 1u); break; } } } } while (0)

struct XcdBarrier {
    unsigned* bar; unsigned x;
    volatile LAS unsigned* st;
};

__device__ __forceinline__ XcdBarrier xcd_barrier_post(unsigned* bar, volatile LAS unsigned* st) {
    XcdBarrier b; b.bar = bar; b.x = xb_xcc_id(); b.st = st;
    if (threadIdx.x == 0) (void)xb_add(&bar[XB_XCNT(b.x)], 1u);
    return b;
}
__device__ __forceinline__ void xcd_barrier_complete(unsigned* bar, unsigned x, unsigned& nloc, unsigned& nx) {
    const unsigned G = gridDim.x * gridDim.y * gridDim.z;
    unsigned sum, cnt, mine, sp = 0u;
    for (;;) {
        sum = 0u; cnt = 0u; mine = 0u;
#pragma unroll
        for (unsigned j = 0; j < 16; ++j) { const unsigned c = xb_ld(&bar[XB_XCNT(j)]); sum += c; cnt += (c > 0u) ? 1u : 0u; mine = (j == x) ? c : mine; }
        if (sum == G) break;
        __builtin_amdgcn_s_sleep(1);
        if ((++sp & 255u) == 0u) { if (xb_ld(&bar[XB_TMO])) break; if (sp > XB_SPIN_CAP) { atomicAdd(&bar[XB_TMO], 1u); break; } }
    }
    nloc = mine > 0u ? mine : 1u; nx = cnt > 0u ? cnt : 1u;
}

__device__ __forceinline__ void xcd_barrier(const XcdBarrier& b) {
    asm volatile("s_waitcnt vmcnt(0)" ::: "memory");
    __syncthreads();
    if (threadIdx.x == 0) {
        unsigned* bar = b.bar;
        __builtin_amdgcn_s_waitcnt(0);
        unsigned nloc = b.st[0], nx = b.st[1];
        if (nloc == 0u) { xcd_barrier_complete(bar, b.x, nloc, nx); b.st[0] = nloc; b.st[1] = nx; }
        const unsigned old = xb_add(&bar[XB_XSUB(b.x)], 1u);
        const unsigned gen = old / nloc;
        if (old + 1u == (gen + 1u) * nloc) {
            __builtin_amdgcn_fence(__ATOMIC_RELEASE, "agent");
            asm volatile("s_waitcnt vmcnt(0)" ::: "memory");
            const unsigned og = xb_add(&bar[XB_TOP], 1u);
            const unsigned tg = og / nx;
            if (og + 1u == (tg + 1u) * nx) xb_add(&bar[XB_TOPGEN], 1u);
            else XB_SPIN(xb_ld(&bar[XB_TOPGEN]) == tg, bar);
            __builtin_amdgcn_fence(__ATOMIC_ACQUIRE, "agent");
            xb_add(&bar[XB_XGEN(b.x)], 1u);
            asm volatile("s_waitcnt vmcnt(0)" ::: "memory");
        } else {
            XB_SPIN(xb_ld(&bar[XB_XGEN(b.x)]) == gen, bar);
            __builtin_amdgcn_fence(__ATOMIC_ACQUIRE, "agent");
            asm volatile("s_waitcnt vmcnt(0)" ::: "memory");
        }
    }
    __syncthreads();
}

struct Args { const float* in[40]; float* out; unsigned char* ws; float inv_freq[32]; int g_lo, g_hi; };
struct ArgsD { const GAS float* in[40]; GAS float* out; GAS unsigned char* ws; float inv_freq[32]; int g_lo, g_hi; };
typedef const __attribute__((address_space(4))) ArgsD* ArgsP;
typedef LAS float* LF; typedef const LAS float* CLF;
#ifndef PH_FN
#define PH_FN __device__ __noinline__
#endif
#ifndef PH_HEAVY
#define PH_HEAVY __device__ __forceinline__
#endif
struct Ctx {
    LAS unsigned char* lds;
    GAS unsigned char* ws; GAS float* h;
    int tid, lane, wave, bid, G;
};
typedef unsigned u32x4 __attribute__((ext_vector_type(4)));
typedef unsigned u32x2 __attribute__((ext_vector_type(2)));
typedef float f32x2 __attribute__((ext_vector_type(2)));
typedef float f32x16 __attribute__((ext_vector_type(16)));
__device__ __forceinline__ float bf2f(bf16 x) { return __uint_as_float((unsigned)x << 16); }
__device__ __forceinline__ float bflo(unsigned w) { return __uint_as_float(w << 16); }
__device__ __forceinline__ float bfhi(unsigned w) { return __uint_as_float(w & 0xffff0000u); }
__device__ __forceinline__ void unpack8(const u32x4 w, float* o) { o[0] = bflo(w.x); o[1] = bfhi(w.x); o[2] = bflo(w.y); o[3] = bfhi(w.y); o[4] = bflo(w.z); o[5] = bfhi(w.z); o[6] = bflo(w.w); o[7] = bfhi(w.w); }
__device__ __forceinline__ u32x4 pack8(const float* o) { u32x4 w; w.x = pk2(o[0], o[1]); w.y = pk2(o[2], o[3]); w.z = pk2(o[4], o[5]); w.w = pk2(o[6], o[7]); return w; }
__device__ __forceinline__ float sigmoidf_(float x) { return 1.0f / (1.0f + __expf(-x)); }
__device__ __forceinline__ float siluf_(float x) { return x * sigmoidf_(x); }
__device__ __forceinline__ float softplusf_(float x) { return fmaxf(x, 0.f) + log1pf(__expf(-fabsf(x))); }
__device__ __forceinline__ float logsigmoidf_(float x) { return fminf(x, 0.f) - log1pf(__expf(-fabsf(x))); }
__device__ __forceinline__ float wave_sum(float v) {
#pragma unroll
    for (int o = 1; o < 64; o <<= 1) v += __shfl_xor(v, o);
    return v;
}
#define WG_SYNC() __syncthreads()
#define RW_BAR() do { asm volatile("s_waitcnt lgkmcnt(0)" ::: "memory"); __builtin_amdgcn_s_barrier(); asm volatile("" ::: "memory"); } while (0)
__device__ __forceinline__ Ctx fresh(const Ctx& C0) { Ctx C = C0; int t = threadIdx.x; asm volatile("" : "+v"(t)); C.tid = t; C.lane = t & 63; C.wave = __builtin_amdgcn_readfirstlane(t >> 6); return C; }

PH_FN void ph_prologue(const Ctx C, ArgsP a) {
    GAS float* cosT = (GAS float*)(C.ws + WS_COS); GAS float* sinT = (GAS float*)(C.ws + WS_SIN);
    for (int idx = C.bid * NTHR + C.tid; idx < SEQ * 32; idx += C.G * NTHR) {
        const int t = idx >> 5, j = idx & 31;
        const float ang = (float)t * a->inv_freq[j];
        const double rev = (double)ang * 0.15915494309189535;
        const float fr = (float)(rev - floor(rev));
        cosT[idx] = __builtin_amdgcn_cosf(fr); sinT[idx] = __builtin_amdgcn_sinf(fr);
    }
    const GAS float* x = a->in[0]; GAS bf16* hb = (GAS bf16*)(C.ws + WS_HB); GAS float* ssq = (GAS float*)(C.ws + WS_SSQ);
    const int gw = C.bid * NWAVES + C.wave, NGW = C.G * NWAVES;
    f32x4 nv[4];
#define PRO_LD(m_) do { const GAS f32x4* xr_ = (const GAS f32x4*)(x + (size_t)(m_) * D) + C.lane; _Pragma("unroll") for (int j = 0; j < 4; ++j) nv[j] = xr_[64 * j]; } while (0)
    if (gw < M) PRO_LD(gw);
#pragma unroll 1
    for (int m = gw; m < M; m += NGW) {
        f32x4 v[4];
#pragma unroll
        for (int j = 0; j < 4; ++j) v[j] = nv[j];
        if (m + NGW < M) PRO_LD(m + NGW);
        GAS unsigned long long* o8 = (GAS unsigned long long*)(hb + (size_t)m * D) + C.lane;
        float s = 0.f;
#pragma unroll
        for (int j = 0; j < 4; ++j) { s += (v[j].x * v[j].x + v[j].y * v[j].y) + (v[j].z * v[j].z + v[j].w * v[j].w);
            o8[64 * j] = (unsigned long long)pk2(v[j].x, v[j].y) | ((unsigned long long)pk2(v[j].z, v[j].w) << 32); }
        s = wave_sum(s);
        if (C.lane == 0) *(GAS f32x4*)(ssq + (size_t)m * 4) = (f32x4){s, 0.f, 0.f, 0.f};
    }
#undef PRO_LD
}

template <class SrcF>
__device__ __forceinline__ void tr_item(const SrcF src, const GAS float* gk, GAS bf16* WT, int K, int kb, int nb, LAS bf16* scr, int lane) {
    const int k0 = 64 * kb, n0 = 64 * nb, kr = lane >> 4, n4 = 4 * (lane & 15);
    const int ld = src.ld(); const long co = src.col(n0 + n4); const bool ok = co >= 0; const GAS float* colp = src.base(n0 + n4) + (ok ? co : 0);
    f32x4 v[16];
#pragma unroll
    for (int i = 0; i < 16; ++i) v[i] = ok ? *(const GAS f32x4*)(colp + (size_t)(k0 + 4 * i + kr) * ld) : (f32x4){0.f, 0.f, 0.f, 0.f};
#pragma unroll
    for (int i = 0; i < 16; ++i) { const int kk = 4 * i + kr; const float g = gk ? gk[k0 + kk] : 1.0f;
#pragma unroll
        for (int e = 0; e < 4; ++e) scr[(n4 + e) * 72 + kk] = (bf16)f2bf(v[i][e] * g); }
    LDS_WAIT(); asm volatile("" ::: "memory");
    const int c = lane & 7;
#pragma unroll
    for (int j = 0; j < 8; ++j) { const int n = (lane >> 3) + 8 * j; *(GAS v4u*)(WT + (size_t)(n0 + n) * K + k0 + 8 * c) = *(const LAS v4u*)(scr + n * 72 + 8 * c); }
    LDS_WAIT(); asm volatile("" ::: "memory");
}
struct SrcGU { const GAS float* wg; const GAS float* wu;
    __device__ __forceinline__ int ld() const { return FF; }
    __device__ __forceinline__ const GAS float* base(int n) const { const uintptr_t sel = (uintptr_t)((n >> 7) & 1); return (const GAS float*)((uintptr_t)wg + sel * ((uintptr_t)wu - (uintptr_t)wg)); }
    __device__ __forceinline__ long col(int n) const { return 128 * (n >> 8) + (n & 127); } };
struct SrcPlain { const GAS float* w; int ldw;
    __device__ __forceinline__ int ld() const { return ldw; }
    __device__ __forceinline__ const GAS float* base(int) const { return w; }
    __device__ __forceinline__ long col(int n) const { return n; } };
struct SrcWin { const GAS float* w;
    __device__ __forceinline__ int ld() const { return 10520; }
    __device__ __forceinline__ const GAS float* base(int) const { return w; }
    __device__ __forceinline__ long col(int n) const {
        int c;
        if (n < 1024) { const int cl = n & 255; c = (4 * (n >> 8) + ((cl >> 5) & 3)) * 64 + 32 * (cl >> 7) + 8 * ((cl >> 3) & 3) + 4 * ((cl >> 2) & 1) + (cl & 3); }
        else if (n < 3072) c = n; else if (n < 4608) c = n - 3072 + 3088; else if (n < 6400) c = n - 4608 + 4632; else if (n < 6416) c = n - 6400 + 3072; else if (n < 6424) c = n - 6416 + 4624; else if (n < 6656) c = -1;
        else { const int m = n - 6656, pn = m >> 8, cl = m & 255, z = 2 * (cl >> 7) + ((cl >> 2) & 1), ch = 64 * pn + 16 * ((cl >> 5) & 3) + 4 * ((cl >> 3) & 3) + (cl & 3); c = 6424 + z * 1024 + ch; }
        return c; } };
PH_FN void ph_weights(const Ctx C, ArgsP a, int l, int mask, int gw, int NGW) {
    LAS bf16* scr = (LAS bf16*)(C.lds + C.wave * 16384);
    int rot = 0;
#define W_FIRST(cnt) ({ const int f_ = (gw + NGW - rot % NGW) % NGW; rot += (cnt); f_; })
#pragma unroll 1
    for (int f = 0; f < 2; ++f) { if (!(mask & (1 << f))) continue;
        const GAS float* nrm = a->in[f ? 35 : 1] + (size_t)l * D; const GAS float* wg = a->in[f ? 36 : 2] + (size_t)l * D * FF; const GAS float* wu = a->in[f ? 37 : 3] + (size_t)l * D * FF; const GAS float* wd = a->in[f ? 38 : 4] + (size_t)l * FF * D;
        GAS bf16* Wgu = (GAS bf16*)(C.ws + (f ? WS_WGU2 : WS_WGU1)); GAS bf16* Wd = (GAS bf16*)(C.ws + (f ? WS_WD2 : WS_WD1));
        const SrcGU sgu{wg, wu};
        for (int it = W_FIRST((D / 64) * (2 * FF / 64)); it < (D / 64) * (2 * FF / 64); it += NGW) tr_item(sgu, nrm, Wgu, D, it / (2 * FF / 64), it % (2 * FF / 64), scr, C.lane);
        const SrcPlain sd{wd, D};
        for (int it = W_FIRST((FF / 64) * (D / 64)); it < (FF / 64) * (D / 64); it += NGW) tr_item(sd, nullptr, Wd, FF, it / (D / 64), it % (D / 64), scr, C.lane);
    }
    if (mask & 4)
    { const SrcWin sw{a->in[6] + (size_t)l * D * 10520}; const GAS float* nrm = a->in[5] + (size_t)l * D; GAS bf16* Win = (GAS bf16*)(C.ws + WS_WIN);
      for (int it = W_FIRST((D / 64) * (NWIN / 64)); it < (D / 64) * (NWIN / 64); it += NGW) tr_item(sw, nrm, Win, D, it / (NWIN / 64), it % (NWIN / 64), scr, C.lane); }
    if (!(mask & 8)) return;
    { GAS bf16* Wb = (GAS bf16*)(C.ws + WS_WB);
      for (int it = W_FIRST(4 * (512 / 64) * (D / 64)); it < 4 * (512 / 64) * (D / 64); it += NGW) { const int z = it / ((512 / 64) * (D / 64)), r = it % ((512 / 64) * (D / 64));
          const SrcPlain sb{a->in[32] + ((size_t)l * 4 + z) * 512 * D - (size_t)z * 512 * D, D}; tr_item(sb, nullptr, Wb, 2048, z * 8 + r / (D / 64), r % (D / 64), scr, C.lane); } }
    { GAS bf16* W2T = (GAS bf16*)(C.ws + WS_RW2T); GAS bf16* A2T = W2T + 512 * 64; GAS bf16* G2T = A2T + 512 * 64;
      const SrcPlain s1{a->in[23] + (size_t)l * 64 * 512, 512}, s2{a->in[25] + (size_t)l * 64 * 512, 512}, s3{a->in[26] + (size_t)l * 128 * 512, 512};
      for (int it = W_FIRST(8); it < 8; it += NGW) tr_item(s1, nullptr, W2T, 64, 0, it, scr, C.lane);
      for (int it = W_FIRST(8); it < 8; it += NGW) tr_item(s2, nullptr, A2T, 64, 0, it, scr, C.lane);
      for (int it = W_FIRST(16); it < 16; it += NGW) tr_item(s3, nullptr, G2T, 128, it >> 3, it & 7, scr, C.lane); }
    { const SrcPlain so{a->in[34] + (size_t)l * D * D, D}; GAS bf16* Wo = (GAS bf16*)(C.ws + WS_WO);
      for (int it = W_FIRST((D / 64) * (D / 64)); it < (D / 64) * (D / 64); it += NGW) tr_item(so, nullptr, Wo, D, it / (D / 64), it % (D / 64), scr, C.lane); }
}

#undef W_FIRST

typedef LAS bf16* LB; typedef const LAS bf16* CLB;
__device__ __forceinline__ pg8::bf16x8 frag32(CLB X, int ld, int row0, int k0, int lane) { return *(const LAS pg8::bf16x8*)(X + (row0 + (lane & 31)) * ld + k0 + 8 * (lane >> 5)); }
template <int K> __device__ __forceinline__ void mma_nt(f32x16& acc, CLB A, int lda, int m0, CLB Bt, int ldb, int n0, int lane) {
#pragma unroll
    for (int k = 0; k < K; k += 16) acc = __builtin_amdgcn_mfma_f32_32x32x16_bf16(frag32(A, lda, m0, k, lane), frag32(Bt, ldb, n0, k, lane), acc, 0, 0, 0);
}
__device__ __forceinline__ int crow(int r, int hi) { return (r & 3) + 8 * (r >> 2) + 4 * hi; }
__device__ __forceinline__ f32x16 zero16() { f32x16 z;
#pragma unroll
    for (int r = 0; r < 16; ++r) z[r] = 0.f;
    return z; }

__device__ __forceinline__ void gla_compute_G(const Ctx& C, ArgsP a, int l, int bc, int h, LF Gs) {
    const GAS bf16* P = (const GAS bf16*)(C.ws + WS_P); const GAS float* W2 = a->in[12] + (size_t)l * 16 * 256; const GAS float* gb = a->in[13] + (size_t)l * 256;
    const int t = C.tid >> 3, kg = C.tid & 7; const size_t row = (size_t)bc * 64 + t;
    float glr[16]; unpack8(*(const GAS u32x4*)(P + row * NPM + C_GLR), glr); unpack8(*(const GAS u32x4*)(P + row * NPM + C_GLR + 8), glr + 8);
#pragma unroll
    for (int i = 0; i < 8; ++i) { const int k = h * 64 + kg * 8 + i; float x = gb[k];
#pragma unroll
        for (int r = 0; r < 16; ++r) x += glr[r] * W2[r * 256 + k];
        Gs[t * 68 + kg * 8 + i] = logsigmoidf_(x) * (1.0f / 16.0f); }
    RW_BAR();
    { const int seg = C.tid >> 6, k = C.tid & 63; float run = 0.f;
#pragma unroll
      for (int i = 0; i < 8; ++i) { run += Gs[(8 * seg + i) * 68 + k]; Gs[(8 * seg + i) * 68 + k] = run; }
      RW_BAR();
      float off = 0.f;
#pragma unroll
      for (int sg = 0; sg < 7; ++sg) { const float tot = Gs[(8 * sg + 7) * 68 + k]; off += (sg < seg) ? tot : 0.f; }
      RW_BAR();
#pragma unroll
      for (int i = 0; i < 8; ++i) Gs[(8 * seg + i) * 68 + k] += off; }
    RW_BAR();
}
PH_HEAVY void ph_gla_a(const Ctx C, ArgsP a, int l) {
    const GAS bf16* P = (const GAS bf16*)(C.ws + WS_P); GAS bf16* GKV = (GAS bf16*)(C.ws + WS_GKV); GAS float* GL = (GAS float*)(C.ws + WS_GLAST); GAS bf16* YSg = (GAS bf16*)(C.ws + WS_YS);
    LF Gs = (LF)C.lds; LB KDT = (LB)(C.lds + 17408); LB VT = (LB)(C.lds + 26624);
    for (int it = C.bid; it < NBC * 4; it += C.G) {
        const int bc = it >> 2, h = it & 3;
        const u32x4 kw_ = *(const GAS u32x4*)(P + ((size_t)bc * 64 + (C.tid >> 3)) * NPM + C_GK + h * 64 + (C.tid & 7) * 8);
        const u32x4 v0 = *(const GAS u32x4*)(P + ((size_t)bc * 64 + (C.tid >> 3)) * NPM + C_GV + h * 128 + (C.tid & 7) * 16), v1 = *(const GAS u32x4*)(P + ((size_t)bc * 64 + (C.tid >> 3)) * NPM + C_GV + h * 128 + (C.tid & 7) * 16 + 8);
        RW_BAR();
        gla_compute_G(C, a, l, bc, h, Gs);
        { const int t = C.tid >> 3, g8 = C.tid & 7; const size_t row = (size_t)bc * 64 + t;
          { GAS float* gst = (GAS float*)(YSg + row * 2048 + 512 + h * 128) + g8 * 8; *(GAS f32x4*)gst = *(const LAS f32x4*)(Gs + t * 68 + g8 * 8); *(GAS f32x4*)(gst + 4) = *(const LAS f32x4*)(Gs + t * 68 + g8 * 8 + 4); }
          float kf[8]; unpack8(kw_, kf);
#pragma unroll
          for (int i = 0; i < 8; ++i) { const int k = g8 * 8 + i; KDT[k * 72 + t] = (bf16)f2bf(kf[i] * __expf(Gs[63 * 68 + k] - Gs[t * 68 + k])); }
          const unsigned vw[8] = {v0.x, v0.y, v0.z, v0.w, v1.x, v1.y, v1.z, v1.w};
#pragma unroll
          for (int i = 0; i < 8; ++i) { VT[(g8 * 16 + 2 * i) * 72 + t] = (bf16)(vw[i] & 0xffffu); VT[(g8 * 16 + 2 * i + 1) * 72 + t] = (bf16)(vw[i] >> 16); }
          if (C.tid < 64) GL[(size_t)it * 64 + C.tid] = Gs[63 * 68 + C.tid]; }
        RW_BAR();
        { const int kt = C.wave >> 2, vt = C.wave & 3, n = C.lane & 31, hi = C.lane >> 5;
          f32x16 acc = zero16(); mma_nt<64>(acc, KDT, 72, 32 * kt, VT, 72, 32 * vt, C.lane);
          GAS bf16* dst = GKV + ((size_t)it * 128 + 32 * vt + n) * 64 + 32 * kt + 4 * hi;
#pragma unroll
          for (int g = 0; g < 4; ++g) { u32x2 w; w.x = pk2(acc[4 * g], acc[4 * g + 1]); w.y = pk2(acc[4 * g + 2], acc[4 * g + 3]); *(GAS u32x2*)(dst + 8 * g) = w; } }
    }
    WG_SYNC();
}
PH_FN void gla_scan_part(const Ctx C, int part) {
    GAS unsigned* GKV = (GAS unsigned*)(C.ws + WS_GKV); const GAS float* GL = (const GAS float*)(C.ws + WS_GLAST);
    const int part_ = __builtin_amdgcn_readfirstlane(part), chain = part_ >> 3, idx = (part_ & 7) * NTHR + C.tid,     b = chain >> 2, h = chain & 3, k = (2 * idx) & 63;
    float s0 = 0.f, s1 = 0.f;
    unsigned tA[8], tB[8]; f32x2 dA[8], dB[8];
    GAS unsigned* gp = GKV + ((size_t)(b * NCH) * 4 + h) * 4096 + idx; const GAS float* lp = GL + ((size_t)(b * NCH) * 4 + h) * 64 + k;
#define GS_LOAD(T, D, c0_) do { GAS unsigned* g_ = gp + (size_t)(c0_) * 16384; const GAS float* l_ = lp + (size_t)(c0_) * 256; _Pragma("unroll") for (int i = 0; i < 8; ++i) { T[i] = g_[i * 16384]; D[i] = *(const GAS f32x2*)(l_ + i * 256); } } while (0)
#define GS_PROC(T, D, c0_) do { GAS unsigned* g_ = gp + (size_t)(c0_) * 16384; _Pragma("unroll") for (int i = 0; i < 8; ++i) { g_[i * 16384] = pk2(s0, s1); s0 = __expf(D[i][0]) * s0 + bflo(T[i]); s1 = __expf(D[i][1]) * s1 + bfhi(T[i]); } } while (0)
    GS_LOAD(tA, dA, 0);
#pragma unroll 1
    for (int c0 = 0; c0 < NCH; c0 += 16) { GS_LOAD(tB, dB, c0 + 8); GS_PROC(tA, dA, c0); if (c0 + 16 < NCH) GS_LOAD(tA, dA, c0 + 16); GS_PROC(tB, dB, c0 + 8); }
#undef GS_LOAD
#undef GS_PROC
}
PH_HEAVY void ph_gla_c(const Ctx C, ArgsP a, int l) {
    const GAS bf16* P = (const GAS bf16*)(C.ws + WS_P); const GAS bf16* GKV = (const GAS bf16*)(C.ws + WS_GKV); GAS bf16* YS = (GAS bf16*)(C.ws + WS_YS);
    const GAS float* gnorm = a->in[14] + (size_t)l * 128;
    LF Gs = (LF)C.lds; LB QD = (LB)(C.lds + 17408); LB KDR = (LB)(C.lds + 26624); LB QI = (LB)(C.lds + 35840); LB ATT = (LB)(C.lds + 45056); LB VT = (LB)(C.lds + 54272); LB ST = (LB)(C.lds + 72704); LF PS = (LF)(C.lds + 91136);
    for (int it = C.bid; it < NBC * 4; it += C.G) {
        const int bc = it >> 2, h = it & 3;
        { const int t = C.tid >> 3, g8 = C.tid & 7; const size_t row = (size_t)bc * 64 + t;
          const GAS float* gst = (const GAS float*)(YS + row * 2048 + 512 + h * 128) + g8 * 8; const f32x4 gs0 = *(const GAS f32x4*)gst, gs1 = *(const GAS f32x4*)(gst + 4);
          const u32x4 qw = *(const GAS u32x4*)(P + row * NPM + C_GQ + h * 64 + g8 * 8), kw = *(const GAS u32x4*)(P + row * NPM + C_GK + h * 64 + g8 * 8);
          const u32x4 v0 = *(const GAS u32x4*)(P + row * NPM + C_GV + h * 128 + g8 * 16), v1 = *(const GAS u32x4*)(P + row * NPM + C_GV + h * 128 + g8 * 16 + 8);
          const int v = C.tid >> 2, kq = (C.tid & 3) * 16; const GAS bf16* sp = GKV + ((size_t)it * 128 + v) * 64 + kq; const u32x4 st0 = *(const GAS u32x4*)sp, st1 = *(const GAS u32x4*)(sp + 8);
          __builtin_amdgcn_sched_barrier(0);
          RW_BAR();
          *(LAS f32x4*)(Gs + t * 68 + g8 * 8) = gs0; *(LAS f32x4*)(Gs + t * 68 + g8 * 8 + 4) = gs1;
          RW_BAR();
          float qf[8], kf[8], o1[8], o2[8], o3[8];
          unpack8(qw, qf); unpack8(kw, kf);
#pragma unroll
          for (int i = 0; i < 8; ++i) { const int k = g8 * 8 + i; const float g = Gs[t * 68 + k], d = g - Gs[32 * 68 + k]; o1[i] = qf[i] * 0.125f * __expf(d); o2[i] = kf[i] * __expf(-d); o3[i] = qf[i] * 0.125f * __expf(g); }
          *(LAS u32x4*)(QD + t * 72 + g8 * 8) = pack8(o1); *(LAS u32x4*)(KDR + t * 72 + g8 * 8) = pack8(o2); *(LAS u32x4*)(QI + t * 72 + g8 * 8) = pack8(o3);
          const unsigned vw[8] = {v0.x, v0.y, v0.z, v0.w, v1.x, v1.y, v1.z, v1.w};
#pragma unroll
          for (int i = 0; i < 8; ++i) { VT[(g8 * 16 + 2 * i) * 72 + t] = (bf16)(vw[i] & 0xffffu); VT[(g8 * 16 + 2 * i + 1) * 72 + t] = (bf16)(vw[i] >> 16); }
          *(LAS u32x4*)(ST + v * 72 + kq) = st0; *(LAS u32x4*)(ST + v * 72 + kq + 8) = st1; }
        RW_BAR();
        const int n = C.lane & 31, hi = C.lane >> 5;
        if (C.wave < 4) {
            const int it_ = C.wave >> 1, jt = C.wave & 1;
            f32x16 acc = zero16();
            if (jt <= it_) mma_nt<64>(acc, QD, 72, 32 * it_, KDR, 72, 32 * jt, C.lane);
#pragma unroll
            for (int r = 0; r < 16; ++r) { const int i = 32 * it_ + crow(r, hi), j = 32 * jt + n; ATT[i * 72 + j] = (bf16)f2bf(j <= i ? acc[r] : 0.f); }
        }
        RW_BAR();
        {
            const int it_ = C.wave & 1, vt = C.wave >> 1;
            f32x16 acc = zero16();
            mma_nt<64>(acc, VT, 72, 32 * vt, ATT, 72, 32 * it_, C.lane);
            mma_nt<64>(acc, ST, 72, 32 * vt, QI, 72, 32 * it_, C.lane);
            float ss = 0.f;
#pragma unroll
            for (int r = 0; r < 16; ++r) ss += acc[r] * acc[r];
            ss += __shfl_xor(ss, 32);
            if (hi == 0) PS[(32 * it_ + n) * 4 + vt] = ss;
            const int i = 32 * it_ + n; const size_t row = (size_t)bc * 64 + i;
            u32x2 ogq[4]; f32x4 gnq[4];
#pragma unroll
            for (int g = 0; g < 4; ++g) { const int v0 = 32 * vt + 8 * g + 4 * hi; ogq[g] = *(const GAS u32x2*)(P + row * NPM + C_GOG + h * 128 + v0); gnq[g] = *(const GAS f32x4*)(gnorm + v0); }
            RW_BAR();
            const float tot = (PS[i * 4] + PS[i * 4 + 1]) + (PS[i * 4 + 2] + PS[i * 4 + 3]);
            const float rs = 1.0f / sqrtf(tot * (1.0f / 128.0f) + EPS);
#pragma unroll
            for (int g = 0; g < 4; ++g) { const int v0 = 32 * vt + 8 * g + 4 * hi;
                const u32x2 ogw = ogq[g]; const f32x4 gn = gnq[g];
                const float og[4] = {bflo(ogw.x), bfhi(ogw.x), bflo(ogw.y), bfhi(ogw.y)}; float o4[4];
#pragma unroll
                for (int y = 0; y < 4; ++y) o4[y] = acc[4 * g + y] * rs * gn[y] * siluf_(og[y]);
                u32x2 w; w.x = pk2(o4[0], o4[1]); w.y = pk2(o4[2], o4[3]); *(GAS u32x2*)(YS + row * 2048 + 512 + h * 128 + v0) = w; }
        }
    }
    WG_SYNC();
}

__device__ __forceinline__ void ssd_conv8(const GAS bf16* P, const GAS float* cw, const GAS float* cb, int bc, int t, int ch0, float* o) {
    const int pos = (bc & 127) * 64 + t; const size_t row = (size_t)bc * 64 + t;
#pragma unroll
    for (int i = 0; i < 8; ++i) o[i] = cb[ch0 + i];
#pragma unroll
    for (int tap = 0; tap < 4; ++tap) { if (pos - 3 + tap >= 0) { float x[8]; unpack8(*(const GAS u32x4*)(P + (row - 3 + tap) * NPM + C_SX + ch0), x);
#pragma unroll
        for (int i = 0; i < 8; ++i) o[i] += cw[tap * 1024 + ch0 + i] * x[i]; } }
#pragma unroll
    for (int i = 0; i < 8; ++i) o[i] = siluf_(o[i]);
}
struct ConvIn { u32x4 x[4]; };
__device__ __forceinline__ ConvIn ssd_conv_ld(const GAS bf16* P, int bc, int t, int ch0) {
    const int pos = (bc & 127) * 64 + t; const size_t row = (size_t)bc * 64 + t; ConvIn r;
#pragma unroll
    for (int tap = 0; tap < 4; ++tap) { const bool in = pos - 3 + tap >= 0; r.x[tap] = *(const GAS u32x4*)(P + (row - (in ? 3 - tap : 0)) * NPM + C_SX + ch0); }
    return r;
}
__device__ __forceinline__ void ssd_conv_fin(const ConvIn& in, const LAS float* cws, int bc, int t, int ch0, float* o) {
    const int pos = (bc & 127) * 64 + t;
    { const f32x4 b0 = *(const LAS f32x4*)(cws + 4096 + ch0), b1 = *(const LAS f32x4*)(cws + 4096 + ch0 + 4);
#pragma unroll
      for (int i = 0; i < 4; ++i) { o[i] = b0[i]; o[4 + i] = b1[i]; } }
#pragma unroll
    for (int tap = 0; tap < 4; ++tap) { const bool inr = pos - 3 + tap >= 0; float x[8]; unpack8(in.x[tap], x);
        const f32x4 w0 = *(const LAS f32x4*)(cws + tap * 1024 + ch0), w1 = *(const LAS f32x4*)(cws + tap * 1024 + ch0 + 4);
#pragma unroll
        for (int i = 0; i < 4; ++i) { o[i] += w0[i] * (inr ? x[i] : 0.f); o[4 + i] += w1[i] * (inr ? x[4 + i] : 0.f); } }
#pragma unroll
    for (int i = 0; i < 8; ++i) o[i] = siluf_(o[i]);
}
__device__ __forceinline__ void ssd_conv_weights(const Ctx& C, const GAS float* cw, const GAS float* cb, LAS float* cws) {
    for (int q = C.tid * 4; q < 5120; q += NTHR * 4) *(LAS f32x4*)(cws + q) = (q < 4096) ? *(const GAS f32x4*)(cw + q) : *(const GAS f32x4*)(cb + (q - 4096));
}
PH_HEAVY void ph_ssd_a(const Ctx C, ArgsP a, int l) {
    const GAS bf16* P = (const GAS bf16*)(C.ws + WS_P); GAS bf16* SST = (GAS bf16*)(C.ws + WS_SST); GAS float* SDT = (GAS float*)(C.ws + WS_SDT); GAS float* SAC = (GAS float*)(C.ws + WS_SACUM); GAS float* SCD = (GAS float*)(C.ws + WS_SCDEC); GAS bf16* YSs = (GAS bf16*)(C.ws + WS_YS);
    const GAS float* cw = a->in[15] + (size_t)l * 4 * 1024; const GAS float* cb = a->in[16] + (size_t)l * 1024; const GAS float* dtb = a->in[17] + (size_t)l * 8; const GAS float* alog = a->in[18] + (size_t)l * 8;
    LB BT = (LB)C.lds; LB XDT = (LB)(C.lds + 18432); LF dtv = (LF)(C.lds + 55296); LF acu = dtv + 256; LF cws = (LF)(C.lds + 57344);
    WG_SYNC();
    ssd_conv_weights(C, cw, cb, cws);
    for (int it = C.bid; it < NBC * 2; it += C.G) {
        const int bc = it >> 1, g = it & 1; const int t = C.tid >> 3, cg = C.tid & 7;
        const ConvIn ib0 = ssd_conv_ld(P, bc, t, 512 + g * 128 + cg * 16), ib1 = ssd_conv_ld(P, bc, t, 512 + g * 128 + cg * 16 + 8);
        ConvIn ix[4];
#pragma unroll
        for (int hh = 0; hh < 4; ++hh) ix[hh] = ssd_conv_ld(P, bc, t, (4 * g + hh) * 64 + cg * 8);
        const int hw = 4 * g + (C.wave & 3); const size_t rowd = (size_t)bc * 64 + C.lane;
        const bf16 dtraw = P[rowd * NPM + C_SDT + hw]; const float dtb_ = dtb[hw], al_ = alog[hw];
        __builtin_amdgcn_sched_barrier(0);
        RW_BAR();
        if (C.wave < 4) { const float dt = softplusf_(bf2f(dtraw) + dtb_); float s = -__expf(al_) * dt;
#pragma unroll
            for (int o = 1; o < 64; o <<= 1) { const float nb_ = __shfl_up(s, o); if (C.lane >= o) s += nb_; }
            dtv[C.wave * 64 + C.lane] = dt; acu[C.wave * 64 + C.lane] = s; SDT[rowd * 8 + hw] = dt; SAC[rowd * 8 + hw] = s; if (C.lane == 63) SCD[(size_t)bc * 8 + hw] = __expf(s); }
        float xo[4][8];
        { float o[8];
          ssd_conv_fin(ib0, cws, bc, t, 512 + g * 128 + cg * 16, o);
#pragma unroll
          for (int i = 0; i < 8; ++i) BT[(cg * 16 + i) * 72 + t] = (bf16)f2bf(o[i]);
          ssd_conv_fin(ib1, cws, bc, t, 512 + g * 128 + cg * 16 + 8, o);
#pragma unroll
          for (int i = 0; i < 8; ++i) BT[(cg * 16 + 8 + i) * 72 + t] = (bf16)f2bf(o[i]); }
#pragma unroll
        for (int hh = 0; hh < 4; ++hh) { ssd_conv_fin(ix[hh], cws, bc, t, (4 * g + hh) * 64 + cg * 8, xo[hh]);
            *(GAS u32x4*)(YSs + ((size_t)bc * 64 + t) * 2048 + 1024 + (4 * g + hh) * 64 + cg * 8) = pack8(xo[hh]); }
        RW_BAR();
#pragma unroll
        for (int hh = 0; hh < 4; ++hh) { const float sc = dtv[hh * 64 + t] * __expf(acu[hh * 64 + 63] - acu[hh * 64 + t]);
#pragma unroll
            for (int i = 0; i < 8; ++i) XDT[hh * 4608 + (cg * 8 + i) * 72 + t] = (bf16)f2bf(xo[hh][i] * sc); }
        RW_BAR();
        { const int pt = C.wave >> 2, nt = C.wave & 3, n = C.lane & 31, hi = C.lane >> 5;
#pragma unroll
          for (int hh = 0; hh < 4; ++hh) { const size_t item8 = (size_t)bc * 8 + 4 * g + hh;
              f32x16 acc = zero16(); mma_nt<64>(acc, XDT + hh * 4608, 72, 32 * pt, BT, 72, 32 * nt, C.lane);
#pragma unroll
              for (int r = 0; r < 16; ++r) SST[(item8 * 64 + 32 * pt + crow(r, hi)) * 128 + 32 * nt + n] = (bf16)f2bf(acc[r]); } }
    }
    WG_SYNC();
}
PH_FN void ssd_scan_part(const Ctx C, int part) {
    GAS unsigned* SST = (GAS unsigned*)(C.ws + WS_SST); const GAS float* SCD = (const GAS float*)(C.ws + WS_SCDEC);
    const int part_ = __builtin_amdgcn_readfirstlane(part), chain = part_ >> 3, idx = (part_ & 7) * NTHR + C.tid, b = chain >> 3, hd = chain & 7;
    float s0 = 0.f, s1 = 0.f;
    unsigned tA[8], tB[8]; float dA[8], dB[8];
    GAS unsigned* gp = SST + ((size_t)(b * NCH) * 8 + hd) * 4096 + idx; const GAS float* lp = SCD + (size_t)(b * NCH) * 8 + hd;
#define SS_LOAD(T, D, c0_) do { GAS unsigned* g_ = gp + (size_t)(c0_) * 32768; const GAS float* l_ = lp + (size_t)(c0_) * 8; _Pragma("unroll") for (int i = 0; i < 8; ++i) { T[i] = g_[i * 32768]; D[i] = l_[i * 8]; } } while (0)
#define SS_PROC(T, D, c0_) do { GAS unsigned* g_ = gp + (size_t)(c0_) * 32768; _Pragma("unroll") for (int i = 0; i < 8; ++i) { g_[i * 32768] = pk2(s0, s1); s0 = D[i] * s0 + bflo(T[i]); s1 = D[i] * s1 + bfhi(T[i]); } } while (0)
    SS_LOAD(tA, dA, 0);
#pragma unroll 1
    for (int c0 = 0; c0 < NCH; c0 += 16) { SS_LOAD(tB, dB, c0 + 8); SS_PROC(tA, dA, c0); if (c0 + 16 < NCH) SS_LOAD(tA, dA, c0 + 16); SS_PROC(tB, dB, c0 + 8); }
#undef SS_LOAD
#undef SS_PROC
}
PH_HEAVY void ph_ssd_c(const Ctx C, ArgsP a, int l) {
    const GAS bf16* P = (const GAS bf16*)(C.ws + WS_P); const GAS bf16* SST = (const GAS bf16*)(C.ws + WS_SST); const GAS float* SDT = (const GAS float*)(C.ws + WS_SDT); const GAS float* SAC = (const GAS float*)(C.ws + WS_SACUM); GAS bf16* YS = (GAS bf16*)(C.ws + WS_YS);
    const GAS float* cw = a->in[15] + (size_t)l * 4 * 1024; const GAS float* cb = a->in[16] + (size_t)l * 1024; const GAS float* dpar = a->in[19] + (size_t)l * 8; const GAS float* snorm = a->in[20] + (size_t)l * 512;
    LB BN = (LB)C.lds; LB CN = (LB)(C.lds + 17408); LF CB = (LF)(C.lds + 34816); LF dtv = (LF)(C.lds + 123904); LF acu = dtv + 128; LF PSQ = (LF)(C.lds + 124928); LF cwt = (LF)(C.lds + 125952);
    const int hs = C.wave >> 2;
    LB SCw = (LB)(C.lds + 52224 + hs * 35840); LB XSTw = SCw + 64 * 72; LB HPw = XSTw + 64 * 72;
    WG_SYNC();
    { const int g0 = C.bid & 1, j = C.tid & 255, ch = (j < 128 ? 512 + g0 * 128 + j : 768 + g0 * 128 + (j - 128));
      if (C.tid < 256) { cwt[j] = cw[ch]; cwt[256 + j] = cw[1024 + ch]; cwt[1024 + j] = cb[ch]; } else { cwt[512 + j] = cw[2048 + ch]; cwt[768 + j] = cw[3072 + ch]; } }
    for (int it = C.bid; it < NBC * 2; it += C.G) {
        const int bc = it >> 1, g = it & 1;
        const int t = C.tid >> 3, cg = C.tid & 7, n = C.lane & 31, hi = C.lane >> 5;
        ConvIn ibc[4];
#pragma unroll
        for (int q = 0; q < 4; ++q) ibc[q] = ssd_conv_ld(P, bc, t, 512 + (q >> 1) * 256 + g * 128 + cg * 16 + (q & 1) * 8);
        u32x4 xw[4];
#pragma unroll
        for (int hh = 0; hh < 4; ++hh) xw[hh] = *(const GAS u32x4*)(YS + ((size_t)bc * 64 + t) * 2048 + 1024 + (4 * g + hh) * 64 + cg * 8);
        u32x4 hq[2][4]; float dq[2][2];
#define SSC_LD(hp_) do { _Pragma("unroll") for (int s_ = 0; s_ < 2; ++s_) { const size_t item8_ = (size_t)bc * 8 + 4 * g + 2 * (hp_) + s_; const GAS bf16* sp_ = SST + (item8_ * 64 + (C.tid >> 3)) * 128 + (C.tid & 7) * 16; \
            hq[hp_][2 * s_] = *(const GAS u32x4*)sp_; hq[hp_][2 * s_ + 1] = *(const GAS u32x4*)(sp_ + 8); } \
          { const int s_ = (C.tid >> 6) & 1, i_ = C.tid & 63, hd_ = 4 * g + 2 * (hp_) + s_; const size_t row_ = (size_t)bc * 64 + i_; dq[hp_][0] = SDT[row_ * 8 + hd_]; dq[hp_][1] = SAC[row_ * 8 + hd_]; } } while (0)
        SSC_LD(0);
        __builtin_amdgcn_sched_barrier(0);
        RW_BAR();
        { float o[8];
#pragma unroll
          for (int q = 0; q < 4; ++q) { const int lj = (q >> 1) * 128 + cg * 16 + (q & 1) * 8; const int pos = (bc & 127) * 64 + t;
              { const f32x4 b0 = *(const LAS f32x4*)(cwt + 1024 + lj), b1 = *(const LAS f32x4*)(cwt + 1024 + lj + 4);
#pragma unroll
                for (int i = 0; i < 4; ++i) { o[i] = b0[i]; o[4 + i] = b1[i]; } }
#pragma unroll
              for (int tap = 0; tap < 4; ++tap) { const bool inr = pos - 3 + tap >= 0; float x[8]; unpack8(ibc[q].x[tap], x);
                  const f32x4 w0 = *(const LAS f32x4*)(cwt + tap * 256 + lj), w1 = *(const LAS f32x4*)(cwt + tap * 256 + lj + 4);
#pragma unroll
                  for (int i = 0; i < 4; ++i) { o[i] += w0[i] * (inr ? x[i] : 0.f); o[4 + i] += w1[i] * (inr ? x[4 + i] : 0.f); } }
#pragma unroll
              for (int i = 0; i < 8; ++i) o[i] = siluf_(o[i]);
              *(LAS u32x4*)(((q >> 1) ? CN : BN) + t * 136 + cg * 16 + (q & 1) * 8) = pack8(o); } }
        RW_BAR();
        if (C.wave < 4) {
            const int it_ = C.wave >> 1, jt = C.wave & 1;
            f32x16 acc = zero16(); mma_nt<128>(acc, CN, 136, 32 * it_, BN, 136, 32 * jt, C.lane);
#pragma unroll
            for (int r = 0; r < 16; ++r) CB[(32 * it_ + crow(r, hi)) * 68 + 32 * jt + n] = acc[r];
        }
        float yk[2][16]; float ssq = 0.f;
        const int pt = (C.wave >> 1) & 1, it2 = C.wave & 1;
#pragma unroll
        for (int hp = 0; hp < 2; ++hp) {
            RW_BAR();
            if (C.tid < 128) { dtv[C.tid] = dq[hp][0]; acu[C.tid] = dq[hp][1]; }
#pragma unroll
            for (int s = 0; s < 2; ++s) { const int hd = 4 * g + 2 * hp + s; const size_t item8 = (size_t)bc * 8 + hd; LB XSTs = (LB)(C.lds + 52224 + s * 35840) + 64 * 72; LB HPs = XSTs + 64 * 72;
                { const u32x4 xq = xw[2 * hp + s]; const unsigned xv[4] = {xq.x, xq.y, xq.z, xq.w};
#pragma unroll
                  for (int i = 0; i < 4; ++i) { XSTs[(cg * 8 + 2 * i) * 72 + t] = (bf16)(xv[i] & 0xffffu); XSTs[(cg * 8 + 2 * i + 1) * 72 + t] = (bf16)(xv[i] >> 16); } }
                const int p = C.tid >> 3, n0 = (C.tid & 7) * 16; (void)item8;
                *(LAS u32x4*)(HPs + p * 136 + n0) = hq[hp][2 * s]; *(LAS u32x4*)(HPs + p * 136 + n0 + 8) = hq[hp][2 * s + 1]; }
            if (hp == 0) SSC_LD(1);
            RW_BAR();
#pragma unroll
            for (int s = 0; s < 2; ++s) { LB SCs = (LB)(C.lds + 52224 + s * 35840); const float ai = acu[s * 64 + t]; float o[8];
#pragma unroll
                for (int jj = 0; jj < 8; ++jj) { const int j = 8 * cg + jj; o[jj] = (j <= t) ? CB[t * 68 + j] * __expf(ai - acu[s * 64 + j]) * dtv[s * 64 + j] : 0.f; }
                *(LAS u32x4*)(SCs + t * 72 + 8 * cg) = pack8(o); }
            RW_BAR();
            {
                const int hd = 4 * g + 2 * hp + hs; const int i = 32 * it2 + n; const size_t row = (size_t)bc * 64 + i; const float dh = dpar[hd];
                u32x2 zq[4];
#pragma unroll
                for (int q4 = 0; q4 < 4; ++q4) zq[q4] = *(const GAS u32x2*)(P + row * NPM + C_SZ + hd * 64 + 32 * pt + 8 * q4 + 4 * hi);
                __builtin_amdgcn_sched_barrier(0);
                f32x16 acc = zero16();
                mma_nt<128>(acc, HPw, 136, 32 * pt, CN, 136, 32 * it2, C.lane);
                const float ea = __expf(acu[hs * 64 + i]);
#pragma unroll
                for (int r = 0; r < 16; ++r) acc[r] *= ea;
                mma_nt<64>(acc, XSTw, 72, 32 * pt, SCw, 72, 32 * it2, C.lane);
#pragma unroll
                for (int q4 = 0; q4 < 4; ++q4) { const int p0 = 32 * pt + 8 * q4 + 4 * hi;
                    const u32x2 zw = zq[q4]; const float zf[4] = {bflo(zw.x), bfhi(zw.x), bflo(zw.y), bfhi(zw.y)};
#pragma unroll
                    for (int e = 0; e < 4; ++e) { const float xs = bf2f(XSTw[(p0 + e) * 72 + i]); const float v = (acc[4 * q4 + e] + dh * xs) * siluf_(zf[e]); yk[hp][4 * q4 + e] = v; ssq += v * v; } }
            }
        }
        { ssq += __shfl_xor(ssq, 32); if (hi == 0) PSQ[(32 * it2 + n) * 4 + pt * 2 + hs] = ssq; }
        RW_BAR();
        {   const int i = 32 * it2 + n; const f32x4 ps = *(const LAS f32x4*)(PSQ + i * 4); const float rs = 1.0f / sqrtf(((ps[0] + ps[1]) + (ps[2] + ps[3])) * (1.0f / 256.0f) + EPS); const size_t row = (size_t)bc * 64 + i;
#pragma unroll
            for (int hp = 0; hp < 2; ++hp)
#pragma unroll
                for (int q4 = 0; q4 < 4; ++q4) { const int ch = g * 256 + (2 * hp + hs) * 64 + 32 * pt + 8 * q4 + 4 * hi; const f32x4 sn = *(const GAS f32x4*)(snorm + ch);
                    u32x2 w; w.x = pk2(yk[hp][4 * q4] * rs * sn[0], yk[hp][4 * q4 + 1] * rs * sn[1]); w.y = pk2(yk[hp][4 * q4 + 2] * rs * sn[2], yk[hp][4 * q4 + 3] * rs * sn[3]);
                    *(GAS u32x2*)(YS + row * 2048 + 1024 + ch) = w; }
        }
    }
    WG_SYNC();
}
#undef SSC_LD

struct LerpIn { u32x4 x, xp; };
__device__ __forceinline__ LerpIn rw_lerp_ld(const GAS bf16* P, size_t row, bool first, int c0) {
    LerpIn r; r.x = *(const GAS u32x4*)(P + row * NPM + C_RR + c0); r.xp = *(const GAS u32x4*)(P + (row - (first ? 0 : 1)) * NPM + C_RR + c0); return r; }
__device__ __forceinline__ void rw_lerp_fin(const LerpIn& in, bool first, const LAS float* mus, float* o) {
    float x[8], xp[8]; unpack8(in.x, x); unpack8(in.xp, xp); const f32x4 m0 = *(const LAS f32x4*)mus, m1 = *(const LAS f32x4*)(mus + 4);
#pragma unroll
    for (int i = 0; i < 8; ++i) { const float d = (first ? 0.f : xp[i]) - x[i]; o[i] = x[i] + d * (i < 4 ? m0[i] : m1[i - 4]); }
}
#define RW_WFRAG(WT_, K_, nt_, s_) (*(const GAS pg8::bf16x8*)((WT_) + (size_t)(head * 64 + 32 * (nt_) + n) * (K_) + 16 * (s_) + 8 * hi))
#define RWP_PTRS \
    const GAS bf16* P = (const GAS bf16*)(C.ws + WS_P); \
    GAS float* RWW = (GAS float*)(C.ws + WS_RWW); GAS bf16* RWR = (GAS bf16*)(C.ws + WS_RWR); GAS bf16* RWK = (GAS bf16*)(C.ws + WS_RWK); GAS bf16* RWV = (GAS bf16*)(C.ws + WS_RWV); GAS bf16* RWKK = (GAS bf16*)(C.ws + WS_RWKK); GAS bf16* RWB = (GAS bf16*)(C.ws + WS_RWB); GAS bf16* RWG = (GAS bf16*)(C.ws + WS_RWG); \
    const GAS bf16* W2T = (const GAS bf16*)(C.ws + WS_RW2T); const GAS bf16* A2T = W2T + 512 * 64; const GAS bf16* G2T = A2T + 512 * 64;       \
    const GAS float* mu = a->in[21] + (size_t)l * 1792; const GAS float* w0 = a->in[22] + (size_t)l * 512; const GAS float* a0 = a->in[24] + (size_t)l * 512; \
    const GAS float* k_k = a->in[27] + (size_t)l * 512; const GAS float* k_a = a->in[28] + (size_t)l * 512; \
    LB WLb = (LB)C.lds; LB ALb = (LB)(C.lds + 9216); LB GLb = (LB)(C.lds + 18432);         \
    LB KX = (LB)(C.lds + 35840); LF w0s = (LF)(C.lds + 102400); LF a0s = w0s + 512; LF kks = a0s + 512; LF kas = kks + 512; LF INVs = kas + 512; LF mus = INVs + 512;     \
    (void)mus; (void)KX; (void)w0s; (void)a0s; (void)kks; (void)kas; (void)INVs; \
    (void)P; (void)RWW; (void)RWR; (void)RWK; (void)RWV; (void)RWKK; (void)RWB; (void)RWG; (void)W2T; (void)A2T; (void)G2T; (void)mu; (void)w0; (void)a0; (void)k_k; (void)k_a; (void)WLb; (void)ALb; (void)GLb;
#define RWP_LANE const int head = C.wave, n = C.lane & 31, hi = C.lane >> 5; const size_t row0 = (size_t)bc * 64 + 32 * tt; (void)row0;
PH_FN void rwp_stage(const Ctx C, ArgsP a, int l, int bc) {
    RWP_PTRS
    const int t = C.tid >> 3, cg = C.tid & 7; const size_t row = (size_t)bc * 64 + t; const bool first = ((bc & 127) == 0) && (t == 0);
    const LerpIn iw = rw_lerp_ld(P, row, first, 1536 + cg * 8), ia = rw_lerp_ld(P, row, first, 1600 + cg * 8), ig0 = rw_lerp_ld(P, row, first, 1664 + cg * 16), ig1 = rw_lerp_ld(P, row, first, 1664 + cg * 16 + 8);
    LerpIn cr = rw_lerp_ld(P, row, first, cg * 8), cv = rw_lerp_ld(P, row, first, 1024 + cg * 8), ck = rw_lerp_ld(P, row, first, 512 + cg * 8);
    const int q = C.tid * 4; const f32x4 pv = *(const GAS f32x4*)((q < 512 ? w0 : q < 1024 ? a0 - 512 : q < 1536 ? k_k - 1024 : k_a - 1536) + q); const f32x4 mv = *(const GAS f32x4*)(mu + (C.tid < 448 ? q : 0));
    WG_SYNC();
    *(LAS f32x4*)(w0s + q) = pv; if (C.tid < 448) *(LAS f32x4*)(mus + q) = mv;
    WG_SYNC();
    { float o[8];
      rw_lerp_fin(iw, first, mus + 1536 + cg * 8, o);
#pragma unroll
      for (int i = 0; i < 8; ++i) o[i] = tanhf(o[i]);
      *(LAS u32x4*)(WLb + t * 72 + cg * 8) = pack8(o);
      rw_lerp_fin(ia, first, mus + 1600 + cg * 8, o); *(LAS u32x4*)(ALb + t * 72 + cg * 8) = pack8(o);
      rw_lerp_fin(ig0, first, mus + 1664 + cg * 16, o);
#pragma unroll
      for (int i = 0; i < 8; ++i) o[i] = sigmoidf_(o[i]);
      *(LAS u32x4*)(GLb + t * 136 + cg * 16) = pack8(o);
      rw_lerp_fin(ig1, first, mus + 1664 + cg * 16 + 8, o);
#pragma unroll
      for (int i = 0; i < 8; ++i) o[i] = sigmoidf_(o[i]);
      *(LAS u32x4*)(GLb + t * 136 + cg * 16 + 8) = pack8(o);
#pragma unroll
      for (int j = 0; j < 8; ++j) { const int c = j * 64 + cg * 8;
          LerpIn nr = cr, nv = cv, nk = ck;
          if (j < 7) { nr = rw_lerp_ld(P, row, first, c + 64); nv = rw_lerp_ld(P, row, first, 1024 + c + 64); nk = rw_lerp_ld(P, row, first, 512 + c + 64); }
          rw_lerp_fin(cr, first, mus + c, o); *(GAS u32x4*)(RWR + row * 512 + c) = pack8(o);
          rw_lerp_fin(cv, first, mus + 1024 + c, o); *(GAS u32x4*)(RWV + row * 512 + c) = pack8(o);
          rw_lerp_fin(ck, first, mus + 512 + c, o); *(LAS u32x4*)(KX + t * 520 + c) = pack8(o);
          const f32x4 k0 = *(const LAS f32x4*)(kks + c), k1 = *(const LAS f32x4*)(kks + c + 4); float ss = 0.f;
#pragma unroll
          for (int i = 0; i < 4; ++i) { const float q0 = o[i] * k0[i], q1 = o[4 + i] * k1[i]; ss += q0 * q0 + q1 * q1; }
          ss += __shfl_xor(ss, 1); ss += __shfl_xor(ss, 2); ss += __shfl_xor(ss, 4);
          if (cg == 0) INVs[t * 8 + j] = 1.0f / fmaxf(sqrtf(ss), 1e-12f);
          cr = nr; cv = nv; ck = nk; } }
    WG_SYNC();
}
PH_FN void rwp_w(const Ctx C, ArgsP a, int l, int bc, int tt) {
    RWP_PTRS RWP_LANE
    pg8::bf16x8 wf[2][4]; f32x16 c[2] = {zero16(), zero16()};
#pragma unroll
    for (int nt = 0; nt < 2; ++nt)
#pragma unroll
        for (int s4 = 0; s4 < 4; ++s4) wf[nt][s4] = RW_WFRAG(W2T, 64, nt, s4);
#pragma unroll
    for (int s4 = 0; s4 < 4; ++s4) { const pg8::bf16x8 af = frag32(WLb, 72, 32 * tt, 16 * s4, C.lane);
#pragma unroll
        for (int nt = 0; nt < 2; ++nt) c[nt] = __builtin_amdgcn_mfma_f32_32x32x16_bf16(af, wf[nt][s4], c[nt], 0, 0, 0); }
#pragma unroll
    for (int nt = 0; nt < 2; ++nt) { const int ch = head * 64 + 32 * nt + n; const float w0c = w0s[ch];
#pragma unroll
        for (int r = 0; r < 16; ++r) RWW[(row0 + crow(r, hi)) * 512 + ch] = -0.606531f * sigmoidf_(w0c + c[nt][r]); }
}
PH_FN void rwp_g(const Ctx C, ArgsP a, int l, int bc, int tt) {
    RWP_PTRS RWP_LANE
    pg8::bf16x8 wf[2][8]; f32x16 c[2] = {zero16(), zero16()};
#pragma unroll
    for (int nt = 0; nt < 2; ++nt)
#pragma unroll
        for (int s8 = 0; s8 < 8; ++s8) wf[nt][s8] = RW_WFRAG(G2T, 128, nt, s8);
#pragma unroll
    for (int s8 = 0; s8 < 8; ++s8) { const pg8::bf16x8 af = frag32(GLb, 136, 32 * tt, 16 * s8, C.lane);
#pragma unroll
        for (int nt = 0; nt < 2; ++nt) c[nt] = __builtin_amdgcn_mfma_f32_32x32x16_bf16(af, wf[nt][s8], c[nt], 0, 0, 0); }
#pragma unroll
    for (int nt = 0; nt < 2; ++nt) { const int ch = head * 64 + 32 * nt + n;
#pragma unroll
        for (int r = 0; r < 16; ++r) RWG[(row0 + crow(r, hi)) * 512 + ch] = (bf16)f2bf(c[nt][r]); }
}
PH_FN void rwp_ak(const Ctx C, ArgsP a, int l, int bc, int tt) {
    RWP_PTRS RWP_LANE
    pg8::bf16x8 wf[2][4]; f32x16 c[2] = {zero16(), zero16()};
#pragma unroll
    for (int nt = 0; nt < 2; ++nt)
#pragma unroll
        for (int s4 = 0; s4 < 4; ++s4) wf[nt][s4] = RW_WFRAG(A2T, 64, nt, s4);
#pragma unroll
    for (int s4 = 0; s4 < 4; ++s4) { const pg8::bf16x8 af = frag32(ALb, 72, 32 * tt, 16 * s4, C.lane);
#pragma unroll
        for (int nt = 0; nt < 2; ++nt) c[nt] = __builtin_amdgcn_mfma_f32_32x32x16_bf16(af, wf[nt][s4], c[nt], 0, 0, 0); }
#pragma unroll
    for (int nt = 0; nt < 2; ++nt) { const int ch = head * 64 + 32 * nt + n; const float a0c = a0s[ch], kkc = kks[ch], kac = kas[ch];
#pragma unroll
        for (int r = 0; r < 16; ++r) { const int tl = 32 * tt + crow(r, hi); const float al = sigmoidf_(a0c + c[nt][r]), x = bf2f(KX[tl * 520 + ch]), kkn = x * kkc * INVs[tl * 8 + head];
            const size_t g = ((size_t)bc * 64 + tl) * 512 + ch;
            RWKK[g] = (bf16)f2bf(kkn); RWB[g] = (bf16)f2bf(kkn * al); RWK[g] = (bf16)f2bf(x * (1.0f + (al - 1.0f) * kac)); } }
}
#undef RW_WFRAG
#undef RWP_PTRS
#undef RWP_LANE
__device__ __forceinline__ void ph_rw_prep(const Ctx& C, ArgsP a, int l) {
    for (int bc = C.bid; bc < NBC; bc += C.G) { rwp_stage(C, a, l, bc);
#pragma unroll 1
        for (int tt = 0; tt < 2; ++tt) { rwp_w(C, a, l, bc, tt); rwp_g(C, a, l, bc, tt); rwp_ak(C, a, l, bc, tt); } }
    WG_SYNC();
}
PH_FN void ph_rw_out(const Ctx C, ArgsP a, int l) {
    const GAS bf16* RWR = (const GAS bf16*)(C.ws + WS_RWR); const GAS bf16* RWK = (const GAS bf16*)(C.ws + WS_RWK); const GAS bf16* RWV = (const GAS bf16*)(C.ws + WS_RWV); const GAS bf16* RWG = (const GAS bf16*)(C.ws + WS_RWG); const GAS bf16* RWY = (const GAS bf16*)(C.ws + WS_RWY);
    GAS bf16* YS = (GAS bf16*)(C.ws + WS_YS);
    const GAS float* r_k = a->in[29] + (size_t)l * 512; const GAS float* nw = a->in[30] + (size_t)l * 512; const GAS float* nb = a->in[31] + (size_t)l * 512;
    const int gw = C.bid * NWAVES + C.wave, NGW = C.G * NWAVES, c0 = C.lane * 8;
    float rk[8], w8[8], b8[8];
#pragma unroll
    for (int i = 0; i < 8; ++i) { rk[i] = r_k[c0 + i]; w8[i] = nw[c0 + i]; b8[i] = nb[c0 + i]; }
    u32x4 nyw[2], nrw[2], nkw[2], nvw[2], ngw[2];
#define RWO_LD(r0_) do { _Pragma("unroll") for (int u = 0; u < 2; ++u) { const size_t g = (size_t)((r0_) + u) * 512 + c0; nyw[u] = *(const GAS u32x4*)(RWY + g); nrw[u] = *(const GAS u32x4*)(RWR + g); nkw[u] = *(const GAS u32x4*)(RWK + g); nvw[u] = *(const GAS u32x4*)(RWV + g); ngw[u] = *(const GAS u32x4*)(RWG + g); } } while (0)
    if (gw * 2 < M) RWO_LD(gw * 2);
#pragma unroll 1
    for (int row0 = gw * 2; row0 < M; row0 += NGW * 2) {
        u32x4 yw[2], rw[2], kw[2], vw[2], gw4[2];
#pragma unroll
        for (int u = 0; u < 2; ++u) { yw[u] = nyw[u]; rw[u] = nrw[u]; kw[u] = nkw[u]; vw[u] = nvw[u]; gw4[u] = ngw[u]; }
        if (row0 + NGW * 2 < M) RWO_LD(row0 + NGW * 2);
#pragma unroll
        for (int u = 0; u < 2; ++u) { float y[8], r[8], k[8], v[8], gg[8], o[8]; unpack8(yw[u], y); unpack8(rw[u], r); unpack8(kw[u], k); unpack8(vw[u], v); unpack8(gw4[u], gg);
            float s = 0.f, bs = 0.f;
#pragma unroll
            for (int i = 0; i < 8; ++i) { s += y[i]; bs += r[i] * k[i] * rk[i]; }
            s += __shfl_xor(s, 1); s += __shfl_xor(s, 2); s += __shfl_xor(s, 4); bs += __shfl_xor(bs, 1); bs += __shfl_xor(bs, 2); bs += __shfl_xor(bs, 4);
            const float mu = s * (1.0f / 64.0f); float q = 0.f;
#pragma unroll
            for (int i = 0; i < 8; ++i) { y[i] -= mu; q += y[i] * y[i]; }
            q += __shfl_xor(q, 1); q += __shfl_xor(q, 2); q += __shfl_xor(q, 4);
            const float rs = 1.0f / sqrtf(q * (1.0f / 64.0f) + 64e-5f);
#pragma unroll
            for (int i = 0; i < 8; ++i) o[i] = (y[i] * rs * w8[i] + b8[i] + bs * v[i]) * gg[i];
            *(GAS u32x4*)(YS + (size_t)(row0 + u) * 2048 + 1536 + c0) = pack8(o); }
    }
#undef RWO_LD
}

__device__ __forceinline__ int pi_swap23(int i) { return (i & ~12) | ((i & 4) << 1) | ((i & 8) >> 1); }
__device__ __forceinline__ void da_unit(const Ctx& C, const Args& a, int l, int b, int h, int jq, float lam, float oml) {
    const GAS bf16* P = (const GAS bf16*)(C.ws + WS_P); GAS bf16* YS = (GAS bf16*)(C.ws + WS_YS);
    const GAS float* dnorm = (const GAS float*)a.in[11] + (size_t)l * 128;
    const int comp = C.wave >> 2, wq = C.wave & 3, q = C.lane & 31, hi = C.lane >> 5;
    const size_t qrow = (size_t)b * SEQ + jq * 128 + wq * 32 + q;
    pg8::bf16x8 qf[4];
#pragma unroll
    for (int d0 = 0; d0 < 4; ++d0) qf[d0] = *(const GAS pg8::bf16x8*)(P + qrow * NPM + C_DAQ + h * 128 + comp * 64 + 16 * d0 + 8 * hi);
    const int ntile = 2 * jq + 2, my_last = 2 * jq + (wq >= 2 ? 1 : 0);
    f32x16 O[4];
#pragma unroll
    for (int db = 0; db < 4; ++db)
#pragma unroll
        for (int r = 0; r < 16; ++r) O[db][r] = 0.f;
    float mrun = 0.f, lrun = 0.f;
    f32x16 negm;
#pragma unroll
    for (int r = 0; r < 16; ++r) negm[r] = 0.f;
    const GAS bf16* kgb = P + (size_t)b * SEQ * NPM + C_DAK + h * 128 + C.wave * 8;
    const GAS bf16* vgb = P + (size_t)b * SEQ * NPM + C_DAV + h * 128;
    const unsigned vslot_p = (unsigned)C.wave * 64u + (unsigned)C.lane, vrow_p = 8u * (vslot_p >> 7) + ((vslot_p >> 2) & 7u), vch_p = 4u * ((vslot_p >> 5) & 3u) + ((vslot_p & 3u) ^ ((vrow_p >> 2) & 3u));
    const unsigned koff = (unsigned)C.lane * (unsigned)(NPM * 2), voff = vrow_p * (unsigned)(NPM * 2) + vch_p * 16u;
    const unsigned lds0 = (unsigned)(size_t)C.lds;
    const unsigned kdst0 = lds0 + (unsigned)(C.wave >> 3) * 8192u + (unsigned)(C.wave & 7) * 1024u;
    const unsigned vdst0 = lds0 + 49152u + (unsigned)C.wave * 1024u;
    const unsigned vtr_c = 2u * ((unsigned)(C.lane >> 4) & 1u) + (((unsigned)C.lane & 3u) >> 1), vtr_q = ((unsigned)C.lane & 15u) >> 2;
    const unsigned vtb0 = 2048u * (unsigned)hi + 64u * vtr_q + 8u * ((unsigned)C.lane & 1u) + 16u * (vtr_c ^ ((2u * (unsigned)hi) & 3u));
    const unsigned vtb1 = 2048u * (unsigned)hi + 64u * (4u + vtr_q) + 8u * ((unsigned)C.lane & 1u) + 16u * (vtr_c ^ ((2u * (unsigned)hi + 1u) & 3u));
    typedef short v4i16_da __attribute__((ext_vector_type(4)));
#define DA_VTR(base_, off_) ({ const v4i16_da lo_ = __builtin_amdgcn_ds_read_tr16_b64_v4i16((LAS v4i16_da*)((base_) + vtb0 + (off_))), hi_ = __builtin_amdgcn_ds_read_tr16_b64_v4i16((LAS v4i16_da*)((base_) + vtb1 + (off_))); \
        (pg8::bf16x8)__builtin_shufflevector(lo_, hi_, 0, 1, 2, 3, 4, 5, 6, 7); })
    const int pq = pi_swap23(q);
    pg8::bf16x8 pb[4] = {};
    int ks = 0;
#define DA_ROT(x_) (((x_) == 32768) ? 0 : (x_) + 16384)
#define DA_GLDS(base_, off_, dst_) do { unsigned keep_; asm volatile("s_mov_b32 %0, m0\n\ts_mov_b32 m0, %3\n\ts_nop 0\n\tglobal_load_lds_dwordx4 %1, %2\n\ts_mov_b32 m0, %0" : "=&s"(keep_) : "v"(off_), "s"(base_), "s"((unsigned)__builtin_amdgcn_readfirstlane(dst_)) : "memory"); } while (0)
#define DA_DMA(tile_, kslot_) do { const GAS bf16* kp_ = kgb + (size_t)(tile_) * 64 * NPM; const GAS bf16* vp_ = vgb + (size_t)(tile_) * 64 * NPM; const unsigned kd_ = kdst0 + (unsigned)(kslot_), vd_ = vdst0 + (unsigned)((tile_) & 3) * 16384u; \
        DA_GLDS(kp_, koff, kd_); DA_GLDS(kp_ + 64, koff, kd_ + 8192u); DA_GLDS(vp_, voff, vd_); DA_GLDS(vp_ + 32 * NPM, voff, vd_ + 8192u); } while (0)
#define DA_STAGE(tile_) do { if ((tile_) + 1 < ntile) asm volatile("s_waitcnt vmcnt(4)" ::: "memory"); else asm volatile("s_waitcnt vmcnt(0)" ::: "memory"); RW_BAR(); if ((tile_) + 2 < ntile) DA_DMA((tile_) + 2, DA_ROT(DA_ROT(ks))); } while (0)
#define DA_QK(tile_) do { const LAS unsigned char* kb_ = C.lds + ks + comp * 8192 + hi * 1024 + pq * 16; pg8::bf16x8 ka_[8]; \
        _Pragma("unroll") for (int d0 = 0; d0 < 4; ++d0) { ka_[2 * d0] = *(const LAS pg8::bf16x8*)(kb_ + d0 * 2048); ka_[2 * d0 + 1] = *(const LAS pg8::bf16x8*)(kb_ + d0 * 2048 + 512); } \
        __builtin_amdgcn_sched_barrier(0); \
        p0 = __builtin_amdgcn_mfma_f32_32x32x16_bf16(ka_[0], qf[0], negm, 0, 0, 0); p1 = __builtin_amdgcn_mfma_f32_32x32x16_bf16(ka_[1], qf[0], negm, 0, 0, 0); \
        _Pragma("unroll") for (int d0 = 1; d0 < 4; ++d0) { p0 = __builtin_amdgcn_mfma_f32_32x32x16_bf16(ka_[2 * d0], qf[d0], p0, 0, 0, 0); p1 = __builtin_amdgcn_mfma_f32_32x32x16_bf16(ka_[2 * d0 + 1], qf[d0], p1, 0, 0, 0); } } while (0)
#define DA_PV(PB_, voff_) do { const LAS unsigned char* vb_ = C.lds + 49152 + (voff_); _Pragma("unroll") for (int db = 0; db < 4; ++db) _Pragma("unroll") for (int s = 0; s < 4; ++s) { \
            const pg8::bf16x8 vf_ = DA_VTR(vb_, 4096 * s + 512 * db); O[db] = __builtin_amdgcn_mfma_f32_32x32x16_bf16(vf_, PB_[s], O[db], 0, 0, 0); } } while (0)
#define DA_MX3(a_, b_, c_) __builtin_fmaxf(__builtin_fmaxf((a_), (b_)), (c_))
#define DA_SM_MAX(FIRST_, PBP_) do { \
        float ma = DA_MX3(p0[0], p0[1], p1[0]), mb = DA_MX3(p0[2], p0[3], p1[1]); ma = DA_MX3(ma, p1[2], p1[3]); \
        _Pragma("unroll") for (int r = 4; r < 16; r += 4) { ma = DA_MX3(ma, p0[r], p0[r + 1]); mb = DA_MX3(mb, p0[r + 2], p0[r + 3]); ma = DA_MX3(ma, p1[r], p1[r + 1]); mb = DA_MX3(mb, p1[r + 2], p1[r + 3]); } \
        float rm = __builtin_fmaxf(ma, mb); { const auto rr_ = __builtin_amdgcn_permlane32_swap(__float_as_uint(rm), __float_as_uint(rm), false, false); rm = __builtin_fmaxf(__uint_as_float(rr_[0]), __uint_as_float(rr_[1])); }   \
        if ((FIRST_) || __any(rm > 8.0f)) { const float dl = (FIRST_) ? rm : __builtin_fmaxf(rm, 0.f); mrun += dl; const float f = __builtin_amdgcn_exp2f(-dl); lrun *= f; \
            _Pragma("unroll") for (int r = 0; r < 16; ++r) { p0[r] -= dl; p1[r] -= dl; negm[r] = -mrun; } \
            _Pragma("unroll") for (int db = 0; db < 4; ++db) _Pragma("unroll") for (int r = 0; r < 16; ++r) O[db][r] *= f; \
            if (!(FIRST_)) { _Pragma("unroll") for (int s_ = 0; s_ < 4; ++s_) { const u32x4 w_ = __builtin_bit_cast(u32x4, PBP_[s_]); u32x4 o_; \
                o_.x = pk2(bflo(w_.x) * f, bfhi(w_.x) * f); o_.y = pk2(bflo(w_.y) * f, bfhi(w_.y) * f); o_.z = pk2(bflo(w_.z) * f, bfhi(w_.z) * f); o_.w = pk2(bflo(w_.w) * f, bfhi(w_.w) * f); PBP_[s_] = __builtin_bit_cast(pg8::bf16x8, o_); } } } } while (0)
#define DA_SM_EXP(PBO_) do { \
        _Pragma("unroll") for (int r = 0; r < 16; ++r) { p0[r] = __builtin_amdgcn_exp2f(p0[r]); p1[r] = __builtin_amdgcn_exp2f(p1[r]); } \
        { f32x2 s2 = {0.f, 0.f}; _Pragma("unroll") for (int r = 0; r < 16; r += 2) { s2 += (f32x2){p0[r], p0[r + 1]}; s2 += (f32x2){p1[r], p1[r + 1]}; } lrun += s2[0] + s2[1]; } \
        { u32x4 w; \
          w.x = pk2(p0[0], p0[1]); w.y = pk2(p0[2], p0[3]); w.z = pk2(p0[4], p0[5]); w.w = pk2(p0[6], p0[7]); PBO_[0] = __builtin_bit_cast(pg8::bf16x8, w); \
          w.x = pk2(p0[8], p0[9]); w.y = pk2(p0[10], p0[11]); w.z = pk2(p0[12], p0[13]); w.w = pk2(p0[14], p0[15]); PBO_[1] = __builtin_bit_cast(pg8::bf16x8, w); \
          w.x = pk2(p1[0], p1[1]); w.y = pk2(p1[2], p1[3]); w.z = pk2(p1[4], p1[5]); w.w = pk2(p1[6], p1[7]); PBO_[2] = __builtin_bit_cast(pg8::bf16x8, w); \
          w.x = pk2(p1[8], p1[9]); w.y = pk2(p1[10], p1[11]); w.z = pk2(p1[12], p1[13]); w.w = pk2(p1[14], p1[15]); PBO_[3] = __builtin_bit_cast(pg8::bf16x8, w); } } while (0)
#define DA_VADDR(i_) (((i_) & 3) * 4096 + ((i_) >> 2) * 512)
#define DA_PV_EXP(PBP_, voff_, PBO_) do { const LAS unsigned char* vb_ = C.lds + 49152 + (voff_); f32x2 s2_ = {0.f, 0.f}; unsigned pw_[16]; \
        pg8::bf16x8 vq_[4];   \
        vq_[0] = DA_VTR(vb_, DA_VADDR(0)); vq_[1] = DA_VTR(vb_, DA_VADDR(1)); vq_[2] = DA_VTR(vb_, DA_VADDR(2)); \
        _Pragma("unroll") for (int i_ = 0; i_ < 16; ++i_) { const int db_ = i_ >> 2, s_ = i_ & 3; \
            if (i_ + 3 < 16) vq_[(i_ + 3) & 3] = DA_VTR(vb_, DA_VADDR(i_ + 3)); \
            O[db_] = __builtin_amdgcn_mfma_f32_32x32x16_bf16(vq_[i_ & 3], PBP_[s_], O[db_], 0, 0, 0); \
            float e0_, e1_; if (i_ < 8) { e0_ = __builtin_amdgcn_exp2f(p0[2 * i_]); e1_ = __builtin_amdgcn_exp2f(p0[2 * i_ + 1]); } else { e0_ = __builtin_amdgcn_exp2f(p1[2 * i_ - 16]); e1_ = __builtin_amdgcn_exp2f(p1[2 * i_ - 15]); } \
            s2_ += (f32x2){e0_, e1_}; pw_[i_] = pk2(e0_, e1_); \
            __builtin_amdgcn_sched_barrier(0); } \
        lrun += s2_[0] + s2_[1]; \
        _Pragma("unroll") for (int k_ = 0; k_ < 4; ++k_) { u32x4 w_; w_.x = pw_[4 * k_]; w_.y = pw_[4 * k_ + 1]; w_.z = pw_[4 * k_ + 2]; w_.w = pw_[4 * k_ + 3]; PBO_[k_] = __builtin_bit_cast(pg8::bf16x8, w_); } } while (0)
    f32x16 p0, p1;
    if (comp == 0) __builtin_amdgcn_s_setprio(1);
    DA_DMA(0, 0); DA_DMA(1, 16384);
    DA_STAGE(0); DA_QK(0); DA_SM_MAX(true, pb); DA_SM_EXP(pb);
    for (int tile = 1; tile <= my_last; ++tile) {
        ks = DA_ROT(ks);
        DA_STAGE(tile); DA_QK(tile); DA_SM_MAX(false, pb);
        DA_PV_EXP(pb, ((tile - 1) & 3) * 16384, pb);
    }
    if (my_last < ntile - 1) { ks = DA_ROT(ks); DA_STAGE(ntile - 1); }
    __builtin_amdgcn_s_setprio(0);
    DA_PV(pb, (my_last & 3) * 16384);
#undef DA_GLDS
#undef DA_ROT
#undef DA_DMA
#undef DA_STAGE
#undef DA_QK
#undef DA_PV
#undef DA_MX3
#undef DA_SM_MAX
#undef DA_SM_EXP
#undef DA_PV_EXP
#undef DA_VADDR
#undef DA_VTR
    const float ltot = lrun + __shfl_xor(lrun, 32); const float inv = 1.0f / ltot;
    WG_SYNC();
    LF X = (LF)C.lds + (wq * 32 + q) * 132;
    if (comp == 1) {
        const float sc = inv * lam;
#pragma unroll
        for (int db = 0; db < 4; ++db)
#pragma unroll
            for (int g4 = 0; g4 < 4; ++g4) *(LAS f32x4*)(X + 32 * db + 8 * g4 + 4 * hi) = (f32x4){O[db][4 * g4] * sc, O[db][4 * g4 + 1] * sc, O[db][4 * g4 + 2] * sc, O[db][4 * g4 + 3] * sc};
    }
    WG_SYNC();
    if (comp == 0) {
        float ss = 0.f;
#pragma unroll
        for (int db = 0; db < 4; ++db)
#pragma unroll
            for (int g4 = 0; g4 < 4; ++g4) { const f32x4 x = *(const LAS f32x4*)(X + 32 * db + 8 * g4 + 4 * hi);
#pragma unroll
                for (int e = 0; e < 4; ++e) { const float v = O[db][4 * g4 + e] * inv - x[e]; O[db][4 * g4 + e] = v; ss += v * v; } }
        ss += __shfl_xor(ss, 32);
        const float rs = oml / sqrtf(ss * (1.0f / 128.0f) + EPS);
#pragma unroll
        for (int db = 0; db < 4; ++db)
#pragma unroll
            for (int g4 = 0; g4 < 4; ++g4) { const int d = 32 * db + 8 * g4 + 4 * hi; const f32x4 gn = *(const GAS f32x4*)(dnorm + d);
                u32x2 w; w.x = pk2(O[db][4 * g4] * rs * gn[0], O[db][4 * g4 + 1] * rs * gn[1]); w.y = pk2(O[db][4 * g4 + 2] * rs * gn[2], O[db][4 * g4 + 3] * rs * gn[3]);
                *(GAS u32x2*)(YS + qrow * 2048 + h * 128 + d) = w; }
    }
    WG_SYNC();
}
__device__ const signed char ATT_BINS30[30][3] = {{63,4,3}, {62,5,2}, {61,6,1}, {60,7,0}, {59,8,-1}, {58,9,-1}, {57,10,-1}, {56,11,-1}, {55,12,-1}, {54,13,-1}, {53,14,-1}, {52,15,-1}, {51,16,-1}, {50,17,-1}, {49,18,-1}, {48,19,-1}, {47,20,-1}, {46,21,-1}, {45,22,-1}, {44,23,-1}, {43,24,-1}, {42,25,-1}, {41,26,-1}, {40,27,-1}, {39,28,-1}, {38,29,-1}, {37,30,-1}, {36,31,-1}, {35,32,-1}, {34,33,-1}};
__device__ __forceinline__ int att_bin_unit(int bin, int i) { return i < 3 ? (int)ATT_BINS30[bin][i] : -1; }
__device__ __forceinline__ void ph_da_attn(const Ctx& C, const Args& a, int l, int bh, int bin) {
    const GAS float* q1 = (const GAS float*)a.in[7] + (size_t)l * 64; const GAS float* k1 = (const GAS float*)a.in[8] + (size_t)l * 64; const GAS float* q2 = (const GAS float*)a.in[9] + (size_t)l * 64; const GAS float* k2 = (const GAS float*)a.in[10] + (size_t)l * 64;
    float s1 = 0.f, s2 = 0.f;
    for (int i = 0; i < 64; ++i) { s1 += q1[i] * k1[i]; s2 += q2[i] * k2[i]; }
    int ll = l; asm volatile("" : "+s"(ll));
    const float lam_init = 0.8f - 0.6f * expf(-0.3f * (float)ll); const float lam_v = expf(s1) - expf(s2) + lam_init;
    const float lam = __uint_as_float(__builtin_amdgcn_readfirstlane(__float_as_uint(lam_v))), oml = __uint_as_float(__builtin_amdgcn_readfirstlane(__float_as_uint(1.0f - lam_init)));
    for (int i = 0; i < 12; ++i) { const int jq = att_bin_unit(bin, i); if (jq < 0) break; da_unit(C, a, l, bh >> 2, bh & 3, jq, lam, oml); }
}

PH_FN void ph_final(const Ctx C, ArgsP a) {
    const GAS float* ssq = (const GAS float*)(C.ws + WS_SSQ); const GAS float* fn = a->in[39]; const GAS bf16* hb = (const GAS bf16*)(C.ws + WS_HB);
    const int gw = C.bid * NWAVES + C.wave, NGW = C.G * NWAVES;
    u32x2 nw[4]; f32x4 nq;
#define FIN_LD(m_) do { const GAS u32x2* hr_ = (const GAS u32x2*)(hb + (size_t)(m_) * D) + C.lane; _Pragma("unroll") for (int j = 0; j < 4; ++j) nw[j] = hr_[64 * j]; nq = *(const GAS f32x4*)(ssq + (size_t)(m_) * 4); } while (0)
    const GAS f32x4* gr = (const GAS f32x4*)fn + C.lane; f32x4 g4[4];
#pragma unroll
    for (int j = 0; j < 4; ++j) g4[j] = gr[64 * j];
    if (gw < M) FIN_LD(gw);
#pragma unroll 1
    for (int m = gw; m < M; m += NGW) {
        u32x2 w[4]; const f32x4 pq = nq;
#pragma unroll
        for (int j = 0; j < 4; ++j) w[j] = nw[j];
        if (m + NGW < M) FIN_LD(m + NGW);
        const float rs = __builtin_amdgcn_rsqf(((pq[0] + pq[1]) + (pq[2] + pq[3])) * (1.0f / 1024.0f) + 1e-6f);
        GAS f32x4* orow = (GAS f32x4*)(C.h + (size_t)m * D) + C.lane;
#pragma unroll
        for (int j = 0; j < 4; ++j) orow[64 * j] = (f32x4){bflo(w[j].x) * rs * g4[j][0], bfhi(w[j].x) * rs * g4[j][1], bflo(w[j].y) * rs * g4[j][2], bfhi(w[j].y) * rs * g4[j][3]};
    }
#undef FIN_LD
}
#define RWC_PTRS \
    GAS float* RWW = (GAS float*)(C.ws + WS_RWW); const GAS bf16* RWR = (const GAS bf16*)(C.ws + WS_RWR); const GAS bf16* RWK = (const GAS bf16*)(C.ws + WS_RWK); const GAS bf16* RWV = (const GAS bf16*)(C.ws + WS_RWV); \
    GAS bf16* RWKK = (GAS bf16*)(C.ws + WS_RWKK); GAS bf16* RWB = (GAS bf16*)(C.ws + WS_RWB); GAS bf16* RWY = (GAS bf16*)(C.ws + WS_RWY); \
    LF LGs = (LF)C.lds; LB LP = (LB)C.lds; LB LPT = (LB)(C.lds + 9216); LB AT = (LB)(C.lds + 18432); LB LAK = AT; LB LP2 = AT; LB RT = (LB)(C.lds + 27648); LB BTl = (LB)(C.lds + 36864); LB MRB = BTl; LB KTl = (LB)(C.lds + 46080); LB MRK = KTl; \
    LB VT = (LB)(C.lds + 55296); LB BHT = (LB)(C.lds + 64512); LB KHT = (LB)(C.lds + 73728); LB XB0 = (LB)(C.lds + 82944); LB XB1 = (LB)(C.lds + 101376); LB LPT2 = (LB)(C.lds + 119808); LF rho = (LF)(C.lds + 129024); LF lgl = rho + 64; \
    const int t = C.tid >> 3, g8 = C.tid & 7, n = C.lane & 31, hi = C.lane >> 5; \
    (void)RWW; (void)RWR; (void)RWK; (void)RWV; (void)RWKK; (void)RWB; (void)RWY; (void)LGs; (void)LP; (void)LPT; (void)AT; (void)LAK; (void)LP2; (void)RT; (void)BTl; (void)MRB; (void)KTl; (void)MRK; (void)VT; (void)BHT; (void)KHT; (void)XB0; (void)XB1; (void)LPT2; (void)rho; (void)lgl; (void)t; (void)g8; (void)n; (void)hi;
struct S0In { f32x4 x0, x1; u32x4 rv, kv, kkv, bv, vv; };
__device__ __forceinline__ S0In rwc_s0_load(const Ctx& C, int bc, int h) {
    RWC_PTRS
    const size_t g = ((size_t)bc * 64 + t) * 512 + h * 64 + g8 * 8; S0In in;
    in.rv = *(const GAS u32x4*)(RWR + g); in.kv = *(const GAS u32x4*)(RWK + g); in.kkv = *(const GAS u32x4*)(RWKK + g); in.bv = *(const GAS u32x4*)(RWB + g); in.vv = *(const GAS u32x4*)(RWV + g);
    in.x0 = *(const GAS f32x4*)(RWW + g); in.x1 = *(const GAS f32x4*)(RWW + g + 4); return in;
}
__device__ __forceinline__ void rwc_stage0_body(const Ctx& C, int bc, int h, const S0In& in) {
    RWC_PTRS
    LF TOT = (LF)C.lds;
    float lw[8] = {in.x0[0], in.x0[1], in.x0[2], in.x0[3], in.x1[0], in.x1[1], in.x1[2], in.x1[3]}, lg[8], rh[8], ll[8];
#pragma unroll
    for (int i = 0; i < 8; ++i) lg[i] = lw[i];
#pragma unroll
    for (int st = 1; st < 8; ++st) {
#pragma unroll
        for (int i = 0; i < 8; ++i) { const float nb_ = __shfl_up(lg[i], 8); if ((t & 7) == st) lg[i] += nb_; } }
    if ((t & 7) == 7) { *(LAS f32x4*)(TOT + C.wave * 64 + g8 * 8) = (f32x4){lg[0], lg[1], lg[2], lg[3]}; *(LAS f32x4*)(TOT + C.wave * 64 + g8 * 8 + 4) = (f32x4){lg[4], lg[5], lg[6], lg[7]}; }
    RW_BAR();
    {   float off[8], run[8];
#pragma unroll
        for (int i = 0; i < 8; ++i) { off[i] = 0.f; run[i] = 0.f; }
#pragma unroll
        for (int w = 0; w < 8; ++w) { const f32x4 a0 = *(const LAS f32x4*)(TOT + w * 64 + g8 * 8), a1 = *(const LAS f32x4*)(TOT + w * 64 + g8 * 8 + 4);
#pragma unroll
            for (int i = 0; i < 8; ++i) { const float v = i < 4 ? a0[i & 3] : a1[i & 3]; off[i] += (w < C.wave) ? v : 0.f; run[i] += v; if (w == 3) rh[i] = run[i]; } }
#pragma unroll
        for (int i = 0; i < 8; ++i) { lg[i] += off[i]; ll[i] = run[i]; } }
    {   float rf[8], kf[8], kkf[8], bf[8], o1[8], o2[8], o3[8], o4[8];
        unpack8(in.rv, rf); unpack8(in.kv, kf); unpack8(in.kkv, kkf); unpack8(in.bv, bf);
#pragma unroll
        for (int i = 0; i < 8; ++i) { const int k = g8 * 8 + i; const float lm1 = lg[i] - lw[i];
            const float ed = __expf(lg[i] - rh[i]), edi = __expf(rh[i] - lg[i]), el = __expf(ll[i] - lg[i]);
            o1[i] = -kkf[i] * __expf(lm1 - rh[i]); o2[i] = rf[i] * ed; o3[i] = bf[i] * edi; o4[i] = kf[i] * edi;
            XB0[k * 72 + t] = (bf16)f2bf(-kkf[i] * __expf(lm1));
            BHT[k * 72 + t] = (bf16)f2bf(bf[i] * el); KHT[k * 72 + t] = (bf16)f2bf(kf[i] * el); }
        *(LAS u32x4*)(AT + t * 72 + g8 * 8) = pack8(o1); *(LAS u32x4*)(RT + t * 72 + g8 * 8) = pack8(o2); *(LAS u32x4*)(BTl + t * 72 + g8 * 8) = pack8(o3); *(LAS u32x4*)(KTl + t * 72 + g8 * 8) = pack8(o4);
        const unsigned vw[4] = {in.vv.x, in.vv.y, in.vv.z, in.vv.w};
#pragma unroll
        for (int i = 0; i < 4; ++i) { VT[(g8 * 8 + 2 * i) * 72 + t] = (bf16)(vw[i] & 0xffffu); VT[(g8 * 8 + 2 * i + 1) * 72 + t] = (bf16)(vw[i] >> 16); }
        if (t == 0) {
#pragma unroll
            for (int i = 0; i < 8; ++i) { rho[g8 * 8 + i] = rh[i]; lgl[g8 * 8 + i] = ll[i]; } }
    }
    RW_BAR();
}
PH_FN void rwc_stage0(const Ctx C, int bc, int h) { const S0In in = rwc_s0_load(C, bc, h); rwc_stage0_body(C, bc, h, in); }
PH_FN void rwc_stage12(const Ctx C) {
    RWC_PTRS
    {   const int mt = C.wave >> 1, nt0 = 2 * (C.wave & 1);
        CLB Am = (mt < 2) ? (CLB)AT : (CLB)RT; const int m0 = 32 * (mt & 1);
        CLB Bm = (nt0 < 2) ? (CLB)BTl : (CLB)KTl;
        f32x16 c0 = zero16(), c1 = zero16();
        mma_nt<64>(c0, Am, 72, m0, Bm, 72, 0, C.lane); mma_nt<64>(c1, Am, 72, m0, Bm, 72, 32, C.lane);
        RW_BAR();
#pragma unroll
        for (int r = 0; r < 16; ++r) { const int tt = m0 + crow(r, hi); const int j0 = n, j1 = 32 + n;
            if (mt < 2) { const bf16 x0 = (bf16)f2bf((j0 < tt) ? c0[r] : 0.f), x1 = (bf16)f2bf((j1 < tt) ? c1[r] : 0.f);
                if (nt0 < 2) { LP[tt * 72 + j0] = x0; LP[tt * 72 + j1] = x1; LPT[j0 * 72 + tt] = x0; LPT[j1 * 72 + tt] = x1; } else { LAK[tt * 72 + j0] = x0; LAK[tt * 72 + j1] = x1; } }
            else { const bf16 x0 = (bf16)f2bf((j0 <= tt) ? c0[r] : 0.f), x1 = (bf16)f2bf((j1 <= tt) ? c1[r] : 0.f);
                if (nt0 < 2) { MRB[tt * 72 + j0] = x0; MRB[tt * 72 + j1] = x1; } else { MRK[tt * 72 + j0] = x0; MRK[tt * 72 + j1] = x1; } } }
    }
    RW_BAR();
    if (C.wave < 4) { const int vt = C.wave >> 1, tt0 = C.wave & 1; f32x16 c = zero16(); mma_nt<64>(c, VT, 72, 32 * vt, LAK, 72, 32 * tt0, C.lane);
#pragma unroll
        for (int r = 0; r < 16; ++r) XB0[(64 + 32 * vt + crow(r, hi)) * 72 + 32 * tt0 + n] = (bf16)f2bf(c[r]); }
    RW_BAR();
}
#ifndef RWC_NSTEP
#define RWC_NSTEP 6
#endif
#ifndef RWC_REP0
#define RWC_REP0 1
#endif
PH_FN void rwc_solve(const Ctx C) {
    RWC_PTRS
    const int ct = C.wave >> 1, tt = C.wave & 1;
    const int sk = C.wave >> 2, st = (C.wave >> 1) & 1, sj = C.wave & 1;
#pragma unroll 1
    for (int i = 0; i < RWC_NSTEP; ++i) {
        CLB Pc = (i & 1) ? (CLB)LP2 : (CLB)LP; CLB PTc = (i & 1) ? (CLB)LPT2 : (CLB)LPT; LB Pn = (i & 1) ? LP : LP2; LB PTn = (i & 1) ? LPT : LPT2;
        CLB Xc = (i & 1) ? (CLB)XB1 : (CLB)XB0; LB Xn = (i & 1) ? XB0 : XB1;
        { f32x16 acc;
#pragma unroll
          for (int r = 0; r < 16; ++r) acc[r] = bf2f(Xc[(32 * ct + crow(r, hi)) * 72 + 32 * tt + n]);
          mma_nt<64>(acc, Xc, 72, 32 * ct, Pc, 72, 32 * tt, C.lane);
#pragma unroll
          for (int r = 0; r < 16; ++r) Xn[(32 * ct + crow(r, hi)) * 72 + 32 * tt + n] = (bf16)f2bf(acc[r]); }
        if (i < RWC_NSTEP - 1) { f32x16 acc = zero16();
          if (sk == 0) mma_nt<64>(acc, Pc, 72, 32 * st, PTc, 72, 32 * sj, C.lane); else mma_nt<64>(acc, PTc, 72, 32 * st, Pc, 72, 32 * sj, C.lane);
          LB dst = (sk == 0) ? Pn : PTn;
#pragma unroll
          for (int r = 0; r < 16; ++r) dst[(32 * st + crow(r, hi)) * 72 + 32 * sj + n] = (bf16)f2bf(acc[r]); }
        RW_BAR();
    }
}
__device__ __forceinline__ void rwc_stage4_body(const Ctx& C, int bc, int h) {
    RWC_PTRS
    const size_t row0 = (size_t)bc * 64; CLB A2T = (CLB)XB0; CLB WT = (CLB)(XB0 + 64 * 72);
    {   const int kind = C.wave >> 1, mt = C.wave & 1;
        f32x16 c0 = zero16(), c1 = zero16();
        if (kind == 0) { mma_nt<64>(c0, BHT, 72, 32 * mt, A2T, 72, 0, C.lane); mma_nt<64>(c1, BHT, 72, 32 * mt, A2T, 72, 32, C.lane); }
        else if (kind == 1) { mma_nt<64>(c0, BHT, 72, 32 * mt, WT, 72, 0, C.lane); mma_nt<64>(c1, BHT, 72, 32 * mt, WT, 72, 32, C.lane); mma_nt<64>(c0, KHT, 72, 32 * mt, VT, 72, 0, C.lane); mma_nt<64>(c1, KHT, 72, 32 * mt, VT, 72, 32, C.lane); }
        else if (kind == 2) { mma_nt<64>(c0, MRB, 72, 32 * mt, A2T, 72, 0, C.lane); mma_nt<64>(c1, MRB, 72, 32 * mt, A2T, 72, 32, C.lane); }
        else { mma_nt<64>(c0, MRB, 72, 32 * mt, WT, 72, 0, C.lane); mma_nt<64>(c1, MRB, 72, 32 * mt, WT, 72, 32, C.lane); mma_nt<64>(c0, MRK, 72, 32 * mt, VT, 72, 0, C.lane); mma_nt<64>(c1, MRK, 72, 32 * mt, VT, 72, 32, C.lane); }
#pragma unroll
        for (int r = 0; r < 16; ++r) { const int m = 32 * mt + crow(r, hi); const size_t go = (row0 + m) * 512 + h * 64;
            if (kind == 0) { const float d = __expf(lgl[m]); RWB[go + n] = (bf16)f2bf(c0[r] + ((n == m) ? d : 0.f)); RWB[go + 32 + n] = (bf16)f2bf(c1[r] + ((32 + n == m) ? d : 0.f)); }
            else if (kind == 1) { RWW[go + n] = c0[r]; RWW[go + 32 + n] = c1[r]; }
            else if (kind == 2) { RWKK[go + n] = (bf16)f2bf(c0[r] + bf2f(RT[m * 72 + n]) * __expf(rho[n])); RWKK[go + 32 + n] = (bf16)f2bf(c1[r] + bf2f(RT[m * 72 + 32 + n]) * __expf(rho[32 + n])); }
            else { RWY[go + n] = (bf16)f2bf(c0[r]); RWY[go + 32 + n] = (bf16)f2bf(c1[r]); } }
    }
}
PH_FN void rwc_stage4(const Ctx C, int bc, int h) { rwc_stage4_body(C, bc, h); }
PH_FN void rwc_stage40(const Ctx C, int bc, int h) {
    const S0In in = rwc_s0_load(C, bc, h + 1); __builtin_amdgcn_sched_barrier(0);
    rwc_stage4_body(C, bc, h);
    rwc_stage0_body(C, bc, h + 1, in);
}
__device__ __forceinline__ void ph_rw_chunk(const Ctx& C, int bc) {
    rwc_stage0(C, bc, 0);
#pragma unroll 1
    for (int h = 0; h < 8; ++h) { rwc_stage12(C); rwc_solve(C); if (h < 7) rwc_stage40(C, bc, h); else rwc_stage4(C, bc, h); }
    WG_SYNC();
}
PH_FN void rw_scan_producer(const Ctx C, int chain) {
    const float* RWW = (const float*)(unsigned char*)(C.ws + WS_RWW); const bf16* RWKK = (const bf16*)(unsigned char*)(C.ws + WS_RWKK); const bf16* RWB = (const bf16*)(unsigned char*)(C.ws + WS_RWB); bf16* RWY = (bf16*)(unsigned char*)(C.ws + WS_RWY);
    const int b = chain >> 3, h = chain & 7; const size_t rowb = (size_t)b * SEQ;
    constexpr int BUFB = 45056, O_RQ = 0, O_PT = 9216, O_QT = 18432, O_Y0 = 35840;
    LAS unsigned char* L = C.lds;
        const int p = C.tid - 256, t = p >> 2, q4 = (p & 3) * 16;
        u32x4 Arq0, Arq1, Apt0, Apt1, Ay00, Ay01, Brq0, Brq1, Bpt0, Bpt1, By00, By01; f32x4 Aq0, Aq1, Aq2, Aq3, Bq0, Bq1, Bq2, Bq3;
#define SC_LOAD(S, c_) do { const size_t g_ = (rowb + (size_t)(c_) * 64 + t) * 512 + h * 64 + q4; \
            S##rq0 = *(const u32x4*)(RWKK + g_); S##rq1 = *(const u32x4*)(RWKK + g_ + 8); S##pt0 = *(const u32x4*)(RWB + g_); S##pt1 = *(const u32x4*)(RWB + g_ + 8); S##y00 = *(const u32x4*)(RWY + g_); S##y01 = *(const u32x4*)(RWY + g_ + 8); \
            S##q0 = *(const f32x4*)(RWW + g_); S##q1 = *(const f32x4*)(RWW + g_ + 4); S##q2 = *(const f32x4*)(RWW + g_ + 8); S##q3 = *(const f32x4*)(RWW + g_ + 12); } while (0)
#define SC_WRITE(S, Lb) do { \
            *(LAS u32x4*)((LB)((Lb) + O_RQ) + t * 72 + q4) = S##rq0; *(LAS u32x4*)((LB)((Lb) + O_RQ) + t * 72 + q4 + 8) = S##rq1; \
            *(LAS u32x4*)((LB)((Lb) + O_PT) + t * 72 + q4) = S##pt0; *(LAS u32x4*)((LB)((Lb) + O_PT) + t * 72 + q4 + 8) = S##pt1; \
            *(LAS u32x4*)((LB)((Lb) + O_Y0) + t * 72 + q4) = S##y00; *(LAS u32x4*)((LB)((Lb) + O_Y0) + t * 72 + q4 + 8) = S##y01; \
            { LF d_ = (LF)((Lb) + O_QT) + t * 68 + q4; *(LAS f32x4*)d_ = S##q0; *(LAS f32x4*)(d_ + 4) = S##q1; *(LAS f32x4*)(d_ + 8) = S##q2; *(LAS f32x4*)(d_ + 12) = S##q3; } } while (0)
        SC_LOAD(A, 0); SC_LOAD(B, 1);
        for (int c = 0; c < NCH; c += 2) {
            SC_WRITE(A, L); if (c + 2 < NCH) SC_LOAD(A, c + 2); RW_BAR();
            SC_WRITE(B, L + BUFB); if (c + 3 < NCH) SC_LOAD(B, c + 3); RW_BAR();
        }
        RW_BAR();
#undef SC_LOAD
#undef SC_WRITE
}
PH_FN void rw_scan_consumer(const Ctx C, int chain) {
    const float* RWW = (const float*)(unsigned char*)(C.ws + WS_RWW); const bf16* RWKK = (const bf16*)(unsigned char*)(C.ws + WS_RWKK); const bf16* RWB = (const bf16*)(unsigned char*)(C.ws + WS_RWB); bf16* RWY = (bf16*)(unsigned char*)(C.ws + WS_RWY);
    const int b = chain >> 3, h = chain & 7; const size_t rowb = (size_t)b * SEQ;
    constexpr int BUFB = 45056, O_RQ = 0, O_PT = 9216, O_QT = 18432, O_Y0 = 35840;
    LAS unsigned char* L = C.lds;
        const int n = C.lane & 31, hi = C.lane >> 5, vh = C.wave & 1;
        f32x16 st0 = zero16(), st1 = zero16();
        for (int c = 0; c < NCH; ++c) {
            RW_BAR();
            if (C.wave < 2) {
                const LAS unsigned char* Lb = L + (c & 1) * BUFB;
                CLB RQ = (CLB)(Lb + O_RQ); CLB PT = (CLB)(Lb + O_PT); CLF QT = (CLF)(Lb + O_QT); CLB Y0 = (CLB)(Lb + O_Y0);
                pg8::bf16x8 sb[4];
                { u32x4 w;
                  w.x = pk2(st0[0], st0[1]); w.y = pk2(st0[2], st0[3]); w.z = pk2(st0[4], st0[5]); w.w = pk2(st0[6], st0[7]); sb[0] = __builtin_bit_cast(pg8::bf16x8, w);
                  w.x = pk2(st0[8], st0[9]); w.y = pk2(st0[10], st0[11]); w.z = pk2(st0[12], st0[13]); w.w = pk2(st0[14], st0[15]); sb[1] = __builtin_bit_cast(pg8::bf16x8, w);
                  w.x = pk2(st1[0], st1[1]); w.y = pk2(st1[2], st1[3]); w.z = pk2(st1[4], st1[5]); w.w = pk2(st1[6], st1[7]); sb[2] = __builtin_bit_cast(pg8::bf16x8, w);
                  w.x = pk2(st1[8], st1[9]); w.y = pk2(st1[10], st1[11]); w.z = pk2(st1[12], st1[13]); w.w = pk2(st1[14], st1[15]); sb[3] = __builtin_bit_cast(pg8::bf16x8, w); }
#define SC_AFRAG(X_, row_, s_) ({ const u32x2 lo_ = *(const LAS u32x2*)((X_) + (row_) * 72 + 16 * (s_) + 4 * hi), hi_ = *(const LAS u32x2*)((X_) + (row_) * 72 + 16 * (s_) + 8 + 4 * hi); \
                    u32x4 w_; w_.x = lo_.x; w_.y = lo_.y; w_.z = hi_.x; w_.w = hi_.y; __builtin_bit_cast(pg8::bf16x8, w_); })
#pragma unroll
                for (int tt = 0; tt < 2; ++tt) { f32x16 y;
#pragma unroll
                    for (int r = 0; r < 16; ++r) y[r] = bf2f(Y0[(32 * tt + crow(r, hi)) * 72 + 32 * vh + n]);
#pragma unroll
                    for (int s = 0; s < 4; ++s) y = __builtin_amdgcn_mfma_f32_32x32x16_bf16(SC_AFRAG(RQ, 32 * tt + n, s), sb[s], y, 0, 0, 0);
                    bf16* yo = RWY + (rowb + (size_t)c * 64 + 32 * tt) * 512 + h * 64 + 32 * vh + n;
#pragma unroll
                    for (int r = 0; r < 16; ++r) yo[(size_t)crow(r, hi) * 512] = (bf16)f2bf(y[r]); }
                f32x16 n0, n1;
#pragma unroll
                for (int r = 0; r < 16; ++r) { n0[r] = QT[crow(r, hi) * 68 + 32 * vh + n]; n1[r] = QT[(32 + crow(r, hi)) * 68 + 32 * vh + n]; }
#pragma unroll
                for (int s = 0; s < 4; ++s) { n0 = __builtin_amdgcn_mfma_f32_32x32x16_bf16(SC_AFRAG(PT, n, s), sb[s], n0, 0, 0, 0); n1 = __builtin_amdgcn_mfma_f32_32x32x16_bf16(SC_AFRAG(PT, 32 + n, s), sb[s], n1, 0, 0, 0); }
                st0 = n0; st1 = n1;
#undef SC_AFRAG
            }
        }
        RW_BAR();
}
__device__ __forceinline__ void rw_scan_unit(const Ctx& C, int chain) { if (C.wave >= 4) rw_scan_producer(C, chain); else rw_scan_consumer(C, chain); }
#ifndef REP_ATTN
#define REP_ATTN 1
#endif
#ifndef REP_W
#define REP_W 1
#endif
#ifndef REP_RWC
#define REP_RWC 1
#endif
#ifndef REP_MA
#define REP_MA 1
#endif
#ifndef REP_GLAA
#define REP_GLAA 1
#endif
#ifndef REP_SSDA
#define REP_SSDA 1
#endif
#ifndef REP_RWP
#define REP_RWP 1
#endif
#ifndef REP_GLAC
#define REP_GLAC 1
#endif
#ifndef REP_SSDC
#define REP_SSDC 1
#endif
#ifndef REP_RWO
#define REP_RWO 1
#endif
#ifndef REP_MAFULL
#define REP_MAFULL 1
#endif
#ifndef REP_SCANS
#define REP_SCANS 1
#endif
#ifndef REP_MC
#define REP_MC 1
#endif
#ifndef REP_GEMM
#define REP_GEMM 1
#endif
constexpr int NPH = 12, G_FINAL = 1 + NL * NPH, G_END = G_FINAL + 1;
template <int GRP>
__global__ void __launch_bounds__(NTHR, 2) hybrid_fwd(Args args) {
    constexpr bool ALL = (GRP < 0);
    constexpr bool EN_G1 = ALL || GRP == 0, EN_G2 = EN_G1, EN_G3 = EN_G1, EN_G7 = EN_G1, EN_G8 = EN_G1, EN_G9 = EN_G1;
    constexpr bool EN_PRO = ALL || GRP == 1, EN_W = EN_PRO, EN_FIN = EN_PRO, EN_MA1 = EN_PRO, EN_MA2 = EN_PRO, EN_MA3 = EN_PRO, EN_MA4 = EN_PRO;
    constexpr bool EN_MB1 = ALL || GRP == 2, EN_MB2 = EN_MB1;
    constexpr bool EN_MC1 = ALL || GRP == 3, EN_MC2 = EN_MC1, EN_MC3 = EN_MC1;
    extern __shared__ __attribute__((aligned(16))) unsigned char lds[];
    Ctx C; C.lds = (LAS unsigned char*)lds; C.ws = (GAS unsigned char*)args.ws; C.h = (GAS float*)args.out; C.tid = threadIdx.x; C.lane = C.tid & 63; C.wave = __builtin_amdgcn_readfirstlane(C.tid >> 6); C.bid = blockIdx.x; C.G = gridDim.x;
    LAS unsigned char* ldsl = (LAS unsigned char*)lds;
    const ArgsP ap = (ArgsP)__builtin_amdgcn_kernarg_segment_ptr();
    for (int u = C.tid; u < (LDS_BYTES - LDSCTL_OFF) / 4; u += NTHR) ((LAS unsigned*)(ldsl + LDSCTL_OFF))[u] = 0u;
    __syncthreads();
    volatile LAS unsigned* MISC = (volatile LAS unsigned*)(ldsl + MISC_OFF);
    gu32* ctl = (gu32*)(args.ws + WS_CTL);
    const int g_lo = args.g_lo, g_hi = args.g_hi;
    XcdBarrier bar; bar.bar = (unsigned*)(ctl + CW_BAR); bar.x = 0; bar.st = nullptr;
    if (g_hi - g_lo > 1) bar = xcd_barrier_post((unsigned*)(ctl + CW_BAR), MISC + 8);
#define IN(g) (g_lo <= (g) && (g) < g_hi)
#define SEAM(g) do { if (IN(g) && IN((g) + 1)) xcd_barrier(bar); } while (0)
    bf16* HB = (bf16*)(args.ws + WS_HB); float* SSQ = (float*)(args.ws + WS_SSQ);

    if (IN(0)) { if (EN_PRO) ph_prologue(fresh(C), ap); if (EN_W) ph_weights(fresh(C), ap, 0, 13, C.bid * NWAVES + C.wave, C.G * NWAVES); }
    SEAM(0);
#define W_TAIL(layer, mask) do { if (EN_W && C.bid >= 128 && (layer) < NL) ph_weights(fresh(C), ap, (layer), (mask), (C.bid - 128) * NWAVES + C.wave, 128 * NWAVES); } while (0)
#pragma unroll 1
    for (int l = 0; l < NL; ++l) {
        const int gb = 1 + NPH * l;
#pragma unroll 1
        for (int f = 0; f < 2; ++f) {
            const int gu = gb + (f ? 10 : 1);
            if (EN_G1 && IN(gu)) {
                pg8::Gemm g{HB, (const bf16*)(args.ws + (f ? WS_WGU2 : WS_WGU1)), M, 2 * FF, D, D}; pg8::StaticOrder S; S.init(M, 2 * FF, C.G, C.bid);
                pg8::EpiSwiglu E{(bf16*)(args.ws + WS_ACT), FF, SSQ, M};
                pg8::gemm_phase<pg8::EpiSwiglu, pg8::StaticOrder, true, true>(ldsl, g, S, E);
                if (f == 0) W_TAIL(l, l > 0 ? 10 : 2); else W_TAIL(l + 1, 4);
            }
            SEAM(gu);
            if (EN_G2 && IN(gu + 1)) {
                pg8::Gemm g{(const bf16*)(args.ws + WS_ACT), (const bf16*)(args.ws + (f ? WS_WD2 : WS_WD1)), M, D, FF, FF}; pg8::StaticOrder S; S.init(M, D, C.G, C.bid);
                pg8::EpiResid E{HB, SSQ, M, 0.5f};
                pg8::gemm_phase<pg8::EpiResid, pg8::StaticOrder, false, true>(ldsl, g, S, E);
            }
            SEAM(gu + 1);
            if (f == 0) {
                if (EN_G3 && IN(gb + 3)) {
                    pg8::Gemm g{HB, (const bf16*)(args.ws + WS_WIN), M, NPM, D, D}; pg8::StaticOrder S; S.init(M, NPM, C.G, C.bid);
                    pg8::EpiMixRope E{(bf16*)(args.ws + WS_P), NPM, SSQ, M, (const float*)(args.ws + WS_COS), (const float*)(args.ws + WS_SIN)};
                    pg8::gemm_phase<pg8::EpiMixRope, pg8::StaticOrder, true, true>(ldsl, g, S, E);
                    W_TAIL(l + 1, 1);
                }
                SEAM(gb + 3);
                if (IN(gb + 4)) { for (int rf = 0; rf < REP_MAFULL; ++rf) { for (int rep = 0; rep < REP_MA; ++rep) { for (int r2 = 0; r2 < REP_GLAA; ++r2) if (EN_MA2) ph_gla_a(fresh(C), ap, l); for (int r2 = 0; r2 < REP_SSDA; ++r2) if (EN_MA3) ph_ssd_a(fresh(C), ap, l); for (int r2 = 0; r2 < REP_RWP; ++r2) if (EN_MA4) ph_rw_prep(fresh(C), ap, l); } if (EN_MA4) ph_rw_chunk(fresh(C), C.bid); } }
                SEAM(gb + 4);
                if (IN(gb + 5)) {
#define MB_SCANS() do { if (EN_MB2) { if (C.bid < 16) rw_scan_unit(fresh(C), C.bid); else { for (int p = C.bid - 16; p < 192; p += C.G - 16) { if (p < 64) gla_scan_part(fresh(C), p); else ssd_scan_part(fresh(C), p - 64); } } } } while (0)
                    MB_SCANS();
                    for (int rs = 1; rs < REP_SCANS; ++rs) {
                        xcd_barrier(bar); if (EN_MA2) ph_gla_a(fresh(C), ap, l); if (EN_MA3) ph_ssd_a(fresh(C), ap, l); if (EN_MA4) { ph_rw_prep(fresh(C), ap, l); ph_rw_chunk(fresh(C), C.bid); } xcd_barrier(bar); MB_SCANS(); }
                    if (C.bid >= 16) { const int a = C.bid - 16; for (int rep = 0; rep < REP_ATTN; ++rep) if (EN_MB1) ph_da_attn(fresh(C), args, l, a & 7, ((a >> 3) + 6) % 30);     }
                }
                SEAM(gb + 5);
                if (IN(gb + 6)) { for (int rep = 0; rep < REP_MC; ++rep) { for (int r2 = 0; r2 < REP_GLAC; ++r2) if (EN_MC1) ph_gla_c(fresh(C), ap, l); for (int r2 = 0; r2 < REP_SSDC; ++r2) if (EN_MC2) ph_ssd_c(fresh(C), ap, l); for (int r2 = 0; r2 < REP_RWO; ++r2) if (EN_MC3) ph_rw_out(fresh(C), ap, l); } }
                SEAM(gb + 6);
                if (EN_G7 && IN(gb + 7)) {
                    pg8::Gemm g{HB, (const bf16*)(args.ws + WS_WIN) + (size_t)NPM * D, M, 4096, D, D}; pg8::StaticOrder S; S.init(M, 4096, C.G, C.bid);
                    pg8::EpiGateRatio E{(bf16*)(args.ws + WS_PG), args.in[33] + (size_t)l * 4096, SSQ, M};
                    pg8::gemm_phase<pg8::EpiGateRatio, pg8::StaticOrder, true, true>(ldsl, g, S, E);
                }
                SEAM(gb + 7);
                if (EN_G8 && IN(gb + 8)) {
                    pg8::Gemm g{(const bf16*)(args.ws + WS_YS), (const bf16*)(args.ws + WS_WB), M, D, 2048, 2048}; pg8::StaticOrder S; S.init(M, D, C.G, C.bid);
                    pg8::EpiGateHorner E{(bf16*)(args.ws + WS_MERGED), (const bf16*)(args.ws + WS_PG)};
                    pg8::gemm_phase<pg8::EpiGateHorner, pg8::StaticOrder, true, true>(ldsl, g, S, E);
                }
                SEAM(gb + 8);
                if (EN_G9 && IN(gb + 9)) {
                    pg8::Gemm g{(const bf16*)(args.ws + WS_MERGED), (const bf16*)(args.ws + WS_WO), M, D, D, D}; pg8::StaticOrder S; S.init(M, D, C.G, C.bid);
                    pg8::EpiResid E{HB, SSQ, M, 1.0f};
                    pg8::gemm_phase<pg8::EpiResid, pg8::StaticOrder, false, true>(ldsl, g, S, E);
                }
                SEAM(gb + 9);
            }
        }
    }
    if (EN_FIN && IN(G_FINAL)) ph_final(fresh(C), ap);
#undef IN
#undef SEAM
}

#ifndef ONE_LAUNCH
#define ONE_LAUNCH 1
#endif
extern "C" void kernel_launch(void* const* d_in, const int* in_sizes, int n_in, void* d_out, int out_size, void* d_ws, size_t ws_size, hipStream_t stream) {
    static int grid = 0;
    if (grid == 0) {
        if (n_in != 40 || in_sizes[0] != M * D || out_size != M * D || ws_size < WS_END) { fprintf(stderr, "kernel_launch: unexpected shapes (n_in %d, in0 %d, out %d, ws %zu < %zu); nothing launched\n", n_in, n_in > 0 ? in_sizes[0] : -1, out_size, ws_size, (size_t)WS_END); grid = -1; return; }
        int dev = 0, cus = 0, per_cu = 0;
        if (hipGetDevice(&dev) != hipSuccess || hipDeviceGetAttribute(&cus, hipDeviceAttributeMultiprocessorCount, dev) != hipSuccess) { grid = -1; return; }
#if ONE_LAUNCH
        if (hipFuncSetAttribute((const void*)hybrid_fwd<-1>, hipFuncAttributeMaxDynamicSharedMemorySize, LDS_BYTES) != hipSuccess) { fprintf(stderr, "kernel_launch: hipFuncSetAttribute failed\n"); grid = -1; return; }
#else
        if (hipFuncSetAttribute((const void*)hybrid_fwd<0>, hipFuncAttributeMaxDynamicSharedMemorySize, LDS_BYTES) != hipSuccess || hipFuncSetAttribute((const void*)hybrid_fwd<1>, hipFuncAttributeMaxDynamicSharedMemorySize, LDS_BYTES) != hipSuccess ||
            hipFuncSetAttribute((const void*)hybrid_fwd<2>, hipFuncAttributeMaxDynamicSharedMemorySize, LDS_BYTES) != hipSuccess || hipFuncSetAttribute((const void*)hybrid_fwd<3>, hipFuncAttributeMaxDynamicSharedMemorySize, LDS_BYTES) != hipSuccess) { fprintf(stderr, "kernel_launch: hipFuncSetAttribute failed\n"); grid = -1; return; }
#endif
        if (hipOccupancyMaxActiveBlocksPerMultiprocessor(&per_cu, (const void*)hybrid_fwd<(ONE_LAUNCH ? -1 : 0)>, NTHR, LDS_BYTES) != hipSuccess || per_cu < 1) { fprintf(stderr, "kernel_launch: occupancy query reports %d workgroups per CU: the grid would not be resident; nothing launched\n", per_cu); (void)hipGetLastError(); grid = -1; return; }
        (void)hipGetLastError();
        grid = cus;
        if (grid != 256) { fprintf(stderr, "kernel_launch: %d CUs; this kernel is laid out for 256 workgroups; nothing launched\n", grid); grid = -1; return; }
    }
    if (grid < 0) return;
    if (hipMemsetAsync((char*)d_ws + WS_CTL, 0, CTL_ZERO_BYTES, stream) != hipSuccess) return;
    Args a{};
    for (int i = 0; i < 40; ++i) a.in[i] = (const float*)d_in[i];
    a.out = (float*)d_out; a.ws = (unsigned char*)d_ws;
    for (int j = 0; j < 32; ++j) a.inv_freq[j] = (float)pow(10000.0, -(double)j / 32.0);
#if ONE_LAUNCH
    a.g_lo = 0; a.g_hi = G_END;
    hipLaunchKernelGGL(hybrid_fwd<-1>, dim3(grid), dim3(NTHR), LDS_BYTES, stream, a);
#else
    for (int g = 0; g < G_END; ++g) {
        a.g_lo = g; a.g_hi = g + 1;
        int grp = 1;
        if (g >= 1 && g < G_FINAL) { const int k = (g - 1) % NPH; grp = (k == 0 || k == 4) ? 1 : (k == 5) ? 2 : (k == 6) ? 3 : 0; }
        if (grp == 0) hipLaunchKernelGGL(hybrid_fwd<0>, dim3(grid), dim3(NTHR), LDS_BYTES, stream, a);
        else if (grp == 1) hipLaunchKernelGGL(hybrid_fwd<1>, dim3(grid), dim3(NTHR), LDS_BYTES, stream, a);
        else if (grp == 2) hipLaunchKernelGGL(hybrid_fwd<2>, dim3(grid), dim3(NTHR), LDS_BYTES, stream, a);
        else hipLaunchKernelGGL(hybrid_fwd<3>, dim3(grid), dim3(NTHR), LDS_BYTES, stream, a);
    }
#endif
}
```

```cpp
#include <hip/hip_runtime.h>
#include <cstdio>
#include <cstdint>
#include <cmath>

namespace pg8 {
#define PG8_LAS __attribute__((address_space(3)))
typedef unsigned short bf16_t;
typedef short bf16x8 __attribute__((ext_vector_type(8)));
typedef float f32x4 __attribute__((ext_vector_type(4)));
typedef unsigned u32x4 __attribute__((ext_vector_type(4)));
constexpr int BM = 256, BK = 64, HALF = 128, HTB = HALF * BK * 2  , STAGE_BYTES = 8 * HTB, NXCD = 8, WGM = 8;

__host__ __device__ __forceinline__ int lds_byte(int r, int c) { const int st = (r >> 4) * 2 + (c >> 5), rr = r & 15, cc = c & 31, ob = rr * 64 + cc * 2; return st * 1024 + (ob ^ (((ob >> 9) & 1) << 5)); }
__host__ __device__ __forceinline__ void stage_rc(int b, int& R, int& C) { const int st = b / 1024, sb = b % 1024, swz = sb ^ (((sb >> 9) & 1) << 5); R = (st >> 1) * 16 + swz / 64; C = (st & 1) * 32 + (swz % 64) / 2; }
__host__ __device__ __forceinline__ int perm32(int rho) { const int n = rho >> 4, i = rho & 15; return 8 * (i >> 2) + 4 * n + (i & 3); }

struct Unit { int pm, pn, z; };
struct Gemm { const bf16_t* A; const bf16_t* Bt; int M, N, K, lda; };

struct StaticOrder {
    int nM, nN, nwg, G, c;
    __host__ __device__ void init(int M, int N, int G_, int c_) { nM = M / BM; nN = N / BM; nwg = nM * nN; G = G_; c = c_; }
    __host__ __device__ bool next(int i, Unit& u) const {
        const long L = (long)i * G + c; if (L >= nwg) return false;
        int wgid = (int)L; { const int q = nwg / NXCD, r = nwg % NXCD, xcd = wgid % NXCD, off = wgid / NXCD; wgid = (xcd < r ? xcd * (q + 1) : r * (q + 1) + (xcd - r) * q) + off; }
        const int nig = WGM * nN, gid = wgid / nig, fm = gid * WGM, gsz = (nM - fm) < WGM ? (nM - fm) : WGM;
        u.pm = fm + ((wgid % nig) % gsz); u.pn = (wgid % nig) / gsz; u.z = 0; return true;
    }
    __device__ __forceinline__ void a_ready(const Unit&) const {}
    __device__ __forceinline__ void done(const Unit&) const {}
    __device__ __forceinline__ size_t a_off(const Unit&) const { return 0; }
    __device__ __forceinline__ int b_tile(const Unit& u) const { return u.pn; }
};
__device__ __forceinline__ unsigned cvt_pk_bf16(float lo, float hi) { unsigned r; asm volatile("v_cvt_pk_bf16_f32 %0, %1, %2" : "=v"(r) : "v"(lo), "v"(hi)); return r; }
typedef float f32x2_pg __attribute__((ext_vector_type(2))); typedef __bf16 bf16x2_pg __attribute__((ext_vector_type(2)));
__device__ __forceinline__ unsigned cvt_pk_bf16_c(float lo, float hi) { const f32x2_pg v = {lo, hi}; const bf16x2_pg b = __builtin_convertvector(v, bf16x2_pg); return __builtin_bit_cast(unsigned, b); }
__device__ __forceinline__ float bf_lo(unsigned w) { return __uint_as_float(w << 16); }
__device__ __forceinline__ float bf_hi(unsigned w) { return __uint_as_float(w & 0xffff0000u); }
__device__ __forceinline__ float fast_sigmoid(float x) { return __builtin_amdgcn_rcpf(1.0f + __builtin_amdgcn_exp2f(-1.4426950408889634f * x)); }

__device__ __forceinline__ float row_rstd(const float* ssq, int row, int M_) {
    const f32x4 p = *(const f32x4*)(ssq + (size_t)row * 4); const float s = (p[0] + p[1]) + (p[2] + p[3]); (void)M_;
    return __builtin_amdgcn_rsqf(s * (1.0f / 1024.0f) + 1e-6f);
}
__device__ __forceinline__ void row_rstd8(const float* ssq, int row0, float (&rs)[8]) {
    f32x4 p[8];
#pragma unroll
    for (int j = 0; j < 8; ++j) p[j] = *(const f32x4*)(ssq + (size_t)(row0 + (j >> 2) * HALF + (j & 3) * 16) * 4);
#pragma unroll
    for (int j = 0; j < 8; ++j) rs[j] = __builtin_amdgcn_rsqf(((p[j][0] + p[j][1]) + (p[j][2] + p[j][3])) * (1.0f / 1024.0f) + 1e-6f);
    asm volatile("" ::: "memory");
}
constexpr int RS_OFF = 131072 + 1024, RS_SLOT = 4096;
__device__ __forceinline__ void row_rstd8_lds(const PG8_LAS float* rsl, int wr, int fr, float (&rs)[8]) {
    f32x4 p[8];
#pragma unroll
    for (int j = 0; j < 8; ++j) p[j] = *(const PG8_LAS f32x4*)(rsl + ((j >> 2) * HALF + wr * 64 + (j & 3) * 16 + fr) * 4);
#pragma unroll
    for (int j = 0; j < 8; ++j) rs[j] = __builtin_amdgcn_rsqf(((p[j][0] + p[j][1]) + (p[j][2] + p[j][3])) * (1.0f / 1024.0f) + 1e-6f);
}
struct EpiScaleBf16 {
    static constexpr bool PERM = true, AFTER_DRAIN = false, RSTD_LDS = true; static constexpr int SEG_TILES = 0; struct Pre {};
    bf16_t* O; int ldc; const float* ssq; int M_;
    __device__ __forceinline__ void operator()(const f32x4 (&acc)[2][2][4][2], const Unit& u, int wr, int wc, int fr, int fq, const PG8_LAS float* rsl) const {
        const int row0 = u.pm * BM + wr * 64 + fr; const int col0 = u.pn * BM + wc * 32 + 8 * fq; float rs8[8]; row_rstd8_lds(rsl, wr, fr, rs8);
#pragma unroll
        for (int ai = 0; ai < 2; ++ai)
#pragma unroll
            for (int m = 0; m < 4; ++m) { const int row = row0 + ai * HALF + m * 16; const float rs = rs8[ai * 4 + m]; bf16_t* rowp = O + (size_t)row * ldc + col0;
#pragma unroll
                for (int bj = 0; bj < 2; ++bj) { const f32x4 v0 = acc[ai][bj][m][0] * rs, v1 = acc[ai][bj][m][1] * rs;
                    u32x4 w; w.x = cvt_pk_bf16(v0[0], v0[1]); w.y = cvt_pk_bf16(v0[2], v0[3]); w.z = cvt_pk_bf16(v1[0], v1[1]); w.w = cvt_pk_bf16(v1[2], v1[3]);
                    *(u32x4*)(rowp + bj * HALF) = w; } }
    }
};
struct EpiMixRope {
    static constexpr bool PERM = true, AFTER_DRAIN = false, RSTD_LDS = true; static constexpr int SEG_TILES = 0; struct Pre {};
    bf16_t* O; int ldc; const float* ssq; int M_; const float* cosT; const float* sinT;
    __device__ __forceinline__ void operator()(const f32x4 (&acc)[2][2][4][2], const Unit& u, int wr, int wc, int fr, int fq, const PG8_LAS float* rsl) const {
        const int row0 = u.pm * BM + wr * 64 + fr; float rs8[8]; row_rstd8_lds(rsl, wr, fr, rs8);
        if (u.pn < 4) {
            const int colq = (4 * u.pn + wc) * 64 + 8 * fq; const float sc = (u.pn < 2) ? 0.125f * 1.4426950408889634f : 1.0f;
#pragma unroll
            for (int ai = 0; ai < 2; ++ai)
#pragma unroll
                for (int m = 0; m < 4; ++m) { const int row = row0 + ai * HALF + m * 16; const float rs = rs8[ai * 4 + m] * sc; const int t = row & 8191;
                    const float* cp = cosT + t * 32 + 8 * fq; const float* sp = sinT + t * 32 + 8 * fq;
                    const f32x4 c0 = *(const f32x4*)cp, c1 = *(const f32x4*)(cp + 4), s0 = *(const f32x4*)sp, s1 = *(const f32x4*)(sp + 4);
                    const f32x4 xa0 = acc[ai][0][m][0] * rs, xa1 = acc[ai][0][m][1] * rs, xb0 = acc[ai][1][m][0] * rs, xb1 = acc[ai][1][m][1] * rs;
                    const f32x4 p0 = xa0 * c0 - xb0 * s0, p1 = xa1 * c1 - xb1 * s1, q0 = xb0 * c0 + xa0 * s0, q1 = xb1 * c1 + xa1 * s1;
                    bf16_t* rowp = O + (size_t)row * ldc + colq;
                    u32x4 w; w.x = cvt_pk_bf16(p0[0], p0[1]); w.y = cvt_pk_bf16(p0[2], p0[3]); w.z = cvt_pk_bf16(p1[0], p1[1]); w.w = cvt_pk_bf16(p1[2], p1[3]); *(u32x4*)rowp = w;
                    w.x = cvt_pk_bf16(q0[0], q0[1]); w.y = cvt_pk_bf16(q0[2], q0[3]); w.z = cvt_pk_bf16(q1[0], q1[1]); w.w = cvt_pk_bf16(q1[2], q1[3]); *(u32x4*)(rowp + 32) = w; }
        } else {
            const int col0 = u.pn * BM + wc * 32 + 8 * fq;
#pragma unroll
            for (int ai = 0; ai < 2; ++ai)
#pragma unroll
                for (int m = 0; m < 4; ++m) { const int row = row0 + ai * HALF + m * 16; const float rs = rs8[ai * 4 + m]; bf16_t* rowp = O + (size_t)row * ldc + col0;
#pragma unroll
                    for (int bj = 0; bj < 2; ++bj) { const f32x4 v0 = acc[ai][bj][m][0] * rs, v1 = acc[ai][bj][m][1] * rs;
                        u32x4 w; w.x = cvt_pk_bf16(v0[0], v0[1]); w.y = cvt_pk_bf16(v0[2], v0[3]); w.z = cvt_pk_bf16(v1[0], v1[1]); w.w = cvt_pk_bf16(v1[2], v1[3]);
                        *(u32x4*)(rowp + bj * HALF) = w; } }
        }
    }
};
struct EpiSwiglu {
    static constexpr bool PERM = true, AFTER_DRAIN = false, RSTD_LDS = true; static constexpr int SEG_TILES = 0; struct Pre {};
    bf16_t* O; int ldc; const float* ssq; int M_;
    __device__ __forceinline__ void operator()(const f32x4 (&acc)[2][2][4][2], const Unit& u, int wr, int wc, int fr, int fq, const PG8_LAS float* rsl) const {
        const int row0 = u.pm * BM + wr * 64 + fr; const int col0 = u.pn * HALF + wc * 32 + 8 * fq; float rs8[8]; row_rstd8_lds(rsl, wr, fr, rs8);
#pragma unroll
        for (int ai = 0; ai < 2; ++ai)
#pragma unroll
            for (int m = 0; m < 4; ++m) { const int row = row0 + ai * HALF + m * 16; const float rs = rs8[ai * 4 + m]; bf16_t* rowp = O + (size_t)row * ldc + col0;
                float o[8];
#pragma unroll
                for (int n = 0; n < 2; ++n)
#pragma unroll
                    for (int i = 0; i < 4; ++i) { const float g = acc[ai][0][m][n][i] * rs, up = acc[ai][1][m][n][i] * rs; o[n * 4 + i] = g * fast_sigmoid(g) * up; }
                u32x4 w; w.x = cvt_pk_bf16(o[0], o[1]); w.y = cvt_pk_bf16(o[2], o[3]); w.z = cvt_pk_bf16(o[4], o[5]); w.w = cvt_pk_bf16(o[6], o[7]);
                *(u32x4*)rowp = w; }
    }
};
struct EpiGateRatio {
    static constexpr bool PERM = true, AFTER_DRAIN = false, RSTD_LDS = true; static constexpr int SEG_TILES = 0; struct Pre {};
    bf16_t* O; const float* gb; const float* ssq; int M_;
    __device__ __forceinline__ void operator()(const f32x4 (&acc)[2][2][4][2], const Unit& u, int wr, int wc, int fr, int fq, const PG8_LAS float* rsl) const {
        const int row0 = u.pm * BM + wr * 64 + fr; const int ch0 = u.pn * 64 + wc * 16 + 4 * fq;
        f32x4 b[4];
#pragma unroll
        for (int z = 0; z < 4; ++z) b[z] = *(const f32x4*)(gb + z * 1024 + ch0);
        float rs8[8]; row_rstd8_lds(rsl, wr, fr, rs8);
#pragma unroll
        for (int ai = 0; ai < 2; ++ai)
#pragma unroll
            for (int m = 0; m < 4; ++m) { const int row = row0 + ai * HALF + m * 16; const float rs = rs8[ai * 4 + m]; bf16_t* rowp = O + (size_t)row * 4096 + ch0;
                unsigned w[4][2];
#pragma unroll
                for (int h = 0; h < 2; ++h) { float d[4][2];
#pragma unroll
                    for (int z = 0; z < 4; ++z) {
                        d[z][0] = 1.0f + __builtin_amdgcn_exp2f(-1.4426950408889634f * (acc[ai][z >> 1][m][z & 1][2 * h] * rs + b[z][2 * h]));
                        d[z][1] = 1.0f + __builtin_amdgcn_exp2f(-1.4426950408889634f * (acc[ai][z >> 1][m][z & 1][2 * h + 1] * rs + b[z][2 * h + 1])); }
#pragma unroll
                    for (int z = 0; z < 4; ++z) { const float r0 = __builtin_amdgcn_rcpf(d[z][0]), r1 = __builtin_amdgcn_rcpf(d[z][1]);
                        w[z][h] = z < 3 ? cvt_pk_bf16_c(d[z < 3 ? z + 1 : 3][0] * r0, d[z < 3 ? z + 1 : 3][1] * r1) : cvt_pk_bf16_c(r0, r1); } }
#pragma unroll
                for (int z = 0; z < 4; ++z) { uint2 v; v.x = w[z][0]; v.y = w[z][1]; *(uint2*)(rowp + z * 1024) = v; } }
    }
};
struct EpiGateHorner {
    static constexpr bool PERM = true, AFTER_DRAIN = false, RSTD_LDS = false; static constexpr int SEG_TILES = 8; struct Pre {};
    bf16_t* O; const bf16_t* PG;
    __device__ __forceinline__ void seg(f32x4 (&acc)[2][2][4][2], const Unit& u, int z, int wr, int wc, int fr, int fq) const {
        int row0 = u.pm * BM + wr * 64 + fr; const int col0 = u.pn * BM + wc * 32 + 8 * fq; asm volatile("" : "+v"(row0));
#pragma unroll
        for (int ai = 0; ai < 2; ++ai) { u32x4 f[4][2];
#pragma unroll
            for (int m = 0; m < 4; ++m)
#pragma unroll
                for (int bj = 0; bj < 2; ++bj) f[m][bj] = *(const u32x4*)(PG + (size_t)(row0 + ai * HALF + m * 16) * 4096 + z * 1024 + col0 + bj * HALF);
            asm volatile("" ::: "memory"); __builtin_amdgcn_sched_barrier(0);
#pragma unroll
            for (int m = 0; m < 4; ++m)
#pragma unroll
                for (int bj = 0; bj < 2; ++bj) { const u32x4 g = f[m][bj];
                    acc[ai][bj][m][0] *= (f32x4){bf_lo(g.x), bf_hi(g.x), bf_lo(g.y), bf_hi(g.y)}; acc[ai][bj][m][1] *= (f32x4){bf_lo(g.z), bf_hi(g.z), bf_lo(g.w), bf_hi(g.w)}; }
            __builtin_amdgcn_sched_barrier(0); }
    }
    __device__ __forceinline__ void operator()(const f32x4 (&acc)[2][2][4][2], const Unit& u, int wr, int wc, int fr, int fq) const {
        const int row0 = u.pm * BM + wr * 64 + fr; const int col0 = u.pn * BM + wc * 32 + 8 * fq;
#pragma unroll
        for (int ai = 0; ai < 2; ++ai) { u32x4 f[4][2];
#pragma unroll
            for (int m = 0; m < 4; ++m)
#pragma unroll
                for (int bj = 0; bj < 2; ++bj) f[m][bj] = *(const u32x4*)(PG + (size_t)(row0 + ai * HALF + m * 16) * 4096 + 3 * 1024 + col0 + bj * HALF);
            asm volatile("" ::: "memory");
#pragma unroll
            for (int m = 0; m < 4; ++m) { const int row = row0 + ai * HALF + m * 16;
#pragma unroll
                for (int bj = 0; bj < 2; ++bj) { const u32x4 g = f[m][bj];
                    const f32x4 o0 = acc[ai][bj][m][0] * (f32x4){bf_lo(g.x), bf_hi(g.x), bf_lo(g.y), bf_hi(g.y)}, o1 = acc[ai][bj][m][1] * (f32x4){bf_lo(g.z), bf_hi(g.z), bf_lo(g.w), bf_hi(g.w)};
                    u32x4 w; w.x = cvt_pk_bf16(o0[0], o0[1]); w.y = cvt_pk_bf16(o0[2], o0[3]); w.z = cvt_pk_bf16(o1[0], o1[1]); w.w = cvt_pk_bf16(o1[2], o1[3]);
                    *(u32x4*)(O + (size_t)row * 1024 + col0 + bj * HALF) = w; } }
            asm volatile("" ::: "memory"); }
    }
};
struct EpiResid {
    static constexpr bool PERM = true, AFTER_DRAIN = true, RSTD_LDS = false; static constexpr int SEG_TILES = 0;
    bf16_t* HB; float* ssq; int M_; float s;
    struct Pre { u32x4 hv[2][4][2]; };
    __device__ __forceinline__ void prefetch(Pre& pre, const Unit& u, int wr, int wc, int fr, int fq) const {
        const int row0 = u.pm * BM + wr * 64 + fr; const int col0 = u.pn * BM + wc * 32 + 8 * fq;
#pragma unroll
        for (int ai = 0; ai < 2; ++ai)
#pragma unroll
            for (int m = 0; m < 4; ++m)
#pragma unroll
                for (int bj = 0; bj < 2; ++bj) pre.hv[ai][m][bj] = *(const u32x4*)(HB + (size_t)(row0 + ai * HALF + m * 16) * 1024 + col0 + bj * HALF);
    }
    __device__ __forceinline__ void fused(f32x4 (&acc)[2][2][4][2], const Unit& u, int wr, int wc, int fr, int fq, PG8_LAS unsigned char* lds, int wid, int lane, const Pre& pre) const {
        PG8_LAS float* P = (PG8_LAS float*)lds;
        const int row0 = u.pm * BM + wr * 64 + fr; const int col0 = u.pn * BM + wc * 32 + 8 * fq;
#pragma unroll
        for (int ai = 0; ai < 2; ++ai) {
#pragma unroll
            for (int m = 0; m < 4; ++m) { const int row = row0 + ai * HALF + m * 16; float q = 0.f;
#pragma unroll
                for (int bj = 0; bj < 2; ++bj) { bf16_t* hp = HB + (size_t)row * 1024 + col0 + bj * HALF; const u32x4 hw = pre.hv[ai][m][bj];
                    const f32x4 h0 = (f32x4){bf_lo(hw.x), bf_hi(hw.x), bf_lo(hw.y), bf_hi(hw.y)} + acc[ai][bj][m][0] * s, h1 = (f32x4){bf_lo(hw.z), bf_hi(hw.z), bf_lo(hw.w), bf_hi(hw.w)} + acc[ai][bj][m][1] * s;
                    q += (h0[0] * h0[0] + h0[1] * h0[1]) + (h0[2] * h0[2] + h0[3] * h0[3]) + (h1[0] * h1[0] + h1[1] * h1[1]) + (h1[2] * h1[2] + h1[3] * h1[3]);
                    u32x4 w; w.x = cvt_pk_bf16(h0[0], h0[1]); w.y = cvt_pk_bf16(h0[2], h0[3]); w.z = cvt_pk_bf16(h1[0], h1[1]); w.w = cvt_pk_bf16(h1[2], h1[3]);
                    *(u32x4*)hp = w; }
                q += __shfl_xor(q, 16); q += __shfl_xor(q, 32);
                if (fq == 0) P[(ai * HALF + wr * 64 + m * 16 + fr) * 4 + wc] = q; } }
        asm volatile("s_waitcnt lgkmcnt(0)" ::: "memory"); __builtin_amdgcn_s_barrier(); asm volatile("" ::: "memory");
        const int t = wid * 64 + lane;
        if (t < 256) { const float q = (P[t * 4 + 0] + P[t * 4 + 1]) + (P[t * 4 + 2] + P[t * 4 + 3]); ssq[(size_t)(u.pm * BM + t) * 4 + u.pn] = q; }
        asm volatile("s_waitcnt lgkmcnt(0)" ::: "memory"); __builtin_amdgcn_s_barrier(); asm volatile("" ::: "memory");
    }
};
template <class Epi, class Sched, bool ALIGN_EPI = false, bool SP2 = false>
__device__ __forceinline__ void gemm_phase(PG8_LAS unsigned char* lds, const Gemm g, const Sched& S, const Epi& E) {
    int tid_ = threadIdx.x; asm volatile("" : "+v"(tid_)); const int tid = tid_, wid = __builtin_amdgcn_readfirstlane(tid >> 6), lane = tid & 63, wr = wid >> 2, wc = wid & 3, fr = lane & 15, fq = lane >> 4;
    const int K = g.K, nt = K / BK;
    unsigned voffA[2], voffB[2];
#pragma unroll
    for (int i = 0; i < 2; ++i) { int R, C; stage_rc(tid * 16 + i * 8192, R, C); const int Rb = Epi::PERM ? ((R & ~31) + perm32(R & 31)) : R;
        voffA[i] = (unsigned)(R * g.lda + C) * 2u; voffB[i] = (unsigned)(Rb * K + C) * 2u; }
    const size_t kstep = (size_t)(BK * 2);
    const size_t hstep = (size_t)HALF * K * 2;
    const size_t tstep = 2 * hstep; const size_t hstepA = (size_t)HALF * g.lda * 2, tstepA = 2 * hstepA;
    const unsigned ldsw = (unsigned)wid * 1024u;
    const int aoff = lds_byte(wr * 64 + fr, fq * 8), boff = lds_byte(wc * 32 + fr, fq * 8);
#define PG8_SA(b, h) (((b) * 2 + (h)) * HTB)
#define PG8_SB(b, h) ((4 + (b) * 2 + (h)) * HTB)
#define PG8_STAGE(bufoff, gbase, voff) do { _Pragma("unroll") for (int _i = 0; _i < 2; ++_i) \
        __builtin_amdgcn_global_load_lds((const unsigned*)((const char*)(gbase) + (voff)[_i]), (PG8_LAS unsigned*)(lds + (bufoff) + ldsw + _i * 8192), 16, 0, 0); } while (0)
#define PG8_LDA(dst, b, h) do { _Pragma("unroll") for (int m = 0; m < 4; ++m) _Pragma("unroll") for (int k = 0; k < 2; ++k) dst[m][k] = *(const PG8_LAS bf16x8*)(lds + PG8_SA(b, h) + aoff + m * 2048 + k * 1024); } while (0)
#define PG8_LDB(dst, b, h) do { _Pragma("unroll") for (int n = 0; n < 2; ++n) _Pragma("unroll") for (int k = 0; k < 2; ++k) dst[n][k] = *(const PG8_LAS bf16x8*)(lds + PG8_SB(b, h) + boff + n * 2048 + k * 1024); } while (0)
#define PG8_MMA(ai, bj, At, Bt) do { __builtin_amdgcn_s_setprio(1); _Pragma("unroll") for (int m = 0; m < 4; ++m) _Pragma("unroll") for (int n = 0; n < 2; ++n) _Pragma("unroll") for (int k = 0; k < 2; ++k) \
        acc[ai][bj][m][n] = __builtin_amdgcn_mfma_f32_16x16x32_bf16(Bt[n][k], At[m][k], acc[ai][bj][m][n], 0, 0, 0); __builtin_amdgcn_s_setprio(0); } while (0)
#define PG8_WAIT_V(n) asm volatile("s_waitcnt vmcnt(" #n ")" ::: "memory")
#define PG8_WAIT_L(n) asm volatile("s_waitcnt lgkmcnt(" #n ")" ::: "memory")
#define PG8_BAR __builtin_amdgcn_s_barrier()
#define PG8_SCHED __builtin_amdgcn_sched_barrier(0)
#define PG8_RSTD_DMA(unit, idx) do { if constexpr (Epi::RSTD_LDS) { if (wr == 0) \
        __builtin_amdgcn_global_load_lds((const unsigned*)(E.ssq + ((size_t)(unit).pm * BM + tid) * 4), (PG8_LAS unsigned*)(lds + RS_OFF + ((idx) & 1) * RS_SLOT + wid * 1024), 16, 0, 0); } } while (0)
    Unit cur, nxt; int ui = 0;
    if (!S.next(0, cur)) return;
    f32x4 acc[2][2][4][2];
#pragma unroll
    for (int a = 0; a < 2; ++a)
#pragma unroll
        for (int b = 0; b < 2; ++b)
#pragma unroll
            for (int m = 0; m < 4; ++m)
#pragma unroll
                for (int n = 0; n < 2; ++n) acc[a][b][m][n] = (f32x4){0.f, 0.f, 0.f, 0.f};
    bf16x8 At[4][2], B0[2][2], B1[2][2];
    const char* cA = (const char*)g.A + (size_t)cur.pm * tstepA + S.a_off(cur); const char* cB = (const char*)g.Bt + (size_t)S.b_tile(cur) * tstep;
    S.a_ready(cur);
    PG8_RSTD_DMA(cur, 0);
    if constexpr (SP2) {
        PG8_STAGE(PG8_SB(0, 0), cB, voffB); PG8_STAGE(PG8_SB(0, 1), cB + hstep, voffB); PG8_STAGE(PG8_SA(0, 0), cA, voffA); PG8_STAGE(PG8_SA(0, 1), cA + hstepA, voffA);
        if (wr == 1) PG8_BAR;
        PG8_WAIT_V(2); PG8_BAR;
        PG8_STAGE(PG8_SB(1, 0), cB + kstep, voffB); PG8_STAGE(PG8_SA(1, 0), cA + kstep, voffA); PG8_STAGE(PG8_SB(1, 1), cB + hstep + kstep, voffB);
        PG8_WAIT_V(6); PG8_BAR;
    } else {
        PG8_STAGE(PG8_SB(0, 0), cB, voffB); PG8_STAGE(PG8_SA(0, 0), cA, voffA); PG8_STAGE(PG8_SB(0, 1), cB + hstep, voffB); PG8_STAGE(PG8_SA(0, 1), cA + hstepA, voffA);
        if (wr == 1) PG8_BAR;
        PG8_WAIT_V(4); PG8_BAR;
        PG8_STAGE(PG8_SB(1, 0), cB + kstep, voffB); PG8_STAGE(PG8_SA(1, 0), cA + kstep, voffA); PG8_STAGE(PG8_SB(1, 1), cB + hstep + kstep, voffB);
        PG8_WAIT_V(6); PG8_BAR;
    }
    for (;;) {
        const bool has_next = S.next(ui + 1, nxt);
        const char* nA = has_next ? (const char*)g.A + (size_t)nxt.pm * tstepA + S.a_off(nxt) : cA; const char* nB = has_next ? (const char*)g.Bt + (size_t)S.b_tile(nxt) * tstep : cB;
        for (int t = 0; t < nt; t += 2) {
            const bool last = (t == nt - 2);
            const char* a1 = cA + (size_t)(t + 1) * kstep;
            const char* a2 = last ? nA : cA + (size_t)(t + 2) * kstep; const char* b2 = last ? nB : cB + (size_t)(t + 2) * kstep;
            const char* a3 = a2 + kstep; const char* b3 = b2 + kstep;
            if (last && has_next) S.a_ready(nxt);
            if constexpr (SP2) {
            PG8_LDB(B0, 0, 0); PG8_LDB(B1, 0, 1); PG8_SCHED; PG8_LDA(At, 0, 0); PG8_STAGE(PG8_SA(1, 1), a1 + hstepA, voffA);
            PG8_WAIT_V(8); PG8_WAIT_L(0); PG8_BAR; PG8_MMA(0, 0, At, B0); PG8_MMA(0, 1, At, B1); PG8_BAR; PG8_SCHED;
            PG8_LDA(At, 0, 1); PG8_STAGE(PG8_SB(0, 0), b2, voffB); PG8_STAGE(PG8_SB(0, 1), b2 + hstep, voffB); PG8_STAGE(PG8_SA(0, 0), a2, voffA);
            PG8_WAIT_V(8); PG8_WAIT_L(0); PG8_BAR; PG8_MMA(1, 0, At, B0); PG8_MMA(1, 1, At, B1); PG8_BAR; PG8_SCHED;
            PG8_LDB(B0, 1, 0); PG8_LDB(B1, 1, 1); PG8_SCHED; PG8_LDA(At, 1, 0); PG8_STAGE(PG8_SA(0, 1), a2 + hstepA, voffA);
            PG8_WAIT_V(8); PG8_WAIT_L(0); PG8_BAR; PG8_MMA(0, 0, At, B0); PG8_MMA(0, 1, At, B1); PG8_BAR; PG8_SCHED;
            PG8_LDA(At, 1, 1); PG8_STAGE(PG8_SB(1, 0), b3, voffB); PG8_STAGE(PG8_SB(1, 1), b3 + hstep, voffB); PG8_STAGE(PG8_SA(1, 0), a3, voffA);
            PG8_WAIT_V(8); PG8_WAIT_L(0); PG8_BAR; PG8_MMA(1, 0, At, B0); PG8_MMA(1, 1, At, B1); PG8_BAR; PG8_SCHED;
            } else {
            PG8_LDB(B0, 0, 0); PG8_SCHED; PG8_LDA(At, 0, 0); PG8_STAGE(PG8_SA(1, 1), a1 + hstepA, voffA);
            PG8_WAIT_L(8); PG8_BAR; PG8_WAIT_L(0); PG8_MMA(0, 0, At, B0); PG8_BAR; PG8_SCHED;
            PG8_LDB(B1, 0, 1); PG8_STAGE(PG8_SB(0, 0), b2, voffB);
            PG8_BAR; PG8_WAIT_L(0); PG8_MMA(0, 1, At, B1); PG8_BAR;
            PG8_LDA(At, 0, 1); PG8_STAGE(PG8_SA(0, 0), a2, voffA);
            PG8_BAR; PG8_WAIT_L(0); PG8_MMA(1, 0, At, B0); PG8_BAR; PG8_SCHED;
            PG8_STAGE(PG8_SB(0, 1), b2 + hstep, voffB);
            PG8_WAIT_V(6); PG8_BAR; PG8_MMA(1, 1, At, B1); PG8_BAR;
            PG8_LDB(B0, 1, 0); PG8_SCHED; PG8_LDA(At, 1, 0); PG8_STAGE(PG8_SA(0, 1), a2 + hstepA, voffA);
            PG8_WAIT_L(8); PG8_BAR; PG8_WAIT_L(0); PG8_MMA(0, 0, At, B0); PG8_BAR; PG8_SCHED;
            PG8_LDB(B1, 1, 1); PG8_STAGE(PG8_SB(1, 0), b3, voffB);
            PG8_BAR; PG8_WAIT_L(0); PG8_MMA(0, 1, At, B1); PG8_BAR;
            PG8_LDA(At, 1, 1); PG8_STAGE(PG8_SA(1, 0), a3, voffA);
            PG8_BAR; PG8_WAIT_L(0); PG8_MMA(1, 0, At, B0); PG8_BAR; PG8_SCHED;
            PG8_STAGE(PG8_SB(1, 1), b3 + hstep, voffB);
            PG8_WAIT_V(6); PG8_BAR; PG8_MMA(1, 1, At, B1); PG8_BAR;
            }
            if constexpr (Epi::SEG_TILES > 0) { if (((t + 2) % Epi::SEG_TILES) == 0 && (t + 2) < nt) { E.seg(acc, cur, (t + 2) / Epi::SEG_TILES - 1, wr, wc, fr, fq); PG8_WAIT_V(0); PG8_SCHED; } }
        }
        if constexpr (ALIGN_EPI) { if (wr == 0) PG8_BAR; }
        if constexpr (!Epi::AFTER_DRAIN) { if constexpr (Epi::RSTD_LDS) E(acc, cur, wr, wc, fr, fq, (const PG8_LAS float*)(lds + RS_OFF + (ui & 1) * RS_SLOT)); else E(acc, cur, wr, wc, fr, fq); S.done(cur); }
        if (!has_next) break;
#pragma unroll
        for (int a = 0; a < 2; ++a)
#pragma unroll
            for (int b = 0; b < 2; ++b)
#pragma unroll
                for (int m = 0; m < 4; ++m)
#pragma unroll
                    for (int n = 0; n < 2; ++n) acc[a][b][m][n] = (f32x4){0.f, 0.f, 0.f, 0.f};
        cur = nxt; cA = nA; cB = nB; ++ui;
        PG8_RSTD_DMA(cur, ui);
        if constexpr (ALIGN_EPI) { if (wr == 1) PG8_BAR; }
    }
    typename Epi::Pre pre;
    if constexpr (Epi::AFTER_DRAIN) E.prefetch(pre, cur, wr, wc, fr, fq);
    PG8_WAIT_V(0);
    if constexpr (!ALIGN_EPI) { if (wr == 0) PG8_BAR; }
    PG8_BAR;
    if constexpr (Epi::AFTER_DRAIN) { E.fused(acc, cur, wr, wc, fr, fq, lds, wid, lane, pre); S.done(cur); }
#undef PG8_SA
#undef PG8_SB
#undef PG8_STAGE
#undef PG8_LDA
#undef PG8_LDB
#undef PG8_MMA
#undef PG8_WAIT_V
#undef PG8_WAIT_L
#undef PG8_BAR
#undef PG8_SCHED
#undef PG8_RSTD_DMA
}
}

constexpr int NWAVES = 8, NTHR = 512;
constexpr int M = 16384, SEQ = 8192, D = 1024, FF = 2816, NL = 4, NCH = 128  , NBC = 256  ;
constexpr int NPM = 6656;
constexpr int NWIN = 10752;
constexpr int C_DAQ = 0, C_DAK = 512, C_DAV = 1024, C_GQ = 1536, C_GK = 1792, C_GV = 2048, C_GOG = 2560, C_SZ = 3072, C_SX = 3584, C_SB = 4096, C_SC = 4352,
              C_RR = 4608, C_RK = 5120, C_RV = 5632, C_RWL = 6144, C_RAL = 6208, C_RGL = 6272, C_GLR = 6400, C_SDT = 6416;
constexpr float EPS = 1e-6f, LOG2E = 1.4426950408889634f;

constexpr size_t MiB = 1u << 20;
constexpr size_t WS_CTL = 0, CTL_ZERO_BYTES = 1 * MiB;
constexpr size_t WS_COS = 1 * MiB, WS_SIN = 2 * MiB, WS_SSQ = 3 * MiB, WS_GLAST = 3 * MiB + 512 * 1024, WS_SDT = 4 * MiB, WS_SACUM = 4 * MiB + 512 * 1024, WS_SCDEC = 5 * MiB, WS_RW2T = 5 * MiB + 64 * 1024;
constexpr size_t WS_WGU1 = 8 * MiB, WS_WD1 = 19 * MiB, WS_WIN = 24 * MiB + 512 * 1024, WS_WB = 45 * MiB + 512 * 1024, WS_WO = 49 * MiB + 512 * 1024, WS_WGU2 = 51 * MiB + 512 * 1024, WS_WD2 = 62 * MiB + 512 * 1024;
constexpr size_t WS_HB = 68 * MiB, WS_P = 100 * MiB, WS_PG = 100 * MiB, WS_YS = 308 * MiB, WS_R1 = 372 * MiB, WS_R2 = 500 * MiB, WS_END = 644 * MiB;
constexpr size_t WS_ACT = WS_R1, WS_MERGED = WS_R1;
constexpr size_t WS_RWW = WS_R1, WS_RWR = WS_R1 + 32 * MiB, WS_RWK = WS_R1 + 48 * MiB, WS_RWV = WS_R1 + 64 * MiB, WS_RWKK = WS_R1 + 80 * MiB, WS_RWB = WS_R1 + 96 * MiB, WS_RWG = WS_R1 + 112 * MiB;
constexpr size_t WS_VT = WS_R2, WS_GKV = WS_R2 + 16 * MiB, WS_SST = WS_R2 + 48 * MiB, WS_RWY = WS_R2 + 112 * MiB;
static_assert(WS_WD2 + (size_t)D * FF * 2 <= WS_HB && WS_P + (size_t)M * NPM * 2 <= WS_YS && WS_RWY + (size_t)M * 512 * 2 <= WS_END, "d_ws map");
constexpr int CW_BAR = 4096;

constexpr int RING_BYTES = 131072, LDSCTL_OFF = RING_BYTES, MISC_OFF = LDSCTL_OFF + 320, LDS_BYTES = 147456;

#define GAS __attribute__((address_space(1)))
#define LAS __attribute__((address_space(3)))
typedef unsigned short bf16;
typedef unsigned v4u __attribute__((ext_vector_type(4)));
typedef float f32x4 __attribute__((ext_vector_type(4)));
typedef short bf16x8 __attribute__((ext_vector_type(8)));
typedef GAS unsigned gu32;
typedef GAS unsigned long long gu64;
#define RLX_AGENT __ATOMIC_RELAXED, __HIP_MEMORY_SCOPE_AGENT
#define LDS_WAIT() asm volatile("s_waitcnt lgkmcnt(0)" ::: "memory")
#define VM_WAIT() asm volatile("s_waitcnt vmcnt(0)" ::: "memory")
__device__ __forceinline__ unsigned long long rt() { return __builtin_amdgcn_s_memrealtime(); }
typedef float f32x2_cv __attribute__((ext_vector_type(2))); typedef __bf16 bf16x2_cv __attribute__((ext_vector_type(2)));
__device__ __forceinline__ unsigned pk2(float lo, float hi) { const f32x2_cv v = {lo, hi}; const bf16x2_cv b = __builtin_convertvector(v, bf16x2_cv); return __builtin_bit_cast(unsigned, b); }
__device__ __forceinline__ unsigned f2bf(float f) { return pk2(f, 0.f) & 0xffffu; }

#define XB_TMO      128
#define XB_XCNT(j)  (256  + 64 * (j))
#define XB_XSUB(j)  (1280 + 64 * (j))
#define XB_XGEN(j)  (2304 + 64 * (j))
#define XB_TOP      3328
#define XB_TOPGEN   3392
#define XCD_BAR_WORDS 3456
#define XB_SPIN_CAP (1u << 18)

__device__ __forceinline__ unsigned xb_ld(unsigned* p)              { return __hip_atomic_load(p, __ATOMIC_RELAXED, __HIP_MEMORY_SCOPE_AGENT); }
__device__ __forceinline__ unsigned xb_add(unsigned* p, unsigned v) { return __hip_atomic_fetch_add(p, v, __ATOMIC_RELAXED, __HIP_MEMORY_SCOPE_AGENT); }
__device__ __forceinline__ unsigned xb_xcc_id() { return (unsigned)__builtin_amdgcn_s_getreg((3 << 11) | 20) & 0xFu; }
#define XB_SPIN(cond, bar) do { unsigned _sp = 0; while (cond) { __builtin_amdgcn_s_sleep(1); \
    if ((++_sp & 255u) == 0u) { if (xb_ld(&(bar)[XB_TMO])) break; if (_sp > XB_SPIN_CAP) { atomicAdd(&(bar)[XB_TMO], 1u); break; } } } } while (0)

struct XcdBarrier {
    unsigned* bar; unsigned x;
    volatile LAS unsigned* st;
};

__device__ __forceinline__ XcdBarrier xcd_barrier_post(unsigned* bar, volatile LAS unsigned* st) {
    XcdBarrier b; b.bar = bar; b.x = xb_xcc_id(); b.st = st;
    if (threadIdx.x == 0) (void)xb_add(&bar[XB_XCNT(b.x)], 1u);
    return b;
}
__device__ __forceinline__ void xcd_barrier_complete(unsigned* bar, unsigned x, unsigned& nloc, unsigned& nx) {
    const unsigned G = gridDim.x * gridDim.y * gridDim.z;
    unsigned sum, cnt, mine, sp = 0u;
    for (;;) {
        sum = 0u; cnt = 0u; mine = 0u;
#pragma unroll
        for (unsigned j = 0; j < 16; ++j) { const unsigned c = xb_ld(&bar[XB_XCNT(j)]); sum += c; cnt += (c > 0u) ? 1u : 0u; mine = (j == x) ? c : mine; }
        if (sum == G) break;
        __builtin_amdgcn_s_sleep(1);
        if ((++sp & 255u) == 0u) { if (xb_ld(&bar[XB_TMO])) break; if (sp > XB_SPIN_CAP) { atomicAdd(&bar[XB_TMO], 1u); break; } }
    }
    nloc = mine > 0u ? mine : 1u; nx = cnt > 0u ? cnt : 1u;
}

__device__ __forceinline__ void xcd_barrier(const XcdBarrier& b) {
    asm volatile("s_waitcnt vmcnt(0)" ::: "memory");
    __syncthreads();
    if (threadIdx.x == 0) {
        unsigned* bar = b.bar;
        __builtin_amdgcn_s_waitcnt(0);
        unsigned nloc = b.st[0], nx = b.st[1];
        if (nloc == 0u) { xcd_barrier_complete(bar, b.x, nloc, nx); b.st[0] = nloc; b.st[1] = nx; }
        const unsigned old = xb_add(&bar[XB_XSUB(b.x)], 1u);
        const unsigned gen = old / nloc;
        if (old + 1u == (gen + 1u) * nloc) {
            __builtin_amdgcn_fence(__ATOMIC_RELEASE, "agent");
            asm volatile("s_waitcnt vmcnt(0)" ::: "memory");
            const unsigned og = xb_add(&bar[XB_TOP], 1u);
            const unsigned tg = og / nx;
            if (og + 1u == (tg + 1u) * nx) xb_add(&bar[XB_TOPGEN], 1u);
            else XB_SPIN(xb_ld(&bar[XB_TOPGEN]) == tg, bar);
            __builtin_amdgcn_fence(__ATOMIC_ACQUIRE, "agent");
            xb_add(&bar[XB_XGEN(b.x)], 1u);
            asm volatile("s_waitcnt vmcnt(0)" ::: "memory");
        } else {
            XB_SPIN(xb_ld(&bar[XB_XGEN(b.x)]) == gen, bar);
            __builtin_amdgcn_fence(__ATOMIC_ACQUIRE, "agent");
            asm volatile("s_waitcnt vmcnt(0)" ::: "memory");
        }
    }
    __syncthreads();
}

struct Args { const float* in[40]; float* out; unsigned char* ws; float inv_freq[32]; int g_lo, g_hi; };
struct ArgsD { const GAS float* in[40]; GAS float* out; GAS unsigned char* ws; float inv_freq[32]; int g_lo, g_hi; };
typedef const __attribute__((address_space(4))) ArgsD* ArgsP;
typedef LAS float* LF; typedef const LAS float* CLF;
#ifndef PH_FN
#define PH_FN __device__ __noinline__
#endif
#ifndef PH_HEAVY
#define PH_HEAVY __device__ __forceinline__
#endif
struct Ctx {
    LAS unsigned char* lds;
    GAS unsigned char* ws; GAS float* h;
    int tid, lane, wave, bid, G;
};
typedef unsigned u32x4 __attribute__((ext_vector_type(4)));
typedef unsigned u32x2 __attribute__((ext_vector_type(2)));
typedef float f32x2 __attribute__((ext_vector_type(2)));
typedef float f32x16 __attribute__((ext_vector_type(16)));
__device__ __forceinline__ float bf2f(bf16 x) { return __uint_as_float((unsigned)x << 16); }
__device__ __forceinline__ float bflo(unsigned w) { return __uint_as_float(w << 16); }
__device__ __forceinline__ float bfhi(unsigned w) { return __uint_as_float(w & 0xffff0000u); }
__device__ __forceinline__ void unpack8(const u32x4 w, float* o) { o[0] = bflo(w.x); o[1] = bfhi(w.x); o[2] = bflo(w.y); o[3] = bfhi(w.y); o[4] = bflo(w.z); o[5] = bfhi(w.z); o[6] = bflo(w.w); o[7] = bfhi(w.w); }
__device__ __forceinline__ u32x4 pack8(const float* o) { u32x4 w; w.x = pk2(o[0], o[1]); w.y = pk2(o[2], o[3]); w.z = pk2(o[4], o[5]); w.w = pk2(o[6], o[7]); return w; }
__device__ __forceinline__ float sigmoidf_(float x) { return 1.0f / (1.0f + __expf(-x)); }
__device__ __forceinline__ float siluf_(float x) { return x * sigmoidf_(x); }
__device__ __forceinline__ float softplusf_(float x) { return fmaxf(x, 0.f) + log1pf(__expf(-fabsf(x))); }
__device__ __forceinline__ float logsigmoidf_(float x) { return fminf(x, 0.f) - log1pf(__expf(-fabsf(x))); }
__device__ __forceinline__ float wave_sum(float v) {
#pragma unroll
    for (int o = 1; o < 64; o <<= 1) v += __shfl_xor(v, o);
    return v;
}
#define WG_SYNC() __syncthreads()
#ifndef PROBE_MASK
#define PROBE_MASK 0
#endif
#ifndef PROBE_BID
#define PROBE_BID 0
#endif
#define RW_BAR() do { asm volatile("s_waitcnt lgkmcnt(0)" ::: "memory"); __builtin_amdgcn_s_barrier(); asm volatile("" ::: "memory"); } while (0)
__device__ __forceinline__ Ctx fresh(const Ctx& C0) { Ctx C = C0; int t = threadIdx.x; asm volatile("" : "+v"(t)); C.tid = t; C.lane = t & 63; C.wave = __builtin_amdgcn_readfirstlane(t >> 6); return C; }
__device__ __forceinline__ void probe_sub(const Ctx& C, int bit) {
    if (PROBE_MASK && C.tid == 0 && C.bid == PROBE_BID) { volatile LAS unsigned* PRB = (volatile LAS unsigned*)(C.lds + MISC_OFF) + 16; const unsigned now_ = (unsigned)wall_clock64(); if ((PROBE_MASK >> bit) & 1) PRB[1] += now_ - PRB[0]; PRB[0] = now_; } }

PH_FN void ph_prologue(const Ctx C, ArgsP a) {
    GAS float* cosT = (GAS float*)(C.ws + WS_COS); GAS float* sinT = (GAS float*)(C.ws + WS_SIN);
    for (int idx = C.bid * NTHR + C.tid; idx < SEQ * 32; idx += C.G * NTHR) {
        const int t = idx >> 5, j = idx & 31;
        const float ang = (float)t * a->inv_freq[j];
        const double rev = (double)ang * 0.15915494309189535;
        const float fr = (float)(rev - floor(rev));
        cosT[idx] = __builtin_amdgcn_cosf(fr); sinT[idx] = __builtin_amdgcn_sinf(fr);
    }
    const GAS float* x = a->in[0]; GAS bf16* hb = (GAS bf16*)(C.ws + WS_HB); GAS float* ssq = (GAS float*)(C.ws + WS_SSQ);
    const int gw = C.bid * NWAVES + C.wave, NGW = C.G * NWAVES;
    f32x4 nv[4];
#define PRO_LD(m_) do { const GAS f32x4* xr_ = (const GAS f32x4*)(x + (size_t)(m_) * D) + C.lane; _Pragma("unroll") for (int j = 0; j < 4; ++j) nv[j] = xr_[64 * j]; } while (0)
    if (gw < M) PRO_LD(gw);
#pragma unroll 1
    for (int m = gw; m < M; m += NGW) {
        f32x4 v[4];
#pragma unroll
        for (int j = 0; j < 4; ++j) v[j] = nv[j];
        if (m + NGW < M) PRO_LD(m + NGW);
        GAS unsigned long long* o8 = (GAS unsigned long long*)(hb + (size_t)m * D) + C.lane;
        float s = 0.f;
#pragma unroll
        for (int j = 0; j < 4; ++j) { s += (v[j].x * v[j].x + v[j].y * v[j].y) + (v[j].z * v[j].z + v[j].w * v[j].w);
            o8[64 * j] = (unsigned long long)pk2(v[j].x, v[j].y) | ((unsigned long long)pk2(v[j].z, v[j].w) << 32); }
        s = wave_sum(s);
        if (C.lane == 0) *(GAS f32x4*)(ssq + (size_t)m * 4) = (f32x4){s, 0.f, 0.f, 0.f};
    }
#undef PRO_LD
}

template <class SrcF>
__device__ __forceinline__ void tr_item(const SrcF src, const GAS float* gk, GAS bf16* WT, int K, int kb, int nb, LAS bf16* scr, int lane) {
    const int k0 = 64 * kb, n0 = 64 * nb, kr = lane >> 4, n4 = 4 * (lane & 15);
    const int ld = src.ld(); const long co = src.col(n0 + n4); const bool ok = co >= 0; const GAS float* colp = src.base(n0 + n4) + (ok ? co : 0);
    f32x4 v[16]; float gq[16];
#pragma unroll
    for (int i = 0; i < 16; ++i) gq[i] = gk ? gk[k0 + 4 * i + kr] : 1.0f;
#pragma unroll
    for (int i = 0; i < 16; ++i) v[i] = ok ? *(const GAS f32x4*)(colp + (size_t)(k0 + 4 * i + kr) * ld) : (f32x4){0.f, 0.f, 0.f, 0.f};
    __builtin_amdgcn_sched_barrier(0);
#pragma unroll
    for (int i = 0; i < 16; ++i) { const int kk = 4 * i + kr; const float g = gq[i];
#pragma unroll
        for (int e = 0; e < 4; ++e) scr[(n4 + e) * 72 + kk] = (bf16)f2bf(v[i][e] * g); }
    LDS_WAIT(); asm volatile("" ::: "memory");
    const int c = lane & 7;
#pragma unroll
    for (int j = 0; j < 8; ++j) { const int n = (lane >> 3) + 8 * j; *(GAS v4u*)(WT + (size_t)(n0 + n) * K + k0 + 8 * c) = *(const LAS v4u*)(scr + n * 72 + 8 * c); }
    LDS_WAIT(); asm volatile("" ::: "memory");
}
struct SrcGU { const GAS float* wg; const GAS float* wu;
    __device__ __forceinline__ int ld() const { return FF; }
    __device__ __forceinline__ const GAS float* base(int n) const { const uintptr_t sel = (uintptr_t)((n >> 7) & 1); return (const GAS float*)((uintptr_t)wg + sel * ((uintptr_t)wu - (uintptr_t)wg)); }
    __device__ __forceinline__ long col(int n) const { return 128 * (n >> 8) + (n & 127); } };
struct SrcPlain { const GAS float* w; int ldw;
    __device__ __forceinline__ int ld() const { return ldw; }
    __device__ __forceinline__ const GAS float* base(int) const { return w; }
    __device__ __forceinline__ long col(int n) const { return n; } };
struct SrcWin { const GAS float* w;
    __device__ __forceinline__ int ld() const { return 10520; }
    __device__ __forceinline__ const GAS float* base(int) const { return w; }
    __device__ __forceinline__ long col(int n) const {
        int c;
        if (n < 1024) { const int cl = n & 255; c = (4 * (n >> 8) + ((cl >> 5) & 3)) * 64 + 32 * (cl >> 7) + 8 * ((cl >> 3) & 3) + 4 * ((cl >> 2) & 1) + (cl & 3); }
        else if (n < 3072) c = n; else if (n < 4608) c = n - 3072 + 3088; else if (n < 6400) c = n - 4608 + 4632; else if (n < 6416) c = n - 6400 + 3072; else if (n < 6424) c = n - 6416 + 4624; else if (n < 6656) c = -1;
        else { const int m = n - 6656, pn = m >> 8, cl = m & 255, z = 2 * (cl >> 7) + ((cl >> 2) & 1), ch = 64 * pn + 16 * ((cl >> 5) & 3) + 4 * ((cl >> 3) & 3) + (cl & 3); c = 6424 + z * 1024 + ch; }
        return c; } };
PH_FN void ph_weights(const Ctx C, ArgsP a, int l, int mask, int gw, int NGW) {
    LAS bf16* scr = (LAS bf16*)(C.lds + C.wave * 16384);
    int rot = 0;
#define W_FIRST(cnt) ({ const int f_ = (gw + NGW - rot % NGW) % NGW; rot += (cnt); f_; })
#pragma unroll 1
    for (int f = 0; f < 2; ++f) { if (!(mask & (1 << f))) continue;
        const GAS float* nrm = a->in[f ? 35 : 1] + (size_t)l * D; const GAS float* wg = a->in[f ? 36 : 2] + (size_t)l * D * FF; const GAS float* wu = a->in[f ? 37 : 3] + (size_t)l * D * FF; const GAS float* wd = a->in[f ? 38 : 4] + (size_t)l * FF * D;
        GAS bf16* Wgu = (GAS bf16*)(C.ws + (f ? WS_WGU2 : WS_WGU1)); GAS bf16* Wd = (GAS bf16*)(C.ws + (f ? WS_WD2 : WS_WD1));
        const SrcGU sgu{wg, wu};
        for (int it = W_FIRST((D / 64) * (2 * FF / 64)); it < (D / 64) * (2 * FF / 64); it += NGW) tr_item(sgu, nrm, Wgu, D, it / (2 * FF / 64), it % (2 * FF / 64), scr, C.lane);
        const SrcPlain sd{wd, D};
        for (int it = W_FIRST((FF / 64) * (D / 64)); it < (FF / 64) * (D / 64); it += NGW) tr_item(sd, nullptr, Wd, FF, it / (D / 64), it % (D / 64), scr, C.lane);
    }
    if (mask & 4)
    { const SrcWin sw{a->in[6] + (size_t)l * D * 10520}; const GAS float* nrm = a->in[5] + (size_t)l * D; GAS bf16* Win = (GAS bf16*)(C.ws + WS_WIN);
      for (int it = W_FIRST((D / 64) * (NWIN / 64)); it < (D / 64) * (NWIN / 64); it += NGW) tr_item(sw, nrm, Win, D, it / (NWIN / 64), it % (NWIN / 64), scr, C.lane); }
    if (!(mask & 8)) return;
    { GAS bf16* Wb = (GAS bf16*)(C.ws + WS_WB);
      for (int it = W_FIRST(4 * (512 / 64) * (D / 64)); it < 4 * (512 / 64) * (D / 64); it += NGW) { const int z = it / ((512 / 64) * (D / 64)), r = it % ((512 / 64) * (D / 64));
          const SrcPlain sb{a->in[32] + ((size_t)l * 4 + z) * 512 * D - (size_t)z * 512 * D, D}; tr_item(sb, nullptr, Wb, 2048, z * 8 + r / (D / 64), r % (D / 64), scr, C.lane); } }
    { GAS bf16* W2T = (GAS bf16*)(C.ws + WS_RW2T); GAS bf16* A2T = W2T + 512 * 64; GAS bf16* G2T = A2T + 512 * 64;
      const SrcPlain s1{a->in[23] + (size_t)l * 64 * 512, 512}, s2{a->in[25] + (size_t)l * 64 * 512, 512}, s3{a->in[26] + (size_t)l * 128 * 512, 512};
      for (int it = W_FIRST(8); it < 8; it += NGW) tr_item(s1, nullptr, W2T, 64, 0, it, scr, C.lane);
      for (int it = W_FIRST(8); it < 8; it += NGW) tr_item(s2, nullptr, A2T, 64, 0, it, scr, C.lane);
      for (int it = W_FIRST(16); it < 16; it += NGW) tr_item(s3, nullptr, G2T, 128, it >> 3, it & 7, scr, C.lane); }
    { const SrcPlain so{a->in[34] + (size_t)l * D * D, D}; GAS bf16* Wo = (GAS bf16*)(C.ws + WS_WO);
      for (int it = W_FIRST((D / 64) * (D / 64)); it < (D / 64) * (D / 64); it += NGW) tr_item(so, nullptr, Wo, D, it / (D / 64), it % (D / 64), scr, C.lane); }
}

#undef W_FIRST

typedef LAS bf16* LB; typedef const LAS bf16* CLB;
__device__ __forceinline__ pg8::bf16x8 frag32(CLB X, int ld, int row0, int k0, int lane) { return *(const LAS pg8::bf16x8*)(X + (row0 + (lane & 31)) * ld + k0 + 8 * (lane >> 5)); }
template <int K> __device__ __forceinline__ void mma_nt(f32x16& acc, CLB A, int lda, int m0, CLB Bt, int ldb, int n0, int lane) {
#pragma unroll
    for (int k = 0; k < K; k += 16) acc = __builtin_amdgcn_mfma_f32_32x32x16_bf16(frag32(A, lda, m0, k, lane), frag32(Bt, ldb, n0, k, lane), acc, 0, 0, 0);
}
__device__ __forceinline__ int crow(int r, int hi) { return (r & 3) + 8 * (r >> 2) + 4 * hi; }
__device__ __forceinline__ f32x16 zero16() { f32x16 z;
#pragma unroll
    for (int r = 0; r < 16; ++r) z[r] = 0.f;
    return z; }

__device__ __forceinline__ void gla_compute_G(const Ctx& C, ArgsP a, int l, int bc, int h, LF Gs) {
    const GAS bf16* P = (const GAS bf16*)(C.ws + WS_P); const GAS float* W2 = a->in[12] + (size_t)l * 16 * 256; const GAS float* gb = a->in[13] + (size_t)l * 256;
    const int t = C.tid >> 3, kg = C.tid & 7; const size_t row = (size_t)bc * 64 + t;
    float glr[16]; unpack8(*(const GAS u32x4*)(P + row * NPM + C_GLR), glr); unpack8(*(const GAS u32x4*)(P + row * NPM + C_GLR + 8), glr + 8);
#pragma unroll
    for (int i = 0; i < 8; ++i) { const int k = h * 64 + kg * 8 + i; float x = gb[k];
#pragma unroll
        for (int r = 0; r < 16; ++r) x += glr[r] * W2[r * 256 + k];
        Gs[t * 68 + kg * 8 + i] = logsigmoidf_(x) * (1.0f / 16.0f); }
    RW_BAR();
    { const int seg = C.tid >> 6, k = C.tid & 63; float run = 0.f;
#pragma unroll
      for (int i = 0; i < 8; ++i) { run += Gs[(8 * seg + i) * 68 + k]; Gs[(8 * seg + i) * 68 + k] = run; }
      RW_BAR();
      float off = 0.f;
#pragma unroll
      for (int sg = 0; sg < 7; ++sg) { const float tot = Gs[(8 * sg + 7) * 68 + k]; off += (sg < seg) ? tot : 0.f; }
      RW_BAR();
#pragma unroll
      for (int i = 0; i < 8; ++i) Gs[(8 * seg + i) * 68 + k] += off; }
    RW_BAR();
}
PH_HEAVY void ph_gla_a(const Ctx C, ArgsP a, int l) {
    const GAS bf16* P = (const GAS bf16*)(C.ws + WS_P); GAS bf16* GKV = (GAS bf16*)(C.ws + WS_GKV); GAS float* GL = (GAS float*)(C.ws + WS_GLAST); GAS bf16* YSg = (GAS bf16*)(C.ws + WS_YS);
    LF Gs = (LF)C.lds; LB KDT = (LB)(C.lds + 17408); LB VT = (LB)(C.lds + 26624);
    for (int it = C.bid; it < NBC * 4; it += C.G) {
        const int bc = it >> 2, h = it & 3;
        const u32x4 kw_ = *(const GAS u32x4*)(P + ((size_t)bc * 64 + (C.tid >> 3)) * NPM + C_GK + h * 64 + (C.tid & 7) * 8);
        const u32x4 v0 = *(const GAS u32x4*)(P + ((size_t)bc * 64 + (C.tid >> 3)) * NPM + C_GV + h * 128 + (C.tid & 7) * 16), v1 = *(const GAS u32x4*)(P + ((size_t)bc * 64 + (C.tid >> 3)) * NPM + C_GV + h * 128 + (C.tid & 7) * 16 + 8);
        RW_BAR();
        gla_compute_G(C, a, l, bc, h, Gs);
        { const int t = C.tid >> 3, g8 = C.tid & 7; const size_t row = (size_t)bc * 64 + t;
          { GAS float* gst = (GAS float*)(YSg + row * 2048 + 512 + h * 128) + g8 * 8; *(GAS f32x4*)gst = *(const LAS f32x4*)(Gs + t * 68 + g8 * 8); *(GAS f32x4*)(gst + 4) = *(const LAS f32x4*)(Gs + t * 68 + g8 * 8 + 4); }
          float kf[8]; unpack8(kw_, kf);
#pragma unroll
          for (int i = 0; i < 8; ++i) { const int k = g8 * 8 + i; KDT[k * 72 + t] = (bf16)f2bf(kf[i] * __expf(Gs[63 * 68 + k] - Gs[t * 68 + k])); }
          const unsigned vw[8] = {v0.x, v0.y, v0.z, v0.w, v1.x, v1.y, v1.z, v1.w};
#pragma unroll
          for (int i = 0; i < 8; ++i) { VT[(g8 * 16 + 2 * i) * 72 + t] = (bf16)(vw[i] & 0xffffu); VT[(g8 * 16 + 2 * i + 1) * 72 + t] = (bf16)(vw[i] >> 16); }
          if (C.tid < 64) GL[(size_t)it * 64 + C.tid] = Gs[63 * 68 + C.tid]; }
        RW_BAR();
        { const int kt = C.wave >> 2, vt = C.wave & 3, n = C.lane & 31, hi = C.lane >> 5;
          f32x16 acc = zero16(); mma_nt<64>(acc, KDT, 72, 32 * kt, VT, 72, 32 * vt, C.lane);
          GAS bf16* dst = GKV + ((size_t)it * 128 + 32 * vt + n) * 64 + 32 * kt + 4 * hi;
#pragma unroll
          for (int g = 0; g < 4; ++g) { u32x2 w; w.x = pk2(acc[4 * g], acc[4 * g + 1]); w.y = pk2(acc[4 * g + 2], acc[4 * g + 3]); *(GAS u32x2*)(dst + 8 * g) = w; } }
    }
    WG_SYNC();
}
PH_FN void gla_scan_part(const Ctx C, int part) {
    GAS unsigned* GKV = (GAS unsigned*)(C.ws + WS_GKV); const GAS float* GL = (const GAS float*)(C.ws + WS_GLAST);
    const int part_ = __builtin_amdgcn_readfirstlane(part), chain = part_ >> 3, idx = (part_ & 7) * NTHR + C.tid,     b = chain >> 2, h = chain & 3, k = (2 * idx) & 63;
    float s0 = 0.f, s1 = 0.f;
    unsigned tA[8], tB[8]; f32x2 dA[8], dB[8];
    GAS unsigned* gp = GKV + ((size_t)(b * NCH) * 4 + h) * 4096 + idx; const GAS float* lp = GL + ((size_t)(b * NCH) * 4 + h) * 64 + k;
#define GS_LOAD(T, D, c0_) do { GAS unsigned* g_ = gp + (size_t)(c0_) * 16384; const GAS float* l_ = lp + (size_t)(c0_) * 256; _Pragma("unroll") for (int i = 0; i < 8; ++i) { T[i] = g_[i * 16384]; D[i] = *(const GAS f32x2*)(l_ + i * 256); } } while (0)
#define GS_PROC(T, D, c0_) do { GAS unsigned* g_ = gp + (size_t)(c0_) * 16384; _Pragma("unroll") for (int i = 0; i < 8; ++i) { g_[i * 16384] = pk2(s0, s1); s0 = __expf(D[i][0]) * s0 + bflo(T[i]); s1 = __expf(D[i][1]) * s1 + bfhi(T[i]); } } while (0)
    GS_LOAD(tA, dA, 0);
#pragma unroll 1
    for (int c0 = 0; c0 < NCH; c0 += 16) { GS_LOAD(tB, dB, c0 + 8); GS_PROC(tA, dA, c0); if (c0 + 16 < NCH) GS_LOAD(tA, dA, c0 + 16); GS_PROC(tB, dB, c0 + 8); }
#undef GS_LOAD
#undef GS_PROC
}
PH_HEAVY void ph_gla_c(const Ctx C, ArgsP a, int l) {
    const GAS bf16* P = (const GAS bf16*)(C.ws + WS_P); const GAS bf16* GKV = (const GAS bf16*)(C.ws + WS_GKV); GAS bf16* YS = (GAS bf16*)(C.ws + WS_YS);
    const GAS float* gnorm = a->in[14] + (size_t)l * 128;
    LF Gs = (LF)C.lds; LB QD = (LB)(C.lds + 17408); LB KDR = (LB)(C.lds + 26624); LB QI = (LB)(C.lds + 35840); LB ATT = (LB)(C.lds + 45056); LB VT = (LB)(C.lds + 54272); LB ST = (LB)(C.lds + 72704); LF PS = (LF)(C.lds + 91136);
    for (int it = C.bid; it < NBC * 4; it += C.G) {
        const int bc = it >> 2, h = it & 3;
        { const int t = C.tid >> 3, g8 = C.tid & 7; const size_t row = (size_t)bc * 64 + t;
          const GAS float* gst = (const GAS float*)(YS + row * 2048 + 512 + h * 128) + g8 * 8; const f32x4 gs0 = *(const GAS f32x4*)gst, gs1 = *(const GAS f32x4*)(gst + 4);
          const u32x4 qw = *(const GAS u32x4*)(P + row * NPM + C_GQ + h * 64 + g8 * 8), kw = *(const GAS u32x4*)(P + row * NPM + C_GK + h * 64 + g8 * 8);
          const u32x4 v0 = *(const GAS u32x4*)(P + row * NPM + C_GV + h * 128 + g8 * 16), v1 = *(const GAS u32x4*)(P + row * NPM + C_GV + h * 128 + g8 * 16 + 8);
          const int v = C.tid >> 2, kq = (C.tid & 3) * 16; const GAS bf16* sp = GKV + ((size_t)it * 128 + v) * 64 + kq; const u32x4 st0 = *(const GAS u32x4*)sp, st1 = *(const GAS u32x4*)(sp + 8);
          __builtin_amdgcn_sched_barrier(0);
          RW_BAR();
          *(LAS f32x4*)(Gs + t * 68 + g8 * 8) = gs0; *(LAS f32x4*)(Gs + t * 68 + g8 * 8 + 4) = gs1;
          RW_BAR();
          float qf[8], kf[8], o1[8], o2[8], o3[8];
          unpack8(qw, qf); unpack8(kw, kf);
#pragma unroll
          for (int i = 0; i < 8; ++i) { const int k = g8 * 8 + i; const float g = Gs[t * 68 + k], d = g - Gs[32 * 68 + k]; o1[i] = qf[i] * 0.125f * __expf(d); o2[i] = kf[i] * __expf(-d); o3[i] = qf[i] * 0.125f * __expf(g); }
          *(LAS u32x4*)(QD + t * 72 + g8 * 8) = pack8(o1); *(LAS u32x4*)(KDR + t * 72 + g8 * 8) = pack8(o2); *(LAS u32x4*)(QI + t * 72 + g8 * 8) = pack8(o3);
          const unsigned vw[8] = {v0.x, v0.y, v0.z, v0.w, v1.x, v1.y, v1.z, v1.w};
#pragma unroll
          for (int i = 0; i < 8; ++i) { VT[(g8 * 16 + 2 * i) * 72 + t] = (bf16)(vw[i] & 0xffffu); VT[(g8 * 16 + 2 * i + 1) * 72 + t] = (bf16)(vw[i] >> 16); }
          *(LAS u32x4*)(ST + v * 72 + kq) = st0; *(LAS u32x4*)(ST + v * 72 + kq + 8) = st1; }
        RW_BAR();
        const int n = C.lane & 31, hi = C.lane >> 5;
        if (C.wave < 4) {
            const int it_ = C.wave >> 1, jt = C.wave & 1;
            f32x16 acc = zero16();
            if (jt <= it_) mma_nt<64>(acc, QD, 72, 32 * it_, KDR, 72, 32 * jt, C.lane);
#pragma unroll
            for (int r = 0; r < 16; ++r) { const int i = 32 * it_ + crow(r, hi), j = 32 * jt + n; ATT[i * 72 + j] = (bf16)f2bf(j <= i ? acc[r] : 0.f); }
        }
        RW_BAR();
        {
            const int it_ = C.wave & 1, vt = C.wave >> 1;
            f32x16 acc = zero16();
            mma_nt<64>(acc, VT, 72, 32 * vt, ATT, 72, 32 * it_, C.lane);
            mma_nt<64>(acc, ST, 72, 32 * vt, QI, 72, 32 * it_, C.lane);
            float ss = 0.f;
#pragma unroll
            for (int r = 0; r < 16; ++r) ss += acc[r] * acc[r];
            ss += __shfl_xor(ss, 32);
            if (hi == 0) PS[(32 * it_ + n) * 4 + vt] = ss;
            const int i = 32 * it_ + n; const size_t row = (size_t)bc * 64 + i;
            u32x2 ogq[4]; f32x4 gnq[4];
#pragma unroll
            for (int g = 0; g < 4; ++g) { const int v0 = 32 * vt + 8 * g + 4 * hi; ogq[g] = *(const GAS u32x2*)(P + row * NPM + C_GOG + h * 128 + v0); gnq[g] = *(const GAS f32x4*)(gnorm + v0); }
            RW_BAR();
            const float tot = (PS[i * 4] + PS[i * 4 + 1]) + (PS[i * 4 + 2] + PS[i * 4 + 3]);
            const float rs = 1.0f / sqrtf(tot * (1.0f / 128.0f) + EPS);
#pragma unroll
            for (int g = 0; g < 4; ++g) { const int v0 = 32 * vt + 8 * g + 4 * hi;
                const u32x2 ogw = ogq[g]; const f32x4 gn = gnq[g];
                const float og[4] = {bflo(ogw.x), bfhi(ogw.x), bflo(ogw.y), bfhi(ogw.y)}; float o4[4];
#pragma unroll
                for (int y = 0; y < 4; ++y) o4[y] = acc[4 * g + y] * rs * gn[y] * siluf_(og[y]);
                u32x2 w; w.x = pk2(o4[0], o4[1]); w.y = pk2(o4[2], o4[3]); *(GAS u32x2*)(YS + row * 2048 + 512 + h * 128 + v0) = w; }
        }
    }
    WG_SYNC();
}

__device__ __forceinline__ void ssd_conv8(const GAS bf16* P, const GAS float* cw, const GAS float* cb, int bc, int t, int ch0, float* o) {
    const int pos = (bc & 127) * 64 + t; const size_t row = (size_t)bc * 64 + t;
#pragma unroll
    for (int i = 0; i < 8; ++i) o[i] = cb[ch0 + i];
#pragma unroll
    for (int tap = 0; tap < 4; ++tap) { if (pos - 3 + tap >= 0) { float x[8]; unpack8(*(const GAS u32x4*)(P + (row - 3 + tap) * NPM + C_SX + ch0), x);
#pragma unroll
        for (int i = 0; i < 8; ++i) o[i] += cw[tap * 1024 + ch0 + i] * x[i]; } }
#pragma unroll
    for (int i = 0; i < 8; ++i) o[i] = siluf_(o[i]);
}
struct ConvIn { u32x4 x[4]; };
__device__ __forceinline__ ConvIn ssd_conv_ld(const GAS bf16* P, int bc, int t, int ch0) {
    const int pos = (bc & 127) * 64 + t; const size_t row = (size_t)bc * 64 + t; ConvIn r;
#pragma unroll
    for (int tap = 0; tap < 4; ++tap) { const bool in = pos - 3 + tap >= 0; r.x[tap] = *(const GAS u32x4*)(P + (row - (in ? 3 - tap : 0)) * NPM + C_SX + ch0); }
    return r;
}
__device__ __forceinline__ void ssd_conv_fin(const ConvIn& in, const LAS float* cws, int bc, int t, int ch0, float* o) {
    const int pos = (bc & 127) * 64 + t;
    { const f32x4 b0 = *(const LAS f32x4*)(cws + 4096 + ch0), b1 = *(const LAS f32x4*)(cws + 4096 + ch0 + 4);
#pragma unroll
      for (int i = 0; i < 4; ++i) { o[i] = b0[i]; o[4 + i] = b1[i]; } }
#pragma unroll
    for (int tap = 0; tap < 4; ++tap) { const bool inr = pos - 3 + tap >= 0; float x[8]; unpack8(in.x[tap], x);
        const f32x4 w0 = *(const LAS f32x4*)(cws + tap * 1024 + ch0), w1 = *(const LAS f32x4*)(cws + tap * 1024 + ch0 + 4);
#pragma unroll
        for (int i = 0; i < 4; ++i) { o[i] += w0[i] * (inr ? x[i] : 0.f); o[4 + i] += w1[i] * (inr ? x[4 + i] : 0.f); } }
#pragma unroll
    for (int i = 0; i < 8; ++i) o[i] = siluf_(o[i]);
}
__device__ __forceinline__ void ssd_conv_weights(const Ctx& C, const GAS float* cw, const GAS float* cb, LAS float* cws) {
    for (int q = C.tid * 4; q < 5120; q += NTHR * 4) *(LAS f32x4*)(cws + q) = (q < 4096) ? *(const GAS f32x4*)(cw + q) : *(const GAS f32x4*)(cb + (q - 4096));
}
PH_HEAVY void ph_ssd_a(const Ctx C, ArgsP a, int l) {
    const GAS bf16* P = (const GAS bf16*)(C.ws + WS_P); GAS bf16* SST = (GAS bf16*)(C.ws + WS_SST); GAS float* SDT = (GAS float*)(C.ws + WS_SDT); GAS float* SAC = (GAS float*)(C.ws + WS_SACUM); GAS float* SCD = (GAS float*)(C.ws + WS_SCDEC); GAS bf16* YSs = (GAS bf16*)(C.ws + WS_YS);
    const GAS float* cw = a->in[15] + (size_t)l * 4 * 1024; const GAS float* cb = a->in[16] + (size_t)l * 1024; const GAS float* dtb = a->in[17] + (size_t)l * 8; const GAS float* alog = a->in[18] + (size_t)l * 8;
    LB BT = (LB)C.lds; LB XDT = (LB)(C.lds + 18432); LF dtv = (LF)(C.lds + 55296); LF acu = dtv + 256; LF cws = (LF)(C.lds + 57344);
    WG_SYNC();
    ssd_conv_weights(C, cw, cb, cws);
    for (int it = C.bid; it < NBC * 2; it += C.G) {
        const int bc = it >> 1, g = it & 1; const int t = C.tid >> 3, cg = C.tid & 7;
        const ConvIn ib0 = ssd_conv_ld(P, bc, t, 512 + g * 128 + cg * 16), ib1 = ssd_conv_ld(P, bc, t, 512 + g * 128 + cg * 16 + 8);
        ConvIn ix[4];
#pragma unroll
        for (int hh = 0; hh < 4; ++hh) ix[hh] = ssd_conv_ld(P, bc, t, (4 * g + hh) * 64 + cg * 8);
        const int hw = 4 * g + (C.wave & 3); const size_t rowd = (size_t)bc * 64 + C.lane;
        const bf16 dtraw = P[rowd * NPM + C_SDT + hw]; const float dtb_ = dtb[hw], al_ = alog[hw];
        __builtin_amdgcn_sched_barrier(0);
        RW_BAR();
        if (C.wave < 4) { const float dt = softplusf_(bf2f(dtraw) + dtb_); float s = -__expf(al_) * dt;
#pragma unroll
            for (int o = 1; o < 64; o <<= 1) { const float nb_ = __shfl_up(s, o); if (C.lane >= o) s += nb_; }
            dtv[C.wave * 64 + C.lane] = dt; acu[C.wave * 64 + C.lane] = s; SDT[rowd * 8 + hw] = dt; SAC[rowd * 8 + hw] = s; if (C.lane == 63) SCD[(size_t)bc * 8 + hw] = __expf(s); }
        float xo[4][8];
        { float o[8];
          ssd_conv_fin(ib0, cws, bc, t, 512 + g * 128 + cg * 16, o);
#pragma unroll
          for (int i = 0; i < 8; ++i) BT[(cg * 16 + i) * 72 + t] = (bf16)f2bf(o[i]);
          ssd_conv_fin(ib1, cws, bc, t, 512 + g * 128 + cg * 16 + 8, o);
#pragma unroll
          for (int i = 0; i < 8; ++i) BT[(cg * 16 + 8 + i) * 72 + t] = (bf16)f2bf(o[i]); }
#pragma unroll
        for (int hh = 0; hh < 4; ++hh) { ssd_conv_fin(ix[hh], cws, bc, t, (4 * g + hh) * 64 + cg * 8, xo[hh]);
            *(GAS u32x4*)(YSs + ((size_t)bc * 64 + t) * 2048 + 1024 + (4 * g + hh) * 64 + cg * 8) = pack8(xo[hh]); }
        RW_BAR();
#pragma unroll
        for (int hh = 0; hh < 4; ++hh) { const float sc = dtv[hh * 64 + t] * __expf(acu[hh * 64 + 63] - acu[hh * 64 + t]);
#pragma unroll
            for (int i = 0; i < 8; ++i) XDT[hh * 4608 + (cg * 8 + i) * 72 + t] = (bf16)f2bf(xo[hh][i] * sc); }
        RW_BAR();
        { const int pt = C.wave >> 2, nt = C.wave & 3, n = C.lane & 31, hi = C.lane >> 5;
#pragma unroll
          for (int hh = 0; hh < 4; ++hh) { const size_t item8 = (size_t)bc * 8 + 4 * g + hh;
              f32x16 acc = zero16(); mma_nt<64>(acc, XDT + hh * 4608, 72, 32 * pt, BT, 72, 32 * nt, C.lane);
#pragma unroll
              for (int r = 0; r < 16; ++r) SST[(item8 * 64 + 32 * pt + crow(r, hi)) * 128 + 32 * nt + n] = (bf16)f2bf(acc[r]); } }
    }
    WG_SYNC();
}
PH_FN void ssd_scan_part(const Ctx C, int part) {
    GAS unsigned* SST = (GAS unsigned*)(C.ws + WS_SST); const GAS float* SCD = (const GAS float*)(C.ws + WS_SCDEC);
    const int part_ = __builtin_amdgcn_readfirstlane(part), chain = part_ >> 3, idx = (part_ & 7) * NTHR + C.tid, b = chain >> 3, hd = chain & 7;
    float s0 = 0.f, s1 = 0.f;
    unsigned tA[8], tB[8]; float dA[8], dB[8];
    GAS unsigned* gp = SST + ((size_t)(b * NCH) * 8 + hd) * 4096 + idx; const GAS float* lp = SCD + (size_t)(b * NCH) * 8 + hd;
#define SS_LOAD(T, D, c0_) do { GAS unsigned* g_ = gp + (size_t)(c0_) * 32768; const GAS float* l_ = lp + (size_t)(c0_) * 8; _Pragma("unroll") for (int i = 0; i < 8; ++i) { T[i] = g_[i * 32768]; D[i] = l_[i * 8]; } } while (0)
#define SS_PROC(T, D, c0_) do { GAS unsigned* g_ = gp + (size_t)(c0_) * 32768; _Pragma("unroll") for (int i = 0; i < 8; ++i) { g_[i * 32768] = pk2(s0, s1); s0 = D[i] * s0 + bflo(T[i]); s1 = D[i] * s1 + bfhi(T[i]); } } while (0)
    SS_LOAD(tA, dA, 0);
#pragma unroll 1
    for (int c0 = 0; c0 < NCH; c0 += 16) { SS_LOAD(tB, dB, c0 + 8); SS_PROC(tA, dA, c0); if (c0 + 16 < NCH) SS_LOAD(tA, dA, c0 + 16); SS_PROC(tB, dB, c0 + 8); }
#undef SS_LOAD
#undef SS_PROC
}
PH_HEAVY void ph_ssd_c(const Ctx C, ArgsP a, int l) {
    const GAS bf16* P = (const GAS bf16*)(C.ws + WS_P); const GAS bf16* SST = (const GAS bf16*)(C.ws + WS_SST); const GAS float* SDT = (const GAS float*)(C.ws + WS_SDT); const GAS float* SAC = (const GAS float*)(C.ws + WS_SACUM); GAS bf16* YS = (GAS bf16*)(C.ws + WS_YS);
    const GAS float* cw = a->in[15] + (size_t)l * 4 * 1024; const GAS float* cb = a->in[16] + (size_t)l * 1024; const GAS float* dpar = a->in[19] + (size_t)l * 8; const GAS float* snorm = a->in[20] + (size_t)l * 512;
    LB BN = (LB)C.lds; LB CN = (LB)(C.lds + 17408); LF CB = (LF)(C.lds + 34816); LF dtv = (LF)(C.lds + 123904); LF acu = dtv + 128; LF PSQ = (LF)(C.lds + 124928); LF cwt = (LF)(C.lds + 125952);
    const int hs = C.wave >> 2;
    LB SCw = (LB)(C.lds + 52224 + hs * 35840); LB XSTw = SCw + 64 * 72; LB HPw = XSTw + 64 * 72;
    WG_SYNC();
    { const int g0 = C.bid & 1, j = C.tid & 255, ch = (j < 128 ? 512 + g0 * 128 + j : 768 + g0 * 128 + (j - 128));
      if (C.tid < 256) { cwt[j] = cw[ch]; cwt[256 + j] = cw[1024 + ch]; cwt[1024 + j] = cb[ch]; } else { cwt[512 + j] = cw[2048 + ch]; cwt[768 + j] = cw[3072 + ch]; } }
    for (int it = C.bid; it < NBC * 2; it += C.G) {
        const int bc = it >> 1, g = it & 1;
        const int t = C.tid >> 3, cg = C.tid & 7, n = C.lane & 31, hi = C.lane >> 5;
        ConvIn ibc[4];
#pragma unroll
        for (int q = 0; q < 4; ++q) ibc[q] = ssd_conv_ld(P, bc, t, 512 + (q >> 1) * 256 + g * 128 + cg * 16 + (q & 1) * 8);
        u32x4 xw[4];
#pragma unroll
        for (int hh = 0; hh < 4; ++hh) xw[hh] = *(const GAS u32x4*)(YS + ((size_t)bc * 64 + t) * 2048 + 1024 + (4 * g + hh) * 64 + cg * 8);
        u32x4 hq[2][4]; float dq[2][2];
#define SSC_LD(hp_) do { _Pragma("unroll") for (int s_ = 0; s_ < 2; ++s_) { const size_t item8_ = (size_t)bc * 8 + 4 * g + 2 * (hp_) + s_; const GAS bf16* sp_ = SST + (item8_ * 64 + (C.tid >> 3)) * 128 + (C.tid & 7) * 16; \
            hq[hp_][2 * s_] = *(const GAS u32x4*)sp_; hq[hp_][2 * s_ + 1] = *(const GAS u32x4*)(sp_ + 8); } \
          { const int s_ = (C.tid >> 6) & 1, i_ = C.tid & 63, hd_ = 4 * g + 2 * (hp_) + s_; const size_t row_ = (size_t)bc * 64 + i_; dq[hp_][0] = SDT[row_ * 8 + hd_]; dq[hp_][1] = SAC[row_ * 8 + hd_]; } } while (0)
        SSC_LD(0);
        __builtin_amdgcn_sched_barrier(0);
        RW_BAR();
        { float o[8];
#pragma unroll
          for (int q = 0; q < 4; ++q) { const int lj = (q >> 1) * 128 + cg * 16 + (q & 1) * 8; const int pos = (bc & 127) * 64 + t;
              { const f32x4 b0 = *(const LAS f32x4*)(cwt + 1024 + lj), b1 = *(const LAS f32x4*)(cwt + 1024 + lj + 4);
#pragma unroll
                for (int i = 0; i < 4; ++i) { o[i] = b0[i]; o[4 + i] = b1[i]; } }
#pragma unroll
              for (int tap = 0; tap < 4; ++tap) { const bool inr = pos - 3 + tap >= 0; float x[8]; unpack8(ibc[q].x[tap], x);
                  const f32x4 w0 = *(const LAS f32x4*)(cwt + tap * 256 + lj), w1 = *(const LAS f32x4*)(cwt + tap * 256 + lj + 4);
#pragma unroll
                  for (int i = 0; i < 4; ++i) { o[i] += w0[i] * (inr ? x[i] : 0.f); o[4 + i] += w1[i] * (inr ? x[4 + i] : 0.f); } }
#pragma unroll
              for (int i = 0; i < 8; ++i) o[i] = siluf_(o[i]);
              *(LAS u32x4*)(((q >> 1) ? CN : BN) + t * 136 + cg * 16 + (q & 1) * 8) = pack8(o); } }
        RW_BAR();
        if (C.wave < 4) {
            const int it_ = C.wave >> 1, jt = C.wave & 1;
            f32x16 acc = zero16(); mma_nt<128>(acc, CN, 136, 32 * it_, BN, 136, 32 * jt, C.lane);
#pragma unroll
            for (int r = 0; r < 16; ++r) CB[(32 * it_ + crow(r, hi)) * 68 + 32 * jt + n] = acc[r];
        }
        float yk[2][16]; float ssq = 0.f;
        const int pt = (C.wave >> 1) & 1, it2 = C.wave & 1;
#pragma unroll
        for (int hp = 0; hp < 2; ++hp) {
            RW_BAR();
            if (C.tid < 128) { dtv[C.tid] = dq[hp][0]; acu[C.tid] = dq[hp][1]; }
#pragma unroll
            for (int s = 0; s < 2; ++s) { const int hd = 4 * g + 2 * hp + s; const size_t item8 = (size_t)bc * 8 + hd; LB XSTs = (LB)(C.lds + 52224 + s * 35840) + 64 * 72; LB HPs = XSTs + 64 * 72;
                { const u32x4 xq = xw[2 * hp + s]; const unsigned xv[4] = {xq.x, xq.y, xq.z, xq.w};
#pragma unroll
                  for (int i = 0; i < 4; ++i) { XSTs[(cg * 8 + 2 * i) * 72 + t] = (bf16)(xv[i] & 0xffffu); XSTs[(cg * 8 + 2 * i + 1) * 72 + t] = (bf16)(xv[i] >> 16); } }
                const int p = C.tid >> 3, n0 = (C.tid & 7) * 16; (void)item8;
                *(LAS u32x4*)(HPs + p * 136 + n0) = hq[hp][2 * s]; *(LAS u32x4*)(HPs + p * 136 + n0 + 8) = hq[hp][2 * s + 1]; }
            if (hp == 0) SSC_LD(1);
            RW_BAR();
#pragma unroll
            for (int s = 0; s < 2; ++s) { LB SCs = (LB)(C.lds + 52224 + s * 35840); const float ai = acu[s * 64 + t]; float o[8];
#pragma unroll
                for (int jj = 0; jj < 8; ++jj) { const int j = 8 * cg + jj; o[jj] = (j <= t) ? CB[t * 68 + j] * __expf(ai - acu[s * 64 + j]) * dtv[s * 64 + j] : 0.f; }
                *(LAS u32x4*)(SCs + t * 72 + 8 * cg) = pack8(o); }
            RW_BAR();
            {
                const int hd = 4 * g + 2 * hp + hs; const int i = 32 * it2 + n; const size_t row = (size_t)bc * 64 + i; const float dh = dpar[hd];
                u32x2 zq[4];
#pragma unroll
                for (int q4 = 0; q4 < 4; ++q4) zq[q4] = *(const GAS u32x2*)(P + row * NPM + C_SZ + hd * 64 + 32 * pt + 8 * q4 + 4 * hi);
                __builtin_amdgcn_sched_barrier(0);
                f32x16 acc = zero16();
                mma_nt<128>(acc, HPw, 136, 32 * pt, CN, 136, 32 * it2, C.lane);
                const float ea = __expf(acu[hs * 64 + i]);
#pragma unroll
                for (int r = 0; r < 16; ++r) acc[r] *= ea;
                mma_nt<64>(acc, XSTw, 72, 32 * pt, SCw, 72, 32 * it2, C.lane);
#pragma unroll
                for (int q4 = 0; q4 < 4; ++q4) { const int p0 = 32 * pt + 8 * q4 + 4 * hi;
                    const u32x2 zw = zq[q4]; const float zf[4] = {bflo(zw.x), bfhi(zw.x), bflo(zw.y), bfhi(zw.y)};
#pragma unroll
                    for (int e = 0; e < 4; ++e) { const float xs = bf2f(XSTw[(p0 + e) * 72 + i]); const float v = (acc[4 * q4 + e] + dh * xs) * siluf_(zf[e]); yk[hp][4 * q4 + e] = v; ssq += v * v; } }
            }
        }
        { ssq += __shfl_xor(ssq, 32); if (hi == 0) PSQ[(32 * it2 + n) * 4 + pt * 2 + hs] = ssq; }
        f32x4 snq[2][4];
#pragma unroll
        for (int hp = 0; hp < 2; ++hp)
#pragma unroll
            for (int q4 = 0; q4 < 4; ++q4) snq[hp][q4] = *(const GAS f32x4*)(snorm + g * 256 + (2 * hp + hs) * 64 + 32 * pt + 8 * q4 + 4 * hi);
        __builtin_amdgcn_sched_barrier(0);
        RW_BAR();
        {   const int i = 32 * it2 + n; const f32x4 ps = *(const LAS f32x4*)(PSQ + i * 4); const float rs = 1.0f / sqrtf(((ps[0] + ps[1]) + (ps[2] + ps[3])) * (1.0f / 256.0f) + EPS); const size_t row = (size_t)bc * 64 + i;
#pragma unroll
            for (int hp = 0; hp < 2; ++hp)
#pragma unroll
                for (int q4 = 0; q4 < 4; ++q4) { const int ch = g * 256 + (2 * hp + hs) * 64 + 32 * pt + 8 * q4 + 4 * hi; const f32x4 sn = snq[hp][q4];
                    u32x2 w; w.x = pk2(yk[hp][4 * q4] * rs * sn[0], yk[hp][4 * q4 + 1] * rs * sn[1]); w.y = pk2(yk[hp][4 * q4 + 2] * rs * sn[2], yk[hp][4 * q4 + 3] * rs * sn[3]);
                    *(GAS u32x2*)(YS + row * 2048 + 1024 + ch) = w; }
        }
    }
    WG_SYNC();
}
#undef SSC_LD

struct LerpIn { u32x4 x, xp; };
__device__ __forceinline__ LerpIn rw_lerp_ld(const GAS bf16* P, size_t row, bool first, int c0) {
    LerpIn r; r.x = *(const GAS u32x4*)(P + row * NPM + C_RR + c0); r.xp = *(const GAS u32x4*)(P + (row - (first ? 0 : 1)) * NPM + C_RR + c0); return r; }
__device__ __forceinline__ void rw_lerp_fin(const LerpIn& in, bool first, const LAS float* mus, float* o) {
    float x[8], xp[8]; unpack8(in.x, x); unpack8(in.xp, xp); const f32x4 m0 = *(const LAS f32x4*)mus, m1 = *(const LAS f32x4*)(mus + 4);
#pragma unroll
    for (int i = 0; i < 8; ++i) { const float d = (first ? 0.f : xp[i]) - x[i]; o[i] = x[i] + d * (i < 4 ? m0[i] : m1[i - 4]); }
}
#define RW_WFRAG(WT_, K_, nt_, s_) (*(const GAS pg8::bf16x8*)((WT_) + (size_t)(head * 64 + 32 * (nt_) + n) * (K_) + 16 * (s_) + 8 * hi))
#define RWP_PTRS \
    const GAS bf16* P = (const GAS bf16*)(C.ws + WS_P); \
    GAS float* RWW = (GAS float*)(C.ws + WS_RWW); GAS bf16* RWR = (GAS bf16*)(C.ws + WS_RWR); GAS bf16* RWK = (GAS bf16*)(C.ws + WS_RWK); GAS bf16* RWV = (GAS bf16*)(C.ws + WS_RWV); GAS bf16* RWKK = (GAS bf16*)(C.ws + WS_RWKK); GAS bf16* RWB = (GAS bf16*)(C.ws + WS_RWB); GAS bf16* RWG = (GAS bf16*)(C.ws + WS_RWG); \
    const GAS bf16* W2T = (const GAS bf16*)(C.ws + WS_RW2T); const GAS bf16* A2T = W2T + 512 * 64; const GAS bf16* G2T = A2T + 512 * 64;       \
    const GAS float* mu = a->in[21] + (size_t)l * 1792; const GAS float* w0 = a->in[22] + (size_t)l * 512; const GAS float* a0 = a->in[24] + (size_t)l * 512; \
    const GAS float* k_k = a->in[27] + (size_t)l * 512; const GAS float* k_a = a->in[28] + (size_t)l * 512; \
    LB WLb = (LB)C.lds; LB ALb = (LB)(C.lds + 9216); LB GLb = (LB)(C.lds + 18432);         \
    LB KX = (LB)(C.lds + 35840); LF w0s = (LF)(C.lds + 102400); LF a0s = w0s + 512; LF kks = a0s + 512; LF kas = kks + 512; LF INVs = kas + 512; LF mus = INVs + 512;     \
    (void)mus; (void)KX; (void)w0s; (void)a0s; (void)kks; (void)kas; (void)INVs; \
    (void)P; (void)RWW; (void)RWR; (void)RWK; (void)RWV; (void)RWKK; (void)RWB; (void)RWG; (void)W2T; (void)A2T; (void)G2T; (void)mu; (void)w0; (void)a0; (void)k_k; (void)k_a; (void)WLb; (void)ALb; (void)GLb;
#define RWP_LANE const int head = C.wave, n = C.lane & 31, hi = C.lane >> 5; const size_t row0 = (size_t)bc * 64 + 32 * tt; (void)row0;
PH_FN void rwp_stage(const Ctx C, ArgsP a, int l, int bc) {
    RWP_PTRS
    const int t = C.tid >> 3, cg = C.tid & 7; const size_t row = (size_t)bc * 64 + t; const bool first = ((bc & 127) == 0) && (t == 0);
    const LerpIn iw = rw_lerp_ld(P, row, first, 1536 + cg * 8), ia = rw_lerp_ld(P, row, first, 1600 + cg * 8), ig0 = rw_lerp_ld(P, row, first, 1664 + cg * 16), ig1 = rw_lerp_ld(P, row, first, 1664 + cg * 16 + 8);
    LerpIn cr = rw_lerp_ld(P, row, first, cg * 8), cv = rw_lerp_ld(P, row, first, 1024 + cg * 8), ck = rw_lerp_ld(P, row, first, 512 + cg * 8);
    const int q = C.tid * 4; const f32x4 pv = *(const GAS f32x4*)((q < 512 ? w0 : q < 1024 ? a0 - 512 : q < 1536 ? k_k - 1024 : k_a - 1536) + q); const f32x4 mv = *(const GAS f32x4*)(mu + (C.tid < 448 ? q : 0));
    WG_SYNC();
    *(LAS f32x4*)(w0s + q) = pv; if (C.tid < 448) *(LAS f32x4*)(mus + q) = mv;
    WG_SYNC();
    { float o[8];
      rw_lerp_fin(iw, first, mus + 1536 + cg * 8, o);
#pragma unroll
      for (int i = 0; i < 8; ++i) o[i] = tanhf(o[i]);
      *(LAS u32x4*)(WLb + t * 72 + cg * 8) = pack8(o);
      rw_lerp_fin(ia, first, mus + 1600 + cg * 8, o); *(LAS u32x4*)(ALb + t * 72 + cg * 8) = pack8(o);
      rw_lerp_fin(ig0, first, mus + 1664 + cg * 16, o);
#pragma unroll
      for (int i = 0; i < 8; ++i) o[i] = sigmoidf_(o[i]);
      *(LAS u32x4*)(GLb + t * 136 + cg * 16) = pack8(o);
      rw_lerp_fin(ig1, first, mus + 1664 + cg * 16 + 8, o);
#pragma unroll
      for (int i = 0; i < 8; ++i) o[i] = sigmoidf_(o[i]);
      *(LAS u32x4*)(GLb + t * 136 + cg * 16 + 8) = pack8(o);
#pragma unroll
      for (int j = 0; j < 8; ++j) { const int c = j * 64 + cg * 8;
          LerpIn nr = cr, nv = cv, nk = ck;
          if (j < 7) { nr = rw_lerp_ld(P, row, first, c + 64); nv = rw_lerp_ld(P, row, first, 1024 + c + 64); nk = rw_lerp_ld(P, row, first, 512 + c + 64); }
          rw_lerp_fin(cr, first, mus + c, o); *(GAS u32x4*)(RWR + row * 512 + c) = pack8(o);
          rw_lerp_fin(cv, first, mus + 1024 + c, o); *(GAS u32x4*)(RWV + row * 512 + c) = pack8(o);
          rw_lerp_fin(ck, first, mus + 512 + c, o); *(LAS u32x4*)(KX + t * 520 + c) = pack8(o);
          const f32x4 k0 = *(const LAS f32x4*)(kks + c), k1 = *(const LAS f32x4*)(kks + c + 4); float ss = 0.f;
#pragma unroll
          for (int i = 0; i < 4; ++i) { const float q0 = o[i] * k0[i], q1 = o[4 + i] * k1[i]; ss += q0 * q0 + q1 * q1; }
          ss += __shfl_xor(ss, 1); ss += __shfl_xor(ss, 2); ss += __shfl_xor(ss, 4);
          if (cg == 0) INVs[t * 8 + j] = 1.0f / fmaxf(sqrtf(ss), 1e-12f);
          cr = nr; cv = nv; ck = nk; } }
    WG_SYNC();
}
PH_FN void rwp_w(const Ctx C, ArgsP a, int l, int bc, int tt) {
    RWP_PTRS RWP_LANE
    pg8::bf16x8 wf[2][4]; f32x16 c[2] = {zero16(), zero16()};
#pragma unroll
    for (int nt = 0; nt < 2; ++nt)
#pragma unroll
        for (int s4 = 0; s4 < 4; ++s4) wf[nt][s4] = RW_WFRAG(W2T, 64, nt, s4);
    __builtin_amdgcn_sched_barrier(0);
#pragma unroll
    for (int s4 = 0; s4 < 4; ++s4) { const pg8::bf16x8 af = frag32(WLb, 72, 32 * tt, 16 * s4, C.lane);
#pragma unroll
        for (int nt = 0; nt < 2; ++nt) c[nt] = __builtin_amdgcn_mfma_f32_32x32x16_bf16(af, wf[nt][s4], c[nt], 0, 0, 0); }
#pragma unroll
    for (int nt = 0; nt < 2; ++nt) { const int ch = head * 64 + 32 * nt + n; const float w0c = w0s[ch];
#pragma unroll
        for (int r = 0; r < 16; ++r) RWW[(row0 + crow(r, hi)) * 512 + ch] = -0.606531f * sigmoidf_(w0c + c[nt][r]); }
}
PH_FN void rwp_g(const Ctx C, ArgsP a, int l, int bc, int tt) {
    RWP_PTRS RWP_LANE
    pg8::bf16x8 wf[2][8]; f32x16 c[2] = {zero16(), zero16()};
#pragma unroll
    for (int nt = 0; nt < 2; ++nt)
#pragma unroll
        for (int s8 = 0; s8 < 8; ++s8) wf[nt][s8] = RW_WFRAG(G2T, 128, nt, s8);
    __builtin_amdgcn_sched_barrier(0);
#pragma unroll
    for (int s8 = 0; s8 < 8; ++s8) { const pg8::bf16x8 af = frag32(GLb, 136, 32 * tt, 16 * s8, C.lane);
#pragma unroll
        for (int nt = 0; nt < 2; ++nt) c[nt] = __builtin_amdgcn_mfma_f32_32x32x16_bf16(af, wf[nt][s8], c[nt], 0, 0, 0); }
#pragma unroll
    for (int nt = 0; nt < 2; ++nt) { const int ch = head * 64 + 32 * nt + n;
#pragma unroll
        for (int r = 0; r < 16; ++r) RWG[(row0 + crow(r, hi)) * 512 + ch] = (bf16)f2bf(c[nt][r]); }
}
PH_FN void rwp_ak(const Ctx C, ArgsP a, int l, int bc, int tt) {
    RWP_PTRS RWP_LANE
    pg8::bf16x8 wf[2][4]; f32x16 c[2] = {zero16(), zero16()};
#pragma unroll
    for (int nt = 0; nt < 2; ++nt)
#pragma unroll
        for (int s4 = 0; s4 < 4; ++s4) wf[nt][s4] = RW_WFRAG(A2T, 64, nt, s4);
    __builtin_amdgcn_sched_barrier(0);
#pragma unroll
    for (int s4 = 0; s4 < 4; ++s4) { const pg8::bf16x8 af = frag32(ALb, 72, 32 * tt, 16 * s4, C.lane);
#pragma unroll
        for (int nt = 0; nt < 2; ++nt) c[nt] = __builtin_amdgcn_mfma_f32_32x32x16_bf16(af, wf[nt][s4], c[nt], 0, 0, 0); }
#pragma unroll
    for (int nt = 0; nt < 2; ++nt) { const int ch = head * 64 + 32 * nt + n; const float a0c = a0s[ch], kkc = kks[ch], kac = kas[ch];
#pragma unroll
        for (int r = 0; r < 16; ++r) { const int tl = 32 * tt + crow(r, hi); const float al = sigmoidf_(a0c + c[nt][r]), x = bf2f(KX[tl * 520 + ch]), kkn = x * kkc * INVs[tl * 8 + head];
            const size_t g = ((size_t)bc * 64 + tl) * 512 + ch;
            RWKK[g] = (bf16)f2bf(kkn); RWB[g] = (bf16)f2bf(kkn * al); RWK[g] = (bf16)f2bf(x * (1.0f + (al - 1.0f) * kac)); } }
}
#undef RW_WFRAG
#undef RWP_PTRS
#undef RWP_LANE
__device__ __forceinline__ void ph_rw_prep(const Ctx& C, ArgsP a, int l) {
    for (int bc = C.bid; bc < NBC; bc += C.G) { rwp_stage(C, a, l, bc);
#pragma unroll 1
        for (int tt = 0; tt < 2; ++tt) { rwp_w(C, a, l, bc, tt); rwp_g(C, a, l, bc, tt); rwp_ak(C, a, l, bc, tt); } }
    WG_SYNC();
}
PH_FN void ph_rw_out(const Ctx C, ArgsP a, int l) {
    const GAS bf16* RWR = (const GAS bf16*)(C.ws + WS_RWR); const GAS bf16* RWK = (const GAS bf16*)(C.ws + WS_RWK); const GAS bf16* RWV = (const GAS bf16*)(C.ws + WS_RWV); const GAS bf16* RWG = (const GAS bf16*)(C.ws + WS_RWG); const GAS bf16* RWY = (const GAS bf16*)(C.ws + WS_RWY);
    GAS bf16* YS = (GAS bf16*)(C.ws + WS_YS);
    const GAS float* r_k = a->in[29] + (size_t)l * 512; const GAS float* nw = a->in[30] + (size_t)l * 512; const GAS float* nb = a->in[31] + (size_t)l * 512;
    const int gw = C.bid * NWAVES + C.wave, NGW = C.G * NWAVES, c0 = C.lane * 8;
    float rk[8], w8[8], b8[8];
#pragma unroll
    for (int i = 0; i < 8; ++i) { rk[i] = r_k[c0 + i]; w8[i] = nw[c0 + i]; b8[i] = nb[c0 + i]; }
    u32x4 nyw[2], nrw[2], nkw[2], nvw[2], ngw[2];
#define RWO_LD(r0_) do { _Pragma("unroll") for (int u = 0; u < 2; ++u) { const size_t g = (size_t)((r0_) + u) * 512 + c0; nyw[u] = *(const GAS u32x4*)(RWY + g); nrw[u] = *(const GAS u32x4*)(RWR + g); nkw[u] = *(const GAS u32x4*)(RWK + g); nvw[u] = *(const GAS u32x4*)(RWV + g); ngw[u] = *(const GAS u32x4*)(RWG + g); } } while (0)
    if (gw * 2 < M) RWO_LD(gw * 2);
#pragma unroll 1
    for (int row0 = gw * 2; row0 < M; row0 += NGW * 2) {
        u32x4 yw[2], rw[2], kw[2], vw[2], gw4[2];
#pragma unroll
        for (int u = 0; u < 2; ++u) { yw[u] = nyw[u]; rw[u] = nrw[u]; kw[u] = nkw[u]; vw[u] = nvw[u]; gw4[u] = ngw[u]; }
        if (row0 + NGW * 2 < M) RWO_LD(row0 + NGW * 2);
#pragma unroll
        for (int u = 0; u < 2; ++u) { float y[8], r[8], k[8], v[8], gg[8], o[8]; unpack8(yw[u], y); unpack8(rw[u], r); unpack8(kw[u], k); unpack8(vw[u], v); unpack8(gw4[u], gg);
            float s = 0.f, bs = 0.f;
#pragma unroll
            for (int i = 0; i < 8; ++i) { s += y[i]; bs += r[i] * k[i] * rk[i]; }
            s += __shfl_xor(s, 1); s += __shfl_xor(s, 2); s += __shfl_xor(s, 4); bs += __shfl_xor(bs, 1); bs += __shfl_xor(bs, 2); bs += __shfl_xor(bs, 4);
            const float mu = s * (1.0f / 64.0f); float q = 0.f;
#pragma unroll
            for (int i = 0; i < 8; ++i) { y[i] -= mu; q += y[i] * y[i]; }
            q += __shfl_xor(q, 1); q += __shfl_xor(q, 2); q += __shfl_xor(q, 4);
            const float rs = 1.0f / sqrtf(q * (1.0f / 64.0f) + 64e-5f);
#pragma unroll
            for (int i = 0; i < 8; ++i) o[i] = (y[i] * rs * w8[i] + b8[i] + bs * v[i]) * gg[i];
            *(GAS u32x4*)(YS + (size_t)(row0 + u) * 2048 + 1536 + c0) = pack8(o); }
    }
#undef RWO_LD
}

__device__ __forceinline__ int pi_swap23(int i) { return (i & ~12) | ((i & 4) << 1) | ((i & 8) >> 1); }
__device__ __forceinline__ void da_unit(const Ctx& C, const Args& a, int l, int b, int h, int jq, float lam, float oml, gu32* qnext, int& nx) {
    const GAS bf16* P = (const GAS bf16*)(C.ws + WS_P); GAS bf16* YS = (GAS bf16*)(C.ws + WS_YS);
    const GAS float* dnorm = (const GAS float*)a.in[11] + (size_t)l * 128;
    const int comp = C.wave >> 2, wq = C.wave & 3, q = C.lane & 31, hi = C.lane >> 5;
    const size_t qrow = (size_t)b * SEQ + jq * 128 + wq * 32 + q;
    pg8::bf16x8 qf[4];
#pragma unroll
    for (int d0 = 0; d0 < 4; ++d0) qf[d0] = *(const GAS pg8::bf16x8*)(P + qrow * NPM + C_DAQ + h * 128 + comp * 64 + 16 * d0 + 8 * hi);
    const int ntile = 2 * jq + 2, my_last = 2 * jq + (wq >= 2 ? 1 : 0);
    f32x16 O[4];
#pragma unroll
    for (int db = 0; db < 4; ++db)
#pragma unroll
        for (int r = 0; r < 16; ++r) O[db][r] = 0.f;
    float mrun = 0.f, lrun = 0.f;
    f32x16 negm;
#pragma unroll
    for (int r = 0; r < 16; ++r) negm[r] = 0.f;
    const GAS bf16* kgb = P + (size_t)b * SEQ * NPM + C_DAK + h * 128 + C.wave * 8;
    const GAS bf16* vgb = P + (size_t)b * SEQ * NPM + C_DAV + h * 128;
    const unsigned vslot_p = (unsigned)C.wave * 64u + (unsigned)C.lane, vrow_p = 8u * (vslot_p >> 7) + ((vslot_p >> 2) & 7u), vch_p = 4u * ((vslot_p >> 5) & 3u) + ((vslot_p & 3u) ^ ((vrow_p >> 2) & 3u));
    const unsigned koff = (unsigned)C.lane * (unsigned)(NPM * 2), voff = vrow_p * (unsigned)(NPM * 2) + vch_p * 16u;
    const unsigned lds0 = (unsigned)(size_t)C.lds;
    const unsigned kdst0 = lds0 + (unsigned)(C.wave >> 3) * 8192u + (unsigned)(C.wave & 7) * 1024u;
    const unsigned vdst0 = lds0 + 49152u + (unsigned)C.wave * 1024u;
    const unsigned vtr_c = 2u * ((unsigned)(C.lane >> 4) & 1u) + (((unsigned)C.lane & 3u) >> 1), vtr_q = ((unsigned)C.lane & 15u) >> 2;
    const unsigned vtb0 = 2048u * (unsigned)hi + 64u * vtr_q + 8u * ((unsigned)C.lane & 1u) + 16u * (vtr_c ^ ((2u * (unsigned)hi) & 3u));
    const unsigned vtb1 = 2048u * (unsigned)hi + 64u * (4u + vtr_q) + 8u * ((unsigned)C.lane & 1u) + 16u * (vtr_c ^ ((2u * (unsigned)hi + 1u) & 3u));
    typedef short v4i16_da __attribute__((ext_vector_type(4)));
#define DA_VTR(base_, off_) ({ const v4i16_da lo_ = __builtin_amdgcn_ds_read_tr16_b64_v4i16((LAS v4i16_da*)((base_) + vtb0 + (off_))), hi_ = __builtin_amdgcn_ds_read_tr16_b64_v4i16((LAS v4i16_da*)((base_) + vtb1 + (off_))); \
        (pg8::bf16x8)__builtin_shufflevector(lo_, hi_, 0, 1, 2, 3, 4, 5, 6, 7); })
    const int pq = pi_swap23(q);
    pg8::bf16x8 pb[4] = {};
    int ks = 0;
#define DA_ROT(x_) (((x_) == 32768) ? 0 : (x_) + 16384)
#define DA_GLDS(base_, off_, dst_) do { unsigned keep_; asm volatile("s_mov_b32 %0, m0\n\ts_mov_b32 m0, %3\n\ts_nop 0\n\tglobal_load_lds_dwordx4 %1, %2\n\ts_mov_b32 m0, %0" : "=&s"(keep_) : "v"(off_), "s"(base_), "s"((unsigned)__builtin_amdgcn_readfirstlane(dst_)) : "memory"); } while (0)
#define DA_DMA(tile_, kslot_) do { const GAS bf16* kp_ = kgb + (size_t)(tile_) * 64 * NPM; const GAS bf16* vp_ = vgb + (size_t)(tile_) * 64 * NPM; const unsigned kd_ = kdst0 + (unsigned)(kslot_), vd_ = vdst0 + (unsigned)((tile_) & 3) * 16384u; \
        DA_GLDS(kp_, koff, kd_); DA_GLDS(kp_ + 64, koff, kd_ + 8192u); DA_GLDS(vp_, voff, vd_); DA_GLDS(vp_ + 32 * NPM, voff, vd_ + 8192u); } while (0)
#define DA_STAGE(tile_) do { if ((tile_) + 1 < ntile) asm volatile("s_waitcnt vmcnt(4)" ::: "memory"); else asm volatile("s_waitcnt vmcnt(0)" ::: "memory"); RW_BAR(); if ((tile_) + 2 < ntile) DA_DMA((tile_) + 2, DA_ROT(DA_ROT(ks))); } while (0)
#define DA_QK(tile_) do { const LAS unsigned char* kb_ = C.lds + ks + comp * 8192 + hi * 1024 + pq * 16; pg8::bf16x8 ka_[8]; \
        _Pragma("unroll") for (int d0 = 0; d0 < 4; ++d0) { ka_[2 * d0] = *(const LAS pg8::bf16x8*)(kb_ + d0 * 2048); ka_[2 * d0 + 1] = *(const LAS pg8::bf16x8*)(kb_ + d0 * 2048 + 512); } \
        __builtin_amdgcn_sched_barrier(0); \
        p0 = __builtin_amdgcn_mfma_f32_32x32x16_bf16(ka_[0], qf[0], negm, 0, 0, 0); p1 = __builtin_amdgcn_mfma_f32_32x32x16_bf16(ka_[1], qf[0], negm, 0, 0, 0); \
        _Pragma("unroll") for (int d0 = 1; d0 < 4; ++d0) { p0 = __builtin_amdgcn_mfma_f32_32x32x16_bf16(ka_[2 * d0], qf[d0], p0, 0, 0, 0); p1 = __builtin_amdgcn_mfma_f32_32x32x16_bf16(ka_[2 * d0 + 1], qf[d0], p1, 0, 0, 0); } } while (0)
#define DA_PV(PB_, voff_) do { const LAS unsigned char* vb_ = C.lds + 49152 + (voff_); _Pragma("unroll") for (int db = 0; db < 4; ++db) _Pragma("unroll") for (int s = 0; s < 4; ++s) { \
            const pg8::bf16x8 vf_ = DA_VTR(vb_, 4096 * s + 512 * db); O[db] = __builtin_amdgcn_mfma_f32_32x32x16_bf16(vf_, PB_[s], O[db], 0, 0, 0); } } while (0)
#define DA_MX3(a_, b_, c_) __builtin_fmaxf(__builtin_fmaxf((a_), (b_)), (c_))
#define DA_SM_MAX(FIRST_, PBP_) do { \
        float ma = DA_MX3(p0[0], p0[1], p1[0]), mb = DA_MX3(p0[2], p0[3], p1[1]); ma = DA_MX3(ma, p1[2], p1[3]); \
        _Pragma("unroll") for (int r = 4; r < 16; r += 4) { ma = DA_MX3(ma, p0[r], p0[r + 1]); mb = DA_MX3(mb, p0[r + 2], p0[r + 3]); ma = DA_MX3(ma, p1[r], p1[r + 1]); mb = DA_MX3(mb, p1[r + 2], p1[r + 3]); } \
        float rm = __builtin_fmaxf(ma, mb); { const auto rr_ = __builtin_amdgcn_permlane32_swap(__float_as_uint(rm), __float_as_uint(rm), false, false); rm = __builtin_fmaxf(__uint_as_float(rr_[0]), __uint_as_float(rr_[1])); }   \
        if ((FIRST_) || __any(rm > 8.0f)) { const float dl = (FIRST_) ? rm : __builtin_fmaxf(rm, 0.f); mrun += dl; const float f = __builtin_amdgcn_exp2f(-dl); lrun *= f; \
            _Pragma("unroll") for (int r = 0; r < 16; ++r) { p0[r] -= dl; p1[r] -= dl; negm[r] = -mrun; } \
            _Pragma("unroll") for (int db = 0; db < 4; ++db) _Pragma("unroll") for (int r = 0; r < 16; ++r) O[db][r] *= f; \
            if (!(FIRST_)) { _Pragma("unroll") for (int s_ = 0; s_ < 4; ++s_) { const u32x4 w_ = __builtin_bit_cast(u32x4, PBP_[s_]); u32x4 o_; \
                o_.x = pk2(bflo(w_.x) * f, bfhi(w_.x) * f); o_.y = pk2(bflo(w_.y) * f, bfhi(w_.y) * f); o_.z = pk2(bflo(w_.z) * f, bfhi(w_.z) * f); o_.w = pk2(bflo(w_.w) * f, bfhi(w_.w) * f); PBP_[s_] = __builtin_bit_cast(pg8::bf16x8, o_); } } } } while (0)
#define DA_SM_EXP(PBO_) do { \
        _Pragma("unroll") for (int r = 0; r < 16; ++r) { p0[r] = __builtin_amdgcn_exp2f(p0[r]); p1[r] = __builtin_amdgcn_exp2f(p1[r]); } \
        { f32x2 s2 = {0.f, 0.f}; _Pragma("unroll") for (int r = 0; r < 16; r += 2) { s2 += (f32x2){p0[r], p0[r + 1]}; s2 += (f32x2){p1[r], p1[r + 1]}; } lrun += s2[0] + s2[1]; } \
        { u32x4 w; \
          w.x = pk2(p0[0], p0[1]); w.y = pk2(p0[2], p0[3]); w.z = pk2(p0[4], p0[5]); w.w = pk2(p0[6], p0[7]); PBO_[0] = __builtin_bit_cast(pg8::bf16x8, w); \
          w.x = pk2(p0[8], p0[9]); w.y = pk2(p0[10], p0[11]); w.z = pk2(p0[12], p0[13]); w.w = pk2(p0[14], p0[15]); PBO_[1] = __builtin_bit_cast(pg8::bf16x8, w); \
          w.x = pk2(p1[0], p1[1]); w.y = pk2(p1[2], p1[3]); w.z = pk2(p1[4], p1[5]); w.w = pk2(p1[6], p1[7]); PBO_[2] = __builtin_bit_cast(pg8::bf16x8, w); \
          w.x = pk2(p1[8], p1[9]); w.y = pk2(p1[10], p1[11]); w.z = pk2(p1[12], p1[13]); w.w = pk2(p1[14], p1[15]); PBO_[3] = __builtin_bit_cast(pg8::bf16x8, w); } } while (0)
#define DA_VADDR(i_) (((i_) & 3) * 4096 + ((i_) >> 2) * 512)
#define DA_PV_EXP(PBP_, voff_, PBO_) do { const LAS unsigned char* vb_ = C.lds + 49152 + (voff_); f32x2 s2_ = {0.f, 0.f}; unsigned pw_[16]; \
        pg8::bf16x8 vq_[4];   \
        vq_[0] = DA_VTR(vb_, DA_VADDR(0)); vq_[1] = DA_VTR(vb_, DA_VADDR(1)); vq_[2] = DA_VTR(vb_, DA_VADDR(2)); \
        _Pragma("unroll") for (int i_ = 0; i_ < 16; ++i_) { const int db_ = i_ >> 2, s_ = i_ & 3; \
            if (i_ + 3 < 16) vq_[(i_ + 3) & 3] = DA_VTR(vb_, DA_VADDR(i_ + 3)); \
            O[db_] = __builtin_amdgcn_mfma_f32_32x32x16_bf16(vq_[i_ & 3], PBP_[s_], O[db_], 0, 0, 0); \
            float e0_, e1_; if (i_ < 8) { e0_ = __builtin_amdgcn_exp2f(p0[2 * i_]); e1_ = __builtin_amdgcn_exp2f(p0[2 * i_ + 1]); } else { e0_ = __builtin_amdgcn_exp2f(p1[2 * i_ - 16]); e1_ = __builtin_amdgcn_exp2f(p1[2 * i_ - 15]); } \
            s2_ += (f32x2){e0_, e1_}; pw_[i_] = pk2(e0_, e1_); \
            __builtin_amdgcn_sched_barrier(0); } \
        lrun += s2_[0] + s2_[1]; \
        _Pragma("unroll") for (int k_ = 0; k_ < 4; ++k_) { u32x4 w_; w_.x = pw_[4 * k_]; w_.y = pw_[4 * k_ + 1]; w_.z = pw_[4 * k_ + 2]; w_.w = pw_[4 * k_ + 3]; PBO_[k_] = __builtin_bit_cast(pg8::bf16x8, w_); } } while (0)
    f32x16 p0, p1;
    if (comp == 0) __builtin_amdgcn_s_setprio(1);
    DA_DMA(0, 0); DA_DMA(1, 16384);
    DA_STAGE(0); DA_QK(0); DA_SM_MAX(true, pb); DA_SM_EXP(pb);
    for (int tile = 1; tile <= my_last; ++tile) {
        ks = DA_ROT(ks);
        DA_STAGE(tile); DA_QK(tile); DA_SM_MAX(false, pb);
        DA_PV_EXP(pb, ((tile - 1) & 3) * 16384, pb);
    }
    if (my_last < ntile - 1) { ks = DA_ROT(ks); DA_STAGE(ntile - 1); }
    __builtin_amdgcn_s_setprio(0);
    DA_PV(pb, (my_last & 3) * 16384);
#undef DA_GLDS
#undef DA_ROT
#undef DA_DMA
#undef DA_STAGE
#undef DA_QK
#undef DA_PV
#undef DA_MX3
#undef DA_SM_MAX
#undef DA_SM_EXP
#undef DA_PV_EXP
#undef DA_VADDR
#undef DA_VTR
    if (C.tid == 0) nx = (int)__hip_atomic_fetch_add((unsigned*)qnext, 1u, __ATOMIC_RELAXED, __HIP_MEMORY_SCOPE_AGENT);
    const float ltot = lrun + __shfl_xor(lrun, 32); const float inv = 1.0f / ltot;
    f32x4 gnq[4][4];
#pragma unroll
    for (int db = 0; db < 4; ++db)
#pragma unroll
        for (int g4 = 0; g4 < 4; ++g4) gnq[db][g4] = *(const GAS f32x4*)(dnorm + 32 * db + 8 * g4 + 4 * hi);
    __builtin_amdgcn_sched_barrier(0);
    WG_SYNC();
    LF X = (LF)C.lds + (wq * 32 + q) * 132;
    if (comp == 1) {
        const float sc = inv * lam;
#pragma unroll
        for (int db = 0; db < 4; ++db)
#pragma unroll
            for (int g4 = 0; g4 < 4; ++g4) *(LAS f32x4*)(X + 32 * db + 8 * g4 + 4 * hi) = (f32x4){O[db][4 * g4] * sc, O[db][4 * g4 + 1] * sc, O[db][4 * g4 + 2] * sc, O[db][4 * g4 + 3] * sc};
    }
    WG_SYNC();
    if (comp == 0) {
        float ss = 0.f;
#pragma unroll
        for (int db = 0; db < 4; ++db)
#pragma unroll
            for (int g4 = 0; g4 < 4; ++g4) { const f32x4 x = *(const LAS f32x4*)(X + 32 * db + 8 * g4 + 4 * hi);
#pragma unroll
                for (int e = 0; e < 4; ++e) { const float v = O[db][4 * g4 + e] * inv - x[e]; O[db][4 * g4 + e] = v; ss += v * v; } }
        ss += __shfl_xor(ss, 32);
        const float rs = oml / sqrtf(ss * (1.0f / 128.0f) + EPS);
#pragma unroll
        for (int db = 0; db < 4; ++db)
#pragma unroll
            for (int g4 = 0; g4 < 4; ++g4) { const int d = 32 * db + 8 * g4 + 4 * hi; const f32x4 gn = gnq[db][g4];
                u32x2 w; w.x = pk2(O[db][4 * g4] * rs * gn[0], O[db][4 * g4 + 1] * rs * gn[1]); w.y = pk2(O[db][4 * g4 + 2] * rs * gn[2], O[db][4 * g4 + 3] * rs * gn[3]);
                *(GAS u32x2*)(YS + qrow * 2048 + h * 128 + d) = w; }
    }
    WG_SYNC();
}
__device__ const signed char ATT_BINS30[30][3] = {{63,4,3}, {62,5,2}, {61,6,1}, {60,7,0}, {59,8,-1}, {58,9,-1}, {57,10,-1}, {56,11,-1}, {55,12,-1}, {54,13,-1}, {53,14,-1}, {52,15,-1}, {51,16,-1}, {50,17,-1}, {49,18,-1}, {48,19,-1}, {47,20,-1}, {46,21,-1}, {45,22,-1}, {44,23,-1}, {43,24,-1}, {42,25,-1}, {41,26,-1}, {40,27,-1}, {39,28,-1}, {38,29,-1}, {37,30,-1}, {36,31,-1}, {35,32,-1}, {34,33,-1}};
__device__ __forceinline__ int att_bin_unit(int bin, int i) { return i < 3 ? (int)ATT_BINS30[bin][i] : -1; }
__device__ __forceinline__ void ph_da_attn(const Ctx& C, const Args& a, int l, int bh, int bin) {
    const GAS float* q1 = (const GAS float*)a.in[7] + (size_t)l * 64; const GAS float* k1 = (const GAS float*)a.in[8] + (size_t)l * 64; const GAS float* q2 = (const GAS float*)a.in[9] + (size_t)l * 64; const GAS float* k2 = (const GAS float*)a.in[10] + (size_t)l * 64;
    float s1 = 0.f, s2 = 0.f;
    for (int i = 0; i < 64; ++i) { s1 += q1[i] * k1[i]; s2 += q2[i] * k2[i]; }
    int ll = l; asm volatile("" : "+s"(ll));
    const float lam_init = 0.8f - 0.6f * expf(-0.3f * (float)ll); const float lam_v = expf(s1) - expf(s2) + lam_init;
    const float lam = __uint_as_float(__builtin_amdgcn_readfirstlane(__float_as_uint(lam_v))), oml = __uint_as_float(__builtin_amdgcn_readfirstlane(__float_as_uint(1.0f - lam_init)));
    (void)bin;
    gu32* qbase = (gu32*)(C.ws + WS_CTL) + 16384 + ll * 8 * 16;
    volatile LAS int* qslot = (volatile LAS int*)(C.lds + MISC_OFF) + 24;
    int cbh = bh;
    if (C.tid == 0) qslot[0] = (int)__hip_atomic_fetch_add((unsigned*)(qbase + cbh * 16), 1u, __ATOMIC_RELAXED, __HIP_MEMORY_SCOPE_AGENT);
    WG_SYNC();
    int nextu = qslot[0];
    for (;;) {
        if (nextu >= 64) {
            if (C.tid < 64) { const unsigned v = (C.tid < 8) ? __hip_atomic_load((unsigned*)(qbase + C.tid * 16), __ATOMIC_RELAXED, __HIP_MEMORY_SCOPE_AGENT) : 64u;
                const unsigned long long m = __ballot(v < 64u); if (C.tid == 0) qslot[1] = m ? (int)__ffsll((long long)m) - 1 : -1; }
            WG_SYNC();
            const int nb = qslot[1]; if (nb < 0) break;
            cbh = __builtin_amdgcn_readfirstlane(nb);
            if (C.tid == 0) qslot[0] = (int)__hip_atomic_fetch_add((unsigned*)(qbase + cbh * 16), 1u, __ATOMIC_RELAXED, __HIP_MEMORY_SCOPE_AGENT);
        } else {
            int nx_ = 0;
            da_unit(C, a, l, cbh >> 2, cbh & 3, 63 - nextu, lam, oml, qbase + cbh * 16, nx_);
            if (C.tid == 0) qslot[0] = nx_;
        }
        WG_SYNC();
        nextu = __builtin_amdgcn_readfirstlane(qslot[0]);
    }
}

PH_FN void ph_final(const Ctx C, ArgsP a) {
    const GAS float* ssq = (const GAS float*)(C.ws + WS_SSQ); const GAS float* fn = a->in[39]; const GAS bf16* hb = (const GAS bf16*)(C.ws + WS_HB);
    const int gw = C.bid * NWAVES + C.wave, NGW = C.G * NWAVES;
    u32x2 nw[4]; f32x4 nq;
#define FIN_LD(m_) do { const GAS u32x2* hr_ = (const GAS u32x2*)(hb + (size_t)(m_) * D) + C.lane; _Pragma("unroll") for (int j = 0; j < 4; ++j) nw[j] = hr_[64 * j]; nq = *(const GAS f32x4*)(ssq + (size_t)(m_) * 4); } while (0)
    const GAS f32x4* gr = (const GAS f32x4*)fn + C.lane; f32x4 g4[4];
#pragma unroll
    for (int j = 0; j < 4; ++j) g4[j] = gr[64 * j];
    if (gw < M) FIN_LD(gw);
#pragma unroll 1
    for (int m = gw; m < M; m += NGW) {
        u32x2 w[4]; const f32x4 pq = nq;
#pragma unroll
        for (int j = 0; j < 4; ++j) w[j] = nw[j];
        if (m + NGW < M) FIN_LD(m + NGW);
        const float rs = __builtin_amdgcn_rsqf(((pq[0] + pq[1]) + (pq[2] + pq[3])) * (1.0f / 1024.0f) + 1e-6f);
        GAS f32x4* orow = (GAS f32x4*)(C.h + (size_t)m * D) + C.lane;
#pragma unroll
        for (int j = 0; j < 4; ++j) orow[64 * j] = (f32x4){bflo(w[j].x) * rs * g4[j][0], bfhi(w[j].x) * rs * g4[j][1], bflo(w[j].y) * rs * g4[j][2], bfhi(w[j].y) * rs * g4[j][3]};
    }
#undef FIN_LD
}
#define RWC_PTRS \
    GAS float* RWW = (GAS float*)(C.ws + WS_RWW); const GAS bf16* RWR = (const GAS bf16*)(C.ws + WS_RWR); const GAS bf16* RWK = (const GAS bf16*)(C.ws + WS_RWK); const GAS bf16* RWV = (const GAS bf16*)(C.ws + WS_RWV); \
    GAS bf16* RWKK = (GAS bf16*)(C.ws + WS_RWKK); GAS bf16* RWB = (GAS bf16*)(C.ws + WS_RWB); GAS bf16* RWY = (GAS bf16*)(C.ws + WS_RWY); \
    LF LGs = (LF)C.lds; LB LP = (LB)C.lds; LB LPT = (LB)(C.lds + 9216); LB AT = (LB)(C.lds + 18432); LB LAK = AT; LB LP2 = AT; LB RT = (LB)(C.lds + 27648); LB BTl = (LB)(C.lds + 36864); LB MRB = BTl; LB KTl = (LB)(C.lds + 46080); LB MRK = KTl; \
    LB VT = (LB)(C.lds + 55296); LB BHT = (LB)(C.lds + 64512); LB KHT = (LB)(C.lds + 73728); LB XB0 = (LB)(C.lds + 82944); LB XB1 = (LB)(C.lds + 101376); LB LPT2 = (LB)(C.lds + 119808); LF rho = (LF)(C.lds + 129024); LF lgl = rho + 64; \
    const int t = C.tid >> 3, g8 = C.tid & 7, n = C.lane & 31, hi = C.lane >> 5; \
    (void)RWW; (void)RWR; (void)RWK; (void)RWV; (void)RWKK; (void)RWB; (void)RWY; (void)LGs; (void)LP; (void)LPT; (void)AT; (void)LAK; (void)LP2; (void)RT; (void)BTl; (void)MRB; (void)KTl; (void)MRK; (void)VT; (void)BHT; (void)KHT; (void)XB0; (void)XB1; (void)LPT2; (void)rho; (void)lgl; (void)t; (void)g8; (void)n; (void)hi;
struct S0In { f32x4 x0, x1; u32x4 rv, kv, kkv, bv, vv; };
__device__ __forceinline__ S0In rwc_s0_load(const Ctx& C, int bc, int h) {
    RWC_PTRS
    const size_t g = ((size_t)bc * 64 + t) * 512 + h * 64 + g8 * 8; S0In in;
    in.rv = *(const GAS u32x4*)(RWR + g); in.kv = *(const GAS u32x4*)(RWK + g); in.kkv = *(const GAS u32x4*)(RWKK + g); in.bv = *(const GAS u32x4*)(RWB + g); in.vv = *(const GAS u32x4*)(RWV + g);
    in.x0 = *(const GAS f32x4*)(RWW + g); in.x1 = *(const GAS f32x4*)(RWW + g + 4); return in;
}
__device__ __forceinline__ void rwc_stage0_body(const Ctx& C, int bc, int h, const S0In& in) {
    RWC_PTRS
    LF TOT = (LF)C.lds;
    float lw[8] = {in.x0[0], in.x0[1], in.x0[2], in.x0[3], in.x1[0], in.x1[1], in.x1[2], in.x1[3]}, lg[8], rh[8], ll[8];
#pragma unroll
    for (int i = 0; i < 8; ++i) lg[i] = lw[i];
#pragma unroll
    for (int st = 1; st < 8; ++st) {
#pragma unroll
        for (int i = 0; i < 8; ++i) { const float nb_ = __shfl_up(lg[i], 8); if ((t & 7) == st) lg[i] += nb_; } }
    if ((t & 7) == 7) { *(LAS f32x4*)(TOT + C.wave * 64 + g8 * 8) = (f32x4){lg[0], lg[1], lg[2], lg[3]}; *(LAS f32x4*)(TOT + C.wave * 64 + g8 * 8 + 4) = (f32x4){lg[4], lg[5], lg[6], lg[7]}; }
    probe_sub(C, 24);
    RW_BAR();
    probe_sub(C, 25);
    {   float off[8], run[8];
#pragma unroll
        for (int i = 0; i < 8; ++i) { off[i] = 0.f; run[i] = 0.f; }
#pragma unroll
        for (int w = 0; w < 8; ++w) { const f32x4 a0 = *(const LAS f32x4*)(TOT + w * 64 + g8 * 8), a1 = *(const LAS f32x4*)(TOT + w * 64 + g8 * 8 + 4);
#pragma unroll
            for (int i = 0; i < 8; ++i) { const float v = i < 4 ? a0[i & 3] : a1[i & 3]; off[i] += (w < C.wave) ? v : 0.f; run[i] += v; if (w == 3) rh[i] = run[i]; } }
#pragma unroll
        for (int i = 0; i < 8; ++i) { lg[i] += off[i]; ll[i] = run[i]; } }
    {   float rf[8], kf[8], kkf[8], bf[8], o1[8], o2[8], o3[8], o4[8];
        unpack8(in.rv, rf); unpack8(in.kv, kf); unpack8(in.kkv, kkf); unpack8(in.bv, bf);
#pragma unroll
        for (int i = 0; i < 8; ++i) { const int k = g8 * 8 + i; const float lm1 = lg[i] - lw[i];
            const float ed = __expf(lg[i] - rh[i]), edi = __expf(rh[i] - lg[i]), el = __expf(ll[i] - lg[i]);
            o1[i] = -kkf[i] * __expf(lm1 - rh[i]); o2[i] = rf[i] * ed; o3[i] = bf[i] * edi; o4[i] = kf[i] * edi;
            XB0[k * 72 + t] = (bf16)f2bf(-kkf[i] * __expf(lm1));
            BHT[k * 72 + t] = (bf16)f2bf(bf[i] * el); KHT[k * 72 + t] = (bf16)f2bf(kf[i] * el); }
        *(LAS u32x4*)(AT + t * 72 + g8 * 8) = pack8(o1); *(LAS u32x4*)(RT + t * 72 + g8 * 8) = pack8(o2); *(LAS u32x4*)(BTl + t * 72 + g8 * 8) = pack8(o3); *(LAS u32x4*)(KTl + t * 72 + g8 * 8) = pack8(o4);
        const unsigned vw[4] = {in.vv.x, in.vv.y, in.vv.z, in.vv.w};
#pragma unroll
        for (int i = 0; i < 4; ++i) { VT[(g8 * 8 + 2 * i) * 72 + t] = (bf16)(vw[i] & 0xffffu); VT[(g8 * 8 + 2 * i + 1) * 72 + t] = (bf16)(vw[i] >> 16); }
        if (t == 0) {
#pragma unroll
            for (int i = 0; i < 8; ++i) { rho[g8 * 8 + i] = rh[i]; lgl[g8 * 8 + i] = ll[i]; } }
    }
    probe_sub(C, 26);
    RW_BAR();
}
PH_FN void rwc_stage0(const Ctx C, int bc, int h) { const S0In in = rwc_s0_load(C, bc, h); rwc_stage0_body(C, bc, h, in); }
PH_FN void rwc_stage12(const Ctx C) {
    RWC_PTRS
    {   const int mt = C.wave >> 1, nt0 = 2 * (C.wave & 1);
        CLB Am = (mt < 2) ? (CLB)AT : (CLB)RT; const int m0 = 32 * (mt & 1);
        CLB Bm = (nt0 < 2) ? (CLB)BTl : (CLB)KTl;
        f32x16 c0 = zero16(), c1 = zero16();
        mma_nt<64>(c0, Am, 72, m0, Bm, 72, 0, C.lane); mma_nt<64>(c1, Am, 72, m0, Bm, 72, 32, C.lane);
        RW_BAR();
#pragma unroll
        for (int r = 0; r < 16; ++r) { const int tt = m0 + crow(r, hi); const int j0 = n, j1 = 32 + n;
            if (mt < 2) { const bf16 x0 = (bf16)f2bf((j0 < tt) ? c0[r] : 0.f), x1 = (bf16)f2bf((j1 < tt) ? c1[r] : 0.f);
                if (nt0 < 2) { LP[tt * 72 + j0] = x0; LP[tt * 72 + j1] = x1; LPT[j0 * 72 + tt] = x0; LPT[j1 * 72 + tt] = x1; } else { LAK[tt * 72 + j0] = x0; LAK[tt * 72 + j1] = x1; } }
            else { const bf16 x0 = (bf16)f2bf((j0 <= tt) ? c0[r] : 0.f), x1 = (bf16)f2bf((j1 <= tt) ? c1[r] : 0.f);
                if (nt0 < 2) { MRB[tt * 72 + j0] = x0; MRB[tt * 72 + j1] = x1; } else { MRK[tt * 72 + j0] = x0; MRK[tt * 72 + j1] = x1; } } }
    }
    RW_BAR();
    if (C.wave < 4) { const int vt = C.wave >> 1, tt0 = C.wave & 1; f32x16 c = zero16(); mma_nt<64>(c, VT, 72, 32 * vt, LAK, 72, 32 * tt0, C.lane);
#pragma unroll
        for (int r = 0; r < 16; ++r) XB0[(64 + 32 * vt + crow(r, hi)) * 72 + 32 * tt0 + n] = (bf16)f2bf(c[r]); }
    RW_BAR();
}
#ifndef RWC_NSTEP
#define RWC_NSTEP 6
#endif
#ifndef RWC_REP0
#define RWC_REP0 1
#endif
PH_FN void rwc_solve(const Ctx C) {
    RWC_PTRS
    const int ct = C.wave >> 1, tt = C.wave & 1;
    const int sk = C.wave >> 2, st = (C.wave >> 1) & 1, sj = C.wave & 1;
#pragma unroll 1
    for (int i = 0; i < RWC_NSTEP; ++i) {
        CLB Pc = (i & 1) ? (CLB)LP2 : (CLB)LP; CLB PTc = (i & 1) ? (CLB)LPT2 : (CLB)LPT; LB Pn = (i & 1) ? LP : LP2; LB PTn = (i & 1) ? LPT : LPT2;
        CLB Xc = (i & 1) ? (CLB)XB1 : (CLB)XB0; LB Xn = (i & 1) ? XB0 : XB1;
        { f32x16 acc;
#pragma unroll
          for (int r = 0; r < 16; ++r) acc[r] = bf2f(Xc[(32 * ct + crow(r, hi)) * 72 + 32 * tt + n]);
          mma_nt<64>(acc, Xc, 72, 32 * ct, Pc, 72, 32 * tt, C.lane);
#pragma unroll
          for (int r = 0; r < 16; ++r) Xn[(32 * ct + crow(r, hi)) * 72 + 32 * tt + n] = (bf16)f2bf(acc[r]); }
        if (i < RWC_NSTEP - 1) { f32x16 acc = zero16();
          if (sk == 0) mma_nt<64>(acc, Pc, 72, 32 * st, PTc, 72, 32 * sj, C.lane); else mma_nt<64>(acc, PTc, 72, 32 * st, Pc, 72, 32 * sj, C.lane);
          LB dst = (sk == 0) ? Pn : PTn;
#pragma unroll
          for (int r = 0; r < 16; ++r) dst[(32 * st + crow(r, hi)) * 72 + 32 * sj + n] = (bf16)f2bf(acc[r]); }
        RW_BAR();
    }
}
__device__ __forceinline__ void rwc_stage4_body(const Ctx& C, int bc, int h, const S0In* touch) {
    RWC_PTRS
    const size_t row0 = (size_t)bc * 64; CLB A2T = (CLB)XB0; CLB WT = (CLB)(XB0 + 64 * 72);
    {   const int kind = C.wave >> 1, mt = C.wave & 1;
        f32x16 c0 = zero16(), c1 = zero16();
        if (kind == 0) { mma_nt<64>(c0, BHT, 72, 32 * mt, A2T, 72, 0, C.lane); mma_nt<64>(c1, BHT, 72, 32 * mt, A2T, 72, 32, C.lane); }
        else if (kind == 1) { mma_nt<64>(c0, BHT, 72, 32 * mt, WT, 72, 0, C.lane); mma_nt<64>(c1, BHT, 72, 32 * mt, WT, 72, 32, C.lane); mma_nt<64>(c0, KHT, 72, 32 * mt, VT, 72, 0, C.lane); mma_nt<64>(c1, KHT, 72, 32 * mt, VT, 72, 32, C.lane); }
        else if (kind == 2) { mma_nt<64>(c0, MRB, 72, 32 * mt, A2T, 72, 0, C.lane); mma_nt<64>(c1, MRB, 72, 32 * mt, A2T, 72, 32, C.lane); }
        else { mma_nt<64>(c0, MRB, 72, 32 * mt, WT, 72, 0, C.lane); mma_nt<64>(c1, MRB, 72, 32 * mt, WT, 72, 32, C.lane); mma_nt<64>(c0, MRK, 72, 32 * mt, VT, 72, 0, C.lane); mma_nt<64>(c1, MRK, 72, 32 * mt, VT, 72, 32, C.lane); }
        if (touch) asm volatile("" :: "v"(touch->x0), "v"(touch->x1), "v"(touch->rv), "v"(touch->kv), "v"(touch->kkv), "v"(touch->bv), "v"(touch->vv));
#pragma unroll
        for (int r = 0; r < 16; ++r) { const int m = 32 * mt + crow(r, hi); const size_t go = (row0 + m) * 512 + h * 64;
            if (kind == 0) { const float d = __expf(lgl[m]); RWB[go + n] = (bf16)f2bf(c0[r] + ((n == m) ? d : 0.f)); RWB[go + 32 + n] = (bf16)f2bf(c1[r] + ((32 + n == m) ? d : 0.f)); }
            else if (kind == 1) { RWW[go + n] = c0[r]; RWW[go + 32 + n] = c1[r]; }
            else if (kind == 2) { RWKK[go + n] = (bf16)f2bf(c0[r] + bf2f(RT[m * 72 + n]) * __expf(rho[n])); RWKK[go + 32 + n] = (bf16)f2bf(c1[r] + bf2f(RT[m * 72 + 32 + n]) * __expf(rho[32 + n])); }
            else { RWY[go + n] = (bf16)f2bf(c0[r]); RWY[go + 32 + n] = (bf16)f2bf(c1[r]); } }
    }
}
PH_FN void rwc_stage4(const Ctx C, int bc, int h) { rwc_stage4_body(C, bc, h, nullptr); }
PH_FN void rwc_stage40(const Ctx C, int bc, int h) {
    const S0In in = rwc_s0_load(C, bc, h + 1); __builtin_amdgcn_sched_barrier(0);
    rwc_stage4_body(C, bc, h, &in);
    probe_sub(C, 23);
    rwc_stage0_body(C, bc, h + 1, in);
}
__device__ __forceinline__ void ph_rw_chunk(const Ctx& C, int bc) {
    rwc_stage0(C, bc, 0);
#pragma unroll 1
    for (int h = 0; h < 8; ++h) { probe_sub(C, 31); rwc_stage12(C); probe_sub(C, 20); rwc_solve(C); probe_sub(C, 21); if (h < 7) rwc_stage40(C, bc, h); else rwc_stage4(C, bc, h); probe_sub(C, 22); }
    WG_SYNC();
}
PH_FN void rw_scan_producer(const Ctx C, int chain) {
    const float* RWW = (const float*)(unsigned char*)(C.ws + WS_RWW); const bf16* RWKK = (const bf16*)(unsigned char*)(C.ws + WS_RWKK); const bf16* RWB = (const bf16*)(unsigned char*)(C.ws + WS_RWB); bf16* RWY = (bf16*)(unsigned char*)(C.ws + WS_RWY);
    const int b = chain >> 3, h = chain & 7; const size_t rowb = (size_t)b * SEQ;
    constexpr int BUFB = 45056, O_RQ = 0, O_PT = 9216, O_QT = 18432, O_Y0 = 35840;
    LAS unsigned char* L = C.lds;
        const int p = C.tid - 256, t = p >> 2, q4 = (p & 3) * 16;
        u32x4 Arq0, Arq1, Apt0, Apt1, Ay00, Ay01, Brq0, Brq1, Bpt0, Bpt1, By00, By01; f32x4 Aq0, Aq1, Aq2, Aq3, Bq0, Bq1, Bq2, Bq3;
#define SC_LOAD(S, c_) do { const size_t g_ = (rowb + (size_t)(c_) * 64 + t) * 512 + h * 64 + q4; \
            S##rq0 = *(const u32x4*)(RWKK + g_); S##rq1 = *(const u32x4*)(RWKK + g_ + 8); S##pt0 = *(const u32x4*)(RWB + g_); S##pt1 = *(const u32x4*)(RWB + g_ + 8); S##y00 = *(const u32x4*)(RWY + g_); S##y01 = *(const u32x4*)(RWY + g_ + 8); \
            S##q0 = *(const f32x4*)(RWW + g_); S##q1 = *(const f32x4*)(RWW + g_ + 4); S##q2 = *(const f32x4*)(RWW + g_ + 8); S##q3 = *(const f32x4*)(RWW + g_ + 12); } while (0)
#define SC_WRITE(S, Lb) do { \
            *(LAS u32x4*)((LB)((Lb) + O_RQ) + t * 72 + q4) = S##rq0; *(LAS u32x4*)((LB)((Lb) + O_RQ) + t * 72 + q4 + 8) = S##rq1; \
            *(LAS u32x4*)((LB)((Lb) + O_PT) + t * 72 + q4) = S##pt0; *(LAS u32x4*)((LB)((Lb) + O_PT) + t * 72 + q4 + 8) = S##pt1; \
            *(LAS u32x4*)((LB)((Lb) + O_Y0) + t * 72 + q4) = S##y00; *(LAS u32x4*)((LB)((Lb) + O_Y0) + t * 72 + q4 + 8) = S##y01; \
            { LF d_ = (LF)((Lb) + O_QT) + t * 68 + q4; *(LAS f32x4*)d_ = S##q0; *(LAS f32x4*)(d_ + 4) = S##q1; *(LAS f32x4*)(d_ + 8) = S##q2; *(LAS f32x4*)(d_ + 12) = S##q3; } } while (0)
        SC_LOAD(A, 0); SC_LOAD(B, 1);
        for (int c = 0; c < NCH; c += 2) {
            SC_WRITE(A, L); if (c + 2 < NCH) SC_LOAD(A, c + 2); RW_BAR();
            SC_WRITE(B, L + BUFB); if (c + 3 < NCH) SC_LOAD(B, c + 3); RW_BAR();
        }
        RW_BAR();
#undef SC_LOAD
#undef SC_WRITE
}
PH_FN void rw_scan_consumer(const Ctx C, int chain) {
    const float* RWW = (const float*)(unsigned char*)(C.ws + WS_RWW); const bf16* RWKK = (const bf16*)(unsigned char*)(C.ws + WS_RWKK); const bf16* RWB = (const bf16*)(unsigned char*)(C.ws + WS_RWB); bf16* RWY = (bf16*)(unsigned char*)(C.ws + WS_RWY);
    const int b = chain >> 3, h = chain & 7; const size_t rowb = (size_t)b * SEQ;
    constexpr int BUFB = 45056, O_RQ = 0, O_PT = 9216, O_QT = 18432, O_Y0 = 35840;
    LAS unsigned char* L = C.lds;
        const int n = C.lane & 31, hi = C.lane >> 5, vh = C.wave & 1;
        f32x16 st0 = zero16(), st1 = zero16();
        for (int c = 0; c < NCH; ++c) {
            RW_BAR();
            if (C.wave < 2) {
                const LAS unsigned char* Lb = L + (c & 1) * BUFB;
                CLB RQ = (CLB)(Lb + O_RQ); CLB PT = (CLB)(Lb + O_PT); CLF QT = (CLF)(Lb + O_QT); CLB Y0 = (CLB)(Lb + O_Y0);
                pg8::bf16x8 sb[4];
                { u32x4 w;
                  w.x = pk2(st0[0], st0[1]); w.y = pk2(st0[2], st0[3]); w.z = pk2(st0[4], st0[5]); w.w = pk2(st0[6], st0[7]); sb[0] = __builtin_bit_cast(pg8::bf16x8, w);
                  w.x = pk2(st0[8], st0[9]); w.y = pk2(st0[10], st0[11]); w.z = pk2(st0[12], st0[13]); w.w = pk2(st0[14], st0[15]); sb[1] = __builtin_bit_cast(pg8::bf16x8, w);
                  w.x = pk2(st1[0], st1[1]); w.y = pk2(st1[2], st1[3]); w.z = pk2(st1[4], st1[5]); w.w = pk2(st1[6], st1[7]); sb[2] = __builtin_bit_cast(pg8::bf16x8, w);
                  w.x = pk2(st1[8], st1[9]); w.y = pk2(st1[10], st1[11]); w.z = pk2(st1[12], st1[13]); w.w = pk2(st1[14], st1[15]); sb[3] = __builtin_bit_cast(pg8::bf16x8, w); }
#define SC_AFRAG(X_, row_, s_) ({ const u32x2 lo_ = *(const LAS u32x2*)((X_) + (row_) * 72 + 16 * (s_) + 4 * hi), hi_ = *(const LAS u32x2*)((X_) + (row_) * 72 + 16 * (s_) + 8 + 4 * hi); \
                    u32x4 w_; w_.x = lo_.x; w_.y = lo_.y; w_.z = hi_.x; w_.w = hi_.y; __builtin_bit_cast(pg8::bf16x8, w_); })
#pragma unroll
                for (int tt = 0; tt < 2; ++tt) { f32x16 y;
#pragma unroll
                    for (int r = 0; r < 16; ++r) y[r] = bf2f(Y0[(32 * tt + crow(r, hi)) * 72 + 32 * vh + n]);
#pragma unroll
                    for (int s = 0; s < 4; ++s) y = __builtin_amdgcn_mfma_f32_32x32x16_bf16(SC_AFRAG(RQ, 32 * tt + n, s), sb[s], y, 0, 0, 0);
                    bf16* yo = RWY + (rowb + (size_t)c * 64 + 32 * tt) * 512 + h * 64 + 32 * vh + n;
#pragma unroll
                    for (int r = 0; r < 16; ++r) yo[(size_t)crow(r, hi) * 512] = (bf16)f2bf(y[r]); }
                f32x16 n0, n1;
#pragma unroll
                for (int r = 0; r < 16; ++r) { n0[r] = QT[crow(r, hi) * 68 + 32 * vh + n]; n1[r] = QT[(32 + crow(r, hi)) * 68 + 32 * vh + n]; }
#pragma unroll
                for (int s = 0; s < 4; ++s) { n0 = __builtin_amdgcn_mfma_f32_32x32x16_bf16(SC_AFRAG(PT, n, s), sb[s], n0, 0, 0, 0); n1 = __builtin_amdgcn_mfma_f32_32x32x16_bf16(SC_AFRAG(PT, 32 + n, s), sb[s], n1, 0, 0, 0); }
                st0 = n0; st1 = n1;
#undef SC_AFRAG
            }
        }
        RW_BAR();
}
__device__ __forceinline__ void rw_scan_unit(const Ctx& C, int chain) { if (C.wave >= 4) rw_scan_producer(C, chain); else rw_scan_consumer(C, chain); }
#ifndef REP_ATTN
#define REP_ATTN 1
#endif
#ifndef REP_W
#define REP_W 1
#endif
#ifndef REP_RWC
#define REP_RWC 1
#endif
#ifndef REP_MA
#define REP_MA 1
#endif
#ifndef REP_GLAA
#define REP_GLAA 1
#endif
#ifndef REP_SSDA
#define REP_SSDA 1
#endif
#ifndef REP_RWP
#define REP_RWP 1
#endif
#ifndef REP_GLAC
#define REP_GLAC 1
#endif
#ifndef REP_SSDC
#define REP_SSDC 1
#endif
#ifndef REP_RWO
#define REP_RWO 1
#endif
#ifndef REP_MAFULL
#define REP_MAFULL 1
#endif
#ifndef REP_SCANS
#define REP_SCANS 1
#endif
#ifndef REP_MC
#define REP_MC 1
#endif
#ifndef REP_GEMM
#define REP_GEMM 1
#endif
constexpr int NPH = 12, G_FINAL = 1 + NL * NPH, G_END = G_FINAL + 1;
template <int GRP>
__global__ void __launch_bounds__(NTHR, 2) hybrid_fwd(Args args) {
    constexpr bool ALL = (GRP < 0);
    constexpr bool EN_G1 = ALL || GRP == 0, EN_G2 = EN_G1, EN_G3 = EN_G1, EN_G7 = EN_G1, EN_G8 = EN_G1, EN_G9 = EN_G1;
    constexpr bool EN_PRO = ALL || GRP == 1, EN_W = EN_PRO, EN_FIN = EN_PRO, EN_MA1 = EN_PRO, EN_MA2 = EN_PRO, EN_MA3 = EN_PRO, EN_MA4 = EN_PRO;
    constexpr bool EN_MB1 = ALL || GRP == 2, EN_MB2 = EN_MB1;
    constexpr bool EN_MC1 = ALL || GRP == 3, EN_MC2 = EN_MC1, EN_MC3 = EN_MC1;
    extern __shared__ __attribute__((aligned(16))) unsigned char lds[];
    Ctx C; C.lds = (LAS unsigned char*)lds; C.ws = (GAS unsigned char*)args.ws; C.h = (GAS float*)args.out; C.tid = threadIdx.x; C.lane = C.tid & 63; C.wave = __builtin_amdgcn_readfirstlane(C.tid >> 6); C.bid = blockIdx.x; C.G = gridDim.x;
    LAS unsigned char* ldsl = (LAS unsigned char*)lds;
    const ArgsP ap = (ArgsP)__builtin_amdgcn_kernarg_segment_ptr();
    for (int u = C.tid; u < (LDS_BYTES - LDSCTL_OFF) / 4; u += NTHR) ((LAS unsigned*)(ldsl + LDSCTL_OFF))[u] = 0u;
    __syncthreads();
    volatile LAS unsigned* MISC = (volatile LAS unsigned*)(ldsl + MISC_OFF);
    gu32* ctl = (gu32*)(args.ws + WS_CTL);
    const int g_lo = args.g_lo, g_hi = args.g_hi;
    XcdBarrier bar; bar.bar = (unsigned*)(ctl + CW_BAR); bar.x = 0; bar.st = nullptr;
    if (g_hi - g_lo > 1) bar = xcd_barrier_post((unsigned*)(ctl + CW_BAR), MISC + 8);
#define IN(g) (g_lo <= (g) && (g) < g_hi)
    volatile LAS unsigned* PRB = (volatile LAS unsigned*)(ldsl + MISC_OFF) + 16;
    if (PROBE_MASK && C.tid == 0 && C.bid == PROBE_BID) PRB[0] = (unsigned)wall_clock64();
#define PROBE(g) do { if (PROBE_MASK && C.tid == 0 && C.bid == PROBE_BID) { const unsigned now_ = (unsigned)wall_clock64(); const int k_ = ((g) == 0) ? 12 : (((g) - 1) % 12); if ((PROBE_MASK >> k_) & 1) PRB[1] += now_ - PRB[0]; PRB[0] = now_; } } while (0)
#define PROBE_SUB(bit_) do { if (PROBE_MASK && C.tid == 0 && C.bid == PROBE_BID) { const unsigned now_ = (unsigned)wall_clock64(); if ((PROBE_MASK >> (bit_)) & 1) PRB[1] += now_ - PRB[0]; PRB[0] = now_; } } while (0)
#define SEAM(g) do { if (IN(g) && IN((g) + 1)) xcd_barrier(bar); PROBE(g); } while (0)
    bf16* HB = (bf16*)(args.ws + WS_HB); float* SSQ = (float*)(args.ws + WS_SSQ);

    if (IN(0)) { if (EN_PRO) ph_prologue(fresh(C), ap); if (EN_W) ph_weights(fresh(C), ap, 0, 5, C.bid * NWAVES + C.wave, C.G * NWAVES); }
    SEAM(0);
#define W_TAIL(layer, mask) do { if (EN_W && C.bid >= 128 && (layer) < NL) ph_weights(fresh(C), ap, (layer), (mask), (C.bid - 128) * NWAVES + C.wave, 128 * NWAVES); } while (0)
#pragma unroll 1
    for (int l = 0; l < NL; ++l) {
        const int gb = 1 + NPH * l;
#pragma unroll 1
        for (int f = 0; f < 2; ++f) {
            const int gu = gb + (f ? 10 : 1);
            if (EN_G1 && IN(gu)) {
                pg8::Gemm g{HB, (const bf16*)(args.ws + (f ? WS_WGU2 : WS_WGU1)), M, 2 * FF, D, D}; pg8::StaticOrder S; S.init(M, 2 * FF, C.G, C.bid);
                pg8::EpiSwiglu E{(bf16*)(args.ws + WS_ACT), FF, SSQ, M};
                pg8::gemm_phase<pg8::EpiSwiglu, pg8::StaticOrder, true, true>(ldsl, g, S, E);
                if (f == 0) W_TAIL(l, 10); else W_TAIL(l + 1, 4);
            }
            SEAM(gu);
            if (EN_G2 && IN(gu + 1)) {
                pg8::Gemm g{(const bf16*)(args.ws + WS_ACT), (const bf16*)(args.ws + (f ? WS_WD2 : WS_WD1)), M, D, FF, FF}; pg8::StaticOrder S; S.init(M, D, C.G, C.bid);
                pg8::EpiResid E{HB, SSQ, M, 0.5f};
                pg8::gemm_phase<pg8::EpiResid, pg8::StaticOrder, false, true>(ldsl, g, S, E);
            }
            SEAM(gu + 1);
            if (f == 0) {
                if (EN_G3 && IN(gb + 3)) {
                    pg8::Gemm g{HB, (const bf16*)(args.ws + WS_WIN), M, NPM, D, D}; pg8::StaticOrder S; S.init(M, NPM, C.G, C.bid);
                    pg8::EpiMixRope E{(bf16*)(args.ws + WS_P), NPM, SSQ, M, (const float*)(args.ws + WS_COS), (const float*)(args.ws + WS_SIN)};
                    pg8::gemm_phase<pg8::EpiMixRope, pg8::StaticOrder, true, true>(ldsl, g, S, E);
                    W_TAIL(l + 1, 1);
                }
                SEAM(gb + 3);
                if (IN(gb + 4)) { for (int rf = 0; rf < REP_MAFULL; ++rf) { for (int rep = 0; rep < REP_MA; ++rep) { for (int r2 = 0; r2 < REP_GLAA; ++r2) if (EN_MA2) ph_gla_a(fresh(C), ap, l); PROBE_SUB(13); for (int r2 = 0; r2 < REP_SSDA; ++r2) if (EN_MA3) ph_ssd_a(fresh(C), ap, l); PROBE_SUB(14); for (int r2 = 0; r2 < REP_RWP; ++r2) if (EN_MA4) ph_rw_prep(fresh(C), ap, l); PROBE_SUB(15); } if (EN_MA4) ph_rw_chunk(fresh(C), C.bid); PROBE_SUB(16); } }
                SEAM(gb + 4);
                if (IN(gb + 5)) {
#define MB_SCANS() do { if (EN_MB2) { if (C.bid < 16) rw_scan_unit(fresh(C), C.bid); else { for (int p = C.bid - 16; p < 192; p += C.G - 16) { if (p < 64) gla_scan_part(fresh(C), p); else ssd_scan_part(fresh(C), p - 64); } } } } while (0)
                    MB_SCANS(); PROBE_SUB(27);
                    for (int rs = 1; rs < REP_SCANS; ++rs) {
                        xcd_barrier(bar); if (EN_MA2) ph_gla_a(fresh(C), ap, l); if (EN_MA3) ph_ssd_a(fresh(C), ap, l); if (EN_MA4) { ph_rw_prep(fresh(C), ap, l); ph_rw_chunk(fresh(C), C.bid); } xcd_barrier(bar); MB_SCANS(); }
                    if (C.bid >= 16) { const int a = C.bid - 16; for (int rep = 0; rep < REP_ATTN; ++rep) if (EN_MB1) ph_da_attn(fresh(C), args, l, a & 7, ((a >> 3) + 6) % 30);     }
                    PROBE_SUB(28);
                }
                SEAM(gb + 5);
                if (IN(gb + 6)) { for (int rep = 0; rep < REP_MC; ++rep) { for (int r2 = 0; r2 < REP_GLAC; ++r2) if (EN_MC1) ph_gla_c(fresh(C), ap, l); PROBE_SUB(17); for (int r2 = 0; r2 < REP_SSDC; ++r2) if (EN_MC2) ph_ssd_c(fresh(C), ap, l); PROBE_SUB(18); for (int r2 = 0; r2 < REP_RWO; ++r2) if (EN_MC3) ph_rw_out(fresh(C), ap, l); PROBE_SUB(19); } }
                SEAM(gb + 6);
                if (EN_G7 && IN(gb + 7)) {
                    pg8::Gemm g{HB, (const bf16*)(args.ws + WS_WIN) + (size_t)NPM * D, M, 4096, D, D}; pg8::StaticOrder S; S.init(M, 4096, C.G, C.bid);
                    pg8::EpiGateRatio E{(bf16*)(args.ws + WS_PG), args.in[33] + (size_t)l * 4096, SSQ, M};
                    pg8::gemm_phase<pg8::EpiGateRatio, pg8::StaticOrder, true, true>(ldsl, g, S, E);
                }
                SEAM(gb + 7);
                if (EN_G8 && IN(gb + 8)) {
                    pg8::Gemm g{(const bf16*)(args.ws + WS_YS), (const bf16*)(args.ws + WS_WB), M, D, 2048, 2048}; pg8::StaticOrder S; S.init(M, D, C.G, C.bid);
                    pg8::EpiGateHorner E{(bf16*)(args.ws + WS_MERGED), (const bf16*)(args.ws + WS_PG)};
                    pg8::gemm_phase<pg8::EpiGateHorner, pg8::StaticOrder, true, true>(ldsl, g, S, E);
                }
                SEAM(gb + 8);
                if (EN_G9 && IN(gb + 9)) {
                    pg8::Gemm g{(const bf16*)(args.ws + WS_MERGED), (const bf16*)(args.ws + WS_WO), M, D, D, D}; pg8::StaticOrder S; S.init(M, D, C.G, C.bid);
                    pg8::EpiResid E{HB, SSQ, M, 1.0f};
                    pg8::gemm_phase<pg8::EpiResid, pg8::StaticOrder, false, true>(ldsl, g, S, E);
                }
                SEAM(gb + 9);
            }
        }
    }
    if (EN_FIN && IN(G_FINAL)) ph_final(fresh(C), ap);
    if (PROBE_MASK && C.tid == 0 && C.bid == PROBE_BID) { const unsigned tgt_ = PRB[1], t0_ = (unsigned)wall_clock64(); while ((unsigned)wall_clock64() - t0_ < tgt_) __builtin_amdgcn_s_sleep(20); }
#undef IN
#undef SEAM
}

#ifndef ONE_LAUNCH
#define ONE_LAUNCH 1
#endif
extern "C" void kernel_launch(void* const* d_in, const int* in_sizes, int n_in, void* d_out, int out_size, void* d_ws, size_t ws_size, hipStream_t stream) {
    static int grid = 0;
    if (grid == 0) {
        if (n_in != 40 || in_sizes[0] != M * D || out_size != M * D || ws_size < WS_END) { fprintf(stderr, "kernel_launch: unexpected shapes (n_in %d, in0 %d, out %d, ws %zu < %zu); nothing launched\n", n_in, n_in > 0 ? in_sizes[0] : -1, out_size, ws_size, (size_t)WS_END); grid = -1; return; }
        int dev = 0, cus = 0, per_cu = 0;
        if (hipGetDevice(&dev) != hipSuccess || hipDeviceGetAttribute(&cus, hipDeviceAttributeMultiprocessorCount, dev) != hipSuccess) { grid = -1; return; }
#if ONE_LAUNCH
        if (hipFuncSetAttribute((const void*)hybrid_fwd<-1>, hipFuncAttributeMaxDynamicSharedMemorySize, LDS_BYTES) != hipSuccess) { fprintf(stderr, "kernel_launch: hipFuncSetAttribute failed\n"); grid = -1; return; }
#else
        if (hipFuncSetAttribute((const void*)hybrid_fwd<0>, hipFuncAttributeMaxDynamicSharedMemorySize, LDS_BYTES) != hipSuccess || hipFuncSetAttribute((const void*)hybrid_fwd<1>, hipFuncAttributeMaxDynamicSharedMemorySize, LDS_BYTES) != hipSuccess ||
            hipFuncSetAttribute((const void*)hybrid_fwd<2>, hipFuncAttributeMaxDynamicSharedMemorySize, LDS_BYTES) != hipSuccess || hipFuncSetAttribute((const void*)hybrid_fwd<3>, hipFuncAttributeMaxDynamicSharedMemorySize, LDS_BYTES) != hipSuccess) { fprintf(stderr, "kernel_launch: hipFuncSetAttribute failed\n"); grid = -1; return; }
#endif
        if (hipOccupancyMaxActiveBlocksPerMultiprocessor(&per_cu, (const void*)hybrid_fwd<(ONE_LAUNCH ? -1 : 0)>, NTHR, LDS_BYTES) != hipSuccess || per_cu < 1) { fprintf(stderr, "kernel_launch: occupancy query reports %d workgroups per CU: the grid would not be resident; nothing launched\n", per_cu); (void)hipGetLastError(); grid = -1; return; }
        (void)hipGetLastError();
        grid = cus;
        if (grid != 256) { fprintf(stderr, "kernel_launch: %d CUs; this kernel is laid out for 256 workgroups; nothing launched\n", grid); grid = -1; return; }
    }
    if (grid < 0) return;
    if (hipMemsetAsync((char*)d_ws + WS_CTL, 0, CTL_ZERO_BYTES, stream) != hipSuccess) return;
    Args a{};
    for (int i = 0; i < 40; ++i) a.in[i] = (const float*)d_in[i];
    a.out = (float*)d_out; a.ws = (unsigned char*)d_ws;
    for (int j = 0; j < 32; ++j) a.inv_freq[j] = (float)pow(10000.0, -(double)j / 32.0);
#if ONE_LAUNCH
    a.g_lo = 0; a.g_hi = G_END;
    hipLaunchKernelGGL(hybrid_fwd<-1>, dim3(grid), dim3(NTHR), LDS_BYTES, stream, a);
#else
    for (int g = 0; g < G_END; ++g) {
        a.g_lo = g; a.g_hi = g + 1;
        int grp = 1;
        if (g >= 1 && g < G_FINAL) { const int k = (g - 1) % NPH; grp = (k == 0 || k == 4) ? 1 : (k == 5) ? 2 : (k == 6) ? 3 : 0; }
        if (grp == 0) hipLaunchKernelGGL(hybrid_fwd<0>, dim3(grid), dim3(NTHR), LDS_BYTES, stream, a);
        else if (grp == 1) hipLaunchKernelGGL(hybrid_fwd<1>, dim3(grid), dim3(NTHR), LDS_BYTES, stream, a);
        else if (grp == 2) hipLaunchKernelGGL(hybrid_fwd<2>, dim3(grid), dim3(NTHR), LDS_BYTES, stream, a);
        else hipLaunchKernelGGL(hybrid_fwd<3>, dim3(grid), dim3(NTHR), LDS_BYTES, stream, a);
    }
#endif
}
```
